# Optimizing an MI355X kernel written in HIP

```python
import jax, jax.numpy as jnp
from jax import lax
import numpy as np

D_MODEL = 2048
BATCH = 4
SEQ = 2048
DEPTH = 2
DEC_BATCH = 128
DEC_SEQ = 4
PAST_LEN = 16384
PAGE_SIZE = 128

HGRN_WIDTH = D_MODEL // 2
HGRN_HEAD_DIM = 128
HGRN_HEADS = HGRN_WIDTH // HGRN_HEAD_DIM
HGRN_CHUNK = 64
POOL_WIDTH = D_MODEL - HGRN_WIDTH
POOL_WINDOWS = (2, 4, 8, 16)
POOL_GROUPS = len(POOL_WINDOWS)
POOL_GROUP_DIM = POOL_WIDTH // POOL_GROUPS
POOL_BUF = max(POOL_WINDOWS) - 1
IN_PROJ_WIDTH = 4 * HGRN_WIDTH + POOL_WIDTH
PEER_HEADS = 8
PEER_N_KEYS = 128
PEER_N_EXPERTS = PEER_N_KEYS ** 2
PEER_TOPK = 16
PEER_QUERY_DIM = 256
PEER_HALF = PEER_QUERY_DIM // 2
PEER_BLOCK = 128
N_MOD = 6
EPS = 1e-6

kernel_name = "hgrn2_pool_peer_hybrid_step"


def rmsnorm(x, g):
    xf = x.astype(jnp.float32)
    y = xf * lax.rsqrt(jnp.mean(xf * xf, axis=-1, keepdims=True) + EPS)
    return (y * g.astype(jnp.float32)).astype(x.dtype)


def modulate(x, shift, scale):
    return x * (1 + scale[:, None]) + shift[:, None]


def hgrn2_chunked(q, k, v, log_f, s0, chunk):
    dt = v.dtype
    B, T, H, DK = q.shape
    DV = v.shape[-1]
    n = -(-T // chunk)
    pad = n * chunk - T

    def prep(a):
        a = jnp.pad(a.astype(jnp.float32), ((0, 0), (0, pad), (0, 0), (0, 0)))
        return a.reshape(B, n, chunk, H, a.shape[-1]).swapaxes(0, 1)

    mask = jnp.tril(jnp.ones((chunk, chunk), dtype=bool))[None, :, :, None, None]

    def step(S, inp):
        qc, kc, vc, gc = inp
        G = jnp.cumsum(gc, axis=1)
        o_inter = jnp.einsum('bthk,bhkv->bthv', qc * jnp.exp(G), S)
        diff = G[:, :, None] - G[:, None, :]
        decay = jnp.exp(jnp.where(mask, diff, -jnp.inf))
        A = jnp.einsum('bthk,bshk,btshk->bths', qc, kc, decay)
        o_intra = jnp.einsum('bths,bshv->bthv', A, vc)
        g_end = G[:, -1]
        k_dec = kc * jnp.exp(g_end[:, None] - G)
        S_new = jnp.exp(g_end)[..., None] * S + jnp.einsum('bshk,bshv->bhkv', k_dec, vc)
        return S_new, o_inter + o_intra

    S_fin, o = lax.scan(step, s0.astype(jnp.float32), (prep(q), prep(k), prep(v), prep(log_f)))
    o = o.swapaxes(0, 1).reshape(B, n * chunk, H, DV)[:, :T]
    return o.astype(dt), S_fin.astype(s0.dtype)


def multiscale_pool(v, buf, start_pos):
    B, T, W = v.shape
    full = jnp.concatenate([buf.astype(v.dtype), v], axis=1)
    cs = jnp.pad(jnp.cumsum(full.astype(jnp.float32), axis=1), ((0, 0), (1, 0), (0, 0)))
    pos = start_pos + jnp.arange(T, dtype=jnp.int32)
    vf = v.astype(jnp.float32)
    outs = []
    for gi, w in enumerate(POOL_WINDOWS):
        sl = slice(gi * POOL_GROUP_DIM, (gi + 1) * POOL_GROUP_DIM)
        hi = cs[:, POOL_BUF + 1:POOL_BUF + 1 + T, sl]
        lo = cs[:, POOL_BUF + 1 - w:POOL_BUF + 1 - w + T, sl]
        cnt = jnp.minimum(w, pos + 1).astype(jnp.float32)
        outs.append((hi - lo) / cnt[None, :, None] - vf[..., sl])
    pooled = jnp.stack(outs, axis=2)
    return pooled, full[:, -POOL_BUF:]


def peer_ffn(h, wq, keys, u_tab, v_tab):
    B, T, D = h.shape
    N = B * T
    xt = h.reshape(N, D)
    qry = (xt @ wq).reshape(N, PEER_HEADS, 2, PEER_HALF).astype(jnp.float32)
    qry = qry * lax.rsqrt(jnp.mean(qry * qry, axis=-1, keepdims=True) + EPS)
    scores = jnp.einsum('nhpd,hpkd->nhpk', qry, keys.astype(jnp.float32))
    s1, i1 = lax.top_k(scores[:, :, 0], PEER_TOPK)
    s2, i2 = lax.top_k(scores[:, :, 1], PEER_TOPK)
    cand = (s1[..., :, None] + s2[..., None, :]).reshape(N, PEER_HEADS, PEER_TOPK * PEER_TOPK)
    cidx = (i1[..., :, None] * PEER_N_KEYS + i2[..., None, :]).reshape(N, PEER_HEADS, PEER_TOPK * PEER_TOPK)
    top_s, top_pos = lax.top_k(cand, PEER_TOPK)
    eidx = jnp.take_along_axis(cidx, top_pos, axis=-1)
    gate = jax.nn.softmax(top_s, axis=-1).astype(h.dtype)
    nb = -(-N // PEER_BLOCK)
    pad = nb * PEER_BLOCK - N
    xb = jnp.pad(xt, ((0, pad), (0, 0))).reshape(nb, PEER_BLOCK, D)
    eb = jnp.pad(eidx, ((0, pad), (0, 0), (0, 0))).reshape(nb, PEER_BLOCK, PEER_HEADS, PEER_TOPK)
    gb = jnp.pad(gate, ((0, pad), (0, 0), (0, 0))).reshape(nb, PEER_BLOCK, PEER_HEADS, PEER_TOPK)

    def block(args):
        xs, es, gs = args
        u = u_tab[es]
        a = jax.nn.gelu(jnp.einsum('bd,bhkd->bhk', xs, u), approximate=False) * gs
        return jnp.einsum('bhk,bhkd->bd', a, v_tab[es])

    out = lax.map(block, (xb, eb, gb)).reshape(nb * PEER_BLOCK, D)[:N]
    return out.reshape(B, T, D)


def hybrid_layer(x, c, hgrn_state, pool_buf, start_pos, lb, w_ada, b_ada, norm1_g, norm2_g,
                 w_in, w_out, hgrn_norm_g, pool_w, pool_b, pool_scale,
                 peer_wq, peer_keys, peer_u, peer_v):
    B, T, D = x.shape
    mod = jax.nn.silu(c) @ w_ada + b_ada
    sh1, sc1, g1, sh2, sc2, g2 = jnp.split(mod, N_MOD, axis=-1)
    h = modulate(rmsnorm(x, norm1_g), sh1, sc1)
    z = h @ w_in
    zq, zf, zi, zg, zp = jnp.split(
        z, [HGRN_WIDTH, 2 * HGRN_WIDTH, 3 * HGRN_WIDTH, 4 * HGRN_WIDTH], axis=-1)

    def heads(a):
        return a.reshape(B, T, HGRN_HEADS, HGRN_HEAD_DIM)

    q = jax.nn.silu(heads(zq))
    zf32 = heads(zf).astype(jnp.float32)
    lbh = lb.reshape(HGRN_HEADS, HGRN_HEAD_DIM).astype(jnp.float32)
    log_f = jnp.logaddexp(jnp.log(lbh), jnp.log1p(-lbh) + jax.nn.log_sigmoid(zf32))
    k = (1 - lbh) * jax.nn.sigmoid(-zf32)
    o, new_state = hgrn2_chunked(q, k, heads(zi), log_f, hgrn_state, min(HGRN_CHUNK, T))
    o_a = (rmsnorm(o, hgrn_norm_g) * jax.nn.silu(heads(zg))).reshape(B, T, HGRN_WIDTH)

    pooled, new_buf = multiscale_pool(zp, pool_buf, start_pos)
    pooled = pooled.astype(x.dtype)
    o_b = (jnp.einsum('btgi,gio->btgo', pooled, pool_w)
           + pool_b.reshape(POOL_GROUPS, POOL_GROUP_DIM)) * pool_scale.reshape(POOL_GROUPS, POOL_GROUP_DIM)
    o_b = o_b.reshape(B, T, POOL_WIDTH)

    mix = jnp.concatenate([o_a, o_b], axis=-1) @ w_out
    x = x + g1[:, None] * mix

    h2 = modulate(rmsnorm(x, norm2_g), sh2, sc2)
    x = x + g2[:, None] * peer_ffn(h2, peer_wq, peer_keys, peer_u, peer_v)
    return x, new_state, new_buf


def setup_inputs(seed: int = 0) -> dict:
    key = jax.random.key(seed)
    ks = jax.random.split(key, 24)

    def nrm(k, shape, scale):
        return jax.random.normal(k, shape, jnp.float32) * scale

    D = D_MODEL
    return {
        "x_prompt": nrm(ks[0], (BATCH, SEQ, D), 1.0),
        "x_sample": nrm(ks[1], (DEC_BATCH, DEC_SEQ, D), 1.0),
        "c_prompt": nrm(ks[2], (BATCH, D), 1.0),
        "c_sample": nrm(ks[3], (DEC_BATCH, D), 1.0),
        "state_hgrn": nrm(ks[4], (DEPTH, DEC_BATCH, HGRN_HEADS, HGRN_HEAD_DIM, HGRN_HEAD_DIM), 0.2),
        "state_pool": nrm(ks[5], (DEPTH, DEC_BATCH, POOL_BUF, POOL_WIDTH), 1.0),
        "w_ada": nrm(ks[6], (DEPTH, D, N_MOD * D), 0.5 * D ** -0.5),
        "b_ada": nrm(ks[7], (DEPTH, N_MOD * D), 0.01),
        "norm1_g": 1.0 + nrm(ks[8], (DEPTH, D), 0.02),
        "norm2_g": 1.0 + nrm(ks[9], (DEPTH, D), 0.02),
        "w_in": nrm(ks[10], (DEPTH, D, IN_PROJ_WIDTH), D ** -0.5),
        "w_out": nrm(ks[11], (DEPTH, D, D), D ** -0.5),
        "lb_logits": nrm(ks[12], (DEPTH, HGRN_WIDTH), 1.0),
        "hgrn_norm_g": 1.0 + nrm(ks[13], (DEPTH, HGRN_HEAD_DIM), 0.02),
        "pool_w": nrm(ks[14], (DEPTH, POOL_GROUPS, POOL_GROUP_DIM, POOL_GROUP_DIM), POOL_GROUP_DIM ** -0.5),
        "pool_b": nrm(ks[15], (DEPTH, POOL_WIDTH), 0.01),
        "pool_scale": 1.0 + nrm(ks[16], (DEPTH, POOL_WIDTH), 0.02),
        "peer_wq": nrm(ks[17], (DEPTH, D, PEER_HEADS * PEER_QUERY_DIM), D ** -0.5),
        "peer_keys": nrm(ks[18], (DEPTH, PEER_HEADS, 2, PEER_N_KEYS, PEER_HALF), PEER_HALF ** -0.5),
        "peer_u": nrm(ks[19], (DEPTH, PEER_N_EXPERTS, D), D ** -0.5),
        "peer_v": nrm(ks[20], (DEPTH, PEER_N_EXPERTS, D), PEER_HEADS ** -0.5),
        "final_g": 1.0 + nrm(ks[21], (D,), 0.02),
        "w_ada_final": nrm(ks[22], (D, 2 * D), 0.5 * D ** -0.5),
        "b_ada_final": nrm(ks[23], (2 * D,), 0.01),
    }


def reference(x_prompt, x_sample, c_prompt, c_sample, state_hgrn, state_pool,
              w_ada, b_ada, norm1_g, norm2_g, w_in, w_out, lb_logits, hgrn_norm_g,
              pool_w, pool_b, pool_scale, peer_wq, peer_keys, peer_u, peer_v,
              final_g, w_ada_final, b_ada_final):
    lb_all = jnp.cumsum(jax.nn.softmax(lb_logits.astype(jnp.float32), axis=0), axis=0)
    lb_all = lb_all - lb_all[0:1]

    zero_state = jnp.zeros((BATCH, HGRN_HEADS, HGRN_HEAD_DIM, HGRN_HEAD_DIM), x_prompt.dtype)
    zero_buf = jnp.zeros((BATCH, POOL_BUF, POOL_WIDTH), x_prompt.dtype)

    xp, xs = x_prompt, x_sample
    sp_list, bp_list, ss_list, bs_list = [], [], [], []
    for l in range(DEPTH):
        w = (lb_all[l], w_ada[l], b_ada[l], norm1_g[l], norm2_g[l], w_in[l], w_out[l],
             hgrn_norm_g[l], pool_w[l], pool_b[l], pool_scale[l],
             peer_wq[l], peer_keys[l], peer_u[l], peer_v[l])
        xp, sp, bp = hybrid_layer(xp, c_prompt, zero_state, zero_buf, 0, *w)
        xs, ss, bs = hybrid_layer(xs, c_sample, state_hgrn[l], state_pool[l], PAST_LEN, *w)
        sp_list.append(sp)
        bp_list.append(bp)
        ss_list.append(ss)
        bs_list.append(bs)

    def final_norm(x, c):
        mod = jax.nn.silu(c) @ w_ada_final + b_ada_final
        sh, sc = jnp.split(mod, 2, axis=-1)
        return modulate(rmsnorm(x, final_g), sh, sc)

    y_prompt = final_norm(xp, c_prompt)
    y_sample = final_norm(xs, c_sample)
    return (y_prompt, y_sample, jnp.stack(sp_list), jnp.stack(bp_list), jnp.stack(ss_list), jnp.stack(bs_list))
```

```cpp
#ifndef HIPEMU
#include <hip/hip_runtime.h>
#include <cstdio>
#endif
#include <stdint.h>

#ifndef CFG_PB
#define CFG_PB 4
#define CFG_SEQ 2048
#define CFG_DB 128
#endif

#ifdef HIPEMU
#define DEV inline
#define LAS
#define READLANE_I(v, l) emu_readlane((v), (l))
#define READLANE_F(v, l) emu_readlane_f((v), (l))
#define MFMA_BF16(a, b, c) emu_mfma_bf16_16x16x32((a), (b), (c))
#define MFMA_F32(a, b, c) emu_mfma_f32_16x16x4((a), (b), (c))
#define __expf expf
#define __logf logf
#else
#define DEV __device__ __forceinline__
#define LAS __attribute__((address_space(3)))
#define READLANE_I(v, l) __builtin_amdgcn_readlane((v), (l))
#define READLANE_F(v, l) __uint_as_float((unsigned)__builtin_amdgcn_readlane((int)__float_as_uint(v), (l)))
#define MFMA_BF16(a, b, c) __builtin_amdgcn_mfma_f32_16x16x32_bf16((a), (b), (c), 0, 0, 0)
#define MFMA_F32(a, b, c) __builtin_amdgcn_mfma_f32_16x16x4f32((a), (b), (c), 0, 0, 0)
#endif

typedef unsigned short bf16_t;
typedef short bf16x8 __attribute__((ext_vector_type(8)));
typedef float f32x4 __attribute__((ext_vector_type(4)));
typedef unsigned u32x4 __attribute__((ext_vector_type(4)));
typedef unsigned u32x2 __attribute__((ext_vector_type(2)));

namespace cfg {
constexpr int D = 2048, PB = CFG_PB, SEQ = CFG_SEQ, DB = CFG_DB, DSEQ = 4;
constexpr int NP = PB * SEQ, NS = DB * DSEQ, NTOK = NP + NS, MPAD = (NTOK + 255) / 256 * 256;
constexpr int NC = PB + DB;
constexpr int HH = 8, HD = 128, PW = 1024, PBUF = 15, ZW = 5120;
constexpr int NE = 16384;
constexpr int NMOD = 6 * D;
constexpr int MODW = 2 * NMOD + 2 * D;
constexpr float EPS = 1e-6f;
constexpr int NCHAIN = PB * HH;
constexpr size_t OFF_Y = 0;
constexpr size_t OFF_HP = (size_t)NTOK * D;
constexpr size_t OFF_PP = OFF_HP + (size_t)2 * PB * HH * HD * HD;
constexpr size_t OFF_HS = OFF_PP + (size_t)2 * PB * PBUF * PW;
constexpr size_t OFF_PS = OFF_HS + (size_t)2 * DB * HH * HD * HD;
constexpr size_t OUT_TOTAL = OFF_PS + (size_t)2 * DB * PBUF * PW;
}
using namespace cfg;

struct Params {
    const float *x_prompt, *x_sample, *c_prompt, *c_sample, *state_hgrn, *state_pool, *w_ada, *b_ada, *norm1_g, *norm2_g, *w_in, *w_out,
        *lb_logits, *hgrn_norm_g, *pool_w, *pool_b, *pool_scale, *peer_wq, *peer_keys, *peer_u, *peer_v, *final_g, *w_ada_final, *b_ada_final;
    float* out;
    unsigned* bar; float* modbuf; bf16_t* csil; bf16_t* wt_ada; bf16_t* wt_in; bf16_t* wt_out; bf16_t* wt_q; bf16_t* wt_pool;
    bf16_t* ub; bf16_t* vb; bf16_t* hA; bf16_t* hB; bf16_t* z; bf16_t* pooled; bf16_t* cat; float* xa; float* xb; float* qry; int* eidx; float* gate;
    int ph_lo, ph_hi;
};

DEV float bf2f(unsigned v) { return __uint_as_float(v << 16); }
DEV unsigned f2bf(float f) { unsigned u = __float_as_uint(f); u += 0x7fffu + ((u >> 16) & 1u); return u >> 16; }
DEV unsigned pack2(float lo, float hi) {
#ifdef HIPEMU
    return f2bf(lo) | (f2bf(hi) << 16);
#else
    unsigned r; asm volatile("v_cvt_pk_bf16_f32 %0, %1, %2" : "=v"(r) : "v"(lo), "v"(hi)); return r;
#endif
}
DEV float lo16(unsigned w) { return __uint_as_float(w << 16); }
DEV float hi16(unsigned w) { return __uint_as_float(w & 0xffff0000u); }
DEV float wave_sum(float v) { v += __shfl_xor(v, 32); v += __shfl_xor(v, 16); v += __shfl_xor(v, 8); v += __shfl_xor(v, 4); v += __shfl_xor(v, 2); v += __shfl_xor(v, 1); return v; }
DEV float wave_max(float v) { v = fmaxf(v, __shfl_xor(v, 32)); v = fmaxf(v, __shfl_xor(v, 16)); v = fmaxf(v, __shfl_xor(v, 8)); v = fmaxf(v, __shfl_xor(v, 4)); v = fmaxf(v, __shfl_xor(v, 2)); v = fmaxf(v, __shfl_xor(v, 1)); return v; }
DEV float sigmoidf_(float x) { return 1.0f / (1.0f + __expf(-x)); }
DEV float siluf_(float x) { return x / (1.0f + __expf(-x)); }
DEV float gelu_erf(float x) { return 0.5f * x * (1.0f + erff(x * 0.70710678118f)); }
DEV int tok_batch(int t) { return t < NP ? t / SEQ : PB + (t - NP) / DSEQ; }

namespace pg8 {
constexpr int BM = 256, BK = 64, HALF = 128, HTB = HALF * BK * 2, STAGE_BYTES = 8 * HTB, NXCD = 8, WGM = 8;
DEV int lds_byte(int r, int c) { const int st = (r >> 4) * 2 + (c >> 5), rr = r & 15, cc = c & 31, ob = rr * 64 + cc * 2; return st * 1024 + (ob ^ (((ob >> 9) & 1) << 5)); }
DEV void stage_rc(int b, int& R, int& C) { const int st = b / 1024, sb = b % 1024, swz = sb ^ (((sb >> 9) & 1) << 5); R = (st >> 1) * 16 + swz / 64; C = (st & 1) * 32 + (swz % 64) / 2; }
DEV int perm32(int rho) { const int n = rho >> 4, i = rho & 15; return 8 * (i >> 2) + 4 * n + (i & 3); }
struct Unit { int pm, pn; };
struct Gemm { const bf16_t* A; const bf16_t* Bt; int M, N, K; };
struct StaticOrder {
    int nM, nN, nwg, G, c;
    DEV void init(int M, int N, int G_, int c_) { nM = M / BM; nN = N / BM; nwg = nM * nN; G = G_; c = c_; }
    DEV bool next(int i, Unit& u) const {
        const long L = (long)i * G + c; if (L >= nwg) return false;
        int wgid = (int)L; { const int q = nwg / NXCD, r = nwg % NXCD, xcd = wgid % NXCD, off = wgid / NXCD; wgid = (xcd < r ? xcd * (q + 1) : r * (q + 1) + (xcd - r) * q) + off; }
        const int nig = WGM * nN, gid = wgid / nig, fm = gid * WGM, gsz = (nM - fm) < WGM ? (nM - fm) : WGM;
        u.pm = fm + ((wgid % nig) % gsz); u.pn = (wgid % nig) / gsz; return true;
    }
    DEV void a_ready(const Unit&) const {}
    DEV void done(const Unit&) const {}
};
struct PoolOrder {
    int G, c;
    DEV bool next(int i, Unit& u) const { const int L = i * G + c; if (L >= 4 * (MPAD / 256)) return false; u.pm = L; u.pn = L / (MPAD / 256); return true; }
    DEV void a_ready(const Unit&) const {}
    DEV void done(const Unit&) const {}
};

struct EpiF32 {
    static constexpr bool PERM = false;
    float* C; int ldc;
    DEV void operator()(const f32x4 (&acc)[2][2][4][2], const Unit& u, int wr, int wc, int fr, int fq) const {
        const int row0 = u.pm * BM + wr * 64 + fr, col0 = u.pn * BM + wc * 32 + 4 * fq;
#pragma unroll
        for (int ai = 0; ai < 2; ++ai)
#pragma unroll
            for (int m = 0; m < 4; ++m) { float* rowp = C + (size_t)(row0 + ai * HALF + m * 16) * ldc + col0;
#pragma unroll
                for (int bj = 0; bj < 2; ++bj)
#pragma unroll
                    for (int n = 0; n < 2; ++n) *(f32x4*)(rowp + bj * HALF + n * 16) = acc[ai][bj][m][n]; }
    }
};
struct EpiAda {
    static constexpr bool PERM = false;
    float* C; const float* b_ada; const float* b_fin;
    DEV void operator()(const f32x4 (&acc)[2][2][4][2], const Unit& u, int wr, int wc, int fr, int fq) const {
        const int row0 = u.pm * BM + wr * 64 + fr, col0 = u.pn * BM + wc * 32 + 4 * fq;
        const float* bias = (u.pn * BM < 2 * NMOD) ? b_ada + col0 : b_fin + (col0 - 2 * NMOD);
        f32x4 bv[2][2];
#pragma unroll
        for (int bj = 0; bj < 2; ++bj)
#pragma unroll
            for (int n = 0; n < 2; ++n) bv[bj][n] = *(const f32x4*)(bias + bj * HALF + n * 16);
#pragma unroll
        for (int ai = 0; ai < 2; ++ai)
#pragma unroll
            for (int m = 0; m < 4; ++m) { float* rowp = C + (size_t)(row0 + ai * HALF + m * 16) * MODW + col0;
#pragma unroll
                for (int bj = 0; bj < 2; ++bj)
#pragma unroll
                    for (int n = 0; n < 2; ++n) *(f32x4*)(rowp + bj * HALF + n * 16) = acc[ai][bj][m][n] + bv[bj][n]; }
    }
};
struct EpiResid {
    static constexpr bool PERM = false;
    const float* xlo; const float* xhi; const float* gmod  ; float* out;
    DEV void operator()(const f32x4 (&acc)[2][2][4][2], const Unit& u, int wr, int wc, int fr, int fq) const {
        const int row0 = u.pm * BM + wr * 64 + fr, col0 = u.pn * BM + wc * 32 + 4 * fq;
#pragma unroll
        for (int ai = 0; ai < 2; ++ai)
#pragma unroll
            for (int m = 0; m < 4; ++m) {
                const int row = row0 + ai * HALF + m * 16;
                if (row < NTOK) {
                    const float* xr = (row < NP ? xlo + (size_t)row * D : xhi + (size_t)(row - NP) * D) + col0;
                    const float* gr = gmod + (size_t)tok_batch(row) * MODW + col0;
                    float* rowp = out + (size_t)row * D + col0;
#pragma unroll
                    for (int bj = 0; bj < 2; ++bj)
#pragma unroll
                        for (int n = 0; n < 2; ++n) { const f32x4 xv = *(const f32x4*)(xr + bj * HALF + n * 16), gv = *(const f32x4*)(gr + bj * HALF + n * 16);
                            *(f32x4*)(rowp + bj * HALF + n * 16) = xv + gv * acc[ai][bj][m][n]; }
                }
            }
    }
};
struct EpiBf16 {
    static constexpr bool PERM = true;
    bf16_t* O; int ldc;
    DEV void operator()(const f32x4 (&acc)[2][2][4][2], const Unit& u, int wr, int wc, int fr, int fq) const {
        const int row0 = u.pm * BM + wr * 64 + fr, col0 = u.pn * BM + wc * 32 + 8 * fq;
#pragma unroll
        for (int ai = 0; ai < 2; ++ai)
#pragma unroll
            for (int m = 0; m < 4; ++m) { bf16_t* rowp = O + (size_t)(row0 + ai * HALF + m * 16) * ldc + col0;
#pragma unroll
                for (int bj = 0; bj < 2; ++bj) { const f32x4 v0 = acc[ai][bj][m][0], v1 = acc[ai][bj][m][1];
                    u32x4 w; w.x = pack2(v0[0], v0[1]); w.y = pack2(v0[2], v0[3]); w.z = pack2(v1[0], v1[1]); w.w = pack2(v1[2], v1[3]);
                    *(u32x4*)(rowp + bj * HALF) = w; } }
    }
};
struct EpiPool {
    static constexpr bool PERM = true;
    bf16_t* cat; const float* pb; const float* ps;
    DEV void operator()(const f32x4 (&acc)[2][2][4][2], const Unit& u, int wr, int wc, int fr, int fq) const {
        const int g = u.pn, tok0 = u.pm * BM - g * MPAD + wr * 64 + fr, col0 = g * 256 + wc * 32 + 8 * fq;
#pragma unroll
        for (int bj = 0; bj < 2; ++bj) {
            const f32x4 b0 = *(const f32x4*)(pb + col0 + bj * HALF), b1 = *(const f32x4*)(pb + col0 + bj * HALF + 4);
            const f32x4 s0 = *(const f32x4*)(ps + col0 + bj * HALF), s1 = *(const f32x4*)(ps + col0 + bj * HALF + 4);
#pragma unroll
            for (int ai = 0; ai < 2; ++ai)
#pragma unroll
                for (int m = 0; m < 4; ++m) { const int tok = tok0 + ai * HALF + m * 16;
                    if (tok < NTOK) { const f32x4 v0 = (acc[ai][bj][m][0] + b0) * s0, v1 = (acc[ai][bj][m][1] + b1) * s1;
                        u32x4 w; w.x = pack2(v0[0], v0[1]); w.y = pack2(v0[2], v0[3]); w.z = pack2(v1[0], v1[1]); w.w = pack2(v1[2], v1[3]);
                        *(u32x4*)(cat + (size_t)tok * D + 1024 + col0 + bj * HALF) = w; } }
        }
    }
};

#ifdef HIPEMU
template <class Epi, class Sched>
static void gemm_phase(unsigned char*, const Gemm g, const Sched& S, const Epi& E) {
    const int tid = threadIdx.x, wid = tid >> 6, lane = tid & 63, wr = wid >> 2, wc = wid & 3, fr = lane & 15, fq = lane >> 4;
    Unit cur;
    for (int ui = 0; S.next(ui, cur); ++ui) {
        f32x4 acc[2][2][4][2];
        for (int ai = 0; ai < 2; ++ai) for (int bj = 0; bj < 2; ++bj) for (int m = 0; m < 4; ++m) for (int n = 0; n < 2; ++n) for (int j = 0; j < 4; ++j) {
            const int row = 256 * cur.pm + 128 * ai + 64 * wr + 16 * m + fr;
            const int col = Epi::PERM ? 256 * cur.pn + 128 * bj + 32 * wc + 8 * fq + 4 * n + j : 256 * cur.pn + 128 * bj + 32 * wc + 16 * n + 4 * fq + j;
            float s = 0.f;
            if ((row % emu_row_mod) < emu_row_limit) { const float* a = emu_f32_copy(g.A, (size_t)g.M * g.K) + (size_t)row * g.K; const float* b = emu_f32_copy(g.Bt, (size_t)g.N * g.K) + (size_t)col * g.K;
                for (int k = 0; k < g.K; ++k) s += a[k] * b[k]; }
            acc[ai][bj][m][n][j] = s; }
        E(acc, cur, wr, wc, fr, fq);
    }
    __syncthreads();
}
#else
template <class Epi, class Sched>
__device__ __forceinline__ void gemm_phase(LAS unsigned char* lds, const Gemm g, const Sched& S, const Epi& E) {
    const int tid = threadIdx.x, wid = __builtin_amdgcn_readfirstlane(tid >> 6), lane = tid & 63, wr = wid >> 2, wc = wid & 3, fr = lane & 15, fq = lane >> 4;
    int K = g.K; asm volatile("" : "+s"(K));
    const int nt = K / BK;
    unsigned voffA[2], voffB[2];
#pragma unroll
    for (int i = 0; i < 2; ++i) { int R, C; stage_rc(tid * 16 + i * 8192, R, C); const int Rb = Epi::PERM ? ((R & ~31) + perm32(R & 31)) : R;
        voffA[i] = (unsigned)(R * K + C) * 2u; voffB[i] = (unsigned)(Rb * K + C) * 2u; }
    const size_t kstep = (size_t)(BK * 2);
    const size_t hstep = (size_t)HALF * K * 2;
    const size_t tstep = 2 * hstep;
    const unsigned ldsw = (unsigned)wid * 1024u;
    const int aoff = lds_byte(wr * 64 + fr, fq * 8), boff = lds_byte(wc * 32 + fr, fq * 8);
#define PG8_SA(b, h) (((b) * 2 + (h)) * HTB)
#define PG8_SB(b, h) ((4 + (b) * 2 + (h)) * HTB)
#define PG8_STAGE(bufoff, gbase, voff) do { _Pragma("unroll") for (int _i = 0; _i < 2; ++_i) \
        __builtin_amdgcn_global_load_lds((const unsigned*)((const char*)(gbase) + (voff)[_i]), (LAS unsigned*)(lds + (bufoff) + ldsw + _i * 8192), 16, 0, 0); } while (0)
#define PG8_LDA(dst, b, h) do { _Pragma("unroll") for (int m = 0; m < 4; ++m) _Pragma("unroll") for (int k = 0; k < 2; ++k) dst[m][k] = *(const LAS bf16x8*)(lds + PG8_SA(b, h) + aoff + m * 2048 + k * 1024); } while (0)
#define PG8_LDB(dst, b, h) do { _Pragma("unroll") for (int n = 0; n < 2; ++n) _Pragma("unroll") for (int k = 0; k < 2; ++k) dst[n][k] = *(const LAS bf16x8*)(lds + PG8_SB(b, h) + boff + n * 2048 + k * 1024); } while (0)
#define PG8_MMA(ai, bj, At, Bt) do { __builtin_amdgcn_s_setprio(1); _Pragma("unroll") for (int m = 0; m < 4; ++m) _Pragma("unroll") for (int n = 0; n < 2; ++n) _Pragma("unroll") for (int k = 0; k < 2; ++k) \
        acc[ai][bj][m][n] = __builtin_amdgcn_mfma_f32_16x16x32_bf16(Bt[n][k], At[m][k], acc[ai][bj][m][n], 0, 0, 0); __builtin_amdgcn_s_setprio(0); } while (0)
#define PG8_WAIT_V(n) asm volatile("s_waitcnt vmcnt(" #n ")" ::: "memory")
#define PG8_WAIT_L(n) asm volatile("s_waitcnt lgkmcnt(" #n ")" ::: "memory")
#define PG8_BAR __builtin_amdgcn_s_barrier()
#define PG8_SCHED __builtin_amdgcn_sched_barrier(0)
    Unit cur, nxt; int ui = 0;
    if (!S.next(0, cur)) return;
    f32x4 acc[2][2][4][2];
#pragma unroll
    for (int a = 0; a < 2; ++a)
#pragma unroll
        for (int b = 0; b < 2; ++b)
#pragma unroll
            for (int m = 0; m < 4; ++m)
#pragma unroll
                for (int n = 0; n < 2; ++n) acc[a][b][m][n] = (f32x4){0.f, 0.f, 0.f, 0.f};
    bf16x8 At[4][2], B0[2][2], B1[2][2];
    const char* cA = (const char*)g.A + (size_t)cur.pm * tstep; const char* cB = (const char*)g.Bt + (size_t)cur.pn * tstep;
    S.a_ready(cur);
    PG8_STAGE(PG8_SB(0, 0), cB, voffB); PG8_STAGE(PG8_SA(0, 0), cA, voffA); PG8_STAGE(PG8_SB(0, 1), cB + hstep, voffB); PG8_STAGE(PG8_SA(0, 1), cA + hstep, voffA);
    if (wr == 1) PG8_BAR;
    PG8_WAIT_V(4); PG8_BAR;
    PG8_STAGE(PG8_SB(1, 0), cB + kstep, voffB); PG8_STAGE(PG8_SA(1, 0), cA + kstep, voffA); PG8_STAGE(PG8_SB(1, 1), cB + hstep + kstep, voffB);
    PG8_WAIT_V(6); PG8_BAR;
    for (;;) {
        const bool has_next = S.next(ui + 1, nxt);
        const char* nA = has_next ? (const char*)g.A + (size_t)nxt.pm * tstep : cA; const char* nB = has_next ? (const char*)g.Bt + (size_t)nxt.pn * tstep : cB;
        for (int t = 0; t < nt; t += 2) {
            const bool last = (t == nt - 2);
            const char* a1 = cA + (size_t)(t + 1) * kstep;
            const char* a2 = last ? nA : cA + (size_t)(t + 2) * kstep; const char* b2 = last ? nB : cB + (size_t)(t + 2) * kstep;
            const char* a3 = a2 + kstep; const char* b3 = b2 + kstep;
            if (last && has_next) S.a_ready(nxt);
            PG8_LDB(B0, 0, 0); PG8_SCHED; PG8_LDA(At, 0, 0); PG8_STAGE(PG8_SA(1, 1), a1 + hstep, voffA);
            PG8_WAIT_L(8); PG8_BAR; PG8_WAIT_L(0); PG8_MMA(0, 0, At, B0); PG8_BAR; PG8_SCHED;
            PG8_LDB(B1, 0, 1); PG8_STAGE(PG8_SB(0, 0), b2, voffB);
            PG8_BAR; PG8_WAIT_L(0); PG8_MMA(0, 1, At, B1); PG8_BAR;
            PG8_LDA(At, 0, 1); PG8_STAGE(PG8_SA(0, 0), a2, voffA);
            PG8_BAR; PG8_WAIT_L(0); PG8_MMA(1, 0, At, B0); PG8_BAR; PG8_SCHED;
            PG8_STAGE(PG8_SB(0, 1), b2 + hstep, voffB);
            PG8_WAIT_V(6); PG8_BAR; PG8_MMA(1, 1, At, B1); PG8_BAR;
            PG8_LDB(B0, 1, 0); PG8_SCHED; PG8_LDA(At, 1, 0); PG8_STAGE(PG8_SA(0, 1), a2 + hstep, voffA);
            PG8_WAIT_L(8); PG8_BAR; PG8_WAIT_L(0); PG8_MMA(0, 0, At, B0); PG8_BAR; PG8_SCHED;
            PG8_LDB(B1, 1, 1); PG8_STAGE(PG8_SB(1, 0), b3, voffB);
            PG8_BAR; PG8_WAIT_L(0); PG8_MMA(0, 1, At, B1); PG8_BAR;
            PG8_LDA(At, 1, 1); PG8_STAGE(PG8_SA(1, 0), a3, voffA);
            PG8_BAR; PG8_WAIT_L(0); PG8_MMA(1, 0, At, B0); PG8_BAR; PG8_SCHED;
            PG8_STAGE(PG8_SB(1, 1), b3 + hstep, voffB);
            PG8_WAIT_V(6); PG8_BAR; PG8_MMA(1, 1, At, B1); PG8_BAR;
        }
        { int tz = threadIdx.x; asm volatile("" : "+v"(tz)); const int wz = tz >> 6, lz = tz & 63;
          E(acc, cur, wz >> 2, wz & 3, lz & 15, lz >> 4); } S.done(cur);
        if (!has_next) break;
#pragma unroll
        for (int a = 0; a < 2; ++a)
#pragma unroll
            for (int b = 0; b < 2; ++b)
#pragma unroll
                for (int m = 0; m < 4; ++m)
#pragma unroll
                    for (int n = 0; n < 2; ++n) acc[a][b][m][n] = (f32x4){0.f, 0.f, 0.f, 0.f};
        cur = nxt; cA = nA; cB = nB; ++ui;
    }
    PG8_WAIT_V(0);
    if (wr == 0) PG8_BAR;
    PG8_BAR;
#undef PG8_SA
#undef PG8_SB
#undef PG8_STAGE
#undef PG8_LDA
#undef PG8_LDB
#undef PG8_MMA
#undef PG8_WAIT_V
#undef PG8_WAIT_L
#undef PG8_BAR
#undef PG8_SCHED
}
#endif
}

DEV void transpose_tile(const float* src, int ld_src, bf16_t* dst, int ld_dst, float* tile) {
    const int tid = threadIdx.x;
#pragma unroll
    for (int i = 0; i < 2; ++i) { const int idx = tid + i * 512, r = idx >> 4, c4 = idx & 15; const f32x4 v = *(const f32x4*)(src + (size_t)r * ld_src + c4 * 4);
        float* t = tile + r * 65 + c4 * 4; t[0] = v[0]; t[1] = v[1]; t[2] = v[2]; t[3] = v[3]; }
    __syncthreads();
    const int n = tid >> 3, kg = tid & 7; const float* t = tile + (kg * 8) * 65 + n;
    u32x4 w; w.x = pack2(t[0], t[65]); w.y = pack2(t[2 * 65], t[3 * 65]); w.z = pack2(t[4 * 65], t[5 * 65]); w.w = pack2(t[6 * 65], t[7 * 65]);
    *(u32x4*)(dst + (size_t)n * ld_dst + kg * 8) = w;
    __syncthreads();
}
DEV int cvt_job_tiles(int j) { const int K = j < 9 ? 2048 : 256; const int N = j < 2 ? NMOD : (j == 2 ? 2 * D : (j < 5 ? ZW : (j < 9 ? D : 256))); return (K / 64) * (N / 64); }
DEV void phase_convert(const Params& p, unsigned char* lds) {
    float* tile = (float*)lds;
    const int tid = threadIdx.x;
    int total = 0;
#pragma unroll
    for (int q = 0; q < 17; ++q) total += cvt_job_tiles(q);
    for (int tl = blockIdx.x; tl < total; tl += gridDim.x) {
        int j = 0, loc = 0, base = 0;
#pragma unroll
        for (int q = 0; q < 17; ++q) { const int cnt = cvt_job_tiles(q); if (tl >= base && tl < base + cnt) { j = q; loc = tl - base; } base += cnt; }
        const float* src; bf16_t* dst; int K = 2048, N;
        if (j < 2) { N = NMOD; src = p.w_ada + (size_t)j * 2048 * NMOD; dst = p.wt_ada + (size_t)j * NMOD * 2048; }
        else if (j == 2) { N = 2 * D; src = p.w_ada_final; dst = p.wt_ada + (size_t)2 * NMOD * 2048; }
        else if (j < 5) { N = ZW; src = p.w_in + (size_t)(j - 3) * 2048 * ZW; dst = p.wt_in + (size_t)(j - 3) * ZW * 2048; }
        else if (j < 7) { N = D; src = p.w_out + (size_t)(j - 5) * D * D; dst = p.wt_out + (size_t)(j - 5) * D * D; }
        else if (j < 9) { N = D; src = p.peer_wq + (size_t)(j - 7) * D * D; dst = p.wt_q + (size_t)(j - 7) * D * D; }
        else { K = 256; N = 256; src = p.pool_w + (size_t)(j - 9) * 65536; dst = p.wt_pool + (size_t)(j - 9) * 65536; }
        const int ntn = N / 64, kt = loc / ntn, nt = loc % ntn;
        transpose_tile(src + (size_t)kt * 64 * N + nt * 64, N, dst + (size_t)nt * 64 * K + kt * 64, K, tile);
    }
    const size_t gt = (size_t)blockIdx.x * 512 + tid, gs = (size_t)gridDim.x * 512;
    const size_t n8 = (size_t)2 * NE * D / 8;
    for (int which = 0; which < 2; ++which) {
        const float* s = which ? p.peer_v : p.peer_u; bf16_t* d = which ? p.vb : p.ub;
        for (size_t i = gt; i < n8; i += gs) { const f32x4 a = *(const f32x4*)(s + i * 8), b = *(const f32x4*)(s + i * 8 + 4);
            u32x4 w; w.x = pack2(a[0], a[1]); w.y = pack2(a[2], a[3]); w.z = pack2(b[0], b[1]); w.w = pack2(b[2], b[3]); *(u32x4*)(d + i * 8) = w; }
    }
    for (size_t i = gt; i < (size_t)256 * D / 8; i += gs) {
        const int row = (int)(i / (D / 8)), c8 = (int)(i % (D / 8)) * 8; u32x4 w = (u32x4){0u, 0u, 0u, 0u};
        if (row < NC) { const float* s = (row < PB ? p.c_prompt + (size_t)row * D : p.c_sample + (size_t)(row - PB) * D) + c8;
            const f32x4 a = *(const f32x4*)s, b = *(const f32x4*)(s + 4);
            w.x = pack2(siluf_(a[0]), siluf_(a[1])); w.y = pack2(siluf_(a[2]), siluf_(a[3])); w.z = pack2(siluf_(b[0]), siluf_(b[1])); w.w = pack2(siluf_(b[2]), siluf_(b[3])); }
        *(u32x4*)(p.csil + i * 8) = w;
    }
}

DEV void phase_norm(const Params& p, const float* xlo, const float* xhi, const float* gn, int sh_off, int sc_off, bf16_t* obf, float* of32) {
    const int lane = threadIdx.x & 63, gw = blockIdx.x * 8 + (threadIdx.x >> 6), nw = gridDim.x * 8;
    for (int t = gw; t < NTOK; t += nw) {
        const float* xr = t < NP ? xlo + (size_t)t * D : xhi + (size_t)(t - NP) * D;
        const float* mrow = p.modbuf + (size_t)tok_batch(t) * MODW;
        f32x4 v[8]; float ss = 0.f;
#pragma unroll
        for (int c = 0; c < 4; ++c) { const int col = c * 512 + lane * 8; v[2 * c] = *(const f32x4*)(xr + col); v[2 * c + 1] = *(const f32x4*)(xr + col + 4);
#pragma unroll
            for (int j = 0; j < 4; ++j) ss += v[2 * c][j] * v[2 * c][j] + v[2 * c + 1][j] * v[2 * c + 1][j]; }
        ss = wave_sum(ss);
        const float rstd = rsqrtf(ss * (1.0f / D) + EPS);
#pragma unroll
        for (int c = 0; c < 4; ++c) { const int col = c * 512 + lane * 8; f32x4 y[2];
#pragma unroll
            for (int q = 0; q < 2; ++q) { const f32x4 g4 = *(const f32x4*)(gn + col + 4 * q), sc = *(const f32x4*)(mrow + sc_off + col + 4 * q), sh = *(const f32x4*)(mrow + sh_off + col + 4 * q);
                y[q] = (v[2 * c + q] * rstd) * g4 * (sc + 1.0f) + sh; }
            if (obf) { u32x4 w; w.x = pack2(y[0][0], y[0][1]); w.y = pack2(y[0][2], y[0][3]); w.z = pack2(y[1][0], y[1][1]); w.w = pack2(y[1][2], y[1][3]); *(u32x4*)(obf + (size_t)t * D + col) = w; }
            else { *(f32x4*)(of32 + (size_t)t * D + col) = y[0]; *(f32x4*)(of32 + (size_t)t * D + col + 4) = y[1]; }
        }
    }
}

namespace hg {
constexpr int QS = 136, VS = 72;
constexpr int O_QT = 0, O_QH = O_QT + 64 * QS * 2, O_KT = O_QH + 64 * QS * 2, O_KDT = O_KT + 160 * QS * 2, O_VT = O_KDT + 128 * VS * 2,
              O_ST = O_VT + 128 * VS * 2, O_AB = O_ST + 128 * QS * 2, O_GS = O_AB + 64 * VS * 2, O_END = O_GS + 4 * 128 * 4;
constexpr int OS = 132;
static_assert(64 * OS * 4 <= 160 * QS * 2, "o buffer must fit in the K~ region");
static_assert(O_END <= 163840 - 64, "HGRN LDS layout too large");
}
DEV int kt_rowbase(int i) { return i == 0 ? 0 : (i == 1 ? 16 : (i == 2 ? 48 : 96)); }

DEV void hgrn_prompt_chain(const Params& p, int l, int unit, unsigned char* lds) {
    using namespace hg;
    const int tid = threadIdx.x, lane = tid & 63, w = tid >> 6, g = lane >> 4, c16 = lane & 15;
    const int b = unit / HH, h = unit % HH;
    bf16_t* Qt = (bf16_t*)(lds + O_QT); bf16_t* Qh = (bf16_t*)(lds + O_QH); bf16_t* Kt = (bf16_t*)(lds + O_KT); float* Ob = (float*)(lds + O_KT);
    bf16_t* Kdt = (bf16_t*)(lds + O_KDT); bf16_t* Vt = (bf16_t*)(lds + O_VT); bf16_t* St = (bf16_t*)(lds + O_ST); bf16_t* Ab = (bf16_t*)(lds + O_AB); float* Gs = (float*)(lds + O_GS);
    const int kk = tid & 127, sj = tid >> 7;
    float lbv = 0.f;
    if (l > 0) lbv = sigmoidf_(p.lb_logits[HH * HD + h * HD + kk] - p.lb_logits[h * HD + kk]);
    const float oml = 1.0f - lbv;
    f32x4 Sacc[8];
#pragma unroll
    for (int i = 0; i < 8; ++i) Sacc[i] = (f32x4){0.f, 0.f, 0.f, 0.f};
    for (int i = tid; i < 128 * QS / 2; i += 512) ((unsigned*)St)[i] = 0u;
    for (int i = tid; i < 64 * VS / 2; i += 512) ((unsigned*)Ab)[i] = 0u;
    __syncthreads();
    const bf16_t* zb = p.z + (size_t)b * SEQ * ZW;
    for (int c = 0; c < SEQ / 64; ++c) {
        float Gl[16], qv[16], kv[16];
        {
            const bf16_t* zr = zb + (size_t)(c * 64 + sj * 16) * ZW + h * HD + kk;
            float run = 0.f; unsigned vpk[8];
#pragma unroll
            for (int s = 0; s < 16; ++s) {
                const float zq = bf2f(zr[(size_t)s * ZW]), zf = bf2f(zr[(size_t)s * ZW + 1024]), zi = bf2f(zr[(size_t)s * ZW + 2048]);
                const float e = __expf(-zf), sg = 1.0f / (1.0f + e);
                const float f = lbv + oml * sg;
                run += __logf(f); Gl[s] = run;
                kv[s] = oml * (e * sg);
                qv[s] = siluf_(zq);
                if (s & 1) vpk[s >> 1] |= f2bf(zi) << 16; else vpk[s >> 1] = f2bf(zi);
            }
            Gs[sj * 128 + kk] = run;
            u32x4 w0 = (u32x4){vpk[0], vpk[1], vpk[2], vpk[3]}, w1 = (u32x4){vpk[4], vpk[5], vpk[6], vpk[7]};
            *(u32x4*)(Vt + kk * VS + sj * 16) = w0; *(u32x4*)(Vt + kk * VS + sj * 16 + 8) = w1;
        }
        __syncthreads();
        {
            const float g0 = Gs[kk], g1 = Gs[128 + kk], g2 = Gs[256 + kk], g3 = Gs[384 + kk];
            float Gb[4]; Gb[0] = 0.f; Gb[1] = g0; Gb[2] = g0 + g1; Gb[3] = g0 + g1 + g2; const float Gend = Gb[3] + g3;
            const float Gbj = sj == 0 ? Gb[0] : (sj == 1 ? Gb[1] : (sj == 2 ? Gb[2] : Gb[3]));
            unsigned kd[8];
#pragma unroll
            for (int s = 0; s < 16; ++s) {
                const int t = sj * 16 + s;
                const float eq = __expf(Gl[s]);
                Qt[t * QS + kk] = (bf16_t)f2bf(qv[s] * eq);
                Qh[t * QS + kk] = (bf16_t)f2bf(qv[s] * eq * __expf(Gbj));
#pragma unroll
                for (int i = 0; i < 4; ++i) if (i >= sj) Kt[(kt_rowbase(i) + t) * QS + kk] = (bf16_t)f2bf(kv[s] * __expf(fminf(Gb[i] - Gbj - Gl[s], 60.f)));
                const unsigned kdv = f2bf(kv[s] * __expf(Gend - Gbj - Gl[s]));
                if (s & 1) kd[s >> 1] |= kdv << 16; else kd[s >> 1] = kdv;
            }
            *(u32x4*)(Kdt + kk * VS + sj * 16) = (u32x4){kd[0], kd[1], kd[2], kd[3]}; *(u32x4*)(Kdt + kk * VS + sj * 16 + 8) = (u32x4){kd[4], kd[5], kd[6], kd[7]};
        }
        __syncthreads();
        for (int blk = w; blk < 10; blk += 8) {
            int bi, bjj;
            if (blk == 0) { bi = 0; bjj = 0; } else if (blk < 3) { bi = 1; bjj = blk - 1; } else if (blk < 6) { bi = 2; bjj = blk - 3; } else { bi = 3; bjj = blk - 6; }
            f32x4 acc = (f32x4){0.f, 0.f, 0.f, 0.f};
#pragma unroll
            for (int ks = 0; ks < 4; ++ks) {
                const bf16x8 a = *(const bf16x8*)(Qt + (16 * bi + c16) * QS + 32 * ks + 8 * g);
                const bf16x8 bb = *(const bf16x8*)(Kt + (kt_rowbase(bi) + 16 * bjj + c16) * QS + 32 * ks + 8 * g);
                acc = MFMA_BF16(a, bb, acc);
            }
#pragma unroll
            for (int r = 0; r < 4; ++r) { const int tl = 4 * g + r; float v = acc[r]; if (bi == bjj && c16 > tl) v = 0.f; Ab[(16 * bi + tl) * VS + 16 * bjj + c16] = (bf16_t)f2bf(v); }
        }
        __syncthreads();
        {
            f32x4 oacc[4];
#pragma unroll
            for (int tt = 0; tt < 4; ++tt) {
                f32x4 acc = (f32x4){0.f, 0.f, 0.f, 0.f};
#pragma unroll
                for (int ks = 0; ks < 4; ++ks) {
                    const bf16x8 a = *(const bf16x8*)(Qh + (16 * tt + c16) * QS + 32 * ks + 8 * g);
                    const bf16x8 bb = *(const bf16x8*)(St + (16 * w + c16) * QS + 32 * ks + 8 * g);
                    acc = MFMA_BF16(a, bb, acc);
                }
#pragma unroll
                for (int ks = 0; ks < 2; ++ks) {
                    const bf16x8 a = *(const bf16x8*)(Ab + (16 * tt + c16) * VS + 32 * ks + 8 * g);
                    const bf16x8 bb = *(const bf16x8*)(Vt + (16 * w + c16) * VS + 32 * ks + 8 * g);
                    acc = MFMA_BF16(a, bb, acc);
                }
                oacc[tt] = acc;
            }
            float gam[4];
#pragma unroll
            for (int r = 0; r < 4; ++r) { const int k2 = 16 * w + 4 * g + r; gam[r] = __expf(Gs[k2] + Gs[128 + k2] + Gs[256 + k2] + Gs[384 + k2]); }
#pragma unroll
            for (int vt = 0; vt < 8; ++vt) {
                f32x4 acc = Sacc[vt];
#pragma unroll
                for (int r = 0; r < 4; ++r) acc[r] *= gam[r];
#pragma unroll
                for (int ks = 0; ks < 2; ++ks) {
                    const bf16x8 a = *(const bf16x8*)(Kdt + (16 * w + c16) * VS + 32 * ks + 8 * g);
                    const bf16x8 bb = *(const bf16x8*)(Vt + (16 * vt + c16) * VS + 32 * ks + 8 * g);
                    acc = MFMA_BF16(a, bb, acc);
                }
                Sacc[vt] = acc;
            }
            __syncthreads();
#pragma unroll
            for (int tt = 0; tt < 4; ++tt)
#pragma unroll
                for (int r = 0; r < 4; ++r) Ob[(16 * tt + 4 * g + r) * OS + 16 * w + c16] = oacc[tt][r];
#pragma unroll
            for (int vt = 0; vt < 8; ++vt) { u32x2 sw; sw.x = pack2(Sacc[vt][0], Sacc[vt][1]); sw.y = pack2(Sacc[vt][2], Sacc[vt][3]); *(u32x2*)(St + (16 * vt + c16) * QS + 16 * w + 4 * g) = sw; }
        }
        __syncthreads();
        {
            const int t = tid >> 3, part = tid & 7; const size_t row = (size_t)b * SEQ + c * 64 + t;
            float ov[16]; float ss = 0.f;
#pragma unroll
            for (int q = 0; q < 4; ++q) { const f32x4 x = *(const f32x4*)(Ob + t * OS + 16 * part + 4 * q); ov[4 * q] = x[0]; ov[4 * q + 1] = x[1]; ov[4 * q + 2] = x[2]; ov[4 * q + 3] = x[3];
                ss += x[0] * x[0] + x[1] * x[1] + x[2] * x[2] + x[3] * x[3]; }
            ss += __shfl_xor(ss, 1); ss += __shfl_xor(ss, 2); ss += __shfl_xor(ss, 4);
            const float rstd = rsqrtf(ss * (1.0f / HD) + EPS);
            const bf16_t* zg = p.z + row * ZW + 3072 + h * HD + 16 * part;
            const u32x4 za = *(const u32x4*)zg, zc = *(const u32x4*)(zg + 8);
            const unsigned zw[8] = {za.x, za.y, za.z, za.w, zc.x, zc.y, zc.z, zc.w};
            const float* gn = p.hgrn_norm_g + l * HD + 16 * part;
            unsigned ow[8];
#pragma unroll
            for (int q = 0; q < 8; ++q) { const float a0 = ov[2 * q] * rstd * gn[2 * q] * siluf_(lo16(zw[q])), a1 = ov[2 * q + 1] * rstd * gn[2 * q + 1] * siluf_(hi16(zw[q])); ow[q] = pack2(a0, a1); }
            bf16_t* dst = p.cat + row * D + h * HD + 16 * part;
            *(u32x4*)dst = (u32x4){ow[0], ow[1], ow[2], ow[3]}; *(u32x4*)(dst + 8) = (u32x4){ow[4], ow[5], ow[6], ow[7]};
        }
    }
    float* so = p.out + OFF_HP + ((size_t)(l * PB + b) * HH + h) * HD * HD;
#pragma unroll
    for (int vt = 0; vt < 8; ++vt)
#pragma unroll
        for (int r = 0; r < 4; ++r) so[(size_t)(16 * w + 4 * g + r) * HD + 16 * vt + c16] = Sacc[vt][r];
    __syncthreads();
}

DEV void hgrn_sample_unit(const Params& p, int l, int unit, unsigned char* lds) {
    const int tid = threadIdx.x, lane = tid & 63, w = tid >> 6;
    const int b = unit / HH, h = unit % HH;
    float* fS = (float*)lds; float* kS = fS + 512; float* qS = kS + 512; float* vS = qS + 512; float* red = vS + 512; float* part = red + 4 * 4 * 128;
    const int r0 = NP + b * DSEQ;
    {
        const int t = tid >> 7, kk = tid & 127; const bf16_t* zr = p.z + (size_t)(r0 + t) * ZW + h * HD + kk;
        float lbv = 0.f; if (l > 0) lbv = sigmoidf_(p.lb_logits[HH * HD + h * HD + kk] - p.lb_logits[h * HD + kk]);
        const float zq = bf2f(zr[0]), zf = bf2f(zr[1024]), zi = bf2f(zr[2048]);
        const float e = __expf(-zf), sg = 1.0f / (1.0f + e);
        fS[tid] = lbv + (1.0f - lbv) * sg; kS[tid] = (1.0f - lbv) * (e * sg); qS[tid] = siluf_(zq); vS[tid] = zi;
    }
    const int v = tid & 127, kq = tid >> 7;
    const float* s0 = p.state_hgrn + ((size_t)(l * DB + b) * HH + h) * HD * HD + (size_t)(32 * kq) * HD + v;
    float S[32];
#pragma unroll
    for (int i = 0; i < 32; ++i) S[i] = s0[(size_t)i * HD];
    __syncthreads();
#pragma unroll
    for (int t = 0; t < 4; ++t) {
        const float vv = vS[t * 128 + v]; float po = 0.f;
#pragma unroll
        for (int i = 0; i < 32; ++i) { const int kk = t * 128 + 32 * kq + i; S[i] = fS[kk] * S[i] + kS[kk] * vv; po += qS[kk] * S[i]; }
        red[(t * 4 + kq) * 128 + v] = po;
    }
    float* so = p.out + OFF_HS + ((size_t)(l * DB + b) * HH + h) * HD * HD + (size_t)(32 * kq) * HD + v;
#pragma unroll
    for (int i = 0; i < 32; ++i) so[(size_t)i * HD] = S[i];
    __syncthreads();
    {
        const int t = tid >> 7; const float o = red[(t * 4 + 0) * 128 + v] + red[(t * 4 + 1) * 128 + v] + red[(t * 4 + 2) * 128 + v] + red[(t * 4 + 3) * 128 + v];
        const float ss = wave_sum(o * o);
        if (lane == 0) part[w] = ss;
        __syncthreads();
        const float tot = part[2 * t] + part[2 * t + 1];
        const float rstd = rsqrtf(tot * (1.0f / HD) + EPS);
        const float zg = bf2f(p.z[(size_t)(r0 + t) * ZW + 3072 + h * HD + v]);
        p.cat[(size_t)(r0 + t) * D + h * HD + v] = (bf16_t)f2bf(o * rstd * p.hgrn_norm_g[l * HD + v] * siluf_(zg));
    }
    __syncthreads();
}

DEV void pool_pre_unit(const Params& p, int l, int unit) {
    const int tid = threadIdx.x, tk = tid >> 7, cg = tid & 127, c = cg * 8, gi = cg >> 5, wnd = 2 << gi;
    const int r = unit * 4 + tk;
    if (r >= NTOK) return;
    float sum[8], cur[8];
#pragma unroll
    for (int j = 0; j < 8; ++j) { sum[j] = 0.f; cur[j] = 0.f; }
    float cnt;
    if (r < NP) {
        const int t = r % SEQ; const int n = (wnd < t + 1) ? wnd : (t + 1); cnt = (float)n;
        for (int j = 0; j < n; ++j) { const u32x4 q = *(const u32x4*)(p.z + (size_t)(r - j) * ZW + 4096 + c);
            const float f[8] = {lo16(q.x), hi16(q.x), lo16(q.y), hi16(q.y), lo16(q.z), hi16(q.z), lo16(q.w), hi16(q.w)};
#pragma unroll
            for (int e = 0; e < 8; ++e) { sum[e] += f[e]; if (j == 0) cur[e] = f[e]; } }
        if (t >= SEQ - PBUF) { float* o = p.out + OFF_PP + ((size_t)(l * PB + r / SEQ) * PBUF + (t - (SEQ - PBUF))) * PW + c;
            *(f32x4*)o = (f32x4){cur[0], cur[1], cur[2], cur[3]}; *(f32x4*)(o + 4) = (f32x4){cur[4], cur[5], cur[6], cur[7]}; }
    } else {
        const int bb = (r - NP) / DSEQ, t = (r - NP) % DSEQ; cnt = (float)wnd;
        const float* sp = p.state_pool + (size_t)(l * DB + bb) * PBUF * PW + c;
        for (int j = 0; j < wnd; ++j) { const int tj = t - j;
            if (tj >= 0) { const u32x4 q = *(const u32x4*)(p.z + (size_t)(NP + bb * DSEQ + tj) * ZW + 4096 + c);
                const float f[8] = {lo16(q.x), hi16(q.x), lo16(q.y), hi16(q.y), lo16(q.z), hi16(q.z), lo16(q.w), hi16(q.w)};
#pragma unroll
                for (int e = 0; e < 8; ++e) { sum[e] += f[e]; if (j == 0) cur[e] = f[e]; } }
            else { const float* s = sp + (size_t)(PBUF + tj) * PW; const f32x4 a = *(const f32x4*)s, b2 = *(const f32x4*)(s + 4);
                sum[0] += a[0]; sum[1] += a[1]; sum[2] += a[2]; sum[3] += a[3]; sum[4] += b2[0]; sum[5] += b2[1]; sum[6] += b2[2]; sum[7] += b2[3]; } }
        float* ob = p.out + OFF_PS + (size_t)(l * DB + bb) * PBUF * PW + c;
        { float* o = ob + (size_t)(11 + t) * PW; *(f32x4*)o = (f32x4){cur[0], cur[1], cur[2], cur[3]}; *(f32x4*)(o + 4) = (f32x4){cur[4], cur[5], cur[6], cur[7]}; }
        for (int i = t; i < 11; i += 4) { const float* s = sp + (size_t)(4 + i) * PW; float* o = ob + (size_t)i * PW; *(f32x4*)o = *(const f32x4*)s; *(f32x4*)(o + 4) = *(const f32x4*)(s + 4); }
    }
    const float inv = 1.0f / cnt;
    u32x4 w; w.x = pack2(sum[0] * inv - cur[0], sum[1] * inv - cur[1]); w.y = pack2(sum[2] * inv - cur[2], sum[3] * inv - cur[3]);
    w.z = pack2(sum[4] * inv - cur[4], sum[5] * inv - cur[5]); w.w = pack2(sum[6] * inv - cur[6], sum[7] * inv - cur[7]);
    *(u32x4*)(p.pooled + ((size_t)gi * MPAD + r) * 256 + (c & 255)) = w;
}

DEV void phase_mix(const Params& p, int l, unsigned char* lds) {
    const int nch = (2 * NCHAIN <= (int)gridDim.x) ? NCHAIN : 0;
    if ((int)blockIdx.x < nch) { hgrn_prompt_chain(p, l, blockIdx.x, lds); return; }
    const int ob = blockIdx.x - nch, on = gridDim.x - nch;
    if (nch == 0) for (int u = blockIdx.x; u < NCHAIN; u += gridDim.x) hgrn_prompt_chain(p, l, u, lds);
    for (int u = ob; u < DB * HH; u += on) hgrn_sample_unit(p, l, u, lds);
    for (int u = ob; u < (NTOK + 3) / 4; u += on) pool_pre_unit(p, l, u);
}

DEV void select_unit(const Params& p, int l, int tt, int h, unsigned char* lds) {
    const int tid = threadIdx.x, lane = tid & 63, w = tid >> 6, g = lane >> 4, c16 = lane & 15;
    float* qn = (float*)lds;
    float* sc = qn + 16 * 260;
    float* ts = sc + 2 * 16 * 132;
    int* ti = (int*)(ts + 512);
    const int tok0 = tt * 16;
    {
        const int tk = tid >> 5, part = tid & 31; const int tok = tok0 + tk;
        f32x4 a = (f32x4){0.f, 0.f, 0.f, 0.f}, b2 = a;
        if (tok < NTOK) { const float* q = p.qry + (size_t)tok * D + h * 256 + part * 8; a = *(const f32x4*)q; b2 = *(const f32x4*)(q + 4); }
        float ss = a[0] * a[0] + a[1] * a[1] + a[2] * a[2] + a[3] * a[3] + b2[0] * b2[0] + b2[1] * b2[1] + b2[2] * b2[2] + b2[3] * b2[3];
        ss += __shfl_xor(ss, 1); ss += __shfl_xor(ss, 2); ss += __shfl_xor(ss, 4); ss += __shfl_xor(ss, 8);
        const float rn = rsqrtf(ss * (1.0f / 128.0f) + EPS);
        float* d = qn + tk * 260 + part * 8; *(f32x4*)d = a * rn; *(f32x4*)(d + 4) = b2 * rn;
    }
    __syncthreads();
#pragma unroll
    for (int ph = 0; ph < 2; ++ph) {
        const float* kr = p.peer_keys + ((size_t)((l * 8 + h) * 2 + ph) * 128 + 16 * w + c16) * 128 + 32 * g;
        const float* qa = qn + c16 * 260 + ph * 128 + 32 * g;
        f32x4 acc = (f32x4){0.f, 0.f, 0.f, 0.f};
#pragma unroll
        for (int k4 = 0; k4 < 8; ++k4) { const f32x4 kb = *(const f32x4*)(kr + 4 * k4), av = *(const f32x4*)(qa + 4 * k4);
            acc = MFMA_F32(av[0], kb[0], acc); acc = MFMA_F32(av[1], kb[1], acc); acc = MFMA_F32(av[2], kb[2], acc); acc = MFMA_F32(av[3], kb[3], acc); }
#pragma unroll
        for (int r = 0; r < 4; ++r) sc[(ph * 16 + 4 * g + r) * 132 + 16 * w + c16] = acc[r];
    }
    __syncthreads();
    for (int rr = 0; rr < 4; ++rr) {
        const int row = w * 4 + rr;
        float v0 = sc[row * 132 + lane], v1 = sc[row * 132 + 64 + lane]; float rs = 0.f; int ri = 0;
        for (int it = 0; it < 16; ++it) {
            const float m = wave_max(fmaxf(v0, v1));
            const unsigned long long b0 = __ballot(v0 == m); int idx;
            if (b0) { const int src = __ffsll(b0) - 1; idx = src; if (lane == src) v0 = -3.0e38f; }
            else { const unsigned long long b1 = __ballot(v1 == m); const int src = __ffsll(b1) - 1; idx = 64 + src; if (lane == src) v1 = -3.0e38f; }
            if (lane == it) { rs = m; ri = idx; }
        }
        if (lane < 16) { ts[row * 16 + lane] = rs; ti[row * 16 + lane] = ri; }
    }
    __syncthreads();
    int ci = 0, cj = 0, cvalid = 0;
    { int cnt = 0; for (int i = 0; i < 16; ++i) { const int nj = 16 / (i + 1); for (int j = 0; j < nj; ++j) { if (cnt == lane) { ci = i; cj = j; cvalid = 1; } ++cnt; } } }
    for (int q = 0; q < 2; ++q) {
        const int tk = w * 2 + q, tok = tok0 + tk;
        float cv = cvalid ? ts[tk * 16 + ci] + ts[(16 + tk) * 16 + cj] : -3.0e38f;
        const int ce = cvalid ? ti[tk * 16 + ci] * 128 + ti[(16 + tk) * 16 + cj] : 0;
        float rs = 0.f; int re = 0;
        for (int it = 0; it < 16; ++it) {
            const float m = wave_max(cv);
            const unsigned long long b0 = __ballot(cv == m); const int src = __ffsll(b0) - 1;
            const int e = READLANE_I(ce, src);
            if (lane == src) cv = -3.0e38f;
            if (lane == it) { rs = m; re = e; }
        }
        const float mx = READLANE_F(rs, 0);
        float ex = lane < 16 ? __expf(rs - mx) : 0.f;
        float sm = ex; sm += __shfl_xor(sm, 1); sm += __shfl_xor(sm, 2); sm += __shfl_xor(sm, 4); sm += __shfl_xor(sm, 8);
        if (lane < 16 && tok < NTOK) { p.eidx[(size_t)tok * 128 + h * 16 + lane] = re; p.gate[(size_t)tok * 128 + h * 16 + lane] = ex / sm; }
    }
    __syncthreads();
}
DEV void phase_select(const Params& p, int l, unsigned char* lds) {
    const int ntt = (NTOK + 15) / 16;
    for (int u = blockIdx.x; u < ntt * 8; u += gridDim.x) select_unit(p, l, u >> 3, u & 7, lds);
}

DEV float dot8(u32x4 q, const float* h) { return lo16(q.x) * h[0] + hi16(q.x) * h[1] + lo16(q.y) * h[2] + hi16(q.y) * h[3] + lo16(q.z) * h[4] + hi16(q.z) * h[5] + lo16(q.w) * h[6] + hi16(q.w) * h[7]; }
DEV void phase_peer(const Params& p, int l) {
    const int lane = threadIdx.x & 63, gw = blockIdx.x * 8 + (threadIdx.x >> 6), nw = gridDim.x * 8;
    const bf16_t* U = p.ub + (size_t)l * NE * D; const bf16_t* V = p.vb + (size_t)l * NE * D;
    for (int t = gw; t < NTOK; t += nw) {
        float hf[32];
#pragma unroll
        for (int c = 0; c < 4; ++c) { const u32x4 q = *(const u32x4*)(p.hB + (size_t)t * D + c * 512 + lane * 8);
            hf[c * 8] = lo16(q.x); hf[c * 8 + 1] = hi16(q.x); hf[c * 8 + 2] = lo16(q.y); hf[c * 8 + 3] = hi16(q.y); hf[c * 8 + 4] = lo16(q.z); hf[c * 8 + 5] = hi16(q.z); hf[c * 8 + 6] = lo16(q.w); hf[c * 8 + 7] = hi16(q.w); }
        const int e_lo = p.eidx[(size_t)t * 128 + lane], e_hi = p.eidx[(size_t)t * 128 + 64 + lane];
        float a_lo = 0.f, a_hi = 0.f;
        for (int i = 0; i < 64; ++i) {
            const int e = READLANE_I(e_lo, i); const bf16_t* ur = U + (size_t)e * D + lane * 8; float s = 0.f;
#pragma unroll
            for (int c = 0; c < 4; ++c) s += dot8(*(const u32x4*)(ur + c * 512), hf + c * 8);
            s = wave_sum(s); if (lane == i) a_lo = s;
        }
        for (int i = 0; i < 64; ++i) {
            const int e = READLANE_I(e_hi, i); const bf16_t* ur = U + (size_t)e * D + lane * 8; float s = 0.f;
#pragma unroll
            for (int c = 0; c < 4; ++c) s += dot8(*(const u32x4*)(ur + c * 512), hf + c * 8);
            s = wave_sum(s); if (lane == i) a_hi = s;
        }
        a_lo = gelu_erf(a_lo) * p.gate[(size_t)t * 128 + lane]; a_hi = gelu_erf(a_hi) * p.gate[(size_t)t * 128 + 64 + lane];
        float acc[32];
#pragma unroll
        for (int j = 0; j < 32; ++j) acc[j] = 0.f;
        for (int i = 0; i < 128; ++i) {
            const int e = i < 64 ? READLANE_I(e_lo, i) : READLANE_I(e_hi, i - 64); const float av = i < 64 ? READLANE_F(a_lo, i) : READLANE_F(a_hi, i - 64);
            const bf16_t* vr = V + (size_t)e * D + lane * 8;
#pragma unroll
            for (int c = 0; c < 4; ++c) { const u32x4 q = *(const u32x4*)(vr + c * 512);
                acc[c * 8] += av * lo16(q.x); acc[c * 8 + 1] += av * hi16(q.x); acc[c * 8 + 2] += av * lo16(q.y); acc[c * 8 + 3] += av * hi16(q.y);
                acc[c * 8 + 4] += av * lo16(q.z); acc[c * 8 + 5] += av * hi16(q.z); acc[c * 8 + 6] += av * lo16(q.w); acc[c * 8 + 7] += av * hi16(q.w); }
        }
        const float* g2 = p.modbuf + (size_t)tok_batch(t) * MODW + l * NMOD + 5 * D;
#pragma unroll
        for (int c = 0; c < 4; ++c) { const int col = c * 512 + lane * 8;
#pragma unroll
            for (int q = 0; q < 2; ++q) { const f32x4 x1 = *(const f32x4*)(p.xa + (size_t)t * D + col + 4 * q), gv = *(const f32x4*)(g2 + col + 4 * q);
                f32x4 o; o[0] = x1[0] + gv[0] * acc[c * 8 + 4 * q]; o[1] = x1[1] + gv[1] * acc[c * 8 + 4 * q + 1]; o[2] = x1[2] + gv[2] * acc[c * 8 + 4 * q + 2]; o[3] = x1[3] + gv[3] * acc[c * 8 + 4 * q + 3];
                *(f32x4*)(p.xb + (size_t)t * D + col + 4 * q) = o; } }
    }
}

constexpr int N_PHASES = 21;
#ifndef HIPEMU
#define XB_TMO      128
#define XB_XCNT(j)  (256  + 64 * (j))
#define XB_XSUB(j)  (1280 + 64 * (j))
#define XB_XGEN(j)  (2304 + 64 * (j))
#define XB_TOP      3328
#define XB_TOPGEN   3392
#define XCD_BAR_WORDS 3456
#define XB_SPIN_CAP (1u << 22)
__device__ __forceinline__ unsigned xb_ld(unsigned* p)              { return __hip_atomic_load(p, __ATOMIC_RELAXED, __HIP_MEMORY_SCOPE_AGENT); }
__device__ __forceinline__ unsigned xb_add(unsigned* p, unsigned v) { return __hip_atomic_fetch_add(p, v, __ATOMIC_RELAXED, __HIP_MEMORY_SCOPE_AGENT); }
__device__ __forceinline__ unsigned xb_xcc_id() { return (unsigned)__builtin_amdgcn_s_getreg((3 << 11) | 20) & 0xFu; }
#define XB_SPIN(cond, bar) do { unsigned _sp = 0; while (cond) { __builtin_amdgcn_s_sleep(1); \
    if ((++_sp & 255u) == 0u) { if (xb_ld(&(bar)[XB_TMO])) break; if (_sp > XB_SPIN_CAP) { atomicAdd(&(bar)[XB_TMO], 1u); break; } } } } while (0)
struct XcdBarrier { unsigned* bar; unsigned x; volatile LAS unsigned* st; };
__device__ __forceinline__ XcdBarrier xcd_barrier_post(unsigned* bar, volatile LAS unsigned* st) {
    XcdBarrier b; b.bar = bar; b.x = xb_xcc_id(); b.st = st;
    if (threadIdx.x == 0) (void)xb_add(&bar[XB_XCNT(b.x)], 1u);
    return b;
}
__device__ __forceinline__ void xcd_barrier_complete(unsigned* bar, unsigned x, unsigned& nloc, unsigned& nx) {
    const unsigned G = gridDim.x * gridDim.y * gridDim.z;
    unsigned sum, cnt, mine, sp = 0u;
    for (;;) {
        sum = 0u; cnt = 0u; mine = 0u;
#pragma unroll
        for (unsigned j = 0; j < 16; ++j) { const unsigned c = xb_ld(&bar[XB_XCNT(j)]); sum += c; cnt += (c > 0u) ? 1u : 0u; mine = (j == x) ? c : mine; }
        if (sum == G) break;
        __builtin_amdgcn_s_sleep(1);
        if ((++sp & 255u) == 0u) { if (xb_ld(&bar[XB_TMO])) break; if (sp > XB_SPIN_CAP) { atomicAdd(&bar[XB_TMO], 1u); break; } }
    }
    nloc = mine > 0u ? mine : 1u; nx = cnt > 0u ? cnt : 1u;
}
__device__ __forceinline__ void xcd_barrier(const XcdBarrier& b) {
    asm volatile("s_waitcnt vmcnt(0)" ::: "memory");
    __syncthreads();
    if (threadIdx.x == 0) {
        unsigned* bar = b.bar;
        __builtin_amdgcn_s_waitcnt(0);
        unsigned nloc = b.st[0], nx = b.st[1];
        if (nloc == 0u) { xcd_barrier_complete(bar, b.x, nloc, nx); b.st[0] = nloc; b.st[1] = nx; }
        const unsigned old = xb_add(&bar[XB_XSUB(b.x)], 1u);
        const unsigned gen = old / nloc;
        if (old + 1u == (gen + 1u) * nloc) {
            __builtin_amdgcn_fence(__ATOMIC_RELEASE, "agent");
            asm volatile("s_waitcnt vmcnt(0)" ::: "memory");
            const unsigned og = xb_add(&bar[XB_TOP], 1u);
            const unsigned tg = og / nx;
            if (og + 1u == (tg + 1u) * nx) xb_add(&bar[XB_TOPGEN], 1u);
            else XB_SPIN(xb_ld(&bar[XB_TOPGEN]) == tg, bar);
            __builtin_amdgcn_fence(__ATOMIC_ACQUIRE, "agent");
            xb_add(&bar[XB_XGEN(b.x)], 1u);
            asm volatile("s_waitcnt vmcnt(0)" ::: "memory");
        } else {
            XB_SPIN(xb_ld(&bar[XB_XGEN(b.x)]) == gen, bar);
            __builtin_amdgcn_fence(__ATOMIC_ACQUIRE, "agent");
            asm volatile("s_waitcnt vmcnt(0)" ::: "memory");
        }
    }
    __syncthreads();
}
#endif

constexpr int LDS_BYTES = 163840;
constexpr int LDS_BARW = LDS_BYTES - 16;

#ifndef PH_MASK
#define PH_MASK 0xFFFFFFFFu
#endif
#define PH_BIT(k) ((PH_MASK >> ((k) < 2 ? (k) : ((k) == 20 ? 11 : 2 + ((k) - 2) % 9))) & 1u)
#ifdef HIPEMU
static void run_phase(const Params& pp, int ph, unsigned char* lds)
#define GRID_BAR() do {} while (0)
#define IN(k) (ph == (k))
#define GLDS lds
#define LOADP() const Params& p = pp
#else
typedef const __attribute__((address_space(4))) unsigned char* kargp_t;
__device__ __forceinline__ kargp_t karg_ptr() { kargp_t kp = (kargp_t)__builtin_amdgcn_kernarg_segment_ptr(); asm volatile("" : "+s"(kp)); return kp; }
#define LOADP() Params p; __builtin_memcpy(&p, karg_ptr(), sizeof(Params))
#define IN(k) (PH_BIT(k) && ph_lo <= (k) && (k) < ph_hi)
#define GLDS ((LAS unsigned char*)lds_raw)
__global__ void __launch_bounds__(512, 2) mega_fwd(Params p_unused)
#endif
{
#ifndef HIPEMU
    extern __shared__ __attribute__((aligned(16))) unsigned char lds_raw[];
    unsigned char* lds = lds_raw;
    if (threadIdx.x == 0) { *(volatile unsigned*)(lds_raw + LDS_BARW) = 0u; *(volatile unsigned*)(lds_raw + LDS_BARW + 4) = 0u; }
    __syncthreads();
    int ph_lo, ph_hi; XcdBarrier bar;
    { LOADP(); ph_lo = p.ph_lo; ph_hi = p.ph_hi; bar.bar = p.bar; bar.x = 0; bar.st = nullptr; }
    const bool multi = (ph_hi - ph_lo) > 1;
    if (multi) bar = xcd_barrier_post(bar.bar, (volatile LAS unsigned*)(lds_raw + LDS_BARW));
#define GRID_BAR() do { if (multi) xcd_barrier(bar); } while (0)
#endif
    if (IN(0)) { LOADP(); phase_convert(p, lds); GRID_BAR(); }
    if (IN(1)) {
        LOADP();
        pg8::Gemm g{p.csil, p.wt_ada, 256, MODW, D}; pg8::StaticOrder S; S.init(256, MODW, gridDim.x, blockIdx.x);
        pg8::EpiAda E{p.modbuf, p.b_ada, p.b_ada_final};
        pg8::gemm_phase<pg8::EpiAda, pg8::StaticOrder>(GLDS, g, S, E);
        GRID_BAR();
    }
#define LAYER(l) do { \
        constexpr int base = 2 + 9 * (l); \
        if (IN(base + 0)) { LOADP(); phase_norm(p, (l) == 0 ? p.x_prompt : p.xb, (l) == 0 ? p.x_sample : p.xb + (size_t)NP * D, p.norm1_g + (l) * D, (l) * NMOD + 0 * D, (l) * NMOD + 1 * D, p.hA, nullptr); GRID_BAR(); } \
        if (IN(base + 1)) { LOADP(); \
            pg8::Gemm g{p.hA, p.wt_in + (size_t)(l) * ZW * D, MPAD, ZW, D}; pg8::StaticOrder S; S.init(MPAD, ZW, gridDim.x, blockIdx.x); \
            pg8::EpiBf16 E{p.z, ZW}; \
            pg8::gemm_phase<pg8::EpiBf16, pg8::StaticOrder>(GLDS, g, S, E); \
            GRID_BAR(); } \
        if (IN(base + 2)) { LOADP(); phase_mix(p, (l), lds); GRID_BAR(); } \
        if (IN(base + 3)) { LOADP(); \
            pg8::Gemm g{p.pooled, p.wt_pool + (size_t)(l) * 1024 * 256, 4 * MPAD, 1024, 256}; pg8::PoolOrder S{(int)gridDim.x, (int)blockIdx.x}; \
            pg8::EpiPool E{p.cat, p.pool_b + (l) * PW, p.pool_scale + (l) * PW}; \
            pg8::gemm_phase<pg8::EpiPool, pg8::PoolOrder>(GLDS, g, S, E); \
            GRID_BAR(); } \
        if (IN(base + 4)) { LOADP(); \
            pg8::Gemm g{p.cat, p.wt_out + (size_t)(l) * D * D, MPAD, D, D}; pg8::StaticOrder S; S.init(MPAD, D, gridDim.x, blockIdx.x); \
            pg8::EpiResid E{(l) == 0 ? p.x_prompt : p.xb, (l) == 0 ? p.x_sample : p.xb + (size_t)NP * D, p.modbuf + (l) * NMOD + 2 * D, p.xa}; \
            pg8::gemm_phase<pg8::EpiResid, pg8::StaticOrder>(GLDS, g, S, E); \
            GRID_BAR(); } \
        if (IN(base + 5)) { LOADP(); phase_norm(p, p.xa, p.xa + (size_t)NP * D, p.norm2_g + (l) * D, (l) * NMOD + 3 * D, (l) * NMOD + 4 * D, p.hB, nullptr); GRID_BAR(); } \
        if (IN(base + 6)) { LOADP(); \
            pg8::Gemm g{p.hB, p.wt_q + (size_t)(l) * D * D, MPAD, D, D}; pg8::StaticOrder S; S.init(MPAD, D, gridDim.x, blockIdx.x); \
            pg8::EpiF32 E{p.qry, D}; \
            pg8::gemm_phase<pg8::EpiF32, pg8::StaticOrder>(GLDS, g, S, E); \
            GRID_BAR(); } \
        if (IN(base + 7)) { LOADP(); phase_select(p, (l), lds); GRID_BAR(); } \
        if (IN(base + 8)) { LOADP(); phase_peer(p, (l)); GRID_BAR(); } \
    } while (0)
    LAYER(0);
    LAYER(1);
    if (IN(20)) { LOADP(); phase_norm(p, p.xb, p.xb + (size_t)NP * D, p.final_g, 2 * NMOD, 2 * NMOD + D, nullptr, p.out + OFF_Y); }
#undef LAYER
#undef IN
#undef GRID_BAR
#undef GLDS
#undef LOADP
}

struct WsLayout { size_t bar, modbuf, csil, wt_ada, wt_in, wt_out, wt_q, wt_pool, ub, vb, hA, hB, z, pooled, cat, xa, xb, qry, eidx, gate, end; };
static WsLayout ws_layout() {
    WsLayout L; size_t o = 0;
    auto take = [&](size_t bytes) { const size_t r = o; o += (bytes + 255) & ~(size_t)255; return r; };
    L.bar = take(16384);
    L.modbuf = take((size_t)256 * MODW * 4);
    L.csil = take((size_t)256 * D * 2);
    L.wt_ada = take((size_t)MODW * D * 2);
    L.wt_in = take((size_t)2 * ZW * D * 2);
    L.wt_out = take((size_t)2 * D * D * 2);
    L.wt_q = take((size_t)2 * D * D * 2);
    L.wt_pool = take((size_t)2 * 1024 * 256 * 2);
    L.ub = take((size_t)2 * NE * D * 2);
    L.vb = take((size_t)2 * NE * D * 2);
    L.hA = take((size_t)MPAD * D * 2);
    L.hB = take((size_t)MPAD * D * 2);
    L.z = take((size_t)MPAD * ZW * 2);
    L.pooled = take((size_t)4 * MPAD * 256 * 2);
    L.cat = take((size_t)MPAD * D * 2);
    L.xa = take((size_t)MPAD * D * 4);
    L.xb = take((size_t)MPAD * D * 4);
    L.qry = take((size_t)MPAD * D * 4);
    L.eidx = take((size_t)MPAD * 128 * 4);
    L.gate = take((size_t)MPAD * 128 * 4);
    L.end = o;
    return L;
}
static void fill_params(Params& p, void* const* d_in, void* d_out, void* d_ws) {
    const float** f = (const float**)&p;
    for (int i = 0; i < 24; ++i) f[i] = (const float*)d_in[i];
    p.out = (float*)d_out;
    const WsLayout L = ws_layout(); unsigned char* w = (unsigned char*)d_ws;
    p.bar = (unsigned*)(w + L.bar); p.modbuf = (float*)(w + L.modbuf); p.csil = (bf16_t*)(w + L.csil); p.wt_ada = (bf16_t*)(w + L.wt_ada); p.wt_in = (bf16_t*)(w + L.wt_in);
    p.wt_out = (bf16_t*)(w + L.wt_out); p.wt_q = (bf16_t*)(w + L.wt_q); p.wt_pool = (bf16_t*)(w + L.wt_pool); p.ub = (bf16_t*)(w + L.ub); p.vb = (bf16_t*)(w + L.vb);
    p.hA = (bf16_t*)(w + L.hA); p.hB = (bf16_t*)(w + L.hB); p.z = (bf16_t*)(w + L.z); p.pooled = (bf16_t*)(w + L.pooled); p.cat = (bf16_t*)(w + L.cat);
    p.xa = (float*)(w + L.xa); p.xb = (float*)(w + L.xb); p.qry = (float*)(w + L.qry); p.eidx = (int*)(w + L.eidx); p.gate = (float*)(w + L.gate);
}

#ifndef HIPEMU
#ifndef MK_ONE_LAUNCH
#define MK_ONE_LAUNCH 1
#endif
extern "C" void kernel_launch(void* const* d_in, const int* in_sizes, int n_in, void* d_out, int out_size, void* d_ws, size_t ws_size, hipStream_t stream) {
    static int grid = 0;
    if (grid == 0) {
        const WsLayout L = ws_layout();
        if (n_in != 24 || (size_t)out_size != OUT_TOTAL || ws_size < L.end) { fprintf(stderr, "kernel_launch: unexpected shapes (n_in %d, out %d, ws %zu < %zu)\n", n_in, out_size, ws_size, L.end); grid = -1; return; }
        int dev = 0, cus = 0, per_cu = 0;
        hipGetDevice(&dev); hipDeviceGetAttribute(&cus, hipDeviceAttributeMultiprocessorCount, dev);
        if (hipFuncSetAttribute((const void*)mega_fwd, hipFuncAttributeMaxDynamicSharedMemorySize, LDS_BYTES) != hipSuccess) { fprintf(stderr, "kernel_launch: hipFuncSetAttribute failed\n"); grid = -1; return; }
        hipOccupancyMaxActiveBlocksPerMultiprocessor(&per_cu, (const void*)mega_fwd, 512, LDS_BYTES);
        (void)hipGetLastError();
        if (per_cu < 1) fprintf(stderr, "kernel_launch: occupancy query says %d blocks per CU\n", per_cu);
        grid = cus;
    }
    if (grid < 0) return;
    Params p{};
    fill_params(p, d_in, d_out, d_ws);
    hipMemsetAsync(p.bar, 0, 16384, stream);
#if MK_ONE_LAUNCH
    p.ph_lo = 0; p.ph_hi = N_PHASES;
    hipLaunchKernelGGL(mega_fwd, dim3(grid), dim3(512), LDS_BYTES, stream, p);
#else
    for (int ph = 0; ph < N_PHASES; ++ph) { p.ph_lo = ph; p.ph_hi = ph + 1; hipLaunchKernelGGL(mega_fwd, dim3(grid), dim3(512), LDS_BYTES, stream, p); }
#endif
}
#endif
```

```cpp
#ifndef HIPEMU
#include <hip/hip_runtime.h>
#include <cstdio>
#endif
#include <stdint.h>

#ifndef CFG_PB
#define CFG_PB 4
#define CFG_SEQ 2048
#define CFG_DB 128
#endif

#ifdef HIPEMU
#define DEV inline
#define LAS
#define READLANE_I(v, l) emu_readlane((v), (l))
#define READLANE_F(v, l) emu_readlane_f((v), (l))
#define MFMA_BF16(a, b, c) emu_mfma_bf16_16x16x32((a), (b), (c))
#define MFMA_F32(a, b, c) emu_mfma_f32_16x16x4((a), (b), (c))
#define __expf expf
#define __logf logf
#else
#define DEV __device__ __forceinline__
#define LAS __attribute__((address_space(3)))
#define READLANE_I(v, l) __builtin_amdgcn_readlane((v), (l))
#define READLANE_F(v, l) __uint_as_float((unsigned)__builtin_amdgcn_readlane((int)__float_as_uint(v), (l)))
#define MFMA_BF16(a, b, c) __builtin_amdgcn_mfma_f32_16x16x32_bf16((a), (b), (c), 0, 0, 0)
#define MFMA_F32(a, b, c) __builtin_amdgcn_mfma_f32_16x16x4f32((a), (b), (c), 0, 0, 0)
#endif

typedef unsigned short bf16_t;
typedef short bf16x8 __attribute__((ext_vector_type(8)));
typedef float f32x4 __attribute__((ext_vector_type(4)));
typedef unsigned u32x4 __attribute__((ext_vector_type(4)));
typedef unsigned u32x2 __attribute__((ext_vector_type(2)));

namespace cfg {
constexpr int D = 2048, PB = CFG_PB, SEQ = CFG_SEQ, DB = CFG_DB, DSEQ = 4;
constexpr int NP = PB * SEQ, NS = DB * DSEQ, NTOK = NP + NS, MPAD = (NTOK + 255) / 256 * 256;
constexpr int NC = PB + DB;
constexpr int HH = 8, HD = 128, PW = 1024, PBUF = 15, ZW = 5120;
constexpr int NE = 16384;
constexpr int NMOD = 6 * D;
constexpr int MODW = 2 * NMOD + 2 * D;
constexpr float EPS = 1e-6f;
constexpr int NCHAIN = PB * HH;
constexpr size_t OFF_Y = 0;
constexpr size_t OFF_HP = (size_t)NTOK * D;
constexpr size_t OFF_PP = OFF_HP + (size_t)2 * PB * HH * HD * HD;
constexpr size_t OFF_HS = OFF_PP + (size_t)2 * PB * PBUF * PW;
constexpr size_t OFF_PS = OFF_HS + (size_t)2 * DB * HH * HD * HD;
constexpr size_t OUT_TOTAL = OFF_PS + (size_t)2 * DB * PBUF * PW;
}
using namespace cfg;

struct Params {
    const float *x_prompt, *x_sample, *c_prompt, *c_sample, *state_hgrn, *state_pool, *w_ada, *b_ada, *norm1_g, *norm2_g, *w_in, *w_out,
        *lb_logits, *hgrn_norm_g, *pool_w, *pool_b, *pool_scale, *peer_wq, *peer_keys, *peer_u, *peer_v, *final_g, *w_ada_final, *b_ada_final;
    float* out;
    unsigned* bar; float* modbuf; bf16_t* csil; bf16_t* wt_ada; bf16_t* wt_in; bf16_t* wt_out; bf16_t* wt_q; bf16_t* wt_pool;
    unsigned char* u8; unsigned char* v8; float* su; float* sv; float* iscu; float* part; bf16_t* hA; bf16_t* hB; bf16_t* z; bf16_t* pooled; bf16_t* cat; float* xa; float* xb; float* qry; int* eidx; float* gate;
    int ph_lo, ph_hi;
};

DEV float bf2f(unsigned v) { return __uint_as_float(v << 16); }
#ifdef HIPEMU
DEV unsigned f2bf(float f) { unsigned u = __float_as_uint(f); u += 0x7fffu + ((u >> 16) & 1u); return u >> 16; }
DEV unsigned pack2(float lo, float hi) { return f2bf(lo) | (f2bf(hi) << 16); }
#else
typedef float f32x2_t __attribute__((ext_vector_type(2)));
typedef __bf16 bf16x2_t __attribute__((ext_vector_type(2)));
DEV unsigned pack2(float lo, float hi) { const f32x2_t v = {lo, hi}; return __builtin_bit_cast(unsigned, __builtin_convertvector(v, bf16x2_t)); }
DEV unsigned f2bf(float f) { return (unsigned)__builtin_bit_cast(unsigned short, (__bf16)f); }
#endif
DEV float lo16(unsigned w) { return __uint_as_float(w << 16); }
DEV float hi16(unsigned w) { return __uint_as_float(w & 0xffff0000u); }
DEV float wave_sum(float v) { v += __shfl_xor(v, 32); v += __shfl_xor(v, 16); v += __shfl_xor(v, 8); v += __shfl_xor(v, 4); v += __shfl_xor(v, 2); v += __shfl_xor(v, 1); return v; }
DEV float wave_max(float v) { v = fmaxf(v, __shfl_xor(v, 32)); v = fmaxf(v, __shfl_xor(v, 16)); v = fmaxf(v, __shfl_xor(v, 8)); v = fmaxf(v, __shfl_xor(v, 4)); v = fmaxf(v, __shfl_xor(v, 2)); v = fmaxf(v, __shfl_xor(v, 1)); return v; }
DEV float sigmoidf_(float x) { return 1.0f / (1.0f + __expf(-x)); }
DEV float siluf_(float x) { return x / (1.0f + __expf(-x)); }
DEV float gelu_erf(float x) { return 0.5f * x * (1.0f + erff(x * 0.70710678118f)); }
DEV int tok_batch(int t) { return t < NP ? t / SEQ : PB + (t - NP) / DSEQ; }


#ifdef HIPEMU
static inline unsigned emu_fp8_enc1(float x) {
    const unsigned sgn = x < 0.f ? 0x80u : 0u; float a = fabsf(x);
    if (!(a == a)) return 0x7fu;
    if (a >= 448.f) return sgn | 0x7eu;
    if (a < 0.015625f) { const int q = (int)rintf(a * 512.f); return sgn | (unsigned)q; }
    int e = (int)floorf(log2f(a)); if (ldexpf(1.f, e) > a) --e; if (ldexpf(1.f, e + 1) <= a) ++e;
    int m = (int)rintf((a / ldexpf(1.f, e) - 1.f) * 8.f); if (m == 8) { m = 0; ++e; }
    if (e > 8) return sgn | 0x7eu;
    return sgn | (unsigned)((e + 7) << 3) | (unsigned)m;
}
static inline float emu_fp8_dec1(unsigned b) { const float sg = (b & 0x80u) ? -1.f : 1.f; const int e = (b >> 3) & 15, m = b & 7; return sg * (e == 0 ? m * 0.001953125f : (1.f + m * 0.125f) * ldexpf(1.f, e - 7)); }
DEV unsigned fp8x4_enc(float a, float b, float c, float d) { return emu_fp8_enc1(a) | (emu_fp8_enc1(b) << 8) | (emu_fp8_enc1(c) << 16) | (emu_fp8_enc1(d) << 24); }
DEV void fp8x4_dec(unsigned w, float* o) { o[0] = emu_fp8_dec1(w & 255u); o[1] = emu_fp8_dec1((w >> 8) & 255u); o[2] = emu_fp8_dec1((w >> 16) & 255u); o[3] = emu_fp8_dec1(w >> 24); }
#define DPP_XOR1(v) __shfl((v), emu_lane() ^ 1)
#define DPP_XOR2(v) __shfl((v), emu_lane() ^ 2)
#define DPP_HMIRROR(v) __shfl((v), (emu_lane() & ~7) | (7 - (emu_lane() & 7)))
#define DPP_XOR8(v) __shfl((v), emu_lane() ^ 8)
#define WAVE_LDS_SYNC() emu_wbar()
#else
typedef float f32x2v_t __attribute__((ext_vector_type(2)));
DEV unsigned fp8x4_enc(float a, float b, float c, float d) { int r = __builtin_amdgcn_cvt_pk_fp8_f32(a, b, 0, false); r = __builtin_amdgcn_cvt_pk_fp8_f32(c, d, r, true); return (unsigned)r; }
DEV void fp8x4_dec(unsigned w, float* o) { const f32x2v_t lo = __builtin_amdgcn_cvt_pk_f32_fp8((int)w, false), hi = __builtin_amdgcn_cvt_pk_f32_fp8((int)w, true); o[0] = lo[0]; o[1] = lo[1]; o[2] = hi[0]; o[3] = hi[1]; }
template <int CTRL> DEV float dpp_f(float v) { return __uint_as_float((unsigned)__builtin_amdgcn_update_dpp(0, (int)__float_as_uint(v), CTRL, 0xf, 0xf, true)); }
#define DPP_XOR1(v) dpp_f<0xB1>(v)
#define DPP_XOR2(v) dpp_f<0x4E>(v)
#define DPP_HMIRROR(v) dpp_f<0x141>(v)
#define DPP_XOR8(v) dpp_f<0x128>(v)
#define WAVE_LDS_SYNC() asm volatile("s_waitcnt lgkmcnt(0)" ::: "memory")
#endif
DEV void fp8x16_dec(u32x4 q, float* o) { fp8x4_dec(q.x, o); fp8x4_dec(q.y, o + 4); fp8x4_dec(q.z, o + 8); fp8x4_dec(q.w, o + 12); }

namespace pg8 {
constexpr int BM = 256, BK = 64, HALF = 128, HTB = HALF * BK * 2, STAGE_BYTES = 8 * HTB, NXCD = 8, WGM = 8;
DEV int lds_byte(int r, int c) { const int st = (r >> 4) * 2 + (c >> 5), rr = r & 15, cc = c & 31, ob = rr * 64 + cc * 2; return st * 1024 + (ob ^ (((ob >> 9) & 1) << 5)); }
DEV void stage_rc(int b, int& R, int& C) { const int st = b / 1024, sb = b % 1024, swz = sb ^ (((sb >> 9) & 1) << 5); R = (st >> 1) * 16 + swz / 64; C = (st & 1) * 32 + (swz % 64) / 2; }
DEV int perm32(int rho) { const int n = rho >> 4, i = rho & 15; return 8 * (i >> 2) + 4 * n + (i & 3); }
struct Unit { int pm, pn; };
struct Gemm { const bf16_t* A; const bf16_t* Bt; int M, N, K; };
struct StaticOrder {
    int nM, nN, nwg, G, c;
    DEV void init(int M, int N, int G_, int c_) { nM = M / BM; nN = N / BM; nwg = nM * nN; G = G_; c = c_; }
    DEV bool next(int i, Unit& u) const {
        const long L = (long)i * G + c; if (L >= nwg) return false;
        int wgid = (int)L; { const int q = nwg / NXCD, r = nwg % NXCD, xcd = wgid % NXCD, off = wgid / NXCD; wgid = (xcd < r ? xcd * (q + 1) : r * (q + 1) + (xcd - r) * q) + off; }
        const int nig = WGM * nN, gid = wgid / nig, fm = gid * WGM, gsz = (nM - fm) < WGM ? (nM - fm) : WGM;
        u.pm = fm + ((wgid % nig) % gsz); u.pn = (wgid % nig) / gsz; return true;
    }
    DEV void a_ready(const Unit&) const {}
    DEV void done(const Unit&) const {}
};
struct PoolOrder {
    int G, c;
    DEV bool next(int i, Unit& u) const { const int L = i * G + c; if (L >= 4 * (MPAD / 256)) return false; u.pm = L; u.pn = L / (MPAD / 256); return true; }
    DEV void a_ready(const Unit&) const {}
    DEV void done(const Unit&) const {}
};

struct EpiF32 {
    static constexpr bool PERM = false;
    float* C; int ldc;
    DEV void operator()(const f32x4 (&acc)[2][2][4][2], const Unit& u, int wr, int wc, int fr, int fq) const {
        const int row0 = u.pm * BM + wr * 64 + fr, col0 = u.pn * BM + wc * 32 + 4 * fq;
#pragma unroll
        for (int ai = 0; ai < 2; ++ai)
#pragma unroll
            for (int m = 0; m < 4; ++m) { float* rowp = C + (size_t)(row0 + ai * HALF + m * 16) * ldc + col0;
#pragma unroll
                for (int bj = 0; bj < 2; ++bj)
#pragma unroll
                    for (int n = 0; n < 2; ++n) *(f32x4*)(rowp + bj * HALF + n * 16) = acc[ai][bj][m][n]; }
    }
};
struct EpiAda {
    static constexpr bool PERM = false;
    float* C; const float* b_ada; const float* b_fin;
    DEV void operator()(const f32x4 (&acc)[2][2][4][2], const Unit& u, int wr, int wc, int fr, int fq) const {
        const int row0 = u.pm * BM + wr * 64 + fr, col0 = u.pn * BM + wc * 32 + 4 * fq;
        const float* bias = (u.pn * BM < 2 * NMOD) ? b_ada + col0 : b_fin + (col0 - 2 * NMOD);
        f32x4 bv[2][2];
#pragma unroll
        for (int bj = 0; bj < 2; ++bj)
#pragma unroll
            for (int n = 0; n < 2; ++n) bv[bj][n] = *(const f32x4*)(bias + bj * HALF + n * 16);
#pragma unroll
        for (int ai = 0; ai < 2; ++ai)
#pragma unroll
            for (int m = 0; m < 4; ++m) { float* rowp = C + (size_t)(row0 + ai * HALF + m * 16) * MODW + col0;
#pragma unroll
                for (int bj = 0; bj < 2; ++bj)
#pragma unroll
                    for (int n = 0; n < 2; ++n) *(f32x4*)(rowp + bj * HALF + n * 16) = acc[ai][bj][m][n] + bv[bj][n]; }
    }
};
struct EpiResid {
    static constexpr bool PERM = false;
    const float* xlo; const float* xhi; const float* gmod  ; float* out;
    DEV void operator()(const f32x4 (&acc)[2][2][4][2], const Unit& u, int wr, int wc, int fr, int fq) const {
        const int row0 = u.pm * BM + wr * 64 + fr, col0 = u.pn * BM + wc * 32 + 4 * fq;
#pragma unroll
        for (int ai = 0; ai < 2; ++ai)
#pragma unroll
            for (int m = 0; m < 4; ++m) {
                const int row = row0 + ai * HALF + m * 16;
                if (row < NTOK) {
                    const float* xr = (row < NP ? xlo + (size_t)row * D : xhi + (size_t)(row - NP) * D) + col0;
                    const float* gr = gmod + (size_t)tok_batch(row) * MODW + col0;
                    float* rowp = out + (size_t)row * D + col0;
#pragma unroll
                    for (int bj = 0; bj < 2; ++bj)
#pragma unroll
                        for (int n = 0; n < 2; ++n) { const f32x4 xv = *(const f32x4*)(xr + bj * HALF + n * 16), gv = *(const f32x4*)(gr + bj * HALF + n * 16);
                            *(f32x4*)(rowp + bj * HALF + n * 16) = xv + gv * acc[ai][bj][m][n]; }
                }
            }
    }
};
struct EpiBf16 {
    static constexpr bool PERM = true;
    bf16_t* O; int ldc;
    DEV void operator()(const f32x4 (&acc)[2][2][4][2], const Unit& u, int wr, int wc, int fr, int fq) const {
        const int row0 = u.pm * BM + wr * 64 + fr, col0 = u.pn * BM + wc * 32 + 8 * fq;
#pragma unroll
        for (int ai = 0; ai < 2; ++ai)
#pragma unroll
            for (int m = 0; m < 4; ++m) { bf16_t* rowp = O + (size_t)(row0 + ai * HALF + m * 16) * ldc + col0;
#pragma unroll
                for (int bj = 0; bj < 2; ++bj) { const f32x4 v0 = acc[ai][bj][m][0], v1 = acc[ai][bj][m][1];
                    u32x4 w; w.x = pack2(v0[0], v0[1]); w.y = pack2(v0[2], v0[3]); w.z = pack2(v1[0], v1[1]); w.w = pack2(v1[2], v1[3]);
                    *(u32x4*)(rowp + bj * HALF) = w; } }
    }
};
struct EpiPool {
    static constexpr bool PERM = true;
    bf16_t* cat; const float* pb; const float* ps;
    DEV void operator()(const f32x4 (&acc)[2][2][4][2], const Unit& u, int wr, int wc, int fr, int fq) const {
        const int g = u.pn, tok0 = u.pm * BM - g * MPAD + wr * 64 + fr, col0 = g * 256 + wc * 32 + 8 * fq;
#pragma unroll
        for (int bj = 0; bj < 2; ++bj) {
            const f32x4 b0 = *(const f32x4*)(pb + col0 + bj * HALF), b1 = *(const f32x4*)(pb + col0 + bj * HALF + 4);
            const f32x4 s0 = *(const f32x4*)(ps + col0 + bj * HALF), s1 = *(const f32x4*)(ps + col0 + bj * HALF + 4);
#pragma unroll
            for (int ai = 0; ai < 2; ++ai)
#pragma unroll
                for (int m = 0; m < 4; ++m) { const int tok = tok0 + ai * HALF + m * 16;
                    if (tok < NTOK) { const f32x4 v0 = (acc[ai][bj][m][0] + b0) * s0, v1 = (acc[ai][bj][m][1] + b1) * s1;
                        u32x4 w; w.x = pack2(v0[0], v0[1]); w.y = pack2(v0[2], v0[3]); w.z = pack2(v1[0], v1[1]); w.w = pack2(v1[2], v1[3]);
                        *(u32x4*)(cat + (size_t)tok * D + 1024 + col0 + bj * HALF) = w; } }
        }
    }
};

#ifdef HIPEMU
template <class Epi, class Sched>
static void gemm_phase(unsigned char*, const Gemm g, const Sched& S, const Epi& E) {
    const int tid = threadIdx.x, wid = tid >> 6, lane = tid & 63, wr = wid >> 2, wc = wid & 3, fr = lane & 15, fq = lane >> 4;
    Unit cur;
    for (int ui = 0; S.next(ui, cur); ++ui) {
        f32x4 acc[2][2][4][2];
        for (int ai = 0; ai < 2; ++ai) for (int bj = 0; bj < 2; ++bj) for (int m = 0; m < 4; ++m) for (int n = 0; n < 2; ++n) for (int j = 0; j < 4; ++j) {
            const int row = 256 * cur.pm + 128 * ai + 64 * wr + 16 * m + fr;
            const int col = Epi::PERM ? 256 * cur.pn + 128 * bj + 32 * wc + 8 * fq + 4 * n + j : 256 * cur.pn + 128 * bj + 32 * wc + 16 * n + 4 * fq + j;
            float s = 0.f;
            if ((row % emu_row_mod) < emu_row_limit) { const float* a = emu_f32_copy(g.A, (size_t)g.M * g.K) + (size_t)row * g.K; const float* b = emu_f32_copy(g.Bt, (size_t)g.N * g.K) + (size_t)col * g.K;
                for (int k = 0; k < g.K; ++k) s += a[k] * b[k]; }
            acc[ai][bj][m][n][j] = s; }
        E(acc, cur, wr, wc, fr, fq);
    }
    __syncthreads();
}
#else
template <class Epi, class Sched>
__device__ __forceinline__ void gemm_phase(LAS unsigned char* lds, const Gemm g, const Sched& S, const Epi& E) {
    const int tid = threadIdx.x, wid = __builtin_amdgcn_readfirstlane(tid >> 6), lane = tid & 63, wr = wid >> 2, wc = wid & 3, fr = lane & 15, fq = lane >> 4;
    int K = g.K; asm volatile("" : "+s"(K));
    const int nt = K / BK;
    unsigned voffA[2], voffB[2];
#pragma unroll
    for (int i = 0; i < 2; ++i) { int R, C; stage_rc(tid * 16 + i * 8192, R, C); const int Rb = Epi::PERM ? ((R & ~31) + perm32(R & 31)) : R;
        voffA[i] = (unsigned)(R * K + C) * 2u; voffB[i] = (unsigned)(Rb * K + C) * 2u; }
    const size_t kstep = (size_t)(BK * 2);
    const size_t hstep = (size_t)HALF * K * 2;
    const size_t tstep = 2 * hstep;
    const unsigned ldsw = (unsigned)wid * 1024u;
    const int aoff = lds_byte(wr * 64 + fr, fq * 8), boff = lds_byte(wc * 32 + fr, fq * 8);
#define PG8_SA(b, h) (((b) * 2 + (h)) * HTB)
#define PG8_SB(b, h) ((4 + (b) * 2 + (h)) * HTB)
#define PG8_STAGE(bufoff, gbase, voff) do { _Pragma("unroll") for (int _i = 0; _i < 2; ++_i) \
        __builtin_amdgcn_global_load_lds((const unsigned*)((const char*)(gbase) + (voff)[_i]), (LAS unsigned*)(lds + (bufoff) + ldsw + _i * 8192), 16, 0, 0); } while (0)
#define PG8_LDA(dst, b, h) do { _Pragma("unroll") for (int m = 0; m < 4; ++m) _Pragma("unroll") for (int k = 0; k < 2; ++k) dst[m][k] = *(const LAS bf16x8*)(lds + PG8_SA(b, h) + aoff + m * 2048 + k * 1024); } while (0)
#define PG8_LDB(dst, b, h) do { _Pragma("unroll") for (int n = 0; n < 2; ++n) _Pragma("unroll") for (int k = 0; k < 2; ++k) dst[n][k] = *(const LAS bf16x8*)(lds + PG8_SB(b, h) + boff + n * 2048 + k * 1024); } while (0)
#define PG8_MMA(ai, bj, At, Bt) do { __builtin_amdgcn_s_setprio(1); _Pragma("unroll") for (int m = 0; m < 4; ++m) _Pragma("unroll") for (int n = 0; n < 2; ++n) _Pragma("unroll") for (int k = 0; k < 2; ++k) \
        acc[ai][bj][m][n] = __builtin_amdgcn_mfma_f32_16x16x32_bf16(Bt[n][k], At[m][k], acc[ai][bj][m][n], 0, 0, 0); __builtin_amdgcn_s_setprio(0); } while (0)
#define PG8_WAIT_V(n) asm volatile("s_waitcnt vmcnt(" #n ")" ::: "memory")
#define PG8_WAIT_L(n) asm volatile("s_waitcnt lgkmcnt(" #n ")" ::: "memory")
#define PG8_BAR __builtin_amdgcn_s_barrier()
#define PG8_SCHED __builtin_amdgcn_sched_barrier(0)
    Unit cur, nxt; int ui = 0;
    if (!S.next(0, cur)) return;
    f32x4 acc[2][2][4][2];
#pragma unroll
    for (int a = 0; a < 2; ++a)
#pragma unroll
        for (int b = 0; b < 2; ++b)
#pragma unroll
            for (int m = 0; m < 4; ++m)
#pragma unroll
                for (int n = 0; n < 2; ++n) acc[a][b][m][n] = (f32x4){0.f, 0.f, 0.f, 0.f};
    bf16x8 At[4][2], B0[2][2], B1[2][2];
    const char* cA = (const char*)g.A + (size_t)cur.pm * tstep; const char* cB = (const char*)g.Bt + (size_t)cur.pn * tstep;
    S.a_ready(cur);
    PG8_STAGE(PG8_SB(0, 0), cB, voffB); PG8_STAGE(PG8_SA(0, 0), cA, voffA); PG8_STAGE(PG8_SB(0, 1), cB + hstep, voffB); PG8_STAGE(PG8_SA(0, 1), cA + hstep, voffA);
    if (wr == 1) PG8_BAR;
    PG8_WAIT_V(4); PG8_BAR;
    PG8_STAGE(PG8_SB(1, 0), cB + kstep, voffB); PG8_STAGE(PG8_SA(1, 0), cA + kstep, voffA); PG8_STAGE(PG8_SB(1, 1), cB + hstep + kstep, voffB);
    PG8_WAIT_V(6); PG8_BAR;
    for (;;) {
        const bool has_next = S.next(ui + 1, nxt);
        const char* nA = has_next ? (const char*)g.A + (size_t)nxt.pm * tstep : cA; const char* nB = has_next ? (const char*)g.Bt + (size_t)nxt.pn * tstep : cB;
        for (int t = 0; t < nt; t += 2) {
            const bool last = (t == nt - 2);
            const char* a1 = cA + (size_t)(t + 1) * kstep;
            const char* a2 = last ? nA : cA + (size_t)(t + 2) * kstep; const char* b2 = last ? nB : cB + (size_t)(t + 2) * kstep;
            const char* a3 = a2 + kstep; const char* b3 = b2 + kstep;
            if (last && has_next) S.a_ready(nxt);
            PG8_LDB(B0, 0, 0); PG8_SCHED; PG8_LDA(At, 0, 0); PG8_STAGE(PG8_SA(1, 1), a1 + hstep, voffA);
            PG8_WAIT_L(8); PG8_BAR; PG8_WAIT_L(0); PG8_MMA(0, 0, At, B0); PG8_BAR; PG8_SCHED;
            PG8_LDB(B1, 0, 1); PG8_STAGE(PG8_SB(0, 0), b2, voffB);
            PG8_BAR; PG8_WAIT_L(0); PG8_MMA(0, 1, At, B1); PG8_BAR;
            PG8_LDA(At, 0, 1); PG8_STAGE(PG8_SA(0, 0), a2, voffA);
            PG8_BAR; PG8_WAIT_L(0); PG8_MMA(1, 0, At, B0); PG8_BAR; PG8_SCHED;
            PG8_STAGE(PG8_SB(0, 1), b2 + hstep, voffB);
            PG8_WAIT_V(6); PG8_BAR; PG8_MMA(1, 1, At, B1); PG8_BAR;
            PG8_LDB(B0, 1, 0); PG8_SCHED; PG8_LDA(At, 1, 0); PG8_STAGE(PG8_SA(0, 1), a2 + hstep, voffA);
            PG8_WAIT_L(8); PG8_BAR; PG8_WAIT_L(0); PG8_MMA(0, 0, At, B0); PG8_BAR; PG8_SCHED;
            PG8_LDB(B1, 1, 1); PG8_STAGE(PG8_SB(1, 0), b3, voffB);
            PG8_BAR; PG8_WAIT_L(0); PG8_MMA(0, 1, At, B1); PG8_BAR;
            PG8_LDA(At, 1, 1); PG8_STAGE(PG8_SA(1, 0), a3, voffA);
            PG8_BAR; PG8_WAIT_L(0); PG8_MMA(1, 0, At, B0); PG8_BAR; PG8_SCHED;
            PG8_STAGE(PG8_SB(1, 1), b3 + hstep, voffB);
            PG8_WAIT_V(6); PG8_BAR; PG8_MMA(1, 1, At, B1); PG8_BAR;
        }
        { int tz = threadIdx.x; asm volatile("" : "+v"(tz)); const int wz = tz >> 6, lz = tz & 63;
          E(acc, cur, wz >> 2, wz & 3, lz & 15, lz >> 4); } S.done(cur);
        if (!has_next) break;
#pragma unroll
        for (int a = 0; a < 2; ++a)
#pragma unroll
            for (int b = 0; b < 2; ++b)
#pragma unroll
                for (int m = 0; m < 4; ++m)
#pragma unroll
                    for (int n = 0; n < 2; ++n) acc[a][b][m][n] = (f32x4){0.f, 0.f, 0.f, 0.f};
        cur = nxt; cA = nA; cB = nB; ++ui;
    }
    PG8_WAIT_V(0);
    if (wr == 0) PG8_BAR;
    PG8_BAR;
#undef PG8_SA
#undef PG8_SB
#undef PG8_STAGE
#undef PG8_LDA
#undef PG8_LDB
#undef PG8_MMA
#undef PG8_WAIT_V
#undef PG8_WAIT_L
#undef PG8_BAR
#undef PG8_SCHED
}
#endif
}

DEV void transpose_tile(const float* src, int ld_src, bf16_t* dst, int ld_dst, float* tile) {
    const int tid = threadIdx.x;
#pragma unroll
    for (int i = 0; i < 2; ++i) { const int idx = tid + i * 512, r = idx >> 4, c4 = idx & 15; const f32x4 v = *(const f32x4*)(src + (size_t)r * ld_src + c4 * 4);
        float* t = tile + r * 65 + c4 * 4; t[0] = v[0]; t[1] = v[1]; t[2] = v[2]; t[3] = v[3]; }
    __syncthreads();
    const int n = tid >> 3, kg = tid & 7; const float* t = tile + (kg * 8) * 65 + n;
    u32x4 w; w.x = pack2(t[0], t[65]); w.y = pack2(t[2 * 65], t[3 * 65]); w.z = pack2(t[4 * 65], t[5 * 65]); w.w = pack2(t[6 * 65], t[7 * 65]);
    *(u32x4*)(dst + (size_t)n * ld_dst + kg * 8) = w;
    __syncthreads();
}
DEV int cvt_job_tiles(int j) { const int K = j < 9 ? 2048 : 256; const int N = j < 2 ? NMOD : (j == 2 ? 2 * D : (j < 5 ? ZW : (j < 9 ? D : 256))); return (K / 64) * (N / 64); }
DEV void phase_convert(const Params& p, unsigned char* lds) {
    float* tile = (float*)lds;
    const int tid = threadIdx.x;
    int total = 0;
#pragma unroll
    for (int q = 0; q < 17; ++q) total += cvt_job_tiles(q);
    for (int tl = blockIdx.x; tl < total; tl += gridDim.x) {
        int j = 0, loc = 0, base = 0;
#pragma unroll
        for (int q = 0; q < 17; ++q) { const int cnt = cvt_job_tiles(q); if (tl >= base && tl < base + cnt) { j = q; loc = tl - base; } base += cnt; }
        const float* src; bf16_t* dst; int K = 2048, N;
        if (j < 2) { N = NMOD; src = p.w_ada + (size_t)j * 2048 * NMOD; dst = p.wt_ada + (size_t)j * NMOD * 2048; }
        else if (j == 2) { N = 2 * D; src = p.w_ada_final; dst = p.wt_ada + (size_t)2 * NMOD * 2048; }
        else if (j < 5) { N = ZW; src = p.w_in + (size_t)(j - 3) * 2048 * ZW; dst = p.wt_in + (size_t)(j - 3) * ZW * 2048; }
        else if (j < 7) { N = D; src = p.w_out + (size_t)(j - 5) * D * D; dst = p.wt_out + (size_t)(j - 5) * D * D; }
        else if (j < 9) { N = D; src = p.peer_wq + (size_t)(j - 7) * D * D; dst = p.wt_q + (size_t)(j - 7) * D * D; }
        else { K = 256; N = 256; src = p.pool_w + (size_t)(j - 9) * 65536; dst = p.wt_pool + (size_t)(j - 9) * 65536; }
        const int ntn = N / 64, kt = loc / ntn, nt = loc % ntn;
        transpose_tile(src + (size_t)kt * 64 * N + nt * 64, N, dst + (size_t)nt * 64 * K + kt * 64, K, tile);
    }
    const size_t gt = (size_t)blockIdx.x * 512 + tid, gs = (size_t)gridDim.x * 512;
    {
        const int lane = tid & 63, gw = blockIdx.x * 8 + (tid >> 6), nw = gridDim.x * 8;
        for (int row = gw; row < 4 * NE; row += nw) {
            const int which = row / (2 * NE), rr = row % (2 * NE);
            const float* src = (which ? p.peer_v : p.peer_u) + (size_t)rr * D; unsigned* dst = (unsigned*)((which ? p.v8 : p.u8) + (size_t)rr * D);
            f32x4 v[8]; float am = 0.f;
#pragma unroll
            for (int k = 0; k < 8; ++k) { v[k] = *(const f32x4*)(src + 4 * lane + 256 * k); am = fmaxf(am, fmaxf(fmaxf(fabsf(v[k][0]), fabsf(v[k][1])), fmaxf(fabsf(v[k][2]), fabsf(v[k][3])))); }
            am = wave_max(am);
            const float sc = am > 0.f ? 224.0f / am : 1.0f;
#pragma unroll
            for (int k = 0; k < 8; ++k) dst[lane + 64 * k] = fp8x4_enc(v[k][0] * sc, v[k][1] * sc, v[k][2] * sc, v[k][3] * sc);
            if (lane == 0) (which ? p.sv : p.su)[rr] = am > 0.f ? am * (1.0f / 224.0f) : 1.0f;
        }
    }
    for (size_t i = gt; i < (size_t)256 * D / 8; i += gs) {
        const int row = (int)(i / (D / 8)), c8 = (int)(i % (D / 8)) * 8; u32x4 w = (u32x4){0u, 0u, 0u, 0u};
        if (row < NC) { const float* s = (row < PB ? p.c_prompt + (size_t)row * D : p.c_sample + (size_t)(row - PB) * D) + c8;
            const f32x4 a = *(const f32x4*)s, b = *(const f32x4*)(s + 4);
            w.x = pack2(siluf_(a[0]), siluf_(a[1])); w.y = pack2(siluf_(a[2]), siluf_(a[3])); w.z = pack2(siluf_(b[0]), siluf_(b[1])); w.w = pack2(siluf_(b[2]), siluf_(b[3])); }
        *(u32x4*)(p.csil + i * 8) = w;
    }
}

DEV void phase_norm(const Params& p, const float* xlo, const float* xhi, const float* gn, int sh_off, int sc_off, bf16_t* obf, float* of32) {
    const int lane = threadIdx.x & 63, gw = blockIdx.x * 8 + (threadIdx.x >> 6), nw = gridDim.x * 8;
    for (int t = gw; t < NTOK; t += nw) {
        const float* xr = t < NP ? xlo + (size_t)t * D : xhi + (size_t)(t - NP) * D;
        const float* mrow = p.modbuf + (size_t)tok_batch(t) * MODW;
        f32x4 v[8]; float ss = 0.f;
#pragma unroll
        for (int c = 0; c < 4; ++c) { const int col = c * 512 + lane * 8; v[2 * c] = *(const f32x4*)(xr + col); v[2 * c + 1] = *(const f32x4*)(xr + col + 4);
#pragma unroll
            for (int j = 0; j < 4; ++j) ss += v[2 * c][j] * v[2 * c][j] + v[2 * c + 1][j] * v[2 * c + 1][j]; }
        ss = wave_sum(ss);
        const float rstd = rsqrtf(ss * (1.0f / D) + EPS);
#pragma unroll
        for (int c = 0; c < 4; ++c) { const int col = c * 512 + lane * 8; f32x4 y[2];
#pragma unroll
            for (int q = 0; q < 2; ++q) { const f32x4 g4 = *(const f32x4*)(gn + col + 4 * q), sc = *(const f32x4*)(mrow + sc_off + col + 4 * q), sh = *(const f32x4*)(mrow + sh_off + col + 4 * q);
                y[q] = (v[2 * c + q] * rstd) * g4 * (sc + 1.0f) + sh; }
            if (obf) { u32x4 w; w.x = pack2(y[0][0], y[0][1]); w.y = pack2(y[0][2], y[0][3]); w.z = pack2(y[1][0], y[1][1]); w.w = pack2(y[1][2], y[1][3]); *(u32x4*)(obf + (size_t)t * D + col) = w; }
            else { *(f32x4*)(of32 + (size_t)t * D + col) = y[0]; *(f32x4*)(of32 + (size_t)t * D + col + 4) = y[1]; }
        }
    }
}

namespace hg {
constexpr int QS = 136, VS = 72;
constexpr int O_QT = 0, O_QH = O_QT + 64 * QS * 2, O_KT = O_QH + 64 * QS * 2, O_KDT = O_KT + 160 * QS * 2, O_VT = O_KDT + 128 * VS * 2,
              O_ST = O_VT + 128 * VS * 2, O_AB = O_ST + 128 * QS * 2, O_GS = O_AB + 64 * VS * 2, O_END = O_GS + 4 * 128 * 4;
constexpr int OS = 132;
static_assert(64 * OS * 4 <= 160 * QS * 2, "o buffer must fit in the K~ region");
static_assert(O_END <= 163840 - 64, "HGRN LDS layout too large");
}
DEV int kt_rowbase(int i) { return i == 0 ? 0 : (i == 1 ? 16 : (i == 2 ? 48 : 96)); }

DEV void hgrn_prompt_chain(const Params& p, int l, int unit, unsigned char* lds) {
    using namespace hg;
    const int tid = threadIdx.x, lane = tid & 63, w = tid >> 6, g = lane >> 4, c16 = lane & 15;
    const int b = unit / HH, h = unit % HH;
    bf16_t* Qt = (bf16_t*)(lds + O_QT); bf16_t* Qh = (bf16_t*)(lds + O_QH); bf16_t* Kt = (bf16_t*)(lds + O_KT); float* Ob = (float*)(lds + O_KT);
    bf16_t* Kdt = (bf16_t*)(lds + O_KDT); bf16_t* Vt = (bf16_t*)(lds + O_VT); bf16_t* St = (bf16_t*)(lds + O_ST); bf16_t* Ab = (bf16_t*)(lds + O_AB); float* Gs = (float*)(lds + O_GS);
    const int kk = tid & 127, sj = tid >> 7;
    float lbv = 0.f;
    if (l > 0) lbv = sigmoidf_(p.lb_logits[HH * HD + h * HD + kk] - p.lb_logits[h * HD + kk]);
    const float oml = 1.0f - lbv;
    f32x4 Sacc[8];
#pragma unroll
    for (int i = 0; i < 8; ++i) Sacc[i] = (f32x4){0.f, 0.f, 0.f, 0.f};
    for (int i = tid; i < 128 * QS / 2; i += 512) ((unsigned*)St)[i] = 0u;
    for (int i = tid; i < 64 * VS / 2; i += 512) ((unsigned*)Ab)[i] = 0u;
    __syncthreads();
    const bf16_t* zb = p.z + (size_t)b * SEQ * ZW;
    for (int c = 0; c < SEQ / 64; ++c) {
        float Gl[16], qv[16], kv[16];
        {
            const bf16_t* zr = zb + (size_t)(c * 64 + sj * 16) * ZW + h * HD + kk;
            float run = 0.f; unsigned vpk[8];
#pragma unroll
            for (int s = 0; s < 16; ++s) {
                const float zq = bf2f(zr[(size_t)s * ZW]), zf = bf2f(zr[(size_t)s * ZW + 1024]), zi = bf2f(zr[(size_t)s * ZW + 2048]);
                const float e = __expf(-zf), sg = 1.0f / (1.0f + e);
                const float f = lbv + oml * sg;
                run += __logf(f); Gl[s] = run;
                kv[s] = oml * (e * sg);
                qv[s] = siluf_(zq);
                if (s & 1) vpk[s >> 1] |= f2bf(zi) << 16; else vpk[s >> 1] = f2bf(zi);
            }
            Gs[sj * 128 + kk] = run;
            u32x4 w0 = (u32x4){vpk[0], vpk[1], vpk[2], vpk[3]}, w1 = (u32x4){vpk[4], vpk[5], vpk[6], vpk[7]};
            *(u32x4*)(Vt + kk * VS + sj * 16) = w0; *(u32x4*)(Vt + kk * VS + sj * 16 + 8) = w1;
        }
        __syncthreads();
        {
            const float g0 = Gs[kk], g1 = Gs[128 + kk], g2 = Gs[256 + kk], g3 = Gs[384 + kk];
            float Gb[4]; Gb[0] = 0.f; Gb[1] = g0; Gb[2] = g0 + g1; Gb[3] = g0 + g1 + g2; const float Gend = Gb[3] + g3;
            const float Gbj = sj == 0 ? Gb[0] : (sj == 1 ? Gb[1] : (sj == 2 ? Gb[2] : Gb[3]));
            unsigned kd[8];
#pragma unroll
            for (int s = 0; s < 16; ++s) {
                const int t = sj * 16 + s;
                const float eq = __expf(Gl[s]);
                Qt[t * QS + kk] = (bf16_t)f2bf(qv[s] * eq);
                Qh[t * QS + kk] = (bf16_t)f2bf(qv[s] * eq * __expf(Gbj));
#pragma unroll
                for (int i = 0; i < 4; ++i) if (i >= sj) Kt[(kt_rowbase(i) + t) * QS + kk] = (bf16_t)f2bf(kv[s] * __expf(fminf(Gb[i] - Gbj - Gl[s], 60.f)));
                const unsigned kdv = f2bf(kv[s] * __expf(Gend - Gbj - Gl[s]));
                if (s & 1) kd[s >> 1] |= kdv << 16; else kd[s >> 1] = kdv;
            }
            *(u32x4*)(Kdt + kk * VS + sj * 16) = (u32x4){kd[0], kd[1], kd[2], kd[3]}; *(u32x4*)(Kdt + kk * VS + sj * 16 + 8) = (u32x4){kd[4], kd[5], kd[6], kd[7]};
        }
        __syncthreads();
        for (int blk = w; blk < 10; blk += 8) {
            int bi, bjj;
            if (blk == 0) { bi = 0; bjj = 0; } else if (blk < 3) { bi = 1; bjj = blk - 1; } else if (blk < 6) { bi = 2; bjj = blk - 3; } else { bi = 3; bjj = blk - 6; }
            f32x4 acc = (f32x4){0.f, 0.f, 0.f, 0.f};
#pragma unroll
            for (int ks = 0; ks < 4; ++ks) {
                const bf16x8 a = *(const bf16x8*)(Qt + (16 * bi + c16) * QS + 32 * ks + 8 * g);
                const bf16x8 bb = *(const bf16x8*)(Kt + (kt_rowbase(bi) + 16 * bjj + c16) * QS + 32 * ks + 8 * g);
                acc = MFMA_BF16(a, bb, acc);
            }
#pragma unroll
            for (int r = 0; r < 4; ++r) { const int tl = 4 * g + r; float v = acc[r]; if (bi == bjj && c16 > tl) v = 0.f; Ab[(16 * bi + tl) * VS + 16 * bjj + c16] = (bf16_t)f2bf(v); }
        }
        __syncthreads();
        {
            f32x4 oacc[4];
#pragma unroll
            for (int tt = 0; tt < 4; ++tt) {
                f32x4 acc = (f32x4){0.f, 0.f, 0.f, 0.f};
#pragma unroll
                for (int ks = 0; ks < 4; ++ks) {
                    const bf16x8 a = *(const bf16x8*)(Qh + (16 * tt + c16) * QS + 32 * ks + 8 * g);
                    const bf16x8 bb = *(const bf16x8*)(St + (16 * w + c16) * QS + 32 * ks + 8 * g);
                    acc = MFMA_BF16(a, bb, acc);
                }
#pragma unroll
                for (int ks = 0; ks < 2; ++ks) {
                    const bf16x8 a = *(const bf16x8*)(Ab + (16 * tt + c16) * VS + 32 * ks + 8 * g);
                    const bf16x8 bb = *(const bf16x8*)(Vt + (16 * w + c16) * VS + 32 * ks + 8 * g);
                    acc = MFMA_BF16(a, bb, acc);
                }
                oacc[tt] = acc;
            }
            float gam[4];
#pragma unroll
            for (int r = 0; r < 4; ++r) { const int k2 = 16 * w + 4 * g + r; gam[r] = __expf(Gs[k2] + Gs[128 + k2] + Gs[256 + k2] + Gs[384 + k2]); }
#pragma unroll
            for (int vt = 0; vt < 8; ++vt) {
                f32x4 acc = Sacc[vt];
#pragma unroll
                for (int r = 0; r < 4; ++r) acc[r] *= gam[r];
#pragma unroll
                for (int ks = 0; ks < 2; ++ks) {
                    const bf16x8 a = *(const bf16x8*)(Kdt + (16 * w + c16) * VS + 32 * ks + 8 * g);
                    const bf16x8 bb = *(const bf16x8*)(Vt + (16 * vt + c16) * VS + 32 * ks + 8 * g);
                    acc = MFMA_BF16(a, bb, acc);
                }
                Sacc[vt] = acc;
            }
            __syncthreads();
#pragma unroll
            for (int tt = 0; tt < 4; ++tt)
#pragma unroll
                for (int r = 0; r < 4; ++r) Ob[(16 * tt + 4 * g + r) * OS + 16 * w + c16] = oacc[tt][r];
#pragma unroll
            for (int vt = 0; vt < 8; ++vt) { u32x2 sw; sw.x = pack2(Sacc[vt][0], Sacc[vt][1]); sw.y = pack2(Sacc[vt][2], Sacc[vt][3]); *(u32x2*)(St + (16 * vt + c16) * QS + 16 * w + 4 * g) = sw; }
        }
        __syncthreads();
        {
            const int t = tid >> 3, part = tid & 7; const size_t row = (size_t)b * SEQ + c * 64 + t;
            float ov[16]; float ss = 0.f;
#pragma unroll
            for (int q = 0; q < 4; ++q) { const f32x4 x = *(const f32x4*)(Ob + t * OS + 16 * part + 4 * q); ov[4 * q] = x[0]; ov[4 * q + 1] = x[1]; ov[4 * q + 2] = x[2]; ov[4 * q + 3] = x[3];
                ss += x[0] * x[0] + x[1] * x[1] + x[2] * x[2] + x[3] * x[3]; }
            ss += __shfl_xor(ss, 1); ss += __shfl_xor(ss, 2); ss += __shfl_xor(ss, 4);
            const float rstd = rsqrtf(ss * (1.0f / HD) + EPS);
            const bf16_t* zg = p.z + row * ZW + 3072 + h * HD + 16 * part;
            const u32x4 za = *(const u32x4*)zg, zc = *(const u32x4*)(zg + 8);
            const unsigned zw[8] = {za.x, za.y, za.z, za.w, zc.x, zc.y, zc.z, zc.w};
            const float* gn = p.hgrn_norm_g + l * HD + 16 * part;
            unsigned ow[8];
#pragma unroll
            for (int q = 0; q < 8; ++q) { const float a0 = ov[2 * q] * rstd * gn[2 * q] * siluf_(lo16(zw[q])), a1 = ov[2 * q + 1] * rstd * gn[2 * q + 1] * siluf_(hi16(zw[q])); ow[q] = pack2(a0, a1); }
            bf16_t* dst = p.cat + row * D + h * HD + 16 * part;
            *(u32x4*)dst = (u32x4){ow[0], ow[1], ow[2], ow[3]}; *(u32x4*)(dst + 8) = (u32x4){ow[4], ow[5], ow[6], ow[7]};
        }
    }
    float* so = p.out + OFF_HP + ((size_t)(l * PB + b) * HH + h) * HD * HD;
#pragma unroll
    for (int vt = 0; vt < 8; ++vt)
#pragma unroll
        for (int r = 0; r < 4; ++r) so[(size_t)(16 * w + 4 * g + r) * HD + 16 * vt + c16] = Sacc[vt][r];
    __syncthreads();
}

DEV void hgrn_sample_unit(const Params& p, int l, int unit, unsigned char* lds) {
    const int tid = threadIdx.x, lane = tid & 63, w = tid >> 6;
    const int b = unit / HH, h = unit % HH;
    float* fS = (float*)lds; float* kS = fS + 512; float* qS = kS + 512; float* vS = qS + 512; float* red = vS + 512; float* part = red + 4 * 4 * 128;
    const int r0 = NP + b * DSEQ;
    {
        const int t = tid >> 7, kk = tid & 127; const bf16_t* zr = p.z + (size_t)(r0 + t) * ZW + h * HD + kk;
        float lbv = 0.f; if (l > 0) lbv = sigmoidf_(p.lb_logits[HH * HD + h * HD + kk] - p.lb_logits[h * HD + kk]);
        const float zq = bf2f(zr[0]), zf = bf2f(zr[1024]), zi = bf2f(zr[2048]);
        const float e = __expf(-zf), sg = 1.0f / (1.0f + e);
        fS[tid] = lbv + (1.0f - lbv) * sg; kS[tid] = (1.0f - lbv) * (e * sg); qS[tid] = siluf_(zq); vS[tid] = zi;
    }
    const int v = tid & 127, kq = tid >> 7;
    const float* s0 = p.state_hgrn + ((size_t)(l * DB + b) * HH + h) * HD * HD + (size_t)(32 * kq) * HD + v;
    float S[32];
#pragma unroll
    for (int i = 0; i < 32; ++i) S[i] = s0[(size_t)i * HD];
    __syncthreads();
#pragma unroll
    for (int t = 0; t < 4; ++t) {
        const float vv = vS[t * 128 + v]; float po = 0.f;
#pragma unroll
        for (int i = 0; i < 32; ++i) { const int kk = t * 128 + 32 * kq + i; S[i] = fS[kk] * S[i] + kS[kk] * vv; po += qS[kk] * S[i]; }
        red[(t * 4 + kq) * 128 + v] = po;
    }
    float* so = p.out + OFF_HS + ((size_t)(l * DB + b) * HH + h) * HD * HD + (size_t)(32 * kq) * HD + v;
#pragma unroll
    for (int i = 0; i < 32; ++i) so[(size_t)i * HD] = S[i];
    __syncthreads();
    {
        const int t = tid >> 7; const float o = red[(t * 4 + 0) * 128 + v] + red[(t * 4 + 1) * 128 + v] + red[(t * 4 + 2) * 128 + v] + red[(t * 4 + 3) * 128 + v];
        const float ss = wave_sum(o * o);
        if (lane == 0) part[w] = ss;
        __syncthreads();
        const float tot = part[2 * t] + part[2 * t + 1];
        const float rstd = rsqrtf(tot * (1.0f / HD) + EPS);
        const float zg = bf2f(p.z[(size_t)(r0 + t) * ZW + 3072 + h * HD + v]);
        p.cat[(size_t)(r0 + t) * D + h * HD + v] = (bf16_t)f2bf(o * rstd * p.hgrn_norm_g[l * HD + v] * siluf_(zg));
    }
    __syncthreads();
}

DEV void pool_pre_unit(const Params& p, int l, int unit) {
    const int tid = threadIdx.x, tk = tid >> 7, cg = tid & 127, c = cg * 8, gi = cg >> 5, wnd = 2 << gi;
    const int r = unit * 4 + tk;
    if (r >= NTOK) return;
    float sum[8], cur[8];
#pragma unroll
    for (int j = 0; j < 8; ++j) { sum[j] = 0.f; cur[j] = 0.f; }
    float cnt;
    if (r < NP) {
        const int t = r % SEQ; const int n = (wnd < t + 1) ? wnd : (t + 1); cnt = (float)n;
        for (int j = 0; j < n; ++j) { const u32x4 q = *(const u32x4*)(p.z + (size_t)(r - j) * ZW + 4096 + c);
            const float f[8] = {lo16(q.x), hi16(q.x), lo16(q.y), hi16(q.y), lo16(q.z), hi16(q.z), lo16(q.w), hi16(q.w)};
#pragma unroll
            for (int e = 0; e < 8; ++e) { sum[e] += f[e]; if (j == 0) cur[e] = f[e]; } }
        if (t >= SEQ - PBUF) { float* o = p.out + OFF_PP + ((size_t)(l * PB + r / SEQ) * PBUF + (t - (SEQ - PBUF))) * PW + c;
            *(f32x4*)o = (f32x4){cur[0], cur[1], cur[2], cur[3]}; *(f32x4*)(o + 4) = (f32x4){cur[4], cur[5], cur[6], cur[7]}; }
    } else {
        const int bb = (r - NP) / DSEQ, t = (r - NP) % DSEQ; cnt = (float)wnd;
        const float* sp = p.state_pool + (size_t)(l * DB + bb) * PBUF * PW + c;
        for (int j = 0; j < wnd; ++j) { const int tj = t - j;
            if (tj >= 0) { const u32x4 q = *(const u32x4*)(p.z + (size_t)(NP + bb * DSEQ + tj) * ZW + 4096 + c);
                const float f[8] = {lo16(q.x), hi16(q.x), lo16(q.y), hi16(q.y), lo16(q.z), hi16(q.z), lo16(q.w), hi16(q.w)};
#pragma unroll
                for (int e = 0; e < 8; ++e) { sum[e] += f[e]; if (j == 0) cur[e] = f[e]; } }
            else { const float* s = sp + (size_t)(PBUF + tj) * PW; const f32x4 a = *(const f32x4*)s, b2 = *(const f32x4*)(s + 4);
                sum[0] += a[0]; sum[1] += a[1]; sum[2] += a[2]; sum[3] += a[3]; sum[4] += b2[0]; sum[5] += b2[1]; sum[6] += b2[2]; sum[7] += b2[3]; } }
        float* ob = p.out + OFF_PS + (size_t)(l * DB + bb) * PBUF * PW + c;
        { float* o = ob + (size_t)(11 + t) * PW; *(f32x4*)o = (f32x4){cur[0], cur[1], cur[2], cur[3]}; *(f32x4*)(o + 4) = (f32x4){cur[4], cur[5], cur[6], cur[7]}; }
        for (int i = t; i < 11; i += 4) { const float* s = sp + (size_t)(4 + i) * PW; float* o = ob + (size_t)i * PW; *(f32x4*)o = *(const f32x4*)s; *(f32x4*)(o + 4) = *(const f32x4*)(s + 4); }
    }
    const float inv = 1.0f / cnt;
    u32x4 w; w.x = pack2(sum[0] * inv - cur[0], sum[1] * inv - cur[1]); w.y = pack2(sum[2] * inv - cur[2], sum[3] * inv - cur[3]);
    w.z = pack2(sum[4] * inv - cur[4], sum[5] * inv - cur[5]); w.w = pack2(sum[6] * inv - cur[6], sum[7] * inv - cur[7]);
    *(u32x4*)(p.pooled + ((size_t)gi * MPAD + r) * 256 + (c & 255)) = w;
}

#ifndef PROBE_SUB
#define PROBE_SUB 0
#endif
DEV void phase_mix(const Params& p, int l, unsigned char* lds) {
    const int nch = (2 * NCHAIN <= (int)gridDim.x) ? NCHAIN : 0;
    if ((int)blockIdx.x < nch) { for (int rep = 0; rep < (PROBE_SUB == 1 ? 2 : 1); ++rep) hgrn_prompt_chain(p, l, blockIdx.x, lds); return; }
    const int ob = blockIdx.x - nch, on = gridDim.x - nch;
    if (nch == 0) for (int u = blockIdx.x; u < NCHAIN; u += gridDim.x) hgrn_prompt_chain(p, l, u, lds);
    for (int rep = 0; rep < (PROBE_SUB == 2 ? 2 : 1); ++rep) for (int u = ob; u < DB * HH; u += on) hgrn_sample_unit(p, l, u, lds);
    for (int rep = 0; rep < (PROBE_SUB == 3 ? 2 : 1); ++rep) for (int u = ob; u < (NTOK + 3) / 4; u += on) pool_pre_unit(p, l, u);
}

#ifdef HIPEMU
#define MBCNT(mask) __builtin_popcountll((mask) & ((1ull << emu_lane()) - 1ull))
#define POPC64(m) __builtin_popcountll(m)
#else
#define MBCNT(mask) ((int)__builtin_amdgcn_mbcnt_hi((unsigned)((mask) >> 32), __builtin_amdgcn_mbcnt_lo((unsigned)(mask), 0u)))
#define POPC64(m) __popcll(m)
#endif
DEV unsigned fkey(float f) { const unsigned u = __float_as_uint(f); return u ^ ((unsigned)((int)u >> 31) | 0x80000000u); }
DEV unsigned long long lowest_n_bits(unsigned long long m, int n) { unsigned long long r = 0ull; while (n > 0 && m) { const unsigned long long b = m & (~m + 1ull); r |= b; m ^= b; --n; } return r; }
template <int NV> DEV unsigned kth_threshold(const unsigned (&key)[NV], int& cnt) {
    unsigned L = 0u, R = 0xFFFFFFFFu; int cR = 0;
    while (L < R) {
        const unsigned mid = L + ((R - L) >> 1);
        int c = 0;
#pragma unroll
        for (int i = 0; i < NV; ++i) c += (int)POPC64(__ballot(key[i] > mid));
        if (c <= 16) { R = mid; cR = c; if (c == 16) break; } else L = mid + 1u;
    }
    cnt = cR; return R;
}
template <int NV> DEV void topk_masks(const unsigned (&key)[NV], unsigned long long (&sel)[NV]) {
    int cnt; const unsigned T = kth_threshold<NV>(key, cnt);
    int need = 16 - cnt;
#pragma unroll
    for (int i = 0; i < NV; ++i) {
        sel[i] = __ballot(key[i] > T);
        if (need > 0) { const unsigned long long eq = __ballot(key[i] == T), take = lowest_n_bits(eq, need); sel[i] |= take; need -= (int)POPC64(take); }
    }
}
DEV void select_unit(const Params& p, int l, int tt, int h, unsigned char* lds, const f32x4 (&kb)[2][8]) {
    const int tid = threadIdx.x, lane = tid & 63, w = tid >> 6, g = lane >> 4, c16 = lane & 15;
    float* qn = (float*)lds;
    float* sc = qn + 16 * 260;
    float* ts = sc + 2 * 16 * 132;
    int* ti = (int*)(ts + 512);
    const int tok0 = tt * 16;
    {
        const int tk = tid >> 5, part = tid & 31; const int tok = tok0 + tk;
        f32x4 a = (f32x4){0.f, 0.f, 0.f, 0.f}, b2 = a;
        if (tok < NTOK) { const float* q = p.qry + (size_t)tok * D + h * 256 + part * 8; a = *(const f32x4*)q; b2 = *(const f32x4*)(q + 4); }
        float ss = a[0] * a[0] + a[1] * a[1] + a[2] * a[2] + a[3] * a[3] + b2[0] * b2[0] + b2[1] * b2[1] + b2[2] * b2[2] + b2[3] * b2[3];
        ss += __shfl_xor(ss, 1); ss += __shfl_xor(ss, 2); ss += __shfl_xor(ss, 4); ss += __shfl_xor(ss, 8);
        const float rn = rsqrtf(ss * (1.0f / 128.0f) + EPS);
        float* d = qn + tk * 260 + part * 8; *(f32x4*)d = a * rn; *(f32x4*)(d + 4) = b2 * rn;
    }
    __syncthreads();
#pragma unroll
    for (int ph = 0; ph < 2; ++ph) {
        const float* qa = qn + c16 * 260 + ph * 128 + 32 * g;
        f32x4 acc = (f32x4){0.f, 0.f, 0.f, 0.f};
#pragma unroll
        for (int k4 = 0; k4 < 8; ++k4) { const f32x4 av = *(const f32x4*)(qa + 4 * k4);
            acc = MFMA_F32(av[0], kb[ph][k4][0], acc); acc = MFMA_F32(av[1], kb[ph][k4][1], acc); acc = MFMA_F32(av[2], kb[ph][k4][2], acc); acc = MFMA_F32(av[3], kb[ph][k4][3], acc); }
#pragma unroll
        for (int r = 0; r < 4; ++r) sc[(ph * 16 + 4 * g + r) * 132 + 16 * w + c16] = acc[r];
    }
    __syncthreads();
    for (int rr = 0; rr < 4; ++rr) {
        const int row = w * 4 + rr;
        const float v0 = sc[row * 132 + lane], v1 = sc[row * 132 + 64 + lane];
        const unsigned key[2] = {fkey(v0), fkey(v1)}; unsigned long long sel[2];
        topk_masks<2>(key, sel);
        const int n0 = (int)POPC64(sel[0]);
        if ((sel[0] >> lane) & 1ull) { const int pos = MBCNT(sel[0]); ts[row * 16 + pos] = v0; ti[row * 16 + pos] = lane; }
        if ((sel[1] >> lane) & 1ull) { const int pos = n0 + MBCNT(sel[1]); ts[row * 16 + pos] = v1; ti[row * 16 + pos] = 64 + lane; }
    }
    __syncthreads();
    for (int q2 = 0; q2 < 2; ++q2) {
        const int tk = w * 2 + q2, tok = tok0 + tk, ci = lane >> 2, cj0 = 4 * (lane & 3);
        const float s1 = ts[tk * 16 + ci]; const int i1 = ti[tk * 16 + ci];
        float cv[4]; unsigned key[4]; unsigned long long sel[4];
#pragma unroll
        for (int q = 0; q < 4; ++q) { cv[q] = s1 + ts[(16 + tk) * 16 + cj0 + q]; key[q] = fkey(cv[q]); }
        topk_masks<4>(key, sel);
        float mx = -3.0e38f;
#pragma unroll
        for (int q = 0; q < 4; ++q) if ((sel[q] >> lane) & 1ull) mx = fmaxf(mx, cv[q]);
        mx = wave_max(mx);
        float ex[4]; float sm = 0.f;
#pragma unroll
        for (int q = 0; q < 4; ++q) { ex[q] = ((sel[q] >> lane) & 1ull) ? __expf(cv[q] - mx) : 0.f; sm += ex[q]; }
        sm = wave_sum(sm);
        const float inv = 1.0f / sm;
        int base = 0;
#pragma unroll
        for (int q = 0; q < 4; ++q) {
            if (((sel[q] >> lane) & 1ull) && tok < NTOK) { const int pos = base + MBCNT(sel[q]);
                const int e = i1 * 128 + ti[(16 + tk) * 16 + cj0 + q]; const size_t o = (size_t)tok * 128 + h * 16 + pos;
                p.eidx[o] = e; p.gate[o] = ex[q] * inv * p.sv[l * NE + e]; p.iscu[o] = p.su[l * NE + e]; }
            base += (int)POPC64(sel[q]);
        }
    }
    __syncthreads();
}
DEV void phase_select(const Params& p, int l, unsigned char* lds) {
    const int ntt = (NTOK + 15) / 16, lane = threadIdx.x & 63, w = threadIdx.x >> 6, g = lane >> 4, c16 = lane & 15;
    const bool fixed = (gridDim.x % 8u) == 0u;
    const int nunits = ntt * 8;
    int hcur = -1; f32x4 kb[2][8];
    for (int i = 0;; ++i) {
        int tt, h;
        if (fixed) { h = blockIdx.x & 7; tt = (blockIdx.x >> 3) + i * (gridDim.x >> 3); if (tt >= ntt) break; }
        else { const int u = blockIdx.x + i * gridDim.x; if (u >= nunits) break; tt = u >> 3; h = u & 7; }
        if (h != hcur) {
            hcur = h;
#pragma unroll
            for (int ph = 0; ph < 2; ++ph) { const float* kr = p.peer_keys + ((size_t)((l * 8 + h) * 2 + ph) * 128 + 16 * w + c16) * 128 + 32 * g;
#pragma unroll
                for (int k4 = 0; k4 < 8; ++k4) kb[ph][k4] = *(const f32x4*)(kr + 4 * k4); }
        }
        select_unit(p, l, tt, h, lds, kb);
    }
}

constexpr int PEER_TB = 272;
struct PeerDeal { int xs_first, xs_step, t_begin, t_end; };
DEV PeerDeal peer_deal() {
    PeerDeal d; const bool sl = (gridDim.x % 8u) == 0u;
    const int nranks = sl ? (int)(gridDim.x >> 3) : (int)gridDim.x, rank = sl ? (int)(blockIdx.x >> 3) : (int)blockIdx.x, tpr = (NTOK + nranks - 1) / nranks;
    d.xs_first = sl ? (int)(blockIdx.x & 7) : 0; d.xs_step = sl ? 8 : 1; d.t_begin = rank * tpr; d.t_end = d.t_begin + tpr < NTOK ? d.t_begin + tpr : NTOK;
    return d;
}
DEV void phase_peer_u(const Params& p, int l, unsigned char* lds) {
    const int lane = threadIdx.x & 63, w = threadIdx.x >> 6, j8 = lane & 7, g8 = lane >> 3;
    const bool b2 = (j8 & 4) != 0, b1 = (j8 & 2) != 0, b0 = (j8 & 1) != 0;
    const PeerDeal dl = peer_deal();
    const unsigned char* U = p.u8 + (size_t)l * NE * D;
    float* lp = (float*)lds;
    for (int xs = dl.xs_first; xs < 8; xs += dl.xs_step)
    for (int t0 = dl.t_begin; t0 < dl.t_end; t0 += PEER_TB) {
        const int nb = dl.t_end - t0 < PEER_TB ? dl.t_end - t0 : PEER_TB;
        for (int ch = 0; ch < 2; ++ch) {
            const int c0 = 256 * xs + 128 * ch + 16 * j8;
            for (int tk = w; tk < nb; tk += 8) {
                const int t = t0 + tk;
                const u32x4 ha = *(const u32x4*)(p.hB + (size_t)t * D + c0), hb = *(const u32x4*)(p.hB + (size_t)t * D + c0 + 8);
                const float hf[16] = {lo16(ha.x), hi16(ha.x), lo16(ha.y), hi16(ha.y), lo16(ha.z), hi16(ha.z), lo16(ha.w), hi16(ha.w), lo16(hb.x), hi16(hb.x), lo16(hb.y), hi16(hb.y), lo16(hb.z), hi16(hb.z), lo16(hb.w), hi16(hb.w)};
                const u32x4* ep = (const u32x4*)(p.eidx + (size_t)t * 128 + 16 * g8);
                const u32x4 e0 = ep[0], e1 = ep[1], e2 = ep[2], e3 = ep[3];
                const unsigned ev[16] = {e0.x, e0.y, e0.z, e0.w, e1.x, e1.y, e1.z, e1.w, e2.x, e2.y, e2.z, e2.w, e3.x, e3.y, e3.z, e3.w};
                u32x4 q[16];
#pragma unroll
                for (int i = 0; i < 16; ++i) q[i] = *(const u32x4*)(U + (size_t)ev[i] * D + c0);
                float ps[16];
#pragma unroll
                for (int i = 0; i < 16; ++i) { float dq[16]; fp8x16_dec(q[i], dq); float a = 0.f;
#pragma unroll
                    for (int k = 0; k < 16; ++k) a += dq[k] * hf[k];
                    ps[i] = a; }
                float q8[8], q4[4], q2[2];
#pragma unroll
                for (int k = 0; k < 8; ++k) { const float keep = b2 ? ps[8 + k] : ps[k], send = b2 ? ps[k] : ps[8 + k]; q8[k] = keep + DPP_HMIRROR(send); }
#pragma unroll
                for (int k = 0; k < 4; ++k) { const float keep = b1 ? q8[4 + k] : q8[k], send = b1 ? q8[k] : q8[4 + k]; q4[k] = keep + DPP_XOR2(send); }
#pragma unroll
                for (int k = 0; k < 2; ++k) { const float keep = b0 ? q4[2 + k] : q4[k], send = b0 ? q4[k] : q4[2 + k]; q2[k] = keep + DPP_XOR1(send); }
                float* lrow = lp + tk * 128 + 16 * g8 + 2 * j8;
                if (ch == 0) { lrow[0] = q2[0]; lrow[1] = q2[1]; }
                else { const size_t o = (size_t)t * 128 + 16 * g8 + 2 * j8;
                    float* dst = p.part + ((size_t)t * 8 + xs) * 128 + 16 * g8 + 2 * j8;
                    dst[0] = (q2[0] + lrow[0]) * p.iscu[o]; dst[1] = (q2[1] + lrow[1]) * p.iscu[o + 1]; }
            }
        }
    }
}
DEV void phase_peer_v(const Params& p, int l, unsigned char* lds) {
    const int lane = threadIdx.x & 63, w = threadIdx.x >> 6, j8 = lane & 7, g8 = lane >> 3;
    const bool b3 = (g8 & 1) != 0, b4 = (g8 & 2) != 0, b5 = (g8 & 4) != 0;
    const PeerDeal dl = peer_deal();
    const unsigned char* V = p.v8 + (size_t)l * NE * D;
    float* la_all = (float*)lds;
    for (int xs = dl.xs_first; xs < 8; xs += dl.xs_step)
    for (int t0 = dl.t_begin; t0 < dl.t_end; t0 += PEER_TB) {
        const int nb = dl.t_end - t0 < PEER_TB ? dl.t_end - t0 : PEER_TB;
        for (int ch = 0; ch < 2; ++ch) {
            const int c0 = 256 * xs + 128 * ch + 16 * j8;
            for (int tk = w; tk < nb; tk += 8) {
                const int t = t0 + tk;
                float* la = la_all + tk * 128;
                if (ch == 0) {
                    float s_lo = 0.f, s_hi = 0.f;
#pragma unroll
                    for (int x = 0; x < 8; ++x) { s_lo += p.part[((size_t)t * 8 + x) * 128 + lane]; s_hi += p.part[((size_t)t * 8 + x) * 128 + 64 + lane]; }
                    la[lane] = gelu_erf(s_lo) * p.gate[(size_t)t * 128 + lane]; la[64 + lane] = gelu_erf(s_hi) * p.gate[(size_t)t * 128 + 64 + lane];
                    WAVE_LDS_SYNC();
                }
                const f32x4 a0 = *(const f32x4*)(la + 16 * g8), a1 = *(const f32x4*)(la + 16 * g8 + 4), a2 = *(const f32x4*)(la + 16 * g8 + 8), a3 = *(const f32x4*)(la + 16 * g8 + 12);
                const float av[16] = {a0[0], a0[1], a0[2], a0[3], a1[0], a1[1], a1[2], a1[3], a2[0], a2[1], a2[2], a2[3], a3[0], a3[1], a3[2], a3[3]};
                const u32x4* ep = (const u32x4*)(p.eidx + (size_t)t * 128 + 16 * g8);
                const u32x4 e0 = ep[0], e1 = ep[1], e2 = ep[2], e3 = ep[3];
                const unsigned ev[16] = {e0.x, e0.y, e0.z, e0.w, e1.x, e1.y, e1.z, e1.w, e2.x, e2.y, e2.z, e2.w, e3.x, e3.y, e3.z, e3.w};
                u32x4 q[16];
#pragma unroll
                for (int i = 0; i < 16; ++i) q[i] = *(const u32x4*)(V + (size_t)ev[i] * D + c0);
                float acc[16];
#pragma unroll
                for (int k = 0; k < 16; ++k) acc[k] = 0.f;
#pragma unroll
                for (int i = 0; i < 16; ++i) { float dq[16]; fp8x16_dec(q[i], dq);
#pragma unroll
                    for (int k = 0; k < 16; ++k) acc[k] += av[i] * dq[k]; }
                float q8[8], q4[4], q2[2];
#pragma unroll
                for (int k = 0; k < 8; ++k) { const float keep = b3 ? acc[8 + k] : acc[k], send = b3 ? acc[k] : acc[8 + k]; q8[k] = keep + DPP_XOR8(send); }
#pragma unroll
                for (int k = 0; k < 4; ++k) { const float keep = b4 ? q8[4 + k] : q8[k], send = b4 ? q8[k] : q8[4 + k]; q4[k] = keep + __shfl_xor(send, 16); }
#pragma unroll
                for (int k = 0; k < 2; ++k) { const float keep = b5 ? q4[2 + k] : q4[k], send = b5 ? q4[k] : q4[2 + k]; q2[k] = keep + __shfl_xor(send, 32); }
                const int col = c0 + (b3 ? 8 : 0) + (b4 ? 4 : 0) + (b5 ? 2 : 0);
                const float* g2 = p.modbuf + (size_t)tok_batch(t) * MODW + l * NMOD + 5 * D + col;
                const float* x1 = p.xa + (size_t)t * D + col; float* o = p.xb + (size_t)t * D + col;
                o[0] = x1[0] + g2[0] * q2[0]; o[1] = x1[1] + g2[1] * q2[1];
            }
        }
    }
}

constexpr int N_PHASES = 23;
DEV int phase_class(int k) { return k < 2 ? k : (k == 22 ? 12 : 2 + (k - 2) % 10); }
#ifndef HIPEMU
#define XB_TMO      128
#define XB_XCNT(j)  (256  + 64 * (j))
#define XB_XSUB(j)  (1280 + 64 * (j))
#define XB_XGEN(j)  (2304 + 64 * (j))
#define XB_TOP      3328
#define XB_TOPGEN   3392
#define XCD_BAR_WORDS 3456
#define XB_SPIN_CAP (1u << 22)
__device__ __forceinline__ unsigned xb_ld(unsigned* p)              { return __hip_atomic_load(p, __ATOMIC_RELAXED, __HIP_MEMORY_SCOPE_AGENT); }
__device__ __forceinline__ unsigned xb_add(unsigned* p, unsigned v) { return __hip_atomic_fetch_add(p, v, __ATOMIC_RELAXED, __HIP_MEMORY_SCOPE_AGENT); }
__device__ __forceinline__ unsigned xb_xcc_id() { return (unsigned)__builtin_amdgcn_s_getreg((3 << 11) | 20) & 0xFu; }
#define XB_SPIN(cond, bar) do { unsigned _sp = 0; while (cond) { __builtin_amdgcn_s_sleep(1); \
    if ((++_sp & 255u) == 0u) { if (xb_ld(&(bar)[XB_TMO])) break; if (_sp > XB_SPIN_CAP) { atomicAdd(&(bar)[XB_TMO], 1u); break; } } } } while (0)
struct XcdBarrier { unsigned* bar; unsigned x; volatile LAS unsigned* st; };
__device__ __forceinline__ XcdBarrier xcd_barrier_post(unsigned* bar, volatile LAS unsigned* st) {
    XcdBarrier b; b.bar = bar; b.x = xb_xcc_id(); b.st = st;
    if (threadIdx.x == 0) (void)xb_add(&bar[XB_XCNT(b.x)], 1u);
    return b;
}
__device__ __forceinline__ void xcd_barrier_complete(unsigned* bar, unsigned x, unsigned& nloc, unsigned& nx) {
    const unsigned G = gridDim.x * gridDim.y * gridDim.z;
    unsigned sum, cnt, mine, sp = 0u;
    for (;;) {
        sum = 0u; cnt = 0u; mine = 0u;
#pragma unroll
        for (unsigned j = 0; j < 16; ++j) { const unsigned c = xb_ld(&bar[XB_XCNT(j)]); sum += c; cnt += (c > 0u) ? 1u : 0u; mine = (j == x) ? c : mine; }
        if (sum == G) break;
        __builtin_amdgcn_s_sleep(1);
        if ((++sp & 255u) == 0u) { if (xb_ld(&bar[XB_TMO])) break; if (sp > XB_SPIN_CAP) { atomicAdd(&bar[XB_TMO], 1u); break; } }
    }
    nloc = mine > 0u ? mine : 1u; nx = cnt > 0u ? cnt : 1u;
}
__device__ __forceinline__ void xcd_barrier(const XcdBarrier& b) {
    asm volatile("s_waitcnt vmcnt(0)" ::: "memory");
    __syncthreads();
    if (threadIdx.x == 0) {
        unsigned* bar = b.bar;
        __builtin_amdgcn_s_waitcnt(0);
        unsigned nloc = b.st[0], nx = b.st[1];
        if (nloc == 0u) { xcd_barrier_complete(bar, b.x, nloc, nx); b.st[0] = nloc; b.st[1] = nx; }
        const unsigned old = xb_add(&bar[XB_XSUB(b.x)], 1u);
        const unsigned gen = old / nloc;
        if (old + 1u == (gen + 1u) * nloc) {
            __builtin_amdgcn_fence(__ATOMIC_RELEASE, "agent");
            asm volatile("s_waitcnt vmcnt(0)" ::: "memory");
            const unsigned og = xb_add(&bar[XB_TOP], 1u);
            const unsigned tg = og / nx;
            if (og + 1u == (tg + 1u) * nx) xb_add(&bar[XB_TOPGEN], 1u);
            else XB_SPIN(xb_ld(&bar[XB_TOPGEN]) == tg, bar);
            __builtin_amdgcn_fence(__ATOMIC_ACQUIRE, "agent");
            xb_add(&bar[XB_XGEN(b.x)], 1u);
            asm volatile("s_waitcnt vmcnt(0)" ::: "memory");
        } else {
            XB_SPIN(xb_ld(&bar[XB_XGEN(b.x)]) == gen, bar);
            __builtin_amdgcn_fence(__ATOMIC_ACQUIRE, "agent");
            asm volatile("s_waitcnt vmcnt(0)" ::: "memory");
        }
    }
    __syncthreads();
}
#endif

constexpr int LDS_BYTES = 163840;
constexpr int LDS_BARW = LDS_BYTES - 16;

#ifndef PH_MASK
#define PH_MASK 0xFFFFFFFFu
#endif
#ifndef PROBE_DUP
#define PROBE_DUP 0u
#endif
#define DUP_N(k) (1 + (int)((PROBE_DUP >> phase_class(k)) & 1u))
#define PH_BIT(k) ((PH_MASK >> phase_class(k)) & 1u)
#ifdef HIPEMU
static void run_phase(const Params& pp, int ph, unsigned char* lds)
#define GRID_BAR() do {} while (0)
#define IN(k) (ph == (k))
#define GLDS lds
#define LOADP() const Params& p = pp
#else
typedef const __attribute__((address_space(4))) unsigned char* kargp_t;
__device__ __forceinline__ kargp_t karg_ptr() { kargp_t kp = (kargp_t)__builtin_amdgcn_kernarg_segment_ptr(); asm volatile("" : "+s"(kp)); return kp; }
#define LOADP() Params p; __builtin_memcpy(&p, karg_ptr(), sizeof(Params))
#define IN(k) (PH_BIT(k) && ph_lo <= (k) && (k) < ph_hi)
#define GLDS ((LAS unsigned char*)lds_raw)
__global__ void __launch_bounds__(512, 2) mega_fwd(Params p_unused)
#endif
{
#ifndef HIPEMU
    extern __shared__ __attribute__((aligned(16))) unsigned char lds_raw[];
    unsigned char* lds = lds_raw;
    if (threadIdx.x == 0) { *(volatile unsigned*)(lds_raw + LDS_BARW) = 0u; *(volatile unsigned*)(lds_raw + LDS_BARW + 4) = 0u; }
    __syncthreads();
    int ph_lo, ph_hi; XcdBarrier bar;
    { LOADP(); ph_lo = p.ph_lo; ph_hi = p.ph_hi; bar.bar = p.bar; bar.x = 0; bar.st = nullptr; }
    const bool multi = (ph_hi - ph_lo) > 1;
    if (multi) bar = xcd_barrier_post(bar.bar, (volatile LAS unsigned*)(lds_raw + LDS_BARW));
#define GRID_BAR() do { if (multi) xcd_barrier(bar); } while (0)
#endif
    if (IN(0)) { for (int rep = 0; rep < DUP_N(0); ++rep) { LOADP(); phase_convert(p, lds); GRID_BAR(); } }
    if (IN(1)) {
        LOADP();
        pg8::Gemm g{p.csil, p.wt_ada, 256, MODW, D}; pg8::StaticOrder S; S.init(256, MODW, gridDim.x, blockIdx.x);
        pg8::EpiAda E{p.modbuf, p.b_ada, p.b_ada_final};
        pg8::gemm_phase<pg8::EpiAda, pg8::StaticOrder>(GLDS, g, S, E);
        GRID_BAR();
    }
#define LAYER(l) do { \
        constexpr int base = 2 + 10 * (l); \
        if (IN(base + 0)) { LOADP(); phase_norm(p, (l) == 0 ? p.x_prompt : p.xb, (l) == 0 ? p.x_sample : p.xb + (size_t)NP * D, p.norm1_g + (l) * D, (l) * NMOD + 0 * D, (l) * NMOD + 1 * D, p.hA, nullptr); GRID_BAR(); } \
        if (IN(base + 1)) { LOADP(); \
            pg8::Gemm g{p.hA, p.wt_in + (size_t)(l) * ZW * D, MPAD, ZW, D}; pg8::StaticOrder S; S.init(MPAD, ZW, gridDim.x, blockIdx.x); \
            pg8::EpiBf16 E{p.z, ZW}; \
            pg8::gemm_phase<pg8::EpiBf16, pg8::StaticOrder>(GLDS, g, S, E); \
            GRID_BAR(); } \
        if (IN(base + 2)) { for (int rep = 0; rep < DUP_N(base + 2); ++rep) { LOADP(); phase_mix(p, (l), lds); GRID_BAR(); } } \
        if (IN(base + 3)) { LOADP(); \
            pg8::Gemm g{p.pooled, p.wt_pool + (size_t)(l) * 1024 * 256, 4 * MPAD, 1024, 256}; pg8::PoolOrder S{(int)gridDim.x, (int)blockIdx.x}; \
            pg8::EpiPool E{p.cat, p.pool_b + (l) * PW, p.pool_scale + (l) * PW}; \
            pg8::gemm_phase<pg8::EpiPool, pg8::PoolOrder>(GLDS, g, S, E); \
            GRID_BAR(); } \
        if (IN(base + 4)) { LOADP(); \
            pg8::Gemm g{p.cat, p.wt_out + (size_t)(l) * D * D, MPAD, D, D}; pg8::StaticOrder S; S.init(MPAD, D, gridDim.x, blockIdx.x); \
            pg8::EpiResid E{(l) == 0 ? p.x_prompt : p.xb, (l) == 0 ? p.x_sample : p.xb + (size_t)NP * D, p.modbuf + (l) * NMOD + 2 * D, p.xa}; \
            pg8::gemm_phase<pg8::EpiResid, pg8::StaticOrder>(GLDS, g, S, E); \
            GRID_BAR(); } \
        if (IN(base + 5)) { LOADP(); phase_norm(p, p.xa, p.xa + (size_t)NP * D, p.norm2_g + (l) * D, (l) * NMOD + 3 * D, (l) * NMOD + 4 * D, p.hB, nullptr); GRID_BAR(); } \
        if (IN(base + 6)) { LOADP(); \
            pg8::Gemm g{p.hB, p.wt_q + (size_t)(l) * D * D, MPAD, D, D}; pg8::StaticOrder S; S.init(MPAD, D, gridDim.x, blockIdx.x); \
            pg8::EpiF32 E{p.qry, D}; \
            pg8::gemm_phase<pg8::EpiF32, pg8::StaticOrder>(GLDS, g, S, E); \
            GRID_BAR(); } \
        if (IN(base + 7)) { for (int rep = 0; rep < DUP_N(base + 7); ++rep) { LOADP(); phase_select(p, (l), lds); GRID_BAR(); } } \
        if (IN(base + 8)) { for (int rep = 0; rep < DUP_N(base + 8); ++rep) { LOADP(); phase_peer_u(p, (l), lds); GRID_BAR(); } } \
        if (IN(base + 9)) { for (int rep = 0; rep < DUP_N(base + 9); ++rep) { LOADP(); phase_peer_v(p, (l), lds); GRID_BAR(); } } \
    } while (0)
    LAYER(0);
    LAYER(1);
    if (IN(22)) { LOADP(); phase_norm(p, p.xb, p.xb + (size_t)NP * D, p.final_g, 2 * NMOD, 2 * NMOD + D, nullptr, p.out + OFF_Y); }
#undef LAYER
#undef IN
#undef GRID_BAR
#undef GLDS
#undef LOADP
}

struct WsLayout { size_t bar, modbuf, csil, wt_ada, wt_in, wt_out, wt_q, wt_pool, u8, v8, su, sv, iscu, part, hA, hB, z, pooled, cat, xa, xb, qry, eidx, gate, end; };
static WsLayout ws_layout() {
    WsLayout L; size_t o = 0;
    auto take = [&](size_t bytes) { const size_t r = o; o += (bytes + 255) & ~(size_t)255; return r; };
    L.bar = take(16384);
    L.modbuf = take((size_t)256 * MODW * 4);
    L.csil = take((size_t)256 * D * 2);
    L.wt_ada = take((size_t)MODW * D * 2);
    L.wt_in = take((size_t)2 * ZW * D * 2);
    L.wt_out = take((size_t)2 * D * D * 2);
    L.wt_q = take((size_t)2 * D * D * 2);
    L.wt_pool = take((size_t)2 * 1024 * 256 * 2);
    L.u8 = take((size_t)2 * NE * D);
    L.v8 = take((size_t)2 * NE * D);
    L.su = take((size_t)2 * NE * 4);
    L.sv = take((size_t)2 * NE * 4);
    L.iscu = take((size_t)MPAD * 128 * 4);
    L.part = take((size_t)MPAD * 8 * 128 * 4);
    L.hA = take((size_t)MPAD * D * 2);
    L.hB = take((size_t)MPAD * D * 2);
    L.z = take((size_t)MPAD * ZW * 2);
    L.pooled = take((size_t)4 * MPAD * 256 * 2);
    L.cat = take((size_t)MPAD * D * 2);
    L.xa = take((size_t)MPAD * D * 4);
    L.xb = take((size_t)MPAD * D * 4);
    L.qry = take((size_t)MPAD * D * 4);
    L.eidx = take((size_t)MPAD * 128 * 4);
    L.gate = take((size_t)MPAD * 128 * 4);
    L.end = o;
    return L;
}
static void fill_params(Params& p, void* const* d_in, void* d_out, void* d_ws) {
    const float** f = (const float**)&p;
    for (int i = 0; i < 24; ++i) f[i] = (const float*)d_in[i];
    p.out = (float*)d_out;
    const WsLayout L = ws_layout(); unsigned char* w = (unsigned char*)d_ws;
    p.bar = (unsigned*)(w + L.bar); p.modbuf = (float*)(w + L.modbuf); p.csil = (bf16_t*)(w + L.csil); p.wt_ada = (bf16_t*)(w + L.wt_ada); p.wt_in = (bf16_t*)(w + L.wt_in);
    p.wt_out = (bf16_t*)(w + L.wt_out); p.wt_q = (bf16_t*)(w + L.wt_q); p.wt_pool = (bf16_t*)(w + L.wt_pool); p.u8 = w + L.u8; p.v8 = w + L.v8; p.su = (float*)(w + L.su); p.sv = (float*)(w + L.sv); p.iscu = (float*)(w + L.iscu); p.part = (float*)(w + L.part);
    p.hA = (bf16_t*)(w + L.hA); p.hB = (bf16_t*)(w + L.hB); p.z = (bf16_t*)(w + L.z); p.pooled = (bf16_t*)(w + L.pooled); p.cat = (bf16_t*)(w + L.cat);
    p.xa = (float*)(w + L.xa); p.xb = (float*)(w + L.xb); p.qry = (float*)(w + L.qry); p.eidx = (int*)(w + L.eidx); p.gate = (float*)(w + L.gate);
}

#ifndef HIPEMU
#ifndef MK_ONE_LAUNCH
#define MK_ONE_LAUNCH 1
#endif
extern "C" void kernel_launch(void* const* d_in, const int* in_sizes, int n_in, void* d_out, int out_size, void* d_ws, size_t ws_size, hipStream_t stream) {
    static int grid = 0;
    if (grid == 0) {
        const WsLayout L = ws_layout();
        if (n_in != 24 || (size_t)out_size != OUT_TOTAL || ws_size < L.end) { fprintf(stderr, "kernel_launch: unexpected shapes (n_in %d, out %d, ws %zu < %zu)\n", n_in, out_size, ws_size, L.end); grid = -1; return; }
        int dev = 0, cus = 0, per_cu = 0;
        hipGetDevice(&dev); hipDeviceGetAttribute(&cus, hipDeviceAttributeMultiprocessorCount, dev);
        if (hipFuncSetAttribute((const void*)mega_fwd, hipFuncAttributeMaxDynamicSharedMemorySize, LDS_BYTES) != hipSuccess) { fprintf(stderr, "kernel_launch: hipFuncSetAttribute failed\n"); grid = -1; return; }
        hipOccupancyMaxActiveBlocksPerMultiprocessor(&per_cu, (const void*)mega_fwd, 512, LDS_BYTES);
        (void)hipGetLastError();
        if (per_cu < 1) fprintf(stderr, "kernel_launch: occupancy query says %d blocks per CU\n", per_cu);
        grid = cus;
    }
    if (grid < 0) return;
    Params p{};
    fill_params(p, d_in, d_out, d_ws);
    hipMemsetAsync(p.bar, 0, 16384, stream);
#if MK_ONE_LAUNCH
    p.ph_lo = 0; p.ph_hi = N_PHASES;
    hipLaunchKernelGGL(mega_fwd, dim3(grid), dim3(512), LDS_BYTES, stream, p);
#else
    for (int ph = 0; ph < N_PHASES; ++ph) { p.ph_lo = ph; p.ph_hi = ph + 1; hipLaunchKernelGGL(mega_fwd, dim3(grid), dim3(512), LDS_BYTES, stream, p); }
#endif
}
#endif
```

```cpp
#ifndef HIPEMU
#include <hip/hip_runtime.h>
#include <cstdio>
#endif
#include <stdint.h>

#ifndef CFG_PB
#define CFG_PB 4
#define CFG_SEQ 2048
#define CFG_DB 128
#endif

#ifdef HIPEMU
#define DEV inline
#define LAS
#define READLANE_I(v, l) emu_readlane((v), (l))
#define READLANE_F(v, l) emu_readlane_f((v), (l))
#define MFMA_BF16(a, b, c) emu_mfma_bf16_16x16x32((a), (b), (c))
#define MFMA_F32(a, b, c) emu_mfma_f32_16x16x4((a), (b), (c))
#define __expf expf
#define __logf logf
#else
#define DEV __device__ __forceinline__
#define LAS __attribute__((address_space(3)))
#define READLANE_I(v, l) __builtin_amdgcn_readlane((v), (l))
#define READLANE_F(v, l) __uint_as_float((unsigned)__builtin_amdgcn_readlane((int)__float_as_uint(v), (l)))
#define MFMA_BF16(a, b, c) __builtin_amdgcn_mfma_f32_16x16x32_bf16((a), (b), (c), 0, 0, 0)
#define MFMA_F32(a, b, c) __builtin_amdgcn_mfma_f32_16x16x4f32((a), (b), (c), 0, 0, 0)
#endif

typedef unsigned short bf16_t;
typedef short bf16x8 __attribute__((ext_vector_type(8)));
typedef float f32x4 __attribute__((ext_vector_type(4)));
typedef unsigned u32x4 __attribute__((ext_vector_type(4)));
typedef unsigned u32x2 __attribute__((ext_vector_type(2)));

namespace cfg {
constexpr int D = 2048, PB = CFG_PB, SEQ = CFG_SEQ, DB = CFG_DB, DSEQ = 4;
constexpr int NP = PB * SEQ, NS = DB * DSEQ, NTOK = NP + NS, MPAD = (NTOK + 255) / 256 * 256;
constexpr int NC = PB + DB;
constexpr int HH = 8, HD = 128, PW = 1024, PBUF = 15, ZW = 5120;
constexpr int NE = 16384;
constexpr int NMOD = 6 * D;
constexpr int MODW = 2 * NMOD + 2 * D;
constexpr float EPS = 1e-6f;
constexpr int NCHAIN = PB * HH;
constexpr size_t OFF_Y = 0;
constexpr size_t OFF_HP = (size_t)NTOK * D;
constexpr size_t OFF_PP = OFF_HP + (size_t)2 * PB * HH * HD * HD;
constexpr size_t OFF_HS = OFF_PP + (size_t)2 * PB * PBUF * PW;
constexpr size_t OFF_PS = OFF_HS + (size_t)2 * DB * HH * HD * HD;
constexpr size_t OUT_TOTAL = OFF_PS + (size_t)2 * DB * PBUF * PW;
}
using namespace cfg;

struct Params {
    const float *x_prompt, *x_sample, *c_prompt, *c_sample, *state_hgrn, *state_pool, *w_ada, *b_ada, *norm1_g, *norm2_g, *w_in, *w_out,
        *lb_logits, *hgrn_norm_g, *pool_w, *pool_b, *pool_scale, *peer_wq, *peer_keys, *peer_u, *peer_v, *final_g, *w_ada_final, *b_ada_final;
    float* out;
    unsigned* bar; float* modbuf; bf16_t* csil; bf16_t* wt_ada; bf16_t* wt_in; bf16_t* wt_out; bf16_t* wt_q; bf16_t* wt_pool;
    unsigned char* u8; unsigned char* v8; float* su; float* sv; float* iscu; float* part; float* hg_oin; float* hg_ds; float* hg_gam; bf16_t* hg_qh; bf16_t* hg_sc; bf16_t* hA; bf16_t* hB; bf16_t* z; bf16_t* pooled; bf16_t* cat; float* xa; float* xb; float* qry; int* eidx; float* gate;
    int ph_lo, ph_hi;
};

DEV float bf2f(unsigned v) { return __uint_as_float(v << 16); }
#ifdef HIPEMU
DEV unsigned f2bf(float f) { unsigned u = __float_as_uint(f); u += 0x7fffu + ((u >> 16) & 1u); return u >> 16; }
DEV unsigned pack2(float lo, float hi) { return f2bf(lo) | (f2bf(hi) << 16); }
#else
typedef float f32x2_t __attribute__((ext_vector_type(2)));
typedef __bf16 bf16x2_t __attribute__((ext_vector_type(2)));
DEV unsigned pack2(float lo, float hi) { const f32x2_t v = {lo, hi}; return __builtin_bit_cast(unsigned, __builtin_convertvector(v, bf16x2_t)); }
DEV unsigned f2bf(float f) { return (unsigned)__builtin_bit_cast(unsigned short, (__bf16)f); }
#endif
DEV float lo16(unsigned w) { return __uint_as_float(w << 16); }
DEV float hi16(unsigned w) { return __uint_as_float(w & 0xffff0000u); }
DEV float wave_sum(float v) { v += __shfl_xor(v, 32); v += __shfl_xor(v, 16); v += __shfl_xor(v, 8); v += __shfl_xor(v, 4); v += __shfl_xor(v, 2); v += __shfl_xor(v, 1); return v; }
DEV float wave_max(float v) { v = fmaxf(v, __shfl_xor(v, 32)); v = fmaxf(v, __shfl_xor(v, 16)); v = fmaxf(v, __shfl_xor(v, 8)); v = fmaxf(v, __shfl_xor(v, 4)); v = fmaxf(v, __shfl_xor(v, 2)); v = fmaxf(v, __shfl_xor(v, 1)); return v; }
DEV float sigmoidf_(float x) { return 1.0f / (1.0f + __expf(-x)); }
DEV float siluf_(float x) { return x / (1.0f + __expf(-x)); }
DEV float gelu_erf(float x) { return 0.5f * x * (1.0f + erff(x * 0.70710678118f)); }
DEV int tok_batch(int t) { return t < NP ? t / SEQ : PB + (t - NP) / DSEQ; }


#ifdef HIPEMU
static inline unsigned emu_fp8_enc1(float x) {
    const unsigned sgn = x < 0.f ? 0x80u : 0u; float a = fabsf(x);
    if (!(a == a)) return 0x7fu;
    if (a >= 448.f) return sgn | 0x7eu;
    if (a < 0.015625f) { const int q = (int)rintf(a * 512.f); return sgn | (unsigned)q; }
    int e = (int)floorf(log2f(a)); if (ldexpf(1.f, e) > a) --e; if (ldexpf(1.f, e + 1) <= a) ++e;
    int m = (int)rintf((a / ldexpf(1.f, e) - 1.f) * 8.f); if (m == 8) { m = 0; ++e; }
    if (e > 8) return sgn | 0x7eu;
    return sgn | (unsigned)((e + 7) << 3) | (unsigned)m;
}
static inline float emu_fp8_dec1(unsigned b) { const float sg = (b & 0x80u) ? -1.f : 1.f; const int e = (b >> 3) & 15, m = b & 7; return sg * (e == 0 ? m * 0.001953125f : (1.f + m * 0.125f) * ldexpf(1.f, e - 7)); }
DEV unsigned fp8x4_enc(float a, float b, float c, float d) { return emu_fp8_enc1(a) | (emu_fp8_enc1(b) << 8) | (emu_fp8_enc1(c) << 16) | (emu_fp8_enc1(d) << 24); }
DEV void fp8x4_dec(unsigned w, float* o) { o[0] = emu_fp8_dec1(w & 255u); o[1] = emu_fp8_dec1((w >> 8) & 255u); o[2] = emu_fp8_dec1((w >> 16) & 255u); o[3] = emu_fp8_dec1(w >> 24); }
#define DPP_XOR1(v) __shfl((v), emu_lane() ^ 1)
#define DPP_XOR2(v) __shfl((v), emu_lane() ^ 2)
#define DPP_HMIRROR(v) __shfl((v), (emu_lane() & ~7) | (7 - (emu_lane() & 7)))
#define DPP_XOR8(v) __shfl((v), emu_lane() ^ 8)
#define WAVE_LDS_SYNC() emu_wbar()
#else
typedef float f32x2v_t __attribute__((ext_vector_type(2)));
DEV unsigned fp8x4_enc(float a, float b, float c, float d) { int r = __builtin_amdgcn_cvt_pk_fp8_f32(a, b, 0, false); r = __builtin_amdgcn_cvt_pk_fp8_f32(c, d, r, true); return (unsigned)r; }
DEV void fp8x4_dec(unsigned w, float* o) { const f32x2v_t lo = __builtin_amdgcn_cvt_pk_f32_fp8((int)w, false), hi = __builtin_amdgcn_cvt_pk_f32_fp8((int)w, true); o[0] = lo[0]; o[1] = lo[1]; o[2] = hi[0]; o[3] = hi[1]; }
template <int CTRL> DEV float dpp_f(float v) { return __uint_as_float((unsigned)__builtin_amdgcn_update_dpp(0, (int)__float_as_uint(v), CTRL, 0xf, 0xf, true)); }
#define DPP_XOR1(v) dpp_f<0xB1>(v)
#define DPP_XOR2(v) dpp_f<0x4E>(v)
#define DPP_HMIRROR(v) dpp_f<0x141>(v)
#define DPP_XOR8(v) dpp_f<0x128>(v)
#define WAVE_LDS_SYNC() asm volatile("s_waitcnt lgkmcnt(0)" ::: "memory")
#endif
typedef float f32x2 __attribute__((ext_vector_type(2)));
#ifdef HIPEMU
DEV void fp8x4_dec2(unsigned w, f32x2& lo, f32x2& hi) { float o[4]; fp8x4_dec(w, o); lo = (f32x2){o[0], o[1]}; hi = (f32x2){o[2], o[3]}; }
#else
DEV void fp8x4_dec2(unsigned w, f32x2& lo, f32x2& hi) { lo = __builtin_amdgcn_cvt_pk_f32_fp8((int)w, false); hi = __builtin_amdgcn_cvt_pk_f32_fp8((int)w, true); }
#endif
DEV void fp8x16_dec2(u32x4 q, f32x2* o) { fp8x4_dec2(q.x, o[0], o[1]); fp8x4_dec2(q.y, o[2], o[3]); fp8x4_dec2(q.z, o[4], o[5]); fp8x4_dec2(q.w, o[6], o[7]); }

namespace pg8 {
constexpr int BM = 256, BK = 64, HALF = 128, HTB = HALF * BK * 2, STAGE_BYTES = 8 * HTB, NXCD = 8, WGM = 8;
DEV int lds_byte(int r, int c) { const int st = (r >> 4) * 2 + (c >> 5), rr = r & 15, cc = c & 31, ob = rr * 64 + cc * 2; return st * 1024 + (ob ^ (((ob >> 9) & 1) << 5)); }
DEV void stage_rc(int b, int& R, int& C) { const int st = b / 1024, sb = b % 1024, swz = sb ^ (((sb >> 9) & 1) << 5); R = (st >> 1) * 16 + swz / 64; C = (st & 1) * 32 + (swz % 64) / 2; }
DEV int perm32(int rho) { const int n = rho >> 4, i = rho & 15; return 8 * (i >> 2) + 4 * n + (i & 3); }
struct Unit { int pm, pn; };
struct Gemm { const bf16_t* A; const bf16_t* Bt; int M, N, K; };
struct StaticOrder {
    int nM, nN, nwg, G, c;
    DEV void init(int M, int N, int G_, int c_) { nM = M / BM; nN = N / BM; nwg = nM * nN; G = G_; c = c_; }
    DEV bool next(int i, Unit& u) const {
        const long L = (long)i * G + c; if (L >= nwg) return false;
        int wgid = (int)L; { const int q = nwg / NXCD, r = nwg % NXCD, xcd = wgid % NXCD, off = wgid / NXCD; wgid = (xcd < r ? xcd * (q + 1) : r * (q + 1) + (xcd - r) * q) + off; }
        const int nig = WGM * nN, gid = wgid / nig, fm = gid * WGM, gsz = (nM - fm) < WGM ? (nM - fm) : WGM;
        u.pm = fm + ((wgid % nig) % gsz); u.pn = (wgid % nig) / gsz; return true;
    }
    DEV void a_ready(const Unit&) const {}
    DEV void done(const Unit&) const {}
};
struct PoolOrder {
    int G, c;
    DEV bool next(int i, Unit& u) const { const int L = i * G + c; if (L >= 4 * (MPAD / 256)) return false; u.pm = L; u.pn = L / (MPAD / 256); return true; }
    DEV void a_ready(const Unit&) const {}
    DEV void done(const Unit&) const {}
};

struct EpiF32 {
    static constexpr bool PERM = false;
    float* C; int ldc;
    DEV void operator()(const f32x4 (&acc)[2][2][4][2], const Unit& u, int wr, int wc, int fr, int fq) const {
        const int row0 = u.pm * BM + wr * 64 + fr, col0 = u.pn * BM + wc * 32 + 4 * fq;
#pragma unroll
        for (int ai = 0; ai < 2; ++ai)
#pragma unroll
            for (int m = 0; m < 4; ++m) { float* rowp = C + (size_t)(row0 + ai * HALF + m * 16) * ldc + col0;
#pragma unroll
                for (int bj = 0; bj < 2; ++bj)
#pragma unroll
                    for (int n = 0; n < 2; ++n) *(f32x4*)(rowp + bj * HALF + n * 16) = acc[ai][bj][m][n]; }
    }
};
struct EpiAda {
    static constexpr bool PERM = false;
    float* C; const float* b_ada; const float* b_fin;
    DEV void operator()(const f32x4 (&acc)[2][2][4][2], const Unit& u, int wr, int wc, int fr, int fq) const {
        const int row0 = u.pm * BM + wr * 64 + fr, col0 = u.pn * BM + wc * 32 + 4 * fq;
        const float* bias = (u.pn * BM < 2 * NMOD) ? b_ada + col0 : b_fin + (col0 - 2 * NMOD);
        f32x4 bv[2][2];
#pragma unroll
        for (int bj = 0; bj < 2; ++bj)
#pragma unroll
            for (int n = 0; n < 2; ++n) bv[bj][n] = *(const f32x4*)(bias + bj * HALF + n * 16);
#pragma unroll
        for (int ai = 0; ai < 2; ++ai)
#pragma unroll
            for (int m = 0; m < 4; ++m) { float* rowp = C + (size_t)(row0 + ai * HALF + m * 16) * MODW + col0;
#pragma unroll
                for (int bj = 0; bj < 2; ++bj)
#pragma unroll
                    for (int n = 0; n < 2; ++n) *(f32x4*)(rowp + bj * HALF + n * 16) = acc[ai][bj][m][n] + bv[bj][n]; }
    }
};
struct EpiResid {
    static constexpr bool PERM = false;
    const float* xlo; const float* xhi; const float* gmod  ; float* out;
    DEV void operator()(const f32x4 (&acc)[2][2][4][2], const Unit& u, int wr, int wc, int fr, int fq) const {
        const int row0 = u.pm * BM + wr * 64 + fr, col0 = u.pn * BM + wc * 32 + 4 * fq;
#pragma unroll
        for (int ai = 0; ai < 2; ++ai)
#pragma unroll
            for (int m = 0; m < 4; ++m) {
                const int row = row0 + ai * HALF + m * 16;
                if (row < NTOK) {
                    const float* xr = (row < NP ? xlo + (size_t)row * D : xhi + (size_t)(row - NP) * D) + col0;
                    const float* gr = gmod + (size_t)tok_batch(row) * MODW + col0;
                    float* rowp = out + (size_t)row * D + col0;
#pragma unroll
                    for (int bj = 0; bj < 2; ++bj)
#pragma unroll
                        for (int n = 0; n < 2; ++n) { const f32x4 xv = *(const f32x4*)(xr + bj * HALF + n * 16), gv = *(const f32x4*)(gr + bj * HALF + n * 16);
                            *(f32x4*)(rowp + bj * HALF + n * 16) = xv + gv * acc[ai][bj][m][n]; }
                }
            }
    }
};
struct EpiBf16 {
    static constexpr bool PERM = true;
    bf16_t* O; int ldc;
    DEV void operator()(const f32x4 (&acc)[2][2][4][2], const Unit& u, int wr, int wc, int fr, int fq) const {
        const int row0 = u.pm * BM + wr * 64 + fr, col0 = u.pn * BM + wc * 32 + 8 * fq;
#pragma unroll
        for (int ai = 0; ai < 2; ++ai)
#pragma unroll
            for (int m = 0; m < 4; ++m) { bf16_t* rowp = O + (size_t)(row0 + ai * HALF + m * 16) * ldc + col0;
#pragma unroll
                for (int bj = 0; bj < 2; ++bj) { const f32x4 v0 = acc[ai][bj][m][0], v1 = acc[ai][bj][m][1];
                    u32x4 w; w.x = pack2(v0[0], v0[1]); w.y = pack2(v0[2], v0[3]); w.z = pack2(v1[0], v1[1]); w.w = pack2(v1[2], v1[3]);
                    *(u32x4*)(rowp + bj * HALF) = w; } }
    }
};
struct EpiPool {
    static constexpr bool PERM = true;
    bf16_t* cat; const float* pb; const float* ps;
    DEV void operator()(const f32x4 (&acc)[2][2][4][2], const Unit& u, int wr, int wc, int fr, int fq) const {
        const int g = u.pn, tok0 = u.pm * BM - g * MPAD + wr * 64 + fr, col0 = g * 256 + wc * 32 + 8 * fq;
#pragma unroll
        for (int bj = 0; bj < 2; ++bj) {
            const f32x4 b0 = *(const f32x4*)(pb + col0 + bj * HALF), b1 = *(const f32x4*)(pb + col0 + bj * HALF + 4);
            const f32x4 s0 = *(const f32x4*)(ps + col0 + bj * HALF), s1 = *(const f32x4*)(ps + col0 + bj * HALF + 4);
#pragma unroll
            for (int ai = 0; ai < 2; ++ai)
#pragma unroll
                for (int m = 0; m < 4; ++m) { const int tok = tok0 + ai * HALF + m * 16;
                    if (tok < NTOK) { const f32x4 v0 = (acc[ai][bj][m][0] + b0) * s0, v1 = (acc[ai][bj][m][1] + b1) * s1;
                        u32x4 w; w.x = pack2(v0[0], v0[1]); w.y = pack2(v0[2], v0[3]); w.z = pack2(v1[0], v1[1]); w.w = pack2(v1[2], v1[3]);
                        *(u32x4*)(cat + (size_t)tok * D + 1024 + col0 + bj * HALF) = w; } }
        }
    }
};

#ifdef HIPEMU
template <class Epi, class Sched>
static void gemm_phase(unsigned char*, const Gemm g, const Sched& S, const Epi& E) {
    const int tid = threadIdx.x, wid = tid >> 6, lane = tid & 63, wr = wid >> 2, wc = wid & 3, fr = lane & 15, fq = lane >> 4;
    Unit cur;
    for (int ui = 0; S.next(ui, cur); ++ui) {
        f32x4 acc[2][2][4][2];
        for (int ai = 0; ai < 2; ++ai) for (int bj = 0; bj < 2; ++bj) for (int m = 0; m < 4; ++m) for (int n = 0; n < 2; ++n) for (int j = 0; j < 4; ++j) {
            const int row = 256 * cur.pm + 128 * ai + 64 * wr + 16 * m + fr;
            const int col = Epi::PERM ? 256 * cur.pn + 128 * bj + 32 * wc + 8 * fq + 4 * n + j : 256 * cur.pn + 128 * bj + 32 * wc + 16 * n + 4 * fq + j;
            float s = 0.f;
            if ((row % emu_row_mod) < emu_row_limit) { const float* a = emu_f32_copy(g.A, (size_t)g.M * g.K) + (size_t)row * g.K; const float* b = emu_f32_copy(g.Bt, (size_t)g.N * g.K) + (size_t)col * g.K;
                for (int k = 0; k < g.K; ++k) s += a[k] * b[k]; }
            acc[ai][bj][m][n][j] = s; }
        E(acc, cur, wr, wc, fr, fq);
    }
    __syncthreads();
}
#else
template <class Epi, class Sched>
__device__ __forceinline__ void gemm_phase(LAS unsigned char* lds, const Gemm g, const Sched& S, const Epi& E) {
    const int tid = threadIdx.x, wid = __builtin_amdgcn_readfirstlane(tid >> 6), lane = tid & 63, wr = wid >> 2, wc = wid & 3, fr = lane & 15, fq = lane >> 4;
    int K = g.K; asm volatile("" : "+s"(K));
    const int nt = K / BK;
    unsigned voffA[2], voffB[2];
#pragma unroll
    for (int i = 0; i < 2; ++i) { int R, C; stage_rc(tid * 16 + i * 8192, R, C); const int Rb = Epi::PERM ? ((R & ~31) + perm32(R & 31)) : R;
        voffA[i] = (unsigned)(R * K + C) * 2u; voffB[i] = (unsigned)(Rb * K + C) * 2u; }
    const size_t kstep = (size_t)(BK * 2);
    const size_t hstep = (size_t)HALF * K * 2;
    const size_t tstep = 2 * hstep;
    const unsigned ldsw = (unsigned)wid * 1024u;
    const int aoff = lds_byte(wr * 64 + fr, fq * 8), boff = lds_byte(wc * 32 + fr, fq * 8);
#define PG8_SA(b, h) (((b) * 2 + (h)) * HTB)
#define PG8_SB(b, h) ((4 + (b) * 2 + (h)) * HTB)
#define PG8_STAGE(bufoff, gbase, voff) do { _Pragma("unroll") for (int _i = 0; _i < 2; ++_i) \
        __builtin_amdgcn_global_load_lds((const unsigned*)((const char*)(gbase) + (voff)[_i]), (LAS unsigned*)(lds + (bufoff) + ldsw + _i * 8192), 16, 0, 0); } while (0)
#define PG8_LDA(dst, b, h) do { _Pragma("unroll") for (int m = 0; m < 4; ++m) _Pragma("unroll") for (int k = 0; k < 2; ++k) dst[m][k] = *(const LAS bf16x8*)(lds + PG8_SA(b, h) + aoff + m * 2048 + k * 1024); } while (0)
#define PG8_LDB(dst, b, h) do { _Pragma("unroll") for (int n = 0; n < 2; ++n) _Pragma("unroll") for (int k = 0; k < 2; ++k) dst[n][k] = *(const LAS bf16x8*)(lds + PG8_SB(b, h) + boff + n * 2048 + k * 1024); } while (0)
#define PG8_MMA(ai, bj, At, Bt) do { __builtin_amdgcn_s_setprio(1); _Pragma("unroll") for (int m = 0; m < 4; ++m) _Pragma("unroll") for (int n = 0; n < 2; ++n) _Pragma("unroll") for (int k = 0; k < 2; ++k) \
        acc[ai][bj][m][n] = __builtin_amdgcn_mfma_f32_16x16x32_bf16(Bt[n][k], At[m][k], acc[ai][bj][m][n], 0, 0, 0); __builtin_amdgcn_s_setprio(0); } while (0)
#define PG8_WAIT_V(n) asm volatile("s_waitcnt vmcnt(" #n ")" ::: "memory")
#define PG8_WAIT_L(n) asm volatile("s_waitcnt lgkmcnt(" #n ")" ::: "memory")
#define PG8_BAR __builtin_amdgcn_s_barrier()
#define PG8_SCHED __builtin_amdgcn_sched_barrier(0)
    Unit cur, nxt; int ui = 0;
    if (!S.next(0, cur)) return;
    f32x4 acc[2][2][4][2];
#pragma unroll
    for (int a = 0; a < 2; ++a)
#pragma unroll
        for (int b = 0; b < 2; ++b)
#pragma unroll
            for (int m = 0; m < 4; ++m)
#pragma unroll
                for (int n = 0; n < 2; ++n) acc[a][b][m][n] = (f32x4){0.f, 0.f, 0.f, 0.f};
    bf16x8 At[4][2], B0[2][2], B1[2][2];
    const char* cA = (const char*)g.A + (size_t)cur.pm * tstep; const char* cB = (const char*)g.Bt + (size_t)cur.pn * tstep;
    S.a_ready(cur);
    PG8_STAGE(PG8_SB(0, 0), cB, voffB); PG8_STAGE(PG8_SA(0, 0), cA, voffA); PG8_STAGE(PG8_SB(0, 1), cB + hstep, voffB); PG8_STAGE(PG8_SA(0, 1), cA + hstep, voffA);
    if (wr == 1) PG8_BAR;
    PG8_WAIT_V(4); PG8_BAR;
    PG8_STAGE(PG8_SB(1, 0), cB + kstep, voffB); PG8_STAGE(PG8_SA(1, 0), cA + kstep, voffA); PG8_STAGE(PG8_SB(1, 1), cB + hstep + kstep, voffB);
    PG8_WAIT_V(6); PG8_BAR;
    for (;;) {
        const bool has_next = S.next(ui + 1, nxt);
        const char* nA = has_next ? (const char*)g.A + (size_t)nxt.pm * tstep : cA; const char* nB = has_next ? (const char*)g.Bt + (size_t)nxt.pn * tstep : cB;
        for (int t = 0; t < nt; t += 2) {
            const bool last = (t == nt - 2);
            const char* a1 = cA + (size_t)(t + 1) * kstep;
            const char* a2 = last ? nA : cA + (size_t)(t + 2) * kstep; const char* b2 = last ? nB : cB + (size_t)(t + 2) * kstep;
            const char* a3 = a2 + kstep; const char* b3 = b2 + kstep;
            if (last && has_next) S.a_ready(nxt);
            PG8_LDB(B0, 0, 0); PG8_SCHED; PG8_LDA(At, 0, 0); PG8_STAGE(PG8_SA(1, 1), a1 + hstep, voffA);
            PG8_WAIT_L(8); PG8_BAR; PG8_WAIT_L(0); PG8_MMA(0, 0, At, B0); PG8_BAR; PG8_SCHED;
            PG8_LDB(B1, 0, 1); PG8_STAGE(PG8_SB(0, 0), b2, voffB);
            PG8_BAR; PG8_WAIT_L(0); PG8_MMA(0, 1, At, B1); PG8_BAR;
            PG8_LDA(At, 0, 1); PG8_STAGE(PG8_SA(0, 0), a2, voffA);
            PG8_BAR; PG8_WAIT_L(0); PG8_MMA(1, 0, At, B0); PG8_BAR; PG8_SCHED;
            PG8_STAGE(PG8_SB(0, 1), b2 + hstep, voffB);
            PG8_WAIT_V(6); PG8_BAR; PG8_MMA(1, 1, At, B1); PG8_BAR;
            PG8_LDB(B0, 1, 0); PG8_SCHED; PG8_LDA(At, 1, 0); PG8_STAGE(PG8_SA(0, 1), a2 + hstep, voffA);
            PG8_WAIT_L(8); PG8_BAR; PG8_WAIT_L(0); PG8_MMA(0, 0, At, B0); PG8_BAR; PG8_SCHED;
            PG8_LDB(B1, 1, 1); PG8_STAGE(PG8_SB(1, 0), b3, voffB);
            PG8_BAR; PG8_WAIT_L(0); PG8_MMA(0, 1, At, B1); PG8_BAR;
            PG8_LDA(At, 1, 1); PG8_STAGE(PG8_SA(1, 0), a3, voffA);
            PG8_BAR; PG8_WAIT_L(0); PG8_MMA(1, 0, At, B0); PG8_BAR; PG8_SCHED;
            PG8_STAGE(PG8_SB(1, 1), b3 + hstep, voffB);
            PG8_WAIT_V(6); PG8_BAR; PG8_MMA(1, 1, At, B1); PG8_BAR;
        }
        { int tz = threadIdx.x; asm volatile("" : "+v"(tz)); const int wz = tz >> 6, lz = tz & 63;
          E(acc, cur, wz >> 2, wz & 3, lz & 15, lz >> 4); } S.done(cur);
        if (!has_next) break;
#pragma unroll
        for (int a = 0; a < 2; ++a)
#pragma unroll
            for (int b = 0; b < 2; ++b)
#pragma unroll
                for (int m = 0; m < 4; ++m)
#pragma unroll
                    for (int n = 0; n < 2; ++n) acc[a][b][m][n] = (f32x4){0.f, 0.f, 0.f, 0.f};
        cur = nxt; cA = nA; cB = nB; ++ui;
    }
    PG8_WAIT_V(0);
    if (wr == 0) PG8_BAR;
    PG8_BAR;
#undef PG8_SA
#undef PG8_SB
#undef PG8_STAGE
#undef PG8_LDA
#undef PG8_LDB
#undef PG8_MMA
#undef PG8_WAIT_V
#undef PG8_WAIT_L
#undef PG8_BAR
#undef PG8_SCHED
}
#endif
}

constexpr int MBIG = (NP / 256) * 256;
template <class F> DEV void small_gemm(const bf16_t* A, const bf16_t* Bt, int K, unsigned char* lds, const F& f) {
    const int tid = threadIdx.x, lane = tid & 63, w = tid >> 6, g = lane >> 4, c16 = lane & 15;
    const int tiles_m = (NTOK - MBIG + 63) / 64, ntiles = tiles_m * 32, kw = K / 8;
    float* part = (float*)lds;
    for (int tl = blockIdx.x; tl < ntiles; tl += gridDim.x) {
        const int r0 = MBIG + (tl / 32) * 64, n0 = (tl % 32) * 64;
        f32x4 acc[4][4];
#pragma unroll
        for (int i = 0; i < 4; ++i)
#pragma unroll
            for (int j = 0; j < 4; ++j) acc[i][j] = (f32x4){0.f, 0.f, 0.f, 0.f};
        for (int k0 = w * kw; k0 < (w + 1) * kw; k0 += 128) {
            bf16x8 af[4][4], bfr[4][4];
#pragma unroll
            for (int u = 0; u < 4; ++u)
#pragma unroll
                for (int i = 0; i < 4; ++i) { int arow = r0 + 16 * i + c16; if (arow >= MPAD) arow = MPAD - 1;
                    af[u][i] = *(const bf16x8*)(A + (size_t)arow * K + k0 + 32 * u + 8 * g); bfr[u][i] = *(const bf16x8*)(Bt + (size_t)(n0 + 16 * i + c16) * K + k0 + 32 * u + 8 * g); }
#pragma unroll
            for (int u = 0; u < 4; ++u)
#pragma unroll
                for (int i = 0; i < 4; ++i)
#pragma unroll
                    for (int j = 0; j < 4; ++j) acc[i][j] = MFMA_BF16(af[u][i], bfr[u][j], acc[i][j]);
        }
#pragma unroll
        for (int i = 0; i < 4; ++i)
#pragma unroll
            for (int j = 0; j < 4; ++j)
#pragma unroll
                for (int r = 0; r < 4; ++r) part[(w * 64 + 16 * i + 4 * g + r) * 68 + 16 * j + c16] = acc[i][j][r];
        __syncthreads();
        {
            const int row = tid >> 3, c8 = (tid & 7) * 8; f32x4 s0 = (f32x4){0.f, 0.f, 0.f, 0.f}, s1 = s0;
#pragma unroll
            for (int ww = 0; ww < 8; ++ww) { s0 += *(const f32x4*)(part + (ww * 64 + row) * 68 + c8); s1 += *(const f32x4*)(part + (ww * 64 + row) * 68 + c8 + 4); }
            if (r0 + row < NTOK) f(r0 + row, n0 + c8, s0, s1);
        }
        __syncthreads();
    }
}
struct SmallResid { const float* xlo; const float* xhi; const float* gmod; float* out;
    DEV void operator()(int row, int col, f32x4 v0, f32x4 v1) const { const float* xr = (row < NP ? xlo + (size_t)row * D : xhi + (size_t)(row - NP) * D) + col; const float* gr = gmod + (size_t)tok_batch(row) * MODW + col;
        float* o = out + (size_t)row * D + col; *(f32x4*)o = *(const f32x4*)xr + *(const f32x4*)gr * v0; *(f32x4*)(o + 4) = *(const f32x4*)(xr + 4) + *(const f32x4*)(gr + 4) * v1; } };
struct SmallF32 { float* out; DEV void operator()(int row, int col, f32x4 v0, f32x4 v1) const { float* o = out + (size_t)row * D + col; *(f32x4*)o = v0; *(f32x4*)(o + 4) = v1; } };

DEV void transpose_tile(const float* src, int ld_src, bf16_t* dst, int ld_dst, float* tile) {
    const int tid = threadIdx.x;
#pragma unroll
    for (int i = 0; i < 2; ++i) { const int idx = tid + i * 512, r = idx >> 4, c4 = idx & 15; const f32x4 v = *(const f32x4*)(src + (size_t)r * ld_src + c4 * 4);
        float* t = tile + r * 65 + c4 * 4; t[0] = v[0]; t[1] = v[1]; t[2] = v[2]; t[3] = v[3]; }
    __syncthreads();
    const int n = tid >> 3, kg = tid & 7; const float* t = tile + (kg * 8) * 65 + n;
    u32x4 w; w.x = pack2(t[0], t[65]); w.y = pack2(t[2 * 65], t[3 * 65]); w.z = pack2(t[4 * 65], t[5 * 65]); w.w = pack2(t[6 * 65], t[7 * 65]);
    *(u32x4*)(dst + (size_t)n * ld_dst + kg * 8) = w;
    __syncthreads();
}
DEV int cvt_job_tiles(int j) { const int K = j < 9 ? 2048 : 256; const int N = j < 2 ? NMOD : (j == 2 ? 2 * D : (j < 5 ? ZW : (j < 9 ? D : 256))); return (K / 64) * (N / 64); }
DEV void phase_convert(const Params& p, unsigned char* lds) {
    float* tile = (float*)lds;
    const int tid = threadIdx.x;
    int total = 0;
#pragma unroll
    for (int q = 0; q < 17; ++q) total += cvt_job_tiles(q);
    for (int tl = blockIdx.x; tl < total; tl += gridDim.x) {
        int j = 0, loc = 0, base = 0;
#pragma unroll
        for (int q = 0; q < 17; ++q) { const int cnt = cvt_job_tiles(q); if (tl >= base && tl < base + cnt) { j = q; loc = tl - base; } base += cnt; }
        const float* src; bf16_t* dst; int K = 2048, N;
        if (j < 2) { N = NMOD; src = p.w_ada + (size_t)j * 2048 * NMOD; dst = p.wt_ada + (size_t)j * NMOD * 2048; }
        else if (j == 2) { N = 2 * D; src = p.w_ada_final; dst = p.wt_ada + (size_t)2 * NMOD * 2048; }
        else if (j < 5) { N = ZW; src = p.w_in + (size_t)(j - 3) * 2048 * ZW; dst = p.wt_in + (size_t)(j - 3) * ZW * 2048; }
        else if (j < 7) { N = D; src = p.w_out + (size_t)(j - 5) * D * D; dst = p.wt_out + (size_t)(j - 5) * D * D; }
        else if (j < 9) { N = D; src = p.peer_wq + (size_t)(j - 7) * D * D; dst = p.wt_q + (size_t)(j - 7) * D * D; }
        else { K = 256; N = 256; src = p.pool_w + (size_t)(j - 9) * 65536; dst = p.wt_pool + (size_t)(j - 9) * 65536; }
        const int ntn = N / 64, kt = loc / ntn, nt = loc % ntn;
        transpose_tile(src + (size_t)kt * 64 * N + nt * 64, N, dst + (size_t)nt * 64 * K + kt * 64, K, tile);
    }
    const size_t gt = (size_t)blockIdx.x * 512 + tid, gs = (size_t)gridDim.x * 512;
    {
        const int lane = tid & 63, gw = blockIdx.x * 8 + (tid >> 6), nw = gridDim.x * 8;
        for (int row = gw; row < 4 * NE; row += nw) {
            const int which = row / (2 * NE), rr = row % (2 * NE);
            const float* src = (which ? p.peer_v : p.peer_u) + (size_t)rr * D; unsigned char* tab = (which ? p.v8 : p.u8) + (size_t)(rr / NE) * NE * D; const int e = rr % NE;
            f32x4 v[8]; float am = 0.f;
#pragma unroll
            for (int k = 0; k < 8; ++k) { v[k] = *(const f32x4*)(src + 4 * lane + 256 * k); am = fmaxf(am, fmaxf(fmaxf(fabsf(v[k][0]), fabsf(v[k][1])), fmaxf(fabsf(v[k][2]), fabsf(v[k][3])))); }
            am = wave_max(am);
            const float sc = am > 0.f ? 224.0f / am : 1.0f;
#pragma unroll
            for (int k = 0; k < 8; ++k) *(unsigned*)(tab + ((size_t)(2 * k + (lane >> 5)) * NE + e) * 128 + 4 * (lane & 31)) = fp8x4_enc(v[k][0] * sc, v[k][1] * sc, v[k][2] * sc, v[k][3] * sc);
            if (lane == 0) (which ? p.sv : p.su)[rr] = am > 0.f ? am * (1.0f / 224.0f) : 1.0f;
        }
    }
    for (size_t i = gt; i < (size_t)256 * D / 8; i += gs) {
        const int row = (int)(i / (D / 8)), c8 = (int)(i % (D / 8)) * 8; u32x4 w = (u32x4){0u, 0u, 0u, 0u};
        if (row < NC) { const float* s = (row < PB ? p.c_prompt + (size_t)row * D : p.c_sample + (size_t)(row - PB) * D) + c8;
            const f32x4 a = *(const f32x4*)s, b = *(const f32x4*)(s + 4);
            w.x = pack2(siluf_(a[0]), siluf_(a[1])); w.y = pack2(siluf_(a[2]), siluf_(a[3])); w.z = pack2(siluf_(b[0]), siluf_(b[1])); w.w = pack2(siluf_(b[2]), siluf_(b[3])); }
        *(u32x4*)(p.csil + i * 8) = w;
    }
}

DEV void phase_norm(const Params& p, const float* xlo, const float* xhi, const float* gn, int sh_off, int sc_off, bf16_t* obf, float* of32) {
    const int lane = threadIdx.x & 63, gw = blockIdx.x * 8 + (threadIdx.x >> 6), nw = gridDim.x * 8;
    for (int t = gw; t < NTOK; t += nw) {
        const float* xr = t < NP ? xlo + (size_t)t * D : xhi + (size_t)(t - NP) * D;
        const float* mrow = p.modbuf + (size_t)tok_batch(t) * MODW;
        f32x4 v[8]; float ss = 0.f;
#pragma unroll
        for (int c = 0; c < 4; ++c) { const int col = c * 512 + lane * 8; v[2 * c] = *(const f32x4*)(xr + col); v[2 * c + 1] = *(const f32x4*)(xr + col + 4);
#pragma unroll
            for (int j = 0; j < 4; ++j) ss += v[2 * c][j] * v[2 * c][j] + v[2 * c + 1][j] * v[2 * c + 1][j]; }
        ss = wave_sum(ss);
        const float rstd = rsqrtf(ss * (1.0f / D) + EPS);
#pragma unroll
        for (int c = 0; c < 4; ++c) { const int col = c * 512 + lane * 8; f32x4 y[2];
#pragma unroll
            for (int q = 0; q < 2; ++q) { const f32x4 g4 = *(const f32x4*)(gn + col + 4 * q), sc = *(const f32x4*)(mrow + sc_off + col + 4 * q), sh = *(const f32x4*)(mrow + sh_off + col + 4 * q);
                y[q] = (v[2 * c + q] * rstd) * g4 * (sc + 1.0f) + sh; }
            if (obf) { u32x4 w; w.x = pack2(y[0][0], y[0][1]); w.y = pack2(y[0][2], y[0][3]); w.z = pack2(y[1][0], y[1][1]); w.w = pack2(y[1][2], y[1][3]); *(u32x4*)(obf + (size_t)t * D + col) = w; }
            else { *(f32x4*)(of32 + (size_t)t * D + col) = y[0]; *(f32x4*)(of32 + (size_t)t * D + col + 4) = y[1]; }
        }
    }
}

namespace hg {
constexpr int QS = 136, VS = 72;
constexpr int O_QT = 0, O_QH = O_QT + 64 * QS * 2, O_KT = O_QH + 64 * QS * 2, O_KDT = O_KT + 160 * QS * 2, O_VT = O_KDT + 128 * VS * 2,
              O_AB = O_VT + 128 * VS * 2, O_GS = O_AB + 64 * VS * 2, O_END = O_GS + 4 * 128 * 4;
constexpr int OS = 132;
static_assert(O_END <= 163840 - 64, "HGRN LDS layout too large");
constexpr int NCHUNK = SEQ / 64, NUNIT = PB * HH * NCHUNK;
}
DEV int kt_rowbase(int i) { return i == 0 ? 0 : (i == 1 ? 16 : (i == 2 ? 48 : 96)); }

DEV void hgrn_pre_unit(const Params& p, int l, int unit, unsigned char* lds) {
    using namespace hg;
    const int tid = threadIdx.x, lane = tid & 63, w = tid >> 6, g = lane >> 4, c16 = lane & 15;
    const int c = unit % NCHUNK, bh = unit / NCHUNK, b = bh / HH, h = bh % HH;
    bf16_t* Qt = (bf16_t*)(lds + O_QT); bf16_t* Qh = (bf16_t*)(lds + O_QH); bf16_t* Kt = (bf16_t*)(lds + O_KT);
    bf16_t* Kdt = (bf16_t*)(lds + O_KDT); bf16_t* Vt = (bf16_t*)(lds + O_VT); bf16_t* Ab = (bf16_t*)(lds + O_AB); float* Gs = (float*)(lds + O_GS);
    const int kk = tid & 127, sj = tid >> 7;
    float lbv = 0.f;
    if (l > 0) lbv = sigmoidf_(p.lb_logits[HH * HD + h * HD + kk] - p.lb_logits[h * HD + kk]);
    const float oml = 1.0f - lbv;
    for (int i = tid; i < 64 * VS / 2; i += 512) ((unsigned*)Ab)[i] = 0u;
    const size_t row0 = (size_t)b * SEQ + c * 64;
    float Gl[16], qv[16], kv[16];
    {
        const bf16_t* zr = p.z + (row0 + sj * 16) * ZW + h * HD + kk;
        unsigned short zq16[16], zf16[16], zi16[16];
#pragma unroll
        for (int s = 0; s < 16; ++s) { zq16[s] = zr[(size_t)s * ZW]; zf16[s] = zr[(size_t)s * ZW + 1024]; zi16[s] = zr[(size_t)s * ZW + 2048]; }
        float run = 0.f; unsigned vpk[8];
#pragma unroll
        for (int s = 0; s < 16; ++s) {
            const float zq = bf2f(zq16[s]), zf = bf2f(zf16[s]);
            const float e = __expf(-zf), sg = 1.0f / (1.0f + e);
            const float f = lbv + oml * sg;
            run += __logf(f); Gl[s] = run;
            kv[s] = oml * (e * sg);
            qv[s] = siluf_(zq);
            if (s & 1) vpk[s >> 1] |= (unsigned)zi16[s] << 16; else vpk[s >> 1] = zi16[s];
        }
        Gs[sj * 128 + kk] = run;
        *(u32x4*)(Vt + kk * VS + sj * 16) = (u32x4){vpk[0], vpk[1], vpk[2], vpk[3]}; *(u32x4*)(Vt + kk * VS + sj * 16 + 8) = (u32x4){vpk[4], vpk[5], vpk[6], vpk[7]};
    }
    __syncthreads();
    float Gend;
    {
        const float g0 = Gs[kk], g1 = Gs[128 + kk], g2 = Gs[256 + kk], g3 = Gs[384 + kk];
        float Gb[4]; Gb[0] = 0.f; Gb[1] = g0; Gb[2] = g0 + g1; Gb[3] = g0 + g1 + g2; Gend = Gb[3] + g3;
        const float Gbj = sj == 0 ? Gb[0] : (sj == 1 ? Gb[1] : (sj == 2 ? Gb[2] : Gb[3]));
        const float eGb = __expf(Gbj);
        unsigned kd[8]; unsigned qh[8];
#pragma unroll
        for (int s = 0; s < 16; ++s) {
            const int t = sj * 16 + s;
            const float q1 = qv[s] * __expf(Gl[s]);
            Qt[t * QS + kk] = (bf16_t)f2bf(q1);
            const unsigned qhv = f2bf(q1 * eGb);
            Qh[t * QS + kk] = (bf16_t)qhv;
#pragma unroll
            for (int i = 0; i < 4; ++i) if (i >= sj) Kt[(kt_rowbase(i) + t) * QS + kk] = (bf16_t)f2bf(kv[s] * __expf(fminf(Gb[i] - Gbj - Gl[s], 60.f)));
            const unsigned kdv = f2bf(kv[s] * __expf(Gend - Gbj - Gl[s]));
            if (s & 1) kd[s >> 1] |= kdv << 16; else kd[s >> 1] = kdv;
        }
        *(u32x4*)(Kdt + kk * VS + sj * 16) = (u32x4){kd[0], kd[1], kd[2], kd[3]}; *(u32x4*)(Kdt + kk * VS + sj * 16 + 8) = (u32x4){kd[4], kd[5], kd[6], kd[7]};
        if (sj == 0) p.hg_gam[(size_t)unit * HD + kk] = __expf(Gend);
    }
    __syncthreads();
    {
        const int t = tid >> 3, part = tid & 7;
        const u32x4 a = *(const u32x4*)(Qh + t * QS + 16 * part), b2 = *(const u32x4*)(Qh + t * QS + 16 * part + 8);
        bf16_t* dst = p.hg_qh + (row0 + t) * 1024 + h * HD + 16 * part; *(u32x4*)dst = a; *(u32x4*)(dst + 8) = b2;
    }
    for (int blk = w; blk < 10; blk += 8) {
        int bi, bjj;
        if (blk == 0) { bi = 0; bjj = 0; } else if (blk < 3) { bi = 1; bjj = blk - 1; } else if (blk < 6) { bi = 2; bjj = blk - 3; } else { bi = 3; bjj = blk - 6; }
        f32x4 acc = (f32x4){0.f, 0.f, 0.f, 0.f};
#pragma unroll
        for (int ks = 0; ks < 4; ++ks) {
            const bf16x8 a = *(const bf16x8*)(Qt + (16 * bi + c16) * QS + 32 * ks + 8 * g);
            const bf16x8 bb = *(const bf16x8*)(Kt + (kt_rowbase(bi) + 16 * bjj + c16) * QS + 32 * ks + 8 * g);
            acc = MFMA_BF16(a, bb, acc);
        }
#pragma unroll
        for (int r = 0; r < 4; ++r) { const int tl = 4 * g + r; float v = acc[r]; if (bi == bjj && c16 > tl) v = 0.f; Ab[(16 * bi + tl) * VS + 16 * bjj + c16] = (bf16_t)f2bf(v); }
    }
    __syncthreads();
    {
        f32x4* oin = (f32x4*)(p.hg_oin + (size_t)unit * 64 * 128);
#pragma unroll
        for (int tt = 0; tt < 4; ++tt) {
            f32x4 acc = (f32x4){0.f, 0.f, 0.f, 0.f};
#pragma unroll
            for (int ks = 0; ks < 2; ++ks) {
                const bf16x8 a = *(const bf16x8*)(Ab + (16 * tt + c16) * VS + 32 * ks + 8 * g);
                const bf16x8 bb = *(const bf16x8*)(Vt + (16 * w + c16) * VS + 32 * ks + 8 * g);
                acc = MFMA_BF16(a, bb, acc);
            }
            oin[(tt * 8 + w) * 64 + lane] = acc;
        }
        f32x4* ds = (f32x4*)(p.hg_ds + (size_t)unit * 128 * 128);
#pragma unroll
        for (int vt = 0; vt < 8; ++vt) {
            f32x4 acc = (f32x4){0.f, 0.f, 0.f, 0.f};
#pragma unroll
            for (int ks = 0; ks < 2; ++ks) {
                const bf16x8 a = *(const bf16x8*)(Kdt + (16 * w + c16) * VS + 32 * ks + 8 * g);
                const bf16x8 bb = *(const bf16x8*)(Vt + (16 * vt + c16) * VS + 32 * ks + 8 * g);
                acc = MFMA_BF16(a, bb, acc);
            }
            ds[(w * 8 + vt) * 64 + lane] = acc;
        }
    }
    __syncthreads();
}

DEV void hgrn_scan_unit(const Params& p, int l, int su) {
    using namespace hg;
    const int tid = threadIdx.x, lane = tid & 63, w = tid >> 6, g = lane >> 4, c16 = lane & 15;
    const int vt = su % 8, bh = su / 8, b = bh / HH, h = bh % HH;
    f32x4 S = (f32x4){0.f, 0.f, 0.f, 0.f};
    for (int c = 0; c < NCHUNK; ++c) {
        const size_t unit = (size_t)bh * NCHUNK + c;
        u32x2 sw; sw.x = pack2(S[0], S[1]); sw.y = pack2(S[2], S[3]);
        *(u32x2*)(p.hg_sc + (unit * 128 + 16 * vt + c16) * 128 + 16 * w + 4 * g) = sw;
        const f32x4 d = ((const f32x4*)(p.hg_ds + unit * 128 * 128))[(w * 8 + vt) * 64 + lane];
        const f32x4 gm = *(const f32x4*)(p.hg_gam + unit * HD + 16 * w + 4 * g);
        S = S * gm + d;
    }
    float* so = p.out + OFF_HP + ((size_t)(l * PB + b) * HH + h) * HD * HD;
#pragma unroll
    for (int r = 0; r < 4; ++r) so[(size_t)(16 * w + 4 * g + r) * HD + 16 * vt + c16] = S[r];
}

DEV void hgrn_post_unit(const Params& p, int l, int unit, unsigned char* lds) {
    using namespace hg;
    const int tid = threadIdx.x, lane = tid & 63, w = tid >> 6, g = lane >> 4, c16 = lane & 15;
    const int c = unit % NCHUNK, bh = unit / NCHUNK, b = bh / HH, h = bh % HH;
    float* Ob = (float*)lds;
    const size_t row0 = (size_t)b * SEQ + c * 64;
    const f32x4* oin = (const f32x4*)(p.hg_oin + (size_t)unit * 64 * 128);
    f32x4 acc[4];
#pragma unroll
    for (int tt = 0; tt < 4; ++tt) acc[tt] = oin[(tt * 8 + w) * 64 + lane];
    if (c > 0) {
        bf16x8 bfr[4];
#pragma unroll
        for (int ks = 0; ks < 4; ++ks) bfr[ks] = *(const bf16x8*)(p.hg_sc + ((size_t)unit * 128 + 16 * w + c16) * 128 + 32 * ks + 8 * g);
#pragma unroll
        for (int tt = 0; tt < 4; ++tt)
#pragma unroll
            for (int ks = 0; ks < 4; ++ks) { const bf16x8 a = *(const bf16x8*)(p.hg_qh + (row0 + 16 * tt + c16) * 1024 + h * HD + 32 * ks + 8 * g); acc[tt] = MFMA_BF16(a, bfr[ks], acc[tt]); }
    }
#pragma unroll
    for (int tt = 0; tt < 4; ++tt)
#pragma unroll
        for (int r = 0; r < 4; ++r) Ob[(16 * tt + 4 * g + r) * OS + 16 * w + c16] = acc[tt][r];
    __syncthreads();
    {
        const int t = tid >> 3, part = tid & 7; const size_t row = row0 + t;
        float ov[16]; float ss = 0.f;
#pragma unroll
        for (int q = 0; q < 4; ++q) { const f32x4 x = *(const f32x4*)(Ob + t * OS + 16 * part + 4 * q); ov[4 * q] = x[0]; ov[4 * q + 1] = x[1]; ov[4 * q + 2] = x[2]; ov[4 * q + 3] = x[3];
            ss += x[0] * x[0] + x[1] * x[1] + x[2] * x[2] + x[3] * x[3]; }
        ss += __shfl_xor(ss, 1); ss += __shfl_xor(ss, 2); ss += __shfl_xor(ss, 4);
        const float rstd = rsqrtf(ss * (1.0f / HD) + EPS);
        const bf16_t* zg = p.z + row * ZW + 3072 + h * HD + 16 * part;
        const u32x4 za = *(const u32x4*)zg, zc = *(const u32x4*)(zg + 8);
        const unsigned zw[8] = {za.x, za.y, za.z, za.w, zc.x, zc.y, zc.z, zc.w};
        const float* gn = p.hgrn_norm_g + l * HD + 16 * part;
        unsigned ow[8];
#pragma unroll
        for (int q = 0; q < 8; ++q) { const float a0 = ov[2 * q] * rstd * gn[2 * q] * siluf_(lo16(zw[q])), a1 = ov[2 * q + 1] * rstd * gn[2 * q + 1] * siluf_(hi16(zw[q])); ow[q] = pack2(a0, a1); }
        bf16_t* dst = p.cat + row * D + h * HD + 16 * part;
        *(u32x4*)dst = (u32x4){ow[0], ow[1], ow[2], ow[3]}; *(u32x4*)(dst + 8) = (u32x4){ow[4], ow[5], ow[6], ow[7]};
    }
    __syncthreads();
}

DEV void hgrn_sample_unit(const Params& p, int l, int unit, unsigned char* lds) {
    const int tid = threadIdx.x, lane = tid & 63, w = tid >> 6;
    const int b = unit / HH, h = unit % HH;
    float* fS = (float*)lds; float* kS = fS + 512; float* qS = kS + 512; float* vS = qS + 512; float* red = vS + 512; float* part = red + 4 * 4 * 128;
    const int r0 = NP + b * DSEQ;
    {
        const int t = tid >> 7, kk = tid & 127; const bf16_t* zr = p.z + (size_t)(r0 + t) * ZW + h * HD + kk;
        float lbv = 0.f; if (l > 0) lbv = sigmoidf_(p.lb_logits[HH * HD + h * HD + kk] - p.lb_logits[h * HD + kk]);
        const float zq = bf2f(zr[0]), zf = bf2f(zr[1024]), zi = bf2f(zr[2048]);
        const float e = __expf(-zf), sg = 1.0f / (1.0f + e);
        fS[tid] = lbv + (1.0f - lbv) * sg; kS[tid] = (1.0f - lbv) * (e * sg); qS[tid] = siluf_(zq); vS[tid] = zi;
    }
    const int v = tid & 127, kq = tid >> 7;
    const float* s0 = p.state_hgrn + ((size_t)(l * DB + b) * HH + h) * HD * HD + (size_t)(32 * kq) * HD + v;
    float S[32];
#pragma unroll
    for (int i = 0; i < 32; ++i) S[i] = s0[(size_t)i * HD];
    __syncthreads();
#pragma unroll
    for (int t = 0; t < 4; ++t) {
        const float vv = vS[t * 128 + v]; float po = 0.f;
#pragma unroll
        for (int i = 0; i < 32; ++i) { const int kk = t * 128 + 32 * kq + i; S[i] = fS[kk] * S[i] + kS[kk] * vv; po += qS[kk] * S[i]; }
        red[(t * 4 + kq) * 128 + v] = po;
    }
    float* so = p.out + OFF_HS + ((size_t)(l * DB + b) * HH + h) * HD * HD + (size_t)(32 * kq) * HD + v;
#pragma unroll
    for (int i = 0; i < 32; ++i) so[(size_t)i * HD] = S[i];
    __syncthreads();
    {
        const int t = tid >> 7; const float o = red[(t * 4 + 0) * 128 + v] + red[(t * 4 + 1) * 128 + v] + red[(t * 4 + 2) * 128 + v] + red[(t * 4 + 3) * 128 + v];
        const float ss = wave_sum(o * o);
        if (lane == 0) part[w] = ss;
        __syncthreads();
        const float tot = part[2 * t] + part[2 * t + 1];
        const float rstd = rsqrtf(tot * (1.0f / HD) + EPS);
        const float zg = bf2f(p.z[(size_t)(r0 + t) * ZW + 3072 + h * HD + v]);
        p.cat[(size_t)(r0 + t) * D + h * HD + v] = (bf16_t)f2bf(o * rstd * p.hgrn_norm_g[l * HD + v] * siluf_(zg));
    }
    __syncthreads();
}

DEV void pool_pre_unit(const Params& p, int l, int unit) {
    const int tid = threadIdx.x, tk = tid >> 7, cg = tid & 127, c = cg * 8, gi = cg >> 5, wnd = 2 << gi;
    const int r = unit * 4 + tk;
    if (r >= NTOK) return;
    f32x2 sum[4] = {{0.f, 0.f}, {0.f, 0.f}, {0.f, 0.f}, {0.f, 0.f}}; float cur[8];
    float cnt;
    if (r < NP) {
        const int t = r % SEQ; const int n = (wnd < t + 1) ? wnd : (t + 1); cnt = (float)n;
        u32x4 q[16];
#pragma unroll
        for (int j = 0; j < 16; ++j) q[j] = (j < n) ? *(const u32x4*)(p.z + (size_t)(r - j) * ZW + 4096 + c) : (u32x4){0u, 0u, 0u, 0u};
#pragma unroll
        for (int j = 0; j < 16; ++j) { sum[0] += (f32x2){lo16(q[j].x), hi16(q[j].x)}; sum[1] += (f32x2){lo16(q[j].y), hi16(q[j].y)}; sum[2] += (f32x2){lo16(q[j].z), hi16(q[j].z)}; sum[3] += (f32x2){lo16(q[j].w), hi16(q[j].w)}; }
        cur[0] = lo16(q[0].x); cur[1] = hi16(q[0].x); cur[2] = lo16(q[0].y); cur[3] = hi16(q[0].y); cur[4] = lo16(q[0].z); cur[5] = hi16(q[0].z); cur[6] = lo16(q[0].w); cur[7] = hi16(q[0].w);
        if (t >= SEQ - PBUF) { float* o = p.out + OFF_PP + ((size_t)(l * PB + r / SEQ) * PBUF + (t - (SEQ - PBUF))) * PW + c;
            *(f32x4*)o = (f32x4){cur[0], cur[1], cur[2], cur[3]}; *(f32x4*)(o + 4) = (f32x4){cur[4], cur[5], cur[6], cur[7]}; }
    } else {
        const int bb = (r - NP) / DSEQ, t = (r - NP) % DSEQ; cnt = (float)wnd;
        const float* sp = p.state_pool + (size_t)(l * DB + bb) * PBUF * PW + c;
        u32x4 q[4]; f32x4 sa[15], sb[15];
#pragma unroll
        for (int j = 0; j < 4; ++j) q[j] = (j <= t && j < wnd) ? *(const u32x4*)(p.z + (size_t)(NP + bb * DSEQ + t - j) * ZW + 4096 + c) : (u32x4){0u, 0u, 0u, 0u};
#pragma unroll
        for (int j = 1; j < 16; ++j) {
            const int back = j - t;
            const bool use = (back >= 1) && (j < wnd);
            const float* srow = sp + (size_t)(PBUF - (use ? back : 1)) * PW;
            sa[j - 1] = use ? *(const f32x4*)srow : (f32x4){0.f, 0.f, 0.f, 0.f}; sb[j - 1] = use ? *(const f32x4*)(srow + 4) : (f32x4){0.f, 0.f, 0.f, 0.f};
        }
#pragma unroll
        for (int j = 0; j < 4; ++j) { sum[0] += (f32x2){lo16(q[j].x), hi16(q[j].x)}; sum[1] += (f32x2){lo16(q[j].y), hi16(q[j].y)}; sum[2] += (f32x2){lo16(q[j].z), hi16(q[j].z)}; sum[3] += (f32x2){lo16(q[j].w), hi16(q[j].w)}; }
#pragma unroll
        for (int j = 0; j < 15; ++j) { sum[0] += (f32x2){sa[j][0], sa[j][1]}; sum[1] += (f32x2){sa[j][2], sa[j][3]}; sum[2] += (f32x2){sb[j][0], sb[j][1]}; sum[3] += (f32x2){sb[j][2], sb[j][3]}; }
        cur[0] = lo16(q[0].x); cur[1] = hi16(q[0].x); cur[2] = lo16(q[0].y); cur[3] = hi16(q[0].y); cur[4] = lo16(q[0].z); cur[5] = hi16(q[0].z); cur[6] = lo16(q[0].w); cur[7] = hi16(q[0].w);
        float* ob = p.out + OFF_PS + (size_t)(l * DB + bb) * PBUF * PW + c;
        { float* o = ob + (size_t)(11 + t) * PW; *(f32x4*)o = (f32x4){cur[0], cur[1], cur[2], cur[3]}; *(f32x4*)(o + 4) = (f32x4){cur[4], cur[5], cur[6], cur[7]}; }
        for (int i = t; i < 11; i += 4) { const float* s2 = sp + (size_t)(4 + i) * PW; float* o = ob + (size_t)i * PW; *(f32x4*)o = *(const f32x4*)s2; *(f32x4*)(o + 4) = *(const f32x4*)(s2 + 4); }
    }
    const float inv = 1.0f / cnt;
    u32x4 w; w.x = pack2(sum[0][0] * inv - cur[0], sum[0][1] * inv - cur[1]); w.y = pack2(sum[1][0] * inv - cur[2], sum[1][1] * inv - cur[3]);
    w.z = pack2(sum[2][0] * inv - cur[4], sum[2][1] * inv - cur[5]); w.w = pack2(sum[3][0] * inv - cur[6], sum[3][1] * inv - cur[7]);
    *(u32x4*)(p.pooled + ((size_t)gi * MPAD + r) * 256 + (c & 255)) = w;
}

#ifndef PROBE_SUB
#define PROBE_SUB 0
#endif
DEV void phase_mix1(const Params& p, int l, unsigned char* lds) {
    for (int rep = 0; rep < (PROBE_SUB == 1 ? 2 : 1); ++rep) for (int u = blockIdx.x; u < hg::NUNIT; u += gridDim.x) hgrn_pre_unit(p, l, u, lds);
    for (int rep = 0; rep < (PROBE_SUB == 2 ? 2 : 1); ++rep) for (int u = blockIdx.x; u < DB * HH; u += gridDim.x) hgrn_sample_unit(p, l, u, lds);
    for (int rep = 0; rep < (PROBE_SUB == 3 ? 2 : 1); ++rep) for (int u = blockIdx.x; u < (NTOK + 3) / 4; u += gridDim.x) pool_pre_unit(p, l, u);
}
DEV void phase_mix2(const Params& p, int l) { for (int u = blockIdx.x; u < PB * HH * 8; u += gridDim.x) hgrn_scan_unit(p, l, u); }
DEV void phase_mix3(const Params& p, int l, unsigned char* lds) { for (int u = blockIdx.x; u < hg::NUNIT; u += gridDim.x) hgrn_post_unit(p, l, u, lds); }

#ifdef HIPEMU
#define MBCNT(mask) __builtin_popcountll((mask) & ((1ull << emu_lane()) - 1ull))
#define POPC64(m) __builtin_popcountll(m)
#else
#define MBCNT(mask) ((int)__builtin_amdgcn_mbcnt_hi((unsigned)((mask) >> 32), __builtin_amdgcn_mbcnt_lo((unsigned)(mask), 0u)))
#define POPC64(m) __popcll(m)
#endif
DEV unsigned fkey(float f) { const unsigned u = __float_as_uint(f); return u ^ ((unsigned)((int)u >> 31) | 0x80000000u); }
DEV unsigned long long lowest_n_bits(unsigned long long m, int n) { unsigned long long r = 0ull; while (n > 0 && m) { const unsigned long long b = m & (~m + 1ull); r |= b; m ^= b; --n; } return r; }
#ifdef HIPEMU
#define DPPU_XOR1(v) __shfl((v), emu_lane() ^ 1)
#define DPPU_XOR2(v) __shfl((v), emu_lane() ^ 2)
#define DPPU_HMIRROR(v) __shfl((v), (emu_lane() & ~7) | (7 - (emu_lane() & 7)))
#else
template <int CTRL> DEV unsigned dpp_u(unsigned v) { return (unsigned)__builtin_amdgcn_update_dpp(0, (int)v, CTRL, 0xf, 0xf, true); }
#define DPPU_XOR1(v) dpp_u<0xB1>(v)
#define DPPU_XOR2(v) dpp_u<0x4E>(v)
#define DPPU_HMIRROR(v) dpp_u<0x141>(v)
#endif
template <int GL> DEV unsigned group_sum(unsigned c) { c += DPPU_XOR1(c); c += DPPU_XOR2(c); if (GL == 8) c += DPPU_HMIRROR(c); return c; }
template <int GL> DEV unsigned group_or(unsigned c) { c |= DPPU_XOR1(c); c |= DPPU_XOR2(c); if (GL == 8) c |= DPPU_HMIRROR(c); return c; }
template <int GL> DEV float group_maxf(float v) { v = fmaxf(v, DPP_XOR1(v)); v = fmaxf(v, DPP_XOR2(v)); if (GL == 8) v = fmaxf(v, DPP_HMIRROR(v)); return v; }
template <int GL> DEV float group_sumf(float v) { v += DPP_XOR1(v); v += DPP_XOR2(v); if (GL == 8) v += DPP_HMIRROR(v); return v; }
DEV unsigned bytesum(unsigned w) { return (w * 0x01010101u) >> 24; }
template <int GL> DEV unsigned group_excl_prefix(unsigned c, int sub) {
    const unsigned sh = 8u * (unsigned)(sub & 3);
    unsigned wlo = (GL == 4 || sub < 4) ? (c << sh) : 0u, whi = (GL == 8 && sub >= 4) ? (c << sh) : 0u;
    wlo = group_or<GL>(wlo);
    unsigned r;
    if (GL == 4) r = bytesum(wlo & ((1u << sh) - 1u));
    else { whi = group_or<GL>(whi); r = sub < 4 ? bytesum(wlo & ((1u << sh) - 1u)) : bytesum(wlo) + bytesum(whi & ((1u << sh) - 1u)); }
    return r;
}
DEV float fkey_inv(unsigned k) { return __uint_as_float((k & 0x80000000u) ? (k ^ 0x80000000u) : ~k); }
template <int GL> DEV unsigned group_top16(const unsigned (&k)[32], bool active, int sub, unsigned& pos0) {
    unsigned L = 0u, R = active ? 0xFFFFFFFFu : 0u, cR = 0u;
    for (;;) {
        if (__ballot(L < R) == 0ull) break;
        const unsigned mid = L + ((R - L) >> 1);
        unsigned c = 0u;
#pragma unroll
        for (int i = 0; i < 32; ++i) c += (k[i] > mid) ? 1u : 0u;
        c = group_sum<GL>(c);
        const bool le = c <= 16u, hit = c == 16u;
        R = le ? mid : R; cR = le ? c : cR; L = hit ? mid : (le ? L : mid + 1u);
    }
    unsigned mask = 0u;
#pragma unroll
    for (int i = 0; i < 32; ++i) mask |= (k[i] > R) ? (1u << i) : 0u;
    const unsigned need = 16u - cR;
    if (__ballot(active && need > 0u) != 0ull) {
        unsigned eqm = 0u;
#pragma unroll
        for (int i = 0; i < 32; ++i) eqm |= (k[i] == R) ? (1u << i) : 0u;
        const unsigned eqc = (unsigned)__builtin_popcount(eqm), before = group_excl_prefix<GL>(eqc, sub);
        unsigned take = need > before ? need - before : 0u; if (take > eqc) take = eqc;
        if (!active) take = 0u;
        while (take > 0u) { const unsigned b = eqm & (~eqm + 1u); mask |= b; eqm ^= b; --take; }
    }
    if (!active) mask = 0u;
    pos0 = group_excl_prefix<GL>((unsigned)__builtin_popcount(mask), sub);
    return mask;
}
constexpr int SEL_NT = 4;
constexpr int SEL_RS = 144;
DEV void select_step(const Params& p, int l, int tt0, int tstride, int ntile, int h, unsigned char* lds, const bf16x8 (&kh)[2][4], const bf16x8 (&kl)[2][4]) {
    const int tid = threadIdx.x, lane = tid & 63, w = tid >> 6, g = lane >> 4, c16 = lane & 15;
    constexpr int NTK = SEL_NT * 16;
    constexpr int QRS = 264;
    bf16_t* qh = (bf16_t*)lds;
    bf16_t* ql = qh + NTK * QRS;
    float* sc = (float*)(ql + NTK * QRS);
    float* ts = sc + 2 * NTK * SEL_RS;
    int* ti = (int*)(ts + 2 * NTK * 16);
#pragma unroll
    for (int k = 0; k < SEL_NT; ++k) {
        const int tk = tid >> 5, part = tid & 31; const int tok = (tt0 + k * tstride) * 16 + tk;
        f32x4 a = (f32x4){0.f, 0.f, 0.f, 0.f}, b2 = a;
        if (k < ntile && tok < NTOK) { const float* q = p.qry + (size_t)tok * D + h * 256 + part * 8; a = *(const f32x4*)q; b2 = *(const f32x4*)(q + 4); }
        float ss = a[0] * a[0] + a[1] * a[1] + a[2] * a[2] + a[3] * a[3] + b2[0] * b2[0] + b2[1] * b2[1] + b2[2] * b2[2] + b2[3] * b2[3];
        ss += __shfl_xor(ss, 1); ss += __shfl_xor(ss, 2); ss += __shfl_xor(ss, 4); ss += __shfl_xor(ss, 8);
        const float rn = rsqrtf(ss * (1.0f / 128.0f) + EPS);
        const float v[8] = {a[0] * rn, a[1] * rn, a[2] * rn, a[3] * rn, b2[0] * rn, b2[1] * rn, b2[2] * rn, b2[3] * rn};
        unsigned hi[4], lo[4];
#pragma unroll
        for (int j = 0; j < 4; ++j) { hi[j] = pack2(v[2 * j], v[2 * j + 1]); lo[j] = pack2(v[2 * j] - lo16(hi[j]), v[2 * j + 1] - hi16(hi[j])); }
        *(u32x4*)(qh + (k * 16 + tk) * QRS + part * 8) = (u32x4){hi[0], hi[1], hi[2], hi[3]}; *(u32x4*)(ql + (k * 16 + tk) * QRS + part * 8) = (u32x4){lo[0], lo[1], lo[2], lo[3]};
    }
    __syncthreads();
    for (int k = 0; k < ntile; ++k) {
#pragma unroll
        for (int ph = 0; ph < 2; ++ph) {
            f32x4 acc = (f32x4){0.f, 0.f, 0.f, 0.f};
#pragma unroll
            for (int ks = 0; ks < 4; ++ks) {
                const bf16x8 ah = *(const bf16x8*)(qh + (k * 16 + c16) * QRS + ph * 128 + 32 * ks + 8 * g), al = *(const bf16x8*)(ql + (k * 16 + c16) * QRS + ph * 128 + 32 * ks + 8 * g);
                acc = MFMA_BF16(al, kh[ph][ks], acc); acc = MFMA_BF16(ah, kl[ph][ks], acc); acc = MFMA_BF16(ah, kh[ph][ks], acc);
            }
            const int kidx = 16 * w + c16;
#pragma unroll
            for (int r = 0; r < 4; ++r) sc[(ph * NTK + k * 16 + 4 * g + r) * SEL_RS + (kidx >> 5) * 36 + (kidx & 31)] = acc[r];
        }
    }
    __syncthreads();
    {
        const int row = tid >> 2, sub = tid & 3; const bool active = ((row % NTK) >> 4) < ntile;
        unsigned k[32];
#pragma unroll
        for (int i4 = 0; i4 < 8; ++i4) { const f32x4 v = *(const f32x4*)(sc + row * SEL_RS + sub * 36 + 4 * i4); k[4 * i4] = fkey(v[0]); k[4 * i4 + 1] = fkey(v[1]); k[4 * i4 + 2] = fkey(v[2]); k[4 * i4 + 3] = fkey(v[3]); }
        unsigned pos; const unsigned mask = group_top16<4>(k, active, sub, pos);
#pragma unroll
        for (int i = 0; i < 32; ++i) if ((mask >> i) & 1u) { if (pos < 16u) { ts[row * 16 + pos] = fkey_inv(k[i]); ti[row * 16 + pos] = 32 * sub + i; } ++pos; }
    }
    __syncthreads();
    {
        const int tk = tid >> 3, sub = tid & 7; const bool active = (tk >> 4) < ntile; const int tok = (tt0 + (tk >> 4) * tstride) * 16 + (tk & 15);
        const float s1a = ts[tk * 16 + 2 * sub], s1b = ts[tk * 16 + 2 * sub + 1];
        unsigned k[32];
#pragma unroll
        for (int j4 = 0; j4 < 4; ++j4) { const f32x4 s2 = *(const f32x4*)(ts + (NTK + tk) * 16 + 4 * j4);
#pragma unroll
            for (int j = 0; j < 4; ++j) { k[4 * j4 + j] = fkey(s1a + s2[j]); k[16 + 4 * j4 + j] = fkey(s1b + s2[j]); } }
        unsigned pos; const unsigned mask = group_top16<8>(k, active, sub, pos);
        float mx = -3.0e38f;
#pragma unroll
        for (int i = 0; i < 32; ++i) if ((mask >> i) & 1u) mx = fmaxf(mx, fkey_inv(k[i]));
        mx = group_maxf<8>(mx);
        float sm = 0.f;
#pragma unroll
        for (int i = 0; i < 32; ++i) if ((mask >> i) & 1u) sm += __expf(fkey_inv(k[i]) - mx);
        sm = group_sumf<8>(sm);
        const float inv = 1.0f / sm;
        const int i1a = ti[tk * 16 + 2 * sub], i1b = ti[tk * 16 + 2 * sub + 1];
        if (active && tok < NTOK) {
#pragma unroll
            for (int i = 0; i < 32; ++i) if ((mask >> i) & 1u) {
                if (pos < 16u) { const int e = (i < 16 ? i1a : i1b) * 128 + ti[(NTK + tk) * 16 + (i & 15)]; const size_t o = (size_t)tok * 128 + h * 16 + pos;
                    p.eidx[o] = e; p.gate[o] = __expf(fkey_inv(k[i]) - mx) * inv * p.sv[l * NE + e]; p.iscu[o] = p.su[l * NE + e]; }
                ++pos; }
        }
    }
    __syncthreads();
}
DEV void phase_select(const Params& p, int l, unsigned char* lds) {
    const int ntt = (NTOK + 15) / 16, lane = threadIdx.x & 63, w = threadIdx.x >> 6, g = lane >> 4, c16 = lane & 15;
    const bool fixed = (gridDim.x % 8u) == 0u;
    const int nq = fixed ? (int)(gridDim.x >> 3) : 1;
    for (int hh = 0; hh < (fixed ? 1 : 8); ++hh) {
        const int h = fixed ? (int)(blockIdx.x & 7) : hh;
        bf16x8 kh[2][4], kl[2][4];
#pragma unroll
        for (int ph = 0; ph < 2; ++ph)
#pragma unroll
            for (int ks = 0; ks < 4; ++ks) { const float* kr = p.peer_keys + ((size_t)((l * 8 + h) * 2 + ph) * 128 + 16 * w + c16) * 128 + 32 * ks + 8 * g;
                const f32x4 a = *(const f32x4*)kr, b2 = *(const f32x4*)(kr + 4); const float v[8] = {a[0], a[1], a[2], a[3], b2[0], b2[1], b2[2], b2[3]};
                u32x4 hi, lo; unsigned hw[4], lw[4];
#pragma unroll
                for (int j = 0; j < 4; ++j) { hw[j] = pack2(v[2 * j], v[2 * j + 1]); lw[j] = pack2(v[2 * j] - lo16(hw[j]), v[2 * j + 1] - hi16(hw[j])); }
                hi = (u32x4){hw[0], hw[1], hw[2], hw[3]}; lo = (u32x4){lw[0], lw[1], lw[2], lw[3]};
                kh[ph][ks] = __builtin_bit_cast(bf16x8, hi); kl[ph][ks] = __builtin_bit_cast(bf16x8, lo); }
        const int first = fixed ? (int)(blockIdx.x >> 3) : (int)blockIdx.x, stride = fixed ? nq : (int)gridDim.x;
        for (int tt0 = first; tt0 < ntt; tt0 += SEL_NT * stride) {
            int ntile = 0;
#pragma unroll
            for (int k = 0; k < SEL_NT; ++k) if (tt0 + k * stride < ntt) ntile = k + 1;
            select_step(p, l, tt0, stride, ntile, h, lds, kh, kl);
        }
    }
}

constexpr int PEER_TB = 272;
struct PeerDeal { int xs_first, xs_step, t_begin, t_end; };
DEV PeerDeal peer_deal() {
    PeerDeal d; const bool sl = (gridDim.x % 8u) == 0u;
    const int nranks = sl ? (int)(gridDim.x >> 3) : (int)gridDim.x, rank = sl ? (int)(blockIdx.x >> 3) : (int)blockIdx.x, tpr = (NTOK + nranks - 1) / nranks;
    d.xs_first = sl ? (int)(blockIdx.x & 7) : 0; d.xs_step = sl ? 8 : 1; d.t_begin = rank * tpr; d.t_end = d.t_begin + tpr < NTOK ? d.t_begin + tpr : NTOK;
    return d;
}
struct PeerTok { u32x4 e0, e1, e2, e3, ha, hb; };
DEV void peer_fetch_u(const Params& p, int t, int c0, int g8, PeerTok& k) {
    const u32x4* ep = (const u32x4*)(p.eidx + (size_t)t * 128 + 16 * g8); k.e0 = ep[0]; k.e1 = ep[1]; k.e2 = ep[2]; k.e3 = ep[3];
    k.ha = *(const u32x4*)(p.hB + (size_t)t * D + c0); k.hb = *(const u32x4*)(p.hB + (size_t)t * D + c0 + 8);
}
DEV void phase_peer_u(const Params& p, int l, unsigned char* lds) {
    const int lane = threadIdx.x & 63, w = threadIdx.x >> 6, j8 = lane & 7, g8 = lane >> 3;
    const bool b2 = (j8 & 4) != 0, b1 = (j8 & 2) != 0, b0 = (j8 & 1) != 0;
    const PeerDeal dl = peer_deal();
    const unsigned char* U = p.u8 + (size_t)l * NE * D;
    float* lp = (float*)lds;
    for (int xs = dl.xs_first; xs < 8; xs += dl.xs_step)
    for (int t0 = dl.t_begin; t0 < dl.t_end; t0 += PEER_TB) {
        const int nb = dl.t_end - t0 < PEER_TB ? dl.t_end - t0 : PEER_TB;
        for (int ch = 0; ch < 2; ++ch) {
            const int c0 = 256 * xs + 128 * ch + 16 * j8;
            const unsigned char* Us = U + (size_t)(2 * xs + ch) * NE * 128 + 16 * j8;
            PeerTok nx; if (w < nb) peer_fetch_u(p, t0 + w, c0, g8, nx);
            for (int tk = w; tk < nb; tk += 8) {
                const int t = t0 + tk;
                const PeerTok cu = nx;
                const unsigned ev[16] = {cu.e0.x, cu.e0.y, cu.e0.z, cu.e0.w, cu.e1.x, cu.e1.y, cu.e1.z, cu.e1.w, cu.e2.x, cu.e2.y, cu.e2.z, cu.e2.w, cu.e3.x, cu.e3.y, cu.e3.z, cu.e3.w};
                u32x4 q[16];
#pragma unroll
                for (int i = 0; i < 16; ++i) q[i] = *(const u32x4*)(Us + (size_t)ev[i] * 128);
                if (tk + 8 < nb) peer_fetch_u(p, t + 8, c0, g8, nx);
                const u32x4 ha = cu.ha, hb = cu.hb;
                const f32x2 hf[8] = {{lo16(ha.x), hi16(ha.x)}, {lo16(ha.y), hi16(ha.y)}, {lo16(ha.z), hi16(ha.z)}, {lo16(ha.w), hi16(ha.w)}, {lo16(hb.x), hi16(hb.x)}, {lo16(hb.y), hi16(hb.y)}, {lo16(hb.z), hi16(hb.z)}, {lo16(hb.w), hi16(hb.w)}};
                float ps[16];
#pragma unroll
                for (int i = 0; i < 16; ++i) { f32x2 dq[8]; fp8x16_dec2(q[i], dq); f32x2 a = dq[0] * hf[0];
#pragma unroll
                    for (int k = 1; k < 8; ++k) a = __builtin_elementwise_fma(dq[k], hf[k], a);
                    ps[i] = a[0] + a[1]; }
                float q8[8], q4[4], q2[2];
#pragma unroll
                for (int k = 0; k < 8; ++k) { const float keep = b2 ? ps[8 + k] : ps[k], send = b2 ? ps[k] : ps[8 + k]; q8[k] = keep + DPP_HMIRROR(send); }
#pragma unroll
                for (int k = 0; k < 4; ++k) { const float keep = b1 ? q8[4 + k] : q8[k], send = b1 ? q8[k] : q8[4 + k]; q4[k] = keep + DPP_XOR2(send); }
#pragma unroll
                for (int k = 0; k < 2; ++k) { const float keep = b0 ? q4[2 + k] : q4[k], send = b0 ? q4[k] : q4[2 + k]; q2[k] = keep + DPP_XOR1(send); }
                float* lrow = lp + tk * 128 + 16 * g8 + 2 * j8;
                if (ch == 0) { lrow[0] = q2[0]; lrow[1] = q2[1]; }
                else { const size_t o = (size_t)t * 128 + 16 * g8 + 2 * j8;
                    float* dst = p.part + ((size_t)t * 8 + xs) * 128 + 16 * g8 + 2 * j8;
                    dst[0] = (q2[0] + lrow[0]) * p.iscu[o]; dst[1] = (q2[1] + lrow[1]) * p.iscu[o + 1]; }
            }
        }
    }
}
DEV void phase_peer_c(const Params& p) {
    const size_t n = (size_t)NTOK * 128, gs = (size_t)gridDim.x * 512;
    for (size_t i = (size_t)blockIdx.x * 512 + threadIdx.x; i < n; i += gs) {
        const size_t t = i >> 7; const int pr = (int)(i & 127); float sacc = 0.f;
#pragma unroll
        for (int x = 0; x < 8; ++x) sacc += p.part[(t * 8 + x) * 128 + pr];
        p.gate[i] = gelu_erf(sacc) * p.gate[i];
    }
}
struct PeerTokV { u32x4 e0, e1, e2, e3; f32x4 a0, a1, a2, a3; f32x2 x1, g2; };
DEV void peer_fetch_v(const Params& p, int l, int t, int col, int g8, PeerTokV& k) {
    const u32x4* ep = (const u32x4*)(p.eidx + (size_t)t * 128 + 16 * g8); k.e0 = ep[0]; k.e1 = ep[1]; k.e2 = ep[2]; k.e3 = ep[3];
    const f32x4* ap = (const f32x4*)(p.gate + (size_t)t * 128 + 16 * g8); k.a0 = ap[0]; k.a1 = ap[1]; k.a2 = ap[2]; k.a3 = ap[3];
    k.x1 = *(const f32x2*)(p.xa + (size_t)t * D + col); k.g2 = *(const f32x2*)(p.modbuf + (size_t)tok_batch(t) * MODW + l * NMOD + 5 * D + col);
}
DEV void phase_peer_v(const Params& p, int l, unsigned char* lds) {
    const int lane = threadIdx.x & 63, w = threadIdx.x >> 6, j8 = lane & 7, g8 = lane >> 3;
    const bool b3 = (g8 & 1) != 0, b4 = (g8 & 2) != 0, b5 = (g8 & 4) != 0;
    const PeerDeal dl = peer_deal();
    const unsigned char* V = p.v8 + (size_t)l * NE * D;
    for (int xs = dl.xs_first; xs < 8; xs += dl.xs_step)
        for (int ch = 0; ch < 2; ++ch) {
            const int c0 = 256 * xs + 128 * ch + 16 * j8, col = c0 + (b3 ? 8 : 0) + (b4 ? 4 : 0) + (b5 ? 2 : 0);
            const unsigned char* Vs = V + (size_t)(2 * xs + ch) * NE * 128 + 16 * j8;
            PeerTokV nx; if (dl.t_begin + w < dl.t_end) peer_fetch_v(p, l, dl.t_begin + w, col, g8, nx);
            for (int t = dl.t_begin + w; t < dl.t_end; t += 8) {
                const PeerTokV cu = nx;
                const unsigned ev[16] = {cu.e0.x, cu.e0.y, cu.e0.z, cu.e0.w, cu.e1.x, cu.e1.y, cu.e1.z, cu.e1.w, cu.e2.x, cu.e2.y, cu.e2.z, cu.e2.w, cu.e3.x, cu.e3.y, cu.e3.z, cu.e3.w};
                u32x4 q[16];
#pragma unroll
                for (int i = 0; i < 16; ++i) q[i] = *(const u32x4*)(Vs + (size_t)ev[i] * 128);
                if (t + 8 < dl.t_end) peer_fetch_v(p, l, t + 8, col, g8, nx);
                const float av[16] = {cu.a0[0], cu.a0[1], cu.a0[2], cu.a0[3], cu.a1[0], cu.a1[1], cu.a1[2], cu.a1[3], cu.a2[0], cu.a2[1], cu.a2[2], cu.a2[3], cu.a3[0], cu.a3[1], cu.a3[2], cu.a3[3]};
                f32x2 acc2[8];
#pragma unroll
                for (int k = 0; k < 8; ++k) acc2[k] = (f32x2){0.f, 0.f};
#pragma unroll
                for (int i = 0; i < 16; ++i) { f32x2 dq[8]; fp8x16_dec2(q[i], dq); const f32x2 a2v = (f32x2){av[i], av[i]};
#pragma unroll
                    for (int k = 0; k < 8; ++k) acc2[k] = __builtin_elementwise_fma(a2v, dq[k], acc2[k]); }
                float acc[16];
#pragma unroll
                for (int k = 0; k < 8; ++k) { acc[2 * k] = acc2[k][0]; acc[2 * k + 1] = acc2[k][1]; }
                float q8[8], q4[4], q2[2];
#pragma unroll
                for (int k = 0; k < 8; ++k) { const float keep = b3 ? acc[8 + k] : acc[k], send = b3 ? acc[k] : acc[8 + k]; q8[k] = keep + DPP_XOR8(send); }
#pragma unroll
                for (int k = 0; k < 4; ++k) { const float keep = b4 ? q8[4 + k] : q8[k], send = b4 ? q8[k] : q8[4 + k]; q4[k] = keep + __shfl_xor(send, 16); }
#pragma unroll
                for (int k = 0; k < 2; ++k) { const float keep = b5 ? q4[2 + k] : q4[k], send = b5 ? q4[k] : q4[2 + k]; q2[k] = keep + __shfl_xor(send, 32); }
                f32x2 o; o[0] = cu.x1[0] + cu.g2[0] * q2[0]; o[1] = cu.x1[1] + cu.g2[1] * q2[1];
                *(f32x2*)(p.xb + (size_t)t * D + col) = o;
            }
        }
}

constexpr int N_PHASES = 29;
DEV int phase_class(int k) { return k < 2 ? k : (k == 28 ? 15 : 2 + (k - 2) % 13); }
#ifndef HIPEMU
#define XB_TMO      128
#define XB_XCNT(j)  (256  + 64 * (j))
#define XB_XSUB(j)  (1280 + 64 * (j))
#define XB_XGEN(j)  (2304 + 64 * (j))
#define XB_TOP      3328
#define XB_TOPGEN   3392
#define XCD_BAR_WORDS 3456
#define XB_SPIN_CAP (1u << 22)
__device__ __forceinline__ unsigned xb_ld(unsigned* p)              { return __hip_atomic_load(p, __ATOMIC_RELAXED, __HIP_MEMORY_SCOPE_AGENT); }
__device__ __forceinline__ unsigned xb_add(unsigned* p, unsigned v) { return __hip_atomic_fetch_add(p, v, __ATOMIC_RELAXED, __HIP_MEMORY_SCOPE_AGENT); }
__device__ __forceinline__ unsigned xb_xcc_id() { return (unsigned)__builtin_amdgcn_s_getreg((3 << 11) | 20) & 0xFu; }
#define XB_SPIN(cond, bar) do { unsigned _sp = 0; while (cond) { __builtin_amdgcn_s_sleep(1); \
    if ((++_sp & 255u) == 0u) { if (xb_ld(&(bar)[XB_TMO])) break; if (_sp > XB_SPIN_CAP) { atomicAdd(&(bar)[XB_TMO], 1u); break; } } } } while (0)
struct XcdBarrier { unsigned* bar; unsigned x; volatile LAS unsigned* st; };
__device__ __forceinline__ XcdBarrier xcd_barrier_post(unsigned* bar, volatile LAS unsigned* st) {
    XcdBarrier b; b.bar = bar; b.x = xb_xcc_id(); b.st = st;
    if (threadIdx.x == 0) (void)xb_add(&bar[XB_XCNT(b.x)], 1u);
    return b;
}
__device__ __forceinline__ void xcd_barrier_complete(unsigned* bar, unsigned x, unsigned& nloc, unsigned& nx) {
    const unsigned G = gridDim.x * gridDim.y * gridDim.z;
    unsigned sum, cnt, mine, sp = 0u;
    for (;;) {
        sum = 0u; cnt = 0u; mine = 0u;
#pragma unroll
        for (unsigned j = 0; j < 16; ++j) { const unsigned c = xb_ld(&bar[XB_XCNT(j)]); sum += c; cnt += (c > 0u) ? 1u : 0u; mine = (j == x) ? c : mine; }
        if (sum == G) break;
        __builtin_amdgcn_s_sleep(1);
        if ((++sp & 255u) == 0u) { if (xb_ld(&bar[XB_TMO])) break; if (sp > XB_SPIN_CAP) { atomicAdd(&bar[XB_TMO], 1u); break; } }
    }
    nloc = mine > 0u ? mine : 1u; nx = cnt > 0u ? cnt : 1u;
}
__device__ __forceinline__ void xcd_barrier(const XcdBarrier& b) {
    asm volatile("s_waitcnt vmcnt(0)" ::: "memory");
    __syncthreads();
    if (threadIdx.x == 0) {
        unsigned* bar = b.bar;
        __builtin_amdgcn_s_waitcnt(0);
        unsigned nloc = b.st[0], nx = b.st[1];
        if (nloc == 0u) { xcd_barrier_complete(bar, b.x, nloc, nx); b.st[0] = nloc; b.st[1] = nx; }
        const unsigned old = xb_add(&bar[XB_XSUB(b.x)], 1u);
        const unsigned gen = old / nloc;
        if (old + 1u == (gen + 1u) * nloc) {
            __builtin_amdgcn_fence(__ATOMIC_RELEASE, "agent");
            asm volatile("s_waitcnt vmcnt(0)" ::: "memory");
            const unsigned og = xb_add(&bar[XB_TOP], 1u);
            const unsigned tg = og / nx;
            if (og + 1u == (tg + 1u) * nx) xb_add(&bar[XB_TOPGEN], 1u);
            else XB_SPIN(xb_ld(&bar[XB_TOPGEN]) == tg, bar);
            __builtin_amdgcn_fence(__ATOMIC_ACQUIRE, "agent");
            xb_add(&bar[XB_XGEN(b.x)], 1u);
            asm volatile("s_waitcnt vmcnt(0)" ::: "memory");
        } else {
            XB_SPIN(xb_ld(&bar[XB_XGEN(b.x)]) == gen, bar);
            __builtin_amdgcn_fence(__ATOMIC_ACQUIRE, "agent");
            asm volatile("s_waitcnt vmcnt(0)" ::: "memory");
        }
    }
    __syncthreads();
}
#endif

constexpr int LDS_BYTES = 163840;
constexpr int LDS_BARW = LDS_BYTES - 16;

#ifndef PH_MASK
#define PH_MASK 0xFFFFFFFFu
#endif
#ifndef PROBE_DUP
#define PROBE_DUP 0u
#endif
#define DUP_N(k) (1 + (int)((PROBE_DUP >> phase_class(k)) & 1u))
#define PH_BIT(k) ((PH_MASK >> phase_class(k)) & 1u)
#ifdef HIPEMU
static void run_phase(const Params& pp, int ph, unsigned char* lds)
#define GRID_BAR() do {} while (0)
#define IN(k) (ph == (k))
#define GLDS lds
#define LOADP() const Params& p = pp
#else
typedef const __attribute__((address_space(4))) unsigned char* kargp_t;
__device__ __forceinline__ kargp_t karg_ptr() { kargp_t kp = (kargp_t)__builtin_amdgcn_kernarg_segment_ptr(); asm volatile("" : "+s"(kp)); return kp; }
#define LOADP() Params p; __builtin_memcpy(&p, karg_ptr(), sizeof(Params))
#define IN(k) (PH_BIT(k) && ph_lo <= (k) && (k) < ph_hi)
#define GLDS ((LAS unsigned char*)lds_raw)
__global__ void __launch_bounds__(512, 2) mega_fwd(Params p_unused)
#endif
{
#ifndef HIPEMU
    extern __shared__ __attribute__((aligned(16))) unsigned char lds_raw[];
    unsigned char* lds = lds_raw;
    if (threadIdx.x == 0) { *(volatile unsigned*)(lds_raw + LDS_BARW) = 0u; *(volatile unsigned*)(lds_raw + LDS_BARW + 4) = 0u; }
    __syncthreads();
    int ph_lo, ph_hi; XcdBarrier bar;
    { LOADP(); ph_lo = p.ph_lo; ph_hi = p.ph_hi; bar.bar = p.bar; bar.x = 0; bar.st = nullptr; }
    const bool multi = (ph_hi - ph_lo) > 1;
    if (multi) bar = xcd_barrier_post(bar.bar, (volatile LAS unsigned*)(lds_raw + LDS_BARW));
#define GRID_BAR() do { if (multi) xcd_barrier(bar); } while (0)
#endif
    if (IN(0)) { for (int rep = 0; rep < DUP_N(0); ++rep) { LOADP(); phase_convert(p, lds); GRID_BAR(); } }
    if (IN(1)) {
        LOADP();
        pg8::Gemm g{p.csil, p.wt_ada, 256, MODW, D}; pg8::StaticOrder S; S.init(256, MODW, gridDim.x, blockIdx.x);
        pg8::EpiAda E{p.modbuf, p.b_ada, p.b_ada_final};
        pg8::gemm_phase<pg8::EpiAda, pg8::StaticOrder>(GLDS, g, S, E);
        GRID_BAR();
    }
#define LAYER(l) do { \
        constexpr int base = 2 + 13 * (l); \
        if (IN(base + 0)) { for (int rep = 0; rep < DUP_N(base + 0); ++rep) { LOADP(); phase_norm(p, (l) == 0 ? p.x_prompt : p.xb, (l) == 0 ? p.x_sample : p.xb + (size_t)NP * D, p.norm1_g + (l) * D, (l) * NMOD + 0 * D, (l) * NMOD + 1 * D, p.hA, nullptr); GRID_BAR(); } } \
        if (IN(base + 1)) { for (int rep = 0; rep < DUP_N(base + 1); ++rep) { LOADP(); \
            pg8::Gemm g{p.hA, p.wt_in + (size_t)(l) * ZW * D, MPAD, ZW, D}; pg8::StaticOrder S; S.init(MPAD, ZW, gridDim.x, blockIdx.x); \
            pg8::EpiBf16 E{p.z, ZW}; \
            pg8::gemm_phase<pg8::EpiBf16, pg8::StaticOrder>(GLDS, g, S, E); \
            GRID_BAR(); } } \
        if (IN(base + 2)) { for (int rep = 0; rep < DUP_N(base + 2); ++rep) { LOADP(); phase_mix1(p, (l), lds); GRID_BAR(); } } \
        if (IN(base + 3)) { for (int rep = 0; rep < DUP_N(base + 3); ++rep) { LOADP(); phase_mix2(p, (l)); GRID_BAR(); } } \
        if (IN(base + 4)) { for (int rep = 0; rep < DUP_N(base + 4); ++rep) { LOADP(); phase_mix3(p, (l), lds); GRID_BAR(); } } \
        if (IN(base + 5)) { for (int rep = 0; rep < DUP_N(base + 5); ++rep) { LOADP(); \
            pg8::Gemm g{p.pooled, p.wt_pool + (size_t)(l) * 1024 * 256, 4 * MPAD, 1024, 256}; pg8::PoolOrder S{(int)gridDim.x, (int)blockIdx.x}; \
            pg8::EpiPool E{p.cat, p.pool_b + (l) * PW, p.pool_scale + (l) * PW}; \
            pg8::gemm_phase<pg8::EpiPool, pg8::PoolOrder>(GLDS, g, S, E); \
            GRID_BAR(); } } \
        if (IN(base + 6)) { for (int rep = 0; rep < DUP_N(base + 6); ++rep) { LOADP(); \
            pg8::Gemm g{p.cat, p.wt_out + (size_t)(l) * D * D, MBIG, D, D}; pg8::StaticOrder S; S.init(MBIG, D, gridDim.x, blockIdx.x); \
            pg8::EpiResid E{(l) == 0 ? p.x_prompt : p.xb, (l) == 0 ? p.x_sample : p.xb + (size_t)NP * D, p.modbuf + (l) * NMOD + 2 * D, p.xa}; \
            pg8::gemm_phase<pg8::EpiResid, pg8::StaticOrder>(GLDS, g, S, E); \
            { SmallResid sf{E.xlo, E.xhi, E.gmod, E.out}; small_gemm(p.cat, p.wt_out + (size_t)(l) * D * D, D, lds, sf); } \
            GRID_BAR(); } } \
        if (IN(base + 7)) { for (int rep = 0; rep < DUP_N(base + 7); ++rep) { LOADP(); phase_norm(p, p.xa, p.xa + (size_t)NP * D, p.norm2_g + (l) * D, (l) * NMOD + 3 * D, (l) * NMOD + 4 * D, p.hB, nullptr); GRID_BAR(); } } \
        if (IN(base + 8)) { for (int rep = 0; rep < DUP_N(base + 8); ++rep) { LOADP(); \
            pg8::Gemm g{p.hB, p.wt_q + (size_t)(l) * D * D, MBIG, D, D}; pg8::StaticOrder S; S.init(MBIG, D, gridDim.x, blockIdx.x); \
            pg8::EpiF32 E{p.qry, D}; \
            pg8::gemm_phase<pg8::EpiF32, pg8::StaticOrder>(GLDS, g, S, E); \
            { SmallF32 sf{p.qry}; small_gemm(p.hB, p.wt_q + (size_t)(l) * D * D, D, lds, sf); } \
            GRID_BAR(); } } \
        if (IN(base + 9)) { for (int rep = 0; rep < DUP_N(base + 9); ++rep) { LOADP(); phase_select(p, (l), lds); GRID_BAR(); } } \
        if (IN(base + 10)) { for (int rep = 0; rep < DUP_N(base + 10); ++rep) { LOADP(); phase_peer_u(p, (l), lds); GRID_BAR(); } } \
        if (IN(base + 11)) { LOADP(); phase_peer_c(p); GRID_BAR(); } \
        if (IN(base + 12)) { for (int rep = 0; rep < DUP_N(base + 12); ++rep) { LOADP(); phase_peer_v(p, (l), lds); GRID_BAR(); } } \
    } while (0)
    LAYER(0);
    LAYER(1);
    if (IN(28)) { LOADP(); phase_norm(p, p.xb, p.xb + (size_t)NP * D, p.final_g, 2 * NMOD, 2 * NMOD + D, nullptr, p.out + OFF_Y); }
#undef LAYER
#undef IN
#undef GRID_BAR
#undef GLDS
#undef LOADP
}

struct WsLayout { size_t bar, modbuf, csil, wt_ada, wt_in, wt_out, wt_q, wt_pool, u8, v8, su, sv, iscu, part, hg_oin, hg_ds, hg_gam, hg_qh, hg_sc, hA, hB, z, pooled, cat, xa, xb, qry, eidx, gate, end; };
static WsLayout ws_layout() {
    WsLayout L; size_t o = 0;
    auto take = [&](size_t bytes) { const size_t r = o; o += (bytes + 255) & ~(size_t)255; return r; };
    L.bar = take(16384);
    L.modbuf = take((size_t)256 * MODW * 4);
    L.csil = take((size_t)256 * D * 2);
    L.wt_ada = take((size_t)MODW * D * 2);
    L.wt_in = take((size_t)2 * ZW * D * 2);
    L.wt_out = take((size_t)2 * D * D * 2);
    L.wt_q = take((size_t)2 * D * D * 2);
    L.wt_pool = take((size_t)2 * 1024 * 256 * 2);
    L.u8 = take((size_t)2 * NE * D);
    L.v8 = take((size_t)2 * NE * D);
    L.su = take((size_t)2 * NE * 4);
    L.sv = take((size_t)2 * NE * 4);
    L.iscu = take((size_t)MPAD * 128 * 4);
    L.part = take((size_t)MPAD * 8 * 128 * 4);
    L.hg_oin = take((size_t)hg::NUNIT * 64 * 128 * 4);
    L.hg_ds = take((size_t)hg::NUNIT * 128 * 128 * 4);
    L.hg_gam = take((size_t)hg::NUNIT * 128 * 4);
    L.hg_qh = take((size_t)NP * 1024 * 2);
    L.hg_sc = take((size_t)hg::NUNIT * 128 * 128 * 2);
    L.hA = take((size_t)MPAD * D * 2);
    L.hB = take((size_t)MPAD * D * 2);
    L.z = take((size_t)MPAD * ZW * 2);
    L.pooled = take((size_t)4 * MPAD * 256 * 2);
    L.cat = take((size_t)MPAD * D * 2);
    L.xa = take((size_t)MPAD * D * 4);
    L.xb = take((size_t)MPAD * D * 4);
    L.qry = take((size_t)MPAD * D * 4);
    L.eidx = take((size_t)MPAD * 128 * 4);
    L.gate = take((size_t)MPAD * 128 * 4);
    L.end = o;
    return L;
}
static void fill_params(Params& p, void* const* d_in, void* d_out, void* d_ws) {
    const float** f = (const float**)&p;
    for (int i = 0; i < 24; ++i) f[i] = (const float*)d_in[i];
    p.out = (float*)d_out;
    const WsLayout L = ws_layout(); unsigned char* w = (unsigned char*)d_ws;
    p.bar = (unsigned*)(w + L.bar); p.modbuf = (float*)(w + L.modbuf); p.csil = (bf16_t*)(w + L.csil); p.wt_ada = (bf16_t*)(w + L.wt_ada); p.wt_in = (bf16_t*)(w + L.wt_in);
    p.wt_out = (bf16_t*)(w + L.wt_out); p.wt_q = (bf16_t*)(w + L.wt_q); p.wt_pool = (bf16_t*)(w + L.wt_pool); p.u8 = w + L.u8; p.v8 = w + L.v8; p.su = (float*)(w + L.su); p.sv = (float*)(w + L.sv); p.iscu = (float*)(w + L.iscu); p.part = (float*)(w + L.part); p.hg_oin = (float*)(w + L.hg_oin); p.hg_ds = (float*)(w + L.hg_ds); p.hg_gam = (float*)(w + L.hg_gam); p.hg_qh = (bf16_t*)(w + L.hg_qh); p.hg_sc = (bf16_t*)(w + L.hg_sc);
    p.hA = (bf16_t*)(w + L.hA); p.hB = (bf16_t*)(w + L.hB); p.z = (bf16_t*)(w + L.z); p.pooled = (bf16_t*)(w + L.pooled); p.cat = (bf16_t*)(w + L.cat);
    p.xa = (float*)(w + L.xa); p.xb = (float*)(w + L.xb); p.qry = (float*)(w + L.qry); p.eidx = (int*)(w + L.eidx); p.gate = (float*)(w + L.gate);
}

#ifndef HIPEMU
#ifndef MK_ONE_LAUNCH
#define MK_ONE_LAUNCH 1
#endif
extern "C" void kernel_launch(void* const* d_in, const int* in_sizes, int n_in, void* d_out, int out_size, void* d_ws, size_t ws_size, hipStream_t stream) {
    static int grid = 0;
    if (grid == 0) {
        const WsLayout L = ws_layout();
        if (n_in != 24 || (size_t)out_size != OUT_TOTAL || ws_size < L.end) { fprintf(stderr, "kernel_launch: unexpected shapes (n_in %d, out %d, ws %zu < %zu)\n", n_in, out_size, ws_size, L.end); grid = -1; return; }
        int dev = 0, cus = 0, per_cu = 0;
        hipGetDevice(&dev); hipDeviceGetAttribute(&cus, hipDeviceAttributeMultiprocessorCount, dev);
        if (hipFuncSetAttribute((const void*)mega_fwd, hipFuncAttributeMaxDynamicSharedMemorySize, LDS_BYTES) != hipSuccess) { fprintf(stderr, "kernel_launch: hipFuncSetAttribute failed\n"); grid = -1; return; }
        hipOccupancyMaxActiveBlocksPerMultiprocessor(&per_cu, (const void*)mega_fwd, 512, LDS_BYTES);
        (void)hipGetLastError();
        if (per_cu < 1) fprintf(stderr, "kernel_launch: occupancy query says %d blocks per CU\n", per_cu);
        grid = cus;
    }
    if (grid < 0) return;
    Params p{};
    fill_params(p, d_in, d_out, d_ws);
    hipMemsetAsync(p.bar, 0, 16384, stream);
#if MK_ONE_LAUNCH
    p.ph_lo = 0; p.ph_hi = N_PHASES;
    hipLaunchKernelGGL(mega_fwd, dim3(grid), dim3(512), LDS_BYTES, stream, p);
#else
    for (int ph = 0; ph < N_PHASES; ++ph) { p.ph_lo = ph; p.ph_hi = ph + 1; hipLaunchKernelGGL(mega_fwd, dim3(grid), dim3(512), LDS_BYTES, stream, p); }
#endif
}
#endif
```

```cpp
#ifndef HIPEMU
#include <hip/hip_runtime.h>
#include <cstdio>
#endif
#include <stdint.h>

#ifndef CFG_PB
#define CFG_PB 4
#define CFG_SEQ 2048
#define CFG_DB 128
#endif

#ifdef HIPEMU
#define DEV inline
#define LAS
#define READLANE_I(v, l) emu_readlane((v), (l))
#define READLANE_F(v, l) emu_readlane_f((v), (l))
#define MFMA_BF16(a, b, c) emu_mfma_bf16_16x16x32((a), (b), (c))
#define MFMA_F32(a, b, c) emu_mfma_f32_16x16x4((a), (b), (c))
#define __expf expf
#define __logf logf
#else
#define DEV __device__ __forceinline__
#define LAS __attribute__((address_space(3)))
#define READLANE_I(v, l) __builtin_amdgcn_readlane((v), (l))
#define READLANE_F(v, l) __uint_as_float((unsigned)__builtin_amdgcn_readlane((int)__float_as_uint(v), (l)))
#define MFMA_BF16(a, b, c) __builtin_amdgcn_mfma_f32_16x16x32_bf16((a), (b), (c), 0, 0, 0)
#define MFMA_F32(a, b, c) __builtin_amdgcn_mfma_f32_16x16x4f32((a), (b), (c), 0, 0, 0)
#endif

typedef unsigned short bf16_t;
typedef short bf16x8 __attribute__((ext_vector_type(8)));
typedef float f32x4 __attribute__((ext_vector_type(4)));
typedef unsigned u32x4 __attribute__((ext_vector_type(4)));
typedef unsigned u32x2 __attribute__((ext_vector_type(2)));

namespace cfg {
constexpr int D = 2048, PB = CFG_PB, SEQ = CFG_SEQ, DB = CFG_DB, DSEQ = 4;
constexpr int NP = PB * SEQ, NS = DB * DSEQ, NTOK = NP + NS, MPAD = (NTOK + 255) / 256 * 256;
constexpr int NC = PB + DB;
constexpr int HH = 8, HD = 128, PW = 1024, PBUF = 15, ZW = 5120;
constexpr int NE = 16384;
constexpr int NMOD = 6 * D;
constexpr int MODW = 2 * NMOD + 2 * D;
constexpr float EPS = 1e-6f;
constexpr int NCHAIN = PB * HH;
constexpr size_t OFF_Y = 0;
constexpr size_t OFF_HP = (size_t)NTOK * D;
constexpr size_t OFF_PP = OFF_HP + (size_t)2 * PB * HH * HD * HD;
constexpr size_t OFF_HS = OFF_PP + (size_t)2 * PB * PBUF * PW;
constexpr size_t OFF_PS = OFF_HS + (size_t)2 * DB * HH * HD * HD;
constexpr size_t OUT_TOTAL = OFF_PS + (size_t)2 * DB * PBUF * PW;
}
using namespace cfg;

struct Params {
    const float *x_prompt, *x_sample, *c_prompt, *c_sample, *state_hgrn, *state_pool, *w_ada, *b_ada, *norm1_g, *norm2_g, *w_in, *w_out,
        *lb_logits, *hgrn_norm_g, *pool_w, *pool_b, *pool_scale, *peer_wq, *peer_keys, *peer_u, *peer_v, *final_g, *w_ada_final, *b_ada_final;
    float* out;
    unsigned* bar; float* modbuf; bf16_t* csil; bf16_t* wt_ada; bf16_t* wt_in; bf16_t* wt_out; bf16_t* wt_q; bf16_t* wt_pool;
    unsigned char* u8; unsigned char* v8; float* su; float* sv; float* iscu; float* part; float* hg_oin; float* hg_ds; float* hg_gam; bf16_t* hg_qh; bf16_t* hg_sc; bf16_t* hA; bf16_t* hB; bf16_t* z; bf16_t* pooled; bf16_t* cat; float* xa; float* xb; float* qry; unsigned short* eidx; float* gate; bf16_t* ab16;
    int ph_lo, ph_hi;
};

DEV float bf2f(unsigned v) { return __uint_as_float(v << 16); }
#ifdef HIPEMU
DEV unsigned f2bf(float f) { unsigned u = __float_as_uint(f); u += 0x7fffu + ((u >> 16) & 1u); return u >> 16; }
DEV unsigned pack2(float lo, float hi) { return f2bf(lo) | (f2bf(hi) << 16); }
#else
typedef float f32x2_t __attribute__((ext_vector_type(2)));
typedef __bf16 bf16x2_t __attribute__((ext_vector_type(2)));
DEV unsigned pack2(float lo, float hi) { const f32x2_t v = {lo, hi}; return __builtin_bit_cast(unsigned, __builtin_convertvector(v, bf16x2_t)); }
DEV unsigned f2bf(float f) { return (unsigned)__builtin_bit_cast(unsigned short, (__bf16)f); }
#endif
DEV float lo16(unsigned w) { return __uint_as_float(w << 16); }
DEV float hi16(unsigned w) { return __uint_as_float(w & 0xffff0000u); }
DEV float wave_sum(float v) { v += __shfl_xor(v, 32); v += __shfl_xor(v, 16); v += __shfl_xor(v, 8); v += __shfl_xor(v, 4); v += __shfl_xor(v, 2); v += __shfl_xor(v, 1); return v; }
DEV float wave_max(float v) { v = fmaxf(v, __shfl_xor(v, 32)); v = fmaxf(v, __shfl_xor(v, 16)); v = fmaxf(v, __shfl_xor(v, 8)); v = fmaxf(v, __shfl_xor(v, 4)); v = fmaxf(v, __shfl_xor(v, 2)); v = fmaxf(v, __shfl_xor(v, 1)); return v; }
DEV float sigmoidf_(float x) { return 1.0f / (1.0f + __expf(-x)); }
DEV float siluf_(float x) { return x / (1.0f + __expf(-x)); }
DEV float gelu_erf(float x) { return 0.5f * x * (1.0f + erff(x * 0.70710678118f)); }
DEV int tok_batch(int t) { return t < NP ? t / SEQ : PB + (t - NP) / DSEQ; }


#ifdef HIPEMU
static inline unsigned emu_fp8_enc1(float x) {
    const unsigned sgn = x < 0.f ? 0x80u : 0u; float a = fabsf(x);
    if (!(a == a)) return 0x7fu;
    if (a >= 448.f) return sgn | 0x7eu;
    if (a < 0.015625f) { const int q = (int)rintf(a * 512.f); return sgn | (unsigned)q; }
    int e = (int)floorf(log2f(a)); if (ldexpf(1.f, e) > a) --e; if (ldexpf(1.f, e + 1) <= a) ++e;
    int m = (int)rintf((a / ldexpf(1.f, e) - 1.f) * 8.f); if (m == 8) { m = 0; ++e; }
    if (e > 8) return sgn | 0x7eu;
    return sgn | (unsigned)((e + 7) << 3) | (unsigned)m;
}
static inline float emu_fp8_dec1(unsigned b) { const float sg = (b & 0x80u) ? -1.f : 1.f; const int e = (b >> 3) & 15, m = b & 7; return sg * (e == 0 ? m * 0.001953125f : (1.f + m * 0.125f) * ldexpf(1.f, e - 7)); }
DEV unsigned fp8x4_enc(float a, float b, float c, float d) { return emu_fp8_enc1(a) | (emu_fp8_enc1(b) << 8) | (emu_fp8_enc1(c) << 16) | (emu_fp8_enc1(d) << 24); }
DEV void fp8x4_dec(unsigned w, float* o) { o[0] = emu_fp8_dec1(w & 255u); o[1] = emu_fp8_dec1((w >> 8) & 255u); o[2] = emu_fp8_dec1((w >> 16) & 255u); o[3] = emu_fp8_dec1(w >> 24); }
#define DPP_XOR1(v) __shfl((v), emu_lane() ^ 1)
#define DPP_XOR2(v) __shfl((v), emu_lane() ^ 2)
#define DPP_HMIRROR(v) __shfl((v), (emu_lane() & ~7) | (7 - (emu_lane() & 7)))
#define DPP_XOR8(v) __shfl((v), emu_lane() ^ 8)
#define DPP_RMIRROR(v) __shfl((v), (emu_lane() & ~15) | (15 - (emu_lane() & 15)))
#define WAVE_LDS_SYNC() emu_wbar()
DEV float xsum16(float a, float b) { const bool hi = (emu_lane() & 16) != 0; return (hi ? b : a) + __shfl_xor(hi ? a : b, 16); }
DEV float xsum32(float a, float b) { const bool hi = (emu_lane() & 32) != 0; return (hi ? b : a) + __shfl_xor(hi ? a : b, 32); }
#else
typedef float f32x2v_t __attribute__((ext_vector_type(2)));
DEV unsigned fp8x4_enc(float a, float b, float c, float d) { int r = __builtin_amdgcn_cvt_pk_fp8_f32(a, b, 0, false); r = __builtin_amdgcn_cvt_pk_fp8_f32(c, d, r, true); return (unsigned)r; }
DEV void fp8x4_dec(unsigned w, float* o) { const f32x2v_t lo = __builtin_amdgcn_cvt_pk_f32_fp8((int)w, false), hi = __builtin_amdgcn_cvt_pk_f32_fp8((int)w, true); o[0] = lo[0]; o[1] = lo[1]; o[2] = hi[0]; o[3] = hi[1]; }
template <int CTRL> DEV float dpp_f(float v) { return __uint_as_float((unsigned)__builtin_amdgcn_update_dpp(0, (int)__float_as_uint(v), CTRL, 0xf, 0xf, true)); }
#define DPP_XOR1(v) dpp_f<0xB1>(v)
#define DPP_XOR2(v) dpp_f<0x4E>(v)
#define DPP_HMIRROR(v) dpp_f<0x141>(v)
#define DPP_XOR8(v) dpp_f<0x128>(v)
#define DPP_RMIRROR(v) dpp_f<0x140>(v)
#define WAVE_LDS_SYNC() asm volatile("s_waitcnt lgkmcnt(0)" ::: "memory")
DEV float xsum16(float a, float b) { const u32x2 r = __builtin_amdgcn_permlane16_swap(__float_as_uint(a), __float_as_uint(b), false, false); return __uint_as_float(r[0]) + __uint_as_float(r[1]); }
DEV float xsum32(float a, float b) { const u32x2 r = __builtin_amdgcn_permlane32_swap(__float_as_uint(a), __float_as_uint(b), false, false); return __uint_as_float(r[0]) + __uint_as_float(r[1]); }
#endif
typedef float f32x2 __attribute__((ext_vector_type(2)));
#ifdef HIPEMU
DEV void fp8x4_dec2(unsigned w, f32x2& lo, f32x2& hi) { float o[4]; fp8x4_dec(w, o); lo = (f32x2){o[0], o[1]}; hi = (f32x2){o[2], o[3]}; }
#else
DEV void fp8x4_dec2(unsigned w, f32x2& lo, f32x2& hi) { lo = __builtin_amdgcn_cvt_pk_f32_fp8((int)w, false); hi = __builtin_amdgcn_cvt_pk_f32_fp8((int)w, true); }
#endif
DEV void fp8x16_dec2(u32x4 q, f32x2* o) { fp8x4_dec2(q.x, o[0], o[1]); fp8x4_dec2(q.y, o[2], o[3]); fp8x4_dec2(q.z, o[4], o[5]); fp8x4_dec2(q.w, o[6], o[7]); }

namespace pg8 {
constexpr int BM = 256, BK = 64, HALF = 128, HTB = HALF * BK * 2, STAGE_BYTES = 8 * HTB, NXCD = 8, WGM = 8;
DEV int lds_byte(int r, int c) { const int st = (r >> 4) * 2 + (c >> 5), rr = r & 15, cc = c & 31, ob = rr * 64 + cc * 2; return st * 1024 + (ob ^ (((ob >> 9) & 1) << 5)); }
DEV void stage_rc(int b, int& R, int& C) { const int st = b / 1024, sb = b % 1024, swz = sb ^ (((sb >> 9) & 1) << 5); R = (st >> 1) * 16 + swz / 64; C = (st & 1) * 32 + (swz % 64) / 2; }
DEV int perm32(int rho) { const int n = rho >> 4, i = rho & 15; return 8 * (i >> 2) + 4 * n + (i & 3); }
struct Unit { int pm, pn; };
struct Gemm { const bf16_t* A; const bf16_t* Bt; int M, N, K; };
struct StaticOrder {
    int nM, nN, nwg, G, c;
    DEV void init(int M, int N, int G_, int c_) { nM = M / BM; nN = N / BM; nwg = nM * nN; G = G_; c = c_; }
    DEV bool next(int i, Unit& u) const {
        const long L = (long)i * G + c; if (L >= nwg) return false;
        int wgid = (int)L; { const int q = nwg / NXCD, r = nwg % NXCD, xcd = wgid % NXCD, off = wgid / NXCD; wgid = (xcd < r ? xcd * (q + 1) : r * (q + 1) + (xcd - r) * q) + off; }
        const int nig = WGM * nN, gid = wgid / nig, fm = gid * WGM, gsz = (nM - fm) < WGM ? (nM - fm) : WGM;
        u.pm = fm + ((wgid % nig) % gsz); u.pn = (wgid % nig) / gsz; return true;
    }
    DEV void a_ready(const Unit&) const {}
    DEV void done(const Unit&) const {}
};
struct PoolOrder {
    int G, c;
    DEV bool next(int i, Unit& u) const { const int L = i * G + c; if (L >= 4 * (MPAD / 256)) return false; u.pm = L; u.pn = L / (MPAD / 256); return true; }
    DEV void a_ready(const Unit&) const {}
    DEV void done(const Unit&) const {}
};

struct EpiF32 {
    static constexpr bool PERM = false;
    float* C; int ldc;
    DEV void operator()(const f32x4 (&acc)[2][2][4][2], const Unit& u, int wr, int wc, int fr, int fq) const {
        const int row0 = u.pm * BM + wr * 64 + fr, col0 = u.pn * BM + wc * 32 + 4 * fq;
#pragma unroll
        for (int ai = 0; ai < 2; ++ai)
#pragma unroll
            for (int m = 0; m < 4; ++m) { float* rowp = C + (size_t)(row0 + ai * HALF + m * 16) * ldc + col0;
#pragma unroll
                for (int bj = 0; bj < 2; ++bj)
#pragma unroll
                    for (int n = 0; n < 2; ++n) *(f32x4*)(rowp + bj * HALF + n * 16) = acc[ai][bj][m][n]; }
    }
};
struct EpiAda {
    static constexpr bool PERM = false;
    float* C; const float* b_ada; const float* b_fin;
    DEV void operator()(const f32x4 (&acc)[2][2][4][2], const Unit& u, int wr, int wc, int fr, int fq) const {
        const int row0 = u.pm * BM + wr * 64 + fr, col0 = u.pn * BM + wc * 32 + 4 * fq;
        const float* bias = (u.pn * BM < 2 * NMOD) ? b_ada + col0 : b_fin + (col0 - 2 * NMOD);
        f32x4 bv[2][2];
#pragma unroll
        for (int bj = 0; bj < 2; ++bj)
#pragma unroll
            for (int n = 0; n < 2; ++n) bv[bj][n] = *(const f32x4*)(bias + bj * HALF + n * 16);
#pragma unroll
        for (int ai = 0; ai < 2; ++ai)
#pragma unroll
            for (int m = 0; m < 4; ++m) { float* rowp = C + (size_t)(row0 + ai * HALF + m * 16) * MODW + col0;
#pragma unroll
                for (int bj = 0; bj < 2; ++bj)
#pragma unroll
                    for (int n = 0; n < 2; ++n) *(f32x4*)(rowp + bj * HALF + n * 16) = acc[ai][bj][m][n] + bv[bj][n]; }
    }
};
struct EpiResid {
    static constexpr bool PERM = false;
    const float* xlo; const float* xhi; const float* gmod  ; float* out;
    DEV void operator()(const f32x4 (&acc)[2][2][4][2], const Unit& u, int wr, int wc, int fr, int fq) const {
        const int row0 = u.pm * BM + wr * 64 + fr, col0 = u.pn * BM + wc * 32 + 4 * fq;
#pragma unroll
        for (int ai = 0; ai < 2; ++ai)
#pragma unroll
            for (int m = 0; m < 4; ++m) {
                const int row = row0 + ai * HALF + m * 16;
                if (row < NTOK) {
                    const float* xr = (row < NP ? xlo + (size_t)row * D : xhi + (size_t)(row - NP) * D) + col0;
                    const float* gr = gmod + (size_t)tok_batch(row) * MODW + col0;
                    float* rowp = out + (size_t)row * D + col0;
#pragma unroll
                    for (int bj = 0; bj < 2; ++bj)
#pragma unroll
                        for (int n = 0; n < 2; ++n) { const f32x4 xv = *(const f32x4*)(xr + bj * HALF + n * 16), gv = *(const f32x4*)(gr + bj * HALF + n * 16);
                            *(f32x4*)(rowp + bj * HALF + n * 16) = xv + gv * acc[ai][bj][m][n]; }
                }
            }
    }
};
struct EpiBf16 {
    static constexpr bool PERM = true;
    bf16_t* O; int ldc;
    DEV void operator()(const f32x4 (&acc)[2][2][4][2], const Unit& u, int wr, int wc, int fr, int fq) const {
        const int row0 = u.pm * BM + wr * 64 + fr, col0 = u.pn * BM + wc * 32 + 8 * fq;
#pragma unroll
        for (int ai = 0; ai < 2; ++ai)
#pragma unroll
            for (int m = 0; m < 4; ++m) { bf16_t* rowp = O + (size_t)(row0 + ai * HALF + m * 16) * ldc + col0;
#pragma unroll
                for (int bj = 0; bj < 2; ++bj) { const f32x4 v0 = acc[ai][bj][m][0], v1 = acc[ai][bj][m][1];
                    u32x4 w; w.x = pack2(v0[0], v0[1]); w.y = pack2(v0[2], v0[3]); w.z = pack2(v1[0], v1[1]); w.w = pack2(v1[2], v1[3]);
                    *(u32x4*)(rowp + bj * HALF) = w; } }
    }
};
struct EpiPool {
    static constexpr bool PERM = true;
    bf16_t* cat; const float* pb; const float* ps;
    DEV void operator()(const f32x4 (&acc)[2][2][4][2], const Unit& u, int wr, int wc, int fr, int fq) const {
        const int g = u.pn, tok0 = u.pm * BM - g * MPAD + wr * 64 + fr, col0 = g * 256 + wc * 32 + 8 * fq;
#pragma unroll
        for (int bj = 0; bj < 2; ++bj) {
            const f32x4 b0 = *(const f32x4*)(pb + col0 + bj * HALF), b1 = *(const f32x4*)(pb + col0 + bj * HALF + 4);
            const f32x4 s0 = *(const f32x4*)(ps + col0 + bj * HALF), s1 = *(const f32x4*)(ps + col0 + bj * HALF + 4);
#pragma unroll
            for (int ai = 0; ai < 2; ++ai)
#pragma unroll
                for (int m = 0; m < 4; ++m) { const int tok = tok0 + ai * HALF + m * 16;
                    if (tok < NTOK) { const f32x4 v0 = (acc[ai][bj][m][0] + b0) * s0, v1 = (acc[ai][bj][m][1] + b1) * s1;
                        u32x4 w; w.x = pack2(v0[0], v0[1]); w.y = pack2(v0[2], v0[3]); w.z = pack2(v1[0], v1[1]); w.w = pack2(v1[2], v1[3]);
                        *(u32x4*)(cat + (size_t)tok * D + 1024 + col0 + bj * HALF) = w; } }
        }
    }
};

#ifdef HIPEMU
template <class Epi, class Sched>
static void gemm_phase(unsigned char*, const Gemm g, const Sched& S, const Epi& E) {
    const int tid = threadIdx.x, wid = tid >> 6, lane = tid & 63, wr = wid >> 2, wc = wid & 3, fr = lane & 15, fq = lane >> 4;
    Unit cur;
    for (int ui = 0; S.next(ui, cur); ++ui) {
        f32x4 acc[2][2][4][2];
        for (int ai = 0; ai < 2; ++ai) for (int bj = 0; bj < 2; ++bj) for (int m = 0; m < 4; ++m) for (int n = 0; n < 2; ++n) for (int j = 0; j < 4; ++j) {
            const int row = 256 * cur.pm + 128 * ai + 64 * wr + 16 * m + fr;
            const int col = Epi::PERM ? 256 * cur.pn + 128 * bj + 32 * wc + 8 * fq + 4 * n + j : 256 * cur.pn + 128 * bj + 32 * wc + 16 * n + 4 * fq + j;
            float s = 0.f;
            if ((row % emu_row_mod) < emu_row_limit) { const float* a = emu_f32_copy(g.A, (size_t)g.M * g.K) + (size_t)row * g.K; const float* b = emu_f32_copy(g.Bt, (size_t)g.N * g.K) + (size_t)col * g.K;
                for (int k = 0; k < g.K; ++k) s += a[k] * b[k]; }
            acc[ai][bj][m][n][j] = s; }
        E(acc, cur, wr, wc, fr, fq);
    }
    __syncthreads();
}
#else
template <class Epi, class Sched>
__device__ __forceinline__ void gemm_phase(LAS unsigned char* lds, const Gemm g, const Sched& S, const Epi& E) {
    const int tid = threadIdx.x, wid = __builtin_amdgcn_readfirstlane(tid >> 6), lane = tid & 63, wr = wid >> 2, wc = wid & 3, fr = lane & 15, fq = lane >> 4;
    int K = g.K; asm volatile("" : "+s"(K));
    const int nt = K / BK;
    unsigned voffA[2], voffB[2];
#pragma unroll
    for (int i = 0; i < 2; ++i) { int R, C; stage_rc(tid * 16 + i * 8192, R, C); const int Rb = Epi::PERM ? ((R & ~31) + perm32(R & 31)) : R;
        voffA[i] = (unsigned)(R * K + C) * 2u; voffB[i] = (unsigned)(Rb * K + C) * 2u; }
    const size_t kstep = (size_t)(BK * 2);
    const size_t hstep = (size_t)HALF * K * 2;
    const size_t tstep = 2 * hstep;
    const unsigned ldsw = (unsigned)wid * 1024u;
    const int aoff = lds_byte(wr * 64 + fr, fq * 8), boff = lds_byte(wc * 32 + fr, fq * 8);
#define PG8_SA(b, h) (((b) * 2 + (h)) * HTB)
#define PG8_SB(b, h) ((4 + (b) * 2 + (h)) * HTB)
#define PG8_STAGE(bufoff, gbase, voff) do { _Pragma("unroll") for (int _i = 0; _i < 2; ++_i) \
        __builtin_amdgcn_global_load_lds((const unsigned*)((const char*)(gbase) + (voff)[_i]), (LAS unsigned*)(lds + (bufoff) + ldsw + _i * 8192), 16, 0, 0); } while (0)
#define PG8_LDA(dst, b, h) do { _Pragma("unroll") for (int m = 0; m < 4; ++m) _Pragma("unroll") for (int k = 0; k < 2; ++k) dst[m][k] = *(const LAS bf16x8*)(lds + PG8_SA(b, h) + aoff + m * 2048 + k * 1024); } while (0)
#define PG8_LDB(dst, b, h) do { _Pragma("unroll") for (int n = 0; n < 2; ++n) _Pragma("unroll") for (int k = 0; k < 2; ++k) dst[n][k] = *(const LAS bf16x8*)(lds + PG8_SB(b, h) + boff + n * 2048 + k * 1024); } while (0)
#define PG8_MMA(ai, bj, At, Bt) do { __builtin_amdgcn_s_setprio(1); _Pragma("unroll") for (int m = 0; m < 4; ++m) _Pragma("unroll") for (int n = 0; n < 2; ++n) _Pragma("unroll") for (int k = 0; k < 2; ++k) \
        acc[ai][bj][m][n] = __builtin_amdgcn_mfma_f32_16x16x32_bf16(Bt[n][k], At[m][k], acc[ai][bj][m][n], 0, 0, 0); __builtin_amdgcn_s_setprio(0); } while (0)
#define PG8_WAIT_V(n) asm volatile("s_waitcnt vmcnt(" #n ")" ::: "memory")
#define PG8_WAIT_L(n) asm volatile("s_waitcnt lgkmcnt(" #n ")" ::: "memory")
#define PG8_BAR __builtin_amdgcn_s_barrier()
#define PG8_SCHED __builtin_amdgcn_sched_barrier(0)
    Unit cur, nxt; int ui = 0;
    if (!S.next(0, cur)) return;
    f32x4 acc[2][2][4][2];
#pragma unroll
    for (int a = 0; a < 2; ++a)
#pragma unroll
        for (int b = 0; b < 2; ++b)
#pragma unroll
            for (int m = 0; m < 4; ++m)
#pragma unroll
                for (int n = 0; n < 2; ++n) acc[a][b][m][n] = (f32x4){0.f, 0.f, 0.f, 0.f};
    bf16x8 At[4][2], B0[2][2], B1[2][2];
    const char* cA = (const char*)g.A + (size_t)cur.pm * tstep; const char* cB = (const char*)g.Bt + (size_t)cur.pn * tstep;
    S.a_ready(cur);
    PG8_STAGE(PG8_SB(0, 0), cB, voffB); PG8_STAGE(PG8_SA(0, 0), cA, voffA); PG8_STAGE(PG8_SB(0, 1), cB + hstep, voffB); PG8_STAGE(PG8_SA(0, 1), cA + hstep, voffA);
    if (wr == 1) PG8_BAR;
    PG8_WAIT_V(4); PG8_BAR;
    PG8_STAGE(PG8_SB(1, 0), cB + kstep, voffB); PG8_STAGE(PG8_SA(1, 0), cA + kstep, voffA); PG8_STAGE(PG8_SB(1, 1), cB + hstep + kstep, voffB);
    PG8_WAIT_V(6); PG8_BAR;
    for (;;) {
        const bool has_next = S.next(ui + 1, nxt);
        const char* nA = has_next ? (const char*)g.A + (size_t)nxt.pm * tstep : cA; const char* nB = has_next ? (const char*)g.Bt + (size_t)nxt.pn * tstep : cB;
        for (int t = 0; t < nt; t += 2) {
            const bool last = (t == nt - 2);
            const char* a1 = cA + (size_t)(t + 1) * kstep;
            const char* a2 = last ? nA : cA + (size_t)(t + 2) * kstep; const char* b2 = last ? nB : cB + (size_t)(t + 2) * kstep;
            const char* a3 = a2 + kstep; const char* b3 = b2 + kstep;
            if (last && has_next) S.a_ready(nxt);
            PG8_LDB(B0, 0, 0); PG8_SCHED; PG8_LDA(At, 0, 0); PG8_STAGE(PG8_SA(1, 1), a1 + hstep, voffA);
            PG8_WAIT_L(8); PG8_BAR; PG8_WAIT_L(0); PG8_MMA(0, 0, At, B0); PG8_BAR; PG8_SCHED;
            PG8_LDB(B1, 0, 1); PG8_STAGE(PG8_SB(0, 0), b2, voffB);
            PG8_BAR; PG8_WAIT_L(0); PG8_MMA(0, 1, At, B1); PG8_BAR;
            PG8_LDA(At, 0, 1); PG8_STAGE(PG8_SA(0, 0), a2, voffA);
            PG8_BAR; PG8_WAIT_L(0); PG8_MMA(1, 0, At, B0); PG8_BAR; PG8_SCHED;
            PG8_STAGE(PG8_SB(0, 1), b2 + hstep, voffB);
            PG8_WAIT_V(6); PG8_BAR; PG8_MMA(1, 1, At, B1); PG8_BAR;
            PG8_LDB(B0, 1, 0); PG8_SCHED; PG8_LDA(At, 1, 0); PG8_STAGE(PG8_SA(0, 1), a2 + hstep, voffA);
            PG8_WAIT_L(8); PG8_BAR; PG8_WAIT_L(0); PG8_MMA(0, 0, At, B0); PG8_BAR; PG8_SCHED;
            PG8_LDB(B1, 1, 1); PG8_STAGE(PG8_SB(1, 0), b3, voffB);
            PG8_BAR; PG8_WAIT_L(0); PG8_MMA(0, 1, At, B1); PG8_BAR;
            PG8_LDA(At, 1, 1); PG8_STAGE(PG8_SA(1, 0), a3, voffA);
            PG8_BAR; PG8_WAIT_L(0); PG8_MMA(1, 0, At, B0); PG8_BAR; PG8_SCHED;
            PG8_STAGE(PG8_SB(1, 1), b3 + hstep, voffB);
            PG8_WAIT_V(6); PG8_BAR; PG8_MMA(1, 1, At, B1); PG8_BAR;
        }
        { int tz = threadIdx.x; asm volatile("" : "+v"(tz)); const int wz = tz >> 6, lz = tz & 63;
          E(acc, cur, wz >> 2, wz & 3, lz & 15, lz >> 4); } S.done(cur);
        if (!has_next) break;
#pragma unroll
        for (int a = 0; a < 2; ++a)
#pragma unroll
            for (int b = 0; b < 2; ++b)
#pragma unroll
                for (int m = 0; m < 4; ++m)
#pragma unroll
                    for (int n = 0; n < 2; ++n) acc[a][b][m][n] = (f32x4){0.f, 0.f, 0.f, 0.f};
        cur = nxt; cA = nA; cB = nB; ++ui;
    }
    PG8_WAIT_V(0);
    if (wr == 0) PG8_BAR;
    PG8_BAR;
#undef PG8_SA
#undef PG8_SB
#undef PG8_STAGE
#undef PG8_LDA
#undef PG8_LDB
#undef PG8_MMA
#undef PG8_WAIT_V
#undef PG8_WAIT_L
#undef PG8_BAR
#undef PG8_SCHED
}
#endif
}

constexpr int MBIG = (NP / 256) * 256;
template <class F> DEV void small_gemm(const bf16_t* A, const bf16_t* Bt, int K, unsigned char* lds, const F& f) {
    const int tid = threadIdx.x, lane = tid & 63, w = tid >> 6, g = lane >> 4, c16 = lane & 15;
    const int tiles_m = (NTOK - MBIG + 63) / 64, ntiles = tiles_m * 32, kw = K / 8;
    float* part = (float*)lds;
    for (int tl = blockIdx.x; tl < ntiles; tl += gridDim.x) {
        const int r0 = MBIG + (tl / 32) * 64, n0 = (tl % 32) * 64;
        f32x4 acc[4][4];
#pragma unroll
        for (int i = 0; i < 4; ++i)
#pragma unroll
            for (int j = 0; j < 4; ++j) acc[i][j] = (f32x4){0.f, 0.f, 0.f, 0.f};
        for (int k0 = w * kw; k0 < (w + 1) * kw; k0 += 128) {
            bf16x8 af[4][4], bfr[4][4];
#pragma unroll
            for (int u = 0; u < 4; ++u)
#pragma unroll
                for (int i = 0; i < 4; ++i) { int arow = r0 + 16 * i + c16; if (arow >= MPAD) arow = MPAD - 1;
                    af[u][i] = *(const bf16x8*)(A + (size_t)arow * K + k0 + 32 * u + 8 * g); bfr[u][i] = *(const bf16x8*)(Bt + (size_t)(n0 + 16 * i + c16) * K + k0 + 32 * u + 8 * g); }
#pragma unroll
            for (int u = 0; u < 4; ++u)
#pragma unroll
                for (int i = 0; i < 4; ++i)
#pragma unroll
                    for (int j = 0; j < 4; ++j) acc[i][j] = MFMA_BF16(af[u][i], bfr[u][j], acc[i][j]);
        }
#pragma unroll
        for (int i = 0; i < 4; ++i)
#pragma unroll
            for (int j = 0; j < 4; ++j)
#pragma unroll
                for (int r = 0; r < 4; ++r) part[(w * 64 + 16 * i + 4 * g + r) * 68 + 16 * j + c16] = acc[i][j][r];
        __syncthreads();
        {
            const int row = tid >> 3, c8 = (tid & 7) * 8; f32x4 s0 = (f32x4){0.f, 0.f, 0.f, 0.f}, s1 = s0;
#pragma unroll
            for (int ww = 0; ww < 8; ++ww) { s0 += *(const f32x4*)(part + (ww * 64 + row) * 68 + c8); s1 += *(const f32x4*)(part + (ww * 64 + row) * 68 + c8 + 4); }
            if (r0 + row < NTOK) f(r0 + row, n0 + c8, s0, s1);
        }
        __syncthreads();
    }
}
struct SmallResid { const float* xlo; const float* xhi; const float* gmod; float* out;
    DEV void operator()(int row, int col, f32x4 v0, f32x4 v1) const { const float* xr = (row < NP ? xlo + (size_t)row * D : xhi + (size_t)(row - NP) * D) + col; const float* gr = gmod + (size_t)tok_batch(row) * MODW + col;
        float* o = out + (size_t)row * D + col; *(f32x4*)o = *(const f32x4*)xr + *(const f32x4*)gr * v0; *(f32x4*)(o + 4) = *(const f32x4*)(xr + 4) + *(const f32x4*)(gr + 4) * v1; } };
struct SmallF32 { float* out; DEV void operator()(int row, int col, f32x4 v0, f32x4 v1) const { float* o = out + (size_t)row * D + col; *(f32x4*)o = v0; *(f32x4*)(o + 4) = v1; } };

DEV void transpose_tile(const float* src, int ld_src, bf16_t* dst, int ld_dst, float* tile) {
    const int tid = threadIdx.x;
#pragma unroll
    for (int i = 0; i < 2; ++i) { const int idx = tid + i * 512, r = idx >> 4, c4 = idx & 15; const f32x4 v = *(const f32x4*)(src + (size_t)r * ld_src + c4 * 4);
        float* t = tile + r * 65 + c4 * 4; t[0] = v[0]; t[1] = v[1]; t[2] = v[2]; t[3] = v[3]; }
    __syncthreads();
    const int n = tid >> 3, kg = tid & 7; const float* t = tile + (kg * 8) * 65 + n;
    u32x4 w; w.x = pack2(t[0], t[65]); w.y = pack2(t[2 * 65], t[3 * 65]); w.z = pack2(t[4 * 65], t[5 * 65]); w.w = pack2(t[6 * 65], t[7 * 65]);
    *(u32x4*)(dst + (size_t)n * ld_dst + kg * 8) = w;
    __syncthreads();
}
DEV int cvt_job_tiles(int j) { const int K = j < 9 ? 2048 : 256; const int N = j < 2 ? NMOD : (j == 2 ? 2 * D : (j < 5 ? ZW : (j < 9 ? D : 256))); return (K / 64) * (N / 64); }
DEV void phase_convert(const Params& p, unsigned char* lds) {
    float* tile = (float*)lds;
    const int tid = threadIdx.x;
    int total = 0;
#pragma unroll
    for (int q = 0; q < 17; ++q) total += cvt_job_tiles(q);
    for (int tl = blockIdx.x; tl < total; tl += gridDim.x) {
        int j = 0, loc = 0, base = 0;
#pragma unroll
        for (int q = 0; q < 17; ++q) { const int cnt = cvt_job_tiles(q); if (tl >= base && tl < base + cnt) { j = q; loc = tl - base; } base += cnt; }
        const float* src; bf16_t* dst; int K = 2048, N;
        if (j < 2) { N = NMOD; src = p.w_ada + (size_t)j * 2048 * NMOD; dst = p.wt_ada + (size_t)j * NMOD * 2048; }
        else if (j == 2) { N = 2 * D; src = p.w_ada_final; dst = p.wt_ada + (size_t)2 * NMOD * 2048; }
        else if (j < 5) { N = ZW; src = p.w_in + (size_t)(j - 3) * 2048 * ZW; dst = p.wt_in + (size_t)(j - 3) * ZW * 2048; }
        else if (j < 7) { N = D; src = p.w_out + (size_t)(j - 5) * D * D; dst = p.wt_out + (size_t)(j - 5) * D * D; }
        else if (j < 9) { N = D; src = p.peer_wq + (size_t)(j - 7) * D * D; dst = p.wt_q + (size_t)(j - 7) * D * D; }
        else { K = 256; N = 256; src = p.pool_w + (size_t)(j - 9) * 65536; dst = p.wt_pool + (size_t)(j - 9) * 65536; }
        const int ntn = N / 64, kt = loc / ntn, nt = loc % ntn;
        transpose_tile(src + (size_t)kt * 64 * N + nt * 64, N, dst + (size_t)nt * 64 * K + kt * 64, K, tile);
    }
    const size_t gt = (size_t)blockIdx.x * 512 + tid, gs = (size_t)gridDim.x * 512;
    {
        const int lane = tid & 63, gw = blockIdx.x * 8 + (tid >> 6), nw = gridDim.x * 8;
        for (int row = gw; row < 4 * NE; row += nw) {
            const int which = row / (2 * NE), rr = row % (2 * NE);
            const float* src = (which ? p.peer_v : p.peer_u) + (size_t)rr * D; unsigned char* tab = (which ? p.v8 : p.u8) + (size_t)(rr / NE) * NE * D; const int e = rr % NE;
            f32x4 v[8]; float am = 0.f;
#pragma unroll
            for (int k = 0; k < 8; ++k) { v[k] = *(const f32x4*)(src + 4 * lane + 256 * k); am = fmaxf(am, fmaxf(fmaxf(fabsf(v[k][0]), fabsf(v[k][1])), fmaxf(fabsf(v[k][2]), fabsf(v[k][3])))); }
            am = wave_max(am);
            const float sc = am > 0.f ? 224.0f / am : 1.0f;
#pragma unroll
            for (int k = 0; k < 8; ++k) *(unsigned*)(tab + ((size_t)(2 * k + (lane >> 5)) * NE + e) * 128 + 4 * (lane & 31)) = fp8x4_enc(v[k][0] * sc, v[k][1] * sc, v[k][2] * sc, v[k][3] * sc);
            if (lane == 0) (which ? p.sv : p.su)[rr] = am > 0.f ? am * (1.0f / 224.0f) : 1.0f;
        }
    }
    for (size_t i = gt; i < (size_t)256 * D / 8; i += gs) {
        const int row = (int)(i / (D / 8)), c8 = (int)(i % (D / 8)) * 8; u32x4 w = (u32x4){0u, 0u, 0u, 0u};
        if (row < NC) { const float* s = (row < PB ? p.c_prompt + (size_t)row * D : p.c_sample + (size_t)(row - PB) * D) + c8;
            const f32x4 a = *(const f32x4*)s, b = *(const f32x4*)(s + 4);
            w.x = pack2(siluf_(a[0]), siluf_(a[1])); w.y = pack2(siluf_(a[2]), siluf_(a[3])); w.z = pack2(siluf_(b[0]), siluf_(b[1])); w.w = pack2(siluf_(b[2]), siluf_(b[3])); }
        *(u32x4*)(p.csil + i * 8) = w;
    }
}

DEV void phase_norm(const Params& p, const float* xlo, const float* xhi, const float* gn, int sh_off, int sc_off, bf16_t* obf, float* of32) {
    const int lane = threadIdx.x & 63, gw = blockIdx.x * 8 + (threadIdx.x >> 6), nw = gridDim.x * 8;
    for (int t = gw; t < NTOK; t += nw) {
        const float* xr = t < NP ? xlo + (size_t)t * D : xhi + (size_t)(t - NP) * D;
        const float* mrow = p.modbuf + (size_t)tok_batch(t) * MODW;
        f32x4 v[8]; float ss = 0.f;
#pragma unroll
        for (int c = 0; c < 4; ++c) { const int col = c * 512 + lane * 8; v[2 * c] = *(const f32x4*)(xr + col); v[2 * c + 1] = *(const f32x4*)(xr + col + 4);
#pragma unroll
            for (int j = 0; j < 4; ++j) ss += v[2 * c][j] * v[2 * c][j] + v[2 * c + 1][j] * v[2 * c + 1][j]; }
        ss = wave_sum(ss);
        const float rstd = rsqrtf(ss * (1.0f / D) + EPS);
#pragma unroll
        for (int c = 0; c < 4; ++c) { const int col = c * 512 + lane * 8; f32x4 y[2];
#pragma unroll
            for (int q = 0; q < 2; ++q) { const f32x4 g4 = *(const f32x4*)(gn + col + 4 * q), sc = *(const f32x4*)(mrow + sc_off + col + 4 * q), sh = *(const f32x4*)(mrow + sh_off + col + 4 * q);
                y[q] = (v[2 * c + q] * rstd) * g4 * (sc + 1.0f) + sh; }
            if (obf) { u32x4 w; w.x = pack2(y[0][0], y[0][1]); w.y = pack2(y[0][2], y[0][3]); w.z = pack2(y[1][0], y[1][1]); w.w = pack2(y[1][2], y[1][3]); *(u32x4*)(obf + (size_t)t * D + col) = w; }
            else { *(f32x4*)(of32 + (size_t)t * D + col) = y[0]; *(f32x4*)(of32 + (size_t)t * D + col + 4) = y[1]; }
        }
    }
}

namespace hg {
constexpr int QS = 136, VS = 72;
constexpr int O_QT = 0, O_QH = O_QT + 64 * QS * 2, O_KT = O_QH + 64 * QS * 2, O_KDT = O_KT + 160 * QS * 2, O_VT = O_KDT + 128 * VS * 2,
              O_AB = O_VT + 128 * VS * 2, O_GS = O_AB + 64 * VS * 2, O_END = O_GS + 4 * 128 * 4;
constexpr int OS = 132;
static_assert(O_END <= 163840 - 64, "HGRN LDS layout too large");
constexpr int NCHUNK = SEQ / 64, NUNIT = PB * HH * NCHUNK;
}
DEV int kt_rowbase(int i) { return i == 0 ? 0 : (i == 1 ? 16 : (i == 2 ? 48 : 96)); }

DEV void hgrn_pre_unit(const Params& p, int l, int unit, unsigned char* lds) {
    using namespace hg;
    const int tid = threadIdx.x, lane = tid & 63, w = tid >> 6, g = lane >> 4, c16 = lane & 15;
    const int c = unit % NCHUNK, bh = unit / NCHUNK, b = bh / HH, h = bh % HH;
    bf16_t* Qt = (bf16_t*)(lds + O_QT); bf16_t* Qh = (bf16_t*)(lds + O_QH); bf16_t* Kt = (bf16_t*)(lds + O_KT);
    bf16_t* Kdt = (bf16_t*)(lds + O_KDT); bf16_t* Vt = (bf16_t*)(lds + O_VT); bf16_t* Ab = (bf16_t*)(lds + O_AB); float* Gs = (float*)(lds + O_GS);
    const int kk = tid & 127, sj = tid >> 7;
    float lbv = 0.f;
    if (l > 0) lbv = sigmoidf_(p.lb_logits[HH * HD + h * HD + kk] - p.lb_logits[h * HD + kk]);
    const float oml = 1.0f - lbv;
    for (int i = tid; i < 64 * VS / 2; i += 512) ((unsigned*)Ab)[i] = 0u;
    const size_t row0 = (size_t)b * SEQ + c * 64;
    float Gl[16], qv[16], kv[16];
    {
        const bf16_t* zr = p.z + (row0 + sj * 16) * ZW + h * HD + kk;
        unsigned short zq16[16], zf16[16], zi16[16];
#pragma unroll
        for (int s = 0; s < 16; ++s) { zq16[s] = zr[(size_t)s * ZW]; zf16[s] = zr[(size_t)s * ZW + 1024]; zi16[s] = zr[(size_t)s * ZW + 2048]; }
        float run = 0.f; unsigned vpk[8];
#pragma unroll
        for (int s = 0; s < 16; ++s) {
            const float zq = bf2f(zq16[s]), zf = fminf(fmaxf(bf2f(zf16[s]), -80.f), 80.f);
            const float e = __expf(-zf), sg = 1.0f / (1.0f + e);
            const float f = lbv + oml * sg;
            run += __logf(f); Gl[s] = run;
            kv[s] = oml * (e * sg);
            qv[s] = siluf_(zq);
            if (s & 1) vpk[s >> 1] |= (unsigned)zi16[s] << 16; else vpk[s >> 1] = zi16[s];
        }
        Gs[sj * 128 + kk] = run;
        *(u32x4*)(Vt + kk * VS + sj * 16) = (u32x4){vpk[0], vpk[1], vpk[2], vpk[3]}; *(u32x4*)(Vt + kk * VS + sj * 16 + 8) = (u32x4){vpk[4], vpk[5], vpk[6], vpk[7]};
    }
    __syncthreads();
    float Gend;
    {
        const float g0 = Gs[kk], g1 = Gs[128 + kk], g2 = Gs[256 + kk], g3 = Gs[384 + kk];
        float Gb[4]; Gb[0] = 0.f; Gb[1] = g0; Gb[2] = g0 + g1; Gb[3] = g0 + g1 + g2; Gend = Gb[3] + g3;
        const float Gbj = sj == 0 ? Gb[0] : (sj == 1 ? Gb[1] : (sj == 2 ? Gb[2] : Gb[3]));
        const float eGb = __expf(Gbj);
        unsigned kd[8]; unsigned qh[8];
#pragma unroll
        for (int s = 0; s < 16; ++s) {
            const int t = sj * 16 + s;
            const float q1 = qv[s] * __expf(Gl[s]);
            Qt[t * QS + kk] = (bf16_t)f2bf(q1);
            const unsigned qhv = f2bf(q1 * eGb);
            Qh[t * QS + kk] = (bf16_t)qhv;
#pragma unroll
            for (int i = 0; i < 4; ++i) if (i >= sj) Kt[(kt_rowbase(i) + t) * QS + kk] = (bf16_t)f2bf(kv[s] * __expf(fminf(Gb[i] - Gbj - Gl[s], 60.f)));
            const unsigned kdv = f2bf(kv[s] * __expf(Gend - Gbj - Gl[s]));
            if (s & 1) kd[s >> 1] |= kdv << 16; else kd[s >> 1] = kdv;
        }
        *(u32x4*)(Kdt + kk * VS + sj * 16) = (u32x4){kd[0], kd[1], kd[2], kd[3]}; *(u32x4*)(Kdt + kk * VS + sj * 16 + 8) = (u32x4){kd[4], kd[5], kd[6], kd[7]};
        if (sj == 0) p.hg_gam[(size_t)unit * HD + kk] = __expf(Gend);
    }
    __syncthreads();
    {
        const int t = tid >> 3, part = tid & 7;
        const u32x4 a = *(const u32x4*)(Qh + t * QS + 16 * part), b2 = *(const u32x4*)(Qh + t * QS + 16 * part + 8);
        bf16_t* dst = p.hg_qh + (row0 + t) * 1024 + h * HD + 16 * part; *(u32x4*)dst = a; *(u32x4*)(dst + 8) = b2;
    }
    for (int blk = w; blk < 10; blk += 8) {
        int bi, bjj;
        if (blk == 0) { bi = 0; bjj = 0; } else if (blk < 3) { bi = 1; bjj = blk - 1; } else if (blk < 6) { bi = 2; bjj = blk - 3; } else { bi = 3; bjj = blk - 6; }
        f32x4 acc = (f32x4){0.f, 0.f, 0.f, 0.f};
#pragma unroll
        for (int ks = 0; ks < 4; ++ks) {
            const bf16x8 a = *(const bf16x8*)(Qt + (16 * bi + c16) * QS + 32 * ks + 8 * g);
            const bf16x8 bb = *(const bf16x8*)(Kt + (kt_rowbase(bi) + 16 * bjj + c16) * QS + 32 * ks + 8 * g);
            acc = MFMA_BF16(a, bb, acc);
        }
#pragma unroll
        for (int r = 0; r < 4; ++r) { const int tl = 4 * g + r; float v = acc[r]; if (bi == bjj && c16 > tl) v = 0.f; Ab[(16 * bi + tl) * VS + 16 * bjj + c16] = (bf16_t)f2bf(v); }
    }
    __syncthreads();
    {
        f32x4* oin = (f32x4*)(p.hg_oin + (size_t)unit * 64 * 128);
#pragma unroll
        for (int tt = 0; tt < 4; ++tt) {
            f32x4 acc = (f32x4){0.f, 0.f, 0.f, 0.f};
#pragma unroll
            for (int ks = 0; ks < 2; ++ks) {
                const bf16x8 a = *(const bf16x8*)(Ab + (16 * tt + c16) * VS + 32 * ks + 8 * g);
                const bf16x8 bb = *(const bf16x8*)(Vt + (16 * w + c16) * VS + 32 * ks + 8 * g);
                acc = MFMA_BF16(a, bb, acc);
            }
            oin[(tt * 8 + w) * 64 + lane] = acc;
        }
        f32x4* ds = (f32x4*)(p.hg_ds + (size_t)unit * 128 * 128);
#pragma unroll
        for (int vt = 0; vt < 8; ++vt) {
            f32x4 acc = (f32x4){0.f, 0.f, 0.f, 0.f};
#pragma unroll
            for (int ks = 0; ks < 2; ++ks) {
                const bf16x8 a = *(const bf16x8*)(Kdt + (16 * w + c16) * VS + 32 * ks + 8 * g);
                const bf16x8 bb = *(const bf16x8*)(Vt + (16 * vt + c16) * VS + 32 * ks + 8 * g);
                acc = MFMA_BF16(a, bb, acc);
            }
            ds[(w * 8 + vt) * 64 + lane] = acc;
        }
    }
    __syncthreads();
}

DEV void hgrn_scan_unit(const Params& p, int l, int su) {
    using namespace hg;
    const int tid = threadIdx.x, lane = tid & 63, w = tid >> 6, g = lane >> 4, c16 = lane & 15;
    const int vt = su % 8, bh = su / 8, b = bh / HH, h = bh % HH;
    f32x4 S = (f32x4){0.f, 0.f, 0.f, 0.f};
    for (int c = 0; c < NCHUNK; ++c) {
        const size_t unit = (size_t)bh * NCHUNK + c;
        u32x2 sw; sw.x = pack2(S[0], S[1]); sw.y = pack2(S[2], S[3]);
        *(u32x2*)(p.hg_sc + (unit * 128 + 16 * vt + c16) * 128 + 16 * w + 4 * g) = sw;
        const f32x4 d = ((const f32x4*)(p.hg_ds + unit * 128 * 128))[(w * 8 + vt) * 64 + lane];
        const f32x4 gm = *(const f32x4*)(p.hg_gam + unit * HD + 16 * w + 4 * g);
        S = S * gm + d;
    }
    float* so = p.out + OFF_HP + ((size_t)(l * PB + b) * HH + h) * HD * HD;
#pragma unroll
    for (int r = 0; r < 4; ++r) so[(size_t)(16 * w + 4 * g + r) * HD + 16 * vt + c16] = S[r];
}

DEV void hgrn_post_unit(const Params& p, int l, int unit, unsigned char* lds) {
    using namespace hg;
    const int tid = threadIdx.x, lane = tid & 63, w = tid >> 6, g = lane >> 4, c16 = lane & 15;
    const int c = unit % NCHUNK, bh = unit / NCHUNK, b = bh / HH, h = bh % HH;
    float* Ob = (float*)lds;
    const size_t row0 = (size_t)b * SEQ + c * 64;
    const f32x4* oin = (const f32x4*)(p.hg_oin + (size_t)unit * 64 * 128);
    f32x4 acc[4];
#pragma unroll
    for (int tt = 0; tt < 4; ++tt) acc[tt] = oin[(tt * 8 + w) * 64 + lane];
    if (c > 0) {
        bf16x8 bfr[4];
#pragma unroll
        for (int ks = 0; ks < 4; ++ks) bfr[ks] = *(const bf16x8*)(p.hg_sc + ((size_t)unit * 128 + 16 * w + c16) * 128 + 32 * ks + 8 * g);
#pragma unroll
        for (int tt = 0; tt < 4; ++tt)
#pragma unroll
            for (int ks = 0; ks < 4; ++ks) { const bf16x8 a = *(const bf16x8*)(p.hg_qh + (row0 + 16 * tt + c16) * 1024 + h * HD + 32 * ks + 8 * g); acc[tt] = MFMA_BF16(a, bfr[ks], acc[tt]); }
    }
#pragma unroll
    for (int tt = 0; tt < 4; ++tt)
#pragma unroll
        for (int r = 0; r < 4; ++r) Ob[(16 * tt + 4 * g + r) * OS + 16 * w + c16] = acc[tt][r];
    __syncthreads();
    {
        const int t = tid >> 3, part = tid & 7; const size_t row = row0 + t;
        float ov[16]; float ss = 0.f;
#pragma unroll
        for (int q = 0; q < 4; ++q) { const f32x4 x = *(const f32x4*)(Ob + t * OS + 16 * part + 4 * q); ov[4 * q] = x[0]; ov[4 * q + 1] = x[1]; ov[4 * q + 2] = x[2]; ov[4 * q + 3] = x[3];
            ss += x[0] * x[0] + x[1] * x[1] + x[2] * x[2] + x[3] * x[3]; }
        ss += __shfl_xor(ss, 1); ss += __shfl_xor(ss, 2); ss += __shfl_xor(ss, 4);
        const float rstd = rsqrtf(ss * (1.0f / HD) + EPS);
        const bf16_t* zg = p.z + row * ZW + 3072 + h * HD + 16 * part;
        const u32x4 za = *(const u32x4*)zg, zc = *(const u32x4*)(zg + 8);
        const unsigned zw[8] = {za.x, za.y, za.z, za.w, zc.x, zc.y, zc.z, zc.w};
        const float* gn = p.hgrn_norm_g + l * HD + 16 * part;
        unsigned ow[8];
#pragma unroll
        for (int q = 0; q < 8; ++q) { const float a0 = ov[2 * q] * rstd * gn[2 * q] * siluf_(lo16(zw[q])), a1 = ov[2 * q + 1] * rstd * gn[2 * q + 1] * siluf_(hi16(zw[q])); ow[q] = pack2(a0, a1); }
        bf16_t* dst = p.cat + row * D + h * HD + 16 * part;
        *(u32x4*)dst = (u32x4){ow[0], ow[1], ow[2], ow[3]}; *(u32x4*)(dst + 8) = (u32x4){ow[4], ow[5], ow[6], ow[7]};
    }
    __syncthreads();
}

DEV void hgrn_sample_unit(const Params& p, int l, int unit, unsigned char* lds) {
    const int tid = threadIdx.x, lane = tid & 63, w = tid >> 6;
    const int b = unit / HH, h = unit % HH;
    float* fS = (float*)lds; float* kS = fS + 512; float* qS = kS + 512; float* vS = qS + 512; float* red = vS + 512; float* part = red + 4 * 4 * 128;
    const int r0 = NP + b * DSEQ;
    {
        const int t = tid >> 7, kk = tid & 127; const bf16_t* zr = p.z + (size_t)(r0 + t) * ZW + h * HD + kk;
        float lbv = 0.f; if (l > 0) lbv = sigmoidf_(p.lb_logits[HH * HD + h * HD + kk] - p.lb_logits[h * HD + kk]);
        const float zq = bf2f(zr[0]), zf = fminf(fmaxf(bf2f(zr[1024]), -80.f), 80.f), zi = bf2f(zr[2048]);
        const float e = __expf(-zf), sg = 1.0f / (1.0f + e);
        fS[tid] = lbv + (1.0f - lbv) * sg; kS[tid] = (1.0f - lbv) * (e * sg); qS[tid] = siluf_(zq); vS[tid] = zi;
    }
    const int v = tid & 127, kq = tid >> 7;
    const float* s0 = p.state_hgrn + ((size_t)(l * DB + b) * HH + h) * HD * HD + (size_t)(32 * kq) * HD + v;
    float S[32];
#pragma unroll
    for (int i = 0; i < 32; ++i) S[i] = s0[(size_t)i * HD];
    __syncthreads();
#pragma unroll
    for (int t = 0; t < 4; ++t) {
        const float vv = vS[t * 128 + v]; float po = 0.f;
#pragma unroll
        for (int i = 0; i < 32; ++i) { const int kk = t * 128 + 32 * kq + i; S[i] = fS[kk] * S[i] + kS[kk] * vv; po += qS[kk] * S[i]; }
        red[(t * 4 + kq) * 128 + v] = po;
    }
    float* so = p.out + OFF_HS + ((size_t)(l * DB + b) * HH + h) * HD * HD + (size_t)(32 * kq) * HD + v;
#pragma unroll
    for (int i = 0; i < 32; ++i) so[(size_t)i * HD] = S[i];
    __syncthreads();
    {
        const int t = tid >> 7; const float o = red[(t * 4 + 0) * 128 + v] + red[(t * 4 + 1) * 128 + v] + red[(t * 4 + 2) * 128 + v] + red[(t * 4 + 3) * 128 + v];
        const float ss = wave_sum(o * o);
        if (lane == 0) part[w] = ss;
        __syncthreads();
        const float tot = part[2 * t] + part[2 * t + 1];
        const float rstd = rsqrtf(tot * (1.0f / HD) + EPS);
        const float zg = bf2f(p.z[(size_t)(r0 + t) * ZW + 3072 + h * HD + v]);
        p.cat[(size_t)(r0 + t) * D + h * HD + v] = (bf16_t)f2bf(o * rstd * p.hgrn_norm_g[l * HD + v] * siluf_(zg));
    }
    __syncthreads();
}

DEV void pool_pre_unit(const Params& p, int l, int unit) {
    const int tid = threadIdx.x, tk = tid >> 7, cg = tid & 127, c = cg * 8, gi = cg >> 5, wnd = 2 << gi;
    const int r = unit * 4 + tk;
    if (r >= NTOK) return;
    f32x2 sum[4] = {{0.f, 0.f}, {0.f, 0.f}, {0.f, 0.f}, {0.f, 0.f}}; float cur[8];
    float cnt;
    if (r < NP) {
        const int t = r % SEQ; const int n = (wnd < t + 1) ? wnd : (t + 1); cnt = (float)n;
        u32x4 q[16];
#pragma unroll
        for (int j = 0; j < 16; ++j) q[j] = (j < n) ? *(const u32x4*)(p.z + (size_t)(r - j) * ZW + 4096 + c) : (u32x4){0u, 0u, 0u, 0u};
#pragma unroll
        for (int j = 0; j < 16; ++j) { sum[0] += (f32x2){lo16(q[j].x), hi16(q[j].x)}; sum[1] += (f32x2){lo16(q[j].y), hi16(q[j].y)}; sum[2] += (f32x2){lo16(q[j].z), hi16(q[j].z)}; sum[3] += (f32x2){lo16(q[j].w), hi16(q[j].w)}; }
        cur[0] = lo16(q[0].x); cur[1] = hi16(q[0].x); cur[2] = lo16(q[0].y); cur[3] = hi16(q[0].y); cur[4] = lo16(q[0].z); cur[5] = hi16(q[0].z); cur[6] = lo16(q[0].w); cur[7] = hi16(q[0].w);
        if (t >= SEQ - PBUF) { float* o = p.out + OFF_PP + ((size_t)(l * PB + r / SEQ) * PBUF + (t - (SEQ - PBUF))) * PW + c;
            *(f32x4*)o = (f32x4){cur[0], cur[1], cur[2], cur[3]}; *(f32x4*)(o + 4) = (f32x4){cur[4], cur[5], cur[6], cur[7]}; }
    } else {
        const int bb = (r - NP) / DSEQ, t = (r - NP) % DSEQ; cnt = (float)wnd;
        const float* sp = p.state_pool + (size_t)(l * DB + bb) * PBUF * PW + c;
        u32x4 q[4]; f32x4 sa[15], sb[15];
#pragma unroll
        for (int j = 0; j < 4; ++j) q[j] = (j <= t && j < wnd) ? *(const u32x4*)(p.z + (size_t)(NP + bb * DSEQ + t - j) * ZW + 4096 + c) : (u32x4){0u, 0u, 0u, 0u};
#pragma unroll
        for (int j = 1; j < 16; ++j) {
            const int back = j - t;
            const bool use = (back >= 1) && (j < wnd);
            const float* srow = sp + (size_t)(PBUF - (use ? back : 1)) * PW;
            sa[j - 1] = use ? *(const f32x4*)srow : (f32x4){0.f, 0.f, 0.f, 0.f}; sb[j - 1] = use ? *(const f32x4*)(srow + 4) : (f32x4){0.f, 0.f, 0.f, 0.f};
        }
#pragma unroll
        for (int j = 0; j < 4; ++j) { sum[0] += (f32x2){lo16(q[j].x), hi16(q[j].x)}; sum[1] += (f32x2){lo16(q[j].y), hi16(q[j].y)}; sum[2] += (f32x2){lo16(q[j].z), hi16(q[j].z)}; sum[3] += (f32x2){lo16(q[j].w), hi16(q[j].w)}; }
#pragma unroll
        for (int j = 0; j < 15; ++j) { sum[0] += (f32x2){sa[j][0], sa[j][1]}; sum[1] += (f32x2){sa[j][2], sa[j][3]}; sum[2] += (f32x2){sb[j][0], sb[j][1]}; sum[3] += (f32x2){sb[j][2], sb[j][3]}; }
        cur[0] = lo16(q[0].x); cur[1] = hi16(q[0].x); cur[2] = lo16(q[0].y); cur[3] = hi16(q[0].y); cur[4] = lo16(q[0].z); cur[5] = hi16(q[0].z); cur[6] = lo16(q[0].w); cur[7] = hi16(q[0].w);
        float* ob = p.out + OFF_PS + (size_t)(l * DB + bb) * PBUF * PW + c;
        { float* o = ob + (size_t)(11 + t) * PW; *(f32x4*)o = (f32x4){cur[0], cur[1], cur[2], cur[3]}; *(f32x4*)(o + 4) = (f32x4){cur[4], cur[5], cur[6], cur[7]}; }
        for (int i = t; i < 11; i += 4) { const float* s2 = sp + (size_t)(4 + i) * PW; float* o = ob + (size_t)i * PW; *(f32x4*)o = *(const f32x4*)s2; *(f32x4*)(o + 4) = *(const f32x4*)(s2 + 4); }
    }
    const float inv = 1.0f / cnt;
    u32x4 w; w.x = pack2(sum[0][0] * inv - cur[0], sum[0][1] * inv - cur[1]); w.y = pack2(sum[1][0] * inv - cur[2], sum[1][1] * inv - cur[3]);
    w.z = pack2(sum[2][0] * inv - cur[4], sum[2][1] * inv - cur[5]); w.w = pack2(sum[3][0] * inv - cur[6], sum[3][1] * inv - cur[7]);
    *(u32x4*)(p.pooled + ((size_t)gi * MPAD + r) * 256 + (c & 255)) = w;
}

#ifndef PROBE_SUB
#define PROBE_SUB 0
#endif
DEV void phase_mix1(const Params& p, int l, unsigned char* lds) {
    for (int rep = 0; rep < (PROBE_SUB == 1 ? 2 : 1); ++rep) for (int u = blockIdx.x; u < hg::NUNIT; u += gridDim.x) hgrn_pre_unit(p, l, u, lds);
    for (int rep = 0; rep < (PROBE_SUB == 2 ? 2 : 1); ++rep) for (int u = blockIdx.x; u < DB * HH; u += gridDim.x) hgrn_sample_unit(p, l, u, lds);
    for (int rep = 0; rep < (PROBE_SUB == 3 ? 2 : 1); ++rep) for (int u = blockIdx.x; u < (NTOK + 3) / 4; u += gridDim.x) pool_pre_unit(p, l, u);
}
DEV void phase_mix2(const Params& p, int l) { for (int u = blockIdx.x; u < PB * HH * 8; u += gridDim.x) hgrn_scan_unit(p, l, u); }
DEV void phase_mix3(const Params& p, int l, unsigned char* lds) { for (int u = blockIdx.x; u < hg::NUNIT; u += gridDim.x) hgrn_post_unit(p, l, u, lds); }

#ifdef HIPEMU
#define MBCNT(mask) __builtin_popcountll((mask) & ((1ull << emu_lane()) - 1ull))
#define POPC64(m) __builtin_popcountll(m)
#else
#define MBCNT(mask) ((int)__builtin_amdgcn_mbcnt_hi((unsigned)((mask) >> 32), __builtin_amdgcn_mbcnt_lo((unsigned)(mask), 0u)))
#define POPC64(m) __popcll(m)
#endif
DEV unsigned fkey(float f) { const unsigned u = __float_as_uint(f); return u ^ ((unsigned)((int)u >> 31) | 0x80000000u); }
DEV unsigned long long lowest_n_bits(unsigned long long m, int n) { unsigned long long r = 0ull; while (n > 0 && m) { const unsigned long long b = m & (~m + 1ull); r |= b; m ^= b; --n; } return r; }
#ifdef HIPEMU
#define DPPU_XOR1(v) __shfl((v), emu_lane() ^ 1)
#define DPPU_XOR2(v) __shfl((v), emu_lane() ^ 2)
#define DPPU_HMIRROR(v) __shfl((v), (emu_lane() & ~7) | (7 - (emu_lane() & 7)))
#else
template <int CTRL> DEV unsigned dpp_u(unsigned v) { return (unsigned)__builtin_amdgcn_update_dpp(0, (int)v, CTRL, 0xf, 0xf, true); }
#define DPPU_XOR1(v) dpp_u<0xB1>(v)
#define DPPU_XOR2(v) dpp_u<0x4E>(v)
#define DPPU_HMIRROR(v) dpp_u<0x141>(v)
#endif
template <int GL> DEV unsigned group_sum(unsigned c) { c += DPPU_XOR1(c); c += DPPU_XOR2(c); if (GL == 8) c += DPPU_HMIRROR(c); return c; }
template <int GL> DEV unsigned group_or(unsigned c) { c |= DPPU_XOR1(c); c |= DPPU_XOR2(c); if (GL == 8) c |= DPPU_HMIRROR(c); return c; }
template <int GL> DEV float group_maxf(float v) { v = fmaxf(v, DPP_XOR1(v)); v = fmaxf(v, DPP_XOR2(v)); if (GL == 8) v = fmaxf(v, DPP_HMIRROR(v)); return v; }
template <int GL> DEV float group_sumf(float v) { v += DPP_XOR1(v); v += DPP_XOR2(v); if (GL == 8) v += DPP_HMIRROR(v); return v; }
DEV unsigned bytesum(unsigned w) { return (w * 0x01010101u) >> 24; }
template <int GL> DEV unsigned group_excl_prefix(unsigned c, int sub) {
    const unsigned sh = 8u * (unsigned)(sub & 3);
    unsigned wlo = (GL == 4 || sub < 4) ? (c << sh) : 0u, whi = (GL == 8 && sub >= 4) ? (c << sh) : 0u;
    wlo = group_or<GL>(wlo);
    unsigned r;
    if (GL == 4) r = bytesum(wlo & ((1u << sh) - 1u));
    else { whi = group_or<GL>(whi); r = sub < 4 ? bytesum(wlo & ((1u << sh) - 1u)) : bytesum(wlo) + bytesum(whi & ((1u << sh) - 1u)); }
    return r;
}
DEV float fkey_inv(unsigned k) { return __uint_as_float((k & 0x80000000u) ? (k ^ 0x80000000u) : ~k); }
template <int GL> DEV unsigned group_top16(const unsigned (&k)[32], bool active, int sub, unsigned& pos0) {
    unsigned mxk = 0u;
#pragma unroll
    for (int i = 0; i < 32; ++i) mxk = k[i] > mxk ? k[i] : mxk;
    { unsigned o = DPPU_XOR1(mxk); mxk = o > mxk ? o : mxk; o = DPPU_XOR2(mxk); mxk = o > mxk ? o : mxk; if (GL == 8) { o = DPPU_HMIRROR(mxk); mxk = o > mxk ? o : mxk; } }
    unsigned L0 = mxk > 0x01000000u ? mxk - 0x01000000u : 0u, c0 = 0u;
#pragma unroll
    for (int i = 0; i < 32; ++i) c0 += (k[i] > L0) ? 1u : 0u;
    c0 = group_sum<GL>(c0);
    unsigned L = c0 > 16u ? L0 + 1u : 0u, R = active ? mxk : 0u, cR = 0u;
    if (!active) L = 0u;
    if (c0 == 16u && active) { L = L0; R = L0; cR = 16u; }
    for (;;) {
        if (__ballot(L < R) == 0ull) break;
        const unsigned mid = L + ((R - L) >> 1);
        unsigned c = 0u;
#pragma unroll
        for (int i = 0; i < 32; ++i) c += (k[i] > mid) ? 1u : 0u;
        c = group_sum<GL>(c);
        const bool le = c <= 16u, hit = c == 16u;
        R = le ? mid : R; cR = le ? c : cR; L = hit ? mid : (le ? L : mid + 1u);
    }
    unsigned mask = 0u;
#pragma unroll
    for (int i = 0; i < 32; ++i) mask |= (k[i] > R) ? (1u << i) : 0u;
    const unsigned need = 16u - cR;
    if (__ballot(active && need > 0u) != 0ull) {
        unsigned eqm = 0u;
#pragma unroll
        for (int i = 0; i < 32; ++i) eqm |= (k[i] == R) ? (1u << i) : 0u;
        const unsigned eqc = (unsigned)__builtin_popcount(eqm), before = group_excl_prefix<GL>(eqc, sub);
        unsigned take = need > before ? need - before : 0u; if (take > eqc) take = eqc;
        if (!active) take = 0u;
        while (take > 0u) { const unsigned b = eqm & (~eqm + 1u); mask |= b; eqm ^= b; --take; }
    }
    if (!active) mask = 0u;
    pos0 = group_excl_prefix<GL>((unsigned)__builtin_popcount(mask), sub);
    return mask;
}
constexpr int SEL_NT = 4;
constexpr int SEL_RS = 144;
DEV void select_step(const Params& p, int l, int tt0, int tstride, int ntile, int h, unsigned char* lds, const bf16x8 (&kh)[2][4], const bf16x8 (&kl)[2][4]) {
    const int tid = threadIdx.x, lane = tid & 63, w = tid >> 6, g = lane >> 4, c16 = lane & 15;
    constexpr int NTK = SEL_NT * 16;
    constexpr int QRS = 264;
    bf16_t* qh = (bf16_t*)lds;
    bf16_t* ql = qh + NTK * QRS;
    float* sc = (float*)(ql + NTK * QRS);
    float* ts = sc + 2 * NTK * SEL_RS;
    int* ti = (int*)(ts + 2 * NTK * 16);
#pragma unroll
    for (int k = 0; k < SEL_NT; ++k) {
        const int tk = tid >> 5, part = tid & 31; const int tok = (tt0 + k * tstride) * 16 + tk;
        f32x4 a = (f32x4){0.f, 0.f, 0.f, 0.f}, b2 = a;
        if (k < ntile && tok < NTOK) { const float* q = p.qry + (size_t)tok * D + h * 256 + part * 8; a = *(const f32x4*)q; b2 = *(const f32x4*)(q + 4); }
        float ss = a[0] * a[0] + a[1] * a[1] + a[2] * a[2] + a[3] * a[3] + b2[0] * b2[0] + b2[1] * b2[1] + b2[2] * b2[2] + b2[3] * b2[3];
        ss += __shfl_xor(ss, 1); ss += __shfl_xor(ss, 2); ss += __shfl_xor(ss, 4); ss += __shfl_xor(ss, 8);
        const float rn = rsqrtf(ss * (1.0f / 128.0f) + EPS);
        const float v[8] = {a[0] * rn, a[1] * rn, a[2] * rn, a[3] * rn, b2[0] * rn, b2[1] * rn, b2[2] * rn, b2[3] * rn};
        unsigned hi[4], lo[4];
#pragma unroll
        for (int j = 0; j < 4; ++j) { hi[j] = pack2(v[2 * j], v[2 * j + 1]); lo[j] = pack2(v[2 * j] - lo16(hi[j]), v[2 * j + 1] - hi16(hi[j])); }
        *(u32x4*)(qh + (k * 16 + tk) * QRS + part * 8) = (u32x4){hi[0], hi[1], hi[2], hi[3]}; *(u32x4*)(ql + (k * 16 + tk) * QRS + part * 8) = (u32x4){lo[0], lo[1], lo[2], lo[3]};
    }
    __syncthreads();
    for (int k = 0; k < ntile; ++k) {
#pragma unroll
        for (int ph = 0; ph < 2; ++ph) {
            f32x4 acc = (f32x4){0.f, 0.f, 0.f, 0.f};
#pragma unroll
            for (int ks = 0; ks < 4; ++ks) {
                const bf16x8 ah = *(const bf16x8*)(qh + (k * 16 + c16) * QRS + ph * 128 + 32 * ks + 8 * g), al = *(const bf16x8*)(ql + (k * 16 + c16) * QRS + ph * 128 + 32 * ks + 8 * g);
                acc = MFMA_BF16(al, kh[ph][ks], acc); acc = MFMA_BF16(ah, kl[ph][ks], acc); acc = MFMA_BF16(ah, kh[ph][ks], acc);
            }
            const int kidx = 16 * w + c16;
#pragma unroll
            for (int r = 0; r < 4; ++r) sc[(ph * NTK + k * 16 + 4 * g + r) * SEL_RS + (kidx >> 5) * 36 + (kidx & 31)] = acc[r];
        }
    }
    __syncthreads();
    {
        const int row = tid >> 2, sub = tid & 3; const bool active = ((row % NTK) >> 4) < ntile;
        unsigned k[32];
#pragma unroll
        for (int i4 = 0; i4 < 8; ++i4) { const f32x4 v = *(const f32x4*)(sc + row * SEL_RS + sub * 36 + 4 * i4); k[4 * i4] = fkey(v[0]); k[4 * i4 + 1] = fkey(v[1]); k[4 * i4 + 2] = fkey(v[2]); k[4 * i4 + 3] = fkey(v[3]); }
        unsigned pos; const unsigned mask = group_top16<4>(k, active, sub, pos);
#pragma unroll
        for (int i = 0; i < 32; ++i) if ((mask >> i) & 1u) { if (pos < 16u) { ts[row * 16 + pos] = fkey_inv(k[i]); ti[row * 16 + pos] = 32 * sub + i; } ++pos; }
    }
    __syncthreads();
    {
        const int tk = tid >> 3, sub = tid & 7; const bool active = (tk >> 4) < ntile; const int tok = (tt0 + (tk >> 4) * tstride) * 16 + (tk & 15);
        const float s1a = ts[tk * 16 + 2 * sub], s1b = ts[tk * 16 + 2 * sub + 1];
        unsigned k[32];
#pragma unroll
        for (int j4 = 0; j4 < 4; ++j4) { const f32x4 s2 = *(const f32x4*)(ts + (NTK + tk) * 16 + 4 * j4);
#pragma unroll
            for (int j = 0; j < 4; ++j) { k[4 * j4 + j] = fkey(s1a + s2[j]); k[16 + 4 * j4 + j] = fkey(s1b + s2[j]); } }
        unsigned pos; const unsigned mask = group_top16<8>(k, active, sub, pos);
        const int i1a = ti[tk * 16 + 2 * sub], i1b = ti[tk * 16 + 2 * sub + 1];
        int i2v[16];
#pragma unroll
        for (int j4 = 0; j4 < 4; ++j4) { const u32x4 t4 = *(const u32x4*)(ti + (NTK + tk) * 16 + 4 * j4); i2v[4 * j4] = (int)t4.x; i2v[4 * j4 + 1] = (int)t4.y; i2v[4 * j4 + 2] = (int)t4.z; i2v[4 * j4 + 3] = (int)t4.w; }
        u32x2* lst = (u32x2*)sc;
#pragma unroll
        for (int i = 0; i < 32; ++i) if ((mask >> i) & 1u) { if (pos < 16u) lst[tk * 16 + pos] = (u32x2){__float_as_uint(fkey_inv(k[i])), (unsigned)((i < 16 ? i1a : i1b) * 128 + i2v[i & 15])}; ++pos; }
    }
    __syncthreads();
#pragma unroll
    for (int r = 0; r < NTK / 32; ++r) {
        const int tk = (tid >> 4) + 32 * r, slot = tid & 15; const int tok = (tt0 + (tk >> 4) * tstride) * 16 + (tk & 15);
        const u32x2 en = ((const u32x2*)sc)[tk * 16 + slot];
        const float v = __uint_as_float(en.x); const int e = (int)en.y;
        float mx = v; mx = fmaxf(mx, DPP_XOR1(mx)); mx = fmaxf(mx, DPP_XOR2(mx)); mx = fmaxf(mx, DPP_HMIRROR(mx)); mx = fmaxf(mx, DPP_RMIRROR(mx));
        const float ex = __expf(v - mx);
        float sm = ex; sm += DPP_XOR1(sm); sm += DPP_XOR2(sm); sm += DPP_HMIRROR(sm); sm += DPP_RMIRROR(sm);
        if ((tk >> 4) < ntile && tok < NTOK) { const size_t o = (size_t)tok * 128 + h * 16 + slot;
            p.eidx[o] = (unsigned short)e; p.gate[o] = ex / sm * p.sv[l * NE + e]; p.iscu[o] = p.su[l * NE + e]; }
    }
    __syncthreads();
}
DEV void phase_select(const Params& p, int l, unsigned char* lds) {
    const int ntt = (NTOK + 15) / 16, lane = threadIdx.x & 63, w = threadIdx.x >> 6, g = lane >> 4, c16 = lane & 15;
    const bool fixed = (gridDim.x % 8u) == 0u;
    const int nq = fixed ? (int)(gridDim.x >> 3) : 1;
    for (int hh = 0; hh < (fixed ? 1 : 8); ++hh) {
        const int h = fixed ? (int)(blockIdx.x & 7) : hh;
        bf16x8 kh[2][4], kl[2][4];
#pragma unroll
        for (int ph = 0; ph < 2; ++ph)
#pragma unroll
            for (int ks = 0; ks < 4; ++ks) { const float* kr = p.peer_keys + ((size_t)((l * 8 + h) * 2 + ph) * 128 + 16 * w + c16) * 128 + 32 * ks + 8 * g;
                const f32x4 a = *(const f32x4*)kr, b2 = *(const f32x4*)(kr + 4); const float v[8] = {a[0], a[1], a[2], a[3], b2[0], b2[1], b2[2], b2[3]};
                u32x4 hi, lo; unsigned hw[4], lw[4];
#pragma unroll
                for (int j = 0; j < 4; ++j) { hw[j] = pack2(v[2 * j], v[2 * j + 1]); lw[j] = pack2(v[2 * j] - lo16(hw[j]), v[2 * j + 1] - hi16(hw[j])); }
                hi = (u32x4){hw[0], hw[1], hw[2], hw[3]}; lo = (u32x4){lw[0], lw[1], lw[2], lw[3]};
                kh[ph][ks] = __builtin_bit_cast(bf16x8, hi); kl[ph][ks] = __builtin_bit_cast(bf16x8, lo); }
        const int first = fixed ? (int)(blockIdx.x >> 3) : (int)blockIdx.x, stride = fixed ? nq : (int)gridDim.x;
        for (int tt0 = first; tt0 < ntt; tt0 += SEL_NT * stride) {
            int ntile = 0;
#pragma unroll
            for (int k = 0; k < SEL_NT; ++k) if (tt0 + k * stride < ntt) ntile = k + 1;
            select_step(p, l, tt0, stride, ntile, h, lds, kh, kl);
        }
    }
}

constexpr int PEER_TB = 272;
struct PeerDeal { int xs_first, xs_step, t_begin, t_end; };
DEV PeerDeal peer_deal() {
    PeerDeal d; const bool sl = (gridDim.x % 8u) == 0u;
    const int nranks = sl ? (int)(gridDim.x >> 3) : (int)gridDim.x, rank = sl ? (int)(blockIdx.x >> 3) : (int)blockIdx.x, tpr = (NTOK + nranks - 1) / nranks;
    d.xs_first = sl ? (int)(blockIdx.x & 7) : 0; d.xs_step = sl ? 8 : 1; d.t_begin = rank * tpr; d.t_end = d.t_begin + tpr < NTOK ? d.t_begin + tpr : NTOK;
    return d;
}
struct PeerTok { u32x4 e0, e1, ha, hb; };
DEV void peer_fetch_u(const Params& p, int t, int c0, int g8, PeerTok& k) {
    const u32x4* ep = (const u32x4*)(p.eidx + (size_t)t * 128 + 16 * g8); k.e0 = ep[0]; k.e1 = ep[1];
    k.ha = *(const u32x4*)(p.hB + (size_t)t * D + c0); k.hb = *(const u32x4*)(p.hB + (size_t)t * D + c0 + 8);
}
DEV void phase_peer_u(const Params& p, int l, unsigned char* lds) {
    const int lane = threadIdx.x & 63, w = threadIdx.x >> 6, j8 = lane & 7, g8 = lane >> 3;
    const bool b2 = (j8 & 4) != 0, b1 = (j8 & 2) != 0, b0 = (j8 & 1) != 0;
    const PeerDeal dl = peer_deal();
    const unsigned char* U = p.u8 + (size_t)l * NE * D;
    float* lp = (float*)lds;
    for (int xs = dl.xs_first; xs < 8; xs += dl.xs_step)
    for (int t0 = dl.t_begin; t0 < dl.t_end; t0 += PEER_TB) {
        const int nb = dl.t_end - t0 < PEER_TB ? dl.t_end - t0 : PEER_TB;
        for (int ch = 0; ch < 2; ++ch) {
            const int c0 = 256 * xs + 128 * ch + 16 * j8;
            const unsigned char* Us = U + (size_t)(2 * xs + ch) * NE * 128 + 16 * j8;
            PeerTok nx; if (w < nb) peer_fetch_u(p, t0 + w, c0, g8, nx);
            for (int tk = w; tk < nb; tk += 8) {
                const int t = t0 + tk;
                const PeerTok cu = nx;
                const unsigned ew[8] = {cu.e0.x, cu.e0.y, cu.e0.z, cu.e0.w, cu.e1.x, cu.e1.y, cu.e1.z, cu.e1.w}; unsigned ev[16];
#pragma unroll
                for (int i = 0; i < 8; ++i) { ev[2 * i] = ew[i] & 0xffffu; ev[2 * i + 1] = ew[i] >> 16; }
                u32x4 q[16];
#pragma unroll
                for (int i = 0; i < 16; ++i) q[i] = *(const u32x4*)(Us + (size_t)ev[i] * 128);
                if (tk + 8 < nb) peer_fetch_u(p, t + 8, c0, g8, nx);
                const u32x4 ha = cu.ha, hb = cu.hb;
                const f32x2 hf[8] = {{lo16(ha.x), hi16(ha.x)}, {lo16(ha.y), hi16(ha.y)}, {lo16(ha.z), hi16(ha.z)}, {lo16(ha.w), hi16(ha.w)}, {lo16(hb.x), hi16(hb.x)}, {lo16(hb.y), hi16(hb.y)}, {lo16(hb.z), hi16(hb.z)}, {lo16(hb.w), hi16(hb.w)}};
                float ps[16];
#pragma unroll
                for (int i = 0; i < 16; ++i) { f32x2 dq[8]; fp8x16_dec2(q[i], dq); f32x2 a = dq[0] * hf[0];
#pragma unroll
                    for (int k = 1; k < 8; ++k) a = __builtin_elementwise_fma(dq[k], hf[k], a);
                    ps[i] = a[0] + a[1]; }
                float q8[8], q4[4], q2[2];
#pragma unroll
                for (int k = 0; k < 8; ++k) { const float keep = b2 ? ps[8 + k] : ps[k], send = b2 ? ps[k] : ps[8 + k]; q8[k] = keep + DPP_HMIRROR(send); }
#pragma unroll
                for (int k = 0; k < 4; ++k) { const float keep = b1 ? q8[4 + k] : q8[k], send = b1 ? q8[k] : q8[4 + k]; q4[k] = keep + DPP_XOR2(send); }
#pragma unroll
                for (int k = 0; k < 2; ++k) { const float keep = b0 ? q4[2 + k] : q4[k], send = b0 ? q4[k] : q4[2 + k]; q2[k] = keep + DPP_XOR1(send); }
                float* lrow = lp + tk * 128 + 16 * g8 + 2 * j8;
                if (ch == 0) { lrow[0] = q2[0]; lrow[1] = q2[1]; }
                else { const size_t o = (size_t)t * 128 + 16 * g8 + 2 * j8;
                    float* dst = p.part + ((size_t)t * 8 + xs) * 128 + 16 * g8 + 2 * j8;
                    dst[0] = (q2[0] + lrow[0]) * p.iscu[o]; dst[1] = (q2[1] + lrow[1]) * p.iscu[o + 1]; }
            }
        }
    }
}
DEV void phase_peer_c(const Params& p) {
    const size_t n = (size_t)NTOK * 128, gs = (size_t)gridDim.x * 512;
    for (size_t i = (size_t)blockIdx.x * 512 + threadIdx.x; i < n; i += gs) {
        const size_t t = i >> 7; const int pr = (int)(i & 127); float sacc = 0.f;
#pragma unroll
        for (int x = 0; x < 8; ++x) sacc += p.part[(t * 8 + x) * 128 + pr];
        p.ab16[i] = (bf16_t)f2bf(gelu_erf(sacc) * p.gate[i]);
    }
}
struct PeerTokV { u32x4 e0, e1, a0, a1; f32x2 x1, g2; };
DEV void peer_fetch_v(const Params& p, int l, int t, int col, int g8, PeerTokV& k) {
    const u32x4* ep = (const u32x4*)(p.eidx + (size_t)t * 128 + 16 * g8); k.e0 = ep[0]; k.e1 = ep[1];
    const u32x4* ap = (const u32x4*)(p.ab16 + (size_t)t * 128 + 16 * g8); k.a0 = ap[0]; k.a1 = ap[1];
    k.x1 = *(const f32x2*)(p.xa + (size_t)t * D + col); k.g2 = *(const f32x2*)(p.modbuf + (size_t)tok_batch(t) * MODW + l * NMOD + 5 * D + col);
}
DEV void phase_peer_v(const Params& p, int l, unsigned char* lds) {
    const int lane = threadIdx.x & 63, w = threadIdx.x >> 6, j8 = lane & 7, g8 = lane >> 3;
    const bool b3 = (g8 & 1) != 0, b4 = (g8 & 2) != 0, b5 = (g8 & 4) != 0;
    const PeerDeal dl = peer_deal();
    const unsigned char* V = p.v8 + (size_t)l * NE * D;
    for (int xs = dl.xs_first; xs < 8; xs += dl.xs_step)
        for (int ch = 0; ch < 2; ++ch) {
            const int c0 = 256 * xs + 128 * ch + 16 * j8, col = c0 + (b3 ? 8 : 0) + (b4 ? 4 : 0) + (b5 ? 2 : 0);
            const unsigned char* Vs = V + (size_t)(2 * xs + ch) * NE * 128 + 16 * j8;
            PeerTokV nx; if (dl.t_begin + w < dl.t_end) peer_fetch_v(p, l, dl.t_begin + w, col, g8, nx);
            for (int t = dl.t_begin + w; t < dl.t_end; t += 8) {
                const PeerTokV cu = nx;
                const unsigned ew[8] = {cu.e0.x, cu.e0.y, cu.e0.z, cu.e0.w, cu.e1.x, cu.e1.y, cu.e1.z, cu.e1.w}; unsigned ev[16];
#pragma unroll
                for (int i = 0; i < 8; ++i) { ev[2 * i] = ew[i] & 0xffffu; ev[2 * i + 1] = ew[i] >> 16; }
                u32x4 q[16];
#pragma unroll
                for (int i = 0; i < 16; ++i) q[i] = *(const u32x4*)(Vs + (size_t)ev[i] * 128);
                if (t + 8 < dl.t_end) peer_fetch_v(p, l, t + 8, col, g8, nx);
                const unsigned aw[8] = {cu.a0.x, cu.a0.y, cu.a0.z, cu.a0.w, cu.a1.x, cu.a1.y, cu.a1.z, cu.a1.w}; float av[16];
#pragma unroll
                for (int i = 0; i < 8; ++i) { av[2 * i] = lo16(aw[i]); av[2 * i + 1] = hi16(aw[i]); }
                f32x2 acc2[8];
#pragma unroll
                for (int k = 0; k < 8; ++k) acc2[k] = (f32x2){0.f, 0.f};
#pragma unroll
                for (int i = 0; i < 16; ++i) { f32x2 dq[8]; fp8x16_dec2(q[i], dq); const f32x2 a2v = (f32x2){av[i], av[i]};
#pragma unroll
                    for (int k = 0; k < 8; ++k) acc2[k] = __builtin_elementwise_fma(a2v, dq[k], acc2[k]); }
                float acc[16];
#pragma unroll
                for (int k = 0; k < 8; ++k) { acc[2 * k] = acc2[k][0]; acc[2 * k + 1] = acc2[k][1]; }
                float q8[8], q4[4], q2[2];
#pragma unroll
                for (int k = 0; k < 8; ++k) { const float keep = b3 ? acc[8 + k] : acc[k], send = b3 ? acc[k] : acc[8 + k]; q8[k] = keep + DPP_XOR8(send); }
#pragma unroll
                for (int k = 0; k < 4; ++k) q4[k] = xsum16(q8[k], q8[4 + k]);
#pragma unroll
                for (int k = 0; k < 2; ++k) q2[k] = xsum32(q4[k], q4[2 + k]);
                f32x2 o; o[0] = cu.x1[0] + cu.g2[0] * q2[0]; o[1] = cu.x1[1] + cu.g2[1] * q2[1];
                *(f32x2*)(p.xb + (size_t)t * D + col) = o;
            }
        }
}

constexpr int N_PHASES = 29;
DEV int phase_class(int k) { return k < 2 ? k : (k == 28 ? 15 : 2 + (k - 2) % 13); }
#ifndef HIPEMU
#define XB_TMO      128
#define XB_XCNT(j)  (256  + 64 * (j))
#define XB_XSUB(j)  (1280 + 64 * (j))
#define XB_XGEN(j)  (2304 + 64 * (j))
#define XB_TOP      3328
#define XB_TOPGEN   3392
#define XCD_BAR_WORDS 3456
#define XB_SPIN_CAP (1u << 22)
__device__ __forceinline__ unsigned xb_ld(unsigned* p)              { return __hip_atomic_load(p, __ATOMIC_RELAXED, __HIP_MEMORY_SCOPE_AGENT); }
__device__ __forceinline__ unsigned xb_add(unsigned* p, unsigned v) { return __hip_atomic_fetch_add(p, v, __ATOMIC_RELAXED, __HIP_MEMORY_SCOPE_AGENT); }
__device__ __forceinline__ unsigned xb_xcc_id() { return (unsigned)__builtin_amdgcn_s_getreg((3 << 11) | 20) & 0xFu; }
#define XB_SPIN(cond, bar) do { unsigned _sp = 0; while (cond) { __builtin_amdgcn_s_sleep(1); \
    if ((++_sp & 255u) == 0u) { if (xb_ld(&(bar)[XB_TMO])) break; if (_sp > XB_SPIN_CAP) { atomicAdd(&(bar)[XB_TMO], 1u); break; } } } } while (0)
struct XcdBarrier { unsigned* bar; unsigned x; volatile LAS unsigned* st; };
__device__ __forceinline__ XcdBarrier xcd_barrier_post(unsigned* bar, volatile LAS unsigned* st) {
    XcdBarrier b; b.bar = bar; b.x = xb_xcc_id(); b.st = st;
    if (threadIdx.x == 0) (void)xb_add(&bar[XB_XCNT(b.x)], 1u);
    return b;
}
__device__ __forceinline__ void xcd_barrier_complete(unsigned* bar, unsigned x, unsigned& nloc, unsigned& nx) {
    const unsigned G = gridDim.x * gridDim.y * gridDim.z;
    unsigned sum, cnt, mine, sp = 0u;
    for (;;) {
        sum = 0u; cnt = 0u; mine = 0u;
#pragma unroll
        for (unsigned j = 0; j < 16; ++j) { const unsigned c = xb_ld(&bar[XB_XCNT(j)]); sum += c; cnt += (c > 0u) ? 1u : 0u; mine = (j == x) ? c : mine; }
        if (sum == G) break;
        __builtin_amdgcn_s_sleep(1);
        if ((++sp & 255u) == 0u) { if (xb_ld(&bar[XB_TMO])) break; if (sp > XB_SPIN_CAP) { atomicAdd(&bar[XB_TMO], 1u); break; } }
    }
    nloc = mine > 0u ? mine : 1u; nx = cnt > 0u ? cnt : 1u;
}
__device__ __forceinline__ void xcd_barrier(const XcdBarrier& b) {
    asm volatile("s_waitcnt vmcnt(0)" ::: "memory");
    __syncthreads();
    if (threadIdx.x == 0) {
        unsigned* bar = b.bar;
        __builtin_amdgcn_s_waitcnt(0);
        unsigned nloc = b.st[0], nx = b.st[1];
        if (nloc == 0u) { xcd_barrier_complete(bar, b.x, nloc, nx); b.st[0] = nloc; b.st[1] = nx; }
        const unsigned old = xb_add(&bar[XB_XSUB(b.x)], 1u);
        const unsigned gen = old / nloc;
        if (old + 1u == (gen + 1u) * nloc) {
            __builtin_amdgcn_fence(__ATOMIC_RELEASE, "agent");
            asm volatile("s_waitcnt vmcnt(0)" ::: "memory");
            const unsigned og = xb_add(&bar[XB_TOP], 1u);
            const unsigned tg = og / nx;
            if (og + 1u == (tg + 1u) * nx) xb_add(&bar[XB_TOPGEN], 1u);
            else XB_SPIN(xb_ld(&bar[XB_TOPGEN]) == tg, bar);
            __builtin_amdgcn_fence(__ATOMIC_ACQUIRE, "agent");
            xb_add(&bar[XB_XGEN(b.x)], 1u);
            asm volatile("s_waitcnt vmcnt(0)" ::: "memory");
        } else {
            XB_SPIN(xb_ld(&bar[XB_XGEN(b.x)]) == gen, bar);
            __builtin_amdgcn_fence(__ATOMIC_ACQUIRE, "agent");
            asm volatile("s_waitcnt vmcnt(0)" ::: "memory");
        }
    }
    __syncthreads();
}
#endif

constexpr int LDS_BYTES = 163840;
constexpr int LDS_BARW = LDS_BYTES - 16;

#ifndef PH_MASK
#define PH_MASK 0xFFFFFFFFu
#endif
#ifndef PROBE_DUP
#define PROBE_DUP 0u
#endif
#define DUP_N(k) (1 + (int)((PROBE_DUP >> phase_class(k)) & 1u))
#define PH_BIT(k) ((PH_MASK >> phase_class(k)) & 1u)
#ifdef HIPEMU
static void run_phase(const Params& pp, int ph, unsigned char* lds)
#define GRID_BAR() do {} while (0)
#define IN(k) (ph == (k))
#define GLDS lds
#define LOADP() const Params& p = pp
#else
typedef const __attribute__((address_space(4))) unsigned char* kargp_t;
__device__ __forceinline__ kargp_t karg_ptr() { kargp_t kp = (kargp_t)__builtin_amdgcn_kernarg_segment_ptr(); asm volatile("" : "+s"(kp)); return kp; }
#define LOADP() Params p; __builtin_memcpy(&p, karg_ptr(), sizeof(Params))
#define IN(k) (PH_BIT(k) && ph_lo <= (k) && (k) < ph_hi)
#define GLDS ((LAS unsigned char*)lds_raw)
__global__ void __launch_bounds__(512, 2) mega_fwd(Params p_unused)
#endif
{
#ifndef HIPEMU
    extern __shared__ __attribute__((aligned(16))) unsigned char lds_raw[];
    unsigned char* lds = lds_raw;
    if (threadIdx.x == 0) { *(volatile unsigned*)(lds_raw + LDS_BARW) = 0u; *(volatile unsigned*)(lds_raw + LDS_BARW + 4) = 0u; }
    __syncthreads();
    int ph_lo, ph_hi; XcdBarrier bar;
    { LOADP(); ph_lo = p.ph_lo; ph_hi = p.ph_hi; bar.bar = p.bar; bar.x = 0; bar.st = nullptr; }
    const bool multi = (ph_hi - ph_lo) > 1;
    if (multi) bar = xcd_barrier_post(bar.bar, (volatile LAS unsigned*)(lds_raw + LDS_BARW));
#define GRID_BAR() do { if (multi) xcd_barrier(bar); } while (0)
#endif
    if (IN(0)) { for (int rep = 0; rep < DUP_N(0); ++rep) { LOADP(); phase_convert(p, lds); GRID_BAR(); } }
    if (IN(1)) {
        LOADP();
        pg8::Gemm g{p.csil, p.wt_ada, 256, MODW, D}; pg8::StaticOrder S; S.init(256, MODW, gridDim.x, blockIdx.x);
        pg8::EpiAda E{p.modbuf, p.b_ada, p.b_ada_final};
        pg8::gemm_phase<pg8::EpiAda, pg8::StaticOrder>(GLDS, g, S, E);
        GRID_BAR();
    }
#define LAYER(l) do { \
        constexpr int base = 2 + 13 * (l); \
        if (IN(base + 0)) { for (int rep = 0; rep < DUP_N(base + 0); ++rep) { LOADP(); phase_norm(p, (l) == 0 ? p.x_prompt : p.xb, (l) == 0 ? p.x_sample : p.xb + (size_t)NP * D, p.norm1_g + (l) * D, (l) * NMOD + 0 * D, (l) * NMOD + 1 * D, p.hA, nullptr); GRID_BAR(); } } \
        if (IN(base + 1)) { for (int rep = 0; rep < DUP_N(base + 1); ++rep) { LOADP(); \
            pg8::Gemm g{p.hA, p.wt_in + (size_t)(l) * ZW * D, MPAD, ZW, D}; pg8::StaticOrder S; S.init(MPAD, ZW, gridDim.x, blockIdx.x); \
            pg8::EpiBf16 E{p.z, ZW}; \
            pg8::gemm_phase<pg8::EpiBf16, pg8::StaticOrder>(GLDS, g, S, E); \
            GRID_BAR(); } } \
        if (IN(base + 2)) { for (int rep = 0; rep < DUP_N(base + 2); ++rep) { LOADP(); phase_mix1(p, (l), lds); GRID_BAR(); } } \
        if (IN(base + 3)) { for (int rep = 0; rep < DUP_N(base + 3); ++rep) { LOADP(); phase_mix2(p, (l)); GRID_BAR(); } } \
        if (IN(base + 4)) { for (int rep = 0; rep < DUP_N(base + 4); ++rep) { LOADP(); phase_mix3(p, (l), lds); GRID_BAR(); } } \
        if (IN(base + 5)) { for (int rep = 0; rep < DUP_N(base + 5); ++rep) { LOADP(); \
            pg8::Gemm g{p.pooled, p.wt_pool + (size_t)(l) * 1024 * 256, 4 * MPAD, 1024, 256}; pg8::PoolOrder S{(int)gridDim.x, (int)blockIdx.x}; \
            pg8::EpiPool E{p.cat, p.pool_b + (l) * PW, p.pool_scale + (l) * PW}; \
            pg8::gemm_phase<pg8::EpiPool, pg8::PoolOrder>(GLDS, g, S, E); \
            GRID_BAR(); } } \
        if (IN(base + 6)) { for (int rep = 0; rep < DUP_N(base + 6); ++rep) { LOADP(); \
            pg8::Gemm g{p.cat, p.wt_out + (size_t)(l) * D * D, MBIG, D, D}; pg8::StaticOrder S; S.init(MBIG, D, gridDim.x, blockIdx.x); \
            pg8::EpiResid E{(l) == 0 ? p.x_prompt : p.xb, (l) == 0 ? p.x_sample : p.xb + (size_t)NP * D, p.modbuf + (l) * NMOD + 2 * D, p.xa}; \
            pg8::gemm_phase<pg8::EpiResid, pg8::StaticOrder>(GLDS, g, S, E); \
            { SmallResid sf{E.xlo, E.xhi, E.gmod, E.out}; small_gemm(p.cat, p.wt_out + (size_t)(l) * D * D, D, lds, sf); } \
            GRID_BAR(); } } \
        if (IN(base + 7)) { for (int rep = 0; rep < DUP_N(base + 7); ++rep) { LOADP(); phase_norm(p, p.xa, p.xa + (size_t)NP * D, p.norm2_g + (l) * D, (l) * NMOD + 3 * D, (l) * NMOD + 4 * D, p.hB, nullptr); GRID_BAR(); } } \
        if (IN(base + 8)) { for (int rep = 0; rep < DUP_N(base + 8); ++rep) { LOADP(); \
            pg8::Gemm g{p.hB, p.wt_q + (size_t)(l) * D * D, MBIG, D, D}; pg8::StaticOrder S; S.init(MBIG, D, gridDim.x, blockIdx.x); \
            pg8::EpiF32 E{p.qry, D}; \
            pg8::gemm_phase<pg8::EpiF32, pg8::StaticOrder>(GLDS, g, S, E); \
            { SmallF32 sf{p.qry}; small_gemm(p.hB, p.wt_q + (size_t)(l) * D * D, D, lds, sf); } \
            GRID_BAR(); } } \
        if (IN(base + 9)) { for (int rep = 0; rep < DUP_N(base + 9); ++rep) { LOADP(); phase_select(p, (l), lds); GRID_BAR(); } } \
        if (IN(base + 10)) { for (int rep = 0; rep < DUP_N(base + 10); ++rep) { LOADP(); phase_peer_u(p, (l), lds); GRID_BAR(); } } \
        if (IN(base + 11)) { LOADP(); phase_peer_c(p); GRID_BAR(); } \
        if (IN(base + 12)) { for (int rep = 0; rep < DUP_N(base + 12); ++rep) { LOADP(); phase_peer_v(p, (l), lds); GRID_BAR(); } } \
    } while (0)
    LAYER(0);
    LAYER(1);
    if (IN(28)) { LOADP(); phase_norm(p, p.xb, p.xb + (size_t)NP * D, p.final_g, 2 * NMOD, 2 * NMOD + D, nullptr, p.out + OFF_Y); }
#undef LAYER
#undef IN
#undef GRID_BAR
#undef GLDS
#undef LOADP
}

struct WsLayout { size_t bar, modbuf, csil, wt_ada, wt_in, wt_out, wt_q, wt_pool, u8, v8, su, sv, iscu, part, hg_oin, hg_ds, hg_gam, hg_qh, hg_sc, hA, hB, z, pooled, cat, xa, xb, qry, eidx, gate, ab16, end; };
static WsLayout ws_layout() {
    WsLayout L; size_t o = 0;
    auto take = [&](size_t bytes) { const size_t r = o; o += (bytes + 255) & ~(size_t)255; return r; };
    L.bar = take(16384);
    L.modbuf = take((size_t)256 * MODW * 4);
    L.csil = take((size_t)256 * D * 2);
    L.wt_ada = take((size_t)MODW * D * 2);
    L.wt_in = take((size_t)2 * ZW * D * 2);
    L.wt_out = take((size_t)2 * D * D * 2);
    L.wt_q = take((size_t)2 * D * D * 2);
    L.wt_pool = take((size_t)2 * 1024 * 256 * 2);
    L.u8 = take((size_t)2 * NE * D);
    L.v8 = take((size_t)2 * NE * D);
    L.su = take((size_t)2 * NE * 4);
    L.sv = take((size_t)2 * NE * 4);
    L.iscu = take((size_t)MPAD * 128 * 4);
    L.part = take((size_t)MPAD * 8 * 128 * 4);
    L.hg_oin = take((size_t)hg::NUNIT * 64 * 128 * 4);
    L.hg_ds = take((size_t)hg::NUNIT * 128 * 128 * 4);
    L.hg_gam = take((size_t)hg::NUNIT * 128 * 4);
    L.hg_qh = take((size_t)NP * 1024 * 2);
    L.hg_sc = take((size_t)hg::NUNIT * 128 * 128 * 2);
    L.hA = take((size_t)MPAD * D * 2);
    L.hB = take((size_t)MPAD * D * 2);
    L.z = take((size_t)MPAD * ZW * 2);
    L.pooled = take((size_t)4 * MPAD * 256 * 2);
    L.cat = take((size_t)MPAD * D * 2);
    L.xa = take((size_t)MPAD * D * 4);
    L.xb = take((size_t)MPAD * D * 4);
    L.qry = take((size_t)MPAD * D * 4);
    L.eidx = take((size_t)MPAD * 128 * 2);
    L.gate = take((size_t)MPAD * 128 * 4);
    L.ab16 = take((size_t)MPAD * 128 * 2);
    L.end = o;
    return L;
}
static void fill_params(Params& p, void* const* d_in, void* d_out, void* d_ws) {
    const float** f = (const float**)&p;
    for (int i = 0; i < 24; ++i) f[i] = (const float*)d_in[i];
    p.out = (float*)d_out;
    const WsLayout L = ws_layout(); unsigned char* w = (unsigned char*)d_ws;
    p.bar = (unsigned*)(w + L.bar); p.modbuf = (float*)(w + L.modbuf); p.csil = (bf16_t*)(w + L.csil); p.wt_ada = (bf16_t*)(w + L.wt_ada); p.wt_in = (bf16_t*)(w + L.wt_in);
    p.wt_out = (bf16_t*)(w + L.wt_out); p.wt_q = (bf16_t*)(w + L.wt_q); p.wt_pool = (bf16_t*)(w + L.wt_pool); p.u8 = w + L.u8; p.v8 = w + L.v8; p.su = (float*)(w + L.su); p.sv = (float*)(w + L.sv); p.iscu = (float*)(w + L.iscu); p.part = (float*)(w + L.part); p.hg_oin = (float*)(w + L.hg_oin); p.hg_ds = (float*)(w + L.hg_ds); p.hg_gam = (float*)(w + L.hg_gam); p.hg_qh = (bf16_t*)(w + L.hg_qh); p.hg_sc = (bf16_t*)(w + L.hg_sc);
    p.hA = (bf16_t*)(w + L.hA); p.hB = (bf16_t*)(w + L.hB); p.z = (bf16_t*)(w + L.z); p.pooled = (bf16_t*)(w + L.pooled); p.cat = (bf16_t*)(w + L.cat);
    p.xa = (float*)(w + L.xa); p.xb = (float*)(w + L.xb); p.qry = (float*)(w + L.qry); p.eidx = (unsigned short*)(w + L.eidx); p.gate = (float*)(w + L.gate); p.ab16 = (bf16_t*)(w + L.ab16);
}

#ifndef HIPEMU
#ifndef MK_ONE_LAUNCH
#define MK_ONE_LAUNCH 1
#endif
extern "C" void kernel_launch(void* const* d_in, const int* in_sizes, int n_in, void* d_out, int out_size, void* d_ws, size_t ws_size, hipStream_t stream) {
    static int grid = 0;
    if (grid == 0) {
        const WsLayout L = ws_layout();
        if (n_in != 24 || (size_t)out_size != OUT_TOTAL || ws_size < L.end) { fprintf(stderr, "kernel_launch: unexpected shapes (n_in %d, out %d, ws %zu < %zu)\n", n_in, out_size, ws_size, L.end); grid = -1; return; }
        int dev = 0, cus = 0, per_cu = 0;
        hipGetDevice(&dev); hipDeviceGetAttribute(&cus, hipDeviceAttributeMultiprocessorCount, dev);
        if (hipFuncSetAttribute((const void*)mega_fwd, hipFuncAttributeMaxDynamicSharedMemorySize, LDS_BYTES) != hipSuccess) { fprintf(stderr, "kernel_launch: hipFuncSetAttribute failed\n"); grid = -1; return; }
        hipOccupancyMaxActiveBlocksPerMultiprocessor(&per_cu, (const void*)mega_fwd, 512, LDS_BYTES);
        (void)hipGetLastError();
        if (per_cu < 1) fprintf(stderr, "kernel_launch: occupancy query says %d blocks per CU\n", per_cu);
        grid = cus;
    }
    if (grid < 0) return;
    Params p{};
    fill_params(p, d_in, d_out, d_ws);
    hipMemsetAsync(p.bar, 0, 16384, stream);
#if MK_ONE_LAUNCH
    p.ph_lo = 0; p.ph_hi = N_PHASES;
    hipLaunchKernelGGL(mega_fwd, dim3(grid), dim3(512), LDS_BYTES, stream, p);
#else
    for (int ph = 0; ph < N_PHASES; ++ph) { p.ph_lo = ph; p.ph_hi = ph + 1; hipLaunchKernelGGL(mega_fwd, dim3(grid), dim3(512), LDS_BYTES, stream, p); }
#endif
}
#endif
```

```cpp
#ifndef HIPEMU
#include <hip/hip_runtime.h>
#include <cstdio>
#endif
#include <stdint.h>

#ifndef CFG_PB
#define CFG_PB 4
#define CFG_SEQ 2048
#define CFG_DB 128
#endif

#ifdef HIPEMU
#define DEV inline
#define LAS
#define READLANE_I(v, l) emu_readlane((v), (l))
#define READLANE_F(v, l) emu_readlane_f((v), (l))
#define MFMA_BF16(a, b, c) emu_mfma_bf16_16x16x32((a), (b), (c))
#define MFMA_F32(a, b, c) emu_mfma_f32_16x16x4((a), (b), (c))
#define __expf expf
#define __logf logf
#else
#define DEV __device__ __forceinline__
#define LAS __attribute__((address_space(3)))
#define READLANE_I(v, l) __builtin_amdgcn_readlane((v), (l))
#define READLANE_F(v, l) __uint_as_float((unsigned)__builtin_amdgcn_readlane((int)__float_as_uint(v), (l)))
#define MFMA_BF16(a, b, c) __builtin_amdgcn_mfma_f32_16x16x32_bf16((a), (b), (c), 0, 0, 0)
#define MFMA_F32(a, b, c) __builtin_amdgcn_mfma_f32_16x16x4f32((a), (b), (c), 0, 0, 0)
#endif

typedef unsigned short bf16_t;
typedef short bf16x8 __attribute__((ext_vector_type(8)));
typedef float f32x4 __attribute__((ext_vector_type(4)));
typedef unsigned u32x4 __attribute__((ext_vector_type(4)));
typedef unsigned u32x2 __attribute__((ext_vector_type(2)));

namespace cfg {
constexpr int D = 2048, PB = CFG_PB, SEQ = CFG_SEQ, DB = CFG_DB, DSEQ = 4;
constexpr int NP = PB * SEQ, NS = DB * DSEQ, NTOK = NP + NS, MPAD = (NTOK + 255) / 256 * 256;
constexpr int NC = PB + DB;
constexpr int HH = 8, HD = 128, PW = 1024, PBUF = 15, ZW = 5120;
constexpr int NE = 16384;
constexpr int NMOD = 6 * D;
constexpr int MODW = 2 * NMOD + 2 * D;
constexpr float EPS = 1e-6f;
constexpr int NCHAIN = PB * HH;
constexpr size_t OFF_Y = 0;
constexpr size_t OFF_HP = (size_t)NTOK * D;
constexpr size_t OFF_PP = OFF_HP + (size_t)2 * PB * HH * HD * HD;
constexpr size_t OFF_HS = OFF_PP + (size_t)2 * PB * PBUF * PW;
constexpr size_t OFF_PS = OFF_HS + (size_t)2 * DB * HH * HD * HD;
constexpr size_t OUT_TOTAL = OFF_PS + (size_t)2 * DB * PBUF * PW;
}
using namespace cfg;

struct Params {
    const float *x_prompt, *x_sample, *c_prompt, *c_sample, *state_hgrn, *state_pool, *w_ada, *b_ada, *norm1_g, *norm2_g, *w_in, *w_out,
        *lb_logits, *hgrn_norm_g, *pool_w, *pool_b, *pool_scale, *peer_wq, *peer_keys, *peer_u, *peer_v, *final_g, *w_ada_final, *b_ada_final;
    float* out;
    unsigned* bar; float* modbuf; bf16_t* csil; bf16_t* wt_ada; bf16_t* wt_in; bf16_t* wt_out; bf16_t* wt_q; bf16_t* wt_pool;
    unsigned char* u8; unsigned char* v8; float* su; float* sv; float* iscu; float* part; float* hg_oin; float* hg_ds; float* hg_gam; bf16_t* hg_qh; bf16_t* hg_sc; bf16_t* hA; bf16_t* hB; bf16_t* z; bf16_t* pooled; bf16_t* cat; float* xa; float* xb; float* qry; unsigned short* eidx; float* gate; bf16_t* ab16;
    int ph_lo, ph_hi;
};

DEV float bf2f(unsigned v) { return __uint_as_float(v << 16); }
#ifdef HIPEMU
DEV unsigned f2bf(float f) { unsigned u = __float_as_uint(f); u += 0x7fffu + ((u >> 16) & 1u); return u >> 16; }
DEV unsigned pack2(float lo, float hi) { return f2bf(lo) | (f2bf(hi) << 16); }
#else
typedef float f32x2_t __attribute__((ext_vector_type(2)));
typedef __bf16 bf16x2_t __attribute__((ext_vector_type(2)));
DEV unsigned pack2(float lo, float hi) { const f32x2_t v = {lo, hi}; return __builtin_bit_cast(unsigned, __builtin_convertvector(v, bf16x2_t)); }
DEV unsigned f2bf(float f) { return (unsigned)__builtin_bit_cast(unsigned short, (__bf16)f); }
#endif
DEV float lo16(unsigned w) { return __uint_as_float(w << 16); }
DEV float hi16(unsigned w) { return __uint_as_float(w & 0xffff0000u); }
DEV float wave_sum(float v) { v += __shfl_xor(v, 32); v += __shfl_xor(v, 16); v += __shfl_xor(v, 8); v += __shfl_xor(v, 4); v += __shfl_xor(v, 2); v += __shfl_xor(v, 1); return v; }
DEV float wave_max(float v) { v = fmaxf(v, __shfl_xor(v, 32)); v = fmaxf(v, __shfl_xor(v, 16)); v = fmaxf(v, __shfl_xor(v, 8)); v = fmaxf(v, __shfl_xor(v, 4)); v = fmaxf(v, __shfl_xor(v, 2)); v = fmaxf(v, __shfl_xor(v, 1)); return v; }
DEV float sigmoidf_(float x) { return 1.0f / (1.0f + __expf(-x)); }
DEV float siluf_(float x) { return x / (1.0f + __expf(-x)); }
DEV float gelu_erf(float x) { return 0.5f * x * (1.0f + erff(x * 0.70710678118f)); }
DEV int tok_batch(int t) { return t < NP ? t / SEQ : PB + (t - NP) / DSEQ; }


#ifdef HIPEMU
static inline unsigned emu_fp8_enc1(float x) {
    const unsigned sgn = x < 0.f ? 0x80u : 0u; float a = fabsf(x);
    if (!(a == a)) return 0x7fu;
    if (a >= 448.f) return sgn | 0x7eu;
    if (a < 0.015625f) { const int q = (int)rintf(a * 512.f); return sgn | (unsigned)q; }
    int e = (int)floorf(log2f(a)); if (ldexpf(1.f, e) > a) --e; if (ldexpf(1.f, e + 1) <= a) ++e;
    int m = (int)rintf((a / ldexpf(1.f, e) - 1.f) * 8.f); if (m == 8) { m = 0; ++e; }
    if (e > 8) return sgn | 0x7eu;
    return sgn | (unsigned)((e + 7) << 3) | (unsigned)m;
}
static inline float emu_fp8_dec1(unsigned b) { const float sg = (b & 0x80u) ? -1.f : 1.f; const int e = (b >> 3) & 15, m = b & 7; return sg * (e == 0 ? m * 0.001953125f : (1.f + m * 0.125f) * ldexpf(1.f, e - 7)); }
DEV unsigned fp8x4_enc(float a, float b, float c, float d) { return emu_fp8_enc1(a) | (emu_fp8_enc1(b) << 8) | (emu_fp8_enc1(c) << 16) | (emu_fp8_enc1(d) << 24); }
DEV void fp8x4_dec(unsigned w, float* o) { o[0] = emu_fp8_dec1(w & 255u); o[1] = emu_fp8_dec1((w >> 8) & 255u); o[2] = emu_fp8_dec1((w >> 16) & 255u); o[3] = emu_fp8_dec1(w >> 24); }
#define DPP_XOR1(v) __shfl((v), emu_lane() ^ 1)
#define DPP_XOR2(v) __shfl((v), emu_lane() ^ 2)
#define DPP_HMIRROR(v) __shfl((v), (emu_lane() & ~7) | (7 - (emu_lane() & 7)))
#define DPP_XOR8(v) __shfl((v), emu_lane() ^ 8)
#define DPP_RMIRROR(v) __shfl((v), (emu_lane() & ~15) | (15 - (emu_lane() & 15)))
#define WAVE_LDS_SYNC() emu_wbar()
DEV float xsum16(float a, float b) { const bool hi = (emu_lane() & 16) != 0; return (hi ? b : a) + __shfl_xor(hi ? a : b, 16); }
DEV float xsum32(float a, float b) { const bool hi = (emu_lane() & 32) != 0; return (hi ? b : a) + __shfl_xor(hi ? a : b, 32); }
#else
typedef float f32x2v_t __attribute__((ext_vector_type(2)));
DEV unsigned fp8x4_enc(float a, float b, float c, float d) { int r = __builtin_amdgcn_cvt_pk_fp8_f32(a, b, 0, false); r = __builtin_amdgcn_cvt_pk_fp8_f32(c, d, r, true); return (unsigned)r; }
DEV void fp8x4_dec(unsigned w, float* o) { const f32x2v_t lo = __builtin_amdgcn_cvt_pk_f32_fp8((int)w, false), hi = __builtin_amdgcn_cvt_pk_f32_fp8((int)w, true); o[0] = lo[0]; o[1] = lo[1]; o[2] = hi[0]; o[3] = hi[1]; }
template <int CTRL> DEV float dpp_f(float v) { return __uint_as_float((unsigned)__builtin_amdgcn_update_dpp(0, (int)__float_as_uint(v), CTRL, 0xf, 0xf, true)); }
#define DPP_XOR1(v) dpp_f<0xB1>(v)
#define DPP_XOR2(v) dpp_f<0x4E>(v)
#define DPP_HMIRROR(v) dpp_f<0x141>(v)
#define DPP_XOR8(v) dpp_f<0x128>(v)
#define DPP_RMIRROR(v) dpp_f<0x140>(v)
#define WAVE_LDS_SYNC() asm volatile("s_waitcnt lgkmcnt(0)" ::: "memory")
DEV float xsum16(float a, float b) { const u32x2 r = __builtin_amdgcn_permlane16_swap(__float_as_uint(a), __float_as_uint(b), false, false); return __uint_as_float(r[0]) + __uint_as_float(r[1]); }
DEV float xsum32(float a, float b) { const u32x2 r = __builtin_amdgcn_permlane32_swap(__float_as_uint(a), __float_as_uint(b), false, false); return __uint_as_float(r[0]) + __uint_as_float(r[1]); }
#endif
typedef float f32x2 __attribute__((ext_vector_type(2)));
#ifdef HIPEMU
DEV void fp8x4_dec2(unsigned w, f32x2& lo, f32x2& hi) { float o[4]; fp8x4_dec(w, o); lo = (f32x2){o[0], o[1]}; hi = (f32x2){o[2], o[3]}; }
#else
DEV void fp8x4_dec2(unsigned w, f32x2& lo, f32x2& hi) { lo = __builtin_amdgcn_cvt_pk_f32_fp8((int)w, false); hi = __builtin_amdgcn_cvt_pk_f32_fp8((int)w, true); }
#endif
DEV void fp8x16_dec2(u32x4 q, f32x2* o) { fp8x4_dec2(q.x, o[0], o[1]); fp8x4_dec2(q.y, o[2], o[3]); fp8x4_dec2(q.z, o[4], o[5]); fp8x4_dec2(q.w, o[6], o[7]); }

namespace pg8 {
constexpr int BM = 256, BK = 64, HALF = 128, HTB = HALF * BK * 2, STAGE_BYTES = 8 * HTB, NXCD = 8, WGM = 8;
DEV int lds_byte(int r, int c) { const int st = (r >> 4) * 2 + (c >> 5), rr = r & 15, cc = c & 31, ob = rr * 64 + cc * 2; return st * 1024 + (ob ^ (((ob >> 9) & 1) << 5)); }
DEV void stage_rc(int b, int& R, int& C) { const int st = b / 1024, sb = b % 1024, swz = sb ^ (((sb >> 9) & 1) << 5); R = (st >> 1) * 16 + swz / 64; C = (st & 1) * 32 + (swz % 64) / 2; }
DEV int perm32(int rho) { const int n = rho >> 4, i = rho & 15; return 8 * (i >> 2) + 4 * n + (i & 3); }
struct Unit { int pm, pn; };
struct Gemm { const bf16_t* A; const bf16_t* Bt; int M, N, K; };
struct StaticOrder {
    int nM, nN, nwg, G, c;
    DEV void init(int M, int N, int G_, int c_) { nM = M / BM; nN = N / BM; nwg = nM * nN; G = G_; c = c_; }
    DEV bool next(int i, Unit& u) const {
        const long L = (long)i * G + c; if (L >= nwg) return false;
        int wgid = (int)L; { const int q = nwg / NXCD, r = nwg % NXCD, xcd = wgid % NXCD, off = wgid / NXCD; wgid = (xcd < r ? xcd * (q + 1) : r * (q + 1) + (xcd - r) * q) + off; }
        const int nig = WGM * nN, gid = wgid / nig, fm = gid * WGM, gsz = (nM - fm) < WGM ? (nM - fm) : WGM;
        u.pm = fm + ((wgid % nig) % gsz); u.pn = (wgid % nig) / gsz; return true;
    }
    DEV void a_ready(const Unit&) const {}
    DEV void done(const Unit&) const {}
};
struct PoolOrder {
    int G, c;
    DEV bool next(int i, Unit& u) const { const int L = i * G + c; if (L >= 4 * (MPAD / 256)) return false; u.pm = L; u.pn = L / (MPAD / 256); return true; }
    DEV void a_ready(const Unit&) const {}
    DEV void done(const Unit&) const {}
};

struct EpiF32 {
    static constexpr bool PERM = false;
    float* C; int ldc;
    DEV void operator()(const f32x4 (&acc)[2][2][4][2], const Unit& u, int wr, int wc, int fr, int fq) const {
        const int row0 = u.pm * BM + wr * 64 + fr, col0 = u.pn * BM + wc * 32 + 4 * fq;
#pragma unroll
        for (int ai = 0; ai < 2; ++ai)
#pragma unroll
            for (int m = 0; m < 4; ++m) { float* rowp = C + (size_t)(row0 + ai * HALF + m * 16) * ldc + col0;
#pragma unroll
                for (int bj = 0; bj < 2; ++bj)
#pragma unroll
                    for (int n = 0; n < 2; ++n) *(f32x4*)(rowp + bj * HALF + n * 16) = acc[ai][bj][m][n]; }
    }
};
struct EpiAda {
    static constexpr bool PERM = false;
    float* C; const float* b_ada; const float* b_fin;
    DEV void operator()(const f32x4 (&acc)[2][2][4][2], const Unit& u, int wr, int wc, int fr, int fq) const {
        const int row0 = u.pm * BM + wr * 64 + fr, col0 = u.pn * BM + wc * 32 + 4 * fq;
        const float* bias = (u.pn * BM < 2 * NMOD) ? b_ada + col0 : b_fin + (col0 - 2 * NMOD);
        f32x4 bv[2][2];
#pragma unroll
        for (int bj = 0; bj < 2; ++bj)
#pragma unroll
            for (int n = 0; n < 2; ++n) bv[bj][n] = *(const f32x4*)(bias + bj * HALF + n * 16);
#pragma unroll
        for (int ai = 0; ai < 2; ++ai)
#pragma unroll
            for (int m = 0; m < 4; ++m) { float* rowp = C + (size_t)(row0 + ai * HALF + m * 16) * MODW + col0;
#pragma unroll
                for (int bj = 0; bj < 2; ++bj)
#pragma unroll
                    for (int n = 0; n < 2; ++n) *(f32x4*)(rowp + bj * HALF + n * 16) = acc[ai][bj][m][n] + bv[bj][n]; }
    }
};
struct EpiResid {
    static constexpr bool PERM = false;
    const float* xlo; const float* xhi; const float* gmod  ; float* out;
    DEV void operator()(const f32x4 (&acc)[2][2][4][2], const Unit& u, int wr, int wc, int fr, int fq) const {
        const int row0 = u.pm * BM + wr * 64 + fr, col0 = u.pn * BM + wc * 32 + 4 * fq;
#pragma unroll
        for (int ai = 0; ai < 2; ++ai)
#pragma unroll
            for (int m = 0; m < 4; ++m) {
                const int row = row0 + ai * HALF + m * 16;
                if (row < NTOK) {
                    const float* xr = (row < NP ? xlo + (size_t)row * D : xhi + (size_t)(row - NP) * D) + col0;
                    const float* gr = gmod + (size_t)tok_batch(row) * MODW + col0;
                    float* rowp = out + (size_t)row * D + col0;
#pragma unroll
                    for (int bj = 0; bj < 2; ++bj)
#pragma unroll
                        for (int n = 0; n < 2; ++n) { const f32x4 xv = *(const f32x4*)(xr + bj * HALF + n * 16), gv = *(const f32x4*)(gr + bj * HALF + n * 16);
                            *(f32x4*)(rowp + bj * HALF + n * 16) = xv + gv * acc[ai][bj][m][n]; }
                }
            }
    }
};
struct EpiBf16 {
    static constexpr bool PERM = true;
    bf16_t* O; int ldc;
    DEV void operator()(const f32x4 (&acc)[2][2][4][2], const Unit& u, int wr, int wc, int fr, int fq) const {
        const int row0 = u.pm * BM + wr * 64 + fr, col0 = u.pn * BM + wc * 32 + 8 * fq;
#pragma unroll
        for (int ai = 0; ai < 2; ++ai)
#pragma unroll
            for (int m = 0; m < 4; ++m) { bf16_t* rowp = O + (size_t)(row0 + ai * HALF + m * 16) * ldc + col0;
#pragma unroll
                for (int bj = 0; bj < 2; ++bj) { const f32x4 v0 = acc[ai][bj][m][0], v1 = acc[ai][bj][m][1];
                    u32x4 w; w.x = pack2(v0[0], v0[1]); w.y = pack2(v0[2], v0[3]); w.z = pack2(v1[0], v1[1]); w.w = pack2(v1[2], v1[3]);
                    *(u32x4*)(rowp + bj * HALF) = w; } }
    }
};
struct EpiPool {
    static constexpr bool PERM = true;
    bf16_t* cat; const float* pb; const float* ps;
    DEV void operator()(const f32x4 (&acc)[2][2][4][2], const Unit& u, int wr, int wc, int fr, int fq) const {
        const int g = u.pn, tok0 = u.pm * BM - g * MPAD + wr * 64 + fr, col0 = g * 256 + wc * 32 + 8 * fq;
#pragma unroll
        for (int bj = 0; bj < 2; ++bj) {
            const f32x4 b0 = *(const f32x4*)(pb + col0 + bj * HALF), b1 = *(const f32x4*)(pb + col0 + bj * HALF + 4);
            const f32x4 s0 = *(const f32x4*)(ps + col0 + bj * HALF), s1 = *(const f32x4*)(ps + col0 + bj * HALF + 4);
#pragma unroll
            for (int ai = 0; ai < 2; ++ai)
#pragma unroll
                for (int m = 0; m < 4; ++m) { const int tok = tok0 + ai * HALF + m * 16;
                    if (tok < NTOK) { const f32x4 v0 = (acc[ai][bj][m][0] + b0) * s0, v1 = (acc[ai][bj][m][1] + b1) * s1;
                        u32x4 w; w.x = pack2(v0[0], v0[1]); w.y = pack2(v0[2], v0[3]); w.z = pack2(v1[0], v1[1]); w.w = pack2(v1[2], v1[3]);
                        *(u32x4*)(cat + (size_t)tok * D + 1024 + col0 + bj * HALF) = w; } }
        }
    }
};

#ifdef HIPEMU
template <class Epi, class Sched>
static void gemm_phase(unsigned char*, const Gemm g, const Sched& S, const Epi& E) {
    const int tid = threadIdx.x, wid = tid >> 6, lane = tid & 63, wr = wid >> 2, wc = wid & 3, fr = lane & 15, fq = lane >> 4;
    Unit cur;
    for (int ui = 0; S.next(ui, cur); ++ui) {
        f32x4 acc[2][2][4][2];
        for (int ai = 0; ai < 2; ++ai) for (int bj = 0; bj < 2; ++bj) for (int m = 0; m < 4; ++m) for (int n = 0; n < 2; ++n) for (int j = 0; j < 4; ++j) {
            const int row = 256 * cur.pm + 128 * ai + 64 * wr + 16 * m + fr;
            const int col = Epi::PERM ? 256 * cur.pn + 128 * bj + 32 * wc + 8 * fq + 4 * n + j : 256 * cur.pn + 128 * bj + 32 * wc + 16 * n + 4 * fq + j;
            float s = 0.f;
            if ((row % emu_row_mod) < emu_row_limit) { const float* a = emu_f32_copy(g.A, (size_t)g.M * g.K) + (size_t)row * g.K; const float* b = emu_f32_copy(g.Bt, (size_t)g.N * g.K) + (size_t)col * g.K;
                for (int k = 0; k < g.K; ++k) s += a[k] * b[k]; }
            acc[ai][bj][m][n][j] = s; }
        E(acc, cur, wr, wc, fr, fq);
    }
    __syncthreads();
}
#else
template <class Epi, class Sched>
__device__ __forceinline__ void gemm_phase(LAS unsigned char* lds, const Gemm g, const Sched& S, const Epi& E) {
    const int tid = threadIdx.x, wid = __builtin_amdgcn_readfirstlane(tid >> 6), lane = tid & 63, wr = wid >> 2, wc = wid & 3, fr = lane & 15, fq = lane >> 4;
    int K = g.K; asm volatile("" : "+s"(K));
    const int nt = K / BK;
    unsigned voffA[2], voffB[2];
#pragma unroll
    for (int i = 0; i < 2; ++i) { int R, C; stage_rc(tid * 16 + i * 8192, R, C); const int Rb = Epi::PERM ? ((R & ~31) + perm32(R & 31)) : R;
        voffA[i] = (unsigned)(R * K + C) * 2u; voffB[i] = (unsigned)(Rb * K + C) * 2u; }
    const size_t kstep = (size_t)(BK * 2);
    const size_t hstep = (size_t)HALF * K * 2;
    const size_t tstep = 2 * hstep;
    const unsigned ldsw = (unsigned)wid * 1024u;
    const int aoff = lds_byte(wr * 64 + fr, fq * 8), boff = lds_byte(wc * 32 + fr, fq * 8);
#define PG8_SA(b, h) (((b) * 2 + (h)) * HTB)
#define PG8_SB(b, h) ((4 + (b) * 2 + (h)) * HTB)
#define PG8_STAGE(bufoff, gbase, voff) do { _Pragma("unroll") for (int _i = 0; _i < 2; ++_i) \
        __builtin_amdgcn_global_load_lds((const unsigned*)((const char*)(gbase) + (voff)[_i]), (LAS unsigned*)(lds + (bufoff) + ldsw + _i * 8192), 16, 0, 0); } while (0)
#define PG8_LDA(dst, b, h) do { _Pragma("unroll") for (int m = 0; m < 4; ++m) _Pragma("unroll") for (int k = 0; k < 2; ++k) dst[m][k] = *(const LAS bf16x8*)(lds + PG8_SA(b, h) + aoff + m * 2048 + k * 1024); } while (0)
#define PG8_LDB(dst, b, h) do { _Pragma("unroll") for (int n = 0; n < 2; ++n) _Pragma("unroll") for (int k = 0; k < 2; ++k) dst[n][k] = *(const LAS bf16x8*)(lds + PG8_SB(b, h) + boff + n * 2048 + k * 1024); } while (0)
#define PG8_MMA(ai, bj, At, Bt) do { __builtin_amdgcn_s_setprio(1); _Pragma("unroll") for (int m = 0; m < 4; ++m) _Pragma("unroll") for (int n = 0; n < 2; ++n) _Pragma("unroll") for (int k = 0; k < 2; ++k) \
        acc[ai][bj][m][n] = __builtin_amdgcn_mfma_f32_16x16x32_bf16(Bt[n][k], At[m][k], acc[ai][bj][m][n], 0, 0, 0); __builtin_amdgcn_s_setprio(0); } while (0)
#define PG8_WAIT_V(n) asm volatile("s_waitcnt vmcnt(" #n ")" ::: "memory")
#define PG8_WAIT_L(n) asm volatile("s_waitcnt lgkmcnt(" #n ")" ::: "memory")
#define PG8_BAR __builtin_amdgcn_s_barrier()
#define PG8_SCHED __builtin_amdgcn_sched_barrier(0)
    Unit cur, nxt; int ui = 0;
    if (!S.next(0, cur)) return;
    f32x4 acc[2][2][4][2];
#pragma unroll
    for (int a = 0; a < 2; ++a)
#pragma unroll
        for (int b = 0; b < 2; ++b)
#pragma unroll
            for (int m = 0; m < 4; ++m)
#pragma unroll
                for (int n = 0; n < 2; ++n) acc[a][b][m][n] = (f32x4){0.f, 0.f, 0.f, 0.f};
    bf16x8 At[4][2], B0[2][2], B1[2][2];
    const char* cA = (const char*)g.A + (size_t)cur.pm * tstep; const char* cB = (const char*)g.Bt + (size_t)cur.pn * tstep;
    S.a_ready(cur);
    PG8_STAGE(PG8_SB(0, 0), cB, voffB); PG8_STAGE(PG8_SA(0, 0), cA, voffA); PG8_STAGE(PG8_SB(0, 1), cB + hstep, voffB); PG8_STAGE(PG8_SA(0, 1), cA + hstep, voffA);
    if (wr == 1) PG8_BAR;
    PG8_WAIT_V(4); PG8_BAR;
    PG8_STAGE(PG8_SB(1, 0), cB + kstep, voffB); PG8_STAGE(PG8_SA(1, 0), cA + kstep, voffA); PG8_STAGE(PG8_SB(1, 1), cB + hstep + kstep, voffB);
    PG8_WAIT_V(6); PG8_BAR;
    for (;;) {
        const bool has_next = S.next(ui + 1, nxt);
        const char* nA = has_next ? (const char*)g.A + (size_t)nxt.pm * tstep : cA; const char* nB = has_next ? (const char*)g.Bt + (size_t)nxt.pn * tstep : cB;
        for (int t = 0; t < nt; t += 2) {
            const bool last = (t == nt - 2);
            const char* a1 = cA + (size_t)(t + 1) * kstep;
            const char* a2 = last ? nA : cA + (size_t)(t + 2) * kstep; const char* b2 = last ? nB : cB + (size_t)(t + 2) * kstep;
            const char* a3 = a2 + kstep; const char* b3 = b2 + kstep;
            if (last && has_next) S.a_ready(nxt);
            PG8_LDB(B0, 0, 0); PG8_SCHED; PG8_LDA(At, 0, 0); PG8_STAGE(PG8_SA(1, 1), a1 + hstep, voffA);
            PG8_WAIT_L(8); PG8_BAR; PG8_WAIT_L(0); PG8_MMA(0, 0, At, B0); PG8_BAR; PG8_SCHED;
            PG8_LDB(B1, 0, 1); PG8_STAGE(PG8_SB(0, 0), b2, voffB);
            PG8_BAR; PG8_WAIT_L(0); PG8_MMA(0, 1, At, B1); PG8_BAR;
            PG8_LDA(At, 0, 1); PG8_STAGE(PG8_SA(0, 0), a2, voffA);
            PG8_BAR; PG8_WAIT_L(0); PG8_MMA(1, 0, At, B0); PG8_BAR; PG8_SCHED;
            PG8_STAGE(PG8_SB(0, 1), b2 + hstep, voffB);
            PG8_WAIT_V(6); PG8_BAR; PG8_MMA(1, 1, At, B1); PG8_BAR;
            PG8_LDB(B0, 1, 0); PG8_SCHED; PG8_LDA(At, 1, 0); PG8_STAGE(PG8_SA(0, 1), a2 + hstep, voffA);
            PG8_WAIT_L(8); PG8_BAR; PG8_WAIT_L(0); PG8_MMA(0, 0, At, B0); PG8_BAR; PG8_SCHED;
            PG8_LDB(B1, 1, 1); PG8_STAGE(PG8_SB(1, 0), b3, voffB);
            PG8_BAR; PG8_WAIT_L(0); PG8_MMA(0, 1, At, B1); PG8_BAR;
            PG8_LDA(At, 1, 1); PG8_STAGE(PG8_SA(1, 0), a3, voffA);
            PG8_BAR; PG8_WAIT_L(0); PG8_MMA(1, 0, At, B0); PG8_BAR; PG8_SCHED;
            PG8_STAGE(PG8_SB(1, 1), b3 + hstep, voffB);
            PG8_WAIT_V(6); PG8_BAR; PG8_MMA(1, 1, At, B1); PG8_BAR;
        }
        { int tz = threadIdx.x; asm volatile("" : "+v"(tz)); const int wz = tz >> 6, lz = tz & 63;
          E(acc, cur, wz >> 2, wz & 3, lz & 15, lz >> 4); } S.done(cur);
        if (!has_next) break;
#pragma unroll
        for (int a = 0; a < 2; ++a)
#pragma unroll
            for (int b = 0; b < 2; ++b)
#pragma unroll
                for (int m = 0; m < 4; ++m)
#pragma unroll
                    for (int n = 0; n < 2; ++n) acc[a][b][m][n] = (f32x4){0.f, 0.f, 0.f, 0.f};
        cur = nxt; cA = nA; cB = nB; ++ui;
    }
    PG8_WAIT_V(0);
    if (wr == 0) PG8_BAR;
    PG8_BAR;
#undef PG8_SA
#undef PG8_SB
#undef PG8_STAGE
#undef PG8_LDA
#undef PG8_LDB
#undef PG8_MMA
#undef PG8_WAIT_V
#undef PG8_WAIT_L
#undef PG8_BAR
#undef PG8_SCHED
}
#endif
}

constexpr int MBIG = (NP / 256) * 256;
template <class F> DEV void small_gemm(const bf16_t* A, const bf16_t* Bt, int K, unsigned char* lds, const F& f) {
    const int tid = threadIdx.x, lane = tid & 63, w = tid >> 6, g = lane >> 4, c16 = lane & 15;
    const int tiles_m = (NTOK - MBIG + 63) / 64, ntiles = tiles_m * 32, kw = K / 8;
    float* part = (float*)lds;
    for (int tl = blockIdx.x; tl < ntiles; tl += gridDim.x) {
        const int r0 = MBIG + (tl / 32) * 64, n0 = (tl % 32) * 64;
        f32x4 acc[4][4];
#pragma unroll
        for (int i = 0; i < 4; ++i)
#pragma unroll
            for (int j = 0; j < 4; ++j) acc[i][j] = (f32x4){0.f, 0.f, 0.f, 0.f};
        for (int k0 = w * kw; k0 < (w + 1) * kw; k0 += 128) {
            bf16x8 af[4][4], bfr[4][4];
#pragma unroll
            for (int u = 0; u < 4; ++u)
#pragma unroll
                for (int i = 0; i < 4; ++i) { int arow = r0 + 16 * i + c16; if (arow >= MPAD) arow = MPAD - 1;
                    af[u][i] = *(const bf16x8*)(A + (size_t)arow * K + k0 + 32 * u + 8 * g); bfr[u][i] = *(const bf16x8*)(Bt + (size_t)(n0 + 16 * i + c16) * K + k0 + 32 * u + 8 * g); }
#pragma unroll
            for (int u = 0; u < 4; ++u)
#pragma unroll
                for (int i = 0; i < 4; ++i)
#pragma unroll
                    for (int j = 0; j < 4; ++j) acc[i][j] = MFMA_BF16(af[u][i], bfr[u][j], acc[i][j]);
        }
#pragma unroll
        for (int i = 0; i < 4; ++i)
#pragma unroll
            for (int j = 0; j < 4; ++j)
#pragma unroll
                for (int r = 0; r < 4; ++r) part[(w * 64 + 16 * i + 4 * g + r) * 68 + 16 * j + c16] = acc[i][j][r];
        __syncthreads();
        {
            const int row = tid >> 3, c8 = (tid & 7) * 8; f32x4 s0 = (f32x4){0.f, 0.f, 0.f, 0.f}, s1 = s0;
#pragma unroll
            for (int ww = 0; ww < 8; ++ww) { s0 += *(const f32x4*)(part + (ww * 64 + row) * 68 + c8); s1 += *(const f32x4*)(part + (ww * 64 + row) * 68 + c8 + 4); }
            if (r0 + row < NTOK) f(r0 + row, n0 + c8, s0, s1);
        }
        __syncthreads();
    }
}
struct SmallResid { const float* xlo; const float* xhi; const float* gmod; float* out;
    DEV void operator()(int row, int col, f32x4 v0, f32x4 v1) const { const float* xr = (row < NP ? xlo + (size_t)row * D : xhi + (size_t)(row - NP) * D) + col; const float* gr = gmod + (size_t)tok_batch(row) * MODW + col;
        float* o = out + (size_t)row * D + col; *(f32x4*)o = *(const f32x4*)xr + *(const f32x4*)gr * v0; *(f32x4*)(o + 4) = *(const f32x4*)(xr + 4) + *(const f32x4*)(gr + 4) * v1; } };
struct SmallF32 { float* out; DEV void operator()(int row, int col, f32x4 v0, f32x4 v1) const { float* o = out + (size_t)row * D + col; *(f32x4*)o = v0; *(f32x4*)(o + 4) = v1; } };

DEV void transpose_tile(const float* src, int ld_src, bf16_t* dst, int ld_dst, float* tile) {
    const int tid = threadIdx.x;
#pragma unroll
    for (int i = 0; i < 2; ++i) { const int idx = tid + i * 512, r = idx >> 4, c4 = idx & 15; const f32x4 v = *(const f32x4*)(src + (size_t)r * ld_src + c4 * 4);
        float* t = tile + r * 65 + c4 * 4; t[0] = v[0]; t[1] = v[1]; t[2] = v[2]; t[3] = v[3]; }
    __syncthreads();
    const int n = tid >> 3, kg = tid & 7; const float* t = tile + (kg * 8) * 65 + n;
    u32x4 w; w.x = pack2(t[0], t[65]); w.y = pack2(t[2 * 65], t[3 * 65]); w.z = pack2(t[4 * 65], t[5 * 65]); w.w = pack2(t[6 * 65], t[7 * 65]);
    *(u32x4*)(dst + (size_t)n * ld_dst + kg * 8) = w;
    __syncthreads();
}
DEV int cvt_job_tiles(int j) { const int K = j < 9 ? 2048 : 256; const int N = j < 2 ? NMOD : (j == 2 ? 2 * D : (j < 5 ? ZW : (j < 9 ? D : 256))); return (K / 64) * (N / 64); }
DEV void phase_convert(const Params& p, unsigned char* lds, int part) {
    float* tile = (float*)lds;
    const int tid = threadIdx.x;
    const int q_lo = part == 0 ? 0 : 3, q_hi = part == 0 ? 3 : 17;
    int total = 0;
#pragma unroll
    for (int q = 0; q < 17; ++q) if (q >= q_lo && q < q_hi) total += cvt_job_tiles(q);
    for (int tl = blockIdx.x; tl < total; tl += gridDim.x) {
        int j = 0, loc = 0, base = 0;
#pragma unroll
        for (int q = 0; q < 17; ++q) if (q >= q_lo && q < q_hi) { const int cnt = cvt_job_tiles(q); if (tl >= base && tl < base + cnt) { j = q; loc = tl - base; } base += cnt; }
        const float* src; bf16_t* dst; int K = 2048, N;
        if (j < 2) { N = NMOD; src = p.w_ada + (size_t)j * 2048 * NMOD; dst = p.wt_ada + (size_t)j * NMOD * 2048; }
        else if (j == 2) { N = 2 * D; src = p.w_ada_final; dst = p.wt_ada + (size_t)2 * NMOD * 2048; }
        else if (j < 5) { N = ZW; src = p.w_in + (size_t)(j - 3) * 2048 * ZW; dst = p.wt_in + (size_t)(j - 3) * ZW * 2048; }
        else if (j < 7) { N = D; src = p.w_out + (size_t)(j - 5) * D * D; dst = p.wt_out + (size_t)(j - 5) * D * D; }
        else if (j < 9) { N = D; src = p.peer_wq + (size_t)(j - 7) * D * D; dst = p.wt_q + (size_t)(j - 7) * D * D; }
        else { K = 256; N = 256; src = p.pool_w + (size_t)(j - 9) * 65536; dst = p.wt_pool + (size_t)(j - 9) * 65536; }
        const int ntn = N / 64, kt = loc / ntn, nt = loc % ntn;
        transpose_tile(src + (size_t)kt * 64 * N + nt * 64, N, dst + (size_t)nt * 64 * K + kt * 64, K, tile);
    }
    const size_t gt = (size_t)blockIdx.x * 512 + tid, gs = (size_t)gridDim.x * 512;
    if (part == 1) {
        const int lane = tid & 63;
        constexpr int NADA = MODW / 256, R1 = (4 * NE / 8) * 7;
        const bool uneven = (int)gridDim.x > NADA + 16;
        for (int seg = 0; seg < 2; ++seg) {
            int gw, nw, r_lo, r_hi;
            if (!uneven) { if (seg) break; gw = blockIdx.x * 8 + (tid >> 6); nw = gridDim.x * 8; r_lo = 0; r_hi = 4 * NE; }
            else if (seg == 0) { gw = blockIdx.x * 8 + (tid >> 6); nw = gridDim.x * 8; r_lo = 0; r_hi = R1; }
            else { if ((int)blockIdx.x < NADA) break; gw = ((int)blockIdx.x - NADA) * 8 + (tid >> 6); nw = ((int)gridDim.x - NADA) * 8; r_lo = R1; r_hi = 4 * NE; }
        for (int row = r_lo + gw; row < r_hi; row += nw) {
            const int which = row / (2 * NE), rr = row % (2 * NE);
            const float* src = (which ? p.peer_v : p.peer_u) + (size_t)rr * D; unsigned char* tab = (which ? p.v8 : p.u8) + (size_t)(rr / NE) * NE * D; const int e = rr % NE;
            f32x4 v[8]; float am = 0.f;
#pragma unroll
            for (int k = 0; k < 8; ++k) { v[k] = *(const f32x4*)(src + 4 * lane + 256 * k); am = fmaxf(am, fmaxf(fmaxf(fabsf(v[k][0]), fabsf(v[k][1])), fmaxf(fabsf(v[k][2]), fabsf(v[k][3])))); }
            am = wave_max(am);
            const float sc = am > 0.f ? 224.0f / am : 1.0f;
#pragma unroll
            for (int k = 0; k < 8; ++k) *(unsigned*)(tab + ((size_t)(2 * k + (lane >> 5)) * NE + e) * 128 + 4 * (lane & 31)) = fp8x4_enc(v[k][0] * sc, v[k][1] * sc, v[k][2] * sc, v[k][3] * sc);
            if (lane == 0) (which ? p.sv : p.su)[rr] = am > 0.f ? am * (1.0f / 224.0f) : 1.0f;
        }
        }
    }
    if (part == 0) for (size_t i = gt; i < (size_t)256 * D / 8; i += gs) {
        const int row = (int)(i / (D / 8)), c8 = (int)(i % (D / 8)) * 8; u32x4 w = (u32x4){0u, 0u, 0u, 0u};
        if (row < NC) { const float* s = (row < PB ? p.c_prompt + (size_t)row * D : p.c_sample + (size_t)(row - PB) * D) + c8;
            const f32x4 a = *(const f32x4*)s, b = *(const f32x4*)(s + 4);
            w.x = pack2(siluf_(a[0]), siluf_(a[1])); w.y = pack2(siluf_(a[2]), siluf_(a[3])); w.z = pack2(siluf_(b[0]), siluf_(b[1])); w.w = pack2(siluf_(b[2]), siluf_(b[3])); }
        *(u32x4*)(p.csil + i * 8) = w;
    }
}

DEV void phase_norm(const Params& p, const float* xlo, const float* xhi, const float* gn, int sh_off, int sc_off, bf16_t* obf, float* of32) {
    const int lane = threadIdx.x & 63, gw = blockIdx.x * 8 + (threadIdx.x >> 6), nw = gridDim.x * 8;
    for (int t = gw; t < NTOK; t += nw) {
        const float* xr = t < NP ? xlo + (size_t)t * D : xhi + (size_t)(t - NP) * D;
        const float* mrow = p.modbuf + (size_t)tok_batch(t) * MODW;
        f32x4 v[8]; float ss = 0.f;
#pragma unroll
        for (int c = 0; c < 4; ++c) { const int col = c * 512 + lane * 8; v[2 * c] = *(const f32x4*)(xr + col); v[2 * c + 1] = *(const f32x4*)(xr + col + 4);
#pragma unroll
            for (int j = 0; j < 4; ++j) ss += v[2 * c][j] * v[2 * c][j] + v[2 * c + 1][j] * v[2 * c + 1][j]; }
        ss = wave_sum(ss);
        const float rstd = rsqrtf(ss * (1.0f / D) + EPS);
#pragma unroll
        for (int c = 0; c < 4; ++c) { const int col = c * 512 + lane * 8; f32x4 y[2];
#pragma unroll
            for (int q = 0; q < 2; ++q) { const f32x4 g4 = *(const f32x4*)(gn + col + 4 * q), sc = *(const f32x4*)(mrow + sc_off + col + 4 * q), sh = *(const f32x4*)(mrow + sh_off + col + 4 * q);
                y[q] = (v[2 * c + q] * rstd) * g4 * (sc + 1.0f) + sh; }
            if (obf) { u32x4 w; w.x = pack2(y[0][0], y[0][1]); w.y = pack2(y[0][2], y[0][3]); w.z = pack2(y[1][0], y[1][1]); w.w = pack2(y[1][2], y[1][3]); *(u32x4*)(obf + (size_t)t * D + col) = w; }
            else { *(f32x4*)(of32 + (size_t)t * D + col) = y[0]; *(f32x4*)(of32 + (size_t)t * D + col + 4) = y[1]; }
        }
    }
}

namespace hg {
constexpr int QS = 136, VS = 72;
constexpr int O_QT = 0, O_QH = O_QT + 64 * QS * 2, O_KT = O_QH + 64 * QS * 2, O_KDT = O_KT + 160 * QS * 2, O_VT = O_KDT + 128 * VS * 2,
              O_AB = O_VT + 128 * VS * 2, O_GS = O_AB + 64 * VS * 2, O_END = O_GS + 4 * 128 * 4;
constexpr int OS = 132;
static_assert(O_END <= 163840 - 64, "HGRN LDS layout too large");
constexpr int NCHUNK = SEQ / 64, NUNIT = PB * HH * NCHUNK;
}
DEV int kt_rowbase(int i) { return i == 0 ? 0 : (i == 1 ? 16 : (i == 2 ? 48 : 96)); }

DEV void hgrn_pre_unit(const Params& p, int l, int unit, unsigned char* lds) {
    using namespace hg;
    const int tid = threadIdx.x, lane = tid & 63, w = tid >> 6, g = lane >> 4, c16 = lane & 15;
    const int c = unit % NCHUNK, bh = unit / NCHUNK, b = bh / HH, h = bh % HH;
    bf16_t* Qt = (bf16_t*)(lds + O_QT); bf16_t* Qh = (bf16_t*)(lds + O_QH); bf16_t* Kt = (bf16_t*)(lds + O_KT);
    bf16_t* Kdt = (bf16_t*)(lds + O_KDT); bf16_t* Vt = (bf16_t*)(lds + O_VT); bf16_t* Ab = (bf16_t*)(lds + O_AB); float* Gs = (float*)(lds + O_GS);
    const int kk = tid & 127, sj = tid >> 7;
    float lbv = 0.f;
    if (l > 0) lbv = sigmoidf_(p.lb_logits[HH * HD + h * HD + kk] - p.lb_logits[h * HD + kk]);
    const float oml = 1.0f - lbv;
    for (int i = tid; i < 64 * VS / 2; i += 512) ((unsigned*)Ab)[i] = 0u;
    const size_t row0 = (size_t)b * SEQ + c * 64;
    float Gl[16], qv[16], kv[16];
    {
        const bf16_t* zr = p.z + (row0 + sj * 16) * ZW + h * HD + kk;
        unsigned short zq16[16], zf16[16], zi16[16];
#pragma unroll
        for (int s = 0; s < 16; ++s) { zq16[s] = zr[(size_t)s * ZW]; zf16[s] = zr[(size_t)s * ZW + 1024]; zi16[s] = zr[(size_t)s * ZW + 2048]; }
        float run = 0.f; unsigned vpk[8];
#pragma unroll
        for (int s = 0; s < 16; ++s) {
            const float zq = bf2f(zq16[s]), zf = fminf(fmaxf(bf2f(zf16[s]), -80.f), 80.f);
            const float e = __expf(-zf), sg = 1.0f / (1.0f + e);
            const float f = lbv + oml * sg;
            run += __logf(f); Gl[s] = run;
            kv[s] = oml * (e * sg);
            qv[s] = siluf_(zq);
            if (s & 1) vpk[s >> 1] |= (unsigned)zi16[s] << 16; else vpk[s >> 1] = zi16[s];
        }
        Gs[sj * 128 + kk] = run;
        *(u32x4*)(Vt + kk * VS + sj * 16) = (u32x4){vpk[0], vpk[1], vpk[2], vpk[3]}; *(u32x4*)(Vt + kk * VS + sj * 16 + 8) = (u32x4){vpk[4], vpk[5], vpk[6], vpk[7]};
    }
    __syncthreads();
    float Gend;
    {
        const float g0 = Gs[kk], g1 = Gs[128 + kk], g2 = Gs[256 + kk], g3 = Gs[384 + kk];
        float Gb[4]; Gb[0] = 0.f; Gb[1] = g0; Gb[2] = g0 + g1; Gb[3] = g0 + g1 + g2; Gend = Gb[3] + g3;
        const float Gbj = sj == 0 ? Gb[0] : (sj == 1 ? Gb[1] : (sj == 2 ? Gb[2] : Gb[3]));
        const float eGb = __expf(Gbj);
        unsigned kd[8]; unsigned qh[8];
#pragma unroll
        for (int s = 0; s < 16; ++s) {
            const int t = sj * 16 + s;
            const float q1 = qv[s] * __expf(Gl[s]);
            Qt[t * QS + kk] = (bf16_t)f2bf(q1);
            const unsigned qhv = f2bf(q1 * eGb);
            Qh[t * QS + kk] = (bf16_t)qhv;
#pragma unroll
            for (int i = 0; i < 4; ++i) if (i >= sj) Kt[(kt_rowbase(i) + t) * QS + kk] = (bf16_t)f2bf(kv[s] * __expf(fminf(Gb[i] - Gbj - Gl[s], 60.f)));
            const unsigned kdv = f2bf(kv[s] * __expf(Gend - Gbj - Gl[s]));
            if (s & 1) kd[s >> 1] |= kdv << 16; else kd[s >> 1] = kdv;
        }
        *(u32x4*)(Kdt + kk * VS + sj * 16) = (u32x4){kd[0], kd[1], kd[2], kd[3]}; *(u32x4*)(Kdt + kk * VS + sj * 16 + 8) = (u32x4){kd[4], kd[5], kd[6], kd[7]};
        if (sj == 0) p.hg_gam[(size_t)unit * HD + kk] = __expf(Gend);
    }
    __syncthreads();
    {
        const int t = tid >> 3, part = tid & 7;
        const u32x4 a = *(const u32x4*)(Qh + t * QS + 16 * part), b2 = *(const u32x4*)(Qh + t * QS + 16 * part + 8);
        bf16_t* dst = p.hg_qh + (row0 + t) * 1024 + h * HD + 16 * part; *(u32x4*)dst = a; *(u32x4*)(dst + 8) = b2;
    }
    for (int blk = w; blk < 10; blk += 8) {
        int bi, bjj;
        if (blk == 0) { bi = 0; bjj = 0; } else if (blk < 3) { bi = 1; bjj = blk - 1; } else if (blk < 6) { bi = 2; bjj = blk - 3; } else { bi = 3; bjj = blk - 6; }
        f32x4 acc = (f32x4){0.f, 0.f, 0.f, 0.f};
#pragma unroll
        for (int ks = 0; ks < 4; ++ks) {
            const bf16x8 a = *(const bf16x8*)(Qt + (16 * bi + c16) * QS + 32 * ks + 8 * g);
            const bf16x8 bb = *(const bf16x8*)(Kt + (kt_rowbase(bi) + 16 * bjj + c16) * QS + 32 * ks + 8 * g);
            acc = MFMA_BF16(a, bb, acc);
        }
#pragma unroll
        for (int r = 0; r < 4; ++r) { const int tl = 4 * g + r; float v = acc[r]; if (bi == bjj && c16 > tl) v = 0.f; Ab[(16 * bi + tl) * VS + 16 * bjj + c16] = (bf16_t)f2bf(v); }
    }
    __syncthreads();
    {
        f32x4* oin = (f32x4*)(p.hg_oin + (size_t)unit * 64 * 128);
#pragma unroll
        for (int tt = 0; tt < 4; ++tt) {
            f32x4 acc = (f32x4){0.f, 0.f, 0.f, 0.f};
#pragma unroll
            for (int ks = 0; ks < 2; ++ks) {
                const bf16x8 a = *(const bf16x8*)(Ab + (16 * tt + c16) * VS + 32 * ks + 8 * g);
                const bf16x8 bb = *(const bf16x8*)(Vt + (16 * w + c16) * VS + 32 * ks + 8 * g);
                acc = MFMA_BF16(a, bb, acc);
            }
            oin[(tt * 8 + w) * 64 + lane] = acc;
        }
        f32x4* ds = (f32x4*)(p.hg_ds + (size_t)unit * 128 * 128);
#pragma unroll
        for (int vt = 0; vt < 8; ++vt) {
            f32x4 acc = (f32x4){0.f, 0.f, 0.f, 0.f};
#pragma unroll
            for (int ks = 0; ks < 2; ++ks) {
                const bf16x8 a = *(const bf16x8*)(Kdt + (16 * w + c16) * VS + 32 * ks + 8 * g);
                const bf16x8 bb = *(const bf16x8*)(Vt + (16 * vt + c16) * VS + 32 * ks + 8 * g);
                acc = MFMA_BF16(a, bb, acc);
            }
            ds[(w * 8 + vt) * 64 + lane] = acc;
        }
    }
    __syncthreads();
}

DEV void hgrn_scan_unit(const Params& p, int l, int su) {
    using namespace hg;
    const int tid = threadIdx.x, lane = tid & 63, w = tid >> 6, g = lane >> 4, c16 = lane & 15;
    const int vt = su % 8, bh = su / 8, b = bh / HH, h = bh % HH;
    f32x4 S = (f32x4){0.f, 0.f, 0.f, 0.f};
    for (int c = 0; c < NCHUNK; ++c) {
        const size_t unit = (size_t)bh * NCHUNK + c;
        u32x2 sw; sw.x = pack2(S[0], S[1]); sw.y = pack2(S[2], S[3]);
        *(u32x2*)(p.hg_sc + (unit * 128 + 16 * vt + c16) * 128 + 16 * w + 4 * g) = sw;
        const f32x4 d = ((const f32x4*)(p.hg_ds + unit * 128 * 128))[(w * 8 + vt) * 64 + lane];
        const f32x4 gm = *(const f32x4*)(p.hg_gam + unit * HD + 16 * w + 4 * g);
        S = S * gm + d;
    }
    float* so = p.out + OFF_HP + ((size_t)(l * PB + b) * HH + h) * HD * HD;
#pragma unroll
    for (int r = 0; r < 4; ++r) so[(size_t)(16 * w + 4 * g + r) * HD + 16 * vt + c16] = S[r];
}

DEV void hgrn_post_unit(const Params& p, int l, int unit, unsigned char* lds) {
    using namespace hg;
    const int tid = threadIdx.x, lane = tid & 63, w = tid >> 6, g = lane >> 4, c16 = lane & 15;
    const int c = unit % NCHUNK, bh = unit / NCHUNK, b = bh / HH, h = bh % HH;
    float* Ob = (float*)lds;
    const size_t row0 = (size_t)b * SEQ + c * 64;
    const f32x4* oin = (const f32x4*)(p.hg_oin + (size_t)unit * 64 * 128);
    f32x4 acc[4];
#pragma unroll
    for (int tt = 0; tt < 4; ++tt) acc[tt] = oin[(tt * 8 + w) * 64 + lane];
    if (c > 0) {
        bf16x8 bfr[4];
#pragma unroll
        for (int ks = 0; ks < 4; ++ks) bfr[ks] = *(const bf16x8*)(p.hg_sc + ((size_t)unit * 128 + 16 * w + c16) * 128 + 32 * ks + 8 * g);
#pragma unroll
        for (int tt = 0; tt < 4; ++tt)
#pragma unroll
            for (int ks = 0; ks < 4; ++ks) { const bf16x8 a = *(const bf16x8*)(p.hg_qh + (row0 + 16 * tt + c16) * 1024 + h * HD + 32 * ks + 8 * g); acc[tt] = MFMA_BF16(a, bfr[ks], acc[tt]); }
    }
#pragma unroll
    for (int tt = 0; tt < 4; ++tt)
#pragma unroll
        for (int r = 0; r < 4; ++r) Ob[(16 * tt + 4 * g + r) * OS + 16 * w + c16] = acc[tt][r];
    __syncthreads();
    {
        const int t = tid >> 3, part = tid & 7; const size_t row = row0 + t;
        float ov[16]; float ss = 0.f;
#pragma unroll
        for (int q = 0; q < 4; ++q) { const f32x4 x = *(const f32x4*)(Ob + t * OS + 16 * part + 4 * q); ov[4 * q] = x[0]; ov[4 * q + 1] = x[1]; ov[4 * q + 2] = x[2]; ov[4 * q + 3] = x[3];
            ss += x[0] * x[0] + x[1] * x[1] + x[2] * x[2] + x[3] * x[3]; }
        ss += __shfl_xor(ss, 1); ss += __shfl_xor(ss, 2); ss += __shfl_xor(ss, 4);
        const float rstd = rsqrtf(ss * (1.0f / HD) + EPS);
        const bf16_t* zg = p.z + row * ZW + 3072 + h * HD + 16 * part;
        const u32x4 za = *(const u32x4*)zg, zc = *(const u32x4*)(zg + 8);
        const unsigned zw[8] = {za.x, za.y, za.z, za.w, zc.x, zc.y, zc.z, zc.w};
        const float* gn = p.hgrn_norm_g + l * HD + 16 * part;
        unsigned ow[8];
#pragma unroll
        for (int q = 0; q < 8; ++q) { const float a0 = ov[2 * q] * rstd * gn[2 * q] * siluf_(lo16(zw[q])), a1 = ov[2 * q + 1] * rstd * gn[2 * q + 1] * siluf_(hi16(zw[q])); ow[q] = pack2(a0, a1); }
        bf16_t* dst = p.cat + row * D + h * HD + 16 * part;
        *(u32x4*)dst = (u32x4){ow[0], ow[1], ow[2], ow[3]}; *(u32x4*)(dst + 8) = (u32x4){ow[4], ow[5], ow[6], ow[7]};
    }
    __syncthreads();
}

DEV void hgrn_sample_unit(const Params& p, int l, int unit, unsigned char* lds) {
    const int tid = threadIdx.x, lane = tid & 63, w = tid >> 6;
    const int b = unit / HH, h = unit % HH;
    float* fS = (float*)lds; float* kS = fS + 512; float* qS = kS + 512; float* vS = qS + 512; float* red = vS + 512; float* part = red + 4 * 4 * 128;
    const int r0 = NP + b * DSEQ;
    {
        const int t = tid >> 7, kk = tid & 127; const bf16_t* zr = p.z + (size_t)(r0 + t) * ZW + h * HD + kk;
        float lbv = 0.f; if (l > 0) lbv = sigmoidf_(p.lb_logits[HH * HD + h * HD + kk] - p.lb_logits[h * HD + kk]);
        const float zq = bf2f(zr[0]), zf = fminf(fmaxf(bf2f(zr[1024]), -80.f), 80.f), zi = bf2f(zr[2048]);
        const float e = __expf(-zf), sg = 1.0f / (1.0f + e);
        fS[tid] = lbv + (1.0f - lbv) * sg; kS[tid] = (1.0f - lbv) * (e * sg); qS[tid] = siluf_(zq); vS[tid] = zi;
    }
    const int v = tid & 127, kq = tid >> 7;
    const float* s0 = p.state_hgrn + ((size_t)(l * DB + b) * HH + h) * HD * HD + (size_t)(32 * kq) * HD + v;
    float S[32];
#pragma unroll
    for (int i = 0; i < 32; ++i) S[i] = s0[(size_t)i * HD];
    __syncthreads();
#pragma unroll
    for (int t = 0; t < 4; ++t) {
        const float vv = vS[t * 128 + v]; float po = 0.f;
#pragma unroll
        for (int i = 0; i < 32; ++i) { const int kk = t * 128 + 32 * kq + i; S[i] = fS[kk] * S[i] + kS[kk] * vv; po += qS[kk] * S[i]; }
        red[(t * 4 + kq) * 128 + v] = po;
    }
    float* so = p.out + OFF_HS + ((size_t)(l * DB + b) * HH + h) * HD * HD + (size_t)(32 * kq) * HD + v;
#pragma unroll
    for (int i = 0; i < 32; ++i) so[(size_t)i * HD] = S[i];
    __syncthreads();
    {
        const int t = tid >> 7; const float o = red[(t * 4 + 0) * 128 + v] + red[(t * 4 + 1) * 128 + v] + red[(t * 4 + 2) * 128 + v] + red[(t * 4 + 3) * 128 + v];
        const float ss = wave_sum(o * o);
        if (lane == 0) part[w] = ss;
        __syncthreads();
        const float tot = part[2 * t] + part[2 * t + 1];
        const float rstd = rsqrtf(tot * (1.0f / HD) + EPS);
        const float zg = bf2f(p.z[(size_t)(r0 + t) * ZW + 3072 + h * HD + v]);
        p.cat[(size_t)(r0 + t) * D + h * HD + v] = (bf16_t)f2bf(o * rstd * p.hgrn_norm_g[l * HD + v] * siluf_(zg));
    }
    __syncthreads();
}

DEV void pool_pre_unit(const Params& p, int l, int unit) {
    const int tid = threadIdx.x, tk = tid >> 7, cg = tid & 127, c = cg * 8, gi = cg >> 5, wnd = 2 << gi;
    const int r = unit * 4 + tk;
    if (r >= NTOK) return;
    f32x2 sum[4] = {{0.f, 0.f}, {0.f, 0.f}, {0.f, 0.f}, {0.f, 0.f}}; float cur[8];
    float cnt;
    if (r < NP) {
        const int t = r % SEQ; const int n = (wnd < t + 1) ? wnd : (t + 1); cnt = (float)n;
        u32x4 q[16];
#pragma unroll
        for (int j = 0; j < 16; ++j) q[j] = (j < n) ? *(const u32x4*)(p.z + (size_t)(r - j) * ZW + 4096 + c) : (u32x4){0u, 0u, 0u, 0u};
#pragma unroll
        for (int j = 0; j < 16; ++j) { sum[0] += (f32x2){lo16(q[j].x), hi16(q[j].x)}; sum[1] += (f32x2){lo16(q[j].y), hi16(q[j].y)}; sum[2] += (f32x2){lo16(q[j].z), hi16(q[j].z)}; sum[3] += (f32x2){lo16(q[j].w), hi16(q[j].w)}; }
        cur[0] = lo16(q[0].x); cur[1] = hi16(q[0].x); cur[2] = lo16(q[0].y); cur[3] = hi16(q[0].y); cur[4] = lo16(q[0].z); cur[5] = hi16(q[0].z); cur[6] = lo16(q[0].w); cur[7] = hi16(q[0].w);
        if (t >= SEQ - PBUF) { float* o = p.out + OFF_PP + ((size_t)(l * PB + r / SEQ) * PBUF + (t - (SEQ - PBUF))) * PW + c;
            *(f32x4*)o = (f32x4){cur[0], cur[1], cur[2], cur[3]}; *(f32x4*)(o + 4) = (f32x4){cur[4], cur[5], cur[6], cur[7]}; }
    } else {
        const int bb = (r - NP) / DSEQ, t = (r - NP) % DSEQ; cnt = (float)wnd;
        const float* sp = p.state_pool + (size_t)(l * DB + bb) * PBUF * PW + c;
        u32x4 q[4]; f32x4 sa[15], sb[15];
#pragma unroll
        for (int j = 0; j < 4; ++j) q[j] = (j <= t && j < wnd) ? *(const u32x4*)(p.z + (size_t)(NP + bb * DSEQ + t - j) * ZW + 4096 + c) : (u32x4){0u, 0u, 0u, 0u};
#pragma unroll
        for (int j = 1; j < 16; ++j) {
            const int back = j - t;
            const bool use = (back >= 1) && (j < wnd);
            const float* srow = sp + (size_t)(PBUF - (use ? back : 1)) * PW;
            sa[j - 1] = use ? *(const f32x4*)srow : (f32x4){0.f, 0.f, 0.f, 0.f}; sb[j - 1] = use ? *(const f32x4*)(srow + 4) : (f32x4){0.f, 0.f, 0.f, 0.f};
        }
#pragma unroll
        for (int j = 0; j < 4; ++j) { sum[0] += (f32x2){lo16(q[j].x), hi16(q[j].x)}; sum[1] += (f32x2){lo16(q[j].y), hi16(q[j].y)}; sum[2] += (f32x2){lo16(q[j].z), hi16(q[j].z)}; sum[3] += (f32x2){lo16(q[j].w), hi16(q[j].w)}; }
#pragma unroll
        for (int j = 0; j < 15; ++j) { sum[0] += (f32x2){sa[j][0], sa[j][1]}; sum[1] += (f32x2){sa[j][2], sa[j][3]}; sum[2] += (f32x2){sb[j][0], sb[j][1]}; sum[3] += (f32x2){sb[j][2], sb[j][3]}; }
        cur[0] = lo16(q[0].x); cur[1] = hi16(q[0].x); cur[2] = lo16(q[0].y); cur[3] = hi16(q[0].y); cur[4] = lo16(q[0].z); cur[5] = hi16(q[0].z); cur[6] = lo16(q[0].w); cur[7] = hi16(q[0].w);
        float* ob = p.out + OFF_PS + (size_t)(l * DB + bb) * PBUF * PW + c;
        { float* o = ob + (size_t)(11 + t) * PW; *(f32x4*)o = (f32x4){cur[0], cur[1], cur[2], cur[3]}; *(f32x4*)(o + 4) = (f32x4){cur[4], cur[5], cur[6], cur[7]}; }
        for (int i = t; i < 11; i += 4) { const float* s2 = sp + (size_t)(4 + i) * PW; float* o = ob + (size_t)i * PW; *(f32x4*)o = *(const f32x4*)s2; *(f32x4*)(o + 4) = *(const f32x4*)(s2 + 4); }
    }
    const float inv = 1.0f / cnt;
    u32x4 w; w.x = pack2(sum[0][0] * inv - cur[0], sum[0][1] * inv - cur[1]); w.y = pack2(sum[1][0] * inv - cur[2], sum[1][1] * inv - cur[3]);
    w.z = pack2(sum[2][0] * inv - cur[4], sum[2][1] * inv - cur[5]); w.w = pack2(sum[3][0] * inv - cur[6], sum[3][1] * inv - cur[7]);
    *(u32x4*)(p.pooled + ((size_t)gi * MPAD + r) * 256 + (c & 255)) = w;
}

#ifndef PROBE_SUB
#define PROBE_SUB 0
#endif
DEV void phase_mix1(const Params& p, int l, unsigned char* lds) {
    for (int rep = 0; rep < (PROBE_SUB == 1 ? 2 : 1); ++rep) for (int u = blockIdx.x; u < hg::NUNIT; u += gridDim.x) hgrn_pre_unit(p, l, u, lds);
    for (int rep = 0; rep < (PROBE_SUB == 2 ? 2 : 1); ++rep) for (int u = blockIdx.x; u < DB * HH; u += gridDim.x) hgrn_sample_unit(p, l, u, lds);
    for (int rep = 0; rep < (PROBE_SUB == 3 ? 2 : 1); ++rep) for (int u = blockIdx.x; u < (NTOK + 3) / 4; u += gridDim.x) pool_pre_unit(p, l, u);
}
DEV void phase_mix2(const Params& p, int l) { for (int u = blockIdx.x; u < PB * HH * 8; u += gridDim.x) hgrn_scan_unit(p, l, u); }
DEV void phase_mix3(const Params& p, int l, unsigned char* lds) { for (int u = blockIdx.x; u < hg::NUNIT; u += gridDim.x) hgrn_post_unit(p, l, u, lds); }

#ifdef HIPEMU
#define MBCNT(mask) __builtin_popcountll((mask) & ((1ull << emu_lane()) - 1ull))
#define POPC64(m) __builtin_popcountll(m)
#else
#define MBCNT(mask) ((int)__builtin_amdgcn_mbcnt_hi((unsigned)((mask) >> 32), __builtin_amdgcn_mbcnt_lo((unsigned)(mask), 0u)))
#define POPC64(m) __popcll(m)
#endif
DEV unsigned fkey(float f) { const unsigned u = __float_as_uint(f); return u ^ ((unsigned)((int)u >> 31) | 0x80000000u); }
DEV unsigned long long lowest_n_bits(unsigned long long m, int n) { unsigned long long r = 0ull; while (n > 0 && m) { const unsigned long long b = m & (~m + 1ull); r |= b; m ^= b; --n; } return r; }
#ifdef HIPEMU
#define DPPU_XOR1(v) __shfl((v), emu_lane() ^ 1)
#define DPPU_XOR2(v) __shfl((v), emu_lane() ^ 2)
#define DPPU_HMIRROR(v) __shfl((v), (emu_lane() & ~7) | (7 - (emu_lane() & 7)))
#else
template <int CTRL> DEV unsigned dpp_u(unsigned v) { return (unsigned)__builtin_amdgcn_update_dpp(0, (int)v, CTRL, 0xf, 0xf, true); }
#define DPPU_XOR1(v) dpp_u<0xB1>(v)
#define DPPU_XOR2(v) dpp_u<0x4E>(v)
#define DPPU_HMIRROR(v) dpp_u<0x141>(v)
#endif
template <int GL> DEV unsigned group_sum(unsigned c) { c += DPPU_XOR1(c); c += DPPU_XOR2(c); if (GL == 8) c += DPPU_HMIRROR(c); return c; }
template <int GL> DEV unsigned group_or(unsigned c) { c |= DPPU_XOR1(c); c |= DPPU_XOR2(c); if (GL == 8) c |= DPPU_HMIRROR(c); return c; }
template <int GL> DEV float group_maxf(float v) { v = fmaxf(v, DPP_XOR1(v)); v = fmaxf(v, DPP_XOR2(v)); if (GL == 8) v = fmaxf(v, DPP_HMIRROR(v)); return v; }
template <int GL> DEV float group_sumf(float v) { v += DPP_XOR1(v); v += DPP_XOR2(v); if (GL == 8) v += DPP_HMIRROR(v); return v; }
DEV unsigned bytesum(unsigned w) { return (w * 0x01010101u) >> 24; }
template <int GL> DEV unsigned group_excl_prefix(unsigned c, int sub) {
    const unsigned sh = 8u * (unsigned)(sub & 3);
    unsigned wlo = (GL == 4 || sub < 4) ? (c << sh) : 0u, whi = (GL == 8 && sub >= 4) ? (c << sh) : 0u;
    wlo = group_or<GL>(wlo);
    unsigned r;
    if (GL == 4) r = bytesum(wlo & ((1u << sh) - 1u));
    else { whi = group_or<GL>(whi); r = sub < 4 ? bytesum(wlo & ((1u << sh) - 1u)) : bytesum(wlo) + bytesum(whi & ((1u << sh) - 1u)); }
    return r;
}
DEV float fkey_inv(unsigned k) { return __uint_as_float((k & 0x80000000u) ? (k ^ 0x80000000u) : ~k); }
template <int GL> DEV unsigned group_top16(const unsigned (&k)[32], bool active, int sub, unsigned& pos0) {
    unsigned mxk = 0u;
#pragma unroll
    for (int i = 0; i < 32; ++i) mxk = k[i] > mxk ? k[i] : mxk;
    { unsigned o = DPPU_XOR1(mxk); mxk = o > mxk ? o : mxk; o = DPPU_XOR2(mxk); mxk = o > mxk ? o : mxk; if (GL == 8) { o = DPPU_HMIRROR(mxk); mxk = o > mxk ? o : mxk; } }
    unsigned L0 = mxk > 0x01000000u ? mxk - 0x01000000u : 0u, c0 = 0u;
#pragma unroll
    for (int i = 0; i < 32; ++i) c0 += (k[i] > L0) ? 1u : 0u;
    c0 = group_sum<GL>(c0);
    unsigned L = c0 > 16u ? L0 + 1u : 0u, R = active ? mxk : 0u, cR = 0u;
    if (!active) L = 0u;
    if (c0 == 16u && active) { L = L0; R = L0; cR = 16u; }
    for (;;) {
        if (__ballot(L < R) == 0ull) break;
        const unsigned mid = L + ((R - L) >> 1);
        unsigned c = 0u;
#pragma unroll
        for (int i = 0; i < 32; ++i) c += (k[i] > mid) ? 1u : 0u;
        c = group_sum<GL>(c);
        const bool le = c <= 16u, hit = c == 16u;
        R = le ? mid : R; cR = le ? c : cR; L = hit ? mid : (le ? L : mid + 1u);
    }
    unsigned mask = 0u;
#pragma unroll
    for (int i = 0; i < 32; ++i) mask |= (k[i] > R) ? (1u << i) : 0u;
    const unsigned need = 16u - cR;
    if (__ballot(active && need > 0u) != 0ull) {
        unsigned eqm = 0u;
#pragma unroll
        for (int i = 0; i < 32; ++i) eqm |= (k[i] == R) ? (1u << i) : 0u;
        const unsigned eqc = (unsigned)__builtin_popcount(eqm), before = group_excl_prefix<GL>(eqc, sub);
        unsigned take = need > before ? need - before : 0u; if (take > eqc) take = eqc;
        if (!active) take = 0u;
        while (take > 0u) { const unsigned b = eqm & (~eqm + 1u); mask |= b; eqm ^= b; --take; }
    }
    if (!active) mask = 0u;
    pos0 = group_excl_prefix<GL>((unsigned)__builtin_popcount(mask), sub);
    return mask;
}
constexpr int SEL_NT = 4;
constexpr int SEL_RS = 144;
DEV void select_step(const Params& p, int l, int tt0, int tstride, int ntile, int h, unsigned char* lds, const bf16x8 (&kh)[2][4], const bf16x8 (&kl)[2][4]) {
    const int tid = threadIdx.x, lane = tid & 63, w = tid >> 6, g = lane >> 4, c16 = lane & 15;
    constexpr int NTK = SEL_NT * 16;
    constexpr int QRS = 264;
    bf16_t* qh = (bf16_t*)lds;
    bf16_t* ql = qh + NTK * QRS;
    float* sc = (float*)(ql + NTK * QRS);
    float* ts = sc + 2 * NTK * SEL_RS;
    int* ti = (int*)(ts + 2 * NTK * 16);
#pragma unroll
    for (int k = 0; k < SEL_NT; ++k) {
        const int tk = tid >> 5, part = tid & 31; const int tok = (tt0 + k * tstride) * 16 + tk;
        f32x4 a = (f32x4){0.f, 0.f, 0.f, 0.f}, b2 = a;
        if (k < ntile && tok < NTOK) { const float* q = p.qry + (size_t)tok * D + h * 256 + part * 8; a = *(const f32x4*)q; b2 = *(const f32x4*)(q + 4); }
        float ss = a[0] * a[0] + a[1] * a[1] + a[2] * a[2] + a[3] * a[3] + b2[0] * b2[0] + b2[1] * b2[1] + b2[2] * b2[2] + b2[3] * b2[3];
        ss += __shfl_xor(ss, 1); ss += __shfl_xor(ss, 2); ss += __shfl_xor(ss, 4); ss += __shfl_xor(ss, 8);
        const float rn = rsqrtf(ss * (1.0f / 128.0f) + EPS);
        const float v[8] = {a[0] * rn, a[1] * rn, a[2] * rn, a[3] * rn, b2[0] * rn, b2[1] * rn, b2[2] * rn, b2[3] * rn};
        unsigned hi[4], lo[4];
#pragma unroll
        for (int j = 0; j < 4; ++j) { hi[j] = pack2(v[2 * j], v[2 * j + 1]); lo[j] = pack2(v[2 * j] - lo16(hi[j]), v[2 * j + 1] - hi16(hi[j])); }
        *(u32x4*)(qh + (k * 16 + tk) * QRS + part * 8) = (u32x4){hi[0], hi[1], hi[2], hi[3]}; *(u32x4*)(ql + (k * 16 + tk) * QRS + part * 8) = (u32x4){lo[0], lo[1], lo[2], lo[3]};
    }
    __syncthreads();
    for (int k = 0; k < ntile; ++k) {
#pragma unroll
        for (int ph = 0; ph < 2; ++ph) {
            f32x4 acc = (f32x4){0.f, 0.f, 0.f, 0.f};
#pragma unroll
            for (int ks = 0; ks < 4; ++ks) {
                const bf16x8 ah = *(const bf16x8*)(qh + (k * 16 + c16) * QRS + ph * 128 + 32 * ks + 8 * g), al = *(const bf16x8*)(ql + (k * 16 + c16) * QRS + ph * 128 + 32 * ks + 8 * g);
                acc = MFMA_BF16(al, kh[ph][ks], acc); acc = MFMA_BF16(ah, kl[ph][ks], acc); acc = MFMA_BF16(ah, kh[ph][ks], acc);
            }
            const int kidx = 16 * w + c16;
#pragma unroll
            for (int r = 0; r < 4; ++r) sc[(ph * NTK + k * 16 + 4 * g + r) * SEL_RS + (kidx >> 5) * 36 + (kidx & 31)] = acc[r];
        }
    }
    __syncthreads();
    {
        const int row = tid >> 2, sub = tid & 3; const bool active = ((row % NTK) >> 4) < ntile;
        unsigned k[32];
#pragma unroll
        for (int i4 = 0; i4 < 8; ++i4) { const f32x4 v = *(const f32x4*)(sc + row * SEL_RS + sub * 36 + 4 * i4); k[4 * i4] = fkey(v[0]); k[4 * i4 + 1] = fkey(v[1]); k[4 * i4 + 2] = fkey(v[2]); k[4 * i4 + 3] = fkey(v[3]); }
        unsigned pos; const unsigned mask = group_top16<4>(k, active, sub, pos);
#pragma unroll
        for (int i = 0; i < 32; ++i) if ((mask >> i) & 1u) { if (pos < 16u) { ts[row * 16 + pos] = fkey_inv(k[i]); ti[row * 16 + pos] = 32 * sub + i; } ++pos; }
    }
    __syncthreads();
    {
        const int tk = tid >> 3, sub = tid & 7; const bool active = (tk >> 4) < ntile; const int tok = (tt0 + (tk >> 4) * tstride) * 16 + (tk & 15);
        const float s1a = ts[tk * 16 + 2 * sub], s1b = ts[tk * 16 + 2 * sub + 1];
        unsigned k[32];
#pragma unroll
        for (int j4 = 0; j4 < 4; ++j4) { const f32x4 s2 = *(const f32x4*)(ts + (NTK + tk) * 16 + 4 * j4);
#pragma unroll
            for (int j = 0; j < 4; ++j) { k[4 * j4 + j] = fkey(s1a + s2[j]); k[16 + 4 * j4 + j] = fkey(s1b + s2[j]); } }
        unsigned pos; const unsigned mask = group_top16<8>(k, active, sub, pos);
        const int i1a = ti[tk * 16 + 2 * sub], i1b = ti[tk * 16 + 2 * sub + 1];
        int i2v[16];
#pragma unroll
        for (int j4 = 0; j4 < 4; ++j4) { const u32x4 t4 = *(const u32x4*)(ti + (NTK + tk) * 16 + 4 * j4); i2v[4 * j4] = (int)t4.x; i2v[4 * j4 + 1] = (int)t4.y; i2v[4 * j4 + 2] = (int)t4.z; i2v[4 * j4 + 3] = (int)t4.w; }
        u32x2* lst = (u32x2*)sc;
#pragma unroll
        for (int i = 0; i < 32; ++i) if ((mask >> i) & 1u) { if (pos < 16u) lst[tk * 16 + pos] = (u32x2){__float_as_uint(fkey_inv(k[i])), (unsigned)((i < 16 ? i1a : i1b) * 128 + i2v[i & 15])}; ++pos; }
    }
    __syncthreads();
#pragma unroll
    for (int r = 0; r < NTK / 32; ++r) {
        const int tk = (tid >> 4) + 32 * r, slot = tid & 15; const int tok = (tt0 + (tk >> 4) * tstride) * 16 + (tk & 15);
        const u32x2 en = ((const u32x2*)sc)[tk * 16 + slot];
        const float v = __uint_as_float(en.x); const int e = (int)en.y;
        float mx = v; mx = fmaxf(mx, DPP_XOR1(mx)); mx = fmaxf(mx, DPP_XOR2(mx)); mx = fmaxf(mx, DPP_HMIRROR(mx)); mx = fmaxf(mx, DPP_RMIRROR(mx));
        const float ex = __expf(v - mx);
        float sm = ex; sm += DPP_XOR1(sm); sm += DPP_XOR2(sm); sm += DPP_HMIRROR(sm); sm += DPP_RMIRROR(sm);
        if ((tk >> 4) < ntile && tok < NTOK) { const size_t o = (size_t)tok * 128 + h * 16 + slot;
            p.eidx[o] = (unsigned short)e; p.gate[o] = ex / sm * p.sv[l * NE + e]; p.iscu[o] = p.su[l * NE + e]; }
    }
    __syncthreads();
}
DEV void phase_select(const Params& p, int l, unsigned char* lds) {
    const int ntt = (NTOK + 15) / 16, lane = threadIdx.x & 63, w = threadIdx.x >> 6, g = lane >> 4, c16 = lane & 15;
    const bool fixed = (gridDim.x % 8u) == 0u;
    const int nq = fixed ? (int)(gridDim.x >> 3) : 1;
    for (int hh = 0; hh < (fixed ? 1 : 8); ++hh) {
        const int h = fixed ? (int)(blockIdx.x & 7) : hh;
        bf16x8 kh[2][4], kl[2][4];
#pragma unroll
        for (int ph = 0; ph < 2; ++ph)
#pragma unroll
            for (int ks = 0; ks < 4; ++ks) { const float* kr = p.peer_keys + ((size_t)((l * 8 + h) * 2 + ph) * 128 + 16 * w + c16) * 128 + 32 * ks + 8 * g;
                const f32x4 a = *(const f32x4*)kr, b2 = *(const f32x4*)(kr + 4); const float v[8] = {a[0], a[1], a[2], a[3], b2[0], b2[1], b2[2], b2[3]};
                u32x4 hi, lo; unsigned hw[4], lw[4];
#pragma unroll
                for (int j = 0; j < 4; ++j) { hw[j] = pack2(v[2 * j], v[2 * j + 1]); lw[j] = pack2(v[2 * j] - lo16(hw[j]), v[2 * j + 1] - hi16(hw[j])); }
                hi = (u32x4){hw[0], hw[1], hw[2], hw[3]}; lo = (u32x4){lw[0], lw[1], lw[2], lw[3]};
                kh[ph][ks] = __builtin_bit_cast(bf16x8, hi); kl[ph][ks] = __builtin_bit_cast(bf16x8, lo); }
        const int first = fixed ? (int)(blockIdx.x >> 3) : (int)blockIdx.x, stride = fixed ? nq : (int)gridDim.x;
        for (int tt0 = first; tt0 < ntt; tt0 += SEL_NT * stride) {
            int ntile = 0;
#pragma unroll
            for (int k = 0; k < SEL_NT; ++k) if (tt0 + k * stride < ntt) ntile = k + 1;
            select_step(p, l, tt0, stride, ntile, h, lds, kh, kl);
        }
    }
}

constexpr int PEER_TB = 272;
struct PeerDeal { int xs_first, xs_step, t_begin, t_end; };
DEV PeerDeal peer_deal() {
    PeerDeal d; const bool sl = (gridDim.x % 8u) == 0u;
    const int nranks = sl ? (int)(gridDim.x >> 3) : (int)gridDim.x, rank = sl ? (int)(blockIdx.x >> 3) : (int)blockIdx.x, tpr = (NTOK + nranks - 1) / nranks;
    d.xs_first = sl ? (int)(blockIdx.x & 7) : 0; d.xs_step = sl ? 8 : 1; d.t_begin = rank * tpr; d.t_end = d.t_begin + tpr < NTOK ? d.t_begin + tpr : NTOK;
    return d;
}
struct PeerTok { u32x4 e0, e1, ha, hb; };
DEV void peer_fetch_u(const Params& p, int t, int c0, int g8, PeerTok& k) {
    const u32x4* ep = (const u32x4*)(p.eidx + (size_t)t * 128 + 16 * g8); k.e0 = ep[0]; k.e1 = ep[1];
    k.ha = *(const u32x4*)(p.hB + (size_t)t * D + c0); k.hb = *(const u32x4*)(p.hB + (size_t)t * D + c0 + 8);
}
DEV void phase_peer_u(const Params& p, int l, unsigned char* lds) {
    const int lane = threadIdx.x & 63, w = threadIdx.x >> 6, j8 = lane & 7, g8 = lane >> 3;
    const bool b2 = (j8 & 4) != 0, b1 = (j8 & 2) != 0, b0 = (j8 & 1) != 0;
    const PeerDeal dl = peer_deal();
    const unsigned char* U = p.u8 + (size_t)l * NE * D;
    float* lp = (float*)lds;
    for (int xs = dl.xs_first; xs < 8; xs += dl.xs_step)
    for (int t0 = dl.t_begin; t0 < dl.t_end; t0 += PEER_TB) {
        const int nb = dl.t_end - t0 < PEER_TB ? dl.t_end - t0 : PEER_TB;
        for (int ch = 0; ch < 2; ++ch) {
            const int c0 = 256 * xs + 128 * ch + 16 * j8;
            const unsigned char* Us = U + (size_t)(2 * xs + ch) * NE * 128 + 16 * j8;
            PeerTok nx; if (w < nb) peer_fetch_u(p, t0 + w, c0, g8, nx);
            for (int tk = w; tk < nb; tk += 8) {
                const int t = t0 + tk;
                const PeerTok cu = nx;
                const unsigned ew[8] = {cu.e0.x, cu.e0.y, cu.e0.z, cu.e0.w, cu.e1.x, cu.e1.y, cu.e1.z, cu.e1.w}; unsigned ev[16];
#pragma unroll
                for (int i = 0; i < 8; ++i) { ev[2 * i] = ew[i] & 0xffffu; ev[2 * i + 1] = ew[i] >> 16; }
                u32x4 q[16];
#pragma unroll
                for (int i = 0; i < 16; ++i) q[i] = *(const u32x4*)(Us + (size_t)ev[i] * 128);
                if (tk + 8 < nb) peer_fetch_u(p, t + 8, c0, g8, nx);
                const u32x4 ha = cu.ha, hb = cu.hb;
                const f32x2 hf[8] = {{lo16(ha.x), hi16(ha.x)}, {lo16(ha.y), hi16(ha.y)}, {lo16(ha.z), hi16(ha.z)}, {lo16(ha.w), hi16(ha.w)}, {lo16(hb.x), hi16(hb.x)}, {lo16(hb.y), hi16(hb.y)}, {lo16(hb.z), hi16(hb.z)}, {lo16(hb.w), hi16(hb.w)}};
                float ps[16];
#pragma unroll
                for (int i = 0; i < 16; ++i) { f32x2 dq[8]; fp8x16_dec2(q[i], dq); f32x2 a = dq[0] * hf[0];
#pragma unroll
                    for (int k = 1; k < 8; ++k) a = __builtin_elementwise_fma(dq[k], hf[k], a);
                    ps[i] = a[0] + a[1]; }
                float q8[8], q4[4], q2[2];
#pragma unroll
                for (int k = 0; k < 8; ++k) { const float keep = b2 ? ps[8 + k] : ps[k], send = b2 ? ps[k] : ps[8 + k]; q8[k] = keep + DPP_HMIRROR(send); }
#pragma unroll
                for (int k = 0; k < 4; ++k) { const float keep = b1 ? q8[4 + k] : q8[k], send = b1 ? q8[k] : q8[4 + k]; q4[k] = keep + DPP_XOR2(send); }
#pragma unroll
                for (int k = 0; k < 2; ++k) { const float keep = b0 ? q4[2 + k] : q4[k], send = b0 ? q4[k] : q4[2 + k]; q2[k] = keep + DPP_XOR1(send); }
                float* lrow = lp + tk * 128 + 16 * g8 + 2 * j8;
                if (ch == 0) { lrow[0] = q2[0]; lrow[1] = q2[1]; }
                else { const size_t o = (size_t)t * 128 + 16 * g8 + 2 * j8;
                    float* dst = p.part + ((size_t)t * 8 + xs) * 128 + 16 * g8 + 2 * j8;
                    dst[0] = (q2[0] + lrow[0]) * p.iscu[o]; dst[1] = (q2[1] + lrow[1]) * p.iscu[o + 1]; }
            }
        }
    }
}
DEV void phase_peer_c(const Params& p) {
    const size_t n = (size_t)NTOK * 128, gs = (size_t)gridDim.x * 512;
    for (size_t i = (size_t)blockIdx.x * 512 + threadIdx.x; i < n; i += gs) {
        const size_t t = i >> 7; const int pr = (int)(i & 127); float sacc = 0.f;
#pragma unroll
        for (int x = 0; x < 8; ++x) sacc += p.part[(t * 8 + x) * 128 + pr];
        p.ab16[i] = (bf16_t)f2bf(gelu_erf(sacc) * p.gate[i]);
    }
}
struct PeerTokV { u32x4 e0, e1, a0, a1; f32x2 x1, g2; };
DEV void peer_fetch_v(const Params& p, int l, int t, int col, int g8, PeerTokV& k) {
    const u32x4* ep = (const u32x4*)(p.eidx + (size_t)t * 128 + 16 * g8); k.e0 = ep[0]; k.e1 = ep[1];
    const u32x4* ap = (const u32x4*)(p.ab16 + (size_t)t * 128 + 16 * g8); k.a0 = ap[0]; k.a1 = ap[1];
    k.x1 = *(const f32x2*)(p.xa + (size_t)t * D + col); k.g2 = *(const f32x2*)(p.modbuf + (size_t)tok_batch(t) * MODW + l * NMOD + 5 * D + col);
}
DEV void phase_peer_v(const Params& p, int l, unsigned char* lds) {
    const int lane = threadIdx.x & 63, w = threadIdx.x >> 6, j8 = lane & 7, g8 = lane >> 3;
    const bool b3 = (g8 & 1) != 0, b4 = (g8 & 2) != 0, b5 = (g8 & 4) != 0;
    const PeerDeal dl = peer_deal();
    const unsigned char* V = p.v8 + (size_t)l * NE * D;
    for (int xs = dl.xs_first; xs < 8; xs += dl.xs_step)
        for (int ch = 0; ch < 2; ++ch) {
            const int c0 = 256 * xs + 128 * ch + 16 * j8, col = c0 + (b3 ? 8 : 0) + (b4 ? 4 : 0) + (b5 ? 2 : 0);
            const unsigned char* Vs = V + (size_t)(2 * xs + ch) * NE * 128 + 16 * j8;
            PeerTokV nx; if (dl.t_begin + w < dl.t_end) peer_fetch_v(p, l, dl.t_begin + w, col, g8, nx);
            for (int t = dl.t_begin + w; t < dl.t_end; t += 8) {
                const PeerTokV cu = nx;
                const unsigned ew[8] = {cu.e0.x, cu.e0.y, cu.e0.z, cu.e0.w, cu.e1.x, cu.e1.y, cu.e1.z, cu.e1.w}; unsigned ev[16];
#pragma unroll
                for (int i = 0; i < 8; ++i) { ev[2 * i] = ew[i] & 0xffffu; ev[2 * i + 1] = ew[i] >> 16; }
                u32x4 q[16];
#pragma unroll
                for (int i = 0; i < 16; ++i) q[i] = *(const u32x4*)(Vs + (size_t)ev[i] * 128);
                if (t + 8 < dl.t_end) peer_fetch_v(p, l, t + 8, col, g8, nx);
                const unsigned aw[8] = {cu.a0.x, cu.a0.y, cu.a0.z, cu.a0.w, cu.a1.x, cu.a1.y, cu.a1.z, cu.a1.w}; float av[16];
#pragma unroll
                for (int i = 0; i < 8; ++i) { av[2 * i] = lo16(aw[i]); av[2 * i + 1] = hi16(aw[i]); }
                f32x2 acc2[8];
#pragma unroll
                for (int k = 0; k < 8; ++k) acc2[k] = (f32x2){0.f, 0.f};
#pragma unroll
                for (int i = 0; i < 16; ++i) { f32x2 dq[8]; fp8x16_dec2(q[i], dq); const f32x2 a2v = (f32x2){av[i], av[i]};
#pragma unroll
                    for (int k = 0; k < 8; ++k) acc2[k] = __builtin_elementwise_fma(a2v, dq[k], acc2[k]); }
                float acc[16];
#pragma unroll
                for (int k = 0; k < 8; ++k) { acc[2 * k] = acc2[k][0]; acc[2 * k + 1] = acc2[k][1]; }
                float q8[8], q4[4], q2[2];
#pragma unroll
                for (int k = 0; k < 8; ++k) { const float keep = b3 ? acc[8 + k] : acc[k], send = b3 ? acc[k] : acc[8 + k]; q8[k] = keep + DPP_XOR8(send); }
#pragma unroll
                for (int k = 0; k < 4; ++k) q4[k] = xsum16(q8[k], q8[4 + k]);
#pragma unroll
                for (int k = 0; k < 2; ++k) q2[k] = xsum32(q4[k], q4[2 + k]);
                f32x2 o; o[0] = cu.x1[0] + cu.g2[0] * q2[0]; o[1] = cu.x1[1] + cu.g2[1] * q2[1];
                *(f32x2*)(p.xb + (size_t)t * D + col) = o;
            }
        }
}

constexpr int N_PHASES = 27;
DEV int phase_class(int k) { return k < 2 ? k : (k == 26 ? 14 : 2 + (k - 2) % 12); }
#ifndef HIPEMU
#define XB_TMO      128
#define XB_XCNT(j)  (256  + 64 * (j))
#define XB_XSUB(j)  (1280 + 64 * (j))
#define XB_XGEN(j)  (2304 + 64 * (j))
#define XB_TOP      3328
#define XB_TOPGEN   3392
#define XCD_BAR_WORDS 3456
#define XB_SPIN_CAP (1u << 22)
__device__ __forceinline__ unsigned xb_ld(unsigned* p)              { return __hip_atomic_load(p, __ATOMIC_RELAXED, __HIP_MEMORY_SCOPE_AGENT); }
__device__ __forceinline__ unsigned xb_add(unsigned* p, unsigned v) { return __hip_atomic_fetch_add(p, v, __ATOMIC_RELAXED, __HIP_MEMORY_SCOPE_AGENT); }
__device__ __forceinline__ unsigned xb_xcc_id() { return (unsigned)__builtin_amdgcn_s_getreg((3 << 11) | 20) & 0xFu; }
#define XB_SPIN(cond, bar) do { unsigned _sp = 0; while (cond) { __builtin_amdgcn_s_sleep(1); \
    if ((++_sp & 255u) == 0u) { if (xb_ld(&(bar)[XB_TMO])) break; if (_sp > XB_SPIN_CAP) { atomicAdd(&(bar)[XB_TMO], 1u); break; } } } } while (0)
struct XcdBarrier { unsigned* bar; unsigned x; volatile LAS unsigned* st; };
__device__ __forceinline__ XcdBarrier xcd_barrier_post(unsigned* bar, volatile LAS unsigned* st) {
    XcdBarrier b; b.bar = bar; b.x = xb_xcc_id(); b.st = st;
    if (threadIdx.x == 0) (void)xb_add(&bar[XB_XCNT(b.x)], 1u);
    return b;
}
__device__ __forceinline__ void xcd_barrier_complete(unsigned* bar, unsigned x, unsigned& nloc, unsigned& nx) {
    const unsigned G = gridDim.x * gridDim.y * gridDim.z;
    unsigned sum, cnt, mine, sp = 0u;
    for (;;) {
        sum = 0u; cnt = 0u; mine = 0u;
#pragma unroll
        for (unsigned j = 0; j < 16; ++j) { const unsigned c = xb_ld(&bar[XB_XCNT(j)]); sum += c; cnt += (c > 0u) ? 1u : 0u; mine = (j == x) ? c : mine; }
        if (sum == G) break;
        __builtin_amdgcn_s_sleep(1);
        if ((++sp & 255u) == 0u) { if (xb_ld(&bar[XB_TMO])) break; if (sp > XB_SPIN_CAP) { atomicAdd(&bar[XB_TMO], 1u); break; } }
    }
    nloc = mine > 0u ? mine : 1u; nx = cnt > 0u ? cnt : 1u;
}
__device__ __forceinline__ void xcd_barrier(const XcdBarrier& b) {
    asm volatile("s_waitcnt vmcnt(0)" ::: "memory");
    __syncthreads();
    if (threadIdx.x == 0) {
        unsigned* bar = b.bar;
        __builtin_amdgcn_s_waitcnt(0);
        unsigned nloc = b.st[0], nx = b.st[1];
        if (nloc == 0u) { xcd_barrier_complete(bar, b.x, nloc, nx); b.st[0] = nloc; b.st[1] = nx; }
        const unsigned old = xb_add(&bar[XB_XSUB(b.x)], 1u);
        const unsigned gen = old / nloc;
        if (old + 1u == (gen + 1u) * nloc) {
            __builtin_amdgcn_fence(__ATOMIC_RELEASE, "agent");
            asm volatile("s_waitcnt vmcnt(0)" ::: "memory");
            const unsigned og = xb_add(&bar[XB_TOP], 1u);
            const unsigned tg = og / nx;
            if (og + 1u == (tg + 1u) * nx) xb_add(&bar[XB_TOPGEN], 1u);
            else XB_SPIN(xb_ld(&bar[XB_TOPGEN]) == tg, bar);
            __builtin_amdgcn_fence(__ATOMIC_ACQUIRE, "agent");
            xb_add(&bar[XB_XGEN(b.x)], 1u);
            asm volatile("s_waitcnt vmcnt(0)" ::: "memory");
        } else {
            XB_SPIN(xb_ld(&bar[XB_XGEN(b.x)]) == gen, bar);
            __builtin_amdgcn_fence(__ATOMIC_ACQUIRE, "agent");
            asm volatile("s_waitcnt vmcnt(0)" ::: "memory");
        }
    }
    __syncthreads();
}
#endif

constexpr int LDS_BYTES = 163840;
constexpr int LDS_BARW = LDS_BYTES - 16;

#ifndef PH_MASK
#define PH_MASK 0xFFFFFFFFu
#endif
#ifndef PROBE_DUP
#define PROBE_DUP 0u
#endif
#define DUP_N(k) (1 + (int)((PROBE_DUP >> phase_class(k)) & 1u))
#define PH_BIT(k) ((PH_MASK >> phase_class(k)) & 1u)
#ifdef HIPEMU
static void run_phase(const Params& pp, int ph, unsigned char* lds)
#define GRID_BAR() do {} while (0)
#define IN(k) (ph == (k))
#define GLDS lds
#define LOADP() const Params& p = pp
#else
typedef const __attribute__((address_space(4))) unsigned char* kargp_t;
__device__ __forceinline__ kargp_t karg_ptr() { kargp_t kp = (kargp_t)__builtin_amdgcn_kernarg_segment_ptr(); asm volatile("" : "+s"(kp)); return kp; }
#define LOADP() Params p; __builtin_memcpy(&p, karg_ptr(), sizeof(Params))
#define IN(k) (PH_BIT(k) && ph_lo <= (k) && (k) < ph_hi)
#define GLDS ((LAS unsigned char*)lds_raw)
__global__ void __launch_bounds__(512, 2) mega_fwd(Params p_unused)
#endif
{
#ifndef HIPEMU
    extern __shared__ __attribute__((aligned(16))) unsigned char lds_raw[];
    unsigned char* lds = lds_raw;
    if (threadIdx.x == 0) { *(volatile unsigned*)(lds_raw + LDS_BARW) = 0u; *(volatile unsigned*)(lds_raw + LDS_BARW + 4) = 0u; }
    __syncthreads();
    int ph_lo, ph_hi; XcdBarrier bar;
    { LOADP(); ph_lo = p.ph_lo; ph_hi = p.ph_hi; bar.bar = p.bar; bar.x = 0; bar.st = nullptr; }
    const bool multi = (ph_hi - ph_lo) > 1;
    if (multi) bar = xcd_barrier_post(bar.bar, (volatile LAS unsigned*)(lds_raw + LDS_BARW));
#define GRID_BAR() do { if (multi) xcd_barrier(bar); } while (0)
#endif
    if (IN(0)) { for (int rep = 0; rep < DUP_N(0); ++rep) { LOADP(); phase_convert(p, lds, 0); GRID_BAR(); } }
    if (IN(1)) {
        LOADP();
        pg8::Gemm g{p.csil, p.wt_ada, 256, MODW, D}; pg8::StaticOrder S; S.init(256, MODW, gridDim.x, blockIdx.x);
        pg8::EpiAda E{p.modbuf, p.b_ada, p.b_ada_final};
        pg8::gemm_phase<pg8::EpiAda, pg8::StaticOrder>(GLDS, g, S, E);
    }
    if (IN(1)) { LOADP(); phase_convert(p, lds, 1); GRID_BAR(); }
#define LAYER(l) do { \
        constexpr int base = 2 + 12 * (l); \
        if (IN(base + 0)) { for (int rep = 0; rep < DUP_N(base + 0); ++rep) { LOADP(); phase_norm(p, (l) == 0 ? p.x_prompt : p.xb, (l) == 0 ? p.x_sample : p.xb + (size_t)NP * D, p.norm1_g + (l) * D, (l) * NMOD + 0 * D, (l) * NMOD + 1 * D, p.hA, nullptr); GRID_BAR(); } } \
        if (IN(base + 1)) { for (int rep = 0; rep < DUP_N(base + 1); ++rep) { LOADP(); \
            pg8::Gemm g{p.hA, p.wt_in + (size_t)(l) * ZW * D, MPAD, ZW, D}; pg8::StaticOrder S; S.init(MPAD, ZW, gridDim.x, blockIdx.x); \
            pg8::EpiBf16 E{p.z, ZW}; \
            pg8::gemm_phase<pg8::EpiBf16, pg8::StaticOrder>(GLDS, g, S, E); \
            GRID_BAR(); } } \
        if (IN(base + 2)) { for (int rep = 0; rep < DUP_N(base + 2); ++rep) { LOADP(); phase_mix1(p, (l), lds); GRID_BAR(); } } \
        if (IN(base + 3)) { for (int rep = 0; rep < DUP_N(base + 3); ++rep) { LOADP(); phase_mix2(p, (l)); GRID_BAR(); } } \
        if (IN(base + 4)) { LOADP(); phase_mix3(p, (l), lds); } \
        if (IN(base + 4)) { LOADP(); \
            pg8::Gemm g{p.pooled, p.wt_pool + (size_t)(l) * 1024 * 256, 4 * MPAD, 1024, 256}; pg8::PoolOrder S{(int)gridDim.x, (int)(gridDim.x - 1 - blockIdx.x)}; \
            pg8::EpiPool E{p.cat, p.pool_b + (l) * PW, p.pool_scale + (l) * PW}; \
            pg8::gemm_phase<pg8::EpiPool, pg8::PoolOrder>(GLDS, g, S, E); \
            GRID_BAR(); } \
        if (IN(base + 5)) { for (int rep = 0; rep < DUP_N(base + 5); ++rep) { LOADP(); \
            pg8::Gemm g{p.cat, p.wt_out + (size_t)(l) * D * D, MBIG, D, D}; pg8::StaticOrder S; S.init(MBIG, D, gridDim.x, blockIdx.x); \
            pg8::EpiResid E{(l) == 0 ? p.x_prompt : p.xb, (l) == 0 ? p.x_sample : p.xb + (size_t)NP * D, p.modbuf + (l) * NMOD + 2 * D, p.xa}; \
            pg8::gemm_phase<pg8::EpiResid, pg8::StaticOrder>(GLDS, g, S, E); \
            { SmallResid sf{E.xlo, E.xhi, E.gmod, E.out}; small_gemm(p.cat, p.wt_out + (size_t)(l) * D * D, D, lds, sf); } \
            GRID_BAR(); } } \
        if (IN(base + 6)) { for (int rep = 0; rep < DUP_N(base + 6); ++rep) { LOADP(); phase_norm(p, p.xa, p.xa + (size_t)NP * D, p.norm2_g + (l) * D, (l) * NMOD + 3 * D, (l) * NMOD + 4 * D, p.hB, nullptr); GRID_BAR(); } } \
        if (IN(base + 7)) { for (int rep = 0; rep < DUP_N(base + 7); ++rep) { LOADP(); \
            pg8::Gemm g{p.hB, p.wt_q + (size_t)(l) * D * D, MBIG, D, D}; pg8::StaticOrder S; S.init(MBIG, D, gridDim.x, blockIdx.x); \
            pg8::EpiF32 E{p.qry, D}; \
            pg8::gemm_phase<pg8::EpiF32, pg8::StaticOrder>(GLDS, g, S, E); \
            { SmallF32 sf{p.qry}; small_gemm(p.hB, p.wt_q + (size_t)(l) * D * D, D, lds, sf); } \
            GRID_BAR(); } } \
        if (IN(base + 8)) { for (int rep = 0; rep < DUP_N(base + 8); ++rep) { LOADP(); phase_select(p, (l), lds); GRID_BAR(); } } \
        if (IN(base + 9)) { for (int rep = 0; rep < DUP_N(base + 9); ++rep) { LOADP(); phase_peer_u(p, (l), lds); GRID_BAR(); } } \
        if (IN(base + 10)) { LOADP(); phase_peer_c(p); GRID_BAR(); } \
        if (IN(base + 11)) { for (int rep = 0; rep < DUP_N(base + 11); ++rep) { LOADP(); phase_peer_v(p, (l), lds); GRID_BAR(); } } \
    } while (0)
    LAYER(0);
    LAYER(1);
    if (IN(26)) { LOADP(); phase_norm(p, p.xb, p.xb + (size_t)NP * D, p.final_g, 2 * NMOD, 2 * NMOD + D, nullptr, p.out + OFF_Y); }
#undef LAYER
#undef IN
#undef GRID_BAR
#undef GLDS
#undef LOADP
}

struct WsLayout { size_t bar, modbuf, csil, wt_ada, wt_in, wt_out, wt_q, wt_pool, u8, v8, su, sv, iscu, part, hg_oin, hg_ds, hg_gam, hg_qh, hg_sc, hA, hB, z, pooled, cat, xa, xb, qry, eidx, gate, ab16, end; };
static WsLayout ws_layout() {
    WsLayout L; size_t o = 0;
    auto take = [&](size_t bytes) { const size_t r = o; o += (bytes + 255) & ~(size_t)255; return r; };
    L.bar = take(16384);
    L.modbuf = take((size_t)256 * MODW * 4);
    L.csil = take((size_t)256 * D * 2);
    L.wt_ada = take((size_t)MODW * D * 2);
    L.wt_in = take((size_t)2 * ZW * D * 2);
    L.wt_out = take((size_t)2 * D * D * 2);
    L.wt_q = take((size_t)2 * D * D * 2);
    L.wt_pool = take((size_t)2 * 1024 * 256 * 2);
    L.u8 = take((size_t)2 * NE * D);
    L.v8 = take((size_t)2 * NE * D);
    L.su = take((size_t)2 * NE * 4);
    L.sv = take((size_t)2 * NE * 4);
    L.iscu = take((size_t)MPAD * 128 * 4);
    L.part = take((size_t)MPAD * 8 * 128 * 4);
    L.hg_oin = take((size_t)hg::NUNIT * 64 * 128 * 4);
    L.hg_ds = take((size_t)hg::NUNIT * 128 * 128 * 4);
    L.hg_gam = take((size_t)hg::NUNIT * 128 * 4);
    L.hg_qh = take((size_t)NP * 1024 * 2);
    L.hg_sc = take((size_t)hg::NUNIT * 128 * 128 * 2);
    L.hA = take((size_t)MPAD * D * 2);
    L.hB = take((size_t)MPAD * D * 2);
    L.z = take((size_t)MPAD * ZW * 2);
    L.pooled = take((size_t)4 * MPAD * 256 * 2);
    L.cat = take((size_t)MPAD * D * 2);
    L.xa = take((size_t)MPAD * D * 4);
    L.xb = take((size_t)MPAD * D * 4);
    L.qry = take((size_t)MPAD * D * 4);
    L.eidx = take((size_t)MPAD * 128 * 2);
    L.gate = take((size_t)MPAD * 128 * 4);
    L.ab16 = take((size_t)MPAD * 128 * 2);
    L.end = o;
    return L;
}
static void fill_params(Params& p, void* const* d_in, void* d_out, void* d_ws) {
    const float** f = (const float**)&p;
    for (int i = 0; i < 24; ++i) f[i] = (const float*)d_in[i];
    p.out = (float*)d_out;
    const WsLayout L = ws_layout(); unsigned char* w = (unsigned char*)d_ws;
    p.bar = (unsigned*)(w + L.bar); p.modbuf = (float*)(w + L.modbuf); p.csil = (bf16_t*)(w + L.csil); p.wt_ada = (bf16_t*)(w + L.wt_ada); p.wt_in = (bf16_t*)(w + L.wt_in);
    p.wt_out = (bf16_t*)(w + L.wt_out); p.wt_q = (bf16_t*)(w + L.wt_q); p.wt_pool = (bf16_t*)(w + L.wt_pool); p.u8 = w + L.u8; p.v8 = w + L.v8; p.su = (float*)(w + L.su); p.sv = (float*)(w + L.sv); p.iscu = (float*)(w + L.iscu); p.part = (float*)(w + L.part); p.hg_oin = (float*)(w + L.hg_oin); p.hg_ds = (float*)(w + L.hg_ds); p.hg_gam = (float*)(w + L.hg_gam); p.hg_qh = (bf16_t*)(w + L.hg_qh); p.hg_sc = (bf16_t*)(w + L.hg_sc);
    p.hA = (bf16_t*)(w + L.hA); p.hB = (bf16_t*)(w + L.hB); p.z = (bf16_t*)(w + L.z); p.pooled = (bf16_t*)(w + L.pooled); p.cat = (bf16_t*)(w + L.cat);
    p.xa = (float*)(w + L.xa); p.xb = (float*)(w + L.xb); p.qry = (float*)(w + L.qry); p.eidx = (unsigned short*)(w + L.eidx); p.gate = (float*)(w + L.gate); p.ab16 = (bf16_t*)(w + L.ab16);
}

#ifndef HIPEMU
#ifndef MK_ONE_LAUNCH
#define MK_ONE_LAUNCH 1
#endif
extern "C" void kernel_launch(void* const* d_in, const int* in_sizes, int n_in, void* d_out, int out_size, void* d_ws, size_t ws_size, hipStream_t stream) {
    static int grid = 0;
    if (grid == 0) {
        const WsLayout L = ws_layout();
        if (n_in != 24 || (size_t)out_size != OUT_TOTAL || ws_size < L.end) { fprintf(stderr, "kernel_launch: unexpected shapes (n_in %d, out %d, ws %zu < %zu)\n", n_in, out_size, ws_size, L.end); grid = -1; return; }
        int dev = 0, cus = 0, per_cu = 0;
        hipGetDevice(&dev); hipDeviceGetAttribute(&cus, hipDeviceAttributeMultiprocessorCount, dev);
        if (hipFuncSetAttribute((const void*)mega_fwd, hipFuncAttributeMaxDynamicSharedMemorySize, LDS_BYTES) != hipSuccess) { fprintf(stderr, "kernel_launch: hipFuncSetAttribute failed\n"); grid = -1; return; }
        hipOccupancyMaxActiveBlocksPerMultiprocessor(&per_cu, (const void*)mega_fwd, 512, LDS_BYTES);
        (void)hipGetLastError();
        if (per_cu < 1) fprintf(stderr, "kernel_launch: occupancy query says %d blocks per CU\n", per_cu);
        grid = cus;
    }
    if (grid < 0) return;
    Params p{};
    fill_params(p, d_in, d_out, d_ws);
    hipMemsetAsync(p.bar, 0, 16384, stream);
#if MK_ONE_LAUNCH
    p.ph_lo = 0; p.ph_hi = N_PHASES;
    hipLaunchKernelGGL(mega_fwd, dim3(grid), dim3(512), LDS_BYTES, stream, p);
#else
    for (int ph = 0; ph < N_PHASES; ++ph) { p.ph_lo = ph; p.ph_hi = ph + 1; hipLaunchKernelGGL(mega_fwd, dim3(grid), dim3(512), LDS_BYTES, stream, p); }
#endif
}
#endif
```

```cpp
#ifndef HIPEMU
#include <hip/hip_runtime.h>
#include <cstdio>
#endif
#include <stdint.h>

#ifndef CFG_PB
#define CFG_PB 4
#define CFG_SEQ 2048
#define CFG_DB 128
#endif

#ifdef HIPEMU
#define DEV inline
#define LAS
#define READLANE_I(v, l) emu_readlane((v), (l))
#define READLANE_F(v, l) emu_readlane_f((v), (l))
#define MFMA_BF16(a, b, c) emu_mfma_bf16_16x16x32((a), (b), (c))
#define MFMA_F32(a, b, c) emu_mfma_f32_16x16x4((a), (b), (c))
#define __expf expf
#define __logf logf
#else
#define DEV __device__ __forceinline__
#define LAS __attribute__((address_space(3)))
#define READLANE_I(v, l) __builtin_amdgcn_readlane((v), (l))
#define READLANE_F(v, l) __uint_as_float((unsigned)__builtin_amdgcn_readlane((int)__float_as_uint(v), (l)))
#define MFMA_BF16(a, b, c) __builtin_amdgcn_mfma_f32_16x16x32_bf16((a), (b), (c), 0, 0, 0)
#define MFMA_F32(a, b, c) __builtin_amdgcn_mfma_f32_16x16x4f32((a), (b), (c), 0, 0, 0)
#endif

typedef unsigned short bf16_t;
typedef short bf16x8 __attribute__((ext_vector_type(8)));
typedef float f32x4 __attribute__((ext_vector_type(4)));
typedef unsigned u32x4 __attribute__((ext_vector_type(4)));
typedef unsigned u32x2 __attribute__((ext_vector_type(2)));

namespace cfg {
constexpr int D = 2048, PB = CFG_PB, SEQ = CFG_SEQ, DB = CFG_DB, DSEQ = 4;
constexpr int NP = PB * SEQ, NS = DB * DSEQ, NTOK = NP + NS, MPAD = (NTOK + 255) / 256 * 256;
constexpr int NC = PB + DB;
constexpr int HH = 8, HD = 128, PW = 1024, PBUF = 15, ZW = 5120;
constexpr int NE = 16384;
constexpr int NMOD = 6 * D;
constexpr int MODW = 2 * NMOD + 2 * D;
constexpr float EPS = 1e-6f;
constexpr int NCHAIN = PB * HH;
constexpr size_t OFF_Y = 0;
constexpr size_t OFF_HP = (size_t)NTOK * D;
constexpr size_t OFF_PP = OFF_HP + (size_t)2 * PB * HH * HD * HD;
constexpr size_t OFF_HS = OFF_PP + (size_t)2 * PB * PBUF * PW;
constexpr size_t OFF_PS = OFF_HS + (size_t)2 * DB * HH * HD * HD;
constexpr size_t OUT_TOTAL = OFF_PS + (size_t)2 * DB * PBUF * PW;
}
using namespace cfg;

struct Params {
    const float *x_prompt, *x_sample, *c_prompt, *c_sample, *state_hgrn, *state_pool, *w_ada, *b_ada, *norm1_g, *norm2_g, *w_in, *w_out,
        *lb_logits, *hgrn_norm_g, *pool_w, *pool_b, *pool_scale, *peer_wq, *peer_keys, *peer_u, *peer_v, *final_g, *w_ada_final, *b_ada_final;
    float* out;
    unsigned* bar; float* modbuf; bf16_t* csil; bf16_t* wt_ada; bf16_t* wt_in; bf16_t* wt_out; bf16_t* wt_q; bf16_t* wt_pool;
    unsigned char* u8; unsigned char* v8; float* su; float* sv; float* iscu; float* part; bf16_t* hg_oin; bf16_t* hg_ds; float* hg_gam; bf16_t* hg_qh; bf16_t* hg_sc; bf16_t* hA; bf16_t* hB; bf16_t* z; bf16_t* pooled; bf16_t* cat; float* xa; float* xb; float* qry; unsigned short* eidx; float* gate; bf16_t* ab16;
    int ph_lo, ph_hi;
};

DEV float bf2f(unsigned v) { return __uint_as_float(v << 16); }
#ifdef HIPEMU
DEV unsigned f2bf(float f) { unsigned u = __float_as_uint(f); u += 0x7fffu + ((u >> 16) & 1u); return u >> 16; }
DEV unsigned pack2(float lo, float hi) { return f2bf(lo) | (f2bf(hi) << 16); }
#else
typedef float f32x2_t __attribute__((ext_vector_type(2)));
typedef __bf16 bf16x2_t __attribute__((ext_vector_type(2)));
DEV unsigned pack2(float lo, float hi) { const f32x2_t v = {lo, hi}; return __builtin_bit_cast(unsigned, __builtin_convertvector(v, bf16x2_t)); }
DEV unsigned f2bf(float f) { return (unsigned)__builtin_bit_cast(unsigned short, (__bf16)f); }
#endif
DEV float lo16(unsigned w) { return __uint_as_float(w << 16); }
DEV float hi16(unsigned w) { return __uint_as_float(w & 0xffff0000u); }
DEV float wave_sum(float v) { v += __shfl_xor(v, 32); v += __shfl_xor(v, 16); v += __shfl_xor(v, 8); v += __shfl_xor(v, 4); v += __shfl_xor(v, 2); v += __shfl_xor(v, 1); return v; }
DEV float wave_max(float v) { v = fmaxf(v, __shfl_xor(v, 32)); v = fmaxf(v, __shfl_xor(v, 16)); v = fmaxf(v, __shfl_xor(v, 8)); v = fmaxf(v, __shfl_xor(v, 4)); v = fmaxf(v, __shfl_xor(v, 2)); v = fmaxf(v, __shfl_xor(v, 1)); return v; }
DEV float sigmoidf_(float x) { return 1.0f / (1.0f + __expf(-x)); }
DEV float siluf_(float x) { return x / (1.0f + __expf(-x)); }
DEV float gelu_erf(float x) { return 0.5f * x * (1.0f + erff(x * 0.70710678118f)); }
DEV int tok_batch(int t) { return t < NP ? t / SEQ : PB + (t - NP) / DSEQ; }


#ifdef HIPEMU
static inline unsigned emu_fp8_enc1(float x) {
    const unsigned sgn = x < 0.f ? 0x80u : 0u; float a = fabsf(x);
    if (!(a == a)) return 0x7fu;
    if (a >= 448.f) return sgn | 0x7eu;
    if (a < 0.015625f) { const int q = (int)rintf(a * 512.f); return sgn | (unsigned)q; }
    int e = (int)floorf(log2f(a)); if (ldexpf(1.f, e) > a) --e; if (ldexpf(1.f, e + 1) <= a) ++e;
    int m = (int)rintf((a / ldexpf(1.f, e) - 1.f) * 8.f); if (m == 8) { m = 0; ++e; }
    if (e > 8) return sgn | 0x7eu;
    return sgn | (unsigned)((e + 7) << 3) | (unsigned)m;
}
static inline float emu_fp8_dec1(unsigned b) { const float sg = (b & 0x80u) ? -1.f : 1.f; const int e = (b >> 3) & 15, m = b & 7; return sg * (e == 0 ? m * 0.001953125f : (1.f + m * 0.125f) * ldexpf(1.f, e - 7)); }
DEV unsigned fp8x4_enc(float a, float b, float c, float d) { return emu_fp8_enc1(a) | (emu_fp8_enc1(b) << 8) | (emu_fp8_enc1(c) << 16) | (emu_fp8_enc1(d) << 24); }
DEV void fp8x4_dec(unsigned w, float* o) { o[0] = emu_fp8_dec1(w & 255u); o[1] = emu_fp8_dec1((w >> 8) & 255u); o[2] = emu_fp8_dec1((w >> 16) & 255u); o[3] = emu_fp8_dec1(w >> 24); }
#define DPP_XOR1(v) __shfl((v), emu_lane() ^ 1)
#define DPP_XOR2(v) __shfl((v), emu_lane() ^ 2)
#define DPP_HMIRROR(v) __shfl((v), (emu_lane() & ~7) | (7 - (emu_lane() & 7)))
#define DPP_XOR8(v) __shfl((v), emu_lane() ^ 8)
#define DPP_RMIRROR(v) __shfl((v), (emu_lane() & ~15) | (15 - (emu_lane() & 15)))
#define WAVE_LDS_SYNC() emu_wbar()
DEV float xsum16(float a, float b) { const bool hi = (emu_lane() & 16) != 0; return (hi ? b : a) + __shfl_xor(hi ? a : b, 16); }
DEV float xsum32(float a, float b) { const bool hi = (emu_lane() & 32) != 0; return (hi ? b : a) + __shfl_xor(hi ? a : b, 32); }
#else
typedef float f32x2v_t __attribute__((ext_vector_type(2)));
DEV unsigned fp8x4_enc(float a, float b, float c, float d) { int r = __builtin_amdgcn_cvt_pk_fp8_f32(a, b, 0, false); r = __builtin_amdgcn_cvt_pk_fp8_f32(c, d, r, true); return (unsigned)r; }
DEV void fp8x4_dec(unsigned w, float* o) { const f32x2v_t lo = __builtin_amdgcn_cvt_pk_f32_fp8((int)w, false), hi = __builtin_amdgcn_cvt_pk_f32_fp8((int)w, true); o[0] = lo[0]; o[1] = lo[1]; o[2] = hi[0]; o[3] = hi[1]; }
template <int CTRL> DEV float dpp_f(float v) { return __uint_as_float((unsigned)__builtin_amdgcn_update_dpp(0, (int)__float_as_uint(v), CTRL, 0xf, 0xf, true)); }
#define DPP_XOR1(v) dpp_f<0xB1>(v)
#define DPP_XOR2(v) dpp_f<0x4E>(v)
#define DPP_HMIRROR(v) dpp_f<0x141>(v)
#define DPP_XOR8(v) dpp_f<0x128>(v)
#define DPP_RMIRROR(v) dpp_f<0x140>(v)
#define WAVE_LDS_SYNC() asm volatile("s_waitcnt lgkmcnt(0)" ::: "memory")
DEV float xsum16(float a, float b) { const u32x2 r = __builtin_amdgcn_permlane16_swap(__float_as_uint(a), __float_as_uint(b), false, false); return __uint_as_float(r[0]) + __uint_as_float(r[1]); }
DEV float xsum32(float a, float b) { const u32x2 r = __builtin_amdgcn_permlane32_swap(__float_as_uint(a), __float_as_uint(b), false, false); return __uint_as_float(r[0]) + __uint_as_float(r[1]); }
#endif
typedef float f32x2 __attribute__((ext_vector_type(2)));
#ifdef HIPEMU
DEV void fp8x4_dec2(unsigned w, f32x2& lo, f32x2& hi) { float o[4]; fp8x4_dec(w, o); lo = (f32x2){o[0], o[1]}; hi = (f32x2){o[2], o[3]}; }
#else
DEV void fp8x4_dec2(unsigned w, f32x2& lo, f32x2& hi) { lo = __builtin_amdgcn_cvt_pk_f32_fp8((int)w, false); hi = __builtin_amdgcn_cvt_pk_f32_fp8((int)w, true); }
#endif
DEV void fp8x16_dec2(u32x4 q, f32x2* o) { fp8x4_dec2(q.x, o[0], o[1]); fp8x4_dec2(q.y, o[2], o[3]); fp8x4_dec2(q.z, o[4], o[5]); fp8x4_dec2(q.w, o[6], o[7]); }

namespace pg8 {
constexpr int BM = 256, BK = 64, HALF = 128, HTB = HALF * BK * 2, STAGE_BYTES = 8 * HTB, NXCD = 8, WGM = 8;
DEV int lds_byte(int r, int c) { const int st = (r >> 4) * 2 + (c >> 5), rr = r & 15, cc = c & 31, ob = rr * 64 + cc * 2; return st * 1024 + (ob ^ (((ob >> 9) & 1) << 5)); }
DEV void stage_rc(int b, int& R, int& C) { const int st = b / 1024, sb = b % 1024, swz = sb ^ (((sb >> 9) & 1) << 5); R = (st >> 1) * 16 + swz / 64; C = (st & 1) * 32 + (swz % 64) / 2; }
DEV int perm32(int rho) { const int n = rho >> 4, i = rho & 15; return 8 * (i >> 2) + 4 * n + (i & 3); }
struct Unit { int pm, pn; };
struct Gemm { const bf16_t* A; const bf16_t* Bt; int M, N, K; };
struct StaticOrder {
    int nM, nN, nwg, G, c;
    DEV void init(int M, int N, int G_, int c_) { nM = M / BM; nN = N / BM; nwg = nM * nN; G = G_; c = c_; }
    DEV bool next(int i, Unit& u) const {
        const long L = (long)i * G + c; if (L >= nwg) return false;
        int wgid = (int)L; { const int q = nwg / NXCD, r = nwg % NXCD, xcd = wgid % NXCD, off = wgid / NXCD; wgid = (xcd < r ? xcd * (q + 1) : r * (q + 1) + (xcd - r) * q) + off; }
        const int nig = WGM * nN, gid = wgid / nig, fm = gid * WGM, gsz = (nM - fm) < WGM ? (nM - fm) : WGM;
        u.pm = fm + ((wgid % nig) % gsz); u.pn = (wgid % nig) / gsz; return true;
    }
    DEV void a_ready(const Unit&) const {}
    DEV void done(const Unit&) const {}
};
struct PoolOrder {
    int G, c;
    DEV bool next(int i, Unit& u) const { const int L = i * G + c; if (L >= 4 * (MPAD / 256)) return false; u.pm = L; u.pn = L / (MPAD / 256); return true; }
    DEV void a_ready(const Unit&) const {}
    DEV void done(const Unit&) const {}
};

struct EpiF32 {
    static constexpr bool PERM = false;
    float* C; int ldc;
    DEV void operator()(const f32x4 (&acc)[2][2][4][2], const Unit& u, int wr, int wc, int fr, int fq) const {
        const int row0 = u.pm * BM + wr * 64 + fr, col0 = u.pn * BM + wc * 32 + 4 * fq;
#pragma unroll
        for (int ai = 0; ai < 2; ++ai)
#pragma unroll
            for (int m = 0; m < 4; ++m) { float* rowp = C + (size_t)(row0 + ai * HALF + m * 16) * ldc + col0;
#pragma unroll
                for (int bj = 0; bj < 2; ++bj)
#pragma unroll
                    for (int n = 0; n < 2; ++n) *(f32x4*)(rowp + bj * HALF + n * 16) = acc[ai][bj][m][n]; }
    }
};
struct EpiAda {
    static constexpr bool PERM = false;
    float* C; const float* b_ada; const float* b_fin;
    DEV void operator()(const f32x4 (&acc)[2][2][4][2], const Unit& u, int wr, int wc, int fr, int fq) const {
        const int row0 = u.pm * BM + wr * 64 + fr, col0 = u.pn * BM + wc * 32 + 4 * fq;
        const float* bias = (u.pn * BM < 2 * NMOD) ? b_ada + col0 : b_fin + (col0 - 2 * NMOD);
        f32x4 bv[2][2];
#pragma unroll
        for (int bj = 0; bj < 2; ++bj)
#pragma unroll
            for (int n = 0; n < 2; ++n) bv[bj][n] = *(const f32x4*)(bias + bj * HALF + n * 16);
#pragma unroll
        for (int ai = 0; ai < 2; ++ai)
#pragma unroll
            for (int m = 0; m < 4; ++m) { float* rowp = C + (size_t)(row0 + ai * HALF + m * 16) * MODW + col0;
#pragma unroll
                for (int bj = 0; bj < 2; ++bj)
#pragma unroll
                    for (int n = 0; n < 2; ++n) *(f32x4*)(rowp + bj * HALF + n * 16) = acc[ai][bj][m][n] + bv[bj][n]; }
    }
};
struct EpiResid {
    static constexpr bool PERM = false;
    const float* xlo; const float* xhi; const float* gmod  ; float* out;
    DEV void operator()(const f32x4 (&acc)[2][2][4][2], const Unit& u, int wr, int wc, int fr, int fq) const {
        const int row0 = u.pm * BM + wr * 64 + fr, col0 = u.pn * BM + wc * 32 + 4 * fq;
#pragma unroll
        for (int ai = 0; ai < 2; ++ai)
#pragma unroll
            for (int m = 0; m < 4; ++m) {
                const int row = row0 + ai * HALF + m * 16;
                if (row < NTOK) {
                    const float* xr = (row < NP ? xlo + (size_t)row * D : xhi + (size_t)(row - NP) * D) + col0;
                    const float* gr = gmod + (size_t)tok_batch(row) * MODW + col0;
                    float* rowp = out + (size_t)row * D + col0;
#pragma unroll
                    for (int bj = 0; bj < 2; ++bj)
#pragma unroll
                        for (int n = 0; n < 2; ++n) { const f32x4 xv = *(const f32x4*)(xr + bj * HALF + n * 16), gv = *(const f32x4*)(gr + bj * HALF + n * 16);
                            *(f32x4*)(rowp + bj * HALF + n * 16) = xv + gv * acc[ai][bj][m][n]; }
                }
            }
    }
};
struct EpiBf16 {
    static constexpr bool PERM = true;
    bf16_t* O; int ldc;
    DEV void operator()(const f32x4 (&acc)[2][2][4][2], const Unit& u, int wr, int wc, int fr, int fq) const {
        const int row0 = u.pm * BM + wr * 64 + fr, col0 = u.pn * BM + wc * 32 + 8 * fq;
#pragma unroll
        for (int ai = 0; ai < 2; ++ai)
#pragma unroll
            for (int m = 0; m < 4; ++m) { bf16_t* rowp = O + (size_t)(row0 + ai * HALF + m * 16) * ldc + col0;
#pragma unroll
                for (int bj = 0; bj < 2; ++bj) { const f32x4 v0 = acc[ai][bj][m][0], v1 = acc[ai][bj][m][1];
                    u32x4 w; w.x = pack2(v0[0], v0[1]); w.y = pack2(v0[2], v0[3]); w.z = pack2(v1[0], v1[1]); w.w = pack2(v1[2], v1[3]);
                    *(u32x4*)(rowp + bj * HALF) = w; } }
    }
};
struct EpiPool {
    static constexpr bool PERM = true;
    bf16_t* cat; const float* pb; const float* ps;
    DEV void operator()(const f32x4 (&acc)[2][2][4][2], const Unit& u, int wr, int wc, int fr, int fq) const {
        const int g = u.pn, tok0 = u.pm * BM - g * MPAD + wr * 64 + fr, col0 = g * 256 + wc * 32 + 8 * fq;
#pragma unroll
        for (int bj = 0; bj < 2; ++bj) {
            const f32x4 b0 = *(const f32x4*)(pb + col0 + bj * HALF), b1 = *(const f32x4*)(pb + col0 + bj * HALF + 4);
            const f32x4 s0 = *(const f32x4*)(ps + col0 + bj * HALF), s1 = *(const f32x4*)(ps + col0 + bj * HALF + 4);
#pragma unroll
            for (int ai = 0; ai < 2; ++ai)
#pragma unroll
                for (int m = 0; m < 4; ++m) { const int tok = tok0 + ai * HALF + m * 16;
                    if (tok < NTOK) { const f32x4 v0 = (acc[ai][bj][m][0] + b0) * s0, v1 = (acc[ai][bj][m][1] + b1) * s1;
                        u32x4 w; w.x = pack2(v0[0], v0[1]); w.y = pack2(v0[2], v0[3]); w.z = pack2(v1[0], v1[1]); w.w = pack2(v1[2], v1[3]);
                        *(u32x4*)(cat + (size_t)tok * D + 1024 + col0 + bj * HALF) = w; } }
        }
    }
};

#ifdef HIPEMU
template <class Epi, class Sched>
static void gemm_phase(unsigned char*, const Gemm g, const Sched& S, const Epi& E) {
    const int tid = threadIdx.x, wid = tid >> 6, lane = tid & 63, wr = wid >> 2, wc = wid & 3, fr = lane & 15, fq = lane >> 4;
    Unit cur;
    for (int ui = 0; S.next(ui, cur); ++ui) {
        f32x4 acc[2][2][4][2];
        for (int ai = 0; ai < 2; ++ai) for (int bj = 0; bj < 2; ++bj) for (int m = 0; m < 4; ++m) for (int n = 0; n < 2; ++n) for (int j = 0; j < 4; ++j) {
            const int row = 256 * cur.pm + 128 * ai + 64 * wr + 16 * m + fr;
            const int col = Epi::PERM ? 256 * cur.pn + 128 * bj + 32 * wc + 8 * fq + 4 * n + j : 256 * cur.pn + 128 * bj + 32 * wc + 16 * n + 4 * fq + j;
            float s = 0.f;
            if ((row % emu_row_mod) < emu_row_limit) { const float* a = emu_f32_copy(g.A, (size_t)g.M * g.K) + (size_t)row * g.K; const float* b = emu_f32_copy(g.Bt, (size_t)g.N * g.K) + (size_t)col * g.K;
                for (int k = 0; k < g.K; ++k) s += a[k] * b[k]; }
            acc[ai][bj][m][n][j] = s; }
        E(acc, cur, wr, wc, fr, fq);
    }
    __syncthreads();
}
#else
template <class Epi, class Sched>
__device__ __forceinline__ void gemm_phase(LAS unsigned char* lds, const Gemm g, const Sched& S, const Epi& E) {
    const int tid = threadIdx.x, wid = __builtin_amdgcn_readfirstlane(tid >> 6), lane = tid & 63, wr = wid >> 2, wc = wid & 3, fr = lane & 15, fq = lane >> 4;
    int K = g.K; asm volatile("" : "+s"(K));
    const int nt = K / BK;
    unsigned voffA[2], voffB[2];
#pragma unroll
    for (int i = 0; i < 2; ++i) { int R, C; stage_rc(tid * 16 + i * 8192, R, C); const int Rb = Epi::PERM ? ((R & ~31) + perm32(R & 31)) : R;
        voffA[i] = (unsigned)(R * K + C) * 2u; voffB[i] = (unsigned)(Rb * K + C) * 2u; }
    const size_t kstep = (size_t)(BK * 2);
    const size_t hstep = (size_t)HALF * K * 2;
    const size_t tstep = 2 * hstep;
    const unsigned ldsw = (unsigned)wid * 1024u;
    const int aoff = lds_byte(wr * 64 + fr, fq * 8), boff = lds_byte(wc * 32 + fr, fq * 8);
#define PG8_SA(b, h) (((b) * 2 + (h)) * HTB)
#define PG8_SB(b, h) ((4 + (b) * 2 + (h)) * HTB)
#define PG8_STAGE(bufoff, gbase, voff) do { _Pragma("unroll") for (int _i = 0; _i < 2; ++_i) \
        __builtin_amdgcn_global_load_lds((const unsigned*)((const char*)(gbase) + (voff)[_i]), (LAS unsigned*)(lds + (bufoff) + ldsw + _i * 8192), 16, 0, 0); } while (0)
#define PG8_LDA(dst, b, h) do { _Pragma("unroll") for (int m = 0; m < 4; ++m) _Pragma("unroll") for (int k = 0; k < 2; ++k) dst[m][k] = *(const LAS bf16x8*)(lds + PG8_SA(b, h) + aoff + m * 2048 + k * 1024); } while (0)
#define PG8_LDB(dst, b, h) do { _Pragma("unroll") for (int n = 0; n < 2; ++n) _Pragma("unroll") for (int k = 0; k < 2; ++k) dst[n][k] = *(const LAS bf16x8*)(lds + PG8_SB(b, h) + boff + n * 2048 + k * 1024); } while (0)
#define PG8_MMA(ai, bj, At, Bt) do { __builtin_amdgcn_s_setprio(1); _Pragma("unroll") for (int m = 0; m < 4; ++m) _Pragma("unroll") for (int n = 0; n < 2; ++n) _Pragma("unroll") for (int k = 0; k < 2; ++k) \
        acc[ai][bj][m][n] = __builtin_amdgcn_mfma_f32_16x16x32_bf16(Bt[n][k], At[m][k], acc[ai][bj][m][n], 0, 0, 0); __builtin_amdgcn_s_setprio(0); } while (0)
#define PG8_WAIT_V(n) asm volatile("s_waitcnt vmcnt(" #n ")" ::: "memory")
#define PG8_WAIT_L(n) asm volatile("s_waitcnt lgkmcnt(" #n ")" ::: "memory")
#define PG8_BAR __builtin_amdgcn_s_barrier()
#define PG8_SCHED __builtin_amdgcn_sched_barrier(0)
    Unit cur, nxt; int ui = 0;
    if (!S.next(0, cur)) return;
    f32x4 acc[2][2][4][2];
#pragma unroll
    for (int a = 0; a < 2; ++a)
#pragma unroll
        for (int b = 0; b < 2; ++b)
#pragma unroll
            for (int m = 0; m < 4; ++m)
#pragma unroll
                for (int n = 0; n < 2; ++n) acc[a][b][m][n] = (f32x4){0.f, 0.f, 0.f, 0.f};
    bf16x8 At[4][2], B0[2][2], B1[2][2];
    const char* cA = (const char*)g.A + (size_t)cur.pm * tstep; const char* cB = (const char*)g.Bt + (size_t)cur.pn * tstep;
    S.a_ready(cur);
    PG8_STAGE(PG8_SB(0, 0), cB, voffB); PG8_STAGE(PG8_SA(0, 0), cA, voffA); PG8_STAGE(PG8_SB(0, 1), cB + hstep, voffB); PG8_STAGE(PG8_SA(0, 1), cA + hstep, voffA);
    if (wr == 1) PG8_BAR;
    PG8_WAIT_V(4); PG8_BAR;
    PG8_STAGE(PG8_SB(1, 0), cB + kstep, voffB); PG8_STAGE(PG8_SA(1, 0), cA + kstep, voffA); PG8_STAGE(PG8_SB(1, 1), cB + hstep + kstep, voffB);
    PG8_WAIT_V(6); PG8_BAR;
    for (;;) {
        const bool has_next = S.next(ui + 1, nxt);
        const char* nA = has_next ? (const char*)g.A + (size_t)nxt.pm * tstep : cA; const char* nB = has_next ? (const char*)g.Bt + (size_t)nxt.pn * tstep : cB;
        for (int t = 0; t < nt; t += 2) {
            const bool last = (t == nt - 2);
            const char* a1 = cA + (size_t)(t + 1) * kstep;
            const char* a2 = last ? nA : cA + (size_t)(t + 2) * kstep; const char* b2 = last ? nB : cB + (size_t)(t + 2) * kstep;
            const char* a3 = a2 + kstep; const char* b3 = b2 + kstep;
            if (last && has_next) S.a_ready(nxt);
            PG8_LDB(B0, 0, 0); PG8_SCHED; PG8_LDA(At, 0, 0); PG8_STAGE(PG8_SA(1, 1), a1 + hstep, voffA);
            PG8_WAIT_L(8); PG8_BAR; PG8_WAIT_L(0); PG8_MMA(0, 0, At, B0); PG8_BAR; PG8_SCHED;
            PG8_LDB(B1, 0, 1); PG8_STAGE(PG8_SB(0, 0), b2, voffB);
            PG8_BAR; PG8_WAIT_L(0); PG8_MMA(0, 1, At, B1); PG8_BAR;
            PG8_LDA(At, 0, 1); PG8_STAGE(PG8_SA(0, 0), a2, voffA);
            PG8_BAR; PG8_WAIT_L(0); PG8_MMA(1, 0, At, B0); PG8_BAR; PG8_SCHED;
            PG8_STAGE(PG8_SB(0, 1), b2 + hstep, voffB);
            PG8_WAIT_V(6); PG8_BAR; PG8_MMA(1, 1, At, B1); PG8_BAR;
            PG8_LDB(B0, 1, 0); PG8_SCHED; PG8_LDA(At, 1, 0); PG8_STAGE(PG8_SA(0, 1), a2 + hstep, voffA);
            PG8_WAIT_L(8); PG8_BAR; PG8_WAIT_L(0); PG8_MMA(0, 0, At, B0); PG8_BAR; PG8_SCHED;
            PG8_LDB(B1, 1, 1); PG8_STAGE(PG8_SB(1, 0), b3, voffB);
            PG8_BAR; PG8_WAIT_L(0); PG8_MMA(0, 1, At, B1); PG8_BAR;
            PG8_LDA(At, 1, 1); PG8_STAGE(PG8_SA(1, 0), a3, voffA);
            PG8_BAR; PG8_WAIT_L(0); PG8_MMA(1, 0, At, B0); PG8_BAR; PG8_SCHED;
            PG8_STAGE(PG8_SB(1, 1), b3 + hstep, voffB);
            PG8_WAIT_V(6); PG8_BAR; PG8_MMA(1, 1, At, B1); PG8_BAR;
        }
        { int tz = threadIdx.x; asm volatile("" : "+v"(tz)); const int wz = tz >> 6, lz = tz & 63;
          E(acc, cur, wz >> 2, wz & 3, lz & 15, lz >> 4); } S.done(cur);
        if (!has_next) break;
#pragma unroll
        for (int a = 0; a < 2; ++a)
#pragma unroll
            for (int b = 0; b < 2; ++b)
#pragma unroll
                for (int m = 0; m < 4; ++m)
#pragma unroll
                    for (int n = 0; n < 2; ++n) acc[a][b][m][n] = (f32x4){0.f, 0.f, 0.f, 0.f};
        cur = nxt; cA = nA; cB = nB; ++ui;
    }
    PG8_WAIT_V(0);
    if (wr == 0) PG8_BAR;
    PG8_BAR;
#undef PG8_SA
#undef PG8_SB
#undef PG8_STAGE
#undef PG8_LDA
#undef PG8_LDB
#undef PG8_MMA
#undef PG8_WAIT_V
#undef PG8_WAIT_L
#undef PG8_BAR
#undef PG8_SCHED
}
#endif
}

constexpr int MBIG = (NP / 256) * 256;
template <class F> DEV void small_gemm(const bf16_t* A, const bf16_t* Bt, int K, unsigned char* lds, const F& f) {
    const int tid = threadIdx.x, lane = tid & 63, w = tid >> 6, g = lane >> 4, c16 = lane & 15;
    const int tiles_m = (NTOK - MBIG + 63) / 64, ntiles = tiles_m * 32, kw = K / 8;
    float* part = (float*)lds;
    for (int tl = blockIdx.x; tl < ntiles; tl += gridDim.x) {
        const int r0 = MBIG + (tl / 32) * 64, n0 = (tl % 32) * 64;
        f32x4 acc[4][4];
#pragma unroll
        for (int i = 0; i < 4; ++i)
#pragma unroll
            for (int j = 0; j < 4; ++j) acc[i][j] = (f32x4){0.f, 0.f, 0.f, 0.f};
        for (int k0 = w * kw; k0 < (w + 1) * kw; k0 += 128) {
            bf16x8 af[4][4], bfr[4][4];
#pragma unroll
            for (int u = 0; u < 4; ++u)
#pragma unroll
                for (int i = 0; i < 4; ++i) { int arow = r0 + 16 * i + c16; if (arow >= MPAD) arow = MPAD - 1;
                    af[u][i] = *(const bf16x8*)(A + (size_t)arow * K + k0 + 32 * u + 8 * g); bfr[u][i] = *(const bf16x8*)(Bt + (size_t)(n0 + 16 * i + c16) * K + k0 + 32 * u + 8 * g); }
#pragma unroll
            for (int u = 0; u < 4; ++u)
#pragma unroll
                for (int i = 0; i < 4; ++i)
#pragma unroll
                    for (int j = 0; j < 4; ++j) acc[i][j] = MFMA_BF16(af[u][i], bfr[u][j], acc[i][j]);
        }
#pragma unroll
        for (int i = 0; i < 4; ++i)
#pragma unroll
            for (int j = 0; j < 4; ++j)
#pragma unroll
                for (int r = 0; r < 4; ++r) part[(w * 64 + 16 * i + 4 * g + r) * 68 + 16 * j + c16] = acc[i][j][r];
        __syncthreads();
        {
            const int row = tid >> 3, c8 = (tid & 7) * 8; f32x4 s0 = (f32x4){0.f, 0.f, 0.f, 0.f}, s1 = s0;
#pragma unroll
            for (int ww = 0; ww < 8; ++ww) { s0 += *(const f32x4*)(part + (ww * 64 + row) * 68 + c8); s1 += *(const f32x4*)(part + (ww * 64 + row) * 68 + c8 + 4); }
            if (r0 + row < NTOK) f(r0 + row, n0 + c8, s0, s1);
        }
        __syncthreads();
    }
}
struct SmallResid { const float* xlo; const float* xhi; const float* gmod; float* out;
    DEV void operator()(int row, int col, f32x4 v0, f32x4 v1) const { const float* xr = (row < NP ? xlo + (size_t)row * D : xhi + (size_t)(row - NP) * D) + col; const float* gr = gmod + (size_t)tok_batch(row) * MODW + col;
        float* o = out + (size_t)row * D + col; *(f32x4*)o = *(const f32x4*)xr + *(const f32x4*)gr * v0; *(f32x4*)(o + 4) = *(const f32x4*)(xr + 4) + *(const f32x4*)(gr + 4) * v1; } };
struct SmallF32 { float* out; DEV void operator()(int row, int col, f32x4 v0, f32x4 v1) const { float* o = out + (size_t)row * D + col; *(f32x4*)o = v0; *(f32x4*)(o + 4) = v1; } };

DEV void transpose_tile(const float* src, int ld_src, bf16_t* dst, int ld_dst, float* tile) {
    const int tid = threadIdx.x;
#pragma unroll
    for (int i = 0; i < 2; ++i) { const int idx = tid + i * 512, r = idx >> 4, c4 = idx & 15; const f32x4 v = *(const f32x4*)(src + (size_t)r * ld_src + c4 * 4);
        float* t = tile + r * 65 + c4 * 4; t[0] = v[0]; t[1] = v[1]; t[2] = v[2]; t[3] = v[3]; }
    __syncthreads();
    const int n = tid >> 3, kg = tid & 7; const float* t = tile + (kg * 8) * 65 + n;
    u32x4 w; w.x = pack2(t[0], t[65]); w.y = pack2(t[2 * 65], t[3 * 65]); w.z = pack2(t[4 * 65], t[5 * 65]); w.w = pack2(t[6 * 65], t[7 * 65]);
    *(u32x4*)(dst + (size_t)n * ld_dst + kg * 8) = w;
    __syncthreads();
}
DEV int cvt_job_tiles(int j) { const int K = j < 9 ? 2048 : 256; const int N = j < 2 ? NMOD : (j == 2 ? 2 * D : (j < 5 ? ZW : (j < 9 ? D : 256))); return (K / 64) * (N / 64); }
DEV void phase_convert(const Params& p, unsigned char* lds, int part) {
    float* tile = (float*)lds;
    const int tid = threadIdx.x;
    const int q_lo = part == 0 ? 0 : 3, q_hi = part == 0 ? 3 : 17;
    int total = 0;
#pragma unroll
    for (int q = 0; q < 17; ++q) if (q >= q_lo && q < q_hi) total += cvt_job_tiles(q);
    for (int tl = blockIdx.x; tl < total; tl += gridDim.x) {
        int j = 0, loc = 0, base = 0;
#pragma unroll
        for (int q = 0; q < 17; ++q) if (q >= q_lo && q < q_hi) { const int cnt = cvt_job_tiles(q); if (tl >= base && tl < base + cnt) { j = q; loc = tl - base; } base += cnt; }
        const float* src; bf16_t* dst; int K = 2048, N;
        if (j < 2) { N = NMOD; src = p.w_ada + (size_t)j * 2048 * NMOD; dst = p.wt_ada + (size_t)j * NMOD * 2048; }
        else if (j == 2) { N = 2 * D; src = p.w_ada_final; dst = p.wt_ada + (size_t)2 * NMOD * 2048; }
        else if (j < 5) { N = ZW; src = p.w_in + (size_t)(j - 3) * 2048 * ZW; dst = p.wt_in + (size_t)(j - 3) * ZW * 2048; }
        else if (j < 7) { N = D; src = p.w_out + (size_t)(j - 5) * D * D; dst = p.wt_out + (size_t)(j - 5) * D * D; }
        else if (j < 9) { N = D; src = p.peer_wq + (size_t)(j - 7) * D * D; dst = p.wt_q + (size_t)(j - 7) * D * D; }
        else { K = 256; N = 256; src = p.pool_w + (size_t)(j - 9) * 65536; dst = p.wt_pool + (size_t)(j - 9) * 65536; }
        const int ntn = N / 64, kt = loc / ntn, nt = loc % ntn;
        transpose_tile(src + (size_t)kt * 64 * N + nt * 64, N, dst + (size_t)nt * 64 * K + kt * 64, K, tile);
    }
    const size_t gt = (size_t)blockIdx.x * 512 + tid, gs = (size_t)gridDim.x * 512;
    if (part == 1) {
        const int lane = tid & 63;
        constexpr int NADA = MODW / 256, R1 = (4 * NE / 8) * 7;
        const bool uneven = (int)gridDim.x > NADA + 16;
        for (int seg = 0; seg < 2; ++seg) {
            int gw, nw, r_lo, r_hi;
            if (!uneven) { if (seg) break; gw = blockIdx.x * 8 + (tid >> 6); nw = gridDim.x * 8; r_lo = 0; r_hi = 4 * NE; }
            else if (seg == 0) { gw = blockIdx.x * 8 + (tid >> 6); nw = gridDim.x * 8; r_lo = 0; r_hi = R1; }
            else { if ((int)blockIdx.x < NADA) break; gw = ((int)blockIdx.x - NADA) * 8 + (tid >> 6); nw = ((int)gridDim.x - NADA) * 8; r_lo = R1; r_hi = 4 * NE; }
        for (int row = r_lo + gw; row < r_hi; row += nw) {
            const int which = row / (2 * NE), rr = row % (2 * NE);
            const float* src = (which ? p.peer_v : p.peer_u) + (size_t)rr * D; unsigned char* tab = (which ? p.v8 : p.u8) + (size_t)(rr / NE) * NE * D; const int e = rr % NE;
            f32x4 v[8]; float am = 0.f;
#pragma unroll
            for (int k = 0; k < 8; ++k) { v[k] = *(const f32x4*)(src + 4 * lane + 256 * k); am = fmaxf(am, fmaxf(fmaxf(fabsf(v[k][0]), fabsf(v[k][1])), fmaxf(fabsf(v[k][2]), fabsf(v[k][3])))); }
            am = wave_max(am);
            const float sc = am > 0.f ? 224.0f / am : 1.0f;
#pragma unroll
            for (int k = 0; k < 8; ++k) *(unsigned*)(tab + ((size_t)(2 * k + (lane >> 5)) * NE + e) * 128 + 4 * (lane & 31)) = fp8x4_enc(v[k][0] * sc, v[k][1] * sc, v[k][2] * sc, v[k][3] * sc);
            if (lane == 0) (which ? p.sv : p.su)[rr] = am > 0.f ? am * (1.0f / 224.0f) : 1.0f;
        }
        }
    }
    if (part == 0) for (size_t i = gt; i < (size_t)256 * D / 8; i += gs) {
        const int row = (int)(i / (D / 8)), c8 = (int)(i % (D / 8)) * 8; u32x4 w = (u32x4){0u, 0u, 0u, 0u};
        if (row < NC) { const float* s = (row < PB ? p.c_prompt + (size_t)row * D : p.c_sample + (size_t)(row - PB) * D) + c8;
            const f32x4 a = *(const f32x4*)s, b = *(const f32x4*)(s + 4);
            w.x = pack2(siluf_(a[0]), siluf_(a[1])); w.y = pack2(siluf_(a[2]), siluf_(a[3])); w.z = pack2(siluf_(b[0]), siluf_(b[1])); w.w = pack2(siluf_(b[2]), siluf_(b[3])); }
        *(u32x4*)(p.csil + i * 8) = w;
    }
}

DEV void phase_norm(const Params& p, const float* xlo, const float* xhi, const float* gn, int sh_off, int sc_off, bf16_t* obf, float* of32) {
    const int lane = threadIdx.x & 63, gw = blockIdx.x * 8 + (threadIdx.x >> 6), nw = gridDim.x * 8;
    for (int t = gw; t < NTOK; t += nw) {
        const float* xr = t < NP ? xlo + (size_t)t * D : xhi + (size_t)(t - NP) * D;
        const float* mrow = p.modbuf + (size_t)tok_batch(t) * MODW;
        f32x4 v[8]; float ss = 0.f;
#pragma unroll
        for (int c = 0; c < 4; ++c) { const int col = c * 512 + lane * 8; v[2 * c] = *(const f32x4*)(xr + col); v[2 * c + 1] = *(const f32x4*)(xr + col + 4);
#pragma unroll
            for (int j = 0; j < 4; ++j) ss += v[2 * c][j] * v[2 * c][j] + v[2 * c + 1][j] * v[2 * c + 1][j]; }
        ss = wave_sum(ss);
        const float rstd = rsqrtf(ss * (1.0f / D) + EPS);
#pragma unroll
        for (int c = 0; c < 4; ++c) { const int col = c * 512 + lane * 8; f32x4 y[2];
#pragma unroll
            for (int q = 0; q < 2; ++q) { const f32x4 g4 = *(const f32x4*)(gn + col + 4 * q), sc = *(const f32x4*)(mrow + sc_off + col + 4 * q), sh = *(const f32x4*)(mrow + sh_off + col + 4 * q);
                y[q] = (v[2 * c + q] * rstd) * g4 * (sc + 1.0f) + sh; }
            if (obf) { u32x4 w; w.x = pack2(y[0][0], y[0][1]); w.y = pack2(y[0][2], y[0][3]); w.z = pack2(y[1][0], y[1][1]); w.w = pack2(y[1][2], y[1][3]); *(u32x4*)(obf + (size_t)t * D + col) = w; }
            else { *(f32x4*)(of32 + (size_t)t * D + col) = y[0]; *(f32x4*)(of32 + (size_t)t * D + col + 4) = y[1]; }
        }
    }
}

namespace hg {
constexpr int QS = 136, VS = 72;
constexpr int O_QT = 0, O_QH = O_QT + 64 * QS * 2, O_KT = O_QH + 64 * QS * 2, O_KDT = O_KT + 160 * QS * 2, O_VT = O_KDT + 128 * VS * 2,
              O_AB = O_VT + 128 * VS * 2, O_GS = O_AB + 64 * VS * 2, O_END = O_GS + 4 * 128 * 4;
constexpr int OS = 132;
static_assert(O_END <= 163840 - 64, "HGRN LDS layout too large");
constexpr int NCHUNK = SEQ / 64, NUNIT = PB * HH * NCHUNK;
}
DEV int kt_rowbase(int i) { return i == 0 ? 0 : (i == 1 ? 16 : (i == 2 ? 48 : 96)); }

DEV void hgrn_pre_unit(const Params& p, int l, int unit, unsigned char* lds) {
    using namespace hg;
    const int tid = threadIdx.x, lane = tid & 63, w = tid >> 6, g = lane >> 4, c16 = lane & 15;
    const int c = unit % NCHUNK, bh = unit / NCHUNK, b = bh / HH, h = bh % HH;
    bf16_t* Qt = (bf16_t*)(lds + O_QT); bf16_t* Qh = (bf16_t*)(lds + O_QH); bf16_t* Kt = (bf16_t*)(lds + O_KT);
    bf16_t* Kdt = (bf16_t*)(lds + O_KDT); bf16_t* Vt = (bf16_t*)(lds + O_VT); bf16_t* Ab = (bf16_t*)(lds + O_AB); float* Gs = (float*)(lds + O_GS);
    const int kk = tid & 127, sj = tid >> 7;
    float lbv = 0.f;
    if (l > 0) lbv = sigmoidf_(p.lb_logits[HH * HD + h * HD + kk] - p.lb_logits[h * HD + kk]);
    const float oml = 1.0f - lbv;
    for (int i = tid; i < 64 * VS / 2; i += 512) ((unsigned*)Ab)[i] = 0u;
    const size_t row0 = (size_t)b * SEQ + c * 64;
    float Gl[16], qv[16], kv[16];
    {
        const bf16_t* zr = p.z + (row0 + sj * 16) * ZW + h * HD + kk;
        unsigned short zq16[16], zf16[16], zi16[16];
#pragma unroll
        for (int s = 0; s < 16; ++s) { zq16[s] = zr[(size_t)s * ZW]; zf16[s] = zr[(size_t)s * ZW + 1024]; zi16[s] = zr[(size_t)s * ZW + 2048]; }
        float run = 0.f; unsigned vpk[8];
#pragma unroll
        for (int s = 0; s < 16; ++s) {
            const float zq = bf2f(zq16[s]), zf = fminf(fmaxf(bf2f(zf16[s]), -80.f), 80.f);
            const float e = __expf(-zf), sg = 1.0f / (1.0f + e);
            const float f = lbv + oml * sg;
            run += __logf(f); Gl[s] = run;
            kv[s] = oml * (e * sg);
            qv[s] = siluf_(zq);
            if (s & 1) vpk[s >> 1] |= (unsigned)zi16[s] << 16; else vpk[s >> 1] = zi16[s];
        }
        Gs[sj * 128 + kk] = run;
        *(u32x4*)(Vt + kk * VS + sj * 16) = (u32x4){vpk[0], vpk[1], vpk[2], vpk[3]}; *(u32x4*)(Vt + kk * VS + sj * 16 + 8) = (u32x4){vpk[4], vpk[5], vpk[6], vpk[7]};
    }
    __syncthreads();
    float Gend;
    {
        const float g0 = Gs[kk], g1 = Gs[128 + kk], g2 = Gs[256 + kk], g3 = Gs[384 + kk];
        float Gb[4]; Gb[0] = 0.f; Gb[1] = g0; Gb[2] = g0 + g1; Gb[3] = g0 + g1 + g2; Gend = Gb[3] + g3;
        const float Gbj = sj == 0 ? Gb[0] : (sj == 1 ? Gb[1] : (sj == 2 ? Gb[2] : Gb[3]));
        const float eGb = __expf(Gbj);
        unsigned kd[8]; unsigned qh[8];
#pragma unroll
        for (int s = 0; s < 16; ++s) {
            const int t = sj * 16 + s;
            const float q1 = qv[s] * __expf(Gl[s]);
            Qt[t * QS + kk] = (bf16_t)f2bf(q1);
            const unsigned qhv = f2bf(q1 * eGb);
            Qh[t * QS + kk] = (bf16_t)qhv;
#pragma unroll
            for (int i = 0; i < 4; ++i) if (i >= sj) Kt[(kt_rowbase(i) + t) * QS + kk] = (bf16_t)f2bf(kv[s] * __expf(fminf(Gb[i] - Gbj - Gl[s], 60.f)));
            const unsigned kdv = f2bf(kv[s] * __expf(Gend - Gbj - Gl[s]));
            if (s & 1) kd[s >> 1] |= kdv << 16; else kd[s >> 1] = kdv;
        }
        *(u32x4*)(Kdt + kk * VS + sj * 16) = (u32x4){kd[0], kd[1], kd[2], kd[3]}; *(u32x4*)(Kdt + kk * VS + sj * 16 + 8) = (u32x4){kd[4], kd[5], kd[6], kd[7]};
        if (sj == 0) p.hg_gam[(size_t)unit * HD + kk] = __expf(Gend);
    }
    __syncthreads();
    {
        const int t = tid >> 3, part = tid & 7;
        const u32x4 a = *(const u32x4*)(Qh + t * QS + 16 * part), b2 = *(const u32x4*)(Qh + t * QS + 16 * part + 8);
        bf16_t* dst = p.hg_qh + (row0 + t) * 1024 + h * HD + 16 * part; *(u32x4*)dst = a; *(u32x4*)(dst + 8) = b2;
    }
    for (int blk = w; blk < 10; blk += 8) {
        int bi, bjj;
        if (blk == 0) { bi = 0; bjj = 0; } else if (blk < 3) { bi = 1; bjj = blk - 1; } else if (blk < 6) { bi = 2; bjj = blk - 3; } else { bi = 3; bjj = blk - 6; }
        f32x4 acc = (f32x4){0.f, 0.f, 0.f, 0.f};
#pragma unroll
        for (int ks = 0; ks < 4; ++ks) {
            const bf16x8 a = *(const bf16x8*)(Qt + (16 * bi + c16) * QS + 32 * ks + 8 * g);
            const bf16x8 bb = *(const bf16x8*)(Kt + (kt_rowbase(bi) + 16 * bjj + c16) * QS + 32 * ks + 8 * g);
            acc = MFMA_BF16(a, bb, acc);
        }
#pragma unroll
        for (int r = 0; r < 4; ++r) { const int tl = 4 * g + r; float v = acc[r]; if (bi == bjj && c16 > tl) v = 0.f; Ab[(16 * bi + tl) * VS + 16 * bjj + c16] = (bf16_t)f2bf(v); }
    }
    __syncthreads();
    {
        u32x2* oin = (u32x2*)(p.hg_oin + (size_t)unit * 64 * 128);
#pragma unroll
        for (int tt = 0; tt < 4; ++tt) {
            f32x4 acc = (f32x4){0.f, 0.f, 0.f, 0.f};
#pragma unroll
            for (int ks = 0; ks < 2; ++ks) {
                const bf16x8 a = *(const bf16x8*)(Ab + (16 * tt + c16) * VS + 32 * ks + 8 * g);
                const bf16x8 bb = *(const bf16x8*)(Vt + (16 * w + c16) * VS + 32 * ks + 8 * g);
                acc = MFMA_BF16(a, bb, acc);
            }
            oin[(tt * 8 + w) * 64 + lane] = (u32x2){pack2(acc[0], acc[1]), pack2(acc[2], acc[3])};
        }
        u32x2* ds = (u32x2*)(p.hg_ds + (size_t)unit * 128 * 128);
#pragma unroll
        for (int vt = 0; vt < 8; ++vt) {
            f32x4 acc = (f32x4){0.f, 0.f, 0.f, 0.f};
#pragma unroll
            for (int ks = 0; ks < 2; ++ks) {
                const bf16x8 a = *(const bf16x8*)(Kdt + (16 * w + c16) * VS + 32 * ks + 8 * g);
                const bf16x8 bb = *(const bf16x8*)(Vt + (16 * vt + c16) * VS + 32 * ks + 8 * g);
                acc = MFMA_BF16(a, bb, acc);
            }
            ds[(w * 8 + vt) * 64 + lane] = (u32x2){pack2(acc[0], acc[1]), pack2(acc[2], acc[3])};
        }
    }
    __syncthreads();
}

DEV void hgrn_scan_unit(const Params& p, int l, int su) {
    using namespace hg;
    const int tid = threadIdx.x, lane = tid & 63, w = tid >> 6, g = lane >> 4, c16 = lane & 15;
    const int vt = su % 8, bh = su / 8, b = bh / HH, h = bh % HH;
    f32x4 S = (f32x4){0.f, 0.f, 0.f, 0.f};
    for (int c = 0; c < NCHUNK; ++c) {
        const size_t unit = (size_t)bh * NCHUNK + c;
        u32x2 sw; sw.x = pack2(S[0], S[1]); sw.y = pack2(S[2], S[3]);
        *(u32x2*)(p.hg_sc + (unit * 128 + 16 * vt + c16) * 128 + 16 * w + 4 * g) = sw;
        const u32x2 dw = ((const u32x2*)(p.hg_ds + unit * 128 * 128))[(w * 8 + vt) * 64 + lane]; const f32x4 d = (f32x4){lo16(dw.x), hi16(dw.x), lo16(dw.y), hi16(dw.y)};
        const f32x4 gm = *(const f32x4*)(p.hg_gam + unit * HD + 16 * w + 4 * g);
        S = S * gm + d;
    }
    float* so = p.out + OFF_HP + ((size_t)(l * PB + b) * HH + h) * HD * HD;
#pragma unroll
    for (int r = 0; r < 4; ++r) so[(size_t)(16 * w + 4 * g + r) * HD + 16 * vt + c16] = S[r];
}

DEV void hgrn_post_unit(const Params& p, int l, int unit, unsigned char* lds) {
    using namespace hg;
    const int tid = threadIdx.x, lane = tid & 63, w = tid >> 6, g = lane >> 4, c16 = lane & 15;
    const int c = unit % NCHUNK, bh = unit / NCHUNK, b = bh / HH, h = bh % HH;
    float* Ob = (float*)lds;
    const size_t row0 = (size_t)b * SEQ + c * 64;
    const u32x2* oin = (const u32x2*)(p.hg_oin + (size_t)unit * 64 * 128);
    f32x4 acc[4];
#pragma unroll
    for (int tt = 0; tt < 4; ++tt) { const u32x2 ow = oin[(tt * 8 + w) * 64 + lane]; acc[tt] = (f32x4){lo16(ow.x), hi16(ow.x), lo16(ow.y), hi16(ow.y)}; }
    if (c > 0) {
        bf16x8 bfr[4];
#pragma unroll
        for (int ks = 0; ks < 4; ++ks) bfr[ks] = *(const bf16x8*)(p.hg_sc + ((size_t)unit * 128 + 16 * w + c16) * 128 + 32 * ks + 8 * g);
#pragma unroll
        for (int tt = 0; tt < 4; ++tt)
#pragma unroll
            for (int ks = 0; ks < 4; ++ks) { const bf16x8 a = *(const bf16x8*)(p.hg_qh + (row0 + 16 * tt + c16) * 1024 + h * HD + 32 * ks + 8 * g); acc[tt] = MFMA_BF16(a, bfr[ks], acc[tt]); }
    }
#pragma unroll
    for (int tt = 0; tt < 4; ++tt)
#pragma unroll
        for (int r = 0; r < 4; ++r) Ob[(16 * tt + 4 * g + r) * OS + 16 * w + c16] = acc[tt][r];
    __syncthreads();
    {
        const int t = tid >> 3, part = tid & 7; const size_t row = row0 + t;
        float ov[16]; float ss = 0.f;
#pragma unroll
        for (int q = 0; q < 4; ++q) { const f32x4 x = *(const f32x4*)(Ob + t * OS + 16 * part + 4 * q); ov[4 * q] = x[0]; ov[4 * q + 1] = x[1]; ov[4 * q + 2] = x[2]; ov[4 * q + 3] = x[3];
            ss += x[0] * x[0] + x[1] * x[1] + x[2] * x[2] + x[3] * x[3]; }
        ss += __shfl_xor(ss, 1); ss += __shfl_xor(ss, 2); ss += __shfl_xor(ss, 4);
        const float rstd = rsqrtf(ss * (1.0f / HD) + EPS);
        const bf16_t* zg = p.z + row * ZW + 3072 + h * HD + 16 * part;
        const u32x4 za = *(const u32x4*)zg, zc = *(const u32x4*)(zg + 8);
        const unsigned zw[8] = {za.x, za.y, za.z, za.w, zc.x, zc.y, zc.z, zc.w};
        const float* gn = p.hgrn_norm_g + l * HD + 16 * part;
        unsigned ow[8];
#pragma unroll
        for (int q = 0; q < 8; ++q) { const float a0 = ov[2 * q] * rstd * gn[2 * q] * siluf_(lo16(zw[q])), a1 = ov[2 * q + 1] * rstd * gn[2 * q + 1] * siluf_(hi16(zw[q])); ow[q] = pack2(a0, a1); }
        bf16_t* dst = p.cat + row * D + h * HD + 16 * part;
        *(u32x4*)dst = (u32x4){ow[0], ow[1], ow[2], ow[3]}; *(u32x4*)(dst + 8) = (u32x4){ow[4], ow[5], ow[6], ow[7]};
    }
    __syncthreads();
}

DEV void hgrn_sample_unit(const Params& p, int l, int unit, unsigned char* lds) {
    const int tid = threadIdx.x, lane = tid & 63, w = tid >> 6;
    const int b = unit / HH, h = unit % HH;
    float* fS = (float*)lds; float* kS = fS + 512; float* qS = kS + 512; float* vS = qS + 512; float* red = vS + 512; float* part = red + 4 * 4 * 128;
    const int r0 = NP + b * DSEQ;
    {
        const int t = tid >> 7, kk = tid & 127; const bf16_t* zr = p.z + (size_t)(r0 + t) * ZW + h * HD + kk;
        float lbv = 0.f; if (l > 0) lbv = sigmoidf_(p.lb_logits[HH * HD + h * HD + kk] - p.lb_logits[h * HD + kk]);
        const float zq = bf2f(zr[0]), zf = fminf(fmaxf(bf2f(zr[1024]), -80.f), 80.f), zi = bf2f(zr[2048]);
        const float e = __expf(-zf), sg = 1.0f / (1.0f + e);
        fS[tid] = lbv + (1.0f - lbv) * sg; kS[tid] = (1.0f - lbv) * (e * sg); qS[tid] = siluf_(zq); vS[tid] = zi;
    }
    const int v = tid & 127, kq = tid >> 7;
    const float* s0 = p.state_hgrn + ((size_t)(l * DB + b) * HH + h) * HD * HD + (size_t)(32 * kq) * HD + v;
    float S[32];
#pragma unroll
    for (int i = 0; i < 32; ++i) S[i] = s0[(size_t)i * HD];
    __syncthreads();
#pragma unroll
    for (int t = 0; t < 4; ++t) {
        const float vv = vS[t * 128 + v]; float po = 0.f;
#pragma unroll
        for (int i = 0; i < 32; ++i) { const int kk = t * 128 + 32 * kq + i; S[i] = fS[kk] * S[i] + kS[kk] * vv; po += qS[kk] * S[i]; }
        red[(t * 4 + kq) * 128 + v] = po;
    }
    float* so = p.out + OFF_HS + ((size_t)(l * DB + b) * HH + h) * HD * HD + (size_t)(32 * kq) * HD + v;
#pragma unroll
    for (int i = 0; i < 32; ++i) so[(size_t)i * HD] = S[i];
    __syncthreads();
    {
        const int t = tid >> 7; const float o = red[(t * 4 + 0) * 128 + v] + red[(t * 4 + 1) * 128 + v] + red[(t * 4 + 2) * 128 + v] + red[(t * 4 + 3) * 128 + v];
        const float ss = wave_sum(o * o);
        if (lane == 0) part[w] = ss;
        __syncthreads();
        const float tot = part[2 * t] + part[2 * t + 1];
        const float rstd = rsqrtf(tot * (1.0f / HD) + EPS);
        const float zg = bf2f(p.z[(size_t)(r0 + t) * ZW + 3072 + h * HD + v]);
        p.cat[(size_t)(r0 + t) * D + h * HD + v] = (bf16_t)f2bf(o * rstd * p.hgrn_norm_g[l * HD + v] * siluf_(zg));
    }
    __syncthreads();
}

DEV void pool_pre_unit(const Params& p, int l, int unit) {
    const int tid = threadIdx.x, tk = tid >> 7, cg = tid & 127, c = cg * 8, gi = cg >> 5, wnd = 2 << gi;
    const int r = unit * 4 + tk;
    if (r >= NTOK) return;
    f32x2 sum[4] = {{0.f, 0.f}, {0.f, 0.f}, {0.f, 0.f}, {0.f, 0.f}}; float cur[8];
    float cnt;
    if (r < NP) {
        const int t = r % SEQ; const int n = (wnd < t + 1) ? wnd : (t + 1); cnt = (float)n;
        u32x4 q[16];
#pragma unroll
        for (int j = 0; j < 16; ++j) q[j] = (j < n) ? *(const u32x4*)(p.z + (size_t)(r - j) * ZW + 4096 + c) : (u32x4){0u, 0u, 0u, 0u};
#pragma unroll
        for (int j = 0; j < 16; ++j) { sum[0] += (f32x2){lo16(q[j].x), hi16(q[j].x)}; sum[1] += (f32x2){lo16(q[j].y), hi16(q[j].y)}; sum[2] += (f32x2){lo16(q[j].z), hi16(q[j].z)}; sum[3] += (f32x2){lo16(q[j].w), hi16(q[j].w)}; }
        cur[0] = lo16(q[0].x); cur[1] = hi16(q[0].x); cur[2] = lo16(q[0].y); cur[3] = hi16(q[0].y); cur[4] = lo16(q[0].z); cur[5] = hi16(q[0].z); cur[6] = lo16(q[0].w); cur[7] = hi16(q[0].w);
        if (t >= SEQ - PBUF) { float* o = p.out + OFF_PP + ((size_t)(l * PB + r / SEQ) * PBUF + (t - (SEQ - PBUF))) * PW + c;
            *(f32x4*)o = (f32x4){cur[0], cur[1], cur[2], cur[3]}; *(f32x4*)(o + 4) = (f32x4){cur[4], cur[5], cur[6], cur[7]}; }
    } else {
        const int bb = (r - NP) / DSEQ, t = (r - NP) % DSEQ; cnt = (float)wnd;
        const float* sp = p.state_pool + (size_t)(l * DB + bb) * PBUF * PW + c;
        u32x4 q[4]; f32x4 sa[15], sb[15];
#pragma unroll
        for (int j = 0; j < 4; ++j) q[j] = (j <= t && j < wnd) ? *(const u32x4*)(p.z + (size_t)(NP + bb * DSEQ + t - j) * ZW + 4096 + c) : (u32x4){0u, 0u, 0u, 0u};
#pragma unroll
        for (int j = 1; j < 16; ++j) {
            const int back = j - t;
            const bool use = (back >= 1) && (j < wnd);
            const float* srow = sp + (size_t)(PBUF - (use ? back : 1)) * PW;
            sa[j - 1] = use ? *(const f32x4*)srow : (f32x4){0.f, 0.f, 0.f, 0.f}; sb[j - 1] = use ? *(const f32x4*)(srow + 4) : (f32x4){0.f, 0.f, 0.f, 0.f};
        }
#pragma unroll
        for (int j = 0; j < 4; ++j) { sum[0] += (f32x2){lo16(q[j].x), hi16(q[j].x)}; sum[1] += (f32x2){lo16(q[j].y), hi16(q[j].y)}; sum[2] += (f32x2){lo16(q[j].z), hi16(q[j].z)}; sum[3] += (f32x2){lo16(q[j].w), hi16(q[j].w)}; }
#pragma unroll
        for (int j = 0; j < 15; ++j) { sum[0] += (f32x2){sa[j][0], sa[j][1]}; sum[1] += (f32x2){sa[j][2], sa[j][3]}; sum[2] += (f32x2){sb[j][0], sb[j][1]}; sum[3] += (f32x2){sb[j][2], sb[j][3]}; }
        cur[0] = lo16(q[0].x); cur[1] = hi16(q[0].x); cur[2] = lo16(q[0].y); cur[3] = hi16(q[0].y); cur[4] = lo16(q[0].z); cur[5] = hi16(q[0].z); cur[6] = lo16(q[0].w); cur[7] = hi16(q[0].w);
        float* ob = p.out + OFF_PS + (size_t)(l * DB + bb) * PBUF * PW + c;
        { float* o = ob + (size_t)(11 + t) * PW; *(f32x4*)o = (f32x4){cur[0], cur[1], cur[2], cur[3]}; *(f32x4*)(o + 4) = (f32x4){cur[4], cur[5], cur[6], cur[7]}; }
        for (int i = t; i < 11; i += 4) { const float* s2 = sp + (size_t)(4 + i) * PW; float* o = ob + (size_t)i * PW; *(f32x4*)o = *(const f32x4*)s2; *(f32x4*)(o + 4) = *(const f32x4*)(s2 + 4); }
    }
    const float inv = 1.0f / cnt;
    u32x4 w; w.x = pack2(sum[0][0] * inv - cur[0], sum[0][1] * inv - cur[1]); w.y = pack2(sum[1][0] * inv - cur[2], sum[1][1] * inv - cur[3]);
    w.z = pack2(sum[2][0] * inv - cur[4], sum[2][1] * inv - cur[5]); w.w = pack2(sum[3][0] * inv - cur[6], sum[3][1] * inv - cur[7]);
    *(u32x4*)(p.pooled + ((size_t)gi * MPAD + r) * 256 + (c & 255)) = w;
}

#ifndef PROBE_SUB
#define PROBE_SUB 0
#endif
DEV void phase_mix1(const Params& p, int l, unsigned char* lds) {
    for (int rep = 0; rep < (PROBE_SUB == 1 ? 2 : 1); ++rep) for (int u = blockIdx.x; u < hg::NUNIT; u += gridDim.x) hgrn_pre_unit(p, l, u, lds);
    for (int rep = 0; rep < (PROBE_SUB == 2 ? 2 : 1); ++rep) for (int u = blockIdx.x; u < DB * HH; u += gridDim.x) hgrn_sample_unit(p, l, u, lds);
    for (int rep = 0; rep < (PROBE_SUB == 3 ? 2 : 1); ++rep) for (int u = blockIdx.x; u < (NTOK + 3) / 4; u += gridDim.x) pool_pre_unit(p, l, u);
}
DEV void phase_mix2(const Params& p, int l) { for (int u = blockIdx.x; u < PB * HH * 8; u += gridDim.x) hgrn_scan_unit(p, l, u); }
DEV void phase_mix3(const Params& p, int l, unsigned char* lds) { for (int u = blockIdx.x; u < hg::NUNIT; u += gridDim.x) hgrn_post_unit(p, l, u, lds); }

#ifdef HIPEMU
#define MBCNT(mask) __builtin_popcountll((mask) & ((1ull << emu_lane()) - 1ull))
#define POPC64(m) __builtin_popcountll(m)
#else
#define MBCNT(mask) ((int)__builtin_amdgcn_mbcnt_hi((unsigned)((mask) >> 32), __builtin_amdgcn_mbcnt_lo((unsigned)(mask), 0u)))
#define POPC64(m) __popcll(m)
#endif
DEV unsigned fkey(float f) { const unsigned u = __float_as_uint(f); return u ^ ((unsigned)((int)u >> 31) | 0x80000000u); }
DEV unsigned long long lowest_n_bits(unsigned long long m, int n) { unsigned long long r = 0ull; while (n > 0 && m) { const unsigned long long b = m & (~m + 1ull); r |= b; m ^= b; --n; } return r; }
#ifdef HIPEMU
#define DPPU_XOR1(v) __shfl((v), emu_lane() ^ 1)
#define DPPU_XOR2(v) __shfl((v), emu_lane() ^ 2)
#define DPPU_HMIRROR(v) __shfl((v), (emu_lane() & ~7) | (7 - (emu_lane() & 7)))
#else
template <int CTRL> DEV unsigned dpp_u(unsigned v) { return (unsigned)__builtin_amdgcn_update_dpp(0, (int)v, CTRL, 0xf, 0xf, true); }
#define DPPU_XOR1(v) dpp_u<0xB1>(v)
#define DPPU_XOR2(v) dpp_u<0x4E>(v)
#define DPPU_HMIRROR(v) dpp_u<0x141>(v)
#endif
template <int GL> DEV unsigned group_sum(unsigned c) { c += DPPU_XOR1(c); c += DPPU_XOR2(c); if (GL == 8) c += DPPU_HMIRROR(c); return c; }
template <int GL> DEV unsigned group_or(unsigned c) { c |= DPPU_XOR1(c); c |= DPPU_XOR2(c); if (GL == 8) c |= DPPU_HMIRROR(c); return c; }
template <int GL> DEV float group_maxf(float v) { v = fmaxf(v, DPP_XOR1(v)); v = fmaxf(v, DPP_XOR2(v)); if (GL == 8) v = fmaxf(v, DPP_HMIRROR(v)); return v; }
template <int GL> DEV float group_sumf(float v) { v += DPP_XOR1(v); v += DPP_XOR2(v); if (GL == 8) v += DPP_HMIRROR(v); return v; }
DEV unsigned bytesum(unsigned w) { return (w * 0x01010101u) >> 24; }
template <int GL> DEV unsigned group_excl_prefix(unsigned c, int sub) {
    const unsigned sh = 8u * (unsigned)(sub & 3);
    unsigned wlo = (GL == 4 || sub < 4) ? (c << sh) : 0u, whi = (GL == 8 && sub >= 4) ? (c << sh) : 0u;
    wlo = group_or<GL>(wlo);
    unsigned r;
    if (GL == 4) r = bytesum(wlo & ((1u << sh) - 1u));
    else { whi = group_or<GL>(whi); r = sub < 4 ? bytesum(wlo & ((1u << sh) - 1u)) : bytesum(wlo) + bytesum(whi & ((1u << sh) - 1u)); }
    return r;
}
DEV float fkey_inv(unsigned k) { return __uint_as_float((k & 0x80000000u) ? (k ^ 0x80000000u) : ~k); }
template <int GL> DEV unsigned group_top16(const unsigned (&k)[32], bool active, int sub, unsigned& pos0) {
    unsigned mxk = 0u;
#pragma unroll
    for (int i = 0; i < 32; ++i) mxk = k[i] > mxk ? k[i] : mxk;
    { unsigned o = DPPU_XOR1(mxk); mxk = o > mxk ? o : mxk; o = DPPU_XOR2(mxk); mxk = o > mxk ? o : mxk; if (GL == 8) { o = DPPU_HMIRROR(mxk); mxk = o > mxk ? o : mxk; } }
    unsigned L0 = mxk > 0x01000000u ? mxk - 0x01000000u : 0u, c0 = 0u;
#pragma unroll
    for (int i = 0; i < 32; ++i) c0 += (k[i] > L0) ? 1u : 0u;
    c0 = group_sum<GL>(c0);
    unsigned L = c0 > 16u ? L0 + 1u : 0u, R = active ? mxk : 0u, cR = 0u;
    if (!active) L = 0u;
    if (c0 == 16u && active) { L = L0; R = L0; cR = 16u; }
    for (;;) {
        if (__ballot(L < R) == 0ull) break;
        const unsigned mid = L + ((R - L) >> 1);
        unsigned c = 0u;
#pragma unroll
        for (int i = 0; i < 32; ++i) c += (k[i] > mid) ? 1u : 0u;
        c = group_sum<GL>(c);
        const bool le = c <= 16u, hit = c == 16u;
        R = le ? mid : R; cR = le ? c : cR; L = hit ? mid : (le ? L : mid + 1u);
    }
    unsigned mask = 0u;
#pragma unroll
    for (int i = 0; i < 32; ++i) mask |= (k[i] > R) ? (1u << i) : 0u;
    const unsigned need = 16u - cR;
    if (__ballot(active && need > 0u) != 0ull) {
        unsigned eqm = 0u;
#pragma unroll
        for (int i = 0; i < 32; ++i) eqm |= (k[i] == R) ? (1u << i) : 0u;
        const unsigned eqc = (unsigned)__builtin_popcount(eqm), before = group_excl_prefix<GL>(eqc, sub);
        unsigned take = need > before ? need - before : 0u; if (take > eqc) take = eqc;
        if (!active) take = 0u;
        while (take > 0u) { const unsigned b = eqm & (~eqm + 1u); mask |= b; eqm ^= b; --take; }
    }
    if (!active) mask = 0u;
    pos0 = group_excl_prefix<GL>((unsigned)__builtin_popcount(mask), sub);
    return mask;
}
constexpr int SEL_NT = 4;
constexpr int SEL_RS = 144;
DEV void select_step(const Params& p, int l, int tt0, int tstride, int ntile, int h, unsigned char* lds, const bf16x8 (&kh)[2][4], const bf16x8 (&kl)[2][4]) {
    const int tid = threadIdx.x, lane = tid & 63, w = tid >> 6, g = lane >> 4, c16 = lane & 15;
    constexpr int NTK = SEL_NT * 16;
    constexpr int QRS = 264;
    bf16_t* qh = (bf16_t*)lds;
    bf16_t* ql = qh + NTK * QRS;
    float* sc = (float*)(ql + NTK * QRS);
    float* ts = sc + 2 * NTK * SEL_RS;
    int* ti = (int*)(ts + 2 * NTK * 16);
#pragma unroll
    for (int k = 0; k < SEL_NT; ++k) {
        const int tk = tid >> 5, part = tid & 31; const int tok = (tt0 + k * tstride) * 16 + tk;
        f32x4 a = (f32x4){0.f, 0.f, 0.f, 0.f}, b2 = a;
        if (k < ntile && tok < NTOK) { const float* q = p.qry + (size_t)tok * D + h * 256 + part * 8; a = *(const f32x4*)q; b2 = *(const f32x4*)(q + 4); }
        float ss = a[0] * a[0] + a[1] * a[1] + a[2] * a[2] + a[3] * a[3] + b2[0] * b2[0] + b2[1] * b2[1] + b2[2] * b2[2] + b2[3] * b2[3];
        ss += __shfl_xor(ss, 1); ss += __shfl_xor(ss, 2); ss += __shfl_xor(ss, 4); ss += __shfl_xor(ss, 8);
        const float rn = rsqrtf(ss * (1.0f / 128.0f) + EPS);
        const float v[8] = {a[0] * rn, a[1] * rn, a[2] * rn, a[3] * rn, b2[0] * rn, b2[1] * rn, b2[2] * rn, b2[3] * rn};
        unsigned hi[4], lo[4];
#pragma unroll
        for (int j = 0; j < 4; ++j) { hi[j] = pack2(v[2 * j], v[2 * j + 1]); lo[j] = pack2(v[2 * j] - lo16(hi[j]), v[2 * j + 1] - hi16(hi[j])); }
        *(u32x4*)(qh + (k * 16 + tk) * QRS + part * 8) = (u32x4){hi[0], hi[1], hi[2], hi[3]}; *(u32x4*)(ql + (k * 16 + tk) * QRS + part * 8) = (u32x4){lo[0], lo[1], lo[2], lo[3]};
    }
    __syncthreads();
    for (int k = 0; k < ntile; ++k) {
#pragma unroll
        for (int ph = 0; ph < 2; ++ph) {
            f32x4 acc = (f32x4){0.f, 0.f, 0.f, 0.f};
#pragma unroll
            for (int ks = 0; ks < 4; ++ks) {
                const bf16x8 ah = *(const bf16x8*)(qh + (k * 16 + c16) * QRS + ph * 128 + 32 * ks + 8 * g), al = *(const bf16x8*)(ql + (k * 16 + c16) * QRS + ph * 128 + 32 * ks + 8 * g);
                acc = MFMA_BF16(al, kh[ph][ks], acc); acc = MFMA_BF16(ah, kl[ph][ks], acc); acc = MFMA_BF16(ah, kh[ph][ks], acc);
            }
            const int kidx = 16 * w + c16;
#pragma unroll
            for (int r = 0; r < 4; ++r) sc[(ph * NTK + k * 16 + 4 * g + r) * SEL_RS + (kidx >> 5) * 36 + (kidx & 31)] = acc[r];
        }
    }
    __syncthreads();
    {
        const int row = tid >> 2, sub = tid & 3; const bool active = ((row % NTK) >> 4) < ntile;
        unsigned k[32];
#pragma unroll
        for (int i4 = 0; i4 < 8; ++i4) { const f32x4 v = *(const f32x4*)(sc + row * SEL_RS + sub * 36 + 4 * i4); k[4 * i4] = fkey(v[0]); k[4 * i4 + 1] = fkey(v[1]); k[4 * i4 + 2] = fkey(v[2]); k[4 * i4 + 3] = fkey(v[3]); }
        unsigned pos; const unsigned mask = group_top16<4>(k, active, sub, pos);
#pragma unroll
        for (int i = 0; i < 32; ++i) if ((mask >> i) & 1u) { if (pos < 16u) { ts[row * 16 + pos] = fkey_inv(k[i]); ti[row * 16 + pos] = 32 * sub + i; } ++pos; }
    }
    __syncthreads();
    {
        const int tk = tid >> 3, sub = tid & 7; const bool active = (tk >> 4) < ntile; const int tok = (tt0 + (tk >> 4) * tstride) * 16 + (tk & 15);
        const float s1a = ts[tk * 16 + 2 * sub], s1b = ts[tk * 16 + 2 * sub + 1];
        unsigned k[32];
#pragma unroll
        for (int j4 = 0; j4 < 4; ++j4) { const f32x4 s2 = *(const f32x4*)(ts + (NTK + tk) * 16 + 4 * j4);
#pragma unroll
            for (int j = 0; j < 4; ++j) { k[4 * j4 + j] = fkey(s1a + s2[j]); k[16 + 4 * j4 + j] = fkey(s1b + s2[j]); } }
        unsigned pos; const unsigned mask = group_top16<8>(k, active, sub, pos);
        const int i1a = ti[tk * 16 + 2 * sub], i1b = ti[tk * 16 + 2 * sub + 1];
        int i2v[16];
#pragma unroll
        for (int j4 = 0; j4 < 4; ++j4) { const u32x4 t4 = *(const u32x4*)(ti + (NTK + tk) * 16 + 4 * j4); i2v[4 * j4] = (int)t4.x; i2v[4 * j4 + 1] = (int)t4.y; i2v[4 * j4 + 2] = (int)t4.z; i2v[4 * j4 + 3] = (int)t4.w; }
        u32x2* lst = (u32x2*)sc;
#pragma unroll
        for (int i = 0; i < 32; ++i) if ((mask >> i) & 1u) { if (pos < 16u) lst[tk * 16 + pos] = (u32x2){__float_as_uint(fkey_inv(k[i])), (unsigned)((i < 16 ? i1a : i1b) * 128 + i2v[i & 15])}; ++pos; }
    }
    __syncthreads();
#pragma unroll
    for (int r = 0; r < NTK / 32; ++r) {
        const int tk = (tid >> 4) + 32 * r, slot = tid & 15; const int tok = (tt0 + (tk >> 4) * tstride) * 16 + (tk & 15);
        const u32x2 en = ((const u32x2*)sc)[tk * 16 + slot];
        const float v = __uint_as_float(en.x); const int e = (int)en.y;
        float mx = v; mx = fmaxf(mx, DPP_XOR1(mx)); mx = fmaxf(mx, DPP_XOR2(mx)); mx = fmaxf(mx, DPP_HMIRROR(mx)); mx = fmaxf(mx, DPP_RMIRROR(mx));
        const float ex = __expf(v - mx);
        float sm = ex; sm += DPP_XOR1(sm); sm += DPP_XOR2(sm); sm += DPP_HMIRROR(sm); sm += DPP_RMIRROR(sm);
        if ((tk >> 4) < ntile && tok < NTOK) { const size_t o = (size_t)tok * 128 + h * 16 + slot;
            p.eidx[o] = (unsigned short)e; p.gate[o] = ex / sm * p.sv[l * NE + e]; p.iscu[o] = p.su[l * NE + e]; }
    }
    __syncthreads();
}
DEV void phase_select(const Params& p, int l, unsigned char* lds) {
    const int ntt = (NTOK + 15) / 16, lane = threadIdx.x & 63, w = threadIdx.x >> 6, g = lane >> 4, c16 = lane & 15;
    const bool fixed = (gridDim.x % 8u) == 0u;
    const int nq = fixed ? (int)(gridDim.x >> 3) : 1;
    for (int hh = 0; hh < (fixed ? 1 : 8); ++hh) {
        const int h = fixed ? (int)(blockIdx.x & 7) : hh;
        bf16x8 kh[2][4], kl[2][4];
#pragma unroll
        for (int ph = 0; ph < 2; ++ph)
#pragma unroll
            for (int ks = 0; ks < 4; ++ks) { const float* kr = p.peer_keys + ((size_t)((l * 8 + h) * 2 + ph) * 128 + 16 * w + c16) * 128 + 32 * ks + 8 * g;
                const f32x4 a = *(const f32x4*)kr, b2 = *(const f32x4*)(kr + 4); const float v[8] = {a[0], a[1], a[2], a[3], b2[0], b2[1], b2[2], b2[3]};
                u32x4 hi, lo; unsigned hw[4], lw[4];
#pragma unroll
                for (int j = 0; j < 4; ++j) { hw[j] = pack2(v[2 * j], v[2 * j + 1]); lw[j] = pack2(v[2 * j] - lo16(hw[j]), v[2 * j + 1] - hi16(hw[j])); }
                hi = (u32x4){hw[0], hw[1], hw[2], hw[3]}; lo = (u32x4){lw[0], lw[1], lw[2], lw[3]};
                kh[ph][ks] = __builtin_bit_cast(bf16x8, hi); kl[ph][ks] = __builtin_bit_cast(bf16x8, lo); }
        const int first = fixed ? (int)(blockIdx.x >> 3) : (int)blockIdx.x, stride = fixed ? nq : (int)gridDim.x;
        for (int tt0 = first; tt0 < ntt; tt0 += SEL_NT * stride) {
            int ntile = 0;
#pragma unroll
            for (int k = 0; k < SEL_NT; ++k) if (tt0 + k * stride < ntt) ntile = k + 1;
            select_step(p, l, tt0, stride, ntile, h, lds, kh, kl);
        }
    }
}

constexpr int PEER_TB = 272;
struct PeerDeal { int xs_first, xs_step, t_begin, t_end; };
DEV PeerDeal peer_deal() {
    PeerDeal d; const bool sl = (gridDim.x % 8u) == 0u;
    const int nranks = sl ? (int)(gridDim.x >> 3) : (int)gridDim.x, rank = sl ? (int)(blockIdx.x >> 3) : (int)blockIdx.x, tpr = (NTOK + nranks - 1) / nranks;
    d.xs_first = sl ? (int)(blockIdx.x & 7) : 0; d.xs_step = sl ? 8 : 1; d.t_begin = rank * tpr; d.t_end = d.t_begin + tpr < NTOK ? d.t_begin + tpr : NTOK;
    return d;
}
struct PeerTok { u32x4 e0, e1, ha, hb; };
DEV void peer_fetch_u(const Params& p, int t, int c0, int g8, PeerTok& k) {
    const u32x4* ep = (const u32x4*)(p.eidx + (size_t)t * 128 + 16 * g8); k.e0 = ep[0]; k.e1 = ep[1];
    k.ha = *(const u32x4*)(p.hB + (size_t)t * D + c0); k.hb = *(const u32x4*)(p.hB + (size_t)t * D + c0 + 8);
}
DEV void phase_peer_u(const Params& p, int l, unsigned char* lds) {
    const int lane = threadIdx.x & 63, w = threadIdx.x >> 6, j8 = lane & 7, g8 = lane >> 3;
    const bool b2 = (j8 & 4) != 0, b1 = (j8 & 2) != 0, b0 = (j8 & 1) != 0;
    const PeerDeal dl = peer_deal();
    const unsigned char* U = p.u8 + (size_t)l * NE * D;
    float* lp = (float*)lds;
    for (int xs = dl.xs_first; xs < 8; xs += dl.xs_step)
    for (int t0 = dl.t_begin; t0 < dl.t_end; t0 += PEER_TB) {
        const int nb = dl.t_end - t0 < PEER_TB ? dl.t_end - t0 : PEER_TB;
        for (int ch = 0; ch < 2; ++ch) {
            const int c0 = 256 * xs + 128 * ch + 16 * j8;
            const unsigned char* Us = U + (size_t)(2 * xs + ch) * NE * 128 + 16 * j8;
            PeerTok nx; if (w < nb) peer_fetch_u(p, t0 + w, c0, g8, nx);
            for (int tk = w; tk < nb; tk += 8) {
                const int t = t0 + tk;
                const PeerTok cu = nx;
                const unsigned ew[8] = {cu.e0.x, cu.e0.y, cu.e0.z, cu.e0.w, cu.e1.x, cu.e1.y, cu.e1.z, cu.e1.w}; unsigned ev[16];
#pragma unroll
                for (int i = 0; i < 8; ++i) { ev[2 * i] = ew[i] & 0xffffu; ev[2 * i + 1] = ew[i] >> 16; }
                u32x4 q[16];
#pragma unroll
                for (int i = 0; i < 16; ++i) q[i] = *(const u32x4*)(Us + (size_t)ev[i] * 128);
                if (tk + 8 < nb) peer_fetch_u(p, t + 8, c0, g8, nx);
                const u32x4 ha = cu.ha, hb = cu.hb;
                const f32x2 hf[8] = {{lo16(ha.x), hi16(ha.x)}, {lo16(ha.y), hi16(ha.y)}, {lo16(ha.z), hi16(ha.z)}, {lo16(ha.w), hi16(ha.w)}, {lo16(hb.x), hi16(hb.x)}, {lo16(hb.y), hi16(hb.y)}, {lo16(hb.z), hi16(hb.z)}, {lo16(hb.w), hi16(hb.w)}};
                float ps[16];
#pragma unroll
                for (int i = 0; i < 16; ++i) { f32x2 dq[8]; fp8x16_dec2(q[i], dq); f32x2 a = dq[0] * hf[0];
#pragma unroll
                    for (int k = 1; k < 8; ++k) a = __builtin_elementwise_fma(dq[k], hf[k], a);
                    ps[i] = a[0] + a[1]; }
                float q8[8], q4[4], q2[2];
#pragma unroll
                for (int k = 0; k < 8; ++k) { const float keep = b2 ? ps[8 + k] : ps[k], send = b2 ? ps[k] : ps[8 + k]; q8[k] = keep + DPP_HMIRROR(send); }
#pragma unroll
                for (int k = 0; k < 4; ++k) { const float keep = b1 ? q8[4 + k] : q8[k], send = b1 ? q8[k] : q8[4 + k]; q4[k] = keep + DPP_XOR2(send); }
#pragma unroll
                for (int k = 0; k < 2; ++k) { const float keep = b0 ? q4[2 + k] : q4[k], send = b0 ? q4[k] : q4[2 + k]; q2[k] = keep + DPP_XOR1(send); }
                float* lrow = lp + tk * 128 + 16 * g8 + 2 * j8;
                if (ch == 0) { lrow[0] = q2[0]; lrow[1] = q2[1]; }
                else { const size_t o = (size_t)t * 128 + 16 * g8 + 2 * j8;
                    float* dst = p.part + ((size_t)t * 8 + xs) * 128 + 16 * g8 + 2 * j8;
                    dst[0] = (q2[0] + lrow[0]) * p.iscu[o]; dst[1] = (q2[1] + lrow[1]) * p.iscu[o + 1]; }
            }
        }
    }
}
DEV void phase_peer_c(const Params& p) {
    const size_t n = (size_t)NTOK * 128, gs = (size_t)gridDim.x * 512;
    for (size_t i = (size_t)blockIdx.x * 512 + threadIdx.x; i < n; i += gs) {
        const size_t t = i >> 7; const int pr = (int)(i & 127); float sacc = 0.f;
#pragma unroll
        for (int x = 0; x < 8; ++x) sacc += p.part[(t * 8 + x) * 128 + pr];
        p.ab16[i] = (bf16_t)f2bf(gelu_erf(sacc) * p.gate[i]);
    }
}
struct PeerTokV { u32x4 e0, e1, a0, a1; f32x2 x1, g2; };
DEV void peer_fetch_v(const Params& p, int l, int t, int col, int g8, PeerTokV& k) {
    const u32x4* ep = (const u32x4*)(p.eidx + (size_t)t * 128 + 16 * g8); k.e0 = ep[0]; k.e1 = ep[1];
    const u32x4* ap = (const u32x4*)(p.ab16 + (size_t)t * 128 + 16 * g8); k.a0 = ap[0]; k.a1 = ap[1];
    k.x1 = *(const f32x2*)(p.xa + (size_t)t * D + col); k.g2 = *(const f32x2*)(p.modbuf + (size_t)tok_batch(t) * MODW + l * NMOD + 5 * D + col);
}
DEV void phase_peer_v(const Params& p, int l, unsigned char* lds) {
    const int lane = threadIdx.x & 63, w = threadIdx.x >> 6, j8 = lane & 7, g8 = lane >> 3;
    const bool b3 = (g8 & 1) != 0, b4 = (g8 & 2) != 0, b5 = (g8 & 4) != 0;
    const PeerDeal dl = peer_deal();
    const unsigned char* V = p.v8 + (size_t)l * NE * D;
    for (int xs = dl.xs_first; xs < 8; xs += dl.xs_step)
        for (int ch = 0; ch < 2; ++ch) {
            const int c0 = 256 * xs + 128 * ch + 16 * j8, col = c0 + (b3 ? 8 : 0) + (b4 ? 4 : 0) + (b5 ? 2 : 0);
            const unsigned char* Vs = V + (size_t)(2 * xs + ch) * NE * 128 + 16 * j8;
            PeerTokV nx; if (dl.t_begin + w < dl.t_end) peer_fetch_v(p, l, dl.t_begin + w, col, g8, nx);
            for (int t = dl.t_begin + w; t < dl.t_end; t += 8) {
                const PeerTokV cu = nx;
                const unsigned ew[8] = {cu.e0.x, cu.e0.y, cu.e0.z, cu.e0.w, cu.e1.x, cu.e1.y, cu.e1.z, cu.e1.w}; unsigned ev[16];
#pragma unroll
                for (int i = 0; i < 8; ++i) { ev[2 * i] = ew[i] & 0xffffu; ev[2 * i + 1] = ew[i] >> 16; }
                u32x4 q[16];
#pragma unroll
                for (int i = 0; i < 16; ++i) q[i] = *(const u32x4*)(Vs + (size_t)ev[i] * 128);
                if (t + 8 < dl.t_end) peer_fetch_v(p, l, t + 8, col, g8, nx);
                const unsigned aw[8] = {cu.a0.x, cu.a0.y, cu.a0.z, cu.a0.w, cu.a1.x, cu.a1.y, cu.a1.z, cu.a1.w}; float av[16];
#pragma unroll
                for (int i = 0; i < 8; ++i) { av[2 * i] = lo16(aw[i]); av[2 * i + 1] = hi16(aw[i]); }
                f32x2 acc2[8];
#pragma unroll
                for (int k = 0; k < 8; ++k) acc2[k] = (f32x2){0.f, 0.f};
#pragma unroll
                for (int i = 0; i < 16; ++i) { f32x2 dq[8]; fp8x16_dec2(q[i], dq); const f32x2 a2v = (f32x2){av[i], av[i]};
#pragma unroll
                    for (int k = 0; k < 8; ++k) acc2[k] = __builtin_elementwise_fma(a2v, dq[k], acc2[k]); }
                float acc[16];
#pragma unroll
                for (int k = 0; k < 8; ++k) { acc[2 * k] = acc2[k][0]; acc[2 * k + 1] = acc2[k][1]; }
                float q8[8], q4[4], q2[2];
#pragma unroll
                for (int k = 0; k < 8; ++k) { const float keep = b3 ? acc[8 + k] : acc[k], send = b3 ? acc[k] : acc[8 + k]; q8[k] = keep + DPP_XOR8(send); }
#pragma unroll
                for (int k = 0; k < 4; ++k) q4[k] = xsum16(q8[k], q8[4 + k]);
#pragma unroll
                for (int k = 0; k < 2; ++k) q2[k] = xsum32(q4[k], q4[2 + k]);
                f32x2 o; o[0] = cu.x1[0] + cu.g2[0] * q2[0]; o[1] = cu.x1[1] + cu.g2[1] * q2[1];
                *(f32x2*)(p.xb + (size_t)t * D + col) = o;
            }
        }
}

constexpr int N_PHASES = 27;
DEV int phase_class(int k) { return k < 2 ? k : (k == 26 ? 14 : 2 + (k - 2) % 12); }
#ifndef HIPEMU
#define XB_TMO      128
#define XB_XCNT(j)  (256  + 64 * (j))
#define XB_XSUB(j)  (1280 + 64 * (j))
#define XB_XGEN(j)  (2304 + 64 * (j))
#define XB_TOP      3328
#define XB_TOPGEN   3392
#define XCD_BAR_WORDS 3456
#define XB_SPIN_CAP (1u << 22)
__device__ __forceinline__ unsigned xb_ld(unsigned* p)              { return __hip_atomic_load(p, __ATOMIC_RELAXED, __HIP_MEMORY_SCOPE_AGENT); }
__device__ __forceinline__ unsigned xb_add(unsigned* p, unsigned v) { return __hip_atomic_fetch_add(p, v, __ATOMIC_RELAXED, __HIP_MEMORY_SCOPE_AGENT); }
__device__ __forceinline__ unsigned xb_xcc_id() { return (unsigned)__builtin_amdgcn_s_getreg((3 << 11) | 20) & 0xFu; }
#define XB_SPIN(cond, bar) do { unsigned _sp = 0; while (cond) { __builtin_amdgcn_s_sleep(1); \
    if ((++_sp & 255u) == 0u) { if (xb_ld(&(bar)[XB_TMO])) break; if (_sp > XB_SPIN_CAP) { atomicAdd(&(bar)[XB_TMO], 1u); break; } } } } while (0)
struct XcdBarrier { unsigned* bar; unsigned x; volatile LAS unsigned* st; };
__device__ __forceinline__ XcdBarrier xcd_barrier_post(unsigned* bar, volatile LAS unsigned* st) {
    XcdBarrier b; b.bar = bar; b.x = xb_xcc_id(); b.st = st;
    if (threadIdx.x == 0) (void)xb_add(&bar[XB_XCNT(b.x)], 1u);
    return b;
}
__device__ __forceinline__ void xcd_barrier_complete(unsigned* bar, unsigned x, unsigned& nloc, unsigned& nx) {
    const unsigned G = gridDim.x * gridDim.y * gridDim.z;
    unsigned sum, cnt, mine, sp = 0u;
    for (;;) {
        sum = 0u; cnt = 0u; mine = 0u;
#pragma unroll
        for (unsigned j = 0; j < 16; ++j) { const unsigned c = xb_ld(&bar[XB_XCNT(j)]); sum += c; cnt += (c > 0u) ? 1u : 0u; mine = (j == x) ? c : mine; }
        if (sum == G) break;
        __builtin_amdgcn_s_sleep(1);
        if ((++sp & 255u) == 0u) { if (xb_ld(&bar[XB_TMO])) break; if (sp > XB_SPIN_CAP) { atomicAdd(&bar[XB_TMO], 1u); break; } }
    }
    nloc = mine > 0u ? mine : 1u; nx = cnt > 0u ? cnt : 1u;
}
__device__ __forceinline__ void xcd_barrier(const XcdBarrier& b) {
    asm volatile("s_waitcnt vmcnt(0)" ::: "memory");
    __syncthreads();
    if (threadIdx.x == 0) {
        unsigned* bar = b.bar;
        __builtin_amdgcn_s_waitcnt(0);
        unsigned nloc = b.st[0], nx = b.st[1];
        if (nloc == 0u) { xcd_barrier_complete(bar, b.x, nloc, nx); b.st[0] = nloc; b.st[1] = nx; }
        const unsigned old = xb_add(&bar[XB_XSUB(b.x)], 1u);
        const unsigned gen = old / nloc;
        if (old + 1u == (gen + 1u) * nloc) {
            __builtin_amdgcn_fence(__ATOMIC_RELEASE, "agent");
            asm volatile("s_waitcnt vmcnt(0)" ::: "memory");
            const unsigned og = xb_add(&bar[XB_TOP], 1u);
            const unsigned tg = og / nx;
            if (og + 1u == (tg + 1u) * nx) xb_add(&bar[XB_TOPGEN], 1u);
            else XB_SPIN(xb_ld(&bar[XB_TOPGEN]) == tg, bar);
            __builtin_amdgcn_fence(__ATOMIC_ACQUIRE, "agent");
            xb_add(&bar[XB_XGEN(b.x)], 1u);
            asm volatile("s_waitcnt vmcnt(0)" ::: "memory");
        } else {
            XB_SPIN(xb_ld(&bar[XB_XGEN(b.x)]) == gen, bar);
            __builtin_amdgcn_fence(__ATOMIC_ACQUIRE, "agent");
            asm volatile("s_waitcnt vmcnt(0)" ::: "memory");
        }
    }
    __syncthreads();
}
#endif

constexpr int LDS_BYTES = 163840;
constexpr int LDS_BARW = LDS_BYTES - 16;

#ifndef PH_MASK
#define PH_MASK 0xFFFFFFFFu
#endif
#ifndef PROBE_DUP
#define PROBE_DUP 0u
#endif
#define DUP_N(k) (1 + (int)((PROBE_DUP >> phase_class(k)) & 1u))
#define PH_BIT(k) ((PH_MASK >> phase_class(k)) & 1u)
#ifdef HIPEMU
static void run_phase(const Params& pp, int ph, unsigned char* lds)
#define GRID_BAR() do {} while (0)
#define IN(k) (ph == (k))
#define GLDS lds
#define LOADP() const Params& p = pp
#else
typedef const __attribute__((address_space(4))) unsigned char* kargp_t;
__device__ __forceinline__ kargp_t karg_ptr() { kargp_t kp = (kargp_t)__builtin_amdgcn_kernarg_segment_ptr(); asm volatile("" : "+s"(kp)); return kp; }
#define LOADP() Params p; __builtin_memcpy(&p, karg_ptr(), sizeof(Params))
#define IN(k) (PH_BIT(k) && ph_lo <= (k) && (k) < ph_hi)
#define GLDS ((LAS unsigned char*)lds_raw)
__global__ void __launch_bounds__(512, 2) mega_fwd(Params p_unused)
#endif
{
#ifndef HIPEMU
    extern __shared__ __attribute__((aligned(16))) unsigned char lds_raw[];
    unsigned char* lds = lds_raw;
    if (threadIdx.x == 0) { *(volatile unsigned*)(lds_raw + LDS_BARW) = 0u; *(volatile unsigned*)(lds_raw + LDS_BARW + 4) = 0u; }
    __syncthreads();
    int ph_lo, ph_hi; XcdBarrier bar;
    { LOADP(); ph_lo = p.ph_lo; ph_hi = p.ph_hi; bar.bar = p.bar; bar.x = 0; bar.st = nullptr; }
    const bool multi = (ph_hi - ph_lo) > 1;
    if (multi) bar = xcd_barrier_post(bar.bar, (volatile LAS unsigned*)(lds_raw + LDS_BARW));
#define GRID_BAR() do { if (multi) xcd_barrier(bar); } while (0)
#endif
    if (IN(0)) { for (int rep = 0; rep < DUP_N(0); ++rep) { LOADP(); phase_convert(p, lds, 0); GRID_BAR(); } }
    if (IN(1)) {
        LOADP();
        pg8::Gemm g{p.csil, p.wt_ada, 256, MODW, D}; pg8::StaticOrder S; S.init(256, MODW, gridDim.x, blockIdx.x);
        pg8::EpiAda E{p.modbuf, p.b_ada, p.b_ada_final};
        pg8::gemm_phase<pg8::EpiAda, pg8::StaticOrder>(GLDS, g, S, E);
    }
    if (IN(1)) { LOADP(); phase_convert(p, lds, 1); GRID_BAR(); }
#define LAYER(l) do { \
        constexpr int base = 2 + 12 * (l); \
        if (IN(base + 0)) { for (int rep = 0; rep < DUP_N(base + 0); ++rep) { LOADP(); phase_norm(p, (l) == 0 ? p.x_prompt : p.xb, (l) == 0 ? p.x_sample : p.xb + (size_t)NP * D, p.norm1_g + (l) * D, (l) * NMOD + 0 * D, (l) * NMOD + 1 * D, p.hA, nullptr); GRID_BAR(); } } \
        if (IN(base + 1)) { for (int rep = 0; rep < DUP_N(base + 1); ++rep) { LOADP(); \
            pg8::Gemm g{p.hA, p.wt_in + (size_t)(l) * ZW * D, MPAD, ZW, D}; pg8::StaticOrder S; S.init(MPAD, ZW, gridDim.x, blockIdx.x); \
            pg8::EpiBf16 E{p.z, ZW}; \
            pg8::gemm_phase<pg8::EpiBf16, pg8::StaticOrder>(GLDS, g, S, E); \
            GRID_BAR(); } } \
        if (IN(base + 2)) { for (int rep = 0; rep < DUP_N(base + 2); ++rep) { LOADP(); phase_mix1(p, (l), lds); GRID_BAR(); } } \
        if (IN(base + 3)) { for (int rep = 0; rep < DUP_N(base + 3); ++rep) { LOADP(); phase_mix2(p, (l)); GRID_BAR(); } } \
        if (IN(base + 4)) { LOADP(); phase_mix3(p, (l), lds); } \
        if (IN(base + 4)) { LOADP(); \
            pg8::Gemm g{p.pooled, p.wt_pool + (size_t)(l) * 1024 * 256, 4 * MPAD, 1024, 256}; pg8::PoolOrder S{(int)gridDim.x, (int)(gridDim.x - 1 - blockIdx.x)}; \
            pg8::EpiPool E{p.cat, p.pool_b + (l) * PW, p.pool_scale + (l) * PW}; \
            pg8::gemm_phase<pg8::EpiPool, pg8::PoolOrder>(GLDS, g, S, E); \
            GRID_BAR(); } \
        if (IN(base + 5)) { for (int rep = 0; rep < DUP_N(base + 5); ++rep) { LOADP(); \
            pg8::Gemm g{p.cat, p.wt_out + (size_t)(l) * D * D, MBIG, D, D}; pg8::StaticOrder S; S.init(MBIG, D, gridDim.x, blockIdx.x); \
            pg8::EpiResid E{(l) == 0 ? p.x_prompt : p.xb, (l) == 0 ? p.x_sample : p.xb + (size_t)NP * D, p.modbuf + (l) * NMOD + 2 * D, p.xa}; \
            pg8::gemm_phase<pg8::EpiResid, pg8::StaticOrder>(GLDS, g, S, E); \
            { SmallResid sf{E.xlo, E.xhi, E.gmod, E.out}; small_gemm(p.cat, p.wt_out + (size_t)(l) * D * D, D, lds, sf); } \
            GRID_BAR(); } } \
        if (IN(base + 6)) { for (int rep = 0; rep < DUP_N(base + 6); ++rep) { LOADP(); phase_norm(p, p.xa, p.xa + (size_t)NP * D, p.norm2_g + (l) * D, (l) * NMOD + 3 * D, (l) * NMOD + 4 * D, p.hB, nullptr); GRID_BAR(); } } \
        if (IN(base + 7)) { for (int rep = 0; rep < DUP_N(base + 7); ++rep) { LOADP(); \
            pg8::Gemm g{p.hB, p.wt_q + (size_t)(l) * D * D, MBIG, D, D}; pg8::StaticOrder S; S.init(MBIG, D, gridDim.x, blockIdx.x); \
            pg8::EpiF32 E{p.qry, D}; \
            pg8::gemm_phase<pg8::EpiF32, pg8::StaticOrder>(GLDS, g, S, E); \
            { SmallF32 sf{p.qry}; small_gemm(p.hB, p.wt_q + (size_t)(l) * D * D, D, lds, sf); } \
            GRID_BAR(); } } \
        if (IN(base + 8)) { for (int rep = 0; rep < DUP_N(base + 8); ++rep) { LOADP(); phase_select(p, (l), lds); GRID_BAR(); } } \
        if (IN(base + 9)) { for (int rep = 0; rep < DUP_N(base + 9); ++rep) { LOADP(); phase_peer_u(p, (l), lds); GRID_BAR(); } } \
        if (IN(base + 10)) { LOADP(); phase_peer_c(p); GRID_BAR(); } \
        if (IN(base + 11)) { for (int rep = 0; rep < DUP_N(base + 11); ++rep) { LOADP(); phase_peer_v(p, (l), lds); GRID_BAR(); } } \
    } while (0)
    LAYER(0);
    LAYER(1);
    if (IN(26)) { LOADP(); phase_norm(p, p.xb, p.xb + (size_t)NP * D, p.final_g, 2 * NMOD, 2 * NMOD + D, nullptr, p.out + OFF_Y); }
#undef LAYER
#undef IN
#undef GRID_BAR
#undef GLDS
#undef LOADP
}

struct WsLayout { size_t bar, modbuf, csil, wt_ada, wt_in, wt_out, wt_q, wt_pool, u8, v8, su, sv, iscu, part, hg_oin, hg_ds, hg_gam, hg_qh, hg_sc, hA, hB, z, pooled, cat, xa, xb, qry, eidx, gate, ab16, end; };
static WsLayout ws_layout() {
    WsLayout L; size_t o = 0;
    auto take = [&](size_t bytes) { const size_t r = o; o += (bytes + 255) & ~(size_t)255; return r; };
    L.bar = take(16384);
    L.modbuf = take((size_t)256 * MODW * 4);
    L.csil = take((size_t)256 * D * 2);
    L.wt_ada = take((size_t)MODW * D * 2);
    L.wt_in = take((size_t)2 * ZW * D * 2);
    L.wt_out = take((size_t)2 * D * D * 2);
    L.wt_q = take((size_t)2 * D * D * 2);
    L.wt_pool = take((size_t)2 * 1024 * 256 * 2);
    L.u8 = take((size_t)2 * NE * D);
    L.v8 = take((size_t)2 * NE * D);
    L.su = take((size_t)2 * NE * 4);
    L.sv = take((size_t)2 * NE * 4);
    L.iscu = take((size_t)MPAD * 128 * 4);
    L.part = take((size_t)MPAD * 8 * 128 * 4);
    L.hg_oin = take((size_t)hg::NUNIT * 64 * 128 * 2);
    L.hg_ds = take((size_t)hg::NUNIT * 128 * 128 * 2);
    L.hg_gam = take((size_t)hg::NUNIT * 128 * 4);
    L.hg_qh = take((size_t)NP * 1024 * 2);
    L.hg_sc = take((size_t)hg::NUNIT * 128 * 128 * 2);
    L.hA = take((size_t)MPAD * D * 2);
    L.hB = take((size_t)MPAD * D * 2);
    L.z = take((size_t)MPAD * ZW * 2);
    L.pooled = take((size_t)4 * MPAD * 256 * 2);
    L.cat = take((size_t)MPAD * D * 2);
    L.xa = take((size_t)MPAD * D * 4);
    L.xb = take((size_t)MPAD * D * 4);
    L.qry = take((size_t)MPAD * D * 4);
    L.eidx = take((size_t)MPAD * 128 * 2);
    L.gate = take((size_t)MPAD * 128 * 4);
    L.ab16 = take((size_t)MPAD * 128 * 2);
    L.end = o;
    return L;
}
static void fill_params(Params& p, void* const* d_in, void* d_out, void* d_ws) {
    const float** f = (const float**)&p;
    for (int i = 0; i < 24; ++i) f[i] = (const float*)d_in[i];
    p.out = (float*)d_out;
    const WsLayout L = ws_layout(); unsigned char* w = (unsigned char*)d_ws;
    p.bar = (unsigned*)(w + L.bar); p.modbuf = (float*)(w + L.modbuf); p.csil = (bf16_t*)(w + L.csil); p.wt_ada = (bf16_t*)(w + L.wt_ada); p.wt_in = (bf16_t*)(w + L.wt_in);
    p.wt_out = (bf16_t*)(w + L.wt_out); p.wt_q = (bf16_t*)(w + L.wt_q); p.wt_pool = (bf16_t*)(w + L.wt_pool); p.u8 = w + L.u8; p.v8 = w + L.v8; p.su = (float*)(w + L.su); p.sv = (float*)(w + L.sv); p.iscu = (float*)(w + L.iscu); p.part = (float*)(w + L.part); p.hg_oin = (bf16_t*)(w + L.hg_oin); p.hg_ds = (bf16_t*)(w + L.hg_ds); p.hg_gam = (float*)(w + L.hg_gam); p.hg_qh = (bf16_t*)(w + L.hg_qh); p.hg_sc = (bf16_t*)(w + L.hg_sc);
    p.hA = (bf16_t*)(w + L.hA); p.hB = (bf16_t*)(w + L.hB); p.z = (bf16_t*)(w + L.z); p.pooled = (bf16_t*)(w + L.pooled); p.cat = (bf16_t*)(w + L.cat);
    p.xa = (float*)(w + L.xa); p.xb = (float*)(w + L.xb); p.qry = (float*)(w + L.qry); p.eidx = (unsigned short*)(w + L.eidx); p.gate = (float*)(w + L.gate); p.ab16 = (bf16_t*)(w + L.ab16);
}

#ifndef HIPEMU
#ifndef MK_ONE_LAUNCH
#define MK_ONE_LAUNCH 1
#endif
extern "C" void kernel_launch(void* const* d_in, const int* in_sizes, int n_in, void* d_out, int out_size, void* d_ws, size_t ws_size, hipStream_t stream) {
    static int grid = 0;
    if (grid == 0) {
        const WsLayout L = ws_layout();
        if (n_in != 24 || (size_t)out_size != OUT_TOTAL || ws_size < L.end) { fprintf(stderr, "kernel_launch: unexpected shapes (n_in %d, out %d, ws %zu < %zu)\n", n_in, out_size, ws_size, L.end); grid = -1; return; }
        int dev = 0, cus = 0, per_cu = 0;
        hipGetDevice(&dev); hipDeviceGetAttribute(&cus, hipDeviceAttributeMultiprocessorCount, dev);
        if (hipFuncSetAttribute((const void*)mega_fwd, hipFuncAttributeMaxDynamicSharedMemorySize, LDS_BYTES) != hipSuccess) { fprintf(stderr, "kernel_launch: hipFuncSetAttribute failed\n"); grid = -1; return; }
        hipOccupancyMaxActiveBlocksPerMultiprocessor(&per_cu, (const void*)mega_fwd, 512, LDS_BYTES);
        (void)hipGetLastError();
        if (per_cu < 1) fprintf(stderr, "kernel_launch: occupancy query says %d blocks per CU\n", per_cu);
        grid = cus;
    }
    if (grid < 0) return;
    Params p{};
    fill_params(p, d_in, d_out, d_ws);
    hipMemsetAsync(p.bar, 0, 16384, stream);
#if MK_ONE_LAUNCH
    p.ph_lo = 0; p.ph_hi = N_PHASES;
    hipLaunchKernelGGL(mega_fwd, dim3(grid), dim3(512), LDS_BYTES, stream, p);
#else
    for (int ph = 0; ph < N_PHASES; ++ph) { p.ph_lo = ph; p.ph_hi = ph + 1; hipLaunchKernelGGL(mega_fwd, dim3(grid), dim3(512), LDS_BYTES, stream, p); }
#endif
}
#endif
```

```cpp
#ifndef HIPEMU
#include <hip/hip_runtime.h>
#include <cstdio>
#endif
#include <stdint.h>

#ifndef CFG_PB
#define CFG_PB 4
#define CFG_SEQ 2048
#define CFG_DB 128
#endif

#ifdef HIPEMU
#define DEV inline
#define LAS
#define READLANE_I(v, l) emu_readlane((v), (l))
#define READLANE_F(v, l) emu_readlane_f((v), (l))
#define MFMA_BF16(a, b, c) emu_mfma_bf16_16x16x32((a), (b), (c))
#define MFMA_F32(a, b, c) emu_mfma_f32_16x16x4((a), (b), (c))
#define __expf expf
#define __logf logf
#else
#define DEV __device__ __forceinline__
#define LAS __attribute__((address_space(3)))
#define READLANE_I(v, l) __builtin_amdgcn_readlane((v), (l))
#define READLANE_F(v, l) __uint_as_float((unsigned)__builtin_amdgcn_readlane((int)__float_as_uint(v), (l)))
#define MFMA_BF16(a, b, c) __builtin_amdgcn_mfma_f32_16x16x32_bf16((a), (b), (c), 0, 0, 0)
#define MFMA_F32(a, b, c) __builtin_amdgcn_mfma_f32_16x16x4f32((a), (b), (c), 0, 0, 0)
#endif

typedef unsigned short bf16_t;
typedef short bf16x8 __attribute__((ext_vector_type(8)));
typedef float f32x4 __attribute__((ext_vector_type(4)));
typedef unsigned u32x4 __attribute__((ext_vector_type(4)));
typedef unsigned u32x2 __attribute__((ext_vector_type(2)));

namespace cfg {
constexpr int D = 2048, PB = CFG_PB, SEQ = CFG_SEQ, DB = CFG_DB, DSEQ = 4;
constexpr int NP = PB * SEQ, NS = DB * DSEQ, NTOK = NP + NS, MPAD = (NTOK + 255) / 256 * 256;
constexpr int NC = PB + DB;
constexpr int HH = 8, HD = 128, PW = 1024, PBUF = 15, ZW = 5120;
constexpr int NE = 16384;
constexpr int NMOD = 6 * D;
constexpr int MODW = 2 * NMOD + 2 * D;
constexpr float EPS = 1e-6f;
constexpr int NCHAIN = PB * HH;
constexpr size_t OFF_Y = 0;
constexpr size_t OFF_HP = (size_t)NTOK * D;
constexpr size_t OFF_PP = OFF_HP + (size_t)2 * PB * HH * HD * HD;
constexpr size_t OFF_HS = OFF_PP + (size_t)2 * PB * PBUF * PW;
constexpr size_t OFF_PS = OFF_HS + (size_t)2 * DB * HH * HD * HD;
constexpr size_t OUT_TOTAL = OFF_PS + (size_t)2 * DB * PBUF * PW;
}
using namespace cfg;

struct Params {
    const float *x_prompt, *x_sample, *c_prompt, *c_sample, *state_hgrn, *state_pool, *w_ada, *b_ada, *norm1_g, *norm2_g, *w_in, *w_out,
        *lb_logits, *hgrn_norm_g, *pool_w, *pool_b, *pool_scale, *peer_wq, *peer_keys, *peer_u, *peer_v, *final_g, *w_ada_final, *b_ada_final;
    float* out;
    unsigned* bar; float* modbuf; bf16_t* csil; bf16_t* wt_ada; bf16_t* wt_in; bf16_t* wt_out; bf16_t* wt_q; bf16_t* wt_pool;
    unsigned char* u8; unsigned char* v8; float* su; float* sv; float* iscu; float* part; bf16_t* hg_oin; bf16_t* hg_ds; float* hg_gam; bf16_t* hg_qh; bf16_t* hg_sc; bf16_t* hA; bf16_t* hB; bf16_t* z; bf16_t* pooled; bf16_t* cat; float* xa; float* xb; float* qry; unsigned short* eidx; float* gate; bf16_t* ab16;
    int ph_lo, ph_hi;
};

DEV float bf2f(unsigned v) { return __uint_as_float(v << 16); }
#ifdef HIPEMU
DEV unsigned f2bf(float f) { unsigned u = __float_as_uint(f); u += 0x7fffu + ((u >> 16) & 1u); return u >> 16; }
DEV unsigned pack2(float lo, float hi) { return f2bf(lo) | (f2bf(hi) << 16); }
#else
typedef float f32x2_t __attribute__((ext_vector_type(2)));
typedef __bf16 bf16x2_t __attribute__((ext_vector_type(2)));
DEV unsigned pack2(float lo, float hi) { const f32x2_t v = {lo, hi}; return __builtin_bit_cast(unsigned, __builtin_convertvector(v, bf16x2_t)); }
DEV unsigned f2bf(float f) { return (unsigned)__builtin_bit_cast(unsigned short, (__bf16)f); }
#endif
DEV float lo16(unsigned w) { return __uint_as_float(w << 16); }
DEV float hi16(unsigned w) { return __uint_as_float(w & 0xffff0000u); }
DEV float wave_sum(float v) { v += __shfl_xor(v, 32); v += __shfl_xor(v, 16); v += __shfl_xor(v, 8); v += __shfl_xor(v, 4); v += __shfl_xor(v, 2); v += __shfl_xor(v, 1); return v; }
DEV float wave_max(float v) { v = fmaxf(v, __shfl_xor(v, 32)); v = fmaxf(v, __shfl_xor(v, 16)); v = fmaxf(v, __shfl_xor(v, 8)); v = fmaxf(v, __shfl_xor(v, 4)); v = fmaxf(v, __shfl_xor(v, 2)); v = fmaxf(v, __shfl_xor(v, 1)); return v; }
DEV float sigmoidf_(float x) { return 1.0f / (1.0f + __expf(-x)); }
DEV float siluf_(float x) { return x / (1.0f + __expf(-x)); }
DEV float gelu_erf(float x) { return 0.5f * x * (1.0f + erff(x * 0.70710678118f)); }
DEV int tok_batch(int t) { return t < NP ? t / SEQ : PB + (t - NP) / DSEQ; }


#ifdef HIPEMU
static inline unsigned emu_fp8_enc1(float x) {
    const unsigned sgn = x < 0.f ? 0x80u : 0u; float a = fabsf(x);
    if (!(a == a)) return 0x7fu;
    if (a >= 448.f) return sgn | 0x7eu;
    if (a < 0.015625f) { const int q = (int)rintf(a * 512.f); return sgn | (unsigned)q; }
    int e = (int)floorf(log2f(a)); if (ldexpf(1.f, e) > a) --e; if (ldexpf(1.f, e + 1) <= a) ++e;
    int m = (int)rintf((a / ldexpf(1.f, e) - 1.f) * 8.f); if (m == 8) { m = 0; ++e; }
    if (e > 8) return sgn | 0x7eu;
    return sgn | (unsigned)((e + 7) << 3) | (unsigned)m;
}
static inline float emu_fp8_dec1(unsigned b) { const float sg = (b & 0x80u) ? -1.f : 1.f; const int e = (b >> 3) & 15, m = b & 7; return sg * (e == 0 ? m * 0.001953125f : (1.f + m * 0.125f) * ldexpf(1.f, e - 7)); }
DEV unsigned fp8x4_enc(float a, float b, float c, float d) { return emu_fp8_enc1(a) | (emu_fp8_enc1(b) << 8) | (emu_fp8_enc1(c) << 16) | (emu_fp8_enc1(d) << 24); }
DEV void fp8x4_dec(unsigned w, float* o) { o[0] = emu_fp8_dec1(w & 255u); o[1] = emu_fp8_dec1((w >> 8) & 255u); o[2] = emu_fp8_dec1((w >> 16) & 255u); o[3] = emu_fp8_dec1(w >> 24); }
#define DPP_XOR1(v) __shfl((v), emu_lane() ^ 1)
#define DPP_XOR2(v) __shfl((v), emu_lane() ^ 2)
#define DPP_HMIRROR(v) __shfl((v), (emu_lane() & ~7) | (7 - (emu_lane() & 7)))
#define DPP_XOR8(v) __shfl((v), emu_lane() ^ 8)
#define DPP_RMIRROR(v) __shfl((v), (emu_lane() & ~15) | (15 - (emu_lane() & 15)))
#define WAVE_LDS_SYNC() emu_wbar()
DEV float xsum16(float a, float b) { const bool hi = (emu_lane() & 16) != 0; return (hi ? b : a) + __shfl_xor(hi ? a : b, 16); }
DEV float xsum32(float a, float b) { const bool hi = (emu_lane() & 32) != 0; return (hi ? b : a) + __shfl_xor(hi ? a : b, 32); }
#else
typedef float f32x2v_t __attribute__((ext_vector_type(2)));
DEV unsigned fp8x4_enc(float a, float b, float c, float d) { int r = __builtin_amdgcn_cvt_pk_fp8_f32(a, b, 0, false); r = __builtin_amdgcn_cvt_pk_fp8_f32(c, d, r, true); return (unsigned)r; }
DEV void fp8x4_dec(unsigned w, float* o) { const f32x2v_t lo = __builtin_amdgcn_cvt_pk_f32_fp8((int)w, false), hi = __builtin_amdgcn_cvt_pk_f32_fp8((int)w, true); o[0] = lo[0]; o[1] = lo[1]; o[2] = hi[0]; o[3] = hi[1]; }
template <int CTRL> DEV float dpp_f(float v) { return __uint_as_float((unsigned)__builtin_amdgcn_update_dpp(0, (int)__float_as_uint(v), CTRL, 0xf, 0xf, true)); }
#define DPP_XOR1(v) dpp_f<0xB1>(v)
#define DPP_XOR2(v) dpp_f<0x4E>(v)
#define DPP_HMIRROR(v) dpp_f<0x141>(v)
#define DPP_XOR8(v) dpp_f<0x128>(v)
#define DPP_RMIRROR(v) dpp_f<0x140>(v)
#define WAVE_LDS_SYNC() asm volatile("s_waitcnt lgkmcnt(0)" ::: "memory")
DEV float xsum16(float a, float b) { const u32x2 r = __builtin_amdgcn_permlane16_swap(__float_as_uint(a), __float_as_uint(b), false, false); return __uint_as_float(r[0]) + __uint_as_float(r[1]); }
DEV float xsum32(float a, float b) { const u32x2 r = __builtin_amdgcn_permlane32_swap(__float_as_uint(a), __float_as_uint(b), false, false); return __uint_as_float(r[0]) + __uint_as_float(r[1]); }
#endif
typedef float f32x2 __attribute__((ext_vector_type(2)));
#ifdef HIPEMU
DEV void fp8x4_dec2(unsigned w, f32x2& lo, f32x2& hi) { float o[4]; fp8x4_dec(w, o); lo = (f32x2){o[0], o[1]}; hi = (f32x2){o[2], o[3]}; }
#else
DEV void fp8x4_dec2(unsigned w, f32x2& lo, f32x2& hi) { lo = __builtin_amdgcn_cvt_pk_f32_fp8((int)w, false); hi = __builtin_amdgcn_cvt_pk_f32_fp8((int)w, true); }
#endif
DEV void fp8x16_dec2(u32x4 q, f32x2* o) { fp8x4_dec2(q.x, o[0], o[1]); fp8x4_dec2(q.y, o[2], o[3]); fp8x4_dec2(q.z, o[4], o[5]); fp8x4_dec2(q.w, o[6], o[7]); }

namespace pg8 {
constexpr int BM = 256, BK = 64, HALF = 128, HTB = HALF * BK * 2, STAGE_BYTES = 8 * HTB, NXCD = 8, WGM = 8;
DEV int lds_byte(int r, int c) { const int st = (r >> 4) * 2 + (c >> 5), rr = r & 15, cc = c & 31, ob = rr * 64 + cc * 2; return st * 1024 + (ob ^ (((ob >> 9) & 1) << 5)); }
DEV void stage_rc(int b, int& R, int& C) { const int st = b / 1024, sb = b % 1024, swz = sb ^ (((sb >> 9) & 1) << 5); R = (st >> 1) * 16 + swz / 64; C = (st & 1) * 32 + (swz % 64) / 2; }
DEV int perm32(int rho) { const int n = rho >> 4, i = rho & 15; return 8 * (i >> 2) + 4 * n + (i & 3); }
struct Unit { int pm, pn; };
struct Gemm { const bf16_t* A; const bf16_t* Bt; int M, N, K; };
struct StaticOrder {
    int nM, nN, nwg, G, c;
    DEV void init(int M, int N, int G_, int c_) { nM = M / BM; nN = N / BM; nwg = nM * nN; G = G_; c = c_; }
    DEV bool next(int i, Unit& u) const {
        const long L = (long)i * G + c; if (L >= nwg) return false;
        int wgid = (int)L; { const int q = nwg / NXCD, r = nwg % NXCD, xcd = wgid % NXCD, off = wgid / NXCD; wgid = (xcd < r ? xcd * (q + 1) : r * (q + 1) + (xcd - r) * q) + off; }
        const int nig = WGM * nN, gid = wgid / nig, fm = gid * WGM, gsz = (nM - fm) < WGM ? (nM - fm) : WGM;
        u.pm = fm + ((wgid % nig) % gsz); u.pn = (wgid % nig) / gsz; return true;
    }
    DEV void a_ready(const Unit&) const {}
    DEV void done(const Unit&) const {}
};
struct PoolOrder {
    int G, c;
    DEV bool next(int i, Unit& u) const { const int L = i * G + c; if (L >= 4 * (MPAD / 256)) return false; u.pm = L; u.pn = L / (MPAD / 256); return true; }
    DEV void a_ready(const Unit&) const {}
    DEV void done(const Unit&) const {}
};

struct EpiF32 {
    static constexpr bool PERM = false;
    float* C; int ldc;
    DEV void operator()(const f32x4 (&acc)[2][2][4][2], const Unit& u, int wr, int wc, int fr, int fq) const {
        const int row0 = u.pm * BM + wr * 64 + fr, col0 = u.pn * BM + wc * 32 + 4 * fq;
#pragma unroll
        for (int ai = 0; ai < 2; ++ai)
#pragma unroll
            for (int m = 0; m < 4; ++m) { float* rowp = C + (size_t)(row0 + ai * HALF + m * 16) * ldc + col0;
#pragma unroll
                for (int bj = 0; bj < 2; ++bj)
#pragma unroll
                    for (int n = 0; n < 2; ++n) *(f32x4*)(rowp + bj * HALF + n * 16) = acc[ai][bj][m][n]; }
    }
};
struct EpiAda {
    static constexpr bool PERM = false;
    float* C; const float* b_ada; const float* b_fin;
    DEV void operator()(const f32x4 (&acc)[2][2][4][2], const Unit& u, int wr, int wc, int fr, int fq) const {
        const int row0 = u.pm * BM + wr * 64 + fr, col0 = u.pn * BM + wc * 32 + 4 * fq;
        const float* bias = (u.pn * BM < 2 * NMOD) ? b_ada + col0 : b_fin + (col0 - 2 * NMOD);
        f32x4 bv[2][2];
#pragma unroll
        for (int bj = 0; bj < 2; ++bj)
#pragma unroll
            for (int n = 0; n < 2; ++n) bv[bj][n] = *(const f32x4*)(bias + bj * HALF + n * 16);
#pragma unroll
        for (int ai = 0; ai < 2; ++ai)
#pragma unroll
            for (int m = 0; m < 4; ++m) { float* rowp = C + (size_t)(row0 + ai * HALF + m * 16) * MODW + col0;
#pragma unroll
                for (int bj = 0; bj < 2; ++bj)
#pragma unroll
                    for (int n = 0; n < 2; ++n) *(f32x4*)(rowp + bj * HALF + n * 16) = acc[ai][bj][m][n] + bv[bj][n]; }
    }
};
struct EpiResid {
    static constexpr bool PERM = false;
    const float* xlo; const float* xhi; const float* gmod  ; float* out;
    DEV void operator()(const f32x4 (&acc)[2][2][4][2], const Unit& u, int wr, int wc, int fr, int fq) const {
        const int row0 = u.pm * BM + wr * 64 + fr, col0 = u.pn * BM + wc * 32 + 4 * fq;
#pragma unroll
        for (int ai = 0; ai < 2; ++ai)
#pragma unroll
            for (int m = 0; m < 4; ++m) {
                const int row = row0 + ai * HALF + m * 16;
                if (row < NTOK) {
                    const float* xr = (row < NP ? xlo + (size_t)row * D : xhi + (size_t)(row - NP) * D) + col0;
                    const float* gr = gmod + (size_t)tok_batch(row) * MODW + col0;
                    float* rowp = out + (size_t)row * D + col0;
#pragma unroll
                    for (int bj = 0; bj < 2; ++bj)
#pragma unroll
                        for (int n = 0; n < 2; ++n) { const f32x4 xv = *(const f32x4*)(xr + bj * HALF + n * 16), gv = *(const f32x4*)(gr + bj * HALF + n * 16);
                            *(f32x4*)(rowp + bj * HALF + n * 16) = xv + gv * acc[ai][bj][m][n]; }
                }
            }
    }
};
struct EpiBf16 {
    static constexpr bool PERM = true;
    bf16_t* O; int ldc;
    DEV void operator()(const f32x4 (&acc)[2][2][4][2], const Unit& u, int wr, int wc, int fr, int fq) const {
        const int row0 = u.pm * BM + wr * 64 + fr, col0 = u.pn * BM + wc * 32 + 8 * fq;
#pragma unroll
        for (int ai = 0; ai < 2; ++ai)
#pragma unroll
            for (int m = 0; m < 4; ++m) { bf16_t* rowp = O + (size_t)(row0 + ai * HALF + m * 16) * ldc + col0;
#pragma unroll
                for (int bj = 0; bj < 2; ++bj) { const f32x4 v0 = acc[ai][bj][m][0], v1 = acc[ai][bj][m][1];
                    u32x4 w; w.x = pack2(v0[0], v0[1]); w.y = pack2(v0[2], v0[3]); w.z = pack2(v1[0], v1[1]); w.w = pack2(v1[2], v1[3]);
                    *(u32x4*)(rowp + bj * HALF) = w; } }
    }
};
struct EpiPool {
    static constexpr bool PERM = true;
    bf16_t* cat; const float* pb; const float* ps;
    DEV void operator()(const f32x4 (&acc)[2][2][4][2], const Unit& u, int wr, int wc, int fr, int fq) const {
        const int g = u.pn, tok0 = u.pm * BM - g * MPAD + wr * 64 + fr, col0 = g * 256 + wc * 32 + 8 * fq;
#pragma unroll
        for (int bj = 0; bj < 2; ++bj) {
            const f32x4 b0 = *(const f32x4*)(pb + col0 + bj * HALF), b1 = *(const f32x4*)(pb + col0 + bj * HALF + 4);
            const f32x4 s0 = *(const f32x4*)(ps + col0 + bj * HALF), s1 = *(const f32x4*)(ps + col0 + bj * HALF + 4);
#pragma unroll
            for (int ai = 0; ai < 2; ++ai)
#pragma unroll
                for (int m = 0; m < 4; ++m) { const int tok = tok0 + ai * HALF + m * 16;
                    if (tok < NTOK) { const f32x4 v0 = (acc[ai][bj][m][0] + b0) * s0, v1 = (acc[ai][bj][m][1] + b1) * s1;
                        u32x4 w; w.x = pack2(v0[0], v0[1]); w.y = pack2(v0[2], v0[3]); w.z = pack2(v1[0], v1[1]); w.w = pack2(v1[2], v1[3]);
                        *(u32x4*)(cat + (size_t)tok * D + 1024 + col0 + bj * HALF) = w; } }
        }
    }
};

#ifdef HIPEMU
template <class Epi, class Sched>
static void gemm_phase(unsigned char*, const Gemm g, const Sched& S, const Epi& E) {
    const int tid = threadIdx.x, wid = tid >> 6, lane = tid & 63, wr = wid >> 2, wc = wid & 3, fr = lane & 15, fq = lane >> 4;
    Unit cur;
    for (int ui = 0; S.next(ui, cur); ++ui) {
        f32x4 acc[2][2][4][2];
        for (int ai = 0; ai < 2; ++ai) for (int bj = 0; bj < 2; ++bj) for (int m = 0; m < 4; ++m) for (int n = 0; n < 2; ++n) for (int j = 0; j < 4; ++j) {
            const int row = 256 * cur.pm + 128 * ai + 64 * wr + 16 * m + fr;
            const int col = Epi::PERM ? 256 * cur.pn + 128 * bj + 32 * wc + 8 * fq + 4 * n + j : 256 * cur.pn + 128 * bj + 32 * wc + 16 * n + 4 * fq + j;
            float s = 0.f;
            if ((row % emu_row_mod) < emu_row_limit) { const float* a = emu_f32_copy(g.A, (size_t)g.M * g.K) + (size_t)row * g.K; const float* b = emu_f32_copy(g.Bt, (size_t)g.N * g.K) + (size_t)col * g.K;
                for (int k = 0; k < g.K; ++k) s += a[k] * b[k]; }
            acc[ai][bj][m][n][j] = s; }
        E(acc, cur, wr, wc, fr, fq);
    }
    __syncthreads();
}
#else
template <class Epi, class Sched>
__device__ __forceinline__ void gemm_phase(LAS unsigned char* lds, const Gemm g, const Sched& S, const Epi& E) {
    const int tid = threadIdx.x, wid = __builtin_amdgcn_readfirstlane(tid >> 6), lane = tid & 63, wr = wid >> 2, wc = wid & 3, fr = lane & 15, fq = lane >> 4;
    int K = g.K; asm volatile("" : "+s"(K));
    const int nt = K / BK;
    unsigned voffA[2], voffB[2];
#pragma unroll
    for (int i = 0; i < 2; ++i) { int R, C; stage_rc(tid * 16 + i * 8192, R, C); const int Rb = Epi::PERM ? ((R & ~31) + perm32(R & 31)) : R;
        voffA[i] = (unsigned)(R * K + C) * 2u; voffB[i] = (unsigned)(Rb * K + C) * 2u; }
    const size_t kstep = (size_t)(BK * 2);
    const size_t hstep = (size_t)HALF * K * 2;
    const size_t tstep = 2 * hstep;
    const unsigned ldsw = (unsigned)wid * 1024u;
    const int aoff = lds_byte(wr * 64 + fr, fq * 8), boff = lds_byte(wc * 32 + fr, fq * 8);
#define PG8_SA(b, h) (((b) * 2 + (h)) * HTB)
#define PG8_SB(b, h) ((4 + (b) * 2 + (h)) * HTB)
#define PG8_STAGE(bufoff, gbase, voff) do { _Pragma("unroll") for (int _i = 0; _i < 2; ++_i) \
        __builtin_amdgcn_global_load_lds((const unsigned*)((const char*)(gbase) + (voff)[_i]), (LAS unsigned*)(lds + (bufoff) + ldsw + _i * 8192), 16, 0, 0); } while (0)
#define PG8_LDA(dst, b, h) do { _Pragma("unroll") for (int m = 0; m < 4; ++m) _Pragma("unroll") for (int k = 0; k < 2; ++k) dst[m][k] = *(const LAS bf16x8*)(lds + PG8_SA(b, h) + aoff + m * 2048 + k * 1024); } while (0)
#define PG8_LDB(dst, b, h) do { _Pragma("unroll") for (int n = 0; n < 2; ++n) _Pragma("unroll") for (int k = 0; k < 2; ++k) dst[n][k] = *(const LAS bf16x8*)(lds + PG8_SB(b, h) + boff + n * 2048 + k * 1024); } while (0)
#define PG8_MMA(ai, bj, At, Bt) do { __builtin_amdgcn_s_setprio(1); _Pragma("unroll") for (int m = 0; m < 4; ++m) _Pragma("unroll") for (int n = 0; n < 2; ++n) _Pragma("unroll") for (int k = 0; k < 2; ++k) \
        acc[ai][bj][m][n] = __builtin_amdgcn_mfma_f32_16x16x32_bf16(Bt[n][k], At[m][k], acc[ai][bj][m][n], 0, 0, 0); __builtin_amdgcn_s_setprio(0); } while (0)
#define PG8_WAIT_V(n) asm volatile("s_waitcnt vmcnt(" #n ")" ::: "memory")
#define PG8_WAIT_L(n) asm volatile("s_waitcnt lgkmcnt(" #n ")" ::: "memory")
#define PG8_BAR __builtin_amdgcn_s_barrier()
#define PG8_SCHED __builtin_amdgcn_sched_barrier(0)
    Unit cur, nxt; int ui = 0;
    if (!S.next(0, cur)) return;
    f32x4 acc[2][2][4][2];
#pragma unroll
    for (int a = 0; a < 2; ++a)
#pragma unroll
        for (int b = 0; b < 2; ++b)
#pragma unroll
            for (int m = 0; m < 4; ++m)
#pragma unroll
                for (int n = 0; n < 2; ++n) acc[a][b][m][n] = (f32x4){0.f, 0.f, 0.f, 0.f};
    bf16x8 At[4][2], B0[2][2], B1[2][2];
    const char* cA = (const char*)g.A + (size_t)cur.pm * tstep; const char* cB = (const char*)g.Bt + (size_t)cur.pn * tstep;
    S.a_ready(cur);
    PG8_STAGE(PG8_SB(0, 0), cB, voffB); PG8_STAGE(PG8_SA(0, 0), cA, voffA); PG8_STAGE(PG8_SB(0, 1), cB + hstep, voffB); PG8_STAGE(PG8_SA(0, 1), cA + hstep, voffA);
    if (wr == 1) PG8_BAR;
    PG8_WAIT_V(4); PG8_BAR;
    PG8_STAGE(PG8_SB(1, 0), cB + kstep, voffB); PG8_STAGE(PG8_SA(1, 0), cA + kstep, voffA); PG8_STAGE(PG8_SB(1, 1), cB + hstep + kstep, voffB);
    PG8_WAIT_V(6); PG8_BAR;
    for (;;) {
        const bool has_next = S.next(ui + 1, nxt);
        const char* nA = has_next ? (const char*)g.A + (size_t)nxt.pm * tstep : cA; const char* nB = has_next ? (const char*)g.Bt + (size_t)nxt.pn * tstep : cB;
        for (int t = 0; t < nt; t += 2) {
            const bool last = (t == nt - 2);
            const char* a1 = cA + (size_t)(t + 1) * kstep;
            const char* a2 = last ? nA : cA + (size_t)(t + 2) * kstep; const char* b2 = last ? nB : cB + (size_t)(t + 2) * kstep;
            const char* a3 = a2 + kstep; const char* b3 = b2 + kstep;
            if (last && has_next) S.a_ready(nxt);
            PG8_LDB(B0, 0, 0); PG8_SCHED; PG8_LDA(At, 0, 0); PG8_STAGE(PG8_SA(1, 1), a1 + hstep, voffA);
            PG8_WAIT_L(8); PG8_BAR; PG8_WAIT_L(0); PG8_MMA(0, 0, At, B0); PG8_BAR; PG8_SCHED;
            PG8_LDB(B1, 0, 1); PG8_STAGE(PG8_SB(0, 0), b2, voffB);
            PG8_BAR; PG8_WAIT_L(0); PG8_MMA(0, 1, At, B1); PG8_BAR;
            PG8_LDA(At, 0, 1); PG8_STAGE(PG8_SA(0, 0), a2, voffA);
            PG8_BAR; PG8_WAIT_L(0); PG8_MMA(1, 0, At, B0); PG8_BAR; PG8_SCHED;
            PG8_STAGE(PG8_SB(0, 1), b2 + hstep, voffB);
            PG8_WAIT_V(6); PG8_BAR; PG8_MMA(1, 1, At, B1); PG8_BAR;
            PG8_LDB(B0, 1, 0); PG8_SCHED; PG8_LDA(At, 1, 0); PG8_STAGE(PG8_SA(0, 1), a2 + hstep, voffA);
            PG8_WAIT_L(8); PG8_BAR; PG8_WAIT_L(0); PG8_MMA(0, 0, At, B0); PG8_BAR; PG8_SCHED;
            PG8_LDB(B1, 1, 1); PG8_STAGE(PG8_SB(1, 0), b3, voffB);
            PG8_BAR; PG8_WAIT_L(0); PG8_MMA(0, 1, At, B1); PG8_BAR;
            PG8_LDA(At, 1, 1); PG8_STAGE(PG8_SA(1, 0), a3, voffA);
            PG8_BAR; PG8_WAIT_L(0); PG8_MMA(1, 0, At, B0); PG8_BAR; PG8_SCHED;
            PG8_STAGE(PG8_SB(1, 1), b3 + hstep, voffB);
            PG8_WAIT_V(6); PG8_BAR; PG8_MMA(1, 1, At, B1); PG8_BAR;
        }
        { int tz = threadIdx.x; asm volatile("" : "+v"(tz)); const int wz = tz >> 6, lz = tz & 63;
          E(acc, cur, wz >> 2, wz & 3, lz & 15, lz >> 4); } S.done(cur);
        if (!has_next) break;
#pragma unroll
        for (int a = 0; a < 2; ++a)
#pragma unroll
            for (int b = 0; b < 2; ++b)
#pragma unroll
                for (int m = 0; m < 4; ++m)
#pragma unroll
                    for (int n = 0; n < 2; ++n) acc[a][b][m][n] = (f32x4){0.f, 0.f, 0.f, 0.f};
        cur = nxt; cA = nA; cB = nB; ++ui;
    }
    PG8_WAIT_V(0);
    if (wr == 0) PG8_BAR;
    PG8_BAR;
#undef PG8_SA
#undef PG8_SB
#undef PG8_STAGE
#undef PG8_LDA
#undef PG8_LDB
#undef PG8_MMA
#undef PG8_WAIT_V
#undef PG8_WAIT_L
#undef PG8_BAR
#undef PG8_SCHED
}
#endif
}

constexpr int MBIG = (NP / 256) * 256;
template <class F> DEV void small_gemm(const bf16_t* A, const bf16_t* Bt, int K, unsigned char* lds, const F& f) {
    const int tid = threadIdx.x, lane = tid & 63, w = tid >> 6, g = lane >> 4, c16 = lane & 15;
    const int tiles_m = (NTOK - MBIG + 63) / 64, ntiles = tiles_m * 32, kw = K / 8;
    float* part = (float*)lds;
    for (int tl = blockIdx.x; tl < ntiles; tl += gridDim.x) {
        const int r0 = MBIG + (tl / 32) * 64, n0 = (tl % 32) * 64;
        f32x4 acc[4][4];
#pragma unroll
        for (int i = 0; i < 4; ++i)
#pragma unroll
            for (int j = 0; j < 4; ++j) acc[i][j] = (f32x4){0.f, 0.f, 0.f, 0.f};
        for (int k0 = w * kw; k0 < (w + 1) * kw; k0 += 128) {
            bf16x8 af[4][4], bfr[4][4];
#pragma unroll
            for (int u = 0; u < 4; ++u)
#pragma unroll
                for (int i = 0; i < 4; ++i) { int arow = r0 + 16 * i + c16; if (arow >= MPAD) arow = MPAD - 1;
                    af[u][i] = *(const bf16x8*)(A + (size_t)arow * K + k0 + 32 * u + 8 * g); bfr[u][i] = *(const bf16x8*)(Bt + (size_t)(n0 + 16 * i + c16) * K + k0 + 32 * u + 8 * g); }
#pragma unroll
            for (int u = 0; u < 4; ++u)
#pragma unroll
                for (int i = 0; i < 4; ++i)
#pragma unroll
                    for (int j = 0; j < 4; ++j) acc[i][j] = MFMA_BF16(af[u][i], bfr[u][j], acc[i][j]);
        }
#pragma unroll
        for (int i = 0; i < 4; ++i)
#pragma unroll
            for (int j = 0; j < 4; ++j)
#pragma unroll
                for (int r = 0; r < 4; ++r) part[(w * 64 + 16 * i + 4 * g + r) * 68 + 16 * j + c16] = acc[i][j][r];
        __syncthreads();
        {
            const int row = tid >> 3, c8 = (tid & 7) * 8; f32x4 s0 = (f32x4){0.f, 0.f, 0.f, 0.f}, s1 = s0;
#pragma unroll
            for (int ww = 0; ww < 8; ++ww) { s0 += *(const f32x4*)(part + (ww * 64 + row) * 68 + c8); s1 += *(const f32x4*)(part + (ww * 64 + row) * 68 + c8 + 4); }
            if (r0 + row < NTOK) f(r0 + row, n0 + c8, s0, s1);
        }
        __syncthreads();
    }
}
struct SmallResid { const float* xlo; const float* xhi; const float* gmod; float* out;
    DEV void operator()(int row, int col, f32x4 v0, f32x4 v1) const { const float* xr = (row < NP ? xlo + (size_t)row * D : xhi + (size_t)(row - NP) * D) + col; const float* gr = gmod + (size_t)tok_batch(row) * MODW + col;
        float* o = out + (size_t)row * D + col; *(f32x4*)o = *(const f32x4*)xr + *(const f32x4*)gr * v0; *(f32x4*)(o + 4) = *(const f32x4*)(xr + 4) + *(const f32x4*)(gr + 4) * v1; } };
struct SmallF32 { float* out; DEV void operator()(int row, int col, f32x4 v0, f32x4 v1) const { float* o = out + (size_t)row * D + col; *(f32x4*)o = v0; *(f32x4*)(o + 4) = v1; } };

DEV void transpose_tile(const float* src, int ld_src, bf16_t* dst, int ld_dst, float* tile) {
    const int tid = threadIdx.x;
#pragma unroll
    for (int i = 0; i < 2; ++i) { const int idx = tid + i * 512, r = idx >> 4, c4 = idx & 15; const f32x4 v = *(const f32x4*)(src + (size_t)r * ld_src + c4 * 4);
        float* t = tile + r * 65 + c4 * 4; t[0] = v[0]; t[1] = v[1]; t[2] = v[2]; t[3] = v[3]; }
    __syncthreads();
    const int n = tid >> 3, kg = tid & 7; const float* t = tile + (kg * 8) * 65 + n;
    u32x4 w; w.x = pack2(t[0], t[65]); w.y = pack2(t[2 * 65], t[3 * 65]); w.z = pack2(t[4 * 65], t[5 * 65]); w.w = pack2(t[6 * 65], t[7 * 65]);
    *(u32x4*)(dst + (size_t)n * ld_dst + kg * 8) = w;
    __syncthreads();
}
DEV int cvt_job_tiles(int j) { const int K = j < 9 ? 2048 : 256; const int N = j < 2 ? NMOD : (j == 2 ? 2 * D : (j < 5 ? ZW : (j < 9 ? D : 256))); return (K / 64) * (N / 64); }
constexpr int TBL_SLOT = 10240, TBL_VP1 = 4 * NE - 2 * TBL_SLOT;
DEV int gemm_in_idle_blocks() { const int nwg = (MPAD / 256) * (ZW / 256), G = (int)gridDim.x, rounds = (nwg + G - 1) / G, full = nwg - (rounds - 1) * G; return G - full; }
DEV bool tbl_deferred() { return gemm_in_idle_blocks() >= 32; }
DEV void table_row_to_fp8(const Params& p, int vr, int lane) {
    const int l = vr / (2 * NE), which = (vr % (2 * NE)) / NE, e = vr % NE, rr = l * NE + e;
    const float* src = (which ? p.peer_v : p.peer_u) + (size_t)rr * D; unsigned char* tab = (which ? p.v8 : p.u8) + (size_t)l * NE * D;
    f32x4 v[8]; float am = 0.f;
#pragma unroll
    for (int k = 0; k < 8; ++k) { v[k] = *(const f32x4*)(src + 4 * lane + 256 * k); am = fmaxf(am, fmaxf(fmaxf(fabsf(v[k][0]), fabsf(v[k][1])), fmaxf(fabsf(v[k][2]), fabsf(v[k][3])))); }
    am = wave_max(am);
    const float sc = am > 0.f ? 224.0f / am : 1.0f;
#pragma unroll
    for (int k = 0; k < 8; ++k) *(unsigned*)(tab + ((size_t)(2 * k + (lane >> 5)) * NE + e) * 128 + 4 * (lane & 31)) = fp8x4_enc(v[k][0] * sc, v[k][1] * sc, v[k][2] * sc, v[k][3] * sc);
    if (lane == 0) (which ? p.sv : p.su)[rr] = am > 0.f ? am * (1.0f / 224.0f) : 1.0f;
}
DEV void phase_tbl_slot(const Params& p, int l) {
    const int idle = gemm_in_idle_blocks(), first = (int)gridDim.x - idle;
    if (idle < 32 || (int)blockIdx.x < first) return;
    const int gw = ((int)blockIdx.x - first) * 8 + (threadIdx.x >> 6), nw = idle * 8, lo = TBL_VP1 + l * TBL_SLOT;
    for (int vr = lo + gw; vr < lo + TBL_SLOT; vr += nw) table_row_to_fp8(p, vr, threadIdx.x & 63);
}
DEV void phase_convert(const Params& p, unsigned char* lds, int part) {
    float* tile = (float*)lds;
    const int tid = threadIdx.x;
    const int q_lo = part == 0 ? 0 : 3, q_hi = part == 0 ? 3 : 17;
    int total = 0;
#pragma unroll
    for (int q = 0; q < 17; ++q) if (q >= q_lo && q < q_hi) total += cvt_job_tiles(q);
    for (int tl = blockIdx.x; tl < total; tl += gridDim.x) {
        int j = 0, loc = 0, base = 0;
#pragma unroll
        for (int q = 0; q < 17; ++q) if (q >= q_lo && q < q_hi) { const int cnt = cvt_job_tiles(q); if (tl >= base && tl < base + cnt) { j = q; loc = tl - base; } base += cnt; }
        const float* src; bf16_t* dst; int K = 2048, N;
        if (j < 2) { N = NMOD; src = p.w_ada + (size_t)j * 2048 * NMOD; dst = p.wt_ada + (size_t)j * NMOD * 2048; }
        else if (j == 2) { N = 2 * D; src = p.w_ada_final; dst = p.wt_ada + (size_t)2 * NMOD * 2048; }
        else if (j < 5) { N = ZW; src = p.w_in + (size_t)(j - 3) * 2048 * ZW; dst = p.wt_in + (size_t)(j - 3) * ZW * 2048; }
        else if (j < 7) { N = D; src = p.w_out + (size_t)(j - 5) * D * D; dst = p.wt_out + (size_t)(j - 5) * D * D; }
        else if (j < 9) { N = D; src = p.peer_wq + (size_t)(j - 7) * D * D; dst = p.wt_q + (size_t)(j - 7) * D * D; }
        else { K = 256; N = 256; src = p.pool_w + (size_t)(j - 9) * 65536; dst = p.wt_pool + (size_t)(j - 9) * 65536; }
        const int ntn = N / 64, kt = loc / ntn, nt = loc % ntn;
        transpose_tile(src + (size_t)kt * 64 * N + nt * 64, N, dst + (size_t)nt * 64 * K + kt * 64, K, tile);
    }
    const size_t gt = (size_t)blockIdx.x * 512 + tid, gs = (size_t)gridDim.x * 512;
    if (part == 1) {
        constexpr int NADA = MODW / 256;
        const int vend = tbl_deferred() ? TBL_VP1 : 4 * NE, R1 = (vend / 8) * 7;
        const bool uneven = (int)gridDim.x > NADA + 16;
        for (int seg = 0; seg < 2; ++seg) {
            int gw, nw, r_lo, r_hi;
            if (!uneven) { if (seg) break; gw = blockIdx.x * 8 + (tid >> 6); nw = gridDim.x * 8; r_lo = 0; r_hi = vend; }
            else if (seg == 0) { gw = blockIdx.x * 8 + (tid >> 6); nw = gridDim.x * 8; r_lo = 0; r_hi = R1; }
            else { if ((int)blockIdx.x < NADA) break; gw = ((int)blockIdx.x - NADA) * 8 + (tid >> 6); nw = ((int)gridDim.x - NADA) * 8; r_lo = R1; r_hi = vend; }
            for (int vr = r_lo + gw; vr < r_hi; vr += nw) table_row_to_fp8(p, vr, tid & 63);
        }
    }
    if (part == 0) for (size_t i = gt; i < (size_t)256 * D / 8; i += gs) {
        const int row = (int)(i / (D / 8)), c8 = (int)(i % (D / 8)) * 8; u32x4 w = (u32x4){0u, 0u, 0u, 0u};
        if (row < NC) { const float* s = (row < PB ? p.c_prompt + (size_t)row * D : p.c_sample + (size_t)(row - PB) * D) + c8;
            const f32x4 a = *(const f32x4*)s, b = *(const f32x4*)(s + 4);
            w.x = pack2(siluf_(a[0]), siluf_(a[1])); w.y = pack2(siluf_(a[2]), siluf_(a[3])); w.z = pack2(siluf_(b[0]), siluf_(b[1])); w.w = pack2(siluf_(b[2]), siluf_(b[3])); }
        *(u32x4*)(p.csil + i * 8) = w;
    }
}

DEV void phase_norm(const Params& p, const float* xlo, const float* xhi, const float* gn, int sh_off, int sc_off, bf16_t* obf, float* of32) {
    const int lane = threadIdx.x & 63, gw = blockIdx.x * 8 + (threadIdx.x >> 6), nw = gridDim.x * 8;
    for (int t = gw; t < NTOK; t += nw) {
        const float* xr = t < NP ? xlo + (size_t)t * D : xhi + (size_t)(t - NP) * D;
        const float* mrow = p.modbuf + (size_t)tok_batch(t) * MODW;
        f32x4 v[8]; float ss = 0.f;
#pragma unroll
        for (int c = 0; c < 4; ++c) { const int col = c * 512 + lane * 8; v[2 * c] = *(const f32x4*)(xr + col); v[2 * c + 1] = *(const f32x4*)(xr + col + 4);
#pragma unroll
            for (int j = 0; j < 4; ++j) ss += v[2 * c][j] * v[2 * c][j] + v[2 * c + 1][j] * v[2 * c + 1][j]; }
        ss = wave_sum(ss);
        const float rstd = rsqrtf(ss * (1.0f / D) + EPS);
#pragma unroll
        for (int c = 0; c < 4; ++c) { const int col = c * 512 + lane * 8; f32x4 y[2];
#pragma unroll
            for (int q = 0; q < 2; ++q) { const f32x4 g4 = *(const f32x4*)(gn + col + 4 * q), sc = *(const f32x4*)(mrow + sc_off + col + 4 * q), sh = *(const f32x4*)(mrow + sh_off + col + 4 * q);
                y[q] = (v[2 * c + q] * rstd) * g4 * (sc + 1.0f) + sh; }
            if (obf) { u32x4 w; w.x = pack2(y[0][0], y[0][1]); w.y = pack2(y[0][2], y[0][3]); w.z = pack2(y[1][0], y[1][1]); w.w = pack2(y[1][2], y[1][3]); *(u32x4*)(obf + (size_t)t * D + col) = w; }
            else { *(f32x4*)(of32 + (size_t)t * D + col) = y[0]; *(f32x4*)(of32 + (size_t)t * D + col + 4) = y[1]; }
        }
    }
}

namespace hg {
constexpr int QS = 136, VS = 72;
constexpr int O_QT = 0, O_QH = O_QT + 64 * QS * 2, O_KT = O_QH + 64 * QS * 2, O_KDT = O_KT + 160 * QS * 2, O_VT = O_KDT + 128 * VS * 2,
              O_AB = O_VT + 128 * VS * 2, O_GS = O_AB + 64 * VS * 2, O_END = O_GS + 4 * 128 * 4;
constexpr int OS = 132;
static_assert(O_END <= 163840 - 64, "HGRN LDS layout too large");
constexpr int NCHUNK = SEQ / 64, NUNIT = PB * HH * NCHUNK;
}
DEV int kt_rowbase(int i) { return i == 0 ? 0 : (i == 1 ? 16 : (i == 2 ? 48 : 96)); }

DEV void hgrn_pre_unit(const Params& p, int l, int unit, unsigned char* lds) {
    using namespace hg;
    const int tid = threadIdx.x, lane = tid & 63, w = tid >> 6, g = lane >> 4, c16 = lane & 15;
    const int c = unit % NCHUNK, bh = unit / NCHUNK, b = bh / HH, h = bh % HH;
    bf16_t* Qt = (bf16_t*)(lds + O_QT); bf16_t* Qh = (bf16_t*)(lds + O_QH); bf16_t* Kt = (bf16_t*)(lds + O_KT);
    bf16_t* Kdt = (bf16_t*)(lds + O_KDT); bf16_t* Vt = (bf16_t*)(lds + O_VT); bf16_t* Ab = (bf16_t*)(lds + O_AB); float* Gs = (float*)(lds + O_GS);
    const int kk = tid & 127, sj = tid >> 7;
    float lbv = 0.f;
    if (l > 0) lbv = sigmoidf_(p.lb_logits[HH * HD + h * HD + kk] - p.lb_logits[h * HD + kk]);
    const float oml = 1.0f - lbv;
    for (int i = tid; i < 64 * VS / 2; i += 512) ((unsigned*)Ab)[i] = 0u;
    const size_t row0 = (size_t)b * SEQ + c * 64;
    float Gl[16], qv[16], kv[16];
    {
        const bf16_t* zr = p.z + (row0 + sj * 16) * ZW + h * HD + kk;
        unsigned short zq16[16], zf16[16], zi16[16];
#pragma unroll
        for (int s = 0; s < 16; ++s) { zq16[s] = zr[(size_t)s * ZW]; zf16[s] = zr[(size_t)s * ZW + 1024]; zi16[s] = zr[(size_t)s * ZW + 2048]; }
        float run = 0.f; unsigned vpk[8];
#pragma unroll
        for (int s = 0; s < 16; ++s) {
            const float zq = bf2f(zq16[s]), zf = fminf(fmaxf(bf2f(zf16[s]), -80.f), 80.f);
            const float e = __expf(-zf), sg = 1.0f / (1.0f + e);
            const float f = lbv + oml * sg;
            run += __logf(f); Gl[s] = run;
            kv[s] = oml * (e * sg);
            qv[s] = siluf_(zq);
            if (s & 1) vpk[s >> 1] |= (unsigned)zi16[s] << 16; else vpk[s >> 1] = zi16[s];
        }
        Gs[sj * 128 + kk] = run;
        *(u32x4*)(Vt + kk * VS + sj * 16) = (u32x4){vpk[0], vpk[1], vpk[2], vpk[3]}; *(u32x4*)(Vt + kk * VS + sj * 16 + 8) = (u32x4){vpk[4], vpk[5], vpk[6], vpk[7]};
    }
    __syncthreads();
    float Gend;
    {
        const float g0 = Gs[kk], g1 = Gs[128 + kk], g2 = Gs[256 + kk], g3 = Gs[384 + kk];
        float Gb[4]; Gb[0] = 0.f; Gb[1] = g0; Gb[2] = g0 + g1; Gb[3] = g0 + g1 + g2; Gend = Gb[3] + g3;
        const float Gbj = sj == 0 ? Gb[0] : (sj == 1 ? Gb[1] : (sj == 2 ? Gb[2] : Gb[3]));
        const float eGb = __expf(Gbj);
        unsigned kd[8]; unsigned qh[8];
#pragma unroll
        for (int s = 0; s < 16; ++s) {
            const int t = sj * 16 + s;
            const float q1 = qv[s] * __expf(Gl[s]);
            Qt[t * QS + kk] = (bf16_t)f2bf(q1);
            const unsigned qhv = f2bf(q1 * eGb);
            Qh[t * QS + kk] = (bf16_t)qhv;
#pragma unroll
            for (int i = 0; i < 4; ++i) if (i >= sj) Kt[(kt_rowbase(i) + t) * QS + kk] = (bf16_t)f2bf(kv[s] * __expf(fminf(Gb[i] - Gbj - Gl[s], 60.f)));
            const unsigned kdv = f2bf(kv[s] * __expf(Gend - Gbj - Gl[s]));
            if (s & 1) kd[s >> 1] |= kdv << 16; else kd[s >> 1] = kdv;
        }
        *(u32x4*)(Kdt + kk * VS + sj * 16) = (u32x4){kd[0], kd[1], kd[2], kd[3]}; *(u32x4*)(Kdt + kk * VS + sj * 16 + 8) = (u32x4){kd[4], kd[5], kd[6], kd[7]};
        if (sj == 0) p.hg_gam[(size_t)unit * HD + kk] = __expf(Gend);
    }
    __syncthreads();
    {
        const int t = tid >> 3, part = tid & 7;
        const u32x4 a = *(const u32x4*)(Qh + t * QS + 16 * part), b2 = *(const u32x4*)(Qh + t * QS + 16 * part + 8);
        bf16_t* dst = p.hg_qh + (row0 + t) * 1024 + h * HD + 16 * part; *(u32x4*)dst = a; *(u32x4*)(dst + 8) = b2;
    }
    for (int blk = w; blk < 10; blk += 8) {
        int bi, bjj;
        if (blk == 0) { bi = 0; bjj = 0; } else if (blk < 3) { bi = 1; bjj = blk - 1; } else if (blk < 6) { bi = 2; bjj = blk - 3; } else { bi = 3; bjj = blk - 6; }
        f32x4 acc = (f32x4){0.f, 0.f, 0.f, 0.f};
#pragma unroll
        for (int ks = 0; ks < 4; ++ks) {
            const bf16x8 a = *(const bf16x8*)(Qt + (16 * bi + c16) * QS + 32 * ks + 8 * g);
            const bf16x8 bb = *(const bf16x8*)(Kt + (kt_rowbase(bi) + 16 * bjj + c16) * QS + 32 * ks + 8 * g);
            acc = MFMA_BF16(a, bb, acc);
        }
#pragma unroll
        for (int r = 0; r < 4; ++r) { const int tl = 4 * g + r; float v = acc[r]; if (bi == bjj && c16 > tl) v = 0.f; Ab[(16 * bi + tl) * VS + 16 * bjj + c16] = (bf16_t)f2bf(v); }
    }
    __syncthreads();
    {
        u32x2* oin = (u32x2*)(p.hg_oin + (size_t)unit * 64 * 128);
#pragma unroll
        for (int tt = 0; tt < 4; ++tt) {
            f32x4 acc = (f32x4){0.f, 0.f, 0.f, 0.f};
#pragma unroll
            for (int ks = 0; ks < 2; ++ks) {
                const bf16x8 a = *(const bf16x8*)(Ab + (16 * tt + c16) * VS + 32 * ks + 8 * g);
                const bf16x8 bb = *(const bf16x8*)(Vt + (16 * w + c16) * VS + 32 * ks + 8 * g);
                acc = MFMA_BF16(a, bb, acc);
            }
            oin[(tt * 8 + w) * 64 + lane] = (u32x2){pack2(acc[0], acc[1]), pack2(acc[2], acc[3])};
        }
        u32x2* ds = (u32x2*)(p.hg_ds + (size_t)unit * 128 * 128);
#pragma unroll
        for (int vt = 0; vt < 8; ++vt) {
            f32x4 acc = (f32x4){0.f, 0.f, 0.f, 0.f};
#pragma unroll
            for (int ks = 0; ks < 2; ++ks) {
                const bf16x8 a = *(const bf16x8*)(Kdt + (16 * w + c16) * VS + 32 * ks + 8 * g);
                const bf16x8 bb = *(const bf16x8*)(Vt + (16 * vt + c16) * VS + 32 * ks + 8 * g);
                acc = MFMA_BF16(a, bb, acc);
            }
            ds[(w * 8 + vt) * 64 + lane] = (u32x2){pack2(acc[0], acc[1]), pack2(acc[2], acc[3])};
        }
    }
    __syncthreads();
}

DEV void hgrn_scan_unit(const Params& p, int l, int su) {
    using namespace hg;
    const int tid = threadIdx.x, lane = tid & 63, w = tid >> 6, g = lane >> 4, c16 = lane & 15;
    const int vt = su % 8, bh = su / 8, b = bh / HH, h = bh % HH;
    f32x4 S = (f32x4){0.f, 0.f, 0.f, 0.f};
    for (int c = 0; c < NCHUNK; ++c) {
        const size_t unit = (size_t)bh * NCHUNK + c;
        u32x2 sw; sw.x = pack2(S[0], S[1]); sw.y = pack2(S[2], S[3]);
        *(u32x2*)(p.hg_sc + (unit * 128 + 16 * vt + c16) * 128 + 16 * w + 4 * g) = sw;
        const u32x2 dw = ((const u32x2*)(p.hg_ds + unit * 128 * 128))[(w * 8 + vt) * 64 + lane]; const f32x4 d = (f32x4){lo16(dw.x), hi16(dw.x), lo16(dw.y), hi16(dw.y)};
        const f32x4 gm = *(const f32x4*)(p.hg_gam + unit * HD + 16 * w + 4 * g);
        S = S * gm + d;
    }
    float* so = p.out + OFF_HP + ((size_t)(l * PB + b) * HH + h) * HD * HD;
#pragma unroll
    for (int r = 0; r < 4; ++r) so[(size_t)(16 * w + 4 * g + r) * HD + 16 * vt + c16] = S[r];
}

DEV void hgrn_post_unit(const Params& p, int l, int unit, unsigned char* lds) {
    using namespace hg;
    const int tid = threadIdx.x, lane = tid & 63, w = tid >> 6, g = lane >> 4, c16 = lane & 15;
    const int c = unit % NCHUNK, bh = unit / NCHUNK, b = bh / HH, h = bh % HH;
    float* Ob = (float*)lds;
    const size_t row0 = (size_t)b * SEQ + c * 64;
    const u32x2* oin = (const u32x2*)(p.hg_oin + (size_t)unit * 64 * 128);
    f32x4 acc[4];
#pragma unroll
    for (int tt = 0; tt < 4; ++tt) { const u32x2 ow = oin[(tt * 8 + w) * 64 + lane]; acc[tt] = (f32x4){lo16(ow.x), hi16(ow.x), lo16(ow.y), hi16(ow.y)}; }
    if (c > 0) {
        bf16x8 bfr[4];
#pragma unroll
        for (int ks = 0; ks < 4; ++ks) bfr[ks] = *(const bf16x8*)(p.hg_sc + ((size_t)unit * 128 + 16 * w + c16) * 128 + 32 * ks + 8 * g);
#pragma unroll
        for (int tt = 0; tt < 4; ++tt)
#pragma unroll
            for (int ks = 0; ks < 4; ++ks) { const bf16x8 a = *(const bf16x8*)(p.hg_qh + (row0 + 16 * tt + c16) * 1024 + h * HD + 32 * ks + 8 * g); acc[tt] = MFMA_BF16(a, bfr[ks], acc[tt]); }
    }
#pragma unroll
    for (int tt = 0; tt < 4; ++tt)
#pragma unroll
        for (int r = 0; r < 4; ++r) Ob[(16 * tt + 4 * g + r) * OS + 16 * w + c16] = acc[tt][r];
    __syncthreads();
    {
        const int t = tid >> 3, part = tid & 7; const size_t row = row0 + t;
        float ov[16]; float ss = 0.f;
#pragma unroll
        for (int q = 0; q < 4; ++q) { const f32x4 x = *(const f32x4*)(Ob + t * OS + 16 * part + 4 * q); ov[4 * q] = x[0]; ov[4 * q + 1] = x[1]; ov[4 * q + 2] = x[2]; ov[4 * q + 3] = x[3];
            ss += x[0] * x[0] + x[1] * x[1] + x[2] * x[2] + x[3] * x[3]; }
        ss += __shfl_xor(ss, 1); ss += __shfl_xor(ss, 2); ss += __shfl_xor(ss, 4);
        const float rstd = rsqrtf(ss * (1.0f / HD) + EPS);
        const bf16_t* zg = p.z + row * ZW + 3072 + h * HD + 16 * part;
        const u32x4 za = *(const u32x4*)zg, zc = *(const u32x4*)(zg + 8);
        const unsigned zw[8] = {za.x, za.y, za.z, za.w, zc.x, zc.y, zc.z, zc.w};
        const float* gn = p.hgrn_norm_g + l * HD + 16 * part;
        unsigned ow[8];
#pragma unroll
        for (int q = 0; q < 8; ++q) { const float a0 = ov[2 * q] * rstd * gn[2 * q] * siluf_(lo16(zw[q])), a1 = ov[2 * q + 1] * rstd * gn[2 * q + 1] * siluf_(hi16(zw[q])); ow[q] = pack2(a0, a1); }
        bf16_t* dst = p.cat + row * D + h * HD + 16 * part;
        *(u32x4*)dst = (u32x4){ow[0], ow[1], ow[2], ow[3]}; *(u32x4*)(dst + 8) = (u32x4){ow[4], ow[5], ow[6], ow[7]};
    }
    __syncthreads();
}

DEV void hgrn_sample_unit(const Params& p, int l, int unit, unsigned char* lds) {
    const int tid = threadIdx.x, lane = tid & 63, w = tid >> 6;
    const int b = unit / HH, h = unit % HH;
    float* fS = (float*)lds; float* kS = fS + 512; float* qS = kS + 512; float* vS = qS + 512; float* red = vS + 512; float* part = red + 4 * 4 * 128;
    const int r0 = NP + b * DSEQ;
    {
        const int t = tid >> 7, kk = tid & 127; const bf16_t* zr = p.z + (size_t)(r0 + t) * ZW + h * HD + kk;
        float lbv = 0.f; if (l > 0) lbv = sigmoidf_(p.lb_logits[HH * HD + h * HD + kk] - p.lb_logits[h * HD + kk]);
        const float zq = bf2f(zr[0]), zf = fminf(fmaxf(bf2f(zr[1024]), -80.f), 80.f), zi = bf2f(zr[2048]);
        const float e = __expf(-zf), sg = 1.0f / (1.0f + e);
        fS[tid] = lbv + (1.0f - lbv) * sg; kS[tid] = (1.0f - lbv) * (e * sg); qS[tid] = siluf_(zq); vS[tid] = zi;
    }
    const int v = tid & 127, kq = tid >> 7;
    const float* s0 = p.state_hgrn + ((size_t)(l * DB + b) * HH + h) * HD * HD + (size_t)(32 * kq) * HD + v;
    float S[32];
#pragma unroll
    for (int i = 0; i < 32; ++i) S[i] = s0[(size_t)i * HD];
    __syncthreads();
#pragma unroll
    for (int t = 0; t < 4; ++t) {
        const float vv = vS[t * 128 + v]; float po = 0.f;
#pragma unroll
        for (int i = 0; i < 32; ++i) { const int kk = t * 128 + 32 * kq + i; S[i] = fS[kk] * S[i] + kS[kk] * vv; po += qS[kk] * S[i]; }
        red[(t * 4 + kq) * 128 + v] = po;
    }
    float* so = p.out + OFF_HS + ((size_t)(l * DB + b) * HH + h) * HD * HD + (size_t)(32 * kq) * HD + v;
#pragma unroll
    for (int i = 0; i < 32; ++i) so[(size_t)i * HD] = S[i];
    __syncthreads();
    {
        const int t = tid >> 7; const float o = red[(t * 4 + 0) * 128 + v] + red[(t * 4 + 1) * 128 + v] + red[(t * 4 + 2) * 128 + v] + red[(t * 4 + 3) * 128 + v];
        const float ss = wave_sum(o * o);
        if (lane == 0) part[w] = ss;
        __syncthreads();
        const float tot = part[2 * t] + part[2 * t + 1];
        const float rstd = rsqrtf(tot * (1.0f / HD) + EPS);
        const float zg = bf2f(p.z[(size_t)(r0 + t) * ZW + 3072 + h * HD + v]);
        p.cat[(size_t)(r0 + t) * D + h * HD + v] = (bf16_t)f2bf(o * rstd * p.hgrn_norm_g[l * HD + v] * siluf_(zg));
    }
    __syncthreads();
}

DEV void pool_pre_unit(const Params& p, int l, int unit) {
    const int tid = threadIdx.x, tk = tid >> 7, cg = tid & 127, c = cg * 8, gi = cg >> 5, wnd = 2 << gi;
    const int r = unit * 4 + tk;
    if (r >= NTOK) return;
    f32x2 sum[4] = {{0.f, 0.f}, {0.f, 0.f}, {0.f, 0.f}, {0.f, 0.f}}; float cur[8];
    float cnt;
    if (r < NP) {
        const int t = r % SEQ; const int n = (wnd < t + 1) ? wnd : (t + 1); cnt = (float)n;
        u32x4 q[16];
#pragma unroll
        for (int j = 0; j < 16; ++j) q[j] = (j < n) ? *(const u32x4*)(p.z + (size_t)(r - j) * ZW + 4096 + c) : (u32x4){0u, 0u, 0u, 0u};
#pragma unroll
        for (int j = 0; j < 16; ++j) { sum[0] += (f32x2){lo16(q[j].x), hi16(q[j].x)}; sum[1] += (f32x2){lo16(q[j].y), hi16(q[j].y)}; sum[2] += (f32x2){lo16(q[j].z), hi16(q[j].z)}; sum[3] += (f32x2){lo16(q[j].w), hi16(q[j].w)}; }
        cur[0] = lo16(q[0].x); cur[1] = hi16(q[0].x); cur[2] = lo16(q[0].y); cur[3] = hi16(q[0].y); cur[4] = lo16(q[0].z); cur[5] = hi16(q[0].z); cur[6] = lo16(q[0].w); cur[7] = hi16(q[0].w);
        if (t >= SEQ - PBUF) { float* o = p.out + OFF_PP + ((size_t)(l * PB + r / SEQ) * PBUF + (t - (SEQ - PBUF))) * PW + c;
            *(f32x4*)o = (f32x4){cur[0], cur[1], cur[2], cur[3]}; *(f32x4*)(o + 4) = (f32x4){cur[4], cur[5], cur[6], cur[7]}; }
    } else {
        const int bb = (r - NP) / DSEQ, t = (r - NP) % DSEQ; cnt = (float)wnd;
        const float* sp = p.state_pool + (size_t)(l * DB + bb) * PBUF * PW + c;
        u32x4 q[4]; f32x4 sa[15], sb[15];
#pragma unroll
        for (int j = 0; j < 4; ++j) q[j] = (j <= t && j < wnd) ? *(const u32x4*)(p.z + (size_t)(NP + bb * DSEQ + t - j) * ZW + 4096 + c) : (u32x4){0u, 0u, 0u, 0u};
#pragma unroll
        for (int j = 1; j < 16; ++j) {
            const int back = j - t;
            const bool use = (back >= 1) && (j < wnd);
            const float* srow = sp + (size_t)(PBUF - (use ? back : 1)) * PW;
            sa[j - 1] = use ? *(const f32x4*)srow : (f32x4){0.f, 0.f, 0.f, 0.f}; sb[j - 1] = use ? *(const f32x4*)(srow + 4) : (f32x4){0.f, 0.f, 0.f, 0.f};
        }
#pragma unroll
        for (int j = 0; j < 4; ++j) { sum[0] += (f32x2){lo16(q[j].x), hi16(q[j].x)}; sum[1] += (f32x2){lo16(q[j].y), hi16(q[j].y)}; sum[2] += (f32x2){lo16(q[j].z), hi16(q[j].z)}; sum[3] += (f32x2){lo16(q[j].w), hi16(q[j].w)}; }
#pragma unroll
        for (int j = 0; j < 15; ++j) { sum[0] += (f32x2){sa[j][0], sa[j][1]}; sum[1] += (f32x2){sa[j][2], sa[j][3]}; sum[2] += (f32x2){sb[j][0], sb[j][1]}; sum[3] += (f32x2){sb[j][2], sb[j][3]}; }
        cur[0] = lo16(q[0].x); cur[1] = hi16(q[0].x); cur[2] = lo16(q[0].y); cur[3] = hi16(q[0].y); cur[4] = lo16(q[0].z); cur[5] = hi16(q[0].z); cur[6] = lo16(q[0].w); cur[7] = hi16(q[0].w);
        float* ob = p.out + OFF_PS + (size_t)(l * DB + bb) * PBUF * PW + c;
        { float* o = ob + (size_t)(11 + t) * PW; *(f32x4*)o = (f32x4){cur[0], cur[1], cur[2], cur[3]}; *(f32x4*)(o + 4) = (f32x4){cur[4], cur[5], cur[6], cur[7]}; }
        for (int i = t; i < 11; i += 4) { const float* s2 = sp + (size_t)(4 + i) * PW; float* o = ob + (size_t)i * PW; *(f32x4*)o = *(const f32x4*)s2; *(f32x4*)(o + 4) = *(const f32x4*)(s2 + 4); }
    }
    const float inv = 1.0f / cnt;
    u32x4 w; w.x = pack2(sum[0][0] * inv - cur[0], sum[0][1] * inv - cur[1]); w.y = pack2(sum[1][0] * inv - cur[2], sum[1][1] * inv - cur[3]);
    w.z = pack2(sum[2][0] * inv - cur[4], sum[2][1] * inv - cur[5]); w.w = pack2(sum[3][0] * inv - cur[6], sum[3][1] * inv - cur[7]);
    *(u32x4*)(p.pooled + ((size_t)gi * MPAD + r) * 256 + (c & 255)) = w;
}

#ifndef PROBE_SUB
#define PROBE_SUB 0
#endif
DEV void phase_mix1(const Params& p, int l, unsigned char* lds) {
    for (int rep = 0; rep < (PROBE_SUB == 1 ? 2 : 1); ++rep) for (int u = blockIdx.x; u < hg::NUNIT; u += gridDim.x) hgrn_pre_unit(p, l, u, lds);
    for (int rep = 0; rep < (PROBE_SUB == 2 ? 2 : 1); ++rep) for (int u = blockIdx.x; u < DB * HH; u += gridDim.x) hgrn_sample_unit(p, l, u, lds);
    for (int rep = 0; rep < (PROBE_SUB == 3 ? 2 : 1); ++rep) for (int u = blockIdx.x; u < (NTOK + 3) / 4; u += gridDim.x) pool_pre_unit(p, l, u);
}
DEV void phase_mix2(const Params& p, int l) { for (int u = blockIdx.x; u < PB * HH * 8; u += gridDim.x) hgrn_scan_unit(p, l, u); }
DEV void phase_mix3(const Params& p, int l, unsigned char* lds) { for (int u = blockIdx.x; u < hg::NUNIT; u += gridDim.x) hgrn_post_unit(p, l, u, lds); }

#ifdef HIPEMU
#define MBCNT(mask) __builtin_popcountll((mask) & ((1ull << emu_lane()) - 1ull))
#define POPC64(m) __builtin_popcountll(m)
#else
#define MBCNT(mask) ((int)__builtin_amdgcn_mbcnt_hi((unsigned)((mask) >> 32), __builtin_amdgcn_mbcnt_lo((unsigned)(mask), 0u)))
#define POPC64(m) __popcll(m)
#endif
DEV unsigned fkey(float f) { const unsigned u = __float_as_uint(f); return u ^ ((unsigned)((int)u >> 31) | 0x80000000u); }
DEV unsigned long long lowest_n_bits(unsigned long long m, int n) { unsigned long long r = 0ull; while (n > 0 && m) { const unsigned long long b = m & (~m + 1ull); r |= b; m ^= b; --n; } return r; }
#ifdef HIPEMU
#define DPPU_XOR1(v) __shfl((v), emu_lane() ^ 1)
#define DPPU_XOR2(v) __shfl((v), emu_lane() ^ 2)
#define DPPU_HMIRROR(v) __shfl((v), (emu_lane() & ~7) | (7 - (emu_lane() & 7)))
#else
template <int CTRL> DEV unsigned dpp_u(unsigned v) { return (unsigned)__builtin_amdgcn_update_dpp(0, (int)v, CTRL, 0xf, 0xf, true); }
#define DPPU_XOR1(v) dpp_u<0xB1>(v)
#define DPPU_XOR2(v) dpp_u<0x4E>(v)
#define DPPU_HMIRROR(v) dpp_u<0x141>(v)
#endif
template <int GL> DEV unsigned group_sum(unsigned c) { c += DPPU_XOR1(c); c += DPPU_XOR2(c); if (GL == 8) c += DPPU_HMIRROR(c); return c; }
template <int GL> DEV unsigned group_or(unsigned c) { c |= DPPU_XOR1(c); c |= DPPU_XOR2(c); if (GL == 8) c |= DPPU_HMIRROR(c); return c; }
template <int GL> DEV float group_maxf(float v) { v = fmaxf(v, DPP_XOR1(v)); v = fmaxf(v, DPP_XOR2(v)); if (GL == 8) v = fmaxf(v, DPP_HMIRROR(v)); return v; }
template <int GL> DEV float group_sumf(float v) { v += DPP_XOR1(v); v += DPP_XOR2(v); if (GL == 8) v += DPP_HMIRROR(v); return v; }
DEV unsigned bytesum(unsigned w) { return (w * 0x01010101u) >> 24; }
template <int GL> DEV unsigned group_excl_prefix(unsigned c, int sub) {
    const unsigned sh = 8u * (unsigned)(sub & 3);
    unsigned wlo = (GL == 4 || sub < 4) ? (c << sh) : 0u, whi = (GL == 8 && sub >= 4) ? (c << sh) : 0u;
    wlo = group_or<GL>(wlo);
    unsigned r;
    if (GL == 4) r = bytesum(wlo & ((1u << sh) - 1u));
    else { whi = group_or<GL>(whi); r = sub < 4 ? bytesum(wlo & ((1u << sh) - 1u)) : bytesum(wlo) + bytesum(whi & ((1u << sh) - 1u)); }
    return r;
}
DEV float fkey_inv(unsigned k) { return __uint_as_float((k & 0x80000000u) ? (k ^ 0x80000000u) : ~k); }
template <int GL> DEV unsigned group_top16(const unsigned (&k)[32], bool active, int sub, unsigned& pos0) {
    unsigned mxk = 0u;
#pragma unroll
    for (int i = 0; i < 32; ++i) mxk = k[i] > mxk ? k[i] : mxk;
    { unsigned o = DPPU_XOR1(mxk); mxk = o > mxk ? o : mxk; o = DPPU_XOR2(mxk); mxk = o > mxk ? o : mxk; if (GL == 8) { o = DPPU_HMIRROR(mxk); mxk = o > mxk ? o : mxk; } }
    unsigned L0 = mxk > 0x01000000u ? mxk - 0x01000000u : 0u, c0 = 0u;
#pragma unroll
    for (int i = 0; i < 32; ++i) c0 += (k[i] > L0) ? 1u : 0u;
    c0 = group_sum<GL>(c0);
    unsigned L = c0 > 16u ? L0 + 1u : 0u, R = active ? mxk : 0u, cR = 0u;
    if (!active) L = 0u;
    if (c0 == 16u && active) { L = L0; R = L0; cR = 16u; }
    for (;;) {
        if (__ballot(L < R) == 0ull) break;
        const unsigned mid = L + ((R - L) >> 1);
        unsigned c = 0u;
#pragma unroll
        for (int i = 0; i < 32; ++i) c += (k[i] > mid) ? 1u : 0u;
        c = group_sum<GL>(c);
        const bool le = c <= 16u, hit = c == 16u;
        R = le ? mid : R; cR = le ? c : cR; L = hit ? mid : (le ? L : mid + 1u);
    }
    unsigned mask = 0u;
#pragma unroll
    for (int i = 0; i < 32; ++i) mask |= (k[i] > R) ? (1u << i) : 0u;
    const unsigned need = 16u - cR;
    if (__ballot(active && need > 0u) != 0ull) {
        unsigned eqm = 0u;
#pragma unroll
        for (int i = 0; i < 32; ++i) eqm |= (k[i] == R) ? (1u << i) : 0u;
        const unsigned eqc = (unsigned)__builtin_popcount(eqm), before = group_excl_prefix<GL>(eqc, sub);
        unsigned take = need > before ? need - before : 0u; if (take > eqc) take = eqc;
        if (!active) take = 0u;
        while (take > 0u) { const unsigned b = eqm & (~eqm + 1u); mask |= b; eqm ^= b; --take; }
    }
    if (!active) mask = 0u;
    pos0 = group_excl_prefix<GL>((unsigned)__builtin_popcount(mask), sub);
    return mask;
}
constexpr int SEL_NT = 4;
constexpr int SEL_RS = 144;
DEV void select_step(const Params& p, int l, int tt0, int tstride, int ntile, int h, unsigned char* lds, const bf16x8 (&kh)[2][4], const bf16x8 (&kl)[2][4]) {
    const int tid = threadIdx.x, lane = tid & 63, w = tid >> 6, g = lane >> 4, c16 = lane & 15;
    constexpr int NTK = SEL_NT * 16;
    constexpr int QRS = 264;
    bf16_t* qh = (bf16_t*)lds;
    bf16_t* ql = qh + NTK * QRS;
    float* sc = (float*)(ql + NTK * QRS);
    float* ts = sc + 2 * NTK * SEL_RS;
    int* ti = (int*)(ts + 2 * NTK * 16);
#pragma unroll
    for (int k = 0; k < SEL_NT; ++k) {
        const int tk = tid >> 5, part = tid & 31; const int tok = (tt0 + k * tstride) * 16 + tk;
        f32x4 a = (f32x4){0.f, 0.f, 0.f, 0.f}, b2 = a;
        if (k < ntile && tok < NTOK) { const float* q = p.qry + (size_t)tok * D + h * 256 + part * 8; a = *(const f32x4*)q; b2 = *(const f32x4*)(q + 4); }
        float ss = a[0] * a[0] + a[1] * a[1] + a[2] * a[2] + a[3] * a[3] + b2[0] * b2[0] + b2[1] * b2[1] + b2[2] * b2[2] + b2[3] * b2[3];
        ss += __shfl_xor(ss, 1); ss += __shfl_xor(ss, 2); ss += __shfl_xor(ss, 4); ss += __shfl_xor(ss, 8);
        const float rn = rsqrtf(ss * (1.0f / 128.0f) + EPS);
        const float v[8] = {a[0] * rn, a[1] * rn, a[2] * rn, a[3] * rn, b2[0] * rn, b2[1] * rn, b2[2] * rn, b2[3] * rn};
        unsigned hi[4], lo[4];
#pragma unroll
        for (int j = 0; j < 4; ++j) { hi[j] = pack2(v[2 * j], v[2 * j + 1]); lo[j] = pack2(v[2 * j] - lo16(hi[j]), v[2 * j + 1] - hi16(hi[j])); }
        *(u32x4*)(qh + (k * 16 + tk) * QRS + part * 8) = (u32x4){hi[0], hi[1], hi[2], hi[3]}; *(u32x4*)(ql + (k * 16 + tk) * QRS + part * 8) = (u32x4){lo[0], lo[1], lo[2], lo[3]};
    }
    __syncthreads();
    for (int k = 0; k < ntile; ++k) {
#pragma unroll
        for (int ph = 0; ph < 2; ++ph) {
            f32x4 acc = (f32x4){0.f, 0.f, 0.f, 0.f};
#pragma unroll
            for (int ks = 0; ks < 4; ++ks) {
                const bf16x8 ah = *(const bf16x8*)(qh + (k * 16 + c16) * QRS + ph * 128 + 32 * ks + 8 * g), al = *(const bf16x8*)(ql + (k * 16 + c16) * QRS + ph * 128 + 32 * ks + 8 * g);
                acc = MFMA_BF16(al, kh[ph][ks], acc); acc = MFMA_BF16(ah, kl[ph][ks], acc); acc = MFMA_BF16(ah, kh[ph][ks], acc);
            }
            const int kidx = 16 * w + c16;
#pragma unroll
            for (int r = 0; r < 4; ++r) sc[(ph * NTK + k * 16 + 4 * g + r) * SEL_RS + (kidx >> 5) * 36 + (kidx & 31)] = acc[r];
        }
    }
    __syncthreads();
    {
        const int row = tid >> 2, sub = tid & 3; const bool active = ((row % NTK) >> 4) < ntile;
        unsigned k[32];
#pragma unroll
        for (int i4 = 0; i4 < 8; ++i4) { const f32x4 v = *(const f32x4*)(sc + row * SEL_RS + sub * 36 + 4 * i4); k[4 * i4] = fkey(v[0]); k[4 * i4 + 1] = fkey(v[1]); k[4 * i4 + 2] = fkey(v[2]); k[4 * i4 + 3] = fkey(v[3]); }
        unsigned pos; const unsigned mask = group_top16<4>(k, active, sub, pos);
#pragma unroll
        for (int i = 0; i < 32; ++i) if ((mask >> i) & 1u) { if (pos < 16u) { ts[row * 16 + pos] = fkey_inv(k[i]); ti[row * 16 + pos] = 32 * sub + i; } ++pos; }
    }
    __syncthreads();
    {
        const int tk = tid >> 3, sub = tid & 7; const bool active = (tk >> 4) < ntile; const int tok = (tt0 + (tk >> 4) * tstride) * 16 + (tk & 15);
        const float s1a = ts[tk * 16 + 2 * sub], s1b = ts[tk * 16 + 2 * sub + 1];
        unsigned k[32];
#pragma unroll
        for (int j4 = 0; j4 < 4; ++j4) { const f32x4 s2 = *(const f32x4*)(ts + (NTK + tk) * 16 + 4 * j4);
#pragma unroll
            for (int j = 0; j < 4; ++j) { k[4 * j4 + j] = fkey(s1a + s2[j]); k[16 + 4 * j4 + j] = fkey(s1b + s2[j]); } }
        unsigned pos; const unsigned mask = group_top16<8>(k, active, sub, pos);
        const int i1a = ti[tk * 16 + 2 * sub], i1b = ti[tk * 16 + 2 * sub + 1];
        int i2v[16];
#pragma unroll
        for (int j4 = 0; j4 < 4; ++j4) { const u32x4 t4 = *(const u32x4*)(ti + (NTK + tk) * 16 + 4 * j4); i2v[4 * j4] = (int)t4.x; i2v[4 * j4 + 1] = (int)t4.y; i2v[4 * j4 + 2] = (int)t4.z; i2v[4 * j4 + 3] = (int)t4.w; }
        u32x2* lst = (u32x2*)sc;
#pragma unroll
        for (int i = 0; i < 32; ++i) if ((mask >> i) & 1u) { if (pos < 16u) lst[tk * 16 + pos] = (u32x2){__float_as_uint(fkey_inv(k[i])), (unsigned)((i < 16 ? i1a : i1b) * 128 + i2v[i & 15])}; ++pos; }
    }
    __syncthreads();
#pragma unroll
    for (int r = 0; r < NTK / 32; ++r) {
        const int tk = (tid >> 4) + 32 * r, slot = tid & 15; const int tok = (tt0 + (tk >> 4) * tstride) * 16 + (tk & 15);
        const u32x2 en = ((const u32x2*)sc)[tk * 16 + slot];
        const float v = __uint_as_float(en.x); const int e = (int)en.y;
        float mx = v; mx = fmaxf(mx, DPP_XOR1(mx)); mx = fmaxf(mx, DPP_XOR2(mx)); mx = fmaxf(mx, DPP_HMIRROR(mx)); mx = fmaxf(mx, DPP_RMIRROR(mx));
        const float ex = __expf(v - mx);
        float sm = ex; sm += DPP_XOR1(sm); sm += DPP_XOR2(sm); sm += DPP_HMIRROR(sm); sm += DPP_RMIRROR(sm);
        if ((tk >> 4) < ntile && tok < NTOK) { const size_t o = (size_t)tok * 128 + h * 16 + slot;
            p.eidx[o] = (unsigned short)e; p.gate[o] = ex / sm * p.sv[l * NE + e]; p.iscu[o] = p.su[l * NE + e]; }
    }
    __syncthreads();
}
DEV void phase_select(const Params& p, int l, unsigned char* lds) {
    const int ntt = (NTOK + 15) / 16, lane = threadIdx.x & 63, w = threadIdx.x >> 6, g = lane >> 4, c16 = lane & 15;
    const bool fixed = (gridDim.x % 8u) == 0u;
    const int nq = fixed ? (int)(gridDim.x >> 3) : 1;
    for (int hh = 0; hh < (fixed ? 1 : 8); ++hh) {
        const int h = fixed ? (int)(blockIdx.x & 7) : hh;
        bf16x8 kh[2][4], kl[2][4];
#pragma unroll
        for (int ph = 0; ph < 2; ++ph)
#pragma unroll
            for (int ks = 0; ks < 4; ++ks) { const float* kr = p.peer_keys + ((size_t)((l * 8 + h) * 2 + ph) * 128 + 16 * w + c16) * 128 + 32 * ks + 8 * g;
                const f32x4 a = *(const f32x4*)kr, b2 = *(const f32x4*)(kr + 4); const float v[8] = {a[0], a[1], a[2], a[3], b2[0], b2[1], b2[2], b2[3]};
                u32x4 hi, lo; unsigned hw[4], lw[4];
#pragma unroll
                for (int j = 0; j < 4; ++j) { hw[j] = pack2(v[2 * j], v[2 * j + 1]); lw[j] = pack2(v[2 * j] - lo16(hw[j]), v[2 * j + 1] - hi16(hw[j])); }
                hi = (u32x4){hw[0], hw[1], hw[2], hw[3]}; lo = (u32x4){lw[0], lw[1], lw[2], lw[3]};
                kh[ph][ks] = __builtin_bit_cast(bf16x8, hi); kl[ph][ks] = __builtin_bit_cast(bf16x8, lo); }
        const int first = fixed ? (int)(blockIdx.x >> 3) : (int)blockIdx.x, stride = fixed ? nq : (int)gridDim.x;
        for (int tt0 = first; tt0 < ntt; tt0 += SEL_NT * stride) {
            int ntile = 0;
#pragma unroll
            for (int k = 0; k < SEL_NT; ++k) if (tt0 + k * stride < ntt) ntile = k + 1;
            select_step(p, l, tt0, stride, ntile, h, lds, kh, kl);
        }
    }
}

constexpr int PEER_TB = 272;
struct PeerDeal { int xs_first, xs_step, t_begin, t_end; };
DEV PeerDeal peer_deal() {
    PeerDeal d; const bool sl = (gridDim.x % 8u) == 0u;
    const int nranks = sl ? (int)(gridDim.x >> 3) : (int)gridDim.x, rank = sl ? (int)(blockIdx.x >> 3) : (int)blockIdx.x, tpr = (NTOK + nranks - 1) / nranks;
    d.xs_first = sl ? (int)(blockIdx.x & 7) : 0; d.xs_step = sl ? 8 : 1; d.t_begin = rank * tpr; d.t_end = d.t_begin + tpr < NTOK ? d.t_begin + tpr : NTOK;
    return d;
}
struct PeerTok { u32x4 e0, e1, ha, hb; };
DEV void peer_fetch_u(const Params& p, int t, int c0, int g8, PeerTok& k) {
    const u32x4* ep = (const u32x4*)(p.eidx + (size_t)t * 128 + 16 * g8); k.e0 = ep[0]; k.e1 = ep[1];
    k.ha = *(const u32x4*)(p.hB + (size_t)t * D + c0); k.hb = *(const u32x4*)(p.hB + (size_t)t * D + c0 + 8);
}
DEV void phase_peer_u(const Params& p, int l, unsigned char* lds) {
    const int lane = threadIdx.x & 63, w = threadIdx.x >> 6, j8 = lane & 7, g8 = lane >> 3;
    const bool b2 = (j8 & 4) != 0, b1 = (j8 & 2) != 0, b0 = (j8 & 1) != 0;
    const PeerDeal dl = peer_deal();
    const unsigned char* U = p.u8 + (size_t)l * NE * D;
    float* lp = (float*)lds;
    for (int xs = dl.xs_first; xs < 8; xs += dl.xs_step)
    for (int t0 = dl.t_begin; t0 < dl.t_end; t0 += PEER_TB) {
        const int nb = dl.t_end - t0 < PEER_TB ? dl.t_end - t0 : PEER_TB;
        for (int ch = 0; ch < 2; ++ch) {
            const int c0 = 256 * xs + 128 * ch + 16 * j8;
            const unsigned char* Us = U + (size_t)(2 * xs + ch) * NE * 128 + 16 * j8;
            PeerTok nx; if (w < nb) peer_fetch_u(p, t0 + w, c0, g8, nx);
            for (int tk = w; tk < nb; tk += 8) {
                const int t = t0 + tk;
                const PeerTok cu = nx;
                const unsigned ew[8] = {cu.e0.x, cu.e0.y, cu.e0.z, cu.e0.w, cu.e1.x, cu.e1.y, cu.e1.z, cu.e1.w}; unsigned ev[16];
#pragma unroll
                for (int i = 0; i < 8; ++i) { ev[2 * i] = ew[i] & 0xffffu; ev[2 * i + 1] = ew[i] >> 16; }
                u32x4 q[16];
#pragma unroll
                for (int i = 0; i < 16; ++i) q[i] = *(const u32x4*)(Us + (size_t)ev[i] * 128);
                if (tk + 8 < nb) peer_fetch_u(p, t + 8, c0, g8, nx);
                const u32x4 ha = cu.ha, hb = cu.hb;
                const f32x2 hf[8] = {{lo16(ha.x), hi16(ha.x)}, {lo16(ha.y), hi16(ha.y)}, {lo16(ha.z), hi16(ha.z)}, {lo16(ha.w), hi16(ha.w)}, {lo16(hb.x), hi16(hb.x)}, {lo16(hb.y), hi16(hb.y)}, {lo16(hb.z), hi16(hb.z)}, {lo16(hb.w), hi16(hb.w)}};
                float ps[16];
#pragma unroll
                for (int i = 0; i < 16; ++i) { f32x2 dq[8]; fp8x16_dec2(q[i], dq); f32x2 a = dq[0] * hf[0];
#pragma unroll
                    for (int k = 1; k < 8; ++k) a = __builtin_elementwise_fma(dq[k], hf[k], a);
                    ps[i] = a[0] + a[1]; }
                float q8[8], q4[4], q2[2];
#pragma unroll
                for (int k = 0; k < 8; ++k) { const float keep = b2 ? ps[8 + k] : ps[k], send = b2 ? ps[k] : ps[8 + k]; q8[k] = keep + DPP_HMIRROR(send); }
#pragma unroll
                for (int k = 0; k < 4; ++k) { const float keep = b1 ? q8[4 + k] : q8[k], send = b1 ? q8[k] : q8[4 + k]; q4[k] = keep + DPP_XOR2(send); }
#pragma unroll
                for (int k = 0; k < 2; ++k) { const float keep = b0 ? q4[2 + k] : q4[k], send = b0 ? q4[k] : q4[2 + k]; q2[k] = keep + DPP_XOR1(send); }
                float* lrow = lp + tk * 128 + 16 * g8 + 2 * j8;
                if (ch == 0) { lrow[0] = q2[0]; lrow[1] = q2[1]; }
                else { const size_t o = (size_t)t * 128 + 16 * g8 + 2 * j8;
                    float* dst = p.part + ((size_t)t * 8 + xs) * 128 + 16 * g8 + 2 * j8;
                    dst[0] = (q2[0] + lrow[0]) * p.iscu[o]; dst[1] = (q2[1] + lrow[1]) * p.iscu[o + 1]; }
            }
        }
    }
}
DEV void phase_peer_c(const Params& p) {
    const size_t n = (size_t)NTOK * 128, gs = (size_t)gridDim.x * 512;
    for (size_t i = (size_t)blockIdx.x * 512 + threadIdx.x; i < n; i += gs) {
        const size_t t = i >> 7; const int pr = (int)(i & 127); float sacc = 0.f;
#pragma unroll
        for (int x = 0; x < 8; ++x) sacc += p.part[(t * 8 + x) * 128 + pr];
        p.ab16[i] = (bf16_t)f2bf(gelu_erf(sacc) * p.gate[i]);
    }
}
struct PeerTokV { u32x4 e0, e1, a0, a1; f32x2 x1, g2; };
DEV void peer_fetch_v(const Params& p, int l, int t, int col, int g8, PeerTokV& k) {
    const u32x4* ep = (const u32x4*)(p.eidx + (size_t)t * 128 + 16 * g8); k.e0 = ep[0]; k.e1 = ep[1];
    const u32x4* ap = (const u32x4*)(p.ab16 + (size_t)t * 128 + 16 * g8); k.a0 = ap[0]; k.a1 = ap[1];
    k.x1 = *(const f32x2*)(p.xa + (size_t)t * D + col); k.g2 = *(const f32x2*)(p.modbuf + (size_t)tok_batch(t) * MODW + l * NMOD + 5 * D + col);
}
DEV void phase_peer_v(const Params& p, int l, unsigned char* lds) {
    const int lane = threadIdx.x & 63, w = threadIdx.x >> 6, j8 = lane & 7, g8 = lane >> 3;
    const bool b3 = (g8 & 1) != 0, b4 = (g8 & 2) != 0, b5 = (g8 & 4) != 0;
    const PeerDeal dl = peer_deal();
    const unsigned char* V = p.v8 + (size_t)l * NE * D;
    for (int xs = dl.xs_first; xs < 8; xs += dl.xs_step)
        for (int ch = 0; ch < 2; ++ch) {
            const int c0 = 256 * xs + 128 * ch + 16 * j8, col = c0 + (b3 ? 8 : 0) + (b4 ? 4 : 0) + (b5 ? 2 : 0);
            const unsigned char* Vs = V + (size_t)(2 * xs + ch) * NE * 128 + 16 * j8;
            PeerTokV nx; if (dl.t_begin + w < dl.t_end) peer_fetch_v(p, l, dl.t_begin + w, col, g8, nx);
            for (int t = dl.t_begin + w; t < dl.t_end; t += 8) {
                const PeerTokV cu = nx;
                const unsigned ew[8] = {cu.e0.x, cu.e0.y, cu.e0.z, cu.e0.w, cu.e1.x, cu.e1.y, cu.e1.z, cu.e1.w}; unsigned ev[16];
#pragma unroll
                for (int i = 0; i < 8; ++i) { ev[2 * i] = ew[i] & 0xffffu; ev[2 * i + 1] = ew[i] >> 16; }
                u32x4 q[16];
#pragma unroll
                for (int i = 0; i < 16; ++i) q[i] = *(const u32x4*)(Vs + (size_t)ev[i] * 128);
                if (t + 8 < dl.t_end) peer_fetch_v(p, l, t + 8, col, g8, nx);
                const unsigned aw[8] = {cu.a0.x, cu.a0.y, cu.a0.z, cu.a0.w, cu.a1.x, cu.a1.y, cu.a1.z, cu.a1.w}; float av[16];
#pragma unroll
                for (int i = 0; i < 8; ++i) { av[2 * i] = lo16(aw[i]); av[2 * i + 1] = hi16(aw[i]); }
                f32x2 acc2[8];
#pragma unroll
                for (int k = 0; k < 8; ++k) acc2[k] = (f32x2){0.f, 0.f};
#pragma unroll
                for (int i = 0; i < 16; ++i) { f32x2 dq[8]; fp8x16_dec2(q[i], dq); const f32x2 a2v = (f32x2){av[i], av[i]};
#pragma unroll
                    for (int k = 0; k < 8; ++k) acc2[k] = __builtin_elementwise_fma(a2v, dq[k], acc2[k]); }
                float acc[16];
#pragma unroll
                for (int k = 0; k < 8; ++k) { acc[2 * k] = acc2[k][0]; acc[2 * k + 1] = acc2[k][1]; }
                float q8[8], q4[4], q2[2];
#pragma unroll
                for (int k = 0; k < 8; ++k) { const float keep = b3 ? acc[8 + k] : acc[k], send = b3 ? acc[k] : acc[8 + k]; q8[k] = keep + DPP_XOR8(send); }
#pragma unroll
                for (int k = 0; k < 4; ++k) q4[k] = xsum16(q8[k], q8[4 + k]);
#pragma unroll
                for (int k = 0; k < 2; ++k) q2[k] = xsum32(q4[k], q4[2 + k]);
                f32x2 o; o[0] = cu.x1[0] + cu.g2[0] * q2[0]; o[1] = cu.x1[1] + cu.g2[1] * q2[1];
                *(f32x2*)(p.xb + (size_t)t * D + col) = o;
            }
        }
}

constexpr int N_PHASES = 27;
DEV int phase_class(int k) { return k < 2 ? k : (k == 26 ? 14 : 2 + (k - 2) % 12); }
#ifndef HIPEMU
#define XB_TMO      128
#define XB_XCNT(j)  (256  + 64 * (j))
#define XB_XSUB(j)  (1280 + 64 * (j))
#define XB_XGEN(j)  (2304 + 64 * (j))
#define XB_TOP      3328
#define XB_TOPGEN   3392
#define XCD_BAR_WORDS 3456
#define XB_SPIN_CAP (1u << 22)
__device__ __forceinline__ unsigned xb_ld(unsigned* p)              { return __hip_atomic_load(p, __ATOMIC_RELAXED, __HIP_MEMORY_SCOPE_AGENT); }
__device__ __forceinline__ unsigned xb_add(unsigned* p, unsigned v) { return __hip_atomic_fetch_add(p, v, __ATOMIC_RELAXED, __HIP_MEMORY_SCOPE_AGENT); }
__device__ __forceinline__ unsigned xb_xcc_id() { return (unsigned)__builtin_amdgcn_s_getreg((3 << 11) | 20) & 0xFu; }
#define XB_SPIN(cond, bar) do { unsigned _sp = 0; while (cond) { __builtin_amdgcn_s_sleep(1); \
    if ((++_sp & 255u) == 0u) { if (xb_ld(&(bar)[XB_TMO])) break; if (_sp > XB_SPIN_CAP) { atomicAdd(&(bar)[XB_TMO], 1u); break; } } } } while (0)
struct XcdBarrier { unsigned* bar; unsigned x; volatile LAS unsigned* st; };
__device__ __forceinline__ XcdBarrier xcd_barrier_post(unsigned* bar, volatile LAS unsigned* st) {
    XcdBarrier b; b.bar = bar; b.x = xb_xcc_id(); b.st = st;
    if (threadIdx.x == 0) (void)xb_add(&bar[XB_XCNT(b.x)], 1u);
    return b;
}
__device__ __forceinline__ void xcd_barrier_complete(unsigned* bar, unsigned x, unsigned& nloc, unsigned& nx) {
    const unsigned G = gridDim.x * gridDim.y * gridDim.z;
    unsigned sum, cnt, mine, sp = 0u;
    for (;;) {
        sum = 0u; cnt = 0u; mine = 0u;
#pragma unroll
        for (unsigned j = 0; j < 16; ++j) { const unsigned c = xb_ld(&bar[XB_XCNT(j)]); sum += c; cnt += (c > 0u) ? 1u : 0u; mine = (j == x) ? c : mine; }
        if (sum == G) break;
        __builtin_amdgcn_s_sleep(1);
        if ((++sp & 255u) == 0u) { if (xb_ld(&bar[XB_TMO])) break; if (sp > XB_SPIN_CAP) { atomicAdd(&bar[XB_TMO], 1u); break; } }
    }
    nloc = mine > 0u ? mine : 1u; nx = cnt > 0u ? cnt : 1u;
}
__device__ __forceinline__ void xcd_barrier(const XcdBarrier& b) {
    asm volatile("s_waitcnt vmcnt(0)" ::: "memory");
    __syncthreads();
    if (threadIdx.x == 0) {
        unsigned* bar = b.bar;
        __builtin_amdgcn_s_waitcnt(0);
        unsigned nloc = b.st[0], nx = b.st[1];
        if (nloc == 0u) { xcd_barrier_complete(bar, b.x, nloc, nx); b.st[0] = nloc; b.st[1] = nx; }
        const unsigned old = xb_add(&bar[XB_XSUB(b.x)], 1u);
        const unsigned gen = old / nloc;
        if (old + 1u == (gen + 1u) * nloc) {
            __builtin_amdgcn_fence(__ATOMIC_RELEASE, "agent");
            asm volatile("s_waitcnt vmcnt(0)" ::: "memory");
            const unsigned og = xb_add(&bar[XB_TOP], 1u);
            const unsigned tg = og / nx;
            if (og + 1u == (tg + 1u) * nx) xb_add(&bar[XB_TOPGEN], 1u);
            else XB_SPIN(xb_ld(&bar[XB_TOPGEN]) == tg, bar);
            __builtin_amdgcn_fence(__ATOMIC_ACQUIRE, "agent");
            xb_add(&bar[XB_XGEN(b.x)], 1u);
            asm volatile("s_waitcnt vmcnt(0)" ::: "memory");
        } else {
            XB_SPIN(xb_ld(&bar[XB_XGEN(b.x)]) == gen, bar);
            __builtin_amdgcn_fence(__ATOMIC_ACQUIRE, "agent");
            asm volatile("s_waitcnt vmcnt(0)" ::: "memory");
        }
    }
    __syncthreads();
}
#endif

constexpr int LDS_BYTES = 163840;
constexpr int LDS_BARW = LDS_BYTES - 16;

#ifndef PH_MASK
#define PH_MASK 0xFFFFFFFFu
#endif
#ifndef PROBE_DUP
#define PROBE_DUP 0u
#endif
#define DUP_N(k) (1 + (int)((PROBE_DUP >> phase_class(k)) & 1u))
#define PH_BIT(k) ((PH_MASK >> phase_class(k)) & 1u)
#ifdef HIPEMU
static void run_phase(const Params& pp, int ph, unsigned char* lds)
#define GRID_BAR() do {} while (0)
#define IN(k) (ph == (k))
#define GLDS lds
#define LOADP() const Params& p = pp
#else
typedef const __attribute__((address_space(4))) unsigned char* kargp_t;
__device__ __forceinline__ kargp_t karg_ptr() { kargp_t kp = (kargp_t)__builtin_amdgcn_kernarg_segment_ptr(); asm volatile("" : "+s"(kp)); return kp; }
#define LOADP() Params p; __builtin_memcpy(&p, karg_ptr(), sizeof(Params))
#define IN(k) (PH_BIT(k) && ph_lo <= (k) && (k) < ph_hi)
#define GLDS ((LAS unsigned char*)lds_raw)
__global__ void __launch_bounds__(512, 2) mega_fwd(Params p_unused)
#endif
{
#ifndef HIPEMU
    extern __shared__ __attribute__((aligned(16))) unsigned char lds_raw[];
    unsigned char* lds = lds_raw;
    if (threadIdx.x == 0) { *(volatile unsigned*)(lds_raw + LDS_BARW) = 0u; *(volatile unsigned*)(lds_raw + LDS_BARW + 4) = 0u; }
    __syncthreads();
    int ph_lo, ph_hi; XcdBarrier bar;
    { LOADP(); ph_lo = p.ph_lo; ph_hi = p.ph_hi; bar.bar = p.bar; bar.x = 0; bar.st = nullptr; }
    const bool multi = (ph_hi - ph_lo) > 1;
    if (multi) bar = xcd_barrier_post(bar.bar, (volatile LAS unsigned*)(lds_raw + LDS_BARW));
#define GRID_BAR() do { if (multi) xcd_barrier(bar); } while (0)
#endif
    if (IN(0)) { for (int rep = 0; rep < DUP_N(0); ++rep) { LOADP(); phase_convert(p, lds, 0); GRID_BAR(); } }
    if (IN(1)) {
        LOADP();
        pg8::Gemm g{p.csil, p.wt_ada, 256, MODW, D}; pg8::StaticOrder S; S.init(256, MODW, gridDim.x, blockIdx.x);
        pg8::EpiAda E{p.modbuf, p.b_ada, p.b_ada_final};
        pg8::gemm_phase<pg8::EpiAda, pg8::StaticOrder>(GLDS, g, S, E);
    }
    if (IN(1)) { LOADP(); phase_convert(p, lds, 1); GRID_BAR(); }
#define LAYER(l) do { \
        constexpr int base = 2 + 12 * (l); \
        if (IN(base + 0)) { for (int rep = 0; rep < DUP_N(base + 0); ++rep) { LOADP(); phase_norm(p, (l) == 0 ? p.x_prompt : p.xb, (l) == 0 ? p.x_sample : p.xb + (size_t)NP * D, p.norm1_g + (l) * D, (l) * NMOD + 0 * D, (l) * NMOD + 1 * D, p.hA, nullptr); GRID_BAR(); } } \
        if (IN(base + 1)) { for (int rep = 0; rep < DUP_N(base + 1); ++rep) { LOADP(); \
            pg8::Gemm g{p.hA, p.wt_in + (size_t)(l) * ZW * D, MPAD, ZW, D}; pg8::StaticOrder S; S.init(MPAD, ZW, gridDim.x, blockIdx.x); \
            pg8::EpiBf16 E{p.z, ZW}; \
            pg8::gemm_phase<pg8::EpiBf16, pg8::StaticOrder>(GLDS, g, S, E); } } \
        if (IN(base + 1)) { LOADP(); phase_tbl_slot(p, (l)); GRID_BAR(); } \
        if (IN(base + 2)) { for (int rep = 0; rep < DUP_N(base + 2); ++rep) { LOADP(); phase_mix1(p, (l), lds); GRID_BAR(); } } \
        if (IN(base + 3)) { for (int rep = 0; rep < DUP_N(base + 3); ++rep) { LOADP(); phase_mix2(p, (l)); GRID_BAR(); } } \
        if (IN(base + 4)) { LOADP(); phase_mix3(p, (l), lds); } \
        if (IN(base + 4)) { LOADP(); \
            pg8::Gemm g{p.pooled, p.wt_pool + (size_t)(l) * 1024 * 256, 4 * MPAD, 1024, 256}; pg8::PoolOrder S{(int)gridDim.x, (int)(gridDim.x - 1 - blockIdx.x)}; \
            pg8::EpiPool E{p.cat, p.pool_b + (l) * PW, p.pool_scale + (l) * PW}; \
            pg8::gemm_phase<pg8::EpiPool, pg8::PoolOrder>(GLDS, g, S, E); \
            GRID_BAR(); } \
        if (IN(base + 5)) { for (int rep = 0; rep < DUP_N(base + 5); ++rep) { LOADP(); \
            pg8::Gemm g{p.cat, p.wt_out + (size_t)(l) * D * D, MBIG, D, D}; pg8::StaticOrder S; S.init(MBIG, D, gridDim.x, blockIdx.x); \
            pg8::EpiResid E{(l) == 0 ? p.x_prompt : p.xb, (l) == 0 ? p.x_sample : p.xb + (size_t)NP * D, p.modbuf + (l) * NMOD + 2 * D, p.xa}; \
            pg8::gemm_phase<pg8::EpiResid, pg8::StaticOrder>(GLDS, g, S, E); \
            { SmallResid sf{E.xlo, E.xhi, E.gmod, E.out}; small_gemm(p.cat, p.wt_out + (size_t)(l) * D * D, D, lds, sf); } \
            GRID_BAR(); } } \
        if (IN(base + 6)) { for (int rep = 0; rep < DUP_N(base + 6); ++rep) { LOADP(); phase_norm(p, p.xa, p.xa + (size_t)NP * D, p.norm2_g + (l) * D, (l) * NMOD + 3 * D, (l) * NMOD + 4 * D, p.hB, nullptr); GRID_BAR(); } } \
        if (IN(base + 7)) { for (int rep = 0; rep < DUP_N(base + 7); ++rep) { LOADP(); \
            pg8::Gemm g{p.hB, p.wt_q + (size_t)(l) * D * D, MBIG, D, D}; pg8::StaticOrder S; S.init(MBIG, D, gridDim.x, blockIdx.x); \
            pg8::EpiF32 E{p.qry, D}; \
            pg8::gemm_phase<pg8::EpiF32, pg8::StaticOrder>(GLDS, g, S, E); \
            { SmallF32 sf{p.qry}; small_gemm(p.hB, p.wt_q + (size_t)(l) * D * D, D, lds, sf); } \
            GRID_BAR(); } } \
        if (IN(base + 8)) { for (int rep = 0; rep < DUP_N(base + 8); ++rep) { LOADP(); phase_select(p, (l), lds); GRID_BAR(); } } \
        if (IN(base + 9)) { for (int rep = 0; rep < DUP_N(base + 9); ++rep) { LOADP(); phase_peer_u(p, (l), lds); GRID_BAR(); } } \
        if (IN(base + 10)) { LOADP(); phase_peer_c(p); GRID_BAR(); } \
        if (IN(base + 11)) { for (int rep = 0; rep < DUP_N(base + 11); ++rep) { LOADP(); phase_peer_v(p, (l), lds); GRID_BAR(); } } \
    } while (0)
    LAYER(0);
    LAYER(1);
    if (IN(26)) { LOADP(); phase_norm(p, p.xb, p.xb + (size_t)NP * D, p.final_g, 2 * NMOD, 2 * NMOD + D, nullptr, p.out + OFF_Y); }
#undef LAYER
#undef IN
#undef GRID_BAR
#undef GLDS
#undef LOADP
}

struct WsLayout { size_t bar, modbuf, csil, wt_ada, wt_in, wt_out, wt_q, wt_pool, u8, v8, su, sv, iscu, part, hg_oin, hg_ds, hg_gam, hg_qh, hg_sc, hA, hB, z, pooled, cat, xa, xb, qry, eidx, gate, ab16, end; };
static WsLayout ws_layout() {
    WsLayout L; size_t o = 0;
    auto take = [&](size_t bytes) { const size_t r = o; o += (bytes + 255) & ~(size_t)255; return r; };
    L.bar = take(16384);
    L.modbuf = take((size_t)256 * MODW * 4);
    L.csil = take((size_t)256 * D * 2);
    L.wt_ada = take((size_t)MODW * D * 2);
    L.wt_in = take((size_t)2 * ZW * D * 2);
    L.wt_out = take((size_t)2 * D * D * 2);
    L.wt_q = take((size_t)2 * D * D * 2);
    L.wt_pool = take((size_t)2 * 1024 * 256 * 2);
    L.u8 = take((size_t)2 * NE * D);
    L.v8 = take((size_t)2 * NE * D);
    L.su = take((size_t)2 * NE * 4);
    L.sv = take((size_t)2 * NE * 4);
    L.iscu = take((size_t)MPAD * 128 * 4);
    L.part = take((size_t)MPAD * 8 * 128 * 4);
    L.hg_oin = take((size_t)hg::NUNIT * 64 * 128 * 2);
    L.hg_ds = take((size_t)hg::NUNIT * 128 * 128 * 2);
    L.hg_gam = take((size_t)hg::NUNIT * 128 * 4);
    L.hg_qh = take((size_t)NP * 1024 * 2);
    L.hg_sc = take((size_t)hg::NUNIT * 128 * 128 * 2);
    L.hA = take((size_t)MPAD * D * 2);
    L.hB = take((size_t)MPAD * D * 2);
    L.z = take((size_t)MPAD * ZW * 2);
    L.pooled = take((size_t)4 * MPAD * 256 * 2);
    L.cat = take((size_t)MPAD * D * 2);
    L.xa = take((size_t)MPAD * D * 4);
    L.xb = take((size_t)MPAD * D * 4);
    L.qry = take((size_t)MPAD * D * 4);
    L.eidx = take((size_t)MPAD * 128 * 2);
    L.gate = take((size_t)MPAD * 128 * 4);
    L.ab16 = take((size_t)MPAD * 128 * 2);
    L.end = o;
    return L;
}
static void fill_params(Params& p, void* const* d_in, void* d_out, void* d_ws) {
    const float** f = (const float**)&p;
    for (int i = 0; i < 24; ++i) f[i] = (const float*)d_in[i];
    p.out = (float*)d_out;
    const WsLayout L = ws_layout(); unsigned char* w = (unsigned char*)d_ws;
    p.bar = (unsigned*)(w + L.bar); p.modbuf = (float*)(w + L.modbuf); p.csil = (bf16_t*)(w + L.csil); p.wt_ada = (bf16_t*)(w + L.wt_ada); p.wt_in = (bf16_t*)(w + L.wt_in);
    p.wt_out = (bf16_t*)(w + L.wt_out); p.wt_q = (bf16_t*)(w + L.wt_q); p.wt_pool = (bf16_t*)(w + L.wt_pool); p.u8 = w + L.u8; p.v8 = w + L.v8; p.su = (float*)(w + L.su); p.sv = (float*)(w + L.sv); p.iscu = (float*)(w + L.iscu); p.part = (float*)(w + L.part); p.hg_oin = (bf16_t*)(w + L.hg_oin); p.hg_ds = (bf16_t*)(w + L.hg_ds); p.hg_gam = (float*)(w + L.hg_gam); p.hg_qh = (bf16_t*)(w + L.hg_qh); p.hg_sc = (bf16_t*)(w + L.hg_sc);
    p.hA = (bf16_t*)(w + L.hA); p.hB = (bf16_t*)(w + L.hB); p.z = (bf16_t*)(w + L.z); p.pooled = (bf16_t*)(w + L.pooled); p.cat = (bf16_t*)(w + L.cat);
    p.xa = (float*)(w + L.xa); p.xb = (float*)(w + L.xb); p.qry = (float*)(w + L.qry); p.eidx = (unsigned short*)(w + L.eidx); p.gate = (float*)(w + L.gate); p.ab16 = (bf16_t*)(w + L.ab16);
}

#ifndef HIPEMU
#ifndef MK_ONE_LAUNCH
#define MK_ONE_LAUNCH 1
#endif
extern "C" void kernel_launch(void* const* d_in, const int* in_sizes, int n_in, void* d_out, int out_size, void* d_ws, size_t ws_size, hipStream_t stream) {
    static int grid = 0;
    if (grid == 0) {
        const WsLayout L = ws_layout();
        if (n_in != 24 || (size_t)out_size != OUT_TOTAL || ws_size < L.end) { fprintf(stderr, "kernel_launch: unexpected shapes (n_in %d, out %d, ws %zu < %zu)\n", n_in, out_size, ws_size, L.end); grid = -1; return; }
        int dev = 0, cus = 0, per_cu = 0;
        hipGetDevice(&dev); hipDeviceGetAttribute(&cus, hipDeviceAttributeMultiprocessorCount, dev);
        if (hipFuncSetAttribute((const void*)mega_fwd, hipFuncAttributeMaxDynamicSharedMemorySize, LDS_BYTES) != hipSuccess) { fprintf(stderr, "kernel_launch: hipFuncSetAttribute failed\n"); grid = -1; return; }
        hipOccupancyMaxActiveBlocksPerMultiprocessor(&per_cu, (const void*)mega_fwd, 512, LDS_BYTES);
        (void)hipGetLastError();
        if (per_cu < 1) fprintf(stderr, "kernel_launch: occupancy query says %d blocks per CU\n", per_cu);
        grid = cus;
    }
    if (grid < 0) return;
    Params p{};
    fill_params(p, d_in, d_out, d_ws);
    hipMemsetAsync(p.bar, 0, 16384, stream);
#if MK_ONE_LAUNCH
    p.ph_lo = 0; p.ph_hi = N_PHASES;
    hipLaunchKernelGGL(mega_fwd, dim3(grid), dim3(512), LDS_BYTES, stream, p);
#else
    for (int ph = 0; ph < N_PHASES; ++ph) { p.ph_lo = ph; p.ph_hi = ph + 1; hipLaunchKernelGGL(mega_fwd, dim3(grid), dim3(512), LDS_BYTES, stream, p); }
#endif
}
#endif
```

```cpp
#ifndef HIPEMU
#include <hip/hip_runtime.h>
#include <cstdio>
#endif
#include <stdint.h>

#ifndef CFG_PB
#define CFG_PB 4
#define CFG_SEQ 2048
#define CFG_DB 128
#endif

#ifdef HIPEMU
#define DEV inline
#define LAS
#define READLANE_I(v, l) emu_readlane((v), (l))
#define READLANE_F(v, l) emu_readlane_f((v), (l))
#define MFMA_BF16(a, b, c) emu_mfma_bf16_16x16x32((a), (b), (c))
#define MFMA_F32(a, b, c) emu_mfma_f32_16x16x4((a), (b), (c))
#define __expf expf
#define __logf logf
#else
#define DEV __device__ __forceinline__
#define LAS __attribute__((address_space(3)))
#define READLANE_I(v, l) __builtin_amdgcn_readlane((v), (l))
#define READLANE_F(v, l) __uint_as_float((unsigned)__builtin_amdgcn_readlane((int)__float_as_uint(v), (l)))
#define MFMA_BF16(a, b, c) __builtin_amdgcn_mfma_f32_16x16x32_bf16((a), (b), (c), 0, 0, 0)
#define MFMA_F32(a, b, c) __builtin_amdgcn_mfma_f32_16x16x4f32((a), (b), (c), 0, 0, 0)
#endif

typedef unsigned short bf16_t;
typedef short bf16x8 __attribute__((ext_vector_type(8)));
typedef float f32x4 __attribute__((ext_vector_type(4)));
typedef unsigned u32x4 __attribute__((ext_vector_type(4)));
typedef unsigned u32x2 __attribute__((ext_vector_type(2)));

namespace cfg {
constexpr int D = 2048, PB = CFG_PB, SEQ = CFG_SEQ, DB = CFG_DB, DSEQ = 4;
constexpr int NP = PB * SEQ, NS = DB * DSEQ, NTOK = NP + NS, MPAD = (NTOK + 255) / 256 * 256;
constexpr int NC = PB + DB;
constexpr int HH = 8, HD = 128, PW = 1024, PBUF = 15, ZW = 5120;
constexpr int NE = 16384;
constexpr int NMOD = 6 * D;
constexpr int MODW = 2 * NMOD + 2 * D;
constexpr float EPS = 1e-6f;
constexpr int NCHAIN = PB * HH;
constexpr size_t OFF_Y = 0;
constexpr size_t OFF_HP = (size_t)NTOK * D;
constexpr size_t OFF_PP = OFF_HP + (size_t)2 * PB * HH * HD * HD;
constexpr size_t OFF_HS = OFF_PP + (size_t)2 * PB * PBUF * PW;
constexpr size_t OFF_PS = OFF_HS + (size_t)2 * DB * HH * HD * HD;
constexpr size_t OUT_TOTAL = OFF_PS + (size_t)2 * DB * PBUF * PW;
}
using namespace cfg;

struct Params {
    const float *x_prompt, *x_sample, *c_prompt, *c_sample, *state_hgrn, *state_pool, *w_ada, *b_ada, *norm1_g, *norm2_g, *w_in, *w_out,
        *lb_logits, *hgrn_norm_g, *pool_w, *pool_b, *pool_scale, *peer_wq, *peer_keys, *peer_u, *peer_v, *final_g, *w_ada_final, *b_ada_final;
    float* out;
    unsigned* bar; float* modbuf; bf16_t* csil; bf16_t* wt_ada; bf16_t* wt_in; bf16_t* wt_out; bf16_t* wt_q; bf16_t* wt_pool;
    unsigned char* u8; unsigned char* v8; float* su; float* sv; float* iscu; float* part; bf16_t* hg_oin; bf16_t* hg_ds; float* hg_gam; bf16_t* hg_qh; bf16_t* hg_sc; bf16_t* hA; bf16_t* hB; bf16_t* z; bf16_t* pooled; bf16_t* cat; float* xa; float* xb; float* qry; unsigned short* eidx; float* gate; bf16_t* ab16;
    int ph_lo, ph_hi;
};

DEV float bf2f(unsigned v) { return __uint_as_float(v << 16); }
#ifdef HIPEMU
DEV unsigned f2bf(float f) { unsigned u = __float_as_uint(f); u += 0x7fffu + ((u >> 16) & 1u); return u >> 16; }
DEV unsigned pack2(float lo, float hi) { return f2bf(lo) | (f2bf(hi) << 16); }
#else
typedef float f32x2_t __attribute__((ext_vector_type(2)));
typedef __bf16 bf16x2_t __attribute__((ext_vector_type(2)));
DEV unsigned pack2(float lo, float hi) { const f32x2_t v = {lo, hi}; return __builtin_bit_cast(unsigned, __builtin_convertvector(v, bf16x2_t)); }
DEV unsigned f2bf(float f) { return (unsigned)__builtin_bit_cast(unsigned short, (__bf16)f); }
#endif
DEV float lo16(unsigned w) { return __uint_as_float(w << 16); }
DEV float hi16(unsigned w) { return __uint_as_float(w & 0xffff0000u); }
DEV float wave_sum(float v) { v += __shfl_xor(v, 32); v += __shfl_xor(v, 16); v += __shfl_xor(v, 8); v += __shfl_xor(v, 4); v += __shfl_xor(v, 2); v += __shfl_xor(v, 1); return v; }
DEV float wave_max(float v) { v = fmaxf(v, __shfl_xor(v, 32)); v = fmaxf(v, __shfl_xor(v, 16)); v = fmaxf(v, __shfl_xor(v, 8)); v = fmaxf(v, __shfl_xor(v, 4)); v = fmaxf(v, __shfl_xor(v, 2)); v = fmaxf(v, __shfl_xor(v, 1)); return v; }
DEV float sigmoidf_(float x) { return 1.0f / (1.0f + __expf(-x)); }
DEV float siluf_(float x) { return x / (1.0f + __expf(-x)); }
DEV float gelu_erf(float x) { return 0.5f * x * (1.0f + erff(x * 0.70710678118f)); }
DEV int tok_batch(int t) { return t < NP ? t / SEQ : PB + (t - NP) / DSEQ; }


#ifdef HIPEMU
static inline unsigned emu_fp8_enc1(float x) {
    const unsigned sgn = x < 0.f ? 0x80u : 0u; float a = fabsf(x);
    if (!(a == a)) return 0x7fu;
    if (a >= 448.f) return sgn | 0x7eu;
    if (a < 0.015625f) { const int q = (int)rintf(a * 512.f); return sgn | (unsigned)q; }
    int e = (int)floorf(log2f(a)); if (ldexpf(1.f, e) > a) --e; if (ldexpf(1.f, e + 1) <= a) ++e;
    int m = (int)rintf((a / ldexpf(1.f, e) - 1.f) * 8.f); if (m == 8) { m = 0; ++e; }
    if (e > 8) return sgn | 0x7eu;
    return sgn | (unsigned)((e + 7) << 3) | (unsigned)m;
}
static inline float emu_fp8_dec1(unsigned b) { const float sg = (b & 0x80u) ? -1.f : 1.f; const int e = (b >> 3) & 15, m = b & 7; return sg * (e == 0 ? m * 0.001953125f : (1.f + m * 0.125f) * ldexpf(1.f, e - 7)); }
DEV unsigned fp8x4_enc(float a, float b, float c, float d) { return emu_fp8_enc1(a) | (emu_fp8_enc1(b) << 8) | (emu_fp8_enc1(c) << 16) | (emu_fp8_enc1(d) << 24); }
DEV void fp8x4_dec(unsigned w, float* o) { o[0] = emu_fp8_dec1(w & 255u); o[1] = emu_fp8_dec1((w >> 8) & 255u); o[2] = emu_fp8_dec1((w >> 16) & 255u); o[3] = emu_fp8_dec1(w >> 24); }
#define DPP_XOR1(v) __shfl((v), emu_lane() ^ 1)
#define DPP_XOR2(v) __shfl((v), emu_lane() ^ 2)
#define DPP_HMIRROR(v) __shfl((v), (emu_lane() & ~7) | (7 - (emu_lane() & 7)))
#define DPP_XOR8(v) __shfl((v), emu_lane() ^ 8)
#define DPP_RMIRROR(v) __shfl((v), (emu_lane() & ~15) | (15 - (emu_lane() & 15)))
#define WAVE_LDS_SYNC() emu_wbar()
DEV float xsum16(float a, float b) { const bool hi = (emu_lane() & 16) != 0; return (hi ? b : a) + __shfl_xor(hi ? a : b, 16); }
DEV float xsum32(float a, float b) { const bool hi = (emu_lane() & 32) != 0; return (hi ? b : a) + __shfl_xor(hi ? a : b, 32); }
#else
typedef float f32x2v_t __attribute__((ext_vector_type(2)));
DEV unsigned fp8x4_enc(float a, float b, float c, float d) { int r = __builtin_amdgcn_cvt_pk_fp8_f32(a, b, 0, false); r = __builtin_amdgcn_cvt_pk_fp8_f32(c, d, r, true); return (unsigned)r; }
DEV void fp8x4_dec(unsigned w, float* o) { const f32x2v_t lo = __builtin_amdgcn_cvt_pk_f32_fp8((int)w, false), hi = __builtin_amdgcn_cvt_pk_f32_fp8((int)w, true); o[0] = lo[0]; o[1] = lo[1]; o[2] = hi[0]; o[3] = hi[1]; }
template <int CTRL> DEV float dpp_f(float v) { return __uint_as_float((unsigned)__builtin_amdgcn_update_dpp(0, (int)__float_as_uint(v), CTRL, 0xf, 0xf, true)); }
#define DPP_XOR1(v) dpp_f<0xB1>(v)
#define DPP_XOR2(v) dpp_f<0x4E>(v)
#define DPP_HMIRROR(v) dpp_f<0x141>(v)
#define DPP_XOR8(v) dpp_f<0x128>(v)
#define DPP_RMIRROR(v) dpp_f<0x140>(v)
#define WAVE_LDS_SYNC() asm volatile("s_waitcnt lgkmcnt(0)" ::: "memory")
DEV float xsum16(float a, float b) { const u32x2 r = __builtin_amdgcn_permlane16_swap(__float_as_uint(a), __float_as_uint(b), false, false); return __uint_as_float(r[0]) + __uint_as_float(r[1]); }
DEV float xsum32(float a, float b) { const u32x2 r = __builtin_amdgcn_permlane32_swap(__float_as_uint(a), __float_as_uint(b), false, false); return __uint_as_float(r[0]) + __uint_as_float(r[1]); }
#endif
typedef float f32x2 __attribute__((ext_vector_type(2)));
#ifdef HIPEMU
DEV void fp8x4_dec2(unsigned w, f32x2& lo, f32x2& hi) { float o[4]; fp8x4_dec(w, o); lo = (f32x2){o[0], o[1]}; hi = (f32x2){o[2], o[3]}; }
#else
DEV void fp8x4_dec2(unsigned w, f32x2& lo, f32x2& hi) { lo = __builtin_amdgcn_cvt_pk_f32_fp8((int)w, false); hi = __builtin_amdgcn_cvt_pk_f32_fp8((int)w, true); }
#endif
DEV void fp8x16_dec2(u32x4 q, f32x2* o) { fp8x4_dec2(q.x, o[0], o[1]); fp8x4_dec2(q.y, o[2], o[3]); fp8x4_dec2(q.z, o[4], o[5]); fp8x4_dec2(q.w, o[6], o[7]); }

namespace pg8 {
constexpr int BM = 256, BK = 64, HALF = 128, HTB = HALF * BK * 2, STAGE_BYTES = 8 * HTB, NXCD = 8, WGM = 8;
DEV int lds_byte(int r, int c) { const int st = (r >> 4) * 2 + (c >> 5), rr = r & 15, cc = c & 31, ob = rr * 64 + cc * 2; return st * 1024 + (ob ^ (((ob >> 9) & 1) << 5)); }
DEV void stage_rc(int b, int& R, int& C) { const int st = b / 1024, sb = b % 1024, swz = sb ^ (((sb >> 9) & 1) << 5); R = (st >> 1) * 16 + swz / 64; C = (st & 1) * 32 + (swz % 64) / 2; }
DEV int perm32(int rho) { const int n = rho >> 4, i = rho & 15; return 8 * (i >> 2) + 4 * n + (i & 3); }
struct Unit { int pm, pn; };
struct Gemm { const bf16_t* A; const bf16_t* Bt; int M, N, K; };
struct StaticOrder {
    int nM, nN, nwg, G, c;
    DEV void init(int M, int N, int G_, int c_) { nM = M / BM; nN = N / BM; nwg = nM * nN; G = G_; c = c_; }
    DEV bool next(int i, Unit& u) const {
        const long L = (long)i * G + c; if (L >= nwg) return false;
        int wgid = (int)L; { const int q = nwg / NXCD, r = nwg % NXCD, xcd = wgid % NXCD, off = wgid / NXCD; wgid = (xcd < r ? xcd * (q + 1) : r * (q + 1) + (xcd - r) * q) + off; }
        const int nig = WGM * nN, gid = wgid / nig, fm = gid * WGM, gsz = (nM - fm) < WGM ? (nM - fm) : WGM;
        u.pm = fm + ((wgid % nig) % gsz); u.pn = (wgid % nig) / gsz; return true;
    }
    DEV void a_ready(const Unit&) const {}
    DEV void done(const Unit&) const {}
};
struct PoolOrder {
    int G, c;
    DEV bool next(int i, Unit& u) const { const int L = i * G + c; if (L >= 4 * (MPAD / 256)) return false; u.pm = L; u.pn = L / (MPAD / 256); return true; }
    DEV void a_ready(const Unit&) const {}
    DEV void done(const Unit&) const {}
};

struct EpiF32 {
    static constexpr bool PERM = false;
    float* C; int ldc;
    DEV void operator()(const f32x4 (&acc)[2][2][4][2], const Unit& u, int wr, int wc, int fr, int fq) const {
        const int row0 = u.pm * BM + wr * 64 + fr, col0 = u.pn * BM + wc * 32 + 4 * fq;
#pragma unroll
        for (int ai = 0; ai < 2; ++ai)
#pragma unroll
            for (int m = 0; m < 4; ++m) { float* rowp = C + (size_t)(row0 + ai * HALF + m * 16) * ldc + col0;
#pragma unroll
                for (int bj = 0; bj < 2; ++bj)
#pragma unroll
                    for (int n = 0; n < 2; ++n) *(f32x4*)(rowp + bj * HALF + n * 16) = acc[ai][bj][m][n]; }
    }
};
struct EpiAda {
    static constexpr bool PERM = false;
    float* C; const float* b_ada; const float* b_fin;
    DEV void operator()(const f32x4 (&acc)[2][2][4][2], const Unit& u, int wr, int wc, int fr, int fq) const {
        const int row0 = u.pm * BM + wr * 64 + fr, col0 = u.pn * BM + wc * 32 + 4 * fq;
        const float* bias = (u.pn * BM < 2 * NMOD) ? b_ada + col0 : b_fin + (col0 - 2 * NMOD);
        f32x4 bv[2][2];
#pragma unroll
        for (int bj = 0; bj < 2; ++bj)
#pragma unroll
            for (int n = 0; n < 2; ++n) bv[bj][n] = *(const f32x4*)(bias + bj * HALF + n * 16);
#pragma unroll
        for (int ai = 0; ai < 2; ++ai)
#pragma unroll
            for (int m = 0; m < 4; ++m) { float* rowp = C + (size_t)(row0 + ai * HALF + m * 16) * MODW + col0;
#pragma unroll
                for (int bj = 0; bj < 2; ++bj)
#pragma unroll
                    for (int n = 0; n < 2; ++n) *(f32x4*)(rowp + bj * HALF + n * 16) = acc[ai][bj][m][n] + bv[bj][n]; }
    }
};
struct EpiResid {
    static constexpr bool PERM = false;
    const float* xlo; const float* xhi; const float* gmod  ; float* out;
    DEV void operator()(const f32x4 (&acc)[2][2][4][2], const Unit& u, int wr, int wc, int fr, int fq) const {
        const int row0 = u.pm * BM + wr * 64 + fr, col0 = u.pn * BM + wc * 32 + 4 * fq;
#pragma unroll
        for (int ai = 0; ai < 2; ++ai)
#pragma unroll
            for (int m = 0; m < 4; ++m) {
                const int row = row0 + ai * HALF + m * 16;
                if (row < NTOK) {
                    const float* xr = (row < NP ? xlo + (size_t)row * D : xhi + (size_t)(row - NP) * D) + col0;
                    const float* gr = gmod + (size_t)tok_batch(row) * MODW + col0;
                    float* rowp = out + (size_t)row * D + col0;
#pragma unroll
                    for (int bj = 0; bj < 2; ++bj)
#pragma unroll
                        for (int n = 0; n < 2; ++n) { const f32x4 xv = *(const f32x4*)(xr + bj * HALF + n * 16), gv = *(const f32x4*)(gr + bj * HALF + n * 16);
                            *(f32x4*)(rowp + bj * HALF + n * 16) = xv + gv * acc[ai][bj][m][n]; }
                }
            }
    }
};
struct EpiBf16 {
    static constexpr bool PERM = true;
    bf16_t* O; int ldc;
    DEV void operator()(const f32x4 (&acc)[2][2][4][2], const Unit& u, int wr, int wc, int fr, int fq) const {
        const int row0 = u.pm * BM + wr * 64 + fr, col0 = u.pn * BM + wc * 32 + 8 * fq;
#pragma unroll
        for (int ai = 0; ai < 2; ++ai)
#pragma unroll
            for (int m = 0; m < 4; ++m) { bf16_t* rowp = O + (size_t)(row0 + ai * HALF + m * 16) * ldc + col0;
#pragma unroll
                for (int bj = 0; bj < 2; ++bj) { const f32x4 v0 = acc[ai][bj][m][0], v1 = acc[ai][bj][m][1];
                    u32x4 w; w.x = pack2(v0[0], v0[1]); w.y = pack2(v0[2], v0[3]); w.z = pack2(v1[0], v1[1]); w.w = pack2(v1[2], v1[3]);
                    *(u32x4*)(rowp + bj * HALF) = w; } }
    }
};
struct EpiPool {
    static constexpr bool PERM = true;
    bf16_t* cat; const float* pb; const float* ps;
    DEV void operator()(const f32x4 (&acc)[2][2][4][2], const Unit& u, int wr, int wc, int fr, int fq) const {
        const int g = u.pn, tok0 = u.pm * BM - g * MPAD + wr * 64 + fr, col0 = g * 256 + wc * 32 + 8 * fq;
#pragma unroll
        for (int bj = 0; bj < 2; ++bj) {
            const f32x4 b0 = *(const f32x4*)(pb + col0 + bj * HALF), b1 = *(const f32x4*)(pb + col0 + bj * HALF + 4);
            const f32x4 s0 = *(const f32x4*)(ps + col0 + bj * HALF), s1 = *(const f32x4*)(ps + col0 + bj * HALF + 4);
#pragma unroll
            for (int ai = 0; ai < 2; ++ai)
#pragma unroll
                for (int m = 0; m < 4; ++m) { const int tok = tok0 + ai * HALF + m * 16;
                    if (tok < NTOK) { const f32x4 v0 = (acc[ai][bj][m][0] + b0) * s0, v1 = (acc[ai][bj][m][1] + b1) * s1;
                        u32x4 w; w.x = pack2(v0[0], v0[1]); w.y = pack2(v0[2], v0[3]); w.z = pack2(v1[0], v1[1]); w.w = pack2(v1[2], v1[3]);
                        *(u32x4*)(cat + (size_t)tok * D + 1024 + col0 + bj * HALF) = w; } }
        }
    }
};

#ifdef HIPEMU
template <class Epi, class Sched>
static void gemm_phase(unsigned char*, const Gemm g, const Sched& S, const Epi& E) {
    const int tid = threadIdx.x, wid = tid >> 6, lane = tid & 63, wr = wid >> 2, wc = wid & 3, fr = lane & 15, fq = lane >> 4;
    Unit cur;
    for (int ui = 0; S.next(ui, cur); ++ui) {
        f32x4 acc[2][2][4][2];
        for (int ai = 0; ai < 2; ++ai) for (int bj = 0; bj < 2; ++bj) for (int m = 0; m < 4; ++m) for (int n = 0; n < 2; ++n) for (int j = 0; j < 4; ++j) {
            const int row = 256 * cur.pm + 128 * ai + 64 * wr + 16 * m + fr;
            const int col = Epi::PERM ? 256 * cur.pn + 128 * bj + 32 * wc + 8 * fq + 4 * n + j : 256 * cur.pn + 128 * bj + 32 * wc + 16 * n + 4 * fq + j;
            float s = 0.f;
            if ((row % emu_row_mod) < emu_row_limit) { const float* a = emu_f32_copy(g.A, (size_t)g.M * g.K) + (size_t)row * g.K; const float* b = emu_f32_copy(g.Bt, (size_t)g.N * g.K) + (size_t)col * g.K;
                for (int k = 0; k < g.K; ++k) s += a[k] * b[k]; }
            acc[ai][bj][m][n][j] = s; }
        E(acc, cur, wr, wc, fr, fq);
    }
    __syncthreads();
}
#else
template <class Epi, class Sched>
__device__ __forceinline__ void gemm_phase(LAS unsigned char* lds, const Gemm g, const Sched& S, const Epi& E) {
    const int tid = threadIdx.x, wid = __builtin_amdgcn_readfirstlane(tid >> 6), lane = tid & 63, wr = wid >> 2, wc = wid & 3, fr = lane & 15, fq = lane >> 4;
    int K = g.K; asm volatile("" : "+s"(K));
    const int nt = K / BK;
    unsigned voffA[2], voffB[2];
#pragma unroll
    for (int i = 0; i < 2; ++i) { int R, C; stage_rc(tid * 16 + i * 8192, R, C); const int Rb = Epi::PERM ? ((R & ~31) + perm32(R & 31)) : R;
        voffA[i] = (unsigned)(R * K + C) * 2u; voffB[i] = (unsigned)(Rb * K + C) * 2u; }
    const size_t kstep = (size_t)(BK * 2);
    const size_t hstep = (size_t)HALF * K * 2;
    const size_t tstep = 2 * hstep;
    const unsigned ldsw = (unsigned)wid * 1024u;
    const int aoff = lds_byte(wr * 64 + fr, fq * 8), boff = lds_byte(wc * 32 + fr, fq * 8);
#define PG8_SA(b, h) (((b) * 2 + (h)) * HTB)
#define PG8_SB(b, h) ((4 + (b) * 2 + (h)) * HTB)
#define PG8_STAGE(bufoff, gbase, voff) do { _Pragma("unroll") for (int _i = 0; _i < 2; ++_i) \
        __builtin_amdgcn_global_load_lds((const unsigned*)((const char*)(gbase) + (voff)[_i]), (LAS unsigned*)(lds + (bufoff) + ldsw + _i * 8192), 16, 0, 0); } while (0)
#define PG8_LDA(dst, b, h) do { _Pragma("unroll") for (int m = 0; m < 4; ++m) _Pragma("unroll") for (int k = 0; k < 2; ++k) dst[m][k] = *(const LAS bf16x8*)(lds + PG8_SA(b, h) + aoff + m * 2048 + k * 1024); } while (0)
#define PG8_LDB(dst, b, h) do { _Pragma("unroll") for (int n = 0; n < 2; ++n) _Pragma("unroll") for (int k = 0; k < 2; ++k) dst[n][k] = *(const LAS bf16x8*)(lds + PG8_SB(b, h) + boff + n * 2048 + k * 1024); } while (0)
#define PG8_MMA(ai, bj, At, Bt) do { __builtin_amdgcn_s_setprio(1); _Pragma("unroll") for (int m = 0; m < 4; ++m) _Pragma("unroll") for (int n = 0; n < 2; ++n) _Pragma("unroll") for (int k = 0; k < 2; ++k) \
        acc[ai][bj][m][n] = __builtin_amdgcn_mfma_f32_16x16x32_bf16(Bt[n][k], At[m][k], acc[ai][bj][m][n], 0, 0, 0); __builtin_amdgcn_s_setprio(0); } while (0)
#define PG8_WAIT_V(n) asm volatile("s_waitcnt vmcnt(" #n ")" ::: "memory")
#define PG8_WAIT_L(n) asm volatile("s_waitcnt lgkmcnt(" #n ")" ::: "memory")
#define PG8_BAR __builtin_amdgcn_s_barrier()
#define PG8_SCHED __builtin_amdgcn_sched_barrier(0)
    Unit cur, nxt; int ui = 0;
    if (!S.next(0, cur)) return;
    f32x4 acc[2][2][4][2];
#pragma unroll
    for (int a = 0; a < 2; ++a)
#pragma unroll
        for (int b = 0; b < 2; ++b)
#pragma unroll
            for (int m = 0; m < 4; ++m)
#pragma unroll
                for (int n = 0; n < 2; ++n) acc[a][b][m][n] = (f32x4){0.f, 0.f, 0.f, 0.f};
    bf16x8 At[4][2], B0[2][2], B1[2][2];
    const char* cA = (const char*)g.A + (size_t)cur.pm * tstep; const char* cB = (const char*)g.Bt + (size_t)cur.pn * tstep;
    S.a_ready(cur);
    PG8_STAGE(PG8_SB(0, 0), cB, voffB); PG8_STAGE(PG8_SA(0, 0), cA, voffA); PG8_STAGE(PG8_SB(0, 1), cB + hstep, voffB); PG8_STAGE(PG8_SA(0, 1), cA + hstep, voffA);
    if (wr == 1) PG8_BAR;
    PG8_WAIT_V(4); PG8_BAR;
    PG8_STAGE(PG8_SB(1, 0), cB + kstep, voffB); PG8_STAGE(PG8_SA(1, 0), cA + kstep, voffA); PG8_STAGE(PG8_SB(1, 1), cB + hstep + kstep, voffB);
    PG8_WAIT_V(6); PG8_BAR;
    for (;;) {
        const bool has_next = S.next(ui + 1, nxt);
        const char* nA = has_next ? (const char*)g.A + (size_t)nxt.pm * tstep : cA; const char* nB = has_next ? (const char*)g.Bt + (size_t)nxt.pn * tstep : cB;
        for (int t = 0; t < nt; t += 2) {
            const bool last = (t == nt - 2);
            const char* a1 = cA + (size_t)(t + 1) * kstep;
            const char* a2 = last ? nA : cA + (size_t)(t + 2) * kstep; const char* b2 = last ? nB : cB + (size_t)(t + 2) * kstep;
            const char* a3 = a2 + kstep; const char* b3 = b2 + kstep;
            if (last && has_next) S.a_ready(nxt);
            PG8_LDB(B0, 0, 0); PG8_SCHED; PG8_LDA(At, 0, 0); PG8_STAGE(PG8_SA(1, 1), a1 + hstep, voffA);
            PG8_WAIT_L(8); PG8_BAR; PG8_WAIT_L(0); PG8_MMA(0, 0, At, B0); PG8_BAR; PG8_SCHED;
            PG8_LDB(B1, 0, 1); PG8_STAGE(PG8_SB(0, 0), b2, voffB);
            PG8_BAR; PG8_WAIT_L(0); PG8_MMA(0, 1, At, B1); PG8_BAR;
            PG8_LDA(At, 0, 1); PG8_STAGE(PG8_SA(0, 0), a2, voffA);
            PG8_BAR; PG8_WAIT_L(0); PG8_MMA(1, 0, At, B0); PG8_BAR; PG8_SCHED;
            PG8_STAGE(PG8_SB(0, 1), b2 + hstep, voffB);
            PG8_WAIT_V(6); PG8_BAR; PG8_MMA(1, 1, At, B1); PG8_BAR;
            PG8_LDB(B0, 1, 0); PG8_SCHED; PG8_LDA(At, 1, 0); PG8_STAGE(PG8_SA(0, 1), a2 + hstep, voffA);
            PG8_WAIT_L(8); PG8_BAR; PG8_WAIT_L(0); PG8_MMA(0, 0, At, B0); PG8_BAR; PG8_SCHED;
            PG8_LDB(B1, 1, 1); PG8_STAGE(PG8_SB(1, 0), b3, voffB);
            PG8_BAR; PG8_WAIT_L(0); PG8_MMA(0, 1, At, B1); PG8_BAR;
            PG8_LDA(At, 1, 1); PG8_STAGE(PG8_SA(1, 0), a3, voffA);
            PG8_BAR; PG8_WAIT_L(0); PG8_MMA(1, 0, At, B0); PG8_BAR; PG8_SCHED;
            PG8_STAGE(PG8_SB(1, 1), b3 + hstep, voffB);
            PG8_WAIT_V(6); PG8_BAR; PG8_MMA(1, 1, At, B1); PG8_BAR;
        }
        { int tz = threadIdx.x; asm volatile("" : "+v"(tz)); const int wz = tz >> 6, lz = tz & 63;
          E(acc, cur, wz >> 2, wz & 3, lz & 15, lz >> 4); } S.done(cur);
        if (!has_next) break;
#pragma unroll
        for (int a = 0; a < 2; ++a)
#pragma unroll
            for (int b = 0; b < 2; ++b)
#pragma unroll
                for (int m = 0; m < 4; ++m)
#pragma unroll
                    for (int n = 0; n < 2; ++n) acc[a][b][m][n] = (f32x4){0.f, 0.f, 0.f, 0.f};
        cur = nxt; cA = nA; cB = nB; ++ui;
    }
    PG8_WAIT_V(0);
    if (wr == 0) PG8_BAR;
    PG8_BAR;
#undef PG8_SA
#undef PG8_SB
#undef PG8_STAGE
#undef PG8_LDA
#undef PG8_LDB
#undef PG8_MMA
#undef PG8_WAIT_V
#undef PG8_WAIT_L
#undef PG8_BAR
#undef PG8_SCHED
}
#endif
}

constexpr int MBIG = (NP / 256) * 256;
template <class F> DEV void small_gemm(const bf16_t* A, const bf16_t* Bt, int K, unsigned char* lds, const F& f) {
    const int tid = threadIdx.x, lane = tid & 63, w = tid >> 6, g = lane >> 4, c16 = lane & 15;
    const int tiles_m = (NTOK - MBIG + 63) / 64, ntiles = tiles_m * 32, kw = K / 8;
    float* part = (float*)lds;
    for (int tl = blockIdx.x; tl < ntiles; tl += gridDim.x) {
        const int r0 = MBIG + (tl / 32) * 64, n0 = (tl % 32) * 64;
        f32x4 acc[4][4];
#pragma unroll
        for (int i = 0; i < 4; ++i)
#pragma unroll
            for (int j = 0; j < 4; ++j) acc[i][j] = (f32x4){0.f, 0.f, 0.f, 0.f};
        for (int k0 = w * kw; k0 < (w + 1) * kw; k0 += 128) {
            bf16x8 af[4][4], bfr[4][4];
#pragma unroll
            for (int u = 0; u < 4; ++u)
#pragma unroll
                for (int i = 0; i < 4; ++i) { int arow = r0 + 16 * i + c16; if (arow >= MPAD) arow = MPAD - 1;
                    af[u][i] = *(const bf16x8*)(A + (size_t)arow * K + k0 + 32 * u + 8 * g); bfr[u][i] = *(const bf16x8*)(Bt + (size_t)(n0 + 16 * i + c16) * K + k0 + 32 * u + 8 * g); }
#pragma unroll
            for (int u = 0; u < 4; ++u)
#pragma unroll
                for (int i = 0; i < 4; ++i)
#pragma unroll
                    for (int j = 0; j < 4; ++j) acc[i][j] = MFMA_BF16(af[u][i], bfr[u][j], acc[i][j]);
        }
#pragma unroll
        for (int i = 0; i < 4; ++i)
#pragma unroll
            for (int j = 0; j < 4; ++j)
#pragma unroll
                for (int r = 0; r < 4; ++r) part[(w * 64 + 16 * i + 4 * g + r) * 68 + 16 * j + c16] = acc[i][j][r];
        __syncthreads();
        {
            const int row = tid >> 3, c8 = (tid & 7) * 8; f32x4 s0 = (f32x4){0.f, 0.f, 0.f, 0.f}, s1 = s0;
#pragma unroll
            for (int ww = 0; ww < 8; ++ww) { s0 += *(const f32x4*)(part + (ww * 64 + row) * 68 + c8); s1 += *(const f32x4*)(part + (ww * 64 + row) * 68 + c8 + 4); }
            if (r0 + row < NTOK) f(r0 + row, n0 + c8, s0, s1);
        }
        __syncthreads();
    }
}
struct SmallResid { const float* xlo; const float* xhi; const float* gmod; float* out;
    DEV void operator()(int row, int col, f32x4 v0, f32x4 v1) const { const float* xr = (row < NP ? xlo + (size_t)row * D : xhi + (size_t)(row - NP) * D) + col; const float* gr = gmod + (size_t)tok_batch(row) * MODW + col;
        float* o = out + (size_t)row * D + col; *(f32x4*)o = *(const f32x4*)xr + *(const f32x4*)gr * v0; *(f32x4*)(o + 4) = *(const f32x4*)(xr + 4) + *(const f32x4*)(gr + 4) * v1; } };
struct SmallF32 { float* out; DEV void operator()(int row, int col, f32x4 v0, f32x4 v1) const { float* o = out + (size_t)row * D + col; *(f32x4*)o = v0; *(f32x4*)(o + 4) = v1; } };

DEV void transpose_tile(const float* src, int ld_src, bf16_t* dst, int ld_dst, float* tile) {
    const int tid = threadIdx.x;
#pragma unroll
    for (int i = 0; i < 2; ++i) { const int idx = tid + i * 512, r = idx >> 4, c4 = idx & 15; const f32x4 v = *(const f32x4*)(src + (size_t)r * ld_src + c4 * 4);
        float* t = tile + r * 65 + c4 * 4; t[0] = v[0]; t[1] = v[1]; t[2] = v[2]; t[3] = v[3]; }
    __syncthreads();
    const int n = tid >> 3, kg = tid & 7; const float* t = tile + (kg * 8) * 65 + n;
    u32x4 w; w.x = pack2(t[0], t[65]); w.y = pack2(t[2 * 65], t[3 * 65]); w.z = pack2(t[4 * 65], t[5 * 65]); w.w = pack2(t[6 * 65], t[7 * 65]);
    *(u32x4*)(dst + (size_t)n * ld_dst + kg * 8) = w;
    __syncthreads();
}
DEV int cvt_job_tiles(int j) { const int K = j < 9 ? 2048 : 256; const int N = j < 2 ? NMOD : (j == 2 ? 2 * D : (j < 5 ? ZW : (j < 9 ? D : 256))); return (K / 64) * (N / 64); }
constexpr int TBL_SLOT = 10240, TBL_VP1 = 4 * NE - 2 * TBL_SLOT;
DEV int gemm_in_idle_blocks() { const int nwg = (MPAD / 256) * (ZW / 256), G = (int)gridDim.x, rounds = (nwg + G - 1) / G, full = nwg - (rounds - 1) * G; return G - full; }
DEV bool tbl_deferred() { return gemm_in_idle_blocks() >= 32; }
DEV void table_row_to_fp8(const Params& p, int vr, int lane) {
    const int l = vr / (2 * NE), which = (vr % (2 * NE)) / NE, e = vr % NE, rr = l * NE + e;
    const float* src = (which ? p.peer_v : p.peer_u) + (size_t)rr * D; unsigned char* tab = (which ? p.v8 : p.u8) + (size_t)l * NE * D;
    f32x4 v[8]; float am = 0.f;
#pragma unroll
    for (int k = 0; k < 8; ++k) { v[k] = *(const f32x4*)(src + 4 * lane + 256 * k); am = fmaxf(am, fmaxf(fmaxf(fabsf(v[k][0]), fabsf(v[k][1])), fmaxf(fabsf(v[k][2]), fabsf(v[k][3])))); }
    am = wave_max(am);
    const float sc = am > 0.f ? 224.0f / am : 1.0f;
#pragma unroll
    for (int k = 0; k < 8; ++k) *(unsigned*)(tab + ((size_t)(2 * k + (lane >> 5)) * NE + e) * 128 + 4 * (lane & 31)) = fp8x4_enc(v[k][0] * sc, v[k][1] * sc, v[k][2] * sc, v[k][3] * sc);
    if (lane == 0) (which ? p.sv : p.su)[rr] = am > 0.f ? am * (1.0f / 224.0f) : 1.0f;
}
DEV void phase_tbl_slot(const Params& p, int l) {
    const int idle = gemm_in_idle_blocks(), first = (int)gridDim.x - idle;
    if (idle < 32 || (int)blockIdx.x < first) return;
    const int gw = ((int)blockIdx.x - first) * 8 + (threadIdx.x >> 6), nw = idle * 8, lo = TBL_VP1 + l * TBL_SLOT;
    for (int vr = lo + gw; vr < lo + TBL_SLOT; vr += nw) table_row_to_fp8(p, vr, threadIdx.x & 63);
}
DEV void phase_convert(const Params& p, unsigned char* lds, int part) {
    float* tile = (float*)lds;
    const int tid = threadIdx.x;
    const int q_lo = part == 0 ? 0 : 3, q_hi = part == 0 ? 3 : 17;
    int total = 0;
#pragma unroll
    for (int q = 0; q < 17; ++q) if (q >= q_lo && q < q_hi) total += cvt_job_tiles(q);
    for (int tl = blockIdx.x; tl < total; tl += gridDim.x) {
        int j = 0, loc = 0, base = 0;
#pragma unroll
        for (int q = 0; q < 17; ++q) if (q >= q_lo && q < q_hi) { const int cnt = cvt_job_tiles(q); if (tl >= base && tl < base + cnt) { j = q; loc = tl - base; } base += cnt; }
        const float* src; bf16_t* dst; int K = 2048, N;
        if (j < 2) { N = NMOD; src = p.w_ada + (size_t)j * 2048 * NMOD; dst = p.wt_ada + (size_t)j * NMOD * 2048; }
        else if (j == 2) { N = 2 * D; src = p.w_ada_final; dst = p.wt_ada + (size_t)2 * NMOD * 2048; }
        else if (j < 5) { N = ZW; src = p.w_in + (size_t)(j - 3) * 2048 * ZW; dst = p.wt_in + (size_t)(j - 3) * ZW * 2048; }
        else if (j < 7) { N = D; src = p.w_out + (size_t)(j - 5) * D * D; dst = p.wt_out + (size_t)(j - 5) * D * D; }
        else if (j < 9) { N = D; src = p.peer_wq + (size_t)(j - 7) * D * D; dst = p.wt_q + (size_t)(j - 7) * D * D; }
        else { K = 256; N = 256; src = p.pool_w + (size_t)(j - 9) * 65536; dst = p.wt_pool + (size_t)(j - 9) * 65536; }
        const int ntn = N / 64, kt = loc / ntn, nt = loc % ntn;
        transpose_tile(src + (size_t)kt * 64 * N + nt * 64, N, dst + (size_t)nt * 64 * K + kt * 64, K, tile);
    }
    const size_t gt = (size_t)blockIdx.x * 512 + tid, gs = (size_t)gridDim.x * 512;
    if (part == 1) {
        constexpr int NADA = MODW / 256;
        const int vend = tbl_deferred() ? TBL_VP1 : 4 * NE, R1 = (vend / 8) * 7;
        const bool uneven = (int)gridDim.x > NADA + 16;
        for (int seg = 0; seg < 2; ++seg) {
            int gw, nw, r_lo, r_hi;
            if (!uneven) { if (seg) break; gw = blockIdx.x * 8 + (tid >> 6); nw = gridDim.x * 8; r_lo = 0; r_hi = vend; }
            else if (seg == 0) { gw = blockIdx.x * 8 + (tid >> 6); nw = gridDim.x * 8; r_lo = 0; r_hi = R1; }
            else { if ((int)blockIdx.x < NADA) break; gw = ((int)blockIdx.x - NADA) * 8 + (tid >> 6); nw = ((int)gridDim.x - NADA) * 8; r_lo = R1; r_hi = vend; }
            for (int vr = r_lo + gw; vr < r_hi; vr += nw) table_row_to_fp8(p, vr, tid & 63);
        }
    }
    if (part == 0) for (size_t i = gt; i < (size_t)256 * D / 8; i += gs) {
        const int row = (int)(i / (D / 8)), c8 = (int)(i % (D / 8)) * 8; u32x4 w = (u32x4){0u, 0u, 0u, 0u};
        if (row < NC) { const float* s = (row < PB ? p.c_prompt + (size_t)row * D : p.c_sample + (size_t)(row - PB) * D) + c8;
            const f32x4 a = *(const f32x4*)s, b = *(const f32x4*)(s + 4);
            w.x = pack2(siluf_(a[0]), siluf_(a[1])); w.y = pack2(siluf_(a[2]), siluf_(a[3])); w.z = pack2(siluf_(b[0]), siluf_(b[1])); w.w = pack2(siluf_(b[2]), siluf_(b[3])); }
        *(u32x4*)(p.csil + i * 8) = w;
    }
}

DEV void phase_norm(const Params& p, const float* xlo, const float* xhi, const float* gn, int sh_off, int sc_off, bf16_t* obf, float* of32) {
    const int lane = threadIdx.x & 63, gw = blockIdx.x * 8 + (threadIdx.x >> 6), nw = gridDim.x * 8;
    for (int t = gw; t < NTOK; t += nw) {
        const float* xr = t < NP ? xlo + (size_t)t * D : xhi + (size_t)(t - NP) * D;
        const float* mrow = p.modbuf + (size_t)tok_batch(t) * MODW;
        f32x4 v[8]; float ss = 0.f;
#pragma unroll
        for (int c = 0; c < 4; ++c) { const int col = c * 512 + lane * 8; v[2 * c] = *(const f32x4*)(xr + col); v[2 * c + 1] = *(const f32x4*)(xr + col + 4);
#pragma unroll
            for (int j = 0; j < 4; ++j) ss += v[2 * c][j] * v[2 * c][j] + v[2 * c + 1][j] * v[2 * c + 1][j]; }
        ss = wave_sum(ss);
        const float rstd = rsqrtf(ss * (1.0f / D) + EPS);
#pragma unroll
        for (int c = 0; c < 4; ++c) { const int col = c * 512 + lane * 8; f32x4 y[2];
#pragma unroll
            for (int q = 0; q < 2; ++q) { const f32x4 g4 = *(const f32x4*)(gn + col + 4 * q), sc = *(const f32x4*)(mrow + sc_off + col + 4 * q), sh = *(const f32x4*)(mrow + sh_off + col + 4 * q);
                y[q] = (v[2 * c + q] * rstd) * g4 * (sc + 1.0f) + sh; }
            if (obf) { u32x4 w; w.x = pack2(y[0][0], y[0][1]); w.y = pack2(y[0][2], y[0][3]); w.z = pack2(y[1][0], y[1][1]); w.w = pack2(y[1][2], y[1][3]); *(u32x4*)(obf + (size_t)t * D + col) = w; }
            else { *(f32x4*)(of32 + (size_t)t * D + col) = y[0]; *(f32x4*)(of32 + (size_t)t * D + col + 4) = y[1]; }
        }
    }
}

namespace hg {
constexpr int QS = 136, VS = 72;
constexpr int O_QT = 0, O_QH = O_QT + 64 * QS * 2, O_KT = O_QH + 64 * QS * 2, O_KDT = O_KT + 160 * QS * 2, O_VT = O_KDT + 128 * VS * 2,
              O_AB = O_VT + 128 * VS * 2, O_GS = O_AB + 64 * VS * 2, O_END = O_GS + 4 * 128 * 4;
constexpr int OS = 132;
static_assert(O_END <= 163840 - 64, "HGRN LDS layout too large");
constexpr int NCHUNK = SEQ / 64, NUNIT = PB * HH * NCHUNK;
}
DEV int kt_rowbase(int i) { return i == 0 ? 0 : (i == 1 ? 16 : (i == 2 ? 48 : 96)); }

DEV void hgrn_pre_unit(const Params& p, int l, int unit, unsigned char* lds) {
    using namespace hg;
    const int tid = threadIdx.x, lane = tid & 63, w = tid >> 6, g = lane >> 4, c16 = lane & 15;
    const int c = unit % NCHUNK, bh = unit / NCHUNK, b = bh / HH, h = bh % HH;
    bf16_t* Qt = (bf16_t*)(lds + O_QT); bf16_t* Qh = (bf16_t*)(lds + O_QH); bf16_t* Kt = (bf16_t*)(lds + O_KT);
    bf16_t* Kdt = (bf16_t*)(lds + O_KDT); bf16_t* Vt = (bf16_t*)(lds + O_VT); bf16_t* Ab = (bf16_t*)(lds + O_AB); float* Gs = (float*)(lds + O_GS);
    const int kk = tid & 127, sj = tid >> 7;
    float lbv = 0.f;
    if (l > 0) lbv = sigmoidf_(p.lb_logits[HH * HD + h * HD + kk] - p.lb_logits[h * HD + kk]);
    const float oml = 1.0f - lbv;
    for (int i = tid; i < 64 * VS / 2; i += 512) ((unsigned*)Ab)[i] = 0u;
    const size_t row0 = (size_t)b * SEQ + c * 64;
    float Gl[16], qv[16], kv[16];
    {
        const bf16_t* zr = p.z + (row0 + sj * 16) * ZW + h * HD + kk;
        unsigned short zq16[16], zf16[16], zi16[16];
#pragma unroll
        for (int s = 0; s < 16; ++s) { zq16[s] = zr[(size_t)s * ZW]; zf16[s] = zr[(size_t)s * ZW + 1024]; zi16[s] = zr[(size_t)s * ZW + 2048]; }
        float run = 0.f; unsigned vpk[8];
#pragma unroll
        for (int s = 0; s < 16; ++s) {
            const float zq = bf2f(zq16[s]), zf = fminf(fmaxf(bf2f(zf16[s]), -80.f), 80.f);
            const float e = __expf(-zf), sg = 1.0f / (1.0f + e);
            const float f = lbv + oml * sg;
            run += __logf(f); Gl[s] = run;
            kv[s] = oml * (e * sg);
            qv[s] = siluf_(zq);
            if (s & 1) vpk[s >> 1] |= (unsigned)zi16[s] << 16; else vpk[s >> 1] = zi16[s];
        }
        Gs[sj * 128 + kk] = run;
        *(u32x4*)(Vt + kk * VS + sj * 16) = (u32x4){vpk[0], vpk[1], vpk[2], vpk[3]}; *(u32x4*)(Vt + kk * VS + sj * 16 + 8) = (u32x4){vpk[4], vpk[5], vpk[6], vpk[7]};
    }
    __syncthreads();
    float Gend;
    {
        const float g0 = Gs[kk], g1 = Gs[128 + kk], g2 = Gs[256 + kk], g3 = Gs[384 + kk];
        float Gb[4]; Gb[0] = 0.f; Gb[1] = g0; Gb[2] = g0 + g1; Gb[3] = g0 + g1 + g2; Gend = Gb[3] + g3;
        const float Gbj = sj == 0 ? Gb[0] : (sj == 1 ? Gb[1] : (sj == 2 ? Gb[2] : Gb[3]));
        const float eGb = __expf(Gbj);
        unsigned kd[8]; unsigned qh[8];
#pragma unroll
        for (int s = 0; s < 16; ++s) {
            const int t = sj * 16 + s;
            const float q1 = qv[s] * __expf(Gl[s]);
            Qt[t * QS + kk] = (bf16_t)f2bf(q1);
            const unsigned qhv = f2bf(q1 * eGb);
            Qh[t * QS + kk] = (bf16_t)qhv;
#pragma unroll
            for (int i = 0; i < 4; ++i) if (i >= sj) Kt[(kt_rowbase(i) + t) * QS + kk] = (bf16_t)f2bf(kv[s] * __expf(fminf(Gb[i] - Gbj - Gl[s], 60.f)));
            const unsigned kdv = f2bf(kv[s] * __expf(Gend - Gbj - Gl[s]));
            if (s & 1) kd[s >> 1] |= kdv << 16; else kd[s >> 1] = kdv;
        }
        *(u32x4*)(Kdt + kk * VS + sj * 16) = (u32x4){kd[0], kd[1], kd[2], kd[3]}; *(u32x4*)(Kdt + kk * VS + sj * 16 + 8) = (u32x4){kd[4], kd[5], kd[6], kd[7]};
        if (sj == 0) p.hg_gam[(size_t)unit * HD + kk] = __expf(Gend);
    }
    __syncthreads();
    {
        const int t = tid >> 3, part = tid & 7;
        const u32x4 a = *(const u32x4*)(Qh + t * QS + 16 * part), b2 = *(const u32x4*)(Qh + t * QS + 16 * part + 8);
        bf16_t* dst = p.hg_qh + (row0 + t) * 1024 + h * HD + 16 * part; *(u32x4*)dst = a; *(u32x4*)(dst + 8) = b2;
    }
    for (int blk = w; blk < 10; blk += 8) {
        int bi, bjj;
        if (blk == 0) { bi = 0; bjj = 0; } else if (blk < 3) { bi = 1; bjj = blk - 1; } else if (blk < 6) { bi = 2; bjj = blk - 3; } else { bi = 3; bjj = blk - 6; }
        f32x4 acc = (f32x4){0.f, 0.f, 0.f, 0.f};
#pragma unroll
        for (int ks = 0; ks < 4; ++ks) {
            const bf16x8 a = *(const bf16x8*)(Qt + (16 * bi + c16) * QS + 32 * ks + 8 * g);
            const bf16x8 bb = *(const bf16x8*)(Kt + (kt_rowbase(bi) + 16 * bjj + c16) * QS + 32 * ks + 8 * g);
            acc = MFMA_BF16(a, bb, acc);
        }
#pragma unroll
        for (int r = 0; r < 4; ++r) { const int tl = 4 * g + r; float v = acc[r]; if (bi == bjj && c16 > tl) v = 0.f; Ab[(16 * bi + tl) * VS + 16 * bjj + c16] = (bf16_t)f2bf(v); }
    }
    __syncthreads();
    {
        u32x2* oin = (u32x2*)(p.hg_oin + (size_t)unit * 64 * 128);
#pragma unroll
        for (int tt = 0; tt < 4; ++tt) {
            f32x4 acc = (f32x4){0.f, 0.f, 0.f, 0.f};
#pragma unroll
            for (int ks = 0; ks < 2; ++ks) {
                const bf16x8 a = *(const bf16x8*)(Ab + (16 * tt + c16) * VS + 32 * ks + 8 * g);
                const bf16x8 bb = *(const bf16x8*)(Vt + (16 * w + c16) * VS + 32 * ks + 8 * g);
                acc = MFMA_BF16(a, bb, acc);
            }
            oin[(tt * 8 + w) * 64 + lane] = (u32x2){pack2(acc[0], acc[1]), pack2(acc[2], acc[3])};
        }
        u32x2* ds = (u32x2*)(p.hg_ds + (size_t)unit * 128 * 128);
#pragma unroll
        for (int vt = 0; vt < 8; ++vt) {
            f32x4 acc = (f32x4){0.f, 0.f, 0.f, 0.f};
#pragma unroll
            for (int ks = 0; ks < 2; ++ks) {
                const bf16x8 a = *(const bf16x8*)(Kdt + (16 * w + c16) * VS + 32 * ks + 8 * g);
                const bf16x8 bb = *(const bf16x8*)(Vt + (16 * vt + c16) * VS + 32 * ks + 8 * g);
                acc = MFMA_BF16(a, bb, acc);
            }
            ds[(w * 8 + vt) * 64 + lane] = (u32x2){pack2(acc[0], acc[1]), pack2(acc[2], acc[3])};
        }
    }
    __syncthreads();
}

DEV void hgrn_scan_unit(const Params& p, int l, int su) {
    using namespace hg;
    const int tid = threadIdx.x, lane = tid & 63, w = tid >> 6, g = lane >> 4, c16 = lane & 15;
    const int vt = su % 8, bh = su / 8, b = bh / HH, h = bh % HH;
    f32x4 S = (f32x4){0.f, 0.f, 0.f, 0.f};
    constexpr int CB = NCHUNK < 16 ? NCHUNK : 16;
    static_assert(NCHUNK % CB == 0, "chunk batch");
    for (int c0 = 0; c0 < NCHUNK; c0 += CB) {
        u32x2 dw[CB]; f32x4 gm[CB];
#pragma unroll
        for (int i = 0; i < CB; ++i) { const size_t unit = (size_t)bh * NCHUNK + c0 + i;
            dw[i] = ((const u32x2*)(p.hg_ds + unit * 128 * 128))[(w * 8 + vt) * 64 + lane]; gm[i] = *(const f32x4*)(p.hg_gam + unit * HD + 16 * w + 4 * g); }
#pragma unroll
        for (int i = 0; i < CB; ++i) { const size_t unit = (size_t)bh * NCHUNK + c0 + i;
            u32x2 sw; sw.x = pack2(S[0], S[1]); sw.y = pack2(S[2], S[3]);
            *(u32x2*)(p.hg_sc + (unit * 128 + 16 * vt + c16) * 128 + 16 * w + 4 * g) = sw;
            const f32x4 d = (f32x4){lo16(dw[i].x), hi16(dw[i].x), lo16(dw[i].y), hi16(dw[i].y)};
            S = S * gm[i] + d; }
    }
    float* so = p.out + OFF_HP + ((size_t)(l * PB + b) * HH + h) * HD * HD;
#pragma unroll
    for (int r = 0; r < 4; ++r) so[(size_t)(16 * w + 4 * g + r) * HD + 16 * vt + c16] = S[r];
}

DEV void hgrn_post_unit(const Params& p, int l, int unit, unsigned char* lds) {
    using namespace hg;
    const int tid = threadIdx.x, lane = tid & 63, w = tid >> 6, g = lane >> 4, c16 = lane & 15;
    const int c = unit % NCHUNK, bh = unit / NCHUNK, b = bh / HH, h = bh % HH;
    float* Ob = (float*)lds;
    const size_t row0 = (size_t)b * SEQ + c * 64;
    const u32x2* oin = (const u32x2*)(p.hg_oin + (size_t)unit * 64 * 128);
    u32x2 ow[4];
#pragma unroll
    for (int tt = 0; tt < 4; ++tt) ow[tt] = oin[(tt * 8 + w) * 64 + lane];
    bf16x8 bfr[4], af[4][4];
    if (c > 0) {
#pragma unroll
        for (int ks = 0; ks < 4; ++ks) bfr[ks] = *(const bf16x8*)(p.hg_sc + ((size_t)unit * 128 + 16 * w + c16) * 128 + 32 * ks + 8 * g);
#pragma unroll
        for (int tt = 0; tt < 4; ++tt)
#pragma unroll
            for (int ks = 0; ks < 4; ++ks) af[tt][ks] = *(const bf16x8*)(p.hg_qh + (row0 + 16 * tt + c16) * 1024 + h * HD + 32 * ks + 8 * g);
    }
    const bf16_t* zgp = p.z + (row0 + (tid >> 3)) * ZW + 3072 + h * HD + 16 * (tid & 7);
    const u32x4 za = *(const u32x4*)zgp, zc = *(const u32x4*)(zgp + 8);
    f32x4 acc[4];
#pragma unroll
    for (int tt = 0; tt < 4; ++tt) acc[tt] = (f32x4){lo16(ow[tt].x), hi16(ow[tt].x), lo16(ow[tt].y), hi16(ow[tt].y)};
    if (c > 0) {
#pragma unroll
        for (int tt = 0; tt < 4; ++tt)
#pragma unroll
            for (int ks = 0; ks < 4; ++ks) acc[tt] = MFMA_BF16(af[tt][ks], bfr[ks], acc[tt]);
    }
#pragma unroll
    for (int tt = 0; tt < 4; ++tt)
#pragma unroll
        for (int r = 0; r < 4; ++r) Ob[(16 * tt + 4 * g + r) * OS + 16 * w + c16] = acc[tt][r];
    __syncthreads();
    {
        const int t = tid >> 3, part = tid & 7; const size_t row = row0 + t;
        float ov[16]; float ss = 0.f;
#pragma unroll
        for (int q = 0; q < 4; ++q) { const f32x4 x = *(const f32x4*)(Ob + t * OS + 16 * part + 4 * q); ov[4 * q] = x[0]; ov[4 * q + 1] = x[1]; ov[4 * q + 2] = x[2]; ov[4 * q + 3] = x[3];
            ss += x[0] * x[0] + x[1] * x[1] + x[2] * x[2] + x[3] * x[3]; }
        ss += __shfl_xor(ss, 1); ss += __shfl_xor(ss, 2); ss += __shfl_xor(ss, 4);
        const float rstd = rsqrtf(ss * (1.0f / HD) + EPS);
        const unsigned zw[8] = {za.x, za.y, za.z, za.w, zc.x, zc.y, zc.z, zc.w};
        const float* gn = p.hgrn_norm_g + l * HD + 16 * part;
        unsigned ow[8];
#pragma unroll
        for (int q = 0; q < 8; ++q) { const float a0 = ov[2 * q] * rstd * gn[2 * q] * siluf_(lo16(zw[q])), a1 = ov[2 * q + 1] * rstd * gn[2 * q + 1] * siluf_(hi16(zw[q])); ow[q] = pack2(a0, a1); }
        bf16_t* dst = p.cat + row * D + h * HD + 16 * part;
        *(u32x4*)dst = (u32x4){ow[0], ow[1], ow[2], ow[3]}; *(u32x4*)(dst + 8) = (u32x4){ow[4], ow[5], ow[6], ow[7]};
    }
    __syncthreads();
}

DEV void hgrn_sample_unit(const Params& p, int l, int unit, unsigned char* lds) {
    const int tid = threadIdx.x, lane = tid & 63, w = tid >> 6;
    const int b = unit / HH, h = unit % HH;
    float* fS = (float*)lds; float* kS = fS + 512; float* qS = kS + 512; float* vS = qS + 512; float* red = vS + 512; float* part = red + 4 * 4 * 128;
    const int r0 = NP + b * DSEQ;
    {
        const int t = tid >> 7, kk = tid & 127; const bf16_t* zr = p.z + (size_t)(r0 + t) * ZW + h * HD + kk;
        float lbv = 0.f; if (l > 0) lbv = sigmoidf_(p.lb_logits[HH * HD + h * HD + kk] - p.lb_logits[h * HD + kk]);
        const float zq = bf2f(zr[0]), zf = fminf(fmaxf(bf2f(zr[1024]), -80.f), 80.f), zi = bf2f(zr[2048]);
        const float e = __expf(-zf), sg = 1.0f / (1.0f + e);
        fS[tid] = lbv + (1.0f - lbv) * sg; kS[tid] = (1.0f - lbv) * (e * sg); qS[tid] = siluf_(zq); vS[tid] = zi;
    }
    const int v = tid & 127, kq = tid >> 7;
    const float* s0 = p.state_hgrn + ((size_t)(l * DB + b) * HH + h) * HD * HD + (size_t)(32 * kq) * HD + v;
    float S[32];
#pragma unroll
    for (int i = 0; i < 32; ++i) S[i] = s0[(size_t)i * HD];
    __syncthreads();
#pragma unroll
    for (int t = 0; t < 4; ++t) {
        const float vv = vS[t * 128 + v]; float po = 0.f;
#pragma unroll
        for (int i = 0; i < 32; ++i) { const int kk = t * 128 + 32 * kq + i; S[i] = fS[kk] * S[i] + kS[kk] * vv; po += qS[kk] * S[i]; }
        red[(t * 4 + kq) * 128 + v] = po;
    }
    float* so = p.out + OFF_HS + ((size_t)(l * DB + b) * HH + h) * HD * HD + (size_t)(32 * kq) * HD + v;
#pragma unroll
    for (int i = 0; i < 32; ++i) so[(size_t)i * HD] = S[i];
    __syncthreads();
    {
        const int t = tid >> 7; const float o = red[(t * 4 + 0) * 128 + v] + red[(t * 4 + 1) * 128 + v] + red[(t * 4 + 2) * 128 + v] + red[(t * 4 + 3) * 128 + v];
        const float ss = wave_sum(o * o);
        if (lane == 0) part[w] = ss;
        __syncthreads();
        const float tot = part[2 * t] + part[2 * t + 1];
        const float rstd = rsqrtf(tot * (1.0f / HD) + EPS);
        const float zg = bf2f(p.z[(size_t)(r0 + t) * ZW + 3072 + h * HD + v]);
        p.cat[(size_t)(r0 + t) * D + h * HD + v] = (bf16_t)f2bf(o * rstd * p.hgrn_norm_g[l * HD + v] * siluf_(zg));
    }
    __syncthreads();
}

DEV void pool_pre_unit(const Params& p, int l, int unit) {
    const int tid = threadIdx.x, tk = tid >> 7, cg = tid & 127, c = cg * 8, gi = cg >> 5, wnd = 2 << gi;
    const int r = unit * 4 + tk;
    if (r >= NTOK) return;
    f32x2 sum[4] = {{0.f, 0.f}, {0.f, 0.f}, {0.f, 0.f}, {0.f, 0.f}}; float cur[8];
    float cnt;
    if (r < NP) {
        const int t = r % SEQ; const int n = (wnd < t + 1) ? wnd : (t + 1); cnt = (float)n;
        u32x4 q[16];
#pragma unroll
        for (int j = 0; j < 16; ++j) q[j] = (j < n) ? *(const u32x4*)(p.z + (size_t)(r - j) * ZW + 4096 + c) : (u32x4){0u, 0u, 0u, 0u};
#pragma unroll
        for (int j = 0; j < 16; ++j) { sum[0] += (f32x2){lo16(q[j].x), hi16(q[j].x)}; sum[1] += (f32x2){lo16(q[j].y), hi16(q[j].y)}; sum[2] += (f32x2){lo16(q[j].z), hi16(q[j].z)}; sum[3] += (f32x2){lo16(q[j].w), hi16(q[j].w)}; }
        cur[0] = lo16(q[0].x); cur[1] = hi16(q[0].x); cur[2] = lo16(q[0].y); cur[3] = hi16(q[0].y); cur[4] = lo16(q[0].z); cur[5] = hi16(q[0].z); cur[6] = lo16(q[0].w); cur[7] = hi16(q[0].w);
        if (t >= SEQ - PBUF) { float* o = p.out + OFF_PP + ((size_t)(l * PB + r / SEQ) * PBUF + (t - (SEQ - PBUF))) * PW + c;
            *(f32x4*)o = (f32x4){cur[0], cur[1], cur[2], cur[3]}; *(f32x4*)(o + 4) = (f32x4){cur[4], cur[5], cur[6], cur[7]}; }
    } else {
        const int bb = (r - NP) / DSEQ, t = (r - NP) % DSEQ; cnt = (float)wnd;
        const float* sp = p.state_pool + (size_t)(l * DB + bb) * PBUF * PW + c;
        u32x4 q[4]; f32x4 sa[15], sb[15];
#pragma unroll
        for (int j = 0; j < 4; ++j) q[j] = (j <= t && j < wnd) ? *(const u32x4*)(p.z + (size_t)(NP + bb * DSEQ + t - j) * ZW + 4096 + c) : (u32x4){0u, 0u, 0u, 0u};
#pragma unroll
        for (int j = 1; j < 16; ++j) {
            const int back = j - t;
            const bool use = (back >= 1) && (j < wnd);
            const float* srow = sp + (size_t)(PBUF - (use ? back : 1)) * PW;
            sa[j - 1] = use ? *(const f32x4*)srow : (f32x4){0.f, 0.f, 0.f, 0.f}; sb[j - 1] = use ? *(const f32x4*)(srow + 4) : (f32x4){0.f, 0.f, 0.f, 0.f};
        }
#pragma unroll
        for (int j = 0; j < 4; ++j) { sum[0] += (f32x2){lo16(q[j].x), hi16(q[j].x)}; sum[1] += (f32x2){lo16(q[j].y), hi16(q[j].y)}; sum[2] += (f32x2){lo16(q[j].z), hi16(q[j].z)}; sum[3] += (f32x2){lo16(q[j].w), hi16(q[j].w)}; }
#pragma unroll
        for (int j = 0; j < 15; ++j) { sum[0] += (f32x2){sa[j][0], sa[j][1]}; sum[1] += (f32x2){sa[j][2], sa[j][3]}; sum[2] += (f32x2){sb[j][0], sb[j][1]}; sum[3] += (f32x2){sb[j][2], sb[j][3]}; }
        cur[0] = lo16(q[0].x); cur[1] = hi16(q[0].x); cur[2] = lo16(q[0].y); cur[3] = hi16(q[0].y); cur[4] = lo16(q[0].z); cur[5] = hi16(q[0].z); cur[6] = lo16(q[0].w); cur[7] = hi16(q[0].w);
        float* ob = p.out + OFF_PS + (size_t)(l * DB + bb) * PBUF * PW + c;
        { float* o = ob + (size_t)(11 + t) * PW; *(f32x4*)o = (f32x4){cur[0], cur[1], cur[2], cur[3]}; *(f32x4*)(o + 4) = (f32x4){cur[4], cur[5], cur[6], cur[7]}; }
        for (int i = t; i < 11; i += 4) { const float* s2 = sp + (size_t)(4 + i) * PW; float* o = ob + (size_t)i * PW; *(f32x4*)o = *(const f32x4*)s2; *(f32x4*)(o + 4) = *(const f32x4*)(s2 + 4); }
    }
    const float inv = 1.0f / cnt;
    u32x4 w; w.x = pack2(sum[0][0] * inv - cur[0], sum[0][1] * inv - cur[1]); w.y = pack2(sum[1][0] * inv - cur[2], sum[1][1] * inv - cur[3]);
    w.z = pack2(sum[2][0] * inv - cur[4], sum[2][1] * inv - cur[5]); w.w = pack2(sum[3][0] * inv - cur[6], sum[3][1] * inv - cur[7]);
    *(u32x4*)(p.pooled + ((size_t)gi * MPAD + r) * 256 + (c & 255)) = w;
}

#ifndef PROBE_SUB
#define PROBE_SUB 0
#endif
DEV void phase_mix1(const Params& p, int l, unsigned char* lds) {
    for (int rep = 0; rep < (PROBE_SUB == 1 ? 2 : 1); ++rep) for (int u = blockIdx.x; u < hg::NUNIT; u += gridDim.x) hgrn_pre_unit(p, l, u, lds);
    for (int rep = 0; rep < (PROBE_SUB == 2 ? 2 : 1); ++rep) for (int u = blockIdx.x; u < DB * HH; u += gridDim.x) hgrn_sample_unit(p, l, u, lds);
    for (int rep = 0; rep < (PROBE_SUB == 3 ? 2 : 1); ++rep) for (int u = blockIdx.x; u < (NTOK + 3) / 4; u += gridDim.x) pool_pre_unit(p, l, u);
}
DEV void phase_mix2(const Params& p, int l) { for (int u = blockIdx.x; u < PB * HH * 8; u += gridDim.x) hgrn_scan_unit(p, l, u); }
DEV void phase_mix3(const Params& p, int l, unsigned char* lds) { for (int u = blockIdx.x; u < hg::NUNIT; u += gridDim.x) hgrn_post_unit(p, l, u, lds); }

#ifdef HIPEMU
#define MBCNT(mask) __builtin_popcountll((mask) & ((1ull << emu_lane()) - 1ull))
#define POPC64(m) __builtin_popcountll(m)
#else
#define MBCNT(mask) ((int)__builtin_amdgcn_mbcnt_hi((unsigned)((mask) >> 32), __builtin_amdgcn_mbcnt_lo((unsigned)(mask), 0u)))
#define POPC64(m) __popcll(m)
#endif
DEV unsigned fkey(float f) { const unsigned u = __float_as_uint(f); return u ^ ((unsigned)((int)u >> 31) | 0x80000000u); }
DEV unsigned long long lowest_n_bits(unsigned long long m, int n) { unsigned long long r = 0ull; while (n > 0 && m) { const unsigned long long b = m & (~m + 1ull); r |= b; m ^= b; --n; } return r; }
#ifdef HIPEMU
#define DPPU_XOR1(v) __shfl((v), emu_lane() ^ 1)
#define DPPU_XOR2(v) __shfl((v), emu_lane() ^ 2)
#define DPPU_HMIRROR(v) __shfl((v), (emu_lane() & ~7) | (7 - (emu_lane() & 7)))
#else
template <int CTRL> DEV unsigned dpp_u(unsigned v) { return (unsigned)__builtin_amdgcn_update_dpp(0, (int)v, CTRL, 0xf, 0xf, true); }
#define DPPU_XOR1(v) dpp_u<0xB1>(v)
#define DPPU_XOR2(v) dpp_u<0x4E>(v)
#define DPPU_HMIRROR(v) dpp_u<0x141>(v)
#endif
template <int GL> DEV unsigned group_sum(unsigned c) { c += DPPU_XOR1(c); c += DPPU_XOR2(c); if (GL == 8) c += DPPU_HMIRROR(c); return c; }
template <int GL> DEV unsigned group_or(unsigned c) { c |= DPPU_XOR1(c); c |= DPPU_XOR2(c); if (GL == 8) c |= DPPU_HMIRROR(c); return c; }
template <int GL> DEV float group_maxf(float v) { v = fmaxf(v, DPP_XOR1(v)); v = fmaxf(v, DPP_XOR2(v)); if (GL == 8) v = fmaxf(v, DPP_HMIRROR(v)); return v; }
template <int GL> DEV float group_sumf(float v) { v += DPP_XOR1(v); v += DPP_XOR2(v); if (GL == 8) v += DPP_HMIRROR(v); return v; }
DEV unsigned bytesum(unsigned w) { return (w * 0x01010101u) >> 24; }
template <int GL> DEV unsigned group_excl_prefix(unsigned c, int sub) {
    const unsigned sh = 8u * (unsigned)(sub & 3);
    unsigned wlo = (GL == 4 || sub < 4) ? (c << sh) : 0u, whi = (GL == 8 && sub >= 4) ? (c << sh) : 0u;
    wlo = group_or<GL>(wlo);
    unsigned r;
    if (GL == 4) r = bytesum(wlo & ((1u << sh) - 1u));
    else { whi = group_or<GL>(whi); r = sub < 4 ? bytesum(wlo & ((1u << sh) - 1u)) : bytesum(wlo) + bytesum(whi & ((1u << sh) - 1u)); }
    return r;
}
DEV float fkey_inv(unsigned k) { return __uint_as_float((k & 0x80000000u) ? (k ^ 0x80000000u) : ~k); }
template <int NK> DEV unsigned count_above(const unsigned (&k)[NK], unsigned t) {
    unsigned c[4] = {0u, 0u, 0u, 0u};
#pragma unroll
    for (int i = 0; i < NK; ++i) c[i & 3] += (k[i] > t) ? 1u : 0u;
    return (c[0] + c[1]) + (c[2] + c[3]);
}
template <int GL, int NK> DEV unsigned group_top16(const unsigned (&k)[NK], bool active, int sub, unsigned& pos0) {
    unsigned mxk = 0u;
#pragma unroll
    for (int i = 0; i < NK; ++i) mxk = k[i] > mxk ? k[i] : mxk;
    { unsigned o = DPPU_XOR1(mxk); mxk = o > mxk ? o : mxk; o = DPPU_XOR2(mxk); mxk = o > mxk ? o : mxk; if (GL == 8) { o = DPPU_HMIRROR(mxk); mxk = o > mxk ? o : mxk; } }
    unsigned L0 = mxk > 0x01000000u ? mxk - 0x01000000u : 0u, c0 = group_sum<GL>(count_above<NK>(k, L0));
    unsigned L = c0 > 16u ? L0 + 1u : 0u, R = active ? mxk : 0u, cR = 0u;
    if (!active) L = 0u;
    if (c0 == 16u && active) { L = L0; R = L0; cR = 16u; }
    for (;;) {
        if (__ballot(L < R) == 0ull) break;
        const unsigned mid = L + ((R - L) >> 1);
        const unsigned c = group_sum<GL>(count_above<NK>(k, mid));
        const bool le = c <= 16u, hit = c == 16u;
        R = le ? mid : R; cR = le ? c : cR; L = hit ? mid : (le ? L : mid + 1u);
    }
    unsigned mask = 0u;
#pragma unroll
    for (int i = 0; i < NK; ++i) mask |= (k[i] > R) ? (1u << i) : 0u;
    const unsigned need = 16u - cR;
    if (__ballot(active && need > 0u) != 0ull) {
        unsigned eqm = 0u;
#pragma unroll
        for (int i = 0; i < NK; ++i) eqm |= (k[i] == R) ? (1u << i) : 0u;
        const unsigned eqc = (unsigned)__builtin_popcount(eqm), before = group_excl_prefix<GL>(eqc, sub);
        unsigned take = need > before ? need - before : 0u; if (take > eqc) take = eqc;
        if (!active) take = 0u;
        while (take > 0u) { const unsigned b = eqm & (~eqm + 1u); mask |= b; eqm ^= b; --take; }
    }
    if (!active) mask = 0u;
    pos0 = group_excl_prefix<GL>((unsigned)__builtin_popcount(mask), sub);
    return mask;
}
#ifdef HIPEMU
template <int J> DEV unsigned row_bcast_u(unsigned v) { return __shfl(v, (emu_lane() & ~15) | J); }
#else
template <int J> DEV unsigned row_bcast_u(unsigned v) { return (unsigned)__builtin_amdgcn_update_dpp(0, (int)v, 0x150 + J, 0xf, 0xf, true); }
#endif
template <int J> struct RowRank { static DEV unsigned run(unsigned v, int l16) { const unsigned b = row_bcast_u<J>(v); return (((b > v) || (b == v && J < l16)) ? 1u : 0u) + RowRank<J - 1>::run(v, l16); } };
template <> struct RowRank<-1> { static DEV unsigned run(unsigned, int) { return 0u; } };
struct CandTab { unsigned char ij[56]; };
DEV CandTab make_cand_tab() { CandTab t{}; int n = 0; for (int i = 0; i < 16; ++i) for (int j = 0; j < 16 / (i + 1); ++j) t.ij[n++] = (unsigned char)(i * 16 + j); for (; n < 56; ++n) t.ij[n] = 255; return t; }
constexpr int SEL_NT = 4;
constexpr int SEL_RS = 144;
DEV void select_step(const Params& p, int l, int tt0, int tstride, int ntile, int h, unsigned char* lds, const bf16x8 (&kh)[2][4], const bf16x8 (&kl)[2][4]) {
    const int tid = threadIdx.x, lane = tid & 63, w = tid >> 6, g = lane >> 4, c16 = lane & 15;
    constexpr int NTK = SEL_NT * 16;
    constexpr int QRS = 264;
    bf16_t* qh = (bf16_t*)lds;
    bf16_t* ql = qh + NTK * QRS;
    float* sc = (float*)(ql + NTK * QRS);
    float* ts = sc + 2 * NTK * SEL_RS;
    int* ti = (int*)(ts + 2 * NTK * 16);
    unsigned char* ctab = (unsigned char*)(ti + 2 * NTK * 16);
    if (tid == 0) { const CandTab t = make_cand_tab(); for (int n = 0; n < 56; ++n) ctab[n] = t.ij[n]; }
#pragma unroll
    for (int k = 0; k < SEL_NT; ++k) {
        const int tk = tid >> 5, part = tid & 31; const int tok = (tt0 + k * tstride) * 16 + tk;
        f32x4 a = (f32x4){0.f, 0.f, 0.f, 0.f}, b2 = a;
        if (k < ntile && tok < NTOK) { const float* q = p.qry + (size_t)tok * D + h * 256 + part * 8; a = *(const f32x4*)q; b2 = *(const f32x4*)(q + 4); }
        float ss = a[0] * a[0] + a[1] * a[1] + a[2] * a[2] + a[3] * a[3] + b2[0] * b2[0] + b2[1] * b2[1] + b2[2] * b2[2] + b2[3] * b2[3];
        ss += __shfl_xor(ss, 1); ss += __shfl_xor(ss, 2); ss += __shfl_xor(ss, 4); ss += __shfl_xor(ss, 8);
        const float rn = rsqrtf(ss * (1.0f / 128.0f) + EPS);
        const float v[8] = {a[0] * rn, a[1] * rn, a[2] * rn, a[3] * rn, b2[0] * rn, b2[1] * rn, b2[2] * rn, b2[3] * rn};
        unsigned hi[4], lo[4];
#pragma unroll
        for (int j = 0; j < 4; ++j) { hi[j] = pack2(v[2 * j], v[2 * j + 1]); lo[j] = pack2(v[2 * j] - lo16(hi[j]), v[2 * j + 1] - hi16(hi[j])); }
        *(u32x4*)(qh + (k * 16 + tk) * QRS + part * 8) = (u32x4){hi[0], hi[1], hi[2], hi[3]}; *(u32x4*)(ql + (k * 16 + tk) * QRS + part * 8) = (u32x4){lo[0], lo[1], lo[2], lo[3]};
    }
    __syncthreads();
    for (int k = 0; k < ntile; ++k) {
#pragma unroll
        for (int ph = 0; ph < 2; ++ph) {
            f32x4 acc = (f32x4){0.f, 0.f, 0.f, 0.f};
#pragma unroll
            for (int ks = 0; ks < 4; ++ks) {
                const bf16x8 ah = *(const bf16x8*)(qh + (k * 16 + c16) * QRS + ph * 128 + 32 * ks + 8 * g), al = *(const bf16x8*)(ql + (k * 16 + c16) * QRS + ph * 128 + 32 * ks + 8 * g);
                acc = MFMA_BF16(al, kh[ph][ks], acc); acc = MFMA_BF16(ah, kl[ph][ks], acc); acc = MFMA_BF16(ah, kh[ph][ks], acc);
            }
            const int kidx = 16 * w + c16;
#pragma unroll
            for (int r = 0; r < 4; ++r) sc[(ph * NTK + k * 16 + 4 * g + r) * SEL_RS + (kidx >> 5) * 36 + (kidx & 31)] = acc[r];
        }
    }
    __syncthreads();
    {
        const int row = tid >> 2, sub = tid & 3; const bool active = ((row % NTK) >> 4) < ntile;
        unsigned k[32];
#pragma unroll
        for (int i4 = 0; i4 < 8; ++i4) { const f32x4 v = *(const f32x4*)(sc + row * SEL_RS + sub * 36 + 4 * i4); k[4 * i4] = fkey(v[0]); k[4 * i4 + 1] = fkey(v[1]); k[4 * i4 + 2] = fkey(v[2]); k[4 * i4 + 3] = fkey(v[3]); }
        unsigned pos; const unsigned mask = group_top16<4, 32>(k, active, sub, pos);
#pragma unroll
        for (int i = 0; i < 32; ++i) if ((mask >> i) & 1u) { if (pos < 16u) { ts[row * 16 + pos] = fkey_inv(k[i]); ti[row * 16 + pos] = 32 * sub + i; } ++pos; }
    }
    __syncthreads();
    {
        float v4[4]; int i4[4]; unsigned rk[4];
#pragma unroll
        for (int r = 0; r < (2 * NTK) / 32; ++r) { const int row = (tid >> 4) + 32 * r; v4[r] = ts[row * 16 + (tid & 15)]; i4[r] = ti[row * 16 + (tid & 15)]; }
#pragma unroll
        for (int r = 0; r < (2 * NTK) / 32; ++r) rk[r] = RowRank<15>::run(fkey(v4[r]), tid & 15);
        __syncthreads();
#pragma unroll
        for (int r = 0; r < (2 * NTK) / 32; ++r) { const int row = (tid >> 4) + 32 * r; ts[row * 16 + rk[r]] = v4[r]; ti[row * 16 + rk[r]] = i4[r]; }
    }
    __syncthreads();
    {
        const int tk = tid >> 3, sub = tid & 7; const bool active = (tk >> 4) < ntile;
        unsigned k[7]; unsigned cij[7];
#pragma unroll
        for (int q = 0; q < 7; ++q) { cij[q] = ctab[7 * sub + q]; const bool ok = cij[q] != 255u;
            k[q] = ok ? fkey(ts[tk * 16 + (cij[q] >> 4)] + ts[(NTK + tk) * 16 + (cij[q] & 15u)]) : 0u; }
        unsigned pos; const unsigned mask = group_top16<8, 7>(k, active, sub, pos);
        u32x2* lst = (u32x2*)sc;
#pragma unroll
        for (int q = 0; q < 7; ++q) if ((mask >> q) & 1u) { if (pos < 16u) lst[tk * 16 + pos] = (u32x2){__float_as_uint(fkey_inv(k[q])), (unsigned)(ti[tk * 16 + (cij[q] >> 4)] * 128 + ti[(NTK + tk) * 16 + (cij[q] & 15u)])}; ++pos; }
    }
    __syncthreads();
#pragma unroll
    for (int r = 0; r < NTK / 32; ++r) {
        const int tk = (tid >> 4) + 32 * r, slot = tid & 15; const int tok = (tt0 + (tk >> 4) * tstride) * 16 + (tk & 15);
        const u32x2 en = ((const u32x2*)sc)[tk * 16 + slot];
        const float v = __uint_as_float(en.x); const int e = (int)en.y;
        float mx = v; mx = fmaxf(mx, DPP_XOR1(mx)); mx = fmaxf(mx, DPP_XOR2(mx)); mx = fmaxf(mx, DPP_HMIRROR(mx)); mx = fmaxf(mx, DPP_RMIRROR(mx));
        const float ex = __expf(v - mx);
        float sm = ex; sm += DPP_XOR1(sm); sm += DPP_XOR2(sm); sm += DPP_HMIRROR(sm); sm += DPP_RMIRROR(sm);
        if ((tk >> 4) < ntile && tok < NTOK) { const size_t o = (size_t)tok * 128 + h * 16 + slot;
            p.eidx[o] = (unsigned short)e; p.gate[o] = ex / sm; }
    }
    __syncthreads();
}
DEV void phase_select(const Params& p, int l, unsigned char* lds) {
    const int ntt = (NTOK + 15) / 16, lane = threadIdx.x & 63, w = threadIdx.x >> 6, g = lane >> 4, c16 = lane & 15;
    const bool fixed = (gridDim.x % 8u) == 0u;
    const int nq = fixed ? (int)(gridDim.x >> 3) : 1;
    for (int hh = 0; hh < (fixed ? 1 : 8); ++hh) {
        const int h = fixed ? (int)(blockIdx.x & 7) : hh;
        bf16x8 kh[2][4], kl[2][4];
#pragma unroll
        for (int ph = 0; ph < 2; ++ph)
#pragma unroll
            for (int ks = 0; ks < 4; ++ks) { const float* kr = p.peer_keys + ((size_t)((l * 8 + h) * 2 + ph) * 128 + 16 * w + c16) * 128 + 32 * ks + 8 * g;
                const f32x4 a = *(const f32x4*)kr, b2 = *(const f32x4*)(kr + 4); const float v[8] = {a[0], a[1], a[2], a[3], b2[0], b2[1], b2[2], b2[3]};
                u32x4 hi, lo; unsigned hw[4], lw[4];
#pragma unroll
                for (int j = 0; j < 4; ++j) { hw[j] = pack2(v[2 * j], v[2 * j + 1]); lw[j] = pack2(v[2 * j] - lo16(hw[j]), v[2 * j + 1] - hi16(hw[j])); }
                hi = (u32x4){hw[0], hw[1], hw[2], hw[3]}; lo = (u32x4){lw[0], lw[1], lw[2], lw[3]};
                kh[ph][ks] = __builtin_bit_cast(bf16x8, hi); kl[ph][ks] = __builtin_bit_cast(bf16x8, lo); }
        const int first = fixed ? (int)(blockIdx.x >> 3) : (int)blockIdx.x, stride = fixed ? nq : (int)gridDim.x;
        for (int tt0 = first; tt0 < ntt; tt0 += SEL_NT * stride) {
            int ntile = 0;
#pragma unroll
            for (int k = 0; k < SEL_NT; ++k) if (tt0 + k * stride < ntt) ntile = k + 1;
            select_step(p, l, tt0, stride, ntile, h, lds, kh, kl);
        }
    }
}

constexpr int PEER_TB = 272;
struct PeerDeal { int xs_first, xs_step, t_begin, t_end; };
DEV PeerDeal peer_deal() {
    PeerDeal d; const bool sl = (gridDim.x % 8u) == 0u;
    const int nranks = sl ? (int)(gridDim.x >> 3) : (int)gridDim.x, rank = sl ? (int)(blockIdx.x >> 3) : (int)blockIdx.x, tpr = (NTOK + nranks - 1) / nranks;
    d.xs_first = sl ? (int)(blockIdx.x & 7) : 0; d.xs_step = sl ? 8 : 1; d.t_begin = rank * tpr; d.t_end = d.t_begin + tpr < NTOK ? d.t_begin + tpr : NTOK;
    return d;
}
struct PeerTok { u32x4 e0, e1, ha, hb; };
DEV void peer_fetch_u(const Params& p, int t, int c0, int g8, PeerTok& k) {
    const u32x4* ep = (const u32x4*)(p.eidx + (size_t)t * 128 + 16 * g8); k.e0 = ep[0]; k.e1 = ep[1];
    k.ha = *(const u32x4*)(p.hB + (size_t)t * D + c0); k.hb = *(const u32x4*)(p.hB + (size_t)t * D + c0 + 8);
}
DEV void phase_peer_u(const Params& p, int l, unsigned char* lds) {
    const int lane = threadIdx.x & 63, w = threadIdx.x >> 6, j8 = lane & 7, g8 = lane >> 3;
    const bool b2 = (j8 & 4) != 0, b1 = (j8 & 2) != 0, b0 = (j8 & 1) != 0;
    const PeerDeal dl = peer_deal();
    const unsigned char* U = p.u8 + (size_t)l * NE * D;
    float* lp = (float*)lds;
    for (int xs = dl.xs_first; xs < 8; xs += dl.xs_step)
    for (int t0 = dl.t_begin; t0 < dl.t_end; t0 += PEER_TB) {
        const int nb = dl.t_end - t0 < PEER_TB ? dl.t_end - t0 : PEER_TB;
        for (int ch = 0; ch < 2; ++ch) {
            const int c0 = 256 * xs + 128 * ch + 16 * j8;
            const unsigned char* Us = U + (size_t)(2 * xs + ch) * NE * 128 + 16 * j8;
            PeerTok nx; if (w < nb) peer_fetch_u(p, t0 + w, c0, g8, nx);
            for (int tk = w; tk < nb; tk += 8) {
                const int t = t0 + tk;
                const PeerTok cu = nx;
                const unsigned ew[8] = {cu.e0.x, cu.e0.y, cu.e0.z, cu.e0.w, cu.e1.x, cu.e1.y, cu.e1.z, cu.e1.w}; unsigned ev[16];
#pragma unroll
                for (int i = 0; i < 8; ++i) { ev[2 * i] = ew[i] & 0xffffu; ev[2 * i + 1] = ew[i] >> 16; }
                u32x4 q[16];
#pragma unroll
                for (int i = 0; i < 16; ++i) q[i] = *(const u32x4*)(Us + (size_t)ev[i] * 128);
                if (tk + 8 < nb) peer_fetch_u(p, t + 8, c0, g8, nx);
                const u32x4 ha = cu.ha, hb = cu.hb;
                const f32x2 hf[8] = {{lo16(ha.x), hi16(ha.x)}, {lo16(ha.y), hi16(ha.y)}, {lo16(ha.z), hi16(ha.z)}, {lo16(ha.w), hi16(ha.w)}, {lo16(hb.x), hi16(hb.x)}, {lo16(hb.y), hi16(hb.y)}, {lo16(hb.z), hi16(hb.z)}, {lo16(hb.w), hi16(hb.w)}};
                float ps[16];
#pragma unroll
                for (int i = 0; i < 16; ++i) { f32x2 dq[8]; fp8x16_dec2(q[i], dq); f32x2 a = dq[0] * hf[0];
#pragma unroll
                    for (int k = 1; k < 8; ++k) a = __builtin_elementwise_fma(dq[k], hf[k], a);
                    ps[i] = a[0] + a[1]; }
                float q8[8], q4[4], q2[2];
#pragma unroll
                for (int k = 0; k < 8; ++k) { const float keep = b2 ? ps[8 + k] : ps[k], send = b2 ? ps[k] : ps[8 + k]; q8[k] = keep + DPP_HMIRROR(send); }
#pragma unroll
                for (int k = 0; k < 4; ++k) { const float keep = b1 ? q8[4 + k] : q8[k], send = b1 ? q8[k] : q8[4 + k]; q4[k] = keep + DPP_XOR2(send); }
#pragma unroll
                for (int k = 0; k < 2; ++k) { const float keep = b0 ? q4[2 + k] : q4[k], send = b0 ? q4[k] : q4[2 + k]; q2[k] = keep + DPP_XOR1(send); }
                float* lrow = lp + tk * 128 + 16 * g8 + 2 * j8;
                if (ch == 0) { lrow[0] = q2[0]; lrow[1] = q2[1]; }
                else { float* dst = p.part + ((size_t)t * 8 + xs) * 128 + 16 * g8 + 2 * j8; *(f32x2*)dst = (f32x2){q2[0] + lrow[0], q2[1] + lrow[1]}; }
            }
        }
    }
}
DEV void phase_peer_c(const Params& p, int l) {
    const size_t n = (size_t)NTOK * 128, gs = (size_t)gridDim.x * 512;
    for (size_t i = (size_t)blockIdx.x * 512 + threadIdx.x; i < n; i += gs) {
        const size_t t = i >> 7; const int pr = (int)(i & 127); float sacc = 0.f;
        const int e = p.eidx[i]; const float su = p.su[l * NE + e], sv = p.sv[l * NE + e], gt = p.gate[i];
#pragma unroll
        for (int x = 0; x < 8; ++x) sacc += p.part[(t * 8 + x) * 128 + pr];
        p.ab16[i] = (bf16_t)f2bf(gelu_erf(sacc * su) * gt * sv);
    }
}
struct PeerTokV { u32x4 e0, e1, a0, a1; f32x2 x1, g2; };
DEV void peer_fetch_v(const Params& p, int l, int t, int col, int g8, PeerTokV& k) {
    const u32x4* ep = (const u32x4*)(p.eidx + (size_t)t * 128 + 16 * g8); k.e0 = ep[0]; k.e1 = ep[1];
    const u32x4* ap = (const u32x4*)(p.ab16 + (size_t)t * 128 + 16 * g8); k.a0 = ap[0]; k.a1 = ap[1];
    k.x1 = *(const f32x2*)(p.xa + (size_t)t * D + col); k.g2 = *(const f32x2*)(p.modbuf + (size_t)tok_batch(t) * MODW + l * NMOD + 5 * D + col);
}
DEV void phase_peer_v(const Params& p, int l, unsigned char* lds) {
    const int lane = threadIdx.x & 63, w = threadIdx.x >> 6, j8 = lane & 7, g8 = lane >> 3;
    const bool b3 = (g8 & 1) != 0, b4 = (g8 & 2) != 0, b5 = (g8 & 4) != 0;
    const PeerDeal dl = peer_deal();
    const unsigned char* V = p.v8 + (size_t)l * NE * D;
    for (int xs = dl.xs_first; xs < 8; xs += dl.xs_step)
        for (int ch = 0; ch < 2; ++ch) {
            const int c0 = 256 * xs + 128 * ch + 16 * j8, col = c0 + (b3 ? 8 : 0) + (b4 ? 4 : 0) + (b5 ? 2 : 0);
            const unsigned char* Vs = V + (size_t)(2 * xs + ch) * NE * 128 + 16 * j8;
            PeerTokV nx; if (dl.t_begin + w < dl.t_end) peer_fetch_v(p, l, dl.t_begin + w, col, g8, nx);
            for (int t = dl.t_begin + w; t < dl.t_end; t += 8) {
                const PeerTokV cu = nx;
                const unsigned ew[8] = {cu.e0.x, cu.e0.y, cu.e0.z, cu.e0.w, cu.e1.x, cu.e1.y, cu.e1.z, cu.e1.w}; unsigned ev[16];
#pragma unroll
                for (int i = 0; i < 8; ++i) { ev[2 * i] = ew[i] & 0xffffu; ev[2 * i + 1] = ew[i] >> 16; }
                u32x4 q[16];
#pragma unroll
                for (int i = 0; i < 16; ++i) q[i] = *(const u32x4*)(Vs + (size_t)ev[i] * 128);
                if (t + 8 < dl.t_end) peer_fetch_v(p, l, t + 8, col, g8, nx);
                const unsigned aw[8] = {cu.a0.x, cu.a0.y, cu.a0.z, cu.a0.w, cu.a1.x, cu.a1.y, cu.a1.z, cu.a1.w}; float av[16];
#pragma unroll
                for (int i = 0; i < 8; ++i) { av[2 * i] = lo16(aw[i]); av[2 * i + 1] = hi16(aw[i]); }
                f32x2 acc2[8];
#pragma unroll
                for (int k = 0; k < 8; ++k) acc2[k] = (f32x2){0.f, 0.f};
#pragma unroll
                for (int i = 0; i < 16; ++i) { f32x2 dq[8]; fp8x16_dec2(q[i], dq); const f32x2 a2v = (f32x2){av[i], av[i]};
#pragma unroll
                    for (int k = 0; k < 8; ++k) acc2[k] = __builtin_elementwise_fma(a2v, dq[k], acc2[k]); }
                float acc[16];
#pragma unroll
                for (int k = 0; k < 8; ++k) { acc[2 * k] = acc2[k][0]; acc[2 * k + 1] = acc2[k][1]; }
                float q8[8], q4[4], q2[2];
#pragma unroll
                for (int k = 0; k < 8; ++k) { const float keep = b3 ? acc[8 + k] : acc[k], send = b3 ? acc[k] : acc[8 + k]; q8[k] = keep + DPP_XOR8(send); }
#pragma unroll
                for (int k = 0; k < 4; ++k) q4[k] = xsum16(q8[k], q8[4 + k]);
#pragma unroll
                for (int k = 0; k < 2; ++k) q2[k] = xsum32(q4[k], q4[2 + k]);
                f32x2 o; o[0] = cu.x1[0] + cu.g2[0] * q2[0]; o[1] = cu.x1[1] + cu.g2[1] * q2[1];
                *(f32x2*)(p.xb + (size_t)t * D + col) = o;
            }
        }
}

constexpr int N_PHASES = 27;
DEV int phase_class(int k) { return k < 2 ? k : (k == 26 ? 14 : 2 + (k - 2) % 12); }
#ifndef HIPEMU
#define XB_TMO      128
#define XB_XCNT(j)  (256  + 64 * (j))
#define XB_XSUB(j)  (1280 + 64 * (j))
#define XB_XGEN(j)  (2304 + 64 * (j))
#define XB_TOP      3328
#define XB_TOPGEN   3392
#define XCD_BAR_WORDS 3456
#define XB_SPIN_CAP (1u << 22)
__device__ __forceinline__ unsigned xb_ld(unsigned* p)              { return __hip_atomic_load(p, __ATOMIC_RELAXED, __HIP_MEMORY_SCOPE_AGENT); }
__device__ __forceinline__ unsigned xb_add(unsigned* p, unsigned v) { return __hip_atomic_fetch_add(p, v, __ATOMIC_RELAXED, __HIP_MEMORY_SCOPE_AGENT); }
__device__ __forceinline__ unsigned xb_xcc_id() { return (unsigned)__builtin_amdgcn_s_getreg((3 << 11) | 20) & 0xFu; }
#define XB_SPIN(cond, bar) do { unsigned _sp = 0; while (cond) { __builtin_amdgcn_s_sleep(1); \
    if ((++_sp & 255u) == 0u) { if (xb_ld(&(bar)[XB_TMO])) break; if (_sp > XB_SPIN_CAP) { atomicAdd(&(bar)[XB_TMO], 1u); break; } } } } while (0)
struct XcdBarrier { unsigned* bar; unsigned x; volatile LAS unsigned* st; };
__device__ __forceinline__ XcdBarrier xcd_barrier_post(unsigned* bar, volatile LAS unsigned* st) {
    XcdBarrier b; b.bar = bar; b.x = xb_xcc_id(); b.st = st;
    if (threadIdx.x == 0) (void)xb_add(&bar[XB_XCNT(b.x)], 1u);
    return b;
}
__device__ __forceinline__ void xcd_barrier_complete(unsigned* bar, unsigned x, unsigned& nloc, unsigned& nx) {
    const unsigned G = gridDim.x * gridDim.y * gridDim.z;
    unsigned sum, cnt, mine, sp = 0u;
    for (;;) {
        sum = 0u; cnt = 0u; mine = 0u;
#pragma unroll
        for (unsigned j = 0; j < 16; ++j) { const unsigned c = xb_ld(&bar[XB_XCNT(j)]); sum += c; cnt += (c > 0u) ? 1u : 0u; mine = (j == x) ? c : mine; }
        if (sum == G) break;
        __builtin_amdgcn_s_sleep(1);
        if ((++sp & 255u) == 0u) { if (xb_ld(&bar[XB_TMO])) break; if (sp > XB_SPIN_CAP) { atomicAdd(&bar[XB_TMO], 1u); break; } }
    }
    nloc = mine > 0u ? mine : 1u; nx = cnt > 0u ? cnt : 1u;
}
__device__ __forceinline__ void xcd_barrier(const XcdBarrier& b) {
    asm volatile("s_waitcnt vmcnt(0)" ::: "memory");
    __syncthreads();
    if (threadIdx.x == 0) {
        unsigned* bar = b.bar;
        __builtin_amdgcn_s_waitcnt(0);
        unsigned nloc = b.st[0], nx = b.st[1];
        if (nloc == 0u) { xcd_barrier_complete(bar, b.x, nloc, nx); b.st[0] = nloc; b.st[1] = nx; }
        const unsigned old = xb_add(&bar[XB_XSUB(b.x)], 1u);
        const unsigned gen = old / nloc;
        if (old + 1u == (gen + 1u) * nloc) {
            __builtin_amdgcn_fence(__ATOMIC_RELEASE, "agent");
            asm volatile("s_waitcnt vmcnt(0)" ::: "memory");
            const unsigned og = xb_add(&bar[XB_TOP], 1u);
            const unsigned tg = og / nx;
            if (og + 1u == (tg + 1u) * nx) xb_add(&bar[XB_TOPGEN], 1u);
            else XB_SPIN(xb_ld(&bar[XB_TOPGEN]) == tg, bar);
            __builtin_amdgcn_fence(__ATOMIC_ACQUIRE, "agent");
            xb_add(&bar[XB_XGEN(b.x)], 1u);
            asm volatile("s_waitcnt vmcnt(0)" ::: "memory");
        } else {
            XB_SPIN(xb_ld(&bar[XB_XGEN(b.x)]) == gen, bar);
            __builtin_amdgcn_fence(__ATOMIC_ACQUIRE, "agent");
            asm volatile("s_waitcnt vmcnt(0)" ::: "memory");
        }
    }
    __syncthreads();
}
#endif

constexpr int LDS_BYTES = 163840;
constexpr int LDS_BARW = LDS_BYTES - 16;

#ifndef PH_MASK
#define PH_MASK 0xFFFFFFFFu
#endif
#ifndef PROBE_DUP
#define PROBE_DUP 0u
#endif
#define DUP_N(k) (1 + (int)((PROBE_DUP >> phase_class(k)) & 1u))
#define PH_BIT(k) ((PH_MASK >> phase_class(k)) & 1u)
#ifdef HIPEMU
static void run_phase(const Params& pp, int ph, unsigned char* lds)
#define GRID_BAR() do {} while (0)
#define IN(k) (ph == (k))
#define GLDS lds
#define LOADP() const Params& p = pp
#else
typedef const __attribute__((address_space(4))) unsigned char* kargp_t;
__device__ __forceinline__ kargp_t karg_ptr() { kargp_t kp = (kargp_t)__builtin_amdgcn_kernarg_segment_ptr(); asm volatile("" : "+s"(kp)); return kp; }
#define LOADP() Params p; __builtin_memcpy(&p, karg_ptr(), sizeof(Params))
#define IN(k) (PH_BIT(k) && ph_lo <= (k) && (k) < ph_hi)
#define GLDS ((LAS unsigned char*)lds_raw)
__global__ void __launch_bounds__(512, 2) mega_fwd(Params p_unused)
#endif
{
#ifndef HIPEMU
    extern __shared__ __attribute__((aligned(16))) unsigned char lds_raw[];
    unsigned char* lds = lds_raw;
    if (threadIdx.x == 0) { *(volatile unsigned*)(lds_raw + LDS_BARW) = 0u; *(volatile unsigned*)(lds_raw + LDS_BARW + 4) = 0u; }
    __syncthreads();
    int ph_lo, ph_hi; XcdBarrier bar;
    { LOADP(); ph_lo = p.ph_lo; ph_hi = p.ph_hi; bar.bar = p.bar; bar.x = 0; bar.st = nullptr; }
    const bool multi = (ph_hi - ph_lo) > 1;
    if (multi) bar = xcd_barrier_post(bar.bar, (volatile LAS unsigned*)(lds_raw + LDS_BARW));
#define GRID_BAR() do { if (multi) xcd_barrier(bar); } while (0)
#endif
    if (IN(0)) { for (int rep = 0; rep < DUP_N(0); ++rep) { LOADP(); phase_convert(p, lds, 0); GRID_BAR(); } }
    if (IN(1)) {
        LOADP();
        pg8::Gemm g{p.csil, p.wt_ada, 256, MODW, D}; pg8::StaticOrder S; S.init(256, MODW, gridDim.x, blockIdx.x);
        pg8::EpiAda E{p.modbuf, p.b_ada, p.b_ada_final};
        pg8::gemm_phase<pg8::EpiAda, pg8::StaticOrder>(GLDS, g, S, E);
    }
    if (IN(1)) { LOADP(); phase_convert(p, lds, 1); GRID_BAR(); }
#define LAYER(l) do { \
        constexpr int base = 2 + 12 * (l); \
        if (IN(base + 0)) { for (int rep = 0; rep < DUP_N(base + 0); ++rep) { LOADP(); phase_norm(p, (l) == 0 ? p.x_prompt : p.xb, (l) == 0 ? p.x_sample : p.xb + (size_t)NP * D, p.norm1_g + (l) * D, (l) * NMOD + 0 * D, (l) * NMOD + 1 * D, p.hA, nullptr); GRID_BAR(); } } \
        if (IN(base + 1)) { for (int rep = 0; rep < DUP_N(base + 1); ++rep) { LOADP(); \
            pg8::Gemm g{p.hA, p.wt_in + (size_t)(l) * ZW * D, MPAD, ZW, D}; pg8::StaticOrder S; S.init(MPAD, ZW, gridDim.x, blockIdx.x); \
            pg8::EpiBf16 E{p.z, ZW}; \
            pg8::gemm_phase<pg8::EpiBf16, pg8::StaticOrder>(GLDS, g, S, E); } } \
        if (IN(base + 1)) { LOADP(); phase_tbl_slot(p, (l)); GRID_BAR(); } \
        if (IN(base + 2)) { for (int rep = 0; rep < DUP_N(base + 2); ++rep) { LOADP(); phase_mix1(p, (l), lds); GRID_BAR(); } } \
        if (IN(base + 3)) { for (int rep = 0; rep < DUP_N(base + 3); ++rep) { LOADP(); phase_mix2(p, (l)); GRID_BAR(); } } \
        if (IN(base + 4)) { LOADP(); phase_mix3(p, (l), lds); } \
        if (IN(base + 4)) { LOADP(); \
            pg8::Gemm g{p.pooled, p.wt_pool + (size_t)(l) * 1024 * 256, 4 * MPAD, 1024, 256}; pg8::PoolOrder S{(int)gridDim.x, (int)(gridDim.x - 1 - blockIdx.x)}; \
            pg8::EpiPool E{p.cat, p.pool_b + (l) * PW, p.pool_scale + (l) * PW}; \
            pg8::gemm_phase<pg8::EpiPool, pg8::PoolOrder>(GLDS, g, S, E); \
            GRID_BAR(); } \
        if (IN(base + 5)) { for (int rep = 0; rep < DUP_N(base + 5); ++rep) { LOADP(); \
            pg8::Gemm g{p.cat, p.wt_out + (size_t)(l) * D * D, MBIG, D, D}; pg8::StaticOrder S; S.init(MBIG, D, gridDim.x, blockIdx.x); \
            pg8::EpiResid E{(l) == 0 ? p.x_prompt : p.xb, (l) == 0 ? p.x_sample : p.xb + (size_t)NP * D, p.modbuf + (l) * NMOD + 2 * D, p.xa}; \
            pg8::gemm_phase<pg8::EpiResid, pg8::StaticOrder>(GLDS, g, S, E); \
            { SmallResid sf{E.xlo, E.xhi, E.gmod, E.out}; small_gemm(p.cat, p.wt_out + (size_t)(l) * D * D, D, lds, sf); } \
            GRID_BAR(); } } \
        if (IN(base + 6)) { for (int rep = 0; rep < DUP_N(base + 6); ++rep) { LOADP(); phase_norm(p, p.xa, p.xa + (size_t)NP * D, p.norm2_g + (l) * D, (l) * NMOD + 3 * D, (l) * NMOD + 4 * D, p.hB, nullptr); GRID_BAR(); } } \
        if (IN(base + 7)) { for (int rep = 0; rep < DUP_N(base + 7); ++rep) { LOADP(); \
            pg8::Gemm g{p.hB, p.wt_q + (size_t)(l) * D * D, MBIG, D, D}; pg8::StaticOrder S; S.init(MBIG, D, gridDim.x, blockIdx.x); \
            pg8::EpiF32 E{p.qry, D}; \
            pg8::gemm_phase<pg8::EpiF32, pg8::StaticOrder>(GLDS, g, S, E); \
            { SmallF32 sf{p.qry}; small_gemm(p.hB, p.wt_q + (size_t)(l) * D * D, D, lds, sf); } \
            GRID_BAR(); } } \
        if (IN(base + 8)) { for (int rep = 0; rep < DUP_N(base + 8); ++rep) { LOADP(); phase_select(p, (l), lds); GRID_BAR(); } } \
        if (IN(base + 9)) { for (int rep = 0; rep < DUP_N(base + 9); ++rep) { LOADP(); phase_peer_u(p, (l), lds); GRID_BAR(); } } \
        if (IN(base + 10)) { LOADP(); phase_peer_c(p, (l)); GRID_BAR(); } \
        if (IN(base + 11)) { for (int rep = 0; rep < DUP_N(base + 11); ++rep) { LOADP(); phase_peer_v(p, (l), lds); GRID_BAR(); } } \
    } while (0)
    LAYER(0);
    LAYER(1);
    if (IN(26)) { LOADP(); phase_norm(p, p.xb, p.xb + (size_t)NP * D, p.final_g, 2 * NMOD, 2 * NMOD + D, nullptr, p.out + OFF_Y); }
#undef LAYER
#undef IN
#undef GRID_BAR
#undef GLDS
#undef LOADP
}

struct WsLayout { size_t bar, modbuf, csil, wt_ada, wt_in, wt_out, wt_q, wt_pool, u8, v8, su, sv, iscu, part, hg_oin, hg_ds, hg_gam, hg_qh, hg_sc, hA, hB, z, pooled, cat, xa, xb, qry, eidx, gate, ab16, end; };
static WsLayout ws_layout() {
    WsLayout L; size_t o = 0;
    auto take = [&](size_t bytes) { const size_t r = o; o += (bytes + 255) & ~(size_t)255; return r; };
    L.bar = take(16384);
    L.modbuf = take((size_t)256 * MODW * 4);
    L.csil = take((size_t)256 * D * 2);
    L.wt_ada = take((size_t)MODW * D * 2);
    L.wt_in = take((size_t)2 * ZW * D * 2);
    L.wt_out = take((size_t)2 * D * D * 2);
    L.wt_q = take((size_t)2 * D * D * 2);
    L.wt_pool = take((size_t)2 * 1024 * 256 * 2);
    L.u8 = take((size_t)2 * NE * D);
    L.v8 = take((size_t)2 * NE * D);
    L.su = take((size_t)2 * NE * 4);
    L.sv = take((size_t)2 * NE * 4);
    L.iscu = take((size_t)MPAD * 128 * 4);
    L.part = take((size_t)MPAD * 8 * 128 * 4);
    L.hg_oin = take((size_t)hg::NUNIT * 64 * 128 * 2);
    L.hg_ds = take((size_t)hg::NUNIT * 128 * 128 * 2);
    L.hg_gam = take((size_t)hg::NUNIT * 128 * 4);
    L.hg_qh = take((size_t)NP * 1024 * 2);
    L.hg_sc = take((size_t)hg::NUNIT * 128 * 128 * 2);
    L.hA = take((size_t)MPAD * D * 2);
    L.hB = take((size_t)MPAD * D * 2);
    L.z = take((size_t)MPAD * ZW * 2);
    L.pooled = take((size_t)4 * MPAD * 256 * 2);
    L.cat = take((size_t)MPAD * D * 2);
    L.xa = take((size_t)MPAD * D * 4);
    L.xb = take((size_t)MPAD * D * 4);
    L.qry = take((size_t)MPAD * D * 4);
    L.eidx = take((size_t)MPAD * 128 * 2);
    L.gate = take((size_t)MPAD * 128 * 4);
    L.ab16 = take((size_t)MPAD * 128 * 2);
    L.end = o;
    return L;
}
static void fill_params(Params& p, void* const* d_in, void* d_out, void* d_ws) {
    const float** f = (const float**)&p;
    for (int i = 0; i < 24; ++i) f[i] = (const float*)d_in[i];
    p.out = (float*)d_out;
    const WsLayout L = ws_layout(); unsigned char* w = (unsigned char*)d_ws;
    p.bar = (unsigned*)(w + L.bar); p.modbuf = (float*)(w + L.modbuf); p.csil = (bf16_t*)(w + L.csil); p.wt_ada = (bf16_t*)(w + L.wt_ada); p.wt_in = (bf16_t*)(w + L.wt_in);
    p.wt_out = (bf16_t*)(w + L.wt_out); p.wt_q = (bf16_t*)(w + L.wt_q); p.wt_pool = (bf16_t*)(w + L.wt_pool); p.u8 = w + L.u8; p.v8 = w + L.v8; p.su = (float*)(w + L.su); p.sv = (float*)(w + L.sv); p.iscu = (float*)(w + L.iscu); p.part = (float*)(w + L.part); p.hg_oin = (bf16_t*)(w + L.hg_oin); p.hg_ds = (bf16_t*)(w + L.hg_ds); p.hg_gam = (float*)(w + L.hg_gam); p.hg_qh = (bf16_t*)(w + L.hg_qh); p.hg_sc = (bf16_t*)(w + L.hg_sc);
    p.hA = (bf16_t*)(w + L.hA); p.hB = (bf16_t*)(w + L.hB); p.z = (bf16_t*)(w + L.z); p.pooled = (bf16_t*)(w + L.pooled); p.cat = (bf16_t*)(w + L.cat);
    p.xa = (float*)(w + L.xa); p.xb = (float*)(w + L.xb); p.qry = (float*)(w + L.qry); p.eidx = (unsigned short*)(w + L.eidx); p.gate = (float*)(w + L.gate); p.ab16 = (bf16_t*)(w + L.ab16);
}

#ifndef HIPEMU
#ifndef MK_ONE_LAUNCH
#define MK_ONE_LAUNCH 1
#endif
extern "C" void kernel_launch(void* const* d_in, const int* in_sizes, int n_in, void* d_out, int out_size, void* d_ws, size_t ws_size, hipStream_t stream) {
    static int grid = 0;
    if (grid == 0) {
        const WsLayout L = ws_layout();
        if (n_in != 24 || (size_t)out_size != OUT_TOTAL || ws_size < L.end) { fprintf(stderr, "kernel_launch: unexpected shapes (n_in %d, out %d, ws %zu < %zu)\n", n_in, out_size, ws_size, L.end); grid = -1; return; }
        int dev = 0, cus = 0, per_cu = 0;
        hipGetDevice(&dev); hipDeviceGetAttribute(&cus, hipDeviceAttributeMultiprocessorCount, dev);
        if (hipFuncSetAttribute((const void*)mega_fwd, hipFuncAttributeMaxDynamicSharedMemorySize, LDS_BYTES) != hipSuccess) { fprintf(stderr, "kernel_launch: hipFuncSetAttribute failed\n"); grid = -1; return; }
        hipOccupancyMaxActiveBlocksPerMultiprocessor(&per_cu, (const void*)mega_fwd, 512, LDS_BYTES);
        (void)hipGetLastError();
        if (per_cu < 1) fprintf(stderr, "kernel_launch: occupancy query says %d blocks per CU\n", per_cu);
        grid = cus;
    }
    if (grid < 0) return;
    Params p{};
    fill_params(p, d_in, d_out, d_ws);
    hipMemsetAsync(p.bar, 0, 16384, stream);
#if MK_ONE_LAUNCH
    p.ph_lo = 0; p.ph_hi = N_PHASES;
    hipLaunchKernelGGL(mega_fwd, dim3(grid), dim3(512), LDS_BYTES, stream, p);
#else
    for (int ph = 0; ph < N_PHASES; ++ph) { p.ph_lo = ph; p.ph_hi = ph + 1; hipLaunchKernelGGL(mega_fwd, dim3(grid), dim3(512), LDS_BYTES, stream, p); }
#endif
}
#endif
```

```cpp
#ifndef HIPEMU
#include <hip/hip_runtime.h>
#include <cstdio>
#endif
#include <stdint.h>

#ifndef CFG_PB
#define CFG_PB 4
#define CFG_SEQ 2048
#define CFG_DB 128
#endif

#ifdef HIPEMU
#define DEV inline
#define LAS
#define READLANE_I(v, l) emu_readlane((v), (l))
#define READLANE_F(v, l) emu_readlane_f((v), (l))
#define MFMA_BF16(a, b, c) emu_mfma_bf16_16x16x32((a), (b), (c))
#define MFMA_F32(a, b, c) emu_mfma_f32_16x16x4((a), (b), (c))
#define __expf expf
#define __logf logf
#else
#define DEV __device__ __forceinline__
#define LAS __attribute__((address_space(3)))
#define READLANE_I(v, l) __builtin_amdgcn_readlane((v), (l))
#define READLANE_F(v, l) __uint_as_float((unsigned)__builtin_amdgcn_readlane((int)__float_as_uint(v), (l)))
#define MFMA_BF16(a, b, c) __builtin_amdgcn_mfma_f32_16x16x32_bf16((a), (b), (c), 0, 0, 0)
#define MFMA_F32(a, b, c) __builtin_amdgcn_mfma_f32_16x16x4f32((a), (b), (c), 0, 0, 0)
#endif

typedef unsigned short bf16_t;
typedef short bf16x8 __attribute__((ext_vector_type(8)));
typedef float f32x4 __attribute__((ext_vector_type(4)));
typedef unsigned u32x4 __attribute__((ext_vector_type(4)));
typedef unsigned u32x2 __attribute__((ext_vector_type(2)));

namespace cfg {
constexpr int D = 2048, PB = CFG_PB, SEQ = CFG_SEQ, DB = CFG_DB, DSEQ = 4;
constexpr int NP = PB * SEQ, NS = DB * DSEQ, NTOK = NP + NS, MPAD = (NTOK + 255) / 256 * 256;
constexpr int NC = PB + DB;
constexpr int HH = 8, HD = 128, PW = 1024, PBUF = 15, ZW = 5120;
constexpr int NE = 16384;
constexpr int NMOD = 6 * D;
constexpr int MODW = 2 * NMOD + 2 * D;
constexpr float EPS = 1e-6f;
constexpr int NCHAIN = PB * HH;
constexpr size_t OFF_Y = 0;
constexpr size_t OFF_HP = (size_t)NTOK * D;
constexpr size_t OFF_PP = OFF_HP + (size_t)2 * PB * HH * HD * HD;
constexpr size_t OFF_HS = OFF_PP + (size_t)2 * PB * PBUF * PW;
constexpr size_t OFF_PS = OFF_HS + (size_t)2 * DB * HH * HD * HD;
constexpr size_t OUT_TOTAL = OFF_PS + (size_t)2 * DB * PBUF * PW;
}
using namespace cfg;

struct Params {
    const float *x_prompt, *x_sample, *c_prompt, *c_sample, *state_hgrn, *state_pool, *w_ada, *b_ada, *norm1_g, *norm2_g, *w_in, *w_out,
        *lb_logits, *hgrn_norm_g, *pool_w, *pool_b, *pool_scale, *peer_wq, *peer_keys, *peer_u, *peer_v, *final_g, *w_ada_final, *b_ada_final;
    float* out;
    unsigned* bar; float* modbuf; bf16_t* csil; bf16_t* wt_ada; bf16_t* wt_in; bf16_t* wt_out; bf16_t* wt_q; bf16_t* wt_pool;
    unsigned char* u8; unsigned char* v8; float* su; float* sv; float* iscu; float* part; bf16_t* hg_oin; bf16_t* hg_ds; float* hg_gam; bf16_t* hg_qh; bf16_t* hg_sc; bf16_t* hA; bf16_t* hB; bf16_t* z; bf16_t* pooled; bf16_t* cat; float* xa; float* xb; float* qry; unsigned short* eidx; float* gate; bf16_t* ab16;
    int ph_lo, ph_hi;
};

DEV float bf2f(unsigned v) { return __uint_as_float(v << 16); }
#ifdef HIPEMU
DEV unsigned f2bf(float f) { unsigned u = __float_as_uint(f); u += 0x7fffu + ((u >> 16) & 1u); return u >> 16; }
DEV unsigned pack2(float lo, float hi) { return f2bf(lo) | (f2bf(hi) << 16); }
#else
typedef float f32x2_t __attribute__((ext_vector_type(2)));
typedef __bf16 bf16x2_t __attribute__((ext_vector_type(2)));
DEV unsigned pack2(float lo, float hi) { const f32x2_t v = {lo, hi}; return __builtin_bit_cast(unsigned, __builtin_convertvector(v, bf16x2_t)); }
DEV unsigned f2bf(float f) { return (unsigned)__builtin_bit_cast(unsigned short, (__bf16)f); }
#endif
DEV float lo16(unsigned w) { return __uint_as_float(w << 16); }
DEV float hi16(unsigned w) { return __uint_as_float(w & 0xffff0000u); }
DEV float wave_sum(float v) { v += __shfl_xor(v, 32); v += __shfl_xor(v, 16); v += __shfl_xor(v, 8); v += __shfl_xor(v, 4); v += __shfl_xor(v, 2); v += __shfl_xor(v, 1); return v; }
DEV float wave_max(float v) { v = fmaxf(v, __shfl_xor(v, 32)); v = fmaxf(v, __shfl_xor(v, 16)); v = fmaxf(v, __shfl_xor(v, 8)); v = fmaxf(v, __shfl_xor(v, 4)); v = fmaxf(v, __shfl_xor(v, 2)); v = fmaxf(v, __shfl_xor(v, 1)); return v; }
DEV float sigmoidf_(float x) { return 1.0f / (1.0f + __expf(-x)); }
DEV float siluf_(float x) { return x / (1.0f + __expf(-x)); }
DEV float gelu_erf(float x) { return 0.5f * x * (1.0f + erff(x * 0.70710678118f)); }
#ifdef HIPEMU
DEV int wave_id() { return (int)(threadIdx.x >> 6); }
#else
DEV int wave_id() { return __builtin_amdgcn_readfirstlane((int)(threadIdx.x >> 6)); }
#endif
DEV int tok_batch(int t) { return t < NP ? t / SEQ : PB + (t - NP) / DSEQ; }


#ifdef HIPEMU
static inline unsigned emu_fp8_enc1(float x) {
    const unsigned sgn = x < 0.f ? 0x80u : 0u; float a = fabsf(x);
    if (!(a == a)) return 0x7fu;
    if (a >= 448.f) return sgn | 0x7eu;
    if (a < 0.015625f) { const int q = (int)rintf(a * 512.f); return sgn | (unsigned)q; }
    int e = (int)floorf(log2f(a)); if (ldexpf(1.f, e) > a) --e; if (ldexpf(1.f, e + 1) <= a) ++e;
    int m = (int)rintf((a / ldexpf(1.f, e) - 1.f) * 8.f); if (m == 8) { m = 0; ++e; }
    if (e > 8) return sgn | 0x7eu;
    return sgn | (unsigned)((e + 7) << 3) | (unsigned)m;
}
static inline float emu_fp8_dec1(unsigned b) { const float sg = (b & 0x80u) ? -1.f : 1.f; const int e = (b >> 3) & 15, m = b & 7; return sg * (e == 0 ? m * 0.001953125f : (1.f + m * 0.125f) * ldexpf(1.f, e - 7)); }
DEV unsigned fp8x4_enc(float a, float b, float c, float d) { return emu_fp8_enc1(a) | (emu_fp8_enc1(b) << 8) | (emu_fp8_enc1(c) << 16) | (emu_fp8_enc1(d) << 24); }
DEV void fp8x4_dec(unsigned w, float* o) { o[0] = emu_fp8_dec1(w & 255u); o[1] = emu_fp8_dec1((w >> 8) & 255u); o[2] = emu_fp8_dec1((w >> 16) & 255u); o[3] = emu_fp8_dec1(w >> 24); }
#define DPP_XOR1(v) __shfl((v), emu_lane() ^ 1)
#define DPP_XOR2(v) __shfl((v), emu_lane() ^ 2)
#define DPP_HMIRROR(v) __shfl((v), (emu_lane() & ~7) | (7 - (emu_lane() & 7)))
#define DPP_XOR8(v) __shfl((v), emu_lane() ^ 8)
#define DPP_RMIRROR(v) __shfl((v), (emu_lane() & ~15) | (15 - (emu_lane() & 15)))
#define WAVE_LDS_SYNC() emu_wbar()
DEV float xsum16(float a, float b) { const bool hi = (emu_lane() & 16) != 0; return (hi ? b : a) + __shfl_xor(hi ? a : b, 16); }
DEV float xsum32(float a, float b) { const bool hi = (emu_lane() & 32) != 0; return (hi ? b : a) + __shfl_xor(hi ? a : b, 32); }
#else
typedef float f32x2v_t __attribute__((ext_vector_type(2)));
DEV unsigned fp8x4_enc(float a, float b, float c, float d) { int r = __builtin_amdgcn_cvt_pk_fp8_f32(a, b, 0, false); r = __builtin_amdgcn_cvt_pk_fp8_f32(c, d, r, true); return (unsigned)r; }
DEV void fp8x4_dec(unsigned w, float* o) { const f32x2v_t lo = __builtin_amdgcn_cvt_pk_f32_fp8((int)w, false), hi = __builtin_amdgcn_cvt_pk_f32_fp8((int)w, true); o[0] = lo[0]; o[1] = lo[1]; o[2] = hi[0]; o[3] = hi[1]; }
template <int CTRL> DEV float dpp_f(float v) { return __uint_as_float((unsigned)__builtin_amdgcn_update_dpp(0, (int)__float_as_uint(v), CTRL, 0xf, 0xf, true)); }
#define DPP_XOR1(v) dpp_f<0xB1>(v)
#define DPP_XOR2(v) dpp_f<0x4E>(v)
#define DPP_HMIRROR(v) dpp_f<0x141>(v)
#define DPP_XOR8(v) dpp_f<0x128>(v)
#define DPP_RMIRROR(v) dpp_f<0x140>(v)
#define WAVE_LDS_SYNC() asm volatile("s_waitcnt lgkmcnt(0)" ::: "memory")
DEV float xsum16(float a, float b) { const u32x2 r = __builtin_amdgcn_permlane16_swap(__float_as_uint(a), __float_as_uint(b), false, false); return __uint_as_float(r[0]) + __uint_as_float(r[1]); }
DEV float xsum32(float a, float b) { const u32x2 r = __builtin_amdgcn_permlane32_swap(__float_as_uint(a), __float_as_uint(b), false, false); return __uint_as_float(r[0]) + __uint_as_float(r[1]); }
#endif
typedef float f32x2 __attribute__((ext_vector_type(2)));
#ifdef HIPEMU
DEV void fp8x4_dec2(unsigned w, f32x2& lo, f32x2& hi) { float o[4]; fp8x4_dec(w, o); lo = (f32x2){o[0], o[1]}; hi = (f32x2){o[2], o[3]}; }
#else
DEV void fp8x4_dec2(unsigned w, f32x2& lo, f32x2& hi) { lo = __builtin_amdgcn_cvt_pk_f32_fp8((int)w, false); hi = __builtin_amdgcn_cvt_pk_f32_fp8((int)w, true); }
#endif
DEV void fp8x16_dec2(u32x4 q, f32x2* o) { fp8x4_dec2(q.x, o[0], o[1]); fp8x4_dec2(q.y, o[2], o[3]); fp8x4_dec2(q.z, o[4], o[5]); fp8x4_dec2(q.w, o[6], o[7]); }

namespace pg8 {
constexpr int BM = 256, BK = 64, HALF = 128, HTB = HALF * BK * 2, STAGE_BYTES = 8 * HTB, NXCD = 8, WGM = 8;
DEV int lds_byte(int r, int c) { const int st = (r >> 4) * 2 + (c >> 5), rr = r & 15, cc = c & 31, ob = rr * 64 + cc * 2; return st * 1024 + (ob ^ (((ob >> 9) & 1) << 5)); }
DEV void stage_rc(int b, int& R, int& C) { const int st = b / 1024, sb = b % 1024, swz = sb ^ (((sb >> 9) & 1) << 5); R = (st >> 1) * 16 + swz / 64; C = (st & 1) * 32 + (swz % 64) / 2; }
DEV int perm32(int rho) { const int n = rho >> 4, i = rho & 15; return 8 * (i >> 2) + 4 * n + (i & 3); }
struct Unit { int pm, pn; };
struct Gemm { const bf16_t* A; const bf16_t* Bt; int M, N, K; };
struct StaticOrder {
    int nM, nN, nwg, G, c;
    DEV void init(int M, int N, int G_, int c_) { nM = M / BM; nN = N / BM; nwg = nM * nN; G = G_; c = c_; }
    DEV bool next(int i, Unit& u) const {
        const long L = (long)i * G + c; if (L >= nwg) return false;
        int wgid = (int)L; { const int q = nwg / NXCD, r = nwg % NXCD, xcd = wgid % NXCD, off = wgid / NXCD; wgid = (xcd < r ? xcd * (q + 1) : r * (q + 1) + (xcd - r) * q) + off; }
        const int nig = WGM * nN, gid = wgid / nig, fm = gid * WGM, gsz = (nM - fm) < WGM ? (nM - fm) : WGM;
        u.pm = fm + ((wgid % nig) % gsz); u.pn = (wgid % nig) / gsz; return true;
    }
    DEV void a_ready(const Unit&) const {}
    DEV void done(const Unit&) const {}
};
struct PoolOrder {
    int G, c;
    DEV bool next(int i, Unit& u) const { const int L = i * G + c; if (L >= 4 * (MPAD / 256)) return false; u.pm = L; u.pn = L / (MPAD / 256); return true; }
    DEV void a_ready(const Unit&) const {}
    DEV void done(const Unit&) const {}
};

struct EpiF32 {
    static constexpr bool PERM = false;
    float* C; int ldc;
    DEV void operator()(const f32x4 (&acc)[2][2][4][2], const Unit& u, int wr, int wc, int fr, int fq) const {
        const int row0 = u.pm * BM + wr * 64 + fr, col0 = u.pn * BM + wc * 32 + 4 * fq;
#pragma unroll
        for (int ai = 0; ai < 2; ++ai)
#pragma unroll
            for (int m = 0; m < 4; ++m) { float* rowp = C + (size_t)(row0 + ai * HALF + m * 16) * ldc + col0;
#pragma unroll
                for (int bj = 0; bj < 2; ++bj)
#pragma unroll
                    for (int n = 0; n < 2; ++n) *(f32x4*)(rowp + bj * HALF + n * 16) = acc[ai][bj][m][n]; }
    }
};
struct EpiAda {
    static constexpr bool PERM = false;
    float* C; const float* b_ada; const float* b_fin;
    DEV void operator()(const f32x4 (&acc)[2][2][4][2], const Unit& u, int wr, int wc, int fr, int fq) const {
        const int row0 = u.pm * BM + wr * 64 + fr, col0 = u.pn * BM + wc * 32 + 4 * fq;
        const float* bias = (u.pn * BM < 2 * NMOD) ? b_ada + col0 : b_fin + (col0 - 2 * NMOD);
        f32x4 bv[2][2];
#pragma unroll
        for (int bj = 0; bj < 2; ++bj)
#pragma unroll
            for (int n = 0; n < 2; ++n) bv[bj][n] = *(const f32x4*)(bias + bj * HALF + n * 16);
#pragma unroll
        for (int ai = 0; ai < 2; ++ai)
#pragma unroll
            for (int m = 0; m < 4; ++m) { float* rowp = C + (size_t)(row0 + ai * HALF + m * 16) * MODW + col0;
#pragma unroll
                for (int bj = 0; bj < 2; ++bj)
#pragma unroll
                    for (int n = 0; n < 2; ++n) *(f32x4*)(rowp + bj * HALF + n * 16) = acc[ai][bj][m][n] + bv[bj][n]; }
    }
};
struct EpiResid {
    static constexpr bool PERM = false;
    const float* xlo; const float* xhi; const float* gmod  ; float* out;
    DEV void operator()(const f32x4 (&acc)[2][2][4][2], const Unit& u, int wr, int wc, int fr, int fq) const {
        const int row0 = u.pm * BM + wr * 64 + fr, col0 = u.pn * BM + wc * 32 + 4 * fq;
#pragma unroll
        for (int ai = 0; ai < 2; ++ai)
#pragma unroll
            for (int m = 0; m < 4; ++m) {
                const int row = row0 + ai * HALF + m * 16;
                if (row < NTOK) {
                    const float* xr = (row < NP ? xlo + (size_t)row * D : xhi + (size_t)(row - NP) * D) + col0;
                    const float* gr = gmod + (size_t)tok_batch(row) * MODW + col0;
                    float* rowp = out + (size_t)row * D + col0;
#pragma unroll
                    for (int bj = 0; bj < 2; ++bj)
#pragma unroll
                        for (int n = 0; n < 2; ++n) { const f32x4 xv = *(const f32x4*)(xr + bj * HALF + n * 16), gv = *(const f32x4*)(gr + bj * HALF + n * 16);
                            *(f32x4*)(rowp + bj * HALF + n * 16) = xv + gv * acc[ai][bj][m][n]; }
                }
            }
    }
};
struct EpiBf16 {
    static constexpr bool PERM = true;
    bf16_t* O; int ldc;
    DEV void operator()(const f32x4 (&acc)[2][2][4][2], const Unit& u, int wr, int wc, int fr, int fq) const {
        const int row0 = u.pm * BM + wr * 64 + fr, col0 = u.pn * BM + wc * 32 + 8 * fq;
#pragma unroll
        for (int ai = 0; ai < 2; ++ai)
#pragma unroll
            for (int m = 0; m < 4; ++m) { bf16_t* rowp = O + (size_t)(row0 + ai * HALF + m * 16) * ldc + col0;
#pragma unroll
                for (int bj = 0; bj < 2; ++bj) { const f32x4 v0 = acc[ai][bj][m][0], v1 = acc[ai][bj][m][1];
                    u32x4 w; w.x = pack2(v0[0], v0[1]); w.y = pack2(v0[2], v0[3]); w.z = pack2(v1[0], v1[1]); w.w = pack2(v1[2], v1[3]);
                    *(u32x4*)(rowp + bj * HALF) = w; } }
    }
};
struct EpiPool {
    static constexpr bool PERM = true;
    bf16_t* cat; const float* pb; const float* ps;
    DEV void operator()(const f32x4 (&acc)[2][2][4][2], const Unit& u, int wr, int wc, int fr, int fq) const {
        const int g = u.pn, tok0 = u.pm * BM - g * MPAD + wr * 64 + fr, col0 = g * 256 + wc * 32 + 8 * fq;
#pragma unroll
        for (int bj = 0; bj < 2; ++bj) {
            const f32x4 b0 = *(const f32x4*)(pb + col0 + bj * HALF), b1 = *(const f32x4*)(pb + col0 + bj * HALF + 4);
            const f32x4 s0 = *(const f32x4*)(ps + col0 + bj * HALF), s1 = *(const f32x4*)(ps + col0 + bj * HALF + 4);
#pragma unroll
            for (int ai = 0; ai < 2; ++ai)
#pragma unroll
                for (int m = 0; m < 4; ++m) { const int tok = tok0 + ai * HALF + m * 16;
                    if (tok < NTOK) { const f32x4 v0 = (acc[ai][bj][m][0] + b0) * s0, v1 = (acc[ai][bj][m][1] + b1) * s1;
                        u32x4 w; w.x = pack2(v0[0], v0[1]); w.y = pack2(v0[2], v0[3]); w.z = pack2(v1[0], v1[1]); w.w = pack2(v1[2], v1[3]);
                        *(u32x4*)(cat + (size_t)tok * D + 1024 + col0 + bj * HALF) = w; } }
        }
    }
};

#ifdef HIPEMU
template <class Epi, class Sched>
static void gemm_phase(unsigned char*, const Gemm g, const Sched& S, const Epi& E) {
    const int tid = threadIdx.x, wid = tid >> 6, lane = tid & 63, wr = wid >> 2, wc = wid & 3, fr = lane & 15, fq = lane >> 4;
    Unit cur;
    for (int ui = 0; S.next(ui, cur); ++ui) {
        f32x4 acc[2][2][4][2];
        for (int ai = 0; ai < 2; ++ai) for (int bj = 0; bj < 2; ++bj) for (int m = 0; m < 4; ++m) for (int n = 0; n < 2; ++n) for (int j = 0; j < 4; ++j) {
            const int row = 256 * cur.pm + 128 * ai + 64 * wr + 16 * m + fr;
            const int col = Epi::PERM ? 256 * cur.pn + 128 * bj + 32 * wc + 8 * fq + 4 * n + j : 256 * cur.pn + 128 * bj + 32 * wc + 16 * n + 4 * fq + j;
            float s = 0.f;
            if ((row % emu_row_mod) < emu_row_limit) { const float* a = emu_f32_copy(g.A, (size_t)g.M * g.K) + (size_t)row * g.K; const float* b = emu_f32_copy(g.Bt, (size_t)g.N * g.K) + (size_t)col * g.K;
                for (int k = 0; k < g.K; ++k) s += a[k] * b[k]; }
            acc[ai][bj][m][n][j] = s; }
        E(acc, cur, wr, wc, fr, fq);
    }
    __syncthreads();
}
#else
template <class Epi, class Sched>
__device__ __forceinline__ void gemm_phase(LAS unsigned char* lds, const Gemm g, const Sched& S, const Epi& E) {
    const int tid = threadIdx.x, wid = __builtin_amdgcn_readfirstlane(tid >> 6), lane = tid & 63, wr = wid >> 2, wc = wid & 3, fr = lane & 15, fq = lane >> 4;
    int K = g.K; asm volatile("" : "+s"(K));
    const int nt = K / BK;
    unsigned voffA[2], voffB[2];
#pragma unroll
    for (int i = 0; i < 2; ++i) { int R, C; stage_rc(tid * 16 + i * 8192, R, C); const int Rb = Epi::PERM ? ((R & ~31) + perm32(R & 31)) : R;
        voffA[i] = (unsigned)(R * K + C) * 2u; voffB[i] = (unsigned)(Rb * K + C) * 2u; }
    const size_t kstep = (size_t)(BK * 2);
    const size_t hstep = (size_t)HALF * K * 2;
    const size_t tstep = 2 * hstep;
    const unsigned ldsw = (unsigned)wid * 1024u;
    const int aoff = lds_byte(wr * 64 + fr, fq * 8), boff = lds_byte(wc * 32 + fr, fq * 8);
#define PG8_SA(b, h) (((b) * 2 + (h)) * HTB)
#define PG8_SB(b, h) ((4 + (b) * 2 + (h)) * HTB)
#define PG8_STAGE(bufoff, gbase, voff) do { _Pragma("unroll") for (int _i = 0; _i < 2; ++_i) \
        __builtin_amdgcn_global_load_lds((const unsigned*)((const char*)(gbase) + (voff)[_i]), (LAS unsigned*)(lds + (bufoff) + ldsw + _i * 8192), 16, 0, 0); } while (0)
#define PG8_LDA(dst, b, h) do { _Pragma("unroll") for (int m = 0; m < 4; ++m) _Pragma("unroll") for (int k = 0; k < 2; ++k) dst[m][k] = *(const LAS bf16x8*)(lds + PG8_SA(b, h) + aoff + m * 2048 + k * 1024); } while (0)
#define PG8_LDB(dst, b, h) do { _Pragma("unroll") for (int n = 0; n < 2; ++n) _Pragma("unroll") for (int k = 0; k < 2; ++k) dst[n][k] = *(const LAS bf16x8*)(lds + PG8_SB(b, h) + boff + n * 2048 + k * 1024); } while (0)
#define PG8_MMA(ai, bj, At, Bt) do { __builtin_amdgcn_s_setprio(1); _Pragma("unroll") for (int m = 0; m < 4; ++m) _Pragma("unroll") for (int n = 0; n < 2; ++n) _Pragma("unroll") for (int k = 0; k < 2; ++k) \
        acc[ai][bj][m][n] = __builtin_amdgcn_mfma_f32_16x16x32_bf16(Bt[n][k], At[m][k], acc[ai][bj][m][n], 0, 0, 0); __builtin_amdgcn_s_setprio(0); } while (0)
#define PG8_WAIT_V(n) asm volatile("s_waitcnt vmcnt(" #n ")" ::: "memory")
#define PG8_WAIT_L(n) asm volatile("s_waitcnt lgkmcnt(" #n ")" ::: "memory")
#define PG8_BAR __builtin_amdgcn_s_barrier()
#define PG8_SCHED __builtin_amdgcn_sched_barrier(0)
    Unit cur, nxt; int ui = 0;
    if (!S.next(0, cur)) return;
    f32x4 acc[2][2][4][2];
#pragma unroll
    for (int a = 0; a < 2; ++a)
#pragma unroll
        for (int b = 0; b < 2; ++b)
#pragma unroll
            for (int m = 0; m < 4; ++m)
#pragma unroll
                for (int n = 0; n < 2; ++n) acc[a][b][m][n] = (f32x4){0.f, 0.f, 0.f, 0.f};
    bf16x8 At[4][2], B0[2][2], B1[2][2];
    const char* cA = (const char*)g.A + (size_t)cur.pm * tstep; const char* cB = (const char*)g.Bt + (size_t)cur.pn * tstep;
    S.a_ready(cur);
    PG8_STAGE(PG8_SB(0, 0), cB, voffB); PG8_STAGE(PG8_SA(0, 0), cA, voffA); PG8_STAGE(PG8_SB(0, 1), cB + hstep, voffB); PG8_STAGE(PG8_SA(0, 1), cA + hstep, voffA);
    if (wr == 1) PG8_BAR;
    PG8_WAIT_V(4); PG8_BAR;
    PG8_STAGE(PG8_SB(1, 0), cB + kstep, voffB); PG8_STAGE(PG8_SA(1, 0), cA + kstep, voffA); PG8_STAGE(PG8_SB(1, 1), cB + hstep + kstep, voffB);
    PG8_WAIT_V(6); PG8_BAR;
    for (;;) {
        const bool has_next = S.next(ui + 1, nxt);
        const char* nA = has_next ? (const char*)g.A + (size_t)nxt.pm * tstep : cA; const char* nB = has_next ? (const char*)g.Bt + (size_t)nxt.pn * tstep : cB;
        for (int t = 0; t < nt; t += 2) {
            const bool last = (t == nt - 2);
            const char* a1 = cA + (size_t)(t + 1) * kstep;
            const char* a2 = last ? nA : cA + (size_t)(t + 2) * kstep; const char* b2 = last ? nB : cB + (size_t)(t + 2) * kstep;
            const char* a3 = a2 + kstep; const char* b3 = b2 + kstep;
            if (last && has_next) S.a_ready(nxt);
            PG8_LDB(B0, 0, 0); PG8_SCHED; PG8_LDA(At, 0, 0); PG8_STAGE(PG8_SA(1, 1), a1 + hstep, voffA);
            PG8_WAIT_L(8); PG8_BAR; PG8_WAIT_L(0); PG8_MMA(0, 0, At, B0); PG8_BAR; PG8_SCHED;
            PG8_LDB(B1, 0, 1); PG8_STAGE(PG8_SB(0, 0), b2, voffB);
            PG8_BAR; PG8_WAIT_L(0); PG8_MMA(0, 1, At, B1); PG8_BAR;
            PG8_LDA(At, 0, 1); PG8_STAGE(PG8_SA(0, 0), a2, voffA);
            PG8_BAR; PG8_WAIT_L(0); PG8_MMA(1, 0, At, B0); PG8_BAR; PG8_SCHED;
            PG8_STAGE(PG8_SB(0, 1), b2 + hstep, voffB);
            PG8_WAIT_V(6); PG8_BAR; PG8_MMA(1, 1, At, B1); PG8_BAR;
            PG8_LDB(B0, 1, 0); PG8_SCHED; PG8_LDA(At, 1, 0); PG8_STAGE(PG8_SA(0, 1), a2 + hstep, voffA);
            PG8_WAIT_L(8); PG8_BAR; PG8_WAIT_L(0); PG8_MMA(0, 0, At, B0); PG8_BAR; PG8_SCHED;
            PG8_LDB(B1, 1, 1); PG8_STAGE(PG8_SB(1, 0), b3, voffB);
            PG8_BAR; PG8_WAIT_L(0); PG8_MMA(0, 1, At, B1); PG8_BAR;
            PG8_LDA(At, 1, 1); PG8_STAGE(PG8_SA(1, 0), a3, voffA);
            PG8_BAR; PG8_WAIT_L(0); PG8_MMA(1, 0, At, B0); PG8_BAR; PG8_SCHED;
            PG8_STAGE(PG8_SB(1, 1), b3 + hstep, voffB);
            PG8_WAIT_V(6); PG8_BAR; PG8_MMA(1, 1, At, B1); PG8_BAR;
        }
        { int tz = threadIdx.x; asm volatile("" : "+v"(tz)); const int wz = tz >> 6, lz = tz & 63;
          E(acc, cur, wz >> 2, wz & 3, lz & 15, lz >> 4); } S.done(cur);
        if (!has_next) break;
#pragma unroll
        for (int a = 0; a < 2; ++a)
#pragma unroll
            for (int b = 0; b < 2; ++b)
#pragma unroll
                for (int m = 0; m < 4; ++m)
#pragma unroll
                    for (int n = 0; n < 2; ++n) acc[a][b][m][n] = (f32x4){0.f, 0.f, 0.f, 0.f};
        cur = nxt; cA = nA; cB = nB; ++ui;
    }
    PG8_WAIT_V(0);
    if (wr == 0) PG8_BAR;
    PG8_BAR;
#undef PG8_SA
#undef PG8_SB
#undef PG8_STAGE
#undef PG8_LDA
#undef PG8_LDB
#undef PG8_MMA
#undef PG8_WAIT_V
#undef PG8_WAIT_L
#undef PG8_BAR
#undef PG8_SCHED
}
#endif
}

constexpr int MBIG = (NP / 256) * 256;
template <class F> DEV void small_gemm(const bf16_t* A, const bf16_t* Bt, int K, unsigned char* lds, const F& f) {
    const int tid = threadIdx.x, lane = tid & 63, w = tid >> 6, g = lane >> 4, c16 = lane & 15;
    const int tiles_m = (NTOK - MBIG + 63) / 64, ntiles = tiles_m * 32, kw = K / 8;
    float* part = (float*)lds;
    for (int tl = blockIdx.x; tl < ntiles; tl += gridDim.x) {
        const int r0 = MBIG + (tl / 32) * 64, n0 = (tl % 32) * 64;
        f32x4 acc[4][4];
#pragma unroll
        for (int i = 0; i < 4; ++i)
#pragma unroll
            for (int j = 0; j < 4; ++j) acc[i][j] = (f32x4){0.f, 0.f, 0.f, 0.f};
        for (int k0 = w * kw; k0 < (w + 1) * kw; k0 += 128) {
            bf16x8 af[4][4], bfr[4][4];
#pragma unroll
            for (int u = 0; u < 4; ++u)
#pragma unroll
                for (int i = 0; i < 4; ++i) { int arow = r0 + 16 * i + c16; if (arow >= MPAD) arow = MPAD - 1;
                    af[u][i] = *(const bf16x8*)(A + (size_t)arow * K + k0 + 32 * u + 8 * g); bfr[u][i] = *(const bf16x8*)(Bt + (size_t)(n0 + 16 * i + c16) * K + k0 + 32 * u + 8 * g); }
#pragma unroll
            for (int u = 0; u < 4; ++u)
#pragma unroll
                for (int i = 0; i < 4; ++i)
#pragma unroll
                    for (int j = 0; j < 4; ++j) acc[i][j] = MFMA_BF16(af[u][i], bfr[u][j], acc[i][j]);
        }
#pragma unroll
        for (int i = 0; i < 4; ++i)
#pragma unroll
            for (int j = 0; j < 4; ++j)
#pragma unroll
                for (int r = 0; r < 4; ++r) part[(w * 64 + 16 * i + 4 * g + r) * 68 + 16 * j + c16] = acc[i][j][r];
        __syncthreads();
        {
            const int row = tid >> 3, c8 = (tid & 7) * 8; f32x4 s0 = (f32x4){0.f, 0.f, 0.f, 0.f}, s1 = s0;
#pragma unroll
            for (int ww = 0; ww < 8; ++ww) { s0 += *(const f32x4*)(part + (ww * 64 + row) * 68 + c8); s1 += *(const f32x4*)(part + (ww * 64 + row) * 68 + c8 + 4); }
            if (r0 + row < NTOK) f(r0 + row, n0 + c8, s0, s1);
        }
        __syncthreads();
    }
}
struct SmallResid { const float* xlo; const float* xhi; const float* gmod; float* out;
    DEV void operator()(int row, int col, f32x4 v0, f32x4 v1) const { const float* xr = (row < NP ? xlo + (size_t)row * D : xhi + (size_t)(row - NP) * D) + col; const float* gr = gmod + (size_t)tok_batch(row) * MODW + col;
        float* o = out + (size_t)row * D + col; *(f32x4*)o = *(const f32x4*)xr + *(const f32x4*)gr * v0; *(f32x4*)(o + 4) = *(const f32x4*)(xr + 4) + *(const f32x4*)(gr + 4) * v1; } };
struct SmallF32 { float* out; DEV void operator()(int row, int col, f32x4 v0, f32x4 v1) const { float* o = out + (size_t)row * D + col; *(f32x4*)o = v0; *(f32x4*)(o + 4) = v1; } };

DEV void transpose_tile(const float* src, int ld_src, bf16_t* dst, int ld_dst, float* tile) {
    const int tid = threadIdx.x;
#pragma unroll
    for (int i = 0; i < 2; ++i) { const int idx = tid + i * 512, r = idx >> 4, c4 = idx & 15; const f32x4 v = *(const f32x4*)(src + (size_t)r * ld_src + c4 * 4);
        float* t = tile + r * 65 + c4 * 4; t[0] = v[0]; t[1] = v[1]; t[2] = v[2]; t[3] = v[3]; }
    __syncthreads();
    const int n = tid >> 3, kg = tid & 7; const float* t = tile + (kg * 8) * 65 + n;
    u32x4 w; w.x = pack2(t[0], t[65]); w.y = pack2(t[2 * 65], t[3 * 65]); w.z = pack2(t[4 * 65], t[5 * 65]); w.w = pack2(t[6 * 65], t[7 * 65]);
    *(u32x4*)(dst + (size_t)n * ld_dst + kg * 8) = w;
    __syncthreads();
}
DEV int cvt_job_tiles(int j) { const int K = j < 9 ? 2048 : 256; const int N = j < 2 ? NMOD : (j == 2 ? 2 * D : (j < 5 ? ZW : (j < 9 ? D : 256))); return (K / 64) * (N / 64); }
constexpr int TBL_SLOT = 10240, TBL_VP1 = 4 * NE - 2 * TBL_SLOT;
DEV int gemm_in_idle_blocks() { const int nwg = (MPAD / 256) * (ZW / 256), G = (int)gridDim.x, rounds = (nwg + G - 1) / G, full = nwg - (rounds - 1) * G; return G - full; }
DEV bool tbl_deferred() { return gemm_in_idle_blocks() >= 32; }
DEV void table_row_to_fp8(const Params& p, int vr, int lane) {
    const int l = vr / (2 * NE), which = (vr % (2 * NE)) / NE, e = vr % NE, rr = l * NE + e;
    const float* src = (which ? p.peer_v : p.peer_u) + (size_t)rr * D; unsigned char* tab = (which ? p.v8 : p.u8) + (size_t)l * NE * D;
    f32x4 v[8]; float am = 0.f;
#pragma unroll
    for (int k = 0; k < 8; ++k) { v[k] = *(const f32x4*)(src + 4 * lane + 256 * k); am = fmaxf(am, fmaxf(fmaxf(fabsf(v[k][0]), fabsf(v[k][1])), fmaxf(fabsf(v[k][2]), fabsf(v[k][3])))); }
    am = wave_max(am);
    const float sc = am > 0.f ? 224.0f / am : 1.0f;
#pragma unroll
    for (int k = 0; k < 8; ++k) *(unsigned*)(tab + ((size_t)(2 * k + (lane >> 5)) * NE + e) * 128 + 4 * (lane & 31)) = fp8x4_enc(v[k][0] * sc, v[k][1] * sc, v[k][2] * sc, v[k][3] * sc);
    if (lane == 0) (which ? p.sv : p.su)[rr] = am > 0.f ? am * (1.0f / 224.0f) : 1.0f;
}
DEV void phase_tbl_slot(const Params& p, int l) {
    const int idle = gemm_in_idle_blocks(), first = (int)gridDim.x - idle;
    if (idle < 32 || (int)blockIdx.x < first) return;
    const int gw = ((int)blockIdx.x - first) * 8 + wave_id(), nw = idle * 8, lo = TBL_VP1 + l * TBL_SLOT;
    for (int vr = lo + gw; vr < lo + TBL_SLOT; vr += nw) table_row_to_fp8(p, vr, threadIdx.x & 63);
}
DEV void phase_convert(const Params& p, unsigned char* lds, int part) {
    float* tile = (float*)lds;
    const int tid = threadIdx.x;
    const int q_lo = part == 0 ? 0 : 3, q_hi = part == 0 ? 3 : 17;
    int total = 0;
#pragma unroll
    for (int q = 0; q < 17; ++q) if (q >= q_lo && q < q_hi) total += cvt_job_tiles(q);
    for (int tl = blockIdx.x; tl < total; tl += gridDim.x) {
        int j = 0, loc = 0, base = 0;
#pragma unroll
        for (int q = 0; q < 17; ++q) if (q >= q_lo && q < q_hi) { const int cnt = cvt_job_tiles(q); if (tl >= base && tl < base + cnt) { j = q; loc = tl - base; } base += cnt; }
        const float* src; bf16_t* dst; int K = 2048, N;
        if (j < 2) { N = NMOD; src = p.w_ada + (size_t)j * 2048 * NMOD; dst = p.wt_ada + (size_t)j * NMOD * 2048; }
        else if (j == 2) { N = 2 * D; src = p.w_ada_final; dst = p.wt_ada + (size_t)2 * NMOD * 2048; }
        else if (j < 5) { N = ZW; src = p.w_in + (size_t)(j - 3) * 2048 * ZW; dst = p.wt_in + (size_t)(j - 3) * ZW * 2048; }
        else if (j < 7) { N = D; src = p.w_out + (size_t)(j - 5) * D * D; dst = p.wt_out + (size_t)(j - 5) * D * D; }
        else if (j < 9) { N = D; src = p.peer_wq + (size_t)(j - 7) * D * D; dst = p.wt_q + (size_t)(j - 7) * D * D; }
        else { K = 256; N = 256; src = p.pool_w + (size_t)(j - 9) * 65536; dst = p.wt_pool + (size_t)(j - 9) * 65536; }
        const int ntn = N / 64, kt = loc / ntn, nt = loc % ntn;
        transpose_tile(src + (size_t)kt * 64 * N + nt * 64, N, dst + (size_t)nt * 64 * K + kt * 64, K, tile);
    }
    const size_t gt = (size_t)blockIdx.x * 512 + tid, gs = (size_t)gridDim.x * 512;
    if (part == 1) {
        constexpr int NADA = MODW / 256;
        const int vend = tbl_deferred() ? TBL_VP1 : 4 * NE, R1 = (vend / 8) * 7;
        const bool uneven = (int)gridDim.x > NADA + 16;
        for (int seg = 0; seg < 2; ++seg) {
            int gw, nw, r_lo, r_hi;
            if (!uneven) { if (seg) break; gw = blockIdx.x * 8 + wave_id(); nw = gridDim.x * 8; r_lo = 0; r_hi = vend; }
            else if (seg == 0) { gw = blockIdx.x * 8 + wave_id(); nw = gridDim.x * 8; r_lo = 0; r_hi = R1; }
            else { if ((int)blockIdx.x < NADA) break; gw = ((int)blockIdx.x - NADA) * 8 + wave_id(); nw = ((int)gridDim.x - NADA) * 8; r_lo = R1; r_hi = vend; }
            for (int vr = r_lo + gw; vr < r_hi; vr += nw) table_row_to_fp8(p, vr, tid & 63);
        }
    }
    if (part == 0) for (size_t i = gt; i < (size_t)256 * D / 8; i += gs) {
        const int row = (int)(i / (D / 8)), c8 = (int)(i % (D / 8)) * 8; u32x4 w = (u32x4){0u, 0u, 0u, 0u};
        if (row < NC) { const float* s = (row < PB ? p.c_prompt + (size_t)row * D : p.c_sample + (size_t)(row - PB) * D) + c8;
            const f32x4 a = *(const f32x4*)s, b = *(const f32x4*)(s + 4);
            w.x = pack2(siluf_(a[0]), siluf_(a[1])); w.y = pack2(siluf_(a[2]), siluf_(a[3])); w.z = pack2(siluf_(b[0]), siluf_(b[1])); w.w = pack2(siluf_(b[2]), siluf_(b[3])); }
        *(u32x4*)(p.csil + i * 8) = w;
    }
}

DEV void phase_norm(const Params& p, const float* xlo, const float* xhi, const float* gn, int sh_off, int sc_off, bf16_t* obf, float* of32) {
    const int lane = threadIdx.x & 63, gw = blockIdx.x * 8 + wave_id(), nw = gridDim.x * 8;
    for (int t = gw; t < NTOK; t += nw) {
        const float* xr = t < NP ? xlo + (size_t)t * D : xhi + (size_t)(t - NP) * D;
        const float* mrow = p.modbuf + (size_t)tok_batch(t) * MODW;
        f32x4 v[8]; float ss = 0.f;
#pragma unroll
        for (int c = 0; c < 4; ++c) { const int col = c * 512 + lane * 8; v[2 * c] = *(const f32x4*)(xr + col); v[2 * c + 1] = *(const f32x4*)(xr + col + 4);
#pragma unroll
            for (int j = 0; j < 4; ++j) ss += v[2 * c][j] * v[2 * c][j] + v[2 * c + 1][j] * v[2 * c + 1][j]; }
        ss = wave_sum(ss);
        const float rstd = rsqrtf(ss * (1.0f / D) + EPS);
#pragma unroll
        for (int c = 0; c < 4; ++c) { const int col = c * 512 + lane * 8; f32x4 y[2];
#pragma unroll
            for (int q = 0; q < 2; ++q) { const f32x4 g4 = *(const f32x4*)(gn + col + 4 * q), sc = *(const f32x4*)(mrow + sc_off + col + 4 * q), sh = *(const f32x4*)(mrow + sh_off + col + 4 * q);
                y[q] = (v[2 * c + q] * rstd) * g4 * (sc + 1.0f) + sh; }
            if (obf) { u32x4 w; w.x = pack2(y[0][0], y[0][1]); w.y = pack2(y[0][2], y[0][3]); w.z = pack2(y[1][0], y[1][1]); w.w = pack2(y[1][2], y[1][3]); *(u32x4*)(obf + (size_t)t * D + col) = w; }
            else { *(f32x4*)(of32 + (size_t)t * D + col) = y[0]; *(f32x4*)(of32 + (size_t)t * D + col + 4) = y[1]; }
        }
    }
}

namespace hg {
constexpr int QS = 136, VS = 72;
constexpr int O_QT = 0, O_QH = O_QT + 64 * QS * 2, O_KT = O_QH + 64 * QS * 2, O_KDT = O_KT + 160 * QS * 2, O_VT = O_KDT + 128 * VS * 2,
              O_AB = O_VT + 128 * VS * 2, O_GS = O_AB + 64 * VS * 2, O_END = O_GS + 4 * 128 * 4;
constexpr int OS = 132;
static_assert(O_END <= 163840 - 64, "HGRN LDS layout too large");
constexpr int NCHUNK = SEQ / 64, NUNIT = PB * HH * NCHUNK;
}
DEV int kt_rowbase(int i) { return i == 0 ? 0 : (i == 1 ? 16 : (i == 2 ? 48 : 96)); }

DEV void hgrn_pre_unit(const Params& p, int l, int unit, unsigned char* lds) {
    using namespace hg;
    const int tid = threadIdx.x, lane = tid & 63, w = tid >> 6, g = lane >> 4, c16 = lane & 15;
    const int c = unit % NCHUNK, bh = unit / NCHUNK, b = bh / HH, h = bh % HH;
    bf16_t* Qt = (bf16_t*)(lds + O_QT); bf16_t* Qh = (bf16_t*)(lds + O_QH); bf16_t* Kt = (bf16_t*)(lds + O_KT);
    bf16_t* Kdt = (bf16_t*)(lds + O_KDT); bf16_t* Vt = (bf16_t*)(lds + O_VT); bf16_t* Ab = (bf16_t*)(lds + O_AB); float* Gs = (float*)(lds + O_GS);
    const int kk = tid & 127, sj = tid >> 7;
    float lbv = 0.f;
    if (l > 0) lbv = sigmoidf_(p.lb_logits[HH * HD + h * HD + kk] - p.lb_logits[h * HD + kk]);
    const float oml = 1.0f - lbv;
    for (int i = tid; i < 64 * VS / 2; i += 512) ((unsigned*)Ab)[i] = 0u;
    const size_t row0 = (size_t)b * SEQ + c * 64;
    float Gl[16], qv[16], kv[16];
    {
        const bf16_t* zr = p.z + (row0 + sj * 16) * ZW + h * HD + kk;
        unsigned short zq16[16], zf16[16], zi16[16];
#pragma unroll
        for (int s = 0; s < 16; ++s) { zq16[s] = zr[(size_t)s * ZW]; zf16[s] = zr[(size_t)s * ZW + 1024]; zi16[s] = zr[(size_t)s * ZW + 2048]; }
        float run = 0.f; unsigned vpk[8];
#pragma unroll
        for (int s = 0; s < 16; ++s) {
            const float zq = bf2f(zq16[s]), zf = fminf(fmaxf(bf2f(zf16[s]), -80.f), 80.f);
            const float e = __expf(-zf), sg = 1.0f / (1.0f + e);
            const float f = lbv + oml * sg;
            run += __logf(f); Gl[s] = run;
            kv[s] = oml * (e * sg);
            qv[s] = siluf_(zq);
            if (s & 1) vpk[s >> 1] |= (unsigned)zi16[s] << 16; else vpk[s >> 1] = zi16[s];
        }
        Gs[sj * 128 + kk] = run;
        *(u32x4*)(Vt + kk * VS + sj * 16) = (u32x4){vpk[0], vpk[1], vpk[2], vpk[3]}; *(u32x4*)(Vt + kk * VS + sj * 16 + 8) = (u32x4){vpk[4], vpk[5], vpk[6], vpk[7]};
    }
    __syncthreads();
    float Gend;
    {
        const float g0 = Gs[kk], g1 = Gs[128 + kk], g2 = Gs[256 + kk], g3 = Gs[384 + kk];
        float Gb[4]; Gb[0] = 0.f; Gb[1] = g0; Gb[2] = g0 + g1; Gb[3] = g0 + g1 + g2; Gend = Gb[3] + g3;
        const float Gbj = sj == 0 ? Gb[0] : (sj == 1 ? Gb[1] : (sj == 2 ? Gb[2] : Gb[3]));
        const float eGb = __expf(Gbj);
        unsigned kd[8]; unsigned qh[8];
#pragma unroll
        for (int s = 0; s < 16; ++s) {
            const int t = sj * 16 + s;
            const float q1 = qv[s] * __expf(Gl[s]);
            Qt[t * QS + kk] = (bf16_t)f2bf(q1);
            const unsigned qhv = f2bf(q1 * eGb);
            Qh[t * QS + kk] = (bf16_t)qhv;
#pragma unroll
            for (int i = 0; i < 4; ++i) if (i >= sj) Kt[(kt_rowbase(i) + t) * QS + kk] = (bf16_t)f2bf(kv[s] * __expf(fminf(Gb[i] - Gbj - Gl[s], 60.f)));
            const unsigned kdv = f2bf(kv[s] * __expf(Gend - Gbj - Gl[s]));
            if (s & 1) kd[s >> 1] |= kdv << 16; else kd[s >> 1] = kdv;
        }
        *(u32x4*)(Kdt + kk * VS + sj * 16) = (u32x4){kd[0], kd[1], kd[2], kd[3]}; *(u32x4*)(Kdt + kk * VS + sj * 16 + 8) = (u32x4){kd[4], kd[5], kd[6], kd[7]};
        if (sj == 0) p.hg_gam[(size_t)unit * HD + kk] = __expf(Gend);
    }
    __syncthreads();
    {
        const int t = tid >> 3, part = tid & 7;
        const u32x4 a = *(const u32x4*)(Qh + t * QS + 16 * part), b2 = *(const u32x4*)(Qh + t * QS + 16 * part + 8);
        bf16_t* dst = p.hg_qh + (row0 + t) * 1024 + h * HD + 16 * part; *(u32x4*)dst = a; *(u32x4*)(dst + 8) = b2;
    }
    for (int blk = w; blk < 10; blk += 8) {
        int bi, bjj;
        if (blk == 0) { bi = 0; bjj = 0; } else if (blk < 3) { bi = 1; bjj = blk - 1; } else if (blk < 6) { bi = 2; bjj = blk - 3; } else { bi = 3; bjj = blk - 6; }
        f32x4 acc = (f32x4){0.f, 0.f, 0.f, 0.f};
#pragma unroll
        for (int ks = 0; ks < 4; ++ks) {
            const bf16x8 a = *(const bf16x8*)(Qt + (16 * bi + c16) * QS + 32 * ks + 8 * g);
            const bf16x8 bb = *(const bf16x8*)(Kt + (kt_rowbase(bi) + 16 * bjj + c16) * QS + 32 * ks + 8 * g);
            acc = MFMA_BF16(a, bb, acc);
        }
#pragma unroll
        for (int r = 0; r < 4; ++r) { const int tl = 4 * g + r; float v = acc[r]; if (bi == bjj && c16 > tl) v = 0.f; Ab[(16 * bi + tl) * VS + 16 * bjj + c16] = (bf16_t)f2bf(v); }
    }
    __syncthreads();
    {
        u32x2* oin = (u32x2*)(p.hg_oin + (size_t)unit * 64 * 128);
#pragma unroll
        for (int tt = 0; tt < 4; ++tt) {
            f32x4 acc = (f32x4){0.f, 0.f, 0.f, 0.f};
#pragma unroll
            for (int ks = 0; ks < 2; ++ks) {
                const bf16x8 a = *(const bf16x8*)(Ab + (16 * tt + c16) * VS + 32 * ks + 8 * g);
                const bf16x8 bb = *(const bf16x8*)(Vt + (16 * w + c16) * VS + 32 * ks + 8 * g);
                acc = MFMA_BF16(a, bb, acc);
            }
            oin[(tt * 8 + w) * 64 + lane] = (u32x2){pack2(acc[0], acc[1]), pack2(acc[2], acc[3])};
        }
        u32x2* ds = (u32x2*)(p.hg_ds + (size_t)unit * 128 * 128);
#pragma unroll
        for (int vt = 0; vt < 8; ++vt) {
            f32x4 acc = (f32x4){0.f, 0.f, 0.f, 0.f};
#pragma unroll
            for (int ks = 0; ks < 2; ++ks) {
                const bf16x8 a = *(const bf16x8*)(Kdt + (16 * w + c16) * VS + 32 * ks + 8 * g);
                const bf16x8 bb = *(const bf16x8*)(Vt + (16 * vt + c16) * VS + 32 * ks + 8 * g);
                acc = MFMA_BF16(a, bb, acc);
            }
            ds[(w * 8 + vt) * 64 + lane] = (u32x2){pack2(acc[0], acc[1]), pack2(acc[2], acc[3])};
        }
    }
    __syncthreads();
}

DEV void hgrn_scan_unit(const Params& p, int l, int su) {
    using namespace hg;
    const int tid = threadIdx.x, lane = tid & 63, w = tid >> 6, g = lane >> 4, c16 = lane & 15;
    const int vt = su % 8, bh = su / 8, b = bh / HH, h = bh % HH;
    f32x4 S = (f32x4){0.f, 0.f, 0.f, 0.f};
    constexpr int CB = NCHUNK < 16 ? NCHUNK : 16;
    static_assert(NCHUNK % CB == 0, "chunk batch");
    for (int c0 = 0; c0 < NCHUNK; c0 += CB) {
        u32x2 dw[CB]; f32x4 gm[CB];
#pragma unroll
        for (int i = 0; i < CB; ++i) { const size_t unit = (size_t)bh * NCHUNK + c0 + i;
            dw[i] = ((const u32x2*)(p.hg_ds + unit * 128 * 128))[(w * 8 + vt) * 64 + lane]; gm[i] = *(const f32x4*)(p.hg_gam + unit * HD + 16 * w + 4 * g); }
#pragma unroll
        for (int i = 0; i < CB; ++i) { const size_t unit = (size_t)bh * NCHUNK + c0 + i;
            u32x2 sw; sw.x = pack2(S[0], S[1]); sw.y = pack2(S[2], S[3]);
            *(u32x2*)(p.hg_sc + (unit * 128 + 16 * vt + c16) * 128 + 16 * w + 4 * g) = sw;
            const f32x4 d = (f32x4){lo16(dw[i].x), hi16(dw[i].x), lo16(dw[i].y), hi16(dw[i].y)};
            S = S * gm[i] + d; }
    }
    float* so = p.out + OFF_HP + ((size_t)(l * PB + b) * HH + h) * HD * HD;
#pragma unroll
    for (int r = 0; r < 4; ++r) so[(size_t)(16 * w + 4 * g + r) * HD + 16 * vt + c16] = S[r];
}

DEV void hgrn_post_unit(const Params& p, int l, int unit, unsigned char* lds) {
    using namespace hg;
    const int tid = threadIdx.x, lane = tid & 63, w = tid >> 6, g = lane >> 4, c16 = lane & 15;
    const int c = unit % NCHUNK, bh = unit / NCHUNK, b = bh / HH, h = bh % HH;
    float* Ob = (float*)lds;
    const size_t row0 = (size_t)b * SEQ + c * 64;
    const u32x2* oin = (const u32x2*)(p.hg_oin + (size_t)unit * 64 * 128);
    u32x2 ow[4];
#pragma unroll
    for (int tt = 0; tt < 4; ++tt) ow[tt] = oin[(tt * 8 + w) * 64 + lane];
    bf16x8 bfr[4], af[4][4];
    if (c > 0) {
#pragma unroll
        for (int ks = 0; ks < 4; ++ks) bfr[ks] = *(const bf16x8*)(p.hg_sc + ((size_t)unit * 128 + 16 * w + c16) * 128 + 32 * ks + 8 * g);
#pragma unroll
        for (int tt = 0; tt < 4; ++tt)
#pragma unroll
            for (int ks = 0; ks < 4; ++ks) af[tt][ks] = *(const bf16x8*)(p.hg_qh + (row0 + 16 * tt + c16) * 1024 + h * HD + 32 * ks + 8 * g);
    }
    const bf16_t* zgp = p.z + (row0 + (tid >> 3)) * ZW + 3072 + h * HD + 16 * (tid & 7);
    const u32x4 za = *(const u32x4*)zgp, zc = *(const u32x4*)(zgp + 8);
    f32x4 acc[4];
#pragma unroll
    for (int tt = 0; tt < 4; ++tt) acc[tt] = (f32x4){lo16(ow[tt].x), hi16(ow[tt].x), lo16(ow[tt].y), hi16(ow[tt].y)};
    if (c > 0) {
#pragma unroll
        for (int tt = 0; tt < 4; ++tt)
#pragma unroll
            for (int ks = 0; ks < 4; ++ks) acc[tt] = MFMA_BF16(af[tt][ks], bfr[ks], acc[tt]);
    }
#pragma unroll
    for (int tt = 0; tt < 4; ++tt)
#pragma unroll
        for (int r = 0; r < 4; ++r) Ob[(16 * tt + 4 * g + r) * OS + 16 * w + c16] = acc[tt][r];
    __syncthreads();
    {
        const int t = tid >> 3, part = tid & 7; const size_t row = row0 + t;
        float ov[16]; float ss = 0.f;
#pragma unroll
        for (int q = 0; q < 4; ++q) { const f32x4 x = *(const f32x4*)(Ob + t * OS + 16 * part + 4 * q); ov[4 * q] = x[0]; ov[4 * q + 1] = x[1]; ov[4 * q + 2] = x[2]; ov[4 * q + 3] = x[3];
            ss += x[0] * x[0] + x[1] * x[1] + x[2] * x[2] + x[3] * x[3]; }
        ss += __shfl_xor(ss, 1); ss += __shfl_xor(ss, 2); ss += __shfl_xor(ss, 4);
        const float rstd = rsqrtf(ss * (1.0f / HD) + EPS);
        const unsigned zw[8] = {za.x, za.y, za.z, za.w, zc.x, zc.y, zc.z, zc.w};
        const float* gn = p.hgrn_norm_g + l * HD + 16 * part;
        unsigned ow[8];
#pragma unroll
        for (int q = 0; q < 8; ++q) { const float a0 = ov[2 * q] * rstd * gn[2 * q] * siluf_(lo16(zw[q])), a1 = ov[2 * q + 1] * rstd * gn[2 * q + 1] * siluf_(hi16(zw[q])); ow[q] = pack2(a0, a1); }
        bf16_t* dst = p.cat + row * D + h * HD + 16 * part;
        *(u32x4*)dst = (u32x4){ow[0], ow[1], ow[2], ow[3]}; *(u32x4*)(dst + 8) = (u32x4){ow[4], ow[5], ow[6], ow[7]};
    }
    __syncthreads();
}

DEV void hgrn_sample_unit(const Params& p, int l, int unit, unsigned char* lds) {
    const int tid = threadIdx.x, lane = tid & 63, w = tid >> 6;
    const int b = unit / HH, h = unit % HH;
    float* fS = (float*)lds; float* kS = fS + 512; float* qS = kS + 512; float* vS = qS + 512; float* red = vS + 512; float* part = red + 4 * 4 * 128;
    const int r0 = NP + b * DSEQ;
    {
        const int t = tid >> 7, kk = tid & 127; const bf16_t* zr = p.z + (size_t)(r0 + t) * ZW + h * HD + kk;
        float lbv = 0.f; if (l > 0) lbv = sigmoidf_(p.lb_logits[HH * HD + h * HD + kk] - p.lb_logits[h * HD + kk]);
        const float zq = bf2f(zr[0]), zf = fminf(fmaxf(bf2f(zr[1024]), -80.f), 80.f), zi = bf2f(zr[2048]);
        const float e = __expf(-zf), sg = 1.0f / (1.0f + e);
        fS[tid] = lbv + (1.0f - lbv) * sg; kS[tid] = (1.0f - lbv) * (e * sg); qS[tid] = siluf_(zq); vS[tid] = zi;
    }
    const int v = tid & 127, kq = tid >> 7;
    const float* s0 = p.state_hgrn + ((size_t)(l * DB + b) * HH + h) * HD * HD + (size_t)(32 * kq) * HD + v;
    float S[32];
#pragma unroll
    for (int i = 0; i < 32; ++i) S[i] = s0[(size_t)i * HD];
    __syncthreads();
#pragma unroll
    for (int t = 0; t < 4; ++t) {
        const float vv = vS[t * 128 + v]; float po = 0.f;
#pragma unroll
        for (int i = 0; i < 32; ++i) { const int kk = t * 128 + 32 * kq + i; S[i] = fS[kk] * S[i] + kS[kk] * vv; po += qS[kk] * S[i]; }
        red[(t * 4 + kq) * 128 + v] = po;
    }
    float* so = p.out + OFF_HS + ((size_t)(l * DB + b) * HH + h) * HD * HD + (size_t)(32 * kq) * HD + v;
#pragma unroll
    for (int i = 0; i < 32; ++i) so[(size_t)i * HD] = S[i];
    __syncthreads();
    {
        const int t = tid >> 7; const float o = red[(t * 4 + 0) * 128 + v] + red[(t * 4 + 1) * 128 + v] + red[(t * 4 + 2) * 128 + v] + red[(t * 4 + 3) * 128 + v];
        const float ss = wave_sum(o * o);
        if (lane == 0) part[w] = ss;
        __syncthreads();
        const float tot = part[2 * t] + part[2 * t + 1];
        const float rstd = rsqrtf(tot * (1.0f / HD) + EPS);
        const float zg = bf2f(p.z[(size_t)(r0 + t) * ZW + 3072 + h * HD + v]);
        p.cat[(size_t)(r0 + t) * D + h * HD + v] = (bf16_t)f2bf(o * rstd * p.hgrn_norm_g[l * HD + v] * siluf_(zg));
    }
    __syncthreads();
}

DEV void pool_pre_unit(const Params& p, int l, int unit) {
    const int tid = threadIdx.x, tk = tid >> 7, cg = tid & 127, c = cg * 8, gi = cg >> 5, wnd = 2 << gi;
    const int r = unit * 4 + tk;
    if (r >= NTOK) return;
    f32x2 sum[4] = {{0.f, 0.f}, {0.f, 0.f}, {0.f, 0.f}, {0.f, 0.f}}; float cur[8];
    float cnt;
    if (r < NP) {
        const int t = r % SEQ; const int n = (wnd < t + 1) ? wnd : (t + 1); cnt = (float)n;
        u32x4 q[16];
#pragma unroll
        for (int j = 0; j < 16; ++j) q[j] = (j < n) ? *(const u32x4*)(p.z + (size_t)(r - j) * ZW + 4096 + c) : (u32x4){0u, 0u, 0u, 0u};
#pragma unroll
        for (int j = 0; j < 16; ++j) { sum[0] += (f32x2){lo16(q[j].x), hi16(q[j].x)}; sum[1] += (f32x2){lo16(q[j].y), hi16(q[j].y)}; sum[2] += (f32x2){lo16(q[j].z), hi16(q[j].z)}; sum[3] += (f32x2){lo16(q[j].w), hi16(q[j].w)}; }
        cur[0] = lo16(q[0].x); cur[1] = hi16(q[0].x); cur[2] = lo16(q[0].y); cur[3] = hi16(q[0].y); cur[4] = lo16(q[0].z); cur[5] = hi16(q[0].z); cur[6] = lo16(q[0].w); cur[7] = hi16(q[0].w);
        if (t >= SEQ - PBUF) { float* o = p.out + OFF_PP + ((size_t)(l * PB + r / SEQ) * PBUF + (t - (SEQ - PBUF))) * PW + c;
            *(f32x4*)o = (f32x4){cur[0], cur[1], cur[2], cur[3]}; *(f32x4*)(o + 4) = (f32x4){cur[4], cur[5], cur[6], cur[7]}; }
    } else {
        const int bb = (r - NP) / DSEQ, t = (r - NP) % DSEQ; cnt = (float)wnd;
        const float* sp = p.state_pool + (size_t)(l * DB + bb) * PBUF * PW + c;
        u32x4 q[4]; f32x4 sa[15], sb[15];
#pragma unroll
        for (int j = 0; j < 4; ++j) q[j] = (j <= t && j < wnd) ? *(const u32x4*)(p.z + (size_t)(NP + bb * DSEQ + t - j) * ZW + 4096 + c) : (u32x4){0u, 0u, 0u, 0u};
#pragma unroll
        for (int j = 1; j < 16; ++j) {
            const int back = j - t;
            const bool use = (back >= 1) && (j < wnd);
            const float* srow = sp + (size_t)(PBUF - (use ? back : 1)) * PW;
            sa[j - 1] = use ? *(const f32x4*)srow : (f32x4){0.f, 0.f, 0.f, 0.f}; sb[j - 1] = use ? *(const f32x4*)(srow + 4) : (f32x4){0.f, 0.f, 0.f, 0.f};
        }
#pragma unroll
        for (int j = 0; j < 4; ++j) { sum[0] += (f32x2){lo16(q[j].x), hi16(q[j].x)}; sum[1] += (f32x2){lo16(q[j].y), hi16(q[j].y)}; sum[2] += (f32x2){lo16(q[j].z), hi16(q[j].z)}; sum[3] += (f32x2){lo16(q[j].w), hi16(q[j].w)}; }
#pragma unroll
        for (int j = 0; j < 15; ++j) { sum[0] += (f32x2){sa[j][0], sa[j][1]}; sum[1] += (f32x2){sa[j][2], sa[j][3]}; sum[2] += (f32x2){sb[j][0], sb[j][1]}; sum[3] += (f32x2){sb[j][2], sb[j][3]}; }
        cur[0] = lo16(q[0].x); cur[1] = hi16(q[0].x); cur[2] = lo16(q[0].y); cur[3] = hi16(q[0].y); cur[4] = lo16(q[0].z); cur[5] = hi16(q[0].z); cur[6] = lo16(q[0].w); cur[7] = hi16(q[0].w);
        float* ob = p.out + OFF_PS + (size_t)(l * DB + bb) * PBUF * PW + c;
        { float* o = ob + (size_t)(11 + t) * PW; *(f32x4*)o = (f32x4){cur[0], cur[1], cur[2], cur[3]}; *(f32x4*)(o + 4) = (f32x4){cur[4], cur[5], cur[6], cur[7]}; }
        for (int i = t; i < 11; i += 4) { const float* s2 = sp + (size_t)(4 + i) * PW; float* o = ob + (size_t)i * PW; *(f32x4*)o = *(const f32x4*)s2; *(f32x4*)(o + 4) = *(const f32x4*)(s2 + 4); }
    }
    const float inv = 1.0f / cnt;
    u32x4 w; w.x = pack2(sum[0][0] * inv - cur[0], sum[0][1] * inv - cur[1]); w.y = pack2(sum[1][0] * inv - cur[2], sum[1][1] * inv - cur[3]);
    w.z = pack2(sum[2][0] * inv - cur[4], sum[2][1] * inv - cur[5]); w.w = pack2(sum[3][0] * inv - cur[6], sum[3][1] * inv - cur[7]);
    *(u32x4*)(p.pooled + ((size_t)gi * MPAD + r) * 256 + (c & 255)) = w;
}

#ifndef PROBE_SUB
#define PROBE_SUB 0
#endif
DEV void phase_mix1(const Params& p, int l, unsigned char* lds) {
    for (int rep = 0; rep < (PROBE_SUB == 1 ? 2 : 1); ++rep) for (int u = blockIdx.x; u < hg::NUNIT; u += gridDim.x) hgrn_pre_unit(p, l, u, lds);
    for (int rep = 0; rep < (PROBE_SUB == 2 ? 2 : 1); ++rep) for (int u = blockIdx.x; u < DB * HH; u += gridDim.x) hgrn_sample_unit(p, l, u, lds);
    for (int rep = 0; rep < (PROBE_SUB == 3 ? 2 : 1); ++rep) for (int u = blockIdx.x; u < (NTOK + 3) / 4; u += gridDim.x) pool_pre_unit(p, l, u);
}
DEV void phase_mix2(const Params& p, int l) { for (int u = blockIdx.x; u < PB * HH * 8; u += gridDim.x) hgrn_scan_unit(p, l, u); }
DEV void phase_mix3(const Params& p, int l, unsigned char* lds) { for (int u = blockIdx.x; u < hg::NUNIT; u += gridDim.x) hgrn_post_unit(p, l, u, lds); }

#ifdef HIPEMU
#define MBCNT(mask) __builtin_popcountll((mask) & ((1ull << emu_lane()) - 1ull))
#define POPC64(m) __builtin_popcountll(m)
#else
#define MBCNT(mask) ((int)__builtin_amdgcn_mbcnt_hi((unsigned)((mask) >> 32), __builtin_amdgcn_mbcnt_lo((unsigned)(mask), 0u)))
#define POPC64(m) __popcll(m)
#endif
DEV unsigned fkey(float f) { const unsigned u = __float_as_uint(f); return u ^ ((unsigned)((int)u >> 31) | 0x80000000u); }
DEV unsigned long long lowest_n_bits(unsigned long long m, int n) { unsigned long long r = 0ull; while (n > 0 && m) { const unsigned long long b = m & (~m + 1ull); r |= b; m ^= b; --n; } return r; }
#ifdef HIPEMU
#define DPPU_XOR1(v) __shfl((v), emu_lane() ^ 1)
#define DPPU_XOR2(v) __shfl((v), emu_lane() ^ 2)
#define DPPU_HMIRROR(v) __shfl((v), (emu_lane() & ~7) | (7 - (emu_lane() & 7)))
#else
template <int CTRL> DEV unsigned dpp_u(unsigned v) { return (unsigned)__builtin_amdgcn_update_dpp(0, (int)v, CTRL, 0xf, 0xf, true); }
#define DPPU_XOR1(v) dpp_u<0xB1>(v)
#define DPPU_XOR2(v) dpp_u<0x4E>(v)
#define DPPU_HMIRROR(v) dpp_u<0x141>(v)
#endif
template <int GL> DEV unsigned group_sum(unsigned c) { c += DPPU_XOR1(c); c += DPPU_XOR2(c); if (GL == 8) c += DPPU_HMIRROR(c); return c; }
template <int GL> DEV unsigned group_or(unsigned c) { c |= DPPU_XOR1(c); c |= DPPU_XOR2(c); if (GL == 8) c |= DPPU_HMIRROR(c); return c; }
template <int GL> DEV float group_maxf(float v) { v = fmaxf(v, DPP_XOR1(v)); v = fmaxf(v, DPP_XOR2(v)); if (GL == 8) v = fmaxf(v, DPP_HMIRROR(v)); return v; }
template <int GL> DEV float group_sumf(float v) { v += DPP_XOR1(v); v += DPP_XOR2(v); if (GL == 8) v += DPP_HMIRROR(v); return v; }
DEV unsigned bytesum(unsigned w) { return (w * 0x01010101u) >> 24; }
template <int GL> DEV unsigned group_excl_prefix(unsigned c, int sub) {
    const unsigned sh = 8u * (unsigned)(sub & 3);
    unsigned wlo = (GL == 4 || sub < 4) ? (c << sh) : 0u, whi = (GL == 8 && sub >= 4) ? (c << sh) : 0u;
    wlo = group_or<GL>(wlo);
    unsigned r;
    if (GL == 4) r = bytesum(wlo & ((1u << sh) - 1u));
    else { whi = group_or<GL>(whi); r = sub < 4 ? bytesum(wlo & ((1u << sh) - 1u)) : bytesum(wlo) + bytesum(whi & ((1u << sh) - 1u)); }
    return r;
}
DEV float fkey_inv(unsigned k) { return __uint_as_float((k & 0x80000000u) ? (k ^ 0x80000000u) : ~k); }
template <int NK> DEV unsigned count_above(const unsigned (&k)[NK], unsigned t) {
    unsigned c[4] = {0u, 0u, 0u, 0u};
#pragma unroll
    for (int i = 0; i < NK; ++i) c[i & 3] += (k[i] > t) ? 1u : 0u;
    return (c[0] + c[1]) + (c[2] + c[3]);
}
template <int GL, int NK> DEV unsigned group_top16(const unsigned (&k)[NK], bool active, int sub, unsigned& pos0) {
    unsigned mxk = 0u;
#pragma unroll
    for (int i = 0; i < NK; ++i) mxk = k[i] > mxk ? k[i] : mxk;
    { unsigned o = DPPU_XOR1(mxk); mxk = o > mxk ? o : mxk; o = DPPU_XOR2(mxk); mxk = o > mxk ? o : mxk; if (GL == 8) { o = DPPU_HMIRROR(mxk); mxk = o > mxk ? o : mxk; } }
    unsigned L0 = mxk > 0x01000000u ? mxk - 0x01000000u : 0u, c0 = group_sum<GL>(count_above<NK>(k, L0));
    unsigned L = c0 > 16u ? L0 + 1u : 0u, R = active ? mxk : 0u, cR = 0u;
    if (!active) L = 0u;
    if (c0 == 16u && active) { L = L0; R = L0; cR = 16u; }
    for (;;) {
        if (__ballot(L < R) == 0ull) break;
        const unsigned mid = L + ((R - L) >> 1);
        const unsigned c = group_sum<GL>(count_above<NK>(k, mid));
        const bool le = c <= 16u, hit = c == 16u;
        R = le ? mid : R; cR = le ? c : cR; L = hit ? mid : (le ? L : mid + 1u);
    }
    unsigned mask = 0u;
#pragma unroll
    for (int i = 0; i < NK; ++i) mask |= (k[i] > R) ? (1u << i) : 0u;
    const unsigned need = 16u - cR;
    if (__ballot(active && need > 0u) != 0ull) {
        unsigned eqm = 0u;
#pragma unroll
        for (int i = 0; i < NK; ++i) eqm |= (k[i] == R) ? (1u << i) : 0u;
        const unsigned eqc = (unsigned)__builtin_popcount(eqm), before = group_excl_prefix<GL>(eqc, sub);
        unsigned take = need > before ? need - before : 0u; if (take > eqc) take = eqc;
        if (!active) take = 0u;
        while (take > 0u) { const unsigned b = eqm & (~eqm + 1u); mask |= b; eqm ^= b; --take; }
    }
    if (!active) mask = 0u;
    pos0 = group_excl_prefix<GL>((unsigned)__builtin_popcount(mask), sub);
    return mask;
}
#ifdef HIPEMU
template <int J> DEV unsigned row_bcast_u(unsigned v) { return __shfl(v, (emu_lane() & ~15) | J); }
#else
template <int J> DEV unsigned row_bcast_u(unsigned v) { return (unsigned)__builtin_amdgcn_update_dpp(0, (int)v, 0x150 + J, 0xf, 0xf, true); }
#endif
template <int J> struct RowRank { static DEV unsigned run(unsigned v, int l16) { const unsigned b = row_bcast_u<J>(v); return (((b > v) || (b == v && J < l16)) ? 1u : 0u) + RowRank<J - 1>::run(v, l16); } };
template <> struct RowRank<-1> { static DEV unsigned run(unsigned, int) { return 0u; } };
struct CandTab { unsigned char ij[56]; };
DEV CandTab make_cand_tab() { CandTab t{}; int n = 0; for (int i = 0; i < 16; ++i) for (int j = 0; j < 16 / (i + 1); ++j) t.ij[n++] = (unsigned char)(i * 16 + j); for (; n < 56; ++n) t.ij[n] = 255; return t; }
constexpr int SEL_NT = 4;
constexpr int SEL_RS = 144;
DEV void select_step(const Params& p, int l, int tt0, int tstride, int ntile, int h, unsigned char* lds, const bf16x8 (&kh)[2][4], const bf16x8 (&kl)[2][4]) {
    const int tid = threadIdx.x, lane = tid & 63, w = tid >> 6, g = lane >> 4, c16 = lane & 15;
    constexpr int NTK = SEL_NT * 16;
    constexpr int QRS = 264;
    bf16_t* qh = (bf16_t*)lds;
    bf16_t* ql = qh + NTK * QRS;
    float* sc = (float*)(ql + NTK * QRS);
    float* ts = sc + 2 * NTK * SEL_RS;
    int* ti = (int*)(ts + 2 * NTK * 16);
    unsigned char* ctab = (unsigned char*)(ti + 2 * NTK * 16);
    if (tid == 0) { const CandTab t = make_cand_tab(); for (int n = 0; n < 56; ++n) ctab[n] = t.ij[n]; }
#pragma unroll
    for (int k = 0; k < SEL_NT; ++k) {
        const int tk = tid >> 5, part = tid & 31; const int tok = (tt0 + k * tstride) * 16 + tk;
        f32x4 a = (f32x4){0.f, 0.f, 0.f, 0.f}, b2 = a;
        if (k < ntile && tok < NTOK) { const float* q = p.qry + (size_t)tok * D + h * 256 + part * 8; a = *(const f32x4*)q; b2 = *(const f32x4*)(q + 4); }
        float ss = a[0] * a[0] + a[1] * a[1] + a[2] * a[2] + a[3] * a[3] + b2[0] * b2[0] + b2[1] * b2[1] + b2[2] * b2[2] + b2[3] * b2[3];
        ss += __shfl_xor(ss, 1); ss += __shfl_xor(ss, 2); ss += __shfl_xor(ss, 4); ss += __shfl_xor(ss, 8);
        const float rn = rsqrtf(ss * (1.0f / 128.0f) + EPS);
        const float v[8] = {a[0] * rn, a[1] * rn, a[2] * rn, a[3] * rn, b2[0] * rn, b2[1] * rn, b2[2] * rn, b2[3] * rn};
        unsigned hi[4], lo[4];
#pragma unroll
        for (int j = 0; j < 4; ++j) { hi[j] = pack2(v[2 * j], v[2 * j + 1]); lo[j] = pack2(v[2 * j] - lo16(hi[j]), v[2 * j + 1] - hi16(hi[j])); }
        *(u32x4*)(qh + (k * 16 + tk) * QRS + part * 8) = (u32x4){hi[0], hi[1], hi[2], hi[3]}; *(u32x4*)(ql + (k * 16 + tk) * QRS + part * 8) = (u32x4){lo[0], lo[1], lo[2], lo[3]};
    }
    __syncthreads();
    for (int k = 0; k < ntile; ++k) {
#pragma unroll
        for (int ph = 0; ph < 2; ++ph) {
            f32x4 acc = (f32x4){0.f, 0.f, 0.f, 0.f};
#pragma unroll
            for (int ks = 0; ks < 4; ++ks) {
                const bf16x8 ah = *(const bf16x8*)(qh + (k * 16 + c16) * QRS + ph * 128 + 32 * ks + 8 * g), al = *(const bf16x8*)(ql + (k * 16 + c16) * QRS + ph * 128 + 32 * ks + 8 * g);
                acc = MFMA_BF16(al, kh[ph][ks], acc); acc = MFMA_BF16(ah, kl[ph][ks], acc); acc = MFMA_BF16(ah, kh[ph][ks], acc);
            }
            const int kidx = 16 * w + c16;
#pragma unroll
            for (int r = 0; r < 4; ++r) sc[(ph * NTK + k * 16 + 4 * g + r) * SEL_RS + (kidx >> 5) * 36 + (kidx & 31)] = acc[r];
        }
    }
    __syncthreads();
    {
        const int row = tid >> 2, sub = tid & 3; const bool active = ((row % NTK) >> 4) < ntile;
        unsigned k[32];
#pragma unroll
        for (int i4 = 0; i4 < 8; ++i4) { const f32x4 v = *(const f32x4*)(sc + row * SEL_RS + sub * 36 + 4 * i4); k[4 * i4] = fkey(v[0]); k[4 * i4 + 1] = fkey(v[1]); k[4 * i4 + 2] = fkey(v[2]); k[4 * i4 + 3] = fkey(v[3]); }
        unsigned pos; const unsigned mask = group_top16<4, 32>(k, active, sub, pos);
#pragma unroll
        for (int i = 0; i < 32; ++i) if ((mask >> i) & 1u) { if (pos < 16u) { ts[row * 16 + pos] = fkey_inv(k[i]); ti[row * 16 + pos] = 32 * sub + i; } ++pos; }
    }
    __syncthreads();
    {
        float v4[4]; int i4[4]; unsigned rk[4];
#pragma unroll
        for (int r = 0; r < (2 * NTK) / 32; ++r) { const int row = (tid >> 4) + 32 * r; v4[r] = ts[row * 16 + (tid & 15)]; i4[r] = ti[row * 16 + (tid & 15)]; }
#pragma unroll
        for (int r = 0; r < (2 * NTK) / 32; ++r) rk[r] = RowRank<15>::run(fkey(v4[r]), tid & 15);
        __syncthreads();
#pragma unroll
        for (int r = 0; r < (2 * NTK) / 32; ++r) { const int row = (tid >> 4) + 32 * r; ts[row * 16 + rk[r]] = v4[r]; ti[row * 16 + rk[r]] = i4[r]; }
    }
    __syncthreads();
    {
        const int tk = tid >> 3, sub = tid & 7; const bool active = (tk >> 4) < ntile;
        unsigned k[7]; unsigned cij[7];
#pragma unroll
        for (int q = 0; q < 7; ++q) { cij[q] = ctab[7 * sub + q]; const bool ok = cij[q] != 255u;
            k[q] = ok ? fkey(ts[tk * 16 + (cij[q] >> 4)] + ts[(NTK + tk) * 16 + (cij[q] & 15u)]) : 0u; }
        unsigned pos; const unsigned mask = group_top16<8, 7>(k, active, sub, pos);
        u32x2* lst = (u32x2*)sc;
#pragma unroll
        for (int q = 0; q < 7; ++q) if ((mask >> q) & 1u) { if (pos < 16u) lst[tk * 16 + pos] = (u32x2){__float_as_uint(fkey_inv(k[q])), (unsigned)(ti[tk * 16 + (cij[q] >> 4)] * 128 + ti[(NTK + tk) * 16 + (cij[q] & 15u)])}; ++pos; }
    }
    __syncthreads();
#pragma unroll
    for (int r = 0; r < NTK / 32; ++r) {
        const int tk = (tid >> 4) + 32 * r, slot = tid & 15; const int tok = (tt0 + (tk >> 4) * tstride) * 16 + (tk & 15);
        const u32x2 en = ((const u32x2*)sc)[tk * 16 + slot];
        const float v = __uint_as_float(en.x); const int e = (int)en.y;
        float mx = v; mx = fmaxf(mx, DPP_XOR1(mx)); mx = fmaxf(mx, DPP_XOR2(mx)); mx = fmaxf(mx, DPP_HMIRROR(mx)); mx = fmaxf(mx, DPP_RMIRROR(mx));
        const float ex = __expf(v - mx);
        float sm = ex; sm += DPP_XOR1(sm); sm += DPP_XOR2(sm); sm += DPP_HMIRROR(sm); sm += DPP_RMIRROR(sm);
        if ((tk >> 4) < ntile && tok < NTOK) { const size_t o = (size_t)tok * 128 + h * 16 + slot;
            p.eidx[o] = (unsigned short)e; p.gate[o] = ex / sm; }
    }
    __syncthreads();
}
DEV void phase_select(const Params& p, int l, unsigned char* lds) {
    const int ntt = (NTOK + 15) / 16, lane = threadIdx.x & 63, w = threadIdx.x >> 6, g = lane >> 4, c16 = lane & 15;
    const bool fixed = (gridDim.x % 8u) == 0u;
    const int nq = fixed ? (int)(gridDim.x >> 3) : 1;
    for (int hh = 0; hh < (fixed ? 1 : 8); ++hh) {
        const int h = fixed ? (int)(blockIdx.x & 7) : hh;
        bf16x8 kh[2][4], kl[2][4];
#pragma unroll
        for (int ph = 0; ph < 2; ++ph)
#pragma unroll
            for (int ks = 0; ks < 4; ++ks) { const float* kr = p.peer_keys + ((size_t)((l * 8 + h) * 2 + ph) * 128 + 16 * w + c16) * 128 + 32 * ks + 8 * g;
                const f32x4 a = *(const f32x4*)kr, b2 = *(const f32x4*)(kr + 4); const float v[8] = {a[0], a[1], a[2], a[3], b2[0], b2[1], b2[2], b2[3]};
                u32x4 hi, lo; unsigned hw[4], lw[4];
#pragma unroll
                for (int j = 0; j < 4; ++j) { hw[j] = pack2(v[2 * j], v[2 * j + 1]); lw[j] = pack2(v[2 * j] - lo16(hw[j]), v[2 * j + 1] - hi16(hw[j])); }
                hi = (u32x4){hw[0], hw[1], hw[2], hw[3]}; lo = (u32x4){lw[0], lw[1], lw[2], lw[3]};
                kh[ph][ks] = __builtin_bit_cast(bf16x8, hi); kl[ph][ks] = __builtin_bit_cast(bf16x8, lo); }
        const int first = fixed ? (int)(blockIdx.x >> 3) : (int)blockIdx.x, stride = fixed ? nq : (int)gridDim.x;
        for (int tt0 = first; tt0 < ntt; tt0 += SEL_NT * stride) {
            int ntile = 0;
#pragma unroll
            for (int k = 0; k < SEL_NT; ++k) if (tt0 + k * stride < ntt) ntile = k + 1;
            select_step(p, l, tt0, stride, ntile, h, lds, kh, kl);
        }
    }
}

constexpr int PEER_TB = 272;
struct PeerDeal { int xs_first, xs_step, t_begin, t_end; };
DEV PeerDeal peer_deal() {
    PeerDeal d; const bool sl = (gridDim.x % 8u) == 0u;
    const int nranks = sl ? (int)(gridDim.x >> 3) : (int)gridDim.x, rank = sl ? (int)(blockIdx.x >> 3) : (int)blockIdx.x, tpr = (NTOK + nranks - 1) / nranks;
    d.xs_first = sl ? (int)(blockIdx.x & 7) : 0; d.xs_step = sl ? 8 : 1; d.t_begin = rank * tpr; d.t_end = d.t_begin + tpr < NTOK ? d.t_begin + tpr : NTOK;
    return d;
}
struct PeerTok { u32x4 e0, e1, ha, hb; };
DEV void peer_fetch_u(const Params& p, int t, int c0, int g8, PeerTok& k) {
    const u32x4* ep = (const u32x4*)(p.eidx + (size_t)t * 128 + 16 * g8); k.e0 = ep[0]; k.e1 = ep[1];
    k.ha = *(const u32x4*)(p.hB + (size_t)t * D + c0); k.hb = *(const u32x4*)(p.hB + (size_t)t * D + c0 + 8);
}
DEV void phase_peer_u(const Params& p, int l, unsigned char* lds) {
    const int lane = threadIdx.x & 63, w = wave_id(), j8 = lane & 7, g8 = lane >> 3;
    const bool b2 = (j8 & 4) != 0, b1 = (j8 & 2) != 0, b0 = (j8 & 1) != 0;
    const PeerDeal dl = peer_deal();
    const unsigned char* U = p.u8 + (size_t)l * NE * D;
    float* lp = (float*)lds;
    for (int xs = dl.xs_first; xs < 8; xs += dl.xs_step)
    for (int t0 = dl.t_begin; t0 < dl.t_end; t0 += PEER_TB) {
        const int nb = dl.t_end - t0 < PEER_TB ? dl.t_end - t0 : PEER_TB;
        for (int ch = 0; ch < 2; ++ch) {
            const int c0 = 256 * xs + 128 * ch + 16 * j8;
            const unsigned char* Us = U + (size_t)(2 * xs + ch) * NE * 128; const unsigned joff = 16u * (unsigned)j8;
            PeerTok nx; if (w < nb) peer_fetch_u(p, t0 + w, c0, g8, nx);
            for (int tk = w; tk < nb; tk += 8) {
                const int t = t0 + tk;
                const PeerTok cu = nx;
                const unsigned ew[8] = {cu.e0.x, cu.e0.y, cu.e0.z, cu.e0.w, cu.e1.x, cu.e1.y, cu.e1.z, cu.e1.w}; unsigned ev[16];
#pragma unroll
                for (int i = 0; i < 8; ++i) { ev[2 * i] = ew[i] & 0xffffu; ev[2 * i + 1] = ew[i] >> 16; }
                u32x4 q[16];
#pragma unroll
                for (int i = 0; i < 16; ++i) q[i] = *(const u32x4*)(Us + (ev[i] * 128u + joff));
                if (tk + 8 < nb) peer_fetch_u(p, t + 8, c0, g8, nx);
                const u32x4 ha = cu.ha, hb = cu.hb;
                const f32x2 hf[8] = {{lo16(ha.x), hi16(ha.x)}, {lo16(ha.y), hi16(ha.y)}, {lo16(ha.z), hi16(ha.z)}, {lo16(ha.w), hi16(ha.w)}, {lo16(hb.x), hi16(hb.x)}, {lo16(hb.y), hi16(hb.y)}, {lo16(hb.z), hi16(hb.z)}, {lo16(hb.w), hi16(hb.w)}};
                float ps[16];
#pragma unroll
                for (int i = 0; i < 16; ++i) { f32x2 dq[8]; fp8x16_dec2(q[i], dq); f32x2 a = dq[0] * hf[0];
#pragma unroll
                    for (int k = 1; k < 8; ++k) a = __builtin_elementwise_fma(dq[k], hf[k], a);
                    ps[i] = a[0] + a[1]; }
                float q8[8], q4[4], q2[2];
#pragma unroll
                for (int k = 0; k < 8; ++k) { const float keep = b2 ? ps[8 + k] : ps[k], send = b2 ? ps[k] : ps[8 + k]; q8[k] = keep + DPP_HMIRROR(send); }
#pragma unroll
                for (int k = 0; k < 4; ++k) { const float keep = b1 ? q8[4 + k] : q8[k], send = b1 ? q8[k] : q8[4 + k]; q4[k] = keep + DPP_XOR2(send); }
#pragma unroll
                for (int k = 0; k < 2; ++k) { const float keep = b0 ? q4[2 + k] : q4[k], send = b0 ? q4[k] : q4[2 + k]; q2[k] = keep + DPP_XOR1(send); }
                float* lrow = lp + tk * 128 + 16 * g8 + 2 * j8;
                if (ch == 0) { lrow[0] = q2[0]; lrow[1] = q2[1]; }
                else { float* dst = p.part + ((size_t)t * 8 + xs) * 128 + 16 * g8 + 2 * j8; *(f32x2*)dst = (f32x2){q2[0] + lrow[0], q2[1] + lrow[1]}; }
            }
        }
    }
}
DEV void phase_peer_c(const Params& p, int l) {
    const size_t n = (size_t)NTOK * 128, gs = (size_t)gridDim.x * 512;
    for (size_t i = (size_t)blockIdx.x * 512 + threadIdx.x; i < n; i += gs) {
        const size_t t = i >> 7; const int pr = (int)(i & 127); float sacc = 0.f;
        const int e = p.eidx[i]; const float su = p.su[l * NE + e], sv = p.sv[l * NE + e], gt = p.gate[i];
#pragma unroll
        for (int x = 0; x < 8; ++x) sacc += p.part[(t * 8 + x) * 128 + pr];
        p.ab16[i] = (bf16_t)f2bf(gelu_erf(sacc * su) * gt * sv);
    }
}
struct PeerTokV { u32x4 e0, e1, a0, a1; f32x2 x1, g2; };
DEV void peer_fetch_v(const Params& p, int l, int t, int col, int g8, PeerTokV& k) {
    const u32x4* ep = (const u32x4*)(p.eidx + (size_t)t * 128 + 16 * g8); k.e0 = ep[0]; k.e1 = ep[1];
    const u32x4* ap = (const u32x4*)(p.ab16 + (size_t)t * 128 + 16 * g8); k.a0 = ap[0]; k.a1 = ap[1];
    k.x1 = *(const f32x2*)(p.xa + (size_t)t * D + col); k.g2 = *(const f32x2*)(p.modbuf + (size_t)tok_batch(t) * MODW + l * NMOD + 5 * D + col);
}
DEV void phase_peer_v(const Params& p, int l, unsigned char* lds) {
    const int lane = threadIdx.x & 63, w = wave_id(), j8 = lane & 7, g8 = lane >> 3;
    const bool b3 = (g8 & 1) != 0, b4 = (g8 & 2) != 0, b5 = (g8 & 4) != 0;
    const PeerDeal dl = peer_deal();
    const unsigned char* V = p.v8 + (size_t)l * NE * D;
    for (int xs = dl.xs_first; xs < 8; xs += dl.xs_step)
        for (int ch = 0; ch < 2; ++ch) {
            const int c0 = 256 * xs + 128 * ch + 16 * j8, col = c0 + (b3 ? 8 : 0) + (b4 ? 4 : 0) + (b5 ? 2 : 0);
            const unsigned char* Vs = V + (size_t)(2 * xs + ch) * NE * 128; const unsigned joff = 16u * (unsigned)j8;
            PeerTokV nx; if (dl.t_begin + w < dl.t_end) peer_fetch_v(p, l, dl.t_begin + w, col, g8, nx);
            for (int t = dl.t_begin + w; t < dl.t_end; t += 8) {
                const PeerTokV cu = nx;
                const unsigned ew[8] = {cu.e0.x, cu.e0.y, cu.e0.z, cu.e0.w, cu.e1.x, cu.e1.y, cu.e1.z, cu.e1.w}; unsigned ev[16];
#pragma unroll
                for (int i = 0; i < 8; ++i) { ev[2 * i] = ew[i] & 0xffffu; ev[2 * i + 1] = ew[i] >> 16; }
                u32x4 q[16];
#pragma unroll
                for (int i = 0; i < 16; ++i) q[i] = *(const u32x4*)(Vs + (ev[i] * 128u + joff));
                if (t + 8 < dl.t_end) peer_fetch_v(p, l, t + 8, col, g8, nx);
                const unsigned aw[8] = {cu.a0.x, cu.a0.y, cu.a0.z, cu.a0.w, cu.a1.x, cu.a1.y, cu.a1.z, cu.a1.w}; float av[16];
#pragma unroll
                for (int i = 0; i < 8; ++i) { av[2 * i] = lo16(aw[i]); av[2 * i + 1] = hi16(aw[i]); }
                f32x2 acc2[8];
#pragma unroll
                for (int k = 0; k < 8; ++k) acc2[k] = (f32x2){0.f, 0.f};
#pragma unroll
                for (int i = 0; i < 16; ++i) { f32x2 dq[8]; fp8x16_dec2(q[i], dq); const f32x2 a2v = (f32x2){av[i], av[i]};
#pragma unroll
                    for (int k = 0; k < 8; ++k) acc2[k] = __builtin_elementwise_fma(a2v, dq[k], acc2[k]); }
                float acc[16];
#pragma unroll
                for (int k = 0; k < 8; ++k) { acc[2 * k] = acc2[k][0]; acc[2 * k + 1] = acc2[k][1]; }
                float q8[8], q4[4], q2[2];
#pragma unroll
                for (int k = 0; k < 8; ++k) { const float keep = b3 ? acc[8 + k] : acc[k], send = b3 ? acc[k] : acc[8 + k]; q8[k] = keep + DPP_XOR8(send); }
#pragma unroll
                for (int k = 0; k < 4; ++k) q4[k] = xsum16(q8[k], q8[4 + k]);
#pragma unroll
                for (int k = 0; k < 2; ++k) q2[k] = xsum32(q4[k], q4[2 + k]);
                f32x2 o; o[0] = cu.x1[0] + cu.g2[0] * q2[0]; o[1] = cu.x1[1] + cu.g2[1] * q2[1];
                *(f32x2*)(p.xb + (size_t)t * D + col) = o;
            }
        }
}

constexpr int N_PHASES = 27;
DEV int phase_class(int k) { return k < 2 ? k : (k == 26 ? 14 : 2 + (k - 2) % 12); }
#ifndef HIPEMU
#define XB_TMO      128
#define XB_XCNT(j)  (256  + 64 * (j))
#define XB_XSUB(j)  (1280 + 64 * (j))
#define XB_XGEN(j)  (2304 + 64 * (j))
#define XB_TOP      3328
#define XB_TOPGEN   3392
#define XCD_BAR_WORDS 3456
#define XB_SPIN_CAP (1u << 22)
__device__ __forceinline__ unsigned xb_ld(unsigned* p)              { return __hip_atomic_load(p, __ATOMIC_RELAXED, __HIP_MEMORY_SCOPE_AGENT); }
__device__ __forceinline__ unsigned xb_add(unsigned* p, unsigned v) { return __hip_atomic_fetch_add(p, v, __ATOMIC_RELAXED, __HIP_MEMORY_SCOPE_AGENT); }
__device__ __forceinline__ unsigned xb_xcc_id() { return (unsigned)__builtin_amdgcn_s_getreg((3 << 11) | 20) & 0xFu; }
#define XB_SPIN(cond, bar) do { unsigned _sp = 0; while (cond) { __builtin_amdgcn_s_sleep(1); \
    if ((++_sp & 255u) == 0u) { if (xb_ld(&(bar)[XB_TMO])) break; if (_sp > XB_SPIN_CAP) { atomicAdd(&(bar)[XB_TMO], 1u); break; } } } } while (0)
struct XcdBarrier { unsigned* bar; unsigned x; volatile LAS unsigned* st; };
__device__ __forceinline__ XcdBarrier xcd_barrier_post(unsigned* bar, volatile LAS unsigned* st) {
    XcdBarrier b; b.bar = bar; b.x = xb_xcc_id(); b.st = st;
    if (threadIdx.x == 0) (void)xb_add(&bar[XB_XCNT(b.x)], 1u);
    return b;
}
__device__ __forceinline__ void xcd_barrier_complete(unsigned* bar, unsigned x, unsigned& nloc, unsigned& nx) {
    const unsigned G = gridDim.x * gridDim.y * gridDim.z;
    unsigned sum, cnt, mine, sp = 0u;
    for (;;) {
        sum = 0u; cnt = 0u; mine = 0u;
#pragma unroll
        for (unsigned j = 0; j < 16; ++j) { const unsigned c = xb_ld(&bar[XB_XCNT(j)]); sum += c; cnt += (c > 0u) ? 1u : 0u; mine = (j == x) ? c : mine; }
        if (sum == G) break;
        __builtin_amdgcn_s_sleep(1);
        if ((++sp & 255u) == 0u) { if (xb_ld(&bar[XB_TMO])) break; if (sp > XB_SPIN_CAP) { atomicAdd(&bar[XB_TMO], 1u); break; } }
    }
    nloc = mine > 0u ? mine : 1u; nx = cnt > 0u ? cnt : 1u;
}
__device__ __forceinline__ void xcd_barrier(const XcdBarrier& b) {
    asm volatile("s_waitcnt vmcnt(0)" ::: "memory");
    __syncthreads();
    if (threadIdx.x == 0) {
        unsigned* bar = b.bar;
        __builtin_amdgcn_s_waitcnt(0);
        unsigned nloc = b.st[0], nx = b.st[1];
        if (nloc == 0u) { xcd_barrier_complete(bar, b.x, nloc, nx); b.st[0] = nloc; b.st[1] = nx; }
        const unsigned old = xb_add(&bar[XB_XSUB(b.x)], 1u);
        const unsigned gen = old / nloc;
        if (old + 1u == (gen + 1u) * nloc) {
            __builtin_amdgcn_fence(__ATOMIC_RELEASE, "agent");
            asm volatile("s_waitcnt vmcnt(0)" ::: "memory");
            const unsigned og = xb_add(&bar[XB_TOP], 1u);
            const unsigned tg = og / nx;
            if (og + 1u == (tg + 1u) * nx) xb_add(&bar[XB_TOPGEN], 1u);
            else XB_SPIN(xb_ld(&bar[XB_TOPGEN]) == tg, bar);
            __builtin_amdgcn_fence(__ATOMIC_ACQUIRE, "agent");
            xb_add(&bar[XB_XGEN(b.x)], 1u);
            asm volatile("s_waitcnt vmcnt(0)" ::: "memory");
        } else {
            XB_SPIN(xb_ld(&bar[XB_XGEN(b.x)]) == gen, bar);
            __builtin_amdgcn_fence(__ATOMIC_ACQUIRE, "agent");
            asm volatile("s_waitcnt vmcnt(0)" ::: "memory");
        }
    }
    __syncthreads();
}
#endif

constexpr int LDS_BYTES = 163840;
constexpr int LDS_BARW = LDS_BYTES - 16;

#ifndef PH_MASK
#define PH_MASK 0xFFFFFFFFu
#endif
#ifndef PROBE_DUP
#define PROBE_DUP 0u
#endif
#define DUP_N(k) (1 + (int)((PROBE_DUP >> phase_class(k)) & 1u))
#define PH_BIT(k) ((PH_MASK >> phase_class(k)) & 1u)
#ifdef HIPEMU
static void run_phase(const Params& pp, int ph, unsigned char* lds)
#define GRID_BAR() do {} while (0)
#define IN(k) (ph == (k))
#define GLDS lds
#define LOADP() const Params& p = pp
#else
typedef const __attribute__((address_space(4))) unsigned char* kargp_t;
__device__ __forceinline__ kargp_t karg_ptr() { kargp_t kp = (kargp_t)__builtin_amdgcn_kernarg_segment_ptr(); asm volatile("" : "+s"(kp)); return kp; }
#define LOADP() Params p; __builtin_memcpy(&p, karg_ptr(), sizeof(Params))
#define IN(k) (PH_BIT(k) && ph_lo <= (k) && (k) < ph_hi)
#define GLDS ((LAS unsigned char*)lds_raw)
__global__ void __launch_bounds__(512, 2) mega_fwd(Params p_unused)
#endif
{
#ifndef HIPEMU
    extern __shared__ __attribute__((aligned(16))) unsigned char lds_raw[];
    unsigned char* lds = lds_raw;
    if (threadIdx.x == 0) { *(volatile unsigned*)(lds_raw + LDS_BARW) = 0u; *(volatile unsigned*)(lds_raw + LDS_BARW + 4) = 0u; }
    __syncthreads();
    int ph_lo, ph_hi; XcdBarrier bar;
    { LOADP(); ph_lo = p.ph_lo; ph_hi = p.ph_hi; bar.bar = p.bar; bar.x = 0; bar.st = nullptr; }
    const bool multi = (ph_hi - ph_lo) > 1;
    if (multi) bar = xcd_barrier_post(bar.bar, (volatile LAS unsigned*)(lds_raw + LDS_BARW));
#define GRID_BAR() do { if (multi) xcd_barrier(bar); } while (0)
#endif
    if (IN(0)) { for (int rep = 0; rep < DUP_N(0); ++rep) { LOADP(); phase_convert(p, lds, 0); GRID_BAR(); } }
    if (IN(1)) {
        LOADP();
        pg8::Gemm g{p.csil, p.wt_ada, 256, MODW, D}; pg8::StaticOrder S; S.init(256, MODW, gridDim.x, blockIdx.x);
        pg8::EpiAda E{p.modbuf, p.b_ada, p.b_ada_final};
        pg8::gemm_phase<pg8::EpiAda, pg8::StaticOrder>(GLDS, g, S, E);
    }
    if (IN(1)) { LOADP(); phase_convert(p, lds, 1); GRID_BAR(); }
#define LAYER(l) do { \
        constexpr int base = 2 + 12 * (l); \
        if (IN(base + 0)) { for (int rep = 0; rep < DUP_N(base + 0); ++rep) { LOADP(); phase_norm(p, (l) == 0 ? p.x_prompt : p.xb, (l) == 0 ? p.x_sample : p.xb + (size_t)NP * D, p.norm1_g + (l) * D, (l) * NMOD + 0 * D, (l) * NMOD + 1 * D, p.hA, nullptr); GRID_BAR(); } } \
        if (IN(base + 1)) { for (int rep = 0; rep < DUP_N(base + 1); ++rep) { LOADP(); \
            pg8::Gemm g{p.hA, p.wt_in + (size_t)(l) * ZW * D, MPAD, ZW, D}; pg8::StaticOrder S; S.init(MPAD, ZW, gridDim.x, blockIdx.x); \
            pg8::EpiBf16 E{p.z, ZW}; \
            pg8::gemm_phase<pg8::EpiBf16, pg8::StaticOrder>(GLDS, g, S, E); } } \
        if (IN(base + 1)) { LOADP(); phase_tbl_slot(p, (l)); GRID_BAR(); } \
        if (IN(base + 2)) { for (int rep = 0; rep < DUP_N(base + 2); ++rep) { LOADP(); phase_mix1(p, (l), lds); GRID_BAR(); } } \
        if (IN(base + 3)) { for (int rep = 0; rep < DUP_N(base + 3); ++rep) { LOADP(); phase_mix2(p, (l)); GRID_BAR(); } } \
        if (IN(base + 4)) { LOADP(); phase_mix3(p, (l), lds); } \
        if (IN(base + 4)) { LOADP(); \
            pg8::Gemm g{p.pooled, p.wt_pool + (size_t)(l) * 1024 * 256, 4 * MPAD, 1024, 256}; pg8::PoolOrder S{(int)gridDim.x, (int)(gridDim.x - 1 - blockIdx.x)}; \
            pg8::EpiPool E{p.cat, p.pool_b + (l) * PW, p.pool_scale + (l) * PW}; \
            pg8::gemm_phase<pg8::EpiPool, pg8::PoolOrder>(GLDS, g, S, E); \
            GRID_BAR(); } \
        if (IN(base + 5)) { for (int rep = 0; rep < DUP_N(base + 5); ++rep) { LOADP(); \
            pg8::Gemm g{p.cat, p.wt_out + (size_t)(l) * D * D, MBIG, D, D}; pg8::StaticOrder S; S.init(MBIG, D, gridDim.x, blockIdx.x); \
            pg8::EpiResid E{(l) == 0 ? p.x_prompt : p.xb, (l) == 0 ? p.x_sample : p.xb + (size_t)NP * D, p.modbuf + (l) * NMOD + 2 * D, p.xa}; \
            pg8::gemm_phase<pg8::EpiResid, pg8::StaticOrder>(GLDS, g, S, E); \
            { SmallResid sf{E.xlo, E.xhi, E.gmod, E.out}; small_gemm(p.cat, p.wt_out + (size_t)(l) * D * D, D, lds, sf); } \
            GRID_BAR(); } } \
        if (IN(base + 6)) { for (int rep = 0; rep < DUP_N(base + 6); ++rep) { LOADP(); phase_norm(p, p.xa, p.xa + (size_t)NP * D, p.norm2_g + (l) * D, (l) * NMOD + 3 * D, (l) * NMOD + 4 * D, p.hB, nullptr); GRID_BAR(); } } \
        if (IN(base + 7)) { for (int rep = 0; rep < DUP_N(base + 7); ++rep) { LOADP(); \
            pg8::Gemm g{p.hB, p.wt_q + (size_t)(l) * D * D, MBIG, D, D}; pg8::StaticOrder S; S.init(MBIG, D, gridDim.x, blockIdx.x); \
            pg8::EpiF32 E{p.qry, D}; \
            pg8::gemm_phase<pg8::EpiF32, pg8::StaticOrder>(GLDS, g, S, E); \
            { SmallF32 sf{p.qry}; small_gemm(p.hB, p.wt_q + (size_t)(l) * D * D, D, lds, sf); } \
            GRID_BAR(); } } \
        if (IN(base + 8)) { for (int rep = 0; rep < DUP_N(base + 8); ++rep) { LOADP(); phase_select(p, (l), lds); GRID_BAR(); } } \
        if (IN(base + 9)) { for (int rep = 0; rep < DUP_N(base + 9); ++rep) { LOADP(); phase_peer_u(p, (l), lds); GRID_BAR(); } } \
        if (IN(base + 10)) { LOADP(); phase_peer_c(p, (l)); GRID_BAR(); } \
        if (IN(base + 11)) { for (int rep = 0; rep < DUP_N(base + 11); ++rep) { LOADP(); phase_peer_v(p, (l), lds); GRID_BAR(); } } \
    } while (0)
    LAYER(0);
    LAYER(1);
    if (IN(26)) { LOADP(); phase_norm(p, p.xb, p.xb + (size_t)NP * D, p.final_g, 2 * NMOD, 2 * NMOD + D, nullptr, p.out + OFF_Y); }
#undef LAYER
#undef IN
#undef GRID_BAR
#undef GLDS
#undef LOADP
}

struct WsLayout { size_t bar, modbuf, csil, wt_ada, wt_in, wt_out, wt_q, wt_pool, u8, v8, su, sv, iscu, part, hg_oin, hg_ds, hg_gam, hg_qh, hg_sc, hA, hB, z, pooled, cat, xa, xb, qry, eidx, gate, ab16, end; };
static WsLayout ws_layout() {
    WsLayout L; size_t o = 0;
    auto take = [&](size_t bytes) { const size_t r = o; o += (bytes + 255) & ~(size_t)255; return r; };
    L.bar = take(16384);
    L.modbuf = take((size_t)256 * MODW * 4);
    L.csil = take((size_t)256 * D * 2);
    L.wt_ada = take((size_t)MODW * D * 2);
    L.wt_in = take((size_t)2 * ZW * D * 2);
    L.wt_out = take((size_t)2 * D * D * 2);
    L.wt_q = take((size_t)2 * D * D * 2);
    L.wt_pool = take((size_t)2 * 1024 * 256 * 2);
    L.u8 = take((size_t)2 * NE * D);
    L.v8 = take((size_t)2 * NE * D);
    L.su = take((size_t)2 * NE * 4);
    L.sv = take((size_t)2 * NE * 4);
    L.iscu = take((size_t)MPAD * 128 * 4);
    L.part = take((size_t)MPAD * 8 * 128 * 4);
    L.hg_oin = take((size_t)hg::NUNIT * 64 * 128 * 2);
    L.hg_ds = take((size_t)hg::NUNIT * 128 * 128 * 2);
    L.hg_gam = take((size_t)hg::NUNIT * 128 * 4);
    L.hg_qh = take((size_t)NP * 1024 * 2);
    L.hg_sc = take((size_t)hg::NUNIT * 128 * 128 * 2);
    L.hA = take((size_t)MPAD * D * 2);
    L.hB = take((size_t)MPAD * D * 2);
    L.z = take((size_t)MPAD * ZW * 2);
    L.pooled = take((size_t)4 * MPAD * 256 * 2);
    L.cat = take((size_t)MPAD * D * 2);
    L.xa = take((size_t)MPAD * D * 4);
    L.xb = take((size_t)MPAD * D * 4);
    L.qry = take((size_t)MPAD * D * 4);
    L.eidx = take((size_t)MPAD * 128 * 2);
    L.gate = take((size_t)MPAD * 128 * 4);
    L.ab16 = take((size_t)MPAD * 128 * 2);
    L.end = o;
    return L;
}
static void fill_params(Params& p, void* const* d_in, void* d_out, void* d_ws) {
    const float** f = (const float**)&p;
    for (int i = 0; i < 24; ++i) f[i] = (const float*)d_in[i];
    p.out = (float*)d_out;
    const WsLayout L = ws_layout(); unsigned char* w = (unsigned char*)d_ws;
    p.bar = (unsigned*)(w + L.bar); p.modbuf = (float*)(w + L.modbuf); p.csil = (bf16_t*)(w + L.csil); p.wt_ada = (bf16_t*)(w + L.wt_ada); p.wt_in = (bf16_t*)(w + L.wt_in);
    p.wt_out = (bf16_t*)(w + L.wt_out); p.wt_q = (bf16_t*)(w + L.wt_q); p.wt_pool = (bf16_t*)(w + L.wt_pool); p.u8 = w + L.u8; p.v8 = w + L.v8; p.su = (float*)(w + L.su); p.sv = (float*)(w + L.sv); p.iscu = (float*)(w + L.iscu); p.part = (float*)(w + L.part); p.hg_oin = (bf16_t*)(w + L.hg_oin); p.hg_ds = (bf16_t*)(w + L.hg_ds); p.hg_gam = (float*)(w + L.hg_gam); p.hg_qh = (bf16_t*)(w + L.hg_qh); p.hg_sc = (bf16_t*)(w + L.hg_sc);
    p.hA = (bf16_t*)(w + L.hA); p.hB = (bf16_t*)(w + L.hB); p.z = (bf16_t*)(w + L.z); p.pooled = (bf16_t*)(w + L.pooled); p.cat = (bf16_t*)(w + L.cat);
    p.xa = (float*)(w + L.xa); p.xb = (float*)(w + L.xb); p.qry = (float*)(w + L.qry); p.eidx = (unsigned short*)(w + L.eidx); p.gate = (float*)(w + L.gate); p.ab16 = (bf16_t*)(w + L.ab16);
}

#ifndef HIPEMU
#ifndef MK_ONE_LAUNCH
#define MK_ONE_LAUNCH 1
#endif
extern "C" void kernel_launch(void* const* d_in, const int* in_sizes, int n_in, void* d_out, int out_size, void* d_ws, size_t ws_size, hipStream_t stream) {
    static int grid = 0;
    if (grid == 0) {
        const WsLayout L = ws_layout();
        if (n_in != 24 || (size_t)out_size != OUT_TOTAL || ws_size < L.end) { fprintf(stderr, "kernel_launch: unexpected shapes (n_in %d, out %d, ws %zu < %zu)\n", n_in, out_size, ws_size, L.end); grid = -1; return; }
        int dev = 0, cus = 0, per_cu = 0;
        hipGetDevice(&dev); hipDeviceGetAttribute(&cus, hipDeviceAttributeMultiprocessorCount, dev);
        if (hipFuncSetAttribute((const void*)mega_fwd, hipFuncAttributeMaxDynamicSharedMemorySize, LDS_BYTES) != hipSuccess) { fprintf(stderr, "kernel_launch: hipFuncSetAttribute failed\n"); grid = -1; return; }
        hipOccupancyMaxActiveBlocksPerMultiprocessor(&per_cu, (const void*)mega_fwd, 512, LDS_BYTES);
        (void)hipGetLastError();
        if (per_cu < 1) fprintf(stderr, "kernel_launch: occupancy query says %d blocks per CU\n", per_cu);
        grid = cus;
    }
    if (grid < 0) return;
    Params p{};
    fill_params(p, d_in, d_out, d_ws);
    hipMemsetAsync(p.bar, 0, 16384, stream);
#if MK_ONE_LAUNCH
    p.ph_lo = 0; p.ph_hi = N_PHASES;
    hipLaunchKernelGGL(mega_fwd, dim3(grid), dim3(512), LDS_BYTES, stream, p);
#else
    for (int ph = 0; ph < N_PHASES; ++ph) { p.ph_lo = ph; p.ph_hi = ph + 1; hipLaunchKernelGGL(mega_fwd, dim3(grid), dim3(512), LDS_BYTES, stream, p); }
#endif
}
#endif
```

```cpp
#ifndef HIPEMU
#include <hip/hip_runtime.h>
#include <cstdio>
#endif
#include <stdint.h>

#ifndef CFG_PB
#define CFG_PB 4
#define CFG_SEQ 2048
#define CFG_DB 128
#endif

#ifdef HIPEMU
#define DEV inline
#define LAS
#define READLANE_I(v, l) emu_readlane((v), (l))
#define READLANE_F(v, l) emu_readlane_f((v), (l))
#define MFMA_BF16(a, b, c) emu_mfma_bf16_16x16x32((a), (b), (c))
#define MFMA_F32(a, b, c) emu_mfma_f32_16x16x4((a), (b), (c))
#define __expf expf
#define __logf logf
#else
#define DEV __device__ __forceinline__
#define LAS __attribute__((address_space(3)))
#define READLANE_I(v, l) __builtin_amdgcn_readlane((v), (l))
#define READLANE_F(v, l) __uint_as_float((unsigned)__builtin_amdgcn_readlane((int)__float_as_uint(v), (l)))
#define MFMA_BF16(a, b, c) __builtin_amdgcn_mfma_f32_16x16x32_bf16((a), (b), (c), 0, 0, 0)
#define MFMA_F32(a, b, c) __builtin_amdgcn_mfma_f32_16x16x4f32((a), (b), (c), 0, 0, 0)
#endif

typedef unsigned short bf16_t;
typedef short bf16x8 __attribute__((ext_vector_type(8)));
typedef float f32x4 __attribute__((ext_vector_type(4)));
typedef unsigned u32x4 __attribute__((ext_vector_type(4)));
typedef unsigned u32x2 __attribute__((ext_vector_type(2)));

namespace cfg {
constexpr int D = 2048, PB = CFG_PB, SEQ = CFG_SEQ, DB = CFG_DB, DSEQ = 4;
constexpr int NP = PB * SEQ, NS = DB * DSEQ, NTOK = NP + NS, MPAD = (NTOK + 255) / 256 * 256;
constexpr int NC = PB + DB;
constexpr int HH = 8, HD = 128, PW = 1024, PBUF = 15, ZW = 5120;
constexpr int NE = 16384;
constexpr int NMOD = 6 * D;
constexpr int MODW = 2 * NMOD + 2 * D;
constexpr float EPS = 1e-6f;
constexpr int NCHAIN = PB * HH;
constexpr size_t OFF_Y = 0;
constexpr size_t OFF_HP = (size_t)NTOK * D;
constexpr size_t OFF_PP = OFF_HP + (size_t)2 * PB * HH * HD * HD;
constexpr size_t OFF_HS = OFF_PP + (size_t)2 * PB * PBUF * PW;
constexpr size_t OFF_PS = OFF_HS + (size_t)2 * DB * HH * HD * HD;
constexpr size_t OUT_TOTAL = OFF_PS + (size_t)2 * DB * PBUF * PW;
}
using namespace cfg;

struct Params {
    const float *x_prompt, *x_sample, *c_prompt, *c_sample, *state_hgrn, *state_pool, *w_ada, *b_ada, *norm1_g, *norm2_g, *w_in, *w_out,
        *lb_logits, *hgrn_norm_g, *pool_w, *pool_b, *pool_scale, *peer_wq, *peer_keys, *peer_u, *peer_v, *final_g, *w_ada_final, *b_ada_final;
    float* out;
    unsigned* bar; float* modbuf; bf16_t* csil; bf16_t* wt_ada; bf16_t* wt_in; bf16_t* wt_out; bf16_t* wt_q; bf16_t* wt_pool;
    unsigned char* u8; unsigned char* v8; float* su; float* sv; float* iscu; float* part; bf16_t* hg_oin; bf16_t* hg_ds; float* hg_gam; bf16_t* hg_qh; bf16_t* hg_sc; bf16_t* hA; bf16_t* hB; bf16_t* z; bf16_t* pooled; bf16_t* cat; float* xa; float* xb; float* qry; unsigned short* eidx; float* gate; bf16_t* ab16;
    int ph_lo, ph_hi;
};

DEV float bf2f(unsigned v) { return __uint_as_float(v << 16); }
#ifdef HIPEMU
DEV unsigned f2bf(float f) { unsigned u = __float_as_uint(f); u += 0x7fffu + ((u >> 16) & 1u); return u >> 16; }
DEV unsigned pack2(float lo, float hi) { return f2bf(lo) | (f2bf(hi) << 16); }
#else
typedef float f32x2_t __attribute__((ext_vector_type(2)));
typedef __bf16 bf16x2_t __attribute__((ext_vector_type(2)));
DEV unsigned pack2(float lo, float hi) { const f32x2_t v = {lo, hi}; return __builtin_bit_cast(unsigned, __builtin_convertvector(v, bf16x2_t)); }
DEV unsigned f2bf(float f) { return (unsigned)__builtin_bit_cast(unsigned short, (__bf16)f); }
#endif
DEV float lo16(unsigned w) { return __uint_as_float(w << 16); }
DEV float hi16(unsigned w) { return __uint_as_float(w & 0xffff0000u); }
DEV float wave_sum(float v) { v += __shfl_xor(v, 32); v += __shfl_xor(v, 16); v += __shfl_xor(v, 8); v += __shfl_xor(v, 4); v += __shfl_xor(v, 2); v += __shfl_xor(v, 1); return v; }
DEV float wave_max(float v) { v = fmaxf(v, __shfl_xor(v, 32)); v = fmaxf(v, __shfl_xor(v, 16)); v = fmaxf(v, __shfl_xor(v, 8)); v = fmaxf(v, __shfl_xor(v, 4)); v = fmaxf(v, __shfl_xor(v, 2)); v = fmaxf(v, __shfl_xor(v, 1)); return v; }
DEV float sigmoidf_(float x) { return 1.0f / (1.0f + __expf(-x)); }
DEV float siluf_(float x) { return x / (1.0f + __expf(-x)); }
DEV float gelu_erf(float x) { return 0.5f * x * (1.0f + erff(x * 0.70710678118f)); }
#ifdef HIPEMU
DEV int wave_id() { return (int)(threadIdx.x >> 6); }
#else
DEV int wave_id() { return __builtin_amdgcn_readfirstlane((int)(threadIdx.x >> 6)); }
#endif
DEV int tok_batch(int t) { return t < NP ? t / SEQ : PB + (t - NP) / DSEQ; }


#ifdef HIPEMU
static inline unsigned emu_fp8_enc1(float x) {
    const unsigned sgn = x < 0.f ? 0x80u : 0u; float a = fabsf(x);
    if (!(a == a)) return 0x7fu;
    if (a >= 448.f) return sgn | 0x7eu;
    if (a < 0.015625f) { const int q = (int)rintf(a * 512.f); return sgn | (unsigned)q; }
    int e = (int)floorf(log2f(a)); if (ldexpf(1.f, e) > a) --e; if (ldexpf(1.f, e + 1) <= a) ++e;
    int m = (int)rintf((a / ldexpf(1.f, e) - 1.f) * 8.f); if (m == 8) { m = 0; ++e; }
    if (e > 8) return sgn | 0x7eu;
    return sgn | (unsigned)((e + 7) << 3) | (unsigned)m;
}
static inline float emu_fp8_dec1(unsigned b) { const float sg = (b & 0x80u) ? -1.f : 1.f; const int e = (b >> 3) & 15, m = b & 7; return sg * (e == 0 ? m * 0.001953125f : (1.f + m * 0.125f) * ldexpf(1.f, e - 7)); }
DEV unsigned fp8x4_enc(float a, float b, float c, float d) { return emu_fp8_enc1(a) | (emu_fp8_enc1(b) << 8) | (emu_fp8_enc1(c) << 16) | (emu_fp8_enc1(d) << 24); }
DEV void fp8x4_dec(unsigned w, float* o) { o[0] = emu_fp8_dec1(w & 255u); o[1] = emu_fp8_dec1((w >> 8) & 255u); o[2] = emu_fp8_dec1((w >> 16) & 255u); o[3] = emu_fp8_dec1(w >> 24); }
#define DPP_XOR1(v) __shfl((v), emu_lane() ^ 1)
#define DPP_XOR2(v) __shfl((v), emu_lane() ^ 2)
#define DPP_HMIRROR(v) __shfl((v), (emu_lane() & ~7) | (7 - (emu_lane() & 7)))
#define DPP_XOR8(v) __shfl((v), emu_lane() ^ 8)
#define DPP_RMIRROR(v) __shfl((v), (emu_lane() & ~15) | (15 - (emu_lane() & 15)))
#define WAVE_LDS_SYNC() emu_wbar()
DEV float xsum16(float a, float b) { const bool hi = (emu_lane() & 16) != 0; return (hi ? b : a) + __shfl_xor(hi ? a : b, 16); }
DEV float xsum32(float a, float b) { const bool hi = (emu_lane() & 32) != 0; return (hi ? b : a) + __shfl_xor(hi ? a : b, 32); }
#else
typedef float f32x2v_t __attribute__((ext_vector_type(2)));
DEV unsigned fp8x4_enc(float a, float b, float c, float d) { int r = __builtin_amdgcn_cvt_pk_fp8_f32(a, b, 0, false); r = __builtin_amdgcn_cvt_pk_fp8_f32(c, d, r, true); return (unsigned)r; }
DEV void fp8x4_dec(unsigned w, float* o) { const f32x2v_t lo = __builtin_amdgcn_cvt_pk_f32_fp8((int)w, false), hi = __builtin_amdgcn_cvt_pk_f32_fp8((int)w, true); o[0] = lo[0]; o[1] = lo[1]; o[2] = hi[0]; o[3] = hi[1]; }
template <int CTRL> DEV float dpp_f(float v) { return __uint_as_float((unsigned)__builtin_amdgcn_update_dpp(0, (int)__float_as_uint(v), CTRL, 0xf, 0xf, true)); }
#define DPP_XOR1(v) dpp_f<0xB1>(v)
#define DPP_XOR2(v) dpp_f<0x4E>(v)
#define DPP_HMIRROR(v) dpp_f<0x141>(v)
#define DPP_XOR8(v) dpp_f<0x128>(v)
#define DPP_RMIRROR(v) dpp_f<0x140>(v)
#define WAVE_LDS_SYNC() asm volatile("s_waitcnt lgkmcnt(0)" ::: "memory")
DEV float xsum16(float a, float b) { const u32x2 r = __builtin_amdgcn_permlane16_swap(__float_as_uint(a), __float_as_uint(b), false, false); return __uint_as_float(r[0]) + __uint_as_float(r[1]); }
DEV float xsum32(float a, float b) { const u32x2 r = __builtin_amdgcn_permlane32_swap(__float_as_uint(a), __float_as_uint(b), false, false); return __uint_as_float(r[0]) + __uint_as_float(r[1]); }
#endif
typedef float f32x2 __attribute__((ext_vector_type(2)));
#ifdef HIPEMU
DEV void fp8x4_dec2(unsigned w, f32x2& lo, f32x2& hi) { float o[4]; fp8x4_dec(w, o); lo = (f32x2){o[0], o[1]}; hi = (f32x2){o[2], o[3]}; }
#else
DEV void fp8x4_dec2(unsigned w, f32x2& lo, f32x2& hi) { lo = __builtin_amdgcn_cvt_pk_f32_fp8((int)w, false); hi = __builtin_amdgcn_cvt_pk_f32_fp8((int)w, true); }
#endif
DEV void fp8x16_dec2(u32x4 q, f32x2* o) { fp8x4_dec2(q.x, o[0], o[1]); fp8x4_dec2(q.y, o[2], o[3]); fp8x4_dec2(q.z, o[4], o[5]); fp8x4_dec2(q.w, o[6], o[7]); }
#ifdef HIPEMU
static inline unsigned emu_fp4_enc1(float x) {
    const unsigned sgn = x < 0.f ? 8u : 0u; const float a = fabsf(x);
    const unsigned c = a < 0.25f ? 0u : (a < 0.75f ? 1u : (a < 1.25f ? 2u : (a < 1.75f ? 3u : (a < 2.5f ? 4u : (a < 3.5f ? 5u : (a < 5.0f ? 6u : 7u))))));
    return sgn | c;
}
static inline float emu_fp4_dec1(unsigned n) { const float t[8] = {0.f, 0.5f, 1.f, 1.5f, 2.f, 3.f, 4.f, 6.f}; return ((n & 8u) ? -1.f : 1.f) * t[n & 7u]; }
DEV unsigned fp4x4_enc(float a, float b, float c, float d) { return emu_fp4_enc1(a) | (emu_fp4_enc1(b) << 4) | (emu_fp4_enc1(c) << 8) | (emu_fp4_enc1(d) << 12); }
DEV void fp4x8_dec2(unsigned w, f32x2* o) {
    for (int k = 0; k < 4; ++k) o[k] = (f32x2){emu_fp4_dec1((w >> (8 * k)) & 15u), emu_fp4_dec1((w >> (8 * k + 4)) & 15u)};
}
#else
DEV unsigned fp4x4_enc(float a, float b, float c, float d) { unsigned r = 0u; r = __builtin_amdgcn_cvt_scalef32_pk_fp4_f32(r, a, b, 1.0f, 0); r = __builtin_amdgcn_cvt_scalef32_pk_fp4_f32(r, c, d, 1.0f, 1); return r & 0xffffu; }
DEV void fp4x8_dec2(unsigned w, f32x2* o) {
    o[0] = __builtin_amdgcn_cvt_scalef32_pk_f32_fp4(w, 1.0f, 0); o[1] = __builtin_amdgcn_cvt_scalef32_pk_f32_fp4(w, 1.0f, 1);
    o[2] = __builtin_amdgcn_cvt_scalef32_pk_f32_fp4(w, 1.0f, 2); o[3] = __builtin_amdgcn_cvt_scalef32_pk_f32_fp4(w, 1.0f, 3);
}
#endif
DEV void fp4x32_dec2(u32x4 q, f32x2* o) { fp4x8_dec2(q.x, o); fp4x8_dec2(q.y, o + 4); fp4x8_dec2(q.z, o + 8); fp4x8_dec2(q.w, o + 12); }

namespace pg8 {
constexpr int BM = 256, BK = 64, HALF = 128, HTB = HALF * BK * 2, STAGE_BYTES = 8 * HTB, NXCD = 8, WGM = 8;
DEV int lds_byte(int r, int c) { const int st = (r >> 4) * 2 + (c >> 5), rr = r & 15, cc = c & 31, ob = rr * 64 + cc * 2; return st * 1024 + (ob ^ (((ob >> 9) & 1) << 5)); }
DEV void stage_rc(int b, int& R, int& C) { const int st = b / 1024, sb = b % 1024, swz = sb ^ (((sb >> 9) & 1) << 5); R = (st >> 1) * 16 + swz / 64; C = (st & 1) * 32 + (swz % 64) / 2; }
DEV int perm32(int rho) { const int n = rho >> 4, i = rho & 15; return 8 * (i >> 2) + 4 * n + (i & 3); }
struct Unit { int pm, pn; };
struct Gemm { const bf16_t* A; const bf16_t* Bt; int M, N, K; };
struct StaticOrder {
    int nM, nN, nwg, G, c;
    DEV void init(int M, int N, int G_, int c_) { nM = M / BM; nN = N / BM; nwg = nM * nN; G = G_; c = c_; }
    DEV bool next(int i, Unit& u) const {
        const long L = (long)i * G + c; if (L >= nwg) return false;
        int wgid = (int)L; { const int q = nwg / NXCD, r = nwg % NXCD, xcd = wgid % NXCD, off = wgid / NXCD; wgid = (xcd < r ? xcd * (q + 1) : r * (q + 1) + (xcd - r) * q) + off; }
        const int nig = WGM * nN, gid = wgid / nig, fm = gid * WGM, gsz = (nM - fm) < WGM ? (nM - fm) : WGM;
        u.pm = fm + ((wgid % nig) % gsz); u.pn = (wgid % nig) / gsz; return true;
    }
    DEV void a_ready(const Unit&) const {}
    DEV void done(const Unit&) const {}
};
struct PoolOrder {
    int G, c;
    DEV bool next(int i, Unit& u) const { const int L = i * G + c; if (L >= 4 * (MPAD / 256)) return false; u.pm = L; u.pn = L / (MPAD / 256); return true; }
    DEV void a_ready(const Unit&) const {}
    DEV void done(const Unit&) const {}
};

struct EpiF32 {
    static constexpr bool PERM = false;
    float* C; int ldc;
    DEV void operator()(const f32x4 (&acc)[2][2][4][2], const Unit& u, int wr, int wc, int fr, int fq) const {
        const int row0 = u.pm * BM + wr * 64 + fr, col0 = u.pn * BM + wc * 32 + 4 * fq;
#pragma unroll
        for (int ai = 0; ai < 2; ++ai)
#pragma unroll
            for (int m = 0; m < 4; ++m) { float* rowp = C + (size_t)(row0 + ai * HALF + m * 16) * ldc + col0;
#pragma unroll
                for (int bj = 0; bj < 2; ++bj)
#pragma unroll
                    for (int n = 0; n < 2; ++n) *(f32x4*)(rowp + bj * HALF + n * 16) = acc[ai][bj][m][n]; }
    }
};
struct EpiAda {
    static constexpr bool PERM = false;
    float* C; const float* b_ada; const float* b_fin;
    DEV void operator()(const f32x4 (&acc)[2][2][4][2], const Unit& u, int wr, int wc, int fr, int fq) const {
        const int row0 = u.pm * BM + wr * 64 + fr, col0 = u.pn * BM + wc * 32 + 4 * fq;
        const float* bias = (u.pn * BM < 2 * NMOD) ? b_ada + col0 : b_fin + (col0 - 2 * NMOD);
        f32x4 bv[2][2];
#pragma unroll
        for (int bj = 0; bj < 2; ++bj)
#pragma unroll
            for (int n = 0; n < 2; ++n) bv[bj][n] = *(const f32x4*)(bias + bj * HALF + n * 16);
#pragma unroll
        for (int ai = 0; ai < 2; ++ai)
#pragma unroll
            for (int m = 0; m < 4; ++m) { float* rowp = C + (size_t)(row0 + ai * HALF + m * 16) * MODW + col0;
#pragma unroll
                for (int bj = 0; bj < 2; ++bj)
#pragma unroll
                    for (int n = 0; n < 2; ++n) *(f32x4*)(rowp + bj * HALF + n * 16) = acc[ai][bj][m][n] + bv[bj][n]; }
    }
};
struct EpiResid {
    static constexpr bool PERM = false;
    const float* xlo; const float* xhi; const float* gmod  ; float* out;
    DEV void operator()(const f32x4 (&acc)[2][2][4][2], const Unit& u, int wr, int wc, int fr, int fq) const {
        const int row0 = u.pm * BM + wr * 64 + fr, col0 = u.pn * BM + wc * 32 + 4 * fq;
#pragma unroll
        for (int ai = 0; ai < 2; ++ai)
#pragma unroll
            for (int m = 0; m < 4; ++m) {
                const int row = row0 + ai * HALF + m * 16;
                if (row < NTOK) {
                    const float* xr = (row < NP ? xlo + (size_t)row * D : xhi + (size_t)(row - NP) * D) + col0;
                    const float* gr = gmod + (size_t)tok_batch(row) * MODW + col0;
                    float* rowp = out + (size_t)row * D + col0;
#pragma unroll
                    for (int bj = 0; bj < 2; ++bj)
#pragma unroll
                        for (int n = 0; n < 2; ++n) { const f32x4 xv = *(const f32x4*)(xr + bj * HALF + n * 16), gv = *(const f32x4*)(gr + bj * HALF + n * 16);
                            *(f32x4*)(rowp + bj * HALF + n * 16) = xv + gv * acc[ai][bj][m][n]; }
                }
            }
    }
};
struct EpiBf16 {
    static constexpr bool PERM = true;
    bf16_t* O; int ldc;
    DEV void operator()(const f32x4 (&acc)[2][2][4][2], const Unit& u, int wr, int wc, int fr, int fq) const {
        const int row0 = u.pm * BM + wr * 64 + fr, col0 = u.pn * BM + wc * 32 + 8 * fq;
#pragma unroll
        for (int ai = 0; ai < 2; ++ai)
#pragma unroll
            for (int m = 0; m < 4; ++m) { bf16_t* rowp = O + (size_t)(row0 + ai * HALF + m * 16) * ldc + col0;
#pragma unroll
                for (int bj = 0; bj < 2; ++bj) { const f32x4 v0 = acc[ai][bj][m][0], v1 = acc[ai][bj][m][1];
                    u32x4 w; w.x = pack2(v0[0], v0[1]); w.y = pack2(v0[2], v0[3]); w.z = pack2(v1[0], v1[1]); w.w = pack2(v1[2], v1[3]);
                    *(u32x4*)(rowp + bj * HALF) = w; } }
    }
};
struct EpiPool {
    static constexpr bool PERM = true;
    bf16_t* cat; const float* pb; const float* ps;
    DEV void operator()(const f32x4 (&acc)[2][2][4][2], const Unit& u, int wr, int wc, int fr, int fq) const {
        const int g = u.pn, tok0 = u.pm * BM - g * MPAD + wr * 64 + fr, col0 = g * 256 + wc * 32 + 8 * fq;
#pragma unroll
        for (int bj = 0; bj < 2; ++bj) {
            const f32x4 b0 = *(const f32x4*)(pb + col0 + bj * HALF), b1 = *(const f32x4*)(pb + col0 + bj * HALF + 4);
            const f32x4 s0 = *(const f32x4*)(ps + col0 + bj * HALF), s1 = *(const f32x4*)(ps + col0 + bj * HALF + 4);
#pragma unroll
            for (int ai = 0; ai < 2; ++ai)
#pragma unroll
                for (int m = 0; m < 4; ++m) { const int tok = tok0 + ai * HALF + m * 16;
                    if (tok < NTOK) { const f32x4 v0 = (acc[ai][bj][m][0] + b0) * s0, v1 = (acc[ai][bj][m][1] + b1) * s1;
                        u32x4 w; w.x = pack2(v0[0], v0[1]); w.y = pack2(v0[2], v0[3]); w.z = pack2(v1[0], v1[1]); w.w = pack2(v1[2], v1[3]);
                        *(u32x4*)(cat + (size_t)tok * D + 1024 + col0 + bj * HALF) = w; } }
        }
    }
};

#ifdef HIPEMU
template <class Epi, class Sched>
static void gemm_phase(unsigned char*, const Gemm g, const Sched& S, const Epi& E) {
    const int tid = threadIdx.x, wid = tid >> 6, lane = tid & 63, wr = wid >> 2, wc = wid & 3, fr = lane & 15, fq = lane >> 4;
    Unit cur;
    for (int ui = 0; S.next(ui, cur); ++ui) {
        f32x4 acc[2][2][4][2];
        for (int ai = 0; ai < 2; ++ai) for (int bj = 0; bj < 2; ++bj) for (int m = 0; m < 4; ++m) for (int n = 0; n < 2; ++n) for (int j = 0; j < 4; ++j) {
            const int row = 256 * cur.pm + 128 * ai + 64 * wr + 16 * m + fr;
            const int col = Epi::PERM ? 256 * cur.pn + 128 * bj + 32 * wc + 8 * fq + 4 * n + j : 256 * cur.pn + 128 * bj + 32 * wc + 16 * n + 4 * fq + j;
            float s = 0.f;
            if ((row % emu_row_mod) < emu_row_limit) { const float* a = emu_f32_copy(g.A, (size_t)g.M * g.K) + (size_t)row * g.K; const float* b = emu_f32_copy(g.Bt, (size_t)g.N * g.K) + (size_t)col * g.K;
                for (int k = 0; k < g.K; ++k) s += a[k] * b[k]; }
            acc[ai][bj][m][n][j] = s; }
        E(acc, cur, wr, wc, fr, fq);
    }
    __syncthreads();
}
#else
template <class Epi, class Sched>
__device__ __forceinline__ void gemm_phase(LAS unsigned char* lds, const Gemm g, const Sched& S, const Epi& E) {
    const int tid = threadIdx.x, wid = __builtin_amdgcn_readfirstlane(tid >> 6), lane = tid & 63, wr = wid >> 2, wc = wid & 3, fr = lane & 15, fq = lane >> 4;
    int K = g.K; asm volatile("" : "+s"(K));
    const int nt = K / BK;
    unsigned voffA[2], voffB[2];
#pragma unroll
    for (int i = 0; i < 2; ++i) { int R, C; stage_rc(tid * 16 + i * 8192, R, C); const int Rb = Epi::PERM ? ((R & ~31) + perm32(R & 31)) : R;
        voffA[i] = (unsigned)(R * K + C) * 2u; voffB[i] = (unsigned)(Rb * K + C) * 2u; }
    const size_t kstep = (size_t)(BK * 2);
    const size_t hstep = (size_t)HALF * K * 2;
    const size_t tstep = 2 * hstep;
    const unsigned ldsw = (unsigned)wid * 1024u;
    const int aoff = lds_byte(wr * 64 + fr, fq * 8), boff = lds_byte(wc * 32 + fr, fq * 8);
#define PG8_SA(b, h) (((b) * 2 + (h)) * HTB)
#define PG8_SB(b, h) ((4 + (b) * 2 + (h)) * HTB)
#define PG8_STAGE(bufoff, gbase, voff) do { _Pragma("unroll") for (int _i = 0; _i < 2; ++_i) \
        __builtin_amdgcn_global_load_lds((const unsigned*)((const char*)(gbase) + (voff)[_i]), (LAS unsigned*)(lds + (bufoff) + ldsw + _i * 8192), 16, 0, 0); } while (0)
#define PG8_LDA(dst, b, h) do { _Pragma("unroll") for (int m = 0; m < 4; ++m) _Pragma("unroll") for (int k = 0; k < 2; ++k) dst[m][k] = *(const LAS bf16x8*)(lds + PG8_SA(b, h) + aoff + m * 2048 + k * 1024); } while (0)
#define PG8_LDB(dst, b, h) do { _Pragma("unroll") for (int n = 0; n < 2; ++n) _Pragma("unroll") for (int k = 0; k < 2; ++k) dst[n][k] = *(const LAS bf16x8*)(lds + PG8_SB(b, h) + boff + n * 2048 + k * 1024); } while (0)
#define PG8_MMA(ai, bj, At, Bt) do { __builtin_amdgcn_s_setprio(1); _Pragma("unroll") for (int m = 0; m < 4; ++m) _Pragma("unroll") for (int n = 0; n < 2; ++n) _Pragma("unroll") for (int k = 0; k < 2; ++k) \
        acc[ai][bj][m][n] = __builtin_amdgcn_mfma_f32_16x16x32_bf16(Bt[n][k], At[m][k], acc[ai][bj][m][n], 0, 0, 0); __builtin_amdgcn_s_setprio(0); } while (0)
#define PG8_WAIT_V(n) asm volatile("s_waitcnt vmcnt(" #n ")" ::: "memory")
#define PG8_WAIT_L(n) asm volatile("s_waitcnt lgkmcnt(" #n ")" ::: "memory")
#define PG8_BAR __builtin_amdgcn_s_barrier()
#define PG8_SCHED __builtin_amdgcn_sched_barrier(0)
    Unit cur, nxt; int ui = 0;
    if (!S.next(0, cur)) return;
    f32x4 acc[2][2][4][2];
#pragma unroll
    for (int a = 0; a < 2; ++a)
#pragma unroll
        for (int b = 0; b < 2; ++b)
#pragma unroll
            for (int m = 0; m < 4; ++m)
#pragma unroll
                for (int n = 0; n < 2; ++n) acc[a][b][m][n] = (f32x4){0.f, 0.f, 0.f, 0.f};
    bf16x8 At[4][2], B0[2][2], B1[2][2];
    const char* cA = (const char*)g.A + (size_t)cur.pm * tstep; const char* cB = (const char*)g.Bt + (size_t)cur.pn * tstep;
    S.a_ready(cur);
    PG8_STAGE(PG8_SB(0, 0), cB, voffB); PG8_STAGE(PG8_SA(0, 0), cA, voffA); PG8_STAGE(PG8_SB(0, 1), cB + hstep, voffB); PG8_STAGE(PG8_SA(0, 1), cA + hstep, voffA);
    if (wr == 1) PG8_BAR;
    PG8_WAIT_V(4); PG8_BAR;
    PG8_STAGE(PG8_SB(1, 0), cB + kstep, voffB); PG8_STAGE(PG8_SA(1, 0), cA + kstep, voffA); PG8_STAGE(PG8_SB(1, 1), cB + hstep + kstep, voffB);
    PG8_WAIT_V(6); PG8_BAR;
    for (;;) {
        const bool has_next = S.next(ui + 1, nxt);
        const char* nA = has_next ? (const char*)g.A + (size_t)nxt.pm * tstep : cA; const char* nB = has_next ? (const char*)g.Bt + (size_t)nxt.pn * tstep : cB;
        for (int t = 0; t < nt; t += 2) {
            const bool last = (t == nt - 2);
            const char* a1 = cA + (size_t)(t + 1) * kstep;
            const char* a2 = last ? nA : cA + (size_t)(t + 2) * kstep; const char* b2 = last ? nB : cB + (size_t)(t + 2) * kstep;
            const char* a3 = a2 + kstep; const char* b3 = b2 + kstep;
            if (last && has_next) S.a_ready(nxt);
            PG8_LDB(B0, 0, 0); PG8_SCHED; PG8_LDA(At, 0, 0); PG8_STAGE(PG8_SA(1, 1), a1 + hstep, voffA);
            PG8_WAIT_L(8); PG8_BAR; PG8_WAIT_L(0); PG8_MMA(0, 0, At, B0); PG8_BAR; PG8_SCHED;
            PG8_LDB(B1, 0, 1); PG8_STAGE(PG8_SB(0, 0), b2, voffB);
            PG8_BAR; PG8_WAIT_L(0); PG8_MMA(0, 1, At, B1); PG8_BAR;
            PG8_LDA(At, 0, 1); PG8_STAGE(PG8_SA(0, 0), a2, voffA);
            PG8_BAR; PG8_WAIT_L(0); PG8_MMA(1, 0, At, B0); PG8_BAR; PG8_SCHED;
            PG8_STAGE(PG8_SB(0, 1), b2 + hstep, voffB);
            PG8_WAIT_V(6); PG8_BAR; PG8_MMA(1, 1, At, B1); PG8_BAR;
            PG8_LDB(B0, 1, 0); PG8_SCHED; PG8_LDA(At, 1, 0); PG8_STAGE(PG8_SA(0, 1), a2 + hstep, voffA);
            PG8_WAIT_L(8); PG8_BAR; PG8_WAIT_L(0); PG8_MMA(0, 0, At, B0); PG8_BAR; PG8_SCHED;
            PG8_LDB(B1, 1, 1); PG8_STAGE(PG8_SB(1, 0), b3, voffB);
            PG8_BAR; PG8_WAIT_L(0); PG8_MMA(0, 1, At, B1); PG8_BAR;
            PG8_LDA(At, 1, 1); PG8_STAGE(PG8_SA(1, 0), a3, voffA);
            PG8_BAR; PG8_WAIT_L(0); PG8_MMA(1, 0, At, B0); PG8_BAR; PG8_SCHED;
            PG8_STAGE(PG8_SB(1, 1), b3 + hstep, voffB);
            PG8_WAIT_V(6); PG8_BAR; PG8_MMA(1, 1, At, B1); PG8_BAR;
        }
        { int tz = threadIdx.x; asm volatile("" : "+v"(tz)); const int wz = tz >> 6, lz = tz & 63;
          E(acc, cur, wz >> 2, wz & 3, lz & 15, lz >> 4); } S.done(cur);
        if (!has_next) break;
#pragma unroll
        for (int a = 0; a < 2; ++a)
#pragma unroll
            for (int b = 0; b < 2; ++b)
#pragma unroll
                for (int m = 0; m < 4; ++m)
#pragma unroll
                    for (int n = 0; n < 2; ++n) acc[a][b][m][n] = (f32x4){0.f, 0.f, 0.f, 0.f};
        cur = nxt; cA = nA; cB = nB; ++ui;
    }
    PG8_WAIT_V(0);
    if (wr == 0) PG8_BAR;
    PG8_BAR;
#undef PG8_SA
#undef PG8_SB
#undef PG8_STAGE
#undef PG8_LDA
#undef PG8_LDB
#undef PG8_MMA
#undef PG8_WAIT_V
#undef PG8_WAIT_L
#undef PG8_BAR
#undef PG8_SCHED
}
#endif
}

constexpr int MBIG = (NP / 256) * 256;
template <class F> DEV void small_gemm(const bf16_t* A, const bf16_t* Bt, int K, unsigned char* lds, const F& f) {
    const int tid = threadIdx.x, lane = tid & 63, w = tid >> 6, g = lane >> 4, c16 = lane & 15;
    const int tiles_m = (NTOK - MBIG + 63) / 64, ntiles = tiles_m * 32, kw = K / 8;
    float* part = (float*)lds;
    for (int tl = blockIdx.x; tl < ntiles; tl += gridDim.x) {
        const int r0 = MBIG + (tl / 32) * 64, n0 = (tl % 32) * 64;
        f32x4 acc[4][4];
#pragma unroll
        for (int i = 0; i < 4; ++i)
#pragma unroll
            for (int j = 0; j < 4; ++j) acc[i][j] = (f32x4){0.f, 0.f, 0.f, 0.f};
        for (int k0 = w * kw; k0 < (w + 1) * kw; k0 += 128) {
            bf16x8 af[4][4], bfr[4][4];
#pragma unroll
            for (int u = 0; u < 4; ++u)
#pragma unroll
                for (int i = 0; i < 4; ++i) { int arow = r0 + 16 * i + c16; if (arow >= MPAD) arow = MPAD - 1;
                    af[u][i] = *(const bf16x8*)(A + (size_t)arow * K + k0 + 32 * u + 8 * g); bfr[u][i] = *(const bf16x8*)(Bt + (size_t)(n0 + 16 * i + c16) * K + k0 + 32 * u + 8 * g); }
#pragma unroll
            for (int u = 0; u < 4; ++u)
#pragma unroll
                for (int i = 0; i < 4; ++i)
#pragma unroll
                    for (int j = 0; j < 4; ++j) acc[i][j] = MFMA_BF16(af[u][i], bfr[u][j], acc[i][j]);
        }
#pragma unroll
        for (int i = 0; i < 4; ++i)
#pragma unroll
            for (int j = 0; j < 4; ++j)
#pragma unroll
                for (int r = 0; r < 4; ++r) part[(w * 64 + 16 * i + 4 * g + r) * 68 + 16 * j + c16] = acc[i][j][r];
        __syncthreads();
        {
            const int row = tid >> 3, c8 = (tid & 7) * 8; f32x4 s0 = (f32x4){0.f, 0.f, 0.f, 0.f}, s1 = s0;
#pragma unroll
            for (int ww = 0; ww < 8; ++ww) { s0 += *(const f32x4*)(part + (ww * 64 + row) * 68 + c8); s1 += *(const f32x4*)(part + (ww * 64 + row) * 68 + c8 + 4); }
            if (r0 + row < NTOK) f(r0 + row, n0 + c8, s0, s1);
        }
        __syncthreads();
    }
}
struct SmallResid { const float* xlo; const float* xhi; const float* gmod; float* out;
    DEV void operator()(int row, int col, f32x4 v0, f32x4 v1) const { const float* xr = (row < NP ? xlo + (size_t)row * D : xhi + (size_t)(row - NP) * D) + col; const float* gr = gmod + (size_t)tok_batch(row) * MODW + col;
        float* o = out + (size_t)row * D + col; *(f32x4*)o = *(const f32x4*)xr + *(const f32x4*)gr * v0; *(f32x4*)(o + 4) = *(const f32x4*)(xr + 4) + *(const f32x4*)(gr + 4) * v1; } };
struct SmallF32 { float* out; DEV void operator()(int row, int col, f32x4 v0, f32x4 v1) const { float* o = out + (size_t)row * D + col; *(f32x4*)o = v0; *(f32x4*)(o + 4) = v1; } };

DEV void transpose_tile(const float* src, int ld_src, bf16_t* dst, int ld_dst, float* tile) {
    const int tid = threadIdx.x;
#pragma unroll
    for (int i = 0; i < 2; ++i) { const int idx = tid + i * 512, r = idx >> 4, c4 = idx & 15; const f32x4 v = *(const f32x4*)(src + (size_t)r * ld_src + c4 * 4);
        float* t = tile + r * 65 + c4 * 4; t[0] = v[0]; t[1] = v[1]; t[2] = v[2]; t[3] = v[3]; }
    __syncthreads();
    const int n = tid >> 3, kg = tid & 7; const float* t = tile + (kg * 8) * 65 + n;
    u32x4 w; w.x = pack2(t[0], t[65]); w.y = pack2(t[2 * 65], t[3 * 65]); w.z = pack2(t[4 * 65], t[5 * 65]); w.w = pack2(t[6 * 65], t[7 * 65]);
    *(u32x4*)(dst + (size_t)n * ld_dst + kg * 8) = w;
    __syncthreads();
}
DEV int cvt_job_tiles(int j) { const int K = j < 9 ? 2048 : 256; const int N = j < 2 ? NMOD : (j == 2 ? 2 * D : (j < 5 ? ZW : (j < 9 ? D : 256))); return (K / 64) * (N / 64); }
constexpr int TBL_SLOT = 10240, TBL_VP1 = 4 * NE - 2 * TBL_SLOT;
DEV int gemm_in_idle_blocks() { const int nwg = (MPAD / 256) * (ZW / 256), G = (int)gridDim.x, rounds = (nwg + G - 1) / G, full = nwg - (rounds - 1) * G; return G - full; }
DEV bool tbl_deferred() { return gemm_in_idle_blocks() >= 32; }
DEV void table_row_to_fp8(const Params& p, int vr, int lane) {
    const int l = vr / (2 * NE), which = (vr % (2 * NE)) / NE, e = vr % NE, rr = l * NE + e;
    const float* src = (which ? p.peer_v : p.peer_u) + (size_t)rr * D;
    f32x4 v[8]; float am = 0.f;
#pragma unroll
    for (int k = 0; k < 8; ++k) { v[k] = *(const f32x4*)(src + 4 * lane + 256 * k); am = fmaxf(am, fmaxf(fmaxf(fabsf(v[k][0]), fabsf(v[k][1])), fmaxf(fabsf(v[k][2]), fabsf(v[k][3])))); }
    am = wave_max(am);
    if (which == 0) {
        unsigned char* tab = p.u8 + (size_t)l * NE * D;
        const float sc = am > 0.f ? 224.0f / am : 1.0f;
#pragma unroll
        for (int k = 0; k < 8; ++k) *(unsigned*)(tab + ((size_t)(2 * k + (lane >> 5)) * NE + e) * 128 + 4 * (lane & 31)) = fp8x4_enc(v[k][0] * sc, v[k][1] * sc, v[k][2] * sc, v[k][3] * sc);
        if (lane == 0) p.su[rr] = am > 0.f ? am * (1.0f / 224.0f) : 1.0f;
    } else {
        unsigned char* tab = p.v8 + (size_t)l * NE * (D / 2);
        const float sc = am > 0.f ? 6.0f / am : 1.0f;
#pragma unroll
        for (int k = 0; k < 8; ++k) *(unsigned short*)(tab + ((size_t)k * NE + e) * 128 + 2 * lane) = (unsigned short)fp4x4_enc(v[k][0] * sc, v[k][1] * sc, v[k][2] * sc, v[k][3] * sc);
        if (lane == 0) p.sv[rr] = am > 0.f ? am * (1.0f / 6.0f) : 1.0f;
    }
}
DEV void phase_tbl_slot(const Params& p, int l) {
    const int idle = gemm_in_idle_blocks(), first = (int)gridDim.x - idle;
    if (idle < 32 || (int)blockIdx.x < first) return;
    const int gw = ((int)blockIdx.x - first) * 8 + wave_id(), nw = idle * 8, lo = TBL_VP1 + l * TBL_SLOT;
    for (int vr = lo + gw; vr < lo + TBL_SLOT; vr += nw) table_row_to_fp8(p, vr, threadIdx.x & 63);
}
DEV void phase_convert(const Params& p, unsigned char* lds, int part) {
    float* tile = (float*)lds;
    const int tid = threadIdx.x;
    const int q_lo = part == 0 ? 0 : 3, q_hi = part == 0 ? 3 : 17;
    int total = 0;
#pragma unroll
    for (int q = 0; q < 17; ++q) if (q >= q_lo && q < q_hi) total += cvt_job_tiles(q);
    for (int tl = blockIdx.x; tl < total; tl += gridDim.x) {
        int j = 0, loc = 0, base = 0;
#pragma unroll
        for (int q = 0; q < 17; ++q) if (q >= q_lo && q < q_hi) { const int cnt = cvt_job_tiles(q); if (tl >= base && tl < base + cnt) { j = q; loc = tl - base; } base += cnt; }
        const float* src; bf16_t* dst; int K = 2048, N;
        if (j < 2) { N = NMOD; src = p.w_ada + (size_t)j * 2048 * NMOD; dst = p.wt_ada + (size_t)j * NMOD * 2048; }
        else if (j == 2) { N = 2 * D; src = p.w_ada_final; dst = p.wt_ada + (size_t)2 * NMOD * 2048; }
        else if (j < 5) { N = ZW; src = p.w_in + (size_t)(j - 3) * 2048 * ZW; dst = p.wt_in + (size_t)(j - 3) * ZW * 2048; }
        else if (j < 7) { N = D; src = p.w_out + (size_t)(j - 5) * D * D; dst = p.wt_out + (size_t)(j - 5) * D * D; }
        else if (j < 9) { N = D; src = p.peer_wq + (size_t)(j - 7) * D * D; dst = p.wt_q + (size_t)(j - 7) * D * D; }
        else { K = 256; N = 256; src = p.pool_w + (size_t)(j - 9) * 65536; dst = p.wt_pool + (size_t)(j - 9) * 65536; }
        const int ntn = N / 64, kt = loc / ntn, nt = loc % ntn;
        transpose_tile(src + (size_t)kt * 64 * N + nt * 64, N, dst + (size_t)nt * 64 * K + kt * 64, K, tile);
    }
    const size_t gt = (size_t)blockIdx.x * 512 + tid, gs = (size_t)gridDim.x * 512;
    if (part == 1) {
        constexpr int NADA = MODW / 256;
        const int vend = tbl_deferred() ? TBL_VP1 : 4 * NE, R1 = (vend / 8) * 7;
        const bool uneven = (int)gridDim.x > NADA + 16;
        for (int seg = 0; seg < 2; ++seg) {
            int gw, nw, r_lo, r_hi;
            if (!uneven) { if (seg) break; gw = blockIdx.x * 8 + wave_id(); nw = gridDim.x * 8; r_lo = 0; r_hi = vend; }
            else if (seg == 0) { gw = blockIdx.x * 8 + wave_id(); nw = gridDim.x * 8; r_lo = 0; r_hi = R1; }
            else { if ((int)blockIdx.x < NADA) break; gw = ((int)blockIdx.x - NADA) * 8 + wave_id(); nw = ((int)gridDim.x - NADA) * 8; r_lo = R1; r_hi = vend; }
            for (int vr = r_lo + gw; vr < r_hi; vr += nw) table_row_to_fp8(p, vr, tid & 63);
        }
    }
    if (part == 0) for (size_t i = gt; i < (size_t)256 * D / 8; i += gs) {
        const int row = (int)(i / (D / 8)), c8 = (int)(i % (D / 8)) * 8; u32x4 w = (u32x4){0u, 0u, 0u, 0u};
        if (row < NC) { const float* s = (row < PB ? p.c_prompt + (size_t)row * D : p.c_sample + (size_t)(row - PB) * D) + c8;
            const f32x4 a = *(const f32x4*)s, b = *(const f32x4*)(s + 4);
            w.x = pack2(siluf_(a[0]), siluf_(a[1])); w.y = pack2(siluf_(a[2]), siluf_(a[3])); w.z = pack2(siluf_(b[0]), siluf_(b[1])); w.w = pack2(siluf_(b[2]), siluf_(b[3])); }
        *(u32x4*)(p.csil + i * 8) = w;
    }
}

DEV void phase_norm(const Params& p, const float* xlo, const float* xhi, const float* gn, int sh_off, int sc_off, bf16_t* obf, float* of32) {
    const int lane = threadIdx.x & 63, gw = blockIdx.x * 8 + wave_id(), nw = gridDim.x * 8;
    for (int t = gw; t < NTOK; t += nw) {
        const float* xr = t < NP ? xlo + (size_t)t * D : xhi + (size_t)(t - NP) * D;
        const float* mrow = p.modbuf + (size_t)tok_batch(t) * MODW;
        f32x4 v[8]; float ss = 0.f;
#pragma unroll
        for (int c = 0; c < 4; ++c) { const int col = c * 512 + lane * 8; v[2 * c] = *(const f32x4*)(xr + col); v[2 * c + 1] = *(const f32x4*)(xr + col + 4);
#pragma unroll
            for (int j = 0; j < 4; ++j) ss += v[2 * c][j] * v[2 * c][j] + v[2 * c + 1][j] * v[2 * c + 1][j]; }
        ss = wave_sum(ss);
        const float rstd = rsqrtf(ss * (1.0f / D) + EPS);
#pragma unroll
        for (int c = 0; c < 4; ++c) { const int col = c * 512 + lane * 8; f32x4 y[2];
#pragma unroll
            for (int q = 0; q < 2; ++q) { const f32x4 g4 = *(const f32x4*)(gn + col + 4 * q), sc = *(const f32x4*)(mrow + sc_off + col + 4 * q), sh = *(const f32x4*)(mrow + sh_off + col + 4 * q);
                y[q] = (v[2 * c + q] * rstd) * g4 * (sc + 1.0f) + sh; }
            if (obf) { u32x4 w; w.x = pack2(y[0][0], y[0][1]); w.y = pack2(y[0][2], y[0][3]); w.z = pack2(y[1][0], y[1][1]); w.w = pack2(y[1][2], y[1][3]); *(u32x4*)(obf + (size_t)t * D + col) = w; }
            else { *(f32x4*)(of32 + (size_t)t * D + col) = y[0]; *(f32x4*)(of32 + (size_t)t * D + col + 4) = y[1]; }
        }
    }
}

namespace hg {
constexpr int QS = 136, VS = 72;
constexpr int O_QT = 0, O_QH = O_QT + 64 * QS * 2, O_KT = O_QH + 64 * QS * 2, O_KDT = O_KT + 160 * QS * 2, O_VT = O_KDT + 128 * VS * 2,
              O_AB = O_VT + 128 * VS * 2, O_GS = O_AB + 64 * VS * 2, O_END = O_GS + 4 * 128 * 4;
constexpr int OS = 132;
static_assert(O_END <= 163840 - 64, "HGRN LDS layout too large");
constexpr int NCHUNK = SEQ / 64, NUNIT = PB * HH * NCHUNK;
}
DEV int kt_rowbase(int i) { return i == 0 ? 0 : (i == 1 ? 16 : (i == 2 ? 48 : 96)); }

DEV void hgrn_pre_unit(const Params& p, int l, int unit, unsigned char* lds) {
    using namespace hg;
    const int tid = threadIdx.x, lane = tid & 63, w = tid >> 6, g = lane >> 4, c16 = lane & 15;
    const int c = unit % NCHUNK, bh = unit / NCHUNK, b = bh / HH, h = bh % HH;
    bf16_t* Qt = (bf16_t*)(lds + O_QT); bf16_t* Qh = (bf16_t*)(lds + O_QH); bf16_t* Kt = (bf16_t*)(lds + O_KT);
    bf16_t* Kdt = (bf16_t*)(lds + O_KDT); bf16_t* Vt = (bf16_t*)(lds + O_VT); bf16_t* Ab = (bf16_t*)(lds + O_AB); float* Gs = (float*)(lds + O_GS);
    const int kk = tid & 127, sj = tid >> 7;
    float lbv = 0.f;
    if (l > 0) lbv = sigmoidf_(p.lb_logits[HH * HD + h * HD + kk] - p.lb_logits[h * HD + kk]);
    const float oml = 1.0f - lbv;
    for (int i = tid; i < 64 * VS / 2; i += 512) ((unsigned*)Ab)[i] = 0u;
    const size_t row0 = (size_t)b * SEQ + c * 64;
    float Gl[16], qv[16], kv[16];
    {
        const bf16_t* zr = p.z + (row0 + sj * 16) * ZW + h * HD + kk;
        unsigned short zq16[16], zf16[16], zi16[16];
#pragma unroll
        for (int s = 0; s < 16; ++s) { zq16[s] = zr[(size_t)s * ZW]; zf16[s] = zr[(size_t)s * ZW + 1024]; zi16[s] = zr[(size_t)s * ZW + 2048]; }
        float run = 0.f; unsigned vpk[8];
#pragma unroll
        for (int s = 0; s < 16; ++s) {
            const float zq = bf2f(zq16[s]), zf = fminf(fmaxf(bf2f(zf16[s]), -80.f), 80.f);
            const float e = __expf(-zf), sg = 1.0f / (1.0f + e);
            const float f = lbv + oml * sg;
            run += __logf(f); Gl[s] = run;
            kv[s] = oml * (e * sg);
            qv[s] = siluf_(zq);
            if (s & 1) vpk[s >> 1] |= (unsigned)zi16[s] << 16; else vpk[s >> 1] = zi16[s];
        }
        Gs[sj * 128 + kk] = run;
        *(u32x4*)(Vt + kk * VS + sj * 16) = (u32x4){vpk[0], vpk[1], vpk[2], vpk[3]}; *(u32x4*)(Vt + kk * VS + sj * 16 + 8) = (u32x4){vpk[4], vpk[5], vpk[6], vpk[7]};
    }
    __syncthreads();
    float Gend;
    {
        const float g0 = Gs[kk], g1 = Gs[128 + kk], g2 = Gs[256 + kk], g3 = Gs[384 + kk];
        float Gb[4]; Gb[0] = 0.f; Gb[1] = g0; Gb[2] = g0 + g1; Gb[3] = g0 + g1 + g2; Gend = Gb[3] + g3;
        const float Gbj = sj == 0 ? Gb[0] : (sj == 1 ? Gb[1] : (sj == 2 ? Gb[2] : Gb[3]));
        const float eGb = __expf(Gbj);
        unsigned kd[8]; unsigned qh[8];
#pragma unroll
        for (int s = 0; s < 16; ++s) {
            const int t = sj * 16 + s;
            const float q1 = qv[s] * __expf(Gl[s]);
            Qt[t * QS + kk] = (bf16_t)f2bf(q1);
            const unsigned qhv = f2bf(q1 * eGb);
            Qh[t * QS + kk] = (bf16_t)qhv;
#pragma unroll
            for (int i = 0; i < 4; ++i) if (i >= sj) Kt[(kt_rowbase(i) + t) * QS + kk] = (bf16_t)f2bf(kv[s] * __expf(fminf(Gb[i] - Gbj - Gl[s], 60.f)));
            const unsigned kdv = f2bf(kv[s] * __expf(Gend - Gbj - Gl[s]));
            if (s & 1) kd[s >> 1] |= kdv << 16; else kd[s >> 1] = kdv;
        }
        *(u32x4*)(Kdt + kk * VS + sj * 16) = (u32x4){kd[0], kd[1], kd[2], kd[3]}; *(u32x4*)(Kdt + kk * VS + sj * 16 + 8) = (u32x4){kd[4], kd[5], kd[6], kd[7]};
        if (sj == 0) p.hg_gam[(size_t)unit * HD + kk] = __expf(Gend);
    }
    __syncthreads();
    {
        const int t = tid >> 3, part = tid & 7;
        const u32x4 a = *(const u32x4*)(Qh + t * QS + 16 * part), b2 = *(const u32x4*)(Qh + t * QS + 16 * part + 8);
        bf16_t* dst = p.hg_qh + (row0 + t) * 1024 + h * HD + 16 * part; *(u32x4*)dst = a; *(u32x4*)(dst + 8) = b2;
    }
    for (int blk = w; blk < 10; blk += 8) {
        int bi, bjj;
        if (blk == 0) { bi = 0; bjj = 0; } else if (blk < 3) { bi = 1; bjj = blk - 1; } else if (blk < 6) { bi = 2; bjj = blk - 3; } else { bi = 3; bjj = blk - 6; }
        f32x4 acc = (f32x4){0.f, 0.f, 0.f, 0.f};
#pragma unroll
        for (int ks = 0; ks < 4; ++ks) {
            const bf16x8 a = *(const bf16x8*)(Qt + (16 * bi + c16) * QS + 32 * ks + 8 * g);
            const bf16x8 bb = *(const bf16x8*)(Kt + (kt_rowbase(bi) + 16 * bjj + c16) * QS + 32 * ks + 8 * g);
            acc = MFMA_BF16(a, bb, acc);
        }
#pragma unroll
        for (int r = 0; r < 4; ++r) { const int tl = 4 * g + r; float v = acc[r]; if (bi == bjj && c16 > tl) v = 0.f; Ab[(16 * bi + tl) * VS + 16 * bjj + c16] = (bf16_t)f2bf(v); }
    }
    __syncthreads();
    {
        u32x2* oin = (u32x2*)(p.hg_oin + (size_t)unit * 64 * 128);
#pragma unroll
        for (int tt = 0; tt < 4; ++tt) {
            f32x4 acc = (f32x4){0.f, 0.f, 0.f, 0.f};
#pragma unroll
            for (int ks = 0; ks < 2; ++ks) {
                const bf16x8 a = *(const bf16x8*)(Ab + (16 * tt + c16) * VS + 32 * ks + 8 * g);
                const bf16x8 bb = *(const bf16x8*)(Vt + (16 * w + c16) * VS + 32 * ks + 8 * g);
                acc = MFMA_BF16(a, bb, acc);
            }
            oin[(tt * 8 + w) * 64 + lane] = (u32x2){pack2(acc[0], acc[1]), pack2(acc[2], acc[3])};
        }
        u32x2* ds = (u32x2*)(p.hg_ds + (size_t)unit * 128 * 128);
#pragma unroll
        for (int vt = 0; vt < 8; ++vt) {
            f32x4 acc = (f32x4){0.f, 0.f, 0.f, 0.f};
#pragma unroll
            for (int ks = 0; ks < 2; ++ks) {
                const bf16x8 a = *(const bf16x8*)(Kdt + (16 * w + c16) * VS + 32 * ks + 8 * g);
                const bf16x8 bb = *(const bf16x8*)(Vt + (16 * vt + c16) * VS + 32 * ks + 8 * g);
                acc = MFMA_BF16(a, bb, acc);
            }
            ds[(w * 8 + vt) * 64 + lane] = (u32x2){pack2(acc[0], acc[1]), pack2(acc[2], acc[3])};
        }
    }
    __syncthreads();
}

DEV void hgrn_scan_unit(const Params& p, int l, int su) {
    using namespace hg;
    const int tid = threadIdx.x, lane = tid & 63, w = tid >> 6, g = lane >> 4, c16 = lane & 15;
    const int vt = su % 8, bh = su / 8, b = bh / HH, h = bh % HH;
    f32x4 S = (f32x4){0.f, 0.f, 0.f, 0.f};
    constexpr int CB = NCHUNK < 16 ? NCHUNK : 16;
    static_assert(NCHUNK % CB == 0, "chunk batch");
    for (int c0 = 0; c0 < NCHUNK; c0 += CB) {
        u32x2 dw[CB]; f32x4 gm[CB];
#pragma unroll
        for (int i = 0; i < CB; ++i) { const size_t unit = (size_t)bh * NCHUNK + c0 + i;
            dw[i] = ((const u32x2*)(p.hg_ds + unit * 128 * 128))[(w * 8 + vt) * 64 + lane]; gm[i] = *(const f32x4*)(p.hg_gam + unit * HD + 16 * w + 4 * g); }
#pragma unroll
        for (int i = 0; i < CB; ++i) { const size_t unit = (size_t)bh * NCHUNK + c0 + i;
            u32x2 sw; sw.x = pack2(S[0], S[1]); sw.y = pack2(S[2], S[3]);
            *(u32x2*)(p.hg_sc + (unit * 128 + 16 * vt + c16) * 128 + 16 * w + 4 * g) = sw;
            const f32x4 d = (f32x4){lo16(dw[i].x), hi16(dw[i].x), lo16(dw[i].y), hi16(dw[i].y)};
            S = S * gm[i] + d; }
    }
    float* so = p.out + OFF_HP + ((size_t)(l * PB + b) * HH + h) * HD * HD;
#pragma unroll
    for (int r = 0; r < 4; ++r) so[(size_t)(16 * w + 4 * g + r) * HD + 16 * vt + c16] = S[r];
}

DEV void hgrn_post_unit(const Params& p, int l, int unit, unsigned char* lds) {
    using namespace hg;
    const int tid = threadIdx.x, lane = tid & 63, w = tid >> 6, g = lane >> 4, c16 = lane & 15;
    const int c = unit % NCHUNK, bh = unit / NCHUNK, b = bh / HH, h = bh % HH;
    float* Ob = (float*)lds;
    const size_t row0 = (size_t)b * SEQ + c * 64;
    const u32x2* oin = (const u32x2*)(p.hg_oin + (size_t)unit * 64 * 128);
    u32x2 ow[4];
#pragma unroll
    for (int tt = 0; tt < 4; ++tt) ow[tt] = oin[(tt * 8 + w) * 64 + lane];
    bf16x8 bfr[4], af[4][4];
    if (c > 0) {
#pragma unroll
        for (int ks = 0; ks < 4; ++ks) bfr[ks] = *(const bf16x8*)(p.hg_sc + ((size_t)unit * 128 + 16 * w + c16) * 128 + 32 * ks + 8 * g);
#pragma unroll
        for (int tt = 0; tt < 4; ++tt)
#pragma unroll
            for (int ks = 0; ks < 4; ++ks) af[tt][ks] = *(const bf16x8*)(p.hg_qh + (row0 + 16 * tt + c16) * 1024 + h * HD + 32 * ks + 8 * g);
    }
    const bf16_t* zgp = p.z + (row0 + (tid >> 3)) * ZW + 3072 + h * HD + 16 * (tid & 7);
    const u32x4 za = *(const u32x4*)zgp, zc = *(const u32x4*)(zgp + 8);
    f32x4 acc[4];
#pragma unroll
    for (int tt = 0; tt < 4; ++tt) acc[tt] = (f32x4){lo16(ow[tt].x), hi16(ow[tt].x), lo16(ow[tt].y), hi16(ow[tt].y)};
    if (c > 0) {
#pragma unroll
        for (int tt = 0; tt < 4; ++tt)
#pragma unroll
            for (int ks = 0; ks < 4; ++ks) acc[tt] = MFMA_BF16(af[tt][ks], bfr[ks], acc[tt]);
    }
#pragma unroll
    for (int tt = 0; tt < 4; ++tt)
#pragma unroll
        for (int r = 0; r < 4; ++r) Ob[(16 * tt + 4 * g + r) * OS + 16 * w + c16] = acc[tt][r];
    __syncthreads();
    {
        const int t = tid >> 3, part = tid & 7; const size_t row = row0 + t;
        float ov[16]; float ss = 0.f;
#pragma unroll
        for (int q = 0; q < 4; ++q) { const f32x4 x = *(const f32x4*)(Ob + t * OS + 16 * part + 4 * q); ov[4 * q] = x[0]; ov[4 * q + 1] = x[1]; ov[4 * q + 2] = x[2]; ov[4 * q + 3] = x[3];
            ss += x[0] * x[0] + x[1] * x[1] + x[2] * x[2] + x[3] * x[3]; }
        ss += __shfl_xor(ss, 1); ss += __shfl_xor(ss, 2); ss += __shfl_xor(ss, 4);
        const float rstd = rsqrtf(ss * (1.0f / HD) + EPS);
        const unsigned zw[8] = {za.x, za.y, za.z, za.w, zc.x, zc.y, zc.z, zc.w};
        const float* gn = p.hgrn_norm_g + l * HD + 16 * part;
        unsigned ow[8];
#pragma unroll
        for (int q = 0; q < 8; ++q) { const float a0 = ov[2 * q] * rstd * gn[2 * q] * siluf_(lo16(zw[q])), a1 = ov[2 * q + 1] * rstd * gn[2 * q + 1] * siluf_(hi16(zw[q])); ow[q] = pack2(a0, a1); }
        bf16_t* dst = p.cat + row * D + h * HD + 16 * part;
        *(u32x4*)dst = (u32x4){ow[0], ow[1], ow[2], ow[3]}; *(u32x4*)(dst + 8) = (u32x4){ow[4], ow[5], ow[6], ow[7]};
    }
    __syncthreads();
}

DEV void hgrn_sample_unit(const Params& p, int l, int unit, unsigned char* lds) {
    const int tid = threadIdx.x, lane = tid & 63, w = tid >> 6;
    const int b = unit / HH, h = unit % HH;
    float* fS = (float*)lds; float* kS = fS + 512; float* qS = kS + 512; float* vS = qS + 512; float* red = vS + 512; float* part = red + 4 * 4 * 128;
    const int r0 = NP + b * DSEQ;
    {
        const int t = tid >> 7, kk = tid & 127; const bf16_t* zr = p.z + (size_t)(r0 + t) * ZW + h * HD + kk;
        float lbv = 0.f; if (l > 0) lbv = sigmoidf_(p.lb_logits[HH * HD + h * HD + kk] - p.lb_logits[h * HD + kk]);
        const float zq = bf2f(zr[0]), zf = fminf(fmaxf(bf2f(zr[1024]), -80.f), 80.f), zi = bf2f(zr[2048]);
        const float e = __expf(-zf), sg = 1.0f / (1.0f + e);
        fS[tid] = lbv + (1.0f - lbv) * sg; kS[tid] = (1.0f - lbv) * (e * sg); qS[tid] = siluf_(zq); vS[tid] = zi;
    }
    const int v = tid & 127, kq = tid >> 7;
    const float* s0 = p.state_hgrn + ((size_t)(l * DB + b) * HH + h) * HD * HD + (size_t)(32 * kq) * HD + v;
    float S[32];
#pragma unroll
    for (int i = 0; i < 32; ++i) S[i] = s0[(size_t)i * HD];
    __syncthreads();
#pragma unroll
    for (int t = 0; t < 4; ++t) {
        const float vv = vS[t * 128 + v]; float po = 0.f;
#pragma unroll
        for (int i = 0; i < 32; ++i) { const int kk = t * 128 + 32 * kq + i; S[i] = fS[kk] * S[i] + kS[kk] * vv; po += qS[kk] * S[i]; }
        red[(t * 4 + kq) * 128 + v] = po;
    }
    float* so = p.out + OFF_HS + ((size_t)(l * DB + b) * HH + h) * HD * HD + (size_t)(32 * kq) * HD + v;
#pragma unroll
    for (int i = 0; i < 32; ++i) so[(size_t)i * HD] = S[i];
    __syncthreads();
    {
        const int t = tid >> 7; const float o = red[(t * 4 + 0) * 128 + v] + red[(t * 4 + 1) * 128 + v] + red[(t * 4 + 2) * 128 + v] + red[(t * 4 + 3) * 128 + v];
        const float ss = wave_sum(o * o);
        if (lane == 0) part[w] = ss;
        __syncthreads();
        const float tot = part[2 * t] + part[2 * t + 1];
        const float rstd = rsqrtf(tot * (1.0f / HD) + EPS);
        const float zg = bf2f(p.z[(size_t)(r0 + t) * ZW + 3072 + h * HD + v]);
        p.cat[(size_t)(r0 + t) * D + h * HD + v] = (bf16_t)f2bf(o * rstd * p.hgrn_norm_g[l * HD + v] * siluf_(zg));
    }
    __syncthreads();
}

DEV void pool_pre_unit(const Params& p, int l, int unit) {
    const int tid = threadIdx.x, tk = tid >> 7, cg = tid & 127, c = cg * 8, gi = cg >> 5, wnd = 2 << gi;
    const int r = unit * 4 + tk;
    if (r >= NTOK) return;
    f32x2 sum[4] = {{0.f, 0.f}, {0.f, 0.f}, {0.f, 0.f}, {0.f, 0.f}}; float cur[8];
    float cnt;
    if (r < NP) {
        const int t = r % SEQ; const int n = (wnd < t + 1) ? wnd : (t + 1); cnt = (float)n;
        u32x4 q[16];
#pragma unroll
        for (int j = 0; j < 16; ++j) q[j] = (j < n) ? *(const u32x4*)(p.z + (size_t)(r - j) * ZW + 4096 + c) : (u32x4){0u, 0u, 0u, 0u};
#pragma unroll
        for (int j = 0; j < 16; ++j) { sum[0] += (f32x2){lo16(q[j].x), hi16(q[j].x)}; sum[1] += (f32x2){lo16(q[j].y), hi16(q[j].y)}; sum[2] += (f32x2){lo16(q[j].z), hi16(q[j].z)}; sum[3] += (f32x2){lo16(q[j].w), hi16(q[j].w)}; }
        cur[0] = lo16(q[0].x); cur[1] = hi16(q[0].x); cur[2] = lo16(q[0].y); cur[3] = hi16(q[0].y); cur[4] = lo16(q[0].z); cur[5] = hi16(q[0].z); cur[6] = lo16(q[0].w); cur[7] = hi16(q[0].w);
        if (t >= SEQ - PBUF) { float* o = p.out + OFF_PP + ((size_t)(l * PB + r / SEQ) * PBUF + (t - (SEQ - PBUF))) * PW + c;
            *(f32x4*)o = (f32x4){cur[0], cur[1], cur[2], cur[3]}; *(f32x4*)(o + 4) = (f32x4){cur[4], cur[5], cur[6], cur[7]}; }
    } else {
        const int bb = (r - NP) / DSEQ, t = (r - NP) % DSEQ; cnt = (float)wnd;
        const float* sp = p.state_pool + (size_t)(l * DB + bb) * PBUF * PW + c;
        u32x4 q[4]; f32x4 sa[15], sb[15];
#pragma unroll
        for (int j = 0; j < 4; ++j) q[j] = (j <= t && j < wnd) ? *(const u32x4*)(p.z + (size_t)(NP + bb * DSEQ + t - j) * ZW + 4096 + c) : (u32x4){0u, 0u, 0u, 0u};
#pragma unroll
        for (int j = 1; j < 16; ++j) {
            const int back = j - t;
            const bool use = (back >= 1) && (j < wnd);
            const float* srow = sp + (size_t)(PBUF - (use ? back : 1)) * PW;
            sa[j - 1] = use ? *(const f32x4*)srow : (f32x4){0.f, 0.f, 0.f, 0.f}; sb[j - 1] = use ? *(const f32x4*)(srow + 4) : (f32x4){0.f, 0.f, 0.f, 0.f};
        }
#pragma unroll
        for (int j = 0; j < 4; ++j) { sum[0] += (f32x2){lo16(q[j].x), hi16(q[j].x)}; sum[1] += (f32x2){lo16(q[j].y), hi16(q[j].y)}; sum[2] += (f32x2){lo16(q[j].z), hi16(q[j].z)}; sum[3] += (f32x2){lo16(q[j].w), hi16(q[j].w)}; }
#pragma unroll
        for (int j = 0; j < 15; ++j) { sum[0] += (f32x2){sa[j][0], sa[j][1]}; sum[1] += (f32x2){sa[j][2], sa[j][3]}; sum[2] += (f32x2){sb[j][0], sb[j][1]}; sum[3] += (f32x2){sb[j][2], sb[j][3]}; }
        cur[0] = lo16(q[0].x); cur[1] = hi16(q[0].x); cur[2] = lo16(q[0].y); cur[3] = hi16(q[0].y); cur[4] = lo16(q[0].z); cur[5] = hi16(q[0].z); cur[6] = lo16(q[0].w); cur[7] = hi16(q[0].w);
        float* ob = p.out + OFF_PS + (size_t)(l * DB + bb) * PBUF * PW + c;
        { float* o = ob + (size_t)(11 + t) * PW; *(f32x4*)o = (f32x4){cur[0], cur[1], cur[2], cur[3]}; *(f32x4*)(o + 4) = (f32x4){cur[4], cur[5], cur[6], cur[7]}; }
        for (int i = t; i < 11; i += 4) { const float* s2 = sp + (size_t)(4 + i) * PW; float* o = ob + (size_t)i * PW; *(f32x4*)o = *(const f32x4*)s2; *(f32x4*)(o + 4) = *(const f32x4*)(s2 + 4); }
    }
    const float inv = 1.0f / cnt;
    u32x4 w; w.x = pack2(sum[0][0] * inv - cur[0], sum[0][1] * inv - cur[1]); w.y = pack2(sum[1][0] * inv - cur[2], sum[1][1] * inv - cur[3]);
    w.z = pack2(sum[2][0] * inv - cur[4], sum[2][1] * inv - cur[5]); w.w = pack2(sum[3][0] * inv - cur[6], sum[3][1] * inv - cur[7]);
    *(u32x4*)(p.pooled + ((size_t)gi * MPAD + r) * 256 + (c & 255)) = w;
}

#ifndef PROBE_SUB
#define PROBE_SUB 0
#endif
DEV void phase_mix1(const Params& p, int l, unsigned char* lds) {
    for (int rep = 0; rep < (PROBE_SUB == 1 ? 2 : 1); ++rep) for (int u = blockIdx.x; u < hg::NUNIT; u += gridDim.x) hgrn_pre_unit(p, l, u, lds);
    for (int rep = 0; rep < (PROBE_SUB == 2 ? 2 : 1); ++rep) for (int u = blockIdx.x; u < DB * HH; u += gridDim.x) hgrn_sample_unit(p, l, u, lds);
    for (int rep = 0; rep < (PROBE_SUB == 3 ? 2 : 1); ++rep) for (int u = blockIdx.x; u < (NTOK + 3) / 4; u += gridDim.x) pool_pre_unit(p, l, u);
}
DEV void phase_mix2(const Params& p, int l) { for (int u = blockIdx.x; u < PB * HH * 8; u += gridDim.x) hgrn_scan_unit(p, l, u); }
DEV void phase_mix3(const Params& p, int l, unsigned char* lds) { for (int u = blockIdx.x; u < hg::NUNIT; u += gridDim.x) hgrn_post_unit(p, l, u, lds); }

#ifdef HIPEMU
#define MBCNT(mask) __builtin_popcountll((mask) & ((1ull << emu_lane()) - 1ull))
#define POPC64(m) __builtin_popcountll(m)
#else
#define MBCNT(mask) ((int)__builtin_amdgcn_mbcnt_hi((unsigned)((mask) >> 32), __builtin_amdgcn_mbcnt_lo((unsigned)(mask), 0u)))
#define POPC64(m) __popcll(m)
#endif
DEV unsigned fkey(float f) { const unsigned u = __float_as_uint(f); return u ^ ((unsigned)((int)u >> 31) | 0x80000000u); }
DEV unsigned long long lowest_n_bits(unsigned long long m, int n) { unsigned long long r = 0ull; while (n > 0 && m) { const unsigned long long b = m & (~m + 1ull); r |= b; m ^= b; --n; } return r; }
#ifdef HIPEMU
#define DPPU_XOR1(v) __shfl((v), emu_lane() ^ 1)
#define DPPU_XOR2(v) __shfl((v), emu_lane() ^ 2)
#define DPPU_HMIRROR(v) __shfl((v), (emu_lane() & ~7) | (7 - (emu_lane() & 7)))
#else
template <int CTRL> DEV unsigned dpp_u(unsigned v) { return (unsigned)__builtin_amdgcn_update_dpp(0, (int)v, CTRL, 0xf, 0xf, true); }
#define DPPU_XOR1(v) dpp_u<0xB1>(v)
#define DPPU_XOR2(v) dpp_u<0x4E>(v)
#define DPPU_HMIRROR(v) dpp_u<0x141>(v)
#endif
template <int GL> DEV unsigned group_sum(unsigned c) { c += DPPU_XOR1(c); c += DPPU_XOR2(c); if (GL == 8) c += DPPU_HMIRROR(c); return c; }
template <int GL> DEV unsigned group_or(unsigned c) { c |= DPPU_XOR1(c); c |= DPPU_XOR2(c); if (GL == 8) c |= DPPU_HMIRROR(c); return c; }
template <int GL> DEV float group_maxf(float v) { v = fmaxf(v, DPP_XOR1(v)); v = fmaxf(v, DPP_XOR2(v)); if (GL == 8) v = fmaxf(v, DPP_HMIRROR(v)); return v; }
template <int GL> DEV float group_sumf(float v) { v += DPP_XOR1(v); v += DPP_XOR2(v); if (GL == 8) v += DPP_HMIRROR(v); return v; }
DEV unsigned bytesum(unsigned w) { return (w * 0x01010101u) >> 24; }
template <int GL> DEV unsigned group_excl_prefix(unsigned c, int sub) {
    const unsigned sh = 8u * (unsigned)(sub & 3);
    unsigned wlo = (GL == 4 || sub < 4) ? (c << sh) : 0u, whi = (GL == 8 && sub >= 4) ? (c << sh) : 0u;
    wlo = group_or<GL>(wlo);
    unsigned r;
    if (GL == 4) r = bytesum(wlo & ((1u << sh) - 1u));
    else { whi = group_or<GL>(whi); r = sub < 4 ? bytesum(wlo & ((1u << sh) - 1u)) : bytesum(wlo) + bytesum(whi & ((1u << sh) - 1u)); }
    return r;
}
DEV float fkey_inv(unsigned k) { return __uint_as_float((k & 0x80000000u) ? (k ^ 0x80000000u) : ~k); }
template <int NK> DEV unsigned count_above(const unsigned (&k)[NK], unsigned t) {
    unsigned c[4] = {0u, 0u, 0u, 0u};
#pragma unroll
    for (int i = 0; i < NK; ++i) c[i & 3] += (k[i] > t) ? 1u : 0u;
    return (c[0] + c[1]) + (c[2] + c[3]);
}
template <int GL, int NK> DEV unsigned group_top16(const unsigned (&k)[NK], bool active, int sub, unsigned& pos0) {
    unsigned mxk = 0u;
#pragma unroll
    for (int i = 0; i < NK; ++i) mxk = k[i] > mxk ? k[i] : mxk;
    { unsigned o = DPPU_XOR1(mxk); mxk = o > mxk ? o : mxk; o = DPPU_XOR2(mxk); mxk = o > mxk ? o : mxk; if (GL == 8) { o = DPPU_HMIRROR(mxk); mxk = o > mxk ? o : mxk; } }
    unsigned L0 = mxk > 0x01000000u ? mxk - 0x01000000u : 0u, c0 = group_sum<GL>(count_above<NK>(k, L0));
    unsigned L = c0 > 16u ? L0 + 1u : 0u, R = active ? mxk : 0u, cR = 0u;
    if (!active) L = 0u;
    if (c0 == 16u && active) { L = L0; R = L0; cR = 16u; }
    for (;;) {
        if (__ballot(L < R) == 0ull) break;
        const unsigned mid = L + ((R - L) >> 1);
        const unsigned c = group_sum<GL>(count_above<NK>(k, mid));
        const bool le = c <= 16u, hit = c == 16u;
        R = le ? mid : R; cR = le ? c : cR; L = hit ? mid : (le ? L : mid + 1u);
    }
    unsigned mask = 0u;
#pragma unroll
    for (int i = 0; i < NK; ++i) mask |= (k[i] > R) ? (1u << i) : 0u;
    const unsigned need = 16u - cR;
    if (__ballot(active && need > 0u) != 0ull) {
        unsigned eqm = 0u;
#pragma unroll
        for (int i = 0; i < NK; ++i) eqm |= (k[i] == R) ? (1u << i) : 0u;
        const unsigned eqc = (unsigned)__builtin_popcount(eqm), before = group_excl_prefix<GL>(eqc, sub);
        unsigned take = need > before ? need - before : 0u; if (take > eqc) take = eqc;
        if (!active) take = 0u;
        while (take > 0u) { const unsigned b = eqm & (~eqm + 1u); mask |= b; eqm ^= b; --take; }
    }
    if (!active) mask = 0u;
    pos0 = group_excl_prefix<GL>((unsigned)__builtin_popcount(mask), sub);
    return mask;
}
#ifdef HIPEMU
template <int J> DEV unsigned row_bcast_u(unsigned v) { return __shfl(v, (emu_lane() & ~15) | J); }
#else
template <int J> DEV unsigned row_bcast_u(unsigned v) { return (unsigned)__builtin_amdgcn_update_dpp(0, (int)v, 0x150 + J, 0xf, 0xf, true); }
#endif
template <int J> struct RowRank { static DEV unsigned run(unsigned v, int l16) { const unsigned b = row_bcast_u<J>(v); return (((b > v) || (b == v && J < l16)) ? 1u : 0u) + RowRank<J - 1>::run(v, l16); } };
template <> struct RowRank<-1> { static DEV unsigned run(unsigned, int) { return 0u; } };
struct CandTab { unsigned char ij[56]; };
DEV CandTab make_cand_tab() { CandTab t{}; int n = 0; for (int i = 0; i < 16; ++i) for (int j = 0; j < 16 / (i + 1); ++j) t.ij[n++] = (unsigned char)(i * 16 + j); for (; n < 56; ++n) t.ij[n] = 255; return t; }
constexpr int SEL_NT = 4;
constexpr int SEL_RS = 144;
DEV void select_step(const Params& p, int l, int tt0, int tstride, int ntile, int h, unsigned char* lds, const bf16x8 (&kh)[2][4], const bf16x8 (&kl)[2][4]) {
    const int tid = threadIdx.x, lane = tid & 63, w = tid >> 6, g = lane >> 4, c16 = lane & 15;
    constexpr int NTK = SEL_NT * 16;
    constexpr int QRS = 264;
    bf16_t* qh = (bf16_t*)lds;
    bf16_t* ql = qh + NTK * QRS;
    float* sc = (float*)(ql + NTK * QRS);
    float* ts = sc + 2 * NTK * SEL_RS;
    int* ti = (int*)(ts + 2 * NTK * 16);
    unsigned char* ctab = (unsigned char*)(ti + 2 * NTK * 16);
    if (tid == 0) { const CandTab t = make_cand_tab(); for (int n = 0; n < 56; ++n) ctab[n] = t.ij[n]; }
#pragma unroll
    for (int k = 0; k < SEL_NT; ++k) {
        const int tk = tid >> 5, part = tid & 31; const int tok = (tt0 + k * tstride) * 16 + tk;
        f32x4 a = (f32x4){0.f, 0.f, 0.f, 0.f}, b2 = a;
        if (k < ntile && tok < NTOK) { const float* q = p.qry + (size_t)tok * D + h * 256 + part * 8; a = *(const f32x4*)q; b2 = *(const f32x4*)(q + 4); }
        float ss = a[0] * a[0] + a[1] * a[1] + a[2] * a[2] + a[3] * a[3] + b2[0] * b2[0] + b2[1] * b2[1] + b2[2] * b2[2] + b2[3] * b2[3];
        ss += __shfl_xor(ss, 1); ss += __shfl_xor(ss, 2); ss += __shfl_xor(ss, 4); ss += __shfl_xor(ss, 8);
        const float rn = rsqrtf(ss * (1.0f / 128.0f) + EPS);
        const float v[8] = {a[0] * rn, a[1] * rn, a[2] * rn, a[3] * rn, b2[0] * rn, b2[1] * rn, b2[2] * rn, b2[3] * rn};
        unsigned hi[4], lo[4];
#pragma unroll
        for (int j = 0; j < 4; ++j) { hi[j] = pack2(v[2 * j], v[2 * j + 1]); lo[j] = pack2(v[2 * j] - lo16(hi[j]), v[2 * j + 1] - hi16(hi[j])); }
        *(u32x4*)(qh + (k * 16 + tk) * QRS + part * 8) = (u32x4){hi[0], hi[1], hi[2], hi[3]}; *(u32x4*)(ql + (k * 16 + tk) * QRS + part * 8) = (u32x4){lo[0], lo[1], lo[2], lo[3]};
    }
    __syncthreads();
    for (int k = 0; k < ntile; ++k) {
#pragma unroll
        for (int ph = 0; ph < 2; ++ph) {
            f32x4 acc = (f32x4){0.f, 0.f, 0.f, 0.f};
#pragma unroll
            for (int ks = 0; ks < 4; ++ks) {
                const bf16x8 ah = *(const bf16x8*)(qh + (k * 16 + c16) * QRS + ph * 128 + 32 * ks + 8 * g), al = *(const bf16x8*)(ql + (k * 16 + c16) * QRS + ph * 128 + 32 * ks + 8 * g);
                acc = MFMA_BF16(al, kh[ph][ks], acc); acc = MFMA_BF16(ah, kl[ph][ks], acc); acc = MFMA_BF16(ah, kh[ph][ks], acc);
            }
            const int kidx = 16 * w + c16;
#pragma unroll
            for (int r = 0; r < 4; ++r) sc[(ph * NTK + k * 16 + 4 * g + r) * SEL_RS + (kidx >> 5) * 36 + (kidx & 31)] = acc[r];
        }
    }
    __syncthreads();
    {
        const int row = tid >> 2, sub = tid & 3; const bool active = ((row % NTK) >> 4) < ntile;
        unsigned k[32];
#pragma unroll
        for (int i4 = 0; i4 < 8; ++i4) { const f32x4 v = *(const f32x4*)(sc + row * SEL_RS + sub * 36 + 4 * i4); k[4 * i4] = fkey(v[0]); k[4 * i4 + 1] = fkey(v[1]); k[4 * i4 + 2] = fkey(v[2]); k[4 * i4 + 3] = fkey(v[3]); }
        unsigned pos; const unsigned mask = group_top16<4, 32>(k, active, sub, pos);
#pragma unroll
        for (int i = 0; i < 32; ++i) if ((mask >> i) & 1u) { if (pos < 16u) { ts[row * 16 + pos] = fkey_inv(k[i]); ti[row * 16 + pos] = 32 * sub + i; } ++pos; }
    }
    __syncthreads();
    {
        float v4[4]; int i4[4]; unsigned rk[4];
#pragma unroll
        for (int r = 0; r < (2 * NTK) / 32; ++r) { const int row = (tid >> 4) + 32 * r; v4[r] = ts[row * 16 + (tid & 15)]; i4[r] = ti[row * 16 + (tid & 15)]; }
#pragma unroll
        for (int r = 0; r < (2 * NTK) / 32; ++r) rk[r] = RowRank<15>::run(fkey(v4[r]), tid & 15);
        __syncthreads();
#pragma unroll
        for (int r = 0; r < (2 * NTK) / 32; ++r) { const int row = (tid >> 4) + 32 * r; ts[row * 16 + rk[r]] = v4[r]; ti[row * 16 + rk[r]] = i4[r]; }
    }
    __syncthreads();
    {
        const int tk = tid >> 3, sub = tid & 7; const bool active = (tk >> 4) < ntile;
        unsigned k[7]; unsigned cij[7];
#pragma unroll
        for (int q = 0; q < 7; ++q) { cij[q] = ctab[7 * sub + q]; const bool ok = cij[q] != 255u;
            k[q] = ok ? fkey(ts[tk * 16 + (cij[q] >> 4)] + ts[(NTK + tk) * 16 + (cij[q] & 15u)]) : 0u; }
        unsigned pos; const unsigned mask = group_top16<8, 7>(k, active, sub, pos);
        u32x2* lst = (u32x2*)sc;
#pragma unroll
        for (int q = 0; q < 7; ++q) if ((mask >> q) & 1u) { if (pos < 16u) lst[tk * 16 + pos] = (u32x2){__float_as_uint(fkey_inv(k[q])), (unsigned)(ti[tk * 16 + (cij[q] >> 4)] * 128 + ti[(NTK + tk) * 16 + (cij[q] & 15u)])}; ++pos; }
    }
    __syncthreads();
#pragma unroll
    for (int r = 0; r < NTK / 32; ++r) {
        const int tk = (tid >> 4) + 32 * r, slot = tid & 15; const int tok = (tt0 + (tk >> 4) * tstride) * 16 + (tk & 15);
        const u32x2 en = ((const u32x2*)sc)[tk * 16 + slot];
        const float v = __uint_as_float(en.x); const int e = (int)en.y;
        float mx = v; mx = fmaxf(mx, DPP_XOR1(mx)); mx = fmaxf(mx, DPP_XOR2(mx)); mx = fmaxf(mx, DPP_HMIRROR(mx)); mx = fmaxf(mx, DPP_RMIRROR(mx));
        const float ex = __expf(v - mx);
        float sm = ex; sm += DPP_XOR1(sm); sm += DPP_XOR2(sm); sm += DPP_HMIRROR(sm); sm += DPP_RMIRROR(sm);
        if ((tk >> 4) < ntile && tok < NTOK) { const size_t o = (size_t)tok * 128 + h * 16 + slot;
            p.eidx[o] = (unsigned short)e; p.gate[o] = ex / sm; }
    }
    __syncthreads();
}
DEV void phase_select(const Params& p, int l, unsigned char* lds) {
    const int ntt = (NTOK + 15) / 16, lane = threadIdx.x & 63, w = threadIdx.x >> 6, g = lane >> 4, c16 = lane & 15;
    const bool fixed = (gridDim.x % 8u) == 0u;
    const int nq = fixed ? (int)(gridDim.x >> 3) : 1;
    for (int hh = 0; hh < (fixed ? 1 : 8); ++hh) {
        const int h = fixed ? (int)(blockIdx.x & 7) : hh;
        bf16x8 kh[2][4], kl[2][4];
#pragma unroll
        for (int ph = 0; ph < 2; ++ph)
#pragma unroll
            for (int ks = 0; ks < 4; ++ks) { const float* kr = p.peer_keys + ((size_t)((l * 8 + h) * 2 + ph) * 128 + 16 * w + c16) * 128 + 32 * ks + 8 * g;
                const f32x4 a = *(const f32x4*)kr, b2 = *(const f32x4*)(kr + 4); const float v[8] = {a[0], a[1], a[2], a[3], b2[0], b2[1], b2[2], b2[3]};
                u32x4 hi, lo; unsigned hw[4], lw[4];
#pragma unroll
                for (int j = 0; j < 4; ++j) { hw[j] = pack2(v[2 * j], v[2 * j + 1]); lw[j] = pack2(v[2 * j] - lo16(hw[j]), v[2 * j + 1] - hi16(hw[j])); }
                hi = (u32x4){hw[0], hw[1], hw[2], hw[3]}; lo = (u32x4){lw[0], lw[1], lw[2], lw[3]};
                kh[ph][ks] = __builtin_bit_cast(bf16x8, hi); kl[ph][ks] = __builtin_bit_cast(bf16x8, lo); }
        const int first = fixed ? (int)(blockIdx.x >> 3) : (int)blockIdx.x, stride = fixed ? nq : (int)gridDim.x;
        for (int tt0 = first; tt0 < ntt; tt0 += SEL_NT * stride) {
            int ntile = 0;
#pragma unroll
            for (int k = 0; k < SEL_NT; ++k) if (tt0 + k * stride < ntt) ntile = k + 1;
            select_step(p, l, tt0, stride, ntile, h, lds, kh, kl);
        }
    }
}

constexpr int PEER_TB = 272;
struct PeerDeal { int xs_first, xs_step, t_begin, t_end; };
DEV PeerDeal peer_deal() {
    PeerDeal d; const bool sl = (gridDim.x % 8u) == 0u;
    const int nranks = sl ? (int)(gridDim.x >> 3) : (int)gridDim.x, rank = sl ? (int)(blockIdx.x >> 3) : (int)blockIdx.x, tpr = (NTOK + nranks - 1) / nranks;
    d.xs_first = sl ? (int)(blockIdx.x & 7) : 0; d.xs_step = sl ? 8 : 1; d.t_begin = rank * tpr; d.t_end = d.t_begin + tpr < NTOK ? d.t_begin + tpr : NTOK;
    return d;
}
struct PeerTok { u32x4 e0, e1, ha, hb; };
DEV void peer_fetch_u(const Params& p, int t, int c0, int g8, PeerTok& k) {
    const u32x4* ep = (const u32x4*)(p.eidx + (size_t)t * 128 + 16 * g8); k.e0 = ep[0]; k.e1 = ep[1];
    k.ha = *(const u32x4*)(p.hB + (size_t)t * D + c0); k.hb = *(const u32x4*)(p.hB + (size_t)t * D + c0 + 8);
}
DEV void phase_peer_u(const Params& p, int l, unsigned char* lds) {
    const int lane = threadIdx.x & 63, w = wave_id(), j8 = lane & 7, g8 = lane >> 3;
    const bool b2 = (j8 & 4) != 0, b1 = (j8 & 2) != 0, b0 = (j8 & 1) != 0;
    const PeerDeal dl = peer_deal();
    const unsigned char* U = p.u8 + (size_t)l * NE * D;
    float* lp = (float*)lds;
    for (int xs = dl.xs_first; xs < 8; xs += dl.xs_step)
    for (int t0 = dl.t_begin; t0 < dl.t_end; t0 += PEER_TB) {
        const int nb = dl.t_end - t0 < PEER_TB ? dl.t_end - t0 : PEER_TB;
        for (int ch = 0; ch < 2; ++ch) {
            const int c0 = 256 * xs + 128 * ch + 16 * j8;
            const unsigned char* Us = U + (size_t)(2 * xs + ch) * NE * 128; const unsigned joff = 16u * (unsigned)j8;
            PeerTok nx; if (w < nb) peer_fetch_u(p, t0 + w, c0, g8, nx);
            for (int tk = w; tk < nb; tk += 8) {
                const int t = t0 + tk;
                const PeerTok cu = nx;
                const unsigned ew[8] = {cu.e0.x, cu.e0.y, cu.e0.z, cu.e0.w, cu.e1.x, cu.e1.y, cu.e1.z, cu.e1.w}; unsigned ev[16];
#pragma unroll
                for (int i = 0; i < 8; ++i) { ev[2 * i] = ew[i] & 0xffffu; ev[2 * i + 1] = ew[i] >> 16; }
                u32x4 q[16];
#pragma unroll
                for (int i = 0; i < 16; ++i) q[i] = *(const u32x4*)(Us + (ev[i] * 128u + joff));
                if (tk + 8 < nb) peer_fetch_u(p, t + 8, c0, g8, nx);
                const u32x4 ha = cu.ha, hb = cu.hb;
                const f32x2 hf[8] = {{lo16(ha.x), hi16(ha.x)}, {lo16(ha.y), hi16(ha.y)}, {lo16(ha.z), hi16(ha.z)}, {lo16(ha.w), hi16(ha.w)}, {lo16(hb.x), hi16(hb.x)}, {lo16(hb.y), hi16(hb.y)}, {lo16(hb.z), hi16(hb.z)}, {lo16(hb.w), hi16(hb.w)}};
                float ps[16];
#pragma unroll
                for (int i = 0; i < 16; ++i) { f32x2 dq[8]; fp8x16_dec2(q[i], dq); f32x2 a = dq[0] * hf[0];
#pragma unroll
                    for (int k = 1; k < 8; ++k) a = __builtin_elementwise_fma(dq[k], hf[k], a);
                    ps[i] = a[0] + a[1]; }
                float q8[8], q4[4], q2[2];
#pragma unroll
                for (int k = 0; k < 8; ++k) { const float keep = b2 ? ps[8 + k] : ps[k], send = b2 ? ps[k] : ps[8 + k]; q8[k] = keep + DPP_HMIRROR(send); }
#pragma unroll
                for (int k = 0; k < 4; ++k) { const float keep = b1 ? q8[4 + k] : q8[k], send = b1 ? q8[k] : q8[4 + k]; q4[k] = keep + DPP_XOR2(send); }
#pragma unroll
                for (int k = 0; k < 2; ++k) { const float keep = b0 ? q4[2 + k] : q4[k], send = b0 ? q4[k] : q4[2 + k]; q2[k] = keep + DPP_XOR1(send); }
                float* lrow = lp + tk * 128 + 16 * g8 + 2 * j8;
                if (ch == 0) { lrow[0] = q2[0]; lrow[1] = q2[1]; }
                else { float* dst = p.part + ((size_t)t * 8 + xs) * 128 + 16 * g8 + 2 * j8; *(f32x2*)dst = (f32x2){q2[0] + lrow[0], q2[1] + lrow[1]}; }
            }
        }
    }
}
DEV void phase_peer_c(const Params& p, int l) {
    const size_t n = (size_t)NTOK * 128, gs = (size_t)gridDim.x * 512;
    for (size_t i = (size_t)blockIdx.x * 512 + threadIdx.x; i < n; i += gs) {
        const size_t t = i >> 7; const int pr = (int)(i & 127); float sacc = 0.f;
        const int e = p.eidx[i]; const float su = p.su[l * NE + e], sv = p.sv[l * NE + e], gt = p.gate[i];
#pragma unroll
        for (int x = 0; x < 8; ++x) sacc += p.part[(t * 8 + x) * 128 + pr];
        p.ab16[i] = (bf16_t)f2bf(gelu_erf(sacc * su) * gt * sv);
    }
}
struct PeerTokV { u32x4 e0, e1, a0, a1; f32x4 x1, g2; };
DEV void peer_fetch_v(const Params& p, int l, int t, int col, int g8, PeerTokV& k) {
    const u32x4* ep = (const u32x4*)(p.eidx + (size_t)t * 128 + 16 * g8); k.e0 = ep[0]; k.e1 = ep[1];
    const u32x4* ap = (const u32x4*)(p.ab16 + (size_t)t * 128 + 16 * g8); k.a0 = ap[0]; k.a1 = ap[1];
    k.x1 = *(const f32x4*)(p.xa + (size_t)t * D + col); k.g2 = *(const f32x4*)(p.modbuf + (size_t)tok_batch(t) * MODW + l * NMOD + 5 * D + col);
}
DEV void phase_peer_v(const Params& p, int l, unsigned char* lds) {
    const int lane = threadIdx.x & 63, w = wave_id(), j8 = lane & 7, g8 = lane >> 3;
    const bool b3 = (g8 & 1) != 0, b4 = (g8 & 2) != 0, b5 = (g8 & 4) != 0;
    const PeerDeal dl = peer_deal();
    const unsigned char* V = p.v8 + (size_t)l * NE * (D / 2);
    for (int xs = dl.xs_first; xs < 8; xs += dl.xs_step) {
        const int col = 256 * xs + 32 * j8 + (b3 ? 16 : 0) + (b4 ? 8 : 0) + (b5 ? 4 : 0);
        const unsigned char* Vs = V + (size_t)xs * NE * 128; const unsigned joff = 16u * (unsigned)j8;
        PeerTokV nx; if (dl.t_begin + w < dl.t_end) peer_fetch_v(p, l, dl.t_begin + w, col, g8, nx);
        for (int t = dl.t_begin + w; t < dl.t_end; t += 8) {
            const PeerTokV cu = nx;
            const unsigned ew[8] = {cu.e0.x, cu.e0.y, cu.e0.z, cu.e0.w, cu.e1.x, cu.e1.y, cu.e1.z, cu.e1.w}; unsigned ev[16];
#pragma unroll
            for (int i = 0; i < 8; ++i) { ev[2 * i] = ew[i] & 0xffffu; ev[2 * i + 1] = ew[i] >> 16; }
            u32x4 q[16];
#pragma unroll
            for (int i = 0; i < 16; ++i) q[i] = *(const u32x4*)(Vs + (ev[i] * 128u + joff));
            if (t + 8 < dl.t_end) peer_fetch_v(p, l, t + 8, col, g8, nx);
            const unsigned aw[8] = {cu.a0.x, cu.a0.y, cu.a0.z, cu.a0.w, cu.a1.x, cu.a1.y, cu.a1.z, cu.a1.w}; float av[16];
#pragma unroll
            for (int i = 0; i < 8; ++i) { av[2 * i] = lo16(aw[i]); av[2 * i + 1] = hi16(aw[i]); }
            f32x2 acc2[16];
#pragma unroll
            for (int k = 0; k < 16; ++k) acc2[k] = (f32x2){0.f, 0.f};
#pragma unroll
            for (int i = 0; i < 16; ++i) { f32x2 dq[16]; fp4x32_dec2(q[i], dq); const f32x2 a2v = (f32x2){av[i], av[i]};
#pragma unroll
                for (int k = 0; k < 16; ++k) acc2[k] = __builtin_elementwise_fma(a2v, dq[k], acc2[k]); }
            float acc[32];
#pragma unroll
            for (int k = 0; k < 16; ++k) { acc[2 * k] = acc2[k][0]; acc[2 * k + 1] = acc2[k][1]; }
            float q16[16], q8[8], q4[4];
#pragma unroll
            for (int k = 0; k < 16; ++k) { const float keep = b3 ? acc[16 + k] : acc[k], send = b3 ? acc[k] : acc[16 + k]; q16[k] = keep + DPP_XOR8(send); }
#pragma unroll
            for (int k = 0; k < 8; ++k) q8[k] = xsum16(q16[k], q16[8 + k]);
#pragma unroll
            for (int k = 0; k < 4; ++k) q4[k] = xsum32(q8[k], q8[4 + k]);
            f32x4 o;
#pragma unroll
            for (int k = 0; k < 4; ++k) o[k] = cu.x1[k] + cu.g2[k] * q4[k];
            *(f32x4*)(p.xb + (size_t)t * D + col) = o;
        }
    }
}

constexpr int N_PHASES = 27;
DEV int phase_class(int k) { return k < 2 ? k : (k == 26 ? 14 : 2 + (k - 2) % 12); }
#ifndef HIPEMU
#define XB_TMO      128
#define XB_XCNT(j)  (256  + 64 * (j))
#define XB_XSUB(j)  (1280 + 64 * (j))
#define XB_XGEN(j)  (2304 + 64 * (j))
#define XB_TOP      3328
#define XB_TOPGEN   3392
#define XCD_BAR_WORDS 3456
#define XB_SPIN_CAP (1u << 22)
__device__ __forceinline__ unsigned xb_ld(unsigned* p)              { return __hip_atomic_load(p, __ATOMIC_RELAXED, __HIP_MEMORY_SCOPE_AGENT); }
__device__ __forceinline__ unsigned xb_add(unsigned* p, unsigned v) { return __hip_atomic_fetch_add(p, v, __ATOMIC_RELAXED, __HIP_MEMORY_SCOPE_AGENT); }
__device__ __forceinline__ unsigned xb_xcc_id() { return (unsigned)__builtin_amdgcn_s_getreg((3 << 11) | 20) & 0xFu; }
#define XB_SPIN(cond, bar) do { unsigned _sp = 0; while (cond) { __builtin_amdgcn_s_sleep(1); \
    if ((++_sp & 255u) == 0u) { if (xb_ld(&(bar)[XB_TMO])) break; if (_sp > XB_SPIN_CAP) { atomicAdd(&(bar)[XB_TMO], 1u); break; } } } } while (0)
struct XcdBarrier { unsigned* bar; unsigned x; volatile LAS unsigned* st; };
__device__ __forceinline__ XcdBarrier xcd_barrier_post(unsigned* bar, volatile LAS unsigned* st) {
    XcdBarrier b; b.bar = bar; b.x = xb_xcc_id(); b.st = st;
    if (threadIdx.x == 0) (void)xb_add(&bar[XB_XCNT(b.x)], 1u);
    return b;
}
__device__ __forceinline__ void xcd_barrier_complete(unsigned* bar, unsigned x, unsigned& nloc, unsigned& nx) {
    const unsigned G = gridDim.x * gridDim.y * gridDim.z;
    unsigned sum, cnt, mine, sp = 0u;
    for (;;) {
        sum = 0u; cnt = 0u; mine = 0u;
#pragma unroll
        for (unsigned j = 0; j < 16; ++j) { const unsigned c = xb_ld(&bar[XB_XCNT(j)]); sum += c; cnt += (c > 0u) ? 1u : 0u; mine = (j == x) ? c : mine; }
        if (sum == G) break;
        __builtin_amdgcn_s_sleep(1);
        if ((++sp & 255u) == 0u) { if (xb_ld(&bar[XB_TMO])) break; if (sp > XB_SPIN_CAP) { atomicAdd(&bar[XB_TMO], 1u); break; } }
    }
    nloc = mine > 0u ? mine : 1u; nx = cnt > 0u ? cnt : 1u;
}
__device__ __forceinline__ void xcd_barrier(const XcdBarrier& b) {
    asm volatile("s_waitcnt vmcnt(0)" ::: "memory");
    __syncthreads();
    if (threadIdx.x == 0) {
        unsigned* bar = b.bar;
        __builtin_amdgcn_s_waitcnt(0);
        unsigned nloc = b.st[0], nx = b.st[1];
        if (nloc == 0u) { xcd_barrier_complete(bar, b.x, nloc, nx); b.st[0] = nloc; b.st[1] = nx; }
        const unsigned old = xb_add(&bar[XB_XSUB(b.x)], 1u);
        const unsigned gen = old / nloc;
        if (old + 1u == (gen + 1u) * nloc) {
            __builtin_amdgcn_fence(__ATOMIC_RELEASE, "agent");
            asm volatile("s_waitcnt vmcnt(0)" ::: "memory");
            const unsigned og = xb_add(&bar[XB_TOP], 1u);
            const unsigned tg = og / nx;
            if (og + 1u == (tg + 1u) * nx) xb_add(&bar[XB_TOPGEN], 1u);
            else XB_SPIN(xb_ld(&bar[XB_TOPGEN]) == tg, bar);
            __builtin_amdgcn_fence(__ATOMIC_ACQUIRE, "agent");
            xb_add(&bar[XB_XGEN(b.x)], 1u);
            asm volatile("s_waitcnt vmcnt(0)" ::: "memory");
        } else {
            XB_SPIN(xb_ld(&bar[XB_XGEN(b.x)]) == gen, bar);
            __builtin_amdgcn_fence(__ATOMIC_ACQUIRE, "agent");
            asm volatile("s_waitcnt vmcnt(0)" ::: "memory");
        }
    }
    __syncthreads();
}
#endif

constexpr int LDS_BYTES = 163840;
constexpr int LDS_BARW = LDS_BYTES - 16;

#ifndef PH_MASK
#define PH_MASK 0xFFFFFFFFu
#endif
#ifndef PROBE_DUP
#define PROBE_DUP 0u
#endif
#define DUP_N(k) (1 + (int)((PROBE_DUP >> phase_class(k)) & 1u))
#define PH_BIT(k) ((PH_MASK >> phase_class(k)) & 1u)
#ifdef HIPEMU
static void run_phase(const Params& pp, int ph, unsigned char* lds)
#define GRID_BAR() do {} while (0)
#define IN(k) (ph == (k))
#define GLDS lds
#define LOADP() const Params& p = pp
#else
typedef const __attribute__((address_space(4))) unsigned char* kargp_t;
__device__ __forceinline__ kargp_t karg_ptr() { kargp_t kp = (kargp_t)__builtin_amdgcn_kernarg_segment_ptr(); asm volatile("" : "+s"(kp)); return kp; }
#define LOADP() Params p; __builtin_memcpy(&p, karg_ptr(), sizeof(Params))
#define IN(k) (PH_BIT(k) && ph_lo <= (k) && (k) < ph_hi)
#define GLDS ((LAS unsigned char*)lds_raw)
__global__ void __launch_bounds__(512, 2) mega_fwd(Params p_unused)
#endif
{
#ifndef HIPEMU
    extern __shared__ __attribute__((aligned(16))) unsigned char lds_raw[];
    unsigned char* lds = lds_raw;
    if (threadIdx.x == 0) { *(volatile unsigned*)(lds_raw + LDS_BARW) = 0u; *(volatile unsigned*)(lds_raw + LDS_BARW + 4) = 0u; }
    __syncthreads();
    int ph_lo, ph_hi; XcdBarrier bar;
    { LOADP(); ph_lo = p.ph_lo; ph_hi = p.ph_hi; bar.bar = p.bar; bar.x = 0; bar.st = nullptr; }
    const bool multi = (ph_hi - ph_lo) > 1;
    if (multi) bar = xcd_barrier_post(bar.bar, (volatile LAS unsigned*)(lds_raw + LDS_BARW));
#define GRID_BAR() do { if (multi) xcd_barrier(bar); } while (0)
#endif
    if (IN(0)) { for (int rep = 0; rep < DUP_N(0); ++rep) { LOADP(); phase_convert(p, lds, 0); GRID_BAR(); } }
    if (IN(1)) {
        LOADP();
        pg8::Gemm g{p.csil, p.wt_ada, 256, MODW, D}; pg8::StaticOrder S; S.init(256, MODW, gridDim.x, blockIdx.x);
        pg8::EpiAda E{p.modbuf, p.b_ada, p.b_ada_final};
        pg8::gemm_phase<pg8::EpiAda, pg8::StaticOrder>(GLDS, g, S, E);
    }
    if (IN(1)) { LOADP(); phase_convert(p, lds, 1); GRID_BAR(); }
#define LAYER(l) do { \
        constexpr int base = 2 + 12 * (l); \
        if (IN(base + 0)) { for (int rep = 0; rep < DUP_N(base + 0); ++rep) { LOADP(); phase_norm(p, (l) == 0 ? p.x_prompt : p.xb, (l) == 0 ? p.x_sample : p.xb + (size_t)NP * D, p.norm1_g + (l) * D, (l) * NMOD + 0 * D, (l) * NMOD + 1 * D, p.hA, nullptr); GRID_BAR(); } } \
        if (IN(base + 1)) { for (int rep = 0; rep < DUP_N(base + 1); ++rep) { LOADP(); \
            pg8::Gemm g{p.hA, p.wt_in + (size_t)(l) * ZW * D, MPAD, ZW, D}; pg8::StaticOrder S; S.init(MPAD, ZW, gridDim.x, blockIdx.x); \
            pg8::EpiBf16 E{p.z, ZW}; \
            pg8::gemm_phase<pg8::EpiBf16, pg8::StaticOrder>(GLDS, g, S, E); } } \
        if (IN(base + 1)) { LOADP(); phase_tbl_slot(p, (l)); GRID_BAR(); } \
        if (IN(base + 2)) { for (int rep = 0; rep < DUP_N(base + 2); ++rep) { LOADP(); phase_mix1(p, (l), lds); GRID_BAR(); } } \
        if (IN(base + 3)) { for (int rep = 0; rep < DUP_N(base + 3); ++rep) { LOADP(); phase_mix2(p, (l)); GRID_BAR(); } } \
        if (IN(base + 4)) { LOADP(); phase_mix3(p, (l), lds); } \
        if (IN(base + 4)) { LOADP(); \
            pg8::Gemm g{p.pooled, p.wt_pool + (size_t)(l) * 1024 * 256, 4 * MPAD, 1024, 256}; pg8::PoolOrder S{(int)gridDim.x, (int)(gridDim.x - 1 - blockIdx.x)}; \
            pg8::EpiPool E{p.cat, p.pool_b + (l) * PW, p.pool_scale + (l) * PW}; \
            pg8::gemm_phase<pg8::EpiPool, pg8::PoolOrder>(GLDS, g, S, E); \
            GRID_BAR(); } \
        if (IN(base + 5)) { for (int rep = 0; rep < DUP_N(base + 5); ++rep) { LOADP(); \
            pg8::Gemm g{p.cat, p.wt_out + (size_t)(l) * D * D, MBIG, D, D}; pg8::StaticOrder S; S.init(MBIG, D, gridDim.x, blockIdx.x); \
            pg8::EpiResid E{(l) == 0 ? p.x_prompt : p.xb, (l) == 0 ? p.x_sample : p.xb + (size_t)NP * D, p.modbuf + (l) * NMOD + 2 * D, p.xa}; \
            pg8::gemm_phase<pg8::EpiResid, pg8::StaticOrder>(GLDS, g, S, E); \
            { SmallResid sf{E.xlo, E.xhi, E.gmod, E.out}; small_gemm(p.cat, p.wt_out + (size_t)(l) * D * D, D, lds, sf); } \
            GRID_BAR(); } } \
        if (IN(base + 6)) { for (int rep = 0; rep < DUP_N(base + 6); ++rep) { LOADP(); phase_norm(p, p.xa, p.xa + (size_t)NP * D, p.norm2_g + (l) * D, (l) * NMOD + 3 * D, (l) * NMOD + 4 * D, p.hB, nullptr); GRID_BAR(); } } \
        if (IN(base + 7)) { for (int rep = 0; rep < DUP_N(base + 7); ++rep) { LOADP(); \
            pg8::Gemm g{p.hB, p.wt_q + (size_t)(l) * D * D, MBIG, D, D}; pg8::StaticOrder S; S.init(MBIG, D, gridDim.x, blockIdx.x); \
            pg8::EpiF32 E{p.qry, D}; \
            pg8::gemm_phase<pg8::EpiF32, pg8::StaticOrder>(GLDS, g, S, E); \
            { SmallF32 sf{p.qry}; small_gemm(p.hB, p.wt_q + (size_t)(l) * D * D, D, lds, sf); } \
            GRID_BAR(); } } \
        if (IN(base + 8)) { for (int rep = 0; rep < DUP_N(base + 8); ++rep) { LOADP(); phase_select(p, (l), lds); GRID_BAR(); } } \
        if (IN(base + 9)) { for (int rep = 0; rep < DUP_N(base + 9); ++rep) { LOADP(); phase_peer_u(p, (l), lds); GRID_BAR(); } } \
        if (IN(base + 10)) { LOADP(); phase_peer_c(p, (l)); GRID_BAR(); } \
        if (IN(base + 11)) { for (int rep = 0; rep < DUP_N(base + 11); ++rep) { LOADP(); phase_peer_v(p, (l), lds); GRID_BAR(); } } \
    } while (0)
    LAYER(0);
    LAYER(1);
    if (IN(26)) { LOADP(); phase_norm(p, p.xb, p.xb + (size_t)NP * D, p.final_g, 2 * NMOD, 2 * NMOD + D, nullptr, p.out + OFF_Y); }
#undef LAYER
#undef IN
#undef GRID_BAR
#undef GLDS
#undef LOADP
}

struct WsLayout { size_t bar, modbuf, csil, wt_ada, wt_in, wt_out, wt_q, wt_pool, u8, v8, su, sv, iscu, part, hg_oin, hg_ds, hg_gam, hg_qh, hg_sc, hA, hB, z, pooled, cat, xa, xb, qry, eidx, gate, ab16, end; };
static WsLayout ws_layout() {
    WsLayout L; size_t o = 0;
    auto take = [&](size_t bytes) { const size_t r = o; o += (bytes + 255) & ~(size_t)255; return r; };
    L.bar = take(16384);
    L.modbuf = take((size_t)256 * MODW * 4);
    L.csil = take((size_t)256 * D * 2);
    L.wt_ada = take((size_t)MODW * D * 2);
    L.wt_in = take((size_t)2 * ZW * D * 2);
    L.wt_out = take((size_t)2 * D * D * 2);
    L.wt_q = take((size_t)2 * D * D * 2);
    L.wt_pool = take((size_t)2 * 1024 * 256 * 2);
    L.u8 = take((size_t)2 * NE * D);
    L.v8 = take((size_t)2 * NE * D);
    L.su = take((size_t)2 * NE * 4);
    L.sv = take((size_t)2 * NE * 4);
    L.iscu = take((size_t)MPAD * 128 * 4);
    L.part = take((size_t)MPAD * 8 * 128 * 4);
    L.hg_oin = take((size_t)hg::NUNIT * 64 * 128 * 2);
    L.hg_ds = take((size_t)hg::NUNIT * 128 * 128 * 2);
    L.hg_gam = take((size_t)hg::NUNIT * 128 * 4);
    L.hg_qh = take((size_t)NP * 1024 * 2);
    L.hg_sc = take((size_t)hg::NUNIT * 128 * 128 * 2);
    L.hA = take((size_t)MPAD * D * 2);
    L.hB = take((size_t)MPAD * D * 2);
    L.z = take((size_t)MPAD * ZW * 2);
    L.pooled = take((size_t)4 * MPAD * 256 * 2);
    L.cat = take((size_t)MPAD * D * 2);
    L.xa = take((size_t)MPAD * D * 4);
    L.xb = take((size_t)MPAD * D * 4);
    L.qry = take((size_t)MPAD * D * 4);
    L.eidx = take((size_t)MPAD * 128 * 2);
    L.gate = take((size_t)MPAD * 128 * 4);
    L.ab16 = take((size_t)MPAD * 128 * 2);
    L.end = o;
    return L;
}
static void fill_params(Params& p, void* const* d_in, void* d_out, void* d_ws) {
    const float** f = (const float**)&p;
    for (int i = 0; i < 24; ++i) f[i] = (const float*)d_in[i];
    p.out = (float*)d_out;
    const WsLayout L = ws_layout(); unsigned char* w = (unsigned char*)d_ws;
    p.bar = (unsigned*)(w + L.bar); p.modbuf = (float*)(w + L.modbuf); p.csil = (bf16_t*)(w + L.csil); p.wt_ada = (bf16_t*)(w + L.wt_ada); p.wt_in = (bf16_t*)(w + L.wt_in);
    p.wt_out = (bf16_t*)(w + L.wt_out); p.wt_q = (bf16_t*)(w + L.wt_q); p.wt_pool = (bf16_t*)(w + L.wt_pool); p.u8 = w + L.u8; p.v8 = w + L.v8; p.su = (float*)(w + L.su); p.sv = (float*)(w + L.sv); p.iscu = (float*)(w + L.iscu); p.part = (float*)(w + L.part); p.hg_oin = (bf16_t*)(w + L.hg_oin); p.hg_ds = (bf16_t*)(w + L.hg_ds); p.hg_gam = (float*)(w + L.hg_gam); p.hg_qh = (bf16_t*)(w + L.hg_qh); p.hg_sc = (bf16_t*)(w + L.hg_sc);
    p.hA = (bf16_t*)(w + L.hA); p.hB = (bf16_t*)(w + L.hB); p.z = (bf16_t*)(w + L.z); p.pooled = (bf16_t*)(w + L.pooled); p.cat = (bf16_t*)(w + L.cat);
    p.xa = (float*)(w + L.xa); p.xb = (float*)(w + L.xb); p.qry = (float*)(w + L.qry); p.eidx = (unsigned short*)(w + L.eidx); p.gate = (float*)(w + L.gate); p.ab16 = (bf16_t*)(w + L.ab16);
}

#ifndef HIPEMU
#ifndef MK_ONE_LAUNCH
#define MK_ONE_LAUNCH 1
#endif
extern "C" void kernel_launch(void* const* d_in, const int* in_sizes, int n_in, void* d_out, int out_size, void* d_ws, size_t ws_size, hipStream_t stream) {
    static int grid = 0;
    if (grid == 0) {
        const WsLayout L = ws_layout();
        if (n_in != 24 || (size_t)out_size != OUT_TOTAL || ws_size < L.end) { fprintf(stderr, "kernel_launch: unexpected shapes (n_in %d, out %d, ws %zu < %zu)\n", n_in, out_size, ws_size, L.end); grid = -1; return; }
        int dev = 0, cus = 0, per_cu = 0;
        hipGetDevice(&dev); hipDeviceGetAttribute(&cus, hipDeviceAttributeMultiprocessorCount, dev);
        if (hipFuncSetAttribute((const void*)mega_fwd, hipFuncAttributeMaxDynamicSharedMemorySize, LDS_BYTES) != hipSuccess) { fprintf(stderr, "kernel_launch: hipFuncSetAttribute failed\n"); grid = -1; return; }
        hipOccupancyMaxActiveBlocksPerMultiprocessor(&per_cu, (const void*)mega_fwd, 512, LDS_BYTES);
        (void)hipGetLastError();
        if (per_cu < 1) fprintf(stderr, "kernel_launch: occupancy query says %d blocks per CU\n", per_cu);
        grid = cus;
    }
    if (grid < 0) return;
    Params p{};
    fill_params(p, d_in, d_out, d_ws);
    hipMemsetAsync(p.bar, 0, 16384, stream);
#if MK_ONE_LAUNCH
    p.ph_lo = 0; p.ph_hi = N_PHASES;
    hipLaunchKernelGGL(mega_fwd, dim3(grid), dim3(512), LDS_BYTES, stream, p);
#else
    for (int ph = 0; ph < N_PHASES; ++ph) { p.ph_lo = ph; p.ph_hi = ph + 1; hipLaunchKernelGGL(mega_fwd, dim3(grid), dim3(512), LDS_BYTES, stream, p); }
#endif
}
#endif
```

```cpp
#ifndef HIPEMU
#include <hip/hip_runtime.h>
#include <cstdio>
#endif
#include <stdint.h>

#ifndef CFG_PB
#define CFG_PB 4
#define CFG_SEQ 2048
#define CFG_DB 128
#endif

#ifdef HIPEMU
#define DEV inline
#define LAS
#define READLANE_I(v, l) emu_readlane((v), (l))
#define READLANE_F(v, l) emu_readlane_f((v), (l))
#define MFMA_BF16(a, b, c) emu_mfma_bf16_16x16x32((a), (b), (c))
#define MFMA_F32(a, b, c) emu_mfma_f32_16x16x4((a), (b), (c))
#define __expf expf
#define __logf logf
#else
#define DEV __device__ __forceinline__
#define LAS __attribute__((address_space(3)))
#define READLANE_I(v, l) __builtin_amdgcn_readlane((v), (l))
#define READLANE_F(v, l) __uint_as_float((unsigned)__builtin_amdgcn_readlane((int)__float_as_uint(v), (l)))
#define MFMA_BF16(a, b, c) __builtin_amdgcn_mfma_f32_16x16x32_bf16((a), (b), (c), 0, 0, 0)
#define MFMA_F32(a, b, c) __builtin_amdgcn_mfma_f32_16x16x4f32((a), (b), (c), 0, 0, 0)
#endif

typedef unsigned short bf16_t;
typedef short bf16x8 __attribute__((ext_vector_type(8)));
typedef float f32x4 __attribute__((ext_vector_type(4)));
typedef unsigned u32x4 __attribute__((ext_vector_type(4)));
typedef unsigned u32x2 __attribute__((ext_vector_type(2)));

namespace cfg {
constexpr int D = 2048, PB = CFG_PB, SEQ = CFG_SEQ, DB = CFG_DB, DSEQ = 4;
constexpr int NP = PB * SEQ, NS = DB * DSEQ, NTOK = NP + NS, MPAD = (NTOK + 255) / 256 * 256;
constexpr int NC = PB + DB;
constexpr int HH = 8, HD = 128, PW = 1024, PBUF = 15, ZW = 5120;
constexpr int NE = 16384;
constexpr int NMOD = 6 * D;
constexpr int MODW = 2 * NMOD + 2 * D;
constexpr float EPS = 1e-6f;
constexpr int NCHAIN = PB * HH;
constexpr size_t OFF_Y = 0;
constexpr size_t OFF_HP = (size_t)NTOK * D;
constexpr size_t OFF_PP = OFF_HP + (size_t)2 * PB * HH * HD * HD;
constexpr size_t OFF_HS = OFF_PP + (size_t)2 * PB * PBUF * PW;
constexpr size_t OFF_PS = OFF_HS + (size_t)2 * DB * HH * HD * HD;
constexpr size_t OUT_TOTAL = OFF_PS + (size_t)2 * DB * PBUF * PW;
}
using namespace cfg;

struct Params {
    const float *x_prompt, *x_sample, *c_prompt, *c_sample, *state_hgrn, *state_pool, *w_ada, *b_ada, *norm1_g, *norm2_g, *w_in, *w_out,
        *lb_logits, *hgrn_norm_g, *pool_w, *pool_b, *pool_scale, *peer_wq, *peer_keys, *peer_u, *peer_v, *final_g, *w_ada_final, *b_ada_final;
    float* out;
    unsigned* bar; float* modbuf; bf16_t* csil; bf16_t* wt_ada; bf16_t* wt_in; bf16_t* wt_out; bf16_t* wt_q; bf16_t* wt_pool;
    unsigned char* u8; unsigned char* v8; float* su; float* sv; float* iscu; float* part; bf16_t* hg_oin; bf16_t* hg_ds; float* hg_gam; bf16_t* hg_qh; bf16_t* hg_sc; bf16_t* hA; bf16_t* hB; bf16_t* z; bf16_t* pooled; bf16_t* cat; bf16_t* xa; bf16_t* xb; float* qry; unsigned short* eidx; float* gate; bf16_t* ab16;
    int ph_lo, ph_hi;
};

DEV float bf2f(unsigned v) { return __uint_as_float(v << 16); }
#ifdef HIPEMU
DEV unsigned f2bf(float f) { unsigned u = __float_as_uint(f); u += 0x7fffu + ((u >> 16) & 1u); return u >> 16; }
DEV unsigned pack2(float lo, float hi) { return f2bf(lo) | (f2bf(hi) << 16); }
#else
typedef float f32x2_t __attribute__((ext_vector_type(2)));
typedef __bf16 bf16x2_t __attribute__((ext_vector_type(2)));
DEV unsigned pack2(float lo, float hi) { const f32x2_t v = {lo, hi}; return __builtin_bit_cast(unsigned, __builtin_convertvector(v, bf16x2_t)); }
DEV unsigned f2bf(float f) { return (unsigned)__builtin_bit_cast(unsigned short, (__bf16)f); }
#endif
DEV float lo16(unsigned w) { return __uint_as_float(w << 16); }
DEV float hi16(unsigned w) { return __uint_as_float(w & 0xffff0000u); }
DEV float wave_sum(float v) { v += __shfl_xor(v, 32); v += __shfl_xor(v, 16); v += __shfl_xor(v, 8); v += __shfl_xor(v, 4); v += __shfl_xor(v, 2); v += __shfl_xor(v, 1); return v; }
DEV float wave_max(float v) { v = fmaxf(v, __shfl_xor(v, 32)); v = fmaxf(v, __shfl_xor(v, 16)); v = fmaxf(v, __shfl_xor(v, 8)); v = fmaxf(v, __shfl_xor(v, 4)); v = fmaxf(v, __shfl_xor(v, 2)); v = fmaxf(v, __shfl_xor(v, 1)); return v; }
DEV float sigmoidf_(float x) { return 1.0f / (1.0f + __expf(-x)); }
DEV float siluf_(float x) { return x / (1.0f + __expf(-x)); }
DEV float gelu_erf(float x) { return 0.5f * x * (1.0f + erff(x * 0.70710678118f)); }
#ifdef HIPEMU
DEV int wave_id() { return (int)(threadIdx.x >> 6); }
#else
DEV int wave_id() { return __builtin_amdgcn_readfirstlane((int)(threadIdx.x >> 6)); }
#endif
DEV int tok_batch(int t) { return t < NP ? t / SEQ : PB + (t - NP) / DSEQ; }


#ifdef HIPEMU
static inline unsigned emu_fp8_enc1(float x) {
    const unsigned sgn = x < 0.f ? 0x80u : 0u; float a = fabsf(x);
    if (!(a == a)) return 0x7fu;
    if (a >= 448.f) return sgn | 0x7eu;
    if (a < 0.015625f) { const int q = (int)rintf(a * 512.f); return sgn | (unsigned)q; }
    int e = (int)floorf(log2f(a)); if (ldexpf(1.f, e) > a) --e; if (ldexpf(1.f, e + 1) <= a) ++e;
    int m = (int)rintf((a / ldexpf(1.f, e) - 1.f) * 8.f); if (m == 8) { m = 0; ++e; }
    if (e > 8) return sgn | 0x7eu;
    return sgn | (unsigned)((e + 7) << 3) | (unsigned)m;
}
static inline float emu_fp8_dec1(unsigned b) { const float sg = (b & 0x80u) ? -1.f : 1.f; const int e = (b >> 3) & 15, m = b & 7; return sg * (e == 0 ? m * 0.001953125f : (1.f + m * 0.125f) * ldexpf(1.f, e - 7)); }
DEV unsigned fp8x4_enc(float a, float b, float c, float d) { return emu_fp8_enc1(a) | (emu_fp8_enc1(b) << 8) | (emu_fp8_enc1(c) << 16) | (emu_fp8_enc1(d) << 24); }
DEV void fp8x4_dec(unsigned w, float* o) { o[0] = emu_fp8_dec1(w & 255u); o[1] = emu_fp8_dec1((w >> 8) & 255u); o[2] = emu_fp8_dec1((w >> 16) & 255u); o[3] = emu_fp8_dec1(w >> 24); }
#define DPP_XOR1(v) __shfl((v), emu_lane() ^ 1)
#define DPP_XOR2(v) __shfl((v), emu_lane() ^ 2)
#define DPP_HMIRROR(v) __shfl((v), (emu_lane() & ~7) | (7 - (emu_lane() & 7)))
#define DPP_XOR8(v) __shfl((v), emu_lane() ^ 8)
#define DPP_RMIRROR(v) __shfl((v), (emu_lane() & ~15) | (15 - (emu_lane() & 15)))
#define WAVE_LDS_SYNC() emu_wbar()
DEV float xsum16(float a, float b) { const bool hi = (emu_lane() & 16) != 0; return (hi ? b : a) + __shfl_xor(hi ? a : b, 16); }
DEV float xsum32(float a, float b) { const bool hi = (emu_lane() & 32) != 0; return (hi ? b : a) + __shfl_xor(hi ? a : b, 32); }
#else
typedef float f32x2v_t __attribute__((ext_vector_type(2)));
DEV unsigned fp8x4_enc(float a, float b, float c, float d) { int r = __builtin_amdgcn_cvt_pk_fp8_f32(a, b, 0, false); r = __builtin_amdgcn_cvt_pk_fp8_f32(c, d, r, true); return (unsigned)r; }
DEV void fp8x4_dec(unsigned w, float* o) { const f32x2v_t lo = __builtin_amdgcn_cvt_pk_f32_fp8((int)w, false), hi = __builtin_amdgcn_cvt_pk_f32_fp8((int)w, true); o[0] = lo[0]; o[1] = lo[1]; o[2] = hi[0]; o[3] = hi[1]; }
template <int CTRL> DEV float dpp_f(float v) { return __uint_as_float((unsigned)__builtin_amdgcn_update_dpp(0, (int)__float_as_uint(v), CTRL, 0xf, 0xf, true)); }
#define DPP_XOR1(v) dpp_f<0xB1>(v)
#define DPP_XOR2(v) dpp_f<0x4E>(v)
#define DPP_HMIRROR(v) dpp_f<0x141>(v)
#define DPP_XOR8(v) dpp_f<0x128>(v)
#define DPP_RMIRROR(v) dpp_f<0x140>(v)
#define WAVE_LDS_SYNC() asm volatile("s_waitcnt lgkmcnt(0)" ::: "memory")
DEV float xsum16(float a, float b) { const u32x2 r = __builtin_amdgcn_permlane16_swap(__float_as_uint(a), __float_as_uint(b), false, false); return __uint_as_float(r[0]) + __uint_as_float(r[1]); }
DEV float xsum32(float a, float b) { const u32x2 r = __builtin_amdgcn_permlane32_swap(__float_as_uint(a), __float_as_uint(b), false, false); return __uint_as_float(r[0]) + __uint_as_float(r[1]); }
#endif
typedef float f32x2 __attribute__((ext_vector_type(2)));
#ifdef HIPEMU
DEV void fp8x4_dec2(unsigned w, f32x2& lo, f32x2& hi) { float o[4]; fp8x4_dec(w, o); lo = (f32x2){o[0], o[1]}; hi = (f32x2){o[2], o[3]}; }
#else
DEV void fp8x4_dec2(unsigned w, f32x2& lo, f32x2& hi) { lo = __builtin_amdgcn_cvt_pk_f32_fp8((int)w, false); hi = __builtin_amdgcn_cvt_pk_f32_fp8((int)w, true); }
#endif
DEV void fp8x16_dec2(u32x4 q, f32x2* o) { fp8x4_dec2(q.x, o[0], o[1]); fp8x4_dec2(q.y, o[2], o[3]); fp8x4_dec2(q.z, o[4], o[5]); fp8x4_dec2(q.w, o[6], o[7]); }
#ifdef HIPEMU
static inline unsigned emu_fp4_enc1(float x) {
    const unsigned sgn = x < 0.f ? 8u : 0u; const float a = fabsf(x);
    const unsigned c = a < 0.25f ? 0u : (a < 0.75f ? 1u : (a < 1.25f ? 2u : (a < 1.75f ? 3u : (a < 2.5f ? 4u : (a < 3.5f ? 5u : (a < 5.0f ? 6u : 7u))))));
    return sgn | c;
}
static inline float emu_fp4_dec1(unsigned n) { const float t[8] = {0.f, 0.5f, 1.f, 1.5f, 2.f, 3.f, 4.f, 6.f}; return ((n & 8u) ? -1.f : 1.f) * t[n & 7u]; }
DEV unsigned fp4x4_enc(float a, float b, float c, float d) { return emu_fp4_enc1(a) | (emu_fp4_enc1(b) << 4) | (emu_fp4_enc1(c) << 8) | (emu_fp4_enc1(d) << 12); }
DEV void fp4x8_dec2(unsigned w, f32x2* o) {
    for (int k = 0; k < 4; ++k) o[k] = (f32x2){emu_fp4_dec1((w >> (8 * k)) & 15u), emu_fp4_dec1((w >> (8 * k + 4)) & 15u)};
}
#else
DEV unsigned fp4x4_enc(float a, float b, float c, float d) { unsigned r = 0u; r = __builtin_amdgcn_cvt_scalef32_pk_fp4_f32(r, a, b, 1.0f, 0); r = __builtin_amdgcn_cvt_scalef32_pk_fp4_f32(r, c, d, 1.0f, 1); return r & 0xffffu; }
DEV void fp4x8_dec2(unsigned w, f32x2* o) {
    o[0] = __builtin_amdgcn_cvt_scalef32_pk_f32_fp4(w, 1.0f, 0); o[1] = __builtin_amdgcn_cvt_scalef32_pk_f32_fp4(w, 1.0f, 1);
    o[2] = __builtin_amdgcn_cvt_scalef32_pk_f32_fp4(w, 1.0f, 2); o[3] = __builtin_amdgcn_cvt_scalef32_pk_f32_fp4(w, 1.0f, 3);
}
#endif
DEV void fp4x32_dec2(u32x4 q, f32x2* o) { fp4x8_dec2(q.x, o); fp4x8_dec2(q.y, o + 4); fp4x8_dec2(q.z, o + 8); fp4x8_dec2(q.w, o + 12); }
#ifdef HIPEMU
DEV void fp4x8_decb(unsigned w, unsigned* o) { for (int k = 0; k < 4; ++k) o[k] = f2bf(emu_fp4_dec1((w >> (8 * k)) & 15u)) | (f2bf(emu_fp4_dec1((w >> (8 * k + 4)) & 15u)) << 16); }
DEV float dot2bf(unsigned a, unsigned b, float c) { return c + lo16(a) * lo16(b) + hi16(a) * hi16(b); }
#else
typedef __bf16 bf16x2v_t __attribute__((ext_vector_type(2)));
DEV void fp4x8_decb(unsigned w, unsigned* o) {
    o[0] = __builtin_bit_cast(unsigned, __builtin_amdgcn_cvt_scalef32_pk_bf16_fp4(w, 1.0f, 0)); o[1] = __builtin_bit_cast(unsigned, __builtin_amdgcn_cvt_scalef32_pk_bf16_fp4(w, 1.0f, 1));
    o[2] = __builtin_bit_cast(unsigned, __builtin_amdgcn_cvt_scalef32_pk_bf16_fp4(w, 1.0f, 2)); o[3] = __builtin_bit_cast(unsigned, __builtin_amdgcn_cvt_scalef32_pk_bf16_fp4(w, 1.0f, 3));
}
DEV float dot2bf(unsigned a, unsigned b, float c) { return __builtin_amdgcn_fdot2_f32_bf16(__builtin_bit_cast(bf16x2v_t, a), __builtin_bit_cast(bf16x2v_t, b), c, false); }
#endif

namespace pg8 {
constexpr int BM = 256, BK = 64, HALF = 128, HTB = HALF * BK * 2, STAGE_BYTES = 8 * HTB, NXCD = 8, WGM = 8;
DEV int lds_byte(int r, int c) { const int st = (r >> 4) * 2 + (c >> 5), rr = r & 15, cc = c & 31, ob = rr * 64 + cc * 2; return st * 1024 + (ob ^ (((ob >> 9) & 1) << 5)); }
DEV void stage_rc(int b, int& R, int& C) { const int st = b / 1024, sb = b % 1024, swz = sb ^ (((sb >> 9) & 1) << 5); R = (st >> 1) * 16 + swz / 64; C = (st & 1) * 32 + (swz % 64) / 2; }
DEV int perm32(int rho) { const int n = rho >> 4, i = rho & 15; return 8 * (i >> 2) + 4 * n + (i & 3); }
struct Unit { int pm, pn; };
struct Gemm { const bf16_t* A; const bf16_t* Bt; int M, N, K; };
struct StaticOrder {
    int nM, nN, nwg, G, c;
    DEV void init(int M, int N, int G_, int c_) { nM = M / BM; nN = N / BM; nwg = nM * nN; G = G_; c = c_; }
    DEV bool next(int i, Unit& u) const {
        const long L = (long)i * G + c; if (L >= nwg) return false;
        int wgid = (int)L; { const int q = nwg / NXCD, r = nwg % NXCD, xcd = wgid % NXCD, off = wgid / NXCD; wgid = (xcd < r ? xcd * (q + 1) : r * (q + 1) + (xcd - r) * q) + off; }
        const int nig = WGM * nN, gid = wgid / nig, fm = gid * WGM, gsz = (nM - fm) < WGM ? (nM - fm) : WGM;
        u.pm = fm + ((wgid % nig) % gsz); u.pn = (wgid % nig) / gsz; return true;
    }
    DEV void a_ready(const Unit&) const {}
    DEV void done(const Unit&) const {}
};
struct PoolOrder {
    int G, c;
    DEV bool next(int i, Unit& u) const { const int L = i * G + c; if (L >= 4 * (MPAD / 256)) return false; u.pm = L; u.pn = L / (MPAD / 256); return true; }
    DEV void a_ready(const Unit&) const {}
    DEV void done(const Unit&) const {}
};

struct EpiF32 {
    static constexpr bool PERM = false;
    float* C; int ldc;
    DEV void operator()(const f32x4 (&acc)[2][2][4][2], const Unit& u, int wr, int wc, int fr, int fq) const {
        const int row0 = u.pm * BM + wr * 64 + fr, col0 = u.pn * BM + wc * 32 + 4 * fq;
#pragma unroll
        for (int ai = 0; ai < 2; ++ai)
#pragma unroll
            for (int m = 0; m < 4; ++m) { float* rowp = C + (size_t)(row0 + ai * HALF + m * 16) * ldc + col0;
#pragma unroll
                for (int bj = 0; bj < 2; ++bj)
#pragma unroll
                    for (int n = 0; n < 2; ++n) *(f32x4*)(rowp + bj * HALF + n * 16) = acc[ai][bj][m][n]; }
    }
};
struct EpiAda {
    static constexpr bool PERM = false;
    float* C; const float* b_ada; const float* b_fin;
    DEV void operator()(const f32x4 (&acc)[2][2][4][2], const Unit& u, int wr, int wc, int fr, int fq) const {
        const int row0 = u.pm * BM + wr * 64 + fr, col0 = u.pn * BM + wc * 32 + 4 * fq;
        const float* bias = (u.pn * BM < 2 * NMOD) ? b_ada + col0 : b_fin + (col0 - 2 * NMOD);
        f32x4 bv[2][2];
#pragma unroll
        for (int bj = 0; bj < 2; ++bj)
#pragma unroll
            for (int n = 0; n < 2; ++n) bv[bj][n] = *(const f32x4*)(bias + bj * HALF + n * 16);
#pragma unroll
        for (int ai = 0; ai < 2; ++ai)
#pragma unroll
            for (int m = 0; m < 4; ++m) { float* rowp = C + (size_t)(row0 + ai * HALF + m * 16) * MODW + col0;
#pragma unroll
                for (int bj = 0; bj < 2; ++bj)
#pragma unroll
                    for (int n = 0; n < 2; ++n) *(f32x4*)(rowp + bj * HALF + n * 16) = acc[ai][bj][m][n] + bv[bj][n]; }
    }
};
struct EpiResid {
    static constexpr bool PERM = false;
    const float* xlo; const float* xhi; const bf16_t* x16; const float* gmod  ; bf16_t* out;
    DEV void operator()(const f32x4 (&acc)[2][2][4][2], const Unit& u, int wr, int wc, int fr, int fq) const {
        const int row0 = u.pm * BM + wr * 64 + fr, col0 = u.pn * BM + wc * 32 + 4 * fq;
#pragma unroll
        for (int ai = 0; ai < 2; ++ai)
#pragma unroll
            for (int m = 0; m < 4; ++m) {
                const int row = row0 + ai * HALF + m * 16;
                if (row < NTOK) {
                    const float* gr = gmod + (size_t)tok_batch(row) * MODW + col0;
                    bf16_t* rowp = out + (size_t)row * D + col0;
#pragma unroll
                    for (int bj = 0; bj < 2; ++bj)
#pragma unroll
                        for (int n = 0; n < 2; ++n) { f32x4 xv;
                            if (x16) { const u32x2 xw = *(const u32x2*)(x16 + (size_t)row * D + col0 + bj * HALF + n * 16); xv = (f32x4){lo16(xw.x), hi16(xw.x), lo16(xw.y), hi16(xw.y)}; }
                            else xv = *(const f32x4*)((row < NP ? xlo + (size_t)row * D : xhi + (size_t)(row - NP) * D) + col0 + bj * HALF + n * 16);
                            const f32x4 gv = *(const f32x4*)(gr + bj * HALF + n * 16), o = xv + gv * acc[ai][bj][m][n];
                            u32x2 ow; ow.x = pack2(o[0], o[1]); ow.y = pack2(o[2], o[3]); *(u32x2*)(rowp + bj * HALF + n * 16) = ow; }
                }
            }
    }
};
struct EpiBf16 {
    static constexpr bool PERM = true;
    bf16_t* O; int ldc;
    DEV void operator()(const f32x4 (&acc)[2][2][4][2], const Unit& u, int wr, int wc, int fr, int fq) const {
        const int row0 = u.pm * BM + wr * 64 + fr, col0 = u.pn * BM + wc * 32 + 8 * fq;
#pragma unroll
        for (int ai = 0; ai < 2; ++ai)
#pragma unroll
            for (int m = 0; m < 4; ++m) { bf16_t* rowp = O + (size_t)(row0 + ai * HALF + m * 16) * ldc + col0;
#pragma unroll
                for (int bj = 0; bj < 2; ++bj) { const f32x4 v0 = acc[ai][bj][m][0], v1 = acc[ai][bj][m][1];
                    u32x4 w; w.x = pack2(v0[0], v0[1]); w.y = pack2(v0[2], v0[3]); w.z = pack2(v1[0], v1[1]); w.w = pack2(v1[2], v1[3]);
                    *(u32x4*)(rowp + bj * HALF) = w; } }
    }
};
struct EpiPool {
    static constexpr bool PERM = true;
    bf16_t* cat; const float* pb; const float* ps;
    DEV void operator()(const f32x4 (&acc)[2][2][4][2], const Unit& u, int wr, int wc, int fr, int fq) const {
        const int g = u.pn, tok0 = u.pm * BM - g * MPAD + wr * 64 + fr, col0 = g * 256 + wc * 32 + 8 * fq;
#pragma unroll
        for (int bj = 0; bj < 2; ++bj) {
            const f32x4 b0 = *(const f32x4*)(pb + col0 + bj * HALF), b1 = *(const f32x4*)(pb + col0 + bj * HALF + 4);
            const f32x4 s0 = *(const f32x4*)(ps + col0 + bj * HALF), s1 = *(const f32x4*)(ps + col0 + bj * HALF + 4);
#pragma unroll
            for (int ai = 0; ai < 2; ++ai)
#pragma unroll
                for (int m = 0; m < 4; ++m) { const int tok = tok0 + ai * HALF + m * 16;
                    if (tok < NTOK) { const f32x4 v0 = (acc[ai][bj][m][0] + b0) * s0, v1 = (acc[ai][bj][m][1] + b1) * s1;
                        u32x4 w; w.x = pack2(v0[0], v0[1]); w.y = pack2(v0[2], v0[3]); w.z = pack2(v1[0], v1[1]); w.w = pack2(v1[2], v1[3]);
                        *(u32x4*)(cat + (size_t)tok * D + 1024 + col0 + bj * HALF) = w; } }
        }
    }
};

#ifdef HIPEMU
template <class Epi, class Sched>
static void gemm_phase(unsigned char*, const Gemm g, const Sched& S, const Epi& E) {
    const int tid = threadIdx.x, wid = tid >> 6, lane = tid & 63, wr = wid >> 2, wc = wid & 3, fr = lane & 15, fq = lane >> 4;
    Unit cur;
    for (int ui = 0; S.next(ui, cur); ++ui) {
        f32x4 acc[2][2][4][2];
        for (int ai = 0; ai < 2; ++ai) for (int bj = 0; bj < 2; ++bj) for (int m = 0; m < 4; ++m) for (int n = 0; n < 2; ++n) for (int j = 0; j < 4; ++j) {
            const int row = 256 * cur.pm + 128 * ai + 64 * wr + 16 * m + fr;
            const int col = Epi::PERM ? 256 * cur.pn + 128 * bj + 32 * wc + 8 * fq + 4 * n + j : 256 * cur.pn + 128 * bj + 32 * wc + 16 * n + 4 * fq + j;
            float s = 0.f;
            if ((row % emu_row_mod) < emu_row_limit) { const float* a = emu_f32_copy(g.A, (size_t)g.M * g.K) + (size_t)row * g.K; const float* b = emu_f32_copy(g.Bt, (size_t)g.N * g.K) + (size_t)col * g.K;
                for (int k = 0; k < g.K; ++k) s += a[k] * b[k]; }
            acc[ai][bj][m][n][j] = s; }
        E(acc, cur, wr, wc, fr, fq);
    }
    __syncthreads();
}
#else
template <class Epi, class Sched>
__device__ __forceinline__ void gemm_phase(LAS unsigned char* lds, const Gemm g, const Sched& S, const Epi& E) {
    const int tid = threadIdx.x, wid = __builtin_amdgcn_readfirstlane(tid >> 6), lane = tid & 63, wr = wid >> 2, wc = wid & 3, fr = lane & 15, fq = lane >> 4;
    int K = g.K; asm volatile("" : "+s"(K));
    const int nt = K / BK;
    unsigned voffA[2], voffB[2];
#pragma unroll
    for (int i = 0; i < 2; ++i) { int R, C; stage_rc(tid * 16 + i * 8192, R, C); const int Rb = Epi::PERM ? ((R & ~31) + perm32(R & 31)) : R;
        voffA[i] = (unsigned)(R * K + C) * 2u; voffB[i] = (unsigned)(Rb * K + C) * 2u; }
    const size_t kstep = (size_t)(BK * 2);
    const size_t hstep = (size_t)HALF * K * 2;
    const size_t tstep = 2 * hstep;
    const unsigned ldsw = (unsigned)wid * 1024u;
    const int aoff = lds_byte(wr * 64 + fr, fq * 8), boff = lds_byte(wc * 32 + fr, fq * 8);
#define PG8_SA(b, h) (((b) * 2 + (h)) * HTB)
#define PG8_SB(b, h) ((4 + (b) * 2 + (h)) * HTB)
#define PG8_STAGE(bufoff, gbase, voff) do { _Pragma("unroll") for (int _i = 0; _i < 2; ++_i) \
        __builtin_amdgcn_global_load_lds((const unsigned*)((const char*)(gbase) + (voff)[_i]), (LAS unsigned*)(lds + (bufoff) + ldsw + _i * 8192), 16, 0, 0); } while (0)
#define PG8_LDA(dst, b, h) do { _Pragma("unroll") for (int m = 0; m < 4; ++m) _Pragma("unroll") for (int k = 0; k < 2; ++k) dst[m][k] = *(const LAS bf16x8*)(lds + PG8_SA(b, h) + aoff + m * 2048 + k * 1024); } while (0)
#define PG8_LDB(dst, b, h) do { _Pragma("unroll") for (int n = 0; n < 2; ++n) _Pragma("unroll") for (int k = 0; k < 2; ++k) dst[n][k] = *(const LAS bf16x8*)(lds + PG8_SB(b, h) + boff + n * 2048 + k * 1024); } while (0)
#define PG8_MMA(ai, bj, At, Bt) do { __builtin_amdgcn_s_setprio(1); _Pragma("unroll") for (int m = 0; m < 4; ++m) _Pragma("unroll") for (int n = 0; n < 2; ++n) _Pragma("unroll") for (int k = 0; k < 2; ++k) \
        acc[ai][bj][m][n] = __builtin_amdgcn_mfma_f32_16x16x32_bf16(Bt[n][k], At[m][k], acc[ai][bj][m][n], 0, 0, 0); __builtin_amdgcn_s_setprio(0); } while (0)
#define PG8_WAIT_V(n) asm volatile("s_waitcnt vmcnt(" #n ")" ::: "memory")
#define PG8_WAIT_L(n) asm volatile("s_waitcnt lgkmcnt(" #n ")" ::: "memory")
#define PG8_BAR __builtin_amdgcn_s_barrier()
#define PG8_SCHED __builtin_amdgcn_sched_barrier(0)
    Unit cur, nxt; int ui = 0;
    if (!S.next(0, cur)) return;
    f32x4 acc[2][2][4][2];
#pragma unroll
    for (int a = 0; a < 2; ++a)
#pragma unroll
        for (int b = 0; b < 2; ++b)
#pragma unroll
            for (int m = 0; m < 4; ++m)
#pragma unroll
                for (int n = 0; n < 2; ++n) acc[a][b][m][n] = (f32x4){0.f, 0.f, 0.f, 0.f};
    bf16x8 At[4][2], B0[2][2], B1[2][2];
    const char* cA = (const char*)g.A + (size_t)cur.pm * tstep; const char* cB = (const char*)g.Bt + (size_t)cur.pn * tstep;
    S.a_ready(cur);
    PG8_STAGE(PG8_SB(0, 0), cB, voffB); PG8_STAGE(PG8_SA(0, 0), cA, voffA); PG8_STAGE(PG8_SB(0, 1), cB + hstep, voffB); PG8_STAGE(PG8_SA(0, 1), cA + hstep, voffA);
    if (wr == 1) PG8_BAR;
    PG8_WAIT_V(4); PG8_BAR;
    PG8_STAGE(PG8_SB(1, 0), cB + kstep, voffB); PG8_STAGE(PG8_SA(1, 0), cA + kstep, voffA); PG8_STAGE(PG8_SB(1, 1), cB + hstep + kstep, voffB);
    PG8_WAIT_V(6); PG8_BAR;
    for (;;) {
        const bool has_next = S.next(ui + 1, nxt);
        const char* nA = has_next ? (const char*)g.A + (size_t)nxt.pm * tstep : cA; const char* nB = has_next ? (const char*)g.Bt + (size_t)nxt.pn * tstep : cB;
        for (int t = 0; t < nt; t += 2) {
            const bool last = (t == nt - 2);
            const char* a1 = cA + (size_t)(t + 1) * kstep;
            const char* a2 = last ? nA : cA + (size_t)(t + 2) * kstep; const char* b2 = last ? nB : cB + (size_t)(t + 2) * kstep;
            const char* a3 = a2 + kstep; const char* b3 = b2 + kstep;
            if (last && has_next) S.a_ready(nxt);
            PG8_LDB(B0, 0, 0); PG8_SCHED; PG8_LDA(At, 0, 0); PG8_STAGE(PG8_SA(1, 1), a1 + hstep, voffA);
            PG8_WAIT_L(8); PG8_BAR; PG8_WAIT_L(0); PG8_MMA(0, 0, At, B0); PG8_BAR; PG8_SCHED;
            PG8_LDB(B1, 0, 1); PG8_STAGE(PG8_SB(0, 0), b2, voffB);
            PG8_BAR; PG8_WAIT_L(0); PG8_MMA(0, 1, At, B1); PG8_BAR;
            PG8_LDA(At, 0, 1); PG8_STAGE(PG8_SA(0, 0), a2, voffA);
            PG8_BAR; PG8_WAIT_L(0); PG8_MMA(1, 0, At, B0); PG8_BAR; PG8_SCHED;
            PG8_STAGE(PG8_SB(0, 1), b2 + hstep, voffB);
            PG8_WAIT_V(6); PG8_BAR; PG8_MMA(1, 1, At, B1); PG8_BAR;
            PG8_LDB(B0, 1, 0); PG8_SCHED; PG8_LDA(At, 1, 0); PG8_STAGE(PG8_SA(0, 1), a2 + hstep, voffA);
            PG8_WAIT_L(8); PG8_BAR; PG8_WAIT_L(0); PG8_MMA(0, 0, At, B0); PG8_BAR; PG8_SCHED;
            PG8_LDB(B1, 1, 1); PG8_STAGE(PG8_SB(1, 0), b3, voffB);
            PG8_BAR; PG8_WAIT_L(0); PG8_MMA(0, 1, At, B1); PG8_BAR;
            PG8_LDA(At, 1, 1); PG8_STAGE(PG8_SA(1, 0), a3, voffA);
            PG8_BAR; PG8_WAIT_L(0); PG8_MMA(1, 0, At, B0); PG8_BAR; PG8_SCHED;
            PG8_STAGE(PG8_SB(1, 1), b3 + hstep, voffB);
            PG8_WAIT_V(6); PG8_BAR; PG8_MMA(1, 1, At, B1); PG8_BAR;
        }
        { int tz = threadIdx.x; asm volatile("" : "+v"(tz)); const int wz = tz >> 6, lz = tz & 63;
          E(acc, cur, wz >> 2, wz & 3, lz & 15, lz >> 4); } S.done(cur);
        if (!has_next) break;
#pragma unroll
        for (int a = 0; a < 2; ++a)
#pragma unroll
            for (int b = 0; b < 2; ++b)
#pragma unroll
                for (int m = 0; m < 4; ++m)
#pragma unroll
                    for (int n = 0; n < 2; ++n) acc[a][b][m][n] = (f32x4){0.f, 0.f, 0.f, 0.f};
        cur = nxt; cA = nA; cB = nB; ++ui;
    }
    PG8_WAIT_V(0);
    if (wr == 0) PG8_BAR;
    PG8_BAR;
#undef PG8_SA
#undef PG8_SB
#undef PG8_STAGE
#undef PG8_LDA
#undef PG8_LDB
#undef PG8_MMA
#undef PG8_WAIT_V
#undef PG8_WAIT_L
#undef PG8_BAR
#undef PG8_SCHED
}
#endif
}

constexpr int MBIG = (NP / 256) * 256;
template <class F> DEV void small_gemm(const bf16_t* A, const bf16_t* Bt, int K, unsigned char* lds, const F& f) {
    const int tid = threadIdx.x, lane = tid & 63, w = tid >> 6, g = lane >> 4, c16 = lane & 15;
    const int tiles_m = (NTOK - MBIG + 63) / 64, ntiles = tiles_m * 32, kw = K / 8;
    float* part = (float*)lds;
    for (int tl = blockIdx.x; tl < ntiles; tl += gridDim.x) {
        const int r0 = MBIG + (tl / 32) * 64, n0 = (tl % 32) * 64;
        f32x4 acc[4][4];
#pragma unroll
        for (int i = 0; i < 4; ++i)
#pragma unroll
            for (int j = 0; j < 4; ++j) acc[i][j] = (f32x4){0.f, 0.f, 0.f, 0.f};
        for (int k0 = w * kw; k0 < (w + 1) * kw; k0 += 128) {
            bf16x8 af[4][4], bfr[4][4];
#pragma unroll
            for (int u = 0; u < 4; ++u)
#pragma unroll
                for (int i = 0; i < 4; ++i) { int arow = r0 + 16 * i + c16; if (arow >= MPAD) arow = MPAD - 1;
                    af[u][i] = *(const bf16x8*)(A + (size_t)arow * K + k0 + 32 * u + 8 * g); bfr[u][i] = *(const bf16x8*)(Bt + (size_t)(n0 + 16 * i + c16) * K + k0 + 32 * u + 8 * g); }
#pragma unroll
            for (int u = 0; u < 4; ++u)
#pragma unroll
                for (int i = 0; i < 4; ++i)
#pragma unroll
                    for (int j = 0; j < 4; ++j) acc[i][j] = MFMA_BF16(af[u][i], bfr[u][j], acc[i][j]);
        }
#pragma unroll
        for (int i = 0; i < 4; ++i)
#pragma unroll
            for (int j = 0; j < 4; ++j)
#pragma unroll
                for (int r = 0; r < 4; ++r) part[(w * 64 + 16 * i + 4 * g + r) * 68 + 16 * j + c16] = acc[i][j][r];
        __syncthreads();
        {
            const int row = tid >> 3, c8 = (tid & 7) * 8; f32x4 s0 = (f32x4){0.f, 0.f, 0.f, 0.f}, s1 = s0;
#pragma unroll
            for (int ww = 0; ww < 8; ++ww) { s0 += *(const f32x4*)(part + (ww * 64 + row) * 68 + c8); s1 += *(const f32x4*)(part + (ww * 64 + row) * 68 + c8 + 4); }
            if (r0 + row < NTOK) f(r0 + row, n0 + c8, s0, s1);
        }
        __syncthreads();
    }
}
struct SmallResid { const float* xlo; const float* xhi; const bf16_t* x16; const float* gmod; bf16_t* out;
    DEV void operator()(int row, int col, f32x4 v0, f32x4 v1) const { const float* gr = gmod + (size_t)tok_batch(row) * MODW + col; f32x4 x0, x1;
        if (x16) { const u32x4 xw = *(const u32x4*)(x16 + (size_t)row * D + col); x0 = (f32x4){lo16(xw.x), hi16(xw.x), lo16(xw.y), hi16(xw.y)}; x1 = (f32x4){lo16(xw.z), hi16(xw.z), lo16(xw.w), hi16(xw.w)}; }
        else { const float* xr = (row < NP ? xlo + (size_t)row * D : xhi + (size_t)(row - NP) * D) + col; x0 = *(const f32x4*)xr; x1 = *(const f32x4*)(xr + 4); }
        const f32x4 o0 = x0 + *(const f32x4*)gr * v0, o1 = x1 + *(const f32x4*)(gr + 4) * v1;
        u32x4 ow; ow.x = pack2(o0[0], o0[1]); ow.y = pack2(o0[2], o0[3]); ow.z = pack2(o1[0], o1[1]); ow.w = pack2(o1[2], o1[3]); *(u32x4*)(out + (size_t)row * D + col) = ow; } };
struct SmallF32 { float* out; DEV void operator()(int row, int col, f32x4 v0, f32x4 v1) const { float* o = out + (size_t)row * D + col; *(f32x4*)o = v0; *(f32x4*)(o + 4) = v1; } };

DEV void transpose_tile(const float* src, int ld_src, bf16_t* dst, int ld_dst, float* tile) {
    const int tid = threadIdx.x;
#pragma unroll
    for (int i = 0; i < 2; ++i) { const int idx = tid + i * 512, r = idx >> 4, c4 = idx & 15; const f32x4 v = *(const f32x4*)(src + (size_t)r * ld_src + c4 * 4);
        float* t = tile + r * 65 + c4 * 4; t[0] = v[0]; t[1] = v[1]; t[2] = v[2]; t[3] = v[3]; }
    __syncthreads();
    const int n = tid >> 3, kg = tid & 7; const float* t = tile + (kg * 8) * 65 + n;
    u32x4 w; w.x = pack2(t[0], t[65]); w.y = pack2(t[2 * 65], t[3 * 65]); w.z = pack2(t[4 * 65], t[5 * 65]); w.w = pack2(t[6 * 65], t[7 * 65]);
    *(u32x4*)(dst + (size_t)n * ld_dst + kg * 8) = w;
    __syncthreads();
}
DEV int cvt_job_tiles(int j) { const int K = j < 9 ? 2048 : 256; const int N = j < 2 ? NMOD : (j == 2 ? 2 * D : (j < 5 ? ZW : (j < 9 ? D : 256))); return (K / 64) * (N / 64); }
constexpr int TBL_SLOT = 10240, TBL_VP1 = 4 * NE - 2 * TBL_SLOT;
DEV int gemm_in_idle_blocks() { const int nwg = (MPAD / 256) * (ZW / 256), G = (int)gridDim.x, rounds = (nwg + G - 1) / G, full = nwg - (rounds - 1) * G; return G - full; }
DEV bool tbl_deferred() { return gemm_in_idle_blocks() >= 32; }
DEV void table_row_to_fp8(const Params& p, int vr, int lane) {
    const int l = vr / (2 * NE), which = (vr % (2 * NE)) / NE, e = vr % NE, rr = l * NE + e;
    const float* src = (which ? p.peer_v : p.peer_u) + (size_t)rr * D;
    f32x4 v[8]; float am = 0.f;
#pragma unroll
    for (int k = 0; k < 8; ++k) { v[k] = *(const f32x4*)(src + 4 * lane + 256 * k); am = fmaxf(am, fmaxf(fmaxf(fabsf(v[k][0]), fabsf(v[k][1])), fmaxf(fabsf(v[k][2]), fabsf(v[k][3])))); }
    am = wave_max(am);
    unsigned char* tab = (which ? p.v8 : p.u8) + (size_t)l * NE * (D / 2);
    const float sc = am > 0.f ? 6.0f / am : 1.0f;
#pragma unroll
    for (int k = 0; k < 8; ++k) *(unsigned short*)(tab + ((size_t)k * NE + e) * 128 + 2 * lane) = (unsigned short)fp4x4_enc(v[k][0] * sc, v[k][1] * sc, v[k][2] * sc, v[k][3] * sc);
    if (lane == 0) (which ? p.sv : p.su)[rr] = am > 0.f ? am * (1.0f / 6.0f) : 1.0f;
}
DEV void phase_tbl_slot(const Params& p, int l) {
    const int idle = gemm_in_idle_blocks(), first = (int)gridDim.x - idle;
    if (idle < 32 || (int)blockIdx.x < first) return;
    const int gw = ((int)blockIdx.x - first) * 8 + wave_id(), nw = idle * 8, lo = TBL_VP1 + l * TBL_SLOT;
    for (int vr = lo + gw; vr < lo + TBL_SLOT; vr += nw) table_row_to_fp8(p, vr, threadIdx.x & 63);
}
DEV void phase_convert(const Params& p, unsigned char* lds, int part) {
    float* tile = (float*)lds;
    const int tid = threadIdx.x;
    const int q_lo = part == 0 ? 0 : 3, q_hi = part == 0 ? 3 : 17;
    int total = 0;
#pragma unroll
    for (int q = 0; q < 17; ++q) if (q >= q_lo && q < q_hi) total += cvt_job_tiles(q);
    for (int tl = blockIdx.x; tl < total; tl += gridDim.x) {
        int j = 0, loc = 0, base = 0;
#pragma unroll
        for (int q = 0; q < 17; ++q) if (q >= q_lo && q < q_hi) { const int cnt = cvt_job_tiles(q); if (tl >= base && tl < base + cnt) { j = q; loc = tl - base; } base += cnt; }
        const float* src; bf16_t* dst; int K = 2048, N;
        if (j < 2) { N = NMOD; src = p.w_ada + (size_t)j * 2048 * NMOD; dst = p.wt_ada + (size_t)j * NMOD * 2048; }
        else if (j == 2) { N = 2 * D; src = p.w_ada_final; dst = p.wt_ada + (size_t)2 * NMOD * 2048; }
        else if (j < 5) { N = ZW; src = p.w_in + (size_t)(j - 3) * 2048 * ZW; dst = p.wt_in + (size_t)(j - 3) * ZW * 2048; }
        else if (j < 7) { N = D; src = p.w_out + (size_t)(j - 5) * D * D; dst = p.wt_out + (size_t)(j - 5) * D * D; }
        else if (j < 9) { N = D; src = p.peer_wq + (size_t)(j - 7) * D * D; dst = p.wt_q + (size_t)(j - 7) * D * D; }
        else { K = 256; N = 256; src = p.pool_w + (size_t)(j - 9) * 65536; dst = p.wt_pool + (size_t)(j - 9) * 65536; }
        const int ntn = N / 64, kt = loc / ntn, nt = loc % ntn;
        transpose_tile(src + (size_t)kt * 64 * N + nt * 64, N, dst + (size_t)nt * 64 * K + kt * 64, K, tile);
    }
    const size_t gt = (size_t)blockIdx.x * 512 + tid, gs = (size_t)gridDim.x * 512;
    if (part == 1) {
        constexpr int NADA = MODW / 256;
        const int vend = tbl_deferred() ? TBL_VP1 : 4 * NE, R1 = (vend / 8) * 7;
        const bool uneven = (int)gridDim.x > NADA + 16;
        for (int seg = 0; seg < 2; ++seg) {
            int gw, nw, r_lo, r_hi;
            if (!uneven) { if (seg) break; gw = blockIdx.x * 8 + wave_id(); nw = gridDim.x * 8; r_lo = 0; r_hi = vend; }
            else if (seg == 0) { gw = blockIdx.x * 8 + wave_id(); nw = gridDim.x * 8; r_lo = 0; r_hi = R1; }
            else { if ((int)blockIdx.x < NADA) break; gw = ((int)blockIdx.x - NADA) * 8 + wave_id(); nw = ((int)gridDim.x - NADA) * 8; r_lo = R1; r_hi = vend; }
            for (int vr = r_lo + gw; vr < r_hi; vr += nw) table_row_to_fp8(p, vr, tid & 63);
        }
    }
    if (part == 0) for (size_t i = gt; i < (size_t)256 * D / 8; i += gs) {
        const int row = (int)(i / (D / 8)), c8 = (int)(i % (D / 8)) * 8; u32x4 w = (u32x4){0u, 0u, 0u, 0u};
        if (row < NC) { const float* s = (row < PB ? p.c_prompt + (size_t)row * D : p.c_sample + (size_t)(row - PB) * D) + c8;
            const f32x4 a = *(const f32x4*)s, b = *(const f32x4*)(s + 4);
            w.x = pack2(siluf_(a[0]), siluf_(a[1])); w.y = pack2(siluf_(a[2]), siluf_(a[3])); w.z = pack2(siluf_(b[0]), siluf_(b[1])); w.w = pack2(siluf_(b[2]), siluf_(b[3])); }
        *(u32x4*)(p.csil + i * 8) = w;
    }
}

DEV void phase_norm(const Params& p, const float* xlo, const float* xhi, const bf16_t* x16, const float* gn, int sh_off, int sc_off, bf16_t* obf, float* of32) {
    const int lane = threadIdx.x & 63, gw = blockIdx.x * 8 + wave_id(), nw = gridDim.x * 8;
    for (int t = gw; t < NTOK; t += nw) {
        const float* xr = x16 ? nullptr : (t < NP ? xlo + (size_t)t * D : xhi + (size_t)(t - NP) * D);
        const float* mrow = p.modbuf + (size_t)tok_batch(t) * MODW;
        f32x4 v[8]; float ss = 0.f;
#pragma unroll
        for (int c = 0; c < 4; ++c) { const int col = c * 512 + lane * 8;
            if (x16) { const u32x4 xw = *(const u32x4*)(x16 + (size_t)t * D + col); v[2 * c] = (f32x4){lo16(xw.x), hi16(xw.x), lo16(xw.y), hi16(xw.y)}; v[2 * c + 1] = (f32x4){lo16(xw.z), hi16(xw.z), lo16(xw.w), hi16(xw.w)}; }
            else { v[2 * c] = *(const f32x4*)(xr + col); v[2 * c + 1] = *(const f32x4*)(xr + col + 4); }
#pragma unroll
            for (int j = 0; j < 4; ++j) ss += v[2 * c][j] * v[2 * c][j] + v[2 * c + 1][j] * v[2 * c + 1][j]; }
        ss = wave_sum(ss);
        const float rstd = rsqrtf(ss * (1.0f / D) + EPS);
#pragma unroll
        for (int c = 0; c < 4; ++c) { const int col = c * 512 + lane * 8; f32x4 y[2];
#pragma unroll
            for (int q = 0; q < 2; ++q) { const f32x4 g4 = *(const f32x4*)(gn + col + 4 * q), sc = *(const f32x4*)(mrow + sc_off + col + 4 * q), sh = *(const f32x4*)(mrow + sh_off + col + 4 * q);
                y[q] = (v[2 * c + q] * rstd) * g4 * (sc + 1.0f) + sh; }
            if (obf) { u32x4 w; w.x = pack2(y[0][0], y[0][1]); w.y = pack2(y[0][2], y[0][3]); w.z = pack2(y[1][0], y[1][1]); w.w = pack2(y[1][2], y[1][3]); *(u32x4*)(obf + (size_t)t * D + col) = w; }
            else { *(f32x4*)(of32 + (size_t)t * D + col) = y[0]; *(f32x4*)(of32 + (size_t)t * D + col + 4) = y[1]; }
        }
    }
}

namespace hg {
constexpr int QS = 136, VS = 72;
constexpr int O_QT = 0, O_QH = O_QT + 64 * QS * 2, O_KT = O_QH + 64 * QS * 2, O_KDT = O_KT + 160 * QS * 2, O_VT = O_KDT + 128 * VS * 2,
              O_AB = O_VT + 128 * VS * 2, O_GS = O_AB + 64 * VS * 2, O_END = O_GS + 4 * 128 * 4;
constexpr int OS = 132;
static_assert(O_END <= 163840 - 64, "HGRN LDS layout too large");
constexpr int NCHUNK = SEQ / 64, NUNIT = PB * HH * NCHUNK;
}
DEV int kt_rowbase(int i) { return i == 0 ? 0 : (i == 1 ? 16 : (i == 2 ? 48 : 96)); }

DEV void hgrn_pre_unit(const Params& p, int l, int unit, unsigned char* lds) {
    using namespace hg;
    const int tid = threadIdx.x, lane = tid & 63, w = tid >> 6, g = lane >> 4, c16 = lane & 15;
    const int c = unit % NCHUNK, bh = unit / NCHUNK, b = bh / HH, h = bh % HH;
    bf16_t* Qt = (bf16_t*)(lds + O_QT); bf16_t* Qh = (bf16_t*)(lds + O_QH); bf16_t* Kt = (bf16_t*)(lds + O_KT);
    bf16_t* Kdt = (bf16_t*)(lds + O_KDT); bf16_t* Vt = (bf16_t*)(lds + O_VT); bf16_t* Ab = (bf16_t*)(lds + O_AB); float* Gs = (float*)(lds + O_GS);
    const int kk = tid & 127, sj = tid >> 7;
    float lbv = 0.f;
    if (l > 0) lbv = sigmoidf_(p.lb_logits[HH * HD + h * HD + kk] - p.lb_logits[h * HD + kk]);
    const float oml = 1.0f - lbv;
    for (int i = tid; i < 64 * VS / 2; i += 512) ((unsigned*)Ab)[i] = 0u;
    const size_t row0 = (size_t)b * SEQ + c * 64;
    float Gl[16], qv[16], kv[16];
    {
        const bf16_t* zr = p.z + (row0 + sj * 16) * ZW + h * HD + kk;
        unsigned short zq16[16], zf16[16], zi16[16];
#pragma unroll
        for (int s = 0; s < 16; ++s) { zq16[s] = zr[(size_t)s * ZW]; zf16[s] = zr[(size_t)s * ZW + 1024]; zi16[s] = zr[(size_t)s * ZW + 2048]; }
        float run = 0.f; unsigned vpk[8];
#pragma unroll
        for (int s = 0; s < 16; ++s) {
            const float zq = bf2f(zq16[s]), zf = fminf(fmaxf(bf2f(zf16[s]), -80.f), 80.f);
            const float e = __expf(-zf), sg = 1.0f / (1.0f + e);
            const float f = lbv + oml * sg;
            run += __logf(f); Gl[s] = run;
            kv[s] = oml * (e * sg);
            qv[s] = siluf_(zq);
            if (s & 1) vpk[s >> 1] |= (unsigned)zi16[s] << 16; else vpk[s >> 1] = zi16[s];
        }
        Gs[sj * 128 + kk] = run;
        *(u32x4*)(Vt + kk * VS + sj * 16) = (u32x4){vpk[0], vpk[1], vpk[2], vpk[3]}; *(u32x4*)(Vt + kk * VS + sj * 16 + 8) = (u32x4){vpk[4], vpk[5], vpk[6], vpk[7]};
    }
    __syncthreads();
    float Gend;
    {
        const float g0 = Gs[kk], g1 = Gs[128 + kk], g2 = Gs[256 + kk], g3 = Gs[384 + kk];
        float Gb[4]; Gb[0] = 0.f; Gb[1] = g0; Gb[2] = g0 + g1; Gb[3] = g0 + g1 + g2; Gend = Gb[3] + g3;
        const float Gbj = sj == 0 ? Gb[0] : (sj == 1 ? Gb[1] : (sj == 2 ? Gb[2] : Gb[3]));
        const float eGb = __expf(Gbj);
        unsigned kd[8]; unsigned qh[8];
#pragma unroll
        for (int s = 0; s < 16; ++s) {
            const int t = sj * 16 + s;
            const float q1 = qv[s] * __expf(Gl[s]);
            Qt[t * QS + kk] = (bf16_t)f2bf(q1);
            const unsigned qhv = f2bf(q1 * eGb);
            Qh[t * QS + kk] = (bf16_t)qhv;
#pragma unroll
            for (int i = 0; i < 4; ++i) if (i >= sj) Kt[(kt_rowbase(i) + t) * QS + kk] = (bf16_t)f2bf(kv[s] * __expf(fminf(Gb[i] - Gbj - Gl[s], 60.f)));
            const unsigned kdv = f2bf(kv[s] * __expf(Gend - Gbj - Gl[s]));
            if (s & 1) kd[s >> 1] |= kdv << 16; else kd[s >> 1] = kdv;
        }
        *(u32x4*)(Kdt + kk * VS + sj * 16) = (u32x4){kd[0], kd[1], kd[2], kd[3]}; *(u32x4*)(Kdt + kk * VS + sj * 16 + 8) = (u32x4){kd[4], kd[5], kd[6], kd[7]};
        if (sj == 0) p.hg_gam[(size_t)unit * HD + kk] = __expf(Gend);
    }
    __syncthreads();
    {
        const int t = tid >> 3, part = tid & 7;
        const u32x4 a = *(const u32x4*)(Qh + t * QS + 16 * part), b2 = *(const u32x4*)(Qh + t * QS + 16 * part + 8);
        bf16_t* dst = p.hg_qh + (row0 + t) * 1024 + h * HD + 16 * part; *(u32x4*)dst = a; *(u32x4*)(dst + 8) = b2;
    }
    for (int blk = w; blk < 10; blk += 8) {
        int bi, bjj;
        if (blk == 0) { bi = 0; bjj = 0; } else if (blk < 3) { bi = 1; bjj = blk - 1; } else if (blk < 6) { bi = 2; bjj = blk - 3; } else { bi = 3; bjj = blk - 6; }
        f32x4 acc = (f32x4){0.f, 0.f, 0.f, 0.f};
#pragma unroll
        for (int ks = 0; ks < 4; ++ks) {
            const bf16x8 a = *(const bf16x8*)(Qt + (16 * bi + c16) * QS + 32 * ks + 8 * g);
            const bf16x8 bb = *(const bf16x8*)(Kt + (kt_rowbase(bi) + 16 * bjj + c16) * QS + 32 * ks + 8 * g);
            acc = MFMA_BF16(a, bb, acc);
        }
#pragma unroll
        for (int r = 0; r < 4; ++r) { const int tl = 4 * g + r; float v = acc[r]; if (bi == bjj && c16 > tl) v = 0.f; Ab[(16 * bi + tl) * VS + 16 * bjj + c16] = (bf16_t)f2bf(v); }
    }
    __syncthreads();
    {
        u32x2* oin = (u32x2*)(p.hg_oin + (size_t)unit * 64 * 128);
#pragma unroll
        for (int tt = 0; tt < 4; ++tt) {
            f32x4 acc = (f32x4){0.f, 0.f, 0.f, 0.f};
#pragma unroll
            for (int ks = 0; ks < 2; ++ks) {
                const bf16x8 a = *(const bf16x8*)(Ab + (16 * tt + c16) * VS + 32 * ks + 8 * g);
                const bf16x8 bb = *(const bf16x8*)(Vt + (16 * w + c16) * VS + 32 * ks + 8 * g);
                acc = MFMA_BF16(a, bb, acc);
            }
            oin[(tt * 8 + w) * 64 + lane] = (u32x2){pack2(acc[0], acc[1]), pack2(acc[2], acc[3])};
        }
        u32x2* ds = (u32x2*)(p.hg_ds + (size_t)unit * 128 * 128);
#pragma unroll
        for (int vt = 0; vt < 8; ++vt) {
            f32x4 acc = (f32x4){0.f, 0.f, 0.f, 0.f};
#pragma unroll
            for (int ks = 0; ks < 2; ++ks) {
                const bf16x8 a = *(const bf16x8*)(Kdt + (16 * w + c16) * VS + 32 * ks + 8 * g);
                const bf16x8 bb = *(const bf16x8*)(Vt + (16 * vt + c16) * VS + 32 * ks + 8 * g);
                acc = MFMA_BF16(a, bb, acc);
            }
            ds[(w * 8 + vt) * 64 + lane] = (u32x2){pack2(acc[0], acc[1]), pack2(acc[2], acc[3])};
        }
    }
    __syncthreads();
}

DEV void hgrn_scan_unit(const Params& p, int l, int su) {
    using namespace hg;
    const int tid = threadIdx.x, lane = tid & 63, w = tid >> 6, g = lane >> 4, c16 = lane & 15;
    const int vt = su % 8, bh = su / 8, b = bh / HH, h = bh % HH;
    f32x4 S = (f32x4){0.f, 0.f, 0.f, 0.f};
    constexpr int CB = NCHUNK < 16 ? NCHUNK : 16;
    static_assert(NCHUNK % CB == 0, "chunk batch");
    for (int c0 = 0; c0 < NCHUNK; c0 += CB) {
        u32x2 dw[CB]; f32x4 gm[CB];
#pragma unroll
        for (int i = 0; i < CB; ++i) { const size_t unit = (size_t)bh * NCHUNK + c0 + i;
            dw[i] = ((const u32x2*)(p.hg_ds + unit * 128 * 128))[(w * 8 + vt) * 64 + lane]; gm[i] = *(const f32x4*)(p.hg_gam + unit * HD + 16 * w + 4 * g); }
#pragma unroll
        for (int i = 0; i < CB; ++i) { const size_t unit = (size_t)bh * NCHUNK + c0 + i;
            u32x2 sw; sw.x = pack2(S[0], S[1]); sw.y = pack2(S[2], S[3]);
            *(u32x2*)(p.hg_sc + (unit * 128 + 16 * vt + c16) * 128 + 16 * w + 4 * g) = sw;
            const f32x4 d = (f32x4){lo16(dw[i].x), hi16(dw[i].x), lo16(dw[i].y), hi16(dw[i].y)};
            S = S * gm[i] + d; }
    }
    float* so = p.out + OFF_HP + ((size_t)(l * PB + b) * HH + h) * HD * HD;
#pragma unroll
    for (int r = 0; r < 4; ++r) so[(size_t)(16 * w + 4 * g + r) * HD + 16 * vt + c16] = S[r];
}

DEV void hgrn_post_unit(const Params& p, int l, int unit, unsigned char* lds) {
    using namespace hg;
    const int tid = threadIdx.x, lane = tid & 63, w = tid >> 6, g = lane >> 4, c16 = lane & 15;
    const int c = unit % NCHUNK, bh = unit / NCHUNK, b = bh / HH, h = bh % HH;
    float* Ob = (float*)lds;
    const size_t row0 = (size_t)b * SEQ + c * 64;
    const u32x2* oin = (const u32x2*)(p.hg_oin + (size_t)unit * 64 * 128);
    u32x2 ow[4];
#pragma unroll
    for (int tt = 0; tt < 4; ++tt) ow[tt] = oin[(tt * 8 + w) * 64 + lane];
    bf16x8 bfr[4], af[4][4];
    if (c > 0) {
#pragma unroll
        for (int ks = 0; ks < 4; ++ks) bfr[ks] = *(const bf16x8*)(p.hg_sc + ((size_t)unit * 128 + 16 * w + c16) * 128 + 32 * ks + 8 * g);
#pragma unroll
        for (int tt = 0; tt < 4; ++tt)
#pragma unroll
            for (int ks = 0; ks < 4; ++ks) af[tt][ks] = *(const bf16x8*)(p.hg_qh + (row0 + 16 * tt + c16) * 1024 + h * HD + 32 * ks + 8 * g);
    }
    const bf16_t* zgp = p.z + (row0 + (tid >> 3)) * ZW + 3072 + h * HD + 16 * (tid & 7);
    const u32x4 za = *(const u32x4*)zgp, zc = *(const u32x4*)(zgp + 8);
    f32x4 acc[4];
#pragma unroll
    for (int tt = 0; tt < 4; ++tt) acc[tt] = (f32x4){lo16(ow[tt].x), hi16(ow[tt].x), lo16(ow[tt].y), hi16(ow[tt].y)};
    if (c > 0) {
#pragma unroll
        for (int tt = 0; tt < 4; ++tt)
#pragma unroll
            for (int ks = 0; ks < 4; ++ks) acc[tt] = MFMA_BF16(af[tt][ks], bfr[ks], acc[tt]);
    }
#pragma unroll
    for (int tt = 0; tt < 4; ++tt)
#pragma unroll
        for (int r = 0; r < 4; ++r) Ob[(16 * tt + 4 * g + r) * OS + 16 * w + c16] = acc[tt][r];
    __syncthreads();
    {
        const int t = tid >> 3, part = tid & 7; const size_t row = row0 + t;
        float ov[16]; float ss = 0.f;
#pragma unroll
        for (int q = 0; q < 4; ++q) { const f32x4 x = *(const f32x4*)(Ob + t * OS + 16 * part + 4 * q); ov[4 * q] = x[0]; ov[4 * q + 1] = x[1]; ov[4 * q + 2] = x[2]; ov[4 * q + 3] = x[3];
            ss += x[0] * x[0] + x[1] * x[1] + x[2] * x[2] + x[3] * x[3]; }
        ss += __shfl_xor(ss, 1); ss += __shfl_xor(ss, 2); ss += __shfl_xor(ss, 4);
        const float rstd = rsqrtf(ss * (1.0f / HD) + EPS);
        const unsigned zw[8] = {za.x, za.y, za.z, za.w, zc.x, zc.y, zc.z, zc.w};
        const float* gn = p.hgrn_norm_g + l * HD + 16 * part;
        unsigned ow[8];
#pragma unroll
        for (int q = 0; q < 8; ++q) { const float a0 = ov[2 * q] * rstd * gn[2 * q] * siluf_(lo16(zw[q])), a1 = ov[2 * q + 1] * rstd * gn[2 * q + 1] * siluf_(hi16(zw[q])); ow[q] = pack2(a0, a1); }
        bf16_t* dst = p.cat + row * D + h * HD + 16 * part;
        *(u32x4*)dst = (u32x4){ow[0], ow[1], ow[2], ow[3]}; *(u32x4*)(dst + 8) = (u32x4){ow[4], ow[5], ow[6], ow[7]};
    }
    __syncthreads();
}

DEV void hgrn_sample_unit(const Params& p, int l, int unit, unsigned char* lds) {
    const int tid = threadIdx.x, lane = tid & 63, w = tid >> 6;
    const int b = unit / HH, h = unit % HH;
    float* fS = (float*)lds; float* kS = fS + 512; float* qS = kS + 512; float* vS = qS + 512; float* red = vS + 512; float* part = red + 4 * 4 * 128;
    const int r0 = NP + b * DSEQ;
    {
        const int t = tid >> 7, kk = tid & 127; const bf16_t* zr = p.z + (size_t)(r0 + t) * ZW + h * HD + kk;
        float lbv = 0.f; if (l > 0) lbv = sigmoidf_(p.lb_logits[HH * HD + h * HD + kk] - p.lb_logits[h * HD + kk]);
        const float zq = bf2f(zr[0]), zf = fminf(fmaxf(bf2f(zr[1024]), -80.f), 80.f), zi = bf2f(zr[2048]);
        const float e = __expf(-zf), sg = 1.0f / (1.0f + e);
        fS[tid] = lbv + (1.0f - lbv) * sg; kS[tid] = (1.0f - lbv) * (e * sg); qS[tid] = siluf_(zq); vS[tid] = zi;
    }
    const int v = tid & 127, kq = tid >> 7;
    const float* s0 = p.state_hgrn + ((size_t)(l * DB + b) * HH + h) * HD * HD + (size_t)(32 * kq) * HD + v;
    float S[32];
#pragma unroll
    for (int i = 0; i < 32; ++i) S[i] = s0[(size_t)i * HD];
    __syncthreads();
#pragma unroll
    for (int t = 0; t < 4; ++t) {
        const float vv = vS[t * 128 + v]; float po = 0.f;
#pragma unroll
        for (int i = 0; i < 32; ++i) { const int kk = t * 128 + 32 * kq + i; S[i] = fS[kk] * S[i] + kS[kk] * vv; po += qS[kk] * S[i]; }
        red[(t * 4 + kq) * 128 + v] = po;
    }
    float* so = p.out + OFF_HS + ((size_t)(l * DB + b) * HH + h) * HD * HD + (size_t)(32 * kq) * HD + v;
#pragma unroll
    for (int i = 0; i < 32; ++i) so[(size_t)i * HD] = S[i];
    __syncthreads();
    {
        const int t = tid >> 7; const float o = red[(t * 4 + 0) * 128 + v] + red[(t * 4 + 1) * 128 + v] + red[(t * 4 + 2) * 128 + v] + red[(t * 4 + 3) * 128 + v];
        const float ss = wave_sum(o * o);
        if (lane == 0) part[w] = ss;
        __syncthreads();
        const float tot = part[2 * t] + part[2 * t + 1];
        const float rstd = rsqrtf(tot * (1.0f / HD) + EPS);
        const float zg = bf2f(p.z[(size_t)(r0 + t) * ZW + 3072 + h * HD + v]);
        p.cat[(size_t)(r0 + t) * D + h * HD + v] = (bf16_t)f2bf(o * rstd * p.hgrn_norm_g[l * HD + v] * siluf_(zg));
    }
    __syncthreads();
}

DEV void pool_pre_unit(const Params& p, int l, int unit) {
    const int tid = threadIdx.x, tk = tid >> 7, cg = tid & 127, c = cg * 8, gi = cg >> 5, wnd = 2 << gi;
    const int r = unit * 4 + tk;
    if (r >= NTOK) return;
    f32x2 sum[4] = {{0.f, 0.f}, {0.f, 0.f}, {0.f, 0.f}, {0.f, 0.f}}; float cur[8];
    float cnt;
    if (r < NP) {
        const int t = r % SEQ; const int n = (wnd < t + 1) ? wnd : (t + 1); cnt = (float)n;
        u32x4 q[16];
#pragma unroll
        for (int j = 0; j < 16; ++j) q[j] = (j < n) ? *(const u32x4*)(p.z + (size_t)(r - j) * ZW + 4096 + c) : (u32x4){0u, 0u, 0u, 0u};
#pragma unroll
        for (int j = 0; j < 16; ++j) { sum[0] += (f32x2){lo16(q[j].x), hi16(q[j].x)}; sum[1] += (f32x2){lo16(q[j].y), hi16(q[j].y)}; sum[2] += (f32x2){lo16(q[j].z), hi16(q[j].z)}; sum[3] += (f32x2){lo16(q[j].w), hi16(q[j].w)}; }
        cur[0] = lo16(q[0].x); cur[1] = hi16(q[0].x); cur[2] = lo16(q[0].y); cur[3] = hi16(q[0].y); cur[4] = lo16(q[0].z); cur[5] = hi16(q[0].z); cur[6] = lo16(q[0].w); cur[7] = hi16(q[0].w);
        if (t >= SEQ - PBUF) { float* o = p.out + OFF_PP + ((size_t)(l * PB + r / SEQ) * PBUF + (t - (SEQ - PBUF))) * PW + c;
            *(f32x4*)o = (f32x4){cur[0], cur[1], cur[2], cur[3]}; *(f32x4*)(o + 4) = (f32x4){cur[4], cur[5], cur[6], cur[7]}; }
    } else {
        const int bb = (r - NP) / DSEQ, t = (r - NP) % DSEQ; cnt = (float)wnd;
        const float* sp = p.state_pool + (size_t)(l * DB + bb) * PBUF * PW + c;
        u32x4 q[4]; f32x4 sa[15], sb[15];
#pragma unroll
        for (int j = 0; j < 4; ++j) q[j] = (j <= t && j < wnd) ? *(const u32x4*)(p.z + (size_t)(NP + bb * DSEQ + t - j) * ZW + 4096 + c) : (u32x4){0u, 0u, 0u, 0u};
#pragma unroll
        for (int j = 1; j < 16; ++j) {
            const int back = j - t;
            const bool use = (back >= 1) && (j < wnd);
            const float* srow = sp + (size_t)(PBUF - (use ? back : 1)) * PW;
            sa[j - 1] = use ? *(const f32x4*)srow : (f32x4){0.f, 0.f, 0.f, 0.f}; sb[j - 1] = use ? *(const f32x4*)(srow + 4) : (f32x4){0.f, 0.f, 0.f, 0.f};
        }
#pragma unroll
        for (int j = 0; j < 4; ++j) { sum[0] += (f32x2){lo16(q[j].x), hi16(q[j].x)}; sum[1] += (f32x2){lo16(q[j].y), hi16(q[j].y)}; sum[2] += (f32x2){lo16(q[j].z), hi16(q[j].z)}; sum[3] += (f32x2){lo16(q[j].w), hi16(q[j].w)}; }
#pragma unroll
        for (int j = 0; j < 15; ++j) { sum[0] += (f32x2){sa[j][0], sa[j][1]}; sum[1] += (f32x2){sa[j][2], sa[j][3]}; sum[2] += (f32x2){sb[j][0], sb[j][1]}; sum[3] += (f32x2){sb[j][2], sb[j][3]}; }
        cur[0] = lo16(q[0].x); cur[1] = hi16(q[0].x); cur[2] = lo16(q[0].y); cur[3] = hi16(q[0].y); cur[4] = lo16(q[0].z); cur[5] = hi16(q[0].z); cur[6] = lo16(q[0].w); cur[7] = hi16(q[0].w);
        float* ob = p.out + OFF_PS + (size_t)(l * DB + bb) * PBUF * PW + c;
        { float* o = ob + (size_t)(11 + t) * PW; *(f32x4*)o = (f32x4){cur[0], cur[1], cur[2], cur[3]}; *(f32x4*)(o + 4) = (f32x4){cur[4], cur[5], cur[6], cur[7]}; }
        for (int i = t; i < 11; i += 4) { const float* s2 = sp + (size_t)(4 + i) * PW; float* o = ob + (size_t)i * PW; *(f32x4*)o = *(const f32x4*)s2; *(f32x4*)(o + 4) = *(const f32x4*)(s2 + 4); }
    }
    const float inv = 1.0f / cnt;
    u32x4 w; w.x = pack2(sum[0][0] * inv - cur[0], sum[0][1] * inv - cur[1]); w.y = pack2(sum[1][0] * inv - cur[2], sum[1][1] * inv - cur[3]);
    w.z = pack2(sum[2][0] * inv - cur[4], sum[2][1] * inv - cur[5]); w.w = pack2(sum[3][0] * inv - cur[6], sum[3][1] * inv - cur[7]);
    *(u32x4*)(p.pooled + ((size_t)gi * MPAD + r) * 256 + (c & 255)) = w;
}

#ifndef PROBE_SUB
#define PROBE_SUB 0
#endif
DEV void phase_mix1(const Params& p, int l, unsigned char* lds) {
    for (int rep = 0; rep < (PROBE_SUB == 1 ? 2 : 1); ++rep) for (int u = blockIdx.x; u < hg::NUNIT; u += gridDim.x) hgrn_pre_unit(p, l, u, lds);
    for (int rep = 0; rep < (PROBE_SUB == 2 ? 2 : 1); ++rep) for (int u = blockIdx.x; u < DB * HH; u += gridDim.x) hgrn_sample_unit(p, l, u, lds);
    for (int rep = 0; rep < (PROBE_SUB == 3 ? 2 : 1); ++rep) for (int u = blockIdx.x; u < (NTOK + 3) / 4; u += gridDim.x) pool_pre_unit(p, l, u);
}
DEV void phase_mix2(const Params& p, int l) { for (int u = blockIdx.x; u < PB * HH * 8; u += gridDim.x) hgrn_scan_unit(p, l, u); }
DEV void phase_mix3(const Params& p, int l, unsigned char* lds) { for (int u = blockIdx.x; u < hg::NUNIT; u += gridDim.x) hgrn_post_unit(p, l, u, lds); }

#ifdef HIPEMU
#define MBCNT(mask) __builtin_popcountll((mask) & ((1ull << emu_lane()) - 1ull))
#define POPC64(m) __builtin_popcountll(m)
#else
#define MBCNT(mask) ((int)__builtin_amdgcn_mbcnt_hi((unsigned)((mask) >> 32), __builtin_amdgcn_mbcnt_lo((unsigned)(mask), 0u)))
#define POPC64(m) __popcll(m)
#endif
DEV unsigned fkey(float f) { const unsigned u = __float_as_uint(f); return u ^ ((unsigned)((int)u >> 31) | 0x80000000u); }
DEV unsigned long long lowest_n_bits(unsigned long long m, int n) { unsigned long long r = 0ull; while (n > 0 && m) { const unsigned long long b = m & (~m + 1ull); r |= b; m ^= b; --n; } return r; }
#ifdef HIPEMU
#define DPPU_XOR1(v) __shfl((v), emu_lane() ^ 1)
#define DPPU_XOR2(v) __shfl((v), emu_lane() ^ 2)
#define DPPU_HMIRROR(v) __shfl((v), (emu_lane() & ~7) | (7 - (emu_lane() & 7)))
#else
template <int CTRL> DEV unsigned dpp_u(unsigned v) { return (unsigned)__builtin_amdgcn_update_dpp(0, (int)v, CTRL, 0xf, 0xf, true); }
#define DPPU_XOR1(v) dpp_u<0xB1>(v)
#define DPPU_XOR2(v) dpp_u<0x4E>(v)
#define DPPU_HMIRROR(v) dpp_u<0x141>(v)
#endif
template <int GL> DEV unsigned group_sum(unsigned c) { c += DPPU_XOR1(c); c += DPPU_XOR2(c); if (GL == 8) c += DPPU_HMIRROR(c); return c; }
template <int GL> DEV unsigned group_or(unsigned c) { c |= DPPU_XOR1(c); c |= DPPU_XOR2(c); if (GL == 8) c |= DPPU_HMIRROR(c); return c; }
template <int GL> DEV float group_maxf(float v) { v = fmaxf(v, DPP_XOR1(v)); v = fmaxf(v, DPP_XOR2(v)); if (GL == 8) v = fmaxf(v, DPP_HMIRROR(v)); return v; }
template <int GL> DEV float group_sumf(float v) { v += DPP_XOR1(v); v += DPP_XOR2(v); if (GL == 8) v += DPP_HMIRROR(v); return v; }
DEV unsigned bytesum(unsigned w) { return (w * 0x01010101u) >> 24; }
template <int GL> DEV unsigned group_excl_prefix(unsigned c, int sub) {
    const unsigned sh = 8u * (unsigned)(sub & 3);
    unsigned wlo = (GL == 4 || sub < 4) ? (c << sh) : 0u, whi = (GL == 8 && sub >= 4) ? (c << sh) : 0u;
    wlo = group_or<GL>(wlo);
    unsigned r;
    if (GL == 4) r = bytesum(wlo & ((1u << sh) - 1u));
    else { whi = group_or<GL>(whi); r = sub < 4 ? bytesum(wlo & ((1u << sh) - 1u)) : bytesum(wlo) + bytesum(whi & ((1u << sh) - 1u)); }
    return r;
}
DEV float fkey_inv(unsigned k) { return __uint_as_float((k & 0x80000000u) ? (k ^ 0x80000000u) : ~k); }
template <int NK> DEV unsigned count_above(const unsigned (&k)[NK], unsigned t) {
    unsigned c[4] = {0u, 0u, 0u, 0u};
#pragma unroll
    for (int i = 0; i < NK; ++i) c[i & 3] += (k[i] > t) ? 1u : 0u;
    return (c[0] + c[1]) + (c[2] + c[3]);
}
template <int GL, int NK> DEV unsigned group_top16(const unsigned (&k)[NK], bool active, int sub, unsigned& pos0) {
    unsigned mxk = 0u;
#pragma unroll
    for (int i = 0; i < NK; ++i) mxk = k[i] > mxk ? k[i] : mxk;
    { unsigned o = DPPU_XOR1(mxk); mxk = o > mxk ? o : mxk; o = DPPU_XOR2(mxk); mxk = o > mxk ? o : mxk; if (GL == 8) { o = DPPU_HMIRROR(mxk); mxk = o > mxk ? o : mxk; } }
    unsigned L0 = mxk > 0x01000000u ? mxk - 0x01000000u : 0u, c0 = group_sum<GL>(count_above<NK>(k, L0));
    unsigned L = c0 > 16u ? L0 + 1u : 0u, R = active ? mxk : 0u, cR = 0u;
    if (!active) L = 0u;
    if (c0 == 16u && active) { L = L0; R = L0; cR = 16u; }
    for (;;) {
        if (__ballot(L < R) == 0ull) break;
        const unsigned mid = L + ((R - L) >> 1);
        const unsigned c = group_sum<GL>(count_above<NK>(k, mid));
        const bool le = c <= 16u, hit = c == 16u;
        R = le ? mid : R; cR = le ? c : cR; L = hit ? mid : (le ? L : mid + 1u);
    }
    unsigned mask = 0u;
#pragma unroll
    for (int i = 0; i < NK; ++i) mask |= (k[i] > R) ? (1u << i) : 0u;
    const unsigned need = 16u - cR;
    if (__ballot(active && need > 0u) != 0ull) {
        unsigned eqm = 0u;
#pragma unroll
        for (int i = 0; i < NK; ++i) eqm |= (k[i] == R) ? (1u << i) : 0u;
        const unsigned eqc = (unsigned)__builtin_popcount(eqm), before = group_excl_prefix<GL>(eqc, sub);
        unsigned take = need > before ? need - before : 0u; if (take > eqc) take = eqc;
        if (!active) take = 0u;
        while (take > 0u) { const unsigned b = eqm & (~eqm + 1u); mask |= b; eqm ^= b; --take; }
    }
    if (!active) mask = 0u;
    pos0 = group_excl_prefix<GL>((unsigned)__builtin_popcount(mask), sub);
    return mask;
}
#ifdef HIPEMU
template <int J> DEV unsigned row_bcast_u(unsigned v) { return __shfl(v, (emu_lane() & ~15) | J); }
#else
template <int J> DEV unsigned row_bcast_u(unsigned v) { return (unsigned)__builtin_amdgcn_update_dpp(0, (int)v, 0x150 + J, 0xf, 0xf, true); }
#endif
template <int J> struct RowRank { static DEV unsigned run(unsigned v, int l16) { const unsigned b = row_bcast_u<J>(v); return (((b > v) || (b == v && J < l16)) ? 1u : 0u) + RowRank<J - 1>::run(v, l16); } };
template <> struct RowRank<-1> { static DEV unsigned run(unsigned, int) { return 0u; } };
struct CandTab { unsigned char ij[56]; };
DEV CandTab make_cand_tab() { CandTab t{}; int n = 0; for (int i = 0; i < 16; ++i) for (int j = 0; j < 16 / (i + 1); ++j) t.ij[n++] = (unsigned char)(i * 16 + j); for (; n < 56; ++n) t.ij[n] = 255; return t; }
constexpr int SEL_NT = 4;
constexpr int SEL_RS = 144;
DEV void select_step(const Params& p, int l, int tt0, int tstride, int ntile, int h, unsigned char* lds, const bf16x8 (&kh)[2][4], const bf16x8 (&kl)[2][4]) {
    const int tid = threadIdx.x, lane = tid & 63, w = tid >> 6, g = lane >> 4, c16 = lane & 15;
    constexpr int NTK = SEL_NT * 16;
    constexpr int QRS = 264;
    bf16_t* qh = (bf16_t*)lds;
    bf16_t* ql = qh + NTK * QRS;
    float* sc = (float*)(ql + NTK * QRS);
    float* ts = sc + 2 * NTK * SEL_RS;
    int* ti = (int*)(ts + 2 * NTK * 16);
    unsigned char* ctab = (unsigned char*)(ti + 2 * NTK * 16);
    if (tid == 0) { const CandTab t = make_cand_tab(); for (int n = 0; n < 56; ++n) ctab[n] = t.ij[n]; }
#pragma unroll
    for (int k = 0; k < SEL_NT; ++k) {
        const int tk = tid >> 5, part = tid & 31; const int tok = (tt0 + k * tstride) * 16 + tk;
        f32x4 a = (f32x4){0.f, 0.f, 0.f, 0.f}, b2 = a;
        if (k < ntile && tok < NTOK) { const float* q = p.qry + (size_t)tok * D + h * 256 + part * 8; a = *(const f32x4*)q; b2 = *(const f32x4*)(q + 4); }
        float ss = a[0] * a[0] + a[1] * a[1] + a[2] * a[2] + a[3] * a[3] + b2[0] * b2[0] + b2[1] * b2[1] + b2[2] * b2[2] + b2[3] * b2[3];
        ss += __shfl_xor(ss, 1); ss += __shfl_xor(ss, 2); ss += __shfl_xor(ss, 4); ss += __shfl_xor(ss, 8);
        const float rn = rsqrtf(ss * (1.0f / 128.0f) + EPS);
        const float v[8] = {a[0] * rn, a[1] * rn, a[2] * rn, a[3] * rn, b2[0] * rn, b2[1] * rn, b2[2] * rn, b2[3] * rn};
        unsigned hi[4], lo[4];
#pragma unroll
        for (int j = 0; j < 4; ++j) { hi[j] = pack2(v[2 * j], v[2 * j + 1]); lo[j] = pack2(v[2 * j] - lo16(hi[j]), v[2 * j + 1] - hi16(hi[j])); }
        *(u32x4*)(qh + (k * 16 + tk) * QRS + part * 8) = (u32x4){hi[0], hi[1], hi[2], hi[3]}; *(u32x4*)(ql + (k * 16 + tk) * QRS + part * 8) = (u32x4){lo[0], lo[1], lo[2], lo[3]};
    }
    __syncthreads();
    for (int k = 0; k < ntile; ++k) {
#pragma unroll
        for (int ph = 0; ph < 2; ++ph) {
            f32x4 acc = (f32x4){0.f, 0.f, 0.f, 0.f};
#pragma unroll
            for (int ks = 0; ks < 4; ++ks) {
                const bf16x8 ah = *(const bf16x8*)(qh + (k * 16 + c16) * QRS + ph * 128 + 32 * ks + 8 * g), al = *(const bf16x8*)(ql + (k * 16 + c16) * QRS + ph * 128 + 32 * ks + 8 * g);
                acc = MFMA_BF16(al, kh[ph][ks], acc); acc = MFMA_BF16(ah, kl[ph][ks], acc); acc = MFMA_BF16(ah, kh[ph][ks], acc);
            }
            const int kidx = 16 * w + c16;
#pragma unroll
            for (int r = 0; r < 4; ++r) sc[(ph * NTK + k * 16 + 4 * g + r) * SEL_RS + (kidx >> 5) * 36 + (kidx & 31)] = acc[r];
        }
    }
    __syncthreads();
    {
        const int row = tid >> 2, sub = tid & 3; const bool active = ((row % NTK) >> 4) < ntile;
        unsigned k[32];
#pragma unroll
        for (int i4 = 0; i4 < 8; ++i4) { const f32x4 v = *(const f32x4*)(sc + row * SEL_RS + sub * 36 + 4 * i4); k[4 * i4] = fkey(v[0]); k[4 * i4 + 1] = fkey(v[1]); k[4 * i4 + 2] = fkey(v[2]); k[4 * i4 + 3] = fkey(v[3]); }
        unsigned pos; const unsigned mask = group_top16<4, 32>(k, active, sub, pos);
#pragma unroll
        for (int i = 0; i < 32; ++i) if ((mask >> i) & 1u) { if (pos < 16u) { ts[row * 16 + pos] = fkey_inv(k[i]); ti[row * 16 + pos] = 32 * sub + i; } ++pos; }
    }
    __syncthreads();
    {
        float v4[4]; int i4[4]; unsigned rk[4];
#pragma unroll
        for (int r = 0; r < (2 * NTK) / 32; ++r) { const int row = (tid >> 4) + 32 * r; v4[r] = ts[row * 16 + (tid & 15)]; i4[r] = ti[row * 16 + (tid & 15)]; }
#pragma unroll
        for (int r = 0; r < (2 * NTK) / 32; ++r) rk[r] = RowRank<15>::run(fkey(v4[r]), tid & 15);
        __syncthreads();
#pragma unroll
        for (int r = 0; r < (2 * NTK) / 32; ++r) { const int row = (tid >> 4) + 32 * r; ts[row * 16 + rk[r]] = v4[r]; ti[row * 16 + rk[r]] = i4[r]; }
    }
    __syncthreads();
    {
        const int tk = tid >> 3, sub = tid & 7; const bool active = (tk >> 4) < ntile;
        unsigned k[7]; unsigned cij[7];
#pragma unroll
        for (int q = 0; q < 7; ++q) { cij[q] = ctab[7 * sub + q]; const bool ok = cij[q] != 255u;
            k[q] = ok ? fkey(ts[tk * 16 + (cij[q] >> 4)] + ts[(NTK + tk) * 16 + (cij[q] & 15u)]) : 0u; }
        unsigned pos; const unsigned mask = group_top16<8, 7>(k, active, sub, pos);
        u32x2* lst = (u32x2*)sc;
#pragma unroll
        for (int q = 0; q < 7; ++q) if ((mask >> q) & 1u) { if (pos < 16u) lst[tk * 16 + pos] = (u32x2){__float_as_uint(fkey_inv(k[q])), (unsigned)(ti[tk * 16 + (cij[q] >> 4)] * 128 + ti[(NTK + tk) * 16 + (cij[q] & 15u)])}; ++pos; }
    }
    __syncthreads();
#pragma unroll
    for (int r = 0; r < NTK / 32; ++r) {
        const int tk = (tid >> 4) + 32 * r, slot = tid & 15; const int tok = (tt0 + (tk >> 4) * tstride) * 16 + (tk & 15);
        const u32x2 en = ((const u32x2*)sc)[tk * 16 + slot];
        const float v = __uint_as_float(en.x); const int e = (int)en.y;
        float mx = v; mx = fmaxf(mx, DPP_XOR1(mx)); mx = fmaxf(mx, DPP_XOR2(mx)); mx = fmaxf(mx, DPP_HMIRROR(mx)); mx = fmaxf(mx, DPP_RMIRROR(mx));
        const float ex = __expf(v - mx);
        float sm = ex; sm += DPP_XOR1(sm); sm += DPP_XOR2(sm); sm += DPP_HMIRROR(sm); sm += DPP_RMIRROR(sm);
        if ((tk >> 4) < ntile && tok < NTOK) { const size_t o = (size_t)tok * 128 + h * 16 + slot;
            p.eidx[o] = (unsigned short)e; p.gate[o] = ex / sm; }
    }
    __syncthreads();
}
DEV void phase_select(const Params& p, int l, unsigned char* lds) {
    const int ntt = (NTOK + 15) / 16, lane = threadIdx.x & 63, w = threadIdx.x >> 6, g = lane >> 4, c16 = lane & 15;
    const bool fixed = (gridDim.x % 8u) == 0u;
    const int nq = fixed ? (int)(gridDim.x >> 3) : 1;
    for (int hh = 0; hh < (fixed ? 1 : 8); ++hh) {
        const int h = fixed ? (int)(blockIdx.x & 7) : hh;
        bf16x8 kh[2][4], kl[2][4];
#pragma unroll
        for (int ph = 0; ph < 2; ++ph)
#pragma unroll
            for (int ks = 0; ks < 4; ++ks) { const float* kr = p.peer_keys + ((size_t)((l * 8 + h) * 2 + ph) * 128 + 16 * w + c16) * 128 + 32 * ks + 8 * g;
                const f32x4 a = *(const f32x4*)kr, b2 = *(const f32x4*)(kr + 4); const float v[8] = {a[0], a[1], a[2], a[3], b2[0], b2[1], b2[2], b2[3]};
                u32x4 hi, lo; unsigned hw[4], lw[4];
#pragma unroll
                for (int j = 0; j < 4; ++j) { hw[j] = pack2(v[2 * j], v[2 * j + 1]); lw[j] = pack2(v[2 * j] - lo16(hw[j]), v[2 * j + 1] - hi16(hw[j])); }
                hi = (u32x4){hw[0], hw[1], hw[2], hw[3]}; lo = (u32x4){lw[0], lw[1], lw[2], lw[3]};
                kh[ph][ks] = __builtin_bit_cast(bf16x8, hi); kl[ph][ks] = __builtin_bit_cast(bf16x8, lo); }
        const int first = fixed ? (int)(blockIdx.x >> 3) : (int)blockIdx.x, stride = fixed ? nq : (int)gridDim.x;
        for (int tt0 = first; tt0 < ntt; tt0 += SEL_NT * stride) {
            int ntile = 0;
#pragma unroll
            for (int k = 0; k < SEL_NT; ++k) if (tt0 + k * stride < ntt) ntile = k + 1;
            select_step(p, l, tt0, stride, ntile, h, lds, kh, kl);
        }
    }
}

constexpr int PEER_TB = 272;
struct PeerDeal { int xs_first, xs_step, t_begin, t_end; };
DEV PeerDeal peer_deal() {
    PeerDeal d; const bool sl = (gridDim.x % 8u) == 0u;
    const int nranks = sl ? (int)(gridDim.x >> 3) : (int)gridDim.x, rank = sl ? (int)(blockIdx.x >> 3) : (int)blockIdx.x, tpr = (NTOK + nranks - 1) / nranks;
    d.xs_first = sl ? (int)(blockIdx.x & 7) : 0; d.xs_step = sl ? 8 : 1; d.t_begin = rank * tpr; d.t_end = d.t_begin + tpr < NTOK ? d.t_begin + tpr : NTOK;
    return d;
}
struct PeerTok { u32x4 e0, e1, h[4]; };
DEV void peer_fetch_u(const Params& p, int t, int c0, int g8, PeerTok& k) {
    const u32x4* ep = (const u32x4*)(p.eidx + (size_t)t * 128 + 16 * g8); k.e0 = ep[0]; k.e1 = ep[1];
    const u32x4* hp = (const u32x4*)(p.hB + (size_t)t * D + c0);
#pragma unroll
    for (int i = 0; i < 4; ++i) k.h[i] = hp[i];
}
DEV void phase_peer_u(const Params& p, int l, unsigned char* lds) {
    const int lane = threadIdx.x & 63, w = wave_id(), j8 = lane & 7, g8 = lane >> 3;
    const bool b2 = (j8 & 4) != 0, b1 = (j8 & 2) != 0, b0 = (j8 & 1) != 0;
    const PeerDeal dl = peer_deal();
    const unsigned char* U = p.u8 + (size_t)l * NE * (D / 2);
    for (int xs = dl.xs_first; xs < 8; xs += dl.xs_step) {
        const int c0 = 256 * xs + 32 * j8;
        const unsigned char* Us = U + (size_t)xs * NE * 128; const unsigned joff = 16u * (unsigned)j8;
        PeerTok nx; if (dl.t_begin + w < dl.t_end) peer_fetch_u(p, dl.t_begin + w, c0, g8, nx);
        for (int t = dl.t_begin + w; t < dl.t_end; t += 8) {
            const PeerTok cu = nx;
            const unsigned ew[8] = {cu.e0.x, cu.e0.y, cu.e0.z, cu.e0.w, cu.e1.x, cu.e1.y, cu.e1.z, cu.e1.w}; unsigned ev[16];
#pragma unroll
            for (int i = 0; i < 8; ++i) { ev[2 * i] = ew[i] & 0xffffu; ev[2 * i + 1] = ew[i] >> 16; }
            u32x4 q[16];
#pragma unroll
            for (int i = 0; i < 16; ++i) q[i] = *(const u32x4*)(Us + (ev[i] * 128u + joff));
            if (t + 8 < dl.t_end) peer_fetch_u(p, t + 8, c0, g8, nx);
            const unsigned hw[16] = {cu.h[0].x, cu.h[0].y, cu.h[0].z, cu.h[0].w, cu.h[1].x, cu.h[1].y, cu.h[1].z, cu.h[1].w, cu.h[2].x, cu.h[2].y, cu.h[2].z, cu.h[2].w, cu.h[3].x, cu.h[3].y, cu.h[3].z, cu.h[3].w};
            float ps[16];
#pragma unroll
            for (int i = 0; i < 16; ++i) { unsigned dq[16]; fp4x8_decb(q[i].x, dq); fp4x8_decb(q[i].y, dq + 4); fp4x8_decb(q[i].z, dq + 8); fp4x8_decb(q[i].w, dq + 12);
                float a = 0.f, b = 0.f;
#pragma unroll
                for (int k = 0; k < 8; ++k) { a = dot2bf(dq[2 * k], hw[2 * k], a); b = dot2bf(dq[2 * k + 1], hw[2 * k + 1], b); }
                ps[i] = a + b; }
            float q8[8], q4[4], q2[2];
#pragma unroll
            for (int k = 0; k < 8; ++k) { const float keep = b2 ? ps[8 + k] : ps[k], send = b2 ? ps[k] : ps[8 + k]; q8[k] = keep + DPP_HMIRROR(send); }
#pragma unroll
            for (int k = 0; k < 4; ++k) { const float keep = b1 ? q8[4 + k] : q8[k], send = b1 ? q8[k] : q8[4 + k]; q4[k] = keep + DPP_XOR2(send); }
#pragma unroll
            for (int k = 0; k < 2; ++k) { const float keep = b0 ? q4[2 + k] : q4[k], send = b0 ? q4[k] : q4[2 + k]; q2[k] = keep + DPP_XOR1(send); }
            float* dst = p.part + ((size_t)t * 8 + xs) * 128 + 16 * g8 + 2 * j8; *(f32x2*)dst = (f32x2){q2[0], q2[1]};
        }
    }
}
DEV void phase_peer_c(const Params& p, int l) {
    const size_t n = (size_t)NTOK * 128, gs = (size_t)gridDim.x * 512;
    for (size_t i = (size_t)blockIdx.x * 512 + threadIdx.x; i < n; i += gs) {
        const size_t t = i >> 7; const int pr = (int)(i & 127); float sacc = 0.f;
        const int e = p.eidx[i]; const float su = p.su[l * NE + e], sv = p.sv[l * NE + e], gt = p.gate[i];
#pragma unroll
        for (int x = 0; x < 8; ++x) sacc += p.part[(t * 8 + x) * 128 + pr];
        p.ab16[i] = (bf16_t)f2bf(gelu_erf(sacc * su) * gt * sv);
    }
}
struct PeerTokV { u32x4 e0, e1, a0, a1; u32x2 x1; f32x4 g2; };
DEV void peer_fetch_v(const Params& p, int l, int t, int col, int g8, PeerTokV& k) {
    const u32x4* ep = (const u32x4*)(p.eidx + (size_t)t * 128 + 16 * g8); k.e0 = ep[0]; k.e1 = ep[1];
    const u32x4* ap = (const u32x4*)(p.ab16 + (size_t)t * 128 + 16 * g8); k.a0 = ap[0]; k.a1 = ap[1];
    k.x1 = *(const u32x2*)(p.xa + (size_t)t * D + col); k.g2 = *(const f32x4*)(p.modbuf + (size_t)tok_batch(t) * MODW + l * NMOD + 5 * D + col);
}
DEV void phase_peer_v(const Params& p, int l, unsigned char* lds) {
    const int lane = threadIdx.x & 63, w = wave_id(), j8 = lane & 7, g8 = lane >> 3;
    const bool b3 = (g8 & 1) != 0, b4 = (g8 & 2) != 0, b5 = (g8 & 4) != 0;
    const PeerDeal dl = peer_deal();
    const unsigned char* V = p.v8 + (size_t)l * NE * (D / 2);
    for (int xs = dl.xs_first; xs < 8; xs += dl.xs_step) {
        const int col = 256 * xs + 32 * j8 + (b3 ? 16 : 0) + (b4 ? 8 : 0) + (b5 ? 4 : 0);
        const unsigned char* Vs = V + (size_t)xs * NE * 128; const unsigned joff = 16u * (unsigned)j8;
        PeerTokV nx; if (dl.t_begin + w < dl.t_end) peer_fetch_v(p, l, dl.t_begin + w, col, g8, nx);
        for (int t = dl.t_begin + w; t < dl.t_end; t += 8) {
            const PeerTokV cu = nx;
            const unsigned ew[8] = {cu.e0.x, cu.e0.y, cu.e0.z, cu.e0.w, cu.e1.x, cu.e1.y, cu.e1.z, cu.e1.w}; unsigned ev[16];
#pragma unroll
            for (int i = 0; i < 8; ++i) { ev[2 * i] = ew[i] & 0xffffu; ev[2 * i + 1] = ew[i] >> 16; }
            u32x4 q[16];
#pragma unroll
            for (int i = 0; i < 16; ++i) q[i] = *(const u32x4*)(Vs + (ev[i] * 128u + joff));
            if (t + 8 < dl.t_end) peer_fetch_v(p, l, t + 8, col, g8, nx);
            const unsigned aw[8] = {cu.a0.x, cu.a0.y, cu.a0.z, cu.a0.w, cu.a1.x, cu.a1.y, cu.a1.z, cu.a1.w}; float av[16];
#pragma unroll
            for (int i = 0; i < 8; ++i) { av[2 * i] = lo16(aw[i]); av[2 * i + 1] = hi16(aw[i]); }
            f32x2 acc2[16];
#pragma unroll
            for (int k = 0; k < 16; ++k) acc2[k] = (f32x2){0.f, 0.f};
#pragma unroll
            for (int i = 0; i < 16; ++i) { f32x2 dq[16]; fp4x32_dec2(q[i], dq); const f32x2 a2v = (f32x2){av[i], av[i]};
#pragma unroll
                for (int k = 0; k < 16; ++k) acc2[k] = __builtin_elementwise_fma(a2v, dq[k], acc2[k]); }
            float acc[32];
#pragma unroll
            for (int k = 0; k < 16; ++k) { acc[2 * k] = acc2[k][0]; acc[2 * k + 1] = acc2[k][1]; }
            float q16[16], q8[8], q4[4];
#pragma unroll
            for (int k = 0; k < 16; ++k) { const float keep = b3 ? acc[16 + k] : acc[k], send = b3 ? acc[k] : acc[16 + k]; q16[k] = keep + DPP_XOR8(send); }
#pragma unroll
            for (int k = 0; k < 8; ++k) q8[k] = xsum16(q16[k], q16[8 + k]);
#pragma unroll
            for (int k = 0; k < 4; ++k) q4[k] = xsum32(q8[k], q8[4 + k]);
            const f32x4 x1v = (f32x4){lo16(cu.x1.x), hi16(cu.x1.x), lo16(cu.x1.y), hi16(cu.x1.y)}; f32x4 o;
#pragma unroll
            for (int k = 0; k < 4; ++k) o[k] = x1v[k] + cu.g2[k] * q4[k];
            u32x2 ow; ow.x = pack2(o[0], o[1]); ow.y = pack2(o[2], o[3]); *(u32x2*)(p.xb + (size_t)t * D + col) = ow;
        }
    }
}

constexpr int N_PHASES = 27;
DEV int phase_class(int k) { return k < 2 ? k : (k == 26 ? 14 : 2 + (k - 2) % 12); }
#ifndef HIPEMU
#define XB_TMO      128
#define XB_XCNT(j)  (256  + 64 * (j))
#define XB_XSUB(j)  (1280 + 64 * (j))
#define XB_XGEN(j)  (2304 + 64 * (j))
#define XB_TOP      3328
#define XB_TOPGEN   3392
#define XCD_BAR_WORDS 3456
#define XB_SPIN_CAP (1u << 22)
__device__ __forceinline__ unsigned xb_ld(unsigned* p)              { return __hip_atomic_load(p, __ATOMIC_RELAXED, __HIP_MEMORY_SCOPE_AGENT); }
__device__ __forceinline__ unsigned xb_add(unsigned* p, unsigned v) { return __hip_atomic_fetch_add(p, v, __ATOMIC_RELAXED, __HIP_MEMORY_SCOPE_AGENT); }
__device__ __forceinline__ unsigned xb_xcc_id() { return (unsigned)__builtin_amdgcn_s_getreg((3 << 11) | 20) & 0xFu; }
#define XB_SPIN(cond, bar) do { unsigned _sp = 0; while (cond) { __builtin_amdgcn_s_sleep(1); \
    if ((++_sp & 255u) == 0u) { if (xb_ld(&(bar)[XB_TMO])) break; if (_sp > XB_SPIN_CAP) { atomicAdd(&(bar)[XB_TMO], 1u); break; } } } } while (0)
struct XcdBarrier { unsigned* bar; unsigned x; volatile LAS unsigned* st; };
__device__ __forceinline__ XcdBarrier xcd_barrier_post(unsigned* bar, volatile LAS unsigned* st) {
    XcdBarrier b; b.bar = bar; b.x = xb_xcc_id(); b.st = st;
    if (threadIdx.x == 0) (void)xb_add(&bar[XB_XCNT(b.x)], 1u);
    return b;
}
__device__ __forceinline__ void xcd_barrier_complete(unsigned* bar, unsigned x, unsigned& nloc, unsigned& nx) {
    const unsigned G = gridDim.x * gridDim.y * gridDim.z;
    unsigned sum, cnt, mine, sp = 0u;
    for (;;) {
        sum = 0u; cnt = 0u; mine = 0u;
#pragma unroll
        for (unsigned j = 0; j < 16; ++j) { const unsigned c = xb_ld(&bar[XB_XCNT(j)]); sum += c; cnt += (c > 0u) ? 1u : 0u; mine = (j == x) ? c : mine; }
        if (sum == G) break;
        __builtin_amdgcn_s_sleep(1);
        if ((++sp & 255u) == 0u) { if (xb_ld(&bar[XB_TMO])) break; if (sp > XB_SPIN_CAP) { atomicAdd(&bar[XB_TMO], 1u); break; } }
    }
    nloc = mine > 0u ? mine : 1u; nx = cnt > 0u ? cnt : 1u;
}
__device__ __forceinline__ void xcd_barrier(const XcdBarrier& b) {
    asm volatile("s_waitcnt vmcnt(0)" ::: "memory");
    __syncthreads();
    if (threadIdx.x == 0) {
        unsigned* bar = b.bar;
        __builtin_amdgcn_s_waitcnt(0);
        unsigned nloc = b.st[0], nx = b.st[1];
        if (nloc == 0u) { xcd_barrier_complete(bar, b.x, nloc, nx); b.st[0] = nloc; b.st[1] = nx; }
        const unsigned old = xb_add(&bar[XB_XSUB(b.x)], 1u);
        const unsigned gen = old / nloc;
        if (old + 1u == (gen + 1u) * nloc) {
            __builtin_amdgcn_fence(__ATOMIC_RELEASE, "agent");
            asm volatile("s_waitcnt vmcnt(0)" ::: "memory");
            const unsigned og = xb_add(&bar[XB_TOP], 1u);
            const unsigned tg = og / nx;
            if (og + 1u == (tg + 1u) * nx) xb_add(&bar[XB_TOPGEN], 1u);
            else XB_SPIN(xb_ld(&bar[XB_TOPGEN]) == tg, bar);
            __builtin_amdgcn_fence(__ATOMIC_ACQUIRE, "agent");
            xb_add(&bar[XB_XGEN(b.x)], 1u);
            asm volatile("s_waitcnt vmcnt(0)" ::: "memory");
        } else {
            XB_SPIN(xb_ld(&bar[XB_XGEN(b.x)]) == gen, bar);
            __builtin_amdgcn_fence(__ATOMIC_ACQUIRE, "agent");
            asm volatile("s_waitcnt vmcnt(0)" ::: "memory");
        }
    }
    __syncthreads();
}
#endif

constexpr int LDS_BYTES = 163840;
constexpr int LDS_BARW = LDS_BYTES - 16;

#ifndef PH_MASK
#define PH_MASK 0xFFFFFFFFu
#endif
#ifndef PROBE_DUP
#define PROBE_DUP 0u
#endif
#define DUP_N(k) (1 + (int)((PROBE_DUP >> phase_class(k)) & 1u))
#define PH_BIT(k) ((PH_MASK >> phase_class(k)) & 1u)
#ifdef HIPEMU
static void run_phase(const Params& pp, int ph, unsigned char* lds)
#define GRID_BAR() do {} while (0)
#define IN(k) (ph == (k))
#define GLDS lds
#define LOADP() const Params& p = pp
#else
typedef const __attribute__((address_space(4))) unsigned char* kargp_t;
__device__ __forceinline__ kargp_t karg_ptr() { kargp_t kp = (kargp_t)__builtin_amdgcn_kernarg_segment_ptr(); asm volatile("" : "+s"(kp)); return kp; }
#define LOADP() Params p; __builtin_memcpy(&p, karg_ptr(), sizeof(Params))
#define IN(k) (PH_BIT(k) && ph_lo <= (k) && (k) < ph_hi)
#define GLDS ((LAS unsigned char*)lds_raw)
__global__ void __launch_bounds__(512, 2) mega_fwd(Params p_unused)
#endif
{
#ifndef HIPEMU
    extern __shared__ __attribute__((aligned(16))) unsigned char lds_raw[];
    unsigned char* lds = lds_raw;
    if (threadIdx.x == 0) { *(volatile unsigned*)(lds_raw + LDS_BARW) = 0u; *(volatile unsigned*)(lds_raw + LDS_BARW + 4) = 0u; }
    __syncthreads();
    int ph_lo, ph_hi; XcdBarrier bar;
    { LOADP(); ph_lo = p.ph_lo; ph_hi = p.ph_hi; bar.bar = p.bar; bar.x = 0; bar.st = nullptr; }
    const bool multi = (ph_hi - ph_lo) > 1;
    if (multi) bar = xcd_barrier_post(bar.bar, (volatile LAS unsigned*)(lds_raw + LDS_BARW));
#define GRID_BAR() do { if (multi) xcd_barrier(bar); } while (0)
#endif
    if (IN(0)) { for (int rep = 0; rep < DUP_N(0); ++rep) { LOADP(); phase_convert(p, lds, 0); GRID_BAR(); } }
    if (IN(1)) {
        LOADP();
        pg8::Gemm g{p.csil, p.wt_ada, 256, MODW, D}; pg8::StaticOrder S; S.init(256, MODW, gridDim.x, blockIdx.x);
        pg8::EpiAda E{p.modbuf, p.b_ada, p.b_ada_final};
        pg8::gemm_phase<pg8::EpiAda, pg8::StaticOrder>(GLDS, g, S, E);
    }
    if (IN(1)) { LOADP(); phase_convert(p, lds, 1); GRID_BAR(); }
#define LAYER(l) do { \
        constexpr int base = 2 + 12 * (l); \
        if (IN(base + 0)) { for (int rep = 0; rep < DUP_N(base + 0); ++rep) { LOADP(); phase_norm(p, p.x_prompt, p.x_sample, (l) == 0 ? (const bf16_t*)nullptr : p.xb, p.norm1_g + (l) * D, (l) * NMOD + 0 * D, (l) * NMOD + 1 * D, p.hA, nullptr); GRID_BAR(); } } \
        if (IN(base + 1)) { for (int rep = 0; rep < DUP_N(base + 1); ++rep) { LOADP(); \
            pg8::Gemm g{p.hA, p.wt_in + (size_t)(l) * ZW * D, MPAD, ZW, D}; pg8::StaticOrder S; S.init(MPAD, ZW, gridDim.x, blockIdx.x); \
            pg8::EpiBf16 E{p.z, ZW}; \
            pg8::gemm_phase<pg8::EpiBf16, pg8::StaticOrder>(GLDS, g, S, E); } } \
        if (IN(base + 1)) { LOADP(); phase_tbl_slot(p, (l)); GRID_BAR(); } \
        if (IN(base + 2)) { for (int rep = 0; rep < DUP_N(base + 2); ++rep) { LOADP(); phase_mix1(p, (l), lds); GRID_BAR(); } } \
        if (IN(base + 3)) { for (int rep = 0; rep < DUP_N(base + 3); ++rep) { LOADP(); phase_mix2(p, (l)); GRID_BAR(); } } \
        if (IN(base + 4)) { LOADP(); phase_mix3(p, (l), lds); } \
        if (IN(base + 4)) { LOADP(); \
            pg8::Gemm g{p.pooled, p.wt_pool + (size_t)(l) * 1024 * 256, 4 * MPAD, 1024, 256}; pg8::PoolOrder S{(int)gridDim.x, (int)(gridDim.x - 1 - blockIdx.x)}; \
            pg8::EpiPool E{p.cat, p.pool_b + (l) * PW, p.pool_scale + (l) * PW}; \
            pg8::gemm_phase<pg8::EpiPool, pg8::PoolOrder>(GLDS, g, S, E); \
            GRID_BAR(); } \
        if (IN(base + 5)) { for (int rep = 0; rep < DUP_N(base + 5); ++rep) { LOADP(); \
            pg8::Gemm g{p.cat, p.wt_out + (size_t)(l) * D * D, MBIG, D, D}; pg8::StaticOrder S; S.init(MBIG, D, gridDim.x, blockIdx.x); \
            pg8::EpiResid E{p.x_prompt, p.x_sample, (l) == 0 ? (const bf16_t*)nullptr : p.xb, p.modbuf + (l) * NMOD + 2 * D, p.xa}; \
            pg8::gemm_phase<pg8::EpiResid, pg8::StaticOrder>(GLDS, g, S, E); \
            { SmallResid sf{E.xlo, E.xhi, E.x16, E.gmod, E.out}; small_gemm(p.cat, p.wt_out + (size_t)(l) * D * D, D, lds, sf); } \
            GRID_BAR(); } } \
        if (IN(base + 6)) { for (int rep = 0; rep < DUP_N(base + 6); ++rep) { LOADP(); phase_norm(p, nullptr, nullptr, p.xa, p.norm2_g + (l) * D, (l) * NMOD + 3 * D, (l) * NMOD + 4 * D, p.hB, nullptr); GRID_BAR(); } } \
        if (IN(base + 7)) { for (int rep = 0; rep < DUP_N(base + 7); ++rep) { LOADP(); \
            pg8::Gemm g{p.hB, p.wt_q + (size_t)(l) * D * D, MBIG, D, D}; pg8::StaticOrder S; S.init(MBIG, D, gridDim.x, blockIdx.x); \
            pg8::EpiF32 E{p.qry, D}; \
            pg8::gemm_phase<pg8::EpiF32, pg8::StaticOrder>(GLDS, g, S, E); \
            { SmallF32 sf{p.qry}; small_gemm(p.hB, p.wt_q + (size_t)(l) * D * D, D, lds, sf); } \
            GRID_BAR(); } } \
        if (IN(base + 8)) { for (int rep = 0; rep < DUP_N(base + 8); ++rep) { LOADP(); phase_select(p, (l), lds); GRID_BAR(); } } \
        if (IN(base + 9)) { for (int rep = 0; rep < DUP_N(base + 9); ++rep) { LOADP(); phase_peer_u(p, (l), lds); GRID_BAR(); } } \
        if (IN(base + 10)) { LOADP(); phase_peer_c(p, (l)); GRID_BAR(); } \
        if (IN(base + 11)) { for (int rep = 0; rep < DUP_N(base + 11); ++rep) { LOADP(); phase_peer_v(p, (l), lds); GRID_BAR(); } } \
    } while (0)
    LAYER(0);
    LAYER(1);
    if (IN(26)) { LOADP(); phase_norm(p, nullptr, nullptr, p.xb, p.final_g, 2 * NMOD, 2 * NMOD + D, nullptr, p.out + OFF_Y); }
#undef LAYER
#undef IN
#undef GRID_BAR
#undef GLDS
#undef LOADP
}

struct WsLayout { size_t bar, modbuf, csil, wt_ada, wt_in, wt_out, wt_q, wt_pool, u8, v8, su, sv, iscu, part, hg_oin, hg_ds, hg_gam, hg_qh, hg_sc, hA, hB, z, pooled, cat, xa, xb, qry, eidx, gate, ab16, end; };
static WsLayout ws_layout() {
    WsLayout L; size_t o = 0;
    auto take = [&](size_t bytes) { const size_t r = o; o += (bytes + 255) & ~(size_t)255; return r; };
    L.bar = take(16384);
    L.modbuf = take((size_t)256 * MODW * 4);
    L.csil = take((size_t)256 * D * 2);
    L.wt_ada = take((size_t)MODW * D * 2);
    L.wt_in = take((size_t)2 * ZW * D * 2);
    L.wt_out = take((size_t)2 * D * D * 2);
    L.wt_q = take((size_t)2 * D * D * 2);
    L.wt_pool = take((size_t)2 * 1024 * 256 * 2);
    L.u8 = take((size_t)2 * NE * D);
    L.v8 = take((size_t)2 * NE * D);
    L.su = take((size_t)2 * NE * 4);
    L.sv = take((size_t)2 * NE * 4);
    L.iscu = take((size_t)MPAD * 128 * 4);
    L.part = take((size_t)MPAD * 8 * 128 * 4);
    L.hg_oin = take((size_t)hg::NUNIT * 64 * 128 * 2);
    L.hg_ds = take((size_t)hg::NUNIT * 128 * 128 * 2);
    L.hg_gam = take((size_t)hg::NUNIT * 128 * 4);
    L.hg_qh = take((size_t)NP * 1024 * 2);
    L.hg_sc = take((size_t)hg::NUNIT * 128 * 128 * 2);
    L.hA = take((size_t)MPAD * D * 2);
    L.hB = take((size_t)MPAD * D * 2);
    L.z = take((size_t)MPAD * ZW * 2);
    L.pooled = take((size_t)4 * MPAD * 256 * 2);
    L.cat = take((size_t)MPAD * D * 2);
    L.xa = take((size_t)MPAD * D * 2);
    L.xb = take((size_t)MPAD * D * 2);
    L.qry = take((size_t)MPAD * D * 4);
    L.eidx = take((size_t)MPAD * 128 * 2);
    L.gate = take((size_t)MPAD * 128 * 4);
    L.ab16 = take((size_t)MPAD * 128 * 2);
    L.end = o;
    return L;
}
static void fill_params(Params& p, void* const* d_in, void* d_out, void* d_ws) {
    const float** f = (const float**)&p;
    for (int i = 0; i < 24; ++i) f[i] = (const float*)d_in[i];
    p.out = (float*)d_out;
    const WsLayout L = ws_layout(); unsigned char* w = (unsigned char*)d_ws;
    p.bar = (unsigned*)(w + L.bar); p.modbuf = (float*)(w + L.modbuf); p.csil = (bf16_t*)(w + L.csil); p.wt_ada = (bf16_t*)(w + L.wt_ada); p.wt_in = (bf16_t*)(w + L.wt_in);
    p.wt_out = (bf16_t*)(w + L.wt_out); p.wt_q = (bf16_t*)(w + L.wt_q); p.wt_pool = (bf16_t*)(w + L.wt_pool); p.u8 = w + L.u8; p.v8 = w + L.v8; p.su = (float*)(w + L.su); p.sv = (float*)(w + L.sv); p.iscu = (float*)(w + L.iscu); p.part = (float*)(w + L.part); p.hg_oin = (bf16_t*)(w + L.hg_oin); p.hg_ds = (bf16_t*)(w + L.hg_ds); p.hg_gam = (float*)(w + L.hg_gam); p.hg_qh = (bf16_t*)(w + L.hg_qh); p.hg_sc = (bf16_t*)(w + L.hg_sc);
    p.hA = (bf16_t*)(w + L.hA); p.hB = (bf16_t*)(w + L.hB); p.z = (bf16_t*)(w + L.z); p.pooled = (bf16_t*)(w + L.pooled); p.cat = (bf16_t*)(w + L.cat);
    p.xa = (bf16_t*)(w + L.xa); p.xb = (bf16_t*)(w + L.xb); p.qry = (float*)(w + L.qry); p.eidx = (unsigned short*)(w + L.eidx); p.gate = (float*)(w + L.gate); p.ab16 = (bf16_t*)(w + L.ab16);
}

#ifndef HIPEMU
#ifndef MK_ONE_LAUNCH
#define MK_ONE_LAUNCH 1
#endif
extern "C" void kernel_launch(void* const* d_in, const int* in_sizes, int n_in, void* d_out, int out_size, void* d_ws, size_t ws_size, hipStream_t stream) {
    static int grid = 0;
    if (grid == 0) {
        const WsLayout L = ws_layout();
        if (n_in != 24 || (size_t)out_size != OUT_TOTAL || ws_size < L.end) { fprintf(stderr, "kernel_launch: unexpected shapes (n_in %d, out %d, ws %zu < %zu)\n", n_in, out_size, ws_size, L.end); grid = -1; return; }
        int dev = 0, cus = 0, per_cu = 0;
        hipGetDevice(&dev); hipDeviceGetAttribute(&cus, hipDeviceAttributeMultiprocessorCount, dev);
        if (hipFuncSetAttribute((const void*)mega_fwd, hipFuncAttributeMaxDynamicSharedMemorySize, LDS_BYTES) != hipSuccess) { fprintf(stderr, "kernel_launch: hipFuncSetAttribute failed\n"); grid = -1; return; }
        hipOccupancyMaxActiveBlocksPerMultiprocessor(&per_cu, (const void*)mega_fwd, 512, LDS_BYTES);
        (void)hipGetLastError();
        if (per_cu < 1) fprintf(stderr, "kernel_launch: occupancy query says %d blocks per CU\n", per_cu);
        grid = cus;
    }
    if (grid < 0) return;
    Params p{};
    fill_params(p, d_in, d_out, d_ws);
    hipMemsetAsync(p.bar, 0, 16384, stream);
#if MK_ONE_LAUNCH
    p.ph_lo = 0; p.ph_hi = N_PHASES;
    hipLaunchKernelGGL(mega_fwd, dim3(grid), dim3(512), LDS_BYTES, stream, p);
#else
    for (int ph = 0; ph < N_PHASES; ++ph) { p.ph_lo = ph; p.ph_hi = ph + 1; hipLaunchKernelGGL(mega_fwd, dim3(grid), dim3(512), LDS_BYTES, stream, p); }
#endif
}
#endif
```

```cpp
#ifndef HIPEMU
#include <hip/hip_runtime.h>
#include <cstdio>
#endif
#include <stdint.h>

#ifndef CFG_PB
#define CFG_PB 4
#define CFG_SEQ 2048
#define CFG_DB 128
#endif

#ifdef HIPEMU
#define DEV inline
#define LAS
#define READLANE_I(v, l) emu_readlane((v), (l))
#define READLANE_F(v, l) emu_readlane_f((v), (l))
#define MFMA_BF16(a, b, c) emu_mfma_bf16_16x16x32((a), (b), (c))
#define MFMA_F32(a, b, c) emu_mfma_f32_16x16x4((a), (b), (c))
#define __expf expf
#define __logf logf
#else
#define DEV __device__ __forceinline__
#define LAS __attribute__((address_space(3)))
#define READLANE_I(v, l) __builtin_amdgcn_readlane((v), (l))
#define READLANE_F(v, l) __uint_as_float((unsigned)__builtin_amdgcn_readlane((int)__float_as_uint(v), (l)))
#define MFMA_BF16(a, b, c) __builtin_amdgcn_mfma_f32_16x16x32_bf16((a), (b), (c), 0, 0, 0)
#define MFMA_F32(a, b, c) __builtin_amdgcn_mfma_f32_16x16x4f32((a), (b), (c), 0, 0, 0)
#endif

typedef unsigned short bf16_t;
typedef short bf16x8 __attribute__((ext_vector_type(8)));
typedef float f32x4 __attribute__((ext_vector_type(4)));
typedef unsigned u32x4 __attribute__((ext_vector_type(4)));
typedef unsigned u32x2 __attribute__((ext_vector_type(2)));

namespace cfg {
constexpr int D = 2048, PB = CFG_PB, SEQ = CFG_SEQ, DB = CFG_DB, DSEQ = 4;
constexpr int NP = PB * SEQ, NS = DB * DSEQ, NTOK = NP + NS, MPAD = (NTOK + 255) / 256 * 256;
constexpr int NC = PB + DB;
constexpr int HH = 8, HD = 128, PW = 1024, PBUF = 15, ZW = 5120;
constexpr int NE = 16384;
constexpr int NMOD = 6 * D;
constexpr int MODW = 2 * NMOD + 2 * D;
constexpr float EPS = 1e-6f;
constexpr int NCHAIN = PB * HH;
constexpr size_t OFF_Y = 0;
constexpr size_t OFF_HP = (size_t)NTOK * D;
constexpr size_t OFF_PP = OFF_HP + (size_t)2 * PB * HH * HD * HD;
constexpr size_t OFF_HS = OFF_PP + (size_t)2 * PB * PBUF * PW;
constexpr size_t OFF_PS = OFF_HS + (size_t)2 * DB * HH * HD * HD;
constexpr size_t OUT_TOTAL = OFF_PS + (size_t)2 * DB * PBUF * PW;
}
using namespace cfg;

struct Params {
    const float *x_prompt, *x_sample, *c_prompt, *c_sample, *state_hgrn, *state_pool, *w_ada, *b_ada, *norm1_g, *norm2_g, *w_in, *w_out,
        *lb_logits, *hgrn_norm_g, *pool_w, *pool_b, *pool_scale, *peer_wq, *peer_keys, *peer_u, *peer_v, *final_g, *w_ada_final, *b_ada_final;
    float* out;
    unsigned* bar; float* modbuf; bf16_t* csil; bf16_t* wt_ada; bf16_t* wt_in; bf16_t* wt_out; bf16_t* wt_q; bf16_t* wt_pool;
    unsigned char* u8; unsigned char* v8; float* su; float* sv; float* iscu; float* part; bf16_t* hg_oin; bf16_t* hg_ds; float* hg_gam; bf16_t* hg_qh; bf16_t* hg_sc; bf16_t* hA; bf16_t* hB; bf16_t* z; bf16_t* pooled; bf16_t* cat; bf16_t* xa; bf16_t* xb; float* qry; unsigned short* eidx; float* gate; bf16_t* ab16;
    int ph_lo, ph_hi;
};

DEV float bf2f(unsigned v) { return __uint_as_float(v << 16); }
#ifdef HIPEMU
DEV unsigned f2bf(float f) { unsigned u = __float_as_uint(f); u += 0x7fffu + ((u >> 16) & 1u); return u >> 16; }
DEV unsigned pack2(float lo, float hi) { return f2bf(lo) | (f2bf(hi) << 16); }
#else
typedef float f32x2_t __attribute__((ext_vector_type(2)));
typedef __bf16 bf16x2_t __attribute__((ext_vector_type(2)));
DEV unsigned pack2(float lo, float hi) { const f32x2_t v = {lo, hi}; return __builtin_bit_cast(unsigned, __builtin_convertvector(v, bf16x2_t)); }
DEV unsigned f2bf(float f) { return (unsigned)__builtin_bit_cast(unsigned short, (__bf16)f); }
#endif
DEV float lo16(unsigned w) { return __uint_as_float(w << 16); }
DEV float hi16(unsigned w) { return __uint_as_float(w & 0xffff0000u); }
DEV float wave_sum(float v) { v += __shfl_xor(v, 32); v += __shfl_xor(v, 16); v += __shfl_xor(v, 8); v += __shfl_xor(v, 4); v += __shfl_xor(v, 2); v += __shfl_xor(v, 1); return v; }
DEV float wave_max(float v) { v = fmaxf(v, __shfl_xor(v, 32)); v = fmaxf(v, __shfl_xor(v, 16)); v = fmaxf(v, __shfl_xor(v, 8)); v = fmaxf(v, __shfl_xor(v, 4)); v = fmaxf(v, __shfl_xor(v, 2)); v = fmaxf(v, __shfl_xor(v, 1)); return v; }
DEV float sigmoidf_(float x) { return 1.0f / (1.0f + __expf(-x)); }
DEV float siluf_(float x) { return x / (1.0f + __expf(-x)); }
DEV float gelu_erf(float x) { return 0.5f * x * (1.0f + erff(x * 0.70710678118f)); }
#ifdef HIPEMU
DEV int wave_id() { return (int)(threadIdx.x >> 6); }
#else
DEV int wave_id() { return __builtin_amdgcn_readfirstlane((int)(threadIdx.x >> 6)); }
#endif
DEV int tok_batch(int t) { return t < NP ? t / SEQ : PB + (t - NP) / DSEQ; }


#ifdef HIPEMU
static inline unsigned emu_fp8_enc1(float x) {
    const unsigned sgn = x < 0.f ? 0x80u : 0u; float a = fabsf(x);
    if (!(a == a)) return 0x7fu;
    if (a >= 448.f) return sgn | 0x7eu;
    if (a < 0.015625f) { const int q = (int)rintf(a * 512.f); return sgn | (unsigned)q; }
    int e = (int)floorf(log2f(a)); if (ldexpf(1.f, e) > a) --e; if (ldexpf(1.f, e + 1) <= a) ++e;
    int m = (int)rintf((a / ldexpf(1.f, e) - 1.f) * 8.f); if (m == 8) { m = 0; ++e; }
    if (e > 8) return sgn | 0x7eu;
    return sgn | (unsigned)((e + 7) << 3) | (unsigned)m;
}
static inline float emu_fp8_dec1(unsigned b) { const float sg = (b & 0x80u) ? -1.f : 1.f; const int e = (b >> 3) & 15, m = b & 7; return sg * (e == 0 ? m * 0.001953125f : (1.f + m * 0.125f) * ldexpf(1.f, e - 7)); }
DEV unsigned fp8x4_enc(float a, float b, float c, float d) { return emu_fp8_enc1(a) | (emu_fp8_enc1(b) << 8) | (emu_fp8_enc1(c) << 16) | (emu_fp8_enc1(d) << 24); }
DEV void fp8x4_dec(unsigned w, float* o) { o[0] = emu_fp8_dec1(w & 255u); o[1] = emu_fp8_dec1((w >> 8) & 255u); o[2] = emu_fp8_dec1((w >> 16) & 255u); o[3] = emu_fp8_dec1(w >> 24); }
#define DPP_XOR1(v) __shfl((v), emu_lane() ^ 1)
#define DPP_XOR2(v) __shfl((v), emu_lane() ^ 2)
#define DPP_HMIRROR(v) __shfl((v), (emu_lane() & ~7) | (7 - (emu_lane() & 7)))
#define DPP_XOR8(v) __shfl((v), emu_lane() ^ 8)
#define DPP_RMIRROR(v) __shfl((v), (emu_lane() & ~15) | (15 - (emu_lane() & 15)))
#define WAVE_LDS_SYNC() emu_wbar()
DEV float xsum16(float a, float b) { const bool hi = (emu_lane() & 16) != 0; return (hi ? b : a) + __shfl_xor(hi ? a : b, 16); }
DEV float xsum32(float a, float b) { const bool hi = (emu_lane() & 32) != 0; return (hi ? b : a) + __shfl_xor(hi ? a : b, 32); }
#else
typedef float f32x2v_t __attribute__((ext_vector_type(2)));
DEV unsigned fp8x4_enc(float a, float b, float c, float d) { int r = __builtin_amdgcn_cvt_pk_fp8_f32(a, b, 0, false); r = __builtin_amdgcn_cvt_pk_fp8_f32(c, d, r, true); return (unsigned)r; }
DEV void fp8x4_dec(unsigned w, float* o) { const f32x2v_t lo = __builtin_amdgcn_cvt_pk_f32_fp8((int)w, false), hi = __builtin_amdgcn_cvt_pk_f32_fp8((int)w, true); o[0] = lo[0]; o[1] = lo[1]; o[2] = hi[0]; o[3] = hi[1]; }
template <int CTRL> DEV float dpp_f(float v) { return __uint_as_float((unsigned)__builtin_amdgcn_update_dpp(0, (int)__float_as_uint(v), CTRL, 0xf, 0xf, true)); }
#define DPP_XOR1(v) dpp_f<0xB1>(v)
#define DPP_XOR2(v) dpp_f<0x4E>(v)
#define DPP_HMIRROR(v) dpp_f<0x141>(v)
#define DPP_XOR8(v) dpp_f<0x128>(v)
#define DPP_RMIRROR(v) dpp_f<0x140>(v)
#define WAVE_LDS_SYNC() asm volatile("s_waitcnt lgkmcnt(0)" ::: "memory")
DEV float xsum16(float a, float b) { const u32x2 r = __builtin_amdgcn_permlane16_swap(__float_as_uint(a), __float_as_uint(b), false, false); return __uint_as_float(r[0]) + __uint_as_float(r[1]); }
DEV float xsum32(float a, float b) { const u32x2 r = __builtin_amdgcn_permlane32_swap(__float_as_uint(a), __float_as_uint(b), false, false); return __uint_as_float(r[0]) + __uint_as_float(r[1]); }
#endif
typedef float f32x2 __attribute__((ext_vector_type(2)));
#ifdef HIPEMU
DEV void fp8x4_dec2(unsigned w, f32x2& lo, f32x2& hi) { float o[4]; fp8x4_dec(w, o); lo = (f32x2){o[0], o[1]}; hi = (f32x2){o[2], o[3]}; }
#else
DEV void fp8x4_dec2(unsigned w, f32x2& lo, f32x2& hi) { lo = __builtin_amdgcn_cvt_pk_f32_fp8((int)w, false); hi = __builtin_amdgcn_cvt_pk_f32_fp8((int)w, true); }
#endif
DEV void fp8x16_dec2(u32x4 q, f32x2* o) { fp8x4_dec2(q.x, o[0], o[1]); fp8x4_dec2(q.y, o[2], o[3]); fp8x4_dec2(q.z, o[4], o[5]); fp8x4_dec2(q.w, o[6], o[7]); }
#ifdef HIPEMU
static inline unsigned emu_fp4_enc1(float x) {
    const unsigned sgn = x < 0.f ? 8u : 0u; const float a = fabsf(x);
    const unsigned c = a < 0.25f ? 0u : (a < 0.75f ? 1u : (a < 1.25f ? 2u : (a < 1.75f ? 3u : (a < 2.5f ? 4u : (a < 3.5f ? 5u : (a < 5.0f ? 6u : 7u))))));
    return sgn | c;
}
static inline float emu_fp4_dec1(unsigned n) { const float t[8] = {0.f, 0.5f, 1.f, 1.5f, 2.f, 3.f, 4.f, 6.f}; return ((n & 8u) ? -1.f : 1.f) * t[n & 7u]; }
DEV unsigned fp4x4_enc(float a, float b, float c, float d) { return emu_fp4_enc1(a) | (emu_fp4_enc1(b) << 4) | (emu_fp4_enc1(c) << 8) | (emu_fp4_enc1(d) << 12); }
DEV void fp4x8_dec2(unsigned w, f32x2* o) {
    for (int k = 0; k < 4; ++k) o[k] = (f32x2){emu_fp4_dec1((w >> (8 * k)) & 15u), emu_fp4_dec1((w >> (8 * k + 4)) & 15u)};
}
#else
DEV unsigned fp4x4_enc(float a, float b, float c, float d) { unsigned r = 0u; r = __builtin_amdgcn_cvt_scalef32_pk_fp4_f32(r, a, b, 1.0f, 0); r = __builtin_amdgcn_cvt_scalef32_pk_fp4_f32(r, c, d, 1.0f, 1); return r & 0xffffu; }
DEV void fp4x8_dec2(unsigned w, f32x2* o) {
    o[0] = __builtin_amdgcn_cvt_scalef32_pk_f32_fp4(w, 1.0f, 0); o[1] = __builtin_amdgcn_cvt_scalef32_pk_f32_fp4(w, 1.0f, 1);
    o[2] = __builtin_amdgcn_cvt_scalef32_pk_f32_fp4(w, 1.0f, 2); o[3] = __builtin_amdgcn_cvt_scalef32_pk_f32_fp4(w, 1.0f, 3);
}
#endif
DEV void fp4x32_dec2(u32x4 q, f32x2* o) { fp4x8_dec2(q.x, o); fp4x8_dec2(q.y, o + 4); fp4x8_dec2(q.z, o + 8); fp4x8_dec2(q.w, o + 12); }
#ifdef HIPEMU
DEV void fp4x8_decb(unsigned w, unsigned* o) { for (int k = 0; k < 4; ++k) o[k] = f2bf(emu_fp4_dec1((w >> (8 * k)) & 15u)) | (f2bf(emu_fp4_dec1((w >> (8 * k + 4)) & 15u)) << 16); }
DEV float dot2bf(unsigned a, unsigned b, float c) { return c + lo16(a) * lo16(b) + hi16(a) * hi16(b); }
#else
typedef __bf16 bf16x2v_t __attribute__((ext_vector_type(2)));
DEV void fp4x8_decb(unsigned w, unsigned* o) {
    o[0] = __builtin_bit_cast(unsigned, __builtin_amdgcn_cvt_scalef32_pk_bf16_fp4(w, 1.0f, 0)); o[1] = __builtin_bit_cast(unsigned, __builtin_amdgcn_cvt_scalef32_pk_bf16_fp4(w, 1.0f, 1));
    o[2] = __builtin_bit_cast(unsigned, __builtin_amdgcn_cvt_scalef32_pk_bf16_fp4(w, 1.0f, 2)); o[3] = __builtin_bit_cast(unsigned, __builtin_amdgcn_cvt_scalef32_pk_bf16_fp4(w, 1.0f, 3));
}
DEV float dot2bf(unsigned a, unsigned b, float c) { return __builtin_amdgcn_fdot2_f32_bf16(__builtin_bit_cast(bf16x2v_t, a), __builtin_bit_cast(bf16x2v_t, b), c, false); }
#endif

namespace pg8 {
constexpr int BM = 256, BK = 64, HALF = 128, HTB = HALF * BK * 2, STAGE_BYTES = 8 * HTB, NXCD = 8, WGM = 8;
DEV int lds_byte(int r, int c) { const int st = (r >> 4) * 2 + (c >> 5), rr = r & 15, cc = c & 31, ob = rr * 64 + cc * 2; return st * 1024 + (ob ^ (((ob >> 9) & 1) << 5)); }
DEV void stage_rc(int b, int& R, int& C) { const int st = b / 1024, sb = b % 1024, swz = sb ^ (((sb >> 9) & 1) << 5); R = (st >> 1) * 16 + swz / 64; C = (st & 1) * 32 + (swz % 64) / 2; }
DEV int perm32(int rho) { const int n = rho >> 4, i = rho & 15; return 8 * (i >> 2) + 4 * n + (i & 3); }
struct Unit { int pm, pn; };
struct Gemm { const bf16_t* A; const bf16_t* Bt; int M, N, K; };
struct StaticOrder {
    int nM, nN, nwg, G, c;
    DEV void init(int M, int N, int G_, int c_) { nM = M / BM; nN = N / BM; nwg = nM * nN; G = G_; c = c_; }
    DEV bool next(int i, Unit& u) const {
        const long L = (long)i * G + c; if (L >= nwg) return false;
        int wgid = (int)L; { const int q = nwg / NXCD, r = nwg % NXCD, xcd = wgid % NXCD, off = wgid / NXCD; wgid = (xcd < r ? xcd * (q + 1) : r * (q + 1) + (xcd - r) * q) + off; }
        const int nig = WGM * nN, gid = wgid / nig, fm = gid * WGM, gsz = (nM - fm) < WGM ? (nM - fm) : WGM;
        u.pm = fm + ((wgid % nig) % gsz); u.pn = (wgid % nig) / gsz; return true;
    }
    DEV void a_ready(const Unit&) const {}
    DEV void done(const Unit&) const {}
};
struct PoolOrder {
    int G, c;
    DEV bool next(int i, Unit& u) const { const int L = i * G + c; if (L >= 4 * (MPAD / 256)) return false; u.pm = L; u.pn = L / (MPAD / 256); return true; }
    DEV void a_ready(const Unit&) const {}
    DEV void done(const Unit&) const {}
};

struct EpiF32 {
    static constexpr bool PERM = false;
    float* C; int ldc;
    DEV void operator()(const f32x4 (&acc)[2][2][4][2], const Unit& u, int wr, int wc, int fr, int fq) const {
        const int row0 = u.pm * BM + wr * 64 + fr, col0 = u.pn * BM + wc * 32 + 4 * fq;
#pragma unroll
        for (int ai = 0; ai < 2; ++ai)
#pragma unroll
            for (int m = 0; m < 4; ++m) { float* rowp = C + (size_t)(row0 + ai * HALF + m * 16) * ldc + col0;
#pragma unroll
                for (int bj = 0; bj < 2; ++bj)
#pragma unroll
                    for (int n = 0; n < 2; ++n) *(f32x4*)(rowp + bj * HALF + n * 16) = acc[ai][bj][m][n]; }
    }
};
struct EpiAda {
    static constexpr bool PERM = false;
    float* C; const float* b_ada; const float* b_fin;
    DEV void operator()(const f32x4 (&acc)[2][2][4][2], const Unit& u, int wr, int wc, int fr, int fq) const {
        const int row0 = u.pm * BM + wr * 64 + fr, col0 = u.pn * BM + wc * 32 + 4 * fq;
        const float* bias = (u.pn * BM < 2 * NMOD) ? b_ada + col0 : b_fin + (col0 - 2 * NMOD);
        f32x4 bv[2][2];
#pragma unroll
        for (int bj = 0; bj < 2; ++bj)
#pragma unroll
            for (int n = 0; n < 2; ++n) bv[bj][n] = *(const f32x4*)(bias + bj * HALF + n * 16);
#pragma unroll
        for (int ai = 0; ai < 2; ++ai)
#pragma unroll
            for (int m = 0; m < 4; ++m) { float* rowp = C + (size_t)(row0 + ai * HALF + m * 16) * MODW + col0;
#pragma unroll
                for (int bj = 0; bj < 2; ++bj)
#pragma unroll
                    for (int n = 0; n < 2; ++n) *(f32x4*)(rowp + bj * HALF + n * 16) = acc[ai][bj][m][n] + bv[bj][n]; }
    }
};
struct EpiResid {
    static constexpr bool PERM = false;
    const float* xlo; const float* xhi; const bf16_t* x16; const float* gmod  ; bf16_t* out;
    DEV void operator()(const f32x4 (&acc)[2][2][4][2], const Unit& u, int wr, int wc, int fr, int fq) const {
        const int row0 = u.pm * BM + wr * 64 + fr, col0 = u.pn * BM + wc * 32 + 4 * fq;
#pragma unroll
        for (int ai = 0; ai < 2; ++ai)
#pragma unroll
            for (int m = 0; m < 4; ++m) {
                const int row = row0 + ai * HALF + m * 16;
                if (row < NTOK) {
                    const float* gr = gmod + (size_t)tok_batch(row) * MODW + col0;
                    bf16_t* rowp = out + (size_t)row * D + col0;
#pragma unroll
                    for (int bj = 0; bj < 2; ++bj)
#pragma unroll
                        for (int n = 0; n < 2; ++n) { f32x4 xv;
                            if (x16) { const u32x2 xw = *(const u32x2*)(x16 + (size_t)row * D + col0 + bj * HALF + n * 16); xv = (f32x4){lo16(xw.x), hi16(xw.x), lo16(xw.y), hi16(xw.y)}; }
                            else xv = *(const f32x4*)((row < NP ? xlo + (size_t)row * D : xhi + (size_t)(row - NP) * D) + col0 + bj * HALF + n * 16);
                            const f32x4 gv = *(const f32x4*)(gr + bj * HALF + n * 16), o = xv + gv * acc[ai][bj][m][n];
                            u32x2 ow; ow.x = pack2(o[0], o[1]); ow.y = pack2(o[2], o[3]); *(u32x2*)(rowp + bj * HALF + n * 16) = ow; }
                }
            }
    }
};
struct EpiBf16 {
    static constexpr bool PERM = true;
    bf16_t* O; int ldc;
    DEV void operator()(const f32x4 (&acc)[2][2][4][2], const Unit& u, int wr, int wc, int fr, int fq) const {
        const int row0 = u.pm * BM + wr * 64 + fr, col0 = u.pn * BM + wc * 32 + 8 * fq;
#pragma unroll
        for (int ai = 0; ai < 2; ++ai)
#pragma unroll
            for (int m = 0; m < 4; ++m) { bf16_t* rowp = O + (size_t)(row0 + ai * HALF + m * 16) * ldc + col0;
#pragma unroll
                for (int bj = 0; bj < 2; ++bj) { const f32x4 v0 = acc[ai][bj][m][0], v1 = acc[ai][bj][m][1];
                    u32x4 w; w.x = pack2(v0[0], v0[1]); w.y = pack2(v0[2], v0[3]); w.z = pack2(v1[0], v1[1]); w.w = pack2(v1[2], v1[3]);
                    *(u32x4*)(rowp + bj * HALF) = w; } }
    }
};
struct EpiPool {
    static constexpr bool PERM = true;
    bf16_t* cat; const float* pb; const float* ps;
    DEV void operator()(const f32x4 (&acc)[2][2][4][2], const Unit& u, int wr, int wc, int fr, int fq) const {
        const int g = u.pn, tok0 = u.pm * BM - g * MPAD + wr * 64 + fr, col0 = g * 256 + wc * 32 + 8 * fq;
#pragma unroll
        for (int bj = 0; bj < 2; ++bj) {
            const f32x4 b0 = *(const f32x4*)(pb + col0 + bj * HALF), b1 = *(const f32x4*)(pb + col0 + bj * HALF + 4);
            const f32x4 s0 = *(const f32x4*)(ps + col0 + bj * HALF), s1 = *(const f32x4*)(ps + col0 + bj * HALF + 4);
#pragma unroll
            for (int ai = 0; ai < 2; ++ai)
#pragma unroll
                for (int m = 0; m < 4; ++m) { const int tok = tok0 + ai * HALF + m * 16;
                    if (tok < NTOK) { const f32x4 v0 = (acc[ai][bj][m][0] + b0) * s0, v1 = (acc[ai][bj][m][1] + b1) * s1;
                        u32x4 w; w.x = pack2(v0[0], v0[1]); w.y = pack2(v0[2], v0[3]); w.z = pack2(v1[0], v1[1]); w.w = pack2(v1[2], v1[3]);
                        *(u32x4*)(cat + (size_t)tok * D + 1024 + col0 + bj * HALF) = w; } }
        }
    }
};

#ifdef HIPEMU
template <class Epi, class Sched>
static void gemm_phase(unsigned char*, const Gemm g, const Sched& S, const Epi& E) {
    const int tid = threadIdx.x, wid = tid >> 6, lane = tid & 63, wr = wid >> 2, wc = wid & 3, fr = lane & 15, fq = lane >> 4;
    Unit cur;
    for (int ui = 0; S.next(ui, cur); ++ui) {
        f32x4 acc[2][2][4][2];
        for (int ai = 0; ai < 2; ++ai) for (int bj = 0; bj < 2; ++bj) for (int m = 0; m < 4; ++m) for (int n = 0; n < 2; ++n) for (int j = 0; j < 4; ++j) {
            const int row = 256 * cur.pm + 128 * ai + 64 * wr + 16 * m + fr;
            const int col = Epi::PERM ? 256 * cur.pn + 128 * bj + 32 * wc + 8 * fq + 4 * n + j : 256 * cur.pn + 128 * bj + 32 * wc + 16 * n + 4 * fq + j;
            float s = 0.f;
            if ((row % emu_row_mod) < emu_row_limit) { const float* a = emu_f32_copy(g.A, (size_t)g.M * g.K) + (size_t)row * g.K; const float* b = emu_f32_copy(g.Bt, (size_t)g.N * g.K) + (size_t)col * g.K;
                for (int k = 0; k < g.K; ++k) s += a[k] * b[k]; }
            acc[ai][bj][m][n][j] = s; }
        E(acc, cur, wr, wc, fr, fq);
    }
    __syncthreads();
}
#else
template <class Epi, class Sched>
__device__ __forceinline__ void gemm_phase(LAS unsigned char* lds, const Gemm g, const Sched& S, const Epi& E) {
    const int tid = threadIdx.x, wid = __builtin_amdgcn_readfirstlane(tid >> 6), lane = tid & 63, wr = wid >> 2, wc = wid & 3, fr = lane & 15, fq = lane >> 4;
    int K = g.K; asm volatile("" : "+s"(K));
    const int nt = K / BK;
    unsigned voffA[2], voffB[2];
#pragma unroll
    for (int i = 0; i < 2; ++i) { int R, C; stage_rc(tid * 16 + i * 8192, R, C); const int Rb = Epi::PERM ? ((R & ~31) + perm32(R & 31)) : R;
        voffA[i] = (unsigned)(R * K + C) * 2u; voffB[i] = (unsigned)(Rb * K + C) * 2u; }
    const size_t kstep = (size_t)(BK * 2);
    const size_t hstep = (size_t)HALF * K * 2;
    const size_t tstep = 2 * hstep;
    const unsigned ldsw = (unsigned)wid * 1024u;
    const int aoff = lds_byte(wr * 64 + fr, fq * 8), boff = lds_byte(wc * 32 + fr, fq * 8);
#define PG8_SA(b, h) (((b) * 2 + (h)) * HTB)
#define PG8_SB(b, h) ((4 + (b) * 2 + (h)) * HTB)
#define PG8_STAGE(bufoff, gbase, voff) do { _Pragma("unroll") for (int _i = 0; _i < 2; ++_i) \
        __builtin_amdgcn_global_load_lds((const unsigned*)((const char*)(gbase) + (voff)[_i]), (LAS unsigned*)(lds + (bufoff) + ldsw + _i * 8192), 16, 0, 0); } while (0)
#define PG8_LDA(dst, b, h) do { _Pragma("unroll") for (int m = 0; m < 4; ++m) _Pragma("unroll") for (int k = 0; k < 2; ++k) dst[m][k] = *(const LAS bf16x8*)(lds + PG8_SA(b, h) + aoff + m * 2048 + k * 1024); } while (0)
#define PG8_LDB(dst, b, h) do { _Pragma("unroll") for (int n = 0; n < 2; ++n) _Pragma("unroll") for (int k = 0; k < 2; ++k) dst[n][k] = *(const LAS bf16x8*)(lds + PG8_SB(b, h) + boff + n * 2048 + k * 1024); } while (0)
#define PG8_MMA(ai, bj, At, Bt) do { __builtin_amdgcn_s_setprio(1); _Pragma("unroll") for (int m = 0; m < 4; ++m) _Pragma("unroll") for (int n = 0; n < 2; ++n) _Pragma("unroll") for (int k = 0; k < 2; ++k) \
        acc[ai][bj][m][n] = __builtin_amdgcn_mfma_f32_16x16x32_bf16(Bt[n][k], At[m][k], acc[ai][bj][m][n], 0, 0, 0); __builtin_amdgcn_s_setprio(0); } while (0)
#define PG8_WAIT_V(n) asm volatile("s_waitcnt vmcnt(" #n ")" ::: "memory")
#define PG8_WAIT_L(n) asm volatile("s_waitcnt lgkmcnt(" #n ")" ::: "memory")
#define PG8_BAR __builtin_amdgcn_s_barrier()
#define PG8_SCHED __builtin_amdgcn_sched_barrier(0)
    Unit cur, nxt; int ui = 0;
    if (!S.next(0, cur)) return;
    f32x4 acc[2][2][4][2];
#pragma unroll
    for (int a = 0; a < 2; ++a)
#pragma unroll
        for (int b = 0; b < 2; ++b)
#pragma unroll
            for (int m = 0; m < 4; ++m)
#pragma unroll
                for (int n = 0; n < 2; ++n) acc[a][b][m][n] = (f32x4){0.f, 0.f, 0.f, 0.f};
    bf16x8 At[4][2], B0[2][2], B1[2][2];
    const char* cA = (const char*)g.A + (size_t)cur.pm * tstep; const char* cB = (const char*)g.Bt + (size_t)cur.pn * tstep;
    S.a_ready(cur);
    PG8_STAGE(PG8_SB(0, 0), cB, voffB); PG8_STAGE(PG8_SA(0, 0), cA, voffA); PG8_STAGE(PG8_SB(0, 1), cB + hstep, voffB); PG8_STAGE(PG8_SA(0, 1), cA + hstep, voffA);
    if (wr == 1) PG8_BAR;
    PG8_WAIT_V(4); PG8_BAR;
    PG8_STAGE(PG8_SB(1, 0), cB + kstep, voffB); PG8_STAGE(PG8_SA(1, 0), cA + kstep, voffA); PG8_STAGE(PG8_SB(1, 1), cB + hstep + kstep, voffB);
    PG8_WAIT_V(6); PG8_BAR;
    for (;;) {
        const bool has_next = S.next(ui + 1, nxt);
        const char* nA = has_next ? (const char*)g.A + (size_t)nxt.pm * tstep : cA; const char* nB = has_next ? (const char*)g.Bt + (size_t)nxt.pn * tstep : cB;
        for (int t = 0; t < nt; t += 2) {
            const bool last = (t == nt - 2);
            const char* a1 = cA + (size_t)(t + 1) * kstep;
            const char* a2 = last ? nA : cA + (size_t)(t + 2) * kstep; const char* b2 = last ? nB : cB + (size_t)(t + 2) * kstep;
            const char* a3 = a2 + kstep; const char* b3 = b2 + kstep;
            if (last && has_next) S.a_ready(nxt);
            PG8_LDB(B0, 0, 0); PG8_SCHED; PG8_LDA(At, 0, 0); PG8_STAGE(PG8_SA(1, 1), a1 + hstep, voffA);
            PG8_WAIT_L(8); PG8_BAR; PG8_WAIT_L(0); PG8_MMA(0, 0, At, B0); PG8_BAR; PG8_SCHED;
            PG8_LDB(B1, 0, 1); PG8_STAGE(PG8_SB(0, 0), b2, voffB);
            PG8_BAR; PG8_WAIT_L(0); PG8_MMA(0, 1, At, B1); PG8_BAR;
            PG8_LDA(At, 0, 1); PG8_STAGE(PG8_SA(0, 0), a2, voffA);
            PG8_BAR; PG8_WAIT_L(0); PG8_MMA(1, 0, At, B0); PG8_BAR; PG8_SCHED;
            PG8_STAGE(PG8_SB(0, 1), b2 + hstep, voffB);
            PG8_WAIT_V(6); PG8_BAR; PG8_MMA(1, 1, At, B1); PG8_BAR;
            PG8_LDB(B0, 1, 0); PG8_SCHED; PG8_LDA(At, 1, 0); PG8_STAGE(PG8_SA(0, 1), a2 + hstep, voffA);
            PG8_WAIT_L(8); PG8_BAR; PG8_WAIT_L(0); PG8_MMA(0, 0, At, B0); PG8_BAR; PG8_SCHED;
            PG8_LDB(B1, 1, 1); PG8_STAGE(PG8_SB(1, 0), b3, voffB);
            PG8_BAR; PG8_WAIT_L(0); PG8_MMA(0, 1, At, B1); PG8_BAR;
            PG8_LDA(At, 1, 1); PG8_STAGE(PG8_SA(1, 0), a3, voffA);
            PG8_BAR; PG8_WAIT_L(0); PG8_MMA(1, 0, At, B0); PG8_BAR; PG8_SCHED;
            PG8_STAGE(PG8_SB(1, 1), b3 + hstep, voffB);
            PG8_WAIT_V(6); PG8_BAR; PG8_MMA(1, 1, At, B1); PG8_BAR;
        }
        { int tz = threadIdx.x; asm volatile("" : "+v"(tz)); const int wz = tz >> 6, lz = tz & 63;
          E(acc, cur, wz >> 2, wz & 3, lz & 15, lz >> 4); } S.done(cur);
        if (!has_next) break;
#pragma unroll
        for (int a = 0; a < 2; ++a)
#pragma unroll
            for (int b = 0; b < 2; ++b)
#pragma unroll
                for (int m = 0; m < 4; ++m)
#pragma unroll
                    for (int n = 0; n < 2; ++n) acc[a][b][m][n] = (f32x4){0.f, 0.f, 0.f, 0.f};
        cur = nxt; cA = nA; cB = nB; ++ui;
    }
    PG8_WAIT_V(0);
    if (wr == 0) PG8_BAR;
    PG8_BAR;
#undef PG8_SA
#undef PG8_SB
#undef PG8_STAGE
#undef PG8_LDA
#undef PG8_LDB
#undef PG8_MMA
#undef PG8_WAIT_V
#undef PG8_WAIT_L
#undef PG8_BAR
#undef PG8_SCHED
}
#endif
}

constexpr int MBIG = (NP / 256) * 256;
template <class F> DEV void small_gemm(const bf16_t* A, const bf16_t* Bt, int K, unsigned char* lds, const F& f) {
    const int tid = threadIdx.x, lane = tid & 63, w = tid >> 6, g = lane >> 4, c16 = lane & 15;
    const int tiles_m = (NTOK - MBIG + 63) / 64, ntiles = tiles_m * 32, kw = K / 8;
    float* part = (float*)lds;
    for (int tl = blockIdx.x; tl < ntiles; tl += gridDim.x) {
        const int r0 = MBIG + (tl / 32) * 64, n0 = (tl % 32) * 64;
        f32x4 acc[4][4];
#pragma unroll
        for (int i = 0; i < 4; ++i)
#pragma unroll
            for (int j = 0; j < 4; ++j) acc[i][j] = (f32x4){0.f, 0.f, 0.f, 0.f};
        for (int k0 = w * kw; k0 < (w + 1) * kw; k0 += 128) {
            bf16x8 af[4][4], bfr[4][4];
#pragma unroll
            for (int u = 0; u < 4; ++u)
#pragma unroll
                for (int i = 0; i < 4; ++i) { int arow = r0 + 16 * i + c16; if (arow >= MPAD) arow = MPAD - 1;
                    af[u][i] = *(const bf16x8*)(A + (size_t)arow * K + k0 + 32 * u + 8 * g); bfr[u][i] = *(const bf16x8*)(Bt + (size_t)(n0 + 16 * i + c16) * K + k0 + 32 * u + 8 * g); }
#pragma unroll
            for (int u = 0; u < 4; ++u)
#pragma unroll
                for (int i = 0; i < 4; ++i)
#pragma unroll
                    for (int j = 0; j < 4; ++j) acc[i][j] = MFMA_BF16(af[u][i], bfr[u][j], acc[i][j]);
        }
#pragma unroll
        for (int i = 0; i < 4; ++i)
#pragma unroll
            for (int j = 0; j < 4; ++j)
#pragma unroll
                for (int r = 0; r < 4; ++r) part[(w * 64 + 16 * i + 4 * g + r) * 68 + 16 * j + c16] = acc[i][j][r];
        __syncthreads();
        {
            const int row = tid >> 3, c8 = (tid & 7) * 8; f32x4 s0 = (f32x4){0.f, 0.f, 0.f, 0.f}, s1 = s0;
#pragma unroll
            for (int ww = 0; ww < 8; ++ww) { s0 += *(const f32x4*)(part + (ww * 64 + row) * 68 + c8); s1 += *(const f32x4*)(part + (ww * 64 + row) * 68 + c8 + 4); }
            if (r0 + row < NTOK) f(r0 + row, n0 + c8, s0, s1);
        }
        __syncthreads();
    }
}
struct SmallResid { const float* xlo; const float* xhi; const bf16_t* x16; const float* gmod; bf16_t* out;
    DEV void operator()(int row, int col, f32x4 v0, f32x4 v1) const { const float* gr = gmod + (size_t)tok_batch(row) * MODW + col; f32x4 x0, x1;
        if (x16) { const u32x4 xw = *(const u32x4*)(x16 + (size_t)row * D + col); x0 = (f32x4){lo16(xw.x), hi16(xw.x), lo16(xw.y), hi16(xw.y)}; x1 = (f32x4){lo16(xw.z), hi16(xw.z), lo16(xw.w), hi16(xw.w)}; }
        else { const float* xr = (row < NP ? xlo + (size_t)row * D : xhi + (size_t)(row - NP) * D) + col; x0 = *(const f32x4*)xr; x1 = *(const f32x4*)(xr + 4); }
        const f32x4 o0 = x0 + *(const f32x4*)gr * v0, o1 = x1 + *(const f32x4*)(gr + 4) * v1;
        u32x4 ow; ow.x = pack2(o0[0], o0[1]); ow.y = pack2(o0[2], o0[3]); ow.z = pack2(o1[0], o1[1]); ow.w = pack2(o1[2], o1[3]); *(u32x4*)(out + (size_t)row * D + col) = ow; } };
struct SmallF32 { float* out; DEV void operator()(int row, int col, f32x4 v0, f32x4 v1) const { float* o = out + (size_t)row * D + col; *(f32x4*)o = v0; *(f32x4*)(o + 4) = v1; } };

DEV void transpose_tile(const float* src, int ld_src, bf16_t* dst, int ld_dst, float* tile) {
    const int tid = threadIdx.x;
#pragma unroll
    for (int i = 0; i < 2; ++i) { const int idx = tid + i * 512, r = idx >> 4, c4 = idx & 15; const f32x4 v = *(const f32x4*)(src + (size_t)r * ld_src + c4 * 4);
        float* t = tile + r * 65 + c4 * 4; t[0] = v[0]; t[1] = v[1]; t[2] = v[2]; t[3] = v[3]; }
    __syncthreads();
    const int n = tid >> 3, kg = tid & 7; const float* t = tile + (kg * 8) * 65 + n;
    u32x4 w; w.x = pack2(t[0], t[65]); w.y = pack2(t[2 * 65], t[3 * 65]); w.z = pack2(t[4 * 65], t[5 * 65]); w.w = pack2(t[6 * 65], t[7 * 65]);
    *(u32x4*)(dst + (size_t)n * ld_dst + kg * 8) = w;
    __syncthreads();
}
constexpr int ADA_UNITS = MODW / 128, ADA_RT = (NC + 15) / 16, ADA_AS = 72;
DEV void ada_direct_unit(const Params& p, int unit, unsigned char* lds) {
    const int tid = threadIdx.x, lane = tid & 63, w = wave_id(), rho = lane & 15, gam = lane >> 4;
    const int n0 = unit * 128;
    const float* W; const float* bias; int ldw, cw;
    if (n0 < NMOD) { W = p.w_ada; bias = p.b_ada; ldw = NMOD; cw = n0; }
    else if (n0 < 2 * NMOD) { W = p.w_ada + (size_t)D * NMOD; bias = p.b_ada + NMOD; ldw = NMOD; cw = n0 - NMOD; }
    else { W = p.w_ada_final; bias = p.b_ada_final; ldw = 2 * D; cw = n0 - 2 * NMOD; }
    const float* wl = W + (size_t)(8 * gam) * ldw + cw + 16 * w + rho;
    bf16_t* As = (bf16_t*)lds;
    f32x4 acc[ADA_RT];
#pragma unroll
    for (int rt = 0; rt < ADA_RT; ++rt) acc[rt] = (f32x4){0.f, 0.f, 0.f, 0.f};
    constexpr int NCH = D / 64, ACNT = (16 * ADA_RT * 16 + 511) / 512;
    float wa[16], wb[16]; f32x4 cr[ACNT];
#define ADA_WLOAD(dst, kc_) do { const float* wq_ = wl + (size_t)(64 * (kc_)) * ldw; _Pragma("unroll") for (int s2 = 0; s2 < 2; ++s2) _Pragma("unroll") for (int j = 0; j < 8; ++j) dst[8 * s2 + j] = wq_[(size_t)(32 * s2 + j) * ldw]; } while (0)
#define ADA_CLOAD(kc_) do { _Pragma("unroll") for (int u = 0; u < ACNT; ++u) { const int i = tid + 512 * u, r = i >> 4, k4 = (i & 15) * 4; cr[u] = (f32x4){0.f, 0.f, 0.f, 0.f}; \
        if (r < NC) cr[u] = *(const f32x4*)((r < PB ? p.c_prompt + (size_t)r * D : p.c_sample + (size_t)(r - PB) * D) + 64 * (kc_) + k4); } } while (0)
#define ADA_CHUNK(wreg, kc_) do { bf16_t* Ab = As + ((kc_) & 1) * (16 * ADA_RT * ADA_AS); \
        _Pragma("unroll") for (int u = 0; u < ACNT; ++u) { const int i = tid + 512 * u, r = i >> 4, k4 = (i & 15) * 4; \
            if (i < 16 * ADA_RT * 16) { u32x2 pk; pk.x = pack2(siluf_(cr[u][0]), siluf_(cr[u][1])); pk.y = pack2(siluf_(cr[u][2]), siluf_(cr[u][3])); *(u32x2*)(Ab + r * ADA_AS + k4) = pk; } } \
        if ((kc_) + 1 < NCH) ADA_CLOAD((kc_) + 1); \
        u32x4 bw[2]; _Pragma("unroll") for (int s2 = 0; s2 < 2; ++s2) { bw[s2].x = pack2(wreg[8 * s2], wreg[8 * s2 + 1]); bw[s2].y = pack2(wreg[8 * s2 + 2], wreg[8 * s2 + 3]); bw[s2].z = pack2(wreg[8 * s2 + 4], wreg[8 * s2 + 5]); bw[s2].w = pack2(wreg[8 * s2 + 6], wreg[8 * s2 + 7]); } \
        if ((kc_) + 2 < NCH) ADA_WLOAD(wreg, (kc_) + 2); \
        __syncthreads(); \
        _Pragma("unroll") for (int s2 = 0; s2 < 2; ++s2) { const bf16x8 bf = __builtin_bit_cast(bf16x8, bw[s2]); \
            _Pragma("unroll") for (int rt = 0; rt < ADA_RT; ++rt) { const bf16x8 af = *(const bf16x8*)(Ab + (16 * rt + rho) * ADA_AS + 32 * s2 + 8 * gam); acc[rt] = MFMA_BF16(af, bf, acc[rt]); } } } while (0)
    ADA_WLOAD(wa, 0); ADA_WLOAD(wb, 1); ADA_CLOAD(0);
    for (int kc = 0; kc < NCH; kc += 2) { ADA_CHUNK(wa, kc); ADA_CHUNK(wb, kc + 1); }
#undef ADA_WLOAD
#undef ADA_CLOAD
#undef ADA_CHUNK
    const float bv = bias[cw + 16 * w + rho];
#pragma unroll
    for (int rt = 0; rt < ADA_RT; ++rt)
#pragma unroll
        for (int r = 0; r < 4; ++r) { const int row = 16 * rt + 4 * gam + r; if (row < NC) p.modbuf[(size_t)row * MODW + n0 + 16 * w + rho] = acc[rt][r] + bv; }
    __syncthreads();
}
DEV int cvt_job_tiles(int j) { const int K = j < 9 ? 2048 : 256; const int N = j < 2 ? NMOD : (j == 2 ? 2 * D : (j < 5 ? ZW : (j < 9 ? D : 256))); return (K / 64) * (N / 64); }
constexpr int TBL_SLOT = 10240, TBL_VP1 = 4 * NE - 2 * TBL_SLOT;
DEV int gemm_in_idle_blocks() { const int nwg = (MPAD / 256) * (ZW / 256), G = (int)gridDim.x, rounds = (nwg + G - 1) / G, full = nwg - (rounds - 1) * G; return G - full; }
DEV bool tbl_deferred() { return gemm_in_idle_blocks() >= 32; }
DEV void table_row_to_fp8(const Params& p, int vr, int lane) {
    const int l = vr / (2 * NE), which = (vr % (2 * NE)) / NE, e = vr % NE, rr = l * NE + e;
    const float* src = (which ? p.peer_v : p.peer_u) + (size_t)rr * D;
    f32x4 v[8]; float am = 0.f;
#pragma unroll
    for (int k = 0; k < 8; ++k) { v[k] = *(const f32x4*)(src + 4 * lane + 256 * k); am = fmaxf(am, fmaxf(fmaxf(fabsf(v[k][0]), fabsf(v[k][1])), fmaxf(fabsf(v[k][2]), fabsf(v[k][3])))); }
    am = wave_max(am);
    unsigned char* tab = (which ? p.v8 : p.u8) + (size_t)l * NE * (D / 2);
    const float sc = am > 0.f ? 6.0f / am : 1.0f;
#pragma unroll
    for (int k = 0; k < 8; ++k) *(unsigned short*)(tab + ((size_t)k * NE + e) * 128 + 2 * lane) = (unsigned short)fp4x4_enc(v[k][0] * sc, v[k][1] * sc, v[k][2] * sc, v[k][3] * sc);
    if (lane == 0) (which ? p.sv : p.su)[rr] = am > 0.f ? am * (1.0f / 6.0f) : 1.0f;
}
DEV void phase_tbl_slot(const Params& p, int l) {
    const int idle = gemm_in_idle_blocks(), first = (int)gridDim.x - idle;
    if (idle < 32 || (int)blockIdx.x < first) return;
    const int gw = ((int)blockIdx.x - first) * 8 + wave_id(), nw = idle * 8, lo = TBL_VP1 + l * TBL_SLOT;
    for (int vr = lo + gw; vr < lo + TBL_SLOT; vr += nw) table_row_to_fp8(p, vr, threadIdx.x & 63);
}
DEV void phase_convert(const Params& p, unsigned char* lds, int part) {
    float* tile = (float*)lds;
    const int tid = threadIdx.x;
    const int q_lo = part == 0 ? 0 : 3, q_hi = part == 0 ? 3 : 17;
    int total = 0;
#pragma unroll
    for (int q = 0; q < 17; ++q) if (q >= q_lo && q < q_hi) total += cvt_job_tiles(q);
    for (int tl = blockIdx.x; tl < total; tl += gridDim.x) {
        int j = 0, loc = 0, base = 0;
#pragma unroll
        for (int q = 0; q < 17; ++q) if (q >= q_lo && q < q_hi) { const int cnt = cvt_job_tiles(q); if (tl >= base && tl < base + cnt) { j = q; loc = tl - base; } base += cnt; }
        const float* src; bf16_t* dst; int K = 2048, N;
        if (j < 2) { N = NMOD; src = p.w_ada + (size_t)j * 2048 * NMOD; dst = p.wt_ada + (size_t)j * NMOD * 2048; }
        else if (j == 2) { N = 2 * D; src = p.w_ada_final; dst = p.wt_ada + (size_t)2 * NMOD * 2048; }
        else if (j < 5) { N = ZW; src = p.w_in + (size_t)(j - 3) * 2048 * ZW; dst = p.wt_in + (size_t)(j - 3) * ZW * 2048; }
        else if (j < 7) { N = D; src = p.w_out + (size_t)(j - 5) * D * D; dst = p.wt_out + (size_t)(j - 5) * D * D; }
        else if (j < 9) { N = D; src = p.peer_wq + (size_t)(j - 7) * D * D; dst = p.wt_q + (size_t)(j - 7) * D * D; }
        else { K = 256; N = 256; src = p.pool_w + (size_t)(j - 9) * 65536; dst = p.wt_pool + (size_t)(j - 9) * 65536; }
        const int ntn = N / 64, kt = loc / ntn, nt = loc % ntn;
        transpose_tile(src + (size_t)kt * 64 * N + nt * 64, N, dst + (size_t)nt * 64 * K + kt * 64, K, tile);
    }
    const size_t gt = (size_t)blockIdx.x * 512 + tid, gs = (size_t)gridDim.x * 512;
    if (part == 1) {
        constexpr int NADA = ADA_UNITS;
        const int vend = tbl_deferred() ? TBL_VP1 : 4 * NE, R1 = vend - 2048;
        const bool uneven = (int)gridDim.x > NADA + 16;
        for (int seg = 0; seg < 2; ++seg) {
            int gw, nw, r_lo, r_hi;
            if (!uneven) { if (seg) break; gw = blockIdx.x * 8 + wave_id(); nw = gridDim.x * 8; r_lo = 0; r_hi = vend; }
            else if (seg == 0) { gw = blockIdx.x * 8 + wave_id(); nw = gridDim.x * 8; r_lo = 0; r_hi = R1; }
            else { if ((int)blockIdx.x < NADA) break; gw = ((int)blockIdx.x - NADA) * 8 + wave_id(); nw = ((int)gridDim.x - NADA) * 8; r_lo = R1; r_hi = vend; }
            for (int vr = r_lo + gw; vr < r_hi; vr += nw) table_row_to_fp8(p, vr, tid & 63);
        }
    }
    if (part == 0) for (size_t i = gt; i < (size_t)256 * D / 8; i += gs) {
        const int row = (int)(i / (D / 8)), c8 = (int)(i % (D / 8)) * 8; u32x4 w = (u32x4){0u, 0u, 0u, 0u};
        if (row < NC) { const float* s = (row < PB ? p.c_prompt + (size_t)row * D : p.c_sample + (size_t)(row - PB) * D) + c8;
            const f32x4 a = *(const f32x4*)s, b = *(const f32x4*)(s + 4);
            w.x = pack2(siluf_(a[0]), siluf_(a[1])); w.y = pack2(siluf_(a[2]), siluf_(a[3])); w.z = pack2(siluf_(b[0]), siluf_(b[1])); w.w = pack2(siluf_(b[2]), siluf_(b[3])); }
        *(u32x4*)(p.csil + i * 8) = w;
    }
}

DEV void phase_norm(const Params& p, const float* xlo, const float* xhi, const bf16_t* x16, const float* gn, int sh_off, int sc_off, bf16_t* obf, float* of32) {
    const int lane = threadIdx.x & 63, gw = blockIdx.x * 8 + wave_id(), nw = gridDim.x * 8;
    for (int t = gw; t < NTOK; t += nw) {
        const float* xr = x16 ? nullptr : (t < NP ? xlo + (size_t)t * D : xhi + (size_t)(t - NP) * D);
        const float* mrow = p.modbuf + (size_t)tok_batch(t) * MODW;
        f32x4 v[8]; float ss = 0.f;
#pragma unroll
        for (int c = 0; c < 4; ++c) { const int col = c * 512 + lane * 8;
            if (x16) { const u32x4 xw = *(const u32x4*)(x16 + (size_t)t * D + col); v[2 * c] = (f32x4){lo16(xw.x), hi16(xw.x), lo16(xw.y), hi16(xw.y)}; v[2 * c + 1] = (f32x4){lo16(xw.z), hi16(xw.z), lo16(xw.w), hi16(xw.w)}; }
            else { v[2 * c] = *(const f32x4*)(xr + col); v[2 * c + 1] = *(const f32x4*)(xr + col + 4); }
#pragma unroll
            for (int j = 0; j < 4; ++j) ss += v[2 * c][j] * v[2 * c][j] + v[2 * c + 1][j] * v[2 * c + 1][j]; }
        ss = wave_sum(ss);
        const float rstd = rsqrtf(ss * (1.0f / D) + EPS);
#pragma unroll
        for (int c = 0; c < 4; ++c) { const int col = c * 512 + lane * 8; f32x4 y[2];
#pragma unroll
            for (int q = 0; q < 2; ++q) { const f32x4 g4 = *(const f32x4*)(gn + col + 4 * q), sc = *(const f32x4*)(mrow + sc_off + col + 4 * q), sh = *(const f32x4*)(mrow + sh_off + col + 4 * q);
                y[q] = (v[2 * c + q] * rstd) * g4 * (sc + 1.0f) + sh; }
            if (obf) { u32x4 w; w.x = pack2(y[0][0], y[0][1]); w.y = pack2(y[0][2], y[0][3]); w.z = pack2(y[1][0], y[1][1]); w.w = pack2(y[1][2], y[1][3]); *(u32x4*)(obf + (size_t)t * D + col) = w; }
            else { *(f32x4*)(of32 + (size_t)t * D + col) = y[0]; *(f32x4*)(of32 + (size_t)t * D + col + 4) = y[1]; }
        }
    }
}

namespace hg {
constexpr int QS = 136, VS = 72;
constexpr int O_QT = 0, O_QH = O_QT + 64 * QS * 2, O_KT = O_QH + 64 * QS * 2, O_KDT = O_KT + 160 * QS * 2, O_VT = O_KDT + 128 * VS * 2,
              O_AB = O_VT + 128 * VS * 2, O_GS = O_AB + 64 * VS * 2, O_END = O_GS + 4 * 128 * 4;
constexpr int OS = 132;
static_assert(O_END <= 163840 - 64, "HGRN LDS layout too large");
constexpr int NCHUNK = SEQ / 64, NUNIT = PB * HH * NCHUNK;
}
DEV int kt_rowbase(int i) { return i == 0 ? 0 : (i == 1 ? 16 : (i == 2 ? 48 : 96)); }

DEV void hgrn_pre_unit(const Params& p, int l, int unit, unsigned char* lds) {
    using namespace hg;
    const int tid = threadIdx.x, lane = tid & 63, w = tid >> 6, g = lane >> 4, c16 = lane & 15;
    const int c = unit % NCHUNK, bh = unit / NCHUNK, b = bh / HH, h = bh % HH;
    bf16_t* Qt = (bf16_t*)(lds + O_QT); bf16_t* Qh = (bf16_t*)(lds + O_QH); bf16_t* Kt = (bf16_t*)(lds + O_KT);
    bf16_t* Kdt = (bf16_t*)(lds + O_KDT); bf16_t* Vt = (bf16_t*)(lds + O_VT); bf16_t* Ab = (bf16_t*)(lds + O_AB); float* Gs = (float*)(lds + O_GS);
    const int kk = tid & 127, sj = tid >> 7;
    float lbv = 0.f;
    if (l > 0) lbv = sigmoidf_(p.lb_logits[HH * HD + h * HD + kk] - p.lb_logits[h * HD + kk]);
    const float oml = 1.0f - lbv;
    for (int i = tid; i < 64 * VS / 2; i += 512) ((unsigned*)Ab)[i] = 0u;
    const size_t row0 = (size_t)b * SEQ + c * 64;
    float Gl[16], qv[16], kv[16];
    {
        const bf16_t* zr = p.z + (row0 + sj * 16) * ZW + h * HD + kk;
        unsigned short zq16[16], zf16[16], zi16[16];
#pragma unroll
        for (int s = 0; s < 16; ++s) { zq16[s] = zr[(size_t)s * ZW]; zf16[s] = zr[(size_t)s * ZW + 1024]; zi16[s] = zr[(size_t)s * ZW + 2048]; }
        float run = 0.f; unsigned vpk[8];
#pragma unroll
        for (int s = 0; s < 16; ++s) {
            const float zq = bf2f(zq16[s]), zf = fminf(fmaxf(bf2f(zf16[s]), -80.f), 80.f);
            const float e = __expf(-zf), sg = 1.0f / (1.0f + e);
            const float f = lbv + oml * sg;
            run += __logf(f); Gl[s] = run;
            kv[s] = oml * (e * sg);
            qv[s] = siluf_(zq);
            if (s & 1) vpk[s >> 1] |= (unsigned)zi16[s] << 16; else vpk[s >> 1] = zi16[s];
        }
        Gs[sj * 128 + kk] = run;
        *(u32x4*)(Vt + kk * VS + sj * 16) = (u32x4){vpk[0], vpk[1], vpk[2], vpk[3]}; *(u32x4*)(Vt + kk * VS + sj * 16 + 8) = (u32x4){vpk[4], vpk[5], vpk[6], vpk[7]};
    }
    __syncthreads();
    float Gend;
    {
        const float g0 = Gs[kk], g1 = Gs[128 + kk], g2 = Gs[256 + kk], g3 = Gs[384 + kk];
        float Gb[4]; Gb[0] = 0.f; Gb[1] = g0; Gb[2] = g0 + g1; Gb[3] = g0 + g1 + g2; Gend = Gb[3] + g3;
        const float Gbj = sj == 0 ? Gb[0] : (sj == 1 ? Gb[1] : (sj == 2 ? Gb[2] : Gb[3]));
        const float eGb = __expf(Gbj);
        unsigned kd[8]; unsigned qh[8];
#pragma unroll
        for (int s = 0; s < 16; ++s) {
            const int t = sj * 16 + s;
            const float q1 = qv[s] * __expf(Gl[s]);
            Qt[t * QS + kk] = (bf16_t)f2bf(q1);
            const unsigned qhv = f2bf(q1 * eGb);
            Qh[t * QS + kk] = (bf16_t)qhv;
#pragma unroll
            for (int i = 0; i < 4; ++i) if (i >= sj) Kt[(kt_rowbase(i) + t) * QS + kk] = (bf16_t)f2bf(kv[s] * __expf(fminf(Gb[i] - Gbj - Gl[s], 60.f)));
            const unsigned kdv = f2bf(kv[s] * __expf(Gend - Gbj - Gl[s]));
            if (s & 1) kd[s >> 1] |= kdv << 16; else kd[s >> 1] = kdv;
        }
        *(u32x4*)(Kdt + kk * VS + sj * 16) = (u32x4){kd[0], kd[1], kd[2], kd[3]}; *(u32x4*)(Kdt + kk * VS + sj * 16 + 8) = (u32x4){kd[4], kd[5], kd[6], kd[7]};
        if (sj == 0) p.hg_gam[(size_t)unit * HD + kk] = __expf(Gend);
    }
    __syncthreads();
    {
        const int t = tid >> 3, part = tid & 7;
        const u32x4 a = *(const u32x4*)(Qh + t * QS + 16 * part), b2 = *(const u32x4*)(Qh + t * QS + 16 * part + 8);
        bf16_t* dst = p.hg_qh + (row0 + t) * 1024 + h * HD + 16 * part; *(u32x4*)dst = a; *(u32x4*)(dst + 8) = b2;
    }
    for (int blk = w; blk < 10; blk += 8) {
        int bi, bjj;
        if (blk == 0) { bi = 0; bjj = 0; } else if (blk < 3) { bi = 1; bjj = blk - 1; } else if (blk < 6) { bi = 2; bjj = blk - 3; } else { bi = 3; bjj = blk - 6; }
        f32x4 acc = (f32x4){0.f, 0.f, 0.f, 0.f};
#pragma unroll
        for (int ks = 0; ks < 4; ++ks) {
            const bf16x8 a = *(const bf16x8*)(Qt + (16 * bi + c16) * QS + 32 * ks + 8 * g);
            const bf16x8 bb = *(const bf16x8*)(Kt + (kt_rowbase(bi) + 16 * bjj + c16) * QS + 32 * ks + 8 * g);
            acc = MFMA_BF16(a, bb, acc);
        }
#pragma unroll
        for (int r = 0; r < 4; ++r) { const int tl = 4 * g + r; float v = acc[r]; if (bi == bjj && c16 > tl) v = 0.f; Ab[(16 * bi + tl) * VS + 16 * bjj + c16] = (bf16_t)f2bf(v); }
    }
    __syncthreads();
    {
        u32x2* oin = (u32x2*)(p.hg_oin + (size_t)unit * 64 * 128);
#pragma unroll
        for (int tt = 0; tt < 4; ++tt) {
            f32x4 acc = (f32x4){0.f, 0.f, 0.f, 0.f};
#pragma unroll
            for (int ks = 0; ks < 2; ++ks) {
                const bf16x8 a = *(const bf16x8*)(Ab + (16 * tt + c16) * VS + 32 * ks + 8 * g);
                const bf16x8 bb = *(const bf16x8*)(Vt + (16 * w + c16) * VS + 32 * ks + 8 * g);
                acc = MFMA_BF16(a, bb, acc);
            }
            oin[(tt * 8 + w) * 64 + lane] = (u32x2){pack2(acc[0], acc[1]), pack2(acc[2], acc[3])};
        }
        u32x2* ds = (u32x2*)(p.hg_ds + (size_t)unit * 128 * 128);
#pragma unroll
        for (int vt = 0; vt < 8; ++vt) {
            f32x4 acc = (f32x4){0.f, 0.f, 0.f, 0.f};
#pragma unroll
            for (int ks = 0; ks < 2; ++ks) {
                const bf16x8 a = *(const bf16x8*)(Kdt + (16 * w + c16) * VS + 32 * ks + 8 * g);
                const bf16x8 bb = *(const bf16x8*)(Vt + (16 * vt + c16) * VS + 32 * ks + 8 * g);
                acc = MFMA_BF16(a, bb, acc);
            }
            ds[(w * 8 + vt) * 64 + lane] = (u32x2){pack2(acc[0], acc[1]), pack2(acc[2], acc[3])};
        }
    }
    __syncthreads();
}

DEV void hgrn_scan_unit(const Params& p, int l, int su) {
    using namespace hg;
    const int tid = threadIdx.x, lane = tid & 63, w = tid >> 6, g = lane >> 4, c16 = lane & 15;
    const int vt = su % 8, bh = su / 8, b = bh / HH, h = bh % HH;
    f32x4 S = (f32x4){0.f, 0.f, 0.f, 0.f};
    constexpr int CB = NCHUNK < 16 ? NCHUNK : 16;
    static_assert(NCHUNK % CB == 0, "chunk batch");
    for (int c0 = 0; c0 < NCHUNK; c0 += CB) {
        u32x2 dw[CB]; f32x4 gm[CB];
#pragma unroll
        for (int i = 0; i < CB; ++i) { const size_t unit = (size_t)bh * NCHUNK + c0 + i;
            dw[i] = ((const u32x2*)(p.hg_ds + unit * 128 * 128))[(w * 8 + vt) * 64 + lane]; gm[i] = *(const f32x4*)(p.hg_gam + unit * HD + 16 * w + 4 * g); }
#pragma unroll
        for (int i = 0; i < CB; ++i) { const size_t unit = (size_t)bh * NCHUNK + c0 + i;
            u32x2 sw; sw.x = pack2(S[0], S[1]); sw.y = pack2(S[2], S[3]);
            *(u32x2*)(p.hg_sc + (unit * 128 + 16 * vt + c16) * 128 + 16 * w + 4 * g) = sw;
            const f32x4 d = (f32x4){lo16(dw[i].x), hi16(dw[i].x), lo16(dw[i].y), hi16(dw[i].y)};
            S = S * gm[i] + d; }
    }
    float* so = p.out + OFF_HP + ((size_t)(l * PB + b) * HH + h) * HD * HD;
#pragma unroll
    for (int r = 0; r < 4; ++r) so[(size_t)(16 * w + 4 * g + r) * HD + 16 * vt + c16] = S[r];
}

DEV void hgrn_post_unit(const Params& p, int l, int unit, unsigned char* lds) {
    using namespace hg;
    const int tid = threadIdx.x, lane = tid & 63, w = tid >> 6, g = lane >> 4, c16 = lane & 15;
    const int c = unit % NCHUNK, bh = unit / NCHUNK, b = bh / HH, h = bh % HH;
    float* Ob = (float*)lds;
    const size_t row0 = (size_t)b * SEQ + c * 64;
    const u32x2* oin = (const u32x2*)(p.hg_oin + (size_t)unit * 64 * 128);
    u32x2 ow[4];
#pragma unroll
    for (int tt = 0; tt < 4; ++tt) ow[tt] = oin[(tt * 8 + w) * 64 + lane];
    bf16x8 bfr[4], af[4][4];
    if (c > 0) {
#pragma unroll
        for (int ks = 0; ks < 4; ++ks) bfr[ks] = *(const bf16x8*)(p.hg_sc + ((size_t)unit * 128 + 16 * w + c16) * 128 + 32 * ks + 8 * g);
#pragma unroll
        for (int tt = 0; tt < 4; ++tt)
#pragma unroll
            for (int ks = 0; ks < 4; ++ks) af[tt][ks] = *(const bf16x8*)(p.hg_qh + (row0 + 16 * tt + c16) * 1024 + h * HD + 32 * ks + 8 * g);
    }
    const bf16_t* zgp = p.z + (row0 + (tid >> 3)) * ZW + 3072 + h * HD + 16 * (tid & 7);
    const u32x4 za = *(const u32x4*)zgp, zc = *(const u32x4*)(zgp + 8);
    f32x4 acc[4];
#pragma unroll
    for (int tt = 0; tt < 4; ++tt) acc[tt] = (f32x4){lo16(ow[tt].x), hi16(ow[tt].x), lo16(ow[tt].y), hi16(ow[tt].y)};
    if (c > 0) {
#pragma unroll
        for (int tt = 0; tt < 4; ++tt)
#pragma unroll
            for (int ks = 0; ks < 4; ++ks) acc[tt] = MFMA_BF16(af[tt][ks], bfr[ks], acc[tt]);
    }
#pragma unroll
    for (int tt = 0; tt < 4; ++tt)
#pragma unroll
        for (int r = 0; r < 4; ++r) Ob[(16 * tt + 4 * g + r) * OS + 16 * w + c16] = acc[tt][r];
    __syncthreads();
    {
        const int t = tid >> 3, part = tid & 7; const size_t row = row0 + t;
        float ov[16]; float ss = 0.f;
#pragma unroll
        for (int q = 0; q < 4; ++q) { const f32x4 x = *(const f32x4*)(Ob + t * OS + 16 * part + 4 * q); ov[4 * q] = x[0]; ov[4 * q + 1] = x[1]; ov[4 * q + 2] = x[2]; ov[4 * q + 3] = x[3];
            ss += x[0] * x[0] + x[1] * x[1] + x[2] * x[2] + x[3] * x[3]; }
        ss += __shfl_xor(ss, 1); ss += __shfl_xor(ss, 2); ss += __shfl_xor(ss, 4);
        const float rstd = rsqrtf(ss * (1.0f / HD) + EPS);
        const unsigned zw[8] = {za.x, za.y, za.z, za.w, zc.x, zc.y, zc.z, zc.w};
        const float* gn = p.hgrn_norm_g + l * HD + 16 * part;
        unsigned ow[8];
#pragma unroll
        for (int q = 0; q < 8; ++q) { const float a0 = ov[2 * q] * rstd * gn[2 * q] * siluf_(lo16(zw[q])), a1 = ov[2 * q + 1] * rstd * gn[2 * q + 1] * siluf_(hi16(zw[q])); ow[q] = pack2(a0, a1); }
        bf16_t* dst = p.cat + row * D + h * HD + 16 * part;
        *(u32x4*)dst = (u32x4){ow[0], ow[1], ow[2], ow[3]}; *(u32x4*)(dst + 8) = (u32x4){ow[4], ow[5], ow[6], ow[7]};
    }
    __syncthreads();
}

DEV void hgrn_sample_unit(const Params& p, int l, int unit, unsigned char* lds) {
    const int tid = threadIdx.x, lane = tid & 63, w = tid >> 6;
    const int b = unit / HH, h = unit % HH;
    float* fS = (float*)lds; float* kS = fS + 512; float* qS = kS + 512; float* vS = qS + 512; float* red = vS + 512; float* part = red + 4 * 4 * 128;
    const int r0 = NP + b * DSEQ;
    {
        const int t = tid >> 7, kk = tid & 127; const bf16_t* zr = p.z + (size_t)(r0 + t) * ZW + h * HD + kk;
        float lbv = 0.f; if (l > 0) lbv = sigmoidf_(p.lb_logits[HH * HD + h * HD + kk] - p.lb_logits[h * HD + kk]);
        const float zq = bf2f(zr[0]), zf = fminf(fmaxf(bf2f(zr[1024]), -80.f), 80.f), zi = bf2f(zr[2048]);
        const float e = __expf(-zf), sg = 1.0f / (1.0f + e);
        fS[tid] = lbv + (1.0f - lbv) * sg; kS[tid] = (1.0f - lbv) * (e * sg); qS[tid] = siluf_(zq); vS[tid] = zi;
    }
    const int v = tid & 127, kq = tid >> 7;
    const float* s0 = p.state_hgrn + ((size_t)(l * DB + b) * HH + h) * HD * HD + (size_t)(32 * kq) * HD + v;
    float S[32];
#pragma unroll
    for (int i = 0; i < 32; ++i) S[i] = s0[(size_t)i * HD];
    __syncthreads();
#pragma unroll
    for (int t = 0; t < 4; ++t) {
        const float vv = vS[t * 128 + v]; float po = 0.f;
#pragma unroll
        for (int i = 0; i < 32; ++i) { const int kk = t * 128 + 32 * kq + i; S[i] = fS[kk] * S[i] + kS[kk] * vv; po += qS[kk] * S[i]; }
        red[(t * 4 + kq) * 128 + v] = po;
    }
    float* so = p.out + OFF_HS + ((size_t)(l * DB + b) * HH + h) * HD * HD + (size_t)(32 * kq) * HD + v;
#pragma unroll
    for (int i = 0; i < 32; ++i) so[(size_t)i * HD] = S[i];
    __syncthreads();
    {
        const int t = tid >> 7; const float o = red[(t * 4 + 0) * 128 + v] + red[(t * 4 + 1) * 128 + v] + red[(t * 4 + 2) * 128 + v] + red[(t * 4 + 3) * 128 + v];
        const float ss = wave_sum(o * o);
        if (lane == 0) part[w] = ss;
        __syncthreads();
        const float tot = part[2 * t] + part[2 * t + 1];
        const float rstd = rsqrtf(tot * (1.0f / HD) + EPS);
        const float zg = bf2f(p.z[(size_t)(r0 + t) * ZW + 3072 + h * HD + v]);
        p.cat[(size_t)(r0 + t) * D + h * HD + v] = (bf16_t)f2bf(o * rstd * p.hgrn_norm_g[l * HD + v] * siluf_(zg));
    }
    __syncthreads();
}

DEV void pool_pre_unit(const Params& p, int l, int unit) {
    const int tid = threadIdx.x, tk = tid >> 7, cg = tid & 127, c = cg * 8, gi = cg >> 5, wnd = 2 << gi;
    const int r = unit * 4 + tk;
    if (r >= NTOK) return;
    f32x2 sum[4] = {{0.f, 0.f}, {0.f, 0.f}, {0.f, 0.f}, {0.f, 0.f}}; float cur[8];
    float cnt;
    if (r < NP) {
        const int t = r % SEQ; const int n = (wnd < t + 1) ? wnd : (t + 1); cnt = (float)n;
        u32x4 q[16];
#pragma unroll
        for (int j = 0; j < 16; ++j) q[j] = (j < n) ? *(const u32x4*)(p.z + (size_t)(r - j) * ZW + 4096 + c) : (u32x4){0u, 0u, 0u, 0u};
#pragma unroll
        for (int j = 0; j < 16; ++j) { sum[0] += (f32x2){lo16(q[j].x), hi16(q[j].x)}; sum[1] += (f32x2){lo16(q[j].y), hi16(q[j].y)}; sum[2] += (f32x2){lo16(q[j].z), hi16(q[j].z)}; sum[3] += (f32x2){lo16(q[j].w), hi16(q[j].w)}; }
        cur[0] = lo16(q[0].x); cur[1] = hi16(q[0].x); cur[2] = lo16(q[0].y); cur[3] = hi16(q[0].y); cur[4] = lo16(q[0].z); cur[5] = hi16(q[0].z); cur[6] = lo16(q[0].w); cur[7] = hi16(q[0].w);
        if (t >= SEQ - PBUF) { float* o = p.out + OFF_PP + ((size_t)(l * PB + r / SEQ) * PBUF + (t - (SEQ - PBUF))) * PW + c;
            *(f32x4*)o = (f32x4){cur[0], cur[1], cur[2], cur[3]}; *(f32x4*)(o + 4) = (f32x4){cur[4], cur[5], cur[6], cur[7]}; }
    } else {
        const int bb = (r - NP) / DSEQ, t = (r - NP) % DSEQ; cnt = (float)wnd;
        const float* sp = p.state_pool + (size_t)(l * DB + bb) * PBUF * PW + c;
        u32x4 q[4]; f32x4 sa[15], sb[15];
#pragma unroll
        for (int j = 0; j < 4; ++j) q[j] = (j <= t && j < wnd) ? *(const u32x4*)(p.z + (size_t)(NP + bb * DSEQ + t - j) * ZW + 4096 + c) : (u32x4){0u, 0u, 0u, 0u};
#pragma unroll
        for (int j = 1; j < 16; ++j) {
            const int back = j - t;
            const bool use = (back >= 1) && (j < wnd);
            const float* srow = sp + (size_t)(PBUF - (use ? back : 1)) * PW;
            sa[j - 1] = use ? *(const f32x4*)srow : (f32x4){0.f, 0.f, 0.f, 0.f}; sb[j - 1] = use ? *(const f32x4*)(srow + 4) : (f32x4){0.f, 0.f, 0.f, 0.f};
        }
#pragma unroll
        for (int j = 0; j < 4; ++j) { sum[0] += (f32x2){lo16(q[j].x), hi16(q[j].x)}; sum[1] += (f32x2){lo16(q[j].y), hi16(q[j].y)}; sum[2] += (f32x2){lo16(q[j].z), hi16(q[j].z)}; sum[3] += (f32x2){lo16(q[j].w), hi16(q[j].w)}; }
#pragma unroll
        for (int j = 0; j < 15; ++j) { sum[0] += (f32x2){sa[j][0], sa[j][1]}; sum[1] += (f32x2){sa[j][2], sa[j][3]}; sum[2] += (f32x2){sb[j][0], sb[j][1]}; sum[3] += (f32x2){sb[j][2], sb[j][3]}; }
        cur[0] = lo16(q[0].x); cur[1] = hi16(q[0].x); cur[2] = lo16(q[0].y); cur[3] = hi16(q[0].y); cur[4] = lo16(q[0].z); cur[5] = hi16(q[0].z); cur[6] = lo16(q[0].w); cur[7] = hi16(q[0].w);
        float* ob = p.out + OFF_PS + (size_t)(l * DB + bb) * PBUF * PW + c;
        { float* o = ob + (size_t)(11 + t) * PW; *(f32x4*)o = (f32x4){cur[0], cur[1], cur[2], cur[3]}; *(f32x4*)(o + 4) = (f32x4){cur[4], cur[5], cur[6], cur[7]}; }
        for (int i = t; i < 11; i += 4) { const float* s2 = sp + (size_t)(4 + i) * PW; float* o = ob + (size_t)i * PW; *(f32x4*)o = *(const f32x4*)s2; *(f32x4*)(o + 4) = *(const f32x4*)(s2 + 4); }
    }
    const float inv = 1.0f / cnt;
    u32x4 w; w.x = pack2(sum[0][0] * inv - cur[0], sum[0][1] * inv - cur[1]); w.y = pack2(sum[1][0] * inv - cur[2], sum[1][1] * inv - cur[3]);
    w.z = pack2(sum[2][0] * inv - cur[4], sum[2][1] * inv - cur[5]); w.w = pack2(sum[3][0] * inv - cur[6], sum[3][1] * inv - cur[7]);
    *(u32x4*)(p.pooled + ((size_t)gi * MPAD + r) * 256 + (c & 255)) = w;
}

#ifndef PROBE_SUB
#define PROBE_SUB 0
#endif
DEV void phase_mix1(const Params& p, int l, unsigned char* lds) {
    for (int rep = 0; rep < (PROBE_SUB == 1 ? 2 : 1); ++rep) for (int u = blockIdx.x; u < hg::NUNIT; u += gridDim.x) hgrn_pre_unit(p, l, u, lds);
    for (int rep = 0; rep < (PROBE_SUB == 2 ? 2 : 1); ++rep) for (int u = blockIdx.x; u < DB * HH; u += gridDim.x) hgrn_sample_unit(p, l, u, lds);
    for (int rep = 0; rep < (PROBE_SUB == 3 ? 2 : 1); ++rep) for (int u = blockIdx.x; u < (NTOK + 3) / 4; u += gridDim.x) pool_pre_unit(p, l, u);
}
DEV void phase_mix2(const Params& p, int l) { for (int u = blockIdx.x; u < PB * HH * 8; u += gridDim.x) hgrn_scan_unit(p, l, u); }
DEV void phase_mix3(const Params& p, int l, unsigned char* lds) { for (int u = blockIdx.x; u < hg::NUNIT; u += gridDim.x) hgrn_post_unit(p, l, u, lds); }

#ifdef HIPEMU
#define MBCNT(mask) __builtin_popcountll((mask) & ((1ull << emu_lane()) - 1ull))
#define POPC64(m) __builtin_popcountll(m)
#else
#define MBCNT(mask) ((int)__builtin_amdgcn_mbcnt_hi((unsigned)((mask) >> 32), __builtin_amdgcn_mbcnt_lo((unsigned)(mask), 0u)))
#define POPC64(m) __popcll(m)
#endif
DEV unsigned fkey(float f) { const unsigned u = __float_as_uint(f); return u ^ ((unsigned)((int)u >> 31) | 0x80000000u); }
DEV unsigned long long lowest_n_bits(unsigned long long m, int n) { unsigned long long r = 0ull; while (n > 0 && m) { const unsigned long long b = m & (~m + 1ull); r |= b; m ^= b; --n; } return r; }
#ifdef HIPEMU
#define DPPU_XOR1(v) __shfl((v), emu_lane() ^ 1)
#define DPPU_XOR2(v) __shfl((v), emu_lane() ^ 2)
#define DPPU_HMIRROR(v) __shfl((v), (emu_lane() & ~7) | (7 - (emu_lane() & 7)))
#else
template <int CTRL> DEV unsigned dpp_u(unsigned v) { return (unsigned)__builtin_amdgcn_update_dpp(0, (int)v, CTRL, 0xf, 0xf, true); }
#define DPPU_XOR1(v) dpp_u<0xB1>(v)
#define DPPU_XOR2(v) dpp_u<0x4E>(v)
#define DPPU_HMIRROR(v) dpp_u<0x141>(v)
#endif
template <int GL> DEV unsigned group_sum(unsigned c) { c += DPPU_XOR1(c); c += DPPU_XOR2(c); if (GL == 8) c += DPPU_HMIRROR(c); return c; }
template <int GL> DEV unsigned group_or(unsigned c) { c |= DPPU_XOR1(c); c |= DPPU_XOR2(c); if (GL == 8) c |= DPPU_HMIRROR(c); return c; }
template <int GL> DEV float group_maxf(float v) { v = fmaxf(v, DPP_XOR1(v)); v = fmaxf(v, DPP_XOR2(v)); if (GL == 8) v = fmaxf(v, DPP_HMIRROR(v)); return v; }
template <int GL> DEV float group_sumf(float v) { v += DPP_XOR1(v); v += DPP_XOR2(v); if (GL == 8) v += DPP_HMIRROR(v); return v; }
DEV unsigned bytesum(unsigned w) { return (w * 0x01010101u) >> 24; }
template <int GL> DEV unsigned group_excl_prefix(unsigned c, int sub) {
    const unsigned sh = 8u * (unsigned)(sub & 3);
    unsigned wlo = (GL == 4 || sub < 4) ? (c << sh) : 0u, whi = (GL == 8 && sub >= 4) ? (c << sh) : 0u;
    wlo = group_or<GL>(wlo);
    unsigned r;
    if (GL == 4) r = bytesum(wlo & ((1u << sh) - 1u));
    else { whi = group_or<GL>(whi); r = sub < 4 ? bytesum(wlo & ((1u << sh) - 1u)) : bytesum(wlo) + bytesum(whi & ((1u << sh) - 1u)); }
    return r;
}
DEV float fkey_inv(unsigned k) { return __uint_as_float((k & 0x80000000u) ? (k ^ 0x80000000u) : ~k); }
template <int NK> DEV unsigned count_above(const unsigned (&k)[NK], unsigned t) {
    unsigned c[4] = {0u, 0u, 0u, 0u};
#pragma unroll
    for (int i = 0; i < NK; ++i) c[i & 3] += (k[i] > t) ? 1u : 0u;
    return (c[0] + c[1]) + (c[2] + c[3]);
}
template <int GL, int NK> DEV unsigned group_top16(const unsigned (&k)[NK], bool active, int sub, unsigned& pos0) {
    unsigned mxk = 0u;
#pragma unroll
    for (int i = 0; i < NK; ++i) mxk = k[i] > mxk ? k[i] : mxk;
    { unsigned o = DPPU_XOR1(mxk); mxk = o > mxk ? o : mxk; o = DPPU_XOR2(mxk); mxk = o > mxk ? o : mxk; if (GL == 8) { o = DPPU_HMIRROR(mxk); mxk = o > mxk ? o : mxk; } }
    unsigned L0 = mxk > 0x01000000u ? mxk - 0x01000000u : 0u, c0 = group_sum<GL>(count_above<NK>(k, L0));
    unsigned L = c0 > 16u ? L0 + 1u : 0u, R = active ? mxk : 0u, cR = 0u;
    if (!active) L = 0u;
    if (c0 == 16u && active) { L = L0; R = L0; cR = 16u; }
    for (;;) {
        if (__ballot(L < R) == 0ull) break;
        const unsigned mid = L + ((R - L) >> 1);
        const unsigned c = group_sum<GL>(count_above<NK>(k, mid));
        const bool le = c <= 16u, hit = c == 16u;
        R = le ? mid : R; cR = le ? c : cR; L = hit ? mid : (le ? L : mid + 1u);
    }
    unsigned mask = 0u;
#pragma unroll
    for (int i = 0; i < NK; ++i) mask |= (k[i] > R) ? (1u << i) : 0u;
    const unsigned need = 16u - cR;
    if (__ballot(active && need > 0u) != 0ull) {
        unsigned eqm = 0u;
#pragma unroll
        for (int i = 0; i < NK; ++i) eqm |= (k[i] == R) ? (1u << i) : 0u;
        const unsigned eqc = (unsigned)__builtin_popcount(eqm), before = group_excl_prefix<GL>(eqc, sub);
        unsigned take = need > before ? need - before : 0u; if (take > eqc) take = eqc;
        if (!active) take = 0u;
        while (take > 0u) { const unsigned b = eqm & (~eqm + 1u); mask |= b; eqm ^= b; --take; }
    }
    if (!active) mask = 0u;
    pos0 = group_excl_prefix<GL>((unsigned)__builtin_popcount(mask), sub);
    return mask;
}
#ifdef HIPEMU
template <int J> DEV unsigned row_bcast_u(unsigned v) { return __shfl(v, (emu_lane() & ~15) | J); }
#else
template <int J> DEV unsigned row_bcast_u(unsigned v) { return (unsigned)__builtin_amdgcn_update_dpp(0, (int)v, 0x150 + J, 0xf, 0xf, true); }
#endif
template <int J> struct RowRank { static DEV unsigned run(unsigned v, int l16) { const unsigned b = row_bcast_u<J>(v); return (((b > v) || (b == v && J < l16)) ? 1u : 0u) + RowRank<J - 1>::run(v, l16); } };
template <> struct RowRank<-1> { static DEV unsigned run(unsigned, int) { return 0u; } };
struct CandTab { unsigned char ij[56]; };
DEV CandTab make_cand_tab() { CandTab t{}; int n = 0; for (int i = 0; i < 16; ++i) for (int j = 0; j < 16 / (i + 1); ++j) t.ij[n++] = (unsigned char)(i * 16 + j); for (; n < 56; ++n) t.ij[n] = 255; return t; }
constexpr int SEL_NT = 4;
constexpr int SEL_RS = 144;
DEV void select_step(const Params& p, int l, int tt0, int tstride, int ntile, int h, unsigned char* lds, const bf16x8 (&kh)[2][4], const bf16x8 (&kl)[2][4]) {
    const int tid = threadIdx.x, lane = tid & 63, w = tid >> 6, g = lane >> 4, c16 = lane & 15;
    constexpr int NTK = SEL_NT * 16;
    constexpr int QRS = 264;
    bf16_t* qh = (bf16_t*)lds;
    bf16_t* ql = qh + NTK * QRS;
    float* sc = (float*)(ql + NTK * QRS);
    float* ts = sc + 2 * NTK * SEL_RS;
    int* ti = (int*)(ts + 2 * NTK * 16);
    unsigned char* ctab = (unsigned char*)(ti + 2 * NTK * 16);
    if (tid == 0) { const CandTab t = make_cand_tab(); for (int n = 0; n < 56; ++n) ctab[n] = t.ij[n]; }
#pragma unroll
    for (int k = 0; k < SEL_NT; ++k) {
        const int tk = tid >> 5, part = tid & 31; const int tok = (tt0 + k * tstride) * 16 + tk;
        f32x4 a = (f32x4){0.f, 0.f, 0.f, 0.f}, b2 = a;
        if (k < ntile && tok < NTOK) { const float* q = p.qry + (size_t)tok * D + h * 256 + part * 8; a = *(const f32x4*)q; b2 = *(const f32x4*)(q + 4); }
        float ss = a[0] * a[0] + a[1] * a[1] + a[2] * a[2] + a[3] * a[3] + b2[0] * b2[0] + b2[1] * b2[1] + b2[2] * b2[2] + b2[3] * b2[3];
        ss += __shfl_xor(ss, 1); ss += __shfl_xor(ss, 2); ss += __shfl_xor(ss, 4); ss += __shfl_xor(ss, 8);
        const float rn = rsqrtf(ss * (1.0f / 128.0f) + EPS);
        const float v[8] = {a[0] * rn, a[1] * rn, a[2] * rn, a[3] * rn, b2[0] * rn, b2[1] * rn, b2[2] * rn, b2[3] * rn};
        unsigned hi[4], lo[4];
#pragma unroll
        for (int j = 0; j < 4; ++j) { hi[j] = pack2(v[2 * j], v[2 * j + 1]); lo[j] = pack2(v[2 * j] - lo16(hi[j]), v[2 * j + 1] - hi16(hi[j])); }
        *(u32x4*)(qh + (k * 16 + tk) * QRS + part * 8) = (u32x4){hi[0], hi[1], hi[2], hi[3]}; *(u32x4*)(ql + (k * 16 + tk) * QRS + part * 8) = (u32x4){lo[0], lo[1], lo[2], lo[3]};
    }
    __syncthreads();
    for (int k = 0; k < ntile; ++k) {
#pragma unroll
        for (int ph = 0; ph < 2; ++ph) {
            f32x4 acc = (f32x4){0.f, 0.f, 0.f, 0.f};
#pragma unroll
            for (int ks = 0; ks < 4; ++ks) {
                const bf16x8 ah = *(const bf16x8*)(qh + (k * 16 + c16) * QRS + ph * 128 + 32 * ks + 8 * g), al = *(const bf16x8*)(ql + (k * 16 + c16) * QRS + ph * 128 + 32 * ks + 8 * g);
                acc = MFMA_BF16(al, kh[ph][ks], acc); acc = MFMA_BF16(ah, kl[ph][ks], acc); acc = MFMA_BF16(ah, kh[ph][ks], acc);
            }
            const int kidx = 16 * w + c16;
#pragma unroll
            for (int r = 0; r < 4; ++r) sc[(ph * NTK + k * 16 + 4 * g + r) * SEL_RS + (kidx >> 5) * 36 + (kidx & 31)] = acc[r];
        }
    }
    __syncthreads();
    {
        const int row = tid >> 2, sub = tid & 3; const bool active = ((row % NTK) >> 4) < ntile;
        unsigned k[32];
#pragma unroll
        for (int i4 = 0; i4 < 8; ++i4) { const f32x4 v = *(const f32x4*)(sc + row * SEL_RS + sub * 36 + 4 * i4); k[4 * i4] = fkey(v[0]); k[4 * i4 + 1] = fkey(v[1]); k[4 * i4 + 2] = fkey(v[2]); k[4 * i4 + 3] = fkey(v[3]); }
        unsigned pos; const unsigned mask = group_top16<4, 32>(k, active, sub, pos);
#pragma unroll
        for (int i = 0; i < 32; ++i) if ((mask >> i) & 1u) { if (pos < 16u) { ts[row * 16 + pos] = fkey_inv(k[i]); ti[row * 16 + pos] = 32 * sub + i; } ++pos; }
    }
    __syncthreads();
    {
        float v4[4]; int i4[4]; unsigned rk[4];
#pragma unroll
        for (int r = 0; r < (2 * NTK) / 32; ++r) { const int row = (tid >> 4) + 32 * r; v4[r] = ts[row * 16 + (tid & 15)]; i4[r] = ti[row * 16 + (tid & 15)]; }
#pragma unroll
        for (int r = 0; r < (2 * NTK) / 32; ++r) rk[r] = RowRank<15>::run(fkey(v4[r]), tid & 15);
        __syncthreads();
#pragma unroll
        for (int r = 0; r < (2 * NTK) / 32; ++r) { const int row = (tid >> 4) + 32 * r; ts[row * 16 + rk[r]] = v4[r]; ti[row * 16 + rk[r]] = i4[r]; }
    }
    __syncthreads();
    {
        const int tk = tid >> 3, sub = tid & 7; const bool active = (tk >> 4) < ntile;
        unsigned k[7]; unsigned cij[7];
#pragma unroll
        for (int q = 0; q < 7; ++q) { cij[q] = ctab[7 * sub + q]; const bool ok = cij[q] != 255u;
            k[q] = ok ? fkey(ts[tk * 16 + (cij[q] >> 4)] + ts[(NTK + tk) * 16 + (cij[q] & 15u)]) : 0u; }
        unsigned pos; const unsigned mask = group_top16<8, 7>(k, active, sub, pos);
        u32x2* lst = (u32x2*)sc;
#pragma unroll
        for (int q = 0; q < 7; ++q) if ((mask >> q) & 1u) { if (pos < 16u) lst[tk * 16 + pos] = (u32x2){__float_as_uint(fkey_inv(k[q])), (unsigned)(ti[tk * 16 + (cij[q] >> 4)] * 128 + ti[(NTK + tk) * 16 + (cij[q] & 15u)])}; ++pos; }
    }
    __syncthreads();
#pragma unroll
    for (int r = 0; r < NTK / 32; ++r) {
        const int tk = (tid >> 4) + 32 * r, slot = tid & 15; const int tok = (tt0 + (tk >> 4) * tstride) * 16 + (tk & 15);
        const u32x2 en = ((const u32x2*)sc)[tk * 16 + slot];
        const float v = __uint_as_float(en.x); const int e = (int)en.y;
        float mx = v; mx = fmaxf(mx, DPP_XOR1(mx)); mx = fmaxf(mx, DPP_XOR2(mx)); mx = fmaxf(mx, DPP_HMIRROR(mx)); mx = fmaxf(mx, DPP_RMIRROR(mx));
        const float ex = __expf(v - mx);
        float sm = ex; sm += DPP_XOR1(sm); sm += DPP_XOR2(sm); sm += DPP_HMIRROR(sm); sm += DPP_RMIRROR(sm);
        if ((tk >> 4) < ntile && tok < NTOK) { const size_t o = (size_t)tok * 128 + h * 16 + slot;
            p.eidx[o] = (unsigned short)e; p.gate[o] = ex / sm; }
    }
    __syncthreads();
}
DEV void phase_select(const Params& p, int l, unsigned char* lds) {
    const int ntt = (NTOK + 15) / 16, lane = threadIdx.x & 63, w = threadIdx.x >> 6, g = lane >> 4, c16 = lane & 15;
    const bool fixed = (gridDim.x % 8u) == 0u;
    const int nq = fixed ? (int)(gridDim.x >> 3) : 1;
    for (int hh = 0; hh < (fixed ? 1 : 8); ++hh) {
        const int h = fixed ? (int)(blockIdx.x & 7) : hh;
        bf16x8 kh[2][4], kl[2][4];
#pragma unroll
        for (int ph = 0; ph < 2; ++ph)
#pragma unroll
            for (int ks = 0; ks < 4; ++ks) { const float* kr = p.peer_keys + ((size_t)((l * 8 + h) * 2 + ph) * 128 + 16 * w + c16) * 128 + 32 * ks + 8 * g;
                const f32x4 a = *(const f32x4*)kr, b2 = *(const f32x4*)(kr + 4); const float v[8] = {a[0], a[1], a[2], a[3], b2[0], b2[1], b2[2], b2[3]};
                u32x4 hi, lo; unsigned hw[4], lw[4];
#pragma unroll
                for (int j = 0; j < 4; ++j) { hw[j] = pack2(v[2 * j], v[2 * j + 1]); lw[j] = pack2(v[2 * j] - lo16(hw[j]), v[2 * j + 1] - hi16(hw[j])); }
                hi = (u32x4){hw[0], hw[1], hw[2], hw[3]}; lo = (u32x4){lw[0], lw[1], lw[2], lw[3]};
                kh[ph][ks] = __builtin_bit_cast(bf16x8, hi); kl[ph][ks] = __builtin_bit_cast(bf16x8, lo); }
        const int first = fixed ? (int)(blockIdx.x >> 3) : (int)blockIdx.x, stride = fixed ? nq : (int)gridDim.x;
        for (int tt0 = first; tt0 < ntt; tt0 += SEL_NT * stride) {
            int ntile = 0;
#pragma unroll
            for (int k = 0; k < SEL_NT; ++k) if (tt0 + k * stride < ntt) ntile = k + 1;
            select_step(p, l, tt0, stride, ntile, h, lds, kh, kl);
        }
    }
}

constexpr int PEER_TB = 272;
struct PeerDeal { int xs_first, xs_step, t_begin, t_end; };
DEV PeerDeal peer_deal() {
    PeerDeal d; const bool sl = (gridDim.x % 8u) == 0u;
    const int nranks = sl ? (int)(gridDim.x >> 3) : (int)gridDim.x, rank = sl ? (int)(blockIdx.x >> 3) : (int)blockIdx.x, tpr = (NTOK + nranks - 1) / nranks;
    d.xs_first = sl ? (int)(blockIdx.x & 7) : 0; d.xs_step = sl ? 8 : 1; d.t_begin = rank * tpr; d.t_end = d.t_begin + tpr < NTOK ? d.t_begin + tpr : NTOK;
    return d;
}
struct PeerTok { u32x4 e0, e1, h[4]; };
DEV void peer_fetch_u(const Params& p, int t, int c0, int g8, PeerTok& k) {
    const u32x4* ep = (const u32x4*)(p.eidx + (size_t)t * 128 + 16 * g8); k.e0 = ep[0]; k.e1 = ep[1];
    const u32x4* hp = (const u32x4*)(p.hB + (size_t)t * D + c0);
#pragma unroll
    for (int i = 0; i < 4; ++i) k.h[i] = hp[i];
}
DEV void phase_peer_u(const Params& p, int l, unsigned char* lds) {
    const int lane = threadIdx.x & 63, w = wave_id(), j8 = lane & 7, g8 = lane >> 3;
    const bool b2 = (j8 & 4) != 0, b1 = (j8 & 2) != 0, b0 = (j8 & 1) != 0;
    const PeerDeal dl = peer_deal();
    const unsigned char* U = p.u8 + (size_t)l * NE * (D / 2);
    for (int xs = dl.xs_first; xs < 8; xs += dl.xs_step) {
        const int c0 = 256 * xs + 32 * j8;
        const unsigned char* Us = U + (size_t)xs * NE * 128; const unsigned joff = 16u * (unsigned)j8;
        PeerTok nx; if (dl.t_begin + w < dl.t_end) peer_fetch_u(p, dl.t_begin + w, c0, g8, nx);
        for (int t = dl.t_begin + w; t < dl.t_end; t += 8) {
            const PeerTok cu = nx;
            const unsigned ew[8] = {cu.e0.x, cu.e0.y, cu.e0.z, cu.e0.w, cu.e1.x, cu.e1.y, cu.e1.z, cu.e1.w}; unsigned ev[16];
#pragma unroll
            for (int i = 0; i < 8; ++i) { ev[2 * i] = ew[i] & 0xffffu; ev[2 * i + 1] = ew[i] >> 16; }
            u32x4 q[16];
#pragma unroll
            for (int i = 0; i < 16; ++i) q[i] = *(const u32x4*)(Us + (ev[i] * 128u + joff));
            if (t + 8 < dl.t_end) peer_fetch_u(p, t + 8, c0, g8, nx);
            const unsigned hw[16] = {cu.h[0].x, cu.h[0].y, cu.h[0].z, cu.h[0].w, cu.h[1].x, cu.h[1].y, cu.h[1].z, cu.h[1].w, cu.h[2].x, cu.h[2].y, cu.h[2].z, cu.h[2].w, cu.h[3].x, cu.h[3].y, cu.h[3].z, cu.h[3].w};
            float ps[16];
#pragma unroll
            for (int i = 0; i < 16; ++i) { unsigned dq[16]; fp4x8_decb(q[i].x, dq); fp4x8_decb(q[i].y, dq + 4); fp4x8_decb(q[i].z, dq + 8); fp4x8_decb(q[i].w, dq + 12);
                float a = 0.f, b = 0.f;
#pragma unroll
                for (int k = 0; k < 8; ++k) { a = dot2bf(dq[2 * k], hw[2 * k], a); b = dot2bf(dq[2 * k + 1], hw[2 * k + 1], b); }
                ps[i] = a + b; }
            float q8[8], q4[4], q2[2];
#pragma unroll
            for (int k = 0; k < 8; ++k) { const float keep = b2 ? ps[8 + k] : ps[k], send = b2 ? ps[k] : ps[8 + k]; q8[k] = keep + DPP_HMIRROR(send); }
#pragma unroll
            for (int k = 0; k < 4; ++k) { const float keep = b1 ? q8[4 + k] : q8[k], send = b1 ? q8[k] : q8[4 + k]; q4[k] = keep + DPP_XOR2(send); }
#pragma unroll
            for (int k = 0; k < 2; ++k) { const float keep = b0 ? q4[2 + k] : q4[k], send = b0 ? q4[k] : q4[2 + k]; q2[k] = keep + DPP_XOR1(send); }
            float* dst = p.part + ((size_t)t * 8 + xs) * 128 + 16 * g8 + 2 * j8; *(f32x2*)dst = (f32x2){q2[0], q2[1]};
        }
    }
}
DEV void phase_peer_c(const Params& p, int l) {
    const size_t n = (size_t)NTOK * 128, gs = (size_t)gridDim.x * 512;
    for (size_t i = (size_t)blockIdx.x * 512 + threadIdx.x; i < n; i += gs) {
        const size_t t = i >> 7; const int pr = (int)(i & 127); float sacc = 0.f;
        const int e = p.eidx[i]; const float su = p.su[l * NE + e], sv = p.sv[l * NE + e], gt = p.gate[i];
#pragma unroll
        for (int x = 0; x < 8; ++x) sacc += p.part[(t * 8 + x) * 128 + pr];
        p.ab16[i] = (bf16_t)f2bf(gelu_erf(sacc * su) * gt * sv);
    }
}
struct PeerTokV { u32x4 e0, e1, a0, a1; u32x2 x1; f32x4 g2; };
DEV void peer_fetch_v(const Params& p, int l, int t, int col, int g8, PeerTokV& k) {
    const u32x4* ep = (const u32x4*)(p.eidx + (size_t)t * 128 + 16 * g8); k.e0 = ep[0]; k.e1 = ep[1];
    const u32x4* ap = (const u32x4*)(p.ab16 + (size_t)t * 128 + 16 * g8); k.a0 = ap[0]; k.a1 = ap[1];
    k.x1 = *(const u32x2*)(p.xa + (size_t)t * D + col); k.g2 = *(const f32x4*)(p.modbuf + (size_t)tok_batch(t) * MODW + l * NMOD + 5 * D + col);
}
DEV void phase_peer_v(const Params& p, int l, unsigned char* lds) {
    const int lane = threadIdx.x & 63, w = wave_id(), j8 = lane & 7, g8 = lane >> 3;
    const bool b3 = (g8 & 1) != 0, b4 = (g8 & 2) != 0, b5 = (g8 & 4) != 0;
    const PeerDeal dl = peer_deal();
    const unsigned char* V = p.v8 + (size_t)l * NE * (D / 2);
    for (int xs = dl.xs_first; xs < 8; xs += dl.xs_step) {
        const int col = 256 * xs + 32 * j8 + (b3 ? 16 : 0) + (b4 ? 8 : 0) + (b5 ? 4 : 0);
        const unsigned char* Vs = V + (size_t)xs * NE * 128; const unsigned joff = 16u * (unsigned)j8;
        PeerTokV nx; if (dl.t_begin + w < dl.t_end) peer_fetch_v(p, l, dl.t_begin + w, col, g8, nx);
        for (int t = dl.t_begin + w; t < dl.t_end; t += 8) {
            const PeerTokV cu = nx;
            const unsigned ew[8] = {cu.e0.x, cu.e0.y, cu.e0.z, cu.e0.w, cu.e1.x, cu.e1.y, cu.e1.z, cu.e1.w}; unsigned ev[16];
#pragma unroll
            for (int i = 0; i < 8; ++i) { ev[2 * i] = ew[i] & 0xffffu; ev[2 * i + 1] = ew[i] >> 16; }
            u32x4 q[16];
#pragma unroll
            for (int i = 0; i < 16; ++i) q[i] = *(const u32x4*)(Vs + (ev[i] * 128u + joff));
            if (t + 8 < dl.t_end) peer_fetch_v(p, l, t + 8, col, g8, nx);
            const unsigned aw[8] = {cu.a0.x, cu.a0.y, cu.a0.z, cu.a0.w, cu.a1.x, cu.a1.y, cu.a1.z, cu.a1.w}; float av[16];
#pragma unroll
            for (int i = 0; i < 8; ++i) { av[2 * i] = lo16(aw[i]); av[2 * i + 1] = hi16(aw[i]); }
            f32x2 acc2[16];
#pragma unroll
            for (int k = 0; k < 16; ++k) acc2[k] = (f32x2){0.f, 0.f};
#pragma unroll
            for (int i = 0; i < 16; ++i) { f32x2 dq[16]; fp4x32_dec2(q[i], dq); const f32x2 a2v = (f32x2){av[i], av[i]};
#pragma unroll
                for (int k = 0; k < 16; ++k) acc2[k] = __builtin_elementwise_fma(a2v, dq[k], acc2[k]); }
            float acc[32];
#pragma unroll
            for (int k = 0; k < 16; ++k) { acc[2 * k] = acc2[k][0]; acc[2 * k + 1] = acc2[k][1]; }
            float q16[16], q8[8], q4[4];
#pragma unroll
            for (int k = 0; k < 16; ++k) { const float keep = b3 ? acc[16 + k] : acc[k], send = b3 ? acc[k] : acc[16 + k]; q16[k] = keep + DPP_XOR8(send); }
#pragma unroll
            for (int k = 0; k < 8; ++k) q8[k] = xsum16(q16[k], q16[8 + k]);
#pragma unroll
            for (int k = 0; k < 4; ++k) q4[k] = xsum32(q8[k], q8[4 + k]);
            const f32x4 x1v = (f32x4){lo16(cu.x1.x), hi16(cu.x1.x), lo16(cu.x1.y), hi16(cu.x1.y)}; f32x4 o;
#pragma unroll
            for (int k = 0; k < 4; ++k) o[k] = x1v[k] + cu.g2[k] * q4[k];
            u32x2 ow; ow.x = pack2(o[0], o[1]); ow.y = pack2(o[2], o[3]); *(u32x2*)(p.xb + (size_t)t * D + col) = ow;
        }
    }
}

constexpr int N_PHASES = 27;
DEV int phase_class(int k) { return k < 2 ? k : (k == 26 ? 14 : 2 + (k - 2) % 12); }
#ifndef HIPEMU
#define XB_TMO      128
#define XB_XCNT(j)  (256  + 64 * (j))
#define XB_XSUB(j)  (1280 + 64 * (j))
#define XB_XGEN(j)  (2304 + 64 * (j))
#define XB_TOP      3328
#define XB_TOPGEN   3392
#define XCD_BAR_WORDS 3456
#define XB_SPIN_CAP (1u << 22)
__device__ __forceinline__ unsigned xb_ld(unsigned* p)              { return __hip_atomic_load(p, __ATOMIC_RELAXED, __HIP_MEMORY_SCOPE_AGENT); }
__device__ __forceinline__ unsigned xb_add(unsigned* p, unsigned v) { return __hip_atomic_fetch_add(p, v, __ATOMIC_RELAXED, __HIP_MEMORY_SCOPE_AGENT); }
__device__ __forceinline__ unsigned xb_xcc_id() { return (unsigned)__builtin_amdgcn_s_getreg((3 << 11) | 20) & 0xFu; }
#define XB_SPIN(cond, bar) do { unsigned _sp = 0; while (cond) { __builtin_amdgcn_s_sleep(1); \
    if ((++_sp & 255u) == 0u) { if (xb_ld(&(bar)[XB_TMO])) break; if (_sp > XB_SPIN_CAP) { atomicAdd(&(bar)[XB_TMO], 1u); break; } } } } while (0)
struct XcdBarrier { unsigned* bar; unsigned x; volatile LAS unsigned* st; };
__device__ __forceinline__ XcdBarrier xcd_barrier_post(unsigned* bar, volatile LAS unsigned* st) {
    XcdBarrier b; b.bar = bar; b.x = xb_xcc_id(); b.st = st;
    if (threadIdx.x == 0) (void)xb_add(&bar[XB_XCNT(b.x)], 1u);
    return b;
}
__device__ __forceinline__ void xcd_barrier_complete(unsigned* bar, unsigned x, unsigned& nloc, unsigned& nx) {
    const unsigned G = gridDim.x * gridDim.y * gridDim.z;
    unsigned sum, cnt, mine, sp = 0u;
    for (;;) {
        sum = 0u; cnt = 0u; mine = 0u;
#pragma unroll
        for (unsigned j = 0; j < 16; ++j) { const unsigned c = xb_ld(&bar[XB_XCNT(j)]); sum += c; cnt += (c > 0u) ? 1u : 0u; mine = (j == x) ? c : mine; }
        if (sum == G) break;
        __builtin_amdgcn_s_sleep(1);
        if ((++sp & 255u) == 0u) { if (xb_ld(&bar[XB_TMO])) break; if (sp > XB_SPIN_CAP) { atomicAdd(&bar[XB_TMO], 1u); break; } }
    }
    nloc = mine > 0u ? mine : 1u; nx = cnt > 0u ? cnt : 1u;
}
__device__ __forceinline__ void xcd_barrier(const XcdBarrier& b) {
    asm volatile("s_waitcnt vmcnt(0)" ::: "memory");
    __syncthreads();
    if (threadIdx.x == 0) {
        unsigned* bar = b.bar;
        __builtin_amdgcn_s_waitcnt(0);
        unsigned nloc = b.st[0], nx = b.st[1];
        if (nloc == 0u) { xcd_barrier_complete(bar, b.x, nloc, nx); b.st[0] = nloc; b.st[1] = nx; }
        const unsigned old = xb_add(&bar[XB_XSUB(b.x)], 1u);
        const unsigned gen = old / nloc;
        if (old + 1u == (gen + 1u) * nloc) {
            __builtin_amdgcn_fence(__ATOMIC_RELEASE, "agent");
            asm volatile("s_waitcnt vmcnt(0)" ::: "memory");
            const unsigned og = xb_add(&bar[XB_TOP], 1u);
            const unsigned tg = og / nx;
            if (og + 1u == (tg + 1u) * nx) xb_add(&bar[XB_TOPGEN], 1u);
            else XB_SPIN(xb_ld(&bar[XB_TOPGEN]) == tg, bar);
            __builtin_amdgcn_fence(__ATOMIC_ACQUIRE, "agent");
            xb_add(&bar[XB_XGEN(b.x)], 1u);
            asm volatile("s_waitcnt vmcnt(0)" ::: "memory");
        } else {
            XB_SPIN(xb_ld(&bar[XB_XGEN(b.x)]) == gen, bar);
            __builtin_amdgcn_fence(__ATOMIC_ACQUIRE, "agent");
            asm volatile("s_waitcnt vmcnt(0)" ::: "memory");
        }
    }
    __syncthreads();
}
#endif

constexpr int LDS_BYTES = 163840;
constexpr int LDS_BARW = LDS_BYTES - 16;

#ifndef PH_MASK
#define PH_MASK 0xFFFFFFFFu
#endif
#ifndef PROBE_DUP
#define PROBE_DUP 0u
#endif
#define DUP_N(k) (1 + (int)((PROBE_DUP >> phase_class(k)) & 1u))
#define PH_BIT(k) ((PH_MASK >> phase_class(k)) & 1u)
#ifdef HIPEMU
static void run_phase(const Params& pp, int ph, unsigned char* lds)
#define GRID_BAR() do {} while (0)
#define IN(k) (ph == (k))
#define GLDS lds
#define LOADP() const Params& p = pp
#else
typedef const __attribute__((address_space(4))) unsigned char* kargp_t;
__device__ __forceinline__ kargp_t karg_ptr() { kargp_t kp = (kargp_t)__builtin_amdgcn_kernarg_segment_ptr(); asm volatile("" : "+s"(kp)); return kp; }
#define LOADP() Params p; __builtin_memcpy(&p, karg_ptr(), sizeof(Params))
#define IN(k) (PH_BIT(k) && ph_lo <= (k) && (k) < ph_hi)
#define GLDS ((LAS unsigned char*)lds_raw)
__global__ void __launch_bounds__(512, 2) mega_fwd(Params p_unused)
#endif
{
#ifndef HIPEMU
    extern __shared__ __attribute__((aligned(16))) unsigned char lds_raw[];
    unsigned char* lds = lds_raw;
    if (threadIdx.x == 0) { *(volatile unsigned*)(lds_raw + LDS_BARW) = 0u; *(volatile unsigned*)(lds_raw + LDS_BARW + 4) = 0u; }
    __syncthreads();
    int ph_lo, ph_hi; XcdBarrier bar;
    { LOADP(); ph_lo = p.ph_lo; ph_hi = p.ph_hi; bar.bar = p.bar; bar.x = 0; bar.st = nullptr; }
    const bool multi = (ph_hi - ph_lo) > 1;
    if (multi) bar = xcd_barrier_post(bar.bar, (volatile LAS unsigned*)(lds_raw + LDS_BARW));
#define GRID_BAR() do { if (multi) xcd_barrier(bar); } while (0)
#endif
    if (IN(0)) { for (int rep = 0; rep < DUP_N(0); ++rep) { LOADP(); for (int u = blockIdx.x; u < ADA_UNITS; u += gridDim.x) ada_direct_unit(p, u, lds); } }
    if (IN(1)) { LOADP(); phase_convert(p, lds, 1); GRID_BAR(); }
#define LAYER(l) do { \
        constexpr int base = 2 + 12 * (l); \
        if (IN(base + 0)) { for (int rep = 0; rep < DUP_N(base + 0); ++rep) { LOADP(); phase_norm(p, p.x_prompt, p.x_sample, (l) == 0 ? (const bf16_t*)nullptr : p.xb, p.norm1_g + (l) * D, (l) * NMOD + 0 * D, (l) * NMOD + 1 * D, p.hA, nullptr); GRID_BAR(); } } \
        if (IN(base + 1)) { for (int rep = 0; rep < DUP_N(base + 1); ++rep) { LOADP(); \
            pg8::Gemm g{p.hA, p.wt_in + (size_t)(l) * ZW * D, MPAD, ZW, D}; pg8::StaticOrder S; S.init(MPAD, ZW, gridDim.x, blockIdx.x); \
            pg8::EpiBf16 E{p.z, ZW}; \
            pg8::gemm_phase<pg8::EpiBf16, pg8::StaticOrder>(GLDS, g, S, E); } } \
        if (IN(base + 1)) { LOADP(); phase_tbl_slot(p, (l)); GRID_BAR(); } \
        if (IN(base + 2)) { for (int rep = 0; rep < DUP_N(base + 2); ++rep) { LOADP(); phase_mix1(p, (l), lds); GRID_BAR(); } } \
        if (IN(base + 3)) { for (int rep = 0; rep < DUP_N(base + 3); ++rep) { LOADP(); phase_mix2(p, (l)); GRID_BAR(); } } \
        if (IN(base + 4)) { LOADP(); phase_mix3(p, (l), lds); } \
        if (IN(base + 4)) { LOADP(); \
            pg8::Gemm g{p.pooled, p.wt_pool + (size_t)(l) * 1024 * 256, 4 * MPAD, 1024, 256}; pg8::PoolOrder S{(int)gridDim.x, (int)(gridDim.x - 1 - blockIdx.x)}; \
            pg8::EpiPool E{p.cat, p.pool_b + (l) * PW, p.pool_scale + (l) * PW}; \
            pg8::gemm_phase<pg8::EpiPool, pg8::PoolOrder>(GLDS, g, S, E); \
            GRID_BAR(); } \
        if (IN(base + 5)) { for (int rep = 0; rep < DUP_N(base + 5); ++rep) { LOADP(); \
            pg8::Gemm g{p.cat, p.wt_out + (size_t)(l) * D * D, MBIG, D, D}; pg8::StaticOrder S; S.init(MBIG, D, gridDim.x, blockIdx.x); \
            pg8::EpiResid E{p.x_prompt, p.x_sample, (l) == 0 ? (const bf16_t*)nullptr : p.xb, p.modbuf + (l) * NMOD + 2 * D, p.xa}; \
            pg8::gemm_phase<pg8::EpiResid, pg8::StaticOrder>(GLDS, g, S, E); \
            { SmallResid sf{E.xlo, E.xhi, E.x16, E.gmod, E.out}; small_gemm(p.cat, p.wt_out + (size_t)(l) * D * D, D, lds, sf); } \
            GRID_BAR(); } } \
        if (IN(base + 6)) { for (int rep = 0; rep < DUP_N(base + 6); ++rep) { LOADP(); phase_norm(p, nullptr, nullptr, p.xa, p.norm2_g + (l) * D, (l) * NMOD + 3 * D, (l) * NMOD + 4 * D, p.hB, nullptr); GRID_BAR(); } } \
        if (IN(base + 7)) { for (int rep = 0; rep < DUP_N(base + 7); ++rep) { LOADP(); \
            pg8::Gemm g{p.hB, p.wt_q + (size_t)(l) * D * D, MBIG, D, D}; pg8::StaticOrder S; S.init(MBIG, D, gridDim.x, blockIdx.x); \
            pg8::EpiF32 E{p.qry, D}; \
            pg8::gemm_phase<pg8::EpiF32, pg8::StaticOrder>(GLDS, g, S, E); \
            { SmallF32 sf{p.qry}; small_gemm(p.hB, p.wt_q + (size_t)(l) * D * D, D, lds, sf); } \
            GRID_BAR(); } } \
        if (IN(base + 8)) { for (int rep = 0; rep < DUP_N(base + 8); ++rep) { LOADP(); phase_select(p, (l), lds); GRID_BAR(); } } \
        if (IN(base + 9)) { for (int rep = 0; rep < DUP_N(base + 9); ++rep) { LOADP(); phase_peer_u(p, (l), lds); GRID_BAR(); } } \
        if (IN(base + 10)) { LOADP(); phase_peer_c(p, (l)); GRID_BAR(); } \
        if (IN(base + 11)) { for (int rep = 0; rep < DUP_N(base + 11); ++rep) { LOADP(); phase_peer_v(p, (l), lds); GRID_BAR(); } } \
    } while (0)
    LAYER(0);
    LAYER(1);
    if (IN(26)) { LOADP(); phase_norm(p, nullptr, nullptr, p.xb, p.final_g, 2 * NMOD, 2 * NMOD + D, nullptr, p.out + OFF_Y); }
#undef LAYER
#undef IN
#undef GRID_BAR
#undef GLDS
#undef LOADP
}

struct WsLayout { size_t bar, modbuf, csil, wt_ada, wt_in, wt_out, wt_q, wt_pool, u8, v8, su, sv, iscu, part, hg_oin, hg_ds, hg_gam, hg_qh, hg_sc, hA, hB, z, pooled, cat, xa, xb, qry, eidx, gate, ab16, end; };
static WsLayout ws_layout() {
    WsLayout L; size_t o = 0;
    auto take = [&](size_t bytes) { const size_t r = o; o += (bytes + 255) & ~(size_t)255; return r; };
    L.bar = take(16384);
    L.modbuf = take((size_t)256 * MODW * 4);
    L.csil = take((size_t)256 * D * 2);
    L.wt_ada = take((size_t)MODW * D * 2);
    L.wt_in = take((size_t)2 * ZW * D * 2);
    L.wt_out = take((size_t)2 * D * D * 2);
    L.wt_q = take((size_t)2 * D * D * 2);
    L.wt_pool = take((size_t)2 * 1024 * 256 * 2);
    L.u8 = take((size_t)2 * NE * D);
    L.v8 = take((size_t)2 * NE * D);
    L.su = take((size_t)2 * NE * 4);
    L.sv = take((size_t)2 * NE * 4);
    L.iscu = take((size_t)MPAD * 128 * 4);
    L.part = take((size_t)MPAD * 8 * 128 * 4);
    L.hg_oin = take((size_t)hg::NUNIT * 64 * 128 * 2);
    L.hg_ds = take((size_t)hg::NUNIT * 128 * 128 * 2);
    L.hg_gam = take((size_t)hg::NUNIT * 128 * 4);
    L.hg_qh = take((size_t)NP * 1024 * 2);
    L.hg_sc = take((size_t)hg::NUNIT * 128 * 128 * 2);
    L.hA = take((size_t)MPAD * D * 2);
    L.hB = take((size_t)MPAD * D * 2);
    L.z = take((size_t)MPAD * ZW * 2);
    L.pooled = take((size_t)4 * MPAD * 256 * 2);
    L.cat = take((size_t)MPAD * D * 2);
    L.xa = take((size_t)MPAD * D * 2);
    L.xb = take((size_t)MPAD * D * 2);
    L.qry = take((size_t)MPAD * D * 4);
    L.eidx = take((size_t)MPAD * 128 * 2);
    L.gate = take((size_t)MPAD * 128 * 4);
    L.ab16 = take((size_t)MPAD * 128 * 2);
    L.end = o;
    return L;
}
static void fill_params(Params& p, void* const* d_in, void* d_out, void* d_ws) {
    const float** f = (const float**)&p;
    for (int i = 0; i < 24; ++i) f[i] = (const float*)d_in[i];
    p.out = (float*)d_out;
    const WsLayout L = ws_layout(); unsigned char* w = (unsigned char*)d_ws;
    p.bar = (unsigned*)(w + L.bar); p.modbuf = (float*)(w + L.modbuf); p.csil = (bf16_t*)(w + L.csil); p.wt_ada = (bf16_t*)(w + L.wt_ada); p.wt_in = (bf16_t*)(w + L.wt_in);
    p.wt_out = (bf16_t*)(w + L.wt_out); p.wt_q = (bf16_t*)(w + L.wt_q); p.wt_pool = (bf16_t*)(w + L.wt_pool); p.u8 = w + L.u8; p.v8 = w + L.v8; p.su = (float*)(w + L.su); p.sv = (float*)(w + L.sv); p.iscu = (float*)(w + L.iscu); p.part = (float*)(w + L.part); p.hg_oin = (bf16_t*)(w + L.hg_oin); p.hg_ds = (bf16_t*)(w + L.hg_ds); p.hg_gam = (float*)(w + L.hg_gam); p.hg_qh = (bf16_t*)(w + L.hg_qh); p.hg_sc = (bf16_t*)(w + L.hg_sc);
    p.hA = (bf16_t*)(w + L.hA); p.hB = (bf16_t*)(w + L.hB); p.z = (bf16_t*)(w + L.z); p.pooled = (bf16_t*)(w + L.pooled); p.cat = (bf16_t*)(w + L.cat);
    p.xa = (bf16_t*)(w + L.xa); p.xb = (bf16_t*)(w + L.xb); p.qry = (float*)(w + L.qry); p.eidx = (unsigned short*)(w + L.eidx); p.gate = (float*)(w + L.gate); p.ab16 = (bf16_t*)(w + L.ab16);
}

#ifndef HIPEMU
#ifndef MK_ONE_LAUNCH
#define MK_ONE_LAUNCH 1
#endif
extern "C" void kernel_launch(void* const* d_in, const int* in_sizes, int n_in, void* d_out, int out_size, void* d_ws, size_t ws_size, hipStream_t stream) {
    static int grid = 0;
    if (grid == 0) {
        const WsLayout L = ws_layout();
        if (n_in != 24 || (size_t)out_size != OUT_TOTAL || ws_size < L.end) { fprintf(stderr, "kernel_launch: unexpected shapes (n_in %d, out %d, ws %zu < %zu)\n", n_in, out_size, ws_size, L.end); grid = -1; return; }
        int dev = 0, cus = 0, per_cu = 0;
        hipGetDevice(&dev); hipDeviceGetAttribute(&cus, hipDeviceAttributeMultiprocessorCount, dev);
        if (hipFuncSetAttribute((const void*)mega_fwd, hipFuncAttributeMaxDynamicSharedMemorySize, LDS_BYTES) != hipSuccess) { fprintf(stderr, "kernel_launch: hipFuncSetAttribute failed\n"); grid = -1; return; }
        hipOccupancyMaxActiveBlocksPerMultiprocessor(&per_cu, (const void*)mega_fwd, 512, LDS_BYTES);
        (void)hipGetLastError();
        if (per_cu < 1) fprintf(stderr, "kernel_launch: occupancy query says %d blocks per CU\n", per_cu);
        grid = cus;
    }
    if (grid < 0) return;
    Params p{};
    fill_params(p, d_in, d_out, d_ws);
    hipMemsetAsync(p.bar, 0, 16384, stream);
#if MK_ONE_LAUNCH
    p.ph_lo = 0; p.ph_hi = N_PHASES;
    hipLaunchKernelGGL(mega_fwd, dim3(grid), dim3(512), LDS_BYTES, stream, p);
#else
    for (int ph = 0; ph < N_PHASES; ++ph) { p.ph_lo = ph; p.ph_hi = ph + 1; hipLaunchKernelGGL(mega_fwd, dim3(grid), dim3(512), LDS_BYTES, stream, p); }
#endif
}
#endif
```

```cpp
#ifndef HIPEMU
#include <hip/hip_runtime.h>
#include <cstdio>
#endif
#include <stdint.h>

#ifndef CFG_PB
#define CFG_PB 4
#define CFG_SEQ 2048
#define CFG_DB 128
#endif

#ifdef HIPEMU
#define DEV inline
#define LAS
#define READLANE_I(v, l) emu_readlane((v), (l))
#define READLANE_F(v, l) emu_readlane_f((v), (l))
#define MFMA_BF16(a, b, c) emu_mfma_bf16_16x16x32((a), (b), (c))
#define MFMA_F32(a, b, c) emu_mfma_f32_16x16x4((a), (b), (c))
#define __expf expf
#define __logf logf
#else
#define DEV __device__ __forceinline__
#define LAS __attribute__((address_space(3)))
#define READLANE_I(v, l) __builtin_amdgcn_readlane((v), (l))
#define READLANE_F(v, l) __uint_as_float((unsigned)__builtin_amdgcn_readlane((int)__float_as_uint(v), (l)))
#define MFMA_BF16(a, b, c) __builtin_amdgcn_mfma_f32_16x16x32_bf16((a), (b), (c), 0, 0, 0)
#define MFMA_F32(a, b, c) __builtin_amdgcn_mfma_f32_16x16x4f32((a), (b), (c), 0, 0, 0)
#endif

typedef unsigned short bf16_t;
typedef short bf16x8 __attribute__((ext_vector_type(8)));
typedef float f32x4 __attribute__((ext_vector_type(4)));
typedef unsigned u32x4 __attribute__((ext_vector_type(4)));
typedef unsigned u32x2 __attribute__((ext_vector_type(2)));

namespace cfg {
constexpr int D = 2048, PB = CFG_PB, SEQ = CFG_SEQ, DB = CFG_DB, DSEQ = 4;
constexpr int NP = PB * SEQ, NS = DB * DSEQ, NTOK = NP + NS, MPAD = (NTOK + 255) / 256 * 256;
constexpr int NC = PB + DB;
constexpr int HH = 8, HD = 128, PW = 1024, PBUF = 15, ZW = 5120;
constexpr int NE = 16384;
constexpr int NMOD = 6 * D;
constexpr int MODW = 2 * NMOD + 2 * D;
constexpr float EPS = 1e-6f;
constexpr int NCHAIN = PB * HH;
constexpr size_t OFF_Y = 0;
constexpr size_t OFF_HP = (size_t)NTOK * D;
constexpr size_t OFF_PP = OFF_HP + (size_t)2 * PB * HH * HD * HD;
constexpr size_t OFF_HS = OFF_PP + (size_t)2 * PB * PBUF * PW;
constexpr size_t OFF_PS = OFF_HS + (size_t)2 * DB * HH * HD * HD;
constexpr size_t OUT_TOTAL = OFF_PS + (size_t)2 * DB * PBUF * PW;
}
using namespace cfg;

struct Params {
    const float *x_prompt, *x_sample, *c_prompt, *c_sample, *state_hgrn, *state_pool, *w_ada, *b_ada, *norm1_g, *norm2_g, *w_in, *w_out,
        *lb_logits, *hgrn_norm_g, *pool_w, *pool_b, *pool_scale, *peer_wq, *peer_keys, *peer_u, *peer_v, *final_g, *w_ada_final, *b_ada_final;
    float* out;
    unsigned* bar; float* modbuf; bf16_t* csil; bf16_t* wt_ada; bf16_t* wt_in; bf16_t* wt_out; bf16_t* wt_q; bf16_t* wt_pool;
    unsigned char* u8; unsigned char* v8; float* su; float* sv; float* iscu; float* part; bf16_t* hg_oin; bf16_t* hg_ds; float* hg_gam; bf16_t* hg_qh; bf16_t* hg_sc; bf16_t* hA; bf16_t* hB; bf16_t* z; bf16_t* pooled; bf16_t* cat; bf16_t* xa; bf16_t* xb; float* qry; unsigned short* eidx; float* gate; bf16_t* ab16;
    int ph_lo, ph_hi;
};

DEV float bf2f(unsigned v) { return __uint_as_float(v << 16); }
#ifdef HIPEMU
DEV unsigned f2bf(float f) { unsigned u = __float_as_uint(f); u += 0x7fffu + ((u >> 16) & 1u); return u >> 16; }
DEV unsigned pack2(float lo, float hi) { return f2bf(lo) | (f2bf(hi) << 16); }
#else
typedef float f32x2_t __attribute__((ext_vector_type(2)));
typedef __bf16 bf16x2_t __attribute__((ext_vector_type(2)));
DEV unsigned pack2(float lo, float hi) { const f32x2_t v = {lo, hi}; return __builtin_bit_cast(unsigned, __builtin_convertvector(v, bf16x2_t)); }
DEV unsigned f2bf(float f) { return (unsigned)__builtin_bit_cast(unsigned short, (__bf16)f); }
#endif
DEV float lo16(unsigned w) { return __uint_as_float(w << 16); }
DEV float hi16(unsigned w) { return __uint_as_float(w & 0xffff0000u); }
DEV float wave_sum(float v) { v += __shfl_xor(v, 32); v += __shfl_xor(v, 16); v += __shfl_xor(v, 8); v += __shfl_xor(v, 4); v += __shfl_xor(v, 2); v += __shfl_xor(v, 1); return v; }
DEV float wave_max(float v) { v = fmaxf(v, __shfl_xor(v, 32)); v = fmaxf(v, __shfl_xor(v, 16)); v = fmaxf(v, __shfl_xor(v, 8)); v = fmaxf(v, __shfl_xor(v, 4)); v = fmaxf(v, __shfl_xor(v, 2)); v = fmaxf(v, __shfl_xor(v, 1)); return v; }
DEV float sigmoidf_(float x) { return 1.0f / (1.0f + __expf(-x)); }
DEV float siluf_(float x) { return x / (1.0f + __expf(-x)); }
DEV float gelu_erf(float x) { return 0.5f * x * (1.0f + erff(x * 0.70710678118f)); }
#ifdef HIPEMU
DEV int wave_id() { return (int)(threadIdx.x >> 6); }
#else
DEV int wave_id() { return __builtin_amdgcn_readfirstlane((int)(threadIdx.x >> 6)); }
#endif
DEV int tok_batch(int t) { return t < NP ? t / SEQ : PB + (t - NP) / DSEQ; }


#ifdef HIPEMU
static inline unsigned emu_fp8_enc1(float x) {
    const unsigned sgn = x < 0.f ? 0x80u : 0u; float a = fabsf(x);
    if (!(a == a)) return 0x7fu;
    if (a >= 448.f) return sgn | 0x7eu;
    if (a < 0.015625f) { const int q = (int)rintf(a * 512.f); return sgn | (unsigned)q; }
    int e = (int)floorf(log2f(a)); if (ldexpf(1.f, e) > a) --e; if (ldexpf(1.f, e + 1) <= a) ++e;
    int m = (int)rintf((a / ldexpf(1.f, e) - 1.f) * 8.f); if (m == 8) { m = 0; ++e; }
    if (e > 8) return sgn | 0x7eu;
    return sgn | (unsigned)((e + 7) << 3) | (unsigned)m;
}
static inline float emu_fp8_dec1(unsigned b) { const float sg = (b & 0x80u) ? -1.f : 1.f; const int e = (b >> 3) & 15, m = b & 7; return sg * (e == 0 ? m * 0.001953125f : (1.f + m * 0.125f) * ldexpf(1.f, e - 7)); }
DEV unsigned fp8x4_enc(float a, float b, float c, float d) { return emu_fp8_enc1(a) | (emu_fp8_enc1(b) << 8) | (emu_fp8_enc1(c) << 16) | (emu_fp8_enc1(d) << 24); }
DEV void fp8x4_dec(unsigned w, float* o) { o[0] = emu_fp8_dec1(w & 255u); o[1] = emu_fp8_dec1((w >> 8) & 255u); o[2] = emu_fp8_dec1((w >> 16) & 255u); o[3] = emu_fp8_dec1(w >> 24); }
#define DPP_XOR1(v) __shfl((v), emu_lane() ^ 1)
#define DPP_XOR2(v) __shfl((v), emu_lane() ^ 2)
#define DPP_HMIRROR(v) __shfl((v), (emu_lane() & ~7) | (7 - (emu_lane() & 7)))
#define DPP_XOR8(v) __shfl((v), emu_lane() ^ 8)
#define DPP_RMIRROR(v) __shfl((v), (emu_lane() & ~15) | (15 - (emu_lane() & 15)))
#define WAVE_LDS_SYNC() emu_wbar()
DEV float xsum16(float a, float b) { const bool hi = (emu_lane() & 16) != 0; return (hi ? b : a) + __shfl_xor(hi ? a : b, 16); }
DEV float xsum32(float a, float b) { const bool hi = (emu_lane() & 32) != 0; return (hi ? b : a) + __shfl_xor(hi ? a : b, 32); }
#else
typedef float f32x2v_t __attribute__((ext_vector_type(2)));
DEV unsigned fp8x4_enc(float a, float b, float c, float d) { int r = __builtin_amdgcn_cvt_pk_fp8_f32(a, b, 0, false); r = __builtin_amdgcn_cvt_pk_fp8_f32(c, d, r, true); return (unsigned)r; }
DEV void fp8x4_dec(unsigned w, float* o) { const f32x2v_t lo = __builtin_amdgcn_cvt_pk_f32_fp8((int)w, false), hi = __builtin_amdgcn_cvt_pk_f32_fp8((int)w, true); o[0] = lo[0]; o[1] = lo[1]; o[2] = hi[0]; o[3] = hi[1]; }
template <int CTRL> DEV float dpp_f(float v) { return __uint_as_float((unsigned)__builtin_amdgcn_update_dpp(0, (int)__float_as_uint(v), CTRL, 0xf, 0xf, true)); }
#define DPP_XOR1(v) dpp_f<0xB1>(v)
#define DPP_XOR2(v) dpp_f<0x4E>(v)
#define DPP_HMIRROR(v) dpp_f<0x141>(v)
#define DPP_XOR8(v) dpp_f<0x128>(v)
#define DPP_RMIRROR(v) dpp_f<0x140>(v)
#define WAVE_LDS_SYNC() asm volatile("s_waitcnt lgkmcnt(0)" ::: "memory")
DEV float xsum16(float a, float b) { const u32x2 r = __builtin_amdgcn_permlane16_swap(__float_as_uint(a), __float_as_uint(b), false, false); return __uint_as_float(r[0]) + __uint_as_float(r[1]); }
DEV float xsum32(float a, float b) { const u32x2 r = __builtin_amdgcn_permlane32_swap(__float_as_uint(a), __float_as_uint(b), false, false); return __uint_as_float(r[0]) + __uint_as_float(r[1]); }
#endif
typedef float f32x2 __attribute__((ext_vector_type(2)));
#ifdef HIPEMU
DEV void fp8x4_dec2(unsigned w, f32x2& lo, f32x2& hi) { float o[4]; fp8x4_dec(w, o); lo = (f32x2){o[0], o[1]}; hi = (f32x2){o[2], o[3]}; }
#else
DEV void fp8x4_dec2(unsigned w, f32x2& lo, f32x2& hi) { lo = __builtin_amdgcn_cvt_pk_f32_fp8((int)w, false); hi = __builtin_amdgcn_cvt_pk_f32_fp8((int)w, true); }
#endif
DEV void fp8x16_dec2(u32x4 q, f32x2* o) { fp8x4_dec2(q.x, o[0], o[1]); fp8x4_dec2(q.y, o[2], o[3]); fp8x4_dec2(q.z, o[4], o[5]); fp8x4_dec2(q.w, o[6], o[7]); }
#ifdef HIPEMU
static inline unsigned emu_fp4_enc1(float x) {
    const unsigned sgn = x < 0.f ? 8u : 0u; const float a = fabsf(x);
    const unsigned c = a < 0.25f ? 0u : (a < 0.75f ? 1u : (a < 1.25f ? 2u : (a < 1.75f ? 3u : (a < 2.5f ? 4u : (a < 3.5f ? 5u : (a < 5.0f ? 6u : 7u))))));
    return sgn | c;
}
static inline float emu_fp4_dec1(unsigned n) { const float t[8] = {0.f, 0.5f, 1.f, 1.5f, 2.f, 3.f, 4.f, 6.f}; return ((n & 8u) ? -1.f : 1.f) * t[n & 7u]; }
DEV unsigned fp4x4_enc(float a, float b, float c, float d) { return emu_fp4_enc1(a) | (emu_fp4_enc1(b) << 4) | (emu_fp4_enc1(c) << 8) | (emu_fp4_enc1(d) << 12); }
DEV void fp4x8_dec2(unsigned w, f32x2* o) {
    for (int k = 0; k < 4; ++k) o[k] = (f32x2){emu_fp4_dec1((w >> (8 * k)) & 15u), emu_fp4_dec1((w >> (8 * k + 4)) & 15u)};
}
#else
DEV unsigned fp4x4_enc(float a, float b, float c, float d) { unsigned r = 0u; r = __builtin_amdgcn_cvt_scalef32_pk_fp4_f32(r, a, b, 1.0f, 0); r = __builtin_amdgcn_cvt_scalef32_pk_fp4_f32(r, c, d, 1.0f, 1); return r & 0xffffu; }
DEV void fp4x8_dec2(unsigned w, f32x2* o) {
    o[0] = __builtin_amdgcn_cvt_scalef32_pk_f32_fp4(w, 1.0f, 0); o[1] = __builtin_amdgcn_cvt_scalef32_pk_f32_fp4(w, 1.0f, 1);
    o[2] = __builtin_amdgcn_cvt_scalef32_pk_f32_fp4(w, 1.0f, 2); o[3] = __builtin_amdgcn_cvt_scalef32_pk_f32_fp4(w, 1.0f, 3);
}
#endif
DEV void fp4x32_dec2(u32x4 q, f32x2* o) { fp4x8_dec2(q.x, o); fp4x8_dec2(q.y, o + 4); fp4x8_dec2(q.z, o + 8); fp4x8_dec2(q.w, o + 12); }
#ifdef HIPEMU
DEV void fp4x8_decb(unsigned w, unsigned* o) { for (int k = 0; k < 4; ++k) o[k] = f2bf(emu_fp4_dec1((w >> (8 * k)) & 15u)) | (f2bf(emu_fp4_dec1((w >> (8 * k + 4)) & 15u)) << 16); }
DEV float dot2bf(unsigned a, unsigned b, float c) { return c + lo16(a) * lo16(b) + hi16(a) * hi16(b); }
#else
typedef __bf16 bf16x2v_t __attribute__((ext_vector_type(2)));
DEV void fp4x8_decb(unsigned w, unsigned* o) {
    o[0] = __builtin_bit_cast(unsigned, __builtin_amdgcn_cvt_scalef32_pk_bf16_fp4(w, 1.0f, 0)); o[1] = __builtin_bit_cast(unsigned, __builtin_amdgcn_cvt_scalef32_pk_bf16_fp4(w, 1.0f, 1));
    o[2] = __builtin_bit_cast(unsigned, __builtin_amdgcn_cvt_scalef32_pk_bf16_fp4(w, 1.0f, 2)); o[3] = __builtin_bit_cast(unsigned, __builtin_amdgcn_cvt_scalef32_pk_bf16_fp4(w, 1.0f, 3));
}
DEV float dot2bf(unsigned a, unsigned b, float c) { return __builtin_amdgcn_fdot2_f32_bf16(__builtin_bit_cast(bf16x2v_t, a), __builtin_bit_cast(bf16x2v_t, b), c, false); }
#endif

namespace pg8 {
constexpr int BM = 256, BK = 64, HALF = 128, HTB = HALF * BK * 2, STAGE_BYTES = 8 * HTB, NXCD = 8, WGM = 8;
DEV int lds_byte(int r, int c) { const int st = (r >> 4) * 2 + (c >> 5), rr = r & 15, cc = c & 31, ob = rr * 64 + cc * 2; return st * 1024 + (ob ^ (((ob >> 9) & 1) << 5)); }
DEV void stage_rc(int b, int& R, int& C) { const int st = b / 1024, sb = b % 1024, swz = sb ^ (((sb >> 9) & 1) << 5); R = (st >> 1) * 16 + swz / 64; C = (st & 1) * 32 + (swz % 64) / 2; }
DEV int perm32(int rho) { const int n = rho >> 4, i = rho & 15; return 8 * (i >> 2) + 4 * n + (i & 3); }
struct Unit { int pm, pn; };
struct Gemm { const bf16_t* A; const bf16_t* Bt; int M, N, K; };
struct StaticOrder {
    int nM, nN, nwg, G, c;
    DEV void init(int M, int N, int G_, int c_) { nM = M / BM; nN = N / BM; nwg = nM * nN; G = G_; c = c_; }
    DEV bool next(int i, Unit& u) const {
        const long L = (long)i * G + c; if (L >= nwg) return false;
        int wgid = (int)L; { const int q = nwg / NXCD, r = nwg % NXCD, xcd = wgid % NXCD, off = wgid / NXCD; wgid = (xcd < r ? xcd * (q + 1) : r * (q + 1) + (xcd - r) * q) + off; }
        const int nig = WGM * nN, gid = wgid / nig, fm = gid * WGM, gsz = (nM - fm) < WGM ? (nM - fm) : WGM;
        u.pm = fm + ((wgid % nig) % gsz); u.pn = (wgid % nig) / gsz; return true;
    }
    DEV void a_ready(const Unit&) const {}
    DEV void done(const Unit&) const {}
};
struct PoolOrder {
    int G, c;
    DEV bool next(int i, Unit& u) const { const int L = i * G + c; if (L >= 4 * (MPAD / 256)) return false; u.pm = L; u.pn = L / (MPAD / 256); return true; }
    DEV void a_ready(const Unit&) const {}
    DEV void done(const Unit&) const {}
};

struct EpiF32 {
    static constexpr bool PERM = false;
    float* C; int ldc;
    DEV void operator()(const f32x4 (&acc)[2][2][4][2], const Unit& u, int wr, int wc, int fr, int fq) const {
        const int row0 = u.pm * BM + wr * 64 + fr, col0 = u.pn * BM + wc * 32 + 4 * fq;
#pragma unroll
        for (int ai = 0; ai < 2; ++ai)
#pragma unroll
            for (int m = 0; m < 4; ++m) { float* rowp = C + (size_t)(row0 + ai * HALF + m * 16) * ldc + col0;
#pragma unroll
                for (int bj = 0; bj < 2; ++bj)
#pragma unroll
                    for (int n = 0; n < 2; ++n) *(f32x4*)(rowp + bj * HALF + n * 16) = acc[ai][bj][m][n]; }
    }
};
struct EpiAda {
    static constexpr bool PERM = false;
    float* C; const float* b_ada; const float* b_fin;
    DEV void operator()(const f32x4 (&acc)[2][2][4][2], const Unit& u, int wr, int wc, int fr, int fq) const {
        const int row0 = u.pm * BM + wr * 64 + fr, col0 = u.pn * BM + wc * 32 + 4 * fq;
        const float* bias = (u.pn * BM < 2 * NMOD) ? b_ada + col0 : b_fin + (col0 - 2 * NMOD);
        f32x4 bv[2][2];
#pragma unroll
        for (int bj = 0; bj < 2; ++bj)
#pragma unroll
            for (int n = 0; n < 2; ++n) bv[bj][n] = *(const f32x4*)(bias + bj * HALF + n * 16);
#pragma unroll
        for (int ai = 0; ai < 2; ++ai)
#pragma unroll
            for (int m = 0; m < 4; ++m) { float* rowp = C + (size_t)(row0 + ai * HALF + m * 16) * MODW + col0;
#pragma unroll
                for (int bj = 0; bj < 2; ++bj)
#pragma unroll
                    for (int n = 0; n < 2; ++n) *(f32x4*)(rowp + bj * HALF + n * 16) = acc[ai][bj][m][n] + bv[bj][n]; }
    }
};
struct EpiResid {
    static constexpr bool PERM = false;
    const float* xlo; const float* xhi; const bf16_t* x16; const float* gmod  ; bf16_t* out;
    DEV void operator()(const f32x4 (&acc)[2][2][4][2], const Unit& u, int wr, int wc, int fr, int fq) const {
        const int row0 = u.pm * BM + wr * 64 + fr, col0 = u.pn * BM + wc * 32 + 4 * fq;
#pragma unroll
        for (int ai = 0; ai < 2; ++ai)
#pragma unroll
            for (int m = 0; m < 4; ++m) {
                const int row = row0 + ai * HALF + m * 16;
                if (row < NTOK) {
                    const float* gr = gmod + (size_t)tok_batch(row) * MODW + col0;
                    bf16_t* rowp = out + (size_t)row * D + col0;
#pragma unroll
                    for (int bj = 0; bj < 2; ++bj)
#pragma unroll
                        for (int n = 0; n < 2; ++n) { f32x4 xv;
                            if (x16) { const u32x2 xw = *(const u32x2*)(x16 + (size_t)row * D + col0 + bj * HALF + n * 16); xv = (f32x4){lo16(xw.x), hi16(xw.x), lo16(xw.y), hi16(xw.y)}; }
                            else xv = *(const f32x4*)((row < NP ? xlo + (size_t)row * D : xhi + (size_t)(row - NP) * D) + col0 + bj * HALF + n * 16);
                            const f32x4 gv = *(const f32x4*)(gr + bj * HALF + n * 16), o = xv + gv * acc[ai][bj][m][n];
                            u32x2 ow; ow.x = pack2(o[0], o[1]); ow.y = pack2(o[2], o[3]); *(u32x2*)(rowp + bj * HALF + n * 16) = ow; }
                }
            }
    }
};
struct EpiBf16 {
    static constexpr bool PERM = true;
    bf16_t* O; int ldc;
    DEV void operator()(const f32x4 (&acc)[2][2][4][2], const Unit& u, int wr, int wc, int fr, int fq) const {
        const int row0 = u.pm * BM + wr * 64 + fr, col0 = u.pn * BM + wc * 32 + 8 * fq;
#pragma unroll
        for (int ai = 0; ai < 2; ++ai)
#pragma unroll
            for (int m = 0; m < 4; ++m) { bf16_t* rowp = O + (size_t)(row0 + ai * HALF + m * 16) * ldc + col0;
#pragma unroll
                for (int bj = 0; bj < 2; ++bj) { const f32x4 v0 = acc[ai][bj][m][0], v1 = acc[ai][bj][m][1];
                    u32x4 w; w.x = pack2(v0[0], v0[1]); w.y = pack2(v0[2], v0[3]); w.z = pack2(v1[0], v1[1]); w.w = pack2(v1[2], v1[3]);
                    *(u32x4*)(rowp + bj * HALF) = w; } }
    }
};
struct EpiPool {
    static constexpr bool PERM = true;
    bf16_t* cat; const float* pb; const float* ps;
    DEV void operator()(const f32x4 (&acc)[2][2][4][2], const Unit& u, int wr, int wc, int fr, int fq) const {
        const int g = u.pn, tok0 = u.pm * BM - g * MPAD + wr * 64 + fr, col0 = g * 256 + wc * 32 + 8 * fq;
#pragma unroll
        for (int bj = 0; bj < 2; ++bj) {
            const f32x4 b0 = *(const f32x4*)(pb + col0 + bj * HALF), b1 = *(const f32x4*)(pb + col0 + bj * HALF + 4);
            const f32x4 s0 = *(const f32x4*)(ps + col0 + bj * HALF), s1 = *(const f32x4*)(ps + col0 + bj * HALF + 4);
#pragma unroll
            for (int ai = 0; ai < 2; ++ai)
#pragma unroll
                for (int m = 0; m < 4; ++m) { const int tok = tok0 + ai * HALF + m * 16;
                    if (tok < NTOK) { const f32x4 v0 = (acc[ai][bj][m][0] + b0) * s0, v1 = (acc[ai][bj][m][1] + b1) * s1;
                        u32x4 w; w.x = pack2(v0[0], v0[1]); w.y = pack2(v0[2], v0[3]); w.z = pack2(v1[0], v1[1]); w.w = pack2(v1[2], v1[3]);
                        *(u32x4*)(cat + (size_t)tok * D + 1024 + col0 + bj * HALF) = w; } }
        }
    }
};

#ifdef HIPEMU
template <class Epi, class Sched>
static void gemm_phase(unsigned char*, const Gemm g, const Sched& S, const Epi& E) {
    const int tid = threadIdx.x, wid = tid >> 6, lane = tid & 63, wr = wid >> 2, wc = wid & 3, fr = lane & 15, fq = lane >> 4;
    Unit cur;
    for (int ui = 0; S.next(ui, cur); ++ui) {
        f32x4 acc[2][2][4][2];
        for (int ai = 0; ai < 2; ++ai) for (int bj = 0; bj < 2; ++bj) for (int m = 0; m < 4; ++m) for (int n = 0; n < 2; ++n) for (int j = 0; j < 4; ++j) {
            const int row = 256 * cur.pm + 128 * ai + 64 * wr + 16 * m + fr;
            const int col = Epi::PERM ? 256 * cur.pn + 128 * bj + 32 * wc + 8 * fq + 4 * n + j : 256 * cur.pn + 128 * bj + 32 * wc + 16 * n + 4 * fq + j;
            float s = 0.f;
            if ((row % emu_row_mod) < emu_row_limit) { const float* a = emu_f32_copy(g.A, (size_t)g.M * g.K) + (size_t)row * g.K; const float* b = emu_f32_copy(g.Bt, (size_t)g.N * g.K) + (size_t)col * g.K;
                for (int k = 0; k < g.K; ++k) s += a[k] * b[k]; }
            acc[ai][bj][m][n][j] = s; }
        E(acc, cur, wr, wc, fr, fq);
    }
    __syncthreads();
}
#else
template <class Epi, class Sched>
__device__ __forceinline__ void gemm_phase(LAS unsigned char* lds, const Gemm g, const Sched& S, const Epi& E) {
    const int tid = threadIdx.x, wid = __builtin_amdgcn_readfirstlane(tid >> 6), lane = tid & 63, wr = wid >> 2, wc = wid & 3, fr = lane & 15, fq = lane >> 4;
    int K = g.K; asm volatile("" : "+s"(K));
    const int nt = K / BK;
    unsigned voffA[2], voffB[2];
#pragma unroll
    for (int i = 0; i < 2; ++i) { int R, C; stage_rc(tid * 16 + i * 8192, R, C); const int Rb = Epi::PERM ? ((R & ~31) + perm32(R & 31)) : R;
        voffA[i] = (unsigned)(R * K + C) * 2u; voffB[i] = (unsigned)(Rb * K + C) * 2u; }
    const size_t kstep = (size_t)(BK * 2);
    const size_t hstep = (size_t)HALF * K * 2;
    const size_t tstep = 2 * hstep;
    const unsigned ldsw = (unsigned)wid * 1024u;
    const int aoff = lds_byte(wr * 64 + fr, fq * 8), boff = lds_byte(wc * 32 + fr, fq * 8);
#define PG8_SA(b, h) (((b) * 2 + (h)) * HTB)
#define PG8_SB(b, h) ((4 + (b) * 2 + (h)) * HTB)
#define PG8_STAGE(bufoff, gbase, voff) do { _Pragma("unroll") for (int _i = 0; _i < 2; ++_i) \
        __builtin_amdgcn_global_load_lds((const unsigned*)((const char*)(gbase) + (voff)[_i]), (LAS unsigned*)(lds + (bufoff) + ldsw + _i * 8192), 16, 0, 0); } while (0)
#define PG8_LDA(dst, b, h) do { _Pragma("unroll") for (int m = 0; m < 4; ++m) _Pragma("unroll") for (int k = 0; k < 2; ++k) dst[m][k] = *(const LAS bf16x8*)(lds + PG8_SA(b, h) + aoff + m * 2048 + k * 1024); } while (0)
#define PG8_LDB(dst, b, h) do { _Pragma("unroll") for (int n = 0; n < 2; ++n) _Pragma("unroll") for (int k = 0; k < 2; ++k) dst[n][k] = *(const LAS bf16x8*)(lds + PG8_SB(b, h) + boff + n * 2048 + k * 1024); } while (0)
#define PG8_MMA(ai, bj, At, Bt) do { __builtin_amdgcn_s_setprio(1); _Pragma("unroll") for (int m = 0; m < 4; ++m) _Pragma("unroll") for (int n = 0; n < 2; ++n) _Pragma("unroll") for (int k = 0; k < 2; ++k) \
        acc[ai][bj][m][n] = __builtin_amdgcn_mfma_f32_16x16x32_bf16(Bt[n][k], At[m][k], acc[ai][bj][m][n], 0, 0, 0); __builtin_amdgcn_s_setprio(0); } while (0)
#define PG8_WAIT_V(n) asm volatile("s_waitcnt vmcnt(" #n ")" ::: "memory")
#define PG8_WAIT_L(n) asm volatile("s_waitcnt lgkmcnt(" #n ")" ::: "memory")
#define PG8_BAR __builtin_amdgcn_s_barrier()
#define PG8_SCHED __builtin_amdgcn_sched_barrier(0)
    Unit cur, nxt; int ui = 0;
    if (!S.next(0, cur)) return;
    f32x4 acc[2][2][4][2];
#pragma unroll
    for (int a = 0; a < 2; ++a)
#pragma unroll
        for (int b = 0; b < 2; ++b)
#pragma unroll
            for (int m = 0; m < 4; ++m)
#pragma unroll
                for (int n = 0; n < 2; ++n) acc[a][b][m][n] = (f32x4){0.f, 0.f, 0.f, 0.f};
    bf16x8 At[4][2], B0[2][2], B1[2][2];
    const char* cA = (const char*)g.A + (size_t)cur.pm * tstep; const char* cB = (const char*)g.Bt + (size_t)cur.pn * tstep;
    S.a_ready(cur);
    PG8_STAGE(PG8_SB(0, 0), cB, voffB); PG8_STAGE(PG8_SA(0, 0), cA, voffA); PG8_STAGE(PG8_SB(0, 1), cB + hstep, voffB); PG8_STAGE(PG8_SA(0, 1), cA + hstep, voffA);
    if (wr == 1) PG8_BAR;
    PG8_WAIT_V(4); PG8_BAR;
    PG8_STAGE(PG8_SB(1, 0), cB + kstep, voffB); PG8_STAGE(PG8_SA(1, 0), cA + kstep, voffA); PG8_STAGE(PG8_SB(1, 1), cB + hstep + kstep, voffB);
    PG8_WAIT_V(6); PG8_BAR;
    for (;;) {
        const bool has_next = S.next(ui + 1, nxt);
        const char* nA = has_next ? (const char*)g.A + (size_t)nxt.pm * tstep : cA; const char* nB = has_next ? (const char*)g.Bt + (size_t)nxt.pn * tstep : cB;
        for (int t = 0; t < nt; t += 2) {
            const bool last = (t == nt - 2);
            const char* a1 = cA + (size_t)(t + 1) * kstep;
            const char* a2 = last ? nA : cA + (size_t)(t + 2) * kstep; const char* b2 = last ? nB : cB + (size_t)(t + 2) * kstep;
            const char* a3 = a2 + kstep; const char* b3 = b2 + kstep;
            if (last && has_next) S.a_ready(nxt);
            PG8_LDB(B0, 0, 0); PG8_SCHED; PG8_LDA(At, 0, 0); PG8_STAGE(PG8_SA(1, 1), a1 + hstep, voffA);
            PG8_WAIT_L(8); PG8_BAR; PG8_WAIT_L(0); PG8_MMA(0, 0, At, B0); PG8_BAR; PG8_SCHED;
            PG8_LDB(B1, 0, 1); PG8_STAGE(PG8_SB(0, 0), b2, voffB);
            PG8_BAR; PG8_WAIT_L(0); PG8_MMA(0, 1, At, B1); PG8_BAR;
            PG8_LDA(At, 0, 1); PG8_STAGE(PG8_SA(0, 0), a2, voffA);
            PG8_BAR; PG8_WAIT_L(0); PG8_MMA(1, 0, At, B0); PG8_BAR; PG8_SCHED;
            PG8_STAGE(PG8_SB(0, 1), b2 + hstep, voffB);
            PG8_WAIT_V(6); PG8_BAR; PG8_MMA(1, 1, At, B1); PG8_BAR;
            PG8_LDB(B0, 1, 0); PG8_SCHED; PG8_LDA(At, 1, 0); PG8_STAGE(PG8_SA(0, 1), a2 + hstep, voffA);
            PG8_WAIT_L(8); PG8_BAR; PG8_WAIT_L(0); PG8_MMA(0, 0, At, B0); PG8_BAR; PG8_SCHED;
            PG8_LDB(B1, 1, 1); PG8_STAGE(PG8_SB(1, 0), b3, voffB);
            PG8_BAR; PG8_WAIT_L(0); PG8_MMA(0, 1, At, B1); PG8_BAR;
            PG8_LDA(At, 1, 1); PG8_STAGE(PG8_SA(1, 0), a3, voffA);
            PG8_BAR; PG8_WAIT_L(0); PG8_MMA(1, 0, At, B0); PG8_BAR; PG8_SCHED;
            PG8_STAGE(PG8_SB(1, 1), b3 + hstep, voffB);
            PG8_WAIT_V(6); PG8_BAR; PG8_MMA(1, 1, At, B1); PG8_BAR;
        }
        { int tz = threadIdx.x; asm volatile("" : "+v"(tz)); const int wz = tz >> 6, lz = tz & 63;
          E(acc, cur, wz >> 2, wz & 3, lz & 15, lz >> 4); } S.done(cur);
        if (!has_next) break;
#pragma unroll
        for (int a = 0; a < 2; ++a)
#pragma unroll
            for (int b = 0; b < 2; ++b)
#pragma unroll
                for (int m = 0; m < 4; ++m)
#pragma unroll
                    for (int n = 0; n < 2; ++n) acc[a][b][m][n] = (f32x4){0.f, 0.f, 0.f, 0.f};
        cur = nxt; cA = nA; cB = nB; ++ui;
    }
    PG8_WAIT_V(0);
    if (wr == 0) PG8_BAR;
    PG8_BAR;
#undef PG8_SA
#undef PG8_SB
#undef PG8_STAGE
#undef PG8_LDA
#undef PG8_LDB
#undef PG8_MMA
#undef PG8_WAIT_V
#undef PG8_WAIT_L
#undef PG8_BAR
#undef PG8_SCHED
}
#endif
}

constexpr int MBIG = (NP / 256) * 256;
template <class F> DEV void small_gemm(const bf16_t* A, const bf16_t* Bt, int K, unsigned char* lds, const F& f) {
    const int tid = threadIdx.x, lane = tid & 63, w = tid >> 6, g = lane >> 4, c16 = lane & 15;
    const int tiles_m = (NTOK - MBIG + 63) / 64, ntiles = tiles_m * 32, kw = K / 8;
    float* part = (float*)lds;
    for (int tl = blockIdx.x; tl < ntiles; tl += gridDim.x) {
        const int r0 = MBIG + (tl / 32) * 64, n0 = (tl % 32) * 64;
        f32x4 acc[4][4];
#pragma unroll
        for (int i = 0; i < 4; ++i)
#pragma unroll
            for (int j = 0; j < 4; ++j) acc[i][j] = (f32x4){0.f, 0.f, 0.f, 0.f};
        for (int k0 = w * kw; k0 < (w + 1) * kw; k0 += 128) {
            bf16x8 af[4][4], bfr[4][4];
#pragma unroll
            for (int u = 0; u < 4; ++u)
#pragma unroll
                for (int i = 0; i < 4; ++i) { int arow = r0 + 16 * i + c16; if (arow >= MPAD) arow = MPAD - 1;
                    af[u][i] = *(const bf16x8*)(A + (size_t)arow * K + k0 + 32 * u + 8 * g); bfr[u][i] = *(const bf16x8*)(Bt + (size_t)(n0 + 16 * i + c16) * K + k0 + 32 * u + 8 * g); }
#pragma unroll
            for (int u = 0; u < 4; ++u)
#pragma unroll
                for (int i = 0; i < 4; ++i)
#pragma unroll
                    for (int j = 0; j < 4; ++j) acc[i][j] = MFMA_BF16(af[u][i], bfr[u][j], acc[i][j]);
        }
#pragma unroll
        for (int i = 0; i < 4; ++i)
#pragma unroll
            for (int j = 0; j < 4; ++j)
#pragma unroll
                for (int r = 0; r < 4; ++r) part[(w * 64 + 16 * i + 4 * g + r) * 68 + 16 * j + c16] = acc[i][j][r];
        __syncthreads();
        {
            const int row = tid >> 3, c8 = (tid & 7) * 8; f32x4 s0 = (f32x4){0.f, 0.f, 0.f, 0.f}, s1 = s0;
#pragma unroll
            for (int ww = 0; ww < 8; ++ww) { s0 += *(const f32x4*)(part + (ww * 64 + row) * 68 + c8); s1 += *(const f32x4*)(part + (ww * 64 + row) * 68 + c8 + 4); }
            if (r0 + row < NTOK) f(r0 + row, n0 + c8, s0, s1);
        }
        __syncthreads();
    }
}
struct SmallResid { const float* xlo; const float* xhi; const bf16_t* x16; const float* gmod; bf16_t* out;
    DEV void operator()(int row, int col, f32x4 v0, f32x4 v1) const { const float* gr = gmod + (size_t)tok_batch(row) * MODW + col; f32x4 x0, x1;
        if (x16) { const u32x4 xw = *(const u32x4*)(x16 + (size_t)row * D + col); x0 = (f32x4){lo16(xw.x), hi16(xw.x), lo16(xw.y), hi16(xw.y)}; x1 = (f32x4){lo16(xw.z), hi16(xw.z), lo16(xw.w), hi16(xw.w)}; }
        else { const float* xr = (row < NP ? xlo + (size_t)row * D : xhi + (size_t)(row - NP) * D) + col; x0 = *(const f32x4*)xr; x1 = *(const f32x4*)(xr + 4); }
        const f32x4 o0 = x0 + *(const f32x4*)gr * v0, o1 = x1 + *(const f32x4*)(gr + 4) * v1;
        u32x4 ow; ow.x = pack2(o0[0], o0[1]); ow.y = pack2(o0[2], o0[3]); ow.z = pack2(o1[0], o1[1]); ow.w = pack2(o1[2], o1[3]); *(u32x4*)(out + (size_t)row * D + col) = ow; } };
struct SmallF32 { float* out; DEV void operator()(int row, int col, f32x4 v0, f32x4 v1) const { float* o = out + (size_t)row * D + col; *(f32x4*)o = v0; *(f32x4*)(o + 4) = v1; } };

DEV void transpose_tile(const float* src, int ld_src, bf16_t* dst, int ld_dst, float* tile) {
    const int tid = threadIdx.x;
#pragma unroll
    for (int i = 0; i < 2; ++i) { const int idx = tid + i * 512, r = idx >> 4, c4 = idx & 15; const f32x4 v = *(const f32x4*)(src + (size_t)r * ld_src + c4 * 4);
        float* t = tile + r * 65 + c4 * 4; t[0] = v[0]; t[1] = v[1]; t[2] = v[2]; t[3] = v[3]; }
    __syncthreads();
    const int n = tid >> 3, kg = tid & 7; const float* t = tile + (kg * 8) * 65 + n;
    u32x4 w; w.x = pack2(t[0], t[65]); w.y = pack2(t[2 * 65], t[3 * 65]); w.z = pack2(t[4 * 65], t[5 * 65]); w.w = pack2(t[6 * 65], t[7 * 65]);
    *(u32x4*)(dst + (size_t)n * ld_dst + kg * 8) = w;
    __syncthreads();
}
constexpr int ADA_UNITS = MODW / 128, ADA_RT = (NC + 15) / 16, ADA_AS = 72;
DEV void ada_direct_unit(const Params& p, int unit, unsigned char* lds) {
    const int tid = threadIdx.x, lane = tid & 63, w = wave_id(), rho = lane & 15, gam = lane >> 4;
    const int n0 = unit * 128;
    const float* W; const float* bias; int ldw, cw;
    if (n0 < NMOD) { W = p.w_ada; bias = p.b_ada; ldw = NMOD; cw = n0; }
    else if (n0 < 2 * NMOD) { W = p.w_ada + (size_t)D * NMOD; bias = p.b_ada + NMOD; ldw = NMOD; cw = n0 - NMOD; }
    else { W = p.w_ada_final; bias = p.b_ada_final; ldw = 2 * D; cw = n0 - 2 * NMOD; }
    const float* wu = W + cw + 16 * w; const unsigned loff = (unsigned)(8 * gam * ldw + rho);
    bf16_t* As = (bf16_t*)lds;
    f32x4 acc[ADA_RT];
#pragma unroll
    for (int rt = 0; rt < ADA_RT; ++rt) acc[rt] = (f32x4){0.f, 0.f, 0.f, 0.f};
    constexpr int NCH = D / 64, ACNT = (16 * ADA_RT * 16 + 511) / 512;
    float wa[16], wb[16], wc2[16]; f32x4 cr[ACNT];
#define ADA_WLOAD(dst, kc_) do { const float* wq_ = wu + (size_t)(64 * (kc_)) * ldw; _Pragma("unroll") for (int s2 = 0; s2 < 2; ++s2) _Pragma("unroll") for (int j = 0; j < 8; ++j) dst[8 * s2 + j] = (wq_ + (size_t)(32 * s2 + j) * ldw)[loff]; } while (0)
#define ADA_CLOAD(kc_) do { _Pragma("unroll") for (int u = 0; u < ACNT; ++u) { const int i = tid + 512 * u, r = i >> 4, k4 = (i & 15) * 4; cr[u] = (f32x4){0.f, 0.f, 0.f, 0.f}; \
        if (r < NC) cr[u] = *(const f32x4*)((r < PB ? p.c_prompt + (size_t)r * D : p.c_sample + (size_t)(r - PB) * D) + 64 * (kc_) + k4); } } while (0)
#define ADA_CHUNK(wreg, kc_) do { bf16_t* Ab = As + ((kc_) & 1) * (16 * ADA_RT * ADA_AS); \
        _Pragma("unroll") for (int u = 0; u < ACNT; ++u) { const int i = tid + 512 * u, r = i >> 4, k4 = (i & 15) * 4; \
            if (i < 16 * ADA_RT * 16) { u32x2 pk; pk.x = pack2(siluf_(cr[u][0]), siluf_(cr[u][1])); pk.y = pack2(siluf_(cr[u][2]), siluf_(cr[u][3])); *(u32x2*)(Ab + r * ADA_AS + k4) = pk; } } \
        if ((kc_) + 1 < NCH) ADA_CLOAD((kc_) + 1); \
        u32x4 bw[2]; _Pragma("unroll") for (int s2 = 0; s2 < 2; ++s2) { bw[s2].x = pack2(wreg[8 * s2], wreg[8 * s2 + 1]); bw[s2].y = pack2(wreg[8 * s2 + 2], wreg[8 * s2 + 3]); bw[s2].z = pack2(wreg[8 * s2 + 4], wreg[8 * s2 + 5]); bw[s2].w = pack2(wreg[8 * s2 + 6], wreg[8 * s2 + 7]); } \
        if ((kc_) + 3 < NCH) ADA_WLOAD(wreg, (kc_) + 3); \
        __syncthreads(); \
        _Pragma("unroll") for (int s2 = 0; s2 < 2; ++s2) { const bf16x8 bf = __builtin_bit_cast(bf16x8, bw[s2]); \
            _Pragma("unroll") for (int rt = 0; rt < ADA_RT; ++rt) { const bf16x8 af = *(const bf16x8*)(Ab + (16 * rt + rho) * ADA_AS + 32 * s2 + 8 * gam); acc[rt] = MFMA_BF16(af, bf, acc[rt]); } } } while (0)
    static_assert(NCH % 3 == 2, "chunk ring");
    ADA_WLOAD(wa, 0); ADA_WLOAD(wb, 1); ADA_WLOAD(wc2, 2); ADA_CLOAD(0);
    for (int kc = 0; kc + 2 < NCH; kc += 3) { ADA_CHUNK(wa, kc); ADA_CHUNK(wb, kc + 1); ADA_CHUNK(wc2, kc + 2); }
    ADA_CHUNK(wa, NCH - 2); ADA_CHUNK(wb, NCH - 1);
#undef ADA_WLOAD
#undef ADA_CLOAD
#undef ADA_CHUNK
    const float bv = bias[cw + 16 * w + rho];
#pragma unroll
    for (int rt = 0; rt < ADA_RT; ++rt)
#pragma unroll
        for (int r = 0; r < 4; ++r) { const int row = 16 * rt + 4 * gam + r; if (row < NC) p.modbuf[(size_t)row * MODW + n0 + 16 * w + rho] = acc[rt][r] + bv; }
    __syncthreads();
}
DEV int cvt_job_tiles(int j) { const int K = j < 9 ? 2048 : 256; const int N = j < 2 ? NMOD : (j == 2 ? 2 * D : (j < 5 ? ZW : (j < 9 ? D : 256))); return (K / 64) * (N / 64); }
constexpr int TBL_SLOT = 10240, TBL_VP1 = 4 * NE - 2 * TBL_SLOT;
DEV int gemm_in_idle_blocks() { const int nwg = (MPAD / 256) * (ZW / 256), G = (int)gridDim.x, rounds = (nwg + G - 1) / G, full = nwg - (rounds - 1) * G; return G - full; }
DEV bool tbl_deferred() { return gemm_in_idle_blocks() >= 32; }
DEV void table_row_to_fp8(const Params& p, int vr, int lane) {
    const int l = vr / (2 * NE), which = (vr % (2 * NE)) / NE, e = vr % NE, rr = l * NE + e;
    const float* src = (which ? p.peer_v : p.peer_u) + (size_t)rr * D;
    f32x4 v[8]; float am = 0.f;
#pragma unroll
    for (int k = 0; k < 8; ++k) { v[k] = *(const f32x4*)(src + 4 * lane + 256 * k); am = fmaxf(am, fmaxf(fmaxf(fabsf(v[k][0]), fabsf(v[k][1])), fmaxf(fabsf(v[k][2]), fabsf(v[k][3])))); }
    am = wave_max(am);
    unsigned char* tab = (which ? p.v8 : p.u8) + (size_t)l * NE * (D / 2);
    const float sc = am > 0.f ? 6.0f / am : 1.0f;
#pragma unroll
    for (int k = 0; k < 8; ++k) *(unsigned short*)(tab + ((size_t)k * NE + e) * 128 + 2 * lane) = (unsigned short)fp4x4_enc(v[k][0] * sc, v[k][1] * sc, v[k][2] * sc, v[k][3] * sc);
    if (lane == 0) (which ? p.sv : p.su)[rr] = am > 0.f ? am * (1.0f / 6.0f) : 1.0f;
}
DEV void phase_tbl_slot(const Params& p, int l) {
    const int idle = gemm_in_idle_blocks(), first = (int)gridDim.x - idle;
    if (idle < 32 || (int)blockIdx.x < first) return;
    const int gw = ((int)blockIdx.x - first) * 8 + wave_id(), nw = idle * 8, lo = TBL_VP1 + l * TBL_SLOT;
    for (int vr = lo + gw; vr < lo + TBL_SLOT; vr += nw) table_row_to_fp8(p, vr, threadIdx.x & 63);
}
DEV void phase_convert(const Params& p, unsigned char* lds, int part) {
    float* tile = (float*)lds;
    const int tid = threadIdx.x;
    const int q_lo = part == 0 ? 0 : 3, q_hi = part == 0 ? 3 : 17;
    int total = 0;
#pragma unroll
    for (int q = 0; q < 17; ++q) if (q >= q_lo && q < q_hi) total += cvt_job_tiles(q);
    for (int tl = blockIdx.x; tl < total; tl += gridDim.x) {
        int j = 0, loc = 0, base = 0;
#pragma unroll
        for (int q = 0; q < 17; ++q) if (q >= q_lo && q < q_hi) { const int cnt = cvt_job_tiles(q); if (tl >= base && tl < base + cnt) { j = q; loc = tl - base; } base += cnt; }
        const float* src; bf16_t* dst; int K = 2048, N;
        if (j < 2) { N = NMOD; src = p.w_ada + (size_t)j * 2048 * NMOD; dst = p.wt_ada + (size_t)j * NMOD * 2048; }
        else if (j == 2) { N = 2 * D; src = p.w_ada_final; dst = p.wt_ada + (size_t)2 * NMOD * 2048; }
        else if (j < 5) { N = ZW; src = p.w_in + (size_t)(j - 3) * 2048 * ZW; dst = p.wt_in + (size_t)(j - 3) * ZW * 2048; }
        else if (j < 7) { N = D; src = p.w_out + (size_t)(j - 5) * D * D; dst = p.wt_out + (size_t)(j - 5) * D * D; }
        else if (j < 9) { N = D; src = p.peer_wq + (size_t)(j - 7) * D * D; dst = p.wt_q + (size_t)(j - 7) * D * D; }
        else { K = 256; N = 256; src = p.pool_w + (size_t)(j - 9) * 65536; dst = p.wt_pool + (size_t)(j - 9) * 65536; }
        const int ntn = N / 64, kt = loc / ntn, nt = loc % ntn;
        transpose_tile(src + (size_t)kt * 64 * N + nt * 64, N, dst + (size_t)nt * 64 * K + kt * 64, K, tile);
    }
    const size_t gt = (size_t)blockIdx.x * 512 + tid, gs = (size_t)gridDim.x * 512;
    if (part == 1) {
        constexpr int NADA = ADA_UNITS;
        const int vend = tbl_deferred() ? TBL_VP1 : 4 * NE, R1 = vend - 2048;
        const bool uneven = (int)gridDim.x > NADA + 16;
        for (int seg = 0; seg < 2; ++seg) {
            int gw, nw, r_lo, r_hi;
            if (!uneven) { if (seg) break; gw = blockIdx.x * 8 + wave_id(); nw = gridDim.x * 8; r_lo = 0; r_hi = vend; }
            else if (seg == 0) { gw = blockIdx.x * 8 + wave_id(); nw = gridDim.x * 8; r_lo = 0; r_hi = R1; }
            else { if ((int)blockIdx.x < NADA) break; gw = ((int)blockIdx.x - NADA) * 8 + wave_id(); nw = ((int)gridDim.x - NADA) * 8; r_lo = R1; r_hi = vend; }
            for (int vr = r_lo + gw; vr < r_hi; vr += nw) table_row_to_fp8(p, vr, tid & 63);
        }
    }
    if (part == 0) for (size_t i = gt; i < (size_t)256 * D / 8; i += gs) {
        const int row = (int)(i / (D / 8)), c8 = (int)(i % (D / 8)) * 8; u32x4 w = (u32x4){0u, 0u, 0u, 0u};
        if (row < NC) { const float* s = (row < PB ? p.c_prompt + (size_t)row * D : p.c_sample + (size_t)(row - PB) * D) + c8;
            const f32x4 a = *(const f32x4*)s, b = *(const f32x4*)(s + 4);
            w.x = pack2(siluf_(a[0]), siluf_(a[1])); w.y = pack2(siluf_(a[2]), siluf_(a[3])); w.z = pack2(siluf_(b[0]), siluf_(b[1])); w.w = pack2(siluf_(b[2]), siluf_(b[3])); }
        *(u32x4*)(p.csil + i * 8) = w;
    }
}

DEV void phase_norm(const Params& p, const float* xlo, const float* xhi, const bf16_t* x16, const float* gn, int sh_off, int sc_off, bf16_t* obf, float* of32) {
    const int lane = threadIdx.x & 63, gw = blockIdx.x * 8 + wave_id(), nw = gridDim.x * 8;
    for (int t = gw; t < NTOK; t += nw) {
        const float* xr = x16 ? nullptr : (t < NP ? xlo + (size_t)t * D : xhi + (size_t)(t - NP) * D);
        const float* mrow = p.modbuf + (size_t)tok_batch(t) * MODW;
        f32x4 v[8]; float ss = 0.f;
#pragma unroll
        for (int c = 0; c < 4; ++c) { const int col = c * 512 + lane * 8;
            if (x16) { const u32x4 xw = *(const u32x4*)(x16 + (size_t)t * D + col); v[2 * c] = (f32x4){lo16(xw.x), hi16(xw.x), lo16(xw.y), hi16(xw.y)}; v[2 * c + 1] = (f32x4){lo16(xw.z), hi16(xw.z), lo16(xw.w), hi16(xw.w)}; }
            else { v[2 * c] = *(const f32x4*)(xr + col); v[2 * c + 1] = *(const f32x4*)(xr + col + 4); }
#pragma unroll
            for (int j = 0; j < 4; ++j) ss += v[2 * c][j] * v[2 * c][j] + v[2 * c + 1][j] * v[2 * c + 1][j]; }
        ss = wave_sum(ss);
        const float rstd = rsqrtf(ss * (1.0f / D) + EPS);
#pragma unroll
        for (int c = 0; c < 4; ++c) { const int col = c * 512 + lane * 8; f32x4 y[2];
#pragma unroll
            for (int q = 0; q < 2; ++q) { const f32x4 g4 = *(const f32x4*)(gn + col + 4 * q), sc = *(const f32x4*)(mrow + sc_off + col + 4 * q), sh = *(const f32x4*)(mrow + sh_off + col + 4 * q);
                y[q] = (v[2 * c + q] * rstd) * g4 * (sc + 1.0f) + sh; }
            if (obf) { u32x4 w; w.x = pack2(y[0][0], y[0][1]); w.y = pack2(y[0][2], y[0][3]); w.z = pack2(y[1][0], y[1][1]); w.w = pack2(y[1][2], y[1][3]); *(u32x4*)(obf + (size_t)t * D + col) = w; }
            else { *(f32x4*)(of32 + (size_t)t * D + col) = y[0]; *(f32x4*)(of32 + (size_t)t * D + col + 4) = y[1]; }
        }
    }
}

namespace hg {
constexpr int QS = 136, VS = 72;
constexpr int O_QT = 0, O_QH = O_QT + 64 * QS * 2, O_KT = O_QH + 64 * QS * 2, O_KDT = O_KT + 160 * QS * 2, O_VT = O_KDT + 128 * VS * 2,
              O_AB = O_VT + 128 * VS * 2, O_GS = O_AB + 64 * VS * 2, O_END = O_GS + 4 * 128 * 4;
constexpr int OS = 132;
static_assert(O_END <= 163840 - 64, "HGRN LDS layout too large");
constexpr int NCHUNK = SEQ / 64, NUNIT = PB * HH * NCHUNK;
}
DEV int kt_rowbase(int i) { return i == 0 ? 0 : (i == 1 ? 16 : (i == 2 ? 48 : 96)); }

DEV void hgrn_pre_unit(const Params& p, int l, int unit, unsigned char* lds) {
    using namespace hg;
    const int tid = threadIdx.x, lane = tid & 63, w = tid >> 6, g = lane >> 4, c16 = lane & 15;
    const int c = unit % NCHUNK, bh = unit / NCHUNK, b = bh / HH, h = bh % HH;
    bf16_t* Qt = (bf16_t*)(lds + O_QT); bf16_t* Qh = (bf16_t*)(lds + O_QH); bf16_t* Kt = (bf16_t*)(lds + O_KT);
    bf16_t* Kdt = (bf16_t*)(lds + O_KDT); bf16_t* Vt = (bf16_t*)(lds + O_VT); bf16_t* Ab = (bf16_t*)(lds + O_AB); float* Gs = (float*)(lds + O_GS);
    const int kk = tid & 127, sj = tid >> 7;
    float lbv = 0.f;
    if (l > 0) lbv = sigmoidf_(p.lb_logits[HH * HD + h * HD + kk] - p.lb_logits[h * HD + kk]);
    const float oml = 1.0f - lbv;
    for (int i = tid; i < 64 * VS / 2; i += 512) ((unsigned*)Ab)[i] = 0u;
    const size_t row0 = (size_t)b * SEQ + c * 64;
    float Gl[16], qv[16], kv[16];
    {
        const bf16_t* zr = p.z + (row0 + sj * 16) * ZW + h * HD + kk;
        unsigned short zq16[16], zf16[16], zi16[16];
#pragma unroll
        for (int s = 0; s < 16; ++s) { zq16[s] = zr[(size_t)s * ZW]; zf16[s] = zr[(size_t)s * ZW + 1024]; zi16[s] = zr[(size_t)s * ZW + 2048]; }
        float run = 0.f; unsigned vpk[8];
#pragma unroll
        for (int s = 0; s < 16; ++s) {
            const float zq = bf2f(zq16[s]), zf = fminf(fmaxf(bf2f(zf16[s]), -80.f), 80.f);
            const float e = __expf(-zf), sg = 1.0f / (1.0f + e);
            const float f = lbv + oml * sg;
            run += __logf(f); Gl[s] = run;
            kv[s] = oml * (e * sg);
            qv[s] = siluf_(zq);
            if (s & 1) vpk[s >> 1] |= (unsigned)zi16[s] << 16; else vpk[s >> 1] = zi16[s];
        }
        Gs[sj * 128 + kk] = run;
        *(u32x4*)(Vt + kk * VS + sj * 16) = (u32x4){vpk[0], vpk[1], vpk[2], vpk[3]}; *(u32x4*)(Vt + kk * VS + sj * 16 + 8) = (u32x4){vpk[4], vpk[5], vpk[6], vpk[7]};
    }
    __syncthreads();
    float Gend;
    {
        const float g0 = Gs[kk], g1 = Gs[128 + kk], g2 = Gs[256 + kk], g3 = Gs[384 + kk];
        float Gb[4]; Gb[0] = 0.f; Gb[1] = g0; Gb[2] = g0 + g1; Gb[3] = g0 + g1 + g2; Gend = Gb[3] + g3;
        const float Gbj = sj == 0 ? Gb[0] : (sj == 1 ? Gb[1] : (sj == 2 ? Gb[2] : Gb[3]));
        const float eGb = __expf(Gbj);
        unsigned kd[8]; unsigned qh[8];
#pragma unroll
        for (int s = 0; s < 16; ++s) {
            const int t = sj * 16 + s;
            const float q1 = qv[s] * __expf(Gl[s]);
            Qt[t * QS + kk] = (bf16_t)f2bf(q1);
            const unsigned qhv = f2bf(q1 * eGb);
            Qh[t * QS + kk] = (bf16_t)qhv;
#pragma unroll
            for (int i = 0; i < 4; ++i) if (i >= sj) Kt[(kt_rowbase(i) + t) * QS + kk] = (bf16_t)f2bf(kv[s] * __expf(fminf(Gb[i] - Gbj - Gl[s], 60.f)));
            const unsigned kdv = f2bf(kv[s] * __expf(Gend - Gbj - Gl[s]));
            if (s & 1) kd[s >> 1] |= kdv << 16; else kd[s >> 1] = kdv;
        }
        *(u32x4*)(Kdt + kk * VS + sj * 16) = (u32x4){kd[0], kd[1], kd[2], kd[3]}; *(u32x4*)(Kdt + kk * VS + sj * 16 + 8) = (u32x4){kd[4], kd[5], kd[6], kd[7]};
        if (sj == 0) p.hg_gam[(size_t)unit * HD + kk] = __expf(Gend);
    }
    __syncthreads();
    {
        const int t = tid >> 3, part = tid & 7;
        const u32x4 a = *(const u32x4*)(Qh + t * QS + 16 * part), b2 = *(const u32x4*)(Qh + t * QS + 16 * part + 8);
        bf16_t* dst = p.hg_qh + (row0 + t) * 1024 + h * HD + 16 * part; *(u32x4*)dst = a; *(u32x4*)(dst + 8) = b2;
    }
    for (int blk = w; blk < 10; blk += 8) {
        int bi, bjj;
        if (blk == 0) { bi = 0; bjj = 0; } else if (blk < 3) { bi = 1; bjj = blk - 1; } else if (blk < 6) { bi = 2; bjj = blk - 3; } else { bi = 3; bjj = blk - 6; }
        f32x4 acc = (f32x4){0.f, 0.f, 0.f, 0.f};
#pragma unroll
        for (int ks = 0; ks < 4; ++ks) {
            const bf16x8 a = *(const bf16x8*)(Qt + (16 * bi + c16) * QS + 32 * ks + 8 * g);
            const bf16x8 bb = *(const bf16x8*)(Kt + (kt_rowbase(bi) + 16 * bjj + c16) * QS + 32 * ks + 8 * g);
            acc = MFMA_BF16(a, bb, acc);
        }
#pragma unroll
        for (int r = 0; r < 4; ++r) { const int tl = 4 * g + r; float v = acc[r]; if (bi == bjj && c16 > tl) v = 0.f; Ab[(16 * bi + tl) * VS + 16 * bjj + c16] = (bf16_t)f2bf(v); }
    }
    __syncthreads();
    {
        u32x2* oin = (u32x2*)(p.hg_oin + (size_t)unit * 64 * 128);
#pragma unroll
        for (int tt = 0; tt < 4; ++tt) {
            f32x4 acc = (f32x4){0.f, 0.f, 0.f, 0.f};
#pragma unroll
            for (int ks = 0; ks < 2; ++ks) {
                const bf16x8 a = *(const bf16x8*)(Ab + (16 * tt + c16) * VS + 32 * ks + 8 * g);
                const bf16x8 bb = *(const bf16x8*)(Vt + (16 * w + c16) * VS + 32 * ks + 8 * g);
                acc = MFMA_BF16(a, bb, acc);
            }
            oin[(tt * 8 + w) * 64 + lane] = (u32x2){pack2(acc[0], acc[1]), pack2(acc[2], acc[3])};
        }
        u32x2* ds = (u32x2*)(p.hg_ds + (size_t)unit * 128 * 128);
#pragma unroll
        for (int vt = 0; vt < 8; ++vt) {
            f32x4 acc = (f32x4){0.f, 0.f, 0.f, 0.f};
#pragma unroll
            for (int ks = 0; ks < 2; ++ks) {
                const bf16x8 a = *(const bf16x8*)(Kdt + (16 * w + c16) * VS + 32 * ks + 8 * g);
                const bf16x8 bb = *(const bf16x8*)(Vt + (16 * vt + c16) * VS + 32 * ks + 8 * g);
                acc = MFMA_BF16(a, bb, acc);
            }
            ds[(w * 8 + vt) * 64 + lane] = (u32x2){pack2(acc[0], acc[1]), pack2(acc[2], acc[3])};
        }
    }
    __syncthreads();
}

DEV void hgrn_scan_unit(const Params& p, int l, int su) {
    using namespace hg;
    const int tid = threadIdx.x, lane = tid & 63, w = tid >> 6, g = lane >> 4, c16 = lane & 15;
    const int vt = su % 8, bh = su / 8, b = bh / HH, h = bh % HH;
    f32x4 S = (f32x4){0.f, 0.f, 0.f, 0.f};
    constexpr int CB = NCHUNK < 16 ? NCHUNK : 16;
    static_assert(NCHUNK % CB == 0, "chunk batch");
    for (int c0 = 0; c0 < NCHUNK; c0 += CB) {
        u32x2 dw[CB]; f32x4 gm[CB];
#pragma unroll
        for (int i = 0; i < CB; ++i) { const size_t unit = (size_t)bh * NCHUNK + c0 + i;
            dw[i] = ((const u32x2*)(p.hg_ds + unit * 128 * 128))[(w * 8 + vt) * 64 + lane]; gm[i] = *(const f32x4*)(p.hg_gam + unit * HD + 16 * w + 4 * g); }
#pragma unroll
        for (int i = 0; i < CB; ++i) { const size_t unit = (size_t)bh * NCHUNK + c0 + i;
            u32x2 sw; sw.x = pack2(S[0], S[1]); sw.y = pack2(S[2], S[3]);
            *(u32x2*)(p.hg_sc + (unit * 128 + 16 * vt + c16) * 128 + 16 * w + 4 * g) = sw;
            const f32x4 d = (f32x4){lo16(dw[i].x), hi16(dw[i].x), lo16(dw[i].y), hi16(dw[i].y)};
            S = S * gm[i] + d; }
    }
    float* so = p.out + OFF_HP + ((size_t)(l * PB + b) * HH + h) * HD * HD;
#pragma unroll
    for (int r = 0; r < 4; ++r) so[(size_t)(16 * w + 4 * g + r) * HD + 16 * vt + c16] = S[r];
}

DEV void hgrn_post_unit(const Params& p, int l, int unit, unsigned char* lds) {
    using namespace hg;
    const int tid = threadIdx.x, lane = tid & 63, w = tid >> 6, g = lane >> 4, c16 = lane & 15;
    const int c = unit % NCHUNK, bh = unit / NCHUNK, b = bh / HH, h = bh % HH;
    float* Ob = (float*)lds;
    const size_t row0 = (size_t)b * SEQ + c * 64;
    const u32x2* oin = (const u32x2*)(p.hg_oin + (size_t)unit * 64 * 128);
    u32x2 ow[4];
#pragma unroll
    for (int tt = 0; tt < 4; ++tt) ow[tt] = oin[(tt * 8 + w) * 64 + lane];
    bf16x8 bfr[4], af[4][4];
    if (c > 0) {
#pragma unroll
        for (int ks = 0; ks < 4; ++ks) bfr[ks] = *(const bf16x8*)(p.hg_sc + ((size_t)unit * 128 + 16 * w + c16) * 128 + 32 * ks + 8 * g);
#pragma unroll
        for (int tt = 0; tt < 4; ++tt)
#pragma unroll
            for (int ks = 0; ks < 4; ++ks) af[tt][ks] = *(const bf16x8*)(p.hg_qh + (row0 + 16 * tt + c16) * 1024 + h * HD + 32 * ks + 8 * g);
    }
    const bf16_t* zgp = p.z + (row0 + (tid >> 3)) * ZW + 3072 + h * HD + 16 * (tid & 7);
    const u32x4 za = *(const u32x4*)zgp, zc = *(const u32x4*)(zgp + 8);
    f32x4 acc[4];
#pragma unroll
    for (int tt = 0; tt < 4; ++tt) acc[tt] = (f32x4){lo16(ow[tt].x), hi16(ow[tt].x), lo16(ow[tt].y), hi16(ow[tt].y)};
    if (c > 0) {
#pragma unroll
        for (int tt = 0; tt < 4; ++tt)
#pragma unroll
            for (int ks = 0; ks < 4; ++ks) acc[tt] = MFMA_BF16(af[tt][ks], bfr[ks], acc[tt]);
    }
#pragma unroll
    for (int tt = 0; tt < 4; ++tt)
#pragma unroll
        for (int r = 0; r < 4; ++r) Ob[(16 * tt + 4 * g + r) * OS + 16 * w + c16] = acc[tt][r];
    __syncthreads();
    {
        const int t = tid >> 3, part = tid & 7; const size_t row = row0 + t;
        float ov[16]; float ss = 0.f;
#pragma unroll
        for (int q = 0; q < 4; ++q) { const f32x4 x = *(const f32x4*)(Ob + t * OS + 16 * part + 4 * q); ov[4 * q] = x[0]; ov[4 * q + 1] = x[1]; ov[4 * q + 2] = x[2]; ov[4 * q + 3] = x[3];
            ss += x[0] * x[0] + x[1] * x[1] + x[2] * x[2] + x[3] * x[3]; }
        ss += __shfl_xor(ss, 1); ss += __shfl_xor(ss, 2); ss += __shfl_xor(ss, 4);
        const float rstd = rsqrtf(ss * (1.0f / HD) + EPS);
        const unsigned zw[8] = {za.x, za.y, za.z, za.w, zc.x, zc.y, zc.z, zc.w};
        const float* gn = p.hgrn_norm_g + l * HD + 16 * part;
        unsigned ow[8];
#pragma unroll
        for (int q = 0; q < 8; ++q) { const float a0 = ov[2 * q] * rstd * gn[2 * q] * siluf_(lo16(zw[q])), a1 = ov[2 * q + 1] * rstd * gn[2 * q + 1] * siluf_(hi16(zw[q])); ow[q] = pack2(a0, a1); }
        bf16_t* dst = p.cat + row * D + h * HD + 16 * part;
        *(u32x4*)dst = (u32x4){ow[0], ow[1], ow[2], ow[3]}; *(u32x4*)(dst + 8) = (u32x4){ow[4], ow[5], ow[6], ow[7]};
    }
    __syncthreads();
}

DEV void hgrn_sample_unit(const Params& p, int l, int unit, unsigned char* lds) {
    const int tid = threadIdx.x, lane = tid & 63, w = tid >> 6;
    const int b = unit / HH, h = unit % HH;
    float* fS = (float*)lds; float* kS = fS + 512; float* qS = kS + 512; float* vS = qS + 512; float* red = vS + 512; float* part = red + 4 * 4 * 128;
    const int r0 = NP + b * DSEQ;
    {
        const int t = tid >> 7, kk = tid & 127; const bf16_t* zr = p.z + (size_t)(r0 + t) * ZW + h * HD + kk;
        float lbv = 0.f; if (l > 0) lbv = sigmoidf_(p.lb_logits[HH * HD + h * HD + kk] - p.lb_logits[h * HD + kk]);
        const float zq = bf2f(zr[0]), zf = fminf(fmaxf(bf2f(zr[1024]), -80.f), 80.f), zi = bf2f(zr[2048]);
        const float e = __expf(-zf), sg = 1.0f / (1.0f + e);
        fS[tid] = lbv + (1.0f - lbv) * sg; kS[tid] = (1.0f - lbv) * (e * sg); qS[tid] = siluf_(zq); vS[tid] = zi;
    }
    const int v = tid & 127, kq = tid >> 7;
    const float* s0 = p.state_hgrn + ((size_t)(l * DB + b) * HH + h) * HD * HD + (size_t)(32 * kq) * HD + v;
    float S[32];
#pragma unroll
    for (int i = 0; i < 32; ++i) S[i] = s0[(size_t)i * HD];
    __syncthreads();
#pragma unroll
    for (int t = 0; t < 4; ++t) {
        const float vv = vS[t * 128 + v]; float po = 0.f;
#pragma unroll
        for (int i = 0; i < 32; ++i) { const int kk = t * 128 + 32 * kq + i; S[i] = fS[kk] * S[i] + kS[kk] * vv; po += qS[kk] * S[i]; }
        red[(t * 4 + kq) * 128 + v] = po;
    }
    float* so = p.out + OFF_HS + ((size_t)(l * DB + b) * HH + h) * HD * HD + (size_t)(32 * kq) * HD + v;
#pragma unroll
    for (int i = 0; i < 32; ++i) so[(size_t)i * HD] = S[i];
    __syncthreads();
    {
        const int t = tid >> 7; const float o = red[(t * 4 + 0) * 128 + v] + red[(t * 4 + 1) * 128 + v] + red[(t * 4 + 2) * 128 + v] + red[(t * 4 + 3) * 128 + v];
        const float ss = wave_sum(o * o);
        if (lane == 0) part[w] = ss;
        __syncthreads();
        const float tot = part[2 * t] + part[2 * t + 1];
        const float rstd = rsqrtf(tot * (1.0f / HD) + EPS);
        const float zg = bf2f(p.z[(size_t)(r0 + t) * ZW + 3072 + h * HD + v]);
        p.cat[(size_t)(r0 + t) * D + h * HD + v] = (bf16_t)f2bf(o * rstd * p.hgrn_norm_g[l * HD + v] * siluf_(zg));
    }
    __syncthreads();
}

DEV void pool_pre_unit(const Params& p, int l, int unit) {
    const int tid = threadIdx.x, tk = tid >> 7, cg = tid & 127, c = cg * 8, gi = cg >> 5, wnd = 2 << gi;
    const int r = unit * 4 + tk;
    if (r >= NTOK) return;
    f32x2 sum[4] = {{0.f, 0.f}, {0.f, 0.f}, {0.f, 0.f}, {0.f, 0.f}}; float cur[8];
    float cnt;
    if (r < NP) {
        const int t = r % SEQ; const int n = (wnd < t + 1) ? wnd : (t + 1); cnt = (float)n;
        u32x4 q[16];
#pragma unroll
        for (int j = 0; j < 16; ++j) q[j] = (j < n) ? *(const u32x4*)(p.z + (size_t)(r - j) * ZW + 4096 + c) : (u32x4){0u, 0u, 0u, 0u};
#pragma unroll
        for (int j = 0; j < 16; ++j) { sum[0] += (f32x2){lo16(q[j].x), hi16(q[j].x)}; sum[1] += (f32x2){lo16(q[j].y), hi16(q[j].y)}; sum[2] += (f32x2){lo16(q[j].z), hi16(q[j].z)}; sum[3] += (f32x2){lo16(q[j].w), hi16(q[j].w)}; }
        cur[0] = lo16(q[0].x); cur[1] = hi16(q[0].x); cur[2] = lo16(q[0].y); cur[3] = hi16(q[0].y); cur[4] = lo16(q[0].z); cur[5] = hi16(q[0].z); cur[6] = lo16(q[0].w); cur[7] = hi16(q[0].w);
        if (t >= SEQ - PBUF) { float* o = p.out + OFF_PP + ((size_t)(l * PB + r / SEQ) * PBUF + (t - (SEQ - PBUF))) * PW + c;
            *(f32x4*)o = (f32x4){cur[0], cur[1], cur[2], cur[3]}; *(f32x4*)(o + 4) = (f32x4){cur[4], cur[5], cur[6], cur[7]}; }
    } else {
        const int bb = (r - NP) / DSEQ, t = (r - NP) % DSEQ; cnt = (float)wnd;
        const float* sp = p.state_pool + (size_t)(l * DB + bb) * PBUF * PW + c;
        u32x4 q[4]; f32x4 sa[15], sb[15];
#pragma unroll
        for (int j = 0; j < 4; ++j) q[j] = (j <= t && j < wnd) ? *(const u32x4*)(p.z + (size_t)(NP + bb * DSEQ + t - j) * ZW + 4096 + c) : (u32x4){0u, 0u, 0u, 0u};
#pragma unroll
        for (int j = 1; j < 16; ++j) {
            const int back = j - t;
            const bool use = (back >= 1) && (j < wnd);
            const float* srow = sp + (size_t)(PBUF - (use ? back : 1)) * PW;
            sa[j - 1] = use ? *(const f32x4*)srow : (f32x4){0.f, 0.f, 0.f, 0.f}; sb[j - 1] = use ? *(const f32x4*)(srow + 4) : (f32x4){0.f, 0.f, 0.f, 0.f};
        }
#pragma unroll
        for (int j = 0; j < 4; ++j) { sum[0] += (f32x2){lo16(q[j].x), hi16(q[j].x)}; sum[1] += (f32x2){lo16(q[j].y), hi16(q[j].y)}; sum[2] += (f32x2){lo16(q[j].z), hi16(q[j].z)}; sum[3] += (f32x2){lo16(q[j].w), hi16(q[j].w)}; }
#pragma unroll
        for (int j = 0; j < 15; ++j) { sum[0] += (f32x2){sa[j][0], sa[j][1]}; sum[1] += (f32x2){sa[j][2], sa[j][3]}; sum[2] += (f32x2){sb[j][0], sb[j][1]}; sum[3] += (f32x2){sb[j][2], sb[j][3]}; }
        cur[0] = lo16(q[0].x); cur[1] = hi16(q[0].x); cur[2] = lo16(q[0].y); cur[3] = hi16(q[0].y); cur[4] = lo16(q[0].z); cur[5] = hi16(q[0].z); cur[6] = lo16(q[0].w); cur[7] = hi16(q[0].w);
        float* ob = p.out + OFF_PS + (size_t)(l * DB + bb) * PBUF * PW + c;
        { float* o = ob + (size_t)(11 + t) * PW; *(f32x4*)o = (f32x4){cur[0], cur[1], cur[2], cur[3]}; *(f32x4*)(o + 4) = (f32x4){cur[4], cur[5], cur[6], cur[7]}; }
        for (int i = t; i < 11; i += 4) { const float* s2 = sp + (size_t)(4 + i) * PW; float* o = ob + (size_t)i * PW; *(f32x4*)o = *(const f32x4*)s2; *(f32x4*)(o + 4) = *(const f32x4*)(s2 + 4); }
    }
    const float inv = 1.0f / cnt;
    u32x4 w; w.x = pack2(sum[0][0] * inv - cur[0], sum[0][1] * inv - cur[1]); w.y = pack2(sum[1][0] * inv - cur[2], sum[1][1] * inv - cur[3]);
    w.z = pack2(sum[2][0] * inv - cur[4], sum[2][1] * inv - cur[5]); w.w = pack2(sum[3][0] * inv - cur[6], sum[3][1] * inv - cur[7]);
    *(u32x4*)(p.pooled + ((size_t)gi * MPAD + r) * 256 + (c & 255)) = w;
}

#ifndef PROBE_SUB
#define PROBE_SUB 0
#endif
DEV void phase_mix1(const Params& p, int l, unsigned char* lds) {
    for (int rep = 0; rep < (PROBE_SUB == 1 ? 2 : 1); ++rep) for (int u = blockIdx.x; u < hg::NUNIT; u += gridDim.x) hgrn_pre_unit(p, l, u, lds);
    for (int rep = 0; rep < (PROBE_SUB == 2 ? 2 : 1); ++rep) for (int u = blockIdx.x; u < DB * HH; u += gridDim.x) hgrn_sample_unit(p, l, u, lds);
    for (int rep = 0; rep < (PROBE_SUB == 3 ? 2 : 1); ++rep) for (int u = blockIdx.x; u < (NTOK + 3) / 4; u += gridDim.x) pool_pre_unit(p, l, u);
}
DEV void phase_mix2(const Params& p, int l) { for (int u = blockIdx.x; u < PB * HH * 8; u += gridDim.x) hgrn_scan_unit(p, l, u); }
DEV void phase_mix3(const Params& p, int l, unsigned char* lds) { for (int u = blockIdx.x; u < hg::NUNIT; u += gridDim.x) hgrn_post_unit(p, l, u, lds); }

#ifdef HIPEMU
#define MBCNT(mask) __builtin_popcountll((mask) & ((1ull << emu_lane()) - 1ull))
#define POPC64(m) __builtin_popcountll(m)
#else
#define MBCNT(mask) ((int)__builtin_amdgcn_mbcnt_hi((unsigned)((mask) >> 32), __builtin_amdgcn_mbcnt_lo((unsigned)(mask), 0u)))
#define POPC64(m) __popcll(m)
#endif
DEV unsigned fkey(float f) { const unsigned u = __float_as_uint(f); return u ^ ((unsigned)((int)u >> 31) | 0x80000000u); }
DEV unsigned long long lowest_n_bits(unsigned long long m, int n) { unsigned long long r = 0ull; while (n > 0 && m) { const unsigned long long b = m & (~m + 1ull); r |= b; m ^= b; --n; } return r; }
#ifdef HIPEMU
#define DPPU_XOR1(v) __shfl((v), emu_lane() ^ 1)
#define DPPU_XOR2(v) __shfl((v), emu_lane() ^ 2)
#define DPPU_HMIRROR(v) __shfl((v), (emu_lane() & ~7) | (7 - (emu_lane() & 7)))
#else
template <int CTRL> DEV unsigned dpp_u(unsigned v) { return (unsigned)__builtin_amdgcn_update_dpp(0, (int)v, CTRL, 0xf, 0xf, true); }
#define DPPU_XOR1(v) dpp_u<0xB1>(v)
#define DPPU_XOR2(v) dpp_u<0x4E>(v)
#define DPPU_HMIRROR(v) dpp_u<0x141>(v)
#endif
template <int GL> DEV unsigned group_sum(unsigned c) { c += DPPU_XOR1(c); c += DPPU_XOR2(c); if (GL == 8) c += DPPU_HMIRROR(c); return c; }
template <int GL> DEV unsigned group_or(unsigned c) { c |= DPPU_XOR1(c); c |= DPPU_XOR2(c); if (GL == 8) c |= DPPU_HMIRROR(c); return c; }
template <int GL> DEV float group_maxf(float v) { v = fmaxf(v, DPP_XOR1(v)); v = fmaxf(v, DPP_XOR2(v)); if (GL == 8) v = fmaxf(v, DPP_HMIRROR(v)); return v; }
template <int GL> DEV float group_sumf(float v) { v += DPP_XOR1(v); v += DPP_XOR2(v); if (GL == 8) v += DPP_HMIRROR(v); return v; }
DEV unsigned bytesum(unsigned w) { return (w * 0x01010101u) >> 24; }
template <int GL> DEV unsigned group_excl_prefix(unsigned c, int sub) {
    const unsigned sh = 8u * (unsigned)(sub & 3);
    unsigned wlo = (GL == 4 || sub < 4) ? (c << sh) : 0u, whi = (GL == 8 && sub >= 4) ? (c << sh) : 0u;
    wlo = group_or<GL>(wlo);
    unsigned r;
    if (GL == 4) r = bytesum(wlo & ((1u << sh) - 1u));
    else { whi = group_or<GL>(whi); r = sub < 4 ? bytesum(wlo & ((1u << sh) - 1u)) : bytesum(wlo) + bytesum(whi & ((1u << sh) - 1u)); }
    return r;
}
DEV float fkey_inv(unsigned k) { return __uint_as_float((k & 0x80000000u) ? (k ^ 0x80000000u) : ~k); }
template <int NK> DEV unsigned count_above(const unsigned (&k)[NK], unsigned t) {
    unsigned c[4] = {0u, 0u, 0u, 0u};
#pragma unroll
    for (int i = 0; i < NK; ++i) c[i & 3] += (k[i] > t) ? 1u : 0u;
    return (c[0] + c[1]) + (c[2] + c[3]);
}
template <int GL, int NK> DEV unsigned group_top16(const unsigned (&k)[NK], bool active, int sub, unsigned& pos0) {
    unsigned mxk = 0u;
#pragma unroll
    for (int i = 0; i < NK; ++i) mxk = k[i] > mxk ? k[i] : mxk;
    { unsigned o = DPPU_XOR1(mxk); mxk = o > mxk ? o : mxk; o = DPPU_XOR2(mxk); mxk = o > mxk ? o : mxk; if (GL == 8) { o = DPPU_HMIRROR(mxk); mxk = o > mxk ? o : mxk; } }
    unsigned L0 = mxk > 0x01000000u ? mxk - 0x01000000u : 0u, c0 = group_sum<GL>(count_above<NK>(k, L0));
    unsigned L = c0 > 16u ? L0 + 1u : 0u, R = active ? mxk : 0u, cR = 0u;
    if (!active) L = 0u;
    if (c0 == 16u && active) { L = L0; R = L0; cR = 16u; }
    for (;;) {
        if (__ballot(L < R) == 0ull) break;
        const unsigned mid = L + ((R - L) >> 1);
        const unsigned c = group_sum<GL>(count_above<NK>(k, mid));
        const bool le = c <= 16u, hit = c == 16u;
        R = le ? mid : R; cR = le ? c : cR; L = hit ? mid : (le ? L : mid + 1u);
    }
    unsigned mask = 0u;
#pragma unroll
    for (int i = 0; i < NK; ++i) mask |= (k[i] > R) ? (1u << i) : 0u;
    const unsigned need = 16u - cR;
    if (__ballot(active && need > 0u) != 0ull) {
        unsigned eqm = 0u;
#pragma unroll
        for (int i = 0; i < NK; ++i) eqm |= (k[i] == R) ? (1u << i) : 0u;
        const unsigned eqc = (unsigned)__builtin_popcount(eqm), before = group_excl_prefix<GL>(eqc, sub);
        unsigned take = need > before ? need - before : 0u; if (take > eqc) take = eqc;
        if (!active) take = 0u;
        while (take > 0u) { const unsigned b = eqm & (~eqm + 1u); mask |= b; eqm ^= b; --take; }
    }
    if (!active) mask = 0u;
    pos0 = group_excl_prefix<GL>((unsigned)__builtin_popcount(mask), sub);
    return mask;
}
#ifdef HIPEMU
template <int J> DEV unsigned row_bcast_u(unsigned v) { return __shfl(v, (emu_lane() & ~15) | J); }
#else
template <int J> DEV unsigned row_bcast_u(unsigned v) { return (unsigned)__builtin_amdgcn_update_dpp(0, (int)v, 0x150 + J, 0xf, 0xf, true); }
#endif
template <int J> struct RowRank { static DEV unsigned run(unsigned v, int l16) { const unsigned b = row_bcast_u<J>(v); return (((b > v) || (b == v && J < l16)) ? 1u : 0u) + RowRank<J - 1>::run(v, l16); } };
template <> struct RowRank<-1> { static DEV unsigned run(unsigned, int) { return 0u; } };
struct CandTab { unsigned char ij[56]; };
DEV CandTab make_cand_tab() { CandTab t{}; int n = 0; for (int i = 0; i < 16; ++i) for (int j = 0; j < 16 / (i + 1); ++j) t.ij[n++] = (unsigned char)(i * 16 + j); for (; n < 56; ++n) t.ij[n] = 255; return t; }
constexpr int SEL_NT = 4;
constexpr int SEL_RS = 144;
DEV void select_step(const Params& p, int l, int tt0, int tstride, int ntile, int h, unsigned char* lds, const bf16x8 (&kh)[2][4], const bf16x8 (&kl)[2][4]) {
    const int tid = threadIdx.x, lane = tid & 63, w = tid >> 6, g = lane >> 4, c16 = lane & 15;
    constexpr int NTK = SEL_NT * 16;
    constexpr int QRS = 264;
    bf16_t* qh = (bf16_t*)lds;
    bf16_t* ql = qh + NTK * QRS;
    float* sc = (float*)(ql + NTK * QRS);
    float* ts = sc + 2 * NTK * SEL_RS;
    int* ti = (int*)(ts + 2 * NTK * 16);
    unsigned char* ctab = (unsigned char*)(ti + 2 * NTK * 16);
    if (tid == 0) { const CandTab t = make_cand_tab(); for (int n = 0; n < 56; ++n) ctab[n] = t.ij[n]; }
#pragma unroll
    for (int k = 0; k < SEL_NT; ++k) {
        const int tk = tid >> 5, part = tid & 31; const int tok = (tt0 + k * tstride) * 16 + tk;
        f32x4 a = (f32x4){0.f, 0.f, 0.f, 0.f}, b2 = a;
        if (k < ntile && tok < NTOK) { const float* q = p.qry + (size_t)tok * D + h * 256 + part * 8; a = *(const f32x4*)q; b2 = *(const f32x4*)(q + 4); }
        float ss = a[0] * a[0] + a[1] * a[1] + a[2] * a[2] + a[3] * a[3] + b2[0] * b2[0] + b2[1] * b2[1] + b2[2] * b2[2] + b2[3] * b2[3];
        ss += __shfl_xor(ss, 1); ss += __shfl_xor(ss, 2); ss += __shfl_xor(ss, 4); ss += __shfl_xor(ss, 8);
        const float rn = rsqrtf(ss * (1.0f / 128.0f) + EPS);
        const float v[8] = {a[0] * rn, a[1] * rn, a[2] * rn, a[3] * rn, b2[0] * rn, b2[1] * rn, b2[2] * rn, b2[3] * rn};
        unsigned hi[4], lo[4];
#pragma unroll
        for (int j = 0; j < 4; ++j) { hi[j] = pack2(v[2 * j], v[2 * j + 1]); lo[j] = pack2(v[2 * j] - lo16(hi[j]), v[2 * j + 1] - hi16(hi[j])); }
        *(u32x4*)(qh + (k * 16 + tk) * QRS + part * 8) = (u32x4){hi[0], hi[1], hi[2], hi[3]}; *(u32x4*)(ql + (k * 16 + tk) * QRS + part * 8) = (u32x4){lo[0], lo[1], lo[2], lo[3]};
    }
    __syncthreads();
    for (int k = 0; k < ntile; ++k) {
#pragma unroll
        for (int ph = 0; ph < 2; ++ph) {
            f32x4 acc = (f32x4){0.f, 0.f, 0.f, 0.f};
#pragma unroll
            for (int ks = 0; ks < 4; ++ks) {
                const bf16x8 ah = *(const bf16x8*)(qh + (k * 16 + c16) * QRS + ph * 128 + 32 * ks + 8 * g), al = *(const bf16x8*)(ql + (k * 16 + c16) * QRS + ph * 128 + 32 * ks + 8 * g);
                acc = MFMA_BF16(al, kh[ph][ks], acc); acc = MFMA_BF16(ah, kl[ph][ks], acc); acc = MFMA_BF16(ah, kh[ph][ks], acc);
            }
            const int kidx = 16 * w + c16;
#pragma unroll
            for (int r = 0; r < 4; ++r) sc[(ph * NTK + k * 16 + 4 * g + r) * SEL_RS + (kidx >> 5) * 36 + (kidx & 31)] = acc[r];
        }
    }
    __syncthreads();
    {
        const int row = tid >> 2, sub = tid & 3; const bool active = ((row % NTK) >> 4) < ntile;
        unsigned k[32];
#pragma unroll
        for (int i4 = 0; i4 < 8; ++i4) { const f32x4 v = *(const f32x4*)(sc + row * SEL_RS + sub * 36 + 4 * i4); k[4 * i4] = fkey(v[0]); k[4 * i4 + 1] = fkey(v[1]); k[4 * i4 + 2] = fkey(v[2]); k[4 * i4 + 3] = fkey(v[3]); }
        unsigned pos; const unsigned mask = group_top16<4, 32>(k, active, sub, pos);
#pragma unroll
        for (int i = 0; i < 32; ++i) if ((mask >> i) & 1u) { if (pos < 16u) { ts[row * 16 + pos] = fkey_inv(k[i]); ti[row * 16 + pos] = 32 * sub + i; } ++pos; }
    }
    __syncthreads();
    {
        float v4[4]; int i4[4]; unsigned rk[4];
#pragma unroll
        for (int r = 0; r < (2 * NTK) / 32; ++r) { const int row = (tid >> 4) + 32 * r; v4[r] = ts[row * 16 + (tid & 15)]; i4[r] = ti[row * 16 + (tid & 15)]; }
#pragma unroll
        for (int r = 0; r < (2 * NTK) / 32; ++r) rk[r] = RowRank<15>::run(fkey(v4[r]), tid & 15);
        __syncthreads();
#pragma unroll
        for (int r = 0; r < (2 * NTK) / 32; ++r) { const int row = (tid >> 4) + 32 * r; ts[row * 16 + rk[r]] = v4[r]; ti[row * 16 + rk[r]] = i4[r]; }
    }
    __syncthreads();
    {
        const int tk = tid >> 3, sub = tid & 7; const bool active = (tk >> 4) < ntile;
        unsigned k[7]; unsigned cij[7];
#pragma unroll
        for (int q = 0; q < 7; ++q) { cij[q] = ctab[7 * sub + q]; const bool ok = cij[q] != 255u;
            k[q] = ok ? fkey(ts[tk * 16 + (cij[q] >> 4)] + ts[(NTK + tk) * 16 + (cij[q] & 15u)]) : 0u; }
        unsigned pos; const unsigned mask = group_top16<8, 7>(k, active, sub, pos);
        u32x2* lst = (u32x2*)sc;
#pragma unroll
        for (int q = 0; q < 7; ++q) if ((mask >> q) & 1u) { if (pos < 16u) lst[tk * 16 + pos] = (u32x2){__float_as_uint(fkey_inv(k[q])), (unsigned)(ti[tk * 16 + (cij[q] >> 4)] * 128 + ti[(NTK + tk) * 16 + (cij[q] & 15u)])}; ++pos; }
    }
    __syncthreads();
#pragma unroll
    for (int r = 0; r < NTK / 32; ++r) {
        const int tk = (tid >> 4) + 32 * r, slot = tid & 15; const int tok = (tt0 + (tk >> 4) * tstride) * 16 + (tk & 15);
        const u32x2 en = ((const u32x2*)sc)[tk * 16 + slot];
        const float v = __uint_as_float(en.x); const int e = (int)en.y;
        float mx = v; mx = fmaxf(mx, DPP_XOR1(mx)); mx = fmaxf(mx, DPP_XOR2(mx)); mx = fmaxf(mx, DPP_HMIRROR(mx)); mx = fmaxf(mx, DPP_RMIRROR(mx));
        const float ex = __expf(v - mx);
        float sm = ex; sm += DPP_XOR1(sm); sm += DPP_XOR2(sm); sm += DPP_HMIRROR(sm); sm += DPP_RMIRROR(sm);
        if ((tk >> 4) < ntile && tok < NTOK) { const size_t o = (size_t)tok * 128 + h * 16 + slot;
            p.eidx[o] = (unsigned short)e; p.gate[o] = ex / sm; }
    }
    __syncthreads();
}
DEV void phase_select(const Params& p, int l, unsigned char* lds) {
    const int ntt = (NTOK + 15) / 16, lane = threadIdx.x & 63, w = threadIdx.x >> 6, g = lane >> 4, c16 = lane & 15;
    const bool fixed = (gridDim.x % 8u) == 0u;
    const int nq = fixed ? (int)(gridDim.x >> 3) : 1;
    for (int hh = 0; hh < (fixed ? 1 : 8); ++hh) {
        const int h = fixed ? (int)(blockIdx.x & 7) : hh;
        bf16x8 kh[2][4], kl[2][4];
#pragma unroll
        for (int ph = 0; ph < 2; ++ph)
#pragma unroll
            for (int ks = 0; ks < 4; ++ks) { const float* kr = p.peer_keys + ((size_t)((l * 8 + h) * 2 + ph) * 128 + 16 * w + c16) * 128 + 32 * ks + 8 * g;
                const f32x4 a = *(const f32x4*)kr, b2 = *(const f32x4*)(kr + 4); const float v[8] = {a[0], a[1], a[2], a[3], b2[0], b2[1], b2[2], b2[3]};
                u32x4 hi, lo; unsigned hw[4], lw[4];
#pragma unroll
                for (int j = 0; j < 4; ++j) { hw[j] = pack2(v[2 * j], v[2 * j + 1]); lw[j] = pack2(v[2 * j] - lo16(hw[j]), v[2 * j + 1] - hi16(hw[j])); }
                hi = (u32x4){hw[0], hw[1], hw[2], hw[3]}; lo = (u32x4){lw[0], lw[1], lw[2], lw[3]};
                kh[ph][ks] = __builtin_bit_cast(bf16x8, hi); kl[ph][ks] = __builtin_bit_cast(bf16x8, lo); }
        const int first = fixed ? (int)(blockIdx.x >> 3) : (int)blockIdx.x, stride = fixed ? nq : (int)gridDim.x;
        for (int tt0 = first; tt0 < ntt; tt0 += SEL_NT * stride) {
            int ntile = 0;
#pragma unroll
            for (int k = 0; k < SEL_NT; ++k) if (tt0 + k * stride < ntt) ntile = k + 1;
            select_step(p, l, tt0, stride, ntile, h, lds, kh, kl);
        }
    }
}

constexpr int PEER_TB = 272;
struct PeerDeal { int xs_first, xs_step, t_begin, t_end; };
DEV PeerDeal peer_deal() {
    PeerDeal d; const bool sl = (gridDim.x % 8u) == 0u;
    const int nranks = sl ? (int)(gridDim.x >> 3) : (int)gridDim.x, rank = sl ? (int)(blockIdx.x >> 3) : (int)blockIdx.x, tpr = (NTOK + nranks - 1) / nranks;
    d.xs_first = sl ? (int)(blockIdx.x & 7) : 0; d.xs_step = sl ? 8 : 1; d.t_begin = rank * tpr; d.t_end = d.t_begin + tpr < NTOK ? d.t_begin + tpr : NTOK;
    return d;
}
struct PeerTok { u32x4 e0, e1, h[4]; };
DEV void peer_fetch_u(const Params& p, int t, int c0, int g8, PeerTok& k) {
    const u32x4* ep = (const u32x4*)(p.eidx + (size_t)t * 128 + 16 * g8); k.e0 = ep[0]; k.e1 = ep[1];
    const u32x4* hp = (const u32x4*)(p.hB + (size_t)t * D + c0);
#pragma unroll
    for (int i = 0; i < 4; ++i) k.h[i] = hp[i];
}
DEV void phase_peer_u(const Params& p, int l, unsigned char* lds) {
    const int lane = threadIdx.x & 63, w = wave_id(), j8 = lane & 7, g8 = lane >> 3;
    const bool b2 = (j8 & 4) != 0, b1 = (j8 & 2) != 0, b0 = (j8 & 1) != 0;
    const PeerDeal dl = peer_deal();
    const unsigned char* U = p.u8 + (size_t)l * NE * (D / 2);
    for (int xs = dl.xs_first; xs < 8; xs += dl.xs_step) {
        const int c0 = 256 * xs + 32 * j8;
        const unsigned char* Us = U + (size_t)xs * NE * 128; const unsigned joff = 16u * (unsigned)j8;
        PeerTok nx; if (dl.t_begin + w < dl.t_end) peer_fetch_u(p, dl.t_begin + w, c0, g8, nx);
        for (int t = dl.t_begin + w; t < dl.t_end; t += 8) {
            const PeerTok cu = nx;
            const unsigned ew[8] = {cu.e0.x, cu.e0.y, cu.e0.z, cu.e0.w, cu.e1.x, cu.e1.y, cu.e1.z, cu.e1.w}; unsigned ev[16];
#pragma unroll
            for (int i = 0; i < 8; ++i) { ev[2 * i] = ew[i] & 0xffffu; ev[2 * i + 1] = ew[i] >> 16; }
            u32x4 q[16];
#pragma unroll
            for (int i = 0; i < 16; ++i) q[i] = *(const u32x4*)(Us + (ev[i] * 128u + joff));
            if (t + 8 < dl.t_end) peer_fetch_u(p, t + 8, c0, g8, nx);
            const unsigned hw[16] = {cu.h[0].x, cu.h[0].y, cu.h[0].z, cu.h[0].w, cu.h[1].x, cu.h[1].y, cu.h[1].z, cu.h[1].w, cu.h[2].x, cu.h[2].y, cu.h[2].z, cu.h[2].w, cu.h[3].x, cu.h[3].y, cu.h[3].z, cu.h[3].w};
            float ps[16];
#pragma unroll
            for (int i = 0; i < 16; ++i) { unsigned dq[16]; fp4x8_decb(q[i].x, dq); fp4x8_decb(q[i].y, dq + 4); fp4x8_decb(q[i].z, dq + 8); fp4x8_decb(q[i].w, dq + 12);
                float a = 0.f, b = 0.f;
#pragma unroll
                for (int k = 0; k < 8; ++k) { a = dot2bf(dq[2 * k], hw[2 * k], a); b = dot2bf(dq[2 * k + 1], hw[2 * k + 1], b); }
                ps[i] = a + b; }
            float q8[8], q4[4], q2[2];
#pragma unroll
            for (int k = 0; k < 8; ++k) { const float keep = b2 ? ps[8 + k] : ps[k], send = b2 ? ps[k] : ps[8 + k]; q8[k] = keep + DPP_HMIRROR(send); }
#pragma unroll
            for (int k = 0; k < 4; ++k) { const float keep = b1 ? q8[4 + k] : q8[k], send = b1 ? q8[k] : q8[4 + k]; q4[k] = keep + DPP_XOR2(send); }
#pragma unroll
            for (int k = 0; k < 2; ++k) { const float keep = b0 ? q4[2 + k] : q4[k], send = b0 ? q4[k] : q4[2 + k]; q2[k] = keep + DPP_XOR1(send); }
            float* dst = p.part + ((size_t)t * 8 + xs) * 128 + 16 * g8 + 2 * j8; *(f32x2*)dst = (f32x2){q2[0], q2[1]};
        }
    }
}
DEV void phase_peer_c(const Params& p, int l) {
    const size_t n = (size_t)NTOK * 128, gs = (size_t)gridDim.x * 512;
    for (size_t i = (size_t)blockIdx.x * 512 + threadIdx.x; i < n; i += gs) {
        const size_t t = i >> 7; const int pr = (int)(i & 127); float sacc = 0.f;
        const int e = p.eidx[i]; const float su = p.su[l * NE + e], sv = p.sv[l * NE + e], gt = p.gate[i];
#pragma unroll
        for (int x = 0; x < 8; ++x) sacc += p.part[(t * 8 + x) * 128 + pr];
        p.ab16[i] = (bf16_t)f2bf(gelu_erf(sacc * su) * gt * sv);
    }
}
struct PeerTokV { u32x4 e0, e1, a0, a1; u32x2 x1; f32x4 g2; };
DEV void peer_fetch_v(const Params& p, int l, int t, int col, int g8, PeerTokV& k) {
    const u32x4* ep = (const u32x4*)(p.eidx + (size_t)t * 128 + 16 * g8); k.e0 = ep[0]; k.e1 = ep[1];
    const u32x4* ap = (const u32x4*)(p.ab16 + (size_t)t * 128 + 16 * g8); k.a0 = ap[0]; k.a1 = ap[1];
    k.x1 = *(const u32x2*)(p.xa + (size_t)t * D + col); k.g2 = *(const f32x4*)(p.modbuf + (size_t)tok_batch(t) * MODW + l * NMOD + 5 * D + col);
}
DEV void phase_peer_v(const Params& p, int l, unsigned char* lds) {
    const int lane = threadIdx.x & 63, w = wave_id(), j8 = lane & 7, g8 = lane >> 3;
    const bool b3 = (g8 & 1) != 0, b4 = (g8 & 2) != 0, b5 = (g8 & 4) != 0;
    const PeerDeal dl = peer_deal();
    const unsigned char* V = p.v8 + (size_t)l * NE * (D / 2);
    for (int xs = dl.xs_first; xs < 8; xs += dl.xs_step) {
        const int col = 256 * xs + 32 * j8 + (b3 ? 16 : 0) + (b4 ? 8 : 0) + (b5 ? 4 : 0);
        const unsigned char* Vs = V + (size_t)xs * NE * 128; const unsigned joff = 16u * (unsigned)j8;
        PeerTokV nx; if (dl.t_begin + w < dl.t_end) peer_fetch_v(p, l, dl.t_begin + w, col, g8, nx);
        for (int t = dl.t_begin + w; t < dl.t_end; t += 8) {
            const PeerTokV cu = nx;
            const unsigned ew[8] = {cu.e0.x, cu.e0.y, cu.e0.z, cu.e0.w, cu.e1.x, cu.e1.y, cu.e1.z, cu.e1.w}; unsigned ev[16];
#pragma unroll
            for (int i = 0; i < 8; ++i) { ev[2 * i] = ew[i] & 0xffffu; ev[2 * i + 1] = ew[i] >> 16; }
            u32x4 q[16];
#pragma unroll
            for (int i = 0; i < 16; ++i) q[i] = *(const u32x4*)(Vs + (ev[i] * 128u + joff));
            if (t + 8 < dl.t_end) peer_fetch_v(p, l, t + 8, col, g8, nx);
            const unsigned aw[8] = {cu.a0.x, cu.a0.y, cu.a0.z, cu.a0.w, cu.a1.x, cu.a1.y, cu.a1.z, cu.a1.w}; float av[16];
#pragma unroll
            for (int i = 0; i < 8; ++i) { av[2 * i] = lo16(aw[i]); av[2 * i + 1] = hi16(aw[i]); }
            f32x2 acc2[16];
#pragma unroll
            for (int k = 0; k < 16; ++k) acc2[k] = (f32x2){0.f, 0.f};
#pragma unroll
            for (int i = 0; i < 16; ++i) { f32x2 dq[16]; fp4x32_dec2(q[i], dq); const f32x2 a2v = (f32x2){av[i], av[i]};
#pragma unroll
                for (int k = 0; k < 16; ++k) acc2[k] = __builtin_elementwise_fma(a2v, dq[k], acc2[k]); }
            float acc[32];
#pragma unroll
            for (int k = 0; k < 16; ++k) { acc[2 * k] = acc2[k][0]; acc[2 * k + 1] = acc2[k][1]; }
            float q16[16], q8[8], q4[4];
#pragma unroll
            for (int k = 0; k < 16; ++k) { const float keep = b3 ? acc[16 + k] : acc[k], send = b3 ? acc[k] : acc[16 + k]; q16[k] = keep + DPP_XOR8(send); }
#pragma unroll
            for (int k = 0; k < 8; ++k) q8[k] = xsum16(q16[k], q16[8 + k]);
#pragma unroll
            for (int k = 0; k < 4; ++k) q4[k] = xsum32(q8[k], q8[4 + k]);
            const f32x4 x1v = (f32x4){lo16(cu.x1.x), hi16(cu.x1.x), lo16(cu.x1.y), hi16(cu.x1.y)}; f32x4 o;
#pragma unroll
            for (int k = 0; k < 4; ++k) o[k] = x1v[k] + cu.g2[k] * q4[k];
            u32x2 ow; ow.x = pack2(o[0], o[1]); ow.y = pack2(o[2], o[3]); *(u32x2*)(p.xb + (size_t)t * D + col) = ow;
        }
    }
}

constexpr int N_PHASES = 27;
DEV int phase_class(int k) { return k < 2 ? k : (k == 26 ? 14 : 2 + (k - 2) % 12); }
#ifndef HIPEMU
#define XB_TMO      128
#define XB_XCNT(j)  (256  + 64 * (j))
#define XB_XSUB(j)  (1280 + 64 * (j))
#define XB_XGEN(j)  (2304 + 64 * (j))
#define XB_TOP      3328
#define XB_TOPGEN   3392
#define XCD_BAR_WORDS 3456
#define XB_SPIN_CAP (1u << 22)
__device__ __forceinline__ unsigned xb_ld(unsigned* p)              { return __hip_atomic_load(p, __ATOMIC_RELAXED, __HIP_MEMORY_SCOPE_AGENT); }
__device__ __forceinline__ unsigned xb_add(unsigned* p, unsigned v) { return __hip_atomic_fetch_add(p, v, __ATOMIC_RELAXED, __HIP_MEMORY_SCOPE_AGENT); }
__device__ __forceinline__ unsigned xb_xcc_id() { return (unsigned)__builtin_amdgcn_s_getreg((3 << 11) | 20) & 0xFu; }
#define XB_SPIN(cond, bar) do { unsigned _sp = 0; while (cond) { __builtin_amdgcn_s_sleep(1); \
    if ((++_sp & 255u) == 0u) { if (xb_ld(&(bar)[XB_TMO])) break; if (_sp > XB_SPIN_CAP) { atomicAdd(&(bar)[XB_TMO], 1u); break; } } } } while (0)
struct XcdBarrier { unsigned* bar; unsigned x; volatile LAS unsigned* st; };
__device__ __forceinline__ XcdBarrier xcd_barrier_post(unsigned* bar, volatile LAS unsigned* st) {
    XcdBarrier b; b.bar = bar; b.x = xb_xcc_id(); b.st = st;
    if (threadIdx.x == 0) (void)xb_add(&bar[XB_XCNT(b.x)], 1u);
    return b;
}
__device__ __forceinline__ void xcd_barrier_complete(unsigned* bar, unsigned x, unsigned& nloc, unsigned& nx) {
    const unsigned G = gridDim.x * gridDim.y * gridDim.z;
    unsigned sum, cnt, mine, sp = 0u;
    for (;;) {
        sum = 0u; cnt = 0u; mine = 0u;
#pragma unroll
        for (unsigned j = 0; j < 16; ++j) { const unsigned c = xb_ld(&bar[XB_XCNT(j)]); sum += c; cnt += (c > 0u) ? 1u : 0u; mine = (j == x) ? c : mine; }
        if (sum == G) break;
        __builtin_amdgcn_s_sleep(1);
        if ((++sp & 255u) == 0u) { if (xb_ld(&bar[XB_TMO])) break; if (sp > XB_SPIN_CAP) { atomicAdd(&bar[XB_TMO], 1u); break; } }
    }
    nloc = mine > 0u ? mine : 1u; nx = cnt > 0u ? cnt : 1u;
}
__device__ __forceinline__ void xcd_barrier(const XcdBarrier& b) {
    asm volatile("s_waitcnt vmcnt(0)" ::: "memory");
    __syncthreads();
    if (threadIdx.x == 0) {
        unsigned* bar = b.bar;
        __builtin_amdgcn_s_waitcnt(0);
        unsigned nloc = b.st[0], nx = b.st[1];
        if (nloc == 0u) { xcd_barrier_complete(bar, b.x, nloc, nx); b.st[0] = nloc; b.st[1] = nx; }
        const unsigned old = xb_add(&bar[XB_XSUB(b.x)], 1u);
        const unsigned gen = old / nloc;
        if (old + 1u == (gen + 1u) * nloc) {
            __builtin_amdgcn_fence(__ATOMIC_RELEASE, "agent");
            asm volatile("s_waitcnt vmcnt(0)" ::: "memory");
            const unsigned og = xb_add(&bar[XB_TOP], 1u);
            const unsigned tg = og / nx;
            if (og + 1u == (tg + 1u) * nx) xb_add(&bar[XB_TOPGEN], 1u);
            else XB_SPIN(xb_ld(&bar[XB_TOPGEN]) == tg, bar);
            __builtin_amdgcn_fence(__ATOMIC_ACQUIRE, "agent");
            xb_add(&bar[XB_XGEN(b.x)], 1u);
            asm volatile("s_waitcnt vmcnt(0)" ::: "memory");
        } else {
            XB_SPIN(xb_ld(&bar[XB_XGEN(b.x)]) == gen, bar);
            __builtin_amdgcn_fence(__ATOMIC_ACQUIRE, "agent");
            asm volatile("s_waitcnt vmcnt(0)" ::: "memory");
        }
    }
    __syncthreads();
}
#endif

constexpr int LDS_BYTES = 163840;
constexpr int LDS_BARW = LDS_BYTES - 16;

#ifndef PH_MASK
#define PH_MASK 0xFFFFFFFFu
#endif
#ifndef PROBE_DUP
#define PROBE_DUP 0u
#endif
#define DUP_N(k) (1 + (int)((PROBE_DUP >> phase_class(k)) & 1u))
#define PH_BIT(k) ((PH_MASK >> phase_class(k)) & 1u)
#ifdef HIPEMU
static void run_phase(const Params& pp, int ph, unsigned char* lds)
#define GRID_BAR() do {} while (0)
#define IN(k) (ph == (k))
#define GLDS lds
#define LOADP() const Params& p = pp
#else
typedef const __attribute__((address_space(4))) unsigned char* kargp_t;
__device__ __forceinline__ kargp_t karg_ptr() { kargp_t kp = (kargp_t)__builtin_amdgcn_kernarg_segment_ptr(); asm volatile("" : "+s"(kp)); return kp; }
#define LOADP() Params p; __builtin_memcpy(&p, karg_ptr(), sizeof(Params))
#define IN(k) (PH_BIT(k) && ph_lo <= (k) && (k) < ph_hi)
#define GLDS ((LAS unsigned char*)lds_raw)
__global__ void __launch_bounds__(512, 2) mega_fwd(Params p_unused)
#endif
{
#ifndef HIPEMU
    extern __shared__ __attribute__((aligned(16))) unsigned char lds_raw[];
    unsigned char* lds = lds_raw;
    if (threadIdx.x == 0) { *(volatile unsigned*)(lds_raw + LDS_BARW) = 0u; *(volatile unsigned*)(lds_raw + LDS_BARW + 4) = 0u; }
    __syncthreads();
    int ph_lo, ph_hi; XcdBarrier bar;
    { LOADP(); ph_lo = p.ph_lo; ph_hi = p.ph_hi; bar.bar = p.bar; bar.x = 0; bar.st = nullptr; }
    const bool multi = (ph_hi - ph_lo) > 1;
    if (multi) bar = xcd_barrier_post(bar.bar, (volatile LAS unsigned*)(lds_raw + LDS_BARW));
#define GRID_BAR() do { if (multi) xcd_barrier(bar); } while (0)
#endif
    if (IN(0)) { for (int rep = 0; rep < DUP_N(0); ++rep) { LOADP(); for (int u = blockIdx.x; u < ADA_UNITS; u += gridDim.x) ada_direct_unit(p, u, lds); } }
    if (IN(1)) { LOADP(); phase_convert(p, lds, 1); GRID_BAR(); }
#define LAYER(l) do { \
        constexpr int base = 2 + 12 * (l); \
        if (IN(base + 0)) { for (int rep = 0; rep < DUP_N(base + 0); ++rep) { LOADP(); phase_norm(p, p.x_prompt, p.x_sample, (l) == 0 ? (const bf16_t*)nullptr : p.xb, p.norm1_g + (l) * D, (l) * NMOD + 0 * D, (l) * NMOD + 1 * D, p.hA, nullptr); GRID_BAR(); } } \
        if (IN(base + 1)) { for (int rep = 0; rep < DUP_N(base + 1); ++rep) { LOADP(); \
            pg8::Gemm g{p.hA, p.wt_in + (size_t)(l) * ZW * D, MPAD, ZW, D}; pg8::StaticOrder S; S.init(MPAD, ZW, gridDim.x, blockIdx.x); \
            pg8::EpiBf16 E{p.z, ZW}; \
            pg8::gemm_phase<pg8::EpiBf16, pg8::StaticOrder>(GLDS, g, S, E); } } \
        if (IN(base + 1)) { LOADP(); phase_tbl_slot(p, (l)); GRID_BAR(); } \
        if (IN(base + 2)) { for (int rep = 0; rep < DUP_N(base + 2); ++rep) { LOADP(); phase_mix1(p, (l), lds); GRID_BAR(); } } \
        if (IN(base + 3)) { for (int rep = 0; rep < DUP_N(base + 3); ++rep) { LOADP(); phase_mix2(p, (l)); GRID_BAR(); } } \
        if (IN(base + 4)) { LOADP(); phase_mix3(p, (l), lds); } \
        if (IN(base + 4)) { LOADP(); \
            pg8::Gemm g{p.pooled, p.wt_pool + (size_t)(l) * 1024 * 256, 4 * MPAD, 1024, 256}; pg8::PoolOrder S{(int)gridDim.x, (int)(gridDim.x - 1 - blockIdx.x)}; \
            pg8::EpiPool E{p.cat, p.pool_b + (l) * PW, p.pool_scale + (l) * PW}; \
            pg8::gemm_phase<pg8::EpiPool, pg8::PoolOrder>(GLDS, g, S, E); \
            GRID_BAR(); } \
        if (IN(base + 5)) { for (int rep = 0; rep < DUP_N(base + 5); ++rep) { LOADP(); \
            pg8::Gemm g{p.cat, p.wt_out + (size_t)(l) * D * D, MBIG, D, D}; pg8::StaticOrder S; S.init(MBIG, D, gridDim.x, blockIdx.x); \
            pg8::EpiResid E{p.x_prompt, p.x_sample, (l) == 0 ? (const bf16_t*)nullptr : p.xb, p.modbuf + (l) * NMOD + 2 * D, p.xa}; \
            pg8::gemm_phase<pg8::EpiResid, pg8::StaticOrder>(GLDS, g, S, E); \
            { SmallResid sf{E.xlo, E.xhi, E.x16, E.gmod, E.out}; small_gemm(p.cat, p.wt_out + (size_t)(l) * D * D, D, lds, sf); } \
            GRID_BAR(); } } \
        if (IN(base + 6)) { for (int rep = 0; rep < DUP_N(base + 6); ++rep) { LOADP(); phase_norm(p, nullptr, nullptr, p.xa, p.norm2_g + (l) * D, (l) * NMOD + 3 * D, (l) * NMOD + 4 * D, p.hB, nullptr); GRID_BAR(); } } \
        if (IN(base + 7)) { for (int rep = 0; rep < DUP_N(base + 7); ++rep) { LOADP(); \
            pg8::Gemm g{p.hB, p.wt_q + (size_t)(l) * D * D, MBIG, D, D}; pg8::StaticOrder S; S.init(MBIG, D, gridDim.x, blockIdx.x); \
            pg8::EpiF32 E{p.qry, D}; \
            pg8::gemm_phase<pg8::EpiF32, pg8::StaticOrder>(GLDS, g, S, E); \
            { SmallF32 sf{p.qry}; small_gemm(p.hB, p.wt_q + (size_t)(l) * D * D, D, lds, sf); } \
            GRID_BAR(); } } \
        if (IN(base + 8)) { for (int rep = 0; rep < DUP_N(base + 8); ++rep) { LOADP(); phase_select(p, (l), lds); GRID_BAR(); } } \
        if (IN(base + 9)) { for (int rep = 0; rep < DUP_N(base + 9); ++rep) { LOADP(); phase_peer_u(p, (l), lds); GRID_BAR(); } } \
        if (IN(base + 10)) { LOADP(); phase_peer_c(p, (l)); GRID_BAR(); } \
        if (IN(base + 11)) { for (int rep = 0; rep < DUP_N(base + 11); ++rep) { LOADP(); phase_peer_v(p, (l), lds); GRID_BAR(); } } \
    } while (0)
    LAYER(0);
    LAYER(1);
    if (IN(26)) { LOADP(); phase_norm(p, nullptr, nullptr, p.xb, p.final_g, 2 * NMOD, 2 * NMOD + D, nullptr, p.out + OFF_Y); }
#undef LAYER
#undef IN
#undef GRID_BAR
#undef GLDS
#undef LOADP
}

struct WsLayout { size_t bar, modbuf, csil, wt_ada, wt_in, wt_out, wt_q, wt_pool, u8, v8, su, sv, iscu, part, hg_oin, hg_ds, hg_gam, hg_qh, hg_sc, hA, hB, z, pooled, cat, xa, xb, qry, eidx, gate, ab16, end; };
static WsLayout ws_layout() {
    WsLayout L; size_t o = 0;
    auto take = [&](size_t bytes) { const size_t r = o; o += (bytes + 255) & ~(size_t)255; return r; };
    L.bar = take(16384);
    L.modbuf = take((size_t)256 * MODW * 4);
    L.csil = take((size_t)256 * D * 2);
    L.wt_ada = take((size_t)MODW * D * 2);
    L.wt_in = take((size_t)2 * ZW * D * 2);
    L.wt_out = take((size_t)2 * D * D * 2);
    L.wt_q = take((size_t)2 * D * D * 2);
    L.wt_pool = take((size_t)2 * 1024 * 256 * 2);
    L.u8 = take((size_t)2 * NE * D);
    L.v8 = take((size_t)2 * NE * D);
    L.su = take((size_t)2 * NE * 4);
    L.sv = take((size_t)2 * NE * 4);
    L.iscu = take((size_t)MPAD * 128 * 4);
    L.part = take((size_t)MPAD * 8 * 128 * 4);
    L.hg_oin = take((size_t)hg::NUNIT * 64 * 128 * 2);
    L.hg_ds = take((size_t)hg::NUNIT * 128 * 128 * 2);
    L.hg_gam = take((size_t)hg::NUNIT * 128 * 4);
    L.hg_qh = take((size_t)NP * 1024 * 2);
    L.hg_sc = take((size_t)hg::NUNIT * 128 * 128 * 2);
    L.hA = take((size_t)MPAD * D * 2);
    L.hB = take((size_t)MPAD * D * 2);
    L.z = take((size_t)MPAD * ZW * 2);
    L.pooled = take((size_t)4 * MPAD * 256 * 2);
    L.cat = take((size_t)MPAD * D * 2);
    L.xa = take((size_t)MPAD * D * 2);
    L.xb = take((size_t)MPAD * D * 2);
    L.qry = take((size_t)MPAD * D * 4);
    L.eidx = take((size_t)MPAD * 128 * 2);
    L.gate = take((size_t)MPAD * 128 * 4);
    L.ab16 = take((size_t)MPAD * 128 * 2);
    L.end = o;
    return L;
}
static void fill_params(Params& p, void* const* d_in, void* d_out, void* d_ws) {
    const float** f = (const float**)&p;
    for (int i = 0; i < 24; ++i) f[i] = (const float*)d_in[i];
    p.out = (float*)d_out;
    const WsLayout L = ws_layout(); unsigned char* w = (unsigned char*)d_ws;
    p.bar = (unsigned*)(w + L.bar); p.modbuf = (float*)(w + L.modbuf); p.csil = (bf16_t*)(w + L.csil); p.wt_ada = (bf16_t*)(w + L.wt_ada); p.wt_in = (bf16_t*)(w + L.wt_in);
    p.wt_out = (bf16_t*)(w + L.wt_out); p.wt_q = (bf16_t*)(w + L.wt_q); p.wt_pool = (bf16_t*)(w + L.wt_pool); p.u8 = w + L.u8; p.v8 = w + L.v8; p.su = (float*)(w + L.su); p.sv = (float*)(w + L.sv); p.iscu = (float*)(w + L.iscu); p.part = (float*)(w + L.part); p.hg_oin = (bf16_t*)(w + L.hg_oin); p.hg_ds = (bf16_t*)(w + L.hg_ds); p.hg_gam = (float*)(w + L.hg_gam); p.hg_qh = (bf16_t*)(w + L.hg_qh); p.hg_sc = (bf16_t*)(w + L.hg_sc);
    p.hA = (bf16_t*)(w + L.hA); p.hB = (bf16_t*)(w + L.hB); p.z = (bf16_t*)(w + L.z); p.pooled = (bf16_t*)(w + L.pooled); p.cat = (bf16_t*)(w + L.cat);
    p.xa = (bf16_t*)(w + L.xa); p.xb = (bf16_t*)(w + L.xb); p.qry = (float*)(w + L.qry); p.eidx = (unsigned short*)(w + L.eidx); p.gate = (float*)(w + L.gate); p.ab16 = (bf16_t*)(w + L.ab16);
}

#ifndef HIPEMU
#ifndef MK_ONE_LAUNCH
#define MK_ONE_LAUNCH 1
#endif
extern "C" void kernel_launch(void* const* d_in, const int* in_sizes, int n_in, void* d_out, int out_size, void* d_ws, size_t ws_size, hipStream_t stream) {
    static int grid = 0;
    if (grid == 0) {
        const WsLayout L = ws_layout();
        if (n_in != 24 || (size_t)out_size != OUT_TOTAL || ws_size < L.end) { fprintf(stderr, "kernel_launch: unexpected shapes (n_in %d, out %d, ws %zu < %zu)\n", n_in, out_size, ws_size, L.end); grid = -1; return; }
        int dev = 0, cus = 0, per_cu = 0;
        hipGetDevice(&dev); hipDeviceGetAttribute(&cus, hipDeviceAttributeMultiprocessorCount, dev);
        if (hipFuncSetAttribute((const void*)mega_fwd, hipFuncAttributeMaxDynamicSharedMemorySize, LDS_BYTES) != hipSuccess) { fprintf(stderr, "kernel_launch: hipFuncSetAttribute failed\n"); grid = -1; return; }
        hipOccupancyMaxActiveBlocksPerMultiprocessor(&per_cu, (const void*)mega_fwd, 512, LDS_BYTES);
        (void)hipGetLastError();
        if (per_cu < 1) fprintf(stderr, "kernel_launch: occupancy query says %d blocks per CU\n", per_cu);
        grid = cus;
    }
    if (grid < 0) return;
    Params p{};
    fill_params(p, d_in, d_out, d_ws);
    hipMemsetAsync(p.bar, 0, 16384, stream);
#if MK_ONE_LAUNCH
    p.ph_lo = 0; p.ph_hi = N_PHASES;
    hipLaunchKernelGGL(mega_fwd, dim3(grid), dim3(512), LDS_BYTES, stream, p);
#else
    for (int ph = 0; ph < N_PHASES; ++ph) { p.ph_lo = ph; p.ph_hi = ph + 1; hipLaunchKernelGGL(mega_fwd, dim3(grid), dim3(512), LDS_BYTES, stream, p); }
#endif
}
#endif
```

```cpp
#ifndef HIPEMU
#include <hip/hip_runtime.h>
#include <cstdio>
#endif
#include <stdint.h>

#ifndef CFG_PB
#define CFG_PB 4
#define CFG_SEQ 2048
#define CFG_DB 128
#endif

#ifdef HIPEMU
#define DEV inline
#define LAS
#define READLANE_I(v, l) emu_readlane((v), (l))
#define READLANE_F(v, l) emu_readlane_f((v), (l))
#define MFMA_BF16(a, b, c) emu_mfma_bf16_16x16x32((a), (b), (c))
#define MFMA_F32(a, b, c) emu_mfma_f32_16x16x4((a), (b), (c))
#define SDOT8(a, b, c) emu_sdot8((a), (b), (c))
#define __expf expf
#define __logf logf
#else
#define DEV __device__ __forceinline__
#define LAS __attribute__((address_space(3)))
#define READLANE_I(v, l) __builtin_amdgcn_readlane((v), (l))
#define READLANE_F(v, l) __uint_as_float((unsigned)__builtin_amdgcn_readlane((int)__float_as_uint(v), (l)))
#define MFMA_BF16(a, b, c) __builtin_amdgcn_mfma_f32_16x16x32_bf16((a), (b), (c), 0, 0, 0)
#define MFMA_F32(a, b, c) __builtin_amdgcn_mfma_f32_16x16x4f32((a), (b), (c), 0, 0, 0)
#define SDOT8(a, b, c) __builtin_amdgcn_sdot8((int)(a), (int)(b), (c), false)
#endif

typedef unsigned short bf16_t;
typedef short bf16x8 __attribute__((ext_vector_type(8)));
typedef float f32x4 __attribute__((ext_vector_type(4)));
typedef unsigned u32x4 __attribute__((ext_vector_type(4)));
typedef unsigned u32x2 __attribute__((ext_vector_type(2)));

namespace cfg {
constexpr int D = 2048, PB = CFG_PB, SEQ = CFG_SEQ, DB = CFG_DB, DSEQ = 4;
constexpr int NP = PB * SEQ, NS = DB * DSEQ, NTOK = NP + NS, MPAD = (NTOK + 255) / 256 * 256;
constexpr int NC = PB + DB;
constexpr int HH = 8, HD = 128, PW = 1024, PBUF = 15, ZW = 5120;
constexpr int NE = 16384;
constexpr int NMOD = 6 * D;
constexpr int MODW = 2 * NMOD + 2 * D;
constexpr float EPS = 1e-6f;
constexpr int NCHAIN = PB * HH;
constexpr size_t OFF_Y = 0;
constexpr size_t OFF_HP = (size_t)NTOK * D;
constexpr size_t OFF_PP = OFF_HP + (size_t)2 * PB * HH * HD * HD;
constexpr size_t OFF_HS = OFF_PP + (size_t)2 * PB * PBUF * PW;
constexpr size_t OFF_PS = OFF_HS + (size_t)2 * DB * HH * HD * HD;
constexpr size_t OUT_TOTAL = OFF_PS + (size_t)2 * DB * PBUF * PW;
}
using namespace cfg;

struct Params {
    const float *x_prompt, *x_sample, *c_prompt, *c_sample, *state_hgrn, *state_pool, *w_ada, *b_ada, *norm1_g, *norm2_g, *w_in, *w_out,
        *lb_logits, *hgrn_norm_g, *pool_w, *pool_b, *pool_scale, *peer_wq, *peer_keys, *peer_u, *peer_v, *final_g, *w_ada_final, *b_ada_final;
    float* out;
    unsigned* bar; float* modbuf; bf16_t* csil; bf16_t* wt_ada; bf16_t* wt_in; bf16_t* wt_out; bf16_t* wt_q; bf16_t* wt_pool;
    unsigned char* u8; unsigned char* v8; float* su; float* sv; unsigned* hd; float* hs; float* part; bf16_t* hg_oin; bf16_t* hg_ds; float* hg_gam; bf16_t* hg_qh; bf16_t* hg_sc; bf16_t* hA; bf16_t* hB; bf16_t* z; bf16_t* pooled; bf16_t* cat; bf16_t* xa; bf16_t* xb; float* qry; unsigned short* eidx; float* gate; bf16_t* ab16;
    int ph_lo, ph_hi;
};

DEV float bf2f(unsigned v) { return __uint_as_float(v << 16); }
#ifdef HIPEMU
DEV unsigned f2bf(float f) { unsigned u = __float_as_uint(f); u += 0x7fffu + ((u >> 16) & 1u); return u >> 16; }
DEV unsigned pack2(float lo, float hi) { return f2bf(lo) | (f2bf(hi) << 16); }
#else
typedef float f32x2_t __attribute__((ext_vector_type(2)));
typedef __bf16 bf16x2_t __attribute__((ext_vector_type(2)));
DEV unsigned pack2(float lo, float hi) { const f32x2_t v = {lo, hi}; return __builtin_bit_cast(unsigned, __builtin_convertvector(v, bf16x2_t)); }
DEV unsigned f2bf(float f) { return (unsigned)__builtin_bit_cast(unsigned short, (__bf16)f); }
#endif
DEV float lo16(unsigned w) { return __uint_as_float(w << 16); }
DEV float hi16(unsigned w) { return __uint_as_float(w & 0xffff0000u); }
DEV float wave_sum(float v) { v += __shfl_xor(v, 32); v += __shfl_xor(v, 16); v += __shfl_xor(v, 8); v += __shfl_xor(v, 4); v += __shfl_xor(v, 2); v += __shfl_xor(v, 1); return v; }
DEV float wave_max(float v) { v = fmaxf(v, __shfl_xor(v, 32)); v = fmaxf(v, __shfl_xor(v, 16)); v = fmaxf(v, __shfl_xor(v, 8)); v = fmaxf(v, __shfl_xor(v, 4)); v = fmaxf(v, __shfl_xor(v, 2)); v = fmaxf(v, __shfl_xor(v, 1)); return v; }
DEV float sigmoidf_(float x) { return 1.0f / (1.0f + __expf(-x)); }
DEV float siluf_(float x) { return x / (1.0f + __expf(-x)); }
DEV float gelu_erf(float x) { return 0.5f * x * (1.0f + erff(x * 0.70710678118f)); }
#ifdef HIPEMU
DEV int wave_id() { return (int)(threadIdx.x >> 6); }
#else
DEV int wave_id() { return __builtin_amdgcn_readfirstlane((int)(threadIdx.x >> 6)); }
#endif
DEV int tok_batch(int t) { return t < NP ? t / SEQ : PB + (t - NP) / DSEQ; }


#ifdef HIPEMU
static inline unsigned emu_fp8_enc1(float x) {
    const unsigned sgn = x < 0.f ? 0x80u : 0u; float a = fabsf(x);
    if (!(a == a)) return 0x7fu;
    if (a >= 448.f) return sgn | 0x7eu;
    if (a < 0.015625f) { const int q = (int)rintf(a * 512.f); return sgn | (unsigned)q; }
    int e = (int)floorf(log2f(a)); if (ldexpf(1.f, e) > a) --e; if (ldexpf(1.f, e + 1) <= a) ++e;
    int m = (int)rintf((a / ldexpf(1.f, e) - 1.f) * 8.f); if (m == 8) { m = 0; ++e; }
    if (e > 8) return sgn | 0x7eu;
    return sgn | (unsigned)((e + 7) << 3) | (unsigned)m;
}
static inline float emu_fp8_dec1(unsigned b) { const float sg = (b & 0x80u) ? -1.f : 1.f; const int e = (b >> 3) & 15, m = b & 7; return sg * (e == 0 ? m * 0.001953125f : (1.f + m * 0.125f) * ldexpf(1.f, e - 7)); }
DEV unsigned fp8x4_enc(float a, float b, float c, float d) { return emu_fp8_enc1(a) | (emu_fp8_enc1(b) << 8) | (emu_fp8_enc1(c) << 16) | (emu_fp8_enc1(d) << 24); }
DEV void fp8x4_dec(unsigned w, float* o) { o[0] = emu_fp8_dec1(w & 255u); o[1] = emu_fp8_dec1((w >> 8) & 255u); o[2] = emu_fp8_dec1((w >> 16) & 255u); o[3] = emu_fp8_dec1(w >> 24); }
#define DPP_XOR1(v) __shfl((v), emu_lane() ^ 1)
#define DPP_XOR2(v) __shfl((v), emu_lane() ^ 2)
#define DPP_HMIRROR(v) __shfl((v), (emu_lane() & ~7) | (7 - (emu_lane() & 7)))
#define DPP_XOR8(v) __shfl((v), emu_lane() ^ 8)
#define DPP_RMIRROR(v) __shfl((v), (emu_lane() & ~15) | (15 - (emu_lane() & 15)))
#define WAVE_LDS_SYNC() emu_wbar()
DEV float xsum16(float a, float b) { const bool hi = (emu_lane() & 16) != 0; return (hi ? b : a) + __shfl_xor(hi ? a : b, 16); }
DEV float xsum32(float a, float b) { const bool hi = (emu_lane() & 32) != 0; return (hi ? b : a) + __shfl_xor(hi ? a : b, 32); }
#else
typedef float f32x2v_t __attribute__((ext_vector_type(2)));
DEV unsigned fp8x4_enc(float a, float b, float c, float d) { int r = __builtin_amdgcn_cvt_pk_fp8_f32(a, b, 0, false); r = __builtin_amdgcn_cvt_pk_fp8_f32(c, d, r, true); return (unsigned)r; }
DEV void fp8x4_dec(unsigned w, float* o) { const f32x2v_t lo = __builtin_amdgcn_cvt_pk_f32_fp8((int)w, false), hi = __builtin_amdgcn_cvt_pk_f32_fp8((int)w, true); o[0] = lo[0]; o[1] = lo[1]; o[2] = hi[0]; o[3] = hi[1]; }
template <int CTRL> DEV float dpp_f(float v) { return __uint_as_float((unsigned)__builtin_amdgcn_update_dpp(0, (int)__float_as_uint(v), CTRL, 0xf, 0xf, true)); }
#define DPP_XOR1(v) dpp_f<0xB1>(v)
#define DPP_XOR2(v) dpp_f<0x4E>(v)
#define DPP_HMIRROR(v) dpp_f<0x141>(v)
#define DPP_XOR8(v) dpp_f<0x128>(v)
#define DPP_RMIRROR(v) dpp_f<0x140>(v)
#define WAVE_LDS_SYNC() asm volatile("s_waitcnt lgkmcnt(0)" ::: "memory")
DEV float xsum16(float a, float b) { const u32x2 r = __builtin_amdgcn_permlane16_swap(__float_as_uint(a), __float_as_uint(b), false, false); return __uint_as_float(r[0]) + __uint_as_float(r[1]); }
DEV float xsum32(float a, float b) { const u32x2 r = __builtin_amdgcn_permlane32_swap(__float_as_uint(a), __float_as_uint(b), false, false); return __uint_as_float(r[0]) + __uint_as_float(r[1]); }
#endif
typedef float f32x2 __attribute__((ext_vector_type(2)));
#ifdef HIPEMU
DEV void fp8x4_dec2(unsigned w, f32x2& lo, f32x2& hi) { float o[4]; fp8x4_dec(w, o); lo = (f32x2){o[0], o[1]}; hi = (f32x2){o[2], o[3]}; }
#else
DEV void fp8x4_dec2(unsigned w, f32x2& lo, f32x2& hi) { lo = __builtin_amdgcn_cvt_pk_f32_fp8((int)w, false); hi = __builtin_amdgcn_cvt_pk_f32_fp8((int)w, true); }
#endif
DEV void fp8x16_dec2(u32x4 q, f32x2* o) { fp8x4_dec2(q.x, o[0], o[1]); fp8x4_dec2(q.y, o[2], o[3]); fp8x4_dec2(q.z, o[4], o[5]); fp8x4_dec2(q.w, o[6], o[7]); }
#ifdef HIPEMU
static inline unsigned emu_fp4_enc1(float x) {
    const unsigned sgn = x < 0.f ? 8u : 0u; const float a = fabsf(x);
    const unsigned c = a < 0.25f ? 0u : (a < 0.75f ? 1u : (a < 1.25f ? 2u : (a < 1.75f ? 3u : (a < 2.5f ? 4u : (a < 3.5f ? 5u : (a < 5.0f ? 6u : 7u))))));
    return sgn | c;
}
static inline float emu_fp4_dec1(unsigned n) { const float t[8] = {0.f, 0.5f, 1.f, 1.5f, 2.f, 3.f, 4.f, 6.f}; return ((n & 8u) ? -1.f : 1.f) * t[n & 7u]; }
DEV unsigned fp4x4_enc(float a, float b, float c, float d) { return emu_fp4_enc1(a) | (emu_fp4_enc1(b) << 4) | (emu_fp4_enc1(c) << 8) | (emu_fp4_enc1(d) << 12); }
DEV void fp4x8_dec2(unsigned w, f32x2* o) {
    for (int k = 0; k < 4; ++k) o[k] = (f32x2){emu_fp4_dec1((w >> (8 * k)) & 15u), emu_fp4_dec1((w >> (8 * k + 4)) & 15u)};
}
#else
DEV unsigned fp4x4_enc(float a, float b, float c, float d) { unsigned r = 0u; r = __builtin_amdgcn_cvt_scalef32_pk_fp4_f32(r, a, b, 1.0f, 0); r = __builtin_amdgcn_cvt_scalef32_pk_fp4_f32(r, c, d, 1.0f, 1); return r & 0xffffu; }
DEV void fp4x8_dec2(unsigned w, f32x2* o) {
    o[0] = __builtin_amdgcn_cvt_scalef32_pk_f32_fp4(w, 1.0f, 0); o[1] = __builtin_amdgcn_cvt_scalef32_pk_f32_fp4(w, 1.0f, 1);
    o[2] = __builtin_amdgcn_cvt_scalef32_pk_f32_fp4(w, 1.0f, 2); o[3] = __builtin_amdgcn_cvt_scalef32_pk_f32_fp4(w, 1.0f, 3);
}
#endif
DEV void fp4x32_dec2(u32x4 q, f32x2* o) { fp4x8_dec2(q.x, o); fp4x8_dec2(q.y, o + 4); fp4x8_dec2(q.z, o + 8); fp4x8_dec2(q.w, o + 12); }
#ifdef HIPEMU
DEV void fp4x8_decb(unsigned w, unsigned* o) { for (int k = 0; k < 4; ++k) o[k] = f2bf(emu_fp4_dec1((w >> (8 * k)) & 15u)) | (f2bf(emu_fp4_dec1((w >> (8 * k + 4)) & 15u)) << 16); }
DEV float dot2bf(unsigned a, unsigned b, float c) { return c + lo16(a) * lo16(b) + hi16(a) * hi16(b); }
#else
typedef __bf16 bf16x2v_t __attribute__((ext_vector_type(2)));
DEV void fp4x8_decb(unsigned w, unsigned* o) {
    o[0] = __builtin_bit_cast(unsigned, __builtin_amdgcn_cvt_scalef32_pk_bf16_fp4(w, 1.0f, 0)); o[1] = __builtin_bit_cast(unsigned, __builtin_amdgcn_cvt_scalef32_pk_bf16_fp4(w, 1.0f, 1));
    o[2] = __builtin_bit_cast(unsigned, __builtin_amdgcn_cvt_scalef32_pk_bf16_fp4(w, 1.0f, 2)); o[3] = __builtin_bit_cast(unsigned, __builtin_amdgcn_cvt_scalef32_pk_bf16_fp4(w, 1.0f, 3));
}
DEV float dot2bf(unsigned a, unsigned b, float c) { return __builtin_amdgcn_fdot2_f32_bf16(__builtin_bit_cast(bf16x2v_t, a), __builtin_bit_cast(bf16x2v_t, b), c, false); }
#endif

namespace pg8 {
constexpr int BM = 256, BK = 64, HALF = 128, HTB = HALF * BK * 2, STAGE_BYTES = 8 * HTB, NXCD = 8, WGM = 8;
DEV int lds_byte(int r, int c) { const int st = (r >> 4) * 2 + (c >> 5), rr = r & 15, cc = c & 31, ob = rr * 64 + cc * 2; return st * 1024 + (ob ^ (((ob >> 9) & 1) << 5)); }
DEV void stage_rc(int b, int& R, int& C) { const int st = b / 1024, sb = b % 1024, swz = sb ^ (((sb >> 9) & 1) << 5); R = (st >> 1) * 16 + swz / 64; C = (st & 1) * 32 + (swz % 64) / 2; }
DEV int perm32(int rho) { const int n = rho >> 4, i = rho & 15; return 8 * (i >> 2) + 4 * n + (i & 3); }
struct Unit { int pm, pn; };
struct Gemm { const bf16_t* A; const bf16_t* Bt; int M, N, K; };
struct StaticOrder {
    int nM, nN, nwg, G, c;
    DEV void init(int M, int N, int G_, int c_) { nM = M / BM; nN = N / BM; nwg = nM * nN; G = G_; c = c_; }
    DEV bool next(int i, Unit& u) const {
        const long L = (long)i * G + c; if (L >= nwg) return false;
        int wgid = (int)L; { const int q = nwg / NXCD, r = nwg % NXCD, xcd = wgid % NXCD, off = wgid / NXCD; wgid = (xcd < r ? xcd * (q + 1) : r * (q + 1) + (xcd - r) * q) + off; }
        const int nig = WGM * nN, gid = wgid / nig, fm = gid * WGM, gsz = (nM - fm) < WGM ? (nM - fm) : WGM;
        u.pm = fm + ((wgid % nig) % gsz); u.pn = (wgid % nig) / gsz; return true;
    }
    DEV void a_ready(const Unit&) const {}
    DEV void done(const Unit&) const {}
};
struct PoolOrder {
    int G, c;
    DEV bool next(int i, Unit& u) const { const int L = i * G + c; if (L >= 4 * (MPAD / 256)) return false; u.pm = L; u.pn = L / (MPAD / 256); return true; }
    DEV void a_ready(const Unit&) const {}
    DEV void done(const Unit&) const {}
};

struct EpiF32 {
    static constexpr bool PERM = false;
    float* C; int ldc;
    DEV void operator()(const f32x4 (&acc)[2][2][4][2], const Unit& u, int wr, int wc, int fr, int fq) const {
        const int row0 = u.pm * BM + wr * 64 + fr, col0 = u.pn * BM + wc * 32 + 4 * fq;
#pragma unroll
        for (int ai = 0; ai < 2; ++ai)
#pragma unroll
            for (int m = 0; m < 4; ++m) { float* rowp = C + (size_t)(row0 + ai * HALF + m * 16) * ldc + col0;
#pragma unroll
                for (int bj = 0; bj < 2; ++bj)
#pragma unroll
                    for (int n = 0; n < 2; ++n) *(f32x4*)(rowp + bj * HALF + n * 16) = acc[ai][bj][m][n]; }
    }
};
struct EpiAda {
    static constexpr bool PERM = false;
    float* C; const float* b_ada; const float* b_fin;
    DEV void operator()(const f32x4 (&acc)[2][2][4][2], const Unit& u, int wr, int wc, int fr, int fq) const {
        const int row0 = u.pm * BM + wr * 64 + fr, col0 = u.pn * BM + wc * 32 + 4 * fq;
        const float* bias = (u.pn * BM < 2 * NMOD) ? b_ada + col0 : b_fin + (col0 - 2 * NMOD);
        f32x4 bv[2][2];
#pragma unroll
        for (int bj = 0; bj < 2; ++bj)
#pragma unroll
            for (int n = 0; n < 2; ++n) bv[bj][n] = *(const f32x4*)(bias + bj * HALF + n * 16);
#pragma unroll
        for (int ai = 0; ai < 2; ++ai)
#pragma unroll
            for (int m = 0; m < 4; ++m) { float* rowp = C + (size_t)(row0 + ai * HALF + m * 16) * MODW + col0;
#pragma unroll
                for (int bj = 0; bj < 2; ++bj)
#pragma unroll
                    for (int n = 0; n < 2; ++n) *(f32x4*)(rowp + bj * HALF + n * 16) = acc[ai][bj][m][n] + bv[bj][n]; }
    }
};
struct EpiResid {
    static constexpr bool PERM = false;
    const float* xlo; const float* xhi; const bf16_t* x16; const float* gmod  ; bf16_t* out;
    DEV void operator()(const f32x4 (&acc)[2][2][4][2], const Unit& u, int wr, int wc, int fr, int fq) const {
        const int row0 = u.pm * BM + wr * 64 + fr, col0 = u.pn * BM + wc * 32 + 4 * fq;
#pragma unroll
        for (int ai = 0; ai < 2; ++ai)
#pragma unroll
            for (int m = 0; m < 4; ++m) {
                const int row = row0 + ai * HALF + m * 16;
                if (row < NTOK) {
                    const float* gr = gmod + (size_t)tok_batch(row) * MODW + col0;
                    bf16_t* rowp = out + (size_t)row * D + col0;
#pragma unroll
                    for (int bj = 0; bj < 2; ++bj)
#pragma unroll
                        for (int n = 0; n < 2; ++n) { f32x4 xv;
                            if (x16) { const u32x2 xw = *(const u32x2*)(x16 + (size_t)row * D + col0 + bj * HALF + n * 16); xv = (f32x4){lo16(xw.x), hi16(xw.x), lo16(xw.y), hi16(xw.y)}; }
                            else xv = *(const f32x4*)((row < NP ? xlo + (size_t)row * D : xhi + (size_t)(row - NP) * D) + col0 + bj * HALF + n * 16);
                            const f32x4 gv = *(const f32x4*)(gr + bj * HALF + n * 16), o = xv + gv * acc[ai][bj][m][n];
                            u32x2 ow; ow.x = pack2(o[0], o[1]); ow.y = pack2(o[2], o[3]); *(u32x2*)(rowp + bj * HALF + n * 16) = ow; }
                }
            }
    }
};
struct EpiBf16 {
    static constexpr bool PERM = true;
    bf16_t* O; int ldc;
    DEV void operator()(const f32x4 (&acc)[2][2][4][2], const Unit& u, int wr, int wc, int fr, int fq) const {
        const int row0 = u.pm * BM + wr * 64 + fr, col0 = u.pn * BM + wc * 32 + 8 * fq;
#pragma unroll
        for (int ai = 0; ai < 2; ++ai)
#pragma unroll
            for (int m = 0; m < 4; ++m) { bf16_t* rowp = O + (size_t)(row0 + ai * HALF + m * 16) * ldc + col0;
#pragma unroll
                for (int bj = 0; bj < 2; ++bj) { const f32x4 v0 = acc[ai][bj][m][0], v1 = acc[ai][bj][m][1];
                    u32x4 w; w.x = pack2(v0[0], v0[1]); w.y = pack2(v0[2], v0[3]); w.z = pack2(v1[0], v1[1]); w.w = pack2(v1[2], v1[3]);
                    *(u32x4*)(rowp + bj * HALF) = w; } }
    }
};
struct EpiPool {
    static constexpr bool PERM = true;
    bf16_t* cat; const float* pb; const float* ps;
    DEV void operator()(const f32x4 (&acc)[2][2][4][2], const Unit& u, int wr, int wc, int fr, int fq) const {
        const int g = u.pn, tok0 = u.pm * BM - g * MPAD + wr * 64 + fr, col0 = g * 256 + wc * 32 + 8 * fq;
#pragma unroll
        for (int bj = 0; bj < 2; ++bj) {
            const f32x4 b0 = *(const f32x4*)(pb + col0 + bj * HALF), b1 = *(const f32x4*)(pb + col0 + bj * HALF + 4);
            const f32x4 s0 = *(const f32x4*)(ps + col0 + bj * HALF), s1 = *(const f32x4*)(ps + col0 + bj * HALF + 4);
#pragma unroll
            for (int ai = 0; ai < 2; ++ai)
#pragma unroll
                for (int m = 0; m < 4; ++m) { const int tok = tok0 + ai * HALF + m * 16;
                    if (tok < NTOK) { const f32x4 v0 = (acc[ai][bj][m][0] + b0) * s0, v1 = (acc[ai][bj][m][1] + b1) * s1;
                        u32x4 w; w.x = pack2(v0[0], v0[1]); w.y = pack2(v0[2], v0[3]); w.z = pack2(v1[0], v1[1]); w.w = pack2(v1[2], v1[3]);
                        *(u32x4*)(cat + (size_t)tok * D + 1024 + col0 + bj * HALF) = w; } }
        }
    }
};

#ifdef HIPEMU
template <class Epi, class Sched>
static void gemm_phase(unsigned char*, const Gemm g, const Sched& S, const Epi& E) {
    const int tid = threadIdx.x, wid = tid >> 6, lane = tid & 63, wr = wid >> 2, wc = wid & 3, fr = lane & 15, fq = lane >> 4;
    Unit cur;
    for (int ui = 0; S.next(ui, cur); ++ui) {
        f32x4 acc[2][2][4][2];
        for (int ai = 0; ai < 2; ++ai) for (int bj = 0; bj < 2; ++bj) for (int m = 0; m < 4; ++m) for (int n = 0; n < 2; ++n) for (int j = 0; j < 4; ++j) {
            const int row = 256 * cur.pm + 128 * ai + 64 * wr + 16 * m + fr;
            const int col = Epi::PERM ? 256 * cur.pn + 128 * bj + 32 * wc + 8 * fq + 4 * n + j : 256 * cur.pn + 128 * bj + 32 * wc + 16 * n + 4 * fq + j;
            float s = 0.f;
            if ((row % emu_row_mod) < emu_row_limit) { const float* a = emu_f32_copy(g.A, (size_t)g.M * g.K) + (size_t)row * g.K; const float* b = emu_f32_copy(g.Bt, (size_t)g.N * g.K) + (size_t)col * g.K;
                for (int k = 0; k < g.K; ++k) s += a[k] * b[k]; }
            acc[ai][bj][m][n][j] = s; }
        E(acc, cur, wr, wc, fr, fq);
    }
    __syncthreads();
}
#else
template <class Epi, class Sched>
__device__ __forceinline__ void gemm_phase(LAS unsigned char* lds, const Gemm g, const Sched& S, const Epi& E) {
    const int tid = threadIdx.x, wid = __builtin_amdgcn_readfirstlane(tid >> 6), lane = tid & 63, wr = wid >> 2, wc = wid & 3, fr = lane & 15, fq = lane >> 4;
    int K = g.K; asm volatile("" : "+s"(K));
    const int nt = K / BK;
    unsigned voffA[2], voffB[2];
#pragma unroll
    for (int i = 0; i < 2; ++i) { int R, C; stage_rc(tid * 16 + i * 8192, R, C); const int Rb = Epi::PERM ? ((R & ~31) + perm32(R & 31)) : R;
        voffA[i] = (unsigned)(R * K + C) * 2u; voffB[i] = (unsigned)(Rb * K + C) * 2u; }
    const size_t kstep = (size_t)(BK * 2);
    const size_t hstep = (size_t)HALF * K * 2;
    const size_t tstep = 2 * hstep;
    const unsigned ldsw = (unsigned)wid * 1024u;
    const int aoff = lds_byte(wr * 64 + fr, fq * 8), boff = lds_byte(wc * 32 + fr, fq * 8);
#define PG8_SA(b, h) (((b) * 2 + (h)) * HTB)
#define PG8_SB(b, h) ((4 + (b) * 2 + (h)) * HTB)
#define PG8_STAGE(bufoff, gbase, voff) do { _Pragma("unroll") for (int _i = 0; _i < 2; ++_i) \
        __builtin_amdgcn_global_load_lds((const unsigned*)((const char*)(gbase) + (voff)[_i]), (LAS unsigned*)(lds + (bufoff) + ldsw + _i * 8192), 16, 0, 0); } while (0)
#define PG8_LDA(dst, b, h) do { _Pragma("unroll") for (int m = 0; m < 4; ++m) _Pragma("unroll") for (int k = 0; k < 2; ++k) dst[m][k] = *(const LAS bf16x8*)(lds + PG8_SA(b, h) + aoff + m * 2048 + k * 1024); } while (0)
#define PG8_LDB(dst, b, h) do { _Pragma("unroll") for (int n = 0; n < 2; ++n) _Pragma("unroll") for (int k = 0; k < 2; ++k) dst[n][k] = *(const LAS bf16x8*)(lds + PG8_SB(b, h) + boff + n * 2048 + k * 1024); } while (0)
#define PG8_MMA(ai, bj, At, Bt) do { __builtin_amdgcn_s_setprio(1); _Pragma("unroll") for (int m = 0; m < 4; ++m) _Pragma("unroll") for (int n = 0; n < 2; ++n) _Pragma("unroll") for (int k = 0; k < 2; ++k) \
        acc[ai][bj][m][n] = __builtin_amdgcn_mfma_f32_16x16x32_bf16(Bt[n][k], At[m][k], acc[ai][bj][m][n], 0, 0, 0); __builtin_amdgcn_s_setprio(0); } while (0)
#define PG8_WAIT_V(n) asm volatile("s_waitcnt vmcnt(" #n ")" ::: "memory")
#define PG8_WAIT_L(n) asm volatile("s_waitcnt lgkmcnt(" #n ")" ::: "memory")
#define PG8_BAR __builtin_amdgcn_s_barrier()
#define PG8_SCHED __builtin_amdgcn_sched_barrier(0)
    Unit cur, nxt; int ui = 0;
    if (!S.next(0, cur)) return;
    f32x4 acc[2][2][4][2];
#pragma unroll
    for (int a = 0; a < 2; ++a)
#pragma unroll
        for (int b = 0; b < 2; ++b)
#pragma unroll
            for (int m = 0; m < 4; ++m)
#pragma unroll
                for (int n = 0; n < 2; ++n) acc[a][b][m][n] = (f32x4){0.f, 0.f, 0.f, 0.f};
    bf16x8 At[4][2], B0[2][2], B1[2][2];
    const char* cA = (const char*)g.A + (size_t)cur.pm * tstep; const char* cB = (const char*)g.Bt + (size_t)cur.pn * tstep;
    S.a_ready(cur);
    PG8_STAGE(PG8_SB(0, 0), cB, voffB); PG8_STAGE(PG8_SA(0, 0), cA, voffA); PG8_STAGE(PG8_SB(0, 1), cB + hstep, voffB); PG8_STAGE(PG8_SA(0, 1), cA + hstep, voffA);
    if (wr == 1) PG8_BAR;
    PG8_WAIT_V(4); PG8_BAR;
    PG8_STAGE(PG8_SB(1, 0), cB + kstep, voffB); PG8_STAGE(PG8_SA(1, 0), cA + kstep, voffA); PG8_STAGE(PG8_SB(1, 1), cB + hstep + kstep, voffB);
    PG8_WAIT_V(6); PG8_BAR;
    for (;;) {
        const bool has_next = S.next(ui + 1, nxt);
        const char* nA = has_next ? (const char*)g.A + (size_t)nxt.pm * tstep : cA; const char* nB = has_next ? (const char*)g.Bt + (size_t)nxt.pn * tstep : cB;
        for (int t = 0; t < nt; t += 2) {
            const bool last = (t == nt - 2);
            const char* a1 = cA + (size_t)(t + 1) * kstep;
            const char* a2 = last ? nA : cA + (size_t)(t + 2) * kstep; const char* b2 = last ? nB : cB + (size_t)(t + 2) * kstep;
            const char* a3 = a2 + kstep; const char* b3 = b2 + kstep;
            if (last && has_next) S.a_ready(nxt);
            PG8_LDB(B0, 0, 0); PG8_SCHED; PG8_LDA(At, 0, 0); PG8_STAGE(PG8_SA(1, 1), a1 + hstep, voffA);
            PG8_WAIT_L(8); PG8_BAR; PG8_WAIT_L(0); PG8_MMA(0, 0, At, B0); PG8_BAR; PG8_SCHED;
            PG8_LDB(B1, 0, 1); PG8_STAGE(PG8_SB(0, 0), b2, voffB);
            PG8_BAR; PG8_WAIT_L(0); PG8_MMA(0, 1, At, B1); PG8_BAR;
            PG8_LDA(At, 0, 1); PG8_STAGE(PG8_SA(0, 0), a2, voffA);
            PG8_BAR; PG8_WAIT_L(0); PG8_MMA(1, 0, At, B0); PG8_BAR; PG8_SCHED;
            PG8_STAGE(PG8_SB(0, 1), b2 + hstep, voffB);
            PG8_WAIT_V(6); PG8_BAR; PG8_MMA(1, 1, At, B1); PG8_BAR;
            PG8_LDB(B0, 1, 0); PG8_SCHED; PG8_LDA(At, 1, 0); PG8_STAGE(PG8_SA(0, 1), a2 + hstep, voffA);
            PG8_WAIT_L(8); PG8_BAR; PG8_WAIT_L(0); PG8_MMA(0, 0, At, B0); PG8_BAR; PG8_SCHED;
            PG8_LDB(B1, 1, 1); PG8_STAGE(PG8_SB(1, 0), b3, voffB);
            PG8_BAR; PG8_WAIT_L(0); PG8_MMA(0, 1, At, B1); PG8_BAR;
            PG8_LDA(At, 1, 1); PG8_STAGE(PG8_SA(1, 0), a3, voffA);
            PG8_BAR; PG8_WAIT_L(0); PG8_MMA(1, 0, At, B0); PG8_BAR; PG8_SCHED;
            PG8_STAGE(PG8_SB(1, 1), b3 + hstep, voffB);
            PG8_WAIT_V(6); PG8_BAR; PG8_MMA(1, 1, At, B1); PG8_BAR;
        }
        { int tz = threadIdx.x; asm volatile("" : "+v"(tz)); const int wz = tz >> 6, lz = tz & 63;
          E(acc, cur, wz >> 2, wz & 3, lz & 15, lz >> 4); } S.done(cur);
        if (!has_next) break;
#pragma unroll
        for (int a = 0; a < 2; ++a)
#pragma unroll
            for (int b = 0; b < 2; ++b)
#pragma unroll
                for (int m = 0; m < 4; ++m)
#pragma unroll
                    for (int n = 0; n < 2; ++n) acc[a][b][m][n] = (f32x4){0.f, 0.f, 0.f, 0.f};
        cur = nxt; cA = nA; cB = nB; ++ui;
    }
    PG8_WAIT_V(0);
    if (wr == 0) PG8_BAR;
    PG8_BAR;
#undef PG8_SA
#undef PG8_SB
#undef PG8_STAGE
#undef PG8_LDA
#undef PG8_LDB
#undef PG8_MMA
#undef PG8_WAIT_V
#undef PG8_WAIT_L
#undef PG8_BAR
#undef PG8_SCHED
}
#endif
}

constexpr int MBIG = (NP / 256) * 256;
template <class F> DEV void small_gemm(const bf16_t* A, const bf16_t* Bt, int K, unsigned char* lds, const F& f) {
    const int tid = threadIdx.x, lane = tid & 63, w = tid >> 6, g = lane >> 4, c16 = lane & 15;
    const int tiles_m = (NTOK - MBIG + 63) / 64, ntiles = tiles_m * 32, kw = K / 8;
    float* part = (float*)lds;
    for (int tl = blockIdx.x; tl < ntiles; tl += gridDim.x) {
        const int r0 = MBIG + (tl / 32) * 64, n0 = (tl % 32) * 64;
        f32x4 acc[4][4];
#pragma unroll
        for (int i = 0; i < 4; ++i)
#pragma unroll
            for (int j = 0; j < 4; ++j) acc[i][j] = (f32x4){0.f, 0.f, 0.f, 0.f};
        for (int k0 = w * kw; k0 < (w + 1) * kw; k0 += 128) {
            bf16x8 af[4][4], bfr[4][4];
#pragma unroll
            for (int u = 0; u < 4; ++u)
#pragma unroll
                for (int i = 0; i < 4; ++i) { int arow = r0 + 16 * i + c16; if (arow >= MPAD) arow = MPAD - 1;
                    af[u][i] = *(const bf16x8*)(A + (size_t)arow * K + k0 + 32 * u + 8 * g); bfr[u][i] = *(const bf16x8*)(Bt + (size_t)(n0 + 16 * i + c16) * K + k0 + 32 * u + 8 * g); }
#pragma unroll
            for (int u = 0; u < 4; ++u)
#pragma unroll
                for (int i = 0; i < 4; ++i)
#pragma unroll
                    for (int j = 0; j < 4; ++j) acc[i][j] = MFMA_BF16(af[u][i], bfr[u][j], acc[i][j]);
        }
#pragma unroll
        for (int i = 0; i < 4; ++i)
#pragma unroll
            for (int j = 0; j < 4; ++j)
#pragma unroll
                for (int r = 0; r < 4; ++r) part[(w * 64 + 16 * i + 4 * g + r) * 68 + 16 * j + c16] = acc[i][j][r];
        __syncthreads();
        {
            const int row = tid >> 3, c8 = (tid & 7) * 8; f32x4 s0 = (f32x4){0.f, 0.f, 0.f, 0.f}, s1 = s0;
#pragma unroll
            for (int ww = 0; ww < 8; ++ww) { s0 += *(const f32x4*)(part + (ww * 64 + row) * 68 + c8); s1 += *(const f32x4*)(part + (ww * 64 + row) * 68 + c8 + 4); }
            if (r0 + row < NTOK) f(r0 + row, n0 + c8, s0, s1);
        }
        __syncthreads();
    }
}
struct SmallResid { const float* xlo; const float* xhi; const bf16_t* x16; const float* gmod; bf16_t* out;
    DEV void operator()(int row, int col, f32x4 v0, f32x4 v1) const { const float* gr = gmod + (size_t)tok_batch(row) * MODW + col; f32x4 x0, x1;
        if (x16) { const u32x4 xw = *(const u32x4*)(x16 + (size_t)row * D + col); x0 = (f32x4){lo16(xw.x), hi16(xw.x), lo16(xw.y), hi16(xw.y)}; x1 = (f32x4){lo16(xw.z), hi16(xw.z), lo16(xw.w), hi16(xw.w)}; }
        else { const float* xr = (row < NP ? xlo + (size_t)row * D : xhi + (size_t)(row - NP) * D) + col; x0 = *(const f32x4*)xr; x1 = *(const f32x4*)(xr + 4); }
        const f32x4 o0 = x0 + *(const f32x4*)gr * v0, o1 = x1 + *(const f32x4*)(gr + 4) * v1;
        u32x4 ow; ow.x = pack2(o0[0], o0[1]); ow.y = pack2(o0[2], o0[3]); ow.z = pack2(o1[0], o1[1]); ow.w = pack2(o1[2], o1[3]); *(u32x4*)(out + (size_t)row * D + col) = ow; } };
struct SmallF32 { float* out; DEV void operator()(int row, int col, f32x4 v0, f32x4 v1) const { float* o = out + (size_t)row * D + col; *(f32x4*)o = v0; *(f32x4*)(o + 4) = v1; } };

DEV void transpose_tile(const float* src, int ld_src, bf16_t* dst, int ld_dst, float* tile) {
    const int tid = threadIdx.x;
#pragma unroll
    for (int i = 0; i < 2; ++i) { const int idx = tid + i * 512, r = idx >> 4, c4 = idx & 15; const f32x4 v = *(const f32x4*)(src + (size_t)r * ld_src + c4 * 4);
        float* t = tile + r * 65 + c4 * 4; t[0] = v[0]; t[1] = v[1]; t[2] = v[2]; t[3] = v[3]; }
    __syncthreads();
    const int n = tid >> 3, kg = tid & 7; const float* t = tile + (kg * 8) * 65 + n;
    u32x4 w; w.x = pack2(t[0], t[65]); w.y = pack2(t[2 * 65], t[3 * 65]); w.z = pack2(t[4 * 65], t[5 * 65]); w.w = pack2(t[6 * 65], t[7 * 65]);
    *(u32x4*)(dst + (size_t)n * ld_dst + kg * 8) = w;
    __syncthreads();
}
constexpr int ADA_UNITS = MODW / 128, ADA_RT = (NC + 15) / 16, ADA_AS = 72;
DEV void ada_direct_unit(const Params& p, int unit, unsigned char* lds) {
    const int tid = threadIdx.x, lane = tid & 63, w = wave_id(), rho = lane & 15, gam = lane >> 4;
    const int n0 = unit * 128;
    const float* W; const float* bias; int ldw, cw;
    if (n0 < NMOD) { W = p.w_ada; bias = p.b_ada; ldw = NMOD; cw = n0; }
    else if (n0 < 2 * NMOD) { W = p.w_ada + (size_t)D * NMOD; bias = p.b_ada + NMOD; ldw = NMOD; cw = n0 - NMOD; }
    else { W = p.w_ada_final; bias = p.b_ada_final; ldw = 2 * D; cw = n0 - 2 * NMOD; }
    const float* wu = W + cw + 16 * w; const unsigned loff = (unsigned)(8 * gam * ldw + rho);
    bf16_t* As = (bf16_t*)lds;
    f32x4 acc[ADA_RT];
#pragma unroll
    for (int rt = 0; rt < ADA_RT; ++rt) acc[rt] = (f32x4){0.f, 0.f, 0.f, 0.f};
    constexpr int NCH = D / 64, ACNT = (16 * ADA_RT * 16 + 511) / 512;
    float wa[16], wb[16], wc2[16]; f32x4 cr[ACNT];
#define ADA_WLOAD(dst, kc_) do { const float* wq_ = wu + (size_t)(64 * (kc_)) * ldw; _Pragma("unroll") for (int s2 = 0; s2 < 2; ++s2) _Pragma("unroll") for (int j = 0; j < 8; ++j) dst[8 * s2 + j] = (wq_ + (size_t)(32 * s2 + j) * ldw)[loff]; } while (0)
#define ADA_CLOAD(kc_) do { _Pragma("unroll") for (int u = 0; u < ACNT; ++u) { const int i = tid + 512 * u, r = i >> 4, k4 = (i & 15) * 4; cr[u] = (f32x4){0.f, 0.f, 0.f, 0.f}; \
        if (r < NC) cr[u] = *(const f32x4*)((r < PB ? p.c_prompt + (size_t)r * D : p.c_sample + (size_t)(r - PB) * D) + 64 * (kc_) + k4); } } while (0)
#define ADA_CHUNK(wreg, kc_) do { bf16_t* Ab = As + ((kc_) & 1) * (16 * ADA_RT * ADA_AS); \
        _Pragma("unroll") for (int u = 0; u < ACNT; ++u) { const int i = tid + 512 * u, r = i >> 4, k4 = (i & 15) * 4; \
            if (i < 16 * ADA_RT * 16) { u32x2 pk; pk.x = pack2(siluf_(cr[u][0]), siluf_(cr[u][1])); pk.y = pack2(siluf_(cr[u][2]), siluf_(cr[u][3])); *(u32x2*)(Ab + r * ADA_AS + k4) = pk; } } \
        if ((kc_) + 1 < NCH) ADA_CLOAD((kc_) + 1); \
        u32x4 bw[2]; _Pragma("unroll") for (int s2 = 0; s2 < 2; ++s2) { bw[s2].x = pack2(wreg[8 * s2], wreg[8 * s2 + 1]); bw[s2].y = pack2(wreg[8 * s2 + 2], wreg[8 * s2 + 3]); bw[s2].z = pack2(wreg[8 * s2 + 4], wreg[8 * s2 + 5]); bw[s2].w = pack2(wreg[8 * s2 + 6], wreg[8 * s2 + 7]); } \
        if ((kc_) + 3 < NCH) ADA_WLOAD(wreg, (kc_) + 3); \
        __syncthreads(); \
        _Pragma("unroll") for (int s2 = 0; s2 < 2; ++s2) { const bf16x8 bf = __builtin_bit_cast(bf16x8, bw[s2]); \
            _Pragma("unroll") for (int rt = 0; rt < ADA_RT; ++rt) { const bf16x8 af = *(const bf16x8*)(Ab + (16 * rt + rho) * ADA_AS + 32 * s2 + 8 * gam); acc[rt] = MFMA_BF16(af, bf, acc[rt]); } } } while (0)
    static_assert(NCH % 3 == 2, "chunk ring");
    ADA_WLOAD(wa, 0); ADA_WLOAD(wb, 1); ADA_WLOAD(wc2, 2); ADA_CLOAD(0);
    for (int kc = 0; kc + 2 < NCH; kc += 3) { ADA_CHUNK(wa, kc); ADA_CHUNK(wb, kc + 1); ADA_CHUNK(wc2, kc + 2); }
    ADA_CHUNK(wa, NCH - 2); ADA_CHUNK(wb, NCH - 1);
#undef ADA_WLOAD
#undef ADA_CLOAD
#undef ADA_CHUNK
    const float bv = bias[cw + 16 * w + rho];
#pragma unroll
    for (int rt = 0; rt < ADA_RT; ++rt)
#pragma unroll
        for (int r = 0; r < 4; ++r) { const int row = 16 * rt + 4 * gam + r; if (row < NC) p.modbuf[(size_t)row * MODW + n0 + 16 * w + rho] = acc[rt][r] + bv; }
    __syncthreads();
}
DEV int cvt_job_tiles(int j) { const int K = j < 9 ? 2048 : 256; const int N = j < 2 ? NMOD : (j == 2 ? 2 * D : (j < 5 ? ZW : (j < 9 ? D : 256))); return (K / 64) * (N / 64); }
constexpr int TBL_SLOT = 10240, TBL_VP1 = 4 * NE - 2 * TBL_SLOT;
DEV int gemm_in_idle_blocks() { const int nwg = (MPAD / 256) * (ZW / 256), G = (int)gridDim.x, rounds = (nwg + G - 1) / G, full = nwg - (rounds - 1) * G; return G - full; }
DEV bool tbl_deferred() { return gemm_in_idle_blocks() >= 32; }
DEV void table_row_to_fp8(const Params& p, int vr, int lane) {
    const int l = vr / (2 * NE), which = (vr % (2 * NE)) / NE, e = vr % NE, rr = l * NE + e;
    const float* src = (which ? p.peer_v : p.peer_u) + (size_t)rr * D;
    f32x4 v[8];
#pragma unroll
    for (int k = 0; k < 8; ++k) v[k] = *(const f32x4*)(src + 4 * lane + 256 * k);
    unsigned char* tab = (which ? p.v8 : p.u8) + (size_t)l * NE * (D / 2);
    if (which) {
        float am = 0.f;
#pragma unroll
        for (int k = 0; k < 8; ++k) am = fmaxf(am, fmaxf(fmaxf(fabsf(v[k][0]), fabsf(v[k][1])), fmaxf(fabsf(v[k][2]), fabsf(v[k][3]))));
        am = wave_max(am);
        const float sc = am > 0.f ? 6.0f / am : 1.0f;
#pragma unroll
        for (int k = 0; k < 8; ++k) *(unsigned short*)(tab + ((size_t)k * NE + e) * 128 + 2 * lane) = (unsigned short)fp4x4_enc(v[k][0] * sc, v[k][1] * sc, v[k][2] * sc, v[k][3] * sc);
        if (lane == 0) p.sv[rr] = am > 0.f ? am * (1.0f / 6.0f) : 1.0f;
    } else {
#pragma unroll
        for (int k = 0; k < 8; ++k) {
            const float am = wave_max(fmaxf(fmaxf(fabsf(v[k][0]), fabsf(v[k][1])), fmaxf(fabsf(v[k][2]), fabsf(v[k][3]))));
            const float sc = am > 0.f ? 7.0f / am : 1.0f;
            unsigned nb = 0u;
#pragma unroll
            for (int j = 0; j < 4; ++j) { int q = (int)rintf(v[k][j] * sc); q = q > 7 ? 7 : (q < -7 ? -7 : q); nb |= ((unsigned)q & 15u) << (4 * j); }
            *(unsigned short*)(tab + ((size_t)k * NE + e) * 128 + 2 * lane) = (unsigned short)nb;
            if (lane == 0) p.su[(size_t)rr * 8 + k] = am > 0.f ? am * (1.0f / 7.0f) : 1.0f;
        }
    }
}
DEV void phase_tbl_slot(const Params& p, int l) {
    const int idle = gemm_in_idle_blocks(), first = (int)gridDim.x - idle;
    if (idle < 32 || (int)blockIdx.x < first) return;
    const int gw = ((int)blockIdx.x - first) * 8 + wave_id(), nw = idle * 8, lo = TBL_VP1 + l * TBL_SLOT;
    for (int vr = lo + gw; vr < lo + TBL_SLOT; vr += nw) table_row_to_fp8(p, vr, threadIdx.x & 63);
}
DEV void phase_convert(const Params& p, unsigned char* lds, int part) {
    float* tile = (float*)lds;
    const int tid = threadIdx.x;
    const int q_lo = part == 0 ? 0 : 3, q_hi = part == 0 ? 3 : 17;
    int total = 0;
#pragma unroll
    for (int q = 0; q < 17; ++q) if (q >= q_lo && q < q_hi) total += cvt_job_tiles(q);
    for (int tl = blockIdx.x; tl < total; tl += gridDim.x) {
        int j = 0, loc = 0, base = 0;
#pragma unroll
        for (int q = 0; q < 17; ++q) if (q >= q_lo && q < q_hi) { const int cnt = cvt_job_tiles(q); if (tl >= base && tl < base + cnt) { j = q; loc = tl - base; } base += cnt; }
        const float* src; bf16_t* dst; int K = 2048, N;
        if (j < 2) { N = NMOD; src = p.w_ada + (size_t)j * 2048 * NMOD; dst = p.wt_ada + (size_t)j * NMOD * 2048; }
        else if (j == 2) { N = 2 * D; src = p.w_ada_final; dst = p.wt_ada + (size_t)2 * NMOD * 2048; }
        else if (j < 5) { N = ZW; src = p.w_in + (size_t)(j - 3) * 2048 * ZW; dst = p.wt_in + (size_t)(j - 3) * ZW * 2048; }
        else if (j < 7) { N = D; src = p.w_out + (size_t)(j - 5) * D * D; dst = p.wt_out + (size_t)(j - 5) * D * D; }
        else if (j < 9) { N = D; src = p.peer_wq + (size_t)(j - 7) * D * D; dst = p.wt_q + (size_t)(j - 7) * D * D; }
        else { K = 256; N = 256; src = p.pool_w + (size_t)(j - 9) * 65536; dst = p.wt_pool + (size_t)(j - 9) * 65536; }
        const int ntn = N / 64, kt = loc / ntn, nt = loc % ntn;
        transpose_tile(src + (size_t)kt * 64 * N + nt * 64, N, dst + (size_t)nt * 64 * K + kt * 64, K, tile);
    }
    const size_t gt = (size_t)blockIdx.x * 512 + tid, gs = (size_t)gridDim.x * 512;
    if (part == 1) {
        constexpr int NADA = ADA_UNITS;
        const int vend = tbl_deferred() ? TBL_VP1 : 4 * NE, R1 = vend - 2048;
        const bool uneven = (int)gridDim.x > NADA + 16;
        for (int seg = 0; seg < 2; ++seg) {
            int gw, nw, r_lo, r_hi;
            if (!uneven) { if (seg) break; gw = blockIdx.x * 8 + wave_id(); nw = gridDim.x * 8; r_lo = 0; r_hi = vend; }
            else if (seg == 0) { gw = blockIdx.x * 8 + wave_id(); nw = gridDim.x * 8; r_lo = 0; r_hi = R1; }
            else { if ((int)blockIdx.x < NADA) break; gw = ((int)blockIdx.x - NADA) * 8 + wave_id(); nw = ((int)gridDim.x - NADA) * 8; r_lo = R1; r_hi = vend; }
            for (int vr = r_lo + gw; vr < r_hi; vr += nw) table_row_to_fp8(p, vr, tid & 63);
        }
    }
    if (part == 0) for (size_t i = gt; i < (size_t)256 * D / 8; i += gs) {
        const int row = (int)(i / (D / 8)), c8 = (int)(i % (D / 8)) * 8; u32x4 w = (u32x4){0u, 0u, 0u, 0u};
        if (row < NC) { const float* s = (row < PB ? p.c_prompt + (size_t)row * D : p.c_sample + (size_t)(row - PB) * D) + c8;
            const f32x4 a = *(const f32x4*)s, b = *(const f32x4*)(s + 4);
            w.x = pack2(siluf_(a[0]), siluf_(a[1])); w.y = pack2(siluf_(a[2]), siluf_(a[3])); w.z = pack2(siluf_(b[0]), siluf_(b[1])); w.w = pack2(siluf_(b[2]), siluf_(b[3])); }
        *(u32x4*)(p.csil + i * 8) = w;
    }
}

DEV void phase_norm(const Params& p, const float* xlo, const float* xhi, const bf16_t* x16, const float* gn, int sh_off, int sc_off, bf16_t* obf, float* of32, unsigned* hd, float* hs) {
    const int lane = threadIdx.x & 63, gw = blockIdx.x * 8 + wave_id(), nw = gridDim.x * 8;
    for (int t = gw; t < NTOK; t += nw) {
        const float* xr = x16 ? nullptr : (t < NP ? xlo + (size_t)t * D : xhi + (size_t)(t - NP) * D);
        const float* mrow = p.modbuf + (size_t)tok_batch(t) * MODW;
        f32x4 v[8]; float ss = 0.f;
#pragma unroll
        for (int c = 0; c < 4; ++c) { const int col = c * 512 + lane * 8;
            if (x16) { const u32x4 xw = *(const u32x4*)(x16 + (size_t)t * D + col); v[2 * c] = (f32x4){lo16(xw.x), hi16(xw.x), lo16(xw.y), hi16(xw.y)}; v[2 * c + 1] = (f32x4){lo16(xw.z), hi16(xw.z), lo16(xw.w), hi16(xw.w)}; }
            else { v[2 * c] = *(const f32x4*)(xr + col); v[2 * c + 1] = *(const f32x4*)(xr + col + 4); }
#pragma unroll
            for (int j = 0; j < 4; ++j) ss += v[2 * c][j] * v[2 * c][j] + v[2 * c + 1][j] * v[2 * c + 1][j]; }
        ss = wave_sum(ss);
        const float rstd = rsqrtf(ss * (1.0f / D) + EPS);
#pragma unroll
        for (int c = 0; c < 4; ++c) { const int col = c * 512 + lane * 8; f32x4 y[2];
#pragma unroll
            for (int q = 0; q < 2; ++q) { const f32x4 g4 = *(const f32x4*)(gn + col + 4 * q), sc = *(const f32x4*)(mrow + sc_off + col + 4 * q), sh = *(const f32x4*)(mrow + sh_off + col + 4 * q);
                y[q] = (v[2 * c + q] * rstd) * g4 * (sc + 1.0f) + sh; }
            if (obf) { u32x4 w; w.x = pack2(y[0][0], y[0][1]); w.y = pack2(y[0][2], y[0][3]); w.z = pack2(y[1][0], y[1][1]); w.w = pack2(y[1][2], y[1][3]); *(u32x4*)(obf + (size_t)t * D + col) = w; }
            else { *(f32x4*)(of32 + (size_t)t * D + col) = y[0]; *(f32x4*)(of32 + (size_t)t * D + col + 4) = y[1]; }
            if (hd) {
                float am = fmaxf(fmaxf(fmaxf(fabsf(y[0][0]), fabsf(y[0][1])), fmaxf(fabsf(y[0][2]), fabsf(y[0][3]))), fmaxf(fmaxf(fabsf(y[1][0]), fabsf(y[1][1])), fmaxf(fabsf(y[1][2]), fabsf(y[1][3]))));
                am = fmaxf(am, DPP_XOR1(am)); am = fmaxf(am, DPP_XOR2(am));
                const float sc = am > 0.f ? 119.0f / am : 1.0f; unsigned w1 = 0u, w0 = 0u;
#pragma unroll
                for (int jj = 0; jj < 8; ++jj) { const int hq = (int)rintf(y[jj >> 2][jj & 3] * sc), d1 = (hq + 8) >> 4, d0 = hq - 16 * d1; w1 |= ((unsigned)d1 & 15u) << (4 * jj); w0 |= ((unsigned)d0 & 15u) << (4 * jj); }
                const size_t blk = (size_t)t * 64 + c * 16 + (lane >> 2);
                hd[blk * 8 + (lane & 3)] = w1; hd[blk * 8 + 4 + (lane & 3)] = w0;
                if ((lane & 3) == 0) hs[blk] = am > 0.f ? am * (1.0f / 119.0f) : 1.0f; }
        }
    }
}

namespace hg {
constexpr int QS = 136, VS = 72;
constexpr int O_QT = 0, O_QH = O_QT + 64 * QS * 2, O_KT = O_QH + 64 * QS * 2, O_KDT = O_KT + 160 * QS * 2, O_VT = O_KDT + 128 * VS * 2,
              O_AB = O_VT + 128 * VS * 2, O_GS = O_AB + 64 * VS * 2, O_END = O_GS + 4 * 128 * 4;
constexpr int OS = 132;
static_assert(O_END <= 163840 - 64, "HGRN LDS layout too large");
constexpr int NCHUNK = SEQ / 64, NUNIT = PB * HH * NCHUNK;
}
DEV int kt_rowbase(int i) { return i == 0 ? 0 : (i == 1 ? 16 : (i == 2 ? 48 : 96)); }

DEV void hgrn_pre_unit(const Params& p, int l, int unit, unsigned char* lds) {
    using namespace hg;
    const int tid = threadIdx.x, lane = tid & 63, w = tid >> 6, g = lane >> 4, c16 = lane & 15;
    const int c = unit % NCHUNK, bh = unit / NCHUNK, b = bh / HH, h = bh % HH;
    bf16_t* Qt = (bf16_t*)(lds + O_QT); bf16_t* Qh = (bf16_t*)(lds + O_QH); bf16_t* Kt = (bf16_t*)(lds + O_KT);
    bf16_t* Kdt = (bf16_t*)(lds + O_KDT); bf16_t* Vt = (bf16_t*)(lds + O_VT); bf16_t* Ab = (bf16_t*)(lds + O_AB); float* Gs = (float*)(lds + O_GS);
    const int kk = tid & 127, sj = tid >> 7;
    float lbv = 0.f;
    if (l > 0) lbv = sigmoidf_(p.lb_logits[HH * HD + h * HD + kk] - p.lb_logits[h * HD + kk]);
    const float oml = 1.0f - lbv;
    for (int i = tid; i < 64 * VS / 2; i += 512) ((unsigned*)Ab)[i] = 0u;
    const size_t row0 = (size_t)b * SEQ + c * 64;
    float Gl[16], qv[16], kv[16];
    {
        const bf16_t* zr = p.z + (row0 + sj * 16) * ZW + h * HD + kk;
        unsigned short zq16[16], zf16[16], zi16[16];
#pragma unroll
        for (int s = 0; s < 16; ++s) { zq16[s] = zr[(size_t)s * ZW]; zf16[s] = zr[(size_t)s * ZW + 1024]; zi16[s] = zr[(size_t)s * ZW + 2048]; }
        float run = 0.f; unsigned vpk[8];
#pragma unroll
        for (int s = 0; s < 16; ++s) {
            const float zq = bf2f(zq16[s]), zf = fminf(fmaxf(bf2f(zf16[s]), -80.f), 80.f);
            const float e = __expf(-zf), sg = 1.0f / (1.0f + e);
            const float f = lbv + oml * sg;
            run += __logf(f); Gl[s] = run;
            kv[s] = oml * (e * sg);
            qv[s] = siluf_(zq);
            if (s & 1) vpk[s >> 1] |= (unsigned)zi16[s] << 16; else vpk[s >> 1] = zi16[s];
        }
        Gs[sj * 128 + kk] = run;
        *(u32x4*)(Vt + kk * VS + sj * 16) = (u32x4){vpk[0], vpk[1], vpk[2], vpk[3]}; *(u32x4*)(Vt + kk * VS + sj * 16 + 8) = (u32x4){vpk[4], vpk[5], vpk[6], vpk[7]};
    }
    __syncthreads();
    float Gend;
    {
        const float g0 = Gs[kk], g1 = Gs[128 + kk], g2 = Gs[256 + kk], g3 = Gs[384 + kk];
        float Gb[4]; Gb[0] = 0.f; Gb[1] = g0; Gb[2] = g0 + g1; Gb[3] = g0 + g1 + g2; Gend = Gb[3] + g3;
        const float Gbj = sj == 0 ? Gb[0] : (sj == 1 ? Gb[1] : (sj == 2 ? Gb[2] : Gb[3]));
        const float eGb = __expf(Gbj);
        unsigned kd[8]; unsigned qh[8];
#pragma unroll
        for (int s = 0; s < 16; ++s) {
            const int t = sj * 16 + s;
            const float q1 = qv[s] * __expf(Gl[s]);
            Qt[t * QS + kk] = (bf16_t)f2bf(q1);
            const unsigned qhv = f2bf(q1 * eGb);
            Qh[t * QS + kk] = (bf16_t)qhv;
#pragma unroll
            for (int i = 0; i < 4; ++i) if (i >= sj) Kt[(kt_rowbase(i) + t) * QS + kk] = (bf16_t)f2bf(kv[s] * __expf(fminf(Gb[i] - Gbj - Gl[s], 60.f)));
            const unsigned kdv = f2bf(kv[s] * __expf(Gend - Gbj - Gl[s]));
            if (s & 1) kd[s >> 1] |= kdv << 16; else kd[s >> 1] = kdv;
        }
        *(u32x4*)(Kdt + kk * VS + sj * 16) = (u32x4){kd[0], kd[1], kd[2], kd[3]}; *(u32x4*)(Kdt + kk * VS + sj * 16 + 8) = (u32x4){kd[4], kd[5], kd[6], kd[7]};
        if (sj == 0) p.hg_gam[(size_t)unit * HD + kk] = __expf(Gend);
    }
    __syncthreads();
    {
        const int t = tid >> 3, part = tid & 7;
        const u32x4 a = *(const u32x4*)(Qh + t * QS + 16 * part), b2 = *(const u32x4*)(Qh + t * QS + 16 * part + 8);
        bf16_t* dst = p.hg_qh + (row0 + t) * 1024 + h * HD + 16 * part; *(u32x4*)dst = a; *(u32x4*)(dst + 8) = b2;
    }
    for (int blk = w; blk < 10; blk += 8) {
        int bi, bjj;
        if (blk == 0) { bi = 0; bjj = 0; } else if (blk < 3) { bi = 1; bjj = blk - 1; } else if (blk < 6) { bi = 2; bjj = blk - 3; } else { bi = 3; bjj = blk - 6; }
        f32x4 acc = (f32x4){0.f, 0.f, 0.f, 0.f};
#pragma unroll
        for (int ks = 0; ks < 4; ++ks) {
            const bf16x8 a = *(const bf16x8*)(Qt + (16 * bi + c16) * QS + 32 * ks + 8 * g);
            const bf16x8 bb = *(const bf16x8*)(Kt + (kt_rowbase(bi) + 16 * bjj + c16) * QS + 32 * ks + 8 * g);
            acc = MFMA_BF16(a, bb, acc);
        }
#pragma unroll
        for (int r = 0; r < 4; ++r) { const int tl = 4 * g + r; float v = acc[r]; if (bi == bjj && c16 > tl) v = 0.f; Ab[(16 * bi + tl) * VS + 16 * bjj + c16] = (bf16_t)f2bf(v); }
    }
    __syncthreads();
    {
        u32x2* oin = (u32x2*)(p.hg_oin + (size_t)unit * 64 * 128);
#pragma unroll
        for (int tt = 0; tt < 4; ++tt) {
            f32x4 acc = (f32x4){0.f, 0.f, 0.f, 0.f};
#pragma unroll
            for (int ks = 0; ks < 2; ++ks) {
                const bf16x8 a = *(const bf16x8*)(Ab + (16 * tt + c16) * VS + 32 * ks + 8 * g);
                const bf16x8 bb = *(const bf16x8*)(Vt + (16 * w + c16) * VS + 32 * ks + 8 * g);
                acc = MFMA_BF16(a, bb, acc);
            }
            oin[(tt * 8 + w) * 64 + lane] = (u32x2){pack2(acc[0], acc[1]), pack2(acc[2], acc[3])};
        }
        u32x2* ds = (u32x2*)(p.hg_ds + (size_t)unit * 128 * 128);
#pragma unroll
        for (int vt = 0; vt < 8; ++vt) {
            f32x4 acc = (f32x4){0.f, 0.f, 0.f, 0.f};
#pragma unroll
            for (int ks = 0; ks < 2; ++ks) {
                const bf16x8 a = *(const bf16x8*)(Kdt + (16 * w + c16) * VS + 32 * ks + 8 * g);
                const bf16x8 bb = *(const bf16x8*)(Vt + (16 * vt + c16) * VS + 32 * ks + 8 * g);
                acc = MFMA_BF16(a, bb, acc);
            }
            ds[(w * 8 + vt) * 64 + lane] = (u32x2){pack2(acc[0], acc[1]), pack2(acc[2], acc[3])};
        }
    }
    __syncthreads();
}

DEV void hgrn_scan_unit(const Params& p, int l, int su) {
    using namespace hg;
    const int tid = threadIdx.x, lane = tid & 63, w = tid >> 6, g = lane >> 4, c16 = lane & 15;
    const int vt = su % 8, bh = su / 8, b = bh / HH, h = bh % HH;
    f32x4 S = (f32x4){0.f, 0.f, 0.f, 0.f};
    constexpr int CB = NCHUNK < 16 ? NCHUNK : 16;
    static_assert(NCHUNK % CB == 0, "chunk batch");
    for (int c0 = 0; c0 < NCHUNK; c0 += CB) {
        u32x2 dw[CB]; f32x4 gm[CB];
#pragma unroll
        for (int i = 0; i < CB; ++i) { const size_t unit = (size_t)bh * NCHUNK + c0 + i;
            dw[i] = ((const u32x2*)(p.hg_ds + unit * 128 * 128))[(w * 8 + vt) * 64 + lane]; gm[i] = *(const f32x4*)(p.hg_gam + unit * HD + 16 * w + 4 * g); }
#pragma unroll
        for (int i = 0; i < CB; ++i) { const size_t unit = (size_t)bh * NCHUNK + c0 + i;
            u32x2 sw; sw.x = pack2(S[0], S[1]); sw.y = pack2(S[2], S[3]);
            *(u32x2*)(p.hg_sc + (unit * 128 + 16 * vt + c16) * 128 + 16 * w + 4 * g) = sw;
            const f32x4 d = (f32x4){lo16(dw[i].x), hi16(dw[i].x), lo16(dw[i].y), hi16(dw[i].y)};
            S = S * gm[i] + d; }
    }
    float* so = p.out + OFF_HP + ((size_t)(l * PB + b) * HH + h) * HD * HD;
#pragma unroll
    for (int r = 0; r < 4; ++r) so[(size_t)(16 * w + 4 * g + r) * HD + 16 * vt + c16] = S[r];
}

DEV void hgrn_post_unit(const Params& p, int l, int unit, unsigned char* lds) {
    using namespace hg;
    const int tid = threadIdx.x, lane = tid & 63, w = tid >> 6, g = lane >> 4, c16 = lane & 15;
    const int c = unit % NCHUNK, bh = unit / NCHUNK, b = bh / HH, h = bh % HH;
    float* Ob = (float*)lds;
    const size_t row0 = (size_t)b * SEQ + c * 64;
    const u32x2* oin = (const u32x2*)(p.hg_oin + (size_t)unit * 64 * 128);
    u32x2 ow[4];
#pragma unroll
    for (int tt = 0; tt < 4; ++tt) ow[tt] = oin[(tt * 8 + w) * 64 + lane];
    bf16x8 bfr[4], af[4][4];
    if (c > 0) {
#pragma unroll
        for (int ks = 0; ks < 4; ++ks) bfr[ks] = *(const bf16x8*)(p.hg_sc + ((size_t)unit * 128 + 16 * w + c16) * 128 + 32 * ks + 8 * g);
#pragma unroll
        for (int tt = 0; tt < 4; ++tt)
#pragma unroll
            for (int ks = 0; ks < 4; ++ks) af[tt][ks] = *(const bf16x8*)(p.hg_qh + (row0 + 16 * tt + c16) * 1024 + h * HD + 32 * ks + 8 * g);
    }
    const bf16_t* zgp = p.z + (row0 + (tid >> 3)) * ZW + 3072 + h * HD + 16 * (tid & 7);
    const u32x4 za = *(const u32x4*)zgp, zc = *(const u32x4*)(zgp + 8);
    f32x4 acc[4];
#pragma unroll
    for (int tt = 0; tt < 4; ++tt) acc[tt] = (f32x4){lo16(ow[tt].x), hi16(ow[tt].x), lo16(ow[tt].y), hi16(ow[tt].y)};
    if (c > 0) {
#pragma unroll
        for (int tt = 0; tt < 4; ++tt)
#pragma unroll
            for (int ks = 0; ks < 4; ++ks) acc[tt] = MFMA_BF16(af[tt][ks], bfr[ks], acc[tt]);
    }
#pragma unroll
    for (int tt = 0; tt < 4; ++tt)
#pragma unroll
        for (int r = 0; r < 4; ++r) Ob[(16 * tt + 4 * g + r) * OS + 16 * w + c16] = acc[tt][r];
    __syncthreads();
    {
        const int t = tid >> 3, part = tid & 7; const size_t row = row0 + t;
        float ov[16]; float ss = 0.f;
#pragma unroll
        for (int q = 0; q < 4; ++q) { const f32x4 x = *(const f32x4*)(Ob + t * OS + 16 * part + 4 * q); ov[4 * q] = x[0]; ov[4 * q + 1] = x[1]; ov[4 * q + 2] = x[2]; ov[4 * q + 3] = x[3];
            ss += x[0] * x[0] + x[1] * x[1] + x[2] * x[2] + x[3] * x[3]; }
        ss += __shfl_xor(ss, 1); ss += __shfl_xor(ss, 2); ss += __shfl_xor(ss, 4);
        const float rstd = rsqrtf(ss * (1.0f / HD) + EPS);
        const unsigned zw[8] = {za.x, za.y, za.z, za.w, zc.x, zc.y, zc.z, zc.w};
        const float* gn = p.hgrn_norm_g + l * HD + 16 * part;
        unsigned ow[8];
#pragma unroll
        for (int q = 0; q < 8; ++q) { const float a0 = ov[2 * q] * rstd * gn[2 * q] * siluf_(lo16(zw[q])), a1 = ov[2 * q + 1] * rstd * gn[2 * q + 1] * siluf_(hi16(zw[q])); ow[q] = pack2(a0, a1); }
        bf16_t* dst = p.cat + row * D + h * HD + 16 * part;
        *(u32x4*)dst = (u32x4){ow[0], ow[1], ow[2], ow[3]}; *(u32x4*)(dst + 8) = (u32x4){ow[4], ow[5], ow[6], ow[7]};
    }
    __syncthreads();
}

DEV void hgrn_sample_unit(const Params& p, int l, int unit, unsigned char* lds) {
    const int tid = threadIdx.x, lane = tid & 63, w = tid >> 6;
    const int b = unit / HH, h = unit % HH;
    float* fS = (float*)lds; float* kS = fS + 512; float* qS = kS + 512; float* vS = qS + 512; float* red = vS + 512; float* part = red + 4 * 4 * 128;
    const int r0 = NP + b * DSEQ;
    {
        const int t = tid >> 7, kk = tid & 127; const bf16_t* zr = p.z + (size_t)(r0 + t) * ZW + h * HD + kk;
        float lbv = 0.f; if (l > 0) lbv = sigmoidf_(p.lb_logits[HH * HD + h * HD + kk] - p.lb_logits[h * HD + kk]);
        const float zq = bf2f(zr[0]), zf = fminf(fmaxf(bf2f(zr[1024]), -80.f), 80.f), zi = bf2f(zr[2048]);
        const float e = __expf(-zf), sg = 1.0f / (1.0f + e);
        fS[tid] = lbv + (1.0f - lbv) * sg; kS[tid] = (1.0f - lbv) * (e * sg); qS[tid] = siluf_(zq); vS[tid] = zi;
    }
    const int v = tid & 127, kq = tid >> 7;
    const float* s0 = p.state_hgrn + ((size_t)(l * DB + b) * HH + h) * HD * HD + (size_t)(32 * kq) * HD + v;
    float S[32];
#pragma unroll
    for (int i = 0; i < 32; ++i) S[i] = s0[(size_t)i * HD];
    __syncthreads();
#pragma unroll
    for (int t = 0; t < 4; ++t) {
        const float vv = vS[t * 128 + v]; float po = 0.f;
#pragma unroll
        for (int i = 0; i < 32; ++i) { const int kk = t * 128 + 32 * kq + i; S[i] = fS[kk] * S[i] + kS[kk] * vv; po += qS[kk] * S[i]; }
        red[(t * 4 + kq) * 128 + v] = po;
    }
    float* so = p.out + OFF_HS + ((size_t)(l * DB + b) * HH + h) * HD * HD + (size_t)(32 * kq) * HD + v;
#pragma unroll
    for (int i = 0; i < 32; ++i) so[(size_t)i * HD] = S[i];
    __syncthreads();
    {
        const int t = tid >> 7; const float o = red[(t * 4 + 0) * 128 + v] + red[(t * 4 + 1) * 128 + v] + red[(t * 4 + 2) * 128 + v] + red[(t * 4 + 3) * 128 + v];
        const float ss = wave_sum(o * o);
        if (lane == 0) part[w] = ss;
        __syncthreads();
        const float tot = part[2 * t] + part[2 * t + 1];
        const float rstd = rsqrtf(tot * (1.0f / HD) + EPS);
        const float zg = bf2f(p.z[(size_t)(r0 + t) * ZW + 3072 + h * HD + v]);
        p.cat[(size_t)(r0 + t) * D + h * HD + v] = (bf16_t)f2bf(o * rstd * p.hgrn_norm_g[l * HD + v] * siluf_(zg));
    }
    __syncthreads();
}

DEV void pool_pre_unit(const Params& p, int l, int unit) {
    const int tid = threadIdx.x, tk = tid >> 7, cg = tid & 127, c = cg * 8, gi = cg >> 5, wnd = 2 << gi;
    const int r = unit * 4 + tk;
    if (r >= NTOK) return;
    f32x2 sum[4] = {{0.f, 0.f}, {0.f, 0.f}, {0.f, 0.f}, {0.f, 0.f}}; float cur[8];
    float cnt;
    if (r < NP) {
        const int t = r % SEQ; const int n = (wnd < t + 1) ? wnd : (t + 1); cnt = (float)n;
        u32x4 q[16];
#pragma unroll
        for (int j = 0; j < 16; ++j) q[j] = (j < n) ? *(const u32x4*)(p.z + (size_t)(r - j) * ZW + 4096 + c) : (u32x4){0u, 0u, 0u, 0u};
#pragma unroll
        for (int j = 0; j < 16; ++j) { sum[0] += (f32x2){lo16(q[j].x), hi16(q[j].x)}; sum[1] += (f32x2){lo16(q[j].y), hi16(q[j].y)}; sum[2] += (f32x2){lo16(q[j].z), hi16(q[j].z)}; sum[3] += (f32x2){lo16(q[j].w), hi16(q[j].w)}; }
        cur[0] = lo16(q[0].x); cur[1] = hi16(q[0].x); cur[2] = lo16(q[0].y); cur[3] = hi16(q[0].y); cur[4] = lo16(q[0].z); cur[5] = hi16(q[0].z); cur[6] = lo16(q[0].w); cur[7] = hi16(q[0].w);
        if (t >= SEQ - PBUF) { float* o = p.out + OFF_PP + ((size_t)(l * PB + r / SEQ) * PBUF + (t - (SEQ - PBUF))) * PW + c;
            *(f32x4*)o = (f32x4){cur[0], cur[1], cur[2], cur[3]}; *(f32x4*)(o + 4) = (f32x4){cur[4], cur[5], cur[6], cur[7]}; }
    } else {
        const int bb = (r - NP) / DSEQ, t = (r - NP) % DSEQ; cnt = (float)wnd;
        const float* sp = p.state_pool + (size_t)(l * DB + bb) * PBUF * PW + c;
        u32x4 q[4]; f32x4 sa[15], sb[15];
#pragma unroll
        for (int j = 0; j < 4; ++j) q[j] = (j <= t && j < wnd) ? *(const u32x4*)(p.z + (size_t)(NP + bb * DSEQ + t - j) * ZW + 4096 + c) : (u32x4){0u, 0u, 0u, 0u};
#pragma unroll
        for (int j = 1; j < 16; ++j) {
            const int back = j - t;
            const bool use = (back >= 1) && (j < wnd);
            const float* srow = sp + (size_t)(PBUF - (use ? back : 1)) * PW;
            sa[j - 1] = use ? *(const f32x4*)srow : (f32x4){0.f, 0.f, 0.f, 0.f}; sb[j - 1] = use ? *(const f32x4*)(srow + 4) : (f32x4){0.f, 0.f, 0.f, 0.f};
        }
#pragma unroll
        for (int j = 0; j < 4; ++j) { sum[0] += (f32x2){lo16(q[j].x), hi16(q[j].x)}; sum[1] += (f32x2){lo16(q[j].y), hi16(q[j].y)}; sum[2] += (f32x2){lo16(q[j].z), hi16(q[j].z)}; sum[3] += (f32x2){lo16(q[j].w), hi16(q[j].w)}; }
#pragma unroll
        for (int j = 0; j < 15; ++j) { sum[0] += (f32x2){sa[j][0], sa[j][1]}; sum[1] += (f32x2){sa[j][2], sa[j][3]}; sum[2] += (f32x2){sb[j][0], sb[j][1]}; sum[3] += (f32x2){sb[j][2], sb[j][3]}; }
        cur[0] = lo16(q[0].x); cur[1] = hi16(q[0].x); cur[2] = lo16(q[0].y); cur[3] = hi16(q[0].y); cur[4] = lo16(q[0].z); cur[5] = hi16(q[0].z); cur[6] = lo16(q[0].w); cur[7] = hi16(q[0].w);
        float* ob = p.out + OFF_PS + (size_t)(l * DB + bb) * PBUF * PW + c;
        { float* o = ob + (size_t)(11 + t) * PW; *(f32x4*)o = (f32x4){cur[0], cur[1], cur[2], cur[3]}; *(f32x4*)(o + 4) = (f32x4){cur[4], cur[5], cur[6], cur[7]}; }
        for (int i = t; i < 11; i += 4) { const float* s2 = sp + (size_t)(4 + i) * PW; float* o = ob + (size_t)i * PW; *(f32x4*)o = *(const f32x4*)s2; *(f32x4*)(o + 4) = *(const f32x4*)(s2 + 4); }
    }
    const float inv = 1.0f / cnt;
    u32x4 w; w.x = pack2(sum[0][0] * inv - cur[0], sum[0][1] * inv - cur[1]); w.y = pack2(sum[1][0] * inv - cur[2], sum[1][1] * inv - cur[3]);
    w.z = pack2(sum[2][0] * inv - cur[4], sum[2][1] * inv - cur[5]); w.w = pack2(sum[3][0] * inv - cur[6], sum[3][1] * inv - cur[7]);
    *(u32x4*)(p.pooled + ((size_t)gi * MPAD + r) * 256 + (c & 255)) = w;
}

#ifndef PROBE_SUB
#define PROBE_SUB 0
#endif
DEV void phase_mix1(const Params& p, int l, unsigned char* lds) {
    for (int rep = 0; rep < (PROBE_SUB == 1 ? 2 : 1); ++rep) for (int u = blockIdx.x; u < hg::NUNIT; u += gridDim.x) hgrn_pre_unit(p, l, u, lds);
    for (int rep = 0; rep < (PROBE_SUB == 2 ? 2 : 1); ++rep) for (int u = blockIdx.x; u < DB * HH; u += gridDim.x) hgrn_sample_unit(p, l, u, lds);
    for (int rep = 0; rep < (PROBE_SUB == 3 ? 2 : 1); ++rep) for (int u = blockIdx.x; u < (NTOK + 3) / 4; u += gridDim.x) pool_pre_unit(p, l, u);
}
DEV void phase_mix2(const Params& p, int l) { for (int u = blockIdx.x; u < PB * HH * 8; u += gridDim.x) hgrn_scan_unit(p, l, u); }
DEV void phase_mix3(const Params& p, int l, unsigned char* lds) { for (int u = blockIdx.x; u < hg::NUNIT; u += gridDim.x) hgrn_post_unit(p, l, u, lds); }

#ifdef HIPEMU
#define MBCNT(mask) __builtin_popcountll((mask) & ((1ull << emu_lane()) - 1ull))
#define POPC64(m) __builtin_popcountll(m)
#else
#define MBCNT(mask) ((int)__builtin_amdgcn_mbcnt_hi((unsigned)((mask) >> 32), __builtin_amdgcn_mbcnt_lo((unsigned)(mask), 0u)))
#define POPC64(m) __popcll(m)
#endif
DEV unsigned fkey(float f) { const unsigned u = __float_as_uint(f); return u ^ ((unsigned)((int)u >> 31) | 0x80000000u); }
DEV unsigned long long lowest_n_bits(unsigned long long m, int n) { unsigned long long r = 0ull; while (n > 0 && m) { const unsigned long long b = m & (~m + 1ull); r |= b; m ^= b; --n; } return r; }
#ifdef HIPEMU
#define DPPU_XOR1(v) __shfl((v), emu_lane() ^ 1)
#define DPPU_XOR2(v) __shfl((v), emu_lane() ^ 2)
#define DPPU_HMIRROR(v) __shfl((v), (emu_lane() & ~7) | (7 - (emu_lane() & 7)))
#else
template <int CTRL> DEV unsigned dpp_u(unsigned v) { return (unsigned)__builtin_amdgcn_update_dpp(0, (int)v, CTRL, 0xf, 0xf, true); }
#define DPPU_XOR1(v) dpp_u<0xB1>(v)
#define DPPU_XOR2(v) dpp_u<0x4E>(v)
#define DPPU_HMIRROR(v) dpp_u<0x141>(v)
#endif
template <int GL> DEV unsigned group_sum(unsigned c) { c += DPPU_XOR1(c); c += DPPU_XOR2(c); if (GL == 8) c += DPPU_HMIRROR(c); return c; }
template <int GL> DEV unsigned group_or(unsigned c) { c |= DPPU_XOR1(c); c |= DPPU_XOR2(c); if (GL == 8) c |= DPPU_HMIRROR(c); return c; }
template <int GL> DEV float group_maxf(float v) { v = fmaxf(v, DPP_XOR1(v)); v = fmaxf(v, DPP_XOR2(v)); if (GL == 8) v = fmaxf(v, DPP_HMIRROR(v)); return v; }
template <int GL> DEV float group_sumf(float v) { v += DPP_XOR1(v); v += DPP_XOR2(v); if (GL == 8) v += DPP_HMIRROR(v); return v; }
DEV unsigned bytesum(unsigned w) { return (w * 0x01010101u) >> 24; }
template <int GL> DEV unsigned group_excl_prefix(unsigned c, int sub) {
    const unsigned sh = 8u * (unsigned)(sub & 3);
    unsigned wlo = (GL == 4 || sub < 4) ? (c << sh) : 0u, whi = (GL == 8 && sub >= 4) ? (c << sh) : 0u;
    wlo = group_or<GL>(wlo);
    unsigned r;
    if (GL == 4) r = bytesum(wlo & ((1u << sh) - 1u));
    else { whi = group_or<GL>(whi); r = sub < 4 ? bytesum(wlo & ((1u << sh) - 1u)) : bytesum(wlo) + bytesum(whi & ((1u << sh) - 1u)); }
    return r;
}
DEV float fkey_inv(unsigned k) { return __uint_as_float((k & 0x80000000u) ? (k ^ 0x80000000u) : ~k); }
template <int NK> DEV unsigned count_above(const unsigned (&k)[NK], unsigned t) {
    unsigned c[4] = {0u, 0u, 0u, 0u};
#pragma unroll
    for (int i = 0; i < NK; ++i) c[i & 3] += (k[i] > t) ? 1u : 0u;
    return (c[0] + c[1]) + (c[2] + c[3]);
}
template <int GL, int NK> DEV unsigned group_top16(const unsigned (&k)[NK], bool active, int sub, unsigned& pos0) {
    unsigned mxk = 0u;
#pragma unroll
    for (int i = 0; i < NK; ++i) mxk = k[i] > mxk ? k[i] : mxk;
    { unsigned o = DPPU_XOR1(mxk); mxk = o > mxk ? o : mxk; o = DPPU_XOR2(mxk); mxk = o > mxk ? o : mxk; if (GL == 8) { o = DPPU_HMIRROR(mxk); mxk = o > mxk ? o : mxk; } }
    unsigned L0 = mxk > 0x01000000u ? mxk - 0x01000000u : 0u, c0 = group_sum<GL>(count_above<NK>(k, L0));
    unsigned L = c0 > 16u ? L0 + 1u : 0u, R = active ? mxk : 0u, cR = 0u;
    if (!active) L = 0u;
    if (c0 == 16u && active) { L = L0; R = L0; cR = 16u; }
    for (;;) {
        if (__ballot(L < R) == 0ull) break;
        const unsigned mid = L + ((R - L) >> 1);
        const unsigned c = group_sum<GL>(count_above<NK>(k, mid));
        const bool le = c <= 16u, hit = c == 16u;
        R = le ? mid : R; cR = le ? c : cR; L = hit ? mid : (le ? L : mid + 1u);
    }
    unsigned mask = 0u;
#pragma unroll
    for (int i = 0; i < NK; ++i) mask |= (k[i] > R) ? (1u << i) : 0u;
    const unsigned need = 16u - cR;
    if (__ballot(active && need > 0u) != 0ull) {
        unsigned eqm = 0u;
#pragma unroll
        for (int i = 0; i < NK; ++i) eqm |= (k[i] == R) ? (1u << i) : 0u;
        const unsigned eqc = (unsigned)__builtin_popcount(eqm), before = group_excl_prefix<GL>(eqc, sub);
        unsigned take = need > before ? need - before : 0u; if (take > eqc) take = eqc;
        if (!active) take = 0u;
        while (take > 0u) { const unsigned b = eqm & (~eqm + 1u); mask |= b; eqm ^= b; --take; }
    }
    if (!active) mask = 0u;
    pos0 = group_excl_prefix<GL>((unsigned)__builtin_popcount(mask), sub);
    return mask;
}
#ifdef HIPEMU
template <int J> DEV unsigned row_bcast_u(unsigned v) { return __shfl(v, (emu_lane() & ~15) | J); }
#else
template <int J> DEV unsigned row_bcast_u(unsigned v) { return (unsigned)__builtin_amdgcn_update_dpp(0, (int)v, 0x150 + J, 0xf, 0xf, true); }
#endif
template <int J> struct RowRank { static DEV unsigned run(unsigned v, int l16) { const unsigned b = row_bcast_u<J>(v); return (((b > v) || (b == v && J < l16)) ? 1u : 0u) + RowRank<J - 1>::run(v, l16); } };
template <> struct RowRank<-1> { static DEV unsigned run(unsigned, int) { return 0u; } };
struct CandTab { unsigned char ij[56]; };
DEV CandTab make_cand_tab() { CandTab t{}; int n = 0; for (int i = 0; i < 16; ++i) for (int j = 0; j < 16 / (i + 1); ++j) t.ij[n++] = (unsigned char)(i * 16 + j); for (; n < 56; ++n) t.ij[n] = 255; return t; }
constexpr int SEL_NT = 4;
constexpr int SEL_RS = 144;
DEV void select_step(const Params& p, int l, int tt0, int tstride, int ntile, int h, unsigned char* lds, const bf16x8 (&kh)[2][4], const bf16x8 (&kl)[2][4]) {
    const int tid = threadIdx.x, lane = tid & 63, w = tid >> 6, g = lane >> 4, c16 = lane & 15;
    constexpr int NTK = SEL_NT * 16;
    constexpr int QRS = 264;
    bf16_t* qh = (bf16_t*)lds;
    bf16_t* ql = qh + NTK * QRS;
    float* sc = (float*)(ql + NTK * QRS);
    float* ts = sc + 2 * NTK * SEL_RS;
    int* ti = (int*)(ts + 2 * NTK * 16);
    unsigned char* ctab = (unsigned char*)(ti + 2 * NTK * 16);
    if (tid == 0) { const CandTab t = make_cand_tab(); for (int n = 0; n < 56; ++n) ctab[n] = t.ij[n]; }
#pragma unroll
    for (int k = 0; k < SEL_NT; ++k) {
        const int tk = tid >> 5, part = tid & 31; const int tok = (tt0 + k * tstride) * 16 + tk;
        f32x4 a = (f32x4){0.f, 0.f, 0.f, 0.f}, b2 = a;
        if (k < ntile && tok < NTOK) { const float* q = p.qry + (size_t)tok * D + h * 256 + part * 8; a = *(const f32x4*)q; b2 = *(const f32x4*)(q + 4); }
        float ss = a[0] * a[0] + a[1] * a[1] + a[2] * a[2] + a[3] * a[3] + b2[0] * b2[0] + b2[1] * b2[1] + b2[2] * b2[2] + b2[3] * b2[3];
        ss += __shfl_xor(ss, 1); ss += __shfl_xor(ss, 2); ss += __shfl_xor(ss, 4); ss += __shfl_xor(ss, 8);
        const float rn = rsqrtf(ss * (1.0f / 128.0f) + EPS);
        const float v[8] = {a[0] * rn, a[1] * rn, a[2] * rn, a[3] * rn, b2[0] * rn, b2[1] * rn, b2[2] * rn, b2[3] * rn};
        unsigned hi[4], lo[4];
#pragma unroll
        for (int j = 0; j < 4; ++j) { hi[j] = pack2(v[2 * j], v[2 * j + 1]); lo[j] = pack2(v[2 * j] - lo16(hi[j]), v[2 * j + 1] - hi16(hi[j])); }
        *(u32x4*)(qh + (k * 16 + tk) * QRS + part * 8) = (u32x4){hi[0], hi[1], hi[2], hi[3]}; *(u32x4*)(ql + (k * 16 + tk) * QRS + part * 8) = (u32x4){lo[0], lo[1], lo[2], lo[3]};
    }
    __syncthreads();
    for (int k = 0; k < ntile; ++k) {
#pragma unroll
        for (int ph = 0; ph < 2; ++ph) {
            f32x4 acc = (f32x4){0.f, 0.f, 0.f, 0.f};
#pragma unroll
            for (int ks = 0; ks < 4; ++ks) {
                const bf16x8 ah = *(const bf16x8*)(qh + (k * 16 + c16) * QRS + ph * 128 + 32 * ks + 8 * g), al = *(const bf16x8*)(ql + (k * 16 + c16) * QRS + ph * 128 + 32 * ks + 8 * g);
                acc = MFMA_BF16(al, kh[ph][ks], acc); acc = MFMA_BF16(ah, kl[ph][ks], acc); acc = MFMA_BF16(ah, kh[ph][ks], acc);
            }
            const int kidx = 16 * w + c16;
#pragma unroll
            for (int r = 0; r < 4; ++r) sc[(ph * NTK + k * 16 + 4 * g + r) * SEL_RS + (kidx >> 5) * 36 + (kidx & 31)] = acc[r];
        }
    }
    __syncthreads();
    {
        const int row = tid >> 2, sub = tid & 3; const bool active = ((row % NTK) >> 4) < ntile;
        unsigned k[32];
#pragma unroll
        for (int i4 = 0; i4 < 8; ++i4) { const f32x4 v = *(const f32x4*)(sc + row * SEL_RS + sub * 36 + 4 * i4); k[4 * i4] = fkey(v[0]); k[4 * i4 + 1] = fkey(v[1]); k[4 * i4 + 2] = fkey(v[2]); k[4 * i4 + 3] = fkey(v[3]); }
        unsigned pos; const unsigned mask = group_top16<4, 32>(k, active, sub, pos);
#pragma unroll
        for (int i = 0; i < 32; ++i) if ((mask >> i) & 1u) { if (pos < 16u) { ts[row * 16 + pos] = fkey_inv(k[i]); ti[row * 16 + pos] = 32 * sub + i; } ++pos; }
    }
    __syncthreads();
    {
        float v4[4]; int i4[4]; unsigned rk[4];
#pragma unroll
        for (int r = 0; r < (2 * NTK) / 32; ++r) { const int row = (tid >> 4) + 32 * r; v4[r] = ts[row * 16 + (tid & 15)]; i4[r] = ti[row * 16 + (tid & 15)]; }
#pragma unroll
        for (int r = 0; r < (2 * NTK) / 32; ++r) rk[r] = RowRank<15>::run(fkey(v4[r]), tid & 15);
        __syncthreads();
#pragma unroll
        for (int r = 0; r < (2 * NTK) / 32; ++r) { const int row = (tid >> 4) + 32 * r; ts[row * 16 + rk[r]] = v4[r]; ti[row * 16 + rk[r]] = i4[r]; }
    }
    __syncthreads();
    {
        const int tk = tid >> 3, sub = tid & 7; const bool active = (tk >> 4) < ntile;
        unsigned k[7]; unsigned cij[7];
#pragma unroll
        for (int q = 0; q < 7; ++q) { cij[q] = ctab[7 * sub + q]; const bool ok = cij[q] != 255u;
            k[q] = ok ? fkey(ts[tk * 16 + (cij[q] >> 4)] + ts[(NTK + tk) * 16 + (cij[q] & 15u)]) : 0u; }
        unsigned pos; const unsigned mask = group_top16<8, 7>(k, active, sub, pos);
        u32x2* lst = (u32x2*)sc;
#pragma unroll
        for (int q = 0; q < 7; ++q) if ((mask >> q) & 1u) { if (pos < 16u) lst[tk * 16 + pos] = (u32x2){__float_as_uint(fkey_inv(k[q])), (unsigned)(ti[tk * 16 + (cij[q] >> 4)] * 128 + ti[(NTK + tk) * 16 + (cij[q] & 15u)])}; ++pos; }
    }
    __syncthreads();
#pragma unroll
    for (int r = 0; r < NTK / 32; ++r) {
        const int tk = (tid >> 4) + 32 * r, slot = tid & 15; const int tok = (tt0 + (tk >> 4) * tstride) * 16 + (tk & 15);
        const u32x2 en = ((const u32x2*)sc)[tk * 16 + slot];
        const float v = __uint_as_float(en.x); const int e = (int)en.y;
        float mx = v; mx = fmaxf(mx, DPP_XOR1(mx)); mx = fmaxf(mx, DPP_XOR2(mx)); mx = fmaxf(mx, DPP_HMIRROR(mx)); mx = fmaxf(mx, DPP_RMIRROR(mx));
        const float ex = __expf(v - mx);
        float sm = ex; sm += DPP_XOR1(sm); sm += DPP_XOR2(sm); sm += DPP_HMIRROR(sm); sm += DPP_RMIRROR(sm);
        if ((tk >> 4) < ntile && tok < NTOK) { const size_t o = (size_t)tok * 128 + h * 16 + slot;
            p.eidx[o] = (unsigned short)e; p.gate[o] = ex / sm; }
    }
    __syncthreads();
}
DEV void phase_select(const Params& p, int l, unsigned char* lds) {
    const int ntt = (NTOK + 15) / 16, lane = threadIdx.x & 63, w = threadIdx.x >> 6, g = lane >> 4, c16 = lane & 15;
    const bool fixed = (gridDim.x % 8u) == 0u;
    const int nq = fixed ? (int)(gridDim.x >> 3) : 1;
    for (int hh = 0; hh < (fixed ? 1 : 8); ++hh) {
        const int h = fixed ? (int)(blockIdx.x & 7) : hh;
        bf16x8 kh[2][4], kl[2][4];
#pragma unroll
        for (int ph = 0; ph < 2; ++ph)
#pragma unroll
            for (int ks = 0; ks < 4; ++ks) { const float* kr = p.peer_keys + ((size_t)((l * 8 + h) * 2 + ph) * 128 + 16 * w + c16) * 128 + 32 * ks + 8 * g;
                const f32x4 a = *(const f32x4*)kr, b2 = *(const f32x4*)(kr + 4); const float v[8] = {a[0], a[1], a[2], a[3], b2[0], b2[1], b2[2], b2[3]};
                u32x4 hi, lo; unsigned hw[4], lw[4];
#pragma unroll
                for (int j = 0; j < 4; ++j) { hw[j] = pack2(v[2 * j], v[2 * j + 1]); lw[j] = pack2(v[2 * j] - lo16(hw[j]), v[2 * j + 1] - hi16(hw[j])); }
                hi = (u32x4){hw[0], hw[1], hw[2], hw[3]}; lo = (u32x4){lw[0], lw[1], lw[2], lw[3]};
                kh[ph][ks] = __builtin_bit_cast(bf16x8, hi); kl[ph][ks] = __builtin_bit_cast(bf16x8, lo); }
        const int first = fixed ? (int)(blockIdx.x >> 3) : (int)blockIdx.x, stride = fixed ? nq : (int)gridDim.x;
        for (int tt0 = first; tt0 < ntt; tt0 += SEL_NT * stride) {
            int ntile = 0;
#pragma unroll
            for (int k = 0; k < SEL_NT; ++k) if (tt0 + k * stride < ntt) ntile = k + 1;
            select_step(p, l, tt0, stride, ntile, h, lds, kh, kl);
        }
    }
}

constexpr int PEER_TB = 272;
struct PeerDeal { int xs_first, xs_step, t_begin, t_end; };
DEV PeerDeal peer_deal() {
    PeerDeal d; const bool sl = (gridDim.x % 8u) == 0u;
    const int nranks = sl ? (int)(gridDim.x >> 3) : (int)gridDim.x, rank = sl ? (int)(blockIdx.x >> 3) : (int)blockIdx.x, tpr = (NTOK + nranks - 1) / nranks;
    d.xs_first = sl ? (int)(blockIdx.x & 7) : 0; d.xs_step = sl ? 8 : 1; d.t_begin = rank * tpr; d.t_end = d.t_begin + tpr < NTOK ? d.t_begin + tpr : NTOK;
    return d;
}
struct PeerTok { u32x4 e0, e1, d1, d0; float hs; };
DEV void peer_fetch_u(const Params& p, int t, int blk, int g8, PeerTok& k) {
    const u32x4* ep = (const u32x4*)(p.eidx + (size_t)t * 128 + 16 * g8); k.e0 = ep[0]; k.e1 = ep[1];
    const u32x4* hp = (const u32x4*)(p.hd + ((size_t)t * 64 + blk) * 8); k.d1 = hp[0]; k.d0 = hp[1]; k.hs = p.hs[(size_t)t * 64 + blk];
}
DEV void phase_peer_u(const Params& p, int l, unsigned char* lds) {
    const int lane = threadIdx.x & 63, w = wave_id(), j8 = lane & 7, g8 = lane >> 3;
    const bool b2 = (j8 & 4) != 0, b1 = (j8 & 2) != 0, b0 = (j8 & 1) != 0;
    const PeerDeal dl = peer_deal();
    const unsigned char* U = p.u8 + (size_t)l * NE * (D / 2);
    for (int xs = dl.xs_first; xs < 8; xs += dl.xs_step) {
        const int blk = 8 * xs + j8;
        const unsigned char* Us = U + (size_t)xs * NE * 128; const unsigned joff = 16u * (unsigned)j8;
        PeerTok nx; if (dl.t_begin + w < dl.t_end) peer_fetch_u(p, dl.t_begin + w, blk, g8, nx);
        for (int t = dl.t_begin + w; t < dl.t_end; t += 8) {
            const PeerTok cu = nx;
            const unsigned ew[8] = {cu.e0.x, cu.e0.y, cu.e0.z, cu.e0.w, cu.e1.x, cu.e1.y, cu.e1.z, cu.e1.w}; unsigned ev[16];
#pragma unroll
            for (int i = 0; i < 8; ++i) { ev[2 * i] = ew[i] & 0xffffu; ev[2 * i + 1] = ew[i] >> 16; }
            u32x4 q[16];
#pragma unroll
            for (int i = 0; i < 16; ++i) q[i] = *(const u32x4*)(Us + (ev[i] * 128u + joff));
            if (t + 8 < dl.t_end) peer_fetch_u(p, t + 8, blk, g8, nx);
            float ps[16];
#pragma unroll
            for (int i = 0; i < 16; ++i) {
                int a1 = SDOT8(q[i].x, cu.d1.x, 0), a0 = SDOT8(q[i].x, cu.d0.x, 0);
                a1 = SDOT8(q[i].y, cu.d1.y, a1); a0 = SDOT8(q[i].y, cu.d0.y, a0);
                a1 = SDOT8(q[i].z, cu.d1.z, a1); a0 = SDOT8(q[i].z, cu.d0.z, a0);
                a1 = SDOT8(q[i].w, cu.d1.w, a1); a0 = SDOT8(q[i].w, cu.d0.w, a0);
                ps[i] = (float)(a1 * 16 + a0) * cu.hs; }
            float q8[8], q4[4], q2[2];
#pragma unroll
            for (int k = 0; k < 8; ++k) { const float keep = b2 ? ps[8 + k] : ps[k], send = b2 ? ps[k] : ps[8 + k]; q8[k] = keep + DPP_HMIRROR(send); }
#pragma unroll
            for (int k = 0; k < 4; ++k) { const float keep = b1 ? q8[4 + k] : q8[k], send = b1 ? q8[k] : q8[4 + k]; q4[k] = keep + DPP_XOR2(send); }
#pragma unroll
            for (int k = 0; k < 2; ++k) { const float keep = b0 ? q4[2 + k] : q4[k], send = b0 ? q4[k] : q4[2 + k]; q2[k] = keep + DPP_XOR1(send); }
            float* dst = p.part + ((size_t)t * 8 + xs) * 128 + 16 * g8 + 2 * j8; *(f32x2*)dst = (f32x2){q2[0], q2[1]};
        }
    }
}
DEV void phase_peer_c(const Params& p, int l) {
    const size_t n = (size_t)NTOK * 128, gs = (size_t)gridDim.x * 512;
    for (size_t i = (size_t)blockIdx.x * 512 + threadIdx.x; i < n; i += gs) {
        const size_t t = i >> 7; const int pr = (int)(i & 127); float sacc = 0.f;
        const int e = p.eidx[i]; const float sv = p.sv[l * NE + e], gt = p.gate[i];
        const float* sup = p.su + ((size_t)l * NE + e) * 8; const f32x4 s0 = *(const f32x4*)sup, s1 = *(const f32x4*)(sup + 4);
        const float sx[8] = {s0[0], s0[1], s0[2], s0[3], s1[0], s1[1], s1[2], s1[3]};
#pragma unroll
        for (int x = 0; x < 8; ++x) sacc += p.part[(t * 8 + x) * 128 + pr] * sx[x];
        p.ab16[i] = (bf16_t)f2bf(gelu_erf(sacc) * gt * sv);
    }
}
struct PeerTokV { u32x4 e0, e1, a0, a1; u32x2 x1; f32x4 g2; };
DEV void peer_fetch_v(const Params& p, int l, int t, int col, int g8, PeerTokV& k) {
    const u32x4* ep = (const u32x4*)(p.eidx + (size_t)t * 128 + 16 * g8); k.e0 = ep[0]; k.e1 = ep[1];
    const u32x4* ap = (const u32x4*)(p.ab16 + (size_t)t * 128 + 16 * g8); k.a0 = ap[0]; k.a1 = ap[1];
    k.x1 = *(const u32x2*)(p.xa + (size_t)t * D + col); k.g2 = *(const f32x4*)(p.modbuf + (size_t)tok_batch(t) * MODW + l * NMOD + 5 * D + col);
}
DEV void phase_peer_v(const Params& p, int l, unsigned char* lds) {
    const int lane = threadIdx.x & 63, w = wave_id(), j8 = lane & 7, g8 = lane >> 3;
    const bool b3 = (g8 & 1) != 0, b4 = (g8 & 2) != 0, b5 = (g8 & 4) != 0;
    const PeerDeal dl = peer_deal();
    const unsigned char* V = p.v8 + (size_t)l * NE * (D / 2);
    for (int xs = dl.xs_first; xs < 8; xs += dl.xs_step) {
        const int col = 256 * xs + 32 * j8 + (b3 ? 16 : 0) + (b4 ? 8 : 0) + (b5 ? 4 : 0);
        const unsigned char* Vs = V + (size_t)xs * NE * 128; const unsigned joff = 16u * (unsigned)j8;
        PeerTokV nx; if (dl.t_begin + w < dl.t_end) peer_fetch_v(p, l, dl.t_begin + w, col, g8, nx);
        for (int t = dl.t_begin + w; t < dl.t_end; t += 8) {
            const PeerTokV cu = nx;
            const unsigned ew[8] = {cu.e0.x, cu.e0.y, cu.e0.z, cu.e0.w, cu.e1.x, cu.e1.y, cu.e1.z, cu.e1.w}; unsigned ev[16];
#pragma unroll
            for (int i = 0; i < 8; ++i) { ev[2 * i] = ew[i] & 0xffffu; ev[2 * i + 1] = ew[i] >> 16; }
            u32x4 q[16];
#pragma unroll
            for (int i = 0; i < 16; ++i) q[i] = *(const u32x4*)(Vs + (ev[i] * 128u + joff));
            if (t + 8 < dl.t_end) peer_fetch_v(p, l, t + 8, col, g8, nx);
            const unsigned aw[8] = {cu.a0.x, cu.a0.y, cu.a0.z, cu.a0.w, cu.a1.x, cu.a1.y, cu.a1.z, cu.a1.w}; float av[16];
#pragma unroll
            for (int i = 0; i < 8; ++i) { av[2 * i] = lo16(aw[i]); av[2 * i + 1] = hi16(aw[i]); }
            f32x2 acc2[16];
#pragma unroll
            for (int k = 0; k < 16; ++k) acc2[k] = (f32x2){0.f, 0.f};
#pragma unroll
            for (int i = 0; i < 16; ++i) { f32x2 dq[16]; fp4x32_dec2(q[i], dq); const f32x2 a2v = (f32x2){av[i], av[i]};
#pragma unroll
                for (int k = 0; k < 16; ++k) acc2[k] = __builtin_elementwise_fma(a2v, dq[k], acc2[k]); }
            float acc[32];
#pragma unroll
            for (int k = 0; k < 16; ++k) { acc[2 * k] = acc2[k][0]; acc[2 * k + 1] = acc2[k][1]; }
            float q16[16], q8[8], q4[4];
#pragma unroll
            for (int k = 0; k < 16; ++k) { const float keep = b3 ? acc[16 + k] : acc[k], send = b3 ? acc[k] : acc[16 + k]; q16[k] = keep + DPP_XOR8(send); }
#pragma unroll
            for (int k = 0; k < 8; ++k) q8[k] = xsum16(q16[k], q16[8 + k]);
#pragma unroll
            for (int k = 0; k < 4; ++k) q4[k] = xsum32(q8[k], q8[4 + k]);
            const f32x4 x1v = (f32x4){lo16(cu.x1.x), hi16(cu.x1.x), lo16(cu.x1.y), hi16(cu.x1.y)}; f32x4 o;
#pragma unroll
            for (int k = 0; k < 4; ++k) o[k] = x1v[k] + cu.g2[k] * q4[k];
            u32x2 ow; ow.x = pack2(o[0], o[1]); ow.y = pack2(o[2], o[3]); *(u32x2*)(p.xb + (size_t)t * D + col) = ow;
        }
    }
}

constexpr int N_PHASES = 27;
DEV int phase_class(int k) { return k < 2 ? k : (k == 26 ? 14 : 2 + (k - 2) % 12); }
#ifndef HIPEMU
#define XB_TMO      128
#define XB_XCNT(j)  (256  + 64 * (j))
#define XB_XSUB(j)  (1280 + 64 * (j))
#define XB_XGEN(j)  (2304 + 64 * (j))
#define XB_TOP      3328
#define XB_TOPGEN   3392
#define XCD_BAR_WORDS 3456
#define XB_SPIN_CAP (1u << 22)
__device__ __forceinline__ unsigned xb_ld(unsigned* p)              { return __hip_atomic_load(p, __ATOMIC_RELAXED, __HIP_MEMORY_SCOPE_AGENT); }
__device__ __forceinline__ unsigned xb_add(unsigned* p, unsigned v) { return __hip_atomic_fetch_add(p, v, __ATOMIC_RELAXED, __HIP_MEMORY_SCOPE_AGENT); }
__device__ __forceinline__ unsigned xb_xcc_id() { return (unsigned)__builtin_amdgcn_s_getreg((3 << 11) | 20) & 0xFu; }
#define XB_SPIN(cond, bar) do { unsigned _sp = 0; while (cond) { __builtin_amdgcn_s_sleep(1); \
    if ((++_sp & 255u) == 0u) { if (xb_ld(&(bar)[XB_TMO])) break; if (_sp > XB_SPIN_CAP) { atomicAdd(&(bar)[XB_TMO], 1u); break; } } } } while (0)
struct XcdBarrier { unsigned* bar; unsigned x; volatile LAS unsigned* st; };
__device__ __forceinline__ XcdBarrier xcd_barrier_post(unsigned* bar, volatile LAS unsigned* st) {
    XcdBarrier b; b.bar = bar; b.x = xb_xcc_id(); b.st = st;
    if (threadIdx.x == 0) (void)xb_add(&bar[XB_XCNT(b.x)], 1u);
    return b;
}
__device__ __forceinline__ void xcd_barrier_complete(unsigned* bar, unsigned x, unsigned& nloc, unsigned& nx) {
    const unsigned G = gridDim.x * gridDim.y * gridDim.z;
    unsigned sum, cnt, mine, sp = 0u;
    for (;;) {
        sum = 0u; cnt = 0u; mine = 0u;
#pragma unroll
        for (unsigned j = 0; j < 16; ++j) { const unsigned c = xb_ld(&bar[XB_XCNT(j)]); sum += c; cnt += (c > 0u) ? 1u : 0u; mine = (j == x) ? c : mine; }
        if (sum == G) break;
        __builtin_amdgcn_s_sleep(1);
        if ((++sp & 255u) == 0u) { if (xb_ld(&bar[XB_TMO])) break; if (sp > XB_SPIN_CAP) { atomicAdd(&bar[XB_TMO], 1u); break; } }
    }
    nloc = mine > 0u ? mine : 1u; nx = cnt > 0u ? cnt : 1u;
}
__device__ __forceinline__ void xcd_barrier(const XcdBarrier& b) {
    asm volatile("s_waitcnt vmcnt(0)" ::: "memory");
    __syncthreads();
    if (threadIdx.x == 0) {
        unsigned* bar = b.bar;
        __builtin_amdgcn_s_waitcnt(0);
        unsigned nloc = b.st[0], nx = b.st[1];
        if (nloc == 0u) { xcd_barrier_complete(bar, b.x, nloc, nx); b.st[0] = nloc; b.st[1] = nx; }
        const unsigned old = xb_add(&bar[XB_XSUB(b.x)], 1u);
        const unsigned gen = old / nloc;
        if (old + 1u == (gen + 1u) * nloc) {
            __builtin_amdgcn_fence(__ATOMIC_RELEASE, "agent");
            asm volatile("s_waitcnt vmcnt(0)" ::: "memory");
            const unsigned og = xb_add(&bar[XB_TOP], 1u);
            const unsigned tg = og / nx;
            if (og + 1u == (tg + 1u) * nx) xb_add(&bar[XB_TOPGEN], 1u);
            else XB_SPIN(xb_ld(&bar[XB_TOPGEN]) == tg, bar);
            __builtin_amdgcn_fence(__ATOMIC_ACQUIRE, "agent");
            xb_add(&bar[XB_XGEN(b.x)], 1u);
            asm volatile("s_waitcnt vmcnt(0)" ::: "memory");
        } else {
            XB_SPIN(xb_ld(&bar[XB_XGEN(b.x)]) == gen, bar);
            __builtin_amdgcn_fence(__ATOMIC_ACQUIRE, "agent");
            asm volatile("s_waitcnt vmcnt(0)" ::: "memory");
        }
    }
    __syncthreads();
}
#endif

constexpr int LDS_BYTES = 163840;
constexpr int LDS_BARW = LDS_BYTES - 16;

#ifndef PH_MASK
#define PH_MASK 0xFFFFFFFFu
#endif
#ifndef PROBE_DUP
#define PROBE_DUP 0u
#endif
#define DUP_N(k) (1 + (int)((PROBE_DUP >> phase_class(k)) & 1u))
#define PH_BIT(k) ((PH_MASK >> phase_class(k)) & 1u)
#ifdef HIPEMU
static void run_phase(const Params& pp, int ph, unsigned char* lds)
#define GRID_BAR() do {} while (0)
#define IN(k) (ph == (k))
#define GLDS lds
#define LOADP() const Params& p = pp
#else
typedef const __attribute__((address_space(4))) unsigned char* kargp_t;
__device__ __forceinline__ kargp_t karg_ptr() { kargp_t kp = (kargp_t)__builtin_amdgcn_kernarg_segment_ptr(); asm volatile("" : "+s"(kp)); return kp; }
#define LOADP() Params p; __builtin_memcpy(&p, karg_ptr(), sizeof(Params))
#define IN(k) (PH_BIT(k) && ph_lo <= (k) && (k) < ph_hi)
#define GLDS ((LAS unsigned char*)lds_raw)
__global__ void __launch_bounds__(512, 2) mega_fwd(Params p_unused)
#endif
{
#ifndef HIPEMU
    extern __shared__ __attribute__((aligned(16))) unsigned char lds_raw[];
    unsigned char* lds = lds_raw;
    if (threadIdx.x == 0) { *(volatile unsigned*)(lds_raw + LDS_BARW) = 0u; *(volatile unsigned*)(lds_raw + LDS_BARW + 4) = 0u; }
    __syncthreads();
    int ph_lo, ph_hi; XcdBarrier bar;
    { LOADP(); ph_lo = p.ph_lo; ph_hi = p.ph_hi; bar.bar = p.bar; bar.x = 0; bar.st = nullptr; }
    const bool multi = (ph_hi - ph_lo) > 1;
    if (multi) bar = xcd_barrier_post(bar.bar, (volatile LAS unsigned*)(lds_raw + LDS_BARW));
#define GRID_BAR() do { if (multi) xcd_barrier(bar); } while (0)
#endif
    if (IN(0)) { for (int rep = 0; rep < DUP_N(0); ++rep) { LOADP(); for (int u = blockIdx.x; u < ADA_UNITS; u += gridDim.x) ada_direct_unit(p, u, lds); } }
    if (IN(1)) { LOADP(); phase_convert(p, lds, 1); GRID_BAR(); }
#define LAYER(l) do { \
        constexpr int base = 2 + 12 * (l); \
        if (IN(base + 0)) { for (int rep = 0; rep < DUP_N(base + 0); ++rep) { LOADP(); phase_norm(p, p.x_prompt, p.x_sample, (l) == 0 ? (const bf16_t*)nullptr : p.xb, p.norm1_g + (l) * D, (l) * NMOD + 0 * D, (l) * NMOD + 1 * D, p.hA, nullptr, nullptr, nullptr); GRID_BAR(); } } \
        if (IN(base + 1)) { for (int rep = 0; rep < DUP_N(base + 1); ++rep) { LOADP(); \
            pg8::Gemm g{p.hA, p.wt_in + (size_t)(l) * ZW * D, MPAD, ZW, D}; pg8::StaticOrder S; S.init(MPAD, ZW, gridDim.x, blockIdx.x); \
            pg8::EpiBf16 E{p.z, ZW}; \
            pg8::gemm_phase<pg8::EpiBf16, pg8::StaticOrder>(GLDS, g, S, E); } } \
        if (IN(base + 1)) { LOADP(); phase_tbl_slot(p, (l)); GRID_BAR(); } \
        if (IN(base + 2)) { for (int rep = 0; rep < DUP_N(base + 2); ++rep) { LOADP(); phase_mix1(p, (l), lds); GRID_BAR(); } } \
        if (IN(base + 3)) { for (int rep = 0; rep < DUP_N(base + 3); ++rep) { LOADP(); phase_mix2(p, (l)); GRID_BAR(); } } \
        if (IN(base + 4)) { LOADP(); phase_mix3(p, (l), lds); } \
        if (IN(base + 4)) { LOADP(); \
            pg8::Gemm g{p.pooled, p.wt_pool + (size_t)(l) * 1024 * 256, 4 * MPAD, 1024, 256}; pg8::PoolOrder S{(int)gridDim.x, (int)(gridDim.x - 1 - blockIdx.x)}; \
            pg8::EpiPool E{p.cat, p.pool_b + (l) * PW, p.pool_scale + (l) * PW}; \
            pg8::gemm_phase<pg8::EpiPool, pg8::PoolOrder>(GLDS, g, S, E); \
            GRID_BAR(); } \
        if (IN(base + 5)) { for (int rep = 0; rep < DUP_N(base + 5); ++rep) { LOADP(); \
            pg8::Gemm g{p.cat, p.wt_out + (size_t)(l) * D * D, MBIG, D, D}; pg8::StaticOrder S; S.init(MBIG, D, gridDim.x, blockIdx.x); \
            pg8::EpiResid E{p.x_prompt, p.x_sample, (l) == 0 ? (const bf16_t*)nullptr : p.xb, p.modbuf + (l) * NMOD + 2 * D, p.xa}; \
            pg8::gemm_phase<pg8::EpiResid, pg8::StaticOrder>(GLDS, g, S, E); \
            { SmallResid sf{E.xlo, E.xhi, E.x16, E.gmod, E.out}; small_gemm(p.cat, p.wt_out + (size_t)(l) * D * D, D, lds, sf); } \
            GRID_BAR(); } } \
        if (IN(base + 6)) { for (int rep = 0; rep < DUP_N(base + 6); ++rep) { LOADP(); phase_norm(p, nullptr, nullptr, p.xa, p.norm2_g + (l) * D, (l) * NMOD + 3 * D, (l) * NMOD + 4 * D, p.hB, nullptr, p.hd, p.hs); GRID_BAR(); } } \
        if (IN(base + 7)) { for (int rep = 0; rep < DUP_N(base + 7); ++rep) { LOADP(); \
            pg8::Gemm g{p.hB, p.wt_q + (size_t)(l) * D * D, MBIG, D, D}; pg8::StaticOrder S; S.init(MBIG, D, gridDim.x, blockIdx.x); \
            pg8::EpiF32 E{p.qry, D}; \
            pg8::gemm_phase<pg8::EpiF32, pg8::StaticOrder>(GLDS, g, S, E); \
            { SmallF32 sf{p.qry}; small_gemm(p.hB, p.wt_q + (size_t)(l) * D * D, D, lds, sf); } \
            GRID_BAR(); } } \
        if (IN(base + 8)) { for (int rep = 0; rep < DUP_N(base + 8); ++rep) { LOADP(); phase_select(p, (l), lds); GRID_BAR(); } } \
        if (IN(base + 9)) { for (int rep = 0; rep < DUP_N(base + 9); ++rep) { LOADP(); phase_peer_u(p, (l), lds); GRID_BAR(); } } \
        if (IN(base + 10)) { LOADP(); phase_peer_c(p, (l)); GRID_BAR(); } \
        if (IN(base + 11)) { for (int rep = 0; rep < DUP_N(base + 11); ++rep) { LOADP(); phase_peer_v(p, (l), lds); GRID_BAR(); } } \
    } while (0)
    LAYER(0);
    LAYER(1);
    if (IN(26)) { LOADP(); phase_norm(p, nullptr, nullptr, p.xb, p.final_g, 2 * NMOD, 2 * NMOD + D, nullptr, p.out + OFF_Y, nullptr, nullptr); }
#undef LAYER
#undef IN
#undef GRID_BAR
#undef GLDS
#undef LOADP
}

struct WsLayout { size_t bar, modbuf, csil, wt_ada, wt_in, wt_out, wt_q, wt_pool, u8, v8, su, sv, hd, hs, part, hg_oin, hg_ds, hg_gam, hg_qh, hg_sc, hA, hB, z, pooled, cat, xa, xb, qry, eidx, gate, ab16, end; };
static WsLayout ws_layout() {
    WsLayout L; size_t o = 0;
    auto take = [&](size_t bytes) { const size_t r = o; o += (bytes + 255) & ~(size_t)255; return r; };
    L.bar = take(16384);
    L.modbuf = take((size_t)256 * MODW * 4);
    L.csil = take((size_t)256 * D * 2);
    L.wt_ada = take((size_t)MODW * D * 2);
    L.wt_in = take((size_t)2 * ZW * D * 2);
    L.wt_out = take((size_t)2 * D * D * 2);
    L.wt_q = take((size_t)2 * D * D * 2);
    L.wt_pool = take((size_t)2 * 1024 * 256 * 2);
    L.u8 = take((size_t)2 * NE * D);
    L.v8 = take((size_t)2 * NE * D);
    L.su = take((size_t)2 * NE * 8 * 4);
    L.sv = take((size_t)2 * NE * 4);
    L.hd = take((size_t)MPAD * 64 * 32);
    L.hs = take((size_t)MPAD * 64 * 4);
    L.part = take((size_t)MPAD * 8 * 128 * 4);
    L.hg_oin = take((size_t)hg::NUNIT * 64 * 128 * 2);
    L.hg_ds = take((size_t)hg::NUNIT * 128 * 128 * 2);
    L.hg_gam = take((size_t)hg::NUNIT * 128 * 4);
    L.hg_qh = take((size_t)NP * 1024 * 2);
    L.hg_sc = take((size_t)hg::NUNIT * 128 * 128 * 2);
    L.hA = take((size_t)MPAD * D * 2);
    L.hB = take((size_t)MPAD * D * 2);
    L.z = take((size_t)MPAD * ZW * 2);
    L.pooled = take((size_t)4 * MPAD * 256 * 2);
    L.cat = take((size_t)MPAD * D * 2);
    L.xa = take((size_t)MPAD * D * 2);
    L.xb = take((size_t)MPAD * D * 2);
    L.qry = take((size_t)MPAD * D * 4);
    L.eidx = take((size_t)MPAD * 128 * 2);
    L.gate = take((size_t)MPAD * 128 * 4);
    L.ab16 = take((size_t)MPAD * 128 * 2);
    L.end = o;
    return L;
}
static void fill_params(Params& p, void* const* d_in, void* d_out, void* d_ws) {
    const float** f = (const float**)&p;
    for (int i = 0; i < 24; ++i) f[i] = (const float*)d_in[i];
    p.out = (float*)d_out;
    const WsLayout L = ws_layout(); unsigned char* w = (unsigned char*)d_ws;
    p.bar = (unsigned*)(w + L.bar); p.modbuf = (float*)(w + L.modbuf); p.csil = (bf16_t*)(w + L.csil); p.wt_ada = (bf16_t*)(w + L.wt_ada); p.wt_in = (bf16_t*)(w + L.wt_in);
    p.wt_out = (bf16_t*)(w + L.wt_out); p.wt_q = (bf16_t*)(w + L.wt_q); p.wt_pool = (bf16_t*)(w + L.wt_pool); p.u8 = w + L.u8; p.v8 = w + L.v8; p.su = (float*)(w + L.su); p.sv = (float*)(w + L.sv); p.hd = (unsigned*)(w + L.hd); p.hs = (float*)(w + L.hs); p.part = (float*)(w + L.part); p.hg_oin = (bf16_t*)(w + L.hg_oin); p.hg_ds = (bf16_t*)(w + L.hg_ds); p.hg_gam = (float*)(w + L.hg_gam); p.hg_qh = (bf16_t*)(w + L.hg_qh); p.hg_sc = (bf16_t*)(w + L.hg_sc);
    p.hA = (bf16_t*)(w + L.hA); p.hB = (bf16_t*)(w + L.hB); p.z = (bf16_t*)(w + L.z); p.pooled = (bf16_t*)(w + L.pooled); p.cat = (bf16_t*)(w + L.cat);
    p.xa = (bf16_t*)(w + L.xa); p.xb = (bf16_t*)(w + L.xb); p.qry = (float*)(w + L.qry); p.eidx = (unsigned short*)(w + L.eidx); p.gate = (float*)(w + L.gate); p.ab16 = (bf16_t*)(w + L.ab16);
}

#ifndef HIPEMU
#ifndef MK_ONE_LAUNCH
#define MK_ONE_LAUNCH 1
#endif
extern "C" void kernel_launch(void* const* d_in, const int* in_sizes, int n_in, void* d_out, int out_size, void* d_ws, size_t ws_size, hipStream_t stream) {
    static int grid = 0;
    if (grid == 0) {
        const WsLayout L = ws_layout();
        if (n_in != 24 || (size_t)out_size != OUT_TOTAL || ws_size < L.end) { fprintf(stderr, "kernel_launch: unexpected shapes (n_in %d, out %d, ws %zu < %zu)\n", n_in, out_size, ws_size, L.end); grid = -1; return; }
        int dev = 0, cus = 0, per_cu = 0;
        hipGetDevice(&dev); hipDeviceGetAttribute(&cus, hipDeviceAttributeMultiprocessorCount, dev);
        if (hipFuncSetAttribute((const void*)mega_fwd, hipFuncAttributeMaxDynamicSharedMemorySize, LDS_BYTES) != hipSuccess) { fprintf(stderr, "kernel_launch: hipFuncSetAttribute failed\n"); grid = -1; return; }
        hipOccupancyMaxActiveBlocksPerMultiprocessor(&per_cu, (const void*)mega_fwd, 512, LDS_BYTES);
        (void)hipGetLastError();
        if (per_cu < 1) fprintf(stderr, "kernel_launch: occupancy query says %d blocks per CU\n", per_cu);
        grid = cus;
    }
    if (grid < 0) return;
    Params p{};
    fill_params(p, d_in, d_out, d_ws);
    hipMemsetAsync(p.bar, 0, 16384, stream);
#if MK_ONE_LAUNCH
    p.ph_lo = 0; p.ph_hi = N_PHASES;
    hipLaunchKernelGGL(mega_fwd, dim3(grid), dim3(512), LDS_BYTES, stream, p);
#else
    for (int ph = 0; ph < N_PHASES; ++ph) { p.ph_lo = ph; p.ph_hi = ph + 1; hipLaunchKernelGGL(mega_fwd, dim3(grid), dim3(512), LDS_BYTES, stream, p); }
#endif
}
#endif
```

```cpp
#ifndef HIPEMU
#include <hip/hip_runtime.h>
#include <cstdio>
#endif
#include <stdint.h>

#ifndef CFG_PB
#define CFG_PB 4
#define CFG_SEQ 2048
#define CFG_DB 128
#endif

#ifdef HIPEMU
#define DEV inline
#define LAS
#define READLANE_I(v, l) emu_readlane((v), (l))
#define READLANE_F(v, l) emu_readlane_f((v), (l))
#define MFMA_BF16(a, b, c) emu_mfma_bf16_16x16x32((a), (b), (c))
#define MFMA_F32(a, b, c) emu_mfma_f32_16x16x4((a), (b), (c))
#define SDOT8(a, b, c) emu_sdot8((a), (b), (c))
#define __expf expf
#define __logf logf
#else
#define DEV __device__ __forceinline__
#define LAS __attribute__((address_space(3)))
#define READLANE_I(v, l) __builtin_amdgcn_readlane((v), (l))
#define READLANE_F(v, l) __uint_as_float((unsigned)__builtin_amdgcn_readlane((int)__float_as_uint(v), (l)))
#define MFMA_BF16(a, b, c) __builtin_amdgcn_mfma_f32_16x16x32_bf16((a), (b), (c), 0, 0, 0)
#define MFMA_F32(a, b, c) __builtin_amdgcn_mfma_f32_16x16x4f32((a), (b), (c), 0, 0, 0)
#define SDOT8(a, b, c) __builtin_amdgcn_sdot8((int)(a), (int)(b), (c), false)
#endif

typedef unsigned short bf16_t;
typedef short bf16x8 __attribute__((ext_vector_type(8)));
typedef float f32x4 __attribute__((ext_vector_type(4)));
typedef unsigned u32x4 __attribute__((ext_vector_type(4)));
typedef unsigned u32x2 __attribute__((ext_vector_type(2)));

namespace cfg {
constexpr int D = 2048, PB = CFG_PB, SEQ = CFG_SEQ, DB = CFG_DB, DSEQ = 4;
constexpr int NP = PB * SEQ, NS = DB * DSEQ, NTOK = NP + NS, MPAD = (NTOK + 255) / 256 * 256;
constexpr int NC = PB + DB;
constexpr int HH = 8, HD = 128, PW = 1024, PBUF = 15, ZW = 5120;
constexpr int NE = 16384;
constexpr int NMOD = 6 * D;
constexpr int MODW = 2 * NMOD + 2 * D;
constexpr float EPS = 1e-6f;
constexpr int NCHAIN = PB * HH;
constexpr size_t OFF_Y = 0;
constexpr size_t OFF_HP = (size_t)NTOK * D;
constexpr size_t OFF_PP = OFF_HP + (size_t)2 * PB * HH * HD * HD;
constexpr size_t OFF_HS = OFF_PP + (size_t)2 * PB * PBUF * PW;
constexpr size_t OFF_PS = OFF_HS + (size_t)2 * DB * HH * HD * HD;
constexpr size_t OUT_TOTAL = OFF_PS + (size_t)2 * DB * PBUF * PW;
}
using namespace cfg;

struct Params {
    const float *x_prompt, *x_sample, *c_prompt, *c_sample, *state_hgrn, *state_pool, *w_ada, *b_ada, *norm1_g, *norm2_g, *w_in, *w_out,
        *lb_logits, *hgrn_norm_g, *pool_w, *pool_b, *pool_scale, *peer_wq, *peer_keys, *peer_u, *peer_v, *final_g, *w_ada_final, *b_ada_final;
    float* out;
    unsigned* bar; float* modbuf; bf16_t* csil; bf16_t* wt_ada; bf16_t* wt_in; bf16_t* wt_out; bf16_t* wt_q; bf16_t* wt_pool;
    unsigned char* u8; unsigned char* v8; float* su; float* sv; unsigned* hd; float* hs; float* part; bf16_t* hg_oin; bf16_t* hg_ds; float* hg_gam; bf16_t* hg_qh; bf16_t* hg_sc; bf16_t* hA; bf16_t* hB; bf16_t* z; bf16_t* pooled; bf16_t* cat; bf16_t* xa; bf16_t* xb; float* qry; unsigned short* eidx; float* gate; bf16_t* ab16;
    int ph_lo, ph_hi;
};

DEV float bf2f(unsigned v) { return __uint_as_float(v << 16); }
#ifdef HIPEMU
DEV unsigned f2bf(float f) { unsigned u = __float_as_uint(f); u += 0x7fffu + ((u >> 16) & 1u); return u >> 16; }
DEV unsigned pack2(float lo, float hi) { return f2bf(lo) | (f2bf(hi) << 16); }
#else
typedef float f32x2_t __attribute__((ext_vector_type(2)));
typedef __bf16 bf16x2_t __attribute__((ext_vector_type(2)));
DEV unsigned pack2(float lo, float hi) { const f32x2_t v = {lo, hi}; return __builtin_bit_cast(unsigned, __builtin_convertvector(v, bf16x2_t)); }
DEV unsigned f2bf(float f) { return (unsigned)__builtin_bit_cast(unsigned short, (__bf16)f); }
#endif
DEV float lo16(unsigned w) { return __uint_as_float(w << 16); }
DEV float hi16(unsigned w) { return __uint_as_float(w & 0xffff0000u); }
DEV float wave_sum(float v) { v += __shfl_xor(v, 32); v += __shfl_xor(v, 16); v += __shfl_xor(v, 8); v += __shfl_xor(v, 4); v += __shfl_xor(v, 2); v += __shfl_xor(v, 1); return v; }
DEV float wave_max(float v) { v = fmaxf(v, __shfl_xor(v, 32)); v = fmaxf(v, __shfl_xor(v, 16)); v = fmaxf(v, __shfl_xor(v, 8)); v = fmaxf(v, __shfl_xor(v, 4)); v = fmaxf(v, __shfl_xor(v, 2)); v = fmaxf(v, __shfl_xor(v, 1)); return v; }
DEV float sigmoidf_(float x) { return 1.0f / (1.0f + __expf(-x)); }
DEV float siluf_(float x) { return x / (1.0f + __expf(-x)); }
DEV float gelu_erf(float x) { return 0.5f * x * (1.0f + erff(x * 0.70710678118f)); }
#ifdef HIPEMU
DEV int wave_id() { return (int)(threadIdx.x >> 6); }
#else
DEV int wave_id() { return __builtin_amdgcn_readfirstlane((int)(threadIdx.x >> 6)); }
#endif
DEV int tok_batch(int t) { return t < NP ? t / SEQ : PB + (t - NP) / DSEQ; }


#ifdef HIPEMU
static inline unsigned emu_fp8_enc1(float x) {
    const unsigned sgn = x < 0.f ? 0x80u : 0u; float a = fabsf(x);
    if (!(a == a)) return 0x7fu;
    if (a >= 448.f) return sgn | 0x7eu;
    if (a < 0.015625f) { const int q = (int)rintf(a * 512.f); return sgn | (unsigned)q; }
    int e = (int)floorf(log2f(a)); if (ldexpf(1.f, e) > a) --e; if (ldexpf(1.f, e + 1) <= a) ++e;
    int m = (int)rintf((a / ldexpf(1.f, e) - 1.f) * 8.f); if (m == 8) { m = 0; ++e; }
    if (e > 8) return sgn | 0x7eu;
    return sgn | (unsigned)((e + 7) << 3) | (unsigned)m;
}
static inline float emu_fp8_dec1(unsigned b) { const float sg = (b & 0x80u) ? -1.f : 1.f; const int e = (b >> 3) & 15, m = b & 7; return sg * (e == 0 ? m * 0.001953125f : (1.f + m * 0.125f) * ldexpf(1.f, e - 7)); }
DEV unsigned fp8x4_enc(float a, float b, float c, float d) { return emu_fp8_enc1(a) | (emu_fp8_enc1(b) << 8) | (emu_fp8_enc1(c) << 16) | (emu_fp8_enc1(d) << 24); }
DEV void fp8x4_dec(unsigned w, float* o) { o[0] = emu_fp8_dec1(w & 255u); o[1] = emu_fp8_dec1((w >> 8) & 255u); o[2] = emu_fp8_dec1((w >> 16) & 255u); o[3] = emu_fp8_dec1(w >> 24); }
#define DPP_XOR1(v) __shfl((v), emu_lane() ^ 1)
#define DPP_XOR2(v) __shfl((v), emu_lane() ^ 2)
#define DPP_HMIRROR(v) __shfl((v), (emu_lane() & ~7) | (7 - (emu_lane() & 7)))
#define DPP_XOR8(v) __shfl((v), emu_lane() ^ 8)
#define DPP_RMIRROR(v) __shfl((v), (emu_lane() & ~15) | (15 - (emu_lane() & 15)))
#define WAVE_LDS_SYNC() emu_wbar()
DEV float xsum16(float a, float b) { const bool hi = (emu_lane() & 16) != 0; return (hi ? b : a) + __shfl_xor(hi ? a : b, 16); }
DEV float xsum32(float a, float b) { const bool hi = (emu_lane() & 32) != 0; return (hi ? b : a) + __shfl_xor(hi ? a : b, 32); }
#else
typedef float f32x2v_t __attribute__((ext_vector_type(2)));
DEV unsigned fp8x4_enc(float a, float b, float c, float d) { int r = __builtin_amdgcn_cvt_pk_fp8_f32(a, b, 0, false); r = __builtin_amdgcn_cvt_pk_fp8_f32(c, d, r, true); return (unsigned)r; }
DEV void fp8x4_dec(unsigned w, float* o) { const f32x2v_t lo = __builtin_amdgcn_cvt_pk_f32_fp8((int)w, false), hi = __builtin_amdgcn_cvt_pk_f32_fp8((int)w, true); o[0] = lo[0]; o[1] = lo[1]; o[2] = hi[0]; o[3] = hi[1]; }
template <int CTRL> DEV float dpp_f(float v) { return __uint_as_float((unsigned)__builtin_amdgcn_update_dpp(0, (int)__float_as_uint(v), CTRL, 0xf, 0xf, true)); }
#define DPP_XOR1(v) dpp_f<0xB1>(v)
#define DPP_XOR2(v) dpp_f<0x4E>(v)
#define DPP_HMIRROR(v) dpp_f<0x141>(v)
#define DPP_XOR8(v) dpp_f<0x128>(v)
#define DPP_RMIRROR(v) dpp_f<0x140>(v)
#define WAVE_LDS_SYNC() asm volatile("s_waitcnt lgkmcnt(0)" ::: "memory")
DEV float xsum16(float a, float b) { const u32x2 r = __builtin_amdgcn_permlane16_swap(__float_as_uint(a), __float_as_uint(b), false, false); return __uint_as_float(r[0]) + __uint_as_float(r[1]); }
DEV float xsum32(float a, float b) { const u32x2 r = __builtin_amdgcn_permlane32_swap(__float_as_uint(a), __float_as_uint(b), false, false); return __uint_as_float(r[0]) + __uint_as_float(r[1]); }
#endif
typedef float f32x2 __attribute__((ext_vector_type(2)));
#ifdef HIPEMU
DEV void fp8x4_dec2(unsigned w, f32x2& lo, f32x2& hi) { float o[4]; fp8x4_dec(w, o); lo = (f32x2){o[0], o[1]}; hi = (f32x2){o[2], o[3]}; }
#else
DEV void fp8x4_dec2(unsigned w, f32x2& lo, f32x2& hi) { lo = __builtin_amdgcn_cvt_pk_f32_fp8((int)w, false); hi = __builtin_amdgcn_cvt_pk_f32_fp8((int)w, true); }
#endif
DEV void fp8x16_dec2(u32x4 q, f32x2* o) { fp8x4_dec2(q.x, o[0], o[1]); fp8x4_dec2(q.y, o[2], o[3]); fp8x4_dec2(q.z, o[4], o[5]); fp8x4_dec2(q.w, o[6], o[7]); }
#ifdef HIPEMU
static inline unsigned emu_fp4_enc1(float x) {
    const unsigned sgn = x < 0.f ? 8u : 0u; const float a = fabsf(x);
    const unsigned c = a < 0.25f ? 0u : (a < 0.75f ? 1u : (a < 1.25f ? 2u : (a < 1.75f ? 3u : (a < 2.5f ? 4u : (a < 3.5f ? 5u : (a < 5.0f ? 6u : 7u))))));
    return sgn | c;
}
static inline float emu_fp4_dec1(unsigned n) { const float t[8] = {0.f, 0.5f, 1.f, 1.5f, 2.f, 3.f, 4.f, 6.f}; return ((n & 8u) ? -1.f : 1.f) * t[n & 7u]; }
DEV unsigned fp4x4_enc(float a, float b, float c, float d) { return emu_fp4_enc1(a) | (emu_fp4_enc1(b) << 4) | (emu_fp4_enc1(c) << 8) | (emu_fp4_enc1(d) << 12); }
DEV void fp4x8_dec2(unsigned w, f32x2* o) {
    for (int k = 0; k < 4; ++k) o[k] = (f32x2){emu_fp4_dec1((w >> (8 * k)) & 15u), emu_fp4_dec1((w >> (8 * k + 4)) & 15u)};
}
#else
DEV unsigned fp4x4_enc(float a, float b, float c, float d) { unsigned r = 0u; r = __builtin_amdgcn_cvt_scalef32_pk_fp4_f32(r, a, b, 1.0f, 0); r = __builtin_amdgcn_cvt_scalef32_pk_fp4_f32(r, c, d, 1.0f, 1); return r & 0xffffu; }
DEV void fp4x8_dec2(unsigned w, f32x2* o) {
    o[0] = __builtin_amdgcn_cvt_scalef32_pk_f32_fp4(w, 1.0f, 0); o[1] = __builtin_amdgcn_cvt_scalef32_pk_f32_fp4(w, 1.0f, 1);
    o[2] = __builtin_amdgcn_cvt_scalef32_pk_f32_fp4(w, 1.0f, 2); o[3] = __builtin_amdgcn_cvt_scalef32_pk_f32_fp4(w, 1.0f, 3);
}
#endif
DEV void fp4x32_dec2(u32x4 q, f32x2* o) { fp4x8_dec2(q.x, o); fp4x8_dec2(q.y, o + 4); fp4x8_dec2(q.z, o + 8); fp4x8_dec2(q.w, o + 12); }
#ifdef HIPEMU
DEV void fp4x8_decb(unsigned w, unsigned* o) { for (int k = 0; k < 4; ++k) o[k] = f2bf(emu_fp4_dec1((w >> (8 * k)) & 15u)) | (f2bf(emu_fp4_dec1((w >> (8 * k + 4)) & 15u)) << 16); }
DEV float dot2bf(unsigned a, unsigned b, float c) { return c + lo16(a) * lo16(b) + hi16(a) * hi16(b); }
#else
typedef __bf16 bf16x2v_t __attribute__((ext_vector_type(2)));
DEV void fp4x8_decb(unsigned w, unsigned* o) {
    o[0] = __builtin_bit_cast(unsigned, __builtin_amdgcn_cvt_scalef32_pk_bf16_fp4(w, 1.0f, 0)); o[1] = __builtin_bit_cast(unsigned, __builtin_amdgcn_cvt_scalef32_pk_bf16_fp4(w, 1.0f, 1));
    o[2] = __builtin_bit_cast(unsigned, __builtin_amdgcn_cvt_scalef32_pk_bf16_fp4(w, 1.0f, 2)); o[3] = __builtin_bit_cast(unsigned, __builtin_amdgcn_cvt_scalef32_pk_bf16_fp4(w, 1.0f, 3));
}
DEV float dot2bf(unsigned a, unsigned b, float c) { return __builtin_amdgcn_fdot2_f32_bf16(__builtin_bit_cast(bf16x2v_t, a), __builtin_bit_cast(bf16x2v_t, b), c, false); }
#endif

namespace pg8 {
constexpr int BM = 256, BK = 64, HALF = 128, HTB = HALF * BK * 2, STAGE_BYTES = 8 * HTB, NXCD = 8, WGM = 8;
DEV int lds_byte(int r, int c) { const int st = (r >> 4) * 2 + (c >> 5), rr = r & 15, cc = c & 31, ob = rr * 64 + cc * 2; return st * 1024 + (ob ^ (((ob >> 9) & 1) << 5)); }
DEV void stage_rc(int b, int& R, int& C) { const int st = b / 1024, sb = b % 1024, swz = sb ^ (((sb >> 9) & 1) << 5); R = (st >> 1) * 16 + swz / 64; C = (st & 1) * 32 + (swz % 64) / 2; }
DEV int perm32(int rho) { const int n = rho >> 4, i = rho & 15; return 8 * (i >> 2) + 4 * n + (i & 3); }
struct Unit { int pm, pn; };
struct Gemm { const bf16_t* A; const bf16_t* Bt; int M, N, K; };
struct StaticOrder {
    int nM, nN, nwg, G, c;
    DEV void init(int M, int N, int G_, int c_) { nM = M / BM; nN = N / BM; nwg = nM * nN; G = G_; c = c_; }
    DEV bool next(int i, Unit& u) const {
        const long L = (long)i * G + c; if (L >= nwg) return false;
        int wgid = (int)L; { const int q = nwg / NXCD, r = nwg % NXCD, xcd = wgid % NXCD, off = wgid / NXCD; wgid = (xcd < r ? xcd * (q + 1) : r * (q + 1) + (xcd - r) * q) + off; }
        const int nig = WGM * nN, gid = wgid / nig, fm = gid * WGM, gsz = (nM - fm) < WGM ? (nM - fm) : WGM;
        u.pm = fm + ((wgid % nig) % gsz); u.pn = (wgid % nig) / gsz; return true;
    }
    DEV void a_ready(const Unit&) const {}
    DEV void done(const Unit&) const {}
};
struct PoolOrder {
    int G, c;
    DEV bool next(int i, Unit& u) const { const int L = i * G + c; if (L >= 4 * (MPAD / 256)) return false; u.pm = L; u.pn = L / (MPAD / 256); return true; }
    DEV void a_ready(const Unit&) const {}
    DEV void done(const Unit&) const {}
};

struct EpiF32 {
    static constexpr bool PERM = false;
    float* C; int ldc;
    DEV void operator()(const f32x4 (&acc)[2][2][4][2], const Unit& u, int wr, int wc, int fr, int fq) const {
        const int row0 = u.pm * BM + wr * 64 + fr, col0 = u.pn * BM + wc * 32 + 4 * fq;
#pragma unroll
        for (int ai = 0; ai < 2; ++ai)
#pragma unroll
            for (int m = 0; m < 4; ++m) { float* rowp = C + (size_t)(row0 + ai * HALF + m * 16) * ldc + col0;
#pragma unroll
                for (int bj = 0; bj < 2; ++bj)
#pragma unroll
                    for (int n = 0; n < 2; ++n) *(f32x4*)(rowp + bj * HALF + n * 16) = acc[ai][bj][m][n]; }
    }
};
struct EpiAda {
    static constexpr bool PERM = false;
    float* C; const float* b_ada; const float* b_fin;
    DEV void operator()(const f32x4 (&acc)[2][2][4][2], const Unit& u, int wr, int wc, int fr, int fq) const {
        const int row0 = u.pm * BM + wr * 64 + fr, col0 = u.pn * BM + wc * 32 + 4 * fq;
        const float* bias = (u.pn * BM < 2 * NMOD) ? b_ada + col0 : b_fin + (col0 - 2 * NMOD);
        f32x4 bv[2][2];
#pragma unroll
        for (int bj = 0; bj < 2; ++bj)
#pragma unroll
            for (int n = 0; n < 2; ++n) bv[bj][n] = *(const f32x4*)(bias + bj * HALF + n * 16);
#pragma unroll
        for (int ai = 0; ai < 2; ++ai)
#pragma unroll
            for (int m = 0; m < 4; ++m) { float* rowp = C + (size_t)(row0 + ai * HALF + m * 16) * MODW + col0;
#pragma unroll
                for (int bj = 0; bj < 2; ++bj)
#pragma unroll
                    for (int n = 0; n < 2; ++n) *(f32x4*)(rowp + bj * HALF + n * 16) = acc[ai][bj][m][n] + bv[bj][n]; }
    }
};
struct EpiResid {
    static constexpr bool PERM = false;
    const float* xlo; const float* xhi; const bf16_t* x16; const float* gmod  ; bf16_t* out;
    DEV void operator()(const f32x4 (&acc)[2][2][4][2], const Unit& u, int wr, int wc, int fr, int fq) const {
        const int row0 = u.pm * BM + wr * 64 + fr, col0 = u.pn * BM + wc * 32 + 4 * fq;
#pragma unroll
        for (int ai = 0; ai < 2; ++ai)
#pragma unroll
            for (int m = 0; m < 4; ++m) {
                const int row = row0 + ai * HALF + m * 16;
                if (row < NTOK) {
                    const float* gr = gmod + (size_t)tok_batch(row) * MODW + col0;
                    bf16_t* rowp = out + (size_t)row * D + col0;
#pragma unroll
                    for (int bj = 0; bj < 2; ++bj)
#pragma unroll
                        for (int n = 0; n < 2; ++n) { f32x4 xv;
                            if (x16) { const u32x2 xw = *(const u32x2*)(x16 + (size_t)row * D + col0 + bj * HALF + n * 16); xv = (f32x4){lo16(xw.x), hi16(xw.x), lo16(xw.y), hi16(xw.y)}; }
                            else xv = *(const f32x4*)((row < NP ? xlo + (size_t)row * D : xhi + (size_t)(row - NP) * D) + col0 + bj * HALF + n * 16);
                            const f32x4 gv = *(const f32x4*)(gr + bj * HALF + n * 16), o = xv + gv * acc[ai][bj][m][n];
                            u32x2 ow; ow.x = pack2(o[0], o[1]); ow.y = pack2(o[2], o[3]); *(u32x2*)(rowp + bj * HALF + n * 16) = ow; }
                }
            }
    }
};
struct EpiBf16 {
    static constexpr bool PERM = true;
    bf16_t* O; int ldc;
    DEV void operator()(const f32x4 (&acc)[2][2][4][2], const Unit& u, int wr, int wc, int fr, int fq) const {
        const int row0 = u.pm * BM + wr * 64 + fr, col0 = u.pn * BM + wc * 32 + 8 * fq;
#pragma unroll
        for (int ai = 0; ai < 2; ++ai)
#pragma unroll
            for (int m = 0; m < 4; ++m) { bf16_t* rowp = O + (size_t)(row0 + ai * HALF + m * 16) * ldc + col0;
#pragma unroll
                for (int bj = 0; bj < 2; ++bj) { const f32x4 v0 = acc[ai][bj][m][0], v1 = acc[ai][bj][m][1];
                    u32x4 w; w.x = pack2(v0[0], v0[1]); w.y = pack2(v0[2], v0[3]); w.z = pack2(v1[0], v1[1]); w.w = pack2(v1[2], v1[3]);
                    *(u32x4*)(rowp + bj * HALF) = w; } }
    }
};
struct EpiPool {
    static constexpr bool PERM = true;
    bf16_t* cat; const float* pb; const float* ps;
    DEV void operator()(const f32x4 (&acc)[2][2][4][2], const Unit& u, int wr, int wc, int fr, int fq) const {
        const int g = u.pn, tok0 = u.pm * BM - g * MPAD + wr * 64 + fr, col0 = g * 256 + wc * 32 + 8 * fq;
#pragma unroll
        for (int bj = 0; bj < 2; ++bj) {
            const f32x4 b0 = *(const f32x4*)(pb + col0 + bj * HALF), b1 = *(const f32x4*)(pb + col0 + bj * HALF + 4);
            const f32x4 s0 = *(const f32x4*)(ps + col0 + bj * HALF), s1 = *(const f32x4*)(ps + col0 + bj * HALF + 4);
#pragma unroll
            for (int ai = 0; ai < 2; ++ai)
#pragma unroll
                for (int m = 0; m < 4; ++m) { const int tok = tok0 + ai * HALF + m * 16;
                    if (tok < NTOK) { const f32x4 v0 = (acc[ai][bj][m][0] + b0) * s0, v1 = (acc[ai][bj][m][1] + b1) * s1;
                        u32x4 w; w.x = pack2(v0[0], v0[1]); w.y = pack2(v0[2], v0[3]); w.z = pack2(v1[0], v1[1]); w.w = pack2(v1[2], v1[3]);
                        *(u32x4*)(cat + (size_t)tok * D + 1024 + col0 + bj * HALF) = w; } }
        }
    }
};

#ifdef HIPEMU
template <class Epi, class Sched>
static void gemm_phase(unsigned char*, const Gemm g, const Sched& S, const Epi& E) {
    const int tid = threadIdx.x, wid = tid >> 6, lane = tid & 63, wr = wid >> 2, wc = wid & 3, fr = lane & 15, fq = lane >> 4;
    Unit cur;
    for (int ui = 0; S.next(ui, cur); ++ui) {
        f32x4 acc[2][2][4][2];
        for (int ai = 0; ai < 2; ++ai) for (int bj = 0; bj < 2; ++bj) for (int m = 0; m < 4; ++m) for (int n = 0; n < 2; ++n) for (int j = 0; j < 4; ++j) {
            const int row = 256 * cur.pm + 128 * ai + 64 * wr + 16 * m + fr;
            const int col = Epi::PERM ? 256 * cur.pn + 128 * bj + 32 * wc + 8 * fq + 4 * n + j : 256 * cur.pn + 128 * bj + 32 * wc + 16 * n + 4 * fq + j;
            float s = 0.f;
            if ((row % emu_row_mod) < emu_row_limit) { const float* a = emu_f32_copy(g.A, (size_t)g.M * g.K) + (size_t)row * g.K; const float* b = emu_f32_copy(g.Bt, (size_t)g.N * g.K) + (size_t)col * g.K;
                for (int k = 0; k < g.K; ++k) s += a[k] * b[k]; }
            acc[ai][bj][m][n][j] = s; }
        E(acc, cur, wr, wc, fr, fq);
    }
    __syncthreads();
}
#else
template <class Epi, class Sched>
__device__ __forceinline__ void gemm_phase(LAS unsigned char* lds, const Gemm g, const Sched& S, const Epi& E) {
    const int tid = threadIdx.x, wid = __builtin_amdgcn_readfirstlane(tid >> 6), lane = tid & 63, wr = wid >> 2, wc = wid & 3, fr = lane & 15, fq = lane >> 4;
    int K = g.K; asm volatile("" : "+s"(K));
    const int nt = K / BK;
    unsigned voffA[2], voffB[2];
#pragma unroll
    for (int i = 0; i < 2; ++i) { int R, C; stage_rc(tid * 16 + i * 8192, R, C); const int Rb = Epi::PERM ? ((R & ~31) + perm32(R & 31)) : R;
        voffA[i] = (unsigned)(R * K + C) * 2u; voffB[i] = (unsigned)(Rb * K + C) * 2u; }
    const size_t kstep = (size_t)(BK * 2);
    const size_t hstep = (size_t)HALF * K * 2;
    const size_t tstep = 2 * hstep;
    const unsigned ldsw = (unsigned)wid * 1024u;
    const int aoff = lds_byte(wr * 64 + fr, fq * 8), boff = lds_byte(wc * 32 + fr, fq * 8);
#define PG8_SA(b, h) (((b) * 2 + (h)) * HTB)
#define PG8_SB(b, h) ((4 + (b) * 2 + (h)) * HTB)
#define PG8_STAGE(bufoff, gbase, voff) do { _Pragma("unroll") for (int _i = 0; _i < 2; ++_i) \
        __builtin_amdgcn_global_load_lds((const unsigned*)((const char*)(gbase) + (voff)[_i]), (LAS unsigned*)(lds + (bufoff) + ldsw + _i * 8192), 16, 0, 0); } while (0)
#define PG8_LDA(dst, b, h) do { _Pragma("unroll") for (int m = 0; m < 4; ++m) _Pragma("unroll") for (int k = 0; k < 2; ++k) dst[m][k] = *(const LAS bf16x8*)(lds + PG8_SA(b, h) + aoff + m * 2048 + k * 1024); } while (0)
#define PG8_LDB(dst, b, h) do { _Pragma("unroll") for (int n = 0; n < 2; ++n) _Pragma("unroll") for (int k = 0; k < 2; ++k) dst[n][k] = *(const LAS bf16x8*)(lds + PG8_SB(b, h) + boff + n * 2048 + k * 1024); } while (0)
#define PG8_MMA(ai, bj, At, Bt) do { __builtin_amdgcn_s_setprio(1); _Pragma("unroll") for (int m = 0; m < 4; ++m) _Pragma("unroll") for (int n = 0; n < 2; ++n) _Pragma("unroll") for (int k = 0; k < 2; ++k) \
        acc[ai][bj][m][n] = __builtin_amdgcn_mfma_f32_16x16x32_bf16(Bt[n][k], At[m][k], acc[ai][bj][m][n], 0, 0, 0); __builtin_amdgcn_s_setprio(0); } while (0)
#define PG8_WAIT_V(n) asm volatile("s_waitcnt vmcnt(" #n ")" ::: "memory")
#define PG8_WAIT_L(n) asm volatile("s_waitcnt lgkmcnt(" #n ")" ::: "memory")
#define PG8_BAR __builtin_amdgcn_s_barrier()
#define PG8_SCHED __builtin_amdgcn_sched_barrier(0)
    Unit cur, nxt; int ui = 0;
    if (!S.next(0, cur)) return;
    f32x4 acc[2][2][4][2];
#pragma unroll
    for (int a = 0; a < 2; ++a)
#pragma unroll
        for (int b = 0; b < 2; ++b)
#pragma unroll
            for (int m = 0; m < 4; ++m)
#pragma unroll
                for (int n = 0; n < 2; ++n) acc[a][b][m][n] = (f32x4){0.f, 0.f, 0.f, 0.f};
    bf16x8 At[4][2], B0[2][2], B1[2][2];
    const char* cA = (const char*)g.A + (size_t)cur.pm * tstep; const char* cB = (const char*)g.Bt + (size_t)cur.pn * tstep;
    S.a_ready(cur);
    PG8_STAGE(PG8_SB(0, 0), cB, voffB); PG8_STAGE(PG8_SA(0, 0), cA, voffA); PG8_STAGE(PG8_SB(0, 1), cB + hstep, voffB); PG8_STAGE(PG8_SA(0, 1), cA + hstep, voffA);
    if (wr == 1) PG8_BAR;
    PG8_WAIT_V(4); PG8_BAR;
    PG8_STAGE(PG8_SB(1, 0), cB + kstep, voffB); PG8_STAGE(PG8_SA(1, 0), cA + kstep, voffA); PG8_STAGE(PG8_SB(1, 1), cB + hstep + kstep, voffB);
    PG8_WAIT_V(6); PG8_BAR;
    for (;;) {
        const bool has_next = S.next(ui + 1, nxt);
        const char* nA = has_next ? (const char*)g.A + (size_t)nxt.pm * tstep : cA; const char* nB = has_next ? (const char*)g.Bt + (size_t)nxt.pn * tstep : cB;
        for (int t = 0; t < nt; t += 2) {
            const bool last = (t == nt - 2);
            const char* a1 = cA + (size_t)(t + 1) * kstep;
            const char* a2 = last ? nA : cA + (size_t)(t + 2) * kstep; const char* b2 = last ? nB : cB + (size_t)(t + 2) * kstep;
            const char* a3 = a2 + kstep; const char* b3 = b2 + kstep;
            if (last && has_next) S.a_ready(nxt);
            PG8_LDB(B0, 0, 0); PG8_SCHED; PG8_LDA(At, 0, 0); PG8_STAGE(PG8_SA(1, 1), a1 + hstep, voffA);
            PG8_WAIT_L(8); PG8_BAR; PG8_WAIT_L(0); PG8_MMA(0, 0, At, B0); PG8_BAR; PG8_SCHED;
            PG8_LDB(B1, 0, 1); PG8_STAGE(PG8_SB(0, 0), b2, voffB);
            PG8_BAR; PG8_WAIT_L(0); PG8_MMA(0, 1, At, B1); PG8_BAR;
            PG8_LDA(At, 0, 1); PG8_STAGE(PG8_SA(0, 0), a2, voffA);
            PG8_BAR; PG8_WAIT_L(0); PG8_MMA(1, 0, At, B0); PG8_BAR; PG8_SCHED;
            PG8_STAGE(PG8_SB(0, 1), b2 + hstep, voffB);
            PG8_WAIT_V(6); PG8_BAR; PG8_MMA(1, 1, At, B1); PG8_BAR;
            PG8_LDB(B0, 1, 0); PG8_SCHED; PG8_LDA(At, 1, 0); PG8_STAGE(PG8_SA(0, 1), a2 + hstep, voffA);
            PG8_WAIT_L(8); PG8_BAR; PG8_WAIT_L(0); PG8_MMA(0, 0, At, B0); PG8_BAR; PG8_SCHED;
            PG8_LDB(B1, 1, 1); PG8_STAGE(PG8_SB(1, 0), b3, voffB);
            PG8_BAR; PG8_WAIT_L(0); PG8_MMA(0, 1, At, B1); PG8_BAR;
            PG8_LDA(At, 1, 1); PG8_STAGE(PG8_SA(1, 0), a3, voffA);
            PG8_BAR; PG8_WAIT_L(0); PG8_MMA(1, 0, At, B0); PG8_BAR; PG8_SCHED;
            PG8_STAGE(PG8_SB(1, 1), b3 + hstep, voffB);
            PG8_WAIT_V(6); PG8_BAR; PG8_MMA(1, 1, At, B1); PG8_BAR;
        }
        { int tz = threadIdx.x; asm volatile("" : "+v"(tz)); const int wz = tz >> 6, lz = tz & 63;
          E(acc, cur, wz >> 2, wz & 3, lz & 15, lz >> 4); } S.done(cur);
        if (!has_next) break;
#pragma unroll
        for (int a = 0; a < 2; ++a)
#pragma unroll
            for (int b = 0; b < 2; ++b)
#pragma unroll
                for (int m = 0; m < 4; ++m)
#pragma unroll
                    for (int n = 0; n < 2; ++n) acc[a][b][m][n] = (f32x4){0.f, 0.f, 0.f, 0.f};
        cur = nxt; cA = nA; cB = nB; ++ui;
    }
    PG8_WAIT_V(0);
    if (wr == 0) PG8_BAR;
    PG8_BAR;
#undef PG8_SA
#undef PG8_SB
#undef PG8_STAGE
#undef PG8_LDA
#undef PG8_LDB
#undef PG8_MMA
#undef PG8_WAIT_V
#undef PG8_WAIT_L
#undef PG8_BAR
#undef PG8_SCHED
}
#endif
}

constexpr int MBIG = (NP / 256) * 256;
template <class F> DEV void small_gemm(const bf16_t* A, const bf16_t* Bt, int K, unsigned char* lds, const F& f) {
    const int tid = threadIdx.x, lane = tid & 63, w = tid >> 6, g = lane >> 4, c16 = lane & 15;
    const int tiles_m = (NTOK - MBIG + 63) / 64, ntiles = tiles_m * 32, kw = K / 8;
    float* part = (float*)lds;
    for (int tl = blockIdx.x; tl < ntiles; tl += gridDim.x) {
        const int r0 = MBIG + (tl / 32) * 64, n0 = (tl % 32) * 64;
        f32x4 acc[4][4];
#pragma unroll
        for (int i = 0; i < 4; ++i)
#pragma unroll
            for (int j = 0; j < 4; ++j) acc[i][j] = (f32x4){0.f, 0.f, 0.f, 0.f};
        for (int k0 = w * kw; k0 < (w + 1) * kw; k0 += 128) {
            bf16x8 af[4][4], bfr[4][4];
#pragma unroll
            for (int u = 0; u < 4; ++u)
#pragma unroll
                for (int i = 0; i < 4; ++i) { int arow = r0 + 16 * i + c16; if (arow >= MPAD) arow = MPAD - 1;
                    af[u][i] = *(const bf16x8*)(A + (size_t)arow * K + k0 + 32 * u + 8 * g); bfr[u][i] = *(const bf16x8*)(Bt + (size_t)(n0 + 16 * i + c16) * K + k0 + 32 * u + 8 * g); }
#pragma unroll
            for (int u = 0; u < 4; ++u)
#pragma unroll
                for (int i = 0; i < 4; ++i)
#pragma unroll
                    for (int j = 0; j < 4; ++j) acc[i][j] = MFMA_BF16(af[u][i], bfr[u][j], acc[i][j]);
        }
#pragma unroll
        for (int i = 0; i < 4; ++i)
#pragma unroll
            for (int j = 0; j < 4; ++j)
#pragma unroll
                for (int r = 0; r < 4; ++r) part[(w * 64 + 16 * i + 4 * g + r) * 68 + 16 * j + c16] = acc[i][j][r];
        __syncthreads();
        {
            const int row = tid >> 3, c8 = (tid & 7) * 8; f32x4 s0 = (f32x4){0.f, 0.f, 0.f, 0.f}, s1 = s0;
#pragma unroll
            for (int ww = 0; ww < 8; ++ww) { s0 += *(const f32x4*)(part + (ww * 64 + row) * 68 + c8); s1 += *(const f32x4*)(part + (ww * 64 + row) * 68 + c8 + 4); }
            if (r0 + row < NTOK) f(r0 + row, n0 + c8, s0, s1);
        }
        __syncthreads();
    }
}
struct SmallResid { const float* xlo; const float* xhi; const bf16_t* x16; const float* gmod; bf16_t* out;
    DEV void operator()(int row, int col, f32x4 v0, f32x4 v1) const { const float* gr = gmod + (size_t)tok_batch(row) * MODW + col; f32x4 x0, x1;
        if (x16) { const u32x4 xw = *(const u32x4*)(x16 + (size_t)row * D + col); x0 = (f32x4){lo16(xw.x), hi16(xw.x), lo16(xw.y), hi16(xw.y)}; x1 = (f32x4){lo16(xw.z), hi16(xw.z), lo16(xw.w), hi16(xw.w)}; }
        else { const float* xr = (row < NP ? xlo + (size_t)row * D : xhi + (size_t)(row - NP) * D) + col; x0 = *(const f32x4*)xr; x1 = *(const f32x4*)(xr + 4); }
        const f32x4 o0 = x0 + *(const f32x4*)gr * v0, o1 = x1 + *(const f32x4*)(gr + 4) * v1;
        u32x4 ow; ow.x = pack2(o0[0], o0[1]); ow.y = pack2(o0[2], o0[3]); ow.z = pack2(o1[0], o1[1]); ow.w = pack2(o1[2], o1[3]); *(u32x4*)(out + (size_t)row * D + col) = ow; } };
struct SmallBf16 { bf16_t* out; DEV void operator()(int row, int col, f32x4 v0, f32x4 v1) const {
        u32x4 ow; ow.x = pack2(v0[0], v0[1]); ow.y = pack2(v0[2], v0[3]); ow.z = pack2(v1[0], v1[1]); ow.w = pack2(v1[2], v1[3]); *(u32x4*)(out + (size_t)row * D + col) = ow; } };
struct SmallF32 { float* out; DEV void operator()(int row, int col, f32x4 v0, f32x4 v1) const { float* o = out + (size_t)row * D + col; *(f32x4*)o = v0; *(f32x4*)(o + 4) = v1; } };

DEV void transpose_tile(const float* src, int ld_src, bf16_t* dst, int ld_dst, float* tile) {
    const int tid = threadIdx.x;
#pragma unroll
    for (int i = 0; i < 2; ++i) { const int idx = tid + i * 512, r = idx >> 4, c4 = idx & 15; const f32x4 v = *(const f32x4*)(src + (size_t)r * ld_src + c4 * 4);
        float* t = tile + r * 65 + c4 * 4; t[0] = v[0]; t[1] = v[1]; t[2] = v[2]; t[3] = v[3]; }
    __syncthreads();
    const int n = tid >> 3, kg = tid & 7; const float* t = tile + (kg * 8) * 65 + n;
    u32x4 w; w.x = pack2(t[0], t[65]); w.y = pack2(t[2 * 65], t[3 * 65]); w.z = pack2(t[4 * 65], t[5 * 65]); w.w = pack2(t[6 * 65], t[7 * 65]);
    *(u32x4*)(dst + (size_t)n * ld_dst + kg * 8) = w;
    __syncthreads();
}
constexpr int ADA_UNITS = MODW / 128, ADA_RT = (NC + 15) / 16, ADA_AS = 72;
DEV void ada_direct_unit(const Params& p, int unit, unsigned char* lds) {
    const int tid = threadIdx.x, lane = tid & 63, w = wave_id(), rho = lane & 15, gam = lane >> 4;
    const int n0 = unit * 128;
    const float* W; const float* bias; int ldw, cw;
    if (n0 < NMOD) { W = p.w_ada; bias = p.b_ada; ldw = NMOD; cw = n0; }
    else if (n0 < 2 * NMOD) { W = p.w_ada + (size_t)D * NMOD; bias = p.b_ada + NMOD; ldw = NMOD; cw = n0 - NMOD; }
    else { W = p.w_ada_final; bias = p.b_ada_final; ldw = 2 * D; cw = n0 - 2 * NMOD; }
    const float* wu = W + cw + 16 * w; const unsigned loff = (unsigned)(8 * gam * ldw + rho);
    bf16_t* As = (bf16_t*)lds;
    f32x4 acc[ADA_RT];
#pragma unroll
    for (int rt = 0; rt < ADA_RT; ++rt) acc[rt] = (f32x4){0.f, 0.f, 0.f, 0.f};
    constexpr int NCH = D / 64, ACNT = (16 * ADA_RT * 16 + 511) / 512;
    float wa[16], wb[16], wc2[16]; f32x4 cr[ACNT];
#define ADA_WLOAD(dst, kc_) do { const float* wq_ = wu + (size_t)(64 * (kc_)) * ldw; _Pragma("unroll") for (int s2 = 0; s2 < 2; ++s2) _Pragma("unroll") for (int j = 0; j < 8; ++j) dst[8 * s2 + j] = (wq_ + (size_t)(32 * s2 + j) * ldw)[loff]; } while (0)
#define ADA_CLOAD(kc_) do { _Pragma("unroll") for (int u = 0; u < ACNT; ++u) { const int i = tid + 512 * u, r = i >> 4, k4 = (i & 15) * 4; cr[u] = (f32x4){0.f, 0.f, 0.f, 0.f}; \
        if (r < NC) cr[u] = *(const f32x4*)((r < PB ? p.c_prompt + (size_t)r * D : p.c_sample + (size_t)(r - PB) * D) + 64 * (kc_) + k4); } } while (0)
#define ADA_CHUNK(wreg, kc_) do { bf16_t* Ab = As + ((kc_) & 1) * (16 * ADA_RT * ADA_AS); \
        _Pragma("unroll") for (int u = 0; u < ACNT; ++u) { const int i = tid + 512 * u, r = i >> 4, k4 = (i & 15) * 4; \
            if (i < 16 * ADA_RT * 16) { u32x2 pk; pk.x = pack2(siluf_(cr[u][0]), siluf_(cr[u][1])); pk.y = pack2(siluf_(cr[u][2]), siluf_(cr[u][3])); *(u32x2*)(Ab + r * ADA_AS + k4) = pk; } } \
        if ((kc_) + 1 < NCH) ADA_CLOAD((kc_) + 1); \
        u32x4 bw[2]; _Pragma("unroll") for (int s2 = 0; s2 < 2; ++s2) { bw[s2].x = pack2(wreg[8 * s2], wreg[8 * s2 + 1]); bw[s2].y = pack2(wreg[8 * s2 + 2], wreg[8 * s2 + 3]); bw[s2].z = pack2(wreg[8 * s2 + 4], wreg[8 * s2 + 5]); bw[s2].w = pack2(wreg[8 * s2 + 6], wreg[8 * s2 + 7]); } \
        if ((kc_) + 3 < NCH) ADA_WLOAD(wreg, (kc_) + 3); \
        __syncthreads(); \
        _Pragma("unroll") for (int s2 = 0; s2 < 2; ++s2) { const bf16x8 bf = __builtin_bit_cast(bf16x8, bw[s2]); \
            _Pragma("unroll") for (int rt = 0; rt < ADA_RT; ++rt) { const bf16x8 af = *(const bf16x8*)(Ab + (16 * rt + rho) * ADA_AS + 32 * s2 + 8 * gam); acc[rt] = MFMA_BF16(af, bf, acc[rt]); } } } while (0)
    static_assert(NCH % 3 == 2, "chunk ring");
    ADA_WLOAD(wa, 0); ADA_WLOAD(wb, 1); ADA_WLOAD(wc2, 2); ADA_CLOAD(0);
    for (int kc = 0; kc + 2 < NCH; kc += 3) { ADA_CHUNK(wa, kc); ADA_CHUNK(wb, kc + 1); ADA_CHUNK(wc2, kc + 2); }
    ADA_CHUNK(wa, NCH - 2); ADA_CHUNK(wb, NCH - 1);
#undef ADA_WLOAD
#undef ADA_CLOAD
#undef ADA_CHUNK
    const float bv = bias[cw + 16 * w + rho];
#pragma unroll
    for (int rt = 0; rt < ADA_RT; ++rt)
#pragma unroll
        for (int r = 0; r < 4; ++r) { const int row = 16 * rt + 4 * gam + r; if (row < NC) p.modbuf[(size_t)row * MODW + n0 + 16 * w + rho] = acc[rt][r] + bv; }
    __syncthreads();
}
DEV int cvt_job_tiles(int j) { const int K = j < 9 ? 2048 : 256; const int N = j < 2 ? NMOD : (j == 2 ? 2 * D : (j < 5 ? ZW : (j < 9 ? D : 256))); return (K / 64) * (N / 64); }
constexpr int TBL_SLOT = 10240, TBL_VP1 = 4 * NE - 2 * TBL_SLOT;
DEV int gemm_in_idle_blocks() { const int nwg = (MPAD / 256) * (ZW / 256), G = (int)gridDim.x, rounds = (nwg + G - 1) / G, full = nwg - (rounds - 1) * G; return G - full; }
DEV bool tbl_deferred() { return gemm_in_idle_blocks() >= 32; }
DEV void table_row_to_fp8(const Params& p, int vr, int lane) {
    const int l = vr / (2 * NE), which = (vr % (2 * NE)) / NE, e = vr % NE, rr = l * NE + e;
    const float* src = (which ? p.peer_v : p.peer_u) + (size_t)rr * D;
    f32x4 v[8];
#pragma unroll
    for (int k = 0; k < 8; ++k) v[k] = *(const f32x4*)(src + 4 * lane + 256 * k);
    unsigned char* tab = (which ? p.v8 : p.u8) + (size_t)l * NE * (D / 2);
    if (which) {
        float am = 0.f;
#pragma unroll
        for (int k = 0; k < 8; ++k) am = fmaxf(am, fmaxf(fmaxf(fabsf(v[k][0]), fabsf(v[k][1])), fmaxf(fabsf(v[k][2]), fabsf(v[k][3]))));
        am = wave_max(am);
        const float sc = am > 0.f ? 6.0f / am : 1.0f;
#pragma unroll
        for (int k = 0; k < 8; ++k) *(unsigned short*)(tab + ((size_t)k * NE + e) * 128 + 2 * lane) = (unsigned short)fp4x4_enc(v[k][0] * sc, v[k][1] * sc, v[k][2] * sc, v[k][3] * sc);
        if (lane == 0) p.sv[rr] = am > 0.f ? am * (1.0f / 6.0f) : 1.0f;
    } else {
#pragma unroll
        for (int k = 0; k < 8; ++k) {
            const float am = wave_max(fmaxf(fmaxf(fabsf(v[k][0]), fabsf(v[k][1])), fmaxf(fabsf(v[k][2]), fabsf(v[k][3]))));
            const float sc = am > 0.f ? 7.0f / am : 1.0f;
            unsigned nb = 0u;
#pragma unroll
            for (int j = 0; j < 4; ++j) { int q = (int)rintf(v[k][j] * sc); q = q > 7 ? 7 : (q < -7 ? -7 : q); nb |= ((unsigned)q & 15u) << (4 * j); }
            *(unsigned short*)(tab + ((size_t)k * NE + e) * 128 + 2 * lane) = (unsigned short)nb;
            if (lane == 0) p.su[(size_t)rr * 8 + k] = am > 0.f ? am * (1.0f / 7.0f) : 1.0f;
        }
    }
}
DEV void phase_tbl_slot(const Params& p, int l) {
    const int idle = gemm_in_idle_blocks(), first = (int)gridDim.x - idle;
    if (idle < 32 || (int)blockIdx.x < first) return;
    const int gw = ((int)blockIdx.x - first) * 8 + wave_id(), nw = idle * 8, lo = TBL_VP1 + l * TBL_SLOT;
    for (int vr = lo + gw; vr < lo + TBL_SLOT; vr += nw) table_row_to_fp8(p, vr, threadIdx.x & 63);
}
DEV void phase_convert(const Params& p, unsigned char* lds, int part) {
    float* tile = (float*)lds;
    const int tid = threadIdx.x;
    const int q_lo = part == 0 ? 0 : 3, q_hi = part == 0 ? 3 : 17;
    int total = 0;
#pragma unroll
    for (int q = 0; q < 17; ++q) if (q >= q_lo && q < q_hi) total += cvt_job_tiles(q);
    for (int tl = blockIdx.x; tl < total; tl += gridDim.x) {
        int j = 0, loc = 0, base = 0;
#pragma unroll
        for (int q = 0; q < 17; ++q) if (q >= q_lo && q < q_hi) { const int cnt = cvt_job_tiles(q); if (tl >= base && tl < base + cnt) { j = q; loc = tl - base; } base += cnt; }
        const float* src; bf16_t* dst; int K = 2048, N;
        if (j < 2) { N = NMOD; src = p.w_ada + (size_t)j * 2048 * NMOD; dst = p.wt_ada + (size_t)j * NMOD * 2048; }
        else if (j == 2) { N = 2 * D; src = p.w_ada_final; dst = p.wt_ada + (size_t)2 * NMOD * 2048; }
        else if (j < 5) { N = ZW; src = p.w_in + (size_t)(j - 3) * 2048 * ZW; dst = p.wt_in + (size_t)(j - 3) * ZW * 2048; }
        else if (j < 7) { N = D; src = p.w_out + (size_t)(j - 5) * D * D; dst = p.wt_out + (size_t)(j - 5) * D * D; }
        else if (j < 9) { N = D; src = p.peer_wq + (size_t)(j - 7) * D * D; dst = p.wt_q + (size_t)(j - 7) * D * D; }
        else { K = 256; N = 256; src = p.pool_w + (size_t)(j - 9) * 65536; dst = p.wt_pool + (size_t)(j - 9) * 65536; }
        const int ntn = N / 64, kt = loc / ntn, nt = loc % ntn;
        transpose_tile(src + (size_t)kt * 64 * N + nt * 64, N, dst + (size_t)nt * 64 * K + kt * 64, K, tile);
    }
    const size_t gt = (size_t)blockIdx.x * 512 + tid, gs = (size_t)gridDim.x * 512;
    if (part == 1) {
        constexpr int NADA = ADA_UNITS;
        const int vend = tbl_deferred() ? TBL_VP1 : 4 * NE, R1 = vend - 2048;
        const bool uneven = (int)gridDim.x > NADA + 16;
        for (int seg = 0; seg < 2; ++seg) {
            int gw, nw, r_lo, r_hi;
            if (!uneven) { if (seg) break; gw = blockIdx.x * 8 + wave_id(); nw = gridDim.x * 8; r_lo = 0; r_hi = vend; }
            else if (seg == 0) { gw = blockIdx.x * 8 + wave_id(); nw = gridDim.x * 8; r_lo = 0; r_hi = R1; }
            else { if ((int)blockIdx.x < NADA) break; gw = ((int)blockIdx.x - NADA) * 8 + wave_id(); nw = ((int)gridDim.x - NADA) * 8; r_lo = R1; r_hi = vend; }
            for (int vr = r_lo + gw; vr < r_hi; vr += nw) table_row_to_fp8(p, vr, tid & 63);
        }
    }
    if (part == 0) for (size_t i = gt; i < (size_t)256 * D / 8; i += gs) {
        const int row = (int)(i / (D / 8)), c8 = (int)(i % (D / 8)) * 8; u32x4 w = (u32x4){0u, 0u, 0u, 0u};
        if (row < NC) { const float* s = (row < PB ? p.c_prompt + (size_t)row * D : p.c_sample + (size_t)(row - PB) * D) + c8;
            const f32x4 a = *(const f32x4*)s, b = *(const f32x4*)(s + 4);
            w.x = pack2(siluf_(a[0]), siluf_(a[1])); w.y = pack2(siluf_(a[2]), siluf_(a[3])); w.z = pack2(siluf_(b[0]), siluf_(b[1])); w.w = pack2(siluf_(b[2]), siluf_(b[3])); }
        *(u32x4*)(p.csil + i * 8) = w;
    }
}

DEV void phase_norm(const Params& p, const float* xlo, const float* xhi, const bf16_t* x16, const float* gn, int sh_off, int sc_off, bf16_t* obf, float* of32, unsigned* hd, float* hs) {
    const int lane = threadIdx.x & 63, tpw = (NTOK + (int)gridDim.x - 1) / (int)gridDim.x, t_lo = (int)blockIdx.x * tpw, t_hi = t_lo + tpw < NTOK ? t_lo + tpw : NTOK, gw = t_lo + wave_id();
    u32x4 nb[4]; f32x4 nf[8];
#define NORM_LOAD(tt) do { const int t_ = (tt); \
        if (x16) { _Pragma("unroll") for (int c = 0; c < 4; ++c) nb[c] = *(const u32x4*)(x16 + (size_t)t_ * D + c * 512 + lane * 8); } \
        else { const float* xr_ = t_ < NP ? xlo + (size_t)t_ * D : xhi + (size_t)(t_ - NP) * D; \
            _Pragma("unroll") for (int c = 0; c < 4; ++c) { nf[2 * c] = *(const f32x4*)(xr_ + c * 512 + lane * 8); nf[2 * c + 1] = *(const f32x4*)(xr_ + c * 512 + lane * 8 + 4); } } } while (0)
    NORM_LOAD(gw < NTOK ? gw : NTOK - 1);
    for (int t = gw; t < t_hi; t += 8) {
        const float* mrow = p.modbuf + (size_t)tok_batch(t) * MODW;
        f32x4 v[8]; float ss = 0.f;
#pragma unroll
        for (int c = 0; c < 4; ++c) {
            if (x16) { const u32x4 xw = nb[c]; v[2 * c] = (f32x4){lo16(xw.x), hi16(xw.x), lo16(xw.y), hi16(xw.y)}; v[2 * c + 1] = (f32x4){lo16(xw.z), hi16(xw.z), lo16(xw.w), hi16(xw.w)}; }
            else { v[2 * c] = nf[2 * c]; v[2 * c + 1] = nf[2 * c + 1]; } }
        NORM_LOAD(t + 8 < t_hi ? t + 8 : t);
#pragma unroll
        for (int c = 0; c < 4; ++c)
#pragma unroll
            for (int j = 0; j < 4; ++j) ss += v[2 * c][j] * v[2 * c][j] + v[2 * c + 1][j] * v[2 * c + 1][j];
        ss = wave_sum(ss);
        const float rstd = rsqrtf(ss * (1.0f / D) + EPS);
#pragma unroll
        for (int c = 0; c < 4; ++c) { const int col = c * 512 + lane * 8; f32x4 y[2];
#pragma unroll
            for (int q = 0; q < 2; ++q) { const f32x4 g4 = *(const f32x4*)(gn + col + 4 * q), sc = *(const f32x4*)(mrow + sc_off + col + 4 * q), sh = *(const f32x4*)(mrow + sh_off + col + 4 * q);
                y[q] = (v[2 * c + q] * rstd) * g4 * (sc + 1.0f) + sh; }
            if (obf) { u32x4 w; w.x = pack2(y[0][0], y[0][1]); w.y = pack2(y[0][2], y[0][3]); w.z = pack2(y[1][0], y[1][1]); w.w = pack2(y[1][2], y[1][3]); *(u32x4*)(obf + (size_t)t * D + col) = w; }
            else { *(f32x4*)(of32 + (size_t)t * D + col) = y[0]; *(f32x4*)(of32 + (size_t)t * D + col + 4) = y[1]; }
            if (hd) {
                float am = fmaxf(fmaxf(fmaxf(fabsf(y[0][0]), fabsf(y[0][1])), fmaxf(fabsf(y[0][2]), fabsf(y[0][3]))), fmaxf(fmaxf(fabsf(y[1][0]), fabsf(y[1][1])), fmaxf(fabsf(y[1][2]), fabsf(y[1][3]))));
                am = fmaxf(am, DPP_XOR1(am)); am = fmaxf(am, DPP_XOR2(am));
                const float sc = am > 0.f ? 119.0f / am : 1.0f; unsigned w1 = 0u, w0 = 0u;
#pragma unroll
                for (int jj = 0; jj < 8; ++jj) { const int hq = (int)rintf(y[jj >> 2][jj & 3] * sc), d1 = (hq + 8) >> 4, d0 = hq - 16 * d1; w1 |= ((unsigned)d1 & 15u) << (4 * jj); w0 |= ((unsigned)d0 & 15u) << (4 * jj); }
                const size_t blk = (size_t)t * 64 + c * 16 + (lane >> 2);
                hd[blk * 8 + (lane & 3)] = w1; hd[blk * 8 + 4 + (lane & 3)] = w0;
                if ((lane & 3) == 0) hs[blk] = am > 0.f ? am * (1.0f / 119.0f) : 1.0f; }
        }
    }
}

#undef NORM_LOAD
namespace hg {
constexpr int QS = 136, VS = 72;
constexpr int O_QT = 0, O_QH = O_QT + 64 * QS * 2, O_KT = O_QH + 64 * QS * 2, O_KDT = O_KT + 160 * QS * 2, O_VT = O_KDT + 128 * VS * 2,
              O_AB = O_VT + 128 * VS * 2, O_GS = O_AB + 64 * VS * 2, O_END = O_GS + 4 * 128 * 4;
constexpr int OS = 132;
static_assert(O_END <= 163840 - 64, "HGRN LDS layout too large");
constexpr int NCHUNK = SEQ / 64, NUNIT = PB * HH * NCHUNK;
}
DEV int kt_rowbase(int i) { return i == 0 ? 0 : (i == 1 ? 16 : (i == 2 ? 48 : 96)); }

DEV void hgrn_pre_unit(const Params& p, int l, int unit, unsigned char* lds) {
    using namespace hg;
    const int tid = threadIdx.x, lane = tid & 63, w = tid >> 6, g = lane >> 4, c16 = lane & 15;
    const int c = unit % NCHUNK, bh = unit / NCHUNK, b = bh / HH, h = bh % HH;
    bf16_t* Qt = (bf16_t*)(lds + O_QT); bf16_t* Qh = (bf16_t*)(lds + O_QH); bf16_t* Kt = (bf16_t*)(lds + O_KT);
    bf16_t* Kdt = (bf16_t*)(lds + O_KDT); bf16_t* Vt = (bf16_t*)(lds + O_VT); bf16_t* Ab = (bf16_t*)(lds + O_AB); float* Gs = (float*)(lds + O_GS);
    const int kk = tid & 127, sj = tid >> 7;
    float lbv = 0.f;
    if (l > 0) lbv = sigmoidf_(p.lb_logits[HH * HD + h * HD + kk] - p.lb_logits[h * HD + kk]);
    const float oml = 1.0f - lbv;
    for (int i = tid; i < 64 * VS / 2; i += 512) ((unsigned*)Ab)[i] = 0u;
    const size_t row0 = (size_t)b * SEQ + c * 64;
    float Gl[16], qv[16], kv[16];
    {
        const bf16_t* zr = p.z + (row0 + sj * 16) * ZW + h * HD + kk;
        unsigned short zq16[16], zf16[16], zi16[16];
#pragma unroll
        for (int s = 0; s < 16; ++s) { zq16[s] = zr[(size_t)s * ZW]; zf16[s] = zr[(size_t)s * ZW + 1024]; zi16[s] = zr[(size_t)s * ZW + 2048]; }
        float run = 0.f; unsigned vpk[8];
#pragma unroll
        for (int s = 0; s < 16; ++s) {
            const float zq = bf2f(zq16[s]), zf = fminf(fmaxf(bf2f(zf16[s]), -80.f), 80.f);
            const float e = __expf(-zf), sg = 1.0f / (1.0f + e);
            const float f = lbv + oml * sg;
            run += __logf(f); Gl[s] = run;
            kv[s] = oml * (e * sg);
            qv[s] = siluf_(zq);
            if (s & 1) vpk[s >> 1] |= (unsigned)zi16[s] << 16; else vpk[s >> 1] = zi16[s];
        }
        Gs[sj * 128 + kk] = run;
        *(u32x4*)(Vt + kk * VS + sj * 16) = (u32x4){vpk[0], vpk[1], vpk[2], vpk[3]}; *(u32x4*)(Vt + kk * VS + sj * 16 + 8) = (u32x4){vpk[4], vpk[5], vpk[6], vpk[7]};
    }
    __syncthreads();
    float Gend;
    {
        const float g0 = Gs[kk], g1 = Gs[128 + kk], g2 = Gs[256 + kk], g3 = Gs[384 + kk];
        float Gb[4]; Gb[0] = 0.f; Gb[1] = g0; Gb[2] = g0 + g1; Gb[3] = g0 + g1 + g2; Gend = Gb[3] + g3;
        const float Gbj = sj == 0 ? Gb[0] : (sj == 1 ? Gb[1] : (sj == 2 ? Gb[2] : Gb[3]));
        const float eGb = __expf(Gbj);
        unsigned kd[8]; unsigned qh[8];
#pragma unroll
        for (int s = 0; s < 16; ++s) {
            const int t = sj * 16 + s;
            const float q1 = qv[s] * __expf(Gl[s]);
            Qt[t * QS + kk] = (bf16_t)f2bf(q1);
            const unsigned qhv = f2bf(q1 * eGb);
            Qh[t * QS + kk] = (bf16_t)qhv;
#pragma unroll
            for (int i = 0; i < 4; ++i) if (i >= sj) Kt[(kt_rowbase(i) + t) * QS + kk] = (bf16_t)f2bf(kv[s] * __expf(fminf(Gb[i] - Gbj - Gl[s], 60.f)));
            const unsigned kdv = f2bf(kv[s] * __expf(Gend - Gbj - Gl[s]));
            if (s & 1) kd[s >> 1] |= kdv << 16; else kd[s >> 1] = kdv;
        }
        *(u32x4*)(Kdt + kk * VS + sj * 16) = (u32x4){kd[0], kd[1], kd[2], kd[3]}; *(u32x4*)(Kdt + kk * VS + sj * 16 + 8) = (u32x4){kd[4], kd[5], kd[6], kd[7]};
        if (sj == 0) p.hg_gam[(size_t)unit * HD + kk] = __expf(Gend);
    }
    __syncthreads();
    {
        const int t = tid >> 3, part = tid & 7;
        const u32x4 a = *(const u32x4*)(Qh + t * QS + 16 * part), b2 = *(const u32x4*)(Qh + t * QS + 16 * part + 8);
        bf16_t* dst = p.hg_qh + (row0 + t) * 1024 + h * HD + 16 * part; *(u32x4*)dst = a; *(u32x4*)(dst + 8) = b2;
    }
    for (int blk = w; blk < 10; blk += 8) {
        int bi, bjj;
        if (blk == 0) { bi = 0; bjj = 0; } else if (blk < 3) { bi = 1; bjj = blk - 1; } else if (blk < 6) { bi = 2; bjj = blk - 3; } else { bi = 3; bjj = blk - 6; }
        f32x4 acc = (f32x4){0.f, 0.f, 0.f, 0.f};
#pragma unroll
        for (int ks = 0; ks < 4; ++ks) {
            const bf16x8 a = *(const bf16x8*)(Qt + (16 * bi + c16) * QS + 32 * ks + 8 * g);
            const bf16x8 bb = *(const bf16x8*)(Kt + (kt_rowbase(bi) + 16 * bjj + c16) * QS + 32 * ks + 8 * g);
            acc = MFMA_BF16(a, bb, acc);
        }
#pragma unroll
        for (int r = 0; r < 4; ++r) { const int tl = 4 * g + r; float v = acc[r]; if (bi == bjj && c16 > tl) v = 0.f; Ab[(16 * bi + tl) * VS + 16 * bjj + c16] = (bf16_t)f2bf(v); }
    }
    __syncthreads();
    {
        u32x2* oin = (u32x2*)(p.hg_oin + (size_t)unit * 64 * 128);
#pragma unroll
        for (int tt = 0; tt < 4; ++tt) {
            f32x4 acc = (f32x4){0.f, 0.f, 0.f, 0.f};
#pragma unroll
            for (int ks = 0; ks < 2; ++ks) {
                const bf16x8 a = *(const bf16x8*)(Ab + (16 * tt + c16) * VS + 32 * ks + 8 * g);
                const bf16x8 bb = *(const bf16x8*)(Vt + (16 * w + c16) * VS + 32 * ks + 8 * g);
                acc = MFMA_BF16(a, bb, acc);
            }
            oin[(tt * 8 + w) * 64 + lane] = (u32x2){pack2(acc[0], acc[1]), pack2(acc[2], acc[3])};
        }
        u32x2* ds = (u32x2*)(p.hg_ds + (size_t)unit * 128 * 128);
#pragma unroll
        for (int vt = 0; vt < 8; ++vt) {
            f32x4 acc = (f32x4){0.f, 0.f, 0.f, 0.f};
#pragma unroll
            for (int ks = 0; ks < 2; ++ks) {
                const bf16x8 a = *(const bf16x8*)(Kdt + (16 * w + c16) * VS + 32 * ks + 8 * g);
                const bf16x8 bb = *(const bf16x8*)(Vt + (16 * vt + c16) * VS + 32 * ks + 8 * g);
                acc = MFMA_BF16(a, bb, acc);
            }
            ds[(w * 8 + vt) * 64 + lane] = (u32x2){pack2(acc[0], acc[1]), pack2(acc[2], acc[3])};
        }
    }
    __syncthreads();
}

DEV void hgrn_scan_unit(const Params& p, int l, int su) {
    using namespace hg;
    const int tid = threadIdx.x, lane = tid & 63, w = tid >> 6, g = lane >> 4, c16 = lane & 15;
    const int vt = su % 8, bh = su / 8, b = bh / HH, h = bh % HH;
    f32x4 S = (f32x4){0.f, 0.f, 0.f, 0.f};
    constexpr int CB = NCHUNK < 16 ? NCHUNK : 16;
    static_assert(NCHUNK % CB == 0, "chunk batch");
    for (int c0 = 0; c0 < NCHUNK; c0 += CB) {
        u32x2 dw[CB]; f32x4 gm[CB];
#pragma unroll
        for (int i = 0; i < CB; ++i) { const size_t unit = (size_t)bh * NCHUNK + c0 + i;
            dw[i] = ((const u32x2*)(p.hg_ds + unit * 128 * 128))[(w * 8 + vt) * 64 + lane]; gm[i] = *(const f32x4*)(p.hg_gam + unit * HD + 16 * w + 4 * g); }
#pragma unroll
        for (int i = 0; i < CB; ++i) { const size_t unit = (size_t)bh * NCHUNK + c0 + i;
            u32x2 sw; sw.x = pack2(S[0], S[1]); sw.y = pack2(S[2], S[3]);
            *(u32x2*)(p.hg_sc + (unit * 128 + 16 * vt + c16) * 128 + 16 * w + 4 * g) = sw;
            const f32x4 d = (f32x4){lo16(dw[i].x), hi16(dw[i].x), lo16(dw[i].y), hi16(dw[i].y)};
            S = S * gm[i] + d; }
    }
    float* so = p.out + OFF_HP + ((size_t)(l * PB + b) * HH + h) * HD * HD;
#pragma unroll
    for (int r = 0; r < 4; ++r) so[(size_t)(16 * w + 4 * g + r) * HD + 16 * vt + c16] = S[r];
}

DEV void hgrn_post_unit(const Params& p, int l, int unit, unsigned char* lds) {
    using namespace hg;
    const int tid = threadIdx.x, lane = tid & 63, w = tid >> 6, g = lane >> 4, c16 = lane & 15;
    const int c = unit % NCHUNK, bh = unit / NCHUNK, b = bh / HH, h = bh % HH;
    float* Ob = (float*)lds;
    const size_t row0 = (size_t)b * SEQ + c * 64;
    const u32x2* oin = (const u32x2*)(p.hg_oin + (size_t)unit * 64 * 128);
    u32x2 ow[4];
#pragma unroll
    for (int tt = 0; tt < 4; ++tt) ow[tt] = oin[(tt * 8 + w) * 64 + lane];
    bf16x8 bfr[4], af[4][4];
    if (c > 0) {
#pragma unroll
        for (int ks = 0; ks < 4; ++ks) bfr[ks] = *(const bf16x8*)(p.hg_sc + ((size_t)unit * 128 + 16 * w + c16) * 128 + 32 * ks + 8 * g);
#pragma unroll
        for (int tt = 0; tt < 4; ++tt)
#pragma unroll
            for (int ks = 0; ks < 4; ++ks) af[tt][ks] = *(const bf16x8*)(p.hg_qh + (row0 + 16 * tt + c16) * 1024 + h * HD + 32 * ks + 8 * g);
    }
    const bf16_t* zgp = p.z + (row0 + (tid >> 3)) * ZW + 3072 + h * HD + 16 * (tid & 7);
    const u32x4 za = *(const u32x4*)zgp, zc = *(const u32x4*)(zgp + 8);
    f32x4 acc[4];
#pragma unroll
    for (int tt = 0; tt < 4; ++tt) acc[tt] = (f32x4){lo16(ow[tt].x), hi16(ow[tt].x), lo16(ow[tt].y), hi16(ow[tt].y)};
    if (c > 0) {
#pragma unroll
        for (int tt = 0; tt < 4; ++tt)
#pragma unroll
            for (int ks = 0; ks < 4; ++ks) acc[tt] = MFMA_BF16(af[tt][ks], bfr[ks], acc[tt]);
    }
#pragma unroll
    for (int tt = 0; tt < 4; ++tt)
#pragma unroll
        for (int r = 0; r < 4; ++r) Ob[(16 * tt + 4 * g + r) * OS + 16 * w + c16] = acc[tt][r];
    __syncthreads();
    {
        const int t = tid >> 3, part = tid & 7; const size_t row = row0 + t;
        float ov[16]; float ss = 0.f;
#pragma unroll
        for (int q = 0; q < 4; ++q) { const f32x4 x = *(const f32x4*)(Ob + t * OS + 16 * part + 4 * q); ov[4 * q] = x[0]; ov[4 * q + 1] = x[1]; ov[4 * q + 2] = x[2]; ov[4 * q + 3] = x[3];
            ss += x[0] * x[0] + x[1] * x[1] + x[2] * x[2] + x[3] * x[3]; }
        ss += __shfl_xor(ss, 1); ss += __shfl_xor(ss, 2); ss += __shfl_xor(ss, 4);
        const float rstd = rsqrtf(ss * (1.0f / HD) + EPS);
        const unsigned zw[8] = {za.x, za.y, za.z, za.w, zc.x, zc.y, zc.z, zc.w};
        const float* gn = p.hgrn_norm_g + l * HD + 16 * part;
        unsigned ow[8];
#pragma unroll
        for (int q = 0; q < 8; ++q) { const float a0 = ov[2 * q] * rstd * gn[2 * q] * siluf_(lo16(zw[q])), a1 = ov[2 * q + 1] * rstd * gn[2 * q + 1] * siluf_(hi16(zw[q])); ow[q] = pack2(a0, a1); }
        bf16_t* dst = p.cat + row * D + h * HD + 16 * part;
        *(u32x4*)dst = (u32x4){ow[0], ow[1], ow[2], ow[3]}; *(u32x4*)(dst + 8) = (u32x4){ow[4], ow[5], ow[6], ow[7]};
    }
    __syncthreads();
}

DEV void hgrn_sample_unit(const Params& p, int l, int unit, unsigned char* lds) {
    const int tid = threadIdx.x, lane = tid & 63, w = tid >> 6;
    const int b = unit / HH, h = unit % HH;
    float* fS = (float*)lds; float* kS = fS + 512; float* qS = kS + 512; float* vS = qS + 512; float* red = vS + 512; float* part = red + 4 * 4 * 128;
    const int r0 = NP + b * DSEQ;
    {
        const int t = tid >> 7, kk = tid & 127; const bf16_t* zr = p.z + (size_t)(r0 + t) * ZW + h * HD + kk;
        float lbv = 0.f; if (l > 0) lbv = sigmoidf_(p.lb_logits[HH * HD + h * HD + kk] - p.lb_logits[h * HD + kk]);
        const float zq = bf2f(zr[0]), zf = fminf(fmaxf(bf2f(zr[1024]), -80.f), 80.f), zi = bf2f(zr[2048]);
        const float e = __expf(-zf), sg = 1.0f / (1.0f + e);
        fS[tid] = lbv + (1.0f - lbv) * sg; kS[tid] = (1.0f - lbv) * (e * sg); qS[tid] = siluf_(zq); vS[tid] = zi;
    }
    const int v = tid & 127, kq = tid >> 7;
    const float* s0 = p.state_hgrn + ((size_t)(l * DB + b) * HH + h) * HD * HD + (size_t)(32 * kq) * HD + v;
    float S[32];
#pragma unroll
    for (int i = 0; i < 32; ++i) S[i] = s0[(size_t)i * HD];
    __syncthreads();
#pragma unroll
    for (int t = 0; t < 4; ++t) {
        const float vv = vS[t * 128 + v]; float po = 0.f;
#pragma unroll
        for (int i = 0; i < 32; ++i) { const int kk = t * 128 + 32 * kq + i; S[i] = fS[kk] * S[i] + kS[kk] * vv; po += qS[kk] * S[i]; }
        red[(t * 4 + kq) * 128 + v] = po;
    }
    float* so = p.out + OFF_HS + ((size_t)(l * DB + b) * HH + h) * HD * HD + (size_t)(32 * kq) * HD + v;
#pragma unroll
    for (int i = 0; i < 32; ++i) so[(size_t)i * HD] = S[i];
    __syncthreads();
    {
        const int t = tid >> 7; const float o = red[(t * 4 + 0) * 128 + v] + red[(t * 4 + 1) * 128 + v] + red[(t * 4 + 2) * 128 + v] + red[(t * 4 + 3) * 128 + v];
        const float ss = wave_sum(o * o);
        if (lane == 0) part[w] = ss;
        __syncthreads();
        const float tot = part[2 * t] + part[2 * t + 1];
        const float rstd = rsqrtf(tot * (1.0f / HD) + EPS);
        const float zg = bf2f(p.z[(size_t)(r0 + t) * ZW + 3072 + h * HD + v]);
        p.cat[(size_t)(r0 + t) * D + h * HD + v] = (bf16_t)f2bf(o * rstd * p.hgrn_norm_g[l * HD + v] * siluf_(zg));
    }
    __syncthreads();
}

DEV void pool_pre_unit(const Params& p, int l, int unit) {
    const int tid = threadIdx.x, tk = tid >> 7, cg = tid & 127, c = cg * 8, gi = cg >> 5, wnd = 2 << gi;
    const int r = unit * 4 + tk;
    if (r >= NTOK) return;
    f32x2 sum[4] = {{0.f, 0.f}, {0.f, 0.f}, {0.f, 0.f}, {0.f, 0.f}}; float cur[8];
    float cnt;
    if (r < NP) {
        const int t = r % SEQ; const int n = (wnd < t + 1) ? wnd : (t + 1); cnt = (float)n;
        u32x4 q[16];
#pragma unroll
        for (int j = 0; j < 16; ++j) q[j] = (j < n) ? *(const u32x4*)(p.z + (size_t)(r - j) * ZW + 4096 + c) : (u32x4){0u, 0u, 0u, 0u};
#pragma unroll
        for (int j = 0; j < 16; ++j) { sum[0] += (f32x2){lo16(q[j].x), hi16(q[j].x)}; sum[1] += (f32x2){lo16(q[j].y), hi16(q[j].y)}; sum[2] += (f32x2){lo16(q[j].z), hi16(q[j].z)}; sum[3] += (f32x2){lo16(q[j].w), hi16(q[j].w)}; }
        cur[0] = lo16(q[0].x); cur[1] = hi16(q[0].x); cur[2] = lo16(q[0].y); cur[3] = hi16(q[0].y); cur[4] = lo16(q[0].z); cur[5] = hi16(q[0].z); cur[6] = lo16(q[0].w); cur[7] = hi16(q[0].w);
        if (t >= SEQ - PBUF) { float* o = p.out + OFF_PP + ((size_t)(l * PB + r / SEQ) * PBUF + (t - (SEQ - PBUF))) * PW + c;
            *(f32x4*)o = (f32x4){cur[0], cur[1], cur[2], cur[3]}; *(f32x4*)(o + 4) = (f32x4){cur[4], cur[5], cur[6], cur[7]}; }
    } else {
        const int bb = (r - NP) / DSEQ, t = (r - NP) % DSEQ; cnt = (float)wnd;
        const float* sp = p.state_pool + (size_t)(l * DB + bb) * PBUF * PW + c;
        u32x4 q[4]; f32x4 sa[15], sb[15];
#pragma unroll
        for (int j = 0; j < 4; ++j) q[j] = (j <= t && j < wnd) ? *(const u32x4*)(p.z + (size_t)(NP + bb * DSEQ + t - j) * ZW + 4096 + c) : (u32x4){0u, 0u, 0u, 0u};
#pragma unroll
        for (int j = 1; j < 16; ++j) {
            const int back = j - t;
            const bool use = (back >= 1) && (j < wnd);
            const float* srow = sp + (size_t)(PBUF - (use ? back : 1)) * PW;
            sa[j - 1] = use ? *(const f32x4*)srow : (f32x4){0.f, 0.f, 0.f, 0.f}; sb[j - 1] = use ? *(const f32x4*)(srow + 4) : (f32x4){0.f, 0.f, 0.f, 0.f};
        }
#pragma unroll
        for (int j = 0; j < 4; ++j) { sum[0] += (f32x2){lo16(q[j].x), hi16(q[j].x)}; sum[1] += (f32x2){lo16(q[j].y), hi16(q[j].y)}; sum[2] += (f32x2){lo16(q[j].z), hi16(q[j].z)}; sum[3] += (f32x2){lo16(q[j].w), hi16(q[j].w)}; }
#pragma unroll
        for (int j = 0; j < 15; ++j) { sum[0] += (f32x2){sa[j][0], sa[j][1]}; sum[1] += (f32x2){sa[j][2], sa[j][3]}; sum[2] += (f32x2){sb[j][0], sb[j][1]}; sum[3] += (f32x2){sb[j][2], sb[j][3]}; }
        cur[0] = lo16(q[0].x); cur[1] = hi16(q[0].x); cur[2] = lo16(q[0].y); cur[3] = hi16(q[0].y); cur[4] = lo16(q[0].z); cur[5] = hi16(q[0].z); cur[6] = lo16(q[0].w); cur[7] = hi16(q[0].w);
        float* ob = p.out + OFF_PS + (size_t)(l * DB + bb) * PBUF * PW + c;
        { float* o = ob + (size_t)(11 + t) * PW; *(f32x4*)o = (f32x4){cur[0], cur[1], cur[2], cur[3]}; *(f32x4*)(o + 4) = (f32x4){cur[4], cur[5], cur[6], cur[7]}; }
        for (int i = t; i < 11; i += 4) { const float* s2 = sp + (size_t)(4 + i) * PW; float* o = ob + (size_t)i * PW; *(f32x4*)o = *(const f32x4*)s2; *(f32x4*)(o + 4) = *(const f32x4*)(s2 + 4); }
    }
    const float inv = 1.0f / cnt;
    u32x4 w; w.x = pack2(sum[0][0] * inv - cur[0], sum[0][1] * inv - cur[1]); w.y = pack2(sum[1][0] * inv - cur[2], sum[1][1] * inv - cur[3]);
    w.z = pack2(sum[2][0] * inv - cur[4], sum[2][1] * inv - cur[5]); w.w = pack2(sum[3][0] * inv - cur[6], sum[3][1] * inv - cur[7]);
    *(u32x4*)(p.pooled + ((size_t)gi * MPAD + r) * 256 + (c & 255)) = w;
}

template <int W> DEV void pool_quad(const Params& p, int l, int r0, int gi, int c) {
    const int t0 = r0 % SEQ;
    u32x4 q[W + 3];
#pragma unroll
    for (int k = 0; k < W + 3; ++k) q[k] = (t0 + 3 - k >= 0) ? *(const u32x4*)(p.z + (size_t)(r0 + 3 - k) * ZW + 4096 + c) : (u32x4){0u, 0u, 0u, 0u};
    f32x2 sum[4] = {{0.f, 0.f}, {0.f, 0.f}, {0.f, 0.f}, {0.f, 0.f}};
#pragma unroll
    for (int k = 3; k < W + 3; ++k) { sum[0] += (f32x2){lo16(q[k].x), hi16(q[k].x)}; sum[1] += (f32x2){lo16(q[k].y), hi16(q[k].y)}; sum[2] += (f32x2){lo16(q[k].z), hi16(q[k].z)}; sum[3] += (f32x2){lo16(q[k].w), hi16(q[k].w)}; }
#pragma unroll
    for (int i = 0; i < 4; ++i) {
        if (i > 0) {
            const u32x4 a = q[3 - i], b = q[3 - i + W];
            sum[0] += (f32x2){lo16(a.x), hi16(a.x)} - (f32x2){lo16(b.x), hi16(b.x)}; sum[1] += (f32x2){lo16(a.y), hi16(a.y)} - (f32x2){lo16(b.y), hi16(b.y)};
            sum[2] += (f32x2){lo16(a.z), hi16(a.z)} - (f32x2){lo16(b.z), hi16(b.z)}; sum[3] += (f32x2){lo16(a.w), hi16(a.w)} - (f32x2){lo16(b.w), hi16(b.w)};
        }
        const u32x4 cq = q[3 - i];
        const float cur[8] = {lo16(cq.x), hi16(cq.x), lo16(cq.y), hi16(cq.y), lo16(cq.z), hi16(cq.z), lo16(cq.w), hi16(cq.w)};
        const int r = r0 + i, t = t0 + i, n = W < t + 1 ? W : t + 1; const float inv = 1.0f / (float)n;
        if (t >= SEQ - PBUF) { float* o = p.out + OFF_PP + ((size_t)(l * PB + r / SEQ) * PBUF + (t - (SEQ - PBUF))) * PW + c;
            *(f32x4*)o = (f32x4){cur[0], cur[1], cur[2], cur[3]}; *(f32x4*)(o + 4) = (f32x4){cur[4], cur[5], cur[6], cur[7]}; }
        u32x4 w; w.x = pack2(sum[0][0] * inv - cur[0], sum[0][1] * inv - cur[1]); w.y = pack2(sum[1][0] * inv - cur[2], sum[1][1] * inv - cur[3]);
        w.z = pack2(sum[2][0] * inv - cur[4], sum[2][1] * inv - cur[5]); w.w = pack2(sum[3][0] * inv - cur[6], sum[3][1] * inv - cur[7]);
        *(u32x4*)(p.pooled + ((size_t)gi * MPAD + r) * 256 + (c & 255)) = w;
    }
}
DEV void pool_tile16(const Params& p, int l, int unit) {
    const int lane = threadIdx.x & 63, w8 = wave_id(), gi = w8 & 3, tk = ((w8 >> 2) << 1) | (lane >> 5), c = (gi * 32 + (lane & 31)) * 8;
    const int r0 = unit * 16 + tk * 4;
    if (gi == 0) pool_quad<2>(p, l, r0, 0, c); else if (gi == 1) pool_quad<4>(p, l, r0, 1, c); else if (gi == 2) pool_quad<8>(p, l, r0, 2, c); else pool_quad<16>(p, l, r0, 3, c);
}

#ifndef PROBE_SUB
#define PROBE_SUB 0
#endif
DEV void phase_mix1(const Params& p, int l, unsigned char* lds) {
    const bool odd = (blockIdx.x & 1u) != 0u;
    for (int s = 0; s < 2; ++s) {
        if ((s == 0) != odd) { for (int u = blockIdx.x; u < hg::NUNIT; u += gridDim.x) hgrn_pre_unit(p, l, u, lds); }
        else { for (int u = blockIdx.x; u < DB * HH; u += gridDim.x) hgrn_sample_unit(p, l, u, lds); }
    }
    for (int u = blockIdx.x; u < NP / 16; u += gridDim.x) pool_tile16(p, l, u);
    for (int u = NP / 4 + blockIdx.x; u < (NTOK + 3) / 4; u += gridDim.x) pool_pre_unit(p, l, u);
}
DEV void phase_mix2(const Params& p, int l) { for (int u = blockIdx.x; u < PB * HH * 8; u += gridDim.x) hgrn_scan_unit(p, l, u); }
DEV void phase_mix3(const Params& p, int l, unsigned char* lds) { for (int u = blockIdx.x; u < hg::NUNIT; u += gridDim.x) hgrn_post_unit(p, l, u, lds); }

#ifdef HIPEMU
#define MBCNT(mask) __builtin_popcountll((mask) & ((1ull << emu_lane()) - 1ull))
#define POPC64(m) __builtin_popcountll(m)
#else
#define MBCNT(mask) ((int)__builtin_amdgcn_mbcnt_hi((unsigned)((mask) >> 32), __builtin_amdgcn_mbcnt_lo((unsigned)(mask), 0u)))
#define POPC64(m) __popcll(m)
#endif
DEV unsigned fkey(float f) { const unsigned u = __float_as_uint(f); return u ^ ((unsigned)((int)u >> 31) | 0x80000000u); }
DEV unsigned long long lowest_n_bits(unsigned long long m, int n) { unsigned long long r = 0ull; while (n > 0 && m) { const unsigned long long b = m & (~m + 1ull); r |= b; m ^= b; --n; } return r; }
#ifdef HIPEMU
#define DPPU_XOR1(v) __shfl((v), emu_lane() ^ 1)
#define DPPU_XOR2(v) __shfl((v), emu_lane() ^ 2)
#define DPPU_HMIRROR(v) __shfl((v), (emu_lane() & ~7) | (7 - (emu_lane() & 7)))
#else
template <int CTRL> DEV unsigned dpp_u(unsigned v) { return (unsigned)__builtin_amdgcn_update_dpp(0, (int)v, CTRL, 0xf, 0xf, true); }
#define DPPU_XOR1(v) dpp_u<0xB1>(v)
#define DPPU_XOR2(v) dpp_u<0x4E>(v)
#define DPPU_HMIRROR(v) dpp_u<0x141>(v)
#endif
template <int GL> DEV unsigned group_sum(unsigned c) { c += DPPU_XOR1(c); c += DPPU_XOR2(c); if (GL == 8) c += DPPU_HMIRROR(c); return c; }
template <int GL> DEV unsigned group_or(unsigned c) { c |= DPPU_XOR1(c); c |= DPPU_XOR2(c); if (GL == 8) c |= DPPU_HMIRROR(c); return c; }
template <int GL> DEV float group_maxf(float v) { v = fmaxf(v, DPP_XOR1(v)); v = fmaxf(v, DPP_XOR2(v)); if (GL == 8) v = fmaxf(v, DPP_HMIRROR(v)); return v; }
template <int GL> DEV float group_sumf(float v) { v += DPP_XOR1(v); v += DPP_XOR2(v); if (GL == 8) v += DPP_HMIRROR(v); return v; }
DEV unsigned bytesum(unsigned w) { return (w * 0x01010101u) >> 24; }
template <int GL> DEV unsigned group_excl_prefix(unsigned c, int sub) {
    const unsigned sh = 8u * (unsigned)(sub & 3);
    unsigned wlo = (GL == 4 || sub < 4) ? (c << sh) : 0u, whi = (GL == 8 && sub >= 4) ? (c << sh) : 0u;
    wlo = group_or<GL>(wlo);
    unsigned r;
    if (GL == 4) r = bytesum(wlo & ((1u << sh) - 1u));
    else { whi = group_or<GL>(whi); r = sub < 4 ? bytesum(wlo & ((1u << sh) - 1u)) : bytesum(wlo) + bytesum(whi & ((1u << sh) - 1u)); }
    return r;
}
DEV float fkey_inv(unsigned k) { return __uint_as_float((k & 0x80000000u) ? (k ^ 0x80000000u) : ~k); }
template <int NK> DEV unsigned count_above(const unsigned (&k)[NK], unsigned t) {
    unsigned c[4] = {0u, 0u, 0u, 0u};
#pragma unroll
    for (int i = 0; i < NK; ++i) c[i & 3] += (k[i] > t) ? 1u : 0u;
    return (c[0] + c[1]) + (c[2] + c[3]);
}
template <int GL, int NK> DEV unsigned group_top16(const unsigned (&k)[NK], bool active, int sub, unsigned& pos0) {
    unsigned mxk = 0u;
#pragma unroll
    for (int i = 0; i < NK; ++i) mxk = k[i] > mxk ? k[i] : mxk;
    { unsigned o = DPPU_XOR1(mxk); mxk = o > mxk ? o : mxk; o = DPPU_XOR2(mxk); mxk = o > mxk ? o : mxk; if (GL == 8) { o = DPPU_HMIRROR(mxk); mxk = o > mxk ? o : mxk; } }
    unsigned L0 = mxk > 0x01000000u ? mxk - 0x01000000u : 0u, c0 = group_sum<GL>(count_above<NK>(k, L0));
    unsigned L = c0 > 16u ? L0 + 1u : 0u, R = active ? mxk : 0u, cR = 0u;
    if (!active) L = 0u;
    if (c0 == 16u && active) { L = L0; R = L0; cR = 16u; }
    for (;;) {
        if (__ballot(L < R) == 0ull) break;
        const unsigned mid = L + ((R - L) >> 1);
        const unsigned c = group_sum<GL>(count_above<NK>(k, mid));
        const bool le = c <= 16u, hit = c == 16u;
        R = le ? mid : R; cR = le ? c : cR; L = hit ? mid : (le ? L : mid + 1u);
    }
    unsigned mask = 0u;
#pragma unroll
    for (int i = 0; i < NK; ++i) mask |= (k[i] > R) ? (1u << i) : 0u;
    const unsigned need = 16u - cR;
    if (__ballot(active && need > 0u) != 0ull) {
        unsigned eqm = 0u;
#pragma unroll
        for (int i = 0; i < NK; ++i) eqm |= (k[i] == R) ? (1u << i) : 0u;
        const unsigned eqc = (unsigned)__builtin_popcount(eqm), before = group_excl_prefix<GL>(eqc, sub);
        unsigned take = need > before ? need - before : 0u; if (take > eqc) take = eqc;
        if (!active) take = 0u;
        while (take > 0u) { const unsigned b = eqm & (~eqm + 1u); mask |= b; eqm ^= b; --take; }
    }
    if (!active) mask = 0u;
    pos0 = group_excl_prefix<GL>((unsigned)__builtin_popcount(mask), sub);
    return mask;
}
#ifdef HIPEMU
template <int J> DEV unsigned row_bcast_u(unsigned v) { return __shfl(v, (emu_lane() & ~15) | J); }
#else
template <int J> DEV unsigned row_bcast_u(unsigned v) { return (unsigned)__builtin_amdgcn_update_dpp(0, (int)v, 0x150 + J, 0xf, 0xf, true); }
#endif
template <int J> struct RowRank { static DEV unsigned run(unsigned v, int l16) { const unsigned b = row_bcast_u<J>(v); return (((b > v) || (b == v && J < l16)) ? 1u : 0u) + RowRank<J - 1>::run(v, l16); } };
template <> struct RowRank<-1> { static DEV unsigned run(unsigned, int) { return 0u; } };
struct CandTab { unsigned char ij[56]; };
DEV CandTab make_cand_tab() { CandTab t{}; int n = 0; for (int i = 0; i < 16; ++i) for (int j = 0; j < 16 / (i + 1); ++j) t.ij[n++] = (unsigned char)(i * 16 + j); for (; n < 56; ++n) t.ij[n] = 255; return t; }
constexpr int SEL_NT = 4;
constexpr int SEL_RS = 144;
DEV void select_fetch(const Params& p, int h, int tt0, int tstride, int ntt, u32x4 (&qn)[SEL_NT]) {
    const int tk = threadIdx.x >> 5, part = threadIdx.x & 31;
#pragma unroll
    for (int k = 0; k < SEL_NT; ++k) { const int tile = tt0 + k * tstride, tok = tile * 16 + tk;
        qn[k] = (tile < ntt && tok < NTOK) ? *(const u32x4*)((const bf16_t*)p.qry + (size_t)tok * D + h * 256 + part * 8) : (u32x4){0u, 0u, 0u, 0u}; }
}
DEV void select_step(const Params& p, int l, int tt0, int tstride, int ntile, int ntt, int h, unsigned char* lds, const bf16x8 (&kh)[2][4], const bf16x8 (&kl)[2][4], u32x4 (&qn)[SEL_NT]) {
    const int tid = threadIdx.x, lane = tid & 63, w = tid >> 6, g = lane >> 4, c16 = lane & 15;
    constexpr int NTK = SEL_NT * 16;
    constexpr int QRS = 264;
    bf16_t* qh = (bf16_t*)lds;
    bf16_t* ql = qh + NTK * QRS;
    float* sc = (float*)(ql + NTK * QRS);
    float* ts = sc + 2 * NTK * SEL_RS;
    int* ti = (int*)(ts + 2 * NTK * 16);
    unsigned char* ctab = (unsigned char*)(ti + 2 * NTK * 16);
    if (tid == 0) { const CandTab t = make_cand_tab(); for (int n = 0; n < 56; ++n) ctab[n] = t.ij[n]; }
#pragma unroll
    for (int k = 0; k < SEL_NT; ++k) {
        const int tk = tid >> 5, part = tid & 31; const int tok = (tt0 + k * tstride) * 16 + tk;
        const u32x4 qw = qn[k];
        const f32x4 a = (f32x4){lo16(qw.x), hi16(qw.x), lo16(qw.y), hi16(qw.y)}, b2 = (f32x4){lo16(qw.z), hi16(qw.z), lo16(qw.w), hi16(qw.w)};
        float ss = a[0] * a[0] + a[1] * a[1] + a[2] * a[2] + a[3] * a[3] + b2[0] * b2[0] + b2[1] * b2[1] + b2[2] * b2[2] + b2[3] * b2[3];
        ss += __shfl_xor(ss, 1); ss += __shfl_xor(ss, 2); ss += __shfl_xor(ss, 4); ss += __shfl_xor(ss, 8);
        const float rn = rsqrtf(ss * (1.0f / 128.0f) + EPS);
        const float v[8] = {a[0] * rn, a[1] * rn, a[2] * rn, a[3] * rn, b2[0] * rn, b2[1] * rn, b2[2] * rn, b2[3] * rn};
        unsigned hi[4], lo[4];
#pragma unroll
        for (int j = 0; j < 4; ++j) { hi[j] = pack2(v[2 * j], v[2 * j + 1]); lo[j] = pack2(v[2 * j] - lo16(hi[j]), v[2 * j + 1] - hi16(hi[j])); }
        *(u32x4*)(qh + (k * 16 + tk) * QRS + part * 8) = (u32x4){hi[0], hi[1], hi[2], hi[3]}; *(u32x4*)(ql + (k * 16 + tk) * QRS + part * 8) = (u32x4){lo[0], lo[1], lo[2], lo[3]};
    }
    select_fetch(p, h, tt0 + SEL_NT * tstride, tstride, ntt, qn);
    __syncthreads();
    for (int k = 0; k < ntile; ++k) {
#pragma unroll
        for (int ph = 0; ph < 2; ++ph) {
            f32x4 acc = (f32x4){0.f, 0.f, 0.f, 0.f};
#pragma unroll
            for (int ks = 0; ks < 4; ++ks) {
                const bf16x8 ah = *(const bf16x8*)(qh + (k * 16 + c16) * QRS + ph * 128 + 32 * ks + 8 * g), al = *(const bf16x8*)(ql + (k * 16 + c16) * QRS + ph * 128 + 32 * ks + 8 * g);
                acc = MFMA_BF16(al, kh[ph][ks], acc); acc = MFMA_BF16(ah, kl[ph][ks], acc); acc = MFMA_BF16(ah, kh[ph][ks], acc);
            }
            const int kidx = 16 * w + c16;
#pragma unroll
            for (int r = 0; r < 4; ++r) sc[(ph * NTK + k * 16 + 4 * g + r) * SEL_RS + (kidx >> 5) * 36 + (kidx & 31)] = acc[r];
        }
    }
    __syncthreads();
    {
        const int row = tid >> 2, sub = tid & 3; const bool active = ((row % NTK) >> 4) < ntile;
        unsigned k[32];
#pragma unroll
        for (int i4 = 0; i4 < 8; ++i4) { const f32x4 v = *(const f32x4*)(sc + row * SEL_RS + sub * 36 + 4 * i4); k[4 * i4] = fkey(v[0]); k[4 * i4 + 1] = fkey(v[1]); k[4 * i4 + 2] = fkey(v[2]); k[4 * i4 + 3] = fkey(v[3]); }
        unsigned pos; const unsigned mask = group_top16<4, 32>(k, active, sub, pos);
#pragma unroll
        for (int i = 0; i < 32; ++i) if ((mask >> i) & 1u) { if (pos < 16u) { ts[row * 16 + pos] = fkey_inv(k[i]); ti[row * 16 + pos] = 32 * sub + i; } ++pos; }
    }
    __syncthreads();
    {
        float v4[4]; int i4[4]; unsigned rk[4];
#pragma unroll
        for (int r = 0; r < (2 * NTK) / 32; ++r) { const int row = (tid >> 4) + 32 * r; v4[r] = ts[row * 16 + (tid & 15)]; i4[r] = ti[row * 16 + (tid & 15)]; }
#pragma unroll
        for (int r = 0; r < (2 * NTK) / 32; ++r) rk[r] = RowRank<15>::run(fkey(v4[r]), tid & 15);
        __syncthreads();
#pragma unroll
        for (int r = 0; r < (2 * NTK) / 32; ++r) { const int row = (tid >> 4) + 32 * r; ts[row * 16 + rk[r]] = v4[r]; ti[row * 16 + rk[r]] = i4[r]; }
    }
    __syncthreads();
    {
        const int tk = tid >> 3, sub = tid & 7; const bool active = (tk >> 4) < ntile;
        unsigned k[7]; unsigned cij[7];
#pragma unroll
        for (int q = 0; q < 7; ++q) { cij[q] = ctab[7 * sub + q]; const bool ok = cij[q] != 255u;
            k[q] = ok ? fkey(ts[tk * 16 + (cij[q] >> 4)] + ts[(NTK + tk) * 16 + (cij[q] & 15u)]) : 0u; }
        unsigned pos; const unsigned mask = group_top16<8, 7>(k, active, sub, pos);
        u32x2* lst = (u32x2*)sc;
#pragma unroll
        for (int q = 0; q < 7; ++q) if ((mask >> q) & 1u) { if (pos < 16u) lst[tk * 16 + pos] = (u32x2){__float_as_uint(fkey_inv(k[q])), (unsigned)(ti[tk * 16 + (cij[q] >> 4)] * 128 + ti[(NTK + tk) * 16 + (cij[q] & 15u)])}; ++pos; }
    }
    __syncthreads();
#pragma unroll
    for (int r = 0; r < NTK / 32; ++r) {
        const int tk = (tid >> 4) + 32 * r, slot = tid & 15; const int tok = (tt0 + (tk >> 4) * tstride) * 16 + (tk & 15);
        const u32x2 en = ((const u32x2*)sc)[tk * 16 + slot];
        const float v = __uint_as_float(en.x); const int e = (int)en.y;
        float mx = v; mx = fmaxf(mx, DPP_XOR1(mx)); mx = fmaxf(mx, DPP_XOR2(mx)); mx = fmaxf(mx, DPP_HMIRROR(mx)); mx = fmaxf(mx, DPP_RMIRROR(mx));
        const float ex = __expf(v - mx);
        float sm = ex; sm += DPP_XOR1(sm); sm += DPP_XOR2(sm); sm += DPP_HMIRROR(sm); sm += DPP_RMIRROR(sm);
        if ((tk >> 4) < ntile && tok < NTOK) { const size_t o = (size_t)tok * 128 + h * 16 + slot;
            p.eidx[o] = (unsigned short)e; p.gate[o] = ex / sm; }
    }
    __syncthreads();
}
DEV void phase_select(const Params& p, int l, unsigned char* lds) {
    const int ntt = (NTOK + 15) / 16, lane = threadIdx.x & 63, w = threadIdx.x >> 6, g = lane >> 4, c16 = lane & 15;
    const bool fixed = (gridDim.x % 8u) == 0u;
    const int nq = fixed ? (int)(gridDim.x >> 3) : 1;
    for (int hh = 0; hh < (fixed ? 1 : 8); ++hh) {
        const int h = fixed ? (int)(blockIdx.x & 7) : hh;
        bf16x8 kh[2][4], kl[2][4];
#pragma unroll
        for (int ph = 0; ph < 2; ++ph)
#pragma unroll
            for (int ks = 0; ks < 4; ++ks) { const float* kr = p.peer_keys + ((size_t)((l * 8 + h) * 2 + ph) * 128 + 16 * w + c16) * 128 + 32 * ks + 8 * g;
                const f32x4 a = *(const f32x4*)kr, b2 = *(const f32x4*)(kr + 4); const float v[8] = {a[0], a[1], a[2], a[3], b2[0], b2[1], b2[2], b2[3]};
                u32x4 hi, lo; unsigned hw[4], lw[4];
#pragma unroll
                for (int j = 0; j < 4; ++j) { hw[j] = pack2(v[2 * j], v[2 * j + 1]); lw[j] = pack2(v[2 * j] - lo16(hw[j]), v[2 * j + 1] - hi16(hw[j])); }
                hi = (u32x4){hw[0], hw[1], hw[2], hw[3]}; lo = (u32x4){lw[0], lw[1], lw[2], lw[3]};
                kh[ph][ks] = __builtin_bit_cast(bf16x8, hi); kl[ph][ks] = __builtin_bit_cast(bf16x8, lo); }
        const int first = fixed ? (int)(blockIdx.x >> 3) : (int)blockIdx.x, stride = fixed ? nq : (int)gridDim.x;
        u32x4 qn[SEL_NT];
        select_fetch(p, h, first, stride, ntt, qn);
        for (int tt0 = first; tt0 < ntt; tt0 += SEL_NT * stride) {
            int ntile = 0;
#pragma unroll
            for (int k = 0; k < SEL_NT; ++k) if (tt0 + k * stride < ntt) ntile = k + 1;
            select_step(p, l, tt0, stride, ntile, ntt, h, lds, kh, kl, qn);
        }
    }
}

constexpr int PEER_TB = 272;
struct PeerDeal { int xs_first, xs_step, t_begin, t_end; };
DEV PeerDeal peer_deal() {
    PeerDeal d; const bool sl = (gridDim.x % 8u) == 0u;
    const int nranks = sl ? (int)(gridDim.x >> 3) : (int)gridDim.x, rank = sl ? (int)(blockIdx.x >> 3) : (int)blockIdx.x, tpr = (NTOK + nranks - 1) / nranks;
    d.xs_first = sl ? (int)(blockIdx.x & 7) : 0; d.xs_step = sl ? 8 : 1; d.t_begin = rank * tpr; d.t_end = d.t_begin + tpr < NTOK ? d.t_begin + tpr : NTOK;
    return d;
}
struct PeerTok { u32x4 e0, e1, d1, d0; float hs; };
DEV void peer_fetch_u(const Params& p, int t, int blk, int g8, PeerTok& k) {
    const u32x4* ep = (const u32x4*)(p.eidx + (size_t)t * 128 + 16 * g8); k.e0 = ep[0]; k.e1 = ep[1];
    const u32x4* hp = (const u32x4*)(p.hd + ((size_t)t * 64 + blk) * 8); k.d1 = hp[0]; k.d0 = hp[1]; k.hs = p.hs[(size_t)t * 64 + blk];
}
DEV void peer_rows_u(const unsigned char* Us, unsigned joff, const PeerTok& k, u32x4 (&q)[16]) {
    const unsigned ew[8] = {k.e0.x, k.e0.y, k.e0.z, k.e0.w, k.e1.x, k.e1.y, k.e1.z, k.e1.w}; unsigned ev[16];
#pragma unroll
    for (int i = 0; i < 8; ++i) { ev[2 * i] = ew[i] & 0xffffu; ev[2 * i + 1] = ew[i] >> 16; }
#pragma unroll
    for (int i = 0; i < 16; ++i) q[i] = *(const u32x4*)(Us + (ev[i] * 128u + joff));
}
DEV void phase_peer_u(const Params& p, int l, unsigned char* lds) {
    const int lane = threadIdx.x & 63, w = wave_id(), j8 = lane & 7, g8 = lane >> 3;
    const bool b2 = (j8 & 4) != 0, b1 = (j8 & 2) != 0, b0 = (j8 & 1) != 0;
    const PeerDeal dl = peer_deal();
    const unsigned char* U = p.u8 + (size_t)l * NE * (D / 2);
    const int t0 = dl.t_begin + w;
    if (t0 >= dl.t_end) return;
    const int tl = t0 + ((dl.t_end - 1 - t0) / 8) * 8;
    for (int xs = dl.xs_first; xs < 8; xs += dl.xs_step) {
        const int blk = 8 * xs + j8;
        const unsigned char* Us = U + (size_t)xs * NE * 128; const unsigned joff = 16u * (unsigned)j8;
        PeerTok m1, m2; u32x4 qn[16];
        peer_fetch_u(p, t0, blk, g8, m1);
        { const int ta = t0 + 8 < tl ? t0 + 8 : tl; peer_fetch_u(p, ta, blk, g8, m2); }
        peer_rows_u(Us, joff, m1, qn);
        for (int t = t0; t < dl.t_end; t += 8) {
            const PeerTok cu = m1;
            u32x4 q[16];
#pragma unroll
            for (int i = 0; i < 16; ++i) q[i] = qn[i];
            m1 = m2;
            peer_rows_u(Us, joff, m1, qn);
            { const int tb = t + 16 < tl ? t + 16 : tl; peer_fetch_u(p, tb, blk, g8, m2); }
            float ps[16];
#pragma unroll
            for (int i = 0; i < 16; ++i) {
                int a1 = SDOT8(q[i].x, cu.d1.x, 0), a0 = SDOT8(q[i].x, cu.d0.x, 0);
                a1 = SDOT8(q[i].y, cu.d1.y, a1); a0 = SDOT8(q[i].y, cu.d0.y, a0);
                a1 = SDOT8(q[i].z, cu.d1.z, a1); a0 = SDOT8(q[i].z, cu.d0.z, a0);
                a1 = SDOT8(q[i].w, cu.d1.w, a1); a0 = SDOT8(q[i].w, cu.d0.w, a0);
                ps[i] = (float)(a1 * 16 + a0) * cu.hs; }
            float q8[8], q4[4], q2[2];
#pragma unroll
            for (int k = 0; k < 8; ++k) { const float keep = b2 ? ps[8 + k] : ps[k], send = b2 ? ps[k] : ps[8 + k]; q8[k] = keep + DPP_HMIRROR(send); }
#pragma unroll
            for (int k = 0; k < 4; ++k) { const float keep = b1 ? q8[4 + k] : q8[k], send = b1 ? q8[k] : q8[4 + k]; q4[k] = keep + DPP_XOR2(send); }
#pragma unroll
            for (int k = 0; k < 2; ++k) { const float keep = b0 ? q4[2 + k] : q4[k], send = b0 ? q4[k] : q4[2 + k]; q2[k] = keep + DPP_XOR1(send); }
            float* dst = p.part + ((size_t)t * 8 + xs) * 128 + 16 * g8 + 2 * j8; *(f32x2*)dst = (f32x2){q2[0], q2[1]};
        }
    }
}
DEV void phase_peer_c(const Params& p, int l) {
    const size_t n = (size_t)NTOK * 128, gs = (size_t)gridDim.x * 512;
    for (size_t i = (size_t)blockIdx.x * 512 + threadIdx.x; i < n; i += gs) {
        const size_t t = i >> 7; const int pr = (int)(i & 127); float sacc = 0.f;
        const int e = p.eidx[i]; const float sv = p.sv[l * NE + e], gt = p.gate[i];
        const float* sup = p.su + ((size_t)l * NE + e) * 8; const f32x4 s0 = *(const f32x4*)sup, s1 = *(const f32x4*)(sup + 4);
        const float sx[8] = {s0[0], s0[1], s0[2], s0[3], s1[0], s1[1], s1[2], s1[3]};
#pragma unroll
        for (int x = 0; x < 8; ++x) sacc += p.part[(t * 8 + x) * 128 + pr] * sx[x];
        p.ab16[i] = (bf16_t)f2bf(gelu_erf(sacc) * gt * sv);
    }
}
struct PeerTokV { u32x4 e0, e1, a0, a1; u32x2 x1; f32x4 g2; };
DEV void peer_fetch_v(const Params& p, int l, int t, int col, int g8, PeerTokV& k) {
    const u32x4* ep = (const u32x4*)(p.eidx + (size_t)t * 128 + 16 * g8); k.e0 = ep[0]; k.e1 = ep[1];
    const u32x4* ap = (const u32x4*)(p.ab16 + (size_t)t * 128 + 16 * g8); k.a0 = ap[0]; k.a1 = ap[1];
    k.x1 = *(const u32x2*)(p.xa + (size_t)t * D + col); k.g2 = *(const f32x4*)(p.modbuf + (size_t)tok_batch(t) * MODW + l * NMOD + 5 * D + col);
}
DEV void phase_peer_v(const Params& p, int l, unsigned char* lds) {
    const int lane = threadIdx.x & 63, w = wave_id(), j8 = lane & 7, g8 = lane >> 3;
    const bool b3 = (g8 & 1) != 0, b4 = (g8 & 2) != 0, b5 = (g8 & 4) != 0;
    const PeerDeal dl = peer_deal();
    const unsigned char* V = p.v8 + (size_t)l * NE * (D / 2);
    for (int xs = dl.xs_first; xs < 8; xs += dl.xs_step) {
        const int col = 256 * xs + 32 * j8 + (b3 ? 16 : 0) + (b4 ? 8 : 0) + (b5 ? 4 : 0);
        const unsigned char* Vs = V + (size_t)xs * NE * 128; const unsigned joff = 16u * (unsigned)j8;
        PeerTokV nx; if (dl.t_begin + w < dl.t_end) peer_fetch_v(p, l, dl.t_begin + w, col, g8, nx);
        for (int t = dl.t_begin + w; t < dl.t_end; t += 8) {
            const PeerTokV cu = nx;
            const unsigned ew[8] = {cu.e0.x, cu.e0.y, cu.e0.z, cu.e0.w, cu.e1.x, cu.e1.y, cu.e1.z, cu.e1.w}; unsigned ev[16];
#pragma unroll
            for (int i = 0; i < 8; ++i) { ev[2 * i] = ew[i] & 0xffffu; ev[2 * i + 1] = ew[i] >> 16; }
            u32x4 q[16];
#pragma unroll
            for (int i = 0; i < 16; ++i) q[i] = *(const u32x4*)(Vs + (ev[i] * 128u + joff));
            if (t + 8 < dl.t_end) peer_fetch_v(p, l, t + 8, col, g8, nx);
            const unsigned aw[8] = {cu.a0.x, cu.a0.y, cu.a0.z, cu.a0.w, cu.a1.x, cu.a1.y, cu.a1.z, cu.a1.w}; float av[16];
#pragma unroll
            for (int i = 0; i < 8; ++i) { av[2 * i] = lo16(aw[i]); av[2 * i + 1] = hi16(aw[i]); }
            f32x2 acc2[16];
#pragma unroll
            for (int k = 0; k < 16; ++k) acc2[k] = (f32x2){0.f, 0.f};
#pragma unroll
            for (int i = 0; i < 16; ++i) { f32x2 dq[16]; fp4x32_dec2(q[i], dq); const f32x2 a2v = (f32x2){av[i], av[i]};
#pragma unroll
                for (int k = 0; k < 16; ++k) acc2[k] = __builtin_elementwise_fma(a2v, dq[k], acc2[k]); }
            float acc[32];
#pragma unroll
            for (int k = 0; k < 16; ++k) { acc[2 * k] = acc2[k][0]; acc[2 * k + 1] = acc2[k][1]; }
            float q16[16], q8[8], q4[4];
#pragma unroll
            for (int k = 0; k < 16; ++k) { const float keep = b3 ? acc[16 + k] : acc[k], send = b3 ? acc[k] : acc[16 + k]; q16[k] = keep + DPP_XOR8(send); }
#pragma unroll
            for (int k = 0; k < 8; ++k) q8[k] = xsum16(q16[k], q16[8 + k]);
#pragma unroll
            for (int k = 0; k < 4; ++k) q4[k] = xsum32(q8[k], q8[4 + k]);
            const f32x4 x1v = (f32x4){lo16(cu.x1.x), hi16(cu.x1.x), lo16(cu.x1.y), hi16(cu.x1.y)}; f32x4 o;
#pragma unroll
            for (int k = 0; k < 4; ++k) o[k] = x1v[k] + cu.g2[k] * q4[k];
            u32x2 ow; ow.x = pack2(o[0], o[1]); ow.y = pack2(o[2], o[3]); *(u32x2*)(p.xb + (size_t)t * D + col) = ow;
        }
    }
}

constexpr int N_PHASES = 27;
DEV int phase_class(int k) { return k < 2 ? k : (k == 26 ? 14 : 2 + (k - 2) % 12); }
#ifndef HIPEMU
#define XB_TMO      128
#define XB_XCNT(j)  (256  + 64 * (j))
#define XB_XSUB(j)  (1280 + 64 * (j))
#define XB_XGEN(j)  (2304 + 64 * (j))
#define XB_TOP      3328
#define XB_TOPGEN   3392
#define XCD_BAR_WORDS 3456
#define XB_SPIN_CAP (1u << 22)
__device__ __forceinline__ unsigned xb_ld(unsigned* p)              { return __hip_atomic_load(p, __ATOMIC_RELAXED, __HIP_MEMORY_SCOPE_AGENT); }
__device__ __forceinline__ unsigned xb_add(unsigned* p, unsigned v) { return __hip_atomic_fetch_add(p, v, __ATOMIC_RELAXED, __HIP_MEMORY_SCOPE_AGENT); }
__device__ __forceinline__ unsigned xb_xcc_id() { return (unsigned)__builtin_amdgcn_s_getreg((3 << 11) | 20) & 0xFu; }
#define XB_SPIN(cond, bar) do { unsigned _sp = 0; while (cond) { __builtin_amdgcn_s_sleep(1); \
    if ((++_sp & 255u) == 0u) { if (xb_ld(&(bar)[XB_TMO])) break; if (_sp > XB_SPIN_CAP) { atomicAdd(&(bar)[XB_TMO], 1u); break; } } } } while (0)
struct XcdBarrier { unsigned* bar; unsigned x; volatile LAS unsigned* st; };
__device__ __forceinline__ XcdBarrier xcd_barrier_post(unsigned* bar, volatile LAS unsigned* st) {
    XcdBarrier b; b.bar = bar; b.x = xb_xcc_id(); b.st = st;
    if (threadIdx.x == 0) (void)xb_add(&bar[XB_XCNT(b.x)], 1u);
    return b;
}
__device__ __forceinline__ void xcd_barrier_complete(unsigned* bar, unsigned x, unsigned& nloc, unsigned& nx) {
    const unsigned G = gridDim.x * gridDim.y * gridDim.z;
    unsigned sum, cnt, mine, sp = 0u;
    for (;;) {
        sum = 0u; cnt = 0u; mine = 0u;
#pragma unroll
        for (unsigned j = 0; j < 16; ++j) { const unsigned c = xb_ld(&bar[XB_XCNT(j)]); sum += c; cnt += (c > 0u) ? 1u : 0u; mine = (j == x) ? c : mine; }
        if (sum == G) break;
        __builtin_amdgcn_s_sleep(1);
        if ((++sp & 255u) == 0u) { if (xb_ld(&bar[XB_TMO])) break; if (sp > XB_SPIN_CAP) { atomicAdd(&bar[XB_TMO], 1u); break; } }
    }
    nloc = mine > 0u ? mine : 1u; nx = cnt > 0u ? cnt : 1u;
}
__device__ __forceinline__ void xcd_barrier(const XcdBarrier& b) {
    asm volatile("s_waitcnt vmcnt(0)" ::: "memory");
    __syncthreads();
    if (threadIdx.x == 0) {
        unsigned* bar = b.bar;
        __builtin_amdgcn_s_waitcnt(0);
        unsigned nloc = b.st[0], nx = b.st[1];
        if (nloc == 0u) { xcd_barrier_complete(bar, b.x, nloc, nx); b.st[0] = nloc; b.st[1] = nx; }
        const unsigned old = xb_add(&bar[XB_XSUB(b.x)], 1u);
        const unsigned gen = old / nloc;
        if (old + 1u == (gen + 1u) * nloc) {
            __builtin_amdgcn_fence(__ATOMIC_RELEASE, "agent");
            asm volatile("s_waitcnt vmcnt(0)" ::: "memory");
            const unsigned og = xb_add(&bar[XB_TOP], 1u);
            const unsigned tg = og / nx;
            if (og + 1u == (tg + 1u) * nx) xb_add(&bar[XB_TOPGEN], 1u);
            else XB_SPIN(xb_ld(&bar[XB_TOPGEN]) == tg, bar);
            __builtin_amdgcn_fence(__ATOMIC_ACQUIRE, "agent");
            xb_add(&bar[XB_XGEN(b.x)], 1u);
            asm volatile("s_waitcnt vmcnt(0)" ::: "memory");
        } else {
            XB_SPIN(xb_ld(&bar[XB_XGEN(b.x)]) == gen, bar);
            __builtin_amdgcn_fence(__ATOMIC_ACQUIRE, "agent");
            asm volatile("s_waitcnt vmcnt(0)" ::: "memory");
        }
    }
    __syncthreads();
}
#endif

constexpr int LDS_BYTES = 163840;
constexpr int LDS_BARW = LDS_BYTES - 16;

#ifndef PH_MASK
#define PH_MASK 0xFFFFFFFFu
#endif
#ifndef PROBE_DUP
#define PROBE_DUP 0u
#endif
#define DUP_N(k) (1 + (int)((PROBE_DUP >> phase_class(k)) & 1u))
#define PH_BIT(k) ((PH_MASK >> phase_class(k)) & 1u)
#ifdef HIPEMU
static void run_phase(const Params& pp, int ph, unsigned char* lds)
#define GRID_BAR() do {} while (0)
#define IN(k) (ph == (k))
#define GLDS lds
#define LOADP() const Params& p = pp
#else
typedef const __attribute__((address_space(4))) unsigned char* kargp_t;
__device__ __forceinline__ kargp_t karg_ptr() { kargp_t kp = (kargp_t)__builtin_amdgcn_kernarg_segment_ptr(); asm volatile("" : "+s"(kp)); return kp; }
#define LOADP() Params p; __builtin_memcpy(&p, karg_ptr(), sizeof(Params))
#define IN(k) (PH_BIT(k) && ph_lo <= (k) && (k) < ph_hi)
#define GLDS ((LAS unsigned char*)lds_raw)
__global__ void __launch_bounds__(512, 2) mega_fwd(Params p_unused)
#endif
{
#ifndef HIPEMU
    extern __shared__ __attribute__((aligned(16))) unsigned char lds_raw[];
    unsigned char* lds = lds_raw;
    if (threadIdx.x == 0) { *(volatile unsigned*)(lds_raw + LDS_BARW) = 0u; *(volatile unsigned*)(lds_raw + LDS_BARW + 4) = 0u; }
    __syncthreads();
    int ph_lo, ph_hi; XcdBarrier bar;
    { LOADP(); ph_lo = p.ph_lo; ph_hi = p.ph_hi; bar.bar = p.bar; bar.x = 0; bar.st = nullptr; }
    const bool multi = (ph_hi - ph_lo) > 1;
    if (multi) bar = xcd_barrier_post(bar.bar, (volatile LAS unsigned*)(lds_raw + LDS_BARW));
#define GRID_BAR() do { if (multi) xcd_barrier(bar); } while (0)
#endif
    if (IN(0)) { for (int rep = 0; rep < DUP_N(0); ++rep) { LOADP(); for (int u = blockIdx.x; u < ADA_UNITS; u += gridDim.x) ada_direct_unit(p, u, lds); } }
    if (IN(1)) { LOADP(); phase_convert(p, lds, 1); GRID_BAR(); }
#define LAYER(l) do { \
        constexpr int base = 2 + 12 * (l); \
        if (IN(base + 0)) { for (int rep = 0; rep < DUP_N(base + 0); ++rep) { LOADP(); phase_norm(p, p.x_prompt, p.x_sample, (l) == 0 ? (const bf16_t*)nullptr : p.xb, p.norm1_g + (l) * D, (l) * NMOD + 0 * D, (l) * NMOD + 1 * D, p.hA, nullptr, nullptr, nullptr); GRID_BAR(); } } \
        if (IN(base + 1)) { for (int rep = 0; rep < DUP_N(base + 1); ++rep) { LOADP(); \
            pg8::Gemm g{p.hA, p.wt_in + (size_t)(l) * ZW * D, MPAD, ZW, D}; pg8::StaticOrder S; S.init(MPAD, ZW, gridDim.x, blockIdx.x); \
            pg8::EpiBf16 E{p.z, ZW}; \
            pg8::gemm_phase<pg8::EpiBf16, pg8::StaticOrder>(GLDS, g, S, E); } } \
        if (IN(base + 1)) { LOADP(); phase_tbl_slot(p, (l)); GRID_BAR(); } \
        if (IN(base + 2)) { for (int rep = 0; rep < DUP_N(base + 2); ++rep) { LOADP(); phase_mix1(p, (l), lds); GRID_BAR(); } } \
        if (IN(base + 3)) { for (int rep = 0; rep < DUP_N(base + 3); ++rep) { LOADP(); phase_mix2(p, (l)); GRID_BAR(); } } \
        if (IN(base + 4)) { LOADP(); phase_mix3(p, (l), lds); } \
        if (IN(base + 4)) { LOADP(); \
            pg8::Gemm g{p.pooled, p.wt_pool + (size_t)(l) * 1024 * 256, 4 * MPAD, 1024, 256}; pg8::PoolOrder S{(int)gridDim.x, (int)(gridDim.x - 1 - blockIdx.x)}; \
            pg8::EpiPool E{p.cat, p.pool_b + (l) * PW, p.pool_scale + (l) * PW}; \
            pg8::gemm_phase<pg8::EpiPool, pg8::PoolOrder>(GLDS, g, S, E); \
            GRID_BAR(); } \
        if (IN(base + 5)) { for (int rep = 0; rep < DUP_N(base + 5); ++rep) { LOADP(); \
            pg8::Gemm g{p.cat, p.wt_out + (size_t)(l) * D * D, MBIG, D, D}; pg8::StaticOrder S; S.init(MBIG, D, gridDim.x, blockIdx.x); \
            pg8::EpiResid E{p.x_prompt, p.x_sample, (l) == 0 ? (const bf16_t*)nullptr : p.xb, p.modbuf + (l) * NMOD + 2 * D, p.xa}; \
            pg8::gemm_phase<pg8::EpiResid, pg8::StaticOrder>(GLDS, g, S, E); \
            { SmallResid sf{E.xlo, E.xhi, E.x16, E.gmod, E.out}; small_gemm(p.cat, p.wt_out + (size_t)(l) * D * D, D, lds, sf); } \
            GRID_BAR(); } } \
        if (IN(base + 6)) { for (int rep = 0; rep < DUP_N(base + 6); ++rep) { LOADP(); phase_norm(p, p.x_prompt, p.x_sample, p.xa, p.norm2_g + (l) * D, (l) * NMOD + 3 * D, (l) * NMOD + 4 * D, p.hB, nullptr, p.hd, p.hs); GRID_BAR(); } } \
        if (IN(base + 7)) { for (int rep = 0; rep < DUP_N(base + 7); ++rep) { LOADP(); \
            pg8::Gemm g{p.hB, p.wt_q + (size_t)(l) * D * D, MBIG, D, D}; pg8::StaticOrder S; S.init(MBIG, D, gridDim.x, blockIdx.x); \
            pg8::EpiBf16 E{(bf16_t*)p.qry, D}; \
            pg8::gemm_phase<pg8::EpiBf16, pg8::StaticOrder>(GLDS, g, S, E); \
            { SmallBf16 sf{(bf16_t*)p.qry}; small_gemm(p.hB, p.wt_q + (size_t)(l) * D * D, D, lds, sf); } \
            GRID_BAR(); } } \
        if (IN(base + 8)) { for (int rep = 0; rep < DUP_N(base + 8); ++rep) { LOADP(); phase_select(p, (l), lds); GRID_BAR(); } } \
        if (IN(base + 9)) { for (int rep = 0; rep < DUP_N(base + 9); ++rep) { LOADP(); phase_peer_u(p, (l), lds); GRID_BAR(); } } \
        if (IN(base + 10)) { LOADP(); phase_peer_c(p, (l)); GRID_BAR(); } \
        if (IN(base + 11)) { for (int rep = 0; rep < DUP_N(base + 11); ++rep) { LOADP(); phase_peer_v(p, (l), lds); GRID_BAR(); } } \
    } while (0)
    LAYER(0);
    LAYER(1);
    if (IN(26)) { LOADP(); phase_norm(p, p.x_prompt, p.x_sample, p.xb, p.final_g, 2 * NMOD, 2 * NMOD + D, nullptr, p.out + OFF_Y, nullptr, nullptr); }
#undef LAYER
#undef IN
#undef GRID_BAR
#undef GLDS
#undef LOADP
}

struct WsLayout { size_t bar, modbuf, csil, wt_ada, wt_in, wt_out, wt_q, wt_pool, u8, v8, su, sv, hd, hs, part, hg_oin, hg_ds, hg_gam, hg_qh, hg_sc, hA, hB, z, pooled, cat, xa, xb, qry, eidx, gate, ab16, end; };
static WsLayout ws_layout() {
    WsLayout L; size_t o = 0;
    auto take = [&](size_t bytes) { const size_t r = o; o += (bytes + 255) & ~(size_t)255; return r; };
    L.bar = take(16384);
    L.modbuf = take((size_t)256 * MODW * 4);
    L.csil = take((size_t)256 * D * 2);
    L.wt_ada = take((size_t)MODW * D * 2);
    L.wt_in = take((size_t)2 * ZW * D * 2);
    L.wt_out = take((size_t)2 * D * D * 2);
    L.wt_q = take((size_t)2 * D * D * 2);
    L.wt_pool = take((size_t)2 * 1024 * 256 * 2);
    L.u8 = take((size_t)2 * NE * D);
    L.v8 = take((size_t)2 * NE * D);
    L.su = take((size_t)2 * NE * 8 * 4);
    L.sv = take((size_t)2 * NE * 4);
    L.hd = take((size_t)MPAD * 64 * 32);
    L.hs = take((size_t)MPAD * 64 * 4);
    L.part = take((size_t)MPAD * 8 * 128 * 4);
    L.hg_oin = take((size_t)hg::NUNIT * 64 * 128 * 2);
    L.hg_ds = take((size_t)hg::NUNIT * 128 * 128 * 2);
    L.hg_gam = take((size_t)hg::NUNIT * 128 * 4);
    L.hg_qh = take((size_t)NP * 1024 * 2);
    L.hg_sc = take((size_t)hg::NUNIT * 128 * 128 * 2);
    L.hA = take((size_t)MPAD * D * 2);
    L.hB = take((size_t)MPAD * D * 2);
    L.z = take((size_t)MPAD * ZW * 2);
    L.pooled = take((size_t)4 * MPAD * 256 * 2);
    L.cat = take((size_t)MPAD * D * 2);
    L.xa = take((size_t)MPAD * D * 2);
    L.xb = take((size_t)MPAD * D * 2);
    L.qry = take((size_t)MPAD * D * 4);
    L.eidx = take((size_t)MPAD * 128 * 2);
    L.gate = take((size_t)MPAD * 128 * 4);
    L.ab16 = take((size_t)MPAD * 128 * 2);
    L.end = o;
    return L;
}
static void fill_params(Params& p, void* const* d_in, void* d_out, void* d_ws) {
    const float** f = (const float**)&p;
    for (int i = 0; i < 24; ++i) f[i] = (const float*)d_in[i];
    p.out = (float*)d_out;
    const WsLayout L = ws_layout(); unsigned char* w = (unsigned char*)d_ws;
    p.bar = (unsigned*)(w + L.bar); p.modbuf = (float*)(w + L.modbuf); p.csil = (bf16_t*)(w + L.csil); p.wt_ada = (bf16_t*)(w + L.wt_ada); p.wt_in = (bf16_t*)(w + L.wt_in);
    p.wt_out = (bf16_t*)(w + L.wt_out); p.wt_q = (bf16_t*)(w + L.wt_q); p.wt_pool = (bf16_t*)(w + L.wt_pool); p.u8 = w + L.u8; p.v8 = w + L.v8; p.su = (float*)(w + L.su); p.sv = (float*)(w + L.sv); p.hd = (unsigned*)(w + L.hd); p.hs = (float*)(w + L.hs); p.part = (float*)(w + L.part); p.hg_oin = (bf16_t*)(w + L.hg_oin); p.hg_ds = (bf16_t*)(w + L.hg_ds); p.hg_gam = (float*)(w + L.hg_gam); p.hg_qh = (bf16_t*)(w + L.hg_qh); p.hg_sc = (bf16_t*)(w + L.hg_sc);
    p.hA = (bf16_t*)(w + L.hA); p.hB = (bf16_t*)(w + L.hB); p.z = (bf16_t*)(w + L.z); p.pooled = (bf16_t*)(w + L.pooled); p.cat = (bf16_t*)(w + L.cat);
    p.xa = (bf16_t*)(w + L.xa); p.xb = (bf16_t*)(w + L.xb); p.qry = (float*)(w + L.qry); p.eidx = (unsigned short*)(w + L.eidx); p.gate = (float*)(w + L.gate); p.ab16 = (bf16_t*)(w + L.ab16);
}

#ifndef HIPEMU
#ifndef MK_ONE_LAUNCH
#define MK_ONE_LAUNCH 1
#endif
extern "C" void kernel_launch(void* const* d_in, const int* in_sizes, int n_in, void* d_out, int out_size, void* d_ws, size_t ws_size, hipStream_t stream) {
    static int grid = 0;
    if (grid == 0) {
        const WsLayout L = ws_layout();
        if (n_in != 24 || (size_t)out_size != OUT_TOTAL || ws_size < L.end) { fprintf(stderr, "kernel_launch: unexpected shapes (n_in %d, out %d, ws %zu < %zu)\n", n_in, out_size, ws_size, L.end); grid = -1; return; }
        int dev = 0, cus = 0, per_cu = 0;
        hipGetDevice(&dev); hipDeviceGetAttribute(&cus, hipDeviceAttributeMultiprocessorCount, dev);
        if (hipFuncSetAttribute((const void*)mega_fwd, hipFuncAttributeMaxDynamicSharedMemorySize, LDS_BYTES) != hipSuccess) { fprintf(stderr, "kernel_launch: hipFuncSetAttribute failed\n"); grid = -1; return; }
        hipOccupancyMaxActiveBlocksPerMultiprocessor(&per_cu, (const void*)mega_fwd, 512, LDS_BYTES);
        (void)hipGetLastError();
        if (per_cu < 1) fprintf(stderr, "kernel_launch: occupancy query says %d blocks per CU\n", per_cu);
        grid = cus;
    }
    if (grid < 0) return;
    Params p{};
    fill_params(p, d_in, d_out, d_ws);
    hipMemsetAsync(p.bar, 0, 16384, stream);
#if MK_ONE_LAUNCH
    p.ph_lo = 0; p.ph_hi = N_PHASES;
    hipLaunchKernelGGL(mega_fwd, dim3(grid), dim3(512), LDS_BYTES, stream, p);
#else
    for (int ph = 0; ph < N_PHASES; ++ph) { p.ph_lo = ph; p.ph_hi = ph + 1; hipLaunchKernelGGL(mega_fwd, dim3(grid), dim3(512), LDS_BYTES, stream, p); }
#endif
}
#endif
```
